# Optimizing an MI355X kernel written in HIP

```python
import jax, jax.numpy as jnp
from jax import lax
import numpy as np

D_MODEL = 1024
BATCH = 8
SEQ = 8192
DEPTH = 1

CHUNK = 64

RWKV_WIDTH = D_MODEL // 2
RWKV_HEAD = 64
RWKV_HEADS = RWKV_WIDTH // RWKV_HEAD
DECAY_LORA = 64
AAA_LORA = 64
GATE_LORA = 128
GMLP_WIDTH = D_MODEL // 2
GMLP_BLOCK = 128
GMLP_GROUPS = 8
GMLP_GROUP_DIM = GMLP_WIDTH // GMLP_GROUPS
N_BRANCH = 2
RWKV_COLS = 3 * RWKV_WIDTH + DECAY_LORA + AAA_LORA + GATE_LORA
IN_COLS = RWKV_COLS + 2 * GMLP_WIDTH + N_BRANCH * D_MODEL
N_EXPERTS = 256
TOP_K = 8
N_EXPERT_GROUPS = 8
TOPK_GROUPS = 4
EXPERT_FF = D_MODEL // 4
SHARED_FF = D_MODEL // 4
ROUTED_SCALE = 2.5
DISPATCH_BLOCK = 128
RMS_EPS = 1e-6
LN_EPS = 1e-5
GN_EPS = 64e-5

kernel_name = "hybrid_rwkv7_gmlp_moe_adaln"


def rmsnorm(x, g):
    xf = x.astype(jnp.float32)
    y = xf * lax.rsqrt(jnp.mean(xf * xf, axis=-1, keepdims=True) + RMS_EPS)
    return (y * g.astype(jnp.float32)).astype(x.dtype)


def layernorm(x, g, b, eps):
    xf = x.astype(jnp.float32)
    mu = jnp.mean(xf, axis=-1, keepdims=True)
    var = jnp.mean(jnp.square(xf - mu), axis=-1, keepdims=True)
    return (xf - mu) * lax.rsqrt(var + eps) * g.astype(jnp.float32) + b.astype(jnp.float32)


def token_shift(p, mu):
    prev = jnp.pad(p, ((0, 0), (1, 0), (0, 0)))[:, :-1]
    return p + (prev - p) * mu


def rwkv7_scan(r, w, k, v, a, b):
    bsz, _, nh, n = r.shape

    def step(state, inp):
        r_t, w_t, k_t, v_t, a_t, b_t = inp
        sa = jnp.einsum('bhvk,bhk->bhv', state, a_t)
        state = (state * w_t[:, :, None, :] + sa[..., None] * b_t[:, :, None, :]
                 + v_t[..., None] * k_t[:, :, None, :])
        y = jnp.einsum('bhvk,bhk->bhv', state, r_t)
        return state, y

    s0 = jnp.zeros((bsz, nh, n, n), jnp.float32)
    xs = tuple(jnp.swapaxes(t, 0, 1) for t in (r, w, k, v, a, b))
    _, y = lax.scan(step, s0, xs)
    return jnp.swapaxes(y, 0, 1)


def rwkv7_mixer(p, w0, w_up, a0, a_up, g_up, k_k, k_a, r_k, ln_g, ln_b):
    p = p.astype(jnp.float32)
    bsz, s, _ = p.shape
    r, k, v, xw, xa, xg = jnp.split(
        p, [RWKV_WIDTH, 2 * RWKV_WIDTH, 3 * RWKV_WIDTH, 3 * RWKV_WIDTH + DECAY_LORA,
            3 * RWKV_WIDTH + DECAY_LORA + AAA_LORA], axis=-1)
    f32 = lambda t: t.astype(jnp.float32)
    w = -jax.nn.softplus(-(f32(w0) + jnp.tanh(xw) @ f32(w_up))) - 0.5
    decay = jnp.exp(-jnp.exp(w))
    a = jax.nn.sigmoid(f32(a0) + xa @ f32(a_up))
    g = jax.nn.sigmoid(xg) @ f32(g_up)
    hs = lambda t: t.reshape(bsz, s, RWKV_HEADS, RWKV_HEAD)
    kk = hs(k * f32(k_k))
    kk = kk / jnp.maximum(jnp.sqrt(jnp.sum(kk * kk, axis=-1, keepdims=True)), 1e-12)
    k = k * (1.0 + (a - 1.0) * f32(k_a))
    rh, kh, vh, ah = hs(r), hs(k), hs(v), hs(a)
    y = rwkv7_scan(rh, hs(decay), kh, vh, -kk, kk * ah)
    mu = jnp.mean(y, axis=-1, keepdims=True)
    var = jnp.mean(jnp.square(y - mu), axis=-1, keepdims=True)
    y = ((y - mu) * lax.rsqrt(var + GN_EPS)).reshape(bsz, s, RWKV_WIDTH)
    y = y * f32(ln_g) + f32(ln_b)
    bonus = jnp.sum(rh * kh * f32(r_k), axis=-1, keepdims=True) * vh
    y = y + bonus.reshape(bsz, s, RWKV_WIDTH)
    return y * g


def gmlp_mixer(u, v, ln_g, ln_b, ws, bs):
    bsz, s, _ = v.shape
    u = jax.nn.gelu(u.astype(jnp.float32))
    v = layernorm(jax.nn.gelu(v.astype(jnp.float32)), ln_g, ln_b, LN_EPS)
    nb = s // GMLP_BLOCK
    vb = v.reshape(bsz, nb, GMLP_BLOCK, GMLP_GROUPS, GMLP_GROUP_DIM)
    mask = jnp.tril(jnp.ones((GMLP_BLOCK, GMLP_BLOCK), dtype=bool))
    wsm = jnp.where(mask[None], ws.astype(jnp.float32), 0.0)
    sv = jnp.einsum('gij,bnjgc->bnigc', wsm, vb) + bs.astype(jnp.float32).T[None, None, :, :, None]
    return u * sv.reshape(bsz, s, GMLP_WIDTH)


def moe(h, router_w, router_bias, w1, w3, w2, sw1, sw3, sw2):
    bsz, s, d = h.shape
    t = bsz * s
    hf = h.reshape(t, d)
    scores = jax.nn.sigmoid(hf.astype(jnp.float32) @ router_w.astype(jnp.float32))
    sel = scores + router_bias.astype(jnp.float32)
    grp = sel.reshape(t, N_EXPERT_GROUPS, N_EXPERTS // N_EXPERT_GROUPS)
    grp_score = jnp.sum(lax.top_k(grp, 2)[0], axis=-1)
    _, gidx = lax.top_k(grp_score, TOPK_GROUPS)
    gmask = jnp.any(gidx[..., None] == jnp.arange(N_EXPERT_GROUPS)[None, None, :], axis=1)
    emask = jnp.repeat(gmask, N_EXPERTS // N_EXPERT_GROUPS, axis=-1)
    _, eidx = lax.top_k(jnp.where(emask, sel, -jnp.inf), TOP_K)
    wts = jnp.take_along_axis(scores, eidx, axis=-1)
    wts = wts / jnp.sum(wts, axis=-1, keepdims=True) * ROUTED_SCALE

    n_assign = t * TOP_K
    flat_e = eidx.reshape(n_assign)
    flat_tok = jnp.arange(n_assign, dtype=jnp.int32) // TOP_K
    flat_w = wts.reshape(n_assign)
    order = jnp.argsort(flat_e)
    se, stok, sw = flat_e[order], flat_tok[order], flat_w[order]
    counts = jnp.bincount(flat_e, length=N_EXPERTS)
    starts = jnp.cumsum(counts) - counts
    padded = (counts + DISPATCH_BLOCK - 1) // DISPATCH_BLOCK * DISPATCH_BLOCK
    pends = jnp.cumsum(padded)
    pstarts = pends - padded
    dest = pstarts[se] + jnp.arange(n_assign, dtype=jnp.int32) - starts[se]
    n_rows = n_assign + N_EXPERTS * DISPATCH_BLOCK
    n_blocks = n_rows // DISPATCH_BLOCK
    row_tok = jnp.zeros((n_rows,), jnp.int32).at[dest].set(stok)
    row_w = jnp.zeros((n_rows,), jnp.float32).at[dest].set(sw)
    block_start = jnp.arange(n_blocks, dtype=jnp.int32) * DISPATCH_BLOCK
    block_e = jnp.clip(jnp.searchsorted(pends, block_start, side='right'), 0, N_EXPERTS - 1)

    def block_step(acc, inp):
        tok, wt, e = inp
        xb = hf[tok]
        hid = jax.nn.silu(xb @ w1[e]) * (xb @ w3[e])
        yb = hid @ w2[e]
        acc = acc.at[tok].add((yb * wt[:, None]).astype(jnp.float32))
        return acc, None

    acc0 = jnp.zeros((t, d), jnp.float32)
    routed, _ = lax.scan(block_step, acc0,
                         (row_tok.reshape(n_blocks, DISPATCH_BLOCK),
                          row_w.reshape(n_blocks, DISPATCH_BLOCK), block_e))
    shared = (jax.nn.silu(hf @ sw1) * (hf @ sw3)) @ sw2
    return (routed + shared.astype(jnp.float32)).reshape(bsz, s, d)


def setup_inputs(seed: int = 0) -> dict:
    key = jax.random.key(seed)
    ks = jax.random.split(key, 40)
    L, D = DEPTH, D_MODEL
    nrm = lambda k, shape, scale: jax.random.normal(k, shape, jnp.float32) * scale
    gain = lambda k, shape: 1.0 + nrm(k, shape, 0.02)
    return {
        "x": nrm(ks[0], (BATCH, SEQ, D), 1.0),
        "c": nrm(ks[1], (BATCH, D), 1.0),
        "ada_w": nrm(ks[2], (L, D, 6 * D), 0.3 * D ** -0.5),
        "ada_b": nrm(ks[3], (L, 6 * D), 0.02),
        "norm1_g": gain(ks[4], (L, D)),
        "norm2_g": gain(ks[5], (L, D)),
        "w_in": nrm(ks[6], (L, D, IN_COLS), D ** -0.5),
        "tshift_mu": jax.random.uniform(ks[7], (L, RWKV_COLS), jnp.float32),
        "rwkv_w0": jax.random.uniform(ks[8], (L, RWKV_WIDTH), jnp.float32, -6.0, -1.0),
        "rwkv_w_up": nrm(ks[9], (L, DECAY_LORA, RWKV_WIDTH), 0.3 * DECAY_LORA ** -0.5),
        "rwkv_a0": nrm(ks[10], (L, RWKV_WIDTH), 0.1),
        "rwkv_a_up": nrm(ks[11], (L, AAA_LORA, RWKV_WIDTH), 0.5 * AAA_LORA ** -0.5),
        "rwkv_g_up": nrm(ks[12], (L, GATE_LORA, RWKV_WIDTH), GATE_LORA ** -0.5),
        "rwkv_k_k": 0.85 + nrm(ks[13], (L, RWKV_WIDTH), 0.02),
        "rwkv_k_a": gain(ks[14], (L, RWKV_WIDTH)),
        "rwkv_r_k": nrm(ks[15], (L, RWKV_HEADS, RWKV_HEAD), 0.1),
        "rwkv_ln_g": gain(ks[16], (L, RWKV_WIDTH)),
        "rwkv_ln_b": nrm(ks[17], (L, RWKV_WIDTH), 0.02),
        "gmlp_ln_g": gain(ks[18], (L, GMLP_WIDTH)),
        "gmlp_ln_b": nrm(ks[19], (L, GMLP_WIDTH), 0.02),
        "gmlp_ws": nrm(ks[20], (L, GMLP_GROUPS, GMLP_BLOCK, GMLP_BLOCK), GMLP_BLOCK ** -0.5),
        "gmlp_bs": 1.0 + nrm(ks[21], (L, GMLP_GROUPS, GMLP_BLOCK), 0.1),
        "w_out_a": nrm(ks[22], (L, RWKV_WIDTH, D), RWKV_WIDTH ** -0.5),
        "w_out_b": nrm(ks[23], (L, GMLP_WIDTH, D), GMLP_WIDTH ** -0.5),
        "w_out": nrm(ks[24], (L, D, D), D ** -0.5),
        "router_w": nrm(ks[25], (L, D, N_EXPERTS), D ** -0.5),
        "router_bias": nrm(ks[26], (L, N_EXPERTS), 0.01),
        "exp_w1": nrm(ks[27], (L, N_EXPERTS, D, EXPERT_FF), D ** -0.5),
        "exp_w3": nrm(ks[28], (L, N_EXPERTS, D, EXPERT_FF), D ** -0.5),
        "exp_w2": nrm(ks[29], (L, N_EXPERTS, EXPERT_FF, D), EXPERT_FF ** -0.5),
        "shared_w1": nrm(ks[30], (L, D, SHARED_FF), D ** -0.5),
        "shared_w3": nrm(ks[31], (L, D, SHARED_FF), D ** -0.5),
        "shared_w2": nrm(ks[32], (L, SHARED_FF, D), SHARED_FF ** -0.5),
        "normf_g": gain(ks[33], (D,)),
    }


def reference(x, c, ada_w, ada_b, norm1_g, norm2_g, w_in, tshift_mu,
              rwkv_w0, rwkv_w_up, rwkv_a0, rwkv_a_up, rwkv_g_up, rwkv_k_k, rwkv_k_a, rwkv_r_k,
              rwkv_ln_g, rwkv_ln_b, gmlp_ln_g, gmlp_ln_b, gmlp_ws, gmlp_bs,
              w_out_a, w_out_b, w_out, router_w, router_bias,
              exp_w1, exp_w3, exp_w2, shared_w1, shared_w3, shared_w2, normf_g):
    for l in range(DEPTH):
        mod = jax.nn.silu(c) @ ada_w[l] + ada_b[l]
        sh1, sc1, g1, sh2, sc2, g2 = jnp.split(mod[:, None, :], 6, axis=-1)

        h = rmsnorm(x, norm1_g[l]) * (1.0 + sc1) + sh1
        p = h @ w_in[l]
        p_rwkv, p_u, p_v, p_gate = jnp.split(
            p, [RWKV_COLS, RWKV_COLS + GMLP_WIDTH, RWKV_COLS + 2 * GMLP_WIDTH], axis=-1)
        p_rwkv = token_shift(p_rwkv, tshift_mu[l])
        y_a = rwkv7_mixer(p_rwkv, rwkv_w0[l], rwkv_w_up[l], rwkv_a0[l], rwkv_a_up[l], rwkv_g_up[l],
                          rwkv_k_k[l], rwkv_k_a[l], rwkv_r_k[l], rwkv_ln_g[l], rwkv_ln_b[l])
        y_b = gmlp_mixer(p_u, p_v, gmlp_ln_g[l], gmlp_ln_b[l], gmlp_ws[l], gmlp_bs[l])
        gate_a, gate_b = jnp.split(jax.nn.sigmoid(p_gate.astype(jnp.float32)), 2, axis=-1)
        merged = gate_a * (y_a @ w_out_a[l]) + gate_b * (y_b @ w_out_b[l])
        x = x + (g1 * (merged @ w_out[l])).astype(x.dtype)

        h = rmsnorm(x, norm2_g[l]) * (1.0 + sc2) + sh2
        y = moe(h, router_w[l], router_bias[l], exp_w1[l], exp_w3[l], exp_w2[l],
                shared_w1[l], shared_w3[l], shared_w2[l])
        x = x + (g2 * y).astype(x.dtype)
    return rmsnorm(x, normf_g)
```

```cpp
#define MK_SINGLE 1
#include <hip/hip_runtime.h>
#include <cstdio>
#include <cstdint>

#define LAS __attribute__((address_space(3)))
#define GAS __attribute__((address_space(1)))
typedef unsigned short bf16_t;
typedef short bf16x8 __attribute__((ext_vector_type(8)));
typedef float f32x4 __attribute__((ext_vector_type(4)));
typedef float f32x2 __attribute__((ext_vector_type(2)));
typedef unsigned u32x4 __attribute__((ext_vector_type(4)));
typedef unsigned u32x2 __attribute__((ext_vector_type(2)));

constexpr int D = 1024, NB = 8, SEQ = 8192, T = NB * SEQ;
constexpr int RW = 512, HD = 64, NH = 8;
constexpr int RWKV_COLS = 1792, IN_COLS = 4864;
constexpr int NE = 256, TOPK = 8, EFF = 256;
constexpr int NWAVES = 8, NTHREADS = 512;
constexpr int HALF_T = T / 2;
constexpr int MAXROWS = T * TOPK + 512 * 256;

constexpr size_t MiB = 1u << 20;
constexpr size_t WS_CTL = 0;
constexpr int CW_BAR = 0, CW_SEGCNT = 4096, CW_NT = 4608;
constexpr size_t CTL_ZERO_BYTES = 20480;
constexpr size_t WS_MOD = 65536;
constexpr size_t WS_SW = 1 * MiB;
constexpr size_t SW_WIN = WS_SW;
constexpr size_t SW_WOA = SW_WIN + (size_t)IN_COLS * D * 2;
constexpr size_t SW_WOB = SW_WOA + (size_t)D * RW * 2;
constexpr size_t SW_WO = SW_WOB + (size_t)D * RW * 2;
constexpr size_t SW_WR = SW_WO + (size_t)D * D * 2;
constexpr size_t SW_WS13 = SW_WR + (size_t)NE * D * 2;
constexpr size_t SW_WS2 = SW_WS13 + (size_t)512 * D * 2;
constexpr size_t SW_WUP = SW_WS2 + (size_t)D * EFF * 2;
constexpr size_t SW_AUP = SW_WUP + (size_t)RW * 64 * 2;
constexpr size_t SW_GUP = SW_AUP + (size_t)RW * 64 * 2;
constexpr size_t SW_WSM = SW_GUP + (size_t)RW * 128 * 2;
constexpr size_t SW_END = SW_WSM + (size_t)8 * 128 * 128 * 2;
static_assert(SW_END <= 20 * MiB, "small weights");
constexpr size_t WS_RT = 20 * MiB;
constexpr size_t RT_EIDX = WS_RT;
constexpr size_t RT_EWT = RT_EIDX + (size_t)T * 8 * 4;
constexpr size_t RT_LRANK = RT_EWT + (size_t)T * 8 * 4;
constexpr size_t RT_TBASE = RT_LRANK + (size_t)T * 8 * 4;
constexpr size_t RT_ROWTOK = RT_TBASE + (size_t)256 * 256 * 4;
constexpr size_t RT_ROWDST = RT_ROWTOK + (size_t)MAXROWS * 4;
constexpr size_t RT_ROWW = RT_ROWDST + (size_t)MAXROWS * 4;
constexpr size_t RT_TAB = RT_ROWW + (size_t)MAXROWS * 4;
constexpr size_t RT_SBON = RT_TAB + (size_t)3 * 4096 * 8;
constexpr size_t RT_END = RT_SBON + (size_t)T * 8 * 4;
static_assert(RT_END <= 40 * MiB, "routing arrays");
constexpr size_t WS_BIG = 40 * MiB;
constexpr size_t B_H1 = WS_BIG + 0 * MiB;
constexpr size_t B_YB = WS_BIG + 0 * MiB;
constexpr size_t B_YA = WS_BIG + 64 * MiB;
constexpr size_t B_PRW = WS_BIG + 128 * MiB;
constexpr size_t B_PUV = WS_BIG + 352 * MiB;
constexpr size_t B_M1 = WS_BIG + 352 * MiB;
constexpr size_t B_PG = WS_BIG + 480 * MiB;
constexpr size_t B_MTQ = WS_BIG + 736 * MiB;
constexpr size_t B_NTY = WS_BIG + 800 * MiB;
constexpr size_t B_G = WS_BIG + 864 * MiB;
constexpr size_t B_H2 = WS_BIG + 0 * MiB;
constexpr size_t B_W13 = WS_BIG + 128 * MiB;
constexpr size_t B_SH = WS_BIG + 384 * MiB;
constexpr size_t B_SC = WS_BIG + 416 * MiB;
constexpr size_t B_SLOT = WS_BIG + 0 * MiB;
constexpr size_t B_W2 = WS_BIG + 512 * MiB;
constexpr size_t B_HID = WS_BIG + 640 * MiB;
constexpr size_t WS_END = WS_BIG + 960 * MiB;
static_assert((size_t)MAXROWS * EFF * 2 <= 320 * MiB, "hid");

constexpr int LDS_STAGE = 0;
constexpr int LDS_MISC = 147456;
constexpr int LDS_BARW = 155648;
constexpr int LDS_BYTES = 159744;

typedef __bf16 bf16x2_t __attribute__((ext_vector_type(2)));
__device__ __forceinline__ unsigned pk2(float lo, float hi) { f32x2 f = {lo, hi}; return __builtin_bit_cast(unsigned, __builtin_convertvector(f, bf16x2_t)); }
__device__ __forceinline__ float bflo(unsigned w) { return __uint_as_float(w << 16); }
__device__ __forceinline__ float bfhi(unsigned w) { return __uint_as_float(w & 0xffff0000u); }
__device__ __forceinline__ float bf2f(bf16_t h) { return __uint_as_float(((unsigned)h) << 16); }
__device__ __forceinline__ bf16_t f2bf(float f) { return (bf16_t)(pk2(f, 0.f) & 0xffffu); }
__device__ __forceinline__ float fexp(float x) { return __builtin_amdgcn_exp2f(x * 1.44269504089f); }
__device__ __forceinline__ float flog(float x) { return __builtin_amdgcn_logf(x) * 0.69314718056f; }
__device__ __forceinline__ float frcp(float x) { return __builtin_amdgcn_rcpf(x); }
__device__ __forceinline__ float sigmoidf_(float x) { return frcp(1.0f + fexp(-x)); }
__device__ __forceinline__ float siluf_(float x) { return x * sigmoidf_(x); }
__device__ __forceinline__ float tanhf_(float x) { return 1.0f - 2.0f * frcp(1.0f + fexp(2.0f * x)); }
__device__ __forceinline__ float gelu_tanh(float x) { const float u = 0.7978845608f * (x + 0.044715f * x * x * x); return x * frcp(1.0f + fexp(-2.0f * u)); }
__device__ __forceinline__ float wave_sum(float v) {
#pragma unroll
    for (int o = 1; o < 64; o <<= 1) v += __shfl_xor(v, o);
    return v;
}
#define LDS_WAIT() asm volatile("s_waitcnt lgkmcnt(0)" ::: "memory")
#define VM_WAIT() asm volatile("s_waitcnt vmcnt(0)" ::: "memory")

#define XB_TMO      128
#define XB_XCNT(j)  (256  + 64 * (j))
#define XB_XSUB(j)  (1280 + 64 * (j))
#define XB_XGEN(j)  (2304 + 64 * (j))
#define XB_TOP      3328
#define XB_TOPGEN   3392
#define XCD_BAR_WORDS 3456
#define XB_SPIN_CAP (1u << 18)
__device__ __forceinline__ unsigned xb_ld(unsigned* p)              { return __hip_atomic_load(p, __ATOMIC_RELAXED, __HIP_MEMORY_SCOPE_AGENT); }
__device__ __forceinline__ unsigned xb_add(unsigned* p, unsigned v) { return __hip_atomic_fetch_add(p, v, __ATOMIC_RELAXED, __HIP_MEMORY_SCOPE_AGENT); }
__device__ __forceinline__ unsigned xb_xcc_id() { return (unsigned)__builtin_amdgcn_s_getreg((3 << 11) | 20) & 0xFu; }
#define XB_SPIN(cond, bar) do { unsigned _sp = 0; while (cond) { __builtin_amdgcn_s_sleep(1); \
    if ((++_sp & 255u) == 0u) { if (xb_ld(&(bar)[XB_TMO])) break; if (_sp > XB_SPIN_CAP) { atomicAdd(&(bar)[XB_TMO], 1u); break; } } } } while (0)
struct XcdBarrier { unsigned* bar; unsigned x; volatile LAS unsigned* st; };
__device__ __forceinline__ XcdBarrier xcd_barrier_post(unsigned* bar, volatile LAS unsigned* st) {
    XcdBarrier b; b.bar = bar; b.x = xb_xcc_id(); b.st = st;
    if (threadIdx.x == 0) (void)xb_add(&bar[XB_XCNT(b.x)], 1u);
    return b;
}
__device__ __forceinline__ void xcd_barrier_complete(unsigned* bar, unsigned x, unsigned& nloc, unsigned& nx) {
    const unsigned G = gridDim.x * gridDim.y * gridDim.z;
    unsigned sum, cnt, mine, sp = 0u;
    for (;;) {
        sum = 0u; cnt = 0u; mine = 0u;
#pragma unroll
        for (unsigned j = 0; j < 16; ++j) { const unsigned c = xb_ld(&bar[XB_XCNT(j)]); sum += c; cnt += (c > 0u) ? 1u : 0u; mine = (j == x) ? c : mine; }
        if (sum == G) break;
        __builtin_amdgcn_s_sleep(1);
        if ((++sp & 255u) == 0u) { if (xb_ld(&bar[XB_TMO])) break; if (sp > XB_SPIN_CAP) { atomicAdd(&bar[XB_TMO], 1u); break; } }
    }
    nloc = mine > 0u ? mine : 1u; nx = cnt > 0u ? cnt : 1u;
}
__device__ __forceinline__ void xcd_barrier(const XcdBarrier& b) {
    asm volatile("s_waitcnt vmcnt(0)" ::: "memory");
    __syncthreads();
    if (threadIdx.x == 0) {
        unsigned* bar = b.bar;
        __builtin_amdgcn_s_waitcnt(0);
        unsigned nloc = b.st[0], nx = b.st[1];
        if (nloc == 0u) { xcd_barrier_complete(bar, b.x, nloc, nx); b.st[0] = nloc; b.st[1] = nx; }
        const unsigned old = xb_add(&bar[XB_XSUB(b.x)], 1u);
        const unsigned gen = old / nloc;
        if (old + 1u == (gen + 1u) * nloc) {
            __builtin_amdgcn_fence(__ATOMIC_RELEASE, "agent");
            asm volatile("s_waitcnt vmcnt(0)" ::: "memory");
            const unsigned og = xb_add(&bar[XB_TOP], 1u);
            const unsigned tg = og / nx;
            if (og + 1u == (tg + 1u) * nx) xb_add(&bar[XB_TOPGEN], 1u);
            else XB_SPIN(xb_ld(&bar[XB_TOPGEN]) == tg, bar);
            __builtin_amdgcn_fence(__ATOMIC_ACQUIRE, "agent");
            xb_add(&bar[XB_XGEN(b.x)], 1u);
            asm volatile("s_waitcnt vmcnt(0)" ::: "memory");
        } else {
            XB_SPIN(xb_ld(&bar[XB_XGEN(b.x)]) == gen, bar);
            __builtin_amdgcn_fence(__ATOMIC_ACQUIRE, "agent");
            asm volatile("s_waitcnt vmcnt(0)" ::: "memory");
        }
    }
    __syncthreads();
}
namespace gm {
constexpr int BM = 256, BK = 64, HALF = 128, HTB = HALF * BK * 2, STAGE_BYTES = 8 * HTB, NXCD = 8, WGM = 8;
__host__ __device__ __forceinline__ int lds_byte(int r, int c) { const int st = (r >> 4) * 2 + (c >> 5), rr = r & 15, cc = c & 31, ob = rr * 64 + cc * 2; return st * 1024 + (ob ^ (((ob >> 9) & 1) << 5)); }
__host__ __device__ __forceinline__ void stage_rc(int b, int& R, int& C) { const int st = b / 1024, sb = b % 1024, swz = sb ^ (((sb >> 9) & 1) << 5); R = (st >> 1) * 16 + swz / 64; C = (st & 1) * 32 + (swz % 64) / 2; }
__host__ __device__ __forceinline__ int perm32(int rho) { const int n = rho >> 4, i = rho & 15; return 8 * (i >> 2) + 4 * n + (i & 3); }

struct Unit { int pm, pn, e, row0, par; };

struct DenseSched {
    static constexpr bool GATHER = false;
    const char* A; const char* B; int nM, nN, nwg, G, c; size_t tstep;
    __device__ __forceinline__ void init(const void* A_, const void* B_, int M, int N, int K, int G_, int c_) { A = (const char*)A_; B = (const char*)B_; nM = M / BM; nN = N / BM; nwg = nM * nN; G = G_; c = c_; tstep = (size_t)BM * K * 2; }
    __device__ __forceinline__ bool next(int i, Unit& u) const {
        const long L = (long)i * G + c; if (L >= nwg) return false;
        int wgid = (int)L; { const int q = nwg / NXCD, r = nwg % NXCD, xcd = wgid % NXCD, off = wgid / NXCD; wgid = (xcd < r ? xcd * (q + 1) : r * (q + 1) + (xcd - r) * q) + off; }
        const int nig = WGM * nN, gid = wgid / nig, fm = gid * WGM, gsz = (nM - fm) < WGM ? (nM - fm) : WGM;
        u.pm = fm + ((wgid % nig) % gsz); u.pn = (wgid % nig) / gsz; u.e = 0; u.row0 = u.pm * BM; return true;
    }
    __device__ __forceinline__ const char* a_ptr(const Unit& u) const { return A + (size_t)u.pm * tstep; }
    __device__ __forceinline__ const char* b_ptr(const Unit& u) const { return B + (size_t)u.pn * tstep; }
    __device__ __forceinline__ unsigned row_off(const Unit&, int) const { return 0u; }
};
template <bool GATHER_>
struct GroupSched {
    static constexpr bool GATHER = GATHER_;
    const char* A; const char* B; const int* tab; const int* rowtok; int ntiles, npn, G, c, K; size_t ebytes, tstep;
    __device__ __forceinline__ bool next(int i, Unit& u) const {
        const long L = (long)i * G + c; if (L >= (long)ntiles * npn) return false;
        const int tile = (int)(L / npn); u.pn = (int)(L % npn); u.pm = tile;
        u.row0 = __builtin_amdgcn_readfirstlane(tab[2 * tile]); u.e = __builtin_amdgcn_readfirstlane(tab[2 * tile + 1]); return true;
    }
    __device__ __forceinline__ const char* a_ptr(const Unit& u) const { return GATHER ? A : A + (size_t)u.row0 * K * 2; }
    __device__ __forceinline__ const char* b_ptr(const Unit& u) const { return B + (size_t)u.e * ebytes + (size_t)u.pn * tstep; }
    __device__ __forceinline__ unsigned row_off(const Unit& u, int r) const { return (unsigned)rowtok[u.row0 + r] * (unsigned)(K * 2); }
};

template <class Epi, class Sched, bool ALIGN_EPI>
__device__ __forceinline__ void gemm_phase(LAS unsigned char* lds, const int K, const Sched& S, const Epi& E) {
    int tid_ = threadIdx.x; asm volatile("" : "+v"(tid_));
    const int tid = tid_, wid = __builtin_amdgcn_readfirstlane(tid >> 6), lane = tid & 63, wr = wid >> 2, wc = wid & 3, fr = lane & 15, fq = lane >> 4;
    const int nt = K / BK;
    int sR[2], sC[2]; unsigned voffB[2];
#pragma unroll
    for (int i = 0; i < 2; ++i) { int R, C; stage_rc(tid * 16 + i * 8192, R, C); sR[i] = R; sC[i] = C; const int Rb = Epi::PERM ? ((R & ~31) + perm32(R & 31)) : R; voffB[i] = (unsigned)(Rb * K + C) * 2u; }
    const size_t kstep = (size_t)(BK * 2);
    const size_t hstep = (size_t)HALF * K * 2;
    const unsigned ldsw = (unsigned)wid * 1024u;
    const int aoff = lds_byte(wr * 64 + fr, fq * 8), boff = lds_byte(wc * 32 + fr, fq * 8);
#define PG8_SA(b, h) (((b) * 2 + (h)) * HTB)
#define PG8_SB(b, h) ((4 + (b) * 2 + (h)) * HTB)
#define PG8_STGB(bufoff, gbase) do { _Pragma("unroll") for (int _i = 0; _i < 2; ++_i) \
        __builtin_amdgcn_global_load_lds((const unsigned*)((const char*)(gbase) + voffB[_i]), (LAS unsigned*)(lds + (bufoff) + ldsw + _i * 8192), 16, 0, 0); } while (0)
#define PG8_STGA(bufoff, gbase, VO, h) do { _Pragma("unroll") for (int _i = 0; _i < 2; ++_i) \
        __builtin_amdgcn_global_load_lds((const unsigned*)((const char*)(gbase) + VO[h][_i]), (LAS unsigned*)(lds + (bufoff) + ldsw + _i * 8192), 16, 0, 0); } while (0)
#define PG8_VOA(u, VO) do { _Pragma("unroll") for (int _h = 0; _h < 2; ++_h) _Pragma("unroll") for (int _i = 0; _i < 2; ++_i) \
        VO[_h][_i] = Sched::GATHER ? (S.row_off(u, _h * HALF + sR[_i]) + (unsigned)sC[_i] * 2u) : ((unsigned)((_h * HALF + sR[_i]) * K + sC[_i]) * 2u); } while (0)
#define PG8_LDA(dst, b, h) do { _Pragma("unroll") for (int m = 0; m < 4; ++m) _Pragma("unroll") for (int k = 0; k < 2; ++k) dst[m][k] = *(const LAS bf16x8*)(lds + PG8_SA(b, h) + aoff + m * 2048 + k * 1024); } while (0)
#define PG8_LDB(dst, b, h) do { _Pragma("unroll") for (int n = 0; n < 2; ++n) _Pragma("unroll") for (int k = 0; k < 2; ++k) dst[n][k] = *(const LAS bf16x8*)(lds + PG8_SB(b, h) + boff + n * 2048 + k * 1024); } while (0)
#define PG8_MMA(ai, bj, At, Bt) do { __builtin_amdgcn_s_setprio(1); _Pragma("unroll") for (int m = 0; m < 4; ++m) _Pragma("unroll") for (int n = 0; n < 2; ++n) _Pragma("unroll") for (int k = 0; k < 2; ++k) \
        acc[ai][bj][m][n] = __builtin_amdgcn_mfma_f32_16x16x32_bf16(Bt[n][k], At[m][k], acc[ai][bj][m][n], 0, 0, 0); __builtin_amdgcn_s_setprio(0); } while (0)
#define PG8_WAIT_V(n) asm volatile("s_waitcnt vmcnt(" #n ")" ::: "memory")
#define PG8_WAIT_L(n) asm volatile("s_waitcnt lgkmcnt(" #n ")" ::: "memory")
#define PG8_BAR __builtin_amdgcn_s_barrier()
#define PG8_SCHED __builtin_amdgcn_sched_barrier(0)
    Unit cur, nxt; int ui = 0;
    if (!S.next(0, cur)) return;
    f32x4 acc[2][2][4][2];
#pragma unroll
    for (int a = 0; a < 2; ++a)
#pragma unroll
        for (int b = 0; b < 2; ++b)
#pragma unroll
            for (int m = 0; m < 4; ++m)
#pragma unroll
                for (int n = 0; n < 2; ++n) acc[a][b][m][n] = (f32x4){0.f, 0.f, 0.f, 0.f};
    bf16x8 At[4][2], B0[2][2], B1[2][2];
    unsigned voA[2][2], nvoA[2][2];
    PG8_VOA(cur, voA);
    if (Sched::GATHER) { asm volatile("s_waitcnt vmcnt(0)" ::: "memory"); }
    const char* cA = S.a_ptr(cur); const char* cB = S.b_ptr(cur);
    cur.par = 0; E.stage_rows(cur, lds, wid);
    PG8_STGB(PG8_SB(0, 0), cB); PG8_STGB(PG8_SB(0, 1), cB + hstep); PG8_STGA(PG8_SA(0, 0), cA, voA, 0); PG8_STGA(PG8_SA(0, 1), cA, voA, 1);
    if (wr == 1) PG8_BAR;
    PG8_WAIT_V(2); PG8_BAR;
    PG8_STGB(PG8_SB(1, 0), cB + kstep); PG8_STGA(PG8_SA(1, 0), cA + kstep, voA, 0); PG8_STGB(PG8_SB(1, 1), cB + hstep + kstep);
    PG8_WAIT_V(6); PG8_BAR;
    for (;;) {
        const bool has_next = S.next(ui + 1, nxt); nxt.par = (ui + 1) & 1;
        const char* nA = has_next ? S.a_ptr(nxt) : cA; const char* nB = has_next ? S.b_ptr(nxt) : cB;
        if (Sched::GATHER) { if (has_next) { PG8_VOA(nxt, nvoA); } else {
#pragma unroll
            for (int h = 0; h < 2; ++h)
#pragma unroll
                for (int i = 0; i < 2; ++i) nvoA[h][i] = voA[h][i]; } }
#pragma unroll 1
        for (int t = 0; t < nt; t += 2) {
            const bool last = (t == nt - 2);
            const char* a1 = cA + (size_t)(t + 1) * kstep;
            const char* a2 = last ? nA : cA + (size_t)(t + 2) * kstep; const char* b2 = last ? nB : cB + (size_t)(t + 2) * kstep;
            const char* a3 = a2 + kstep; const char* b3 = b2 + kstep;
            unsigned vo2[2][2];
#pragma unroll
            for (int h = 0; h < 2; ++h)
#pragma unroll
                for (int i = 0; i < 2; ++i) vo2[h][i] = (Sched::GATHER && last) ? nvoA[h][i] : voA[h][i];
            if (last && has_next) E.stage_rows(nxt, lds, wid);
            PG8_LDB(B0, 0, 0); PG8_LDB(B1, 0, 1); PG8_SCHED; PG8_LDA(At, 0, 0); PG8_STGA(PG8_SA(1, 1), a1, voA, 1);
            PG8_WAIT_V(8); PG8_WAIT_L(0); PG8_BAR; PG8_MMA(0, 0, At, B0); PG8_MMA(0, 1, At, B1); PG8_BAR; PG8_SCHED;
            PG8_LDA(At, 0, 1); PG8_STGB(PG8_SB(0, 0), b2); PG8_STGB(PG8_SB(0, 1), b2 + hstep); PG8_STGA(PG8_SA(0, 0), a2, vo2, 0);
            PG8_WAIT_V(8); PG8_WAIT_L(0); PG8_BAR; PG8_MMA(1, 0, At, B0); PG8_MMA(1, 1, At, B1); PG8_BAR; PG8_SCHED;
            PG8_LDB(B0, 1, 0); PG8_LDB(B1, 1, 1); PG8_SCHED; PG8_LDA(At, 1, 0); PG8_STGA(PG8_SA(0, 1), a2, vo2, 1);
            PG8_WAIT_V(8); PG8_WAIT_L(0); PG8_BAR; PG8_MMA(0, 0, At, B0); PG8_MMA(0, 1, At, B1); PG8_BAR; PG8_SCHED;
            PG8_LDA(At, 1, 1); PG8_STGB(PG8_SB(1, 0), b3); PG8_STGB(PG8_SB(1, 1), b3 + hstep); PG8_STGA(PG8_SA(1, 0), a3, vo2, 0);
            PG8_WAIT_V(8); PG8_WAIT_L(0); PG8_BAR; PG8_MMA(1, 0, At, B0); PG8_MMA(1, 1, At, B1); PG8_BAR; PG8_SCHED;
        }
        if constexpr (ALIGN_EPI) { if (wr == 0) PG8_BAR; }
        E(acc, cur, wr, wc, fr, fq);
        if (!has_next) break;
#pragma unroll
        for (int a = 0; a < 2; ++a)
#pragma unroll
            for (int b = 0; b < 2; ++b)
#pragma unroll
                for (int m = 0; m < 4; ++m)
#pragma unroll
                    for (int n = 0; n < 2; ++n) acc[a][b][m][n] = (f32x4){0.f, 0.f, 0.f, 0.f};
        cur = nxt; cA = nA; cB = nB; ++ui;
        if (Sched::GATHER) {
#pragma unroll
            for (int h = 0; h < 2; ++h)
#pragma unroll
                for (int i = 0; i < 2; ++i) voA[h][i] = nvoA[h][i]; }
        if constexpr (ALIGN_EPI) { if (wr == 1) PG8_BAR; }
    }
    PG8_WAIT_V(0);
    if constexpr (!ALIGN_EPI) { if (wr == 0) PG8_BAR; }
    PG8_BAR;
#undef PG8_SA
#undef PG8_SB
#undef PG8_STGA
#undef PG8_STGB
#undef PG8_VOA
#undef PG8_LDA
#undef PG8_LDB
#undef PG8_MMA
#undef PG8_WAIT_V
#undef PG8_WAIT_L
#undef PG8_BAR
#undef PG8_SCHED
}

typedef f32x4 Acc[2][2][4][2];
struct EpiInProj {
    static constexpr bool PERM = true;
    __device__ __forceinline__ void stage_rows(const Unit&, LAS unsigned char*, int) const {}
    bf16_t *prw, *puv, *pg;
    template <int ACT> __device__ __forceinline__ void tile(const Acc& acc, bf16_t* base, int ld, int row0, int col0) const {
#pragma unroll
        for (int ai = 0; ai < 2; ++ai)
#pragma unroll
            for (int m = 0; m < 4; ++m) { bf16_t* rowp = base + (size_t)(row0 + ai * HALF + m * 16) * ld + col0;
#pragma unroll
                for (int bj = 0; bj < 2; ++bj) { f32x4 v0 = acc[ai][bj][m][0], v1 = acc[ai][bj][m][1];
                    if (ACT == 1) {
#pragma unroll
                        for (int j = 0; j < 4; ++j) { v0[j] = gelu_tanh(v0[j]); v1[j] = gelu_tanh(v1[j]); } }
                    if (ACT == 2) {
#pragma unroll
                        for (int j = 0; j < 4; ++j) { v0[j] = sigmoidf_(v0[j]); v1[j] = sigmoidf_(v1[j]); } }
                    u32x4 w; w.x = pk2(v0[0], v0[1]); w.y = pk2(v0[2], v0[3]); w.z = pk2(v1[0], v1[1]); w.w = pk2(v1[2], v1[3]);
                    *(u32x4*)(rowp + bj * HALF) = w; }
                __builtin_amdgcn_sched_barrier(0); }
    }
    __device__ __forceinline__ void operator()(const Acc& acc, const Unit& u, int wr, int wc, int fr, int fq) const {
        const int row0 = u.row0 + wr * 64 + fr, cw = wc * 32 + 8 * fq;
        if (u.pn < 7) tile<0>(acc, prw, RWKV_COLS, row0, u.pn * 256 + cw);
        else if (u.pn < 11) tile<1>(acc, puv, 1024, row0, (u.pn - 7) * 256 + cw);
        else tile<2>(acc, pg, 2048, row0, (u.pn - 11) * 256 + cw);
    }
};
template <bool SECOND> struct EpiMerge {
    static constexpr bool PERM = true;
    __device__ __forceinline__ void stage_rows(const Unit&, LAS unsigned char*, int) const {}
    bf16_t* m1; const bf16_t* pg;
    __device__ __forceinline__ void operator()(const Acc& acc, const Unit& u, int wr, int wc, int fr, int fq) const {
        const int row0 = u.row0 + wr * 64 + fr, col0 = u.pn * 256 + wc * 32 + 8 * fq;
#pragma unroll
        for (int ai = 0; ai < 2; ++ai)
#pragma unroll
            for (int m = 0; m < 4; ++m) { const size_t r = (size_t)(row0 + ai * HALF + m * 16);
#pragma unroll
                for (int bj = 0; bj < 2; ++bj) { const int c = col0 + bj * HALF;
                    const u32x4 g = *(const u32x4*)(pg + r * 2048 + (SECOND ? 1024 : 0) + c);
                    f32x4 v0 = acc[ai][bj][m][0], v1 = acc[ai][bj][m][1];
                    v0[0] *= bflo(g.x); v0[1] *= bfhi(g.x); v0[2] *= bflo(g.y); v0[3] *= bfhi(g.y); v1[0] *= bflo(g.z); v1[1] *= bfhi(g.z); v1[2] *= bflo(g.w); v1[3] *= bfhi(g.w);
                    if (SECOND) { const u32x4 p = *(const u32x4*)(m1 + r * 1024 + c);
                        v0[0] += bflo(p.x); v0[1] += bfhi(p.x); v0[2] += bflo(p.y); v0[3] += bfhi(p.y); v1[0] += bflo(p.z); v1[1] += bfhi(p.z); v1[2] += bflo(p.w); v1[3] += bfhi(p.w); }
                    u32x4 w; w.x = pk2(v0[0], v0[1]); w.y = pk2(v0[2], v0[3]); w.z = pk2(v1[0], v1[1]); w.w = pk2(v1[2], v1[3]);
                    *(u32x4*)(m1 + r * 1024 + c) = w; } }
    }
};
struct EpiResid {
    static constexpr bool PERM = false;
    __device__ __forceinline__ void stage_rows(const Unit&, LAS unsigned char*, int) const {}
    float* out; const float* base; const float* gate;
    __device__ __forceinline__ void operator()(const Acc& acc, const Unit& u, int wr, int wc, int fr, int fq) const {
        const int row0 = u.row0 + wr * 64 + fr, col0 = u.pn * 256 + wc * 32 + 4 * fq;
        const float* gp = gate + (size_t)(u.row0 >> 13) * 6144 + col0;
        f32x4 gv[2][2];
#pragma unroll
        for (int bj = 0; bj < 2; ++bj)
#pragma unroll
            for (int n = 0; n < 2; ++n) gv[bj][n] = *(const f32x4*)(gp + bj * HALF + n * 16);
#pragma unroll
        for (int ai = 0; ai < 2; ++ai)
#pragma unroll
            for (int m = 0; m < 4; ++m) { const size_t ro = (size_t)(row0 + ai * HALF + m * 16) * 1024 + col0;
#pragma unroll
                for (int bj = 0; bj < 2; ++bj)
#pragma unroll
                    for (int n = 0; n < 2; ++n) { const f32x4 b = *(const f32x4*)(base + ro + bj * HALF + n * 16);
                        *(f32x4*)(out + ro + bj * HALF + n * 16) = b + gv[bj][n] * acc[ai][bj][m][n]; } }
    }
};
struct EpiRouter {
    static constexpr bool PERM = false;
    __device__ __forceinline__ void stage_rows(const Unit&, LAS unsigned char*, int) const {}
    float* sc;
    __device__ __forceinline__ void operator()(const Acc& acc, const Unit& u, int wr, int wc, int fr, int fq) const {
        const int row0 = u.row0 + wr * 64 + fr, col0 = wc * 32 + 4 * fq;
#pragma unroll
        for (int ai = 0; ai < 2; ++ai)
#pragma unroll
            for (int m = 0; m < 4; ++m) { float* rowp = sc + (size_t)(row0 + ai * HALF + m * 16) * 256 + col0;
#pragma unroll
                for (int bj = 0; bj < 2; ++bj)
#pragma unroll
                    for (int n = 0; n < 2; ++n) { f32x4 v = acc[ai][bj][m][n];
#pragma unroll
                        for (int j = 0; j < 4; ++j) v[j] = sigmoidf_(v[j]);
                        *(f32x4*)(rowp + bj * HALF + n * 16) = v; }
                __builtin_amdgcn_sched_barrier(0); }
    }
};
struct EpiGateUp {
    static constexpr bool PERM = true;
    __device__ __forceinline__ void stage_rows(const Unit&, LAS unsigned char*, int) const {}
    bf16_t* hid;
    __device__ __forceinline__ void operator()(const Acc& acc, const Unit& u, int wr, int wc, int fr, int fq) const {
        const int row0 = u.row0 + wr * 64 + fr, col0 = u.pn * HALF + wc * 32 + 8 * fq;
#pragma unroll
        for (int ai = 0; ai < 2; ++ai)
#pragma unroll
            for (int m = 0; m < 4; ++m) { bf16_t* rowp = hid + (size_t)(row0 + ai * HALF + m * 16) * EFF + col0;
                f32x4 v0, v1;
#pragma unroll
                for (int j = 0; j < 4; ++j) { v0[j] = siluf_(acc[ai][0][m][0][j]) * acc[ai][1][m][0][j]; v1[j] = siluf_(acc[ai][0][m][1][j]) * acc[ai][1][m][1][j]; }
                u32x4 w; w.x = pk2(v0[0], v0[1]); w.y = pk2(v0[2], v0[3]); w.z = pk2(v1[0], v1[1]); w.w = pk2(v1[2], v1[3]);
                *(u32x4*)rowp = w; __builtin_amdgcn_sched_barrier(0); }
    }
};
struct EpiExpertDown {
    static constexpr bool PERM = true;
    bf16_t* slot; const int* rowdst; const float* roww;
    __device__ __forceinline__ void stage_rows(const Unit& u, LAS unsigned char* lds, int wid) const {
        if (wid < 4) { const int lane = threadIdx.x & 63; LAS unsigned char* base = lds + LDS_MISC + u.par * 2048 + wid * 256;
            __builtin_amdgcn_global_load_lds((const unsigned*)(rowdst + u.row0 + wid * 64 + lane), (LAS unsigned*)base, 4, 0, 0);
            __builtin_amdgcn_global_load_lds((const unsigned*)(roww + u.row0 + wid * 64 + lane), (LAS unsigned*)(base + 1024), 4, 0, 0); }
    }
    __device__ __forceinline__ void operator()(const Acc& acc, const Unit& u, int wr, int wc, int fr, int fq) const {
        const unsigned cb = (unsigned)(u.pn * 256 + wc * 32 + 8 * fq) * 2u;
        const LAS int* td = (const LAS int*)((LAS unsigned char*)nullptr + LDS_MISC + u.par * 2048) + wr * 64 + fr; const LAS float* tw = (const LAS float*)(td + 256);
#pragma unroll
        for (int ai = 0; ai < 2; ++ai)
#pragma unroll
            for (int m = 0; m < 4; ++m) {
                const int dst = td[ai * HALF + m * 16]; const float ws_ = tw[ai * HALF + m * 16];
                if (dst >= 0) { unsigned char* rowp = (unsigned char*)slot + (size_t)((unsigned)dst * 2048u + cb);
#pragma unroll
                    for (int bj = 0; bj < 2; ++bj) { const f32x4 v0 = acc[ai][bj][m][0] * ws_, v1 = acc[ai][bj][m][1] * ws_;
                        u32x4 w; w.x = pk2(v0[0], v0[1]); w.y = pk2(v0[2], v0[3]); w.z = pk2(v1[0], v1[1]); w.w = pk2(v1[2], v1[3]);
                        *(u32x4*)(rowp + bj * HALF * 2) = w; } }
                __builtin_amdgcn_sched_barrier(0);
            }
    }
};
}
__device__ __forceinline__ void phase_mod(const float* c, const float* ada_w, const float* ada_b, float* mod, LAS unsigned char* lds, int tid, int G) {
    LAS float* sl = (LAS float*)lds; LAS float* red = (LAS float*)(lds + 32768);
    for (int i = tid; i < NB * D; i += NTHREADS) { const float v = c[i]; sl[i] = siluf_(v); }
    __syncthreads();
    const int cl = tid % 24, kg = tid / 24;
    for (int cb = blockIdx.x; cb < 256; cb += G) {
        const int col0 = cb * 24;
        if (tid < 384) {
            float a[NB];
#pragma unroll
            for (int b = 0; b < NB; ++b) a[b] = 0.f;
            for (int k = kg; k < D; k += 16) { const float w = ada_w[(size_t)k * 6144 + col0 + cl];
#pragma unroll
                for (int b = 0; b < NB; ++b) a[b] += sl[b * D + k] * w; }
#pragma unroll
            for (int b = 0; b < NB; ++b) red[(kg * 24 + cl) * NB + b] = a[b];
        }
        __syncthreads();
        if (tid < 192) { const int c2 = tid >> 3, b = tid & 7; float s = 0.f;
#pragma unroll
            for (int g = 0; g < 16; ++g) s += red[(g * 24 + c2) * NB + b];
            mod[(size_t)b * 6144 + col0 + c2] = s + ada_b[col0 + c2]; }
        __syncthreads();
    }
}
__device__ __forceinline__ void transpose_item(const float* W, int ldw, int k0, int n0, bf16_t* WT, int ldt, int drow0, LAS float* scr, int lane) {
#pragma unroll 8
    for (int i = 0; i < 32; ++i) { const int kk = 2 * i + (lane >> 5); scr[kk * 33 + (lane & 31)] = W[(size_t)(k0 + kk) * ldw + n0 + (lane & 31)]; }
    LDS_WAIT(); asm volatile("" ::: "memory");
    const int c = lane & 7;
#pragma unroll
    for (int j = 0; j < 4; ++j) { const int n = (lane >> 3) + 8 * j; const LAS float* s = scr + (8 * c) * 33 + n;
        u32x4 o; o.x = pk2(s[0 * 33], s[1 * 33]); o.y = pk2(s[2 * 33], s[3 * 33]); o.z = pk2(s[4 * 33], s[5 * 33]); o.w = pk2(s[6 * 33], s[7 * 33]);
        *(u32x4*)(WT + (size_t)(drow0 + n) * ldt + k0 + 8 * c) = o; }
    LDS_WAIT(); asm volatile("" ::: "memory");
}
__device__ __forceinline__ void transpose_job(const float* W, int K, int N, bf16_t* WT, int gated, int goff, int item, LAS float* scr, int lane) {
    const int nblk = N / 32, kb = item / nblk, nb = item % nblk, n0 = 32 * nb;
    const int drow0 = gated ? (256 * (n0 >> 7) + goff + (n0 & 127)) : n0;
    transpose_item(W, N, 64 * kb, n0, WT, K, drow0, scr, lane);
}
struct SmallW { const float *w_in, *w_out_a, *w_out_b, *w_out, *router_w, *sw1, *sw3, *sw2, *w_up, *a_up, *g_up, *gws; };
__device__ __forceinline__ void phase_small_weights(const SmallW& P, unsigned char* ws, LAS unsigned char* lds, int gw, int NGW, int wave, int lane) {
    LAS float* scr = (LAS float*)(lds + 49152 + wave * 8704);
    constexpr int I0 = 16 * 152, I1 = 8 * 32, I2 = 8 * 32, I3 = 16 * 32, I4 = 16 * 8, I5 = 16 * 8, I6 = 16 * 8, I7 = 4 * 32, I8 = 16, I9 = 16, I10 = 2 * 16;
    constexpr int NIT = I0 + I1 + I2 + I3 + I4 + I5 + I6 + I7 + I8 + I9 + I10;
    for (int it = gw; it < NIT; it += NGW) {
        int r = it;
        if (r < I0) { transpose_job(P.w_in, D, IN_COLS, (bf16_t*)(ws + SW_WIN), 0, 0, r, scr, lane); continue; } r -= I0;
        if (r < I1) { transpose_job(P.w_out_a, RW, D, (bf16_t*)(ws + SW_WOA), 0, 0, r, scr, lane); continue; } r -= I1;
        if (r < I2) { transpose_job(P.w_out_b, RW, D, (bf16_t*)(ws + SW_WOB), 0, 0, r, scr, lane); continue; } r -= I2;
        if (r < I3) { transpose_job(P.w_out, D, D, (bf16_t*)(ws + SW_WO), 0, 0, r, scr, lane); continue; } r -= I3;
        if (r < I4) { transpose_job(P.router_w, D, NE, (bf16_t*)(ws + SW_WR), 0, 0, r, scr, lane); continue; } r -= I4;
        if (r < I5) { transpose_job(P.sw1, D, EFF, (bf16_t*)(ws + SW_WS13), 1, 0, r, scr, lane); continue; } r -= I5;
        if (r < I6) { transpose_job(P.sw3, D, EFF, (bf16_t*)(ws + SW_WS13), 1, 128, r, scr, lane); continue; } r -= I6;
        if (r < I7) { transpose_job(P.sw2, EFF, D, (bf16_t*)(ws + SW_WS2), 0, 0, r, scr, lane); continue; } r -= I7;
        if (r < I8) { transpose_job(P.w_up, 64, RW, (bf16_t*)(ws + SW_WUP), 0, 0, r, scr, lane); continue; } r -= I8;
        if (r < I9) { transpose_job(P.a_up, 64, RW, (bf16_t*)(ws + SW_AUP), 0, 0, r, scr, lane); continue; } r -= I9;
        transpose_job(P.g_up, 128, RW, (bf16_t*)(ws + SW_GUP), 0, 0, r, scr, lane);
    }
    bf16_t* wsm = (bf16_t*)(ws + SW_WSM);
    for (int i = gw * 64 + lane; i < 8 * 128 * 128; i += NGW * 64) { const int col = i & 127, row = (i >> 7) & 127; wsm[i] = (col <= row) ? f2bf(P.gws[i]) : (bf16_t)0; }
}
__device__ __forceinline__ void phase_expert_weights(const float* w1, const float* w3, const float* w2, unsigned char* ws, LAS unsigned char* lds, int gw, int NGW, int wave, int lane) {
    LAS float* scr = (LAS float*)(lds + 49152 + wave * 8704);
    constexpr int PER = 128;
    for (int it = gw; it < NE * 3 * PER; it += NGW) {
        const int e = it / (3 * PER), r = it % (3 * PER), which = r / PER, item = r % PER;
        if (which == 0) transpose_job(w1 + (size_t)e * D * EFF, D, EFF, (bf16_t*)(ws + B_W13) + (size_t)e * 512 * D, 1, 0, item, scr, lane);
        else if (which == 1) transpose_job(w3 + (size_t)e * D * EFF, D, EFF, (bf16_t*)(ws + B_W13) + (size_t)e * 512 * D, 1, 128, item, scr, lane);
        else transpose_job(w2 + (size_t)e * EFF * D, EFF, D, (bf16_t*)(ws + B_W2) + (size_t)e * D * EFF, 0, 0, item, scr, lane);
    }
}
__device__ __forceinline__ void phase_norm_mod(const float* X, const float* gain, const float* mod, int sh_off, int sc_off, bf16_t* out, int gw, int NGW, int lane) {
    for (int m = gw; m < T; m += NGW) {
        const int b = m >> 13;
        const f32x4* xr = (const f32x4*)(X + (size_t)m * D) + lane;
        f32x4 v[4]; float ss = 0.f;
#pragma unroll
        for (int j = 0; j < 4; ++j) { v[j] = xr[64 * j]; ss += (v[j].x * v[j].x + v[j].y * v[j].y) + (v[j].z * v[j].z + v[j].w * v[j].w); }
        const float rstd = __builtin_amdgcn_rsqf(wave_sum(ss) * (1.f / D) + 1e-6f);
        const float* mb = mod + (size_t)b * 6144;
        u32x2* o8 = (u32x2*)(out + (size_t)m * D) + lane;
#pragma unroll
        for (int j = 0; j < 4; ++j) { const int col = 4 * lane + 256 * j;
            const f32x4 g = *(const f32x4*)(gain + col), sc = *(const f32x4*)(mb + sc_off + col), sh = *(const f32x4*)(mb + sh_off + col);
            const f32x4 y = v[j] * rstd * g * (sc + 1.0f) + sh;
            u32x2 w; w.x = pk2(y.x, y.y); w.y = pk2(y.z, y.w); o8[64 * j] = w; }
    }
}
struct YaArgs { bf16_t* ya; const bf16_t* g; const bf16_t* prw; const float* sbon; const float* mu; const float* ln_g; const float* ln_b; };
__device__ __forceinline__ void phase_ya_final(const YaArgs& P, int gw, int NGW, int lane) {
    const int ch0 = lane * 8, head = lane >> 3;
    float muv[8], lg[8], lb[8];
#pragma unroll
    for (int j = 0; j < 8; ++j) { muv[j] = P.mu[1024 + ch0 + j]; lg[j] = P.ln_g[ch0 + j]; lb[j] = P.ln_b[ch0 + j]; }
    for (int m = gw; m < T; m += NGW) {
        const u32x4 yw = *(const u32x4*)(P.ya + (size_t)m * RW + ch0);
        const u32x4 gw4 = *(const u32x4*)(P.g + (size_t)m * RW + ch0);
        const u32x4 vc = *(const u32x4*)(P.prw + (size_t)m * RWKV_COLS + 1024 + ch0);
        u32x4 vp = (u32x4){0u, 0u, 0u, 0u};
        if ((m & (SEQ - 1)) != 0) vp = *(const u32x4*)(P.prw + (size_t)(m - 1) * RWKV_COLS + 1024 + ch0);
        const float sb = P.sbon[(size_t)m * NH + head];
        float y[8], gg[8], vv[8], pv[8];
        y[0] = bflo(yw.x); y[1] = bfhi(yw.x); y[2] = bflo(yw.y); y[3] = bfhi(yw.y); y[4] = bflo(yw.z); y[5] = bfhi(yw.z); y[6] = bflo(yw.w); y[7] = bfhi(yw.w);
        gg[0] = bflo(gw4.x); gg[1] = bfhi(gw4.x); gg[2] = bflo(gw4.y); gg[3] = bfhi(gw4.y); gg[4] = bflo(gw4.z); gg[5] = bfhi(gw4.z); gg[6] = bflo(gw4.w); gg[7] = bfhi(gw4.w);
        vv[0] = bflo(vc.x); vv[1] = bfhi(vc.x); vv[2] = bflo(vc.y); vv[3] = bfhi(vc.y); vv[4] = bflo(vc.z); vv[5] = bfhi(vc.z); vv[6] = bflo(vc.w); vv[7] = bfhi(vc.w);
        pv[0] = bflo(vp.x); pv[1] = bfhi(vp.x); pv[2] = bflo(vp.y); pv[3] = bfhi(vp.y); pv[4] = bflo(vp.z); pv[5] = bfhi(vp.z); pv[6] = bflo(vp.w); pv[7] = bfhi(vp.w);
        float s = 0.f;
#pragma unroll
        for (int j = 0; j < 8; ++j) s += y[j];
        s += __shfl_xor(s, 1); s += __shfl_xor(s, 2); s += __shfl_xor(s, 4);
        const float mean = s * (1.f / 64.f); float q = 0.f;
#pragma unroll
        for (int j = 0; j < 8; ++j) { y[j] -= mean; q += y[j] * y[j]; }
        q += __shfl_xor(q, 1); q += __shfl_xor(q, 2); q += __shfl_xor(q, 4);
        const float rstd = __builtin_amdgcn_rsqf(q * (1.f / 64.f) + 64e-5f);
        float o[8];
#pragma unroll
        for (int j = 0; j < 8; ++j) { const float vs = vv[j] + (pv[j] - vv[j]) * muv[j]; o[j] = (y[j] * rstd * lg[j] + lb[j] + sb * vs) * gg[j]; }
        u32x4 w; w.x = pk2(o[0], o[1]); w.y = pk2(o[2], o[3]); w.z = pk2(o[4], o[5]); w.w = pk2(o[6], o[7]);
        *(u32x4*)(P.ya + (size_t)m * RW + ch0) = w;
    }
}
__device__ __forceinline__ void phase_combine(float* out, const bf16_t* slot, const float* mod, const float* normf, int half, int gw, int NGW, int lane) {
    for (int tl = gw; tl < HALF_T; tl += NGW) {
        const int m = half * HALF_T + tl, b = m >> 13;
        f32x4* xr = (f32x4*)(out + (size_t)m * D) + lane;
        const float* g2 = mod + (size_t)b * 6144 + 5120;
        f32x4 a[4];
#pragma unroll
        for (int j = 0; j < 4; ++j) a[j] = (f32x4){0.f, 0.f, 0.f, 0.f};
#pragma unroll
        for (int k = 0; k < TOPK; ++k) { const u32x2* sr = (const u32x2*)(slot + ((size_t)tl * TOPK + k) * D) + lane;
#pragma unroll
            for (int j = 0; j < 4; ++j) { const u32x2 w = sr[64 * j]; a[j].x += bflo(w.x); a[j].y += bfhi(w.x); a[j].z += bflo(w.y); a[j].w += bfhi(w.y); } }
        f32x4 v[4]; float ss = 0.f;
#pragma unroll
        for (int j = 0; j < 4; ++j) { const int col = 4 * lane + 256 * j; v[j] = xr[64 * j] + *(const f32x4*)(g2 + col) * a[j]; ss += (v[j].x * v[j].x + v[j].y * v[j].y) + (v[j].z * v[j].z + v[j].w * v[j].w); }
        const float rstd = __builtin_amdgcn_rsqf(wave_sum(ss) * (1.f / D) + 1e-6f);
#pragma unroll
        for (int j = 0; j < 4; ++j) { const int col = 4 * lane + 256 * j; xr[64 * j] = v[j] * rstd * *(const f32x4*)(normf + col); }
    }
}
namespace rk {
constexpr int LD = 72;
constexpr int SLOTB = 64 * LD * 2;
constexpr int LDG = 136;
typedef LAS bf16_t* lp;
__device__ __forceinline__ lp slot(LAS unsigned char* lds, int i) { return (lp)(lds + i * SLOTB); }
template <int KS>
__device__ __forceinline__ void mm_nt(const LAS bf16_t* X, int ldx, const LAS bf16_t* Y, int ldy, int m, int nt0, int r, int q, f32x4 (&acc)[2]) {
#pragma unroll
    for (int s = 0; s < KS; ++s) {
        const bf16x8 a = *(const LAS bf16x8*)(X + (16 * m + r) * ldx + 32 * s + 8 * q);
#pragma unroll
        for (int n = 0; n < 2; ++n) { const bf16x8 b = *(const LAS bf16x8*)(Y + (16 * (nt0 + n) + r) * ldy + 32 * s + 8 * q); acc[n] = __builtin_amdgcn_mfma_f32_16x16x32_bf16(a, b, acc[n], 0, 0, 0); }
    }
}
__device__ __forceinline__ void st_rm(lp dst, int m, int nt, int r, int q, const f32x4& a) {
#pragma unroll
    for (int ii = 0; ii < 4; ++ii) dst[(16 * m + 4 * q + ii) * LD + 16 * nt + r] = f2bf(a[ii]);
}
__device__ __forceinline__ void st_tr(lp dst, int m, int nt, int r, int q, const f32x4& a) {
    u32x2 w; w.x = pk2(a[0], a[1]); w.y = pk2(a[2], a[3]); *(LAS u32x2*)(dst + (16 * nt + r) * LD + 16 * m + 4 * q) = w;
}
__device__ __forceinline__ void ld_rm(const LAS bf16_t* src, int m, int nt, int r, int q, f32x4& a) {
#pragma unroll
    for (int ii = 0; ii < 4; ++ii) a[ii] = bf2f(src[(16 * m + 4 * q + ii) * LD + 16 * nt + r]);
}
struct Args {
    const bf16_t* prw; const float* mu; const float *w0, *a0, *k_k, *k_a, *r_k;
    const bf16_t *wup, *aup, *gup;
    bf16_t* g; float* sbon; unsigned char* mtq; unsigned char* nty; unsigned* dbg;
};
__device__ __forceinline__ void unit(const Args& P, LAS unsigned char* lds, int b, int h, int c, int uidx, int tid) {
    const int wave = __builtin_amdgcn_readfirstlane(tid >> 6), lane = tid & 63, r = lane & 15, q = lane >> 4, m = wave & 3, nh = wave >> 2;
    const int t0 = b * SEQ + c * 64;
    lp S0 = slot(lds, 0), S1 = slot(lds, 1), S2 = slot(lds, 2), S3 = slot(lds, 3), S4 = slot(lds, 4), S5 = slot(lds, 5), S6 = slot(lds, 6), S7 = slot(lds, 7);
    lp S8 = slot(lds, 8), S9 = slot(lds, 9), S10 = slot(lds, 10), S11 = slot(lds, 11), S12 = slot(lds, 12), S13 = slot(lds, 13), S14 = slot(lds, 14), S15 = slot(lds, 15);
    LAS float* PART = (LAS float*)(lds + LDS_MISC);
    LAS float* CT = PART + 256;
    LAS float* DEND = CT + 256;
#ifdef DBG_CHECK
#define RK_DBG(bit, sp) do { bool bad_ = false, big_ = false; for (int i_ = tid; i_ < 4096; i_ += NTHREADS) { const unsigned e_ = ((sp)[(i_ >> 6) * LD + (i_ & 63)] >> 7) & 0xFFu; bad_ |= (e_ == 0xFFu); big_ |= (e_ != 0xFFu && e_ >= 147u); } if (bad_) atomicOr(P.dbg, 1u << (bit)); if (big_) atomicOr(P.dbg + 2, 1u << (bit)); } while (0)
#else
#define RK_DBG(bit, sp) do {} while (0)
#endif
    for (int task = tid; task < 64 * 56; task += NTHREADS) {
        const int i = task / 56, ch = task % 56;
        int col, act = 0; LAS bf16_t* dst;
        if (ch < 8) { col = h * 64 + 8 * ch; dst = S8 + i * LD + 8 * ch; }
        else if (ch < 16) { col = 512 + h * 64 + 8 * (ch - 8); dst = S9 + i * LD + 8 * (ch - 8); }
        else if (ch < 24) { col = 1024 + h * 64 + 8 * (ch - 16); dst = S10 + i * LD + 8 * (ch - 16); }
        else if (ch < 32) { col = 1536 + 8 * (ch - 24); dst = S11 + i * LD + 8 * (ch - 24); act = 1; }
        else if (ch < 40) { col = 1600 + 8 * (ch - 32); dst = S12 + i * LD + 8 * (ch - 32); }
        else { col = 1664 + 8 * (ch - 40); dst = S13 + i * LDG + 8 * (ch - 40); act = 2; }
        const bf16_t* src = P.prw + (size_t)(t0 + i) * RWKV_COLS + col;
        const u32x4 cw = *(const u32x4*)src;
        u32x4 pw = (u32x4){0u, 0u, 0u, 0u};
        if (i != 0 || c != 0) pw = *(const u32x4*)(src - RWKV_COLS);
        const f32x4 m0 = *(const f32x4*)(P.mu + col), m1 = *(const f32x4*)(P.mu + col + 4);
        float v[8], p[8];
        v[0] = bflo(cw.x); v[1] = bfhi(cw.x); v[2] = bflo(cw.y); v[3] = bfhi(cw.y); v[4] = bflo(cw.z); v[5] = bfhi(cw.z); v[6] = bflo(cw.w); v[7] = bfhi(cw.w);
        p[0] = bflo(pw.x); p[1] = bfhi(pw.x); p[2] = bflo(pw.y); p[3] = bfhi(pw.y); p[4] = bflo(pw.z); p[5] = bfhi(pw.z); p[6] = bflo(pw.w); p[7] = bfhi(pw.w);
#pragma unroll
        for (int j = 0; j < 4; ++j) { v[j] += (p[j] - v[j]) * m0[j]; v[4 + j] += (p[4 + j] - v[4 + j]) * m1[j]; }
        if (act == 1) {
#pragma unroll
            for (int j = 0; j < 8; ++j) v[j] = tanhf_(v[j]); }
        else if (act == 2) {
#pragma unroll
            for (int j = 0; j < 8; ++j) v[j] = sigmoidf_(v[j]); }
        u32x4 w; w.x = pk2(v[0], v[1]); w.y = pk2(v[2], v[3]); w.z = pk2(v[4], v[5]); w.w = pk2(v[6], v[7]);
        *(LAS u32x4*)dst = w;
    }
    __syncthreads();
    f32x4 aw[2], aa[2], ag[2];
#pragma unroll
    for (int n = 0; n < 2; ++n) { aw[n] = (f32x4){0.f, 0.f, 0.f, 0.f}; aa[n] = aw[n]; ag[n] = aw[n]; }
#pragma unroll
    for (int s = 0; s < 2; ++s) {
        const bf16x8 xw = *(const LAS bf16x8*)(S11 + (16 * m + r) * LD + 32 * s + 8 * q), xa = *(const LAS bf16x8*)(S12 + (16 * m + r) * LD + 32 * s + 8 * q);
#pragma unroll
        for (int n = 0; n < 2; ++n) { const int row = h * 64 + 16 * (2 * nh + n) + r;
            const bf16x8 bw = *(const bf16x8*)(P.wup + (size_t)row * 64 + 32 * s + 8 * q), ba = *(const bf16x8*)(P.aup + (size_t)row * 64 + 32 * s + 8 * q);
            aw[n] = __builtin_amdgcn_mfma_f32_16x16x32_bf16(xw, bw, aw[n], 0, 0, 0); aa[n] = __builtin_amdgcn_mfma_f32_16x16x32_bf16(xa, ba, aa[n], 0, 0, 0); }
    }
#pragma unroll
    for (int s = 0; s < 4; ++s) {
        const bf16x8 xg = *(const LAS bf16x8*)(S13 + (16 * m + r) * LDG + 32 * s + 8 * q);
#pragma unroll
        for (int n = 0; n < 2; ++n) { const int row = h * 64 + 16 * (2 * nh + n) + r;
            const bf16x8 bg = *(const bf16x8*)(P.gup + (size_t)row * 128 + 32 * s + 8 * q);
            ag[n] = __builtin_amdgcn_mfma_f32_16x16x32_bf16(xg, bg, ag[n], 0, 0, 0); }
    }
    float rr[2][4], kq[2][4], vv[2][4], av[2][4], lw[2][4], kp[2][4], pre[2][4], preq[2];
    float ss[4] = {0.f, 0.f, 0.f, 0.f}, bs[4] = {0.f, 0.f, 0.f, 0.f};
#pragma unroll
    for (int n = 0; n < 2; ++n) {
        const int ch = 32 * nh + 16 * n + r, chg = h * 64 + ch;
        const float w0v = P.w0[chg], a0v = P.a0[chg], kkc = P.k_k[chg], kac = P.k_a[chg], rkc = P.r_k[chg];
#pragma unroll
        for (int ii = 0; ii < 4; ++ii) {
            const int pos = 16 * m + 4 * q + ii;
            const float rv = bf2f(S8[pos * LD + ch]), kraw = bf2f(S9[pos * LD + ch]); vv[n][ii] = bf2f(S10[pos * LD + ch]); rr[n][ii] = rv;
            const float z = -(w0v + aw[n][ii]);
            const float sp = fmaxf(z, 0.f) + flog(1.0f + fexp(-fabsf(z)));
            lw[n][ii] = -fexp(-sp - 0.5f);
            const float a_ = sigmoidf_(a0v + aa[n][ii]); av[n][ii] = a_;
            P.g[(size_t)(t0 + pos) * RW + chg] = f2bf(ag[n][ii]);
            const float kk = kraw * kkc; kq[n][ii] = kk;
            const float kpv = kraw * (1.0f + (a_ - 1.0f) * kac); kp[n][ii] = kpv;
            ss[ii] += kk * kk; bs[ii] += rv * kpv * rkc;
        }
        pre[n][0] = lw[n][0]; pre[n][1] = pre[n][0] + lw[n][1]; pre[n][2] = pre[n][1] + lw[n][2]; pre[n][3] = pre[n][2] + lw[n][3];
        const float tot = pre[n][3];
        const float t0_ = __shfl(tot, r), t1_ = __shfl(tot, r + 16), t2_ = __shfl(tot, r + 32), t3_ = __shfl(tot, r + 48);
        preq[n] = (q > 0 ? t0_ : 0.f) + (q > 1 ? t1_ : 0.f) + (q > 2 ? t2_ : 0.f);
        if (q == 0) CT[m * 64 + ch] = (t0_ + t1_) + (t2_ + t3_);
    }
#pragma unroll
    for (int ii = 0; ii < 4; ++ii) {
#pragma unroll
        for (int o = 1; o < 16; o <<= 1) { ss[ii] += __shfl_xor(ss[ii], o); bs[ii] += __shfl_xor(bs[ii], o); }
        if (r == 0) { const int pos = 16 * m + 4 * q + ii; PART[(nh * 64 + pos) * 2] = ss[ii]; PART[(nh * 64 + pos) * 2 + 1] = bs[ii]; }
    }
    __syncthreads();
#pragma unroll
    for (int n = 0; n < 2; ++n) {
        const int ch = 32 * nh + 16 * n + r;
        float carry = 0.f, lend = 0.f;
#pragma unroll
        for (int mm = 0; mm < 4; ++mm) { const float cv = CT[mm * 64 + ch]; lend += cv; carry += (mm < m) ? cv : 0.f; }
        f32x4 tA, tBh, tKh, tV;
#pragma unroll
        for (int ii = 0; ii < 4; ++ii) {
            const int pos = 16 * m + 4 * q + ii;
            const float L = carry + preq[n] + pre[n][ii], Lm1 = L - lw[n][ii];
            const float ssum = PART[pos * 2] + PART[(64 + pos) * 2];
            const float inv = frcp(fmaxf(__builtin_sqrtf(ssum), 1e-12f));
            const float kkn = kq[n][ii] * inv, kb = kkn * av[n][ii];
            const float eN = fexp(-L), eE = fexp(lend - L);
            const float At = -kkn * fexp(Lm1), Rt = rr[n][ii] * fexp(L), Bt = kb * eN, Kt = kp[n][ii] * eN;
            S0[pos * LD + ch] = f2bf(At); S1[pos * LD + ch] = f2bf(Bt); S2[pos * LD + ch] = f2bf(Kt); S3[pos * LD + ch] = f2bf(Rt);
            tA[ii] = At; tBh[ii] = kb * eE; tKh[ii] = kp[n][ii] * eE; tV[ii] = vv[n][ii];
        }
        { u32x2 w; const int off = ch * LD + 16 * m + 4 * q;
          w.x = pk2(tA[0], tA[1]); w.y = pk2(tA[2], tA[3]); *(LAS u32x2*)(S4 + off) = w;
          w.x = pk2(tBh[0], tBh[1]); w.y = pk2(tBh[2], tBh[3]); *(LAS u32x2*)(S5 + off) = w;
          w.x = pk2(tKh[0], tKh[1]); w.y = pk2(tKh[2], tKh[3]); *(LAS u32x2*)(S6 + off) = w;
          w.x = pk2(tV[0], tV[1]); w.y = pk2(tV[2], tV[3]); *(LAS u32x2*)(S7 + off) = w; }
        if (m == 0 && q == 0) DEND[ch] = fexp(lend);
    }
    if (nh == 0 && r == 0) {
#pragma unroll
        for (int ii = 0; ii < 4; ++ii) { const int pos = 16 * m + 4 * q + ii; P.sbon[(size_t)(t0 + pos) * NH + h] = PART[pos * 2 + 1] + PART[(64 + pos) * 2 + 1]; }
    }
    __syncthreads();
    RK_DBG(0, S0); RK_DBG(1, S1); RK_DBG(2, S2); RK_DBG(3, S3); RK_DBG(4, S4); RK_DBG(5, S5); RK_DBG(6, S6); RK_DBG(7, S7);
    const int nt0 = 2 * nh;
    f32x4 acc[2], acc2[2];
#define RK_ZERO(a) do { a[0] = (f32x4){0.f, 0.f, 0.f, 0.f}; a[1] = a[0]; } while (0)
    RK_ZERO(acc); mm_nt<2>(S0, LD, S1, LD, m, nt0, r, q, acc);
#pragma unroll
    for (int n = 0; n < 2; ++n) { f32x4 t;
#pragma unroll
        for (int ii = 0; ii < 4; ++ii) { const int row = 16 * m + 4 * q + ii, col = 16 * (nt0 + n) + r; acc[n][ii] = (col < row) ? acc[n][ii] : 0.f; t[ii] = acc[n][ii] + ((col == row) ? 1.f : 0.f); }
        st_rm(S8, m, nt0 + n, r, q, acc[n]); st_tr(S9, m, nt0 + n, r, q, acc[n]); st_rm(S10, m, nt0 + n, r, q, t); }
    RK_ZERO(acc); mm_nt<2>(S0, LD, S2, LD, m, nt0, r, q, acc);
#pragma unroll
    for (int n = 0; n < 2; ++n) {
#pragma unroll
        for (int ii = 0; ii < 4; ++ii) { const int row = 16 * m + 4 * q + ii, col = 16 * (nt0 + n) + r; acc[n][ii] = (col < row) ? acc[n][ii] : 0.f; }
        st_rm(S11, m, nt0 + n, r, q, acc[n]); }
    RK_ZERO(acc); mm_nt<2>(S3, LD, S1, LD, m, nt0, r, q, acc);
#pragma unroll
    for (int n = 0; n < 2; ++n) {
#pragma unroll
        for (int ii = 0; ii < 4; ++ii) { const int row = 16 * m + 4 * q + ii, col = 16 * (nt0 + n) + r; acc[n][ii] = (col <= row) ? acc[n][ii] : 0.f; }
        st_rm(S12, m, nt0 + n, r, q, acc[n]); }
    RK_ZERO(acc); mm_nt<2>(S3, LD, S2, LD, m, nt0, r, q, acc);
#pragma unroll
    for (int n = 0; n < 2; ++n) {
#pragma unroll
        for (int ii = 0; ii < 4; ++ii) { const int row = 16 * m + 4 * q + ii, col = 16 * (nt0 + n) + r; acc[n][ii] = (col <= row) ? acc[n][ii] : 0.f; }
        st_rm(S13, m, nt0 + n, r, q, acc[n]); }
    __syncthreads();
    RK_DBG(8, S8); RK_DBG(9, S10); RK_DBG(10, S11); RK_DBG(11, S12); RK_DBG(12, S13);
    RK_ZERO(acc); mm_nt<2>(S8, LD, S9, LD, m, nt0, r, q, acc);
    RK_ZERO(acc2); mm_nt<2>(S7, LD, S11, LD, m, nt0, r, q, acc2);
#pragma unroll
    for (int n = 0; n < 2; ++n) { st_rm(S0, m, nt0 + n, r, q, acc[n]); st_tr(S1, m, nt0 + n, r, q, acc[n]); st_rm(S14, m, nt0 + n, r, q, acc2[n]); }
    __syncthreads();
    RK_DBG(13, S14);
#define RK_ROUND(Tsrc, Tdst, Psrc, PTsrc, Pdst, PTdst) do { \
        ld_rm(Tsrc, m, nt0, r, q, acc[0]); ld_rm(Tsrc, m, nt0 + 1, r, q, acc[1]); mm_nt<2>(Tsrc, LD, PTsrc, LD, m, nt0, r, q, acc); \
        RK_ZERO(acc2); mm_nt<2>(Psrc, LD, PTsrc, LD, m, nt0, r, q, acc2); \
        _Pragma("unroll") for (int n = 0; n < 2; ++n) { st_rm(Tdst, m, nt0 + n, r, q, acc[n]); st_rm(Pdst, m, nt0 + n, r, q, acc2[n]); st_tr(PTdst, m, nt0 + n, r, q, acc2[n]); } \
        __syncthreads(); } while (0)
    RK_ROUND(S10, S2, S0, S1, S8, S9);
    RK_ROUND(S2, S10, S8, S9, S0, S1);
    RK_ROUND(S10, S2, S0, S1, S8, S9);
    RK_ROUND(S2, S10, S8, S9, S0, S1);
    ld_rm(S10, m, nt0, r, q, acc[0]); ld_rm(S10, m, nt0 + 1, r, q, acc[1]); mm_nt<2>(S10, LD, S1, LD, m, nt0, r, q, acc);
#pragma unroll
    for (int n = 0; n < 2; ++n) st_rm(S2, m, nt0 + n, r, q, acc[n]);
    __syncthreads();
    RK_DBG(14, S2);
    RK_ZERO(acc); mm_nt<2>(S4, LD, S2, LD, m, nt0, r, q, acc);
    RK_ZERO(acc2); mm_nt<2>(S14, LD, S2, LD, m, nt0, r, q, acc2);
#pragma unroll
    for (int n = 0; n < 2; ++n) { st_rm(S11, m, nt0 + n, r, q, acc[n]); st_rm(S15, m, nt0 + n, r, q, acc2[n]); }
    __syncthreads();
    RK_DBG(15, S11); RK_DBG(16, S15);
    RK_ZERO(acc); mm_nt<2>(S5, LD, S11, LD, m, nt0, r, q, acc);
#pragma unroll
    for (int n = 0; n < 2; ++n) {
#pragma unroll
        for (int ii = 0; ii < 4; ++ii) { const int row = 16 * m + 4 * q + ii, col = 16 * (nt0 + n) + r; acc[n][ii] += (row == col) ? DEND[row] : 0.f; }
        st_rm(S0, m, nt0 + n, r, q, acc[n]); }
    RK_ZERO(acc); mm_nt<2>(S15, LD, S5, LD, m, nt0, r, q, acc); mm_nt<2>(S7, LD, S6, LD, m, nt0, r, q, acc);
#pragma unroll
    for (int n = 0; n < 2; ++n) st_rm(S1, m, nt0 + n, r, q, acc[n]);
    ld_rm(S3, m, nt0, r, q, acc[0]); ld_rm(S3, m, nt0 + 1, r, q, acc[1]); mm_nt<2>(S12, LD, S11, LD, m, nt0, r, q, acc);
#pragma unroll
    for (int n = 0; n < 2; ++n) st_rm(S8, m, nt0 + n, r, q, acc[n]);
    RK_ZERO(acc); mm_nt<2>(S15, LD, S12, LD, m, nt0, r, q, acc); mm_nt<2>(S7, LD, S13, LD, m, nt0, r, q, acc);
#pragma unroll
    for (int n = 0; n < 2; ++n) st_rm(S9, m, nt0 + n, r, q, acc[n]);
    __syncthreads();
    {
        unsigned char* mu_ = P.mtq + (size_t)uidx * 16384; unsigned char* nu_ = P.nty + (size_t)uidx * 16384;
        const int f = tid >> 6, mF = f >> 1, sF = f & 1, row = 16 * mF + r, c0 = 32 * sF + 4 * q;
        { const u32x2 lo = *(const LAS u32x2*)(S0 + row * LD + c0), hi = *(const LAS u32x2*)(S0 + row * LD + c0 + 16); *(u32x4*)(mu_ + tid * 16) = (u32x4){lo.x, lo.y, hi.x, hi.y}; }
        { const u32x2 lo = *(const LAS u32x2*)(S8 + row * LD + c0), hi = *(const LAS u32x2*)(S8 + row * LD + c0 + 16); *(u32x4*)(mu_ + 8192 + tid * 16) = (u32x4){lo.x, lo.y, hi.x, hi.y}; }
#pragma unroll
        for (int gi = 0; gi < 2; ++gi) { const int gidx = tid + gi * 512, vq = gidx >> 8, mG = (gidx >> 6) & 3, rowv = 16 * vq + r, colv = 16 * mG + 4 * q;
            *(u32x2*)(nu_ + gidx * 8) = *(const LAS u32x2*)(S1 + rowv * LD + colv);
            *(u32x2*)(nu_ + 8192 + gidx * 8) = *(const LAS u32x2*)(S9 + rowv * LD + colv); }
    }
    __syncthreads();
#undef RK_ZERO
#undef RK_ROUND
}
__device__ __forceinline__ void scan_chain(const unsigned char* mtq, const unsigned char* nty, bf16_t* ya, int b, int h, int vq, int ubase, int lane) {
    const int r = lane & 15, q = lane >> 4;
    bf16x8 sB[2];
#pragma unroll
    for (int s = 0; s < 2; ++s) sB[s] = (bf16x8){0, 0, 0, 0, 0, 0, 0, 0};
    bf16x8 aM[4][2], aQ[4][2]; u32x2 nI[4], yI[4];
    const unsigned char* mu_ = mtq + (size_t)ubase * 16384; const unsigned char* nu_ = nty + (size_t)ubase * 16384;
#define SC_LOAD(c) do { const unsigned char* pm = mu_ + (size_t)(c) * 16384; const unsigned char* pn = nu_ + (size_t)(c) * 16384; \
        _Pragma("unroll") for (int mm = 0; mm < 4; ++mm) { _Pragma("unroll") for (int s = 0; s < 2; ++s) { aM[mm][s] = *(const bf16x8*)(pm + ((mm * 2 + s) * 64 + lane) * 16); aQ[mm][s] = *(const bf16x8*)(pm + 8192 + ((mm * 2 + s) * 64 + lane) * 16); } \
            nI[mm] = *(const u32x2*)(pn + ((vq * 4 + mm) * 64 + lane) * 8); yI[mm] = *(const u32x2*)(pn + 8192 + ((vq * 4 + mm) * 64 + lane) * 8); } } while (0)
    SC_LOAD(0);
    for (int c = 0; c < SEQ / 64; ++c) {
        f32x4 aS[4], aY[4];
#pragma unroll
        for (int mm = 0; mm < 4; ++mm) {
            aS[mm] = (f32x4){bflo(nI[mm].x), bfhi(nI[mm].x), bflo(nI[mm].y), bfhi(nI[mm].y)};
            aY[mm] = (f32x4){bflo(yI[mm].x), bfhi(yI[mm].x), bflo(yI[mm].y), bfhi(yI[mm].y)};
#pragma unroll
            for (int s = 0; s < 2; ++s) { aS[mm] = __builtin_amdgcn_mfma_f32_16x16x32_bf16(aM[mm][s], sB[s], aS[mm], 0, 0, 0); aY[mm] = __builtin_amdgcn_mfma_f32_16x16x32_bf16(aQ[mm][s], sB[s], aY[mm], 0, 0, 0); }
        }
        if (c + 1 < SEQ / 64) SC_LOAD(c + 1);
        bf16_t* yp = ya + (size_t)(b * SEQ + c * 64) * RW + h * 64 + 16 * vq + r;
#pragma unroll
        for (int mm = 0; mm < 4; ++mm)
#pragma unroll
            for (int ii = 0; ii < 4; ++ii) yp[(size_t)(16 * mm + 4 * q + ii) * RW] = f2bf(aY[mm][ii]);
#pragma unroll
        for (int s = 0; s < 2; ++s) { u32x4 w; w.x = pk2(aS[2 * s][0], aS[2 * s][1]); w.y = pk2(aS[2 * s][2], aS[2 * s][3]); w.z = pk2(aS[2 * s + 1][0], aS[2 * s + 1][1]); w.w = pk2(aS[2 * s + 1][2], aS[2 * s + 1][3]);
            sB[s] = __builtin_bit_cast(bf16x8, w); }
    }
#undef SC_LOAD
}
}
namespace gl {
constexpr int LDV = 136;
struct Args { const bf16_t* puv; const bf16_t* wsm; const float* bs; const float* ln_g; const float* ln_b; bf16_t* yb; };
__device__ __forceinline__ void unit(const Args& P, LAS unsigned char* lds, int b, int blk, int tid) {
    const int wave = __builtin_amdgcn_readfirstlane(tid >> 6), lane = tid & 63, r = lane & 15, q = lane >> 4;
    const int t0 = b * SEQ + blk * 128;
    LAS float* STAT = (LAS float*)(lds + LDS_MISC);
    for (int j = 0; j < 16; ++j) {
        const int tk = 16 * wave + j;
        const u32x4 w = *(const u32x4*)(P.puv + (size_t)(t0 + tk) * 1024 + 512 + 8 * lane);
        float v[8]; v[0] = bflo(w.x); v[1] = bfhi(w.x); v[2] = bflo(w.y); v[3] = bfhi(w.y); v[4] = bflo(w.z); v[5] = bfhi(w.z); v[6] = bflo(w.w); v[7] = bfhi(w.w);
        float s = 0.f, s2 = 0.f;
#pragma unroll
        for (int e = 0; e < 8; ++e) { s += v[e]; s2 += v[e] * v[e]; }
        s = wave_sum(s); s2 = wave_sum(s2);
        const float mean = s * (1.f / 512.f), var = fmaxf(s2 * (1.f / 512.f) - mean * mean, 0.f);
        if (lane == 0) { STAT[tk * 2] = mean; STAT[tk * 2 + 1] = __builtin_amdgcn_rsqf(var + 1e-5f); }
    }
    __syncthreads();
    for (int g = 0; g < 8; ++g) {
        LAS bf16_t* VT = (LAS bf16_t*)(lds + (g & 1) * 20480);
#pragma unroll
        for (int it = 0; it < 2; ++it) {
            const int task = tid + it * NTHREADS, j = task >> 3, cc = task & 7, ch = g * 64 + 8 * cc;
            const u32x4 w = *(const u32x4*)(P.puv + (size_t)(t0 + j) * 1024 + 512 + ch);
            const float mean = STAT[j * 2], rstd = STAT[j * 2 + 1];
            const f32x4 g0 = *(const f32x4*)(P.ln_g + ch), g1 = *(const f32x4*)(P.ln_g + ch + 4), b0 = *(const f32x4*)(P.ln_b + ch), b1 = *(const f32x4*)(P.ln_b + ch + 4);
            float v[8]; v[0] = bflo(w.x); v[1] = bfhi(w.x); v[2] = bflo(w.y); v[3] = bfhi(w.y); v[4] = bflo(w.z); v[5] = bfhi(w.z); v[6] = bflo(w.w); v[7] = bfhi(w.w);
#pragma unroll
            for (int e = 0; e < 4; ++e) { v[e] = (v[e] - mean) * rstd * g0[e] + b0[e]; v[4 + e] = (v[4 + e] - mean) * rstd * g1[e] + b1[e]; }
#pragma unroll
            for (int e = 0; e < 8; ++e) VT[(8 * cc + e) * LDV + j] = f2bf(v[e]);
        }
        __syncthreads();
        f32x4 acc[4];
#pragma unroll
        for (int n = 0; n < 4; ++n) acc[n] = (f32x4){0.f, 0.f, 0.f, 0.f};
        const bf16_t* wrow = P.wsm + ((size_t)g * 128 + 16 * wave + r) * 128 + 8 * q;
        const int ks = (wave >> 1) + 1;
        for (int s = 0; s < ks; ++s) {
            const bf16x8 a = *(const bf16x8*)(wrow + 32 * s);
#pragma unroll
            for (int n = 0; n < 4; ++n) { const bf16x8 bb = *(const LAS bf16x8*)(VT + (16 * n + r) * LDV + 32 * s + 8 * q); acc[n] = __builtin_amdgcn_mfma_f32_16x16x32_bf16(a, bb, acc[n], 0, 0, 0); }
        }
#pragma unroll
        for (int ii = 0; ii < 4; ++ii) { const int i = 16 * wave + 4 * q + ii; const float bias = P.bs[g * 128 + i];
#pragma unroll
            for (int n = 0; n < 4; ++n) { const int c = g * 64 + 16 * n + r; const float u = bf2f(P.puv[(size_t)(t0 + i) * 1024 + c]);
                P.yb[(size_t)(t0 + i) * RW + c] = f2bf(u * (acc[n][ii] + bias)); } }
    }
    __syncthreads();
}
}

struct RouteArgs { const float* sc; const float* bias; int* eidx; float* ewt; int* lrank; int* tbase; unsigned* segcnt; };
__device__ __forceinline__ void phase_topk(const RouteArgs& P, LAS unsigned char* lds, int tid, int G) {
    const int wave = __builtin_amdgcn_readfirstlane(tid >> 6), lane = tid & 63, grp = lane >> 3;
    LAS int* hist = (LAS int*)(lds + LDS_MISC);
    const f32x4 bias4 = *(const f32x4*)(P.bias + 4 * lane);
    const float NEG = -__builtin_inff();
    for (int tile = blockIdx.x; tile < T / 256; tile += G) {
        if (tid < NE) hist[tid] = 0;
        __syncthreads();
        for (int j = 0; j < 32; ++j) {
            const int t = tile * 256 + wave * 32 + j;
            const f32x4 s4 = *(const f32x4*)(P.sc + (size_t)t * NE + 4 * lane);
            float s[4] = {s4.x, s4.y, s4.z, s4.w}, v[4];
#pragma unroll
            for (int e = 0; e < 4; ++e) v[e] = s[e] + bias4[e];
            float m1 = fmaxf(fmaxf(v[0], v[1]), fmaxf(v[2], v[3]));
            float m2;
            { const float a = fmaxf(v[0], v[1]), b = fminf(v[0], v[1]), c = fmaxf(v[2], v[3]), d = fminf(v[2], v[3]); m2 = fmaxf(fminf(a, c), fmaxf(b, d)); }
#pragma unroll
            for (int o = 1; o < 8; o <<= 1) { const float o1 = __shfl_xor(m1, o), o2 = __shfl_xor(m2, o); const float n1 = fmaxf(m1, o1), n2 = fmaxf(fminf(m1, o1), fmaxf(m2, o2)); m1 = n1; m2 = n2; }
            const float gs = m1 + m2;
            int cnt = 0;
#pragma unroll
            for (int g = 0; g < 8; ++g) { const float og = __shfl(gs, 8 * g); cnt += (og > gs || (og == gs && g < grp)) ? 1 : 0; }
            const bool sel = cnt < 4;
#pragma unroll
            for (int e = 0; e < 4; ++e) v[e] = sel ? v[e] : NEG;
            int myidx = 0; float mysc = 0.f, ssum = 0.f;
#pragma unroll
            for (int k = 0; k < TOPK; ++k) {
                float bv = v[0]; int bi = 0;
#pragma unroll
                for (int e = 1; e < 4; ++e) { if (v[e] > bv) { bv = v[e]; bi = e; } }
                int idx = 4 * lane + bi;
#pragma unroll
                for (int o = 1; o < 64; o <<= 1) { const float ov = __shfl_xor(bv, o); const int oi = __shfl_xor(idx, o); if (ov > bv || (ov == bv && oi < idx)) { bv = ov; idx = oi; } }
                const int own = idx >> 2, ee = idx & 3;
                const float mine = (ee == 0) ? s[0] : (ee == 1) ? s[1] : (ee == 2) ? s[2] : s[3];
                const float scv = __shfl(mine, own);
                if (lane == own) {
#pragma unroll
                    for (int e = 0; e < 4; ++e) v[e] = (e == ee) ? NEG : v[e]; }
                ssum += scv;
                if (lane == k) { myidx = idx; mysc = scv; }
            }
            if (lane < TOPK) {
                const int lr = __hip_atomic_fetch_add(hist + myidx, 1, __ATOMIC_RELAXED, __HIP_MEMORY_SCOPE_WORKGROUP);
                P.eidx[(size_t)t * TOPK + lane] = myidx; P.ewt[(size_t)t * TOPK + lane] = mysc / ssum * 2.5f; P.lrank[(size_t)t * TOPK + lane] = lr;
            }
        }
        __syncthreads();
        if (tid < NE) { const int cnt = hist[tid]; const int half = tile >> 7; unsigned base = 0u;
            if (cnt) base = __hip_atomic_fetch_add(P.segcnt + tid * 2 + half, (unsigned)cnt, __ATOMIC_RELAXED, __HIP_MEMORY_SCOPE_AGENT);
            P.tbase[tile * NE + tid] = (int)base; }
        __syncthreads();
    }
}
struct ScatArgs { const int* eidx; const float* ewt; const int* lrank; const int* tbase; const unsigned* segcnt; int* rowtok; int* rowdst; float* roww; int* tab; unsigned* ntile; };
__device__ __forceinline__ void phase_scatter(const ScatArgs& P, LAS unsigned char* lds, int tid, int G) {
    LAS int* cntL = (LAS int*)(lds + LDS_MISC); LAS int* segst = cntL + 512; LAS int* tsa = segst + 512; LAS int* tsh = tsa + 512;
    cntL[tid] = (int)__hip_atomic_load(P.segcnt + tid, __ATOMIC_RELAXED, __HIP_MEMORY_SCOPE_AGENT);
    __syncthreads();
    if (tid == 0) {
        int run = 0, ta = 0, th0 = 0, th1 = 0;
        for (int s = 0; s < 512; ++s) { const int nts = (cntL[s] + 255) >> 8; segst[s] = run; tsa[s] = ta; tsh[s] = (s & 1) ? th1 : th0; run += nts * 256; ta += nts; if (s & 1) th1 += nts; else th0 += nts; }
        if (blockIdx.x == 0) { P.ntile[0] = (unsigned)ta; P.ntile[1] = (unsigned)th0; P.ntile[2] = (unsigned)th1; }
    }
    __syncthreads();
    for (int tile = blockIdx.x; tile < T / 256; tile += G) {
        for (int a = tid; a < 256 * TOPK; a += NTHREADS) {
            const int tok = tile * 256 + (a >> 3), k = a & 7; const size_t ai = (size_t)tok * TOPK + k;
            const int e = P.eidx[ai], half = tok >> 15;
            const int pos = segst[e * 2 + half] + P.tbase[tile * NE + e] + P.lrank[ai];
            P.rowtok[pos] = tok; P.rowdst[pos] = (tok & (HALF_T - 1)) * TOPK + k; P.roww[pos] = P.ewt[ai];
        }
    }
    for (int s = blockIdx.x; s < 512; s += G) {
        const int st = segst[s], cnt = cntL[s], nts = (cnt + 255) >> 8;
        for (int p = st + cnt + tid; p < st + nts * 256; p += NTHREADS) { P.rowtok[p] = 0; P.rowdst[p] = -1; P.roww[p] = 0.f; }
        if (tid < nts) { int* ta_ = P.tab + 2 * (tsa[s] + tid); ta_[0] = st + 256 * tid; ta_[1] = s >> 1;
            int* th_ = P.tab + 2 * 4096 * (1 + (s & 1)) + 2 * (tsh[s] + tid); th_[0] = st + 256 * tid; th_[1] = s >> 1; }
    }
}
constexpr int NPHASE = 20;
struct KArgs { const float* in[34]; float* out; unsigned char* ws; int ph_lo, ph_hi; };
template <int PLO, int PHI>
__global__ void __launch_bounds__(NTHREADS, 2) fwd_kernel(KArgs a) {
    extern __shared__ __attribute__((aligned(16))) unsigned char lds_raw[];
    LAS unsigned char* lds = (LAS unsigned char*)lds_raw;
    const int G = gridDim.x, bid = blockIdx.x, NGW = G * NWAVES;
#define PH_IDS() int tid = threadIdx.x; asm volatile("" : "+v"(tid)); const int lane = tid & 63, wave = __builtin_amdgcn_readfirstlane(tid >> 6), gw = bid * NWAVES + wave; (void)lane; (void)wave; (void)gw
    unsigned char* ws = a.ws;
    unsigned* ctl = (unsigned*)(ws + WS_CTL);
    float* mod = (float*)(ws + WS_MOD);
    constexpr int lo = PLO, hi = PHI;
    if (threadIdx.x == 0) *(LAS u32x4*)(lds + LDS_BARW) = (u32x4){0u, 0u, 0u, 0u};
    __syncthreads();
    XcdBarrier bar; bar.bar = ctl + CW_BAR; bar.x = 0; bar.st = nullptr;
    if (hi - lo > 1) bar = xcd_barrier_post(ctl + CW_BAR, (volatile LAS unsigned*)(lds + LDS_BARW));
#define IN(k) (lo <= (k) && (k) < hi)
#define SEAM(k) do { if (IN(k) && IN((k) + 1)) xcd_barrier(bar); } while (0)

    if (IN(0)) { PH_IDS();
        phase_mod(a.in[1], a.in[2], a.in[3], mod, lds, tid, G);
        SmallW sw{a.in[6], a.in[22], a.in[23], a.in[24], a.in[25], a.in[30], a.in[31], a.in[32], a.in[9], a.in[11], a.in[12], a.in[20]};
        phase_small_weights(sw, ws, lds, gw, NGW, wave, lane);
    }
    SEAM(0);
    if (IN(1)) { PH_IDS(); phase_norm_mod(a.in[0], a.in[4], mod, 0, 1024, (bf16_t*)(ws + B_H1), gw, NGW, lane); }
    SEAM(1);
    if (IN(2)) {
        gm::DenseSched S; S.init(ws + B_H1, ws + SW_WIN, T, IN_COLS, D, G, bid);
        gm::EpiInProj E{(bf16_t*)(ws + B_PRW), (bf16_t*)(ws + B_PUV), (bf16_t*)(ws + B_PG)};
        gm::gemm_phase<gm::EpiInProj, gm::DenseSched, true>(lds, D, S, E);
    }
    SEAM(2);
#define RWKV_PREP(half) do { \
        rk::Args P{(const bf16_t*)(ws + B_PRW), a.in[7], a.in[8], a.in[10], a.in[13], a.in[14], a.in[15], (const bf16_t*)(ws + SW_WUP), (const bf16_t*)(ws + SW_AUP), (const bf16_t*)(ws + SW_GUP), \
                   (bf16_t*)(ws + B_G), (float*)(ws + RT_SBON), ws + B_MTQ, ws + B_NTY, ctl + 5100}; \
        for (int u = bid; u < 4096; u += G) rk::unit(P, lds, (half) * 4 + (u >> 10), (u >> 7) & 7, u & 127, u, tid); } while (0)
#define RWKV_SCAN(half) do { \
        for (int w = bid + G * wave; w < 128; w += G * NWAVES) rk::scan_chain(ws + B_MTQ, ws + B_NTY, (bf16_t*)(ws + B_YA), (half) * 4 + (w >> 5), (w >> 2) & 7, w & 3, (w >> 2) * 128, lane); } while (0)
    if (IN(3)) { PH_IDS();
        RWKV_PREP(0);
        gl::Args Q{(const bf16_t*)(ws + B_PUV), (const bf16_t*)(ws + SW_WSM), a.in[21], a.in[18], a.in[19], (bf16_t*)(ws + B_YB)};
        for (int u = bid; u < 512; u += G) gl::unit(Q, lds, u >> 6, u & 63, tid);
    }
    SEAM(3);
    if (IN(4)) { PH_IDS(); RWKV_SCAN(0); }
    SEAM(4);
    if (IN(5)) { PH_IDS(); RWKV_PREP(1); }
    SEAM(5);
    if (IN(6)) { PH_IDS(); RWKV_SCAN(1); }
    SEAM(6);
    if (IN(7)) { PH_IDS(); YaArgs P{(bf16_t*)(ws + B_YA), (const bf16_t*)(ws + B_G), (const bf16_t*)(ws + B_PRW), (const float*)(ws + RT_SBON), a.in[7], a.in[16], a.in[17]}; phase_ya_final(P, gw, NGW, lane); }
    SEAM(7);
    if (IN(8)) {
        gm::DenseSched S; S.init(ws + B_YA, ws + SW_WOA, T, D, RW, G, bid);
        gm::EpiMerge<false> E{(bf16_t*)(ws + B_M1), (const bf16_t*)(ws + B_PG)};
        gm::gemm_phase<gm::EpiMerge<false>, gm::DenseSched, true>(lds, RW, S, E);
    }
    SEAM(8);
    if (IN(9)) {
        gm::DenseSched S; S.init(ws + B_YB, ws + SW_WOB, T, D, RW, G, bid);
        gm::EpiMerge<true> E{(bf16_t*)(ws + B_M1), (const bf16_t*)(ws + B_PG)};
        gm::gemm_phase<gm::EpiMerge<true>, gm::DenseSched, true>(lds, RW, S, E);
    }
    SEAM(9);
    if (IN(10)) {
        gm::DenseSched S; S.init(ws + B_M1, ws + SW_WO, T, D, D, G, bid);
        gm::EpiResid E{a.out, a.in[0], mod + 2048};
        gm::gemm_phase<gm::EpiResid, gm::DenseSched, true>(lds, D, S, E);
    }
    SEAM(10);
    if (IN(11)) { PH_IDS();
        phase_norm_mod(a.out, a.in[5], mod, 3072, 4096, (bf16_t*)(ws + B_H2), gw, NGW, lane);
        phase_expert_weights(a.in[27], a.in[28], a.in[29], ws, lds, gw, NGW, wave, lane);
    }
    SEAM(11);
    if (IN(12)) {
        { gm::DenseSched S; S.init(ws + B_H2, ws + SW_WR, T, NE, D, G, bid); gm::EpiRouter E{(float*)(ws + B_SC)}; gm::gemm_phase<gm::EpiRouter, gm::DenseSched, true>(lds, D, S, E); }
        { gm::DenseSched S; S.init(ws + B_H2, ws + SW_WS13, T, 512, D, G, bid); gm::EpiGateUp E{(bf16_t*)(ws + B_SH)}; gm::gemm_phase<gm::EpiGateUp, gm::DenseSched, true>(lds, D, S, E); }
    }
    SEAM(12);
    if (IN(13)) { PH_IDS();
        RouteArgs R{(const float*)(ws + B_SC), a.in[26], (int*)(ws + RT_EIDX), (float*)(ws + RT_EWT), (int*)(ws + RT_LRANK), (int*)(ws + RT_TBASE), ctl + CW_SEGCNT};
        phase_topk(R, lds, tid, G);
        gm::DenseSched S; S.init(ws + B_SH, ws + SW_WS2, T, D, EFF, G, bid);
        gm::EpiResid E{a.out, a.out, mod + 5120};
        gm::gemm_phase<gm::EpiResid, gm::DenseSched, true>(lds, EFF, S, E);
    }
    SEAM(13);
    if (IN(14)) { PH_IDS();
        ScatArgs P{(const int*)(ws + RT_EIDX), (const float*)(ws + RT_EWT), (const int*)(ws + RT_LRANK), (const int*)(ws + RT_TBASE), ctl + CW_SEGCNT,
                   (int*)(ws + RT_ROWTOK), (int*)(ws + RT_ROWDST), (float*)(ws + RT_ROWW), (int*)(ws + RT_TAB), ctl + CW_NT};
        phase_scatter(P, lds, tid, G);
    }
    SEAM(14);
    if (IN(15)) {
        gm::GroupSched<true> S; S.A = (const char*)(ws + B_H2); S.B = (const char*)(ws + B_W13); S.tab = (const int*)(ws + RT_TAB); S.rowtok = (const int*)(ws + RT_ROWTOK);
        S.ntiles = (int)__hip_atomic_load(ctl + CW_NT, __ATOMIC_RELAXED, __HIP_MEMORY_SCOPE_AGENT); S.npn = 2; S.G = G; S.c = bid; S.K = D; S.ebytes = (size_t)512 * D * 2; S.tstep = (size_t)256 * D * 2;
        gm::EpiGateUp E{(bf16_t*)(ws + B_HID)};
        gm::gemm_phase<gm::EpiGateUp, gm::GroupSched<true>, true>(lds, D, S, E);
    }
    SEAM(15);
#define MOE_DOWN(half) do { \
        gm::GroupSched<false> S; S.A = (const char*)(ws + B_HID); S.B = (const char*)(ws + B_W2); S.tab = (const int*)(ws + RT_TAB) + 2 * 4096 * (1 + (half)); S.rowtok = nullptr; \
        S.ntiles = (int)__hip_atomic_load(ctl + CW_NT + 1 + (half), __ATOMIC_RELAXED, __HIP_MEMORY_SCOPE_AGENT); S.npn = 4; S.G = G; S.c = bid; S.K = EFF; S.ebytes = (size_t)D * EFF * 2; S.tstep = (size_t)256 * EFF * 2; \
        gm::EpiExpertDown E{(bf16_t*)(ws + B_SLOT), (const int*)(ws + RT_ROWDST), (const float*)(ws + RT_ROWW)}; \
        gm::gemm_phase<gm::EpiExpertDown, gm::GroupSched<false>, true>(lds, EFF, S, E); } while (0)
    if (IN(16)) MOE_DOWN(0);
    SEAM(16);
    if (IN(17)) { PH_IDS(); phase_combine(a.out, (const bf16_t*)(ws + B_SLOT), mod, a.in[33], 0, gw, NGW, lane); }
    SEAM(17);
    if (IN(18)) MOE_DOWN(1);
    SEAM(18);
    if (IN(19)) { PH_IDS(); phase_combine(a.out, (const bf16_t*)(ws + B_SLOT), mod, a.in[33], 1, gw, NGW, lane); }
#undef IN
#undef SEAM
#undef RWKV_PREP
#undef RWKV_SCAN
#undef MOE_DOWN
}

#ifdef DBG_CHECK
__global__ void dbg_rows(const int* rowdst, const int* rowtok, const int* tab, const unsigned* nt, unsigned* flags) {
    const unsigned nall = nt[0], n0 = nt[1], n1 = nt[2];
    if (blockIdx.x == 0 && threadIdx.x == 0) { if (nall != n0 + n1 || nall > 2560u || nall < 2048u) atomicOr(flags, 8u); }
    const size_t nrows = (size_t)(nall <= 2560u ? nall : 2560u) * 256;
    unsigned m = 0;
    for (size_t i = (size_t)blockIdx.x * blockDim.x + threadIdx.x; i < nrows; i += (size_t)gridDim.x * blockDim.x) {
        const int d = rowdst[i], t = rowtok[i];
        if (d >= 262144) m |= 1u; if (d < -1) m |= 2u; if (t < 0 || t >= 65536) m |= 4u; }
    for (unsigned i = blockIdx.x * blockDim.x + threadIdx.x; i < 2560u; i += gridDim.x * blockDim.x) {
        if (i < nall) { const int r0 = tab[2 * i]; if (r0 < 0 || r0 + 256 > (int)nrows || (r0 & 255)) m |= 16u; }
        if (i < n0) { const int r0 = tab[2 * 4096 + 2 * i]; if (r0 < 0 || r0 + 256 > (int)nrows || (r0 & 255)) m |= 16u; }
        if (i < n1) { const int r0 = tab[4 * 4096 + 2 * i]; if (r0 < 0 || r0 + 256 > (int)nrows || (r0 & 255)) m |= 16u; } }
    if (m) atomicOr(flags, m);
}
__global__ void dbg_report(float* out, const unsigned* flags) { if (threadIdx.x == 0 && blockIdx.x == 0) out[0] = 100.0f * (float)(flags[0] & 63u); }
static void dbg_run(void* d_out, void* d_ws, hipStream_t stream) {
    unsigned char* ws = (unsigned char*)d_ws; unsigned* flags = (unsigned*)(ws + WS_CTL) + 5100;
    dbg_rows<<<512, 256, 0, stream>>>((const int*)(ws + RT_ROWDST), (const int*)(ws + RT_ROWTOK), (const int*)(ws + RT_TAB), (const unsigned*)(ws + WS_CTL) + CW_NT, flags);
    dbg_report<<<1, 64, 0, stream>>>((float*)d_out, flags);
}
#endif
#ifndef MK_SINGLE
#define MK_SINGLE 0
#endif
template <int PLO, int PHI> static bool prep_kernel() {
    int per_cu = 0;
    if (hipFuncSetAttribute((const void*)fwd_kernel<PLO, PHI>, hipFuncAttributeMaxDynamicSharedMemorySize, LDS_BYTES) != hipSuccess) { fprintf(stderr, "kernel_launch: hipFuncSetAttribute failed\n"); return false; }
    if (hipOccupancyMaxActiveBlocksPerMultiprocessor(&per_cu, (const void*)fwd_kernel<PLO, PHI>, NTHREADS, LDS_BYTES) != hipSuccess || per_cu < 1) { fprintf(stderr, "kernel_launch: occupancy query says %d\n", per_cu); (void)hipGetLastError(); return false; }
    return true;
}
template <int P> struct PhaseLaunch {
    static bool prep() { return prep_kernel<P, P + 1>() && PhaseLaunch<P + 1>::prep(); }
    static void go(int grid, hipStream_t stream, const KArgs& a) { hipLaunchKernelGGL((fwd_kernel<P, P + 1>), dim3(grid), dim3(NTHREADS), LDS_BYTES, stream, a); PhaseLaunch<P + 1>::go(grid, stream, a); }
};
#ifndef DBG_LAST
#define DBG_LAST NPHASE
#endif
template <> struct PhaseLaunch<DBG_LAST> { static bool prep() { return true; } static void go(int, hipStream_t, const KArgs&) {} };
extern "C" void kernel_launch(void* const* d_in, const int* in_sizes, int n_in, void* d_out, int out_size, void* d_ws, size_t ws_size, hipStream_t stream) {
    static int grid = 0;
    if (grid == 0) {
        if (n_in != 34 || out_size != T * D || ws_size < WS_END) { fprintf(stderr, "kernel_launch: unexpected problem shape (n_in %d, out %d, ws %zu < %zu)\n", n_in, out_size, ws_size, (size_t)WS_END); grid = -1; return; }
        int dev = 0, cus = 0;
        if (hipGetDevice(&dev) != hipSuccess || hipDeviceGetAttribute(&cus, hipDeviceAttributeMultiprocessorCount, dev) != hipSuccess) { grid = -1; return; }
#if MK_SINGLE
        if (!prep_kernel<0, NPHASE>()) { grid = -1; return; }
#else
        if (!PhaseLaunch<0>::prep()) { grid = -1; return; }
#endif
        grid = cus;
    }
    if (grid < 0) return;
    (void)hipMemsetAsync((char*)d_ws + WS_CTL, 0, CTL_ZERO_BYTES, stream);
    KArgs a{};
    for (int i = 0; i < 34; ++i) a.in[i] = (const float*)d_in[i];
    a.out = (float*)d_out; a.ws = (unsigned char*)d_ws; a.ph_lo = 0; a.ph_hi = NPHASE;
#if MK_SINGLE
    hipLaunchKernelGGL((fwd_kernel<0, NPHASE>), dim3(grid), dim3(NTHREADS), LDS_BYTES, stream, a);
#else
    PhaseLaunch<0>::go(grid, stream, a);
#endif
#ifdef DBG_CHECK
    dbg_run(d_out, d_ws, stream);
#endif
}
```

```cpp
#define MK_SINGLE 1
#include <hip/hip_runtime.h>
#include <cstdio>
#include <cstdint>

#define LAS __attribute__((address_space(3)))
#define GAS __attribute__((address_space(1)))
typedef unsigned short bf16_t;
typedef short bf16x8 __attribute__((ext_vector_type(8)));
typedef float f32x4 __attribute__((ext_vector_type(4)));
typedef float f32x2 __attribute__((ext_vector_type(2)));
typedef unsigned u32x4 __attribute__((ext_vector_type(4)));
typedef unsigned u32x2 __attribute__((ext_vector_type(2)));

constexpr int D = 1024, NB = 8, SEQ = 8192, T = NB * SEQ;
constexpr int RW = 512, HD = 64, NH = 8;
constexpr int RWKV_COLS = 1792, IN_COLS = 4864;
constexpr int NE = 256, TOPK = 8, EFF = 256;
constexpr int NWAVES = 8, NTHREADS = 512;
constexpr int HALF_T = T / 2;
constexpr int MAXROWS = T * TOPK + 512 * 256;

constexpr size_t MiB = 1u << 20;
constexpr size_t WS_CTL = 0;
constexpr int CW_BAR = 0, CW_SEGCNT = 4096, CW_NT = 4608;
constexpr size_t CTL_ZERO_BYTES = 20480;
constexpr size_t WS_MOD = 65536;
constexpr size_t WS_SW = 1 * MiB;
constexpr size_t SW_WIN = WS_SW;
constexpr size_t SW_WOA = SW_WIN + (size_t)IN_COLS * D * 2;
constexpr size_t SW_WOB = SW_WOA + (size_t)D * RW * 2;
constexpr size_t SW_WO = SW_WOB + (size_t)D * RW * 2;
constexpr size_t SW_WR = SW_WO + (size_t)D * D * 2;
constexpr size_t SW_WS13 = SW_WR + (size_t)NE * D * 2;
constexpr size_t SW_WS2 = SW_WS13 + (size_t)512 * D * 2;
constexpr size_t SW_WUP = SW_WS2 + (size_t)D * EFF * 2;
constexpr size_t SW_AUP = SW_WUP + (size_t)RW * 64 * 2;
constexpr size_t SW_GUP = SW_AUP + (size_t)RW * 64 * 2;
constexpr size_t SW_WSM = SW_GUP + (size_t)RW * 128 * 2;
constexpr size_t SW_END = SW_WSM + (size_t)8 * 128 * 128 * 2;
static_assert(SW_END <= 20 * MiB, "small weights");
constexpr size_t WS_RT = 20 * MiB;
constexpr size_t RT_EIDX = WS_RT;
constexpr size_t RT_EWT = RT_EIDX + (size_t)T * 8 * 4;
constexpr size_t RT_LRANK = RT_EWT + (size_t)T * 8 * 4;
constexpr size_t RT_TBASE = RT_LRANK + (size_t)T * 8 * 4;
constexpr size_t RT_ROWTOK = RT_TBASE + (size_t)256 * 256 * 4;
constexpr size_t RT_ROWDST = RT_ROWTOK + (size_t)MAXROWS * 4;
constexpr size_t RT_ROWW = RT_ROWDST + (size_t)MAXROWS * 4;
constexpr size_t RT_TAB = RT_ROWW + (size_t)MAXROWS * 4;
constexpr size_t RT_SBON = RT_TAB + (size_t)3 * 4096 * 8;
constexpr size_t RT_END = RT_SBON + (size_t)T * 8 * 4;
static_assert(RT_END <= 40 * MiB, "routing arrays");
constexpr size_t WS_BIG = 40 * MiB;
constexpr size_t B_H1 = WS_BIG + 0 * MiB;
constexpr size_t B_YB = WS_BIG + 0 * MiB;
constexpr size_t B_YA = WS_BIG + 64 * MiB;
constexpr size_t B_PRW = WS_BIG + 128 * MiB;
constexpr size_t B_PUV = WS_BIG + 352 * MiB;
constexpr size_t B_M1 = WS_BIG + 352 * MiB;
constexpr size_t B_PG = WS_BIG + 480 * MiB;
constexpr size_t B_MTQ = WS_BIG + 736 * MiB;
constexpr size_t B_NTY = WS_BIG + 800 * MiB;
constexpr size_t B_G = WS_BIG + 864 * MiB;
constexpr size_t B_H2 = WS_BIG + 0 * MiB;
constexpr size_t B_W13 = WS_BIG + 128 * MiB;
constexpr size_t B_SH = WS_BIG + 384 * MiB;
constexpr size_t B_SC = WS_BIG + 416 * MiB;
constexpr size_t B_SLOT = WS_BIG + 0 * MiB;
constexpr size_t B_W2 = WS_BIG + 512 * MiB;
constexpr size_t B_HID = WS_BIG + 640 * MiB;
constexpr size_t WS_END = WS_BIG + 960 * MiB;
static_assert((size_t)MAXROWS * EFF * 2 <= 320 * MiB, "hid");

constexpr int LDS_STAGE = 0;
constexpr int LDS_MISC = 147456;
constexpr int LDS_BARW = 155648;
constexpr int LDS_BYTES = 163840;

typedef __bf16 bf16x2_t __attribute__((ext_vector_type(2)));
__device__ __forceinline__ unsigned pk2(float lo, float hi) { f32x2 f = {lo, hi}; return __builtin_bit_cast(unsigned, __builtin_convertvector(f, bf16x2_t)); }
__device__ __forceinline__ float bflo(unsigned w) { return __uint_as_float(w << 16); }
__device__ __forceinline__ float bfhi(unsigned w) { return __uint_as_float(w & 0xffff0000u); }
__device__ __forceinline__ float bf2f(bf16_t h) { return __uint_as_float(((unsigned)h) << 16); }
__device__ __forceinline__ bf16_t f2bf(float f) { return (bf16_t)(pk2(f, 0.f) & 0xffffu); }
__device__ __forceinline__ float fexp(float x) { return __builtin_amdgcn_exp2f(x * 1.44269504089f); }
__device__ __forceinline__ float flog(float x) { return __builtin_amdgcn_logf(x) * 0.69314718056f; }
__device__ __forceinline__ float frcp(float x) { return __builtin_amdgcn_rcpf(x); }
__device__ __forceinline__ float sigmoidf_(float x) { return frcp(1.0f + fexp(-x)); }
__device__ __forceinline__ float siluf_(float x) { return x * sigmoidf_(x); }
__device__ __forceinline__ float tanhf_(float x) { return 1.0f - 2.0f * frcp(1.0f + fexp(2.0f * x)); }
__device__ __forceinline__ float gelu_tanh(float x) { const float u = 0.7978845608f * (x + 0.044715f * x * x * x); return x * frcp(1.0f + fexp(-2.0f * u)); }
__device__ __forceinline__ float wave_sum(float v) {
#pragma unroll
    for (int o = 1; o < 64; o <<= 1) v += __shfl_xor(v, o);
    return v;
}
#define LDS_WAIT() asm volatile("s_waitcnt lgkmcnt(0)" ::: "memory")
#define VM_WAIT() asm volatile("s_waitcnt vmcnt(0)" ::: "memory")

#define XB_TMO      128
#define XB_XCNT(j)  (256  + 64 * (j))
#define XB_XSUB(j)  (1280 + 64 * (j))
#define XB_XGEN(j)  (2304 + 64 * (j))
#define XB_TOP      3328
#define XB_TOPGEN   3392
#define XCD_BAR_WORDS 3456
#define XB_SPIN_CAP (1u << 18)
__device__ __forceinline__ unsigned xb_ld(unsigned* p)              { return __hip_atomic_load(p, __ATOMIC_RELAXED, __HIP_MEMORY_SCOPE_AGENT); }
__device__ __forceinline__ unsigned xb_add(unsigned* p, unsigned v) { return __hip_atomic_fetch_add(p, v, __ATOMIC_RELAXED, __HIP_MEMORY_SCOPE_AGENT); }
__device__ __forceinline__ unsigned xb_xcc_id() { return (unsigned)__builtin_amdgcn_s_getreg((3 << 11) | 20) & 0xFu; }
#define XB_SPIN(cond, bar) do { unsigned _sp = 0; while (cond) { __builtin_amdgcn_s_sleep(1); \
    if ((++_sp & 255u) == 0u) { if (xb_ld(&(bar)[XB_TMO])) break; if (_sp > XB_SPIN_CAP) { atomicAdd(&(bar)[XB_TMO], 1u); break; } } } } while (0)
struct XcdBarrier { unsigned* bar; unsigned x; volatile LAS unsigned* st; };
__device__ __forceinline__ XcdBarrier xcd_barrier_post(unsigned* bar, volatile LAS unsigned* st) {
    XcdBarrier b; b.bar = bar; b.x = xb_xcc_id(); b.st = st;
    if (threadIdx.x == 0) (void)xb_add(&bar[XB_XCNT(b.x)], 1u);
    return b;
}
__device__ __forceinline__ void xcd_barrier_complete(unsigned* bar, unsigned x, unsigned& nloc, unsigned& nx) {
    const unsigned G = gridDim.x * gridDim.y * gridDim.z;
    unsigned sum, cnt, mine, sp = 0u;
    for (;;) {
        sum = 0u; cnt = 0u; mine = 0u;
#pragma unroll
        for (unsigned j = 0; j < 16; ++j) { const unsigned c = xb_ld(&bar[XB_XCNT(j)]); sum += c; cnt += (c > 0u) ? 1u : 0u; mine = (j == x) ? c : mine; }
        if (sum == G) break;
        __builtin_amdgcn_s_sleep(1);
        if ((++sp & 255u) == 0u) { if (xb_ld(&bar[XB_TMO])) break; if (sp > XB_SPIN_CAP) { atomicAdd(&bar[XB_TMO], 1u); break; } }
    }
    nloc = mine > 0u ? mine : 1u; nx = cnt > 0u ? cnt : 1u;
}
__device__ __forceinline__ void xcd_barrier(const XcdBarrier& b) {
    asm volatile("s_waitcnt vmcnt(0)" ::: "memory");
    __syncthreads();
    if (threadIdx.x == 0) {
        unsigned* bar = b.bar;
        __builtin_amdgcn_s_waitcnt(0);
        unsigned nloc = b.st[0], nx = b.st[1];
        if (nloc == 0u) { xcd_barrier_complete(bar, b.x, nloc, nx); b.st[0] = nloc; b.st[1] = nx; }
        const unsigned old = xb_add(&bar[XB_XSUB(b.x)], 1u);
        const unsigned gen = old / nloc;
        if (old + 1u == (gen + 1u) * nloc) {
            __builtin_amdgcn_fence(__ATOMIC_RELEASE, "agent");
            asm volatile("s_waitcnt vmcnt(0)" ::: "memory");
            const unsigned og = xb_add(&bar[XB_TOP], 1u);
            const unsigned tg = og / nx;
            if (og + 1u == (tg + 1u) * nx) xb_add(&bar[XB_TOPGEN], 1u);
            else XB_SPIN(xb_ld(&bar[XB_TOPGEN]) == tg, bar);
            __builtin_amdgcn_fence(__ATOMIC_ACQUIRE, "agent");
            xb_add(&bar[XB_XGEN(b.x)], 1u);
            asm volatile("s_waitcnt vmcnt(0)" ::: "memory");
        } else {
            XB_SPIN(xb_ld(&bar[XB_XGEN(b.x)]) == gen, bar);
            __builtin_amdgcn_fence(__ATOMIC_ACQUIRE, "agent");
            asm volatile("s_waitcnt vmcnt(0)" ::: "memory");
        }
    }
    __syncthreads();
}
namespace gm {
constexpr int BM = 256, BK = 64, HALF = 128, HTB = HALF * BK * 2, STAGE_BYTES = 8 * HTB, NXCD = 8, WGM = 8;
__host__ __device__ __forceinline__ int lds_byte(int r, int c) { const int st = (r >> 4) * 2 + (c >> 5), rr = r & 15, cc = c & 31, ob = rr * 64 + cc * 2; return st * 1024 + (ob ^ (((ob >> 9) & 1) << 5)); }
__host__ __device__ __forceinline__ void stage_rc(int b, int& R, int& C) { const int st = b / 1024, sb = b % 1024, swz = sb ^ (((sb >> 9) & 1) << 5); R = (st >> 1) * 16 + swz / 64; C = (st & 1) * 32 + (swz % 64) / 2; }
__host__ __device__ __forceinline__ int perm32(int rho) { const int n = rho >> 4, i = rho & 15; return 8 * (i >> 2) + 4 * n + (i & 3); }

struct Unit { int pm, pn, e, row0, par; };

struct DenseSched {
    static constexpr bool GATHER = false;
    const char* A; const char* B; int nM, nN, nwg, G, c; size_t tstep;
    __device__ __forceinline__ void init(const void* A_, const void* B_, int M, int N, int K, int G_, int c_) { A = (const char*)A_; B = (const char*)B_; nM = M / BM; nN = N / BM; nwg = nM * nN; G = G_; c = c_; tstep = (size_t)BM * K * 2; }
    __device__ __forceinline__ bool next(int i, Unit& u) const {
        const long L = (long)i * G + c; if (L >= nwg) return false;
        int wgid = (int)L; { const int q = nwg / NXCD, r = nwg % NXCD, xcd = wgid % NXCD, off = wgid / NXCD; wgid = (xcd < r ? xcd * (q + 1) : r * (q + 1) + (xcd - r) * q) + off; }
        const int nig = WGM * nN, gid = wgid / nig, fm = gid * WGM, gsz = (nM - fm) < WGM ? (nM - fm) : WGM;
        u.pm = fm + ((wgid % nig) % gsz); u.pn = (wgid % nig) / gsz; u.e = 0; u.row0 = u.pm * BM; return true;
    }
    __device__ __forceinline__ const char* a_ptr(const Unit& u) const { return A + (size_t)u.pm * tstep; }
    __device__ __forceinline__ const char* b_ptr(const Unit& u) const { return B + (size_t)u.pn * tstep; }
    __device__ __forceinline__ unsigned row_off(const Unit&, int) const { return 0u; }
};
template <bool GATHER_>
struct GroupSched {
    static constexpr bool GATHER = GATHER_;
    const char* A; const char* B; const int* tab; const int* rowtok; int ntiles, npn, G, c, K; size_t ebytes, tstep;
    __device__ __forceinline__ bool next(int i, Unit& u) const {
        const long L = (long)i * G + c; if (L >= (long)ntiles * npn) return false;
        const int tile = (int)(L / npn); u.pn = (int)(L % npn); u.pm = tile;
        u.row0 = __builtin_amdgcn_readfirstlane(tab[2 * tile]); u.e = __builtin_amdgcn_readfirstlane(tab[2 * tile + 1]); return true;
    }
    __device__ __forceinline__ const char* a_ptr(const Unit& u) const { return GATHER ? A : A + (size_t)u.row0 * K * 2; }
    __device__ __forceinline__ const char* b_ptr(const Unit& u) const { return B + (size_t)u.e * ebytes + (size_t)u.pn * tstep; }
    __device__ __forceinline__ unsigned row_off(const Unit& u, int r) const { return (unsigned)rowtok[u.row0 + r] * (unsigned)(K * 2); }
};

template <class Epi, class Sched, bool ALIGN_EPI>
__device__ __forceinline__ void gemm_phase(LAS unsigned char* lds, const int K, const Sched& S, const Epi& E) {
    int tid_ = threadIdx.x; asm volatile("" : "+v"(tid_));
    const int tid = tid_, wid = __builtin_amdgcn_readfirstlane(tid >> 6), lane = tid & 63, wr = wid >> 2, wc = wid & 3, fr = lane & 15, fq = lane >> 4;
    const int nt = K / BK;
    int sR[2], sC[2]; unsigned voffB[2];
#pragma unroll
    for (int i = 0; i < 2; ++i) { int R, C; stage_rc(tid * 16 + i * 8192, R, C); sR[i] = R; sC[i] = C; const int Rb = Epi::PERM ? ((R & ~31) + perm32(R & 31)) : R; voffB[i] = (unsigned)(Rb * K + C) * 2u; }
    const size_t kstep = (size_t)(BK * 2);
    const size_t hstep = (size_t)HALF * K * 2;
    const unsigned ldsw = (unsigned)wid * 1024u;
    const int aoff = lds_byte(wr * 64 + fr, fq * 8), boff = lds_byte(wc * 32 + fr, fq * 8);
#define PG8_SA(b, h) (((b) * 2 + (h)) * HTB)
#define PG8_SB(b, h) ((4 + (b) * 2 + (h)) * HTB)
#define PG8_STGB(bufoff, gbase) do { _Pragma("unroll") for (int _i = 0; _i < 2; ++_i) \
        __builtin_amdgcn_global_load_lds((const unsigned*)((const char*)(gbase) + voffB[_i]), (LAS unsigned*)(lds + (bufoff) + ldsw + _i * 8192), 16, 0, 0); } while (0)
#define PG8_STGA(bufoff, gbase, VO, h) do { _Pragma("unroll") for (int _i = 0; _i < 2; ++_i) \
        __builtin_amdgcn_global_load_lds((const unsigned*)((const char*)(gbase) + VO[h][_i]), (LAS unsigned*)(lds + (bufoff) + ldsw + _i * 8192), 16, 0, 0); } while (0)
#define PG8_VOA(u, VO) do { _Pragma("unroll") for (int _h = 0; _h < 2; ++_h) _Pragma("unroll") for (int _i = 0; _i < 2; ++_i) \
        VO[_h][_i] = Sched::GATHER ? (S.row_off(u, _h * HALF + sR[_i]) + (unsigned)sC[_i] * 2u) : ((unsigned)((_h * HALF + sR[_i]) * K + sC[_i]) * 2u); } while (0)
#define PG8_LDA(dst, b, h) do { _Pragma("unroll") for (int m = 0; m < 4; ++m) _Pragma("unroll") for (int k = 0; k < 2; ++k) dst[m][k] = *(const LAS bf16x8*)(lds + PG8_SA(b, h) + aoff + m * 2048 + k * 1024); } while (0)
#define PG8_LDB(dst, b, h) do { _Pragma("unroll") for (int n = 0; n < 2; ++n) _Pragma("unroll") for (int k = 0; k < 2; ++k) dst[n][k] = *(const LAS bf16x8*)(lds + PG8_SB(b, h) + boff + n * 2048 + k * 1024); } while (0)
#define PG8_MMA(ai, bj, At, Bt) do { __builtin_amdgcn_s_setprio(1); _Pragma("unroll") for (int m = 0; m < 4; ++m) _Pragma("unroll") for (int n = 0; n < 2; ++n) _Pragma("unroll") for (int k = 0; k < 2; ++k) \
        acc[ai][bj][m][n] = __builtin_amdgcn_mfma_f32_16x16x32_bf16(Bt[n][k], At[m][k], acc[ai][bj][m][n], 0, 0, 0); __builtin_amdgcn_s_setprio(0); } while (0)
#define PG8_WAIT_V(n) asm volatile("s_waitcnt vmcnt(" #n ")" ::: "memory")
#define PG8_WAIT_L(n) asm volatile("s_waitcnt lgkmcnt(" #n ")" ::: "memory")
#define PG8_BAR __builtin_amdgcn_s_barrier()
#define PG8_SCHED __builtin_amdgcn_sched_barrier(0)
    Unit cur, nxt; int ui = 0;
    if (!S.next(0, cur)) return;
    f32x4 acc[2][2][4][2];
#pragma unroll
    for (int a = 0; a < 2; ++a)
#pragma unroll
        for (int b = 0; b < 2; ++b)
#pragma unroll
            for (int m = 0; m < 4; ++m)
#pragma unroll
                for (int n = 0; n < 2; ++n) acc[a][b][m][n] = (f32x4){0.f, 0.f, 0.f, 0.f};
    bf16x8 At[4][2], B0[2][2], B1[2][2];
    unsigned voA[2][2], nvoA[2][2];
    PG8_VOA(cur, voA);
    if (Sched::GATHER) { asm volatile("s_waitcnt vmcnt(0)" ::: "memory"); }
    const char* cA = S.a_ptr(cur); const char* cB = S.b_ptr(cur);
    cur.par = 0; E.stage_rows(cur, lds, wid);
    PG8_STGB(PG8_SB(0, 0), cB); PG8_STGB(PG8_SB(0, 1), cB + hstep); PG8_STGA(PG8_SA(0, 0), cA, voA, 0); PG8_STGA(PG8_SA(0, 1), cA, voA, 1);
    if (wr == 1) PG8_BAR;
    PG8_WAIT_V(2); PG8_BAR;
    PG8_STGB(PG8_SB(1, 0), cB + kstep); PG8_STGA(PG8_SA(1, 0), cA + kstep, voA, 0); PG8_STGB(PG8_SB(1, 1), cB + hstep + kstep);
    PG8_WAIT_V(6); PG8_BAR;
    for (;;) {
        const bool has_next = S.next(ui + 1, nxt); nxt.par = (ui + 1) & 1;
        const char* nA = has_next ? S.a_ptr(nxt) : cA; const char* nB = has_next ? S.b_ptr(nxt) : cB;
        if (Sched::GATHER) { if (has_next) { PG8_VOA(nxt, nvoA); } else {
#pragma unroll
            for (int h = 0; h < 2; ++h)
#pragma unroll
                for (int i = 0; i < 2; ++i) nvoA[h][i] = voA[h][i]; } }
#pragma unroll 1
        for (int t = 0; t < nt; t += 2) {
            const bool last = (t == nt - 2);
            const char* a1 = cA + (size_t)(t + 1) * kstep;
            const char* a2 = last ? nA : cA + (size_t)(t + 2) * kstep; const char* b2 = last ? nB : cB + (size_t)(t + 2) * kstep;
            const char* a3 = a2 + kstep; const char* b3 = b2 + kstep;
            unsigned vo2[2][2];
#pragma unroll
            for (int h = 0; h < 2; ++h)
#pragma unroll
                for (int i = 0; i < 2; ++i) vo2[h][i] = (Sched::GATHER && last) ? nvoA[h][i] : voA[h][i];
            if (last && has_next) E.stage_rows(nxt, lds, wid);
            PG8_LDB(B0, 0, 0); PG8_LDB(B1, 0, 1); PG8_SCHED; PG8_LDA(At, 0, 0); PG8_STGA(PG8_SA(1, 1), a1, voA, 1);
            PG8_WAIT_V(8); PG8_WAIT_L(0); PG8_BAR; PG8_MMA(0, 0, At, B0); PG8_MMA(0, 1, At, B1); PG8_BAR; PG8_SCHED;
            PG8_LDA(At, 0, 1); PG8_STGB(PG8_SB(0, 0), b2); PG8_STGB(PG8_SB(0, 1), b2 + hstep); PG8_STGA(PG8_SA(0, 0), a2, vo2, 0);
            PG8_WAIT_V(8); PG8_WAIT_L(0); PG8_BAR; PG8_MMA(1, 0, At, B0); PG8_MMA(1, 1, At, B1); PG8_BAR; PG8_SCHED;
            PG8_LDB(B0, 1, 0); PG8_LDB(B1, 1, 1); PG8_SCHED; PG8_LDA(At, 1, 0); PG8_STGA(PG8_SA(0, 1), a2, vo2, 1);
            PG8_WAIT_V(8); PG8_WAIT_L(0); PG8_BAR; PG8_MMA(0, 0, At, B0); PG8_MMA(0, 1, At, B1); PG8_BAR; PG8_SCHED;
            PG8_LDA(At, 1, 1); PG8_STGB(PG8_SB(1, 0), b3); PG8_STGB(PG8_SB(1, 1), b3 + hstep); PG8_STGA(PG8_SA(1, 0), a3, vo2, 0);
            PG8_WAIT_V(8); PG8_WAIT_L(0); PG8_BAR; PG8_MMA(1, 0, At, B0); PG8_MMA(1, 1, At, B1); PG8_BAR; PG8_SCHED;
        }
        if constexpr (ALIGN_EPI) { if (wr == 0) PG8_BAR; }
        E(acc, cur, wr, wc, fr, fq);
        if (!has_next) break;
#pragma unroll
        for (int a = 0; a < 2; ++a)
#pragma unroll
            for (int b = 0; b < 2; ++b)
#pragma unroll
                for (int m = 0; m < 4; ++m)
#pragma unroll
                    for (int n = 0; n < 2; ++n) acc[a][b][m][n] = (f32x4){0.f, 0.f, 0.f, 0.f};
        cur = nxt; cA = nA; cB = nB; ++ui;
        if (Sched::GATHER) {
#pragma unroll
            for (int h = 0; h < 2; ++h)
#pragma unroll
                for (int i = 0; i < 2; ++i) voA[h][i] = nvoA[h][i]; }
        if constexpr (ALIGN_EPI) { if (wr == 1) PG8_BAR; }
    }
    PG8_WAIT_V(0);
    if constexpr (!ALIGN_EPI) { if (wr == 0) PG8_BAR; }
    PG8_BAR;
#undef PG8_SA
#undef PG8_SB
#undef PG8_STGA
#undef PG8_STGB
#undef PG8_VOA
#undef PG8_LDA
#undef PG8_LDB
#undef PG8_MMA
#undef PG8_WAIT_V
#undef PG8_WAIT_L
#undef PG8_BAR
#undef PG8_SCHED
}

typedef f32x4 Acc[2][2][4][2];
struct EpiInProj {
    static constexpr bool PERM = true;
    __device__ __forceinline__ void stage_rows(const Unit&, LAS unsigned char*, int) const {}
    bf16_t *prw, *puv, *pg;
    template <int ACT> __device__ __forceinline__ void tile(const Acc& acc, bf16_t* base, int ld, int row0, int col0) const {
#pragma unroll
        for (int ai = 0; ai < 2; ++ai)
#pragma unroll
            for (int m = 0; m < 4; ++m) { bf16_t* rowp = base + (size_t)(row0 + ai * HALF + m * 16) * ld + col0;
#pragma unroll
                for (int bj = 0; bj < 2; ++bj) { f32x4 v0 = acc[ai][bj][m][0], v1 = acc[ai][bj][m][1];
                    if (ACT == 1) {
#pragma unroll
                        for (int j = 0; j < 4; ++j) { v0[j] = gelu_tanh(v0[j]); v1[j] = gelu_tanh(v1[j]); } }
                    if (ACT == 2) {
#pragma unroll
                        for (int j = 0; j < 4; ++j) { v0[j] = sigmoidf_(v0[j]); v1[j] = sigmoidf_(v1[j]); } }
                    u32x4 w; w.x = pk2(v0[0], v0[1]); w.y = pk2(v0[2], v0[3]); w.z = pk2(v1[0], v1[1]); w.w = pk2(v1[2], v1[3]);
                    *(u32x4*)(rowp + bj * HALF) = w; }
                __builtin_amdgcn_sched_barrier(0); }
    }
    __device__ __forceinline__ void operator()(const Acc& acc, const Unit& u, int wr, int wc, int fr, int fq) const {
        const int row0 = u.row0 + wr * 64 + fr, cw = wc * 32 + 8 * fq;
        if (u.pn < 7) tile<0>(acc, prw, RWKV_COLS, row0, u.pn * 256 + cw);
        else if (u.pn < 11) tile<1>(acc, puv, 1024, row0, (u.pn - 7) * 256 + cw);
        else tile<2>(acc, pg, 2048, row0, (u.pn - 11) * 256 + cw);
    }
};
template <bool SECOND> struct EpiMerge {
    static constexpr bool PERM = true;
    __device__ __forceinline__ void stage_rows(const Unit&, LAS unsigned char*, int) const {}
    bf16_t* m1; const bf16_t* pg;
    __device__ __forceinline__ void operator()(const Acc& acc, const Unit& u, int wr, int wc, int fr, int fq) const {
        const int row0 = u.row0 + wr * 64 + fr, col0 = u.pn * 256 + wc * 32 + 8 * fq;
#pragma unroll
        for (int ai = 0; ai < 2; ++ai)
#pragma unroll
            for (int m = 0; m < 4; ++m) { const size_t r = (size_t)(row0 + ai * HALF + m * 16);
#pragma unroll
                for (int bj = 0; bj < 2; ++bj) { const int c = col0 + bj * HALF;
                    const u32x4 g = *(const u32x4*)(pg + r * 2048 + (SECOND ? 1024 : 0) + c);
                    f32x4 v0 = acc[ai][bj][m][0], v1 = acc[ai][bj][m][1];
                    v0[0] *= bflo(g.x); v0[1] *= bfhi(g.x); v0[2] *= bflo(g.y); v0[3] *= bfhi(g.y); v1[0] *= bflo(g.z); v1[1] *= bfhi(g.z); v1[2] *= bflo(g.w); v1[3] *= bfhi(g.w);
                    if (SECOND) { const u32x4 p = *(const u32x4*)(m1 + r * 1024 + c);
                        v0[0] += bflo(p.x); v0[1] += bfhi(p.x); v0[2] += bflo(p.y); v0[3] += bfhi(p.y); v1[0] += bflo(p.z); v1[1] += bfhi(p.z); v1[2] += bflo(p.w); v1[3] += bfhi(p.w); }
                    u32x4 w; w.x = pk2(v0[0], v0[1]); w.y = pk2(v0[2], v0[3]); w.z = pk2(v1[0], v1[1]); w.w = pk2(v1[2], v1[3]);
                    *(u32x4*)(m1 + r * 1024 + c) = w; } }
    }
};
struct EpiResid {
    static constexpr bool PERM = false;
    __device__ __forceinline__ void stage_rows(const Unit&, LAS unsigned char*, int) const {}
    float* out; const float* base; const float* gate;
    __device__ __forceinline__ void operator()(const Acc& acc, const Unit& u, int wr, int wc, int fr, int fq) const {
        const int row0 = u.row0 + wr * 64 + fr, col0 = u.pn * 256 + wc * 32 + 4 * fq;
        const float* gp = gate + (size_t)(u.row0 >> 13) * 6144 + col0;
        f32x4 gv[2][2];
#pragma unroll
        for (int bj = 0; bj < 2; ++bj)
#pragma unroll
            for (int n = 0; n < 2; ++n) gv[bj][n] = *(const f32x4*)(gp + bj * HALF + n * 16);
#pragma unroll
        for (int ai = 0; ai < 2; ++ai)
#pragma unroll
            for (int m = 0; m < 4; ++m) { const size_t ro = (size_t)(row0 + ai * HALF + m * 16) * 1024 + col0;
#pragma unroll
                for (int bj = 0; bj < 2; ++bj)
#pragma unroll
                    for (int n = 0; n < 2; ++n) { const f32x4 b = *(const f32x4*)(base + ro + bj * HALF + n * 16);
                        *(f32x4*)(out + ro + bj * HALF + n * 16) = b + gv[bj][n] * acc[ai][bj][m][n]; } }
    }
};
struct EpiRouter {
    static constexpr bool PERM = false;
    __device__ __forceinline__ void stage_rows(const Unit&, LAS unsigned char*, int) const {}
    float* sc;
    __device__ __forceinline__ void operator()(const Acc& acc, const Unit& u, int wr, int wc, int fr, int fq) const {
        const int row0 = u.row0 + wr * 64 + fr, col0 = wc * 32 + 4 * fq;
#pragma unroll
        for (int ai = 0; ai < 2; ++ai)
#pragma unroll
            for (int m = 0; m < 4; ++m) { float* rowp = sc + (size_t)(row0 + ai * HALF + m * 16) * 256 + col0;
#pragma unroll
                for (int bj = 0; bj < 2; ++bj)
#pragma unroll
                    for (int n = 0; n < 2; ++n) { f32x4 v = acc[ai][bj][m][n];
#pragma unroll
                        for (int j = 0; j < 4; ++j) v[j] = sigmoidf_(v[j]);
                        *(f32x4*)(rowp + bj * HALF + n * 16) = v; }
                __builtin_amdgcn_sched_barrier(0); }
    }
};
struct EpiGateUp {
    static constexpr bool PERM = true;
    __device__ __forceinline__ void stage_rows(const Unit&, LAS unsigned char*, int) const {}
    bf16_t* hid;
    __device__ __forceinline__ void operator()(const Acc& acc, const Unit& u, int wr, int wc, int fr, int fq) const {
        const int row0 = u.row0 + wr * 64 + fr, col0 = u.pn * HALF + wc * 32 + 8 * fq;
#pragma unroll
        for (int ai = 0; ai < 2; ++ai)
#pragma unroll
            for (int m = 0; m < 4; ++m) { bf16_t* rowp = hid + (size_t)(row0 + ai * HALF + m * 16) * EFF + col0;
                f32x4 v0, v1;
#pragma unroll
                for (int j = 0; j < 4; ++j) { v0[j] = siluf_(acc[ai][0][m][0][j]) * acc[ai][1][m][0][j]; v1[j] = siluf_(acc[ai][0][m][1][j]) * acc[ai][1][m][1][j]; }
                u32x4 w; w.x = pk2(v0[0], v0[1]); w.y = pk2(v0[2], v0[3]); w.z = pk2(v1[0], v1[1]); w.w = pk2(v1[2], v1[3]);
                *(u32x4*)rowp = w; __builtin_amdgcn_sched_barrier(0); }
    }
};
struct EpiExpertDown {
    static constexpr bool PERM = true;
    bf16_t* slot; const int* rowdst; const float* roww;
    __device__ __forceinline__ void stage_rows(const Unit& u, LAS unsigned char* lds, int wid) const {
        if (wid < 4) { const int lane = threadIdx.x & 63; LAS unsigned char* base = lds + LDS_MISC + u.par * 2048 + wid * 256;
            __builtin_amdgcn_global_load_lds((const unsigned*)(rowdst + u.row0 + wid * 64 + lane), (LAS unsigned*)base, 4, 0, 0);
            __builtin_amdgcn_global_load_lds((const unsigned*)(roww + u.row0 + wid * 64 + lane), (LAS unsigned*)(base + 1024), 4, 0, 0); }
    }
    __device__ __forceinline__ void operator()(const Acc& acc, const Unit& u, int wr, int wc, int fr, int fq) const {
        const unsigned cb = (unsigned)(u.pn * 256 + wc * 32 + 8 * fq) * 2u;
        const LAS int* td = (const LAS int*)((LAS unsigned char*)nullptr + LDS_MISC + u.par * 2048) + wr * 64 + fr; const LAS float* tw = (const LAS float*)(td + 256);
#pragma unroll
        for (int ai = 0; ai < 2; ++ai)
#pragma unroll
            for (int m = 0; m < 4; ++m) {
                const int dst = td[ai * HALF + m * 16]; const float ws_ = tw[ai * HALF + m * 16];
                if (dst >= 0) { unsigned char* rowp = (unsigned char*)slot + (size_t)((unsigned)dst * 2048u + cb);
#pragma unroll
                    for (int bj = 0; bj < 2; ++bj) { const f32x4 v0 = acc[ai][bj][m][0] * ws_, v1 = acc[ai][bj][m][1] * ws_;
                        u32x4 w; w.x = pk2(v0[0], v0[1]); w.y = pk2(v0[2], v0[3]); w.z = pk2(v1[0], v1[1]); w.w = pk2(v1[2], v1[3]);
                        *(u32x4*)(rowp + bj * HALF * 2) = w; } }
                __builtin_amdgcn_sched_barrier(0);
            }
    }
};
}
__device__ __forceinline__ void phase_mod(const float* c, const float* ada_w, const float* ada_b, float* mod, LAS unsigned char* lds, int tid, int G) {
    LAS float* sl = (LAS float*)lds; LAS float* red = (LAS float*)(lds + 32768);
    for (int i = tid; i < NB * D; i += NTHREADS) { const float v = c[i]; sl[i] = siluf_(v); }
    __syncthreads();
    const int cl = tid % 24, kg = tid / 24;
    for (int cb = blockIdx.x; cb < 256; cb += G) {
        const int col0 = cb * 24;
        if (tid < 384) {
            float a[NB];
#pragma unroll
            for (int b = 0; b < NB; ++b) a[b] = 0.f;
            for (int k = kg; k < D; k += 16) { const float w = ada_w[(size_t)k * 6144 + col0 + cl];
#pragma unroll
                for (int b = 0; b < NB; ++b) a[b] += sl[b * D + k] * w; }
#pragma unroll
            for (int b = 0; b < NB; ++b) red[(kg * 24 + cl) * NB + b] = a[b];
        }
        __syncthreads();
        if (tid < 192) { const int c2 = tid >> 3, b = tid & 7; float s = 0.f;
#pragma unroll
            for (int g = 0; g < 16; ++g) s += red[(g * 24 + c2) * NB + b];
            mod[(size_t)b * 6144 + col0 + c2] = s + ada_b[col0 + c2]; }
        __syncthreads();
    }
}
__device__ __forceinline__ void transpose_item(const float* W, int ldw, int k0, int n0, bf16_t* WT, int ldt, int drow0, LAS float* scr, int lane) {
#pragma unroll 8
    for (int i = 0; i < 32; ++i) { const int kk = 2 * i + (lane >> 5); scr[kk * 33 + (lane & 31)] = W[(size_t)(k0 + kk) * ldw + n0 + (lane & 31)]; }
    LDS_WAIT(); asm volatile("" ::: "memory");
    const int c = lane & 7;
#pragma unroll
    for (int j = 0; j < 4; ++j) { const int n = (lane >> 3) + 8 * j; const LAS float* s = scr + (8 * c) * 33 + n;
        u32x4 o; o.x = pk2(s[0 * 33], s[1 * 33]); o.y = pk2(s[2 * 33], s[3 * 33]); o.z = pk2(s[4 * 33], s[5 * 33]); o.w = pk2(s[6 * 33], s[7 * 33]);
        *(u32x4*)(WT + (size_t)(drow0 + n) * ldt + k0 + 8 * c) = o; }
    LDS_WAIT(); asm volatile("" ::: "memory");
}
__device__ __forceinline__ void transpose_job(const float* W, int K, int N, bf16_t* WT, int gated, int goff, int item, LAS float* scr, int lane) {
    const int nblk = N / 32, kb = item / nblk, nb = item % nblk, n0 = 32 * nb;
    const int drow0 = gated ? (256 * (n0 >> 7) + goff + (n0 & 127)) : n0;
    transpose_item(W, N, 64 * kb, n0, WT, K, drow0, scr, lane);
}
struct SmallW { const float *w_in, *w_out_a, *w_out_b, *w_out, *router_w, *sw1, *sw3, *sw2, *w_up, *a_up, *g_up, *gws; };
__device__ __forceinline__ void phase_small_weights(const SmallW& P, unsigned char* ws, LAS unsigned char* lds, int gw, int NGW, int wave, int lane) {
    LAS float* scr = (LAS float*)(lds + 49152 + wave * 8704);
    constexpr int I0 = 16 * 152, I1 = 8 * 32, I2 = 8 * 32, I3 = 16 * 32, I4 = 16 * 8, I5 = 16 * 8, I6 = 16 * 8, I7 = 4 * 32, I8 = 16, I9 = 16, I10 = 2 * 16;
    constexpr int NIT = I0 + I1 + I2 + I3 + I4 + I5 + I6 + I7 + I8 + I9 + I10;
    for (int it = gw; it < NIT; it += NGW) {
        int r = it;
        if (r < I0) { transpose_job(P.w_in, D, IN_COLS, (bf16_t*)(ws + SW_WIN), 0, 0, r, scr, lane); continue; } r -= I0;
        if (r < I1) { transpose_job(P.w_out_a, RW, D, (bf16_t*)(ws + SW_WOA), 0, 0, r, scr, lane); continue; } r -= I1;
        if (r < I2) { transpose_job(P.w_out_b, RW, D, (bf16_t*)(ws + SW_WOB), 0, 0, r, scr, lane); continue; } r -= I2;
        if (r < I3) { transpose_job(P.w_out, D, D, (bf16_t*)(ws + SW_WO), 0, 0, r, scr, lane); continue; } r -= I3;
        if (r < I4) { transpose_job(P.router_w, D, NE, (bf16_t*)(ws + SW_WR), 0, 0, r, scr, lane); continue; } r -= I4;
        if (r < I5) { transpose_job(P.sw1, D, EFF, (bf16_t*)(ws + SW_WS13), 1, 0, r, scr, lane); continue; } r -= I5;
        if (r < I6) { transpose_job(P.sw3, D, EFF, (bf16_t*)(ws + SW_WS13), 1, 128, r, scr, lane); continue; } r -= I6;
        if (r < I7) { transpose_job(P.sw2, EFF, D, (bf16_t*)(ws + SW_WS2), 0, 0, r, scr, lane); continue; } r -= I7;
        if (r < I8) { transpose_job(P.w_up, 64, RW, (bf16_t*)(ws + SW_WUP), 0, 0, r, scr, lane); continue; } r -= I8;
        if (r < I9) { transpose_job(P.a_up, 64, RW, (bf16_t*)(ws + SW_AUP), 0, 0, r, scr, lane); continue; } r -= I9;
        transpose_job(P.g_up, 128, RW, (bf16_t*)(ws + SW_GUP), 0, 0, r, scr, lane);
    }
    bf16_t* wsm = (bf16_t*)(ws + SW_WSM);
    for (int i = gw * 64 + lane; i < 8 * 128 * 128; i += NGW * 64) { const int col = i & 127, row = (i >> 7) & 127; wsm[i] = (col <= row) ? f2bf(P.gws[i]) : (bf16_t)0; }
}
__device__ __forceinline__ void transpose_item64(const float* W, int ldw, int k0, int n0, bf16_t* WT, int ldt, int drow0, LAS float* scr, int lane) {
    f32x4 v[16];
    const int c4 = lane & 15, r4 = lane >> 4;
#pragma unroll
    for (int i = 0; i < 16; ++i) v[i] = *(const f32x4*)(W + (size_t)(k0 + 4 * i + r4) * ldw + n0 + 4 * c4);
#pragma unroll
    for (int i = 0; i < 16; ++i) { LAS float* d = scr + (4 * i + r4) * 65 + 4 * c4; d[0] = v[i].x; d[1] = v[i].y; d[2] = v[i].z; d[3] = v[i].w; }
    LDS_WAIT(); asm volatile("" ::: "memory");
    const int c = lane & 7;
#pragma unroll
    for (int j = 0; j < 8; ++j) { const int n = (lane >> 3) + 8 * j; const LAS float* s = scr + (8 * c) * 65 + n;
        u32x4 o; o.x = pk2(s[0 * 65], s[1 * 65]); o.y = pk2(s[2 * 65], s[3 * 65]); o.z = pk2(s[4 * 65], s[5 * 65]); o.w = pk2(s[6 * 65], s[7 * 65]);
        *(u32x4*)(WT + (size_t)(drow0 + n) * ldt + k0 + 8 * c) = o; }
    LDS_WAIT(); asm volatile("" ::: "memory");
}
__device__ __forceinline__ void phase_expert_weights(const float* w1, const float* w3, const float* w2, unsigned char* ws, LAS unsigned char* lds, int gw, int NGW, int wave, int lane) {
    LAS float* scr = (LAS float*)(lds + wave * 16640);
    constexpr int PER = 64;
    for (int it = gw; it < NE * 3 * PER; it += NGW) {
        const int e = it / (3 * PER), r = it % (3 * PER), which = r / PER, item = r % PER;
        if (which < 2) { const int kb = item >> 2, nb = item & 3, n0 = 64 * nb;
            transpose_item64((which ? w3 : w1) + (size_t)e * D * EFF, EFF, 64 * kb, n0, (bf16_t*)(ws + B_W13) + (size_t)e * 512 * D, D, 256 * (n0 >> 7) + which * 128 + (n0 & 127), scr, lane); }
        else { const int kb = item >> 4, nb = item & 15;
            transpose_item64(w2 + (size_t)e * EFF * D, D, 64 * kb, 64 * nb, (bf16_t*)(ws + B_W2) + (size_t)e * D * EFF, EFF, 64 * nb, scr, lane); }
    }
}
__device__ __forceinline__ void phase_norm_mod(const float* X, const float* gain, const float* mod, int sh_off, int sc_off, bf16_t* out, int gw, int NGW, int lane) {
    constexpr int R = 4;
    for (int m0 = gw; m0 < T; m0 += R * NGW) {
        f32x4 v[R][4];
#pragma unroll
        for (int rr = 0; rr < R; ++rr) { const int m = m0 + rr * NGW; const f32x4* xr = (const f32x4*)(X + (size_t)(m < T ? m : m0) * D) + lane;
#pragma unroll
            for (int j = 0; j < 4; ++j) v[rr][j] = xr[64 * j]; }
#pragma unroll
        for (int rr = 0; rr < R; ++rr) { const int m = m0 + rr * NGW; if (m >= T) break;
            float ss = 0.f;
#pragma unroll
            for (int j = 0; j < 4; ++j) ss += (v[rr][j].x * v[rr][j].x + v[rr][j].y * v[rr][j].y) + (v[rr][j].z * v[rr][j].z + v[rr][j].w * v[rr][j].w);
            const float rstd = __builtin_amdgcn_rsqf(wave_sum(ss) * (1.f / D) + 1e-6f);
            const float* mb = mod + (size_t)(m >> 13) * 6144;
            u32x2* o8 = (u32x2*)(out + (size_t)m * D) + lane;
#pragma unroll
            for (int j = 0; j < 4; ++j) { const int col = 4 * lane + 256 * j;
                const f32x4 g = *(const f32x4*)(gain + col), sc = *(const f32x4*)(mb + sc_off + col), sh = *(const f32x4*)(mb + sh_off + col);
                const f32x4 y = v[rr][j] * rstd * g * (sc + 1.0f) + sh;
                u32x2 w; w.x = pk2(y.x, y.y); w.y = pk2(y.z, y.w); o8[64 * j] = w; } }
    }
}
struct YaArgs { bf16_t* ya; const bf16_t* g; const bf16_t* prw; const float* sbon; const float* mu; const float* ln_g; const float* ln_b; };
__device__ __forceinline__ void phase_ya_final(const YaArgs& P, int gw, int NGW, int lane) {
    const int ch0 = lane * 8, head = lane >> 3;
    float muv[8], lg[8], lb[8];
#pragma unroll
    for (int j = 0; j < 8; ++j) { muv[j] = P.mu[1024 + ch0 + j]; lg[j] = P.ln_g[ch0 + j]; lb[j] = P.ln_b[ch0 + j]; }
    for (int m = gw; m < T; m += NGW) {
        const u32x4 yw = *(const u32x4*)(P.ya + (size_t)m * RW + ch0);
        const u32x4 gw4 = *(const u32x4*)(P.g + (size_t)m * RW + ch0);
        const u32x4 vc = *(const u32x4*)(P.prw + (size_t)m * RWKV_COLS + 1024 + ch0);
        u32x4 vp = (u32x4){0u, 0u, 0u, 0u};
        if ((m & (SEQ - 1)) != 0) vp = *(const u32x4*)(P.prw + (size_t)(m - 1) * RWKV_COLS + 1024 + ch0);
        const float sb = P.sbon[(size_t)m * NH + head];
        float y[8], gg[8], vv[8], pv[8];
        y[0] = bflo(yw.x); y[1] = bfhi(yw.x); y[2] = bflo(yw.y); y[3] = bfhi(yw.y); y[4] = bflo(yw.z); y[5] = bfhi(yw.z); y[6] = bflo(yw.w); y[7] = bfhi(yw.w);
        gg[0] = bflo(gw4.x); gg[1] = bfhi(gw4.x); gg[2] = bflo(gw4.y); gg[3] = bfhi(gw4.y); gg[4] = bflo(gw4.z); gg[5] = bfhi(gw4.z); gg[6] = bflo(gw4.w); gg[7] = bfhi(gw4.w);
        vv[0] = bflo(vc.x); vv[1] = bfhi(vc.x); vv[2] = bflo(vc.y); vv[3] = bfhi(vc.y); vv[4] = bflo(vc.z); vv[5] = bfhi(vc.z); vv[6] = bflo(vc.w); vv[7] = bfhi(vc.w);
        pv[0] = bflo(vp.x); pv[1] = bfhi(vp.x); pv[2] = bflo(vp.y); pv[3] = bfhi(vp.y); pv[4] = bflo(vp.z); pv[5] = bfhi(vp.z); pv[6] = bflo(vp.w); pv[7] = bfhi(vp.w);
        float s = 0.f;
#pragma unroll
        for (int j = 0; j < 8; ++j) s += y[j];
        s += __shfl_xor(s, 1); s += __shfl_xor(s, 2); s += __shfl_xor(s, 4);
        const float mean = s * (1.f / 64.f); float q = 0.f;
#pragma unroll
        for (int j = 0; j < 8; ++j) { y[j] -= mean; q += y[j] * y[j]; }
        q += __shfl_xor(q, 1); q += __shfl_xor(q, 2); q += __shfl_xor(q, 4);
        const float rstd = __builtin_amdgcn_rsqf(q * (1.f / 64.f) + 64e-5f);
        float o[8];
#pragma unroll
        for (int j = 0; j < 8; ++j) { const float vs = vv[j] + (pv[j] - vv[j]) * muv[j]; o[j] = (y[j] * rstd * lg[j] + lb[j] + sb * vs) * gg[j]; }
        u32x4 w; w.x = pk2(o[0], o[1]); w.y = pk2(o[2], o[3]); w.z = pk2(o[4], o[5]); w.w = pk2(o[6], o[7]);
        *(u32x4*)(P.ya + (size_t)m * RW + ch0) = w;
    }
}
__device__ __forceinline__ void phase_combine(float* out, const bf16_t* slot, const float* mod, const float* normf, int half, int gw, int NGW, int lane) {
    for (int tl = gw; tl < HALF_T; tl += NGW) {
        const int m = half * HALF_T + tl, b = m >> 13;
        f32x4* xr = (f32x4*)(out + (size_t)m * D) + lane;
        const float* g2 = mod + (size_t)b * 6144 + 5120;
        f32x4 a[4];
#pragma unroll
        for (int j = 0; j < 4; ++j) a[j] = (f32x4){0.f, 0.f, 0.f, 0.f};
#pragma unroll
        for (int k = 0; k < TOPK; ++k) { const u32x2* sr = (const u32x2*)(slot + ((size_t)tl * TOPK + k) * D) + lane;
#pragma unroll
            for (int j = 0; j < 4; ++j) { const u32x2 w = sr[64 * j]; a[j].x += bflo(w.x); a[j].y += bfhi(w.x); a[j].z += bflo(w.y); a[j].w += bfhi(w.y); } }
        f32x4 v[4]; float ss = 0.f;
#pragma unroll
        for (int j = 0; j < 4; ++j) { const int col = 4 * lane + 256 * j; v[j] = xr[64 * j] + *(const f32x4*)(g2 + col) * a[j]; ss += (v[j].x * v[j].x + v[j].y * v[j].y) + (v[j].z * v[j].z + v[j].w * v[j].w); }
        const float rstd = __builtin_amdgcn_rsqf(wave_sum(ss) * (1.f / D) + 1e-6f);
#pragma unroll
        for (int j = 0; j < 4; ++j) { const int col = 4 * lane + 256 * j; xr[64 * j] = v[j] * rstd * *(const f32x4*)(normf + col); }
    }
}
namespace rk {
constexpr int LD = 72;
constexpr int SLOTB = 64 * LD * 2;
constexpr int LDG = 136;
typedef LAS bf16_t* lp;
__device__ __forceinline__ lp slot(LAS unsigned char* lds, int i) { return (lp)(lds + i * SLOTB); }
template <int KS>
__device__ __forceinline__ void mm_nt(const LAS bf16_t* X, int ldx, const LAS bf16_t* Y, int ldy, int m, int nt0, int r, int q, f32x4 (&acc)[2]) {
#pragma unroll
    for (int s = 0; s < KS; ++s) {
        const bf16x8 a = *(const LAS bf16x8*)(X + (16 * m + r) * ldx + 32 * s + 8 * q);
#pragma unroll
        for (int n = 0; n < 2; ++n) { const bf16x8 b = *(const LAS bf16x8*)(Y + (16 * (nt0 + n) + r) * ldy + 32 * s + 8 * q); acc[n] = __builtin_amdgcn_mfma_f32_16x16x32_bf16(a, b, acc[n], 0, 0, 0); }
    }
}
__device__ __forceinline__ void st_rm(lp dst, int m, int nt, int r, int q, const f32x4& a) {
#pragma unroll
    for (int ii = 0; ii < 4; ++ii) dst[(16 * m + 4 * q + ii) * LD + 16 * nt + r] = f2bf(a[ii]);
}
__device__ __forceinline__ void st_tr(lp dst, int m, int nt, int r, int q, const f32x4& a) {
    u32x2 w; w.x = pk2(a[0], a[1]); w.y = pk2(a[2], a[3]); *(LAS u32x2*)(dst + (16 * nt + r) * LD + 16 * m + 4 * q) = w;
}
__device__ __forceinline__ void ld_rm(const LAS bf16_t* src, int m, int nt, int r, int q, f32x4& a) {
#pragma unroll
    for (int ii = 0; ii < 4; ++ii) a[ii] = bf2f(src[(16 * m + 4 * q + ii) * LD + 16 * nt + r]);
}
struct Args {
    const bf16_t* prw; const float* mu; const float *w0, *a0, *k_k, *k_a, *r_k;
    const bf16_t *wup, *aup, *gup;
    bf16_t* g; float* sbon; unsigned char* mtq; unsigned char* nty; unsigned* dbg;
};
constexpr int LDS_MU = 155904;
struct Pre { u32x4 cw[7], pw[7]; };
__device__ __forceinline__ void task_map(int task, int h, int& i, int& ch, int& col) {
    i = task / 56; ch = task % 56;
    if (ch < 8) col = h * 64 + 8 * ch; else if (ch < 16) col = 512 + h * 64 + 8 * (ch - 8); else if (ch < 24) col = 1024 + h * 64 + 8 * (ch - 16);
    else if (ch < 32) col = 1536 + 8 * (ch - 24); else if (ch < 40) col = 1600 + 8 * (ch - 32); else col = 1664 + 8 * (ch - 40);
}
__device__ __forceinline__ void load_mu(const Args& P, LAS unsigned char* lds, int tid) {
    LAS float* MU = (LAS float*)(lds + LDS_MU);
    for (int i = tid; i < RWKV_COLS; i += NTHREADS) MU[i] = P.mu[i];
    __syncthreads();
}
__device__ __forceinline__ void prefetch(const Args& P, int b, int h, int c, int tid, Pre& pre) {
    const int t0 = b * SEQ + c * 64;
#pragma unroll
    for (int it = 0; it < 7; ++it) {
        int i, ch, col; task_map(tid + it * NTHREADS, h, i, ch, col);
        const bf16_t* src = P.prw + (size_t)(t0 + i) * RWKV_COLS + col;
        pre.cw[it] = *(const u32x4*)src;
        pre.pw[it] = (u32x4){0u, 0u, 0u, 0u};
        if (i != 0 || c != 0) pre.pw[it] = *(const u32x4*)(src - RWKV_COLS);
    }
}
__device__ __forceinline__ void unit(const Args& P, LAS unsigned char* lds, int b, int h, int c, int uidx, int tid, Pre& pf, bool has_next, int nb, int nh_, int nc) {
    const int wave = __builtin_amdgcn_readfirstlane(tid >> 6), lane = tid & 63, r = lane & 15, q = lane >> 4, m = wave & 3, nh = wave >> 2;
    const int t0 = b * SEQ + c * 64;
    lp S0 = slot(lds, 0), S1 = slot(lds, 1), S2 = slot(lds, 2), S3 = slot(lds, 3), S4 = slot(lds, 4), S5 = slot(lds, 5), S6 = slot(lds, 6), S7 = slot(lds, 7);
    lp S8 = slot(lds, 8), S9 = slot(lds, 9), S10 = slot(lds, 10), S11 = slot(lds, 11), S12 = slot(lds, 12), S13 = slot(lds, 13), S14 = slot(lds, 14), S15 = slot(lds, 15);
    LAS float* PART = (LAS float*)(lds + LDS_MISC);
    LAS float* CT = PART + 256;
    LAS float* DEND = CT + 256;
    const LAS float* MU = (const LAS float*)(lds + LDS_MU);
#define RK_DBG(bit, sp) do {} while (0)
#pragma unroll
    for (int it = 0; it < 7; ++it) {
        int i, ch, col; task_map(tid + it * NTHREADS, h, i, ch, col);
        LAS bf16_t* dst; int act = 0;
        if (ch < 8) dst = S8 + i * LD + 8 * ch; else if (ch < 16) dst = S9 + i * LD + 8 * (ch - 8); else if (ch < 24) dst = S10 + i * LD + 8 * (ch - 16);
        else if (ch < 32) { dst = S11 + i * LD + 8 * (ch - 24); act = 1; } else if (ch < 40) dst = S12 + i * LD + 8 * (ch - 32); else { dst = S13 + i * LDG + 8 * (ch - 40); act = 2; }
        const u32x4 cw = pf.cw[it], pw = pf.pw[it];
        const f32x4 m0 = *(const LAS f32x4*)(MU + col), m1 = *(const LAS f32x4*)(MU + col + 4);
        float v[8], p[8];
        v[0] = bflo(cw.x); v[1] = bfhi(cw.x); v[2] = bflo(cw.y); v[3] = bfhi(cw.y); v[4] = bflo(cw.z); v[5] = bfhi(cw.z); v[6] = bflo(cw.w); v[7] = bfhi(cw.w);
        p[0] = bflo(pw.x); p[1] = bfhi(pw.x); p[2] = bflo(pw.y); p[3] = bfhi(pw.y); p[4] = bflo(pw.z); p[5] = bfhi(pw.z); p[6] = bflo(pw.w); p[7] = bfhi(pw.w);
#pragma unroll
        for (int j = 0; j < 4; ++j) { v[j] += (p[j] - v[j]) * m0[j]; v[4 + j] += (p[4 + j] - v[4 + j]) * m1[j]; }
        if (act == 1) {
#pragma unroll
            for (int j = 0; j < 8; ++j) v[j] = tanhf_(v[j]); }
        else if (act == 2) {
#pragma unroll
            for (int j = 0; j < 8; ++j) v[j] = sigmoidf_(v[j]); }
        u32x4 w; w.x = pk2(v[0], v[1]); w.y = pk2(v[2], v[3]); w.z = pk2(v[4], v[5]); w.w = pk2(v[6], v[7]);
        *(LAS u32x4*)dst = w;
    }
    if (has_next) prefetch(P, nb, nh_, nc, tid, pf);
    __syncthreads();
    f32x4 aw[2], aa[2], ag[2];
#pragma unroll
    for (int n = 0; n < 2; ++n) { aw[n] = (f32x4){0.f, 0.f, 0.f, 0.f}; aa[n] = aw[n]; ag[n] = aw[n]; }
#pragma unroll
    for (int s = 0; s < 2; ++s) {
        const bf16x8 xw = *(const LAS bf16x8*)(S11 + (16 * m + r) * LD + 32 * s + 8 * q), xa = *(const LAS bf16x8*)(S12 + (16 * m + r) * LD + 32 * s + 8 * q);
#pragma unroll
        for (int n = 0; n < 2; ++n) { const int row = h * 64 + 16 * (2 * nh + n) + r;
            const bf16x8 bw = *(const bf16x8*)(P.wup + (size_t)row * 64 + 32 * s + 8 * q), ba = *(const bf16x8*)(P.aup + (size_t)row * 64 + 32 * s + 8 * q);
            aw[n] = __builtin_amdgcn_mfma_f32_16x16x32_bf16(xw, bw, aw[n], 0, 0, 0); aa[n] = __builtin_amdgcn_mfma_f32_16x16x32_bf16(xa, ba, aa[n], 0, 0, 0); }
    }
#pragma unroll
    for (int s = 0; s < 4; ++s) {
        const bf16x8 xg = *(const LAS bf16x8*)(S13 + (16 * m + r) * LDG + 32 * s + 8 * q);
#pragma unroll
        for (int n = 0; n < 2; ++n) { const int row = h * 64 + 16 * (2 * nh + n) + r;
            const bf16x8 bg = *(const bf16x8*)(P.gup + (size_t)row * 128 + 32 * s + 8 * q);
            ag[n] = __builtin_amdgcn_mfma_f32_16x16x32_bf16(xg, bg, ag[n], 0, 0, 0); }
    }
    float rr[2][4], kq[2][4], vv[2][4], av[2][4], lw[2][4], kp[2][4], pre[2][4], preq[2];
    float ss[4] = {0.f, 0.f, 0.f, 0.f}, bs[4] = {0.f, 0.f, 0.f, 0.f};
#pragma unroll
    for (int n = 0; n < 2; ++n) {
        const int ch = 32 * nh + 16 * n + r, chg = h * 64 + ch;
        const float w0v = P.w0[chg], a0v = P.a0[chg], kkc = P.k_k[chg], kac = P.k_a[chg], rkc = P.r_k[chg];
#pragma unroll
        for (int ii = 0; ii < 4; ++ii) {
            const int pos = 16 * m + 4 * q + ii;
            const float rv = bf2f(S8[pos * LD + ch]), kraw = bf2f(S9[pos * LD + ch]); vv[n][ii] = bf2f(S10[pos * LD + ch]); rr[n][ii] = rv;
            const float z = -(w0v + aw[n][ii]);
            const float sp = fmaxf(z, 0.f) + flog(1.0f + fexp(-fabsf(z)));
            lw[n][ii] = -fexp(-sp - 0.5f);
            const float a_ = sigmoidf_(a0v + aa[n][ii]); av[n][ii] = a_;
            P.g[(size_t)(t0 + pos) * RW + chg] = f2bf(ag[n][ii]);
            const float kk = kraw * kkc; kq[n][ii] = kk;
            const float kpv = kraw * (1.0f + (a_ - 1.0f) * kac); kp[n][ii] = kpv;
            ss[ii] += kk * kk; bs[ii] += rv * kpv * rkc;
        }
        pre[n][0] = lw[n][0]; pre[n][1] = pre[n][0] + lw[n][1]; pre[n][2] = pre[n][1] + lw[n][2]; pre[n][3] = pre[n][2] + lw[n][3];
        const float tot = pre[n][3];
        const float t0_ = __shfl(tot, r), t1_ = __shfl(tot, r + 16), t2_ = __shfl(tot, r + 32), t3_ = __shfl(tot, r + 48);
        preq[n] = (q > 0 ? t0_ : 0.f) + (q > 1 ? t1_ : 0.f) + (q > 2 ? t2_ : 0.f);
        if (q == 0) CT[m * 64 + ch] = (t0_ + t1_) + (t2_ + t3_);
    }
#pragma unroll
    for (int ii = 0; ii < 4; ++ii) {
#pragma unroll
        for (int o = 1; o < 16; o <<= 1) { ss[ii] += __shfl_xor(ss[ii], o); bs[ii] += __shfl_xor(bs[ii], o); }
        if (r == 0) { const int pos = 16 * m + 4 * q + ii; PART[(nh * 64 + pos) * 2] = ss[ii]; PART[(nh * 64 + pos) * 2 + 1] = bs[ii]; }
    }
    __syncthreads();
#pragma unroll
    for (int n = 0; n < 2; ++n) {
        const int ch = 32 * nh + 16 * n + r;
        float carry = 0.f, lend = 0.f;
#pragma unroll
        for (int mm = 0; mm < 4; ++mm) { const float cv = CT[mm * 64 + ch]; lend += cv; carry += (mm < m) ? cv : 0.f; }
        f32x4 tA, tBh, tKh, tV;
#pragma unroll
        for (int ii = 0; ii < 4; ++ii) {
            const int pos = 16 * m + 4 * q + ii;
            const float L = carry + preq[n] + pre[n][ii], Lm1 = L - lw[n][ii];
            const float ssum = PART[pos * 2] + PART[(64 + pos) * 2];
            const float inv = frcp(fmaxf(__builtin_sqrtf(ssum), 1e-12f));
            const float kkn = kq[n][ii] * inv, kb = kkn * av[n][ii];
            const float eN = fexp(-L), eE = fexp(lend - L);
            const float At = -kkn * fexp(Lm1), Rt = rr[n][ii] * fexp(L), Bt = kb * eN, Kt = kp[n][ii] * eN;
            S0[pos * LD + ch] = f2bf(At); S1[pos * LD + ch] = f2bf(Bt); S2[pos * LD + ch] = f2bf(Kt); S3[pos * LD + ch] = f2bf(Rt);
            tA[ii] = At; tBh[ii] = kb * eE; tKh[ii] = kp[n][ii] * eE; tV[ii] = vv[n][ii];
        }
        { u32x2 w; const int off = ch * LD + 16 * m + 4 * q;
          w.x = pk2(tA[0], tA[1]); w.y = pk2(tA[2], tA[3]); *(LAS u32x2*)(S4 + off) = w;
          w.x = pk2(tBh[0], tBh[1]); w.y = pk2(tBh[2], tBh[3]); *(LAS u32x2*)(S5 + off) = w;
          w.x = pk2(tKh[0], tKh[1]); w.y = pk2(tKh[2], tKh[3]); *(LAS u32x2*)(S6 + off) = w;
          w.x = pk2(tV[0], tV[1]); w.y = pk2(tV[2], tV[3]); *(LAS u32x2*)(S7 + off) = w; }
        if (m == 0 && q == 0) DEND[ch] = fexp(lend);
    }
    if (nh == 0 && r == 0) {
#pragma unroll
        for (int ii = 0; ii < 4; ++ii) { const int pos = 16 * m + 4 * q + ii; P.sbon[(size_t)(t0 + pos) * NH + h] = PART[pos * 2 + 1] + PART[(64 + pos) * 2 + 1]; }
    }
    __syncthreads();
    RK_DBG(0, S0); RK_DBG(1, S1); RK_DBG(2, S2); RK_DBG(3, S3); RK_DBG(4, S4); RK_DBG(5, S5); RK_DBG(6, S6); RK_DBG(7, S7);
    const int nt0 = 2 * nh;
    f32x4 acc[2], acc2[2];
#define RK_ZERO(a) do { a[0] = (f32x4){0.f, 0.f, 0.f, 0.f}; a[1] = a[0]; } while (0)
    RK_ZERO(acc); mm_nt<2>(S0, LD, S1, LD, m, nt0, r, q, acc);
#pragma unroll
    for (int n = 0; n < 2; ++n) { f32x4 t;
#pragma unroll
        for (int ii = 0; ii < 4; ++ii) { const int row = 16 * m + 4 * q + ii, col = 16 * (nt0 + n) + r; acc[n][ii] = (col < row) ? acc[n][ii] : 0.f; t[ii] = acc[n][ii] + ((col == row) ? 1.f : 0.f); }
        st_rm(S8, m, nt0 + n, r, q, acc[n]); st_tr(S9, m, nt0 + n, r, q, acc[n]); st_rm(S10, m, nt0 + n, r, q, t); }
    RK_ZERO(acc); mm_nt<2>(S0, LD, S2, LD, m, nt0, r, q, acc);
#pragma unroll
    for (int n = 0; n < 2; ++n) {
#pragma unroll
        for (int ii = 0; ii < 4; ++ii) { const int row = 16 * m + 4 * q + ii, col = 16 * (nt0 + n) + r; acc[n][ii] = (col < row) ? acc[n][ii] : 0.f; }
        st_rm(S11, m, nt0 + n, r, q, acc[n]); }
    RK_ZERO(acc); mm_nt<2>(S3, LD, S1, LD, m, nt0, r, q, acc);
#pragma unroll
    for (int n = 0; n < 2; ++n) {
#pragma unroll
        for (int ii = 0; ii < 4; ++ii) { const int row = 16 * m + 4 * q + ii, col = 16 * (nt0 + n) + r; acc[n][ii] = (col <= row) ? acc[n][ii] : 0.f; }
        st_rm(S12, m, nt0 + n, r, q, acc[n]); }
    RK_ZERO(acc); mm_nt<2>(S3, LD, S2, LD, m, nt0, r, q, acc);
#pragma unroll
    for (int n = 0; n < 2; ++n) {
#pragma unroll
        for (int ii = 0; ii < 4; ++ii) { const int row = 16 * m + 4 * q + ii, col = 16 * (nt0 + n) + r; acc[n][ii] = (col <= row) ? acc[n][ii] : 0.f; }
        st_rm(S13, m, nt0 + n, r, q, acc[n]); }
    __syncthreads();
    RK_DBG(8, S8); RK_DBG(9, S10); RK_DBG(10, S11); RK_DBG(11, S12); RK_DBG(12, S13);
    RK_ZERO(acc); mm_nt<2>(S8, LD, S9, LD, m, nt0, r, q, acc);
    RK_ZERO(acc2); mm_nt<2>(S7, LD, S11, LD, m, nt0, r, q, acc2);
#pragma unroll
    for (int n = 0; n < 2; ++n) { st_rm(S0, m, nt0 + n, r, q, acc[n]); st_tr(S1, m, nt0 + n, r, q, acc[n]); st_rm(S14, m, nt0 + n, r, q, acc2[n]); }
    __syncthreads();
    RK_DBG(13, S14);
#define RK_ROUND(Tsrc, Tdst, Psrc, PTsrc, Pdst, PTdst) do { \
        ld_rm(Tsrc, m, nt0, r, q, acc[0]); ld_rm(Tsrc, m, nt0 + 1, r, q, acc[1]); mm_nt<2>(Tsrc, LD, PTsrc, LD, m, nt0, r, q, acc); \
        RK_ZERO(acc2); mm_nt<2>(Psrc, LD, PTsrc, LD, m, nt0, r, q, acc2); \
        _Pragma("unroll") for (int n = 0; n < 2; ++n) { st_rm(Tdst, m, nt0 + n, r, q, acc[n]); st_rm(Pdst, m, nt0 + n, r, q, acc2[n]); st_tr(PTdst, m, nt0 + n, r, q, acc2[n]); } \
        __syncthreads(); } while (0)
    RK_ROUND(S10, S2, S0, S1, S8, S9);
    RK_ROUND(S2, S10, S8, S9, S0, S1);
    RK_ROUND(S10, S2, S0, S1, S8, S9);
    RK_ROUND(S2, S10, S8, S9, S0, S1);
    ld_rm(S10, m, nt0, r, q, acc[0]); ld_rm(S10, m, nt0 + 1, r, q, acc[1]); mm_nt<2>(S10, LD, S1, LD, m, nt0, r, q, acc);
#pragma unroll
    for (int n = 0; n < 2; ++n) st_rm(S2, m, nt0 + n, r, q, acc[n]);
    __syncthreads();
    RK_DBG(14, S2);
    RK_ZERO(acc); mm_nt<2>(S4, LD, S2, LD, m, nt0, r, q, acc);
    RK_ZERO(acc2); mm_nt<2>(S14, LD, S2, LD, m, nt0, r, q, acc2);
#pragma unroll
    for (int n = 0; n < 2; ++n) { st_rm(S11, m, nt0 + n, r, q, acc[n]); st_rm(S15, m, nt0 + n, r, q, acc2[n]); }
    __syncthreads();
    RK_DBG(15, S11); RK_DBG(16, S15);
    RK_ZERO(acc); mm_nt<2>(S5, LD, S11, LD, m, nt0, r, q, acc);
#pragma unroll
    for (int n = 0; n < 2; ++n) {
#pragma unroll
        for (int ii = 0; ii < 4; ++ii) { const int row = 16 * m + 4 * q + ii, col = 16 * (nt0 + n) + r; acc[n][ii] += (row == col) ? DEND[row] : 0.f; }
        st_rm(S0, m, nt0 + n, r, q, acc[n]); }
    RK_ZERO(acc); mm_nt<2>(S15, LD, S5, LD, m, nt0, r, q, acc); mm_nt<2>(S7, LD, S6, LD, m, nt0, r, q, acc);
#pragma unroll
    for (int n = 0; n < 2; ++n) st_rm(S1, m, nt0 + n, r, q, acc[n]);
    ld_rm(S3, m, nt0, r, q, acc[0]); ld_rm(S3, m, nt0 + 1, r, q, acc[1]); mm_nt<2>(S12, LD, S11, LD, m, nt0, r, q, acc);
#pragma unroll
    for (int n = 0; n < 2; ++n) st_rm(S8, m, nt0 + n, r, q, acc[n]);
    RK_ZERO(acc); mm_nt<2>(S15, LD, S12, LD, m, nt0, r, q, acc); mm_nt<2>(S7, LD, S13, LD, m, nt0, r, q, acc);
#pragma unroll
    for (int n = 0; n < 2; ++n) st_rm(S9, m, nt0 + n, r, q, acc[n]);
    __syncthreads();
    {
        unsigned char* mu_ = P.mtq + (size_t)uidx * 16384; unsigned char* nu_ = P.nty + (size_t)uidx * 16384;
        const int f = tid >> 6, mF = f >> 1, sF = f & 1, row = 16 * mF + r, c0 = 32 * sF + 4 * q;
        { const u32x2 lo = *(const LAS u32x2*)(S0 + row * LD + c0), hi = *(const LAS u32x2*)(S0 + row * LD + c0 + 16); *(u32x4*)(mu_ + tid * 16) = (u32x4){lo.x, lo.y, hi.x, hi.y}; }
        { const u32x2 lo = *(const LAS u32x2*)(S8 + row * LD + c0), hi = *(const LAS u32x2*)(S8 + row * LD + c0 + 16); *(u32x4*)(mu_ + 8192 + tid * 16) = (u32x4){lo.x, lo.y, hi.x, hi.y}; }
#pragma unroll
        for (int gi = 0; gi < 2; ++gi) { const int gidx = tid + gi * 512, vq = gidx >> 8, mG = (gidx >> 6) & 3, rowv = 16 * vq + r, colv = 16 * mG + 4 * q;
            *(u32x2*)(nu_ + gidx * 8) = *(const LAS u32x2*)(S1 + rowv * LD + colv);
            *(u32x2*)(nu_ + 8192 + gidx * 8) = *(const LAS u32x2*)(S9 + rowv * LD + colv); }
    }
    __syncthreads();
#undef RK_ZERO
#undef RK_ROUND
}
__device__ __forceinline__ void scan_wg(const unsigned char* mtq, const unsigned char* nty, bf16_t* ya, int b, int h, int ubase, LAS unsigned char* lds, int tid) {
    const int wave = __builtin_amdgcn_readfirstlane(tid >> 6), lane = tid & 63, r = lane & 15, q = lane >> 4;
    constexpr int NC = SEQ / 64, NS = 4, SLOT = 32768;
    const bool loader = wave >= 4; const int j = wave & 3;
    const unsigned char* src = ((j < 2) ? mtq : nty) + (size_t)ubase * 16384 + (size_t)(j & 1) * 8192 + lane * 16;
#define SC_ISSUE(c) do { const unsigned char* s_ = src + (size_t)(c) * 16384; LAS unsigned char* d_ = lds + ((c) % NS) * SLOT + j * 8192; \
        _Pragma("unroll") for (int i_ = 0; i_ < 8; ++i_) __builtin_amdgcn_global_load_lds((const unsigned*)(s_ + i_ * 1024), (LAS unsigned*)(d_ + i_ * 1024), 16, 0, 0); } while (0)
#define SC_BAR() do { asm volatile("s_waitcnt lgkmcnt(0)" ::: "memory"); __builtin_amdgcn_s_barrier(); asm volatile("" ::: "memory"); } while (0)
    bf16x8 sB[2];
#pragma unroll
    for (int s = 0; s < 2; ++s) sB[s] = (bf16x8){0, 0, 0, 0, 0, 0, 0, 0};
    if (loader) { SC_ISSUE(0); SC_ISSUE(1); SC_ISSUE(2); asm volatile("s_waitcnt vmcnt(16)" ::: "memory"); }
    SC_BAR();
    for (int c = 0; c < NC; ++c) {
        if (loader) {
            if (c + 3 < NC) { SC_ISSUE(c + 3); asm volatile("s_waitcnt vmcnt(16)" ::: "memory"); }
            else if (c + 2 < NC) { asm volatile("s_waitcnt vmcnt(8)" ::: "memory"); }
            else { asm volatile("s_waitcnt vmcnt(0)" ::: "memory"); }
        } else {
            const LAS unsigned char* sl = lds + (c % NS) * SLOT; const int vq = j;
            f32x4 aS[4], aY[4];
#pragma unroll
            for (int mm = 0; mm < 4; ++mm) {
                const u32x2 nI = *(const LAS u32x2*)(sl + 16384 + ((vq * 4 + mm) * 64 + lane) * 8), yI = *(const LAS u32x2*)(sl + 24576 + ((vq * 4 + mm) * 64 + lane) * 8);
                aS[mm] = (f32x4){bflo(nI.x), bfhi(nI.x), bflo(nI.y), bfhi(nI.y)};
                aY[mm] = (f32x4){bflo(yI.x), bfhi(yI.x), bflo(yI.y), bfhi(yI.y)};
#pragma unroll
                for (int s = 0; s < 2; ++s) { const bf16x8 aM = *(const LAS bf16x8*)(sl + ((mm * 2 + s) * 64 + lane) * 16), aQ = *(const LAS bf16x8*)(sl + 8192 + ((mm * 2 + s) * 64 + lane) * 16);
                    aS[mm] = __builtin_amdgcn_mfma_f32_16x16x32_bf16(aM, sB[s], aS[mm], 0, 0, 0); aY[mm] = __builtin_amdgcn_mfma_f32_16x16x32_bf16(aQ, sB[s], aY[mm], 0, 0, 0); }
            }
            bf16_t* yp = ya + (size_t)(b * SEQ + c * 64) * RW + h * 64 + 16 * vq + r;
#pragma unroll
            for (int mm = 0; mm < 4; ++mm)
#pragma unroll
                for (int ii = 0; ii < 4; ++ii) yp[(size_t)(16 * mm + 4 * q + ii) * RW] = f2bf(aY[mm][ii]);
#pragma unroll
            for (int s = 0; s < 2; ++s) { u32x4 w; w.x = pk2(aS[2 * s][0], aS[2 * s][1]); w.y = pk2(aS[2 * s][2], aS[2 * s][3]); w.z = pk2(aS[2 * s + 1][0], aS[2 * s + 1][1]); w.w = pk2(aS[2 * s + 1][2], aS[2 * s + 1][3]);
                sB[s] = __builtin_bit_cast(bf16x8, w); }
        }
        SC_BAR();
    }
#undef SC_ISSUE
#undef SC_BAR
}
}
namespace gl {
constexpr int LDV = 136;
struct Args { const bf16_t* puv; const bf16_t* wsm; const float* bs; const float* ln_g; const float* ln_b; bf16_t* yb; };
__device__ __forceinline__ void unit(const Args& P, LAS unsigned char* lds, int b, int blk, int tid) {
    const int wave = __builtin_amdgcn_readfirstlane(tid >> 6), lane = tid & 63, r = lane & 15, q = lane >> 4;
    const int t0 = b * SEQ + blk * 128;
    LAS float* STAT = (LAS float*)(lds + LDS_MISC);
    for (int j = 0; j < 16; ++j) {
        const int tk = 16 * wave + j;
        const u32x4 w = *(const u32x4*)(P.puv + (size_t)(t0 + tk) * 1024 + 512 + 8 * lane);
        float v[8]; v[0] = bflo(w.x); v[1] = bfhi(w.x); v[2] = bflo(w.y); v[3] = bfhi(w.y); v[4] = bflo(w.z); v[5] = bfhi(w.z); v[6] = bflo(w.w); v[7] = bfhi(w.w);
        float s = 0.f, s2 = 0.f;
#pragma unroll
        for (int e = 0; e < 8; ++e) { s += v[e]; s2 += v[e] * v[e]; }
        s = wave_sum(s); s2 = wave_sum(s2);
        const float mean = s * (1.f / 512.f), var = fmaxf(s2 * (1.f / 512.f) - mean * mean, 0.f);
        if (lane == 0) { STAT[tk * 2] = mean; STAT[tk * 2 + 1] = __builtin_amdgcn_rsqf(var + 1e-5f); }
    }
    __syncthreads();
    for (int g = 0; g < 8; ++g) {
        LAS bf16_t* VT = (LAS bf16_t*)(lds + (g & 1) * 20480);
#pragma unroll
        for (int it = 0; it < 2; ++it) {
            const int task = tid + it * NTHREADS, j = task >> 3, cc = task & 7, ch = g * 64 + 8 * cc;
            const u32x4 w = *(const u32x4*)(P.puv + (size_t)(t0 + j) * 1024 + 512 + ch);
            const float mean = STAT[j * 2], rstd = STAT[j * 2 + 1];
            const f32x4 g0 = *(const f32x4*)(P.ln_g + ch), g1 = *(const f32x4*)(P.ln_g + ch + 4), b0 = *(const f32x4*)(P.ln_b + ch), b1 = *(const f32x4*)(P.ln_b + ch + 4);
            float v[8]; v[0] = bflo(w.x); v[1] = bfhi(w.x); v[2] = bflo(w.y); v[3] = bfhi(w.y); v[4] = bflo(w.z); v[5] = bfhi(w.z); v[6] = bflo(w.w); v[7] = bfhi(w.w);
#pragma unroll
            for (int e = 0; e < 4; ++e) { v[e] = (v[e] - mean) * rstd * g0[e] + b0[e]; v[4 + e] = (v[4 + e] - mean) * rstd * g1[e] + b1[e]; }
#pragma unroll
            for (int e = 0; e < 8; ++e) VT[(8 * cc + e) * LDV + j] = f2bf(v[e]);
        }
        __syncthreads();
        f32x4 acc[4];
#pragma unroll
        for (int n = 0; n < 4; ++n) acc[n] = (f32x4){0.f, 0.f, 0.f, 0.f};
        const bf16_t* wrow = P.wsm + ((size_t)g * 128 + 16 * wave + r) * 128 + 8 * q;
        const int ks = (wave >> 1) + 1;
        for (int s = 0; s < ks; ++s) {
            const bf16x8 a = *(const bf16x8*)(wrow + 32 * s);
#pragma unroll
            for (int n = 0; n < 4; ++n) { const bf16x8 bb = *(const LAS bf16x8*)(VT + (16 * n + r) * LDV + 32 * s + 8 * q); acc[n] = __builtin_amdgcn_mfma_f32_16x16x32_bf16(a, bb, acc[n], 0, 0, 0); }
        }
#pragma unroll
        for (int ii = 0; ii < 4; ++ii) { const int i = 16 * wave + 4 * q + ii; const float bias = P.bs[g * 128 + i];
#pragma unroll
            for (int n = 0; n < 4; ++n) { const int c = g * 64 + 16 * n + r; const float u = bf2f(P.puv[(size_t)(t0 + i) * 1024 + c]);
                P.yb[(size_t)(t0 + i) * RW + c] = f2bf(u * (acc[n][ii] + bias)); } }
    }
    __syncthreads();
}
}

struct RouteArgs { const float* sc; const float* bias; int* eidx; float* ewt; int* lrank; int* tbase; unsigned* segcnt; };
__device__ __forceinline__ void phase_topk(const RouteArgs& P, LAS unsigned char* lds, int tid, int G) {
    const int wave = __builtin_amdgcn_readfirstlane(tid >> 6), lane = tid & 63, grp = lane >> 3;
    LAS int* hist = (LAS int*)(lds + LDS_MISC);
    const f32x4 bias4 = *(const f32x4*)(P.bias + 4 * lane);
    const float NEG = -__builtin_inff();
    for (int tile = blockIdx.x; tile < T / 256; tile += G) {
        if (tid < NE) hist[tid] = 0;
        __syncthreads();
        for (int j = 0; j < 32; j += 2) {
            const int t0 = tile * 256 + wave * 32 + j;
            float s[2][4], v[2][4], gs[2];
#pragma unroll
            for (int u = 0; u < 2; ++u) { const f32x4 s4 = *(const f32x4*)(P.sc + (size_t)(t0 + u) * NE + 4 * lane); s[u][0] = s4.x; s[u][1] = s4.y; s[u][2] = s4.z; s[u][3] = s4.w;
#pragma unroll
                for (int e = 0; e < 4; ++e) v[u][e] = s[u][e] + bias4[e]; }
            float m1[2], m2[2];
#pragma unroll
            for (int u = 0; u < 2; ++u) { const float a = fmaxf(v[u][0], v[u][1]), b = fminf(v[u][0], v[u][1]), c = fmaxf(v[u][2], v[u][3]), d = fminf(v[u][2], v[u][3]); m1[u] = fmaxf(a, c); m2[u] = fmaxf(fminf(a, c), fmaxf(b, d)); }
#pragma unroll
            for (int o = 1; o < 8; o <<= 1) {
#pragma unroll
                for (int u = 0; u < 2; ++u) { const float o1 = __shfl_xor(m1[u], o), o2 = __shfl_xor(m2[u], o); const float n1 = fmaxf(m1[u], o1), n2 = fmaxf(fminf(m1[u], o1), fmaxf(m2[u], o2)); m1[u] = n1; m2[u] = n2; } }
#pragma unroll
            for (int u = 0; u < 2; ++u) gs[u] = m1[u] + m2[u];
            int cnt[2] = {0, 0};
#pragma unroll
            for (int g = 0; g < 8; ++g) {
#pragma unroll
                for (int u = 0; u < 2; ++u) { const float og = __shfl(gs[u], 8 * g); cnt[u] += (og > gs[u] || (og == gs[u] && g < grp)) ? 1 : 0; } }
#pragma unroll
            for (int u = 0; u < 2; ++u) {
#pragma unroll
                for (int e = 0; e < 4; ++e) v[u][e] = (cnt[u] < 4) ? v[u][e] : NEG; }
            int myidx[2] = {0, 0}; float mysc[2] = {0.f, 0.f}, ssum[2] = {0.f, 0.f};
#pragma unroll
            for (int k = 0; k < TOPK; ++k) {
                float bv[2]; int idx[2];
#pragma unroll
                for (int u = 0; u < 2; ++u) { bv[u] = v[u][0]; int bi = 0;
#pragma unroll
                    for (int e = 1; e < 4; ++e) { const bool gt = v[u][e] > bv[u]; bv[u] = gt ? v[u][e] : bv[u]; bi = gt ? e : bi; }
                    idx[u] = 4 * lane + bi; }
#pragma unroll
                for (int o = 1; o < 64; o <<= 1) {
#pragma unroll
                    for (int u = 0; u < 2; ++u) { const float ov = __shfl_xor(bv[u], o); const int oi = __shfl_xor(idx[u], o); const bool tk = (ov > bv[u]) || (ov == bv[u] && oi < idx[u]); bv[u] = tk ? ov : bv[u]; idx[u] = tk ? oi : idx[u]; } }
#pragma unroll
                for (int u = 0; u < 2; ++u) { const int own = idx[u] >> 2, ee = idx[u] & 3;
                    const float mine = (ee == 0) ? s[u][0] : (ee == 1) ? s[u][1] : (ee == 2) ? s[u][2] : s[u][3];
                    const float scv = __shfl(mine, own);
#pragma unroll
                    for (int e = 0; e < 4; ++e) v[u][e] = (lane == own && e == ee) ? NEG : v[u][e];
                    ssum[u] += scv; myidx[u] = (lane == k) ? idx[u] : myidx[u]; mysc[u] = (lane == k) ? scv : mysc[u]; }
            }
            if (lane < TOPK) {
#pragma unroll
                for (int u = 0; u < 2; ++u) { const int t = t0 + u;
                    const int lr = __hip_atomic_fetch_add(hist + myidx[u], 1, __ATOMIC_RELAXED, __HIP_MEMORY_SCOPE_WORKGROUP);
                    P.eidx[(size_t)t * TOPK + lane] = myidx[u]; P.ewt[(size_t)t * TOPK + lane] = mysc[u] / ssum[u] * 2.5f; P.lrank[(size_t)t * TOPK + lane] = lr; }
            }
        }
        __syncthreads();
        if (tid < NE) { const int cnt = hist[tid]; const int half = tile >> 7; unsigned base = 0u;
            if (cnt) base = __hip_atomic_fetch_add(P.segcnt + tid * 2 + half, (unsigned)cnt, __ATOMIC_RELAXED, __HIP_MEMORY_SCOPE_AGENT);
            P.tbase[tile * NE + tid] = (int)base; }
        __syncthreads();
    }
}
struct ScatArgs { const int* eidx; const float* ewt; const int* lrank; const int* tbase; const unsigned* segcnt; int* rowtok; int* rowdst; float* roww; int* tab; unsigned* ntile; };
__device__ __forceinline__ void phase_scatter(const ScatArgs& P, LAS unsigned char* lds, int tid, int G) {
    LAS int* cntL = (LAS int*)(lds + LDS_MISC); LAS int* segst = cntL + 512; LAS int* tsa = segst + 512; LAS int* tsh = tsa + 512;
    cntL[tid] = (int)__hip_atomic_load(P.segcnt + tid, __ATOMIC_RELAXED, __HIP_MEMORY_SCOPE_AGENT);
    __syncthreads();
    if (tid == 0) {
        int run = 0, ta = 0, th0 = 0, th1 = 0;
        for (int s = 0; s < 512; ++s) { const int nts = (cntL[s] + 255) >> 8; segst[s] = run; tsa[s] = ta; tsh[s] = (s & 1) ? th1 : th0; run += nts * 256; ta += nts; if (s & 1) th1 += nts; else th0 += nts; }
        if (blockIdx.x == 0) { P.ntile[0] = (unsigned)ta; P.ntile[1] = (unsigned)th0; P.ntile[2] = (unsigned)th1; }
    }
    __syncthreads();
    for (int tile = blockIdx.x; tile < T / 256; tile += G) {
        for (int a = tid; a < 256 * TOPK; a += NTHREADS) {
            const int tok = tile * 256 + (a >> 3), k = a & 7; const size_t ai = (size_t)tok * TOPK + k;
            const int e = P.eidx[ai], half = tok >> 15;
            const int pos = segst[e * 2 + half] + P.tbase[tile * NE + e] + P.lrank[ai];
            P.rowtok[pos] = tok; P.rowdst[pos] = (tok & (HALF_T - 1)) * TOPK + k; P.roww[pos] = P.ewt[ai];
        }
    }
    for (int s = blockIdx.x; s < 512; s += G) {
        const int st = segst[s], cnt = cntL[s], nts = (cnt + 255) >> 8;
        for (int p = st + cnt + tid; p < st + nts * 256; p += NTHREADS) { P.rowtok[p] = 0; P.rowdst[p] = -1; P.roww[p] = 0.f; }
        if (tid < nts) { int* ta_ = P.tab + 2 * (tsa[s] + tid); ta_[0] = st + 256 * tid; ta_[1] = s >> 1;
            int* th_ = P.tab + 2 * 4096 * (1 + (s & 1)) + 2 * (tsh[s] + tid); th_[0] = st + 256 * tid; th_[1] = s >> 1; }
    }
}
constexpr int NPHASE = 20;
struct KArgs { const float* in[34]; float* out; unsigned char* ws; int ph_lo, ph_hi; };
template <int PLO, int PHI>
__global__ void __launch_bounds__(NTHREADS, 2) fwd_kernel(KArgs a) {
    extern __shared__ __attribute__((aligned(16))) unsigned char lds_raw[];
    LAS unsigned char* lds = (LAS unsigned char*)lds_raw;
    const int G = gridDim.x, bid = blockIdx.x, NGW = G * NWAVES;
#define PH_IDS() int tid = threadIdx.x; asm volatile("" : "+v"(tid)); const int lane = tid & 63, wave = __builtin_amdgcn_readfirstlane(tid >> 6), gw = bid * NWAVES + wave; (void)lane; (void)wave; (void)gw
    unsigned char* ws = a.ws;
    unsigned* ctl = (unsigned*)(ws + WS_CTL);
    float* mod = (float*)(ws + WS_MOD);
    constexpr int lo = PLO, hi = PHI;
    if (threadIdx.x == 0) *(LAS u32x4*)(lds + LDS_BARW) = (u32x4){0u, 0u, 0u, 0u};
    __syncthreads();
    XcdBarrier bar; bar.bar = ctl + CW_BAR; bar.x = 0; bar.st = nullptr;
    if (hi - lo > 1) bar = xcd_barrier_post(ctl + CW_BAR, (volatile LAS unsigned*)(lds + LDS_BARW));
#define IN(k) (lo <= (k) && (k) < hi)
#ifdef DBG_TIME
#define STAMP(k) do { if (blockIdx.x == 0 && threadIdx.x == 0) ((unsigned long long*)(ctl + 5200))[k] = __builtin_amdgcn_s_memrealtime(); } while (0)
#else
#define STAMP(k) do {} while (0)
#endif
#define SEAM(k) do { if (IN(k) && IN((k) + 1)) xcd_barrier(bar); } while (0)
#ifndef DBG_REPEAT
#define DBG_REPEAT (-1)
#define DBG_NREP 0
#endif
#define REP(k) for (int rep_ = 0; rep_ < (((k) == DBG_REPEAT) ? 1 + DBG_NREP : 1); ++rep_, (((k) == DBG_REPEAT && rep_ <= DBG_NREP) ? xcd_barrier(bar) : (void)0))

    STAMP(0);
    if (IN(0)) REP(0) { PH_IDS();
        phase_mod(a.in[1], a.in[2], a.in[3], mod, lds, tid, G);
        SmallW sw{a.in[6], a.in[22], a.in[23], a.in[24], a.in[25], a.in[30], a.in[31], a.in[32], a.in[9], a.in[11], a.in[12], a.in[20]};
        phase_small_weights(sw, ws, lds, gw, NGW, wave, lane);
    }
    SEAM(0); STAMP(1);
    if (IN(1)) REP(1) { PH_IDS(); phase_norm_mod(a.in[0], a.in[4], mod, 0, 1024, (bf16_t*)(ws + B_H1), gw, NGW, lane); }
    SEAM(1); STAMP(2);
    if (IN(2)) REP(2) {
        gm::DenseSched S; S.init(ws + B_H1, ws + SW_WIN, T, IN_COLS, D, G, bid);
        gm::EpiInProj E{(bf16_t*)(ws + B_PRW), (bf16_t*)(ws + B_PUV), (bf16_t*)(ws + B_PG)};
        gm::gemm_phase<gm::EpiInProj, gm::DenseSched, true>(lds, D, S, E);
    }
    SEAM(2); STAMP(3);
#define RWKV_PREP(half) do { \
        rk::Args P{(const bf16_t*)(ws + B_PRW), a.in[7], a.in[8], a.in[10], a.in[13], a.in[14], a.in[15], (const bf16_t*)(ws + SW_WUP), (const bf16_t*)(ws + SW_AUP), (const bf16_t*)(ws + SW_GUP), \
                   (bf16_t*)(ws + B_G), (float*)(ws + RT_SBON), ws + B_MTQ, ws + B_NTY, ctl + 5100}; \
        rk::Pre pre; rk::load_mu(P, lds, tid); \
        if (bid < 4096) rk::prefetch(P, (half) * 4 + (bid >> 10), (bid >> 7) & 7, bid & 127, tid, pre); \
        for (int u = bid; u < 4096; u += G) { const int un = u + G; \
            rk::unit(P, lds, (half) * 4 + (u >> 10), (u >> 7) & 7, u & 127, u, tid, pre, un < 4096, (half) * 4 + (un >> 10), (un >> 7) & 7, un & 127); } } while (0)
#define RWKV_SCAN(half) do { \
        for (int w = bid; w < 32; w += G) rk::scan_wg(ws + B_MTQ, ws + B_NTY, (bf16_t*)(ws + B_YA), (half) * 4 + (w >> 3), w & 7, w * 128, lds, tid); } while (0)
    if (IN(3)) REP(3) { PH_IDS();
        RWKV_PREP(0);
        gl::Args Q{(const bf16_t*)(ws + B_PUV), (const bf16_t*)(ws + SW_WSM), a.in[21], a.in[18], a.in[19], (bf16_t*)(ws + B_YB)};
        for (int u = bid; u < 512; u += G) gl::unit(Q, lds, u >> 6, u & 63, tid);
    }
    SEAM(3); STAMP(4);
    if (IN(4)) REP(4) { PH_IDS(); RWKV_SCAN(0); }
    SEAM(4); STAMP(5);
    if (IN(5)) REP(5) { PH_IDS(); RWKV_PREP(1); }
    SEAM(5); STAMP(6);
    if (IN(6)) REP(6) { PH_IDS(); RWKV_SCAN(1); }
    SEAM(6); STAMP(7);
    if (IN(7)) { PH_IDS(); YaArgs P{(bf16_t*)(ws + B_YA), (const bf16_t*)(ws + B_G), (const bf16_t*)(ws + B_PRW), (const float*)(ws + RT_SBON), a.in[7], a.in[16], a.in[17]}; phase_ya_final(P, gw, NGW, lane); }
    SEAM(7); STAMP(8);
    if (IN(8)) REP(8) {
        gm::DenseSched S; S.init(ws + B_YA, ws + SW_WOA, T, D, RW, G, bid);
        gm::EpiMerge<false> E{(bf16_t*)(ws + B_M1), (const bf16_t*)(ws + B_PG)};
        gm::gemm_phase<gm::EpiMerge<false>, gm::DenseSched, true>(lds, RW, S, E);
    }
    SEAM(8); STAMP(9);
    if (IN(9)) {
        gm::DenseSched S; S.init(ws + B_YB, ws + SW_WOB, T, D, RW, G, bid);
        gm::EpiMerge<true> E{(bf16_t*)(ws + B_M1), (const bf16_t*)(ws + B_PG)};
        gm::gemm_phase<gm::EpiMerge<true>, gm::DenseSched, true>(lds, RW, S, E);
    }
    SEAM(9); STAMP(10);
    if (IN(10)) REP(10) {
        gm::DenseSched S; S.init(ws + B_M1, ws + SW_WO, T, D, D, G, bid);
        gm::EpiResid E{a.out, a.in[0], mod + 2048};
        gm::gemm_phase<gm::EpiResid, gm::DenseSched, true>(lds, D, S, E);
    }
    SEAM(10); STAMP(11);
    if (IN(11)) REP(11) { PH_IDS();
        phase_norm_mod(a.out, a.in[5], mod, 3072, 4096, (bf16_t*)(ws + B_H2), gw, NGW, lane);
        phase_expert_weights(a.in[27], a.in[28], a.in[29], ws, lds, gw, NGW, wave, lane);
    }
    SEAM(11); STAMP(12);
    if (IN(12)) REP(12) {
        { gm::DenseSched S; S.init(ws + B_H2, ws + SW_WR, T, NE, D, G, bid); gm::EpiRouter E{(float*)(ws + B_SC)}; gm::gemm_phase<gm::EpiRouter, gm::DenseSched, true>(lds, D, S, E); }
        { gm::DenseSched S; S.init(ws + B_H2, ws + SW_WS13, T, 512, D, G, bid); gm::EpiGateUp E{(bf16_t*)(ws + B_SH)}; gm::gemm_phase<gm::EpiGateUp, gm::DenseSched, true>(lds, D, S, E); }
    }
    SEAM(12); STAMP(13);
    if (IN(13)) { PH_IDS();
        RouteArgs R{(const float*)(ws + B_SC), a.in[26], (int*)(ws + RT_EIDX), (float*)(ws + RT_EWT), (int*)(ws + RT_LRANK), (int*)(ws + RT_TBASE), ctl + CW_SEGCNT};
        phase_topk(R, lds, tid, G);
        gm::DenseSched S; S.init(ws + B_SH, ws + SW_WS2, T, D, EFF, G, bid);
        gm::EpiResid E{a.out, a.out, mod + 5120};
        gm::gemm_phase<gm::EpiResid, gm::DenseSched, true>(lds, EFF, S, E);
    }
    SEAM(13); STAMP(14);
    if (IN(14)) REP(14) { PH_IDS();
        ScatArgs P{(const int*)(ws + RT_EIDX), (const float*)(ws + RT_EWT), (const int*)(ws + RT_LRANK), (const int*)(ws + RT_TBASE), ctl + CW_SEGCNT,
                   (int*)(ws + RT_ROWTOK), (int*)(ws + RT_ROWDST), (float*)(ws + RT_ROWW), (int*)(ws + RT_TAB), ctl + CW_NT};
        phase_scatter(P, lds, tid, G);
    }
    SEAM(14); STAMP(15);
    if (IN(15)) REP(15) {
        gm::GroupSched<true> S; S.A = (const char*)(ws + B_H2); S.B = (const char*)(ws + B_W13); S.tab = (const int*)(ws + RT_TAB); S.rowtok = (const int*)(ws + RT_ROWTOK);
        S.ntiles = (int)__hip_atomic_load(ctl + CW_NT, __ATOMIC_RELAXED, __HIP_MEMORY_SCOPE_AGENT); S.npn = 2; S.G = G; S.c = bid; S.K = D; S.ebytes = (size_t)512 * D * 2; S.tstep = (size_t)256 * D * 2;
        gm::EpiGateUp E{(bf16_t*)(ws + B_HID)};
        gm::gemm_phase<gm::EpiGateUp, gm::GroupSched<true>, true>(lds, D, S, E);
    }
    SEAM(15); STAMP(16);
#define MOE_DOWN(half) do { \
        gm::GroupSched<false> S; S.A = (const char*)(ws + B_HID); S.B = (const char*)(ws + B_W2); S.tab = (const int*)(ws + RT_TAB) + 2 * 4096 * (1 + (half)); S.rowtok = nullptr; \
        S.ntiles = (int)__hip_atomic_load(ctl + CW_NT + 1 + (half), __ATOMIC_RELAXED, __HIP_MEMORY_SCOPE_AGENT); S.npn = 4; S.G = G; S.c = bid; S.K = EFF; S.ebytes = (size_t)D * EFF * 2; S.tstep = (size_t)256 * EFF * 2; \
        gm::EpiExpertDown E{(bf16_t*)(ws + B_SLOT), (const int*)(ws + RT_ROWDST), (const float*)(ws + RT_ROWW)}; \
        gm::gemm_phase<gm::EpiExpertDown, gm::GroupSched<false>, true>(lds, EFF, S, E); } while (0)
    if (IN(16)) REP(16) MOE_DOWN(0);
    SEAM(16); STAMP(17);
    if (IN(17)) { PH_IDS(); phase_combine(a.out, (const bf16_t*)(ws + B_SLOT), mod, a.in[33], 0, gw, NGW, lane); }
    SEAM(17); STAMP(18);
    if (IN(18)) REP(18) MOE_DOWN(1);
    SEAM(18); STAMP(19);
    if (IN(19)) { PH_IDS(); phase_combine(a.out, (const bf16_t*)(ws + B_SLOT), mod, a.in[33], 1, gw, NGW, lane); }
    __syncthreads(); STAMP(20);
#undef IN
#undef SEAM
#undef RWKV_PREP
#undef RWKV_SCAN
#undef MOE_DOWN
}

#if defined(DBG_CHECK) || defined(DBG_TIME)
#ifdef DBG_TIME
__global__ void dbg_time_out(float* out, const unsigned long long* st) {
    if (threadIdx.x == 0 && blockIdx.x == 0) { out[0] = (float)(st[TA1] - st[TA0]) * 0.01f * 0.25f; out[1] = (float)(st[TB1] - st[TB0]) * 0.01f * 0.25f; }
}
static void dbg_run(void* d_out, void* d_ws, hipStream_t stream) {
    dbg_time_out<<<1, 64, 0, stream>>>((float*)d_out, (const unsigned long long*)((unsigned*)((unsigned char*)d_ws + WS_CTL) + 5200));
}
#endif
#endif
#ifndef MK_SINGLE
#define MK_SINGLE 0
#endif
template <int PLO, int PHI> static bool prep_kernel() {
    int per_cu = 0;
    if (hipFuncSetAttribute((const void*)fwd_kernel<PLO, PHI>, hipFuncAttributeMaxDynamicSharedMemorySize, LDS_BYTES) != hipSuccess) { fprintf(stderr, "kernel_launch: hipFuncSetAttribute failed\n"); return false; }
    if (hipOccupancyMaxActiveBlocksPerMultiprocessor(&per_cu, (const void*)fwd_kernel<PLO, PHI>, NTHREADS, LDS_BYTES) != hipSuccess || per_cu < 1) { fprintf(stderr, "kernel_launch: occupancy query says %d\n", per_cu); (void)hipGetLastError(); return false; }
    return true;
}
template <int P> struct PhaseLaunch {
    static bool prep() { return prep_kernel<P, P + 1>() && PhaseLaunch<P + 1>::prep(); }
    static void go(int grid, hipStream_t stream, const KArgs& a) { hipLaunchKernelGGL((fwd_kernel<P, P + 1>), dim3(grid), dim3(NTHREADS), LDS_BYTES, stream, a); PhaseLaunch<P + 1>::go(grid, stream, a); }
};
#ifndef DBG_LAST
#define DBG_LAST NPHASE
#endif
template <> struct PhaseLaunch<DBG_LAST> { static bool prep() { return true; } static void go(int, hipStream_t, const KArgs&) {} };
extern "C" void kernel_launch(void* const* d_in, const int* in_sizes, int n_in, void* d_out, int out_size, void* d_ws, size_t ws_size, hipStream_t stream) {
    static int grid = 0;
    if (grid == 0) {
        if (n_in != 34 || out_size != T * D || ws_size < WS_END) { fprintf(stderr, "kernel_launch: unexpected problem shape (n_in %d, out %d, ws %zu < %zu)\n", n_in, out_size, ws_size, (size_t)WS_END); grid = -1; return; }
        int dev = 0, cus = 0;
        if (hipGetDevice(&dev) != hipSuccess || hipDeviceGetAttribute(&cus, hipDeviceAttributeMultiprocessorCount, dev) != hipSuccess) { grid = -1; return; }
#if MK_SINGLE
        if (!prep_kernel<0, NPHASE>()) { grid = -1; return; }
#else
        if (!PhaseLaunch<0>::prep()) { grid = -1; return; }
#endif
        grid = cus;
    }
    if (grid < 0) return;
    (void)hipMemsetAsync((char*)d_ws + WS_CTL, 0, CTL_ZERO_BYTES, stream);
    KArgs a{};
    for (int i = 0; i < 34; ++i) a.in[i] = (const float*)d_in[i];
    a.out = (float*)d_out; a.ws = (unsigned char*)d_ws; a.ph_lo = 0; a.ph_hi = NPHASE;
#if MK_SINGLE
    hipLaunchKernelGGL((fwd_kernel<0, NPHASE>), dim3(grid), dim3(NTHREADS), LDS_BYTES, stream, a);
#else
    PhaseLaunch<0>::go(grid, stream, a);
#endif
#if defined(DBG_CHECK) || defined(DBG_TIME)
    dbg_run(d_out, d_ws, stream);
#endif
}
```

```cpp
#define MK_SINGLE 1
#include <hip/hip_runtime.h>
#include <cstdio>
#include <cstdint>

#define LAS __attribute__((address_space(3)))
#define GAS __attribute__((address_space(1)))
typedef unsigned short bf16_t;
typedef short bf16x8 __attribute__((ext_vector_type(8)));
typedef float f32x4 __attribute__((ext_vector_type(4)));
typedef float f32x2 __attribute__((ext_vector_type(2)));
typedef unsigned u32x4 __attribute__((ext_vector_type(4)));
typedef unsigned u32x2 __attribute__((ext_vector_type(2)));

constexpr int D = 1024, NB = 8, SEQ = 8192, T = NB * SEQ;
constexpr int RW = 512, HD = 64, NH = 8;
constexpr int RWKV_COLS = 1792, IN_COLS = 4864;
constexpr int NE = 256, TOPK = 8, EFF = 256;
constexpr int NWAVES = 8, NTHREADS = 512;
constexpr int HALF_T = T / 2;
constexpr int MAXROWS = T * TOPK + 512 * 256;

constexpr size_t MiB = 1u << 20;
constexpr size_t WS_CTL = 0;
constexpr int CW_BAR = 0, CW_SEGCNT = 4096, CW_NT = 4608;
constexpr size_t CTL_ZERO_BYTES = 20480;
constexpr size_t WS_MOD = 65536;
constexpr size_t WS_SW = 1 * MiB;
constexpr size_t SW_WIN = WS_SW;
constexpr size_t SW_WOA = SW_WIN + (size_t)IN_COLS * D * 2;
constexpr size_t SW_WOB = SW_WOA + (size_t)D * RW * 2;
constexpr size_t SW_WO = SW_WOB + (size_t)D * RW * 2;
constexpr size_t SW_WR = SW_WO + (size_t)D * D * 2;
constexpr size_t SW_WS13 = SW_WR + (size_t)NE * D * 2;
constexpr size_t SW_WS2 = SW_WS13 + (size_t)512 * D * 2;
constexpr size_t SW_WUP = SW_WS2 + (size_t)D * EFF * 2;
constexpr size_t SW_AUP = SW_WUP + (size_t)RW * 64 * 2;
constexpr size_t SW_GUP = SW_AUP + (size_t)RW * 64 * 2;
constexpr size_t SW_WSM = SW_GUP + (size_t)RW * 128 * 2;
constexpr size_t SW_END = SW_WSM + (size_t)8 * 128 * 128 * 2;
static_assert(SW_END <= 20 * MiB, "small weights");
constexpr size_t WS_RT = 20 * MiB;
constexpr size_t RT_EIDX = WS_RT;
constexpr size_t RT_EWT = RT_EIDX + (size_t)T * 8 * 4;
constexpr size_t RT_LRANK = RT_EWT + (size_t)T * 8 * 4;
constexpr size_t RT_TBASE = RT_LRANK + (size_t)T * 8 * 4;
constexpr size_t RT_ROWTOK = RT_TBASE + (size_t)256 * 256 * 4;
constexpr size_t RT_ROWDST = RT_ROWTOK + (size_t)MAXROWS * 4;
constexpr size_t RT_ROWW = RT_ROWDST + (size_t)MAXROWS * 4;
constexpr size_t RT_TAB = RT_ROWW + (size_t)MAXROWS * 4;
constexpr size_t RT_SBON = RT_TAB + (size_t)3 * 4096 * 8;
constexpr size_t RT_END = RT_SBON + (size_t)T * 8 * 4;
static_assert(RT_END <= 40 * MiB, "routing arrays");
constexpr size_t WS_BIG = 40 * MiB;
constexpr size_t B_H1 = WS_BIG + 0 * MiB;
constexpr size_t B_YB = WS_BIG + 0 * MiB;
constexpr size_t B_YA = WS_BIG + 64 * MiB;
constexpr size_t B_PRW = WS_BIG + 128 * MiB;
constexpr size_t B_S = WS_BIG + 128 * MiB;
constexpr size_t B_PUV = WS_BIG + 352 * MiB;
constexpr size_t B_QY = WS_BIG + 352 * MiB;
constexpr size_t B_M1 = WS_BIG + 352 * MiB;
constexpr size_t B_PG = WS_BIG + 480 * MiB;
constexpr size_t B_MN = WS_BIG + 736 * MiB;
constexpr size_t B_G = WS_BIG + 864 * MiB;
constexpr size_t B_BV = WS_BIG + 928 * MiB;
constexpr size_t B_H2 = WS_BIG + 0 * MiB;
constexpr size_t B_W13 = WS_BIG + 128 * MiB;
constexpr size_t B_SH = WS_BIG + 384 * MiB;
constexpr size_t B_SC = WS_BIG + 416 * MiB;
constexpr size_t B_SLOT = WS_BIG + 0 * MiB;
constexpr size_t B_W2 = WS_BIG + 512 * MiB;
constexpr size_t B_HID = WS_BIG + 640 * MiB;
constexpr size_t WS_END = WS_BIG + 992 * MiB;
static_assert((size_t)MAXROWS * EFF * 2 <= 320 * MiB, "hid");

constexpr int LDS_STAGE = 0;
constexpr int LDS_MISC = 147456;
constexpr int LDS_BARW = 155648;
constexpr int LDS_BYTES = 163840;

typedef __bf16 bf16x2_t __attribute__((ext_vector_type(2)));
__device__ __forceinline__ unsigned pk2(float lo, float hi) { f32x2 f = {lo, hi}; return __builtin_bit_cast(unsigned, __builtin_convertvector(f, bf16x2_t)); }
__device__ __forceinline__ float bflo(unsigned w) { return __uint_as_float(w << 16); }
__device__ __forceinline__ float bfhi(unsigned w) { return __uint_as_float(w & 0xffff0000u); }
__device__ __forceinline__ float bf2f(bf16_t h) { return __uint_as_float(((unsigned)h) << 16); }
__device__ __forceinline__ bf16_t f2bf(float f) { return (bf16_t)(pk2(f, 0.f) & 0xffffu); }
__device__ __forceinline__ float fexp(float x) { return __builtin_amdgcn_exp2f(x * 1.44269504089f); }
__device__ __forceinline__ float flog(float x) { return __builtin_amdgcn_logf(x) * 0.69314718056f; }
__device__ __forceinline__ float frcp(float x) { return __builtin_amdgcn_rcpf(x); }
__device__ __forceinline__ float sigmoidf_(float x) { return frcp(1.0f + fexp(-x)); }
__device__ __forceinline__ float siluf_(float x) { return x * sigmoidf_(x); }
__device__ __forceinline__ float tanhf_(float x) { return 1.0f - 2.0f * frcp(1.0f + fexp(2.0f * x)); }
__device__ __forceinline__ float gelu_tanh(float x) { const float u = 0.7978845608f * (x + 0.044715f * x * x * x); return x * frcp(1.0f + fexp(-2.0f * u)); }
__device__ __forceinline__ float wave_sum(float v) {
#pragma unroll
    for (int o = 1; o < 64; o <<= 1) v += __shfl_xor(v, o);
    return v;
}
#define LDS_WAIT() asm volatile("s_waitcnt lgkmcnt(0)" ::: "memory")
#define VM_WAIT() asm volatile("s_waitcnt vmcnt(0)" ::: "memory")

#define XB_TMO      128
#define XB_XCNT(j)  (256  + 64 * (j))
#define XB_XSUB(j)  (1280 + 64 * (j))
#define XB_XGEN(j)  (2304 + 64 * (j))
#define XB_TOP      3328
#define XB_TOPGEN   3392
#define XCD_BAR_WORDS 3456
#define XB_SPIN_CAP (1u << 18)
__device__ __forceinline__ unsigned xb_ld(unsigned* p)              { return __hip_atomic_load(p, __ATOMIC_RELAXED, __HIP_MEMORY_SCOPE_AGENT); }
__device__ __forceinline__ unsigned xb_add(unsigned* p, unsigned v) { return __hip_atomic_fetch_add(p, v, __ATOMIC_RELAXED, __HIP_MEMORY_SCOPE_AGENT); }
__device__ __forceinline__ unsigned xb_xcc_id() { return (unsigned)__builtin_amdgcn_s_getreg((3 << 11) | 20) & 0xFu; }
#define XB_SPIN(cond, bar) do { unsigned _sp = 0; while (cond) { __builtin_amdgcn_s_sleep(1); \
    if ((++_sp & 255u) == 0u) { if (xb_ld(&(bar)[XB_TMO])) break; if (_sp > XB_SPIN_CAP) { atomicAdd(&(bar)[XB_TMO], 1u); break; } } } } while (0)
struct XcdBarrier { unsigned* bar; unsigned x; volatile LAS unsigned* st; };
__device__ __forceinline__ XcdBarrier xcd_barrier_post(unsigned* bar, volatile LAS unsigned* st) {
    XcdBarrier b; b.bar = bar; b.x = xb_xcc_id(); b.st = st;
    if (threadIdx.x == 0) (void)xb_add(&bar[XB_XCNT(b.x)], 1u);
    return b;
}
__device__ __forceinline__ void xcd_barrier_complete(unsigned* bar, unsigned x, unsigned& nloc, unsigned& nx) {
    const unsigned G = gridDim.x * gridDim.y * gridDim.z;
    unsigned sum, cnt, mine, sp = 0u;
    for (;;) {
        sum = 0u; cnt = 0u; mine = 0u;
#pragma unroll
        for (unsigned j = 0; j < 16; ++j) { const unsigned c = xb_ld(&bar[XB_XCNT(j)]); sum += c; cnt += (c > 0u) ? 1u : 0u; mine = (j == x) ? c : mine; }
        if (sum == G) break;
        __builtin_amdgcn_s_sleep(1);
        if ((++sp & 255u) == 0u) { if (xb_ld(&bar[XB_TMO])) break; if (sp > XB_SPIN_CAP) { atomicAdd(&bar[XB_TMO], 1u); break; } }
    }
    nloc = mine > 0u ? mine : 1u; nx = cnt > 0u ? cnt : 1u;
}
__device__ __forceinline__ void xcd_barrier(const XcdBarrier& b) {
    asm volatile("s_waitcnt vmcnt(0)" ::: "memory");
    __syncthreads();
    if (threadIdx.x == 0) {
        unsigned* bar = b.bar;
        __builtin_amdgcn_s_waitcnt(0);
        unsigned nloc = b.st[0], nx = b.st[1];
        if (nloc == 0u) { xcd_barrier_complete(bar, b.x, nloc, nx); b.st[0] = nloc; b.st[1] = nx; }
        const unsigned old = xb_add(&bar[XB_XSUB(b.x)], 1u);
        const unsigned gen = old / nloc;
        if (old + 1u == (gen + 1u) * nloc) {
            __builtin_amdgcn_fence(__ATOMIC_RELEASE, "agent");
            asm volatile("s_waitcnt vmcnt(0)" ::: "memory");
            const unsigned og = xb_add(&bar[XB_TOP], 1u);
            const unsigned tg = og / nx;
            if (og + 1u == (tg + 1u) * nx) xb_add(&bar[XB_TOPGEN], 1u);
            else XB_SPIN(xb_ld(&bar[XB_TOPGEN]) == tg, bar);
            __builtin_amdgcn_fence(__ATOMIC_ACQUIRE, "agent");
            xb_add(&bar[XB_XGEN(b.x)], 1u);
            asm volatile("s_waitcnt vmcnt(0)" ::: "memory");
        } else {
            XB_SPIN(xb_ld(&bar[XB_XGEN(b.x)]) == gen, bar);
            __builtin_amdgcn_fence(__ATOMIC_ACQUIRE, "agent");
            asm volatile("s_waitcnt vmcnt(0)" ::: "memory");
        }
    }
    __syncthreads();
}
namespace gm {
constexpr int BM = 256, BK = 64, HALF = 128, HTB = HALF * BK * 2, STAGE_BYTES = 8 * HTB, NXCD = 8, WGM = 8;
__host__ __device__ __forceinline__ int lds_byte(int r, int c) { const int st = (r >> 4) * 2 + (c >> 5), rr = r & 15, cc = c & 31, ob = rr * 64 + cc * 2; return st * 1024 + (ob ^ (((ob >> 9) & 1) << 5)); }
__host__ __device__ __forceinline__ void stage_rc(int b, int& R, int& C) { const int st = b / 1024, sb = b % 1024, swz = sb ^ (((sb >> 9) & 1) << 5); R = (st >> 1) * 16 + swz / 64; C = (st & 1) * 32 + (swz % 64) / 2; }
__host__ __device__ __forceinline__ int perm32(int rho) { const int n = rho >> 4, i = rho & 15; return 8 * (i >> 2) + 4 * n + (i & 3); }

struct Unit { int pm, pn, e, row0, par; };

struct DenseSched {
    static constexpr bool GATHER = false;
    const char* A; const char* B; int nM, nN, nwg, G, c; size_t tstep;
    __device__ __forceinline__ void init(const void* A_, const void* B_, int M, int N, int K, int G_, int c_) { A = (const char*)A_; B = (const char*)B_; nM = M / BM; nN = N / BM; nwg = nM * nN; G = G_; c = c_; tstep = (size_t)BM * K * 2; }
    __device__ __forceinline__ bool next(int i, Unit& u) const {
        const long L = (long)i * G + c; if (L >= nwg) return false;
        int wgid = (int)L; { const int q = nwg / NXCD, r = nwg % NXCD, xcd = wgid % NXCD, off = wgid / NXCD; wgid = (xcd < r ? xcd * (q + 1) : r * (q + 1) + (xcd - r) * q) + off; }
        const int nig = WGM * nN, gid = wgid / nig, fm = gid * WGM, gsz = (nM - fm) < WGM ? (nM - fm) : WGM;
        u.pm = fm + ((wgid % nig) % gsz); u.pn = (wgid % nig) / gsz; u.e = 0; u.row0 = u.pm * BM; return true;
    }
    __device__ __forceinline__ const char* a_ptr(const Unit& u) const { return A + (size_t)u.pm * tstep; }
    __device__ __forceinline__ const char* b_ptr(const Unit& u) const { return B + (size_t)u.pn * tstep; }
    __device__ __forceinline__ unsigned row_off(const Unit&, int) const { return 0u; }
};
template <bool GATHER_>
struct GroupSched {
    static constexpr bool GATHER = GATHER_;
    const char* A; const char* B; const int* tab; const int* rowtok; int ntiles, npn, G, c, K; size_t ebytes, tstep;
    __device__ __forceinline__ bool next(int i, Unit& u) const {
        const long L = (long)i * G + c; if (L >= (long)ntiles * npn) return false;
        const int tile = (int)(L / npn); u.pn = (int)(L % npn); u.pm = tile;
        u.row0 = __builtin_amdgcn_readfirstlane(tab[2 * tile]); u.e = __builtin_amdgcn_readfirstlane(tab[2 * tile + 1]); return true;
    }
    __device__ __forceinline__ const char* a_ptr(const Unit& u) const { return GATHER ? A : A + (size_t)u.row0 * K * 2; }
    __device__ __forceinline__ const char* b_ptr(const Unit& u) const { return B + (size_t)u.e * ebytes + (size_t)u.pn * tstep; }
    __device__ __forceinline__ unsigned row_off(const Unit& u, int r) const { return (unsigned)rowtok[u.row0 + r] * (unsigned)(K * 2); }
};

template <class Epi, class Sched, bool ALIGN_EPI>
__device__ __forceinline__ void gemm_phase(LAS unsigned char* lds, const int K, const Sched& S, const Epi& E) {
    int tid_ = threadIdx.x; asm volatile("" : "+v"(tid_));
    const int tid = tid_, wid = __builtin_amdgcn_readfirstlane(tid >> 6), lane = tid & 63, wr = wid >> 2, wc = wid & 3, fr = lane & 15, fq = lane >> 4;
    const int nt = K / BK;
    int sR[2], sC[2]; unsigned voffB[2];
#pragma unroll
    for (int i = 0; i < 2; ++i) { int R, C; stage_rc(tid * 16 + i * 8192, R, C); sR[i] = R; sC[i] = C; const int Rb = Epi::PERM ? ((R & ~31) + perm32(R & 31)) : R; voffB[i] = (unsigned)(Rb * K + C) * 2u; }
    const size_t kstep = (size_t)(BK * 2);
    const size_t hstep = (size_t)HALF * K * 2;
    const unsigned ldsw = (unsigned)wid * 1024u;
    const int aoff = lds_byte(wr * 64 + fr, fq * 8), boff = lds_byte(wc * 32 + fr, fq * 8);
#define PG8_SA(b, h) (((b) * 2 + (h)) * HTB)
#define PG8_SB(b, h) ((4 + (b) * 2 + (h)) * HTB)
#define PG8_STGB(bufoff, gbase) do { _Pragma("unroll") for (int _i = 0; _i < 2; ++_i) \
        __builtin_amdgcn_global_load_lds((const unsigned*)((const char*)(gbase) + voffB[_i]), (LAS unsigned*)(lds + (bufoff) + ldsw + _i * 8192), 16, 0, 0); } while (0)
#define PG8_STGA(bufoff, gbase, VO, h) do { _Pragma("unroll") for (int _i = 0; _i < 2; ++_i) \
        __builtin_amdgcn_global_load_lds((const unsigned*)((const char*)(gbase) + VO[h][_i]), (LAS unsigned*)(lds + (bufoff) + ldsw + _i * 8192), 16, 0, 0); } while (0)
#define PG8_VOA(u, VO) do { _Pragma("unroll") for (int _h = 0; _h < 2; ++_h) _Pragma("unroll") for (int _i = 0; _i < 2; ++_i) \
        VO[_h][_i] = Sched::GATHER ? (S.row_off(u, _h * HALF + sR[_i]) + (unsigned)sC[_i] * 2u) : ((unsigned)((_h * HALF + sR[_i]) * K + sC[_i]) * 2u); } while (0)
#define PG8_LDA(dst, b, h) do { _Pragma("unroll") for (int m = 0; m < 4; ++m) _Pragma("unroll") for (int k = 0; k < 2; ++k) dst[m][k] = *(const LAS bf16x8*)(lds + PG8_SA(b, h) + aoff + m * 2048 + k * 1024); } while (0)
#define PG8_LDB(dst, b, h) do { _Pragma("unroll") for (int n = 0; n < 2; ++n) _Pragma("unroll") for (int k = 0; k < 2; ++k) dst[n][k] = *(const LAS bf16x8*)(lds + PG8_SB(b, h) + boff + n * 2048 + k * 1024); } while (0)
#define PG8_MMA(ai, bj, At, Bt) do { __builtin_amdgcn_s_setprio(1); _Pragma("unroll") for (int m = 0; m < 4; ++m) _Pragma("unroll") for (int n = 0; n < 2; ++n) _Pragma("unroll") for (int k = 0; k < 2; ++k) \
        acc[ai][bj][m][n] = __builtin_amdgcn_mfma_f32_16x16x32_bf16(Bt[n][k], At[m][k], acc[ai][bj][m][n], 0, 0, 0); __builtin_amdgcn_s_setprio(0); } while (0)
#define PG8_WAIT_V(n) asm volatile("s_waitcnt vmcnt(" #n ")" ::: "memory")
#define PG8_WAIT_L(n) asm volatile("s_waitcnt lgkmcnt(" #n ")" ::: "memory")
#define PG8_BAR __builtin_amdgcn_s_barrier()
#define PG8_SCHED __builtin_amdgcn_sched_barrier(0)
    Unit cur, nxt; int ui = 0;
    if (!S.next(0, cur)) return;
    f32x4 acc[2][2][4][2];
#pragma unroll
    for (int a = 0; a < 2; ++a)
#pragma unroll
        for (int b = 0; b < 2; ++b)
#pragma unroll
            for (int m = 0; m < 4; ++m)
#pragma unroll
                for (int n = 0; n < 2; ++n) acc[a][b][m][n] = (f32x4){0.f, 0.f, 0.f, 0.f};
    bf16x8 At[4][2], B0[2][2], B1[2][2];
    unsigned voA[2][2], nvoA[2][2];
    PG8_VOA(cur, voA);
    if (Sched::GATHER) { asm volatile("s_waitcnt vmcnt(0)" ::: "memory"); }
    const char* cA = S.a_ptr(cur); const char* cB = S.b_ptr(cur);
    cur.par = 0; E.stage_rows(cur, lds, wid);
    PG8_STGB(PG8_SB(0, 0), cB); PG8_STGB(PG8_SB(0, 1), cB + hstep); PG8_STGA(PG8_SA(0, 0), cA, voA, 0); PG8_STGA(PG8_SA(0, 1), cA, voA, 1);
    if (wr == 1) PG8_BAR;
    PG8_WAIT_V(2); PG8_BAR;
    PG8_STGB(PG8_SB(1, 0), cB + kstep); PG8_STGA(PG8_SA(1, 0), cA + kstep, voA, 0); PG8_STGB(PG8_SB(1, 1), cB + hstep + kstep);
    PG8_WAIT_V(6); PG8_BAR;
    for (;;) {
        const bool has_next = S.next(ui + 1, nxt); nxt.par = (ui + 1) & 1;
        const char* nA = has_next ? S.a_ptr(nxt) : cA; const char* nB = has_next ? S.b_ptr(nxt) : cB;
        if (Sched::GATHER) { if (has_next) { PG8_VOA(nxt, nvoA); } else {
#pragma unroll
            for (int h = 0; h < 2; ++h)
#pragma unroll
                for (int i = 0; i < 2; ++i) nvoA[h][i] = voA[h][i]; } }
#pragma unroll 1
        for (int t = 0; t < nt; t += 2) {
            const bool last = (t == nt - 2);
            const char* a1 = cA + (size_t)(t + 1) * kstep;
            const char* a2 = last ? nA : cA + (size_t)(t + 2) * kstep; const char* b2 = last ? nB : cB + (size_t)(t + 2) * kstep;
            const char* a3 = a2 + kstep; const char* b3 = b2 + kstep;
            unsigned vo2[2][2];
#pragma unroll
            for (int h = 0; h < 2; ++h)
#pragma unroll
                for (int i = 0; i < 2; ++i) vo2[h][i] = (Sched::GATHER && last) ? nvoA[h][i] : voA[h][i];
            if (last && has_next) E.stage_rows(nxt, lds, wid);
            PG8_LDB(B0, 0, 0); PG8_LDB(B1, 0, 1); PG8_SCHED; PG8_LDA(At, 0, 0); PG8_STGA(PG8_SA(1, 1), a1, voA, 1);
            PG8_WAIT_V(8); PG8_WAIT_L(0); PG8_BAR; PG8_MMA(0, 0, At, B0); PG8_MMA(0, 1, At, B1); PG8_BAR; PG8_SCHED;
            PG8_LDA(At, 0, 1); PG8_STGB(PG8_SB(0, 0), b2); PG8_STGB(PG8_SB(0, 1), b2 + hstep); PG8_STGA(PG8_SA(0, 0), a2, vo2, 0);
            PG8_WAIT_V(8); PG8_WAIT_L(0); PG8_BAR; PG8_MMA(1, 0, At, B0); PG8_MMA(1, 1, At, B1); PG8_BAR; PG8_SCHED;
            PG8_LDB(B0, 1, 0); PG8_LDB(B1, 1, 1); PG8_SCHED; PG8_LDA(At, 1, 0); PG8_STGA(PG8_SA(0, 1), a2, vo2, 1);
            PG8_WAIT_V(8); PG8_WAIT_L(0); PG8_BAR; PG8_MMA(0, 0, At, B0); PG8_MMA(0, 1, At, B1); PG8_BAR; PG8_SCHED;
            PG8_LDA(At, 1, 1); PG8_STGB(PG8_SB(1, 0), b3); PG8_STGB(PG8_SB(1, 1), b3 + hstep); PG8_STGA(PG8_SA(1, 0), a3, vo2, 0);
            PG8_WAIT_V(8); PG8_WAIT_L(0); PG8_BAR; PG8_MMA(1, 0, At, B0); PG8_MMA(1, 1, At, B1); PG8_BAR; PG8_SCHED;
        }
        if constexpr (ALIGN_EPI) { if (wr == 0) PG8_BAR; }
        E(acc, cur, wr, wc, fr, fq);
        if (!has_next) break;
#pragma unroll
        for (int a = 0; a < 2; ++a)
#pragma unroll
            for (int b = 0; b < 2; ++b)
#pragma unroll
                for (int m = 0; m < 4; ++m)
#pragma unroll
                    for (int n = 0; n < 2; ++n) acc[a][b][m][n] = (f32x4){0.f, 0.f, 0.f, 0.f};
        cur = nxt; cA = nA; cB = nB; ++ui;
        if (Sched::GATHER) {
#pragma unroll
            for (int h = 0; h < 2; ++h)
#pragma unroll
                for (int i = 0; i < 2; ++i) voA[h][i] = nvoA[h][i]; }
        if constexpr (ALIGN_EPI) { if (wr == 1) PG8_BAR; }
    }
    PG8_WAIT_V(0);
    if constexpr (!ALIGN_EPI) { if (wr == 0) PG8_BAR; }
    PG8_BAR;
#undef PG8_SA
#undef PG8_SB
#undef PG8_STGA
#undef PG8_STGB
#undef PG8_VOA
#undef PG8_LDA
#undef PG8_LDB
#undef PG8_MMA
#undef PG8_WAIT_V
#undef PG8_WAIT_L
#undef PG8_BAR
#undef PG8_SCHED
}

typedef f32x4 Acc[2][2][4][2];
struct EpiInProj {
    static constexpr bool PERM = true;
    __device__ __forceinline__ void stage_rows(const Unit&, LAS unsigned char*, int) const {}
    bf16_t *prw, *puv, *pg;
    template <int ACT> __device__ __forceinline__ void tile(const Acc& acc, bf16_t* base, int ld, int row0, int col0) const {
#pragma unroll
        for (int ai = 0; ai < 2; ++ai)
#pragma unroll
            for (int m = 0; m < 4; ++m) { bf16_t* rowp = base + (size_t)(row0 + ai * HALF + m * 16) * ld + col0;
#pragma unroll
                for (int bj = 0; bj < 2; ++bj) { f32x4 v0 = acc[ai][bj][m][0], v1 = acc[ai][bj][m][1];
                    if (ACT == 1) {
#pragma unroll
                        for (int j = 0; j < 4; ++j) { v0[j] = gelu_tanh(v0[j]); v1[j] = gelu_tanh(v1[j]); } }
                    if (ACT == 2) {
#pragma unroll
                        for (int j = 0; j < 4; ++j) { v0[j] = sigmoidf_(v0[j]); v1[j] = sigmoidf_(v1[j]); } }
                    u32x4 w; w.x = pk2(v0[0], v0[1]); w.y = pk2(v0[2], v0[3]); w.z = pk2(v1[0], v1[1]); w.w = pk2(v1[2], v1[3]);
                    *(u32x4*)(rowp + bj * HALF) = w; }
                __builtin_amdgcn_sched_barrier(0); }
    }
    __device__ __forceinline__ void operator()(const Acc& acc, const Unit& u, int wr, int wc, int fr, int fq) const {
        const int row0 = u.row0 + wr * 64 + fr, cw = wc * 32 + 8 * fq;
        if (u.pn < 7) tile<0>(acc, prw, RWKV_COLS, row0, u.pn * 256 + cw);
        else if (u.pn < 11) tile<1>(acc, puv, 1024, row0, (u.pn - 7) * 256 + cw);
        else tile<2>(acc, pg, 2048, row0, (u.pn - 11) * 256 + cw);
    }
};
template <bool SECOND> struct EpiMerge {
    static constexpr bool PERM = true;
    __device__ __forceinline__ void stage_rows(const Unit&, LAS unsigned char*, int) const {}
    bf16_t* m1; const bf16_t* pg;
    __device__ __forceinline__ void operator()(const Acc& acc, const Unit& u, int wr, int wc, int fr, int fq) const {
        const int row0 = u.row0 + wr * 64 + fr, col0 = u.pn * 256 + wc * 32 + 8 * fq;
#pragma unroll
        for (int ai = 0; ai < 2; ++ai)
#pragma unroll
            for (int m = 0; m < 4; ++m) { const size_t r = (size_t)(row0 + ai * HALF + m * 16);
#pragma unroll
                for (int bj = 0; bj < 2; ++bj) { const int c = col0 + bj * HALF;
                    const u32x4 g = *(const u32x4*)(pg + r * 2048 + (SECOND ? 1024 : 0) + c);
                    f32x4 v0 = acc[ai][bj][m][0], v1 = acc[ai][bj][m][1];
                    v0[0] *= bflo(g.x); v0[1] *= bfhi(g.x); v0[2] *= bflo(g.y); v0[3] *= bfhi(g.y); v1[0] *= bflo(g.z); v1[1] *= bfhi(g.z); v1[2] *= bflo(g.w); v1[3] *= bfhi(g.w);
                    if (SECOND) { const u32x4 p = *(const u32x4*)(m1 + r * 1024 + c);
                        v0[0] += bflo(p.x); v0[1] += bfhi(p.x); v0[2] += bflo(p.y); v0[3] += bfhi(p.y); v1[0] += bflo(p.z); v1[1] += bfhi(p.z); v1[2] += bflo(p.w); v1[3] += bfhi(p.w); }
                    u32x4 w; w.x = pk2(v0[0], v0[1]); w.y = pk2(v0[2], v0[3]); w.z = pk2(v1[0], v1[1]); w.w = pk2(v1[2], v1[3]);
                    *(u32x4*)(m1 + r * 1024 + c) = w; } }
    }
};
struct EpiResid {
    static constexpr bool PERM = false;
    __device__ __forceinline__ void stage_rows(const Unit&, LAS unsigned char*, int) const {}
    float* out; const float* base; const float* gate;
    __device__ __forceinline__ void operator()(const Acc& acc, const Unit& u, int wr, int wc, int fr, int fq) const {
        const int row0 = u.row0 + wr * 64 + fr, col0 = u.pn * 256 + wc * 32 + 4 * fq;
        const float* gp = gate + (size_t)(u.row0 >> 13) * 6144 + col0;
        f32x4 gv[2][2];
#pragma unroll
        for (int bj = 0; bj < 2; ++bj)
#pragma unroll
            for (int n = 0; n < 2; ++n) gv[bj][n] = *(const f32x4*)(gp + bj * HALF + n * 16);
#pragma unroll
        for (int ai = 0; ai < 2; ++ai)
#pragma unroll
            for (int m = 0; m < 4; ++m) { const size_t ro = (size_t)(row0 + ai * HALF + m * 16) * 1024 + col0;
#pragma unroll
                for (int bj = 0; bj < 2; ++bj)
#pragma unroll
                    for (int n = 0; n < 2; ++n) { const f32x4 b = *(const f32x4*)(base + ro + bj * HALF + n * 16);
                        *(f32x4*)(out + ro + bj * HALF + n * 16) = b + gv[bj][n] * acc[ai][bj][m][n]; } }
    }
};
struct EpiRouter {
    static constexpr bool PERM = false;
    __device__ __forceinline__ void stage_rows(const Unit&, LAS unsigned char*, int) const {}
    float* sc;
    __device__ __forceinline__ void operator()(const Acc& acc, const Unit& u, int wr, int wc, int fr, int fq) const {
        const int row0 = u.row0 + wr * 64 + fr, col0 = wc * 32 + 4 * fq;
#pragma unroll
        for (int ai = 0; ai < 2; ++ai)
#pragma unroll
            for (int m = 0; m < 4; ++m) { float* rowp = sc + (size_t)(row0 + ai * HALF + m * 16) * 256 + col0;
#pragma unroll
                for (int bj = 0; bj < 2; ++bj)
#pragma unroll
                    for (int n = 0; n < 2; ++n) { f32x4 v = acc[ai][bj][m][n];
#pragma unroll
                        for (int j = 0; j < 4; ++j) v[j] = sigmoidf_(v[j]);
                        *(f32x4*)(rowp + bj * HALF + n * 16) = v; }
                __builtin_amdgcn_sched_barrier(0); }
    }
};
struct EpiGateUp {
    static constexpr bool PERM = true;
    __device__ __forceinline__ void stage_rows(const Unit&, LAS unsigned char*, int) const {}
    bf16_t* hid;
    __device__ __forceinline__ void operator()(const Acc& acc, const Unit& u, int wr, int wc, int fr, int fq) const {
        const int row0 = u.row0 + wr * 64 + fr, col0 = u.pn * HALF + wc * 32 + 8 * fq;
#pragma unroll
        for (int ai = 0; ai < 2; ++ai)
#pragma unroll
            for (int m = 0; m < 4; ++m) { bf16_t* rowp = hid + (size_t)(row0 + ai * HALF + m * 16) * EFF + col0;
                f32x4 v0, v1;
#pragma unroll
                for (int j = 0; j < 4; ++j) { v0[j] = siluf_(acc[ai][0][m][0][j]) * acc[ai][1][m][0][j]; v1[j] = siluf_(acc[ai][0][m][1][j]) * acc[ai][1][m][1][j]; }
                u32x4 w; w.x = pk2(v0[0], v0[1]); w.y = pk2(v0[2], v0[3]); w.z = pk2(v1[0], v1[1]); w.w = pk2(v1[2], v1[3]);
                *(u32x4*)rowp = w; __builtin_amdgcn_sched_barrier(0); }
    }
};
struct EpiExpertDown {
    static constexpr bool PERM = true;
    bf16_t* slot; const int* rowdst; const float* roww;
    __device__ __forceinline__ void stage_rows(const Unit& u, LAS unsigned char* lds, int wid) const {
        if (wid < 4) { const int lane = threadIdx.x & 63; LAS unsigned char* base = lds + LDS_MISC + u.par * 2048 + wid * 256;
            __builtin_amdgcn_global_load_lds((const unsigned*)(rowdst + u.row0 + wid * 64 + lane), (LAS unsigned*)base, 4, 0, 0);
            __builtin_amdgcn_global_load_lds((const unsigned*)(roww + u.row0 + wid * 64 + lane), (LAS unsigned*)(base + 1024), 4, 0, 0); }
    }
    __device__ __forceinline__ void operator()(const Acc& acc, const Unit& u, int wr, int wc, int fr, int fq) const {
        const unsigned cb = (unsigned)(u.pn * 256 + wc * 32 + 8 * fq) * 2u;
        const LAS int* td = (const LAS int*)((LAS unsigned char*)nullptr + LDS_MISC + u.par * 2048) + wr * 64 + fr; const LAS float* tw = (const LAS float*)(td + 256);
#pragma unroll
        for (int ai = 0; ai < 2; ++ai)
#pragma unroll
            for (int m = 0; m < 4; ++m) {
                const int dst = td[ai * HALF + m * 16]; const float ws_ = tw[ai * HALF + m * 16];
                if (dst >= 0) { unsigned char* rowp = (unsigned char*)slot + (size_t)((unsigned)dst * 2048u + cb);
#pragma unroll
                    for (int bj = 0; bj < 2; ++bj) { const f32x4 v0 = acc[ai][bj][m][0] * ws_, v1 = acc[ai][bj][m][1] * ws_;
                        u32x4 w; w.x = pk2(v0[0], v0[1]); w.y = pk2(v0[2], v0[3]); w.z = pk2(v1[0], v1[1]); w.w = pk2(v1[2], v1[3]);
                        *(u32x4*)(rowp + bj * HALF * 2) = w; } }
                __builtin_amdgcn_sched_barrier(0);
            }
    }
};
}
__device__ __forceinline__ void phase_mod(const float* c, const float* ada_w, const float* ada_b, float* mod, LAS unsigned char* lds, int tid, int G) {
    LAS float* sl = (LAS float*)lds; LAS float* red = (LAS float*)(lds + 32768);
    for (int i = tid; i < NB * D; i += NTHREADS) { const float v = c[i]; sl[i] = siluf_(v); }
    __syncthreads();
    const int cl = tid % 24, kg = tid / 24;
    for (int cb = blockIdx.x; cb < 256; cb += G) {
        const int col0 = cb * 24;
        if (tid < 384) {
            float a[NB];
#pragma unroll
            for (int b = 0; b < NB; ++b) a[b] = 0.f;
            for (int k = kg; k < D; k += 16) { const float w = ada_w[(size_t)k * 6144 + col0 + cl];
#pragma unroll
                for (int b = 0; b < NB; ++b) a[b] += sl[b * D + k] * w; }
#pragma unroll
            for (int b = 0; b < NB; ++b) red[(kg * 24 + cl) * NB + b] = a[b];
        }
        __syncthreads();
        if (tid < 192) { const int c2 = tid >> 3, b = tid & 7; float s = 0.f;
#pragma unroll
            for (int g = 0; g < 16; ++g) s += red[(g * 24 + c2) * NB + b];
            mod[(size_t)b * 6144 + col0 + c2] = s + ada_b[col0 + c2]; }
        __syncthreads();
    }
}
__device__ __forceinline__ void transpose_item(const float* W, int ldw, int k0, int n0, bf16_t* WT, int ldt, int drow0, LAS float* scr, int lane) {
#pragma unroll 8
    for (int i = 0; i < 32; ++i) { const int kk = 2 * i + (lane >> 5); scr[kk * 33 + (lane & 31)] = W[(size_t)(k0 + kk) * ldw + n0 + (lane & 31)]; }
    LDS_WAIT(); asm volatile("" ::: "memory");
    const int c = lane & 7;
#pragma unroll
    for (int j = 0; j < 4; ++j) { const int n = (lane >> 3) + 8 * j; const LAS float* s = scr + (8 * c) * 33 + n;
        u32x4 o; o.x = pk2(s[0 * 33], s[1 * 33]); o.y = pk2(s[2 * 33], s[3 * 33]); o.z = pk2(s[4 * 33], s[5 * 33]); o.w = pk2(s[6 * 33], s[7 * 33]);
        *(u32x4*)(WT + (size_t)(drow0 + n) * ldt + k0 + 8 * c) = o; }
    LDS_WAIT(); asm volatile("" ::: "memory");
}
__device__ __forceinline__ void transpose_job(const float* W, int K, int N, bf16_t* WT, int gated, int goff, int item, LAS float* scr, int lane) {
    const int nblk = N / 32, kb = item / nblk, nb = item % nblk, n0 = 32 * nb;
    const int drow0 = gated ? (256 * (n0 >> 7) + goff + (n0 & 127)) : n0;
    transpose_item(W, N, 64 * kb, n0, WT, K, drow0, scr, lane);
}
struct SmallW { const float *w_in, *w_out_a, *w_out_b, *w_out, *router_w, *sw1, *sw3, *sw2, *w_up, *a_up, *g_up, *gws; };
__device__ __forceinline__ void phase_small_weights(const SmallW& P, unsigned char* ws, LAS unsigned char* lds, int gw, int NGW, int wave, int lane) {
    LAS float* scr = (LAS float*)(lds + 49152 + wave * 8704);
    constexpr int I0 = 16 * 152, I1 = 8 * 32, I2 = 8 * 32, I3 = 16 * 32, I4 = 16 * 8, I5 = 16 * 8, I6 = 16 * 8, I7 = 4 * 32, I8 = 16, I9 = 16, I10 = 2 * 16;
    constexpr int NIT = I0 + I1 + I2 + I3 + I4 + I5 + I6 + I7 + I8 + I9 + I10;
    for (int it = gw; it < NIT; it += NGW) {
        int r = it;
        if (r < I0) { transpose_job(P.w_in, D, IN_COLS, (bf16_t*)(ws + SW_WIN), 0, 0, r, scr, lane); continue; } r -= I0;
        if (r < I1) { transpose_job(P.w_out_a, RW, D, (bf16_t*)(ws + SW_WOA), 0, 0, r, scr, lane); continue; } r -= I1;
        if (r < I2) { transpose_job(P.w_out_b, RW, D, (bf16_t*)(ws + SW_WOB), 0, 0, r, scr, lane); continue; } r -= I2;
        if (r < I3) { transpose_job(P.w_out, D, D, (bf16_t*)(ws + SW_WO), 0, 0, r, scr, lane); continue; } r -= I3;
        if (r < I4) { transpose_job(P.router_w, D, NE, (bf16_t*)(ws + SW_WR), 0, 0, r, scr, lane); continue; } r -= I4;
        if (r < I5) { transpose_job(P.sw1, D, EFF, (bf16_t*)(ws + SW_WS13), 1, 0, r, scr, lane); continue; } r -= I5;
        if (r < I6) { transpose_job(P.sw3, D, EFF, (bf16_t*)(ws + SW_WS13), 1, 128, r, scr, lane); continue; } r -= I6;
        if (r < I7) { transpose_job(P.sw2, EFF, D, (bf16_t*)(ws + SW_WS2), 0, 0, r, scr, lane); continue; } r -= I7;
        if (r < I8) { transpose_job(P.w_up, 64, RW, (bf16_t*)(ws + SW_WUP), 0, 0, r, scr, lane); continue; } r -= I8;
        if (r < I9) { transpose_job(P.a_up, 64, RW, (bf16_t*)(ws + SW_AUP), 0, 0, r, scr, lane); continue; } r -= I9;
        transpose_job(P.g_up, 128, RW, (bf16_t*)(ws + SW_GUP), 0, 0, r, scr, lane);
    }
    bf16_t* wsm = (bf16_t*)(ws + SW_WSM);
    for (int i = gw * 64 + lane; i < 8 * 128 * 128; i += NGW * 64) { const int col = i & 127, row = (i >> 7) & 127; wsm[i] = (col <= row) ? f2bf(P.gws[i]) : (bf16_t)0; }
}
__device__ __forceinline__ void transpose_item64(const float* W, int ldw, int k0, int n0, bf16_t* WT, int ldt, int drow0, LAS float* scr, int lane) {
    f32x4 v[16];
    const int c4 = lane & 15, r4 = lane >> 4;
#pragma unroll
    for (int i = 0; i < 16; ++i) v[i] = *(const f32x4*)(W + (size_t)(k0 + 4 * i + r4) * ldw + n0 + 4 * c4);
#pragma unroll
    for (int i = 0; i < 16; ++i) { LAS float* d = scr + (4 * i + r4) * 65 + 4 * c4; d[0] = v[i].x; d[1] = v[i].y; d[2] = v[i].z; d[3] = v[i].w; }
    LDS_WAIT(); asm volatile("" ::: "memory");
    const int c = lane & 7;
#pragma unroll
    for (int j = 0; j < 8; ++j) { const int n = (lane >> 3) + 8 * j; const LAS float* s = scr + (8 * c) * 65 + n;
        u32x4 o; o.x = pk2(s[0 * 65], s[1 * 65]); o.y = pk2(s[2 * 65], s[3 * 65]); o.z = pk2(s[4 * 65], s[5 * 65]); o.w = pk2(s[6 * 65], s[7 * 65]);
        *(u32x4*)(WT + (size_t)(drow0 + n) * ldt + k0 + 8 * c) = o; }
    LDS_WAIT(); asm volatile("" ::: "memory");
}
__device__ __forceinline__ void phase_expert_weights(const float* w1, const float* w3, const float* w2, unsigned char* ws, LAS unsigned char* lds, int gw, int NGW, int wave, int lane) {
    LAS float* scr = (LAS float*)(lds + wave * 16640);
    constexpr int PER = 64;
    for (int it = gw; it < NE * 3 * PER; it += NGW) {
        const int e = it / (3 * PER), r = it % (3 * PER), which = r / PER, item = r % PER;
        if (which < 2) { const int kb = item >> 2, nb = item & 3, n0 = 64 * nb;
            transpose_item64((which ? w3 : w1) + (size_t)e * D * EFF, EFF, 64 * kb, n0, (bf16_t*)(ws + B_W13) + (size_t)e * 512 * D, D, 256 * (n0 >> 7) + which * 128 + (n0 & 127), scr, lane); }
        else { const int kb = item >> 4, nb = item & 15;
            transpose_item64(w2 + (size_t)e * EFF * D, D, 64 * kb, 64 * nb, (bf16_t*)(ws + B_W2) + (size_t)e * D * EFF, EFF, 64 * nb, scr, lane); }
    }
}
__device__ __forceinline__ void phase_norm_mod(const float* X, const float* gain, const float* mod, int sh_off, int sc_off, bf16_t* out, int gw, int NGW, int lane) {
    constexpr int R = 4;
    for (int m0 = gw; m0 < T; m0 += R * NGW) {
        f32x4 v[R][4];
#pragma unroll
        for (int rr = 0; rr < R; ++rr) { const int m = m0 + rr * NGW; const f32x4* xr = (const f32x4*)(X + (size_t)(m < T ? m : m0) * D) + lane;
#pragma unroll
            for (int j = 0; j < 4; ++j) v[rr][j] = xr[64 * j]; }
#pragma unroll
        for (int rr = 0; rr < R; ++rr) { const int m = m0 + rr * NGW; if (m >= T) break;
            float ss = 0.f;
#pragma unroll
            for (int j = 0; j < 4; ++j) ss += (v[rr][j].x * v[rr][j].x + v[rr][j].y * v[rr][j].y) + (v[rr][j].z * v[rr][j].z + v[rr][j].w * v[rr][j].w);
            const float rstd = __builtin_amdgcn_rsqf(wave_sum(ss) * (1.f / D) + 1e-6f);
            const float* mb = mod + (size_t)(m >> 13) * 6144;
            u32x2* o8 = (u32x2*)(out + (size_t)m * D) + lane;
#pragma unroll
            for (int j = 0; j < 4; ++j) { const int col = 4 * lane + 256 * j;
                const f32x4 g = *(const f32x4*)(gain + col), sc = *(const f32x4*)(mb + sc_off + col), sh = *(const f32x4*)(mb + sh_off + col);
                const f32x4 y = v[rr][j] * rstd * g * (sc + 1.0f) + sh;
                u32x2 w; w.x = pk2(y.x, y.y); w.y = pk2(y.z, y.w); o8[64 * j] = w; } }
    }
}
struct YaArgs { bf16_t* ya; const bf16_t* g; const bf16_t* prw; const float* sbon; const float* mu; const float* ln_g; const float* ln_b; };
__device__ __forceinline__ void phase_ya_final(const YaArgs& P, int gw, int NGW, int lane) {
    const int ch0 = lane * 8, head = lane >> 3;
    float muv[8], lg[8], lb[8];
#pragma unroll
    for (int j = 0; j < 8; ++j) { muv[j] = P.mu[1024 + ch0 + j]; lg[j] = P.ln_g[ch0 + j]; lb[j] = P.ln_b[ch0 + j]; }
    for (int m = gw; m < T; m += NGW) {
        const u32x4 yw = *(const u32x4*)(P.ya + (size_t)m * RW + ch0);
        const u32x4 gw4 = *(const u32x4*)(P.g + (size_t)m * RW + ch0);
        const u32x4 vc = *(const u32x4*)(P.prw + (size_t)m * RWKV_COLS + 1024 + ch0);
        u32x4 vp = (u32x4){0u, 0u, 0u, 0u};
        if ((m & (SEQ - 1)) != 0) vp = *(const u32x4*)(P.prw + (size_t)(m - 1) * RWKV_COLS + 1024 + ch0);
        const float sb = P.sbon[(size_t)m * NH + head];
        float y[8], gg[8], vv[8], pv[8];
        y[0] = bflo(yw.x); y[1] = bfhi(yw.x); y[2] = bflo(yw.y); y[3] = bfhi(yw.y); y[4] = bflo(yw.z); y[5] = bfhi(yw.z); y[6] = bflo(yw.w); y[7] = bfhi(yw.w);
        gg[0] = bflo(gw4.x); gg[1] = bfhi(gw4.x); gg[2] = bflo(gw4.y); gg[3] = bfhi(gw4.y); gg[4] = bflo(gw4.z); gg[5] = bfhi(gw4.z); gg[6] = bflo(gw4.w); gg[7] = bfhi(gw4.w);
        vv[0] = bflo(vc.x); vv[1] = bfhi(vc.x); vv[2] = bflo(vc.y); vv[3] = bfhi(vc.y); vv[4] = bflo(vc.z); vv[5] = bfhi(vc.z); vv[6] = bflo(vc.w); vv[7] = bfhi(vc.w);
        pv[0] = bflo(vp.x); pv[1] = bfhi(vp.x); pv[2] = bflo(vp.y); pv[3] = bfhi(vp.y); pv[4] = bflo(vp.z); pv[5] = bfhi(vp.z); pv[6] = bflo(vp.w); pv[7] = bfhi(vp.w);
        float s = 0.f;
#pragma unroll
        for (int j = 0; j < 8; ++j) s += y[j];
        s += __shfl_xor(s, 1); s += __shfl_xor(s, 2); s += __shfl_xor(s, 4);
        const float mean = s * (1.f / 64.f); float q = 0.f;
#pragma unroll
        for (int j = 0; j < 8; ++j) { y[j] -= mean; q += y[j] * y[j]; }
        q += __shfl_xor(q, 1); q += __shfl_xor(q, 2); q += __shfl_xor(q, 4);
        const float rstd = __builtin_amdgcn_rsqf(q * (1.f / 64.f) + 64e-5f);
        float o[8];
#pragma unroll
        for (int j = 0; j < 8; ++j) { const float vs = vv[j] + (pv[j] - vv[j]) * muv[j]; o[j] = (y[j] * rstd * lg[j] + lb[j] + sb * vs) * gg[j]; }
        u32x4 w; w.x = pk2(o[0], o[1]); w.y = pk2(o[2], o[3]); w.z = pk2(o[4], o[5]); w.w = pk2(o[6], o[7]);
        *(u32x4*)(P.ya + (size_t)m * RW + ch0) = w;
    }
}
__device__ __forceinline__ void phase_combine(float* out, const bf16_t* slot, const float* mod, const float* normf, int half, int gw, int NGW, int lane) {
    for (int tl = gw; tl < HALF_T; tl += NGW) {
        const int m = half * HALF_T + tl, b = m >> 13;
        f32x4* xr = (f32x4*)(out + (size_t)m * D) + lane;
        const float* g2 = mod + (size_t)b * 6144 + 5120;
        f32x4 a[4];
#pragma unroll
        for (int j = 0; j < 4; ++j) a[j] = (f32x4){0.f, 0.f, 0.f, 0.f};
#pragma unroll
        for (int k = 0; k < TOPK; ++k) { const u32x2* sr = (const u32x2*)(slot + ((size_t)tl * TOPK + k) * D) + lane;
#pragma unroll
            for (int j = 0; j < 4; ++j) { const u32x2 w = sr[64 * j]; a[j].x += bflo(w.x); a[j].y += bfhi(w.x); a[j].z += bflo(w.y); a[j].w += bfhi(w.y); } }
        f32x4 v[4]; float ss = 0.f;
#pragma unroll
        for (int j = 0; j < 4; ++j) { const int col = 4 * lane + 256 * j; v[j] = xr[64 * j] + *(const f32x4*)(g2 + col) * a[j]; ss += (v[j].x * v[j].x + v[j].y * v[j].y) + (v[j].z * v[j].z + v[j].w * v[j].w); }
        const float rstd = __builtin_amdgcn_rsqf(wave_sum(ss) * (1.f / D) + 1e-6f);
#pragma unroll
        for (int j = 0; j < 4; ++j) { const int col = 4 * lane + 256 * j; xr[64 * j] = v[j] * rstd * *(const f32x4*)(normf + col); }
    }
}
namespace rk {
constexpr int LD = 72;
constexpr int SLOTB = 64 * LD * 2;
constexpr int LDG = 136;
typedef LAS bf16_t* lp;
__device__ __forceinline__ lp slot(LAS unsigned char* lds, int i) { return (lp)(lds + i * SLOTB); }
template <int KS>
__device__ __forceinline__ void mm_nt(const LAS bf16_t* X, int ldx, const LAS bf16_t* Y, int ldy, int m, int nt0, int r, int q, f32x4 (&acc)[2]) {
#pragma unroll
    for (int s = 0; s < KS; ++s) {
        const bf16x8 a = *(const LAS bf16x8*)(X + (16 * m + r) * ldx + 32 * s + 8 * q);
#pragma unroll
        for (int n = 0; n < 2; ++n) { const bf16x8 b = *(const LAS bf16x8*)(Y + (16 * (nt0 + n) + r) * ldy + 32 * s + 8 * q); acc[n] = __builtin_amdgcn_mfma_f32_16x16x32_bf16(a, b, acc[n], 0, 0, 0); }
    }
}
__device__ __forceinline__ void st_rm(lp dst, int m, int nt, int r, int q, const f32x4& a) {
#pragma unroll
    for (int ii = 0; ii < 4; ++ii) dst[(16 * m + 4 * q + ii) * LD + 16 * nt + r] = f2bf(a[ii]);
}
__device__ __forceinline__ void st_tr(lp dst, int m, int nt, int r, int q, const f32x4& a) {
    u32x2 w; w.x = pk2(a[0], a[1]); w.y = pk2(a[2], a[3]); *(LAS u32x2*)(dst + (16 * nt + r) * LD + 16 * m + 4 * q) = w;
}
__device__ __forceinline__ void ld_rm(const LAS bf16_t* src, int m, int nt, int r, int q, f32x4& a) {
#pragma unroll
    for (int ii = 0; ii < 4; ++ii) a[ii] = bf2f(src[(16 * m + 4 * q + ii) * LD + 16 * nt + r]);
}
struct Args {
    const bf16_t* prw; const float* mu; const float *w0, *a0, *k_k, *k_a, *r_k;
    const bf16_t *wup, *aup, *gup;
    bf16_t* g; bf16_t* bv; unsigned char* mn; unsigned char* qy;
};
constexpr int LDS_MU = 155904;
struct Pre { u32x4 cw[7], pw[7]; };
__device__ __forceinline__ void task_map(int task, int h, int& i, int& ch, int& col) {
    i = task / 56; ch = task % 56;
    if (ch < 8) col = h * 64 + 8 * ch; else if (ch < 16) col = 512 + h * 64 + 8 * (ch - 8); else if (ch < 24) col = 1024 + h * 64 + 8 * (ch - 16);
    else if (ch < 32) col = 1536 + 8 * (ch - 24); else if (ch < 40) col = 1600 + 8 * (ch - 32); else col = 1664 + 8 * (ch - 40);
}
__device__ __forceinline__ void load_mu(const Args& P, LAS unsigned char* lds, int tid) {
    LAS float* MU = (LAS float*)(lds + LDS_MU);
    for (int i = tid; i < RWKV_COLS; i += NTHREADS) MU[i] = P.mu[i];
    __syncthreads();
}
__device__ __forceinline__ void prefetch(const Args& P, int b, int h, int c, int tid, Pre& pre) {
    const int t0 = b * SEQ + c * 64;
#pragma unroll
    for (int it = 0; it < 7; ++it) {
        int i, ch, col; task_map(tid + it * NTHREADS, h, i, ch, col);
        const bf16_t* src = P.prw + (size_t)(t0 + i) * RWKV_COLS + col;
        pre.cw[it] = *(const u32x4*)src;
        pre.pw[it] = (u32x4){0u, 0u, 0u, 0u};
        if (i != 0 || c != 0) pre.pw[it] = *(const u32x4*)(src - RWKV_COLS);
    }
}
__device__ __forceinline__ void unit(const Args& P, LAS unsigned char* lds, int b, int h, int c, int uidx, int tid, Pre& pf, bool has_next, int nb, int nh_, int nc) {
    const int wave = __builtin_amdgcn_readfirstlane(tid >> 6), lane = tid & 63, r = lane & 15, q = lane >> 4, m = wave & 3, nh = wave >> 2;
    const int t0 = b * SEQ + c * 64;
    lp S0 = slot(lds, 0), S1 = slot(lds, 1), S2 = slot(lds, 2), S3 = slot(lds, 3), S4 = slot(lds, 4), S5 = slot(lds, 5), S6 = slot(lds, 6), S7 = slot(lds, 7);
    lp S8 = slot(lds, 8), S9 = slot(lds, 9), S10 = slot(lds, 10), S11 = slot(lds, 11), S12 = slot(lds, 12), S13 = slot(lds, 13), S14 = slot(lds, 14), S15 = slot(lds, 15);
    LAS float* PART = (LAS float*)(lds + LDS_MISC);
    LAS float* CT = PART + 256;
    LAS float* DEND = CT + 256;
    const LAS float* MU = (const LAS float*)(lds + LDS_MU);
#define RK_DBG(bit, sp) do {} while (0)
#pragma unroll
    for (int it = 0; it < 7; ++it) {
        int i, ch, col; task_map(tid + it * NTHREADS, h, i, ch, col);
        LAS bf16_t* dst; int act = 0;
        if (ch < 8) dst = S8 + i * LD + 8 * ch; else if (ch < 16) dst = S9 + i * LD + 8 * (ch - 8); else if (ch < 24) dst = S10 + i * LD + 8 * (ch - 16);
        else if (ch < 32) { dst = S11 + i * LD + 8 * (ch - 24); act = 1; } else if (ch < 40) dst = S12 + i * LD + 8 * (ch - 32); else { dst = S13 + i * LDG + 8 * (ch - 40); act = 2; }
        const u32x4 cw = pf.cw[it], pw = pf.pw[it];
        const f32x4 m0 = *(const LAS f32x4*)(MU + col), m1 = *(const LAS f32x4*)(MU + col + 4);
        float v[8], p[8];
        v[0] = bflo(cw.x); v[1] = bfhi(cw.x); v[2] = bflo(cw.y); v[3] = bfhi(cw.y); v[4] = bflo(cw.z); v[5] = bfhi(cw.z); v[6] = bflo(cw.w); v[7] = bfhi(cw.w);
        p[0] = bflo(pw.x); p[1] = bfhi(pw.x); p[2] = bflo(pw.y); p[3] = bfhi(pw.y); p[4] = bflo(pw.z); p[5] = bfhi(pw.z); p[6] = bflo(pw.w); p[7] = bfhi(pw.w);
#pragma unroll
        for (int j = 0; j < 4; ++j) { v[j] += (p[j] - v[j]) * m0[j]; v[4 + j] += (p[4 + j] - v[4 + j]) * m1[j]; }
        if (act == 1) {
#pragma unroll
            for (int j = 0; j < 8; ++j) v[j] = tanhf_(v[j]); }
        else if (act == 2) {
#pragma unroll
            for (int j = 0; j < 8; ++j) v[j] = sigmoidf_(v[j]); }
        u32x4 w; w.x = pk2(v[0], v[1]); w.y = pk2(v[2], v[3]); w.z = pk2(v[4], v[5]); w.w = pk2(v[6], v[7]);
        *(LAS u32x4*)dst = w;
    }
    if (has_next) prefetch(P, nb, nh_, nc, tid, pf);
    __syncthreads();
    f32x4 aw[2], aa[2], ag[2];
#pragma unroll
    for (int n = 0; n < 2; ++n) { aw[n] = (f32x4){0.f, 0.f, 0.f, 0.f}; aa[n] = aw[n]; ag[n] = aw[n]; }
#pragma unroll
    for (int s = 0; s < 2; ++s) {
        const bf16x8 xw = *(const LAS bf16x8*)(S11 + (16 * m + r) * LD + 32 * s + 8 * q), xa = *(const LAS bf16x8*)(S12 + (16 * m + r) * LD + 32 * s + 8 * q);
#pragma unroll
        for (int n = 0; n < 2; ++n) { const int row = h * 64 + 16 * (2 * nh + n) + r;
            const bf16x8 bw = *(const bf16x8*)(P.wup + (size_t)row * 64 + 32 * s + 8 * q), ba = *(const bf16x8*)(P.aup + (size_t)row * 64 + 32 * s + 8 * q);
            aw[n] = __builtin_amdgcn_mfma_f32_16x16x32_bf16(xw, bw, aw[n], 0, 0, 0); aa[n] = __builtin_amdgcn_mfma_f32_16x16x32_bf16(xa, ba, aa[n], 0, 0, 0); }
    }
#pragma unroll
    for (int s = 0; s < 4; ++s) {
        const bf16x8 xg = *(const LAS bf16x8*)(S13 + (16 * m + r) * LDG + 32 * s + 8 * q);
#pragma unroll
        for (int n = 0; n < 2; ++n) { const int row = h * 64 + 16 * (2 * nh + n) + r;
            const bf16x8 bg = *(const bf16x8*)(P.gup + (size_t)row * 128 + 32 * s + 8 * q);
            ag[n] = __builtin_amdgcn_mfma_f32_16x16x32_bf16(xg, bg, ag[n], 0, 0, 0); }
    }
    float rr[2][4], kq[2][4], vv[2][4], av[2][4], lw[2][4], kp[2][4], pre[2][4], preq[2];
    float ss[4] = {0.f, 0.f, 0.f, 0.f}, bs[4] = {0.f, 0.f, 0.f, 0.f};
#pragma unroll
    for (int n = 0; n < 2; ++n) {
        const int ch = 32 * nh + 16 * n + r, chg = h * 64 + ch;
        const float w0v = P.w0[chg], a0v = P.a0[chg], kkc = P.k_k[chg], kac = P.k_a[chg], rkc = P.r_k[chg];
#pragma unroll
        for (int ii = 0; ii < 4; ++ii) {
            const int pos = 16 * m + 4 * q + ii;
            const float rv = bf2f(S8[pos * LD + ch]), kraw = bf2f(S9[pos * LD + ch]); vv[n][ii] = bf2f(S10[pos * LD + ch]); rr[n][ii] = rv;
            const float z = -(w0v + aw[n][ii]);
            const float sp = fmaxf(z, 0.f) + flog(1.0f + fexp(-fabsf(z)));
            lw[n][ii] = -fexp(-sp - 0.5f);
            const float a_ = sigmoidf_(a0v + aa[n][ii]); av[n][ii] = a_;
            P.g[(size_t)(t0 + pos) * RW + chg] = f2bf(ag[n][ii]);
            const float kk = kraw * kkc; kq[n][ii] = kk;
            const float kpv = kraw * (1.0f + (a_ - 1.0f) * kac); kp[n][ii] = kpv;
            ss[ii] += kk * kk; bs[ii] += rv * kpv * rkc;
        }
        pre[n][0] = lw[n][0]; pre[n][1] = pre[n][0] + lw[n][1]; pre[n][2] = pre[n][1] + lw[n][2]; pre[n][3] = pre[n][2] + lw[n][3];
        const float tot = pre[n][3];
        const float t0_ = __shfl(tot, r), t1_ = __shfl(tot, r + 16), t2_ = __shfl(tot, r + 32), t3_ = __shfl(tot, r + 48);
        preq[n] = (q > 0 ? t0_ : 0.f) + (q > 1 ? t1_ : 0.f) + (q > 2 ? t2_ : 0.f);
        if (q == 0) CT[m * 64 + ch] = (t0_ + t1_) + (t2_ + t3_);
    }
#pragma unroll
    for (int ii = 0; ii < 4; ++ii) {
#pragma unroll
        for (int o = 1; o < 16; o <<= 1) { ss[ii] += __shfl_xor(ss[ii], o); bs[ii] += __shfl_xor(bs[ii], o); }
        if (r == 0) { const int pos = 16 * m + 4 * q + ii; PART[(nh * 64 + pos) * 2] = ss[ii]; PART[(nh * 64 + pos) * 2 + 1] = bs[ii]; }
    }
    __syncthreads();
#pragma unroll
    for (int n = 0; n < 2; ++n) {
        const int ch = 32 * nh + 16 * n + r;
        float carry = 0.f, lend = 0.f;
#pragma unroll
        for (int mm = 0; mm < 4; ++mm) { const float cv = CT[mm * 64 + ch]; lend += cv; carry += (mm < m) ? cv : 0.f; }
        f32x4 tA, tBh, tKh, tV;
#pragma unroll
        for (int ii = 0; ii < 4; ++ii) {
            const int pos = 16 * m + 4 * q + ii;
            const float L = carry + preq[n] + pre[n][ii], Lm1 = L - lw[n][ii];
            const float ssum = PART[pos * 2] + PART[(64 + pos) * 2];
            const float inv = frcp(fmaxf(__builtin_sqrtf(ssum), 1e-12f));
            const float kkn = kq[n][ii] * inv, kb = kkn * av[n][ii];
            const float eN = fexp(-L), eE = fexp(lend - L);
            const float At = -kkn * fexp(Lm1), Rt = rr[n][ii] * fexp(L), Bt = kb * eN, Kt = kp[n][ii] * eN;
            S0[pos * LD + ch] = f2bf(At); S1[pos * LD + ch] = f2bf(Bt); S2[pos * LD + ch] = f2bf(Kt); S3[pos * LD + ch] = f2bf(Rt);
            tA[ii] = At; tBh[ii] = kb * eE; tKh[ii] = kp[n][ii] * eE; tV[ii] = vv[n][ii];
            P.bv[(size_t)(t0 + pos) * RW + h * 64 + ch] = f2bf((PART[pos * 2 + 1] + PART[(64 + pos) * 2 + 1]) * vv[n][ii]);
        }
        { u32x2 w; const int off = ch * LD + 16 * m + 4 * q;
          w.x = pk2(tA[0], tA[1]); w.y = pk2(tA[2], tA[3]); *(LAS u32x2*)(S4 + off) = w;
          w.x = pk2(tBh[0], tBh[1]); w.y = pk2(tBh[2], tBh[3]); *(LAS u32x2*)(S5 + off) = w;
          w.x = pk2(tKh[0], tKh[1]); w.y = pk2(tKh[2], tKh[3]); *(LAS u32x2*)(S6 + off) = w;
          w.x = pk2(tV[0], tV[1]); w.y = pk2(tV[2], tV[3]); *(LAS u32x2*)(S7 + off) = w; }
        if (m == 0 && q == 0) DEND[ch] = fexp(lend);
    }
    __syncthreads();
    RK_DBG(0, S0); RK_DBG(1, S1); RK_DBG(2, S2); RK_DBG(3, S3); RK_DBG(4, S4); RK_DBG(5, S5); RK_DBG(6, S6); RK_DBG(7, S7);
    const int nt0 = 2 * nh;
    f32x4 acc[2], acc2[2];
#define RK_ZERO(a) do { a[0] = (f32x4){0.f, 0.f, 0.f, 0.f}; a[1] = a[0]; } while (0)
    RK_ZERO(acc); mm_nt<2>(S0, LD, S1, LD, m, nt0, r, q, acc);
#pragma unroll
    for (int n = 0; n < 2; ++n) { f32x4 t;
#pragma unroll
        for (int ii = 0; ii < 4; ++ii) { const int row = 16 * m + 4 * q + ii, col = 16 * (nt0 + n) + r; acc[n][ii] = (col < row) ? acc[n][ii] : 0.f; t[ii] = acc[n][ii] + ((col == row) ? 1.f : 0.f); }
        st_rm(S8, m, nt0 + n, r, q, acc[n]); st_tr(S9, m, nt0 + n, r, q, acc[n]); st_rm(S10, m, nt0 + n, r, q, t); }
    RK_ZERO(acc); mm_nt<2>(S0, LD, S2, LD, m, nt0, r, q, acc);
#pragma unroll
    for (int n = 0; n < 2; ++n) {
#pragma unroll
        for (int ii = 0; ii < 4; ++ii) { const int row = 16 * m + 4 * q + ii, col = 16 * (nt0 + n) + r; acc[n][ii] = (col < row) ? acc[n][ii] : 0.f; }
        st_rm(S11, m, nt0 + n, r, q, acc[n]); }
    RK_ZERO(acc); mm_nt<2>(S3, LD, S1, LD, m, nt0, r, q, acc);
#pragma unroll
    for (int n = 0; n < 2; ++n) {
#pragma unroll
        for (int ii = 0; ii < 4; ++ii) { const int row = 16 * m + 4 * q + ii, col = 16 * (nt0 + n) + r; acc[n][ii] = (col <= row) ? acc[n][ii] : 0.f; }
        st_rm(S12, m, nt0 + n, r, q, acc[n]); }
    RK_ZERO(acc); mm_nt<2>(S3, LD, S2, LD, m, nt0, r, q, acc);
#pragma unroll
    for (int n = 0; n < 2; ++n) {
#pragma unroll
        for (int ii = 0; ii < 4; ++ii) { const int row = 16 * m + 4 * q + ii, col = 16 * (nt0 + n) + r; acc[n][ii] = (col <= row) ? acc[n][ii] : 0.f; }
        st_rm(S13, m, nt0 + n, r, q, acc[n]); }
    __syncthreads();
    RK_DBG(8, S8); RK_DBG(9, S10); RK_DBG(10, S11); RK_DBG(11, S12); RK_DBG(12, S13);
    RK_ZERO(acc); mm_nt<2>(S8, LD, S9, LD, m, nt0, r, q, acc);
    RK_ZERO(acc2); mm_nt<2>(S7, LD, S11, LD, m, nt0, r, q, acc2);
#pragma unroll
    for (int n = 0; n < 2; ++n) { st_rm(S0, m, nt0 + n, r, q, acc[n]); st_tr(S1, m, nt0 + n, r, q, acc[n]); st_rm(S14, m, nt0 + n, r, q, acc2[n]); }
    __syncthreads();
    RK_DBG(13, S14);
#define RK_ROUND(Tsrc, Tdst, Psrc, PTsrc, Pdst, PTdst) do { \
        ld_rm(Tsrc, m, nt0, r, q, acc[0]); ld_rm(Tsrc, m, nt0 + 1, r, q, acc[1]); mm_nt<2>(Tsrc, LD, PTsrc, LD, m, nt0, r, q, acc); \
        RK_ZERO(acc2); mm_nt<2>(Psrc, LD, PTsrc, LD, m, nt0, r, q, acc2); \
        _Pragma("unroll") for (int n = 0; n < 2; ++n) { st_rm(Tdst, m, nt0 + n, r, q, acc[n]); st_rm(Pdst, m, nt0 + n, r, q, acc2[n]); st_tr(PTdst, m, nt0 + n, r, q, acc2[n]); } \
        __syncthreads(); } while (0)
    RK_ROUND(S10, S2, S0, S1, S8, S9);
    RK_ROUND(S2, S10, S8, S9, S0, S1);
    RK_ROUND(S10, S2, S0, S1, S8, S9);
    RK_ROUND(S2, S10, S8, S9, S0, S1);
    ld_rm(S10, m, nt0, r, q, acc[0]); ld_rm(S10, m, nt0 + 1, r, q, acc[1]); mm_nt<2>(S10, LD, S1, LD, m, nt0, r, q, acc);
#pragma unroll
    for (int n = 0; n < 2; ++n) st_rm(S2, m, nt0 + n, r, q, acc[n]);
    __syncthreads();
    RK_DBG(14, S2);
    RK_ZERO(acc); mm_nt<2>(S4, LD, S2, LD, m, nt0, r, q, acc);
    RK_ZERO(acc2); mm_nt<2>(S14, LD, S2, LD, m, nt0, r, q, acc2);
#pragma unroll
    for (int n = 0; n < 2; ++n) { st_rm(S11, m, nt0 + n, r, q, acc[n]); st_rm(S15, m, nt0 + n, r, q, acc2[n]); }
    __syncthreads();
    RK_DBG(15, S11); RK_DBG(16, S15);
    {
        const int sw = wave & 1, ntw = wave >> 1;
        unsigned char* mn_ = P.mn + (size_t)uidx * 16384; unsigned char* qy_ = P.qy + (size_t)uidx * 16384;
        f32x4 c2[2];
#define RK_MM2(X, Y) do { _Pragma("unroll") for (int s_ = 0; s_ < 2; ++s_) { const bf16x8 b_ = *(const LAS bf16x8*)((Y) + (16 * ntw + r) * LD + 32 * s_ + 8 * q); \
            _Pragma("unroll") for (int mi = 0; mi < 2; ++mi) { const bf16x8 a_ = *(const LAS bf16x8*)((X) + (16 * (2 * sw + mi) + r) * LD + 32 * s_ + 8 * q); c2[mi] = __builtin_amdgcn_mfma_f32_16x16x32_bf16(a_, b_, c2[mi], 0, 0, 0); } } } while (0)
        RK_ZERO(c2); RK_MM2(S11, S5);
#pragma unroll
        for (int mi = 0; mi < 2; ++mi)
#pragma unroll
            for (int ii = 0; ii < 4; ++ii) { const int row = 16 * (2 * sw + mi) + 4 * q + ii, col = 16 * ntw + r; c2[mi][ii] += (row == col) ? DEND[row] : 0.f; }
        { u32x4 w; w.x = pk2(c2[0][0], c2[0][1]); w.y = pk2(c2[0][2], c2[0][3]); w.z = pk2(c2[1][0], c2[1][1]); w.w = pk2(c2[1][2], c2[1][3]); *(u32x4*)(mn_ + ((ntw * 2 + sw) * 64 + lane) * 16) = w; }
#pragma unroll
        for (int mi = 0; mi < 2; ++mi) { const u32x2 rw_ = *(const LAS u32x2*)(S3 + (16 * ntw + r) * LD + 16 * (2 * sw + mi) + 4 * q); c2[mi] = (f32x4){bflo(rw_.x), bfhi(rw_.x), bflo(rw_.y), bfhi(rw_.y)}; }
        RK_MM2(S11, S12);
        { u32x4 w; w.x = pk2(c2[0][0], c2[0][1]); w.y = pk2(c2[0][2], c2[0][3]); w.z = pk2(c2[1][0], c2[1][1]); w.w = pk2(c2[1][2], c2[1][3]); *(u32x4*)(qy_ + ((ntw * 2 + sw) * 64 + lane) * 16) = w; }
        RK_ZERO(c2); RK_MM2(S5, S15); RK_MM2(S6, S7);
#pragma unroll
        for (int mi = 0; mi < 2; ++mi) { u32x2 w; w.x = pk2(c2[mi][0], c2[mi][1]); w.y = pk2(c2[mi][2], c2[mi][3]); *(u32x2*)(mn_ + 8192 + ((ntw * 4 + 2 * sw + mi) * 64 + lane) * 8) = w; }
        RK_ZERO(c2); RK_MM2(S15, S12); RK_MM2(S7, S13);
#pragma unroll
        for (int mi = 0; mi < 2; ++mi) { u32x2 w; w.x = pk2(c2[mi][0], c2[mi][1]); w.y = pk2(c2[mi][2], c2[mi][3]); *(u32x2*)(qy_ + 8192 + (((2 * sw + mi) * 4 + ntw) * 64 + lane) * 8) = w; }
#undef RK_MM2
    }
    __syncthreads();
#undef RK_ZERO
#undef RK_ROUND
}
__device__ __forceinline__ void scan_wg(const unsigned char* mn, unsigned char* sbuf, int ubase, int vq, LAS unsigned char* lds, int tid) {
    const int wave = __builtin_amdgcn_readfirstlane(tid >> 6), lane = tid & 63;
    constexpr int NC = SEQ / 64, NS = 8, SLOT = 10240, AHEAD = 6;
    const unsigned char* src = mn + (size_t)ubase * 16384 + lane * 16;
    const bool loader = (wave >= 1 && wave <= 5);
    const size_t poff = (wave == 5) ? (size_t)(8192 + vq * 2048) : (size_t)(2048 * (wave - 1));
#define SC_ISSUE(c) do { const unsigned char* s_ = src + (size_t)(c) * 16384 + poff; LAS unsigned char* d_ = lds + ((c) % NS) * SLOT + 2048 * (wave - 1); \
        _Pragma("unroll") for (int i_ = 0; i_ < 2; ++i_) __builtin_amdgcn_global_load_lds((const unsigned*)(s_ + i_ * 1024), (LAS unsigned*)(d_ + i_ * 1024), 16, 0, 0); } while (0)
#define SC_BAR() do { asm volatile("s_waitcnt lgkmcnt(0)" ::: "memory"); __builtin_amdgcn_s_barrier(); asm volatile("" ::: "memory"); } while (0)
    bf16x8 sB[2];
#pragma unroll
    for (int s = 0; s < 2; ++s) sB[s] = (bf16x8){0, 0, 0, 0, 0, 0, 0, 0};
    if (loader) {
#pragma unroll
        for (int c = 0; c < AHEAD; ++c) SC_ISSUE(c);
        asm volatile("s_waitcnt vmcnt(10)" ::: "memory"); }
    SC_BAR();
    for (int c = 0; c < NC; ++c) {
        if (loader) {
            if (c + AHEAD < NC) { SC_ISSUE(c + AHEAD); asm volatile("s_waitcnt vmcnt(10)" ::: "memory"); }
            else { asm volatile("s_waitcnt vmcnt(0)" ::: "memory"); }
        } else if (wave == 0) {
            const LAS unsigned char* sl = lds + (c % NS) * SLOT;
            unsigned char* so = sbuf + (size_t)(ubase + c) * 8192 + (vq * 2) * 1024 + lane * 16;
            *(bf16x8*)so = sB[0]; *(bf16x8*)(so + 1024) = sB[1];
            f32x4 aS[4];
#pragma unroll
            for (int mm = 0; mm < 4; ++mm) {
                const u32x2 nI = *(const LAS u32x2*)(sl + 8192 + (mm * 64 + lane) * 8);
                aS[mm] = (f32x4){bflo(nI.x), bfhi(nI.x), bflo(nI.y), bfhi(nI.y)};
#pragma unroll
                for (int s = 0; s < 2; ++s) { const bf16x8 aM = *(const LAS bf16x8*)(sl + ((mm * 2 + s) * 64 + lane) * 16); aS[mm] = __builtin_amdgcn_mfma_f32_16x16x32_bf16(aM, sB[s], aS[mm], 0, 0, 0); }
            }
#pragma unroll
            for (int s = 0; s < 2; ++s) { u32x4 w; w.x = pk2(aS[2 * s][0], aS[2 * s][1]); w.y = pk2(aS[2 * s][2], aS[2 * s][3]); w.z = pk2(aS[2 * s + 1][0], aS[2 * s + 1][1]); w.w = pk2(aS[2 * s + 1][2], aS[2 * s + 1][3]);
                sB[s] = __builtin_bit_cast(bf16x8, w); }
        }
        SC_BAR();
    }
#undef SC_ISSUE
#undef SC_BAR
}
struct YArgs { const unsigned char* qy; const unsigned char* sbuf; const bf16_t* g; const bf16_t* bv; const float* ln_g; const float* ln_b; bf16_t* ya; };
__device__ __forceinline__ void ypass_unit(const YArgs& P, int u, int lane) {
    const int r = lane & 15, q = lane >> 4, b = u >> 10, h = (u >> 7) & 7, c = u & 127, t0 = b * SEQ + c * 64;
    const unsigned char* qy_ = P.qy + (size_t)u * 16384; const unsigned char* s_ = P.sbuf + (size_t)u * 8192;
    bf16x8 Qf[4][2], Sf[4][2]; u32x2 y0[4][4];
#pragma unroll
    for (int i = 0; i < 4; ++i)
#pragma unroll
        for (int s = 0; s < 2; ++s) { Qf[i][s] = *(const bf16x8*)(qy_ + ((i * 2 + s) * 64 + lane) * 16); Sf[i][s] = *(const bf16x8*)(s_ + ((i * 2 + s) * 64 + lane) * 16); }
#pragma unroll
    for (int vq = 0; vq < 4; ++vq)
#pragma unroll
        for (int mm = 0; mm < 4; ++mm) y0[vq][mm] = *(const u32x2*)(qy_ + 8192 + ((vq * 4 + mm) * 64 + lane) * 8);
    f32x4 lg[4], lb[4];
#pragma unroll
    for (int vq = 0; vq < 4; ++vq) { lg[vq] = *(const f32x4*)(P.ln_g + h * 64 + 16 * vq + 4 * q); lb[vq] = *(const f32x4*)(P.ln_b + h * 64 + 16 * vq + 4 * q); }
#pragma unroll
    for (int mm = 0; mm < 4; ++mm) {
        const size_t ro = (size_t)(t0 + 16 * mm + r) * RW + h * 64 + 4 * q;
        u32x2 gw_[4], bw_[4];
#pragma unroll
        for (int vq = 0; vq < 4; ++vq) { gw_[vq] = *(const u32x2*)(P.g + ro + 16 * vq); bw_[vq] = *(const u32x2*)(P.bv + ro + 16 * vq); }
        f32x4 acc[4]; float sum = 0.f;
#pragma unroll
        for (int vq = 0; vq < 4; ++vq) {
            acc[vq] = (f32x4){bflo(y0[vq][mm].x), bfhi(y0[vq][mm].x), bflo(y0[vq][mm].y), bfhi(y0[vq][mm].y)};
#pragma unroll
            for (int s = 0; s < 2; ++s) acc[vq] = __builtin_amdgcn_mfma_f32_16x16x32_bf16(Sf[vq][s], Qf[mm][s], acc[vq], 0, 0, 0);
            sum += (acc[vq][0] + acc[vq][1]) + (acc[vq][2] + acc[vq][3]);
        }
        sum += __shfl_xor(sum, 16); sum += __shfl_xor(sum, 32);
        const float mean = sum * (1.f / 64.f); float var = 0.f;
#pragma unroll
        for (int vq = 0; vq < 4; ++vq) { acc[vq] = acc[vq] - mean; var += (acc[vq][0] * acc[vq][0] + acc[vq][1] * acc[vq][1]) + (acc[vq][2] * acc[vq][2] + acc[vq][3] * acc[vq][3]); }
        var += __shfl_xor(var, 16); var += __shfl_xor(var, 32);
        const float rstd = __builtin_amdgcn_rsqf(var * (1.f / 64.f) + 64e-5f);
#pragma unroll
        for (int vq = 0; vq < 4; ++vq) {
            const f32x4 gg = (f32x4){bflo(gw_[vq].x), bfhi(gw_[vq].x), bflo(gw_[vq].y), bfhi(gw_[vq].y)}, bb = (f32x4){bflo(bw_[vq].x), bfhi(bw_[vq].x), bflo(bw_[vq].y), bfhi(bw_[vq].y)};
            const f32x4 o = (acc[vq] * rstd * lg[vq] + lb[vq] + bb) * gg;
            u32x2 w; w.x = pk2(o[0], o[1]); w.y = pk2(o[2], o[3]); *(u32x2*)(P.ya + ro + 16 * vq) = w; }
    }
}
}
namespace gl {
constexpr int LDV = 136;
struct Args { const bf16_t* puv; const bf16_t* wsm; const float* bs; const float* ln_g; const float* ln_b; bf16_t* yb; };
__device__ __forceinline__ void unit(const Args& P, LAS unsigned char* lds, int b, int blk, int tid) {
    const int wave = __builtin_amdgcn_readfirstlane(tid >> 6), lane = tid & 63, r = lane & 15, q = lane >> 4;
    const int t0 = b * SEQ + blk * 128;
    LAS float* STAT = (LAS float*)(lds + LDS_MISC);
    for (int j = 0; j < 16; ++j) {
        const int tk = 16 * wave + j;
        const u32x4 w = *(const u32x4*)(P.puv + (size_t)(t0 + tk) * 1024 + 512 + 8 * lane);
        float v[8]; v[0] = bflo(w.x); v[1] = bfhi(w.x); v[2] = bflo(w.y); v[3] = bfhi(w.y); v[4] = bflo(w.z); v[5] = bfhi(w.z); v[6] = bflo(w.w); v[7] = bfhi(w.w);
        float s = 0.f, s2 = 0.f;
#pragma unroll
        for (int e = 0; e < 8; ++e) { s += v[e]; s2 += v[e] * v[e]; }
        s = wave_sum(s); s2 = wave_sum(s2);
        const float mean = s * (1.f / 512.f), var = fmaxf(s2 * (1.f / 512.f) - mean * mean, 0.f);
        if (lane == 0) { STAT[tk * 2] = mean; STAT[tk * 2 + 1] = __builtin_amdgcn_rsqf(var + 1e-5f); }
    }
    __syncthreads();
    for (int g = 0; g < 8; ++g) {
        LAS bf16_t* VT = (LAS bf16_t*)(lds + (g & 1) * 20480);
#pragma unroll
        for (int it = 0; it < 2; ++it) {
            const int task = tid + it * NTHREADS, j = task >> 3, cc = task & 7, ch = g * 64 + 8 * cc;
            const u32x4 w = *(const u32x4*)(P.puv + (size_t)(t0 + j) * 1024 + 512 + ch);
            const float mean = STAT[j * 2], rstd = STAT[j * 2 + 1];
            const f32x4 g0 = *(const f32x4*)(P.ln_g + ch), g1 = *(const f32x4*)(P.ln_g + ch + 4), b0 = *(const f32x4*)(P.ln_b + ch), b1 = *(const f32x4*)(P.ln_b + ch + 4);
            float v[8]; v[0] = bflo(w.x); v[1] = bfhi(w.x); v[2] = bflo(w.y); v[3] = bfhi(w.y); v[4] = bflo(w.z); v[5] = bfhi(w.z); v[6] = bflo(w.w); v[7] = bfhi(w.w);
#pragma unroll
            for (int e = 0; e < 4; ++e) { v[e] = (v[e] - mean) * rstd * g0[e] + b0[e]; v[4 + e] = (v[4 + e] - mean) * rstd * g1[e] + b1[e]; }
#pragma unroll
            for (int e = 0; e < 8; ++e) VT[(8 * cc + e) * LDV + j] = f2bf(v[e]);
        }
        __syncthreads();
        f32x4 acc[4];
#pragma unroll
        for (int n = 0; n < 4; ++n) acc[n] = (f32x4){0.f, 0.f, 0.f, 0.f};
        const bf16_t* wrow = P.wsm + ((size_t)g * 128 + 16 * wave + r) * 128 + 8 * q;
        const int ks = (wave >> 1) + 1;
        for (int s = 0; s < ks; ++s) {
            const bf16x8 a = *(const bf16x8*)(wrow + 32 * s);
#pragma unroll
            for (int n = 0; n < 4; ++n) { const bf16x8 bb = *(const LAS bf16x8*)(VT + (16 * n + r) * LDV + 32 * s + 8 * q); acc[n] = __builtin_amdgcn_mfma_f32_16x16x32_bf16(a, bb, acc[n], 0, 0, 0); }
        }
#pragma unroll
        for (int ii = 0; ii < 4; ++ii) { const int i = 16 * wave + 4 * q + ii; const float bias = P.bs[g * 128 + i];
#pragma unroll
            for (int n = 0; n < 4; ++n) { const int c = g * 64 + 16 * n + r; const float u = bf2f(P.puv[(size_t)(t0 + i) * 1024 + c]);
                P.yb[(size_t)(t0 + i) * RW + c] = f2bf(u * (acc[n][ii] + bias)); } }
    }
    __syncthreads();
}
}

struct RouteArgs { const float* sc; const float* bias; int* eidx; float* ewt; int* lrank; int* tbase; unsigned* segcnt; };
__device__ __forceinline__ void phase_topk(const RouteArgs& P, LAS unsigned char* lds, int tid, int G) {
    const int wave = __builtin_amdgcn_readfirstlane(tid >> 6), lane = tid & 63, grp = lane >> 3;
    LAS int* hist = (LAS int*)(lds + LDS_MISC);
    const f32x4 bias4 = *(const f32x4*)(P.bias + 4 * lane);
    const float NEG = -__builtin_inff();
    for (int tile = blockIdx.x; tile < T / 256; tile += G) {
        if (tid < NE) hist[tid] = 0;
        __syncthreads();
        for (int j = 0; j < 32; j += 2) {
            const int t0 = tile * 256 + wave * 32 + j;
            float s[2][4], v[2][4], gs[2];
#pragma unroll
            for (int u = 0; u < 2; ++u) { const f32x4 s4 = *(const f32x4*)(P.sc + (size_t)(t0 + u) * NE + 4 * lane); s[u][0] = s4.x; s[u][1] = s4.y; s[u][2] = s4.z; s[u][3] = s4.w;
#pragma unroll
                for (int e = 0; e < 4; ++e) v[u][e] = s[u][e] + bias4[e]; }
            float m1[2], m2[2];
#pragma unroll
            for (int u = 0; u < 2; ++u) { const float a = fmaxf(v[u][0], v[u][1]), b = fminf(v[u][0], v[u][1]), c = fmaxf(v[u][2], v[u][3]), d = fminf(v[u][2], v[u][3]); m1[u] = fmaxf(a, c); m2[u] = fmaxf(fminf(a, c), fmaxf(b, d)); }
#pragma unroll
            for (int o = 1; o < 8; o <<= 1) {
#pragma unroll
                for (int u = 0; u < 2; ++u) { const float o1 = __shfl_xor(m1[u], o), o2 = __shfl_xor(m2[u], o); const float n1 = fmaxf(m1[u], o1), n2 = fmaxf(fminf(m1[u], o1), fmaxf(m2[u], o2)); m1[u] = n1; m2[u] = n2; } }
#pragma unroll
            for (int u = 0; u < 2; ++u) gs[u] = m1[u] + m2[u];
            int cnt[2] = {0, 0};
#pragma unroll
            for (int g = 0; g < 8; ++g) {
#pragma unroll
                for (int u = 0; u < 2; ++u) { const float og = __shfl(gs[u], 8 * g); cnt[u] += (og > gs[u] || (og == gs[u] && g < grp)) ? 1 : 0; } }
#pragma unroll
            for (int u = 0; u < 2; ++u) {
#pragma unroll
                for (int e = 0; e < 4; ++e) v[u][e] = (cnt[u] < 4) ? v[u][e] : NEG; }
            int myidx[2] = {0, 0}; float mysc[2] = {0.f, 0.f}, ssum[2] = {0.f, 0.f};
#pragma unroll
            for (int k = 0; k < TOPK; ++k) {
                float bv[2]; int idx[2];
#pragma unroll
                for (int u = 0; u < 2; ++u) { bv[u] = v[u][0]; int bi = 0;
#pragma unroll
                    for (int e = 1; e < 4; ++e) { const bool gt = v[u][e] > bv[u]; bv[u] = gt ? v[u][e] : bv[u]; bi = gt ? e : bi; }
                    idx[u] = 4 * lane + bi; }
#pragma unroll
                for (int o = 1; o < 64; o <<= 1) {
#pragma unroll
                    for (int u = 0; u < 2; ++u) { const float ov = __shfl_xor(bv[u], o); const int oi = __shfl_xor(idx[u], o); const bool tk = (ov > bv[u]) || (ov == bv[u] && oi < idx[u]); bv[u] = tk ? ov : bv[u]; idx[u] = tk ? oi : idx[u]; } }
#pragma unroll
                for (int u = 0; u < 2; ++u) { const int own = idx[u] >> 2, ee = idx[u] & 3;
                    const float mine = (ee == 0) ? s[u][0] : (ee == 1) ? s[u][1] : (ee == 2) ? s[u][2] : s[u][3];
                    const float scv = __shfl(mine, own);
#pragma unroll
                    for (int e = 0; e < 4; ++e) v[u][e] = (lane == own && e == ee) ? NEG : v[u][e];
                    ssum[u] += scv; myidx[u] = (lane == k) ? idx[u] : myidx[u]; mysc[u] = (lane == k) ? scv : mysc[u]; }
            }
            if (lane < TOPK) {
#pragma unroll
                for (int u = 0; u < 2; ++u) { const int t = t0 + u;
                    const int lr = __hip_atomic_fetch_add(hist + myidx[u], 1, __ATOMIC_RELAXED, __HIP_MEMORY_SCOPE_WORKGROUP);
                    P.eidx[(size_t)t * TOPK + lane] = myidx[u]; P.ewt[(size_t)t * TOPK + lane] = mysc[u] / ssum[u] * 2.5f; P.lrank[(size_t)t * TOPK + lane] = lr; }
            }
        }
        __syncthreads();
        if (tid < NE) { const int cnt = hist[tid]; const int half = tile >> 7; unsigned base = 0u;
            if (cnt) base = __hip_atomic_fetch_add(P.segcnt + tid * 2 + half, (unsigned)cnt, __ATOMIC_RELAXED, __HIP_MEMORY_SCOPE_AGENT);
            P.tbase[tile * NE + tid] = (int)base; }
        __syncthreads();
    }
}
struct ScatArgs { const int* eidx; const float* ewt; const int* lrank; const int* tbase; const unsigned* segcnt; int* rowtok; int* rowdst; float* roww; int* tab; unsigned* ntile; };
__device__ __forceinline__ void phase_scatter(const ScatArgs& P, LAS unsigned char* lds, int tid, int G) {
    LAS int* cntL = (LAS int*)(lds + LDS_MISC); LAS int* segst = cntL + 512; LAS int* tsa = segst + 512; LAS int* tsh = tsa + 512;
    cntL[tid] = (int)__hip_atomic_load(P.segcnt + tid, __ATOMIC_RELAXED, __HIP_MEMORY_SCOPE_AGENT);
    __syncthreads();
    if (tid == 0) {
        int run = 0, ta = 0, th0 = 0, th1 = 0;
        for (int s = 0; s < 512; ++s) { const int nts = (cntL[s] + 255) >> 8; segst[s] = run; tsa[s] = ta; tsh[s] = (s & 1) ? th1 : th0; run += nts * 256; ta += nts; if (s & 1) th1 += nts; else th0 += nts; }
        if (blockIdx.x == 0) { P.ntile[0] = (unsigned)ta; P.ntile[1] = (unsigned)th0; P.ntile[2] = (unsigned)th1; }
    }
    __syncthreads();
    for (int tile = blockIdx.x; tile < T / 256; tile += G) {
        for (int a = tid; a < 256 * TOPK; a += NTHREADS) {
            const int tok = tile * 256 + (a >> 3), k = a & 7; const size_t ai = (size_t)tok * TOPK + k;
            const int e = P.eidx[ai], half = tok >> 15;
            const int pos = segst[e * 2 + half] + P.tbase[tile * NE + e] + P.lrank[ai];
            P.rowtok[pos] = tok; P.rowdst[pos] = (tok & (HALF_T - 1)) * TOPK + k; P.roww[pos] = P.ewt[ai];
        }
    }
    for (int s = blockIdx.x; s < 512; s += G) {
        const int st = segst[s], cnt = cntL[s], nts = (cnt + 255) >> 8;
        for (int p = st + cnt + tid; p < st + nts * 256; p += NTHREADS) { P.rowtok[p] = 0; P.rowdst[p] = -1; P.roww[p] = 0.f; }
        if (tid < nts) { int* ta_ = P.tab + 2 * (tsa[s] + tid); ta_[0] = st + 256 * tid; ta_[1] = s >> 1;
            int* th_ = P.tab + 2 * 4096 * (1 + (s & 1)) + 2 * (tsh[s] + tid); th_[0] = st + 256 * tid; th_[1] = s >> 1; }
    }
}
constexpr int NPHASE = 20;
struct KArgs { const float* in[34]; float* out; unsigned char* ws; int ph_lo, ph_hi; };
template <int PLO, int PHI>
__global__ void __launch_bounds__(NTHREADS, 2) fwd_kernel(KArgs a) {
    extern __shared__ __attribute__((aligned(16))) unsigned char lds_raw[];
    LAS unsigned char* lds = (LAS unsigned char*)lds_raw;
    const int G = gridDim.x, bid = blockIdx.x, NGW = G * NWAVES;
#define PH_IDS() int tid = threadIdx.x; asm volatile("" : "+v"(tid)); const int lane = tid & 63, wave = __builtin_amdgcn_readfirstlane(tid >> 6), gw = bid * NWAVES + wave; (void)lane; (void)wave; (void)gw
    unsigned char* ws = a.ws;
    unsigned* ctl = (unsigned*)(ws + WS_CTL);
    float* mod = (float*)(ws + WS_MOD);
    constexpr int lo = PLO, hi = PHI;
    if (threadIdx.x == 0) *(LAS u32x4*)(lds + LDS_BARW) = (u32x4){0u, 0u, 0u, 0u};
    __syncthreads();
    XcdBarrier bar; bar.bar = ctl + CW_BAR; bar.x = 0; bar.st = nullptr;
    if (hi - lo > 1) bar = xcd_barrier_post(ctl + CW_BAR, (volatile LAS unsigned*)(lds + LDS_BARW));
#define IN(k) (lo <= (k) && (k) < hi)
#ifdef DBG_TIME
#define STAMP(k) do { if (blockIdx.x == 0 && threadIdx.x == 0) ((unsigned long long*)(ctl + 5200))[k] = __builtin_amdgcn_s_memrealtime(); } while (0)
#else
#define STAMP(k) do {} while (0)
#endif
#define SEAM(k) do { if (IN(k) && IN((k) + 1)) xcd_barrier(bar); } while (0)
#ifndef DBG_REPEAT
#define DBG_REPEAT (-1)
#define DBG_NREP 0
#endif
#define REP(k) for (int rep_ = 0; rep_ < (((k) == DBG_REPEAT) ? 1 + DBG_NREP : 1); ++rep_, (((k) == DBG_REPEAT && rep_ <= DBG_NREP) ? xcd_barrier(bar) : (void)0))

    STAMP(0);
    if (IN(0)) REP(0) { PH_IDS();
        phase_mod(a.in[1], a.in[2], a.in[3], mod, lds, tid, G);
        SmallW sw{a.in[6], a.in[22], a.in[23], a.in[24], a.in[25], a.in[30], a.in[31], a.in[32], a.in[9], a.in[11], a.in[12], a.in[20]};
        phase_small_weights(sw, ws, lds, gw, NGW, wave, lane);
    }
    SEAM(0); STAMP(1);
    if (IN(1)) REP(1) { PH_IDS(); phase_norm_mod(a.in[0], a.in[4], mod, 0, 1024, (bf16_t*)(ws + B_H1), gw, NGW, lane); }
    SEAM(1); STAMP(2);
    if (IN(2)) REP(2) {
        gm::DenseSched S; S.init(ws + B_H1, ws + SW_WIN, T, IN_COLS, D, G, bid);
        gm::EpiInProj E{(bf16_t*)(ws + B_PRW), (bf16_t*)(ws + B_PUV), (bf16_t*)(ws + B_PG)};
        gm::gemm_phase<gm::EpiInProj, gm::DenseSched, true>(lds, D, S, E);
    }
    SEAM(2); STAMP(3);
    if (IN(3)) REP(3) { PH_IDS();
        gl::Args Q{(const bf16_t*)(ws + B_PUV), (const bf16_t*)(ws + SW_WSM), a.in[21], a.in[18], a.in[19], (bf16_t*)(ws + B_YB)};
        for (int u = bid; u < 512; u += G) gl::unit(Q, lds, u >> 6, u & 63, tid);
    }
    SEAM(3); STAMP(4);
    if (IN(4)) REP(4) { PH_IDS();
        rk::Args P{(const bf16_t*)(ws + B_PRW), a.in[7], a.in[8], a.in[10], a.in[13], a.in[14], a.in[15], (const bf16_t*)(ws + SW_WUP), (const bf16_t*)(ws + SW_AUP), (const bf16_t*)(ws + SW_GUP),
                   (bf16_t*)(ws + B_G), (bf16_t*)(ws + B_BV), ws + B_MN, ws + B_QY};
        rk::Pre pre; rk::load_mu(P, lds, tid);
        if (bid < 8192) rk::prefetch(P, bid >> 10, (bid >> 7) & 7, bid & 127, tid, pre);
        for (int u = bid; u < 8192; u += G) { const int un = u + G; rk::unit(P, lds, u >> 10, (u >> 7) & 7, u & 127, u, tid, pre, un < 8192, un >> 10, (un >> 7) & 7, un & 127); }
    }
    SEAM(4); STAMP(5);
    if (IN(5)) REP(5) { PH_IDS();
        for (int w = bid; w < 256; w += G) rk::scan_wg(ws + B_MN, ws + B_S, ((w & 7) + 8 * (w >> 5)) * 128, (w >> 3) & 3, lds, tid);
    }
    SEAM(5); STAMP(6);
    if (IN(6)) REP(6) { PH_IDS();
        rk::YArgs Y{ws + B_QY, ws + B_S, (const bf16_t*)(ws + B_G), (const bf16_t*)(ws + B_BV), a.in[16], a.in[17], (bf16_t*)(ws + B_YA)};
        for (int u = gw; u < 8192; u += NGW) rk::ypass_unit(Y, u, lane);
    }
    SEAM(6); STAMP(7);
    STAMP(8);
    if (IN(8)) REP(8) {
        gm::DenseSched S; S.init(ws + B_YA, ws + SW_WOA, T, D, RW, G, bid);
        gm::EpiMerge<false> E{(bf16_t*)(ws + B_M1), (const bf16_t*)(ws + B_PG)};
        gm::gemm_phase<gm::EpiMerge<false>, gm::DenseSched, true>(lds, RW, S, E);
    }
    SEAM(8); STAMP(9);
    if (IN(9)) {
        gm::DenseSched S; S.init(ws + B_YB, ws + SW_WOB, T, D, RW, G, bid);
        gm::EpiMerge<true> E{(bf16_t*)(ws + B_M1), (const bf16_t*)(ws + B_PG)};
        gm::gemm_phase<gm::EpiMerge<true>, gm::DenseSched, true>(lds, RW, S, E);
    }
    SEAM(9); STAMP(10);
    if (IN(10)) REP(10) {
        gm::DenseSched S; S.init(ws + B_M1, ws + SW_WO, T, D, D, G, bid);
        gm::EpiResid E{a.out, a.in[0], mod + 2048};
        gm::gemm_phase<gm::EpiResid, gm::DenseSched, true>(lds, D, S, E);
    }
    SEAM(10); STAMP(11);
    if (IN(11)) REP(11) { PH_IDS();
        phase_norm_mod(a.out, a.in[5], mod, 3072, 4096, (bf16_t*)(ws + B_H2), gw, NGW, lane);
        phase_expert_weights(a.in[27], a.in[28], a.in[29], ws, lds, gw, NGW, wave, lane);
    }
    SEAM(11); STAMP(12);
    if (IN(12)) REP(12) {
        { gm::DenseSched S; S.init(ws + B_H2, ws + SW_WR, T, NE, D, G, bid); gm::EpiRouter E{(float*)(ws + B_SC)}; gm::gemm_phase<gm::EpiRouter, gm::DenseSched, true>(lds, D, S, E); }
        { gm::DenseSched S; S.init(ws + B_H2, ws + SW_WS13, T, 512, D, G, bid); gm::EpiGateUp E{(bf16_t*)(ws + B_SH)}; gm::gemm_phase<gm::EpiGateUp, gm::DenseSched, true>(lds, D, S, E); }
    }
    SEAM(12); STAMP(13);
    if (IN(13)) { PH_IDS();
        RouteArgs R{(const float*)(ws + B_SC), a.in[26], (int*)(ws + RT_EIDX), (float*)(ws + RT_EWT), (int*)(ws + RT_LRANK), (int*)(ws + RT_TBASE), ctl + CW_SEGCNT};
        phase_topk(R, lds, tid, G);
        gm::DenseSched S; S.init(ws + B_SH, ws + SW_WS2, T, D, EFF, G, bid);
        gm::EpiResid E{a.out, a.out, mod + 5120};
        gm::gemm_phase<gm::EpiResid, gm::DenseSched, true>(lds, EFF, S, E);
    }
    SEAM(13); STAMP(14);
    if (IN(14)) REP(14) { PH_IDS();
        ScatArgs P{(const int*)(ws + RT_EIDX), (const float*)(ws + RT_EWT), (const int*)(ws + RT_LRANK), (const int*)(ws + RT_TBASE), ctl + CW_SEGCNT,
                   (int*)(ws + RT_ROWTOK), (int*)(ws + RT_ROWDST), (float*)(ws + RT_ROWW), (int*)(ws + RT_TAB), ctl + CW_NT};
        phase_scatter(P, lds, tid, G);
    }
    SEAM(14); STAMP(15);
    if (IN(15)) REP(15) {
        gm::GroupSched<true> S; S.A = (const char*)(ws + B_H2); S.B = (const char*)(ws + B_W13); S.tab = (const int*)(ws + RT_TAB); S.rowtok = (const int*)(ws + RT_ROWTOK);
        S.ntiles = (int)__hip_atomic_load(ctl + CW_NT, __ATOMIC_RELAXED, __HIP_MEMORY_SCOPE_AGENT); S.npn = 2; S.G = G; S.c = bid; S.K = D; S.ebytes = (size_t)512 * D * 2; S.tstep = (size_t)256 * D * 2;
        gm::EpiGateUp E{(bf16_t*)(ws + B_HID)};
        gm::gemm_phase<gm::EpiGateUp, gm::GroupSched<true>, true>(lds, D, S, E);
    }
    SEAM(15); STAMP(16);
#define MOE_DOWN(half) do { \
        gm::GroupSched<false> S; S.A = (const char*)(ws + B_HID); S.B = (const char*)(ws + B_W2); S.tab = (const int*)(ws + RT_TAB) + 2 * 4096 * (1 + (half)); S.rowtok = nullptr; \
        S.ntiles = (int)__hip_atomic_load(ctl + CW_NT + 1 + (half), __ATOMIC_RELAXED, __HIP_MEMORY_SCOPE_AGENT); S.npn = 4; S.G = G; S.c = bid; S.K = EFF; S.ebytes = (size_t)D * EFF * 2; S.tstep = (size_t)256 * EFF * 2; \
        gm::EpiExpertDown E{(bf16_t*)(ws + B_SLOT), (const int*)(ws + RT_ROWDST), (const float*)(ws + RT_ROWW)}; \
        gm::gemm_phase<gm::EpiExpertDown, gm::GroupSched<false>, true>(lds, EFF, S, E); } while (0)
    if (IN(16)) REP(16) MOE_DOWN(0);
    SEAM(16); STAMP(17);
    if (IN(17)) { PH_IDS(); phase_combine(a.out, (const bf16_t*)(ws + B_SLOT), mod, a.in[33], 0, gw, NGW, lane); }
    SEAM(17); STAMP(18);
    if (IN(18)) REP(18) MOE_DOWN(1);
    SEAM(18); STAMP(19);
    if (IN(19)) { PH_IDS(); phase_combine(a.out, (const bf16_t*)(ws + B_SLOT), mod, a.in[33], 1, gw, NGW, lane); }
    __syncthreads(); STAMP(20);
#undef IN
#undef SEAM
#undef MOE_DOWN
}

#if defined(DBG_CHECK) || defined(DBG_TIME)
#ifdef DBG_TIME
__global__ void dbg_time_out(float* out, const unsigned long long* st) {
    if (threadIdx.x == 0 && blockIdx.x == 0) { out[0] = (float)(st[TA1] - st[TA0]) * 0.01f * 0.25f; out[1] = (float)(st[TB1] - st[TB0]) * 0.01f * 0.25f; }
}
static void dbg_run(void* d_out, void* d_ws, hipStream_t stream) {
    dbg_time_out<<<1, 64, 0, stream>>>((float*)d_out, (const unsigned long long*)((unsigned*)((unsigned char*)d_ws + WS_CTL) + 5200));
}
#endif
#endif
#ifndef MK_SINGLE
#define MK_SINGLE 0
#endif
template <int PLO, int PHI> static bool prep_kernel() {
    int per_cu = 0;
    if (hipFuncSetAttribute((const void*)fwd_kernel<PLO, PHI>, hipFuncAttributeMaxDynamicSharedMemorySize, LDS_BYTES) != hipSuccess) { fprintf(stderr, "kernel_launch: hipFuncSetAttribute failed\n"); return false; }
    if (hipOccupancyMaxActiveBlocksPerMultiprocessor(&per_cu, (const void*)fwd_kernel<PLO, PHI>, NTHREADS, LDS_BYTES) != hipSuccess || per_cu < 1) { fprintf(stderr, "kernel_launch: occupancy query says %d\n", per_cu); (void)hipGetLastError(); return false; }
    return true;
}
template <int P> struct PhaseLaunch {
    static bool prep() { return prep_kernel<P, P + 1>() && PhaseLaunch<P + 1>::prep(); }
    static void go(int grid, hipStream_t stream, const KArgs& a) { hipLaunchKernelGGL((fwd_kernel<P, P + 1>), dim3(grid), dim3(NTHREADS), LDS_BYTES, stream, a); PhaseLaunch<P + 1>::go(grid, stream, a); }
};
#ifndef DBG_LAST
#define DBG_LAST NPHASE
#endif
template <> struct PhaseLaunch<DBG_LAST> { static bool prep() { return true; } static void go(int, hipStream_t, const KArgs&) {} };
extern "C" void kernel_launch(void* const* d_in, const int* in_sizes, int n_in, void* d_out, int out_size, void* d_ws, size_t ws_size, hipStream_t stream) {
    static int grid = 0;
    if (grid == 0) {
        if (n_in != 34 || out_size != T * D || ws_size < WS_END) { fprintf(stderr, "kernel_launch: unexpected problem shape (n_in %d, out %d, ws %zu < %zu)\n", n_in, out_size, ws_size, (size_t)WS_END); grid = -1; return; }
        int dev = 0, cus = 0;
        if (hipGetDevice(&dev) != hipSuccess || hipDeviceGetAttribute(&cus, hipDeviceAttributeMultiprocessorCount, dev) != hipSuccess) { grid = -1; return; }
#if MK_SINGLE
        if (!prep_kernel<0, NPHASE>()) { grid = -1; return; }
#else
        if (!PhaseLaunch<0>::prep()) { grid = -1; return; }
#endif
        grid = cus;
    }
    if (grid < 0) return;
    (void)hipMemsetAsync((char*)d_ws + WS_CTL, 0, CTL_ZERO_BYTES, stream);
    KArgs a{};
    for (int i = 0; i < 34; ++i) a.in[i] = (const float*)d_in[i];
    a.out = (float*)d_out; a.ws = (unsigned char*)d_ws; a.ph_lo = 0; a.ph_hi = NPHASE;
#if MK_SINGLE
    hipLaunchKernelGGL((fwd_kernel<0, NPHASE>), dim3(grid), dim3(NTHREADS), LDS_BYTES, stream, a);
#else
    PhaseLaunch<0>::go(grid, stream, a);
#endif
#if defined(DBG_CHECK) || defined(DBG_TIME)
    dbg_run(d_out, d_ws, stream);
#endif
}
```

```cpp
#define MK_SINGLE 1
#include <hip/hip_runtime.h>
#include <cstdio>
#include <cstdint>

#define LAS __attribute__((address_space(3)))
#define GAS __attribute__((address_space(1)))
typedef unsigned short bf16_t;
typedef short bf16x8 __attribute__((ext_vector_type(8)));
typedef float f32x4 __attribute__((ext_vector_type(4)));
typedef float f32x2 __attribute__((ext_vector_type(2)));
typedef unsigned u32x4 __attribute__((ext_vector_type(4)));
typedef unsigned u32x2 __attribute__((ext_vector_type(2)));

constexpr int D = 1024, NB = 8, SEQ = 8192, T = NB * SEQ;
constexpr int RW = 512, HD = 64, NH = 8;
constexpr int RWKV_COLS = 1792, IN_COLS = 4864;
constexpr int NE = 256, TOPK = 8, EFF = 256;
constexpr int NWAVES = 8, NTHREADS = 512;
constexpr int MAXROWS = T * TOPK + 256 * 256;

constexpr size_t MiB = 1u << 20;
constexpr size_t WS_CTL = 0;
constexpr int CW_BAR = 0, CW_SEGCNT = 4096, CW_NT = 4608;
constexpr size_t CTL_ZERO_BYTES = 20480;
constexpr size_t WS_MOD = 65536;
constexpr size_t WS_SW = 1 * MiB;
constexpr size_t SW_WIN = WS_SW;
constexpr size_t SW_WOA = SW_WIN + (size_t)IN_COLS * D * 2;
constexpr size_t SW_WOB = SW_WOA + (size_t)D * RW * 2;
constexpr size_t SW_WO = SW_WOB + (size_t)D * RW * 2;
constexpr size_t SW_WR = SW_WO + (size_t)D * D * 2;
constexpr size_t SW_WS13 = SW_WR + (size_t)NE * D * 2;
constexpr size_t SW_WS2 = SW_WS13 + (size_t)512 * D * 2;
constexpr size_t SW_WUP = SW_WS2 + (size_t)D * EFF * 2;
constexpr size_t SW_AUP = SW_WUP + (size_t)RW * 64 * 2;
constexpr size_t SW_GUP = SW_AUP + (size_t)RW * 64 * 2;
constexpr size_t SW_WSM = SW_GUP + (size_t)RW * 128 * 2;
constexpr size_t SW_END = SW_WSM + (size_t)8 * 128 * 128 * 2;
static_assert(SW_END <= 20 * MiB, "small weights");
constexpr size_t WS_RT = 20 * MiB;
constexpr size_t RT_EIDX = WS_RT;
constexpr size_t RT_EWT = RT_EIDX + (size_t)T * 8 * 4;
constexpr size_t RT_LRANK = RT_EWT + (size_t)T * 8 * 4;
constexpr size_t RT_TBASE = RT_LRANK + (size_t)T * 8 * 4;
constexpr size_t RT_ROWTOK = RT_TBASE + (size_t)256 * 256 * 4;
constexpr size_t RT_ROWDST = RT_ROWTOK + (size_t)MAXROWS * 4;
constexpr size_t RT_ROWW = RT_ROWDST + (size_t)MAXROWS * 4;
constexpr size_t RT_TAB = RT_ROWW + (size_t)MAXROWS * 4;
constexpr size_t RT_SBON = RT_TAB + (size_t)3 * 4096 * 8;
constexpr size_t RT_END = RT_SBON + (size_t)T * 8 * 4;
static_assert(RT_END <= 40 * MiB, "routing arrays");
constexpr size_t WS_BIG = 40 * MiB;
constexpr size_t B_H1 = WS_BIG + 0 * MiB;
constexpr size_t B_YB = WS_BIG + 0 * MiB;
constexpr size_t B_YA = WS_BIG + 64 * MiB;
constexpr size_t B_PRW = WS_BIG + 128 * MiB;
constexpr size_t B_S = WS_BIG + 128 * MiB;
constexpr size_t B_PUV = WS_BIG + 352 * MiB;
constexpr size_t B_QY = WS_BIG + 352 * MiB;
constexpr size_t B_M1 = WS_BIG + 352 * MiB;
constexpr size_t B_PG = WS_BIG + 480 * MiB;
constexpr size_t B_MN = WS_BIG + 736 * MiB;
constexpr size_t B_G = WS_BIG + 864 * MiB;
constexpr size_t B_BV = WS_BIG + 928 * MiB;
constexpr size_t B_H2 = WS_BIG + 0 * MiB;
constexpr size_t B_W13 = WS_BIG + 128 * MiB;
constexpr size_t B_SH = WS_BIG + 384 * MiB;
constexpr size_t B_SC = WS_BIG + 416 * MiB;
constexpr size_t B_SLOT = WS_BIG + 0 * MiB;
constexpr size_t B_SHO = WS_BIG + 928 * MiB;
constexpr size_t B_W2 = WS_BIG + 512 * MiB;
constexpr size_t B_HID = WS_BIG + 640 * MiB;
constexpr size_t WS_END = WS_BIG + 992 * MiB;
static_assert((size_t)MAXROWS * EFF * 2 <= 320 * MiB, "hid");

constexpr int LDS_STAGE = 0;
constexpr int LDS_MISC = 147456;
constexpr int LDS_BARW = 155648;
constexpr int LDS_BYTES = 163840;

typedef __bf16 bf16x2_t __attribute__((ext_vector_type(2)));
__device__ __forceinline__ unsigned pk2(float lo, float hi) { f32x2 f = {lo, hi}; return __builtin_bit_cast(unsigned, __builtin_convertvector(f, bf16x2_t)); }
__device__ __forceinline__ u32x2 pk8(const f32x4& a, const f32x4& b) { u32x2 w; int t = __builtin_amdgcn_cvt_pk_fp8_f32(a[0], a[1], 0, false); t = __builtin_amdgcn_cvt_pk_fp8_f32(a[2], a[3], t, true); w.x = (unsigned)t;
    t = __builtin_amdgcn_cvt_pk_fp8_f32(b[0], b[1], 0, false); t = __builtin_amdgcn_cvt_pk_fp8_f32(b[2], b[3], t, true); w.y = (unsigned)t; return w; }
__device__ __forceinline__ f32x4 up8(unsigned w) { const f32x2 lo = __builtin_amdgcn_cvt_pk_f32_fp8((int)w, false), hi = __builtin_amdgcn_cvt_pk_f32_fp8((int)w, true); return (f32x4){lo.x, lo.y, hi.x, hi.y}; }
__device__ __forceinline__ float bflo(unsigned w) { return __uint_as_float(w << 16); }
__device__ __forceinline__ float bfhi(unsigned w) { return __uint_as_float(w & 0xffff0000u); }
__device__ __forceinline__ float bf2f(bf16_t h) { return __uint_as_float(((unsigned)h) << 16); }
__device__ __forceinline__ bf16_t f2bf(float f) { return (bf16_t)(pk2(f, 0.f) & 0xffffu); }
__device__ __forceinline__ float fexp(float x) { return __builtin_amdgcn_exp2f(x * 1.44269504089f); }
__device__ __forceinline__ float flog(float x) { return __builtin_amdgcn_logf(x) * 0.69314718056f; }
__device__ __forceinline__ float frcp(float x) { return __builtin_amdgcn_rcpf(x); }
__device__ __forceinline__ float sigmoidf_(float x) { return frcp(1.0f + fexp(-x)); }
__device__ __forceinline__ float siluf_(float x) { return x * sigmoidf_(x); }
__device__ __forceinline__ float tanhf_(float x) { return 1.0f - 2.0f * frcp(1.0f + fexp(2.0f * x)); }
__device__ __forceinline__ float gelu_tanh(float x) { const float u = 0.7978845608f * (x + 0.044715f * x * x * x); return x * frcp(1.0f + fexp(-2.0f * u)); }
__device__ __forceinline__ float wave_sum(float v) {
#pragma unroll
    for (int o = 1; o < 64; o <<= 1) v += __shfl_xor(v, o);
    return v;
}
#define LDS_WAIT() asm volatile("s_waitcnt lgkmcnt(0)" ::: "memory")
#define VM_WAIT() asm volatile("s_waitcnt vmcnt(0)" ::: "memory")

#define XB_TMO      128
#define XB_XCNT(j)  (256  + 64 * (j))
#define XB_XSUB(j)  (1280 + 64 * (j))
#define XB_XGEN(j)  (2304 + 64 * (j))
#define XB_TOP      3328
#define XB_TOPGEN   3392
#define XCD_BAR_WORDS 3456
#define XB_SPIN_CAP (1u << 18)
__device__ __forceinline__ unsigned xb_ld(unsigned* p)              { return __hip_atomic_load(p, __ATOMIC_RELAXED, __HIP_MEMORY_SCOPE_AGENT); }
__device__ __forceinline__ unsigned xb_add(unsigned* p, unsigned v) { return __hip_atomic_fetch_add(p, v, __ATOMIC_RELAXED, __HIP_MEMORY_SCOPE_AGENT); }
__device__ __forceinline__ unsigned xb_xcc_id() { return (unsigned)__builtin_amdgcn_s_getreg((3 << 11) | 20) & 0xFu; }
#define XB_SPIN(cond, bar) do { unsigned _sp = 0; while (cond) { __builtin_amdgcn_s_sleep(1); \
    if ((++_sp & 255u) == 0u) { if (xb_ld(&(bar)[XB_TMO])) break; if (_sp > XB_SPIN_CAP) { atomicAdd(&(bar)[XB_TMO], 1u); break; } } } } while (0)
struct XcdBarrier { unsigned* bar; unsigned x; volatile LAS unsigned* st; };
__device__ __forceinline__ XcdBarrier xcd_barrier_post(unsigned* bar, volatile LAS unsigned* st) {
    XcdBarrier b; b.bar = bar; b.x = xb_xcc_id(); b.st = st;
    if (threadIdx.x == 0) (void)xb_add(&bar[XB_XCNT(b.x)], 1u);
    return b;
}
__device__ __forceinline__ void xcd_barrier_complete(unsigned* bar, unsigned x, unsigned& nloc, unsigned& nx) {
    const unsigned G = gridDim.x * gridDim.y * gridDim.z;
    unsigned sum, cnt, mine, sp = 0u;
    for (;;) {
        sum = 0u; cnt = 0u; mine = 0u;
#pragma unroll
        for (unsigned j = 0; j < 16; ++j) { const unsigned c = xb_ld(&bar[XB_XCNT(j)]); sum += c; cnt += (c > 0u) ? 1u : 0u; mine = (j == x) ? c : mine; }
        if (sum == G) break;
        __builtin_amdgcn_s_sleep(1);
        if ((++sp & 255u) == 0u) { if (xb_ld(&bar[XB_TMO])) break; if (sp > XB_SPIN_CAP) { atomicAdd(&bar[XB_TMO], 1u); break; } }
    }
    nloc = mine > 0u ? mine : 1u; nx = cnt > 0u ? cnt : 1u;
}
__device__ __forceinline__ void xcd_barrier(const XcdBarrier& b) {
    asm volatile("s_waitcnt vmcnt(0)" ::: "memory");
    __syncthreads();
    if (threadIdx.x == 0) {
        unsigned* bar = b.bar;
        __builtin_amdgcn_s_waitcnt(0);
        unsigned nloc = b.st[0], nx = b.st[1];
        if (nloc == 0u) { xcd_barrier_complete(bar, b.x, nloc, nx); b.st[0] = nloc; b.st[1] = nx; }
        const unsigned old = xb_add(&bar[XB_XSUB(b.x)], 1u);
        const unsigned gen = old / nloc;
        if (old + 1u == (gen + 1u) * nloc) {
            __builtin_amdgcn_fence(__ATOMIC_RELEASE, "agent");
            asm volatile("s_waitcnt vmcnt(0)" ::: "memory");
            const unsigned og = xb_add(&bar[XB_TOP], 1u);
            const unsigned tg = og / nx;
            if (og + 1u == (tg + 1u) * nx) xb_add(&bar[XB_TOPGEN], 1u);
            else XB_SPIN(xb_ld(&bar[XB_TOPGEN]) == tg, bar);
            __builtin_amdgcn_fence(__ATOMIC_ACQUIRE, "agent");
            xb_add(&bar[XB_XGEN(b.x)], 1u);
            asm volatile("s_waitcnt vmcnt(0)" ::: "memory");
        } else {
            XB_SPIN(xb_ld(&bar[XB_XGEN(b.x)]) == gen, bar);
            __builtin_amdgcn_fence(__ATOMIC_ACQUIRE, "agent");
            asm volatile("s_waitcnt vmcnt(0)" ::: "memory");
        }
    }
    __syncthreads();
}
namespace gm {
constexpr int BM = 256, BK = 64, HALF = 128, HTB = HALF * BK * 2, STAGE_BYTES = 8 * HTB, NXCD = 8, WGM = 8;
__host__ __device__ __forceinline__ int lds_byte(int r, int c) { const int st = (r >> 4) * 2 + (c >> 5), rr = r & 15, cc = c & 31, ob = rr * 64 + cc * 2; return st * 1024 + (ob ^ (((ob >> 9) & 1) << 5)); }
__host__ __device__ __forceinline__ void stage_rc(int b, int& R, int& C) { const int st = b / 1024, sb = b % 1024, swz = sb ^ (((sb >> 9) & 1) << 5); R = (st >> 1) * 16 + swz / 64; C = (st & 1) * 32 + (swz % 64) / 2; }
__host__ __device__ __forceinline__ int perm32(int rho) { const int n = rho >> 4, i = rho & 15; return 8 * (i >> 2) + 4 * n + (i & 3); }

struct Unit { int pm, pn, e, row0, par; };

struct DenseSched {
    static constexpr bool GATHER = false;
    const char* A; const char* B; int nM, nN, nwg, G, c; size_t tstep;
    __device__ __forceinline__ void init(const void* A_, const void* B_, int M, int N, int K, int G_, int c_) { A = (const char*)A_; B = (const char*)B_; nM = M / BM; nN = N / BM; nwg = nM * nN; G = G_; c = c_; tstep = (size_t)BM * K * 2; }
    __device__ __forceinline__ bool next(int i, Unit& u) const {
        const long L = (long)i * G + c; if (L >= nwg) return false;
        int wgid = (int)L; { const int q = nwg / NXCD, r = nwg % NXCD, xcd = wgid % NXCD, off = wgid / NXCD; wgid = (xcd < r ? xcd * (q + 1) : r * (q + 1) + (xcd - r) * q) + off; }
        const int nig = WGM * nN, gid = wgid / nig, fm = gid * WGM, gsz = (nM - fm) < WGM ? (nM - fm) : WGM;
        u.pm = fm + ((wgid % nig) % gsz); u.pn = (wgid % nig) / gsz; u.e = 0; u.row0 = u.pm * BM; return true;
    }
    __device__ __forceinline__ const char* a_ptr(const Unit& u) const { return A + (size_t)u.pm * tstep; }
    __device__ __forceinline__ const char* b_ptr(const Unit& u) const { return B + (size_t)u.pn * tstep; }
    __device__ __forceinline__ unsigned row_off(const Unit&, int) const { return 0u; }
};
template <bool GATHER_>
struct GroupSched {
    static constexpr bool GATHER = GATHER_;
    const char* A; const char* B; const int* tab; const int* rowtok; int ntiles, npn, G, c, K; size_t ebytes, tstep;
    __device__ __forceinline__ bool next(int i, Unit& u) const {
        const long L = (long)i * G + c; if (L >= (long)ntiles * npn) return false;
        const int tile = (int)(L / npn); u.pn = (int)(L % npn); u.pm = tile;
        u.row0 = __builtin_amdgcn_readfirstlane(tab[2 * tile]); u.e = __builtin_amdgcn_readfirstlane(tab[2 * tile + 1]); return true;
    }
    __device__ __forceinline__ const char* a_ptr(const Unit& u) const { return GATHER ? A : A + (size_t)u.row0 * K * 2; }
    __device__ __forceinline__ const char* b_ptr(const Unit& u) const { return B + (size_t)u.e * ebytes + (size_t)u.pn * tstep; }
    __device__ __forceinline__ unsigned row_off(const Unit& u, int r) const { return (unsigned)rowtok[u.row0 + r] * (unsigned)(K * 2); }
};

template <class Epi, class Sched, bool ALIGN_EPI>
__device__ __forceinline__ void gemm_phase(LAS unsigned char* lds, const int K, const Sched& S, const Epi& E) {
    int tid_ = threadIdx.x; asm volatile("" : "+v"(tid_));
    const int tid = tid_, wid = __builtin_amdgcn_readfirstlane(tid >> 6), lane = tid & 63, wr = wid >> 2, wc = wid & 3, fr = lane & 15, fq = lane >> 4;
    const int nt = K / BK;
    int sR[2], sC[2]; unsigned voffB[2];
#pragma unroll
    for (int i = 0; i < 2; ++i) { int R, C; stage_rc(tid * 16 + i * 8192, R, C); sR[i] = R; sC[i] = C; const int Rb = Epi::PERM ? ((R & ~31) + perm32(R & 31)) : R; voffB[i] = (unsigned)(Rb * K + C) * 2u; }
    const size_t kstep = (size_t)(BK * 2);
    const size_t hstep = (size_t)HALF * K * 2;
    const unsigned ldsw = (unsigned)wid * 1024u;
    const int aoff = lds_byte(wr * 64 + fr, fq * 8), boff = lds_byte(wc * 32 + fr, fq * 8);
#define PG8_SA(b, h) (((b) * 2 + (h)) * HTB)
#define PG8_SB(b, h) ((4 + (b) * 2 + (h)) * HTB)
#define PG8_STGB(bufoff, gbase) do { _Pragma("unroll") for (int _i = 0; _i < 2; ++_i) \
        __builtin_amdgcn_global_load_lds((const unsigned*)((const char*)(gbase) + voffB[_i]), (LAS unsigned*)(lds + (bufoff) + ldsw + _i * 8192), 16, 0, 0); } while (0)
#define PG8_STGA(bufoff, gbase, VO, h) do { _Pragma("unroll") for (int _i = 0; _i < 2; ++_i) \
        __builtin_amdgcn_global_load_lds((const unsigned*)((const char*)(gbase) + VO[h][_i]), (LAS unsigned*)(lds + (bufoff) + ldsw + _i * 8192), 16, 0, 0); } while (0)
#define PG8_VOA(u, VO) do { _Pragma("unroll") for (int _h = 0; _h < 2; ++_h) _Pragma("unroll") for (int _i = 0; _i < 2; ++_i) \
        VO[_h][_i] = Sched::GATHER ? (S.row_off(u, _h * HALF + sR[_i]) + (unsigned)sC[_i] * 2u) : ((unsigned)((_h * HALF + sR[_i]) * K + sC[_i]) * 2u); } while (0)
#define PG8_LDA(dst, b, h) do { _Pragma("unroll") for (int m = 0; m < 4; ++m) _Pragma("unroll") for (int k = 0; k < 2; ++k) dst[m][k] = *(const LAS bf16x8*)(lds + PG8_SA(b, h) + aoff + m * 2048 + k * 1024); } while (0)
#define PG8_LDB(dst, b, h) do { _Pragma("unroll") for (int n = 0; n < 2; ++n) _Pragma("unroll") for (int k = 0; k < 2; ++k) dst[n][k] = *(const LAS bf16x8*)(lds + PG8_SB(b, h) + boff + n * 2048 + k * 1024); } while (0)
#define PG8_MMA(ai, bj, At, Bt) do { __builtin_amdgcn_s_setprio(1); _Pragma("unroll") for (int m = 0; m < 4; ++m) _Pragma("unroll") for (int n = 0; n < 2; ++n) _Pragma("unroll") for (int k = 0; k < 2; ++k) \
        acc[ai][bj][m][n] = __builtin_amdgcn_mfma_f32_16x16x32_bf16(Bt[n][k], At[m][k], acc[ai][bj][m][n], 0, 0, 0); __builtin_amdgcn_s_setprio(0); } while (0)
#define PG8_WAIT_V(n) asm volatile("s_waitcnt vmcnt(" #n ")" ::: "memory")
#define PG8_WAIT_L(n) asm volatile("s_waitcnt lgkmcnt(" #n ")" ::: "memory")
#define PG8_BAR __builtin_amdgcn_s_barrier()
#define PG8_SCHED __builtin_amdgcn_sched_barrier(0)
    Unit cur, nxt; int ui = 0;
    if (!S.next(0, cur)) return;
    f32x4 acc[2][2][4][2];
#pragma unroll
    for (int a = 0; a < 2; ++a)
#pragma unroll
        for (int b = 0; b < 2; ++b)
#pragma unroll
            for (int m = 0; m < 4; ++m)
#pragma unroll
                for (int n = 0; n < 2; ++n) acc[a][b][m][n] = (f32x4){0.f, 0.f, 0.f, 0.f};
    bf16x8 At[4][2], B0[2][2], B1[2][2];
    unsigned voA[2][2], nvoA[2][2];
    PG8_VOA(cur, voA);
    if (Sched::GATHER) { asm volatile("s_waitcnt vmcnt(0)" ::: "memory"); }
    const char* cA = S.a_ptr(cur); const char* cB = S.b_ptr(cur);
    cur.par = 0; E.stage_rows(cur, lds, wid);
    PG8_STGB(PG8_SB(0, 0), cB); PG8_STGB(PG8_SB(0, 1), cB + hstep); PG8_STGA(PG8_SA(0, 0), cA, voA, 0); PG8_STGA(PG8_SA(0, 1), cA, voA, 1);
    if (wr == 1) PG8_BAR;
    PG8_WAIT_V(2); PG8_BAR;
    PG8_STGB(PG8_SB(1, 0), cB + kstep); PG8_STGA(PG8_SA(1, 0), cA + kstep, voA, 0); PG8_STGB(PG8_SB(1, 1), cB + hstep + kstep);
    PG8_WAIT_V(6); PG8_BAR;
    for (;;) {
        const bool has_next = S.next(ui + 1, nxt); nxt.par = (ui + 1) & 1;
        const char* nA = has_next ? S.a_ptr(nxt) : cA; const char* nB = has_next ? S.b_ptr(nxt) : cB;
        if (Sched::GATHER) { if (has_next) { PG8_VOA(nxt, nvoA); } else {
#pragma unroll
            for (int h = 0; h < 2; ++h)
#pragma unroll
                for (int i = 0; i < 2; ++i) nvoA[h][i] = voA[h][i]; } }
#pragma unroll 1
        for (int t = 0; t < nt; t += 2) {
            const bool last = (t == nt - 2);
            const char* a1 = cA + (size_t)(t + 1) * kstep;
            const char* a2 = last ? nA : cA + (size_t)(t + 2) * kstep; const char* b2 = last ? nB : cB + (size_t)(t + 2) * kstep;
            const char* a3 = a2 + kstep; const char* b3 = b2 + kstep;
            unsigned vo2[2][2];
#pragma unroll
            for (int h = 0; h < 2; ++h)
#pragma unroll
                for (int i = 0; i < 2; ++i) vo2[h][i] = (Sched::GATHER && last) ? nvoA[h][i] : voA[h][i];
            if (last && has_next) E.stage_rows(nxt, lds, wid);
            PG8_LDB(B0, 0, 0); PG8_LDB(B1, 0, 1); PG8_SCHED; PG8_LDA(At, 0, 0); PG8_STGA(PG8_SA(1, 1), a1, voA, 1);
            PG8_WAIT_V(8); PG8_WAIT_L(0); PG8_BAR; PG8_MMA(0, 0, At, B0); PG8_MMA(0, 1, At, B1); PG8_BAR; PG8_SCHED;
            PG8_LDA(At, 0, 1); PG8_STGB(PG8_SB(0, 0), b2); PG8_STGB(PG8_SB(0, 1), b2 + hstep); PG8_STGA(PG8_SA(0, 0), a2, vo2, 0);
            PG8_WAIT_V(8); PG8_WAIT_L(0); PG8_BAR; PG8_MMA(1, 0, At, B0); PG8_MMA(1, 1, At, B1); PG8_BAR; PG8_SCHED;
            PG8_LDB(B0, 1, 0); PG8_LDB(B1, 1, 1); PG8_SCHED; PG8_LDA(At, 1, 0); PG8_STGA(PG8_SA(0, 1), a2, vo2, 1);
            PG8_WAIT_V(8); PG8_WAIT_L(0); PG8_BAR; PG8_MMA(0, 0, At, B0); PG8_MMA(0, 1, At, B1); PG8_BAR; PG8_SCHED;
            PG8_LDA(At, 1, 1); PG8_STGB(PG8_SB(1, 0), b3); PG8_STGB(PG8_SB(1, 1), b3 + hstep); PG8_STGA(PG8_SA(1, 0), a3, vo2, 0);
            PG8_WAIT_V(8); PG8_WAIT_L(0); PG8_BAR; PG8_MMA(1, 0, At, B0); PG8_MMA(1, 1, At, B1); PG8_BAR; PG8_SCHED;
        }
        if constexpr (ALIGN_EPI) { if (wr == 0) PG8_BAR; }
        E(acc, cur, wr, wc, fr, fq);
        if (!has_next) break;
#pragma unroll
        for (int a = 0; a < 2; ++a)
#pragma unroll
            for (int b = 0; b < 2; ++b)
#pragma unroll
                for (int m = 0; m < 4; ++m)
#pragma unroll
                    for (int n = 0; n < 2; ++n) acc[a][b][m][n] = (f32x4){0.f, 0.f, 0.f, 0.f};
        cur = nxt; cA = nA; cB = nB; ++ui;
        if (Sched::GATHER) {
#pragma unroll
            for (int h = 0; h < 2; ++h)
#pragma unroll
                for (int i = 0; i < 2; ++i) voA[h][i] = nvoA[h][i]; }
        if constexpr (ALIGN_EPI) { if (wr == 1) PG8_BAR; }
    }
    PG8_WAIT_V(0);
    if constexpr (!ALIGN_EPI) { if (wr == 0) PG8_BAR; }
    PG8_BAR;
#undef PG8_SA
#undef PG8_SB
#undef PG8_STGA
#undef PG8_STGB
#undef PG8_VOA
#undef PG8_LDA
#undef PG8_LDB
#undef PG8_MMA
#undef PG8_WAIT_V
#undef PG8_WAIT_L
#undef PG8_BAR
#undef PG8_SCHED
}

typedef f32x4 Acc[2][2][4][2];
struct EpiInProj {
    static constexpr bool PERM = true;
    __device__ __forceinline__ void stage_rows(const Unit&, LAS unsigned char*, int) const {}
    bf16_t *prw, *puv, *pg;
    template <int ACT> __device__ __forceinline__ void tile(const Acc& acc, bf16_t* base, int ld, int row0, int col0) const {
#pragma unroll
        for (int ai = 0; ai < 2; ++ai)
#pragma unroll
            for (int m = 0; m < 4; ++m) { bf16_t* rowp = base + (size_t)(row0 + ai * HALF + m * 16) * ld + col0;
#pragma unroll
                for (int bj = 0; bj < 2; ++bj) { f32x4 v0 = acc[ai][bj][m][0], v1 = acc[ai][bj][m][1];
                    if (ACT == 1) {
#pragma unroll
                        for (int j = 0; j < 4; ++j) { v0[j] = gelu_tanh(v0[j]); v1[j] = gelu_tanh(v1[j]); } }
                    if (ACT == 2) {
#pragma unroll
                        for (int j = 0; j < 4; ++j) { v0[j] = sigmoidf_(v0[j]); v1[j] = sigmoidf_(v1[j]); } }
                    u32x4 w; w.x = pk2(v0[0], v0[1]); w.y = pk2(v0[2], v0[3]); w.z = pk2(v1[0], v1[1]); w.w = pk2(v1[2], v1[3]);
                    *(u32x4*)(rowp + bj * HALF) = w; }
                __builtin_amdgcn_sched_barrier(0); }
    }
    __device__ __forceinline__ void operator()(const Acc& acc, const Unit& u, int wr, int wc, int fr, int fq) const {
        const int row0 = u.row0 + wr * 64 + fr, cw = wc * 32 + 8 * fq;
        if (u.pn < 7) tile<0>(acc, prw, RWKV_COLS, row0, u.pn * 256 + cw);
        else if (u.pn < 11) tile<1>(acc, puv, 1024, row0, (u.pn - 7) * 256 + cw);
        else tile<2>(acc, pg, 2048, row0, (u.pn - 11) * 256 + cw);
    }
};
template <bool SECOND> struct EpiMerge {
    static constexpr bool PERM = true;
    __device__ __forceinline__ void stage_rows(const Unit&, LAS unsigned char*, int) const {}
    bf16_t* m1; const bf16_t* pg;
    __device__ __forceinline__ void operator()(const Acc& acc, const Unit& u, int wr, int wc, int fr, int fq) const {
        const int row0 = u.row0 + wr * 64 + fr, col0 = u.pn * 256 + wc * 32 + 8 * fq;
#pragma unroll
        for (int ai = 0; ai < 2; ++ai)
#pragma unroll
            for (int m = 0; m < 4; ++m) { const size_t r = (size_t)(row0 + ai * HALF + m * 16);
#pragma unroll
                for (int bj = 0; bj < 2; ++bj) { const int c = col0 + bj * HALF;
                    const u32x4 g = *(const u32x4*)(pg + r * 2048 + (SECOND ? 1024 : 0) + c);
                    f32x4 v0 = acc[ai][bj][m][0], v1 = acc[ai][bj][m][1];
                    v0[0] *= bflo(g.x); v0[1] *= bfhi(g.x); v0[2] *= bflo(g.y); v0[3] *= bfhi(g.y); v1[0] *= bflo(g.z); v1[1] *= bfhi(g.z); v1[2] *= bflo(g.w); v1[3] *= bfhi(g.w);
                    if (SECOND) { const u32x4 p = *(const u32x4*)(m1 + r * 1024 + c);
                        v0[0] += bflo(p.x); v0[1] += bfhi(p.x); v0[2] += bflo(p.y); v0[3] += bfhi(p.y); v1[0] += bflo(p.z); v1[1] += bfhi(p.z); v1[2] += bflo(p.w); v1[3] += bfhi(p.w); }
                    u32x4 w; w.x = pk2(v0[0], v0[1]); w.y = pk2(v0[2], v0[3]); w.z = pk2(v1[0], v1[1]); w.w = pk2(v1[2], v1[3]);
                    *(u32x4*)(m1 + r * 1024 + c) = w; } }
    }
};
struct EpiResid {
    static constexpr bool PERM = false;
    __device__ __forceinline__ void stage_rows(const Unit&, LAS unsigned char*, int) const {}
    float* out; const float* base; const float* gate;
    __device__ __forceinline__ void operator()(const Acc& acc, const Unit& u, int wr, int wc, int fr, int fq) const {
        const int row0 = u.row0 + wr * 64 + fr, col0 = u.pn * 256 + wc * 32 + 4 * fq;
        const float* gp = gate + (size_t)(u.row0 >> 13) * 6144 + col0;
        f32x4 gv[2][2];
#pragma unroll
        for (int bj = 0; bj < 2; ++bj)
#pragma unroll
            for (int n = 0; n < 2; ++n) gv[bj][n] = *(const f32x4*)(gp + bj * HALF + n * 16);
#pragma unroll
        for (int ai = 0; ai < 2; ++ai)
#pragma unroll
            for (int m = 0; m < 4; ++m) { const size_t ro = (size_t)(row0 + ai * HALF + m * 16) * 1024 + col0;
#pragma unroll
                for (int bj = 0; bj < 2; ++bj)
#pragma unroll
                    for (int n = 0; n < 2; ++n) { const f32x4 b = *(const f32x4*)(base + ro + bj * HALF + n * 16);
                        *(f32x4*)(out + ro + bj * HALF + n * 16) = b + gv[bj][n] * acc[ai][bj][m][n]; } }
    }
};
struct EpiRouter {
    static constexpr bool PERM = false;
    __device__ __forceinline__ void stage_rows(const Unit&, LAS unsigned char*, int) const {}
    float* sc;
    __device__ __forceinline__ void operator()(const Acc& acc, const Unit& u, int wr, int wc, int fr, int fq) const {
        const int row0 = u.row0 + wr * 64 + fr, col0 = wc * 32 + 4 * fq;
#pragma unroll
        for (int ai = 0; ai < 2; ++ai)
#pragma unroll
            for (int m = 0; m < 4; ++m) { float* rowp = sc + (size_t)(row0 + ai * HALF + m * 16) * 256 + col0;
#pragma unroll
                for (int bj = 0; bj < 2; ++bj)
#pragma unroll
                    for (int n = 0; n < 2; ++n) { f32x4 v = acc[ai][bj][m][n];
#pragma unroll
                        for (int j = 0; j < 4; ++j) v[j] = sigmoidf_(v[j]);
                        *(f32x4*)(rowp + bj * HALF + n * 16) = v; }
                __builtin_amdgcn_sched_barrier(0); }
    }
};
struct EpiGateUp {
    static constexpr bool PERM = true;
    __device__ __forceinline__ void stage_rows(const Unit&, LAS unsigned char*, int) const {}
    bf16_t* hid;
    __device__ __forceinline__ void operator()(const Acc& acc, const Unit& u, int wr, int wc, int fr, int fq) const {
        const int row0 = u.row0 + wr * 64 + fr, col0 = u.pn * HALF + wc * 32 + 8 * fq;
#pragma unroll
        for (int ai = 0; ai < 2; ++ai)
#pragma unroll
            for (int m = 0; m < 4; ++m) { bf16_t* rowp = hid + (size_t)(row0 + ai * HALF + m * 16) * EFF + col0;
                f32x4 v0, v1;
#pragma unroll
                for (int j = 0; j < 4; ++j) { v0[j] = siluf_(acc[ai][0][m][0][j]) * acc[ai][1][m][0][j]; v1[j] = siluf_(acc[ai][0][m][1][j]) * acc[ai][1][m][1][j]; }
                u32x4 w; w.x = pk2(v0[0], v0[1]); w.y = pk2(v0[2], v0[3]); w.z = pk2(v1[0], v1[1]); w.w = pk2(v1[2], v1[3]);
                *(u32x4*)rowp = w; __builtin_amdgcn_sched_barrier(0); }
    }
};
struct EpiExpertDown {
    static constexpr bool PERM = true;
    unsigned char* slot; const int* rowdst; const float* roww;
    __device__ __forceinline__ void stage_rows(const Unit& u, LAS unsigned char* lds, int wid) const {
        if (wid < 4) { const int lane = threadIdx.x & 63; LAS unsigned char* base = lds + LDS_MISC + u.par * 2048 + wid * 256;
            __builtin_amdgcn_global_load_lds((const unsigned*)(rowdst + u.row0 + wid * 64 + lane), (LAS unsigned*)base, 4, 0, 0);
            __builtin_amdgcn_global_load_lds((const unsigned*)(roww + u.row0 + wid * 64 + lane), (LAS unsigned*)(base + 1024), 4, 0, 0); }
    }
    __device__ __forceinline__ void operator()(const Acc& acc, const Unit& u, int wr, int wc, int fr, int fq) const {
        const unsigned cb = (unsigned)(u.pn * 256 + wc * 32 + 8 * fq);
        const LAS int* td = (const LAS int*)((LAS unsigned char*)nullptr + LDS_MISC + u.par * 2048) + wr * 64 + fr; const LAS float* tw = (const LAS float*)(td + 256);
#pragma unroll
        for (int ai = 0; ai < 2; ++ai)
#pragma unroll
            for (int m = 0; m < 4; ++m) {
                const int dst = td[ai * HALF + m * 16]; const float ws_ = tw[ai * HALF + m * 16];
                if (dst >= 0) { unsigned char* rowp = slot + (size_t)((unsigned)dst * 1024u + cb);
#pragma unroll
                    for (int bj = 0; bj < 2; ++bj) { const f32x4 v0 = acc[ai][bj][m][0] * ws_, v1 = acc[ai][bj][m][1] * ws_;
                        *(u32x2*)(rowp + bj * HALF) = pk8(v0, v1); } }
                __builtin_amdgcn_sched_barrier(0);
            }
    }
};
struct EpiSharedDown {
    static constexpr bool PERM = true;
    unsigned char* sho;
    __device__ __forceinline__ void stage_rows(const Unit&, LAS unsigned char*, int) const {}
    __device__ __forceinline__ void operator()(const Acc& acc, const Unit& u, int wr, int wc, int fr, int fq) const {
        const int row0 = u.row0 + wr * 64 + fr, col0 = u.pn * 256 + wc * 32 + 8 * fq;
#pragma unroll
        for (int ai = 0; ai < 2; ++ai)
#pragma unroll
            for (int m = 0; m < 4; ++m) { unsigned char* rowp = sho + (size_t)(row0 + ai * HALF + m * 16) * 1024 + col0;
#pragma unroll
                for (int bj = 0; bj < 2; ++bj) *(u32x2*)(rowp + bj * HALF) = pk8(acc[ai][bj][m][0], acc[ai][bj][m][1]);
                __builtin_amdgcn_sched_barrier(0); }
    }
};
}
__device__ __forceinline__ void phase_mod(const float* c, const float* ada_w, const float* ada_b, float* mod, LAS unsigned char* lds, int tid, int G) {
    LAS float* sl = (LAS float*)lds; LAS float* red = (LAS float*)(lds + 32768);
    for (int i = tid; i < NB * D; i += NTHREADS) { const float v = c[i]; sl[i] = siluf_(v); }
    __syncthreads();
    const int cl = tid % 24, kg = tid / 24;
    for (int cb = blockIdx.x; cb < 256; cb += G) {
        const int col0 = cb * 24;
        if (tid < 384) {
            float a[NB];
#pragma unroll
            for (int b = 0; b < NB; ++b) a[b] = 0.f;
            for (int k = kg; k < D; k += 16) { const float w = ada_w[(size_t)k * 6144 + col0 + cl];
#pragma unroll
                for (int b = 0; b < NB; ++b) a[b] += sl[b * D + k] * w; }
#pragma unroll
            for (int b = 0; b < NB; ++b) red[(kg * 24 + cl) * NB + b] = a[b];
        }
        __syncthreads();
        if (tid < 192) { const int c2 = tid >> 3, b = tid & 7; float s = 0.f;
#pragma unroll
            for (int g = 0; g < 16; ++g) s += red[(g * 24 + c2) * NB + b];
            mod[(size_t)b * 6144 + col0 + c2] = s + ada_b[col0 + c2]; }
        __syncthreads();
    }
}
__device__ __forceinline__ void transpose_item(const float* W, int ldw, int k0, int n0, bf16_t* WT, int ldt, int drow0, LAS float* scr, int lane) {
#pragma unroll 8
    for (int i = 0; i < 32; ++i) { const int kk = 2 * i + (lane >> 5); scr[kk * 33 + (lane & 31)] = W[(size_t)(k0 + kk) * ldw + n0 + (lane & 31)]; }
    LDS_WAIT(); asm volatile("" ::: "memory");
    const int c = lane & 7;
#pragma unroll
    for (int j = 0; j < 4; ++j) { const int n = (lane >> 3) + 8 * j; const LAS float* s = scr + (8 * c) * 33 + n;
        u32x4 o; o.x = pk2(s[0 * 33], s[1 * 33]); o.y = pk2(s[2 * 33], s[3 * 33]); o.z = pk2(s[4 * 33], s[5 * 33]); o.w = pk2(s[6 * 33], s[7 * 33]);
        *(u32x4*)(WT + (size_t)(drow0 + n) * ldt + k0 + 8 * c) = o; }
    LDS_WAIT(); asm volatile("" ::: "memory");
}
__device__ __forceinline__ void transpose_job(const float* W, int K, int N, bf16_t* WT, int gated, int goff, int item, LAS float* scr, int lane) {
    const int nblk = N / 32, kb = item / nblk, nb = item % nblk, n0 = 32 * nb;
    const int drow0 = gated ? (256 * (n0 >> 7) + goff + (n0 & 127)) : n0;
    transpose_item(W, N, 64 * kb, n0, WT, K, drow0, scr, lane);
}
struct SmallW { const float *w_in, *w_out_a, *w_out_b, *w_out, *router_w, *sw1, *sw3, *sw2, *w_up, *a_up, *g_up, *gws; };
__device__ __forceinline__ void phase_small_weights(const SmallW& P, unsigned char* ws, LAS unsigned char* lds, int gw, int NGW, int wave, int lane) {
    LAS float* scr = (LAS float*)(lds + 49152 + wave * 8704);
    constexpr int I0 = 16 * 152, I1 = 8 * 32, I2 = 8 * 32, I3 = 16 * 32, I4 = 16 * 8, I5 = 16 * 8, I6 = 16 * 8, I7 = 4 * 32, I8 = 16, I9 = 16, I10 = 2 * 16;
    constexpr int NIT = I0 + I1 + I2 + I3 + I4 + I5 + I6 + I7 + I8 + I9 + I10;
    for (int it = gw; it < NIT; it += NGW) {
        int r = it;
        if (r < I0) { transpose_job(P.w_in, D, IN_COLS, (bf16_t*)(ws + SW_WIN), 0, 0, r, scr, lane); continue; } r -= I0;
        if (r < I1) { transpose_job(P.w_out_a, RW, D, (bf16_t*)(ws + SW_WOA), 0, 0, r, scr, lane); continue; } r -= I1;
        if (r < I2) { transpose_job(P.w_out_b, RW, D, (bf16_t*)(ws + SW_WOB), 0, 0, r, scr, lane); continue; } r -= I2;
        if (r < I3) { transpose_job(P.w_out, D, D, (bf16_t*)(ws + SW_WO), 0, 0, r, scr, lane); continue; } r -= I3;
        if (r < I4) { transpose_job(P.router_w, D, NE, (bf16_t*)(ws + SW_WR), 0, 0, r, scr, lane); continue; } r -= I4;
        if (r < I5) { transpose_job(P.sw1, D, EFF, (bf16_t*)(ws + SW_WS13), 1, 0, r, scr, lane); continue; } r -= I5;
        if (r < I6) { transpose_job(P.sw3, D, EFF, (bf16_t*)(ws + SW_WS13), 1, 128, r, scr, lane); continue; } r -= I6;
        if (r < I7) { transpose_job(P.sw2, EFF, D, (bf16_t*)(ws + SW_WS2), 0, 0, r, scr, lane); continue; } r -= I7;
        if (r < I8) { transpose_job(P.w_up, 64, RW, (bf16_t*)(ws + SW_WUP), 0, 0, r, scr, lane); continue; } r -= I8;
        if (r < I9) { transpose_job(P.a_up, 64, RW, (bf16_t*)(ws + SW_AUP), 0, 0, r, scr, lane); continue; } r -= I9;
        transpose_job(P.g_up, 128, RW, (bf16_t*)(ws + SW_GUP), 0, 0, r, scr, lane);
    }
    bf16_t* wsm = (bf16_t*)(ws + SW_WSM);
    for (int i = gw * 64 + lane; i < 8 * 128 * 128; i += NGW * 64) { const int col = i & 127, row = (i >> 7) & 127; wsm[i] = (col <= row) ? f2bf(P.gws[i]) : (bf16_t)0; }
}
__device__ __forceinline__ void transpose_item64(const float* W, int ldw, int k0, int n0, bf16_t* WT, int ldt, int drow0, LAS float* scr, int lane) {
    f32x4 v[16];
    const int c4 = lane & 15, r4 = lane >> 4;
#pragma unroll
    for (int i = 0; i < 16; ++i) v[i] = *(const f32x4*)(W + (size_t)(k0 + 4 * i + r4) * ldw + n0 + 4 * c4);
#pragma unroll
    for (int i = 0; i < 16; ++i) { LAS float* d = scr + (4 * i + r4) * 65 + 4 * c4; d[0] = v[i].x; d[1] = v[i].y; d[2] = v[i].z; d[3] = v[i].w; }
    LDS_WAIT(); asm volatile("" ::: "memory");
    const int c = lane & 7;
#pragma unroll
    for (int j = 0; j < 8; ++j) { const int n = (lane >> 3) + 8 * j; const LAS float* s = scr + (8 * c) * 65 + n;
        u32x4 o; o.x = pk2(s[0 * 65], s[1 * 65]); o.y = pk2(s[2 * 65], s[3 * 65]); o.z = pk2(s[4 * 65], s[5 * 65]); o.w = pk2(s[6 * 65], s[7 * 65]);
        *(u32x4*)(WT + (size_t)(drow0 + n) * ldt + k0 + 8 * c) = o; }
    LDS_WAIT(); asm volatile("" ::: "memory");
}
__device__ __forceinline__ void phase_expert_weights(const float* w1, const float* w3, const float* w2, unsigned char* ws, LAS unsigned char* lds, int gw, int NGW, int wave, int lane) {
    LAS float* scr = (LAS float*)(lds + wave * 16640);
    constexpr int PER = 64;
    for (int it = gw; it < NE * 3 * PER; it += NGW) {
        const int e = it / (3 * PER), r = it % (3 * PER), which = r / PER, item = r % PER;
        if (which < 2) { const int kb = item >> 2, nb = item & 3, n0 = 64 * nb;
            transpose_item64((which ? w3 : w1) + (size_t)e * D * EFF, EFF, 64 * kb, n0, (bf16_t*)(ws + B_W13) + (size_t)e * 512 * D, D, 256 * (n0 >> 7) + which * 128 + (n0 & 127), scr, lane); }
        else { const int kb = item >> 4, nb = item & 15;
            transpose_item64(w2 + (size_t)e * EFF * D, D, 64 * kb, 64 * nb, (bf16_t*)(ws + B_W2) + (size_t)e * D * EFF, EFF, 64 * nb, scr, lane); }
    }
}
__device__ __forceinline__ void phase_norm_mod(const float* X, const float* gain, const float* mod, int sh_off, int sc_off, bf16_t* out, int gw, int NGW, int lane) {
    constexpr int R = 4;
    for (int m0 = gw; m0 < T; m0 += R * NGW) {
        f32x4 v[R][4];
#pragma unroll
        for (int rr = 0; rr < R; ++rr) { const int m = m0 + rr * NGW; const f32x4* xr = (const f32x4*)(X + (size_t)(m < T ? m : m0) * D) + lane;
#pragma unroll
            for (int j = 0; j < 4; ++j) v[rr][j] = xr[64 * j]; }
#pragma unroll
        for (int rr = 0; rr < R; ++rr) { const int m = m0 + rr * NGW; if (m >= T) break;
            float ss = 0.f;
#pragma unroll
            for (int j = 0; j < 4; ++j) ss += (v[rr][j].x * v[rr][j].x + v[rr][j].y * v[rr][j].y) + (v[rr][j].z * v[rr][j].z + v[rr][j].w * v[rr][j].w);
            const float rstd = __builtin_amdgcn_rsqf(wave_sum(ss) * (1.f / D) + 1e-6f);
            const float* mb = mod + (size_t)(m >> 13) * 6144;
            u32x2* o8 = (u32x2*)(out + (size_t)m * D) + lane;
#pragma unroll
            for (int j = 0; j < 4; ++j) { const int col = 4 * lane + 256 * j;
                const f32x4 g = *(const f32x4*)(gain + col), sc = *(const f32x4*)(mb + sc_off + col), sh = *(const f32x4*)(mb + sh_off + col);
                const f32x4 y = v[rr][j] * rstd * g * (sc + 1.0f) + sh;
                u32x2 w; w.x = pk2(y.x, y.y); w.y = pk2(y.z, y.w); o8[64 * j] = w; } }
    }
}
struct YaArgs { bf16_t* ya; const bf16_t* g; const bf16_t* prw; const float* sbon; const float* mu; const float* ln_g; const float* ln_b; };
__device__ __forceinline__ void phase_ya_final(const YaArgs& P, int gw, int NGW, int lane) {
    const int ch0 = lane * 8, head = lane >> 3;
    float muv[8], lg[8], lb[8];
#pragma unroll
    for (int j = 0; j < 8; ++j) { muv[j] = P.mu[1024 + ch0 + j]; lg[j] = P.ln_g[ch0 + j]; lb[j] = P.ln_b[ch0 + j]; }
    for (int m = gw; m < T; m += NGW) {
        const u32x4 yw = *(const u32x4*)(P.ya + (size_t)m * RW + ch0);
        const u32x4 gw4 = *(const u32x4*)(P.g + (size_t)m * RW + ch0);
        const u32x4 vc = *(const u32x4*)(P.prw + (size_t)m * RWKV_COLS + 1024 + ch0);
        u32x4 vp = (u32x4){0u, 0u, 0u, 0u};
        if ((m & (SEQ - 1)) != 0) vp = *(const u32x4*)(P.prw + (size_t)(m - 1) * RWKV_COLS + 1024 + ch0);
        const float sb = P.sbon[(size_t)m * NH + head];
        float y[8], gg[8], vv[8], pv[8];
        y[0] = bflo(yw.x); y[1] = bfhi(yw.x); y[2] = bflo(yw.y); y[3] = bfhi(yw.y); y[4] = bflo(yw.z); y[5] = bfhi(yw.z); y[6] = bflo(yw.w); y[7] = bfhi(yw.w);
        gg[0] = bflo(gw4.x); gg[1] = bfhi(gw4.x); gg[2] = bflo(gw4.y); gg[3] = bfhi(gw4.y); gg[4] = bflo(gw4.z); gg[5] = bfhi(gw4.z); gg[6] = bflo(gw4.w); gg[7] = bfhi(gw4.w);
        vv[0] = bflo(vc.x); vv[1] = bfhi(vc.x); vv[2] = bflo(vc.y); vv[3] = bfhi(vc.y); vv[4] = bflo(vc.z); vv[5] = bfhi(vc.z); vv[6] = bflo(vc.w); vv[7] = bfhi(vc.w);
        pv[0] = bflo(vp.x); pv[1] = bfhi(vp.x); pv[2] = bflo(vp.y); pv[3] = bfhi(vp.y); pv[4] = bflo(vp.z); pv[5] = bfhi(vp.z); pv[6] = bflo(vp.w); pv[7] = bfhi(vp.w);
        float s = 0.f;
#pragma unroll
        for (int j = 0; j < 8; ++j) s += y[j];
        s += __shfl_xor(s, 1); s += __shfl_xor(s, 2); s += __shfl_xor(s, 4);
        const float mean = s * (1.f / 64.f); float q = 0.f;
#pragma unroll
        for (int j = 0; j < 8; ++j) { y[j] -= mean; q += y[j] * y[j]; }
        q += __shfl_xor(q, 1); q += __shfl_xor(q, 2); q += __shfl_xor(q, 4);
        const float rstd = __builtin_amdgcn_rsqf(q * (1.f / 64.f) + 64e-5f);
        float o[8];
#pragma unroll
        for (int j = 0; j < 8; ++j) { const float vs = vv[j] + (pv[j] - vv[j]) * muv[j]; o[j] = (y[j] * rstd * lg[j] + lb[j] + sb * vs) * gg[j]; }
        u32x4 w; w.x = pk2(o[0], o[1]); w.y = pk2(o[2], o[3]); w.z = pk2(o[4], o[5]); w.w = pk2(o[6], o[7]);
        *(u32x4*)(P.ya + (size_t)m * RW + ch0) = w;
    }
}
__device__ __forceinline__ void phase_combine(float* out, const unsigned char* slot, const unsigned char* sho, const float* mod, const float* normf, int gw, int NGW, int lane) {
    for (int m = gw; m < T; m += NGW) {
        const int b = m >> 13;
        f32x4* xr = (f32x4*)(out + (size_t)m * D + 16 * lane);
        const float* g2 = mod + (size_t)b * 6144 + 5120 + 16 * lane;
        u32x4 sw[TOPK + 1];
#pragma unroll
        for (int k = 0; k < TOPK; ++k) sw[k] = *(const u32x4*)(slot + ((size_t)m * TOPK + k) * D + 16 * lane);
        sw[TOPK] = *(const u32x4*)(sho + (size_t)m * D + 16 * lane);
        f32x4 x[4];
#pragma unroll
        for (int j = 0; j < 4; ++j) x[j] = xr[j];
        f32x4 a[4];
#pragma unroll
        for (int j = 0; j < 4; ++j) a[j] = (f32x4){0.f, 0.f, 0.f, 0.f};
#pragma unroll
        for (int k = 0; k <= TOPK; ++k) { a[0] += up8(sw[k].x); a[1] += up8(sw[k].y); a[2] += up8(sw[k].z); a[3] += up8(sw[k].w); }
        float ss = 0.f;
#pragma unroll
        for (int j = 0; j < 4; ++j) { x[j] = x[j] + *(const f32x4*)(g2 + 4 * j) * a[j]; ss += (x[j].x * x[j].x + x[j].y * x[j].y) + (x[j].z * x[j].z + x[j].w * x[j].w); }
        const float rstd = __builtin_amdgcn_rsqf(wave_sum(ss) * (1.f / D) + 1e-6f);
#pragma unroll
        for (int j = 0; j < 4; ++j) xr[j] = x[j] * rstd * *(const f32x4*)(normf + 16 * lane + 4 * j);
    }
}
namespace rk {
constexpr int LD = 72;
constexpr int SLOTB = 64 * LD * 2;
constexpr int LDG = 136;
typedef LAS bf16_t* lp;
__device__ __forceinline__ lp slot(LAS unsigned char* lds, int i) { return (lp)(lds + i * SLOTB); }
template <int KS>
__device__ __forceinline__ void mm_nt(const LAS bf16_t* X, int ldx, const LAS bf16_t* Y, int ldy, int m, int nt0, int r, int q, f32x4 (&acc)[2]) {
#pragma unroll
    for (int s = 0; s < KS; ++s) {
        const bf16x8 a = *(const LAS bf16x8*)(X + (16 * m + r) * ldx + 32 * s + 8 * q);
#pragma unroll
        for (int n = 0; n < 2; ++n) { const bf16x8 b = *(const LAS bf16x8*)(Y + (16 * (nt0 + n) + r) * ldy + 32 * s + 8 * q); acc[n] = __builtin_amdgcn_mfma_f32_16x16x32_bf16(a, b, acc[n], 0, 0, 0); }
    }
}
__device__ __forceinline__ void st_rm(lp dst, int m, int nt, int r, int q, const f32x4& a) {
#pragma unroll
    for (int ii = 0; ii < 4; ++ii) dst[(16 * m + 4 * q + ii) * LD + 16 * nt + r] = f2bf(a[ii]);
}
__device__ __forceinline__ void st_tr(lp dst, int m, int nt, int r, int q, const f32x4& a) {
    u32x2 w; w.x = pk2(a[0], a[1]); w.y = pk2(a[2], a[3]); *(LAS u32x2*)(dst + (16 * nt + r) * LD + 16 * m + 4 * q) = w;
}
__device__ __forceinline__ void ld_rm(const LAS bf16_t* src, int m, int nt, int r, int q, f32x4& a) {
#pragma unroll
    for (int ii = 0; ii < 4; ++ii) a[ii] = bf2f(src[(16 * m + 4 * q + ii) * LD + 16 * nt + r]);
}
struct Args {
    const bf16_t* prw; const float* mu; const float *w0, *a0, *k_k, *k_a, *r_k;
    const bf16_t *wup, *aup, *gup;
    bf16_t* g; bf16_t* bv; unsigned char* mn; unsigned char* qy;
};
constexpr int LDS_MU = 155904;
struct Pre { u32x4 cw[7], pw[7]; };
__device__ __forceinline__ void task_map(int task, int h, int& i, int& ch, int& col) {
    i = task / 56; ch = task % 56;
    if (ch < 8) col = h * 64 + 8 * ch; else if (ch < 16) col = 512 + h * 64 + 8 * (ch - 8); else if (ch < 24) col = 1024 + h * 64 + 8 * (ch - 16);
    else if (ch < 32) col = 1536 + 8 * (ch - 24); else if (ch < 40) col = 1600 + 8 * (ch - 32); else col = 1664 + 8 * (ch - 40);
}
__device__ __forceinline__ void load_mu(const Args& P, LAS unsigned char* lds, int tid) {
    LAS float* MU = (LAS float*)(lds + LDS_MU);
    for (int i = tid; i < RWKV_COLS; i += NTHREADS) MU[i] = P.mu[i];
    __syncthreads();
}
__device__ __forceinline__ void prefetch(const Args& P, int b, int h, int c, int tid, Pre& pre) {
    const int t0 = b * SEQ + c * 64;
#pragma unroll
    for (int it = 0; it < 7; ++it) {
        int i, ch, col; task_map(tid + it * NTHREADS, h, i, ch, col);
        const bf16_t* src = P.prw + (size_t)(t0 + i) * RWKV_COLS + col;
        pre.cw[it] = *(const u32x4*)src;
        pre.pw[it] = (u32x4){0u, 0u, 0u, 0u};
        if (i != 0 || c != 0) pre.pw[it] = *(const u32x4*)(src - RWKV_COLS);
    }
}
__device__ __forceinline__ void unit(const Args& P, LAS unsigned char* lds, int b, int h, int c, int uidx, int tid, Pre& pf, bool has_next, int nb, int nh_, int nc) {
    const int wave = __builtin_amdgcn_readfirstlane(tid >> 6), lane = tid & 63, r = lane & 15, q = lane >> 4, m = wave & 3, nh = wave >> 2;
    const int t0 = b * SEQ + c * 64;
    lp S0 = slot(lds, 0), S1 = slot(lds, 1), S2 = slot(lds, 2), S3 = slot(lds, 3), S4 = slot(lds, 4), S5 = slot(lds, 5), S6 = slot(lds, 6), S7 = slot(lds, 7);
    lp S8 = slot(lds, 8), S9 = slot(lds, 9), S10 = slot(lds, 10), S11 = slot(lds, 11), S12 = slot(lds, 12), S13 = slot(lds, 13), S14 = slot(lds, 14), S15 = slot(lds, 15);
    LAS float* PART = (LAS float*)(lds + LDS_MISC);
    LAS float* CT = PART + 256;
    LAS float* DEND = CT + 256;
    const LAS float* MU = (const LAS float*)(lds + LDS_MU);
#define RK_BAR() do { asm volatile("s_waitcnt lgkmcnt(0)" ::: "memory"); __builtin_amdgcn_s_barrier(); asm volatile("" ::: "memory"); } while (0)
#define RK_DBG(bit, sp) do {} while (0)
#pragma unroll
    for (int it = 0; it < 7; ++it) {
        int i, ch, col; task_map(tid + it * NTHREADS, h, i, ch, col);
        LAS bf16_t* dst; int act = 0;
        if (ch < 8) dst = S8 + i * LD + 8 * ch; else if (ch < 16) dst = S9 + i * LD + 8 * (ch - 8); else if (ch < 24) dst = S10 + i * LD + 8 * (ch - 16);
        else if (ch < 32) { dst = S11 + i * LD + 8 * (ch - 24); act = 1; } else if (ch < 40) dst = S12 + i * LD + 8 * (ch - 32); else { dst = S13 + i * LDG + 8 * (ch - 40); act = 2; }
        const u32x4 cw = pf.cw[it], pw = pf.pw[it];
        const f32x4 m0 = *(const LAS f32x4*)(MU + col), m1 = *(const LAS f32x4*)(MU + col + 4);
        float v[8], p[8];
        v[0] = bflo(cw.x); v[1] = bfhi(cw.x); v[2] = bflo(cw.y); v[3] = bfhi(cw.y); v[4] = bflo(cw.z); v[5] = bfhi(cw.z); v[6] = bflo(cw.w); v[7] = bfhi(cw.w);
        p[0] = bflo(pw.x); p[1] = bfhi(pw.x); p[2] = bflo(pw.y); p[3] = bfhi(pw.y); p[4] = bflo(pw.z); p[5] = bfhi(pw.z); p[6] = bflo(pw.w); p[7] = bfhi(pw.w);
#pragma unroll
        for (int j = 0; j < 4; ++j) { v[j] += (p[j] - v[j]) * m0[j]; v[4 + j] += (p[4 + j] - v[4 + j]) * m1[j]; }
        if (act == 1) {
#pragma unroll
            for (int j = 0; j < 8; ++j) v[j] = tanhf_(v[j]); }
        else if (act == 2) {
#pragma unroll
            for (int j = 0; j < 8; ++j) v[j] = sigmoidf_(v[j]); }
        u32x4 w; w.x = pk2(v[0], v[1]); w.y = pk2(v[2], v[3]); w.z = pk2(v[4], v[5]); w.w = pk2(v[6], v[7]);
        *(LAS u32x4*)dst = w;
    }
    if (has_next) prefetch(P, nb, nh_, nc, tid, pf);
    RK_BAR();
    f32x4 aw[2], aa[2], ag[2];
#pragma unroll
    for (int n = 0; n < 2; ++n) { aw[n] = (f32x4){0.f, 0.f, 0.f, 0.f}; aa[n] = aw[n]; ag[n] = aw[n]; }
#pragma unroll
    for (int s = 0; s < 2; ++s) {
        const bf16x8 xw = *(const LAS bf16x8*)(S11 + (16 * m + r) * LD + 32 * s + 8 * q), xa = *(const LAS bf16x8*)(S12 + (16 * m + r) * LD + 32 * s + 8 * q);
#pragma unroll
        for (int n = 0; n < 2; ++n) { const int row = h * 64 + 16 * (2 * nh + n) + r;
            const bf16x8 bw = *(const bf16x8*)(P.wup + (size_t)row * 64 + 32 * s + 8 * q), ba = *(const bf16x8*)(P.aup + (size_t)row * 64 + 32 * s + 8 * q);
            aw[n] = __builtin_amdgcn_mfma_f32_16x16x32_bf16(xw, bw, aw[n], 0, 0, 0); aa[n] = __builtin_amdgcn_mfma_f32_16x16x32_bf16(xa, ba, aa[n], 0, 0, 0); }
    }
#pragma unroll
    for (int s = 0; s < 4; ++s) {
        const bf16x8 xg = *(const LAS bf16x8*)(S13 + (16 * m + r) * LDG + 32 * s + 8 * q);
#pragma unroll
        for (int n = 0; n < 2; ++n) { const int row = h * 64 + 16 * (2 * nh + n) + r;
            const bf16x8 bg = *(const bf16x8*)(P.gup + (size_t)row * 128 + 32 * s + 8 * q);
            ag[n] = __builtin_amdgcn_mfma_f32_16x16x32_bf16(xg, bg, ag[n], 0, 0, 0); }
    }
    float rr[2][4], kq[2][4], vv[2][4], av[2][4], lw[2][4], kp[2][4], pre[2][4], preq[2];
    float ss[4] = {0.f, 0.f, 0.f, 0.f}, bs[4] = {0.f, 0.f, 0.f, 0.f};
#pragma unroll
    for (int n = 0; n < 2; ++n) {
        const int ch = 32 * nh + 16 * n + r, chg = h * 64 + ch;
        const float w0v = P.w0[chg], a0v = P.a0[chg], kkc = P.k_k[chg], kac = P.k_a[chg], rkc = P.r_k[chg];
#pragma unroll
        for (int ii = 0; ii < 4; ++ii) {
            const int pos = 16 * m + 4 * q + ii;
            const float rv = bf2f(S8[pos * LD + ch]), kraw = bf2f(S9[pos * LD + ch]); vv[n][ii] = bf2f(S10[pos * LD + ch]); rr[n][ii] = rv;
            const float z = -(w0v + aw[n][ii]);
            const float sp = fmaxf(z, 0.f) + flog(1.0f + fexp(-fabsf(z)));
            lw[n][ii] = -fexp(-sp - 0.5f);
            const float a_ = sigmoidf_(a0v + aa[n][ii]); av[n][ii] = a_;
            P.g[(size_t)(t0 + pos) * RW + chg] = f2bf(ag[n][ii]);
            const float kk = kraw * kkc; kq[n][ii] = kk;
            const float kpv = kraw * (1.0f + (a_ - 1.0f) * kac); kp[n][ii] = kpv;
            ss[ii] += kk * kk; bs[ii] += rv * kpv * rkc;
        }
        pre[n][0] = lw[n][0]; pre[n][1] = pre[n][0] + lw[n][1]; pre[n][2] = pre[n][1] + lw[n][2]; pre[n][3] = pre[n][2] + lw[n][3];
        const float tot = pre[n][3];
        const float t0_ = __shfl(tot, r), t1_ = __shfl(tot, r + 16), t2_ = __shfl(tot, r + 32), t3_ = __shfl(tot, r + 48);
        preq[n] = (q > 0 ? t0_ : 0.f) + (q > 1 ? t1_ : 0.f) + (q > 2 ? t2_ : 0.f);
        if (q == 0) CT[m * 64 + ch] = (t0_ + t1_) + (t2_ + t3_);
    }
#pragma unroll
    for (int ii = 0; ii < 4; ++ii) {
#pragma unroll
        for (int o = 1; o < 16; o <<= 1) { ss[ii] += __shfl_xor(ss[ii], o); bs[ii] += __shfl_xor(bs[ii], o); }
        if (r == 0) { const int pos = 16 * m + 4 * q + ii; PART[(nh * 64 + pos) * 2] = ss[ii]; PART[(nh * 64 + pos) * 2 + 1] = bs[ii]; }
    }
    RK_BAR();
#pragma unroll
    for (int n = 0; n < 2; ++n) {
        const int ch = 32 * nh + 16 * n + r;
        float carry = 0.f, lend = 0.f;
#pragma unroll
        for (int mm = 0; mm < 4; ++mm) { const float cv = CT[mm * 64 + ch]; lend += cv; carry += (mm < m) ? cv : 0.f; }
        f32x4 tA, tBh, tKh, tV;
#pragma unroll
        for (int ii = 0; ii < 4; ++ii) {
            const int pos = 16 * m + 4 * q + ii;
            const float L = carry + preq[n] + pre[n][ii], Lm1 = L - lw[n][ii];
            const float ssum = PART[pos * 2] + PART[(64 + pos) * 2];
            const float inv = frcp(fmaxf(__builtin_sqrtf(ssum), 1e-12f));
            const float kkn = kq[n][ii] * inv, kb = kkn * av[n][ii];
            const float eN = fexp(-L), eE = fexp(lend - L);
            const float At = -kkn * fexp(Lm1), Rt = rr[n][ii] * fexp(L), Bt = kb * eN, Kt = kp[n][ii] * eN;
            S0[pos * LD + ch] = f2bf(At); S1[pos * LD + ch] = f2bf(Bt); S2[pos * LD + ch] = f2bf(Kt); S3[pos * LD + ch] = f2bf(Rt);
            tA[ii] = At; tBh[ii] = kb * eE; tKh[ii] = kp[n][ii] * eE; tV[ii] = vv[n][ii];
            P.bv[(size_t)(t0 + pos) * RW + h * 64 + ch] = f2bf((PART[pos * 2 + 1] + PART[(64 + pos) * 2 + 1]) * vv[n][ii]);
        }
        { u32x2 w; const int off = ch * LD + 16 * m + 4 * q;
          w.x = pk2(tA[0], tA[1]); w.y = pk2(tA[2], tA[3]); *(LAS u32x2*)(S4 + off) = w;
          w.x = pk2(tBh[0], tBh[1]); w.y = pk2(tBh[2], tBh[3]); *(LAS u32x2*)(S5 + off) = w;
          w.x = pk2(tKh[0], tKh[1]); w.y = pk2(tKh[2], tKh[3]); *(LAS u32x2*)(S6 + off) = w;
          w.x = pk2(tV[0], tV[1]); w.y = pk2(tV[2], tV[3]); *(LAS u32x2*)(S7 + off) = w; }
        if (m == 0 && q == 0) DEND[ch] = fexp(lend);
    }
    RK_BAR();
    RK_DBG(0, S0); RK_DBG(1, S1); RK_DBG(2, S2); RK_DBG(3, S3); RK_DBG(4, S4); RK_DBG(5, S5); RK_DBG(6, S6); RK_DBG(7, S7);
    const int nt0 = 2 * nh;
    f32x4 acc[2], acc2[2];
#define RK_ZERO(a) do { a[0] = (f32x4){0.f, 0.f, 0.f, 0.f}; a[1] = a[0]; } while (0)
#define RK_LDT(src, mt, ntt, a) do { const u32x2 w_ = *(const LAS u32x2*)((src) + (16 * (ntt) + r) * LD + 16 * (mt) + 4 * q); a = (f32x4){bflo(w_.x), bfhi(w_.x), bflo(w_.y), bfhi(w_.y)}; } while (0)
#define RK_MASK(a, ntt, COND) do { _Pragma("unroll") for (int ii = 0; ii < 4; ++ii) { const int row = 16 * m + 4 * q + ii, col = 16 * (ntt) + r; a[ii] = (COND) ? a[ii] : 0.f; } } while (0)
    RK_ZERO(acc); mm_nt<2>(S0, LD, S1, LD, m, nt0, r, q, acc);
#pragma unroll
    for (int n = 0; n < 2; ++n) { RK_MASK(acc[n], nt0 + n, col < row); st_tr(S9, m, nt0 + n, r, q, acc[n]); }
    RK_ZERO(acc); mm_nt<2>(S1, LD, S0, LD, m, nt0, r, q, acc);
#pragma unroll
    for (int n = 0; n < 2; ++n) { RK_MASK(acc[n], nt0 + n, row < col); st_tr(S8, m, nt0 + n, r, q, acc[n]);
#pragma unroll
        for (int ii = 0; ii < 4; ++ii) acc[n][ii] += ((16 * m + 4 * q + ii) == (16 * (nt0 + n) + r)) ? 1.f : 0.f;
        st_tr(S10, m, nt0 + n, r, q, acc[n]); }
    RK_ZERO(acc); mm_nt<2>(S2, LD, S0, LD, m, nt0, r, q, acc);
#pragma unroll
    for (int n = 0; n < 2; ++n) { RK_MASK(acc[n], nt0 + n, row < col); st_tr(S11, m, nt0 + n, r, q, acc[n]); }
    RK_ZERO(acc); mm_nt<2>(S1, LD, S3, LD, m, nt0, r, q, acc);
#pragma unroll
    for (int n = 0; n < 2; ++n) { RK_MASK(acc[n], nt0 + n, row <= col); st_tr(S12, m, nt0 + n, r, q, acc[n]); }
    RK_ZERO(acc); mm_nt<2>(S2, LD, S3, LD, m, nt0, r, q, acc);
#pragma unroll
    for (int n = 0; n < 2; ++n) { RK_MASK(acc[n], nt0 + n, row <= col); st_tr(S13, m, nt0 + n, r, q, acc[n]); }
    RK_BAR();
    RK_ZERO(acc); mm_nt<2>(S8, LD, S9, LD, m, nt0, r, q, acc);
    RK_ZERO(acc2); mm_nt<2>(S9, LD, S8, LD, m, nt0, r, q, acc2);
#pragma unroll
    for (int n = 0; n < 2; ++n) { st_tr(S1, m, nt0 + n, r, q, acc[n]); st_tr(S0, m, nt0 + n, r, q, acc2[n]); }
    RK_ZERO(acc); mm_nt<2>(S11, LD, S7, LD, m, nt0, r, q, acc);
#pragma unroll
    for (int n = 0; n < 2; ++n) st_tr(S14, m, nt0 + n, r, q, acc[n]);
    RK_BAR();
#define RK_ROUND(Tsrc, Tdst, Psrc, PTsrc, Pdst, PTdst) do { \
        RK_LDT(Tsrc, m, nt0, acc[0]); RK_LDT(Tsrc, m, nt0 + 1, acc[1]); mm_nt<2>(PTsrc, LD, Tsrc, LD, m, nt0, r, q, acc); \
        _Pragma("unroll") for (int n = 0; n < 2; ++n) st_tr(Tdst, m, nt0 + n, r, q, acc[n]); \
        RK_ZERO(acc); mm_nt<2>(Psrc, LD, PTsrc, LD, m, nt0, r, q, acc); RK_ZERO(acc2); mm_nt<2>(PTsrc, LD, Psrc, LD, m, nt0, r, q, acc2); \
        _Pragma("unroll") for (int n = 0; n < 2; ++n) { st_tr(PTdst, m, nt0 + n, r, q, acc[n]); st_tr(Pdst, m, nt0 + n, r, q, acc2[n]); } \
        RK_BAR(); } while (0)
    RK_ROUND(S10, S2, S0, S1, S8, S9);
    RK_ROUND(S2, S10, S8, S9, S0, S1);
    RK_ROUND(S10, S2, S0, S1, S8, S9);
    RK_ROUND(S2, S10, S8, S9, S0, S1);
    RK_LDT(S10, m, nt0, acc[0]); RK_LDT(S10, m, nt0 + 1, acc[1]); mm_nt<2>(S1, LD, S10, LD, m, nt0, r, q, acc);
#pragma unroll
    for (int n = 0; n < 2; ++n) st_tr(S2, m, nt0 + n, r, q, acc[n]);
    RK_BAR();
    RK_ZERO(acc); mm_nt<2>(S2, LD, S4, LD, m, nt0, r, q, acc);
    RK_ZERO(acc2); mm_nt<2>(S2, LD, S14, LD, m, nt0, r, q, acc2);
#pragma unroll
    for (int n = 0; n < 2; ++n) { st_tr(S11, m, nt0 + n, r, q, acc[n]); st_tr(S15, m, nt0 + n, r, q, acc2[n]); }
    RK_BAR();
    {
        const int sw = wave & 1, ntw = wave >> 1;
        unsigned char* mn_ = P.mn + (size_t)uidx * 16384; unsigned char* qy_ = P.qy + (size_t)uidx * 16384;
        f32x4 c2[2];
#define RK_MM2(X, Y) do { _Pragma("unroll") for (int s_ = 0; s_ < 2; ++s_) { const bf16x8 b_ = *(const LAS bf16x8*)((Y) + (16 * ntw + r) * LD + 32 * s_ + 8 * q); \
            _Pragma("unroll") for (int mi = 0; mi < 2; ++mi) { const bf16x8 a_ = *(const LAS bf16x8*)((X) + (16 * (2 * sw + mi) + r) * LD + 32 * s_ + 8 * q); c2[mi] = __builtin_amdgcn_mfma_f32_16x16x32_bf16(a_, b_, c2[mi], 0, 0, 0); } } } while (0)
        RK_ZERO(c2); RK_MM2(S11, S5);
#pragma unroll
        for (int mi = 0; mi < 2; ++mi)
#pragma unroll
            for (int ii = 0; ii < 4; ++ii) { const int row = 16 * (2 * sw + mi) + 4 * q + ii, col = 16 * ntw + r; c2[mi][ii] += (row == col) ? DEND[row] : 0.f; }
        { u32x4 w; w.x = pk2(c2[0][0], c2[0][1]); w.y = pk2(c2[0][2], c2[0][3]); w.z = pk2(c2[1][0], c2[1][1]); w.w = pk2(c2[1][2], c2[1][3]); *(u32x4*)(mn_ + ((ntw * 2 + sw) * 64 + lane) * 16) = w; }
#pragma unroll
        for (int mi = 0; mi < 2; ++mi) { const u32x2 rw_ = *(const LAS u32x2*)(S3 + (16 * ntw + r) * LD + 16 * (2 * sw + mi) + 4 * q); c2[mi] = (f32x4){bflo(rw_.x), bfhi(rw_.x), bflo(rw_.y), bfhi(rw_.y)}; }
        RK_MM2(S11, S12);
        { u32x4 w; w.x = pk2(c2[0][0], c2[0][1]); w.y = pk2(c2[0][2], c2[0][3]); w.z = pk2(c2[1][0], c2[1][1]); w.w = pk2(c2[1][2], c2[1][3]); *(u32x4*)(qy_ + ((ntw * 2 + sw) * 64 + lane) * 16) = w; }
        RK_ZERO(c2); RK_MM2(S5, S15); RK_MM2(S6, S7);
#pragma unroll
        for (int mi = 0; mi < 2; ++mi) { u32x2 w; w.x = pk2(c2[mi][0], c2[mi][1]); w.y = pk2(c2[mi][2], c2[mi][3]); *(u32x2*)(mn_ + 8192 + ((ntw * 4 + 2 * sw + mi) * 64 + lane) * 8) = w; }
        RK_ZERO(c2); RK_MM2(S15, S12); RK_MM2(S7, S13);
#pragma unroll
        for (int mi = 0; mi < 2; ++mi) { u32x2 w; w.x = pk2(c2[mi][0], c2[mi][1]); w.y = pk2(c2[mi][2], c2[mi][3]); *(u32x2*)(qy_ + 8192 + (((2 * sw + mi) * 4 + ntw) * 64 + lane) * 8) = w; }
#undef RK_MM2
    }
    RK_BAR();
#undef RK_ZERO
#undef RK_ROUND
#undef RK_LDT
#undef RK_MASK
#undef RK_BAR
}
__device__ __forceinline__ void scan_wg(const unsigned char* mn, unsigned char* sbuf, int ubase, int vq, LAS unsigned char* lds, int tid) {
    const int wave = __builtin_amdgcn_readfirstlane(tid >> 6), lane = tid & 63;
    constexpr int NC = SEQ / 64, NS = 8, SLOT = 10240, AHEAD = 6;
    const unsigned char* src = mn + (size_t)ubase * 16384 + lane * 16;
    const bool loader = (wave >= 1 && wave <= 5);
    const size_t poff = (wave == 5) ? (size_t)(8192 + vq * 2048) : (size_t)(2048 * (wave - 1));
#define SC_ISSUE(c) do { const unsigned char* s_ = src + (size_t)(c) * 16384 + poff; LAS unsigned char* d_ = lds + ((c) % NS) * SLOT + 2048 * (wave - 1); \
        _Pragma("unroll") for (int i_ = 0; i_ < 2; ++i_) __builtin_amdgcn_global_load_lds((const unsigned*)(s_ + i_ * 1024), (LAS unsigned*)(d_ + i_ * 1024), 16, 0, 0); } while (0)
#define SC_BAR() do { asm volatile("s_waitcnt lgkmcnt(0)" ::: "memory"); __builtin_amdgcn_s_barrier(); asm volatile("" ::: "memory"); } while (0)
    bf16x8 sB[2];
#pragma unroll
    for (int s = 0; s < 2; ++s) sB[s] = (bf16x8){0, 0, 0, 0, 0, 0, 0, 0};
    if (loader) {
#pragma unroll
        for (int c = 0; c < AHEAD; ++c) SC_ISSUE(c);
        asm volatile("s_waitcnt vmcnt(10)" ::: "memory"); }
    SC_BAR();
    for (int c = 0; c < NC; ++c) {
        if (loader) {
            if (c + AHEAD < NC) { SC_ISSUE(c + AHEAD); asm volatile("s_waitcnt vmcnt(10)" ::: "memory"); }
            else { asm volatile("s_waitcnt vmcnt(0)" ::: "memory"); }
        } else if (wave == 0) {
            const LAS unsigned char* sl = lds + (c % NS) * SLOT;
            unsigned char* so = sbuf + (size_t)(ubase + c) * 8192 + (vq * 2) * 1024 + lane * 16;
            *(bf16x8*)so = sB[0]; *(bf16x8*)(so + 1024) = sB[1];
            f32x4 aS[4];
#pragma unroll
            for (int mm = 0; mm < 4; ++mm) {
                const u32x2 nI = *(const LAS u32x2*)(sl + 8192 + (mm * 64 + lane) * 8);
                aS[mm] = (f32x4){bflo(nI.x), bfhi(nI.x), bflo(nI.y), bfhi(nI.y)};
#pragma unroll
                for (int s = 0; s < 2; ++s) { const bf16x8 aM = *(const LAS bf16x8*)(sl + ((mm * 2 + s) * 64 + lane) * 16); aS[mm] = __builtin_amdgcn_mfma_f32_16x16x32_bf16(aM, sB[s], aS[mm], 0, 0, 0); }
            }
#pragma unroll
            for (int s = 0; s < 2; ++s) { u32x4 w; w.x = pk2(aS[2 * s][0], aS[2 * s][1]); w.y = pk2(aS[2 * s][2], aS[2 * s][3]); w.z = pk2(aS[2 * s + 1][0], aS[2 * s + 1][1]); w.w = pk2(aS[2 * s + 1][2], aS[2 * s + 1][3]);
                sB[s] = __builtin_bit_cast(bf16x8, w); }
        }
        SC_BAR();
    }
#undef SC_ISSUE
#undef SC_BAR
}
struct YArgs { const unsigned char* qy; const unsigned char* sbuf; const bf16_t* g; const bf16_t* bv; const float* ln_g; const float* ln_b; bf16_t* ya; };
__device__ __forceinline__ void ypass_unit(const YArgs& P, int u, int lane) {
    const int r = lane & 15, q = lane >> 4, b = u >> 10, h = (u >> 7) & 7, c = u & 127, t0 = b * SEQ + c * 64;
    const unsigned char* qy_ = P.qy + (size_t)u * 16384; const unsigned char* s_ = P.sbuf + (size_t)u * 8192;
    bf16x8 Qf[4][2], Sf[4][2]; u32x2 y0[4][4];
#pragma unroll
    for (int i = 0; i < 4; ++i)
#pragma unroll
        for (int s = 0; s < 2; ++s) { Qf[i][s] = *(const bf16x8*)(qy_ + ((i * 2 + s) * 64 + lane) * 16); Sf[i][s] = *(const bf16x8*)(s_ + ((i * 2 + s) * 64 + lane) * 16); }
#pragma unroll
    for (int vq = 0; vq < 4; ++vq)
#pragma unroll
        for (int mm = 0; mm < 4; ++mm) y0[vq][mm] = *(const u32x2*)(qy_ + 8192 + ((vq * 4 + mm) * 64 + lane) * 8);
    f32x4 lg[4], lb[4];
#pragma unroll
    for (int vq = 0; vq < 4; ++vq) { lg[vq] = *(const f32x4*)(P.ln_g + h * 64 + 16 * vq + 4 * q); lb[vq] = *(const f32x4*)(P.ln_b + h * 64 + 16 * vq + 4 * q); }
#pragma unroll
    for (int mm = 0; mm < 4; ++mm) {
        const size_t ro = (size_t)(t0 + 16 * mm + r) * RW + h * 64 + 4 * q;
        u32x2 gw_[4], bw_[4];
#pragma unroll
        for (int vq = 0; vq < 4; ++vq) { gw_[vq] = *(const u32x2*)(P.g + ro + 16 * vq); bw_[vq] = *(const u32x2*)(P.bv + ro + 16 * vq); }
        f32x4 acc[4]; float sum = 0.f;
#pragma unroll
        for (int vq = 0; vq < 4; ++vq) {
            acc[vq] = (f32x4){bflo(y0[vq][mm].x), bfhi(y0[vq][mm].x), bflo(y0[vq][mm].y), bfhi(y0[vq][mm].y)};
#pragma unroll
            for (int s = 0; s < 2; ++s) acc[vq] = __builtin_amdgcn_mfma_f32_16x16x32_bf16(Sf[vq][s], Qf[mm][s], acc[vq], 0, 0, 0);
            sum += (acc[vq][0] + acc[vq][1]) + (acc[vq][2] + acc[vq][3]);
        }
        sum += __shfl_xor(sum, 16); sum += __shfl_xor(sum, 32);
        const float mean = sum * (1.f / 64.f); float var = 0.f;
#pragma unroll
        for (int vq = 0; vq < 4; ++vq) { acc[vq] = acc[vq] - mean; var += (acc[vq][0] * acc[vq][0] + acc[vq][1] * acc[vq][1]) + (acc[vq][2] * acc[vq][2] + acc[vq][3] * acc[vq][3]); }
        var += __shfl_xor(var, 16); var += __shfl_xor(var, 32);
        const float rstd = __builtin_amdgcn_rsqf(var * (1.f / 64.f) + 64e-5f);
#pragma unroll
        for (int vq = 0; vq < 4; ++vq) {
            const f32x4 gg = (f32x4){bflo(gw_[vq].x), bfhi(gw_[vq].x), bflo(gw_[vq].y), bfhi(gw_[vq].y)}, bb = (f32x4){bflo(bw_[vq].x), bfhi(bw_[vq].x), bflo(bw_[vq].y), bfhi(bw_[vq].y)};
            const f32x4 o = (acc[vq] * rstd * lg[vq] + lb[vq] + bb) * gg;
            u32x2 w; w.x = pk2(o[0], o[1]); w.y = pk2(o[2], o[3]); *(u32x2*)(P.ya + ro + 16 * vq) = w; }
    }
}
}
namespace gl {
constexpr int LDV = 136;
struct Args { const bf16_t* puv; const bf16_t* wsm; const float* bs; const float* ln_g; const float* ln_b; bf16_t* yb; };
__device__ __forceinline__ void unit(const Args& P, LAS unsigned char* lds, int b, int blk, int tid) {
    const int wave = __builtin_amdgcn_readfirstlane(tid >> 6), lane = tid & 63, r = lane & 15, q = lane >> 4;
    const int t0 = b * SEQ + blk * 128;
    LAS float* STAT = (LAS float*)(lds + LDS_MISC);
    for (int j = 0; j < 16; ++j) {
        const int tk = 16 * wave + j;
        const u32x4 w = *(const u32x4*)(P.puv + (size_t)(t0 + tk) * 1024 + 512 + 8 * lane);
        float v[8]; v[0] = bflo(w.x); v[1] = bfhi(w.x); v[2] = bflo(w.y); v[3] = bfhi(w.y); v[4] = bflo(w.z); v[5] = bfhi(w.z); v[6] = bflo(w.w); v[7] = bfhi(w.w);
        float s = 0.f, s2 = 0.f;
#pragma unroll
        for (int e = 0; e < 8; ++e) { s += v[e]; s2 += v[e] * v[e]; }
        s = wave_sum(s); s2 = wave_sum(s2);
        const float mean = s * (1.f / 512.f), var = fmaxf(s2 * (1.f / 512.f) - mean * mean, 0.f);
        if (lane == 0) { STAT[tk * 2] = mean; STAT[tk * 2 + 1] = __builtin_amdgcn_rsqf(var + 1e-5f); }
    }
    __syncthreads();
    for (int g = 0; g < 8; ++g) {
        LAS bf16_t* VT = (LAS bf16_t*)(lds + (g & 1) * 20480);
#pragma unroll
        for (int it = 0; it < 2; ++it) {
            const int task = tid + it * NTHREADS, j = task >> 3, cc = task & 7, ch = g * 64 + 8 * cc;
            const u32x4 w = *(const u32x4*)(P.puv + (size_t)(t0 + j) * 1024 + 512 + ch);
            const float mean = STAT[j * 2], rstd = STAT[j * 2 + 1];
            const f32x4 g0 = *(const f32x4*)(P.ln_g + ch), g1 = *(const f32x4*)(P.ln_g + ch + 4), b0 = *(const f32x4*)(P.ln_b + ch), b1 = *(const f32x4*)(P.ln_b + ch + 4);
            float v[8]; v[0] = bflo(w.x); v[1] = bfhi(w.x); v[2] = bflo(w.y); v[3] = bfhi(w.y); v[4] = bflo(w.z); v[5] = bfhi(w.z); v[6] = bflo(w.w); v[7] = bfhi(w.w);
#pragma unroll
            for (int e = 0; e < 4; ++e) { v[e] = (v[e] - mean) * rstd * g0[e] + b0[e]; v[4 + e] = (v[4 + e] - mean) * rstd * g1[e] + b1[e]; }
#pragma unroll
            for (int e = 0; e < 8; ++e) VT[(8 * cc + e) * LDV + j] = f2bf(v[e]);
        }
        __syncthreads();
        f32x4 acc[4];
#pragma unroll
        for (int n = 0; n < 4; ++n) acc[n] = (f32x4){0.f, 0.f, 0.f, 0.f};
        const bf16_t* wrow = P.wsm + ((size_t)g * 128 + 16 * wave + r) * 128 + 8 * q;
        const int ks = (wave >> 1) + 1;
        for (int s = 0; s < ks; ++s) {
            const bf16x8 a = *(const bf16x8*)(wrow + 32 * s);
#pragma unroll
            for (int n = 0; n < 4; ++n) { const bf16x8 bb = *(const LAS bf16x8*)(VT + (16 * n + r) * LDV + 32 * s + 8 * q); acc[n] = __builtin_amdgcn_mfma_f32_16x16x32_bf16(a, bb, acc[n], 0, 0, 0); }
        }
#pragma unroll
        for (int ii = 0; ii < 4; ++ii) { const int i = 16 * wave + 4 * q + ii; const float bias = P.bs[g * 128 + i];
#pragma unroll
            for (int n = 0; n < 4; ++n) { const int c = g * 64 + 16 * n + r; const float u = bf2f(P.puv[(size_t)(t0 + i) * 1024 + c]);
                P.yb[(size_t)(t0 + i) * RW + c] = f2bf(u * (acc[n][ii] + bias)); } }
    }
    __syncthreads();
}
}

struct RouteArgs { const float* sc; const float* bias; int* eidx; float* ewt; int* lrank; int* tbase; unsigned* segcnt; };
__device__ __forceinline__ void phase_topk(const RouteArgs& P, LAS unsigned char* lds, int tid, int G) {
    const int wave = __builtin_amdgcn_readfirstlane(tid >> 6), lane = tid & 63, grp = lane >> 3;
    LAS int* hist = (LAS int*)(lds + LDS_MISC);
    const f32x4 bias4 = *(const f32x4*)(P.bias + 4 * lane);
    const float NEG = -__builtin_inff();
    for (int tile = blockIdx.x; tile < T / 256; tile += G) {
        if (tid < NE) hist[tid] = 0;
        __syncthreads();
        for (int j = 0; j < 32; j += 2) {
            const int t0 = tile * 256 + wave * 32 + j;
            float s[2][4], v[2][4], gs[2];
#pragma unroll
            for (int u = 0; u < 2; ++u) { const f32x4 s4 = *(const f32x4*)(P.sc + (size_t)(t0 + u) * NE + 4 * lane); s[u][0] = s4.x; s[u][1] = s4.y; s[u][2] = s4.z; s[u][3] = s4.w;
#pragma unroll
                for (int e = 0; e < 4; ++e) v[u][e] = s[u][e] + bias4[e]; }
            float m1[2], m2[2];
#pragma unroll
            for (int u = 0; u < 2; ++u) { const float a = fmaxf(v[u][0], v[u][1]), b = fminf(v[u][0], v[u][1]), c = fmaxf(v[u][2], v[u][3]), d = fminf(v[u][2], v[u][3]); m1[u] = fmaxf(a, c); m2[u] = fmaxf(fminf(a, c), fmaxf(b, d)); }
#pragma unroll
            for (int o = 1; o < 8; o <<= 1) {
#pragma unroll
                for (int u = 0; u < 2; ++u) { const float o1 = __shfl_xor(m1[u], o), o2 = __shfl_xor(m2[u], o); const float n1 = fmaxf(m1[u], o1), n2 = fmaxf(fminf(m1[u], o1), fmaxf(m2[u], o2)); m1[u] = n1; m2[u] = n2; } }
#pragma unroll
            for (int u = 0; u < 2; ++u) gs[u] = m1[u] + m2[u];
            int cnt[2] = {0, 0};
#pragma unroll
            for (int g = 0; g < 8; ++g) {
#pragma unroll
                for (int u = 0; u < 2; ++u) { const float og = __shfl(gs[u], 8 * g); cnt[u] += (og > gs[u] || (og == gs[u] && g < grp)) ? 1 : 0; } }
#pragma unroll
            for (int u = 0; u < 2; ++u) {
#pragma unroll
                for (int e = 0; e < 4; ++e) v[u][e] = (cnt[u] < 4) ? v[u][e] : NEG; }
            int myidx[2] = {0, 0}; float mysc[2] = {0.f, 0.f}, ssum[2] = {0.f, 0.f};
#pragma unroll
            for (int k = 0; k < TOPK; ++k) {
                float bv[2]; int idx[2];
#pragma unroll
                for (int u = 0; u < 2; ++u) { bv[u] = v[u][0]; int bi = 0;
#pragma unroll
                    for (int e = 1; e < 4; ++e) { const bool gt = v[u][e] > bv[u]; bv[u] = gt ? v[u][e] : bv[u]; bi = gt ? e : bi; }
                    idx[u] = 4 * lane + bi; }
#pragma unroll
                for (int o = 1; o < 64; o <<= 1) {
#pragma unroll
                    for (int u = 0; u < 2; ++u) { const float ov = __shfl_xor(bv[u], o); const int oi = __shfl_xor(idx[u], o); const bool tk = (ov > bv[u]) || (ov == bv[u] && oi < idx[u]); bv[u] = tk ? ov : bv[u]; idx[u] = tk ? oi : idx[u]; } }
#pragma unroll
                for (int u = 0; u < 2; ++u) { const int own = idx[u] >> 2, ee = idx[u] & 3;
                    const float mine = (ee == 0) ? s[u][0] : (ee == 1) ? s[u][1] : (ee == 2) ? s[u][2] : s[u][3];
                    const float scv = __shfl(mine, own);
#pragma unroll
                    for (int e = 0; e < 4; ++e) v[u][e] = (lane == own && e == ee) ? NEG : v[u][e];
                    ssum[u] += scv; myidx[u] = (lane == k) ? idx[u] : myidx[u]; mysc[u] = (lane == k) ? scv : mysc[u]; }
            }
            if (lane < TOPK) {
#pragma unroll
                for (int u = 0; u < 2; ++u) { const int t = t0 + u;
                    const int lr = __hip_atomic_fetch_add(hist + myidx[u], 1, __ATOMIC_RELAXED, __HIP_MEMORY_SCOPE_WORKGROUP);
                    P.eidx[(size_t)t * TOPK + lane] = myidx[u]; P.ewt[(size_t)t * TOPK + lane] = mysc[u] / ssum[u] * 2.5f; P.lrank[(size_t)t * TOPK + lane] = lr; }
            }
        }
        __syncthreads();
        if (tid < NE) { const int cnt = hist[tid]; unsigned base = 0u;
            if (cnt) base = __hip_atomic_fetch_add(P.segcnt + tid, (unsigned)cnt, __ATOMIC_RELAXED, __HIP_MEMORY_SCOPE_AGENT);
            P.tbase[tile * NE + tid] = (int)base; }
        __syncthreads();
    }
}
struct ScatArgs { const int* eidx; const float* ewt; const int* lrank; const int* tbase; const unsigned* segcnt; int* rowtok; int* rowdst; float* roww; int* tab; unsigned* ntile; };
__device__ __forceinline__ void phase_scatter(const ScatArgs& P, LAS unsigned char* lds, int tid, int G) {
    LAS int* cntL = (LAS int*)(lds + LDS_MISC); LAS int* segst = cntL + 256; LAS int* tsa = segst + 256;
    if (tid < NE) cntL[tid] = (int)__hip_atomic_load(P.segcnt + tid, __ATOMIC_RELAXED, __HIP_MEMORY_SCOPE_AGENT);
    __syncthreads();
    if (tid == 0) {
        int run = 0, ta = 0;
        for (int s = 0; s < NE; ++s) { const int nts = (cntL[s] + 255) >> 8; segst[s] = run; tsa[s] = ta; run += nts * 256; ta += nts; }
        if (blockIdx.x == 0) P.ntile[0] = (unsigned)ta;
    }
    __syncthreads();
    for (int tile = blockIdx.x; tile < T / 256; tile += G) {
        for (int a = tid; a < 256 * TOPK; a += NTHREADS) {
            const int tok = tile * 256 + (a >> 3), k = a & 7; const size_t ai = (size_t)tok * TOPK + k;
            const int e = P.eidx[ai];
            const int pos = segst[e] + P.tbase[tile * NE + e] + P.lrank[ai];
            P.rowtok[pos] = tok; P.rowdst[pos] = tok * TOPK + k; P.roww[pos] = P.ewt[ai];
        }
    }
    for (int s = blockIdx.x; s < NE; s += G) {
        const int st = segst[s], cnt = cntL[s], nts = (cnt + 255) >> 8;
        for (int p = st + cnt + tid; p < st + nts * 256; p += NTHREADS) { P.rowtok[p] = 0; P.rowdst[p] = -1; P.roww[p] = 0.f; }
        if (tid < nts) { int* ta_ = P.tab + 2 * (tsa[s] + tid); ta_[0] = st + 256 * tid; ta_[1] = s; }
    }
}
constexpr int NPHASE = 20;
struct KArgs { const float* in[34]; float* out; unsigned char* ws; int ph_lo, ph_hi; };
template <int PLO, int PHI>
__global__ void __launch_bounds__(NTHREADS, 2) fwd_kernel(KArgs a) {
    extern __shared__ __attribute__((aligned(16))) unsigned char lds_raw[];
    LAS unsigned char* lds = (LAS unsigned char*)lds_raw;
    const int G = gridDim.x, bid = blockIdx.x, NGW = G * NWAVES;
#define PH_IDS() int tid = threadIdx.x; asm volatile("" : "+v"(tid)); const int lane = tid & 63, wave = __builtin_amdgcn_readfirstlane(tid >> 6), gw = bid * NWAVES + wave; (void)lane; (void)wave; (void)gw
    unsigned char* ws = a.ws;
    unsigned* ctl = (unsigned*)(ws + WS_CTL);
    float* mod = (float*)(ws + WS_MOD);
    constexpr int lo = PLO, hi = PHI;
    if (threadIdx.x == 0) *(LAS u32x4*)(lds + LDS_BARW) = (u32x4){0u, 0u, 0u, 0u};
    __syncthreads();
    XcdBarrier bar; bar.bar = ctl + CW_BAR; bar.x = 0; bar.st = nullptr;
    if (hi - lo > 1) bar = xcd_barrier_post(ctl + CW_BAR, (volatile LAS unsigned*)(lds + LDS_BARW));
#define IN(k) (lo <= (k) && (k) < hi)
#ifdef DBG_TIME
#define STAMP(k) do { if (blockIdx.x == 0 && threadIdx.x == 0) ((unsigned long long*)(ctl + 5200))[k] = __builtin_amdgcn_s_memrealtime(); } while (0)
#else
#define STAMP(k) do {} while (0)
#endif
#define SEAM(k) do { if (IN(k) && IN((k) + 1)) xcd_barrier(bar); } while (0)
#ifndef DBG_REPEAT
#define DBG_REPEAT (-1)
#define DBG_NREP 0
#endif
#define REP(k) for (int rep_ = 0; rep_ < (((k) == DBG_REPEAT) ? 1 + DBG_NREP : 1); ++rep_, (((k) == DBG_REPEAT && rep_ <= DBG_NREP) ? xcd_barrier(bar) : (void)0))

    STAMP(0);
    if (IN(0)) REP(0) { PH_IDS();
        phase_mod(a.in[1], a.in[2], a.in[3], mod, lds, tid, G);
        SmallW sw{a.in[6], a.in[22], a.in[23], a.in[24], a.in[25], a.in[30], a.in[31], a.in[32], a.in[9], a.in[11], a.in[12], a.in[20]};
        phase_small_weights(sw, ws, lds, gw, NGW, wave, lane);
    }
    SEAM(0); STAMP(1);
    if (IN(1)) REP(1) { PH_IDS(); phase_norm_mod(a.in[0], a.in[4], mod, 0, 1024, (bf16_t*)(ws + B_H1), gw, NGW, lane); }
    SEAM(1); STAMP(2);
    if (IN(2)) REP(2) {
        gm::DenseSched S; S.init(ws + B_H1, ws + SW_WIN, T, IN_COLS, D, G, bid);
        gm::EpiInProj E{(bf16_t*)(ws + B_PRW), (bf16_t*)(ws + B_PUV), (bf16_t*)(ws + B_PG)};
        gm::gemm_phase<gm::EpiInProj, gm::DenseSched, true>(lds, D, S, E);
    }
    SEAM(2); STAMP(3);
    if (IN(3)) REP(3) { PH_IDS();
        gl::Args Q{(const bf16_t*)(ws + B_PUV), (const bf16_t*)(ws + SW_WSM), a.in[21], a.in[18], a.in[19], (bf16_t*)(ws + B_YB)};
        for (int u = bid; u < 512; u += G) gl::unit(Q, lds, u >> 6, u & 63, tid);
    }
    SEAM(3); STAMP(4);
    if (IN(4)) REP(4) { PH_IDS();
        rk::Args P{(const bf16_t*)(ws + B_PRW), a.in[7], a.in[8], a.in[10], a.in[13], a.in[14], a.in[15], (const bf16_t*)(ws + SW_WUP), (const bf16_t*)(ws + SW_AUP), (const bf16_t*)(ws + SW_GUP),
                   (bf16_t*)(ws + B_G), (bf16_t*)(ws + B_BV), ws + B_MN, ws + B_QY};
        rk::Pre pre; rk::load_mu(P, lds, tid);
        if (bid < 8192) rk::prefetch(P, bid >> 10, (bid >> 7) & 7, bid & 127, tid, pre);
        for (int u = bid; u < 8192; u += G) { const int un = u + G; rk::unit(P, lds, u >> 10, (u >> 7) & 7, u & 127, u, tid, pre, un < 8192, un >> 10, (un >> 7) & 7, un & 127); }
    }
    SEAM(4); STAMP(5);
    if (IN(5)) REP(5) { PH_IDS();
        for (int w = bid; w < 256; w += G) rk::scan_wg(ws + B_MN, ws + B_S, ((w & 7) + 8 * (w >> 5)) * 128, (w >> 3) & 3, lds, tid);
    }
    SEAM(5); STAMP(6);
    if (IN(6)) REP(6) { PH_IDS();
        rk::YArgs Y{ws + B_QY, ws + B_S, (const bf16_t*)(ws + B_G), (const bf16_t*)(ws + B_BV), a.in[16], a.in[17], (bf16_t*)(ws + B_YA)};
        for (int u = gw; u < 8192; u += NGW) rk::ypass_unit(Y, u, lane);
    }
    SEAM(6); STAMP(7);
    STAMP(8);
    if (IN(8)) REP(8) {
        gm::DenseSched S; S.init(ws + B_YA, ws + SW_WOA, T, D, RW, G, bid);
        gm::EpiMerge<false> E{(bf16_t*)(ws + B_M1), (const bf16_t*)(ws + B_PG)};
        gm::gemm_phase<gm::EpiMerge<false>, gm::DenseSched, true>(lds, RW, S, E);
    }
    SEAM(8); STAMP(9);
    if (IN(9)) {
        gm::DenseSched S; S.init(ws + B_YB, ws + SW_WOB, T, D, RW, G, bid);
        gm::EpiMerge<true> E{(bf16_t*)(ws + B_M1), (const bf16_t*)(ws + B_PG)};
        gm::gemm_phase<gm::EpiMerge<true>, gm::DenseSched, true>(lds, RW, S, E);
    }
    SEAM(9); STAMP(10);
    if (IN(10)) REP(10) {
        gm::DenseSched S; S.init(ws + B_M1, ws + SW_WO, T, D, D, G, bid);
        gm::EpiResid E{a.out, a.in[0], mod + 2048};
        gm::gemm_phase<gm::EpiResid, gm::DenseSched, true>(lds, D, S, E);
    }
    SEAM(10); STAMP(11);
    if (IN(11)) REP(11) { PH_IDS();
        phase_norm_mod(a.out, a.in[5], mod, 3072, 4096, (bf16_t*)(ws + B_H2), gw, NGW, lane);
        phase_expert_weights(a.in[27], a.in[28], a.in[29], ws, lds, gw, NGW, wave, lane);
    }
    SEAM(11); STAMP(12);
    if (IN(12)) REP(12) {
        { gm::DenseSched S; S.init(ws + B_H2, ws + SW_WR, T, NE, D, G, bid); gm::EpiRouter E{(float*)(ws + B_SC)}; gm::gemm_phase<gm::EpiRouter, gm::DenseSched, true>(lds, D, S, E); }
        { gm::DenseSched S; S.init(ws + B_H2, ws + SW_WS13, T, 512, D, G, bid); gm::EpiGateUp E{(bf16_t*)(ws + B_SH)}; gm::gemm_phase<gm::EpiGateUp, gm::DenseSched, true>(lds, D, S, E); }
    }
    SEAM(12); STAMP(13);
    if (IN(13)) { PH_IDS();
        RouteArgs R{(const float*)(ws + B_SC), a.in[26], (int*)(ws + RT_EIDX), (float*)(ws + RT_EWT), (int*)(ws + RT_LRANK), (int*)(ws + RT_TBASE), ctl + CW_SEGCNT};
        phase_topk(R, lds, tid, G);
        gm::DenseSched S; S.init(ws + B_SH, ws + SW_WS2, T, D, EFF, G, bid);
        gm::EpiSharedDown E{ws + B_SHO};
        gm::gemm_phase<gm::EpiSharedDown, gm::DenseSched, true>(lds, EFF, S, E);
    }
    SEAM(13); STAMP(14);
    if (IN(14)) REP(14) { PH_IDS();
        ScatArgs P{(const int*)(ws + RT_EIDX), (const float*)(ws + RT_EWT), (const int*)(ws + RT_LRANK), (const int*)(ws + RT_TBASE), ctl + CW_SEGCNT,
                   (int*)(ws + RT_ROWTOK), (int*)(ws + RT_ROWDST), (float*)(ws + RT_ROWW), (int*)(ws + RT_TAB), ctl + CW_NT};
        phase_scatter(P, lds, tid, G);
    }
    SEAM(14); STAMP(15);
    if (IN(15)) REP(15) {
        gm::GroupSched<true> S; S.A = (const char*)(ws + B_H2); S.B = (const char*)(ws + B_W13); S.tab = (const int*)(ws + RT_TAB); S.rowtok = (const int*)(ws + RT_ROWTOK);
        S.ntiles = (int)__hip_atomic_load(ctl + CW_NT, __ATOMIC_RELAXED, __HIP_MEMORY_SCOPE_AGENT); S.npn = 2; S.G = G; S.c = bid; S.K = D; S.ebytes = (size_t)512 * D * 2; S.tstep = (size_t)256 * D * 2;
        gm::EpiGateUp E{(bf16_t*)(ws + B_HID)};
        gm::gemm_phase<gm::EpiGateUp, gm::GroupSched<true>, true>(lds, D, S, E);
    }
    SEAM(15); STAMP(16);
    if (IN(16)) REP(16) {
        gm::GroupSched<false> S; S.A = (const char*)(ws + B_HID); S.B = (const char*)(ws + B_W2); S.tab = (const int*)(ws + RT_TAB); S.rowtok = nullptr;
        S.ntiles = (int)__hip_atomic_load(ctl + CW_NT, __ATOMIC_RELAXED, __HIP_MEMORY_SCOPE_AGENT); S.npn = 4; S.G = G; S.c = bid; S.K = EFF; S.ebytes = (size_t)D * EFF * 2; S.tstep = (size_t)256 * EFF * 2;
        gm::EpiExpertDown E{ws + B_SLOT, (const int*)(ws + RT_ROWDST), (const float*)(ws + RT_ROWW)};
        gm::gemm_phase<gm::EpiExpertDown, gm::GroupSched<false>, true>(lds, EFF, S, E);
    }
    SEAM(16); STAMP(17);
    if (IN(17)) { PH_IDS(); phase_combine(a.out, ws + B_SLOT, ws + B_SHO, mod, a.in[33], gw, NGW, lane); }
    STAMP(18); STAMP(19);
    __syncthreads(); STAMP(20);
#undef IN
#undef SEAM
}

#if defined(DBG_CHECK) || defined(DBG_TIME)
#ifdef DBG_TIME
#ifndef TSC
#define TSC 0.25f
#endif
__global__ void dbg_time_out(float* out, const unsigned long long* st) {
    if (threadIdx.x == 0 && blockIdx.x == 0) { out[0] = (float)(st[TA1] - st[TA0]) * 0.01f * TSC; out[1] = (float)(st[TB1] - st[TB0]) * 0.01f * TSC; }
}
static void dbg_run(void* d_out, void* d_ws, hipStream_t stream) {
    dbg_time_out<<<1, 64, 0, stream>>>((float*)d_out, (const unsigned long long*)((unsigned*)((unsigned char*)d_ws + WS_CTL) + 5200));
}
#endif
#endif
#ifndef MK_SINGLE
#define MK_SINGLE 0
#endif
template <int PLO, int PHI> static bool prep_kernel() {
    int per_cu = 0;
    if (hipFuncSetAttribute((const void*)fwd_kernel<PLO, PHI>, hipFuncAttributeMaxDynamicSharedMemorySize, LDS_BYTES) != hipSuccess) { fprintf(stderr, "kernel_launch: hipFuncSetAttribute failed\n"); return false; }
    if (hipOccupancyMaxActiveBlocksPerMultiprocessor(&per_cu, (const void*)fwd_kernel<PLO, PHI>, NTHREADS, LDS_BYTES) != hipSuccess || per_cu < 1) { fprintf(stderr, "kernel_launch: occupancy query says %d\n", per_cu); (void)hipGetLastError(); return false; }
    return true;
}
template <int P> struct PhaseLaunch {
    static bool prep() { return prep_kernel<P, P + 1>() && PhaseLaunch<P + 1>::prep(); }
    static void go(int grid, hipStream_t stream, const KArgs& a) { hipLaunchKernelGGL((fwd_kernel<P, P + 1>), dim3(grid), dim3(NTHREADS), LDS_BYTES, stream, a); PhaseLaunch<P + 1>::go(grid, stream, a); }
};
#ifndef DBG_LAST
#define DBG_LAST NPHASE
#endif
template <> struct PhaseLaunch<DBG_LAST> { static bool prep() { return true; } static void go(int, hipStream_t, const KArgs&) {} };
extern "C" void kernel_launch(void* const* d_in, const int* in_sizes, int n_in, void* d_out, int out_size, void* d_ws, size_t ws_size, hipStream_t stream) {
    static int grid = 0;
    if (grid == 0) {
        if (n_in != 34 || out_size != T * D || ws_size < WS_END) { fprintf(stderr, "kernel_launch: unexpected problem shape (n_in %d, out %d, ws %zu < %zu)\n", n_in, out_size, ws_size, (size_t)WS_END); grid = -1; return; }
        int dev = 0, cus = 0;
        if (hipGetDevice(&dev) != hipSuccess || hipDeviceGetAttribute(&cus, hipDeviceAttributeMultiprocessorCount, dev) != hipSuccess) { grid = -1; return; }
#if MK_SINGLE
        if (!prep_kernel<0, NPHASE>()) { grid = -1; return; }
#else
        if (!PhaseLaunch<0>::prep()) { grid = -1; return; }
#endif
        grid = cus;
    }
    if (grid < 0) return;
    (void)hipMemsetAsync((char*)d_ws + WS_CTL, 0, CTL_ZERO_BYTES, stream);
    KArgs a{};
    for (int i = 0; i < 34; ++i) a.in[i] = (const float*)d_in[i];
    a.out = (float*)d_out; a.ws = (unsigned char*)d_ws; a.ph_lo = 0; a.ph_hi = NPHASE;
#if MK_SINGLE
    hipLaunchKernelGGL((fwd_kernel<0, NPHASE>), dim3(grid), dim3(NTHREADS), LDS_BYTES, stream, a);
#else
    PhaseLaunch<0>::go(grid, stream, a);
#endif
#if defined(DBG_CHECK) || defined(DBG_TIME)
    dbg_run(d_out, d_ws, stream);
#endif
}
```

```cpp
#define MK_SINGLE 1
#include <hip/hip_runtime.h>
#include <cstdio>
#include <cstdint>

#define LAS __attribute__((address_space(3)))
#define GAS __attribute__((address_space(1)))
typedef unsigned short bf16_t;
typedef short bf16x8 __attribute__((ext_vector_type(8)));
typedef float f32x4 __attribute__((ext_vector_type(4)));
typedef float f32x2 __attribute__((ext_vector_type(2)));
typedef unsigned u32x4 __attribute__((ext_vector_type(4)));
typedef unsigned u32x2 __attribute__((ext_vector_type(2)));

constexpr int D = 1024, NB = 8, SEQ = 8192, T = NB * SEQ;
constexpr int RW = 512, HD = 64, NH = 8;
constexpr int RWKV_COLS = 1792, IN_COLS = 4864;
constexpr int NE = 256, TOPK = 8, EFF = 256;
constexpr int NWAVES = 8, NTHREADS = 512;
constexpr int MAXROWS = T * TOPK + 256 * 256;

constexpr size_t MiB = 1u << 20;
constexpr size_t WS_CTL = 0;
constexpr int CW_BAR = 0, CW_SEGCNT = 4096, CW_NT = 4608;
constexpr size_t CTL_ZERO_BYTES = 20480;
constexpr size_t WS_MOD = 65536;
constexpr size_t WS_SW = 1 * MiB;
constexpr size_t SW_WIN = WS_SW;
constexpr size_t SW_WOA = SW_WIN + (size_t)IN_COLS * D * 2;
constexpr size_t SW_WOB = SW_WOA + (size_t)D * RW * 2;
constexpr size_t SW_WO = SW_WOB + (size_t)D * RW * 2;
constexpr size_t SW_WR = SW_WO + (size_t)D * D * 2;
constexpr size_t SW_WS13 = SW_WR + (size_t)NE * D * 2;
constexpr size_t SW_WS2 = SW_WS13 + (size_t)512 * D * 2;
constexpr size_t SW_WUP = SW_WS2 + (size_t)D * EFF * 2;
constexpr size_t SW_AUP = SW_WUP + (size_t)RW * 64 * 2;
constexpr size_t SW_GUP = SW_AUP + (size_t)RW * 64 * 2;
constexpr size_t SW_WSM = SW_GUP + (size_t)RW * 128 * 2;
constexpr size_t SW_END = SW_WSM + (size_t)8 * 128 * 128 * 2;
static_assert(SW_END <= 20 * MiB, "small weights");
constexpr size_t WS_RT = 20 * MiB;
constexpr size_t RT_EIDX = WS_RT;
constexpr size_t RT_EWT = RT_EIDX + (size_t)T * 8 * 4;
constexpr size_t RT_LRANK = RT_EWT + (size_t)T * 8 * 4;
constexpr size_t RT_TBASE = RT_LRANK + (size_t)T * 8 * 4;
constexpr size_t RT_ROWTOK = RT_TBASE + (size_t)256 * 256 * 4;
constexpr size_t RT_ROWDST = RT_ROWTOK + (size_t)MAXROWS * 4;
constexpr size_t RT_ROWW = RT_ROWDST + (size_t)MAXROWS * 4;
constexpr size_t RT_TAB = RT_ROWW + (size_t)MAXROWS * 4;
constexpr size_t RT_SBON = RT_TAB + (size_t)3 * 4096 * 8;
constexpr size_t RT_END = RT_SBON + (size_t)T * 8 * 4;
static_assert(RT_END <= 40 * MiB, "routing arrays");
constexpr size_t WS_BIG = 40 * MiB;
constexpr size_t B_H1 = WS_BIG + 0 * MiB;
constexpr size_t B_YB = WS_BIG + 0 * MiB;
constexpr size_t B_YA = WS_BIG + 64 * MiB;
constexpr size_t B_XS = WS_BIG + 64 * MiB;
constexpr size_t B_PRW = WS_BIG + 128 * MiB;
constexpr size_t B_S = WS_BIG + 128 * MiB;
constexpr size_t B_PUV = WS_BIG + 352 * MiB;
constexpr size_t B_QY = WS_BIG + 352 * MiB;
constexpr size_t B_M1 = WS_BIG + 352 * MiB;
constexpr size_t B_PG = WS_BIG + 480 * MiB;
constexpr size_t B_MN = WS_BIG + 736 * MiB;
constexpr size_t B_G = WS_BIG + 864 * MiB;
constexpr size_t B_BV = WS_BIG + 928 * MiB;
constexpr size_t B_H2 = WS_BIG + 0 * MiB;
constexpr size_t B_W13 = WS_BIG + 128 * MiB;
constexpr size_t B_H2F8 = WS_BIG + 256 * MiB;
constexpr size_t B_SH = WS_BIG + 384 * MiB;
constexpr size_t B_SC = WS_BIG + 416 * MiB;
constexpr size_t B_SLOT = WS_BIG + 0 * MiB;
constexpr size_t B_SHO = WS_BIG + 928 * MiB;
constexpr size_t B_W2 = WS_BIG + 512 * MiB;
constexpr size_t B_HID = WS_BIG + 640 * MiB;
constexpr size_t WS_END = WS_BIG + 992 * MiB;
static_assert((size_t)MAXROWS * EFF * 2 <= 320 * MiB, "hid");

constexpr int LDS_STAGE = 0;
constexpr int LDS_MISC = 147456;
constexpr int LDS_BARW = 155648;
constexpr int LDS_BYTES = 163840;

typedef __bf16 bf16x2_t __attribute__((ext_vector_type(2)));
__device__ __forceinline__ unsigned pk2(float lo, float hi) { f32x2 f = {lo, hi}; return __builtin_bit_cast(unsigned, __builtin_convertvector(f, bf16x2_t)); }
__device__ __forceinline__ u32x2 pk8(const f32x4& a, const f32x4& b) { u32x2 w; int t = __builtin_amdgcn_cvt_pk_fp8_f32(a[0], a[1], 0, false); t = __builtin_amdgcn_cvt_pk_fp8_f32(a[2], a[3], t, true); w.x = (unsigned)t;
    t = __builtin_amdgcn_cvt_pk_fp8_f32(b[0], b[1], 0, false); t = __builtin_amdgcn_cvt_pk_fp8_f32(b[2], b[3], t, true); w.y = (unsigned)t; return w; }
__device__ __forceinline__ f32x4 up8(unsigned w) { const f32x2 lo = __builtin_amdgcn_cvt_pk_f32_fp8((int)w, false), hi = __builtin_amdgcn_cvt_pk_f32_fp8((int)w, true); return (f32x4){lo.x, lo.y, hi.x, hi.y}; }
__device__ __forceinline__ float bflo(unsigned w) { return __uint_as_float(w << 16); }
__device__ __forceinline__ float bfhi(unsigned w) { return __uint_as_float(w & 0xffff0000u); }
__device__ __forceinline__ float bf2f(bf16_t h) { return __uint_as_float(((unsigned)h) << 16); }
__device__ __forceinline__ bf16_t f2bf(float f) { return (bf16_t)(pk2(f, 0.f) & 0xffffu); }
__device__ __forceinline__ float fexp(float x) { return __builtin_amdgcn_exp2f(x * 1.44269504089f); }
__device__ __forceinline__ float flog(float x) { return __builtin_amdgcn_logf(x) * 0.69314718056f; }
__device__ __forceinline__ float frcp(float x) { return __builtin_amdgcn_rcpf(x); }
__device__ __forceinline__ float sigmoidf_(float x) { return frcp(1.0f + fexp(-x)); }
__device__ __forceinline__ float siluf_(float x) { return x * sigmoidf_(x); }
__device__ __forceinline__ float tanhf_(float x) { return 1.0f - 2.0f * frcp(1.0f + fexp(2.0f * x)); }
__device__ __forceinline__ float gelu_tanh(float x) { const float u = 0.7978845608f * (x + 0.044715f * x * x * x); return x * frcp(1.0f + fexp(-2.0f * u)); }
__device__ __forceinline__ float wave_sum(float v) {
#pragma unroll
    for (int o = 1; o < 64; o <<= 1) v += __shfl_xor(v, o);
    return v;
}
#define LDS_WAIT() asm volatile("s_waitcnt lgkmcnt(0)" ::: "memory")
#define VM_WAIT() asm volatile("s_waitcnt vmcnt(0)" ::: "memory")

#define XB_TMO      128
#define XB_XCNT(j)  (256  + 64 * (j))
#define XB_XSUB(j)  (1280 + 64 * (j))
#define XB_XGEN(j)  (2304 + 64 * (j))
#define XB_TOP      3328
#define XB_TOPGEN   3392
#define XCD_BAR_WORDS 3456
#define XB_SPIN_CAP (1u << 18)
__device__ __forceinline__ unsigned xb_ld(unsigned* p)              { return __hip_atomic_load(p, __ATOMIC_RELAXED, __HIP_MEMORY_SCOPE_AGENT); }
__device__ __forceinline__ unsigned xb_add(unsigned* p, unsigned v) { return __hip_atomic_fetch_add(p, v, __ATOMIC_RELAXED, __HIP_MEMORY_SCOPE_AGENT); }
__device__ __forceinline__ unsigned xb_xcc_id() { return (unsigned)__builtin_amdgcn_s_getreg((3 << 11) | 20) & 0xFu; }
#define XB_SPIN(cond, bar) do { unsigned _sp = 0; while (cond) { __builtin_amdgcn_s_sleep(1); \
    if ((++_sp & 255u) == 0u) { if (xb_ld(&(bar)[XB_TMO])) break; if (_sp > XB_SPIN_CAP) { atomicAdd(&(bar)[XB_TMO], 1u); break; } } } } while (0)
struct XcdBarrier { unsigned* bar; unsigned x; volatile LAS unsigned* st; };
__device__ __forceinline__ XcdBarrier xcd_barrier_post(unsigned* bar, volatile LAS unsigned* st) {
    XcdBarrier b; b.bar = bar; b.x = xb_xcc_id(); b.st = st;
    if (threadIdx.x == 0) (void)xb_add(&bar[XB_XCNT(b.x)], 1u);
    return b;
}
__device__ __forceinline__ void xcd_barrier_complete(unsigned* bar, unsigned x, unsigned& nloc, unsigned& nx) {
    const unsigned G = gridDim.x * gridDim.y * gridDim.z;
    unsigned sum, cnt, mine, sp = 0u;
    for (;;) {
        sum = 0u; cnt = 0u; mine = 0u;
#pragma unroll
        for (unsigned j = 0; j < 16; ++j) { const unsigned c = xb_ld(&bar[XB_XCNT(j)]); sum += c; cnt += (c > 0u) ? 1u : 0u; mine = (j == x) ? c : mine; }
        if (sum == G) break;
        __builtin_amdgcn_s_sleep(1);
        if ((++sp & 255u) == 0u) { if (xb_ld(&bar[XB_TMO])) break; if (sp > XB_SPIN_CAP) { atomicAdd(&bar[XB_TMO], 1u); break; } }
    }
    nloc = mine > 0u ? mine : 1u; nx = cnt > 0u ? cnt : 1u;
}
__device__ __forceinline__ void xcd_barrier(const XcdBarrier& b) {
    asm volatile("s_waitcnt vmcnt(0)" ::: "memory");
    __syncthreads();
    if (threadIdx.x == 0) {
        unsigned* bar = b.bar;
        __builtin_amdgcn_s_waitcnt(0);
        unsigned nloc = b.st[0], nx = b.st[1];
        if (nloc == 0u) { xcd_barrier_complete(bar, b.x, nloc, nx); b.st[0] = nloc; b.st[1] = nx; }
        const unsigned old = xb_add(&bar[XB_XSUB(b.x)], 1u);
        const unsigned gen = old / nloc;
        if (old + 1u == (gen + 1u) * nloc) {
            __builtin_amdgcn_fence(__ATOMIC_RELEASE, "agent");
            asm volatile("s_waitcnt vmcnt(0)" ::: "memory");
            const unsigned og = xb_add(&bar[XB_TOP], 1u);
            const unsigned tg = og / nx;
            if (og + 1u == (tg + 1u) * nx) xb_add(&bar[XB_TOPGEN], 1u);
            else XB_SPIN(xb_ld(&bar[XB_TOPGEN]) == tg, bar);
            __builtin_amdgcn_fence(__ATOMIC_ACQUIRE, "agent");
            xb_add(&bar[XB_XGEN(b.x)], 1u);
            asm volatile("s_waitcnt vmcnt(0)" ::: "memory");
        } else {
            XB_SPIN(xb_ld(&bar[XB_XGEN(b.x)]) == gen, bar);
            __builtin_amdgcn_fence(__ATOMIC_ACQUIRE, "agent");
            asm volatile("s_waitcnt vmcnt(0)" ::: "memory");
        }
    }
    __syncthreads();
}
namespace gm {
typedef int i32x4 __attribute__((ext_vector_type(4)));
typedef int i32x8 __attribute__((ext_vector_type(8)));
constexpr int BM = 256, BK = 64, HALF = 128, HTB = HALF * BK * 2, STAGE_BYTES = 8 * HTB, NXCD = 8, WGM = 8;
__host__ __device__ __forceinline__ int lds_byte(int r, int c) { const int st = (r >> 4) * 2 + (c >> 5), rr = r & 15, cc = c & 31, ob = rr * 64 + cc * 2; return st * 1024 + (ob ^ (((ob >> 9) & 1) << 5)); }
__host__ __device__ __forceinline__ void stage_rc(int b, int& R, int& C) { const int st = b / 1024, sb = b % 1024, swz = sb ^ (((sb >> 9) & 1) << 5); R = (st >> 1) * 16 + swz / 64; C = (st & 1) * 32 + (swz % 64) / 2; }
__host__ __device__ __forceinline__ int perm32(int rho) { const int n = rho >> 4, i = rho & 15; return 8 * (i >> 2) + 4 * n + (i & 3); }

struct Unit { int pm, pn, e, row0, par; };

struct DenseSched {
    static constexpr bool GATHER = false;
    const char* A; const char* B; int nM, nN, nwg, G, c; size_t tstep;
    __device__ __forceinline__ void init(const void* A_, const void* B_, int M, int N, int K, int G_, int c_, int es = 2) { A = (const char*)A_; B = (const char*)B_; nM = M / BM; nN = N / BM; nwg = nM * nN; G = G_; c = c_; tstep = (size_t)BM * K * es; }
    __device__ __forceinline__ bool next(int i, Unit& u) const {
        const long L = (long)i * G + c; if (L >= nwg) return false;
        int wgid = (int)L; { const int q = nwg / NXCD, r = nwg % NXCD, xcd = wgid % NXCD, off = wgid / NXCD; wgid = (xcd < r ? xcd * (q + 1) : r * (q + 1) + (xcd - r) * q) + off; }
        const int nig = WGM * nN, gid = wgid / nig, fm = gid * WGM, gsz = (nM - fm) < WGM ? (nM - fm) : WGM;
        u.pm = fm + ((wgid % nig) % gsz); u.pn = (wgid % nig) / gsz; u.e = 0; u.row0 = u.pm * BM; return true;
    }
    __device__ __forceinline__ const char* a_ptr(const Unit& u) const { return A + (size_t)u.pm * tstep; }
    __device__ __forceinline__ const char* b_ptr(const Unit& u) const { return B + (size_t)u.pn * tstep; }
    __device__ __forceinline__ unsigned row_off(const Unit&, int) const { return 0u; }
};
template <bool GATHER_>
struct GroupSched {
    static constexpr bool GATHER = GATHER_;
    const char* A; const char* B; const int* tab; const int* rowtok; int ntiles, npn, G, c, K; size_t ebytes, tstep;
    __device__ __forceinline__ bool next(int i, Unit& u) const {
        int tile;
        if (G == 256) {
            const int xcd = c & 7, slot = c >> 3, tpx = 32 / npn; tile = i * 8 * tpx + xcd * tpx + slot / npn; u.pn = slot % npn; if (tile >= ntiles) return false;
        } else { const long L = (long)i * G + c; if (L >= (long)ntiles * npn) return false; tile = (int)(L / npn); u.pn = (int)(L % npn); }
        u.pm = tile;
        u.row0 = __builtin_amdgcn_readfirstlane(tab[2 * tile]); u.e = __builtin_amdgcn_readfirstlane(tab[2 * tile + 1]); return true;
    }
    __device__ __forceinline__ const char* a_ptr(const Unit& u) const { return GATHER ? A : A + (size_t)u.row0 * K; }
    __device__ __forceinline__ const char* b_ptr(const Unit& u) const { return B + (size_t)u.e * ebytes + (size_t)u.pn * tstep; }
    __device__ __forceinline__ unsigned row_off(const Unit& u, int r) const { return (unsigned)rowtok[u.row0 + r] * (unsigned)K; }
};

template <class Epi, class Sched, bool ALIGN_EPI, bool F8 = false, int SCALE_W = 127>
__device__ __forceinline__ void gemm_phase(LAS unsigned char* lds, const int Kel, const Sched& S, const Epi& E) {
    const int K = F8 ? Kel / 2 : Kel;
    int tid_ = threadIdx.x; asm volatile("" : "+v"(tid_));
    const int tid = tid_, wid = __builtin_amdgcn_readfirstlane(tid >> 6), lane = tid & 63, wr = wid >> 2, wc = wid & 3, fr = lane & 15, fq = lane >> 4;
    const int nt = K / BK;
    int sR[2], sC[2]; unsigned voffB[2];
#pragma unroll
    for (int i = 0; i < 2; ++i) { int R, C; stage_rc(tid * 16 + i * 8192, R, C); sR[i] = R; sC[i] = C; const int Rb = Epi::PERM ? ((R & ~31) + perm32(R & 31)) : R; voffB[i] = (unsigned)(Rb * K + C) * 2u; }
    const size_t kstep = (size_t)(BK * 2);
    const size_t hstep = (size_t)HALF * K * 2;
    const unsigned ldsw = (unsigned)wid * 1024u;
    const int aoff = lds_byte(wr * 64 + fr, fq * 8), boff = lds_byte(wc * 32 + fr, fq * 8);
#define PG8_SA(b, h) (((b) * 2 + (h)) * HTB)
#define PG8_SB(b, h) ((4 + (b) * 2 + (h)) * HTB)
#define PG8_STGB(bufoff, gbase) do { _Pragma("unroll") for (int _i = 0; _i < 2; ++_i) \
        __builtin_amdgcn_global_load_lds((const unsigned*)((const char*)(gbase) + voffB[_i]), (LAS unsigned*)(lds + (bufoff) + ldsw + _i * 8192), 16, 0, 0); } while (0)
#define PG8_STGA(bufoff, gbase, VO, h) do { _Pragma("unroll") for (int _i = 0; _i < 2; ++_i) \
        __builtin_amdgcn_global_load_lds((const unsigned*)((const char*)(gbase) + VO[h][_i]), (LAS unsigned*)(lds + (bufoff) + ldsw + _i * 8192), 16, 0, 0); } while (0)
#define PG8_VOA(u, VO) do { _Pragma("unroll") for (int _h = 0; _h < 2; ++_h) _Pragma("unroll") for (int _i = 0; _i < 2; ++_i) \
        VO[_h][_i] = Sched::GATHER ? (S.row_off(u, _h * HALF + sR[_i]) + (unsigned)sC[_i] * 2u) : ((unsigned)((_h * HALF + sR[_i]) * K + sC[_i]) * 2u); } while (0)
#define PG8_LDA(dst, b, h) do { _Pragma("unroll") for (int m = 0; m < 4; ++m) { if constexpr (F8) { dst##8[m].lo = *(const LAS i32x4*)(lds + PG8_SA(b, h) + aoff + m * 2048); dst##8[m].hi = *(const LAS i32x4*)(lds + PG8_SA(b, h) + aoff + m * 2048 + 1024); } else { _Pragma("unroll") for (int k = 0; k < 2; ++k) dst[m][k] = *(const LAS bf16x8*)(lds + PG8_SA(b, h) + aoff + m * 2048 + k * 1024); } } } while (0)
#define PG8_LDB(dst, b, h) do { _Pragma("unroll") for (int n = 0; n < 2; ++n) { if constexpr (F8) { dst##8[n].lo = *(const LAS i32x4*)(lds + PG8_SB(b, h) + boff + n * 2048); dst##8[n].hi = *(const LAS i32x4*)(lds + PG8_SB(b, h) + boff + n * 2048 + 1024); } else { _Pragma("unroll") for (int k = 0; k < 2; ++k) dst[n][k] = *(const LAS bf16x8*)(lds + PG8_SB(b, h) + boff + n * 2048 + k * 1024); } } } while (0)
#define PG8_MMA(ai, bj, At, Bt) do { __builtin_amdgcn_s_setprio(1); _Pragma("unroll") for (int m = 0; m < 4; ++m) _Pragma("unroll") for (int n = 0; n < 2; ++n) { \
        if constexpr (F8) { asm volatile("v_mfma_scale_f32_16x16x128_f8f6f4 %0, %1, %2, %0, %3, %4 op_sel_hi:[0,0,0]" : "+v"(acc[ai][bj][m][n]) : "v"(Bt##8[n]), "v"(At##8[m]), "v"(scw_), "v"(sca_)); } \
        else { _Pragma("unroll") for (int k = 0; k < 2; ++k) acc[ai][bj][m][n] = __builtin_amdgcn_mfma_f32_16x16x32_bf16(Bt[n][k], At[m][k], acc[ai][bj][m][n], 0, 0, 0); } } \
        __builtin_amdgcn_s_setprio(0); } while (0)
#define PG8_WAIT_V(n) asm volatile("s_waitcnt vmcnt(" #n ")" ::: "memory")
#define PG8_WAIT_L(n) asm volatile("s_waitcnt lgkmcnt(" #n ")" ::: "memory")
#define PG8_BAR __builtin_amdgcn_s_barrier()
#define PG8_SCHED __builtin_amdgcn_sched_barrier(0)
    Unit cur, nxt; int ui = 0;
    if (!S.next(0, cur)) return;
    f32x4 acc[2][2][4][2];
#pragma unroll
    for (int a = 0; a < 2; ++a)
#pragma unroll
        for (int b = 0; b < 2; ++b)
#pragma unroll
            for (int m = 0; m < 4; ++m)
#pragma unroll
                for (int n = 0; n < 2; ++n) acc[a][b][m][n] = (f32x4){0.f, 0.f, 0.f, 0.f};
    const int scw_ = SCALE_W, sca_ = 127;
    bf16x8 At[4][2], B0[2][2], B1[2][2]; i32x8 At8[4], B08[2], B18[2];
    unsigned voA[2][2], nvoA[2][2];
    PG8_VOA(cur, voA);
    if (Sched::GATHER) { asm volatile("s_waitcnt vmcnt(0)" ::: "memory"); }
    const char* cA = S.a_ptr(cur); const char* cB = S.b_ptr(cur);
    cur.par = 0; E.stage_rows(cur, lds, wid);
    PG8_STGB(PG8_SB(0, 0), cB); PG8_STGB(PG8_SB(0, 1), cB + hstep); PG8_STGA(PG8_SA(0, 0), cA, voA, 0); PG8_STGA(PG8_SA(0, 1), cA, voA, 1);
    if (wr == 1) PG8_BAR;
    PG8_WAIT_V(2); PG8_BAR;
    PG8_STGB(PG8_SB(1, 0), cB + kstep); PG8_STGA(PG8_SA(1, 0), cA + kstep, voA, 0); PG8_STGB(PG8_SB(1, 1), cB + hstep + kstep);
    PG8_WAIT_V(6); PG8_BAR;
    for (;;) {
        const bool has_next = S.next(ui + 1, nxt); nxt.par = (ui + 1) & 3;
        const char* nA = has_next ? S.a_ptr(nxt) : cA; const char* nB = has_next ? S.b_ptr(nxt) : cB;
        if (Sched::GATHER) { if (has_next) { PG8_VOA(nxt, nvoA); } else {
#pragma unroll
            for (int h = 0; h < 2; ++h)
#pragma unroll
                for (int i = 0; i < 2; ++i) nvoA[h][i] = voA[h][i]; } }
#pragma unroll 1
        for (int t = 0; t < nt; t += 2) {
            const bool last = (t == nt - 2);
            const char* a1 = cA + (size_t)(t + 1) * kstep;
            const char* a2 = last ? nA : cA + (size_t)(t + 2) * kstep; const char* b2 = last ? nB : cB + (size_t)(t + 2) * kstep;
            const char* a3 = a2 + kstep; const char* b3 = b2 + kstep;
            unsigned vo2[2][2];
#pragma unroll
            for (int h = 0; h < 2; ++h)
#pragma unroll
                for (int i = 0; i < 2; ++i) vo2[h][i] = (Sched::GATHER && last) ? nvoA[h][i] : voA[h][i];
            if (last && has_next) E.stage_rows(nxt, lds, wid);
            PG8_LDB(B0, 0, 0); PG8_LDB(B1, 0, 1); PG8_SCHED; PG8_LDA(At, 0, 0); PG8_STGA(PG8_SA(1, 1), a1, voA, 1);
            PG8_WAIT_V(8); PG8_WAIT_L(0); PG8_BAR; PG8_MMA(0, 0, At, B0); PG8_MMA(0, 1, At, B1); PG8_BAR; PG8_SCHED;
            PG8_LDA(At, 0, 1); PG8_STGB(PG8_SB(0, 0), b2); PG8_STGB(PG8_SB(0, 1), b2 + hstep); PG8_STGA(PG8_SA(0, 0), a2, vo2, 0);
            PG8_WAIT_V(8); PG8_WAIT_L(0); PG8_BAR; PG8_MMA(1, 0, At, B0); PG8_MMA(1, 1, At, B1); PG8_BAR; PG8_SCHED;
            PG8_LDB(B0, 1, 0); PG8_LDB(B1, 1, 1); PG8_SCHED; PG8_LDA(At, 1, 0); PG8_STGA(PG8_SA(0, 1), a2, vo2, 1);
            PG8_WAIT_V(8); PG8_WAIT_L(0); PG8_BAR; PG8_MMA(0, 0, At, B0); PG8_MMA(0, 1, At, B1); PG8_BAR; PG8_SCHED;
            PG8_LDA(At, 1, 1); PG8_STGB(PG8_SB(1, 0), b3); PG8_STGB(PG8_SB(1, 1), b3 + hstep); PG8_STGA(PG8_SA(1, 0), a3, vo2, 0);
            PG8_WAIT_V(8); PG8_WAIT_L(0); PG8_BAR; PG8_MMA(1, 0, At, B0); PG8_MMA(1, 1, At, B1); PG8_BAR; PG8_SCHED;
        }
        if constexpr (F8) asm volatile("s_nop 15\n\ts_nop 15\n\ts_nop 15" ::: "memory");
        if constexpr (ALIGN_EPI) { if (wr == 0) PG8_BAR; }
        E(acc, cur, wr, wc, fr, fq);
        if (!has_next) break;
#pragma unroll
        for (int a = 0; a < 2; ++a)
#pragma unroll
            for (int b = 0; b < 2; ++b)
#pragma unroll
                for (int m = 0; m < 4; ++m)
#pragma unroll
                    for (int n = 0; n < 2; ++n) acc[a][b][m][n] = (f32x4){0.f, 0.f, 0.f, 0.f};
        cur = nxt; cA = nA; cB = nB; ++ui;
        if (Sched::GATHER) {
#pragma unroll
            for (int h = 0; h < 2; ++h)
#pragma unroll
                for (int i = 0; i < 2; ++i) voA[h][i] = nvoA[h][i]; }
        if constexpr (ALIGN_EPI) { if (wr == 1) PG8_BAR; }
    }
    PG8_WAIT_V(0);
    if constexpr (!ALIGN_EPI) { if (wr == 0) PG8_BAR; }
    PG8_BAR;
#undef PG8_SA
#undef PG8_SB
#undef PG8_STGA
#undef PG8_STGB
#undef PG8_VOA
#undef PG8_LDA
#undef PG8_LDB
#undef PG8_MMA
#undef PG8_WAIT_V
#undef PG8_WAIT_L
#undef PG8_BAR
#undef PG8_SCHED
}

typedef f32x4 Acc[2][2][4][2];
struct EpiInProj {
    static constexpr bool PERM = true;
    __device__ __forceinline__ void stage_rows(const Unit&, LAS unsigned char*, int) const {}
    bf16_t *prw, *puv, *pg;
    template <int ACT> __device__ __forceinline__ void tile(const Acc& acc, bf16_t* base, int ld, int row0, int col0) const {
#pragma unroll
        for (int ai = 0; ai < 2; ++ai)
#pragma unroll
            for (int m = 0; m < 4; ++m) { bf16_t* rowp = base + (size_t)(row0 + ai * HALF + m * 16) * ld + col0;
#pragma unroll
                for (int bj = 0; bj < 2; ++bj) { f32x4 v0 = acc[ai][bj][m][0], v1 = acc[ai][bj][m][1];
                    if (ACT == 1) {
#pragma unroll
                        for (int j = 0; j < 4; ++j) { v0[j] = gelu_tanh(v0[j]); v1[j] = gelu_tanh(v1[j]); } }
                    if (ACT == 2) {
#pragma unroll
                        for (int j = 0; j < 4; ++j) { v0[j] = sigmoidf_(v0[j]); v1[j] = sigmoidf_(v1[j]); } }
                    u32x4 w; w.x = pk2(v0[0], v0[1]); w.y = pk2(v0[2], v0[3]); w.z = pk2(v1[0], v1[1]); w.w = pk2(v1[2], v1[3]);
                    *(u32x4*)(rowp + bj * HALF) = w; }
                __builtin_amdgcn_sched_barrier(0); }
    }
    __device__ __forceinline__ void operator()(const Acc& acc, const Unit& u, int wr, int wc, int fr, int fq) const {
        const int row0 = u.row0 + wr * 64 + fr, cw = wc * 32 + 8 * fq;
        if (u.pn < 7) tile<0>(acc, prw, RWKV_COLS, row0, u.pn * 256 + cw);
        else if (u.pn < 11) tile<1>(acc, puv, 1024, row0, (u.pn - 7) * 256 + cw);
        else tile<2>(acc, pg, 2048, row0, (u.pn - 11) * 256 + cw);
    }
};
template <bool SECOND> struct EpiMerge {
    static constexpr bool PERM = true;
    __device__ __forceinline__ void stage_rows(const Unit&, LAS unsigned char*, int) const {}
    bf16_t* m1; const bf16_t* pg;
    __device__ __forceinline__ void operator()(const Acc& acc, const Unit& u, int wr, int wc, int fr, int fq) const {
        const int row0 = u.row0 + wr * 64 + fr, col0 = u.pn * 256 + wc * 32 + 8 * fq;
#pragma unroll
        for (int ai = 0; ai < 2; ++ai)
#pragma unroll
            for (int m = 0; m < 4; ++m) { const size_t r = (size_t)(row0 + ai * HALF + m * 16);
#pragma unroll
                for (int bj = 0; bj < 2; ++bj) { const int c = col0 + bj * HALF;
                    const u32x4 g = *(const u32x4*)(pg + r * 2048 + (SECOND ? 1024 : 0) + c);
                    f32x4 v0 = acc[ai][bj][m][0], v1 = acc[ai][bj][m][1];
                    v0[0] *= bflo(g.x); v0[1] *= bfhi(g.x); v0[2] *= bflo(g.y); v0[3] *= bfhi(g.y); v1[0] *= bflo(g.z); v1[1] *= bfhi(g.z); v1[2] *= bflo(g.w); v1[3] *= bfhi(g.w);
                    if (SECOND) { const u32x4 p = *(const u32x4*)(m1 + r * 1024 + c);
                        v0[0] += bflo(p.x); v0[1] += bfhi(p.x); v0[2] += bflo(p.y); v0[3] += bfhi(p.y); v1[0] += bflo(p.z); v1[1] += bfhi(p.z); v1[2] += bflo(p.w); v1[3] += bfhi(p.w); }
                    u32x4 w; w.x = pk2(v0[0], v0[1]); w.y = pk2(v0[2], v0[3]); w.z = pk2(v1[0], v1[1]); w.w = pk2(v1[2], v1[3]);
                    *(u32x4*)(m1 + r * 1024 + c) = w; } }
    }
};
struct EpiResid {
    static constexpr bool PERM = false;
    __device__ __forceinline__ void stage_rows(const Unit&, LAS unsigned char*, int) const {}
    float* out; const float* base; const float* gate;
    __device__ __forceinline__ void operator()(const Acc& acc, const Unit& u, int wr, int wc, int fr, int fq) const {
        const int row0 = u.row0 + wr * 64 + fr, col0 = u.pn * 256 + wc * 32 + 4 * fq;
        const float* gp = gate + (size_t)(u.row0 >> 13) * 6144 + col0;
        f32x4 gv[2][2];
#pragma unroll
        for (int bj = 0; bj < 2; ++bj)
#pragma unroll
            for (int n = 0; n < 2; ++n) gv[bj][n] = *(const f32x4*)(gp + bj * HALF + n * 16);
#pragma unroll
        for (int ai = 0; ai < 2; ++ai)
#pragma unroll
            for (int m = 0; m < 4; ++m) { const size_t ro = (size_t)(row0 + ai * HALF + m * 16) * 1024 + col0;
#pragma unroll
                for (int bj = 0; bj < 2; ++bj)
#pragma unroll
                    for (int n = 0; n < 2; ++n) { const f32x4 b = *(const f32x4*)(base + ro + bj * HALF + n * 16);
                        *(f32x4*)(out + ro + bj * HALF + n * 16) = b + gv[bj][n] * acc[ai][bj][m][n]; } }
    }
};
struct EpiRouter {
    static constexpr bool PERM = false;
    __device__ __forceinline__ void stage_rows(const Unit&, LAS unsigned char*, int) const {}
    float* sc;
    __device__ __forceinline__ void operator()(const Acc& acc, const Unit& u, int wr, int wc, int fr, int fq) const {
        const int row0 = u.row0 + wr * 64 + fr, col0 = wc * 32 + 4 * fq;
#pragma unroll
        for (int ai = 0; ai < 2; ++ai)
#pragma unroll
            for (int m = 0; m < 4; ++m) { float* rowp = sc + (size_t)(row0 + ai * HALF + m * 16) * 256 + col0;
#pragma unroll
                for (int bj = 0; bj < 2; ++bj)
#pragma unroll
                    for (int n = 0; n < 2; ++n) { f32x4 v = acc[ai][bj][m][n];
#pragma unroll
                        for (int j = 0; j < 4; ++j) v[j] = sigmoidf_(v[j]);
                        *(f32x4*)(rowp + bj * HALF + n * 16) = v; }
                __builtin_amdgcn_sched_barrier(0); }
    }
};
template <bool F8OUT> struct EpiGateUp {
    static constexpr bool PERM = true;
    __device__ __forceinline__ void stage_rows(const Unit&, LAS unsigned char*, int) const {}
    void* hid;
    __device__ __forceinline__ void operator()(const Acc& acc, const Unit& u, int wr, int wc, int fr, int fq) const {
        const int row0 = u.row0 + wr * 64 + fr, col0 = u.pn * HALF + wc * 32 + 8 * fq;
#pragma unroll
        for (int ai = 0; ai < 2; ++ai)
#pragma unroll
            for (int m = 0; m < 4; ++m) { const size_t off = (size_t)(row0 + ai * HALF + m * 16) * EFF + col0;
                f32x4 v0, v1;
#pragma unroll
                for (int j = 0; j < 4; ++j) { v0[j] = siluf_(acc[ai][0][m][0][j]) * acc[ai][1][m][0][j]; v1[j] = siluf_(acc[ai][0][m][1][j]) * acc[ai][1][m][1][j]; }
                if constexpr (F8OUT) *(u32x2*)((unsigned char*)hid + off) = pk8(v0, v1);
                else { u32x4 w; w.x = pk2(v0[0], v0[1]); w.y = pk2(v0[2], v0[3]); w.z = pk2(v1[0], v1[1]); w.w = pk2(v1[2], v1[3]); *(u32x4*)((bf16_t*)hid + off) = w; }
                __builtin_amdgcn_sched_barrier(0); }
    }
};
struct EpiExpertDown {
    static constexpr bool PERM = true;
    unsigned char* slot; const int* rowdst; const float* roww;
    __device__ __forceinline__ void stage_rows(const Unit& u, LAS unsigned char* lds, int wid) const {
        if (wid < 4) { const int lane = threadIdx.x & 63; LAS unsigned char* base = lds + LDS_MISC + u.par * 2048 + wid * 256;
            __builtin_amdgcn_global_load_lds((const unsigned*)(rowdst + u.row0 + wid * 64 + lane), (LAS unsigned*)base, 4, 0, 0);
            __builtin_amdgcn_global_load_lds((const unsigned*)(roww + u.row0 + wid * 64 + lane), (LAS unsigned*)(base + 1024), 4, 0, 0); }
    }
    __device__ __forceinline__ void operator()(const Acc& acc, const Unit& u, int wr, int wc, int fr, int fq) const {
        const unsigned cb = (unsigned)(u.pn * 256 + wc * 32 + 8 * fq);
        const LAS int* td = (const LAS int*)((LAS unsigned char*)nullptr + LDS_MISC + u.par * 2048) + wr * 64 + fr; const LAS float* tw = (const LAS float*)(td + 256);
#pragma unroll
        for (int ai = 0; ai < 2; ++ai)
#pragma unroll
            for (int m = 0; m < 4; ++m) {
                const int dst = td[ai * HALF + m * 16]; const float ws_ = tw[ai * HALF + m * 16];
                if (dst >= 0) { unsigned char* rowp = slot + (size_t)((unsigned)dst * 1024u + cb);
#pragma unroll
                    for (int bj = 0; bj < 2; ++bj) { const f32x4 v0 = acc[ai][bj][m][0] * ws_, v1 = acc[ai][bj][m][1] * ws_;
                        *(u32x2*)(rowp + bj * HALF) = pk8(v0, v1); } }
                __builtin_amdgcn_sched_barrier(0);
            }
    }
};
struct EpiSharedDown {
    static constexpr bool PERM = true;
    unsigned char* sho;
    __device__ __forceinline__ void stage_rows(const Unit&, LAS unsigned char*, int) const {}
    __device__ __forceinline__ void operator()(const Acc& acc, const Unit& u, int wr, int wc, int fr, int fq) const {
        const int row0 = u.row0 + wr * 64 + fr, col0 = u.pn * 256 + wc * 32 + 8 * fq;
#pragma unroll
        for (int ai = 0; ai < 2; ++ai)
#pragma unroll
            for (int m = 0; m < 4; ++m) { unsigned char* rowp = sho + (size_t)(row0 + ai * HALF + m * 16) * 1024 + col0;
#pragma unroll
                for (int bj = 0; bj < 2; ++bj) *(u32x2*)(rowp + bj * HALF) = pk8(acc[ai][bj][m][0], acc[ai][bj][m][1]);
                __builtin_amdgcn_sched_barrier(0); }
    }
};
}
__device__ __forceinline__ void phase_mod(const float* c, const float* ada_w, const float* ada_b, float* mod, LAS unsigned char* lds, int tid, int G) {
    LAS float* sl = (LAS float*)lds; LAS float* red = (LAS float*)(lds + 32768);
    for (int i = tid; i < NB * D; i += NTHREADS) { const float v = c[i]; sl[i] = siluf_(v); }
    __syncthreads();
    const int cl = tid % 24, kg = tid / 24;
    for (int cb = blockIdx.x; cb < 256; cb += G) {
        const int col0 = cb * 24;
        if (tid < 384) {
            float a[NB];
#pragma unroll
            for (int b = 0; b < NB; ++b) a[b] = 0.f;
            for (int k = kg; k < D; k += 16) { const float w = ada_w[(size_t)k * 6144 + col0 + cl];
#pragma unroll
                for (int b = 0; b < NB; ++b) a[b] += sl[b * D + k] * w; }
#pragma unroll
            for (int b = 0; b < NB; ++b) red[(kg * 24 + cl) * NB + b] = a[b];
        }
        __syncthreads();
        if (tid < 192) { const int c2 = tid >> 3, b = tid & 7; float s = 0.f;
#pragma unroll
            for (int g = 0; g < 16; ++g) s += red[(g * 24 + c2) * NB + b];
            mod[(size_t)b * 6144 + col0 + c2] = s + ada_b[col0 + c2]; }
        __syncthreads();
    }
}
__device__ __forceinline__ void transpose_item(const float* W, int ldw, int k0, int n0, bf16_t* WT, int ldt, int drow0, LAS float* scr, int lane) {
#pragma unroll 8
    for (int i = 0; i < 32; ++i) { const int kk = 2 * i + (lane >> 5); scr[kk * 33 + (lane & 31)] = W[(size_t)(k0 + kk) * ldw + n0 + (lane & 31)]; }
    LDS_WAIT(); asm volatile("" ::: "memory");
    const int c = lane & 7;
#pragma unroll
    for (int j = 0; j < 4; ++j) { const int n = (lane >> 3) + 8 * j; const LAS float* s = scr + (8 * c) * 33 + n;
        u32x4 o; o.x = pk2(s[0 * 33], s[1 * 33]); o.y = pk2(s[2 * 33], s[3 * 33]); o.z = pk2(s[4 * 33], s[5 * 33]); o.w = pk2(s[6 * 33], s[7 * 33]);
        *(u32x4*)(WT + (size_t)(drow0 + n) * ldt + k0 + 8 * c) = o; }
    LDS_WAIT(); asm volatile("" ::: "memory");
}
__device__ __forceinline__ void transpose_job(const float* W, int K, int N, bf16_t* WT, int gated, int goff, int item, LAS float* scr, int lane) {
    const int nblk = N / 32, kb = item / nblk, nb = item % nblk, n0 = 32 * nb;
    const int drow0 = gated ? (256 * (n0 >> 7) + goff + (n0 & 127)) : n0;
    transpose_item(W, N, 64 * kb, n0, WT, K, drow0, scr, lane);
}
__device__ __forceinline__ void transpose_item64(const float* W, int ldw, int k0, int n0, bf16_t* WT, int ldt, int drow0, LAS float* scr, int lane) {
    f32x4 v[16];
    const int c4 = lane & 15, r4 = lane >> 4;
#pragma unroll
    for (int i = 0; i < 16; ++i) v[i] = *(const f32x4*)(W + (size_t)(k0 + 4 * i + r4) * ldw + n0 + 4 * c4);
#pragma unroll
    for (int i = 0; i < 16; ++i) { LAS float* d = scr + (4 * i + r4) * 65 + 4 * c4; d[0] = v[i].x; d[1] = v[i].y; d[2] = v[i].z; d[3] = v[i].w; }
    LDS_WAIT(); asm volatile("" ::: "memory");
    const int c = lane & 7;
#pragma unroll
    for (int j = 0; j < 8; ++j) { const int n = (lane >> 3) + 8 * j; const LAS float* s = scr + (8 * c) * 65 + n;
        u32x4 o; o.x = pk2(s[0 * 65], s[1 * 65]); o.y = pk2(s[2 * 65], s[3 * 65]); o.z = pk2(s[4 * 65], s[5 * 65]); o.w = pk2(s[6 * 65], s[7 * 65]);
        *(u32x4*)(WT + (size_t)(drow0 + n) * ldt + k0 + 8 * c) = o; }
    LDS_WAIT(); asm volatile("" ::: "memory");
}
constexpr float WSCALE = 32.0f;
__device__ __forceinline__ void transpose_item64_f8(const float* W, int ldw, int k0, int n0, unsigned char* WT8, int ldt, int drow0, LAS float* scr, int lane) {
    f32x4 v[16];
    const int c4 = lane & 15, r4 = lane >> 4;
#pragma unroll
    for (int i = 0; i < 16; ++i) v[i] = *(const f32x4*)(W + (size_t)(k0 + 4 * i + r4) * ldw + n0 + 4 * c4);
#pragma unroll
    for (int i = 0; i < 16; ++i) { LAS float* d = scr + (4 * i + r4) * 65 + 4 * c4; d[0] = v[i].x; d[1] = v[i].y; d[2] = v[i].z; d[3] = v[i].w; }
    LDS_WAIT(); asm volatile("" ::: "memory");
    const int c = lane & 7;
#pragma unroll
    for (int j = 0; j < 8; ++j) { const int n = (lane >> 3) + 8 * j; const LAS float* s = scr + (8 * c) * 65 + n;
        const f32x4 lo = (f32x4){s[0 * 65], s[1 * 65], s[2 * 65], s[3 * 65]} * WSCALE, hi = (f32x4){s[4 * 65], s[5 * 65], s[6 * 65], s[7 * 65]} * WSCALE;
        *(u32x2*)(WT8 + (size_t)(drow0 + n) * ldt + k0 + 8 * c) = pk8(lo, hi); }
    LDS_WAIT(); asm volatile("" ::: "memory");
}
struct SmallW { const float *w_in, *w_out_a, *w_out_b, *w_out, *router_w, *sw1, *sw3, *sw2, *w_up, *a_up, *g_up, *gws; };
__device__ __forceinline__ void phase_small_weights(const SmallW& P, unsigned char* ws, LAS unsigned char* lds, int gw, int NGW, int wave, int lane) {
    LAS float* scr = (LAS float*)(lds + wave * 16640);
    constexpr int I0 = 16 * 76, I1 = 8 * 32, I2 = 8 * 32, I3 = 16 * 32, I4 = 16 * 8, I5 = 16 * 8, I6 = 16 * 8, I7 = 4 * 32, I8 = 16, I9 = 16, I10 = 2 * 16;
    constexpr int NIT = I0 + I1 + I2 + I3 + I4 + I5 + I6 + I7 + I8 + I9 + I10;
    for (int it = gw; it < NIT; it += NGW) {
        int r = it;
        if (r < I0) { const int kb = r / 76, nb = r % 76; transpose_item64_f8(P.w_in, IN_COLS, 64 * kb, 64 * nb, ws + SW_WIN, D, 64 * nb, scr, lane); continue; } r -= I0;
        if (r < I1) { transpose_job(P.w_out_a, RW, D, (bf16_t*)(ws + SW_WOA), 0, 0, r, scr, lane); continue; } r -= I1;
        if (r < I2) { transpose_job(P.w_out_b, RW, D, (bf16_t*)(ws + SW_WOB), 0, 0, r, scr, lane); continue; } r -= I2;
        if (r < I3) { transpose_job(P.w_out, D, D, (bf16_t*)(ws + SW_WO), 0, 0, r, scr, lane); continue; } r -= I3;
        if (r < I4) { transpose_job(P.router_w, D, NE, (bf16_t*)(ws + SW_WR), 0, 0, r, scr, lane); continue; } r -= I4;
        if (r < I5) { transpose_job(P.sw1, D, EFF, (bf16_t*)(ws + SW_WS13), 1, 0, r, scr, lane); continue; } r -= I5;
        if (r < I6) { transpose_job(P.sw3, D, EFF, (bf16_t*)(ws + SW_WS13), 1, 128, r, scr, lane); continue; } r -= I6;
        if (r < I7) { transpose_job(P.sw2, EFF, D, (bf16_t*)(ws + SW_WS2), 0, 0, r, scr, lane); continue; } r -= I7;
        if (r < I8) { transpose_job(P.w_up, 64, RW, (bf16_t*)(ws + SW_WUP), 0, 0, r, scr, lane); continue; } r -= I8;
        if (r < I9) { transpose_job(P.a_up, 64, RW, (bf16_t*)(ws + SW_AUP), 0, 0, r, scr, lane); continue; } r -= I9;
        transpose_job(P.g_up, 128, RW, (bf16_t*)(ws + SW_GUP), 0, 0, r, scr, lane);
    }
    bf16_t* wsm = (bf16_t*)(ws + SW_WSM);
    for (int i = gw * 64 + lane; i < 8 * 128 * 128; i += NGW * 64) { const int col = i & 127, row = (i >> 7) & 127; wsm[i] = (col <= row) ? f2bf(P.gws[i]) : (bf16_t)0; }
}
__device__ __forceinline__ void phase_expert_weights(const float* w1, const float* w3, const float* w2, unsigned char* ws, LAS unsigned char* lds, int gw, int NGW, int wave, int lane) {
    LAS float* scr = (LAS float*)(lds + wave * 16640);
    constexpr int PER = 64;
    for (int it = gw; it < NE * 3 * PER; it += NGW) {
        const int e = it / (3 * PER), r = it % (3 * PER), which = r / PER, item = r % PER;
        if (which < 2) { const int kb = item >> 2, nb = item & 3, n0 = 64 * nb;
            transpose_item64_f8((which ? w3 : w1) + (size_t)e * D * EFF, EFF, 64 * kb, n0, ws + B_W13 + (size_t)e * 512 * D, D, 256 * (n0 >> 7) + which * 128 + (n0 & 127), scr, lane); }
        else { const int kb = item >> 4, nb = item & 15;
            transpose_item64_f8(w2 + (size_t)e * EFF * D, D, 64 * kb, 64 * nb, ws + B_W2 + (size_t)e * D * EFF, EFF, 64 * nb, scr, lane); }
    }
}
__device__ __forceinline__ void phase_norm_mod(const float* X, const float* gain, const float* mod, int sh_off, int sc_off, bf16_t* out, unsigned char* out8, int gw, int NGW, int lane) {
    constexpr int R = 4;
    for (int m0 = gw; m0 < T; m0 += R * NGW) {
        f32x4 v[R][4];
#pragma unroll
        for (int rr = 0; rr < R; ++rr) { const int m = m0 + rr * NGW; const f32x4* xr = (const f32x4*)(X + (size_t)(m < T ? m : m0) * D) + lane;
#pragma unroll
            for (int j = 0; j < 4; ++j) v[rr][j] = xr[64 * j]; }
#pragma unroll
        for (int rr = 0; rr < R; ++rr) { const int m = m0 + rr * NGW; if (m >= T) break;
            float ss = 0.f;
#pragma unroll
            for (int j = 0; j < 4; ++j) ss += (v[rr][j].x * v[rr][j].x + v[rr][j].y * v[rr][j].y) + (v[rr][j].z * v[rr][j].z + v[rr][j].w * v[rr][j].w);
            const float rstd = __builtin_amdgcn_rsqf(wave_sum(ss) * (1.f / D) + 1e-6f);
            const float* mb = mod + (size_t)(m >> 13) * 6144;
            u32x2* o8 = (u32x2*)(out + (size_t)m * D) + lane;
#pragma unroll
            for (int j = 0; j < 4; ++j) { const int col = 4 * lane + 256 * j;
                const f32x4 g = *(const f32x4*)(gain + col), sc = *(const f32x4*)(mb + sc_off + col), sh = *(const f32x4*)(mb + sh_off + col);
                const f32x4 y = v[rr][j] * rstd * g * (sc + 1.0f) + sh;
                if (out) { u32x2 w; w.x = pk2(y.x, y.y); w.y = pk2(y.z, y.w); o8[64 * j] = w; }
                if (out8) { int t8 = __builtin_amdgcn_cvt_pk_fp8_f32(y.x, y.y, 0, false); t8 = __builtin_amdgcn_cvt_pk_fp8_f32(y.z, y.w, t8, true); *(unsigned*)(out8 + (size_t)m * D + col) = (unsigned)t8; } } }
    }
}
struct YaArgs { bf16_t* ya; const bf16_t* g; const bf16_t* prw; const float* sbon; const float* mu; const float* ln_g; const float* ln_b; };
__device__ __forceinline__ void phase_ya_final(const YaArgs& P, int gw, int NGW, int lane) {
    const int ch0 = lane * 8, head = lane >> 3;
    float muv[8], lg[8], lb[8];
#pragma unroll
    for (int j = 0; j < 8; ++j) { muv[j] = P.mu[1024 + ch0 + j]; lg[j] = P.ln_g[ch0 + j]; lb[j] = P.ln_b[ch0 + j]; }
    for (int m = gw; m < T; m += NGW) {
        const u32x4 yw = *(const u32x4*)(P.ya + (size_t)m * RW + ch0);
        const u32x4 gw4 = *(const u32x4*)(P.g + (size_t)m * RW + ch0);
        const u32x4 vc = *(const u32x4*)(P.prw + (size_t)m * RWKV_COLS + 1024 + ch0);
        u32x4 vp = (u32x4){0u, 0u, 0u, 0u};
        if ((m & (SEQ - 1)) != 0) vp = *(const u32x4*)(P.prw + (size_t)(m - 1) * RWKV_COLS + 1024 + ch0);
        const float sb = P.sbon[(size_t)m * NH + head];
        float y[8], gg[8], vv[8], pv[8];
        y[0] = bflo(yw.x); y[1] = bfhi(yw.x); y[2] = bflo(yw.y); y[3] = bfhi(yw.y); y[4] = bflo(yw.z); y[5] = bfhi(yw.z); y[6] = bflo(yw.w); y[7] = bfhi(yw.w);
        gg[0] = bflo(gw4.x); gg[1] = bfhi(gw4.x); gg[2] = bflo(gw4.y); gg[3] = bfhi(gw4.y); gg[4] = bflo(gw4.z); gg[5] = bfhi(gw4.z); gg[6] = bflo(gw4.w); gg[7] = bfhi(gw4.w);
        vv[0] = bflo(vc.x); vv[1] = bfhi(vc.x); vv[2] = bflo(vc.y); vv[3] = bfhi(vc.y); vv[4] = bflo(vc.z); vv[5] = bfhi(vc.z); vv[6] = bflo(vc.w); vv[7] = bfhi(vc.w);
        pv[0] = bflo(vp.x); pv[1] = bfhi(vp.x); pv[2] = bflo(vp.y); pv[3] = bfhi(vp.y); pv[4] = bflo(vp.z); pv[5] = bfhi(vp.z); pv[6] = bflo(vp.w); pv[7] = bfhi(vp.w);
        float s = 0.f;
#pragma unroll
        for (int j = 0; j < 8; ++j) s += y[j];
        s += __shfl_xor(s, 1); s += __shfl_xor(s, 2); s += __shfl_xor(s, 4);
        const float mean = s * (1.f / 64.f); float q = 0.f;
#pragma unroll
        for (int j = 0; j < 8; ++j) { y[j] -= mean; q += y[j] * y[j]; }
        q += __shfl_xor(q, 1); q += __shfl_xor(q, 2); q += __shfl_xor(q, 4);
        const float rstd = __builtin_amdgcn_rsqf(q * (1.f / 64.f) + 64e-5f);
        float o[8];
#pragma unroll
        for (int j = 0; j < 8; ++j) { const float vs = vv[j] + (pv[j] - vv[j]) * muv[j]; o[j] = (y[j] * rstd * lg[j] + lb[j] + sb * vs) * gg[j]; }
        u32x4 w; w.x = pk2(o[0], o[1]); w.y = pk2(o[2], o[3]); w.z = pk2(o[4], o[5]); w.w = pk2(o[6], o[7]);
        *(u32x4*)(P.ya + (size_t)m * RW + ch0) = w;
    }
}
__device__ __forceinline__ void phase_xs(const bf16_t* prw, const float* mu, bf16_t* xs, int gw, int NGW, int lane) {
    const f32x4 m4 = *(const f32x4*)(mu + 1536 + 4 * lane);
    for (int t = gw; t < T; t += NGW) {
        const bf16_t* src = prw + (size_t)t * RWKV_COLS + 1536 + 4 * lane;
        const u32x2 cw = *(const u32x2*)src; u32x2 pw = (u32x2){0u, 0u};
        if ((t & (SEQ - 1)) != 0) pw = *(const u32x2*)(src - RWKV_COLS);
        f32x4 v = (f32x4){bflo(cw.x), bfhi(cw.x), bflo(cw.y), bfhi(cw.y)}; const f32x4 p = (f32x4){bflo(pw.x), bfhi(pw.x), bflo(pw.y), bfhi(pw.y)};
        v = v + (p - v) * m4;
        if (lane < 16) {
#pragma unroll
            for (int j = 0; j < 4; ++j) v[j] = tanhf_(v[j]); }
        else if (lane >= 32) {
#pragma unroll
            for (int j = 0; j < 4; ++j) v[j] = sigmoidf_(v[j]); }
        u32x2 w; w.x = pk2(v[0], v[1]); w.y = pk2(v[2], v[3]);
        *(u32x2*)(xs + (size_t)t * 256 + 4 * lane) = w;
    }
}
__device__ __forceinline__ void phase_combine(float* out, const unsigned char* slot, const unsigned char* sho, const float* mod, const float* normf, int gw, int NGW, int lane) {
    for (int m = gw; m < T; m += NGW) {
        const int b = m >> 13;
        f32x4* xr = (f32x4*)(out + (size_t)m * D + 16 * lane);
        const float* g2 = mod + (size_t)b * 6144 + 5120 + 16 * lane;
        u32x4 sw[TOPK + 1];
#pragma unroll
        for (int k = 0; k < TOPK; ++k) sw[k] = *(const u32x4*)(slot + ((size_t)m * TOPK + k) * D + 16 * lane);
        sw[TOPK] = *(const u32x4*)(sho + (size_t)m * D + 16 * lane);
        f32x4 x[4];
#pragma unroll
        for (int j = 0; j < 4; ++j) x[j] = xr[j];
        f32x4 a[4];
#pragma unroll
        for (int j = 0; j < 4; ++j) a[j] = (f32x4){0.f, 0.f, 0.f, 0.f};
#pragma unroll
        for (int k = 0; k <= TOPK; ++k) { a[0] += up8(sw[k].x); a[1] += up8(sw[k].y); a[2] += up8(sw[k].z); a[3] += up8(sw[k].w); }
        float ss = 0.f;
#pragma unroll
        for (int j = 0; j < 4; ++j) { x[j] = x[j] + *(const f32x4*)(g2 + 4 * j) * a[j]; ss += (x[j].x * x[j].x + x[j].y * x[j].y) + (x[j].z * x[j].z + x[j].w * x[j].w); }
        const float rstd = __builtin_amdgcn_rsqf(wave_sum(ss) * (1.f / D) + 1e-6f);
#pragma unroll
        for (int j = 0; j < 4; ++j) xr[j] = x[j] * rstd * *(const f32x4*)(normf + 16 * lane + 4 * j);
    }
}
namespace rk {
constexpr int LD = 72;
constexpr int SLOTB = 64 * LD * 2;
constexpr int LDG = 136;
typedef LAS bf16_t* lp;
__device__ __forceinline__ lp slot(LAS unsigned char* lds, int i) { return (lp)(lds + i * SLOTB); }
template <int KS>
__device__ __forceinline__ void mm_nt(const LAS bf16_t* X, int ldx, const LAS bf16_t* Y, int ldy, int m, int nt0, int r, int q, f32x4 (&acc)[2]) {
#pragma unroll
    for (int s = 0; s < KS; ++s) {
        const bf16x8 a = *(const LAS bf16x8*)(X + (16 * m + r) * ldx + 32 * s + 8 * q);
#pragma unroll
        for (int n = 0; n < 2; ++n) { const bf16x8 b = *(const LAS bf16x8*)(Y + (16 * (nt0 + n) + r) * ldy + 32 * s + 8 * q); acc[n] = __builtin_amdgcn_mfma_f32_16x16x32_bf16(a, b, acc[n], 0, 0, 0); }
    }
}
__device__ __forceinline__ void st_rm(lp dst, int m, int nt, int r, int q, const f32x4& a) {
#pragma unroll
    for (int ii = 0; ii < 4; ++ii) dst[(16 * m + 4 * q + ii) * LD + 16 * nt + r] = f2bf(a[ii]);
}
__device__ __forceinline__ void st_tr(lp dst, int m, int nt, int r, int q, const f32x4& a) {
    u32x2 w; w.x = pk2(a[0], a[1]); w.y = pk2(a[2], a[3]); *(LAS u32x2*)(dst + (16 * nt + r) * LD + 16 * m + 4 * q) = w;
}
__device__ __forceinline__ void ld_rm(const LAS bf16_t* src, int m, int nt, int r, int q, f32x4& a) {
#pragma unroll
    for (int ii = 0; ii < 4; ++ii) a[ii] = bf2f(src[(16 * m + 4 * q + ii) * LD + 16 * nt + r]);
}
struct Args {
    const bf16_t* prw; const float* mu; const float *w0, *a0, *k_k, *k_a, *r_k;
    const bf16_t *wup, *aup, *gup;
    const bf16_t* xs;
    bf16_t* g; bf16_t* bv; unsigned char* mn; unsigned char* qy;
};
constexpr int LDS_MU = 155904;
struct Pre { u32x4 cw[3], pw[3]; bf16x8 xs[8]; };
__device__ __forceinline__ void task_map(int task, int h, int& i, int& ch, int& col) {
    i = task / 24; ch = task % 24;
    col = (ch >> 3) * 512 + h * 64 + 8 * (ch & 7);
}
__device__ __forceinline__ void load_mu(const Args& P, LAS unsigned char* lds, int tid) {
    LAS float* MU = (LAS float*)(lds + LDS_MU);
    for (int i = tid; i < RWKV_COLS; i += NTHREADS) MU[i] = P.mu[i];
    __syncthreads();
}
__device__ __forceinline__ void prefetch(const Args& P, int b, int h, int c, int tid, Pre& pre) {
    const int t0 = b * SEQ + c * 64;
#pragma unroll
    for (int it = 0; it < 3; ++it) {
        int i, ch, col; task_map(tid + it * NTHREADS, h, i, ch, col);
        const bf16_t* src = P.prw + (size_t)(t0 + i) * RWKV_COLS + col;
        pre.cw[it] = *(const u32x4*)src;
        pre.pw[it] = (u32x4){0u, 0u, 0u, 0u};
        if (i != 0 || c != 0) pre.pw[it] = *(const u32x4*)(src - RWKV_COLS);
    }
    const int lane = tid & 63, r = lane & 15, q = lane >> 4, m = (tid >> 6) & 3;
    const bf16_t* xr = P.xs + (size_t)(t0 + 16 * m + r) * 256 + 8 * q;
#pragma unroll
    for (int f = 0; f < 8; ++f) pre.xs[f] = *(const bf16x8*)(xr + 32 * f);
}
__device__ __forceinline__ void unit(const Args& P, LAS unsigned char* lds, int b, int h, int c, int uidx, int tid, Pre& pf, bool has_next, int nb, int nh_, int nc) {
    const int wave = __builtin_amdgcn_readfirstlane(tid >> 6), lane = tid & 63, r = lane & 15, q = lane >> 4, m = wave & 3, nh = wave >> 2;
    const int t0 = b * SEQ + c * 64;
    lp S0 = slot(lds, 0), S1 = slot(lds, 1), S2 = slot(lds, 2), S3 = slot(lds, 3), S4 = slot(lds, 4), S5 = slot(lds, 5), S6 = slot(lds, 6), S7 = slot(lds, 7);
    lp S8 = slot(lds, 8), S9 = slot(lds, 9), S10 = slot(lds, 10), S11 = slot(lds, 11), S12 = slot(lds, 12), S13 = slot(lds, 13), S14 = slot(lds, 14), S15 = slot(lds, 15);
    LAS float* PART = (LAS float*)(lds + LDS_MISC);
    LAS float* CT = PART + 256;
    LAS float* DEND = CT + 256;
    const LAS float* MU = (const LAS float*)(lds + LDS_MU);
#define RK_BAR() do { asm volatile("s_waitcnt lgkmcnt(0)" ::: "memory"); __builtin_amdgcn_s_barrier(); asm volatile("" ::: "memory"); } while (0)
#define RK_DBG(bit, sp) do {} while (0)
#pragma unroll
    for (int it = 0; it < 3; ++it) {
        int i, ch, col; task_map(tid + it * NTHREADS, h, i, ch, col);
        LAS bf16_t* dst = slot(lds, 8 + (ch >> 3)) + i * LD + 8 * (ch & 7);
        const u32x4 cw = pf.cw[it], pw = pf.pw[it];
        const f32x4 m0 = *(const LAS f32x4*)(MU + col), m1 = *(const LAS f32x4*)(MU + col + 4);
        float v[8], p[8];
        v[0] = bflo(cw.x); v[1] = bfhi(cw.x); v[2] = bflo(cw.y); v[3] = bfhi(cw.y); v[4] = bflo(cw.z); v[5] = bfhi(cw.z); v[6] = bflo(cw.w); v[7] = bfhi(cw.w);
        p[0] = bflo(pw.x); p[1] = bfhi(pw.x); p[2] = bflo(pw.y); p[3] = bfhi(pw.y); p[4] = bflo(pw.z); p[5] = bfhi(pw.z); p[6] = bflo(pw.w); p[7] = bfhi(pw.w);
#pragma unroll
        for (int j = 0; j < 4; ++j) { v[j] += (p[j] - v[j]) * m0[j]; v[4 + j] += (p[4 + j] - v[4 + j]) * m1[j]; }
        u32x4 w; w.x = pk2(v[0], v[1]); w.y = pk2(v[2], v[3]); w.z = pk2(v[4], v[5]); w.w = pk2(v[6], v[7]);
        *(LAS u32x4*)dst = w;
    }
    RK_BAR();
    f32x4 aw[2], aa[2], ag[2];
#pragma unroll
    for (int n = 0; n < 2; ++n) { aw[n] = (f32x4){0.f, 0.f, 0.f, 0.f}; aa[n] = aw[n]; ag[n] = aw[n]; }
#pragma unroll
    for (int s = 0; s < 2; ++s) {
#pragma unroll
        for (int n = 0; n < 2; ++n) { const int row = h * 64 + 16 * (2 * nh + n) + r;
            const bf16x8 bw = *(const bf16x8*)(P.wup + (size_t)row * 64 + 32 * s + 8 * q), ba = *(const bf16x8*)(P.aup + (size_t)row * 64 + 32 * s + 8 * q);
            aw[n] = __builtin_amdgcn_mfma_f32_16x16x32_bf16(pf.xs[s], bw, aw[n], 0, 0, 0); aa[n] = __builtin_amdgcn_mfma_f32_16x16x32_bf16(pf.xs[2 + s], ba, aa[n], 0, 0, 0); }
    }
#pragma unroll
    for (int s = 0; s < 4; ++s) {
#pragma unroll
        for (int n = 0; n < 2; ++n) { const int row = h * 64 + 16 * (2 * nh + n) + r;
            const bf16x8 bg = *(const bf16x8*)(P.gup + (size_t)row * 128 + 32 * s + 8 * q);
            ag[n] = __builtin_amdgcn_mfma_f32_16x16x32_bf16(pf.xs[4 + s], bg, ag[n], 0, 0, 0); }
    }
    if (has_next) prefetch(P, nb, nh_, nc, tid, pf);
    float rr[2][4], kq[2][4], vv[2][4], av[2][4], lw[2][4], kp[2][4], pre[2][4], preq[2];
    float ss[4] = {0.f, 0.f, 0.f, 0.f}, bs[4] = {0.f, 0.f, 0.f, 0.f};
#pragma unroll
    for (int n = 0; n < 2; ++n) {
        const int ch = 32 * nh + 16 * n + r, chg = h * 64 + ch;
        const float w0v = P.w0[chg], a0v = P.a0[chg], kkc = P.k_k[chg], kac = P.k_a[chg], rkc = P.r_k[chg];
#pragma unroll
        for (int ii = 0; ii < 4; ++ii) {
            const int pos = 16 * m + 4 * q + ii;
            const float rv = bf2f(S8[pos * LD + ch]), kraw = bf2f(S9[pos * LD + ch]); vv[n][ii] = bf2f(S10[pos * LD + ch]); rr[n][ii] = rv;
            const float z = -(w0v + aw[n][ii]);
            const float sp = fmaxf(z, 0.f) + flog(1.0f + fexp(-fabsf(z)));
            lw[n][ii] = -fexp(-sp - 0.5f);
            const float a_ = sigmoidf_(a0v + aa[n][ii]); av[n][ii] = a_;
            P.g[(size_t)(t0 + pos) * RW + chg] = f2bf(ag[n][ii]);
            const float kk = kraw * kkc; kq[n][ii] = kk;
            const float kpv = kraw * (1.0f + (a_ - 1.0f) * kac); kp[n][ii] = kpv;
            ss[ii] += kk * kk; bs[ii] += rv * kpv * rkc;
        }
        pre[n][0] = lw[n][0]; pre[n][1] = pre[n][0] + lw[n][1]; pre[n][2] = pre[n][1] + lw[n][2]; pre[n][3] = pre[n][2] + lw[n][3];
        const float tot = pre[n][3];
        const float t0_ = __shfl(tot, r), t1_ = __shfl(tot, r + 16), t2_ = __shfl(tot, r + 32), t3_ = __shfl(tot, r + 48);
        preq[n] = (q > 0 ? t0_ : 0.f) + (q > 1 ? t1_ : 0.f) + (q > 2 ? t2_ : 0.f);
        if (q == 0) CT[m * 64 + ch] = (t0_ + t1_) + (t2_ + t3_);
    }
#pragma unroll
    for (int ii = 0; ii < 4; ++ii) {
#pragma unroll
        for (int o = 1; o < 16; o <<= 1) { ss[ii] += __shfl_xor(ss[ii], o); bs[ii] += __shfl_xor(bs[ii], o); }
        if (r == 0) { const int pos = 16 * m + 4 * q + ii; PART[(nh * 64 + pos) * 2] = ss[ii]; PART[(nh * 64 + pos) * 2 + 1] = bs[ii]; }
    }
    RK_BAR();
#pragma unroll
    for (int n = 0; n < 2; ++n) {
        const int ch = 32 * nh + 16 * n + r;
        float carry = 0.f, lend = 0.f;
#pragma unroll
        for (int mm = 0; mm < 4; ++mm) { const float cv = CT[mm * 64 + ch]; lend += cv; carry += (mm < m) ? cv : 0.f; }
        f32x4 tA, tBh, tKh, tV;
#pragma unroll
        for (int ii = 0; ii < 4; ++ii) {
            const int pos = 16 * m + 4 * q + ii;
            const float L = carry + preq[n] + pre[n][ii], Lm1 = L - lw[n][ii];
            const float ssum = PART[pos * 2] + PART[(64 + pos) * 2];
            const float inv = frcp(fmaxf(__builtin_sqrtf(ssum), 1e-12f));
            const float kkn = kq[n][ii] * inv, kb = kkn * av[n][ii];
            const float eN = fexp(-L), eE = fexp(lend - L);
            const float At = -kkn * fexp(Lm1), Rt = rr[n][ii] * fexp(L), Bt = kb * eN, Kt = kp[n][ii] * eN;
            S0[pos * LD + ch] = f2bf(At); S1[pos * LD + ch] = f2bf(Bt); S2[pos * LD + ch] = f2bf(Kt); S3[pos * LD + ch] = f2bf(Rt);
            tA[ii] = At; tBh[ii] = kb * eE; tKh[ii] = kp[n][ii] * eE; tV[ii] = vv[n][ii];
            P.bv[(size_t)(t0 + pos) * RW + h * 64 + ch] = f2bf((PART[pos * 2 + 1] + PART[(64 + pos) * 2 + 1]) * vv[n][ii]);
        }
        { u32x2 w; const int off = ch * LD + 16 * m + 4 * q;
          w.x = pk2(tA[0], tA[1]); w.y = pk2(tA[2], tA[3]); *(LAS u32x2*)(S4 + off) = w;
          w.x = pk2(tBh[0], tBh[1]); w.y = pk2(tBh[2], tBh[3]); *(LAS u32x2*)(S5 + off) = w;
          w.x = pk2(tKh[0], tKh[1]); w.y = pk2(tKh[2], tKh[3]); *(LAS u32x2*)(S6 + off) = w;
          w.x = pk2(tV[0], tV[1]); w.y = pk2(tV[2], tV[3]); *(LAS u32x2*)(S7 + off) = w; }
        if (m == 0 && q == 0) DEND[ch] = fexp(lend);
    }
    RK_BAR();
    RK_DBG(0, S0); RK_DBG(1, S1); RK_DBG(2, S2); RK_DBG(3, S3); RK_DBG(4, S4); RK_DBG(5, S5); RK_DBG(6, S6); RK_DBG(7, S7);
    const int nt0 = 2 * nh;
    f32x4 acc[2], acc2[2];
#define RK_ZERO(a) do { a[0] = (f32x4){0.f, 0.f, 0.f, 0.f}; a[1] = a[0]; } while (0)
#define RK_LDT(src, mt, ntt, a) do { const u32x2 w_ = *(const LAS u32x2*)((src) + (16 * (ntt) + r) * LD + 16 * (mt) + 4 * q); a = (f32x4){bflo(w_.x), bfhi(w_.x), bflo(w_.y), bfhi(w_.y)}; } while (0)
#define RK_MASK(a, ntt, COND) do { _Pragma("unroll") for (int ii = 0; ii < 4; ++ii) { const int row = 16 * m + 4 * q + ii, col = 16 * (ntt) + r; a[ii] = (COND) ? a[ii] : 0.f; } } while (0)
    RK_ZERO(acc); mm_nt<2>(S0, LD, S1, LD, m, nt0, r, q, acc);
#pragma unroll
    for (int n = 0; n < 2; ++n) { RK_MASK(acc[n], nt0 + n, col < row); st_tr(S9, m, nt0 + n, r, q, acc[n]); }
    RK_ZERO(acc); mm_nt<2>(S1, LD, S0, LD, m, nt0, r, q, acc);
#pragma unroll
    for (int n = 0; n < 2; ++n) { RK_MASK(acc[n], nt0 + n, row < col); st_tr(S8, m, nt0 + n, r, q, acc[n]);
#pragma unroll
        for (int ii = 0; ii < 4; ++ii) acc[n][ii] += ((16 * m + 4 * q + ii) == (16 * (nt0 + n) + r)) ? 1.f : 0.f;
        st_tr(S10, m, nt0 + n, r, q, acc[n]); }
    RK_ZERO(acc); mm_nt<2>(S2, LD, S0, LD, m, nt0, r, q, acc);
#pragma unroll
    for (int n = 0; n < 2; ++n) { RK_MASK(acc[n], nt0 + n, row < col); st_tr(S11, m, nt0 + n, r, q, acc[n]); }
    RK_ZERO(acc); mm_nt<2>(S1, LD, S3, LD, m, nt0, r, q, acc);
#pragma unroll
    for (int n = 0; n < 2; ++n) { RK_MASK(acc[n], nt0 + n, row <= col); st_tr(S12, m, nt0 + n, r, q, acc[n]); }
    RK_ZERO(acc); mm_nt<2>(S2, LD, S3, LD, m, nt0, r, q, acc);
#pragma unroll
    for (int n = 0; n < 2; ++n) { RK_MASK(acc[n], nt0 + n, row <= col); st_tr(S13, m, nt0 + n, r, q, acc[n]); }
    RK_BAR();
    RK_ZERO(acc); mm_nt<2>(S8, LD, S9, LD, m, nt0, r, q, acc);
    RK_ZERO(acc2); mm_nt<2>(S9, LD, S8, LD, m, nt0, r, q, acc2);
#pragma unroll
    for (int n = 0; n < 2; ++n) { st_tr(S1, m, nt0 + n, r, q, acc[n]); st_tr(S0, m, nt0 + n, r, q, acc2[n]); }
    RK_ZERO(acc); mm_nt<2>(S11, LD, S7, LD, m, nt0, r, q, acc);
#pragma unroll
    for (int n = 0; n < 2; ++n) st_tr(S14, m, nt0 + n, r, q, acc[n]);
    RK_BAR();
#define RK_ROUND(Tsrc, Tdst, Psrc, PTsrc, Pdst, PTdst) do { \
        RK_LDT(Tsrc, m, nt0, acc[0]); RK_LDT(Tsrc, m, nt0 + 1, acc[1]); mm_nt<2>(PTsrc, LD, Tsrc, LD, m, nt0, r, q, acc); \
        _Pragma("unroll") for (int n = 0; n < 2; ++n) st_tr(Tdst, m, nt0 + n, r, q, acc[n]); \
        RK_ZERO(acc); mm_nt<2>(Psrc, LD, PTsrc, LD, m, nt0, r, q, acc); RK_ZERO(acc2); mm_nt<2>(PTsrc, LD, Psrc, LD, m, nt0, r, q, acc2); \
        _Pragma("unroll") for (int n = 0; n < 2; ++n) { st_tr(PTdst, m, nt0 + n, r, q, acc[n]); st_tr(Pdst, m, nt0 + n, r, q, acc2[n]); } \
        RK_BAR(); } while (0)
#ifndef EXP_SKIP_ROUNDS
    RK_ROUND(S10, S2, S0, S1, S8, S9);
    RK_ROUND(S2, S10, S8, S9, S0, S1);
    RK_ROUND(S10, S2, S0, S1, S8, S9);
    RK_ROUND(S2, S10, S8, S9, S0, S1);
#endif
    RK_LDT(S10, m, nt0, acc[0]); RK_LDT(S10, m, nt0 + 1, acc[1]); mm_nt<2>(S1, LD, S10, LD, m, nt0, r, q, acc);
#pragma unroll
    for (int n = 0; n < 2; ++n) st_tr(S2, m, nt0 + n, r, q, acc[n]);
    RK_BAR();
    RK_ZERO(acc); mm_nt<2>(S2, LD, S4, LD, m, nt0, r, q, acc);
    RK_ZERO(acc2); mm_nt<2>(S2, LD, S14, LD, m, nt0, r, q, acc2);
#pragma unroll
    for (int n = 0; n < 2; ++n) { st_tr(S11, m, nt0 + n, r, q, acc[n]); st_tr(S15, m, nt0 + n, r, q, acc2[n]); }
    RK_BAR();
    {
        const int sw = wave & 1, ntw = wave >> 1;
        unsigned char* mn_ = P.mn + (size_t)uidx * 16384; unsigned char* qy_ = P.qy + (size_t)uidx * 16384;
        f32x4 c2[2];
#define RK_MM2(X, Y) do { _Pragma("unroll") for (int s_ = 0; s_ < 2; ++s_) { const bf16x8 b_ = *(const LAS bf16x8*)((Y) + (16 * ntw + r) * LD + 32 * s_ + 8 * q); \
            _Pragma("unroll") for (int mi = 0; mi < 2; ++mi) { const bf16x8 a_ = *(const LAS bf16x8*)((X) + (16 * (2 * sw + mi) + r) * LD + 32 * s_ + 8 * q); c2[mi] = __builtin_amdgcn_mfma_f32_16x16x32_bf16(a_, b_, c2[mi], 0, 0, 0); } } } while (0)
        RK_ZERO(c2); RK_MM2(S11, S5);
#pragma unroll
        for (int mi = 0; mi < 2; ++mi)
#pragma unroll
            for (int ii = 0; ii < 4; ++ii) { const int row = 16 * (2 * sw + mi) + 4 * q + ii, col = 16 * ntw + r; c2[mi][ii] += (row == col) ? DEND[row] : 0.f; }
        { u32x4 w; w.x = pk2(c2[0][0], c2[0][1]); w.y = pk2(c2[0][2], c2[0][3]); w.z = pk2(c2[1][0], c2[1][1]); w.w = pk2(c2[1][2], c2[1][3]); *(u32x4*)(mn_ + ((ntw * 2 + sw) * 64 + lane) * 16) = w; }
#pragma unroll
        for (int mi = 0; mi < 2; ++mi) { const u32x2 rw_ = *(const LAS u32x2*)(S3 + (16 * ntw + r) * LD + 16 * (2 * sw + mi) + 4 * q); c2[mi] = (f32x4){bflo(rw_.x), bfhi(rw_.x), bflo(rw_.y), bfhi(rw_.y)}; }
        RK_MM2(S11, S12);
        { u32x4 w; w.x = pk2(c2[0][0], c2[0][1]); w.y = pk2(c2[0][2], c2[0][3]); w.z = pk2(c2[1][0], c2[1][1]); w.w = pk2(c2[1][2], c2[1][3]); *(u32x4*)(qy_ + ((ntw * 2 + sw) * 64 + lane) * 16) = w; }
        RK_ZERO(c2); RK_MM2(S5, S15); RK_MM2(S6, S7);
#pragma unroll
        for (int mi = 0; mi < 2; ++mi) { u32x2 w; w.x = pk2(c2[mi][0], c2[mi][1]); w.y = pk2(c2[mi][2], c2[mi][3]); *(u32x2*)(mn_ + 8192 + ((ntw * 4 + 2 * sw + mi) * 64 + lane) * 8) = w; }
        RK_ZERO(c2); RK_MM2(S15, S12); RK_MM2(S7, S13);
#pragma unroll
        for (int mi = 0; mi < 2; ++mi) { u32x2 w; w.x = pk2(c2[mi][0], c2[mi][1]); w.y = pk2(c2[mi][2], c2[mi][3]); *(u32x2*)(qy_ + 8192 + (((2 * sw + mi) * 4 + ntw) * 64 + lane) * 8) = w; }
#undef RK_MM2
    }
    RK_BAR();
#undef RK_ZERO
#undef RK_ROUND
#undef RK_LDT
#undef RK_MASK
#undef RK_BAR
}
__device__ __forceinline__ void scan_wg(const unsigned char* mn, unsigned char* sbuf, int ubase, int vq, LAS unsigned char* lds, int tid) {
    const int wave = __builtin_amdgcn_readfirstlane(tid >> 6), lane = tid & 63;
    constexpr int NC = SEQ / 64, NS = 8, SLOT = 10240, AHEAD = 6;
    const unsigned char* src = mn + (size_t)ubase * 16384 + lane * 16;
    const bool loader = (wave >= 1 && wave <= 5);
    const size_t poff = (wave == 5) ? (size_t)(8192 + vq * 2048) : (size_t)(2048 * (wave - 1));
#define SC_ISSUE(c) do { const unsigned char* s_ = src + (size_t)(c) * 16384 + poff; LAS unsigned char* d_ = lds + ((c) % NS) * SLOT + 2048 * (wave - 1); \
        _Pragma("unroll") for (int i_ = 0; i_ < 2; ++i_) __builtin_amdgcn_global_load_lds((const unsigned*)(s_ + i_ * 1024), (LAS unsigned*)(d_ + i_ * 1024), 16, 0, 0); } while (0)
#define SC_BAR() do { asm volatile("s_waitcnt lgkmcnt(0)" ::: "memory"); __builtin_amdgcn_s_barrier(); asm volatile("" ::: "memory"); } while (0)
    bf16x8 sB[2];
#pragma unroll
    for (int s = 0; s < 2; ++s) sB[s] = (bf16x8){0, 0, 0, 0, 0, 0, 0, 0};
    if (loader) {
#pragma unroll
        for (int c = 0; c < AHEAD; ++c) SC_ISSUE(c);
        asm volatile("s_waitcnt vmcnt(10)" ::: "memory"); }
    SC_BAR();
    for (int c = 0; c < NC; ++c) {
        if (loader) {
            if (c + AHEAD < NC) { SC_ISSUE(c + AHEAD); asm volatile("s_waitcnt vmcnt(10)" ::: "memory"); }
            else { asm volatile("s_waitcnt vmcnt(0)" ::: "memory"); }
        } else if (wave == 0) {
            const LAS unsigned char* sl = lds + (c % NS) * SLOT;
            unsigned char* so = sbuf + (size_t)(ubase + c) * 8192 + (vq * 2) * 1024 + lane * 16;
            *(bf16x8*)so = sB[0]; *(bf16x8*)(so + 1024) = sB[1];
            f32x4 aS[4];
#pragma unroll
            for (int mm = 0; mm < 4; ++mm) {
                const u32x2 nI = *(const LAS u32x2*)(sl + 8192 + (mm * 64 + lane) * 8);
                aS[mm] = (f32x4){bflo(nI.x), bfhi(nI.x), bflo(nI.y), bfhi(nI.y)};
#pragma unroll
                for (int s = 0; s < 2; ++s) { const bf16x8 aM = *(const LAS bf16x8*)(sl + ((mm * 2 + s) * 64 + lane) * 16); aS[mm] = __builtin_amdgcn_mfma_f32_16x16x32_bf16(aM, sB[s], aS[mm], 0, 0, 0); }
            }
#pragma unroll
            for (int s = 0; s < 2; ++s) { u32x4 w; w.x = pk2(aS[2 * s][0], aS[2 * s][1]); w.y = pk2(aS[2 * s][2], aS[2 * s][3]); w.z = pk2(aS[2 * s + 1][0], aS[2 * s + 1][1]); w.w = pk2(aS[2 * s + 1][2], aS[2 * s + 1][3]);
                sB[s] = __builtin_bit_cast(bf16x8, w); }
        }
        SC_BAR();
    }
#undef SC_ISSUE
#undef SC_BAR
}
struct YArgs { const unsigned char* qy; const unsigned char* sbuf; const bf16_t* g; const bf16_t* bv; const float* ln_g; const float* ln_b; bf16_t* ya; };
__device__ __forceinline__ void ypass_unit(const YArgs& P, int u, int lane) {
    const int r = lane & 15, q = lane >> 4, b = u >> 10, h = (u >> 7) & 7, c = u & 127, t0 = b * SEQ + c * 64;
    const unsigned char* qy_ = P.qy + (size_t)u * 16384; const unsigned char* s_ = P.sbuf + (size_t)u * 8192;
    bf16x8 Qf[4][2], Sf[4][2]; u32x2 y0[4][4];
#pragma unroll
    for (int i = 0; i < 4; ++i)
#pragma unroll
        for (int s = 0; s < 2; ++s) { Qf[i][s] = *(const bf16x8*)(qy_ + ((i * 2 + s) * 64 + lane) * 16); Sf[i][s] = *(const bf16x8*)(s_ + ((i * 2 + s) * 64 + lane) * 16); }
#pragma unroll
    for (int vq = 0; vq < 4; ++vq)
#pragma unroll
        for (int mm = 0; mm < 4; ++mm) y0[vq][mm] = *(const u32x2*)(qy_ + 8192 + ((vq * 4 + mm) * 64 + lane) * 8);
    f32x4 lg[4], lb[4];
#pragma unroll
    for (int vq = 0; vq < 4; ++vq) { lg[vq] = *(const f32x4*)(P.ln_g + h * 64 + 16 * vq + 4 * q); lb[vq] = *(const f32x4*)(P.ln_b + h * 64 + 16 * vq + 4 * q); }
#pragma unroll
    for (int mm = 0; mm < 4; ++mm) {
        const size_t ro = (size_t)(t0 + 16 * mm + r) * RW + h * 64 + 4 * q;
        u32x2 gw_[4], bw_[4];
#pragma unroll
        for (int vq = 0; vq < 4; ++vq) { gw_[vq] = *(const u32x2*)(P.g + ro + 16 * vq); bw_[vq] = *(const u32x2*)(P.bv + ro + 16 * vq); }
        f32x4 acc[4]; float sum = 0.f;
#pragma unroll
        for (int vq = 0; vq < 4; ++vq) {
            acc[vq] = (f32x4){bflo(y0[vq][mm].x), bfhi(y0[vq][mm].x), bflo(y0[vq][mm].y), bfhi(y0[vq][mm].y)};
#pragma unroll
            for (int s = 0; s < 2; ++s) acc[vq] = __builtin_amdgcn_mfma_f32_16x16x32_bf16(Sf[vq][s], Qf[mm][s], acc[vq], 0, 0, 0);
            sum += (acc[vq][0] + acc[vq][1]) + (acc[vq][2] + acc[vq][3]);
        }
        sum += __shfl_xor(sum, 16); sum += __shfl_xor(sum, 32);
        const float mean = sum * (1.f / 64.f); float var = 0.f;
#pragma unroll
        for (int vq = 0; vq < 4; ++vq) { acc[vq] = acc[vq] - mean; var += (acc[vq][0] * acc[vq][0] + acc[vq][1] * acc[vq][1]) + (acc[vq][2] * acc[vq][2] + acc[vq][3] * acc[vq][3]); }
        var += __shfl_xor(var, 16); var += __shfl_xor(var, 32);
        const float rstd = __builtin_amdgcn_rsqf(var * (1.f / 64.f) + 64e-5f);
#pragma unroll
        for (int vq = 0; vq < 4; ++vq) {
            const f32x4 gg = (f32x4){bflo(gw_[vq].x), bfhi(gw_[vq].x), bflo(gw_[vq].y), bfhi(gw_[vq].y)}, bb = (f32x4){bflo(bw_[vq].x), bfhi(bw_[vq].x), bflo(bw_[vq].y), bfhi(bw_[vq].y)};
            const f32x4 o = (acc[vq] * rstd * lg[vq] + lb[vq] + bb) * gg;
            u32x2 w; w.x = pk2(o[0], o[1]); w.y = pk2(o[2], o[3]); *(u32x2*)(P.ya + ro + 16 * vq) = w; }
    }
}
}
namespace gl {
constexpr int LDV = 136;
struct Args { const bf16_t* puv; const bf16_t* wsm; const float* bs; const float* ln_g; const float* ln_b; bf16_t* yb; };
__device__ __forceinline__ void unit(const Args& P, LAS unsigned char* lds, int b, int blk, int tid) {
    const int wave = __builtin_amdgcn_readfirstlane(tid >> 6), lane = tid & 63, r = lane & 15, q = lane >> 4;
    const int t0 = b * SEQ + blk * 128;
    LAS float* STAT = (LAS float*)(lds + LDS_MISC);
    for (int j = 0; j < 16; ++j) {
        const int tk = 16 * wave + j;
        const u32x4 w = *(const u32x4*)(P.puv + (size_t)(t0 + tk) * 1024 + 512 + 8 * lane);
        float v[8]; v[0] = bflo(w.x); v[1] = bfhi(w.x); v[2] = bflo(w.y); v[3] = bfhi(w.y); v[4] = bflo(w.z); v[5] = bfhi(w.z); v[6] = bflo(w.w); v[7] = bfhi(w.w);
        float s = 0.f, s2 = 0.f;
#pragma unroll
        for (int e = 0; e < 8; ++e) { s += v[e]; s2 += v[e] * v[e]; }
        s = wave_sum(s); s2 = wave_sum(s2);
        const float mean = s * (1.f / 512.f), var = fmaxf(s2 * (1.f / 512.f) - mean * mean, 0.f);
        if (lane == 0) { STAT[tk * 2] = mean; STAT[tk * 2 + 1] = __builtin_amdgcn_rsqf(var + 1e-5f); }
    }
    __syncthreads();
    for (int g = 0; g < 8; ++g) {
        LAS bf16_t* VT = (LAS bf16_t*)(lds + (g & 1) * 20480);
#pragma unroll
        for (int it = 0; it < 2; ++it) {
            const int task = tid + it * NTHREADS, j = task >> 3, cc = task & 7, ch = g * 64 + 8 * cc;
            const u32x4 w = *(const u32x4*)(P.puv + (size_t)(t0 + j) * 1024 + 512 + ch);
            const float mean = STAT[j * 2], rstd = STAT[j * 2 + 1];
            const f32x4 g0 = *(const f32x4*)(P.ln_g + ch), g1 = *(const f32x4*)(P.ln_g + ch + 4), b0 = *(const f32x4*)(P.ln_b + ch), b1 = *(const f32x4*)(P.ln_b + ch + 4);
            float v[8]; v[0] = bflo(w.x); v[1] = bfhi(w.x); v[2] = bflo(w.y); v[3] = bfhi(w.y); v[4] = bflo(w.z); v[5] = bfhi(w.z); v[6] = bflo(w.w); v[7] = bfhi(w.w);
#pragma unroll
            for (int e = 0; e < 4; ++e) { v[e] = (v[e] - mean) * rstd * g0[e] + b0[e]; v[4 + e] = (v[4 + e] - mean) * rstd * g1[e] + b1[e]; }
#pragma unroll
            for (int e = 0; e < 8; ++e) VT[(8 * cc + e) * LDV + j] = f2bf(v[e]);
        }
        __syncthreads();
        f32x4 acc[4];
#pragma unroll
        for (int n = 0; n < 4; ++n) acc[n] = (f32x4){0.f, 0.f, 0.f, 0.f};
        const bf16_t* wrow = P.wsm + ((size_t)g * 128 + 16 * wave + r) * 128 + 8 * q;
        const int ks = (wave >> 1) + 1;
        for (int s = 0; s < ks; ++s) {
            const bf16x8 a = *(const bf16x8*)(wrow + 32 * s);
#pragma unroll
            for (int n = 0; n < 4; ++n) { const bf16x8 bb = *(const LAS bf16x8*)(VT + (16 * n + r) * LDV + 32 * s + 8 * q); acc[n] = __builtin_amdgcn_mfma_f32_16x16x32_bf16(a, bb, acc[n], 0, 0, 0); }
        }
#pragma unroll
        for (int ii = 0; ii < 4; ++ii) { const int i = 16 * wave + 4 * q + ii; const float bias = P.bs[g * 128 + i];
#pragma unroll
            for (int n = 0; n < 4; ++n) { const int c = g * 64 + 16 * n + r; const float u = bf2f(P.puv[(size_t)(t0 + i) * 1024 + c]);
                P.yb[(size_t)(t0 + i) * RW + c] = f2bf(u * (acc[n][ii] + bias)); } }
    }
    __syncthreads();
}
}

struct RouteArgs { const float* sc; const float* bias; int* eidx; float* ewt; int* lrank; int* tbase; unsigned* segcnt; };
__device__ __forceinline__ void phase_topk(const RouteArgs& P, LAS unsigned char* lds, int tid, int G) {
    const int wave = __builtin_amdgcn_readfirstlane(tid >> 6), lane = tid & 63, grp = lane >> 3;
    LAS int* hist = (LAS int*)(lds + LDS_MISC);
    const f32x4 bias4 = *(const f32x4*)(P.bias + 4 * lane);
    const float NEG = -__builtin_inff();
    for (int tile = blockIdx.x; tile < T / 256; tile += G) {
        if (tid < NE) hist[tid] = 0;
        __syncthreads();
        for (int j = 0; j < 32; j += 2) {
            const int t0 = tile * 256 + wave * 32 + j;
            float s[2][4], v[2][4], gs[2];
#pragma unroll
            for (int u = 0; u < 2; ++u) { const f32x4 s4 = *(const f32x4*)(P.sc + (size_t)(t0 + u) * NE + 4 * lane); s[u][0] = s4.x; s[u][1] = s4.y; s[u][2] = s4.z; s[u][3] = s4.w;
#pragma unroll
                for (int e = 0; e < 4; ++e) v[u][e] = s[u][e] + bias4[e]; }
            float m1[2], m2[2];
#pragma unroll
            for (int u = 0; u < 2; ++u) { const float a = fmaxf(v[u][0], v[u][1]), b = fminf(v[u][0], v[u][1]), c = fmaxf(v[u][2], v[u][3]), d = fminf(v[u][2], v[u][3]); m1[u] = fmaxf(a, c); m2[u] = fmaxf(fminf(a, c), fmaxf(b, d)); }
#pragma unroll
            for (int o = 1; o < 8; o <<= 1) {
#pragma unroll
                for (int u = 0; u < 2; ++u) { const float o1 = __shfl_xor(m1[u], o), o2 = __shfl_xor(m2[u], o); const float n1 = fmaxf(m1[u], o1), n2 = fmaxf(fminf(m1[u], o1), fmaxf(m2[u], o2)); m1[u] = n1; m2[u] = n2; } }
#pragma unroll
            for (int u = 0; u < 2; ++u) gs[u] = m1[u] + m2[u];
            int cnt[2] = {0, 0};
#pragma unroll
            for (int g = 0; g < 8; ++g) {
#pragma unroll
                for (int u = 0; u < 2; ++u) { const float og = __shfl(gs[u], 8 * g); cnt[u] += (og > gs[u] || (og == gs[u] && g < grp)) ? 1 : 0; } }
#pragma unroll
            for (int u = 0; u < 2; ++u) {
#pragma unroll
                for (int e = 0; e < 4; ++e) v[u][e] = (cnt[u] < 4) ? v[u][e] : NEG; }
            int myidx[2] = {0, 0}; float mysc[2] = {0.f, 0.f}, ssum[2] = {0.f, 0.f};
#pragma unroll
            for (int k = 0; k < TOPK; ++k) {
                float bv[2]; int idx[2];
#pragma unroll
                for (int u = 0; u < 2; ++u) { bv[u] = v[u][0]; int bi = 0;
#pragma unroll
                    for (int e = 1; e < 4; ++e) { const bool gt = v[u][e] > bv[u]; bv[u] = gt ? v[u][e] : bv[u]; bi = gt ? e : bi; }
                    idx[u] = 4 * lane + bi; }
#pragma unroll
                for (int o = 1; o < 64; o <<= 1) {
#pragma unroll
                    for (int u = 0; u < 2; ++u) { const float ov = __shfl_xor(bv[u], o); const int oi = __shfl_xor(idx[u], o); const bool tk = (ov > bv[u]) || (ov == bv[u] && oi < idx[u]); bv[u] = tk ? ov : bv[u]; idx[u] = tk ? oi : idx[u]; } }
#pragma unroll
                for (int u = 0; u < 2; ++u) { const int own = idx[u] >> 2, ee = idx[u] & 3;
                    const float mine = (ee == 0) ? s[u][0] : (ee == 1) ? s[u][1] : (ee == 2) ? s[u][2] : s[u][3];
                    const float scv = __shfl(mine, own);
#pragma unroll
                    for (int e = 0; e < 4; ++e) v[u][e] = (lane == own && e == ee) ? NEG : v[u][e];
                    ssum[u] += scv; myidx[u] = (lane == k) ? idx[u] : myidx[u]; mysc[u] = (lane == k) ? scv : mysc[u]; }
            }
            if (lane < TOPK) {
#pragma unroll
                for (int u = 0; u < 2; ++u) { const int t = t0 + u;
                    const int lr = __hip_atomic_fetch_add(hist + myidx[u], 1, __ATOMIC_RELAXED, __HIP_MEMORY_SCOPE_WORKGROUP);
                    P.eidx[(size_t)t * TOPK + lane] = myidx[u]; P.ewt[(size_t)t * TOPK + lane] = mysc[u] / ssum[u] * 2.5f; P.lrank[(size_t)t * TOPK + lane] = lr; }
            }
        }
        __syncthreads();
        if (tid < NE) { const int cnt = hist[tid]; unsigned base = 0u;
            if (cnt) base = __hip_atomic_fetch_add(P.segcnt + tid, (unsigned)cnt, __ATOMIC_RELAXED, __HIP_MEMORY_SCOPE_AGENT);
            P.tbase[tile * NE + tid] = (int)base; }
        __syncthreads();
    }
}
struct ScatArgs { const int* eidx; const float* ewt; const int* lrank; const int* tbase; const unsigned* segcnt; int* rowtok; int* rowdst; float* roww; int* tab; unsigned* ntile; };
__device__ __forceinline__ void phase_scatter(const ScatArgs& P, LAS unsigned char* lds, int tid, int G) {
    LAS int* cntL = (LAS int*)(lds + LDS_MISC); LAS int* segst = cntL + 256; LAS int* tsa = segst + 256;
    if (tid < NE) cntL[tid] = (int)__hip_atomic_load(P.segcnt + tid, __ATOMIC_RELAXED, __HIP_MEMORY_SCOPE_AGENT);
    __syncthreads();
    if (tid == 0) {
        int run = 0, ta = 0;
        for (int s = 0; s < NE; ++s) { const int nts = (cntL[s] + 255) >> 8; segst[s] = run; tsa[s] = ta; run += nts * 256; ta += nts; }
        if (blockIdx.x == 0) P.ntile[0] = (unsigned)ta;
    }
    __syncthreads();
    for (int tile = blockIdx.x; tile < T / 256; tile += G) {
        for (int a = tid; a < 256 * TOPK; a += NTHREADS) {
            const int tok = tile * 256 + (a >> 3), k = a & 7; const size_t ai = (size_t)tok * TOPK + k;
            const int e = P.eidx[ai];
            const int pos = segst[e] + P.tbase[tile * NE + e] + P.lrank[ai];
            P.rowtok[pos] = tok; P.rowdst[pos] = tok * TOPK + k; P.roww[pos] = P.ewt[ai];
        }
    }
    for (int s = blockIdx.x; s < NE; s += G) {
        const int st = segst[s], cnt = cntL[s], nts = (cnt + 255) >> 8;
        for (int p = st + cnt + tid; p < st + nts * 256; p += NTHREADS) { P.rowtok[p] = 0; P.rowdst[p] = -1; P.roww[p] = 0.f; }
        if (tid < nts) { int* ta_ = P.tab + 2 * (tsa[s] + tid); ta_[0] = st + 256 * tid; ta_[1] = s; }
    }
}
constexpr int NPHASE = 20;
struct KArgs { const float* in[34]; float* out; unsigned char* ws; int ph_lo, ph_hi; };
template <int PLO, int PHI>
__global__ void __launch_bounds__(NTHREADS, 2) fwd_kernel(KArgs a) {
    extern __shared__ __attribute__((aligned(16))) unsigned char lds_raw[];
    LAS unsigned char* lds = (LAS unsigned char*)lds_raw;
    const int G = gridDim.x, bid = blockIdx.x, NGW = G * NWAVES;
#define PH_IDS() int tid = threadIdx.x; asm volatile("" : "+v"(tid)); const int lane = tid & 63, wave = __builtin_amdgcn_readfirstlane(tid >> 6), gw = bid * NWAVES + wave; (void)lane; (void)wave; (void)gw
    unsigned char* ws = a.ws;
    unsigned* ctl = (unsigned*)(ws + WS_CTL);
    float* mod = (float*)(ws + WS_MOD);
    constexpr int lo = PLO, hi = PHI;
    if (threadIdx.x == 0) *(LAS u32x4*)(lds + LDS_BARW) = (u32x4){0u, 0u, 0u, 0u};
    __syncthreads();
    XcdBarrier bar; bar.bar = ctl + CW_BAR; bar.x = 0; bar.st = nullptr;
    if (hi - lo > 1) bar = xcd_barrier_post(ctl + CW_BAR, (volatile LAS unsigned*)(lds + LDS_BARW));
#define IN(k) (lo <= (k) && (k) < hi)
#ifdef DBG_TIME
#define STAMP(k) do { if (blockIdx.x == 0 && threadIdx.x == 0) ((unsigned long long*)(ctl + 5200))[k] = __builtin_amdgcn_s_memrealtime(); } while (0)
#else
#define STAMP(k) do {} while (0)
#endif
#define SEAM(k) do { if (IN(k) && IN((k) + 1)) xcd_barrier(bar); } while (0)
#ifndef DBG_REPEAT
#define DBG_REPEAT (-1)
#define DBG_NREP 0
#endif
#define REP(k) for (int rep_ = 0; rep_ < (((k) == DBG_REPEAT) ? 1 + DBG_NREP : 1); ++rep_, (((k) == DBG_REPEAT && rep_ <= DBG_NREP) ? xcd_barrier(bar) : (void)0))

    STAMP(0);
    if (IN(0)) REP(0) { PH_IDS();
        phase_mod(a.in[1], a.in[2], a.in[3], mod, lds, tid, G);
        SmallW sw{a.in[6], a.in[22], a.in[23], a.in[24], a.in[25], a.in[30], a.in[31], a.in[32], a.in[9], a.in[11], a.in[12], a.in[20]};
        phase_small_weights(sw, ws, lds, gw, NGW, wave, lane);
    }
    SEAM(0); STAMP(1);
    if (IN(1)) REP(1) { PH_IDS(); phase_norm_mod(a.in[0], a.in[4], mod, 0, 1024, nullptr, ws + B_H1, gw, NGW, lane); }
    SEAM(1); STAMP(2);
    if (IN(2)) REP(2) {
        gm::DenseSched S; S.init(ws + B_H1, ws + SW_WIN, T, IN_COLS, D, G, bid, 1);
        gm::EpiInProj E{(bf16_t*)(ws + B_PRW), (bf16_t*)(ws + B_PUV), (bf16_t*)(ws + B_PG)};
        gm::gemm_phase<gm::EpiInProj, gm::DenseSched, true, true, 122>(lds, D, S, E);
    }
    SEAM(2); STAMP(3);
    if (IN(3)) REP(3) { PH_IDS();
        gl::Args Q{(const bf16_t*)(ws + B_PUV), (const bf16_t*)(ws + SW_WSM), a.in[21], a.in[18], a.in[19], (bf16_t*)(ws + B_YB)};
        for (int u = bid; u < 512; u += G) gl::unit(Q, lds, u >> 6, u & 63, tid);
        phase_xs((const bf16_t*)(ws + B_PRW), a.in[7], (bf16_t*)(ws + B_XS), gw, NGW, lane);
    }
    SEAM(3); STAMP(4);
    if (IN(4)) REP(4) { PH_IDS();
        rk::Args P{(const bf16_t*)(ws + B_PRW), a.in[7], a.in[8], a.in[10], a.in[13], a.in[14], a.in[15], (const bf16_t*)(ws + SW_WUP), (const bf16_t*)(ws + SW_AUP), (const bf16_t*)(ws + SW_GUP), (const bf16_t*)(ws + B_XS),
                   (bf16_t*)(ws + B_G), (bf16_t*)(ws + B_BV), ws + B_MN, ws + B_QY};
        rk::Pre pre; rk::load_mu(P, lds, tid);
        if (bid < 8192) rk::prefetch(P, bid >> 10, (bid >> 7) & 7, bid & 127, tid, pre);
        for (int u = bid; u < 8192; u += G) { const int un = u + G; rk::unit(P, lds, u >> 10, (u >> 7) & 7, u & 127, u, tid, pre, un < 8192, un >> 10, (un >> 7) & 7, un & 127); }
    }
    SEAM(4); STAMP(5);
    if (IN(5)) REP(5) { PH_IDS();
        for (int w = bid; w < 256; w += G) rk::scan_wg(ws + B_MN, ws + B_S, ((w & 7) + 8 * (w >> 5)) * 128, (w >> 3) & 3, lds, tid);
    }
    SEAM(5); STAMP(6);
    if (IN(6)) REP(6) { PH_IDS();
        rk::YArgs Y{ws + B_QY, ws + B_S, (const bf16_t*)(ws + B_G), (const bf16_t*)(ws + B_BV), a.in[16], a.in[17], (bf16_t*)(ws + B_YA)};
        for (int u = gw; u < 8192; u += NGW) rk::ypass_unit(Y, u, lane);
    }
    SEAM(6); STAMP(7);
    STAMP(8);
    if (IN(8)) REP(8) {
        gm::DenseSched S; S.init(ws + B_YA, ws + SW_WOA, T, D, RW, G, bid);
        gm::EpiMerge<false> E{(bf16_t*)(ws + B_M1), (const bf16_t*)(ws + B_PG)};
        gm::gemm_phase<gm::EpiMerge<false>, gm::DenseSched, true>(lds, RW, S, E);
    }
    SEAM(8); STAMP(9);
    if (IN(9)) {
        gm::DenseSched S; S.init(ws + B_YB, ws + SW_WOB, T, D, RW, G, bid);
        gm::EpiMerge<true> E{(bf16_t*)(ws + B_M1), (const bf16_t*)(ws + B_PG)};
        gm::gemm_phase<gm::EpiMerge<true>, gm::DenseSched, true>(lds, RW, S, E);
    }
    SEAM(9); STAMP(10);
    if (IN(10)) REP(10) {
        gm::DenseSched S; S.init(ws + B_M1, ws + SW_WO, T, D, D, G, bid);
        gm::EpiResid E{a.out, a.in[0], mod + 2048};
        gm::gemm_phase<gm::EpiResid, gm::DenseSched, true>(lds, D, S, E);
    }
    SEAM(10); STAMP(11);
    if (IN(11)) REP(11) { PH_IDS();
        phase_norm_mod(a.out, a.in[5], mod, 3072, 4096, (bf16_t*)(ws + B_H2), ws + B_H2F8, gw, NGW, lane);
        phase_expert_weights(a.in[27], a.in[28], a.in[29], ws, lds, gw, NGW, wave, lane);
    }
    SEAM(11); STAMP(12);
    if (IN(12)) REP(12) {
        { gm::DenseSched S; S.init(ws + B_H2, ws + SW_WR, T, NE, D, G, bid); gm::EpiRouter E{(float*)(ws + B_SC)}; gm::gemm_phase<gm::EpiRouter, gm::DenseSched, true>(lds, D, S, E); }
        { gm::DenseSched S; S.init(ws + B_H2, ws + SW_WS13, T, 512, D, G, bid); gm::EpiGateUp<false> E{ws + B_SH}; gm::gemm_phase<gm::EpiGateUp<false>, gm::DenseSched, true>(lds, D, S, E); }
    }
    SEAM(12); STAMP(13);
    if (IN(13)) { PH_IDS();
        RouteArgs R{(const float*)(ws + B_SC), a.in[26], (int*)(ws + RT_EIDX), (float*)(ws + RT_EWT), (int*)(ws + RT_LRANK), (int*)(ws + RT_TBASE), ctl + CW_SEGCNT};
        phase_topk(R, lds, tid, G);
        gm::DenseSched S; S.init(ws + B_SH, ws + SW_WS2, T, D, EFF, G, bid);
        gm::EpiSharedDown E{ws + B_SHO};
        gm::gemm_phase<gm::EpiSharedDown, gm::DenseSched, true>(lds, EFF, S, E);
    }
    SEAM(13); STAMP(14);
    if (IN(14)) REP(14) { PH_IDS();
        ScatArgs P{(const int*)(ws + RT_EIDX), (const float*)(ws + RT_EWT), (const int*)(ws + RT_LRANK), (const int*)(ws + RT_TBASE), ctl + CW_SEGCNT,
                   (int*)(ws + RT_ROWTOK), (int*)(ws + RT_ROWDST), (float*)(ws + RT_ROWW), (int*)(ws + RT_TAB), ctl + CW_NT};
        phase_scatter(P, lds, tid, G);
    }
    SEAM(14); STAMP(15);
    if (IN(15)) REP(15) {
        gm::GroupSched<true> S; S.A = (const char*)(ws + B_H2F8); S.B = (const char*)(ws + B_W13); S.tab = (const int*)(ws + RT_TAB); S.rowtok = (const int*)(ws + RT_ROWTOK);
        S.ntiles = (int)__hip_atomic_load(ctl + CW_NT, __ATOMIC_RELAXED, __HIP_MEMORY_SCOPE_AGENT); S.npn = 2; S.G = G; S.c = bid; S.K = D; S.ebytes = (size_t)512 * D; S.tstep = (size_t)256 * D;
        gm::EpiGateUp<true> E{ws + B_HID};
        gm::gemm_phase<gm::EpiGateUp<true>, gm::GroupSched<true>, true, true, 122>(lds, D, S, E);
    }
    SEAM(15); STAMP(16);
    if (IN(16)) REP(16) {
        gm::GroupSched<false> S; S.A = (const char*)(ws + B_HID); S.B = (const char*)(ws + B_W2); S.tab = (const int*)(ws + RT_TAB); S.rowtok = nullptr;
        S.ntiles = (int)__hip_atomic_load(ctl + CW_NT, __ATOMIC_RELAXED, __HIP_MEMORY_SCOPE_AGENT); S.npn = 4; S.G = G; S.c = bid; S.K = EFF; S.ebytes = (size_t)D * EFF; S.tstep = (size_t)256 * EFF;
        gm::EpiExpertDown E{ws + B_SLOT, (const int*)(ws + RT_ROWDST), (const float*)(ws + RT_ROWW)};
        gm::gemm_phase<gm::EpiExpertDown, gm::GroupSched<false>, true, true, 122>(lds, EFF, S, E);
    }
    SEAM(16); STAMP(17);
    if (IN(17)) { PH_IDS(); phase_combine(a.out, ws + B_SLOT, ws + B_SHO, mod, a.in[33], gw, NGW, lane); }
    STAMP(18); STAMP(19);
    __syncthreads(); STAMP(20);
#undef IN
#undef SEAM
}

#if defined(DBG_CHECK) || defined(DBG_TIME)
#ifdef DBG_TIME
#ifndef TSC
#define TSC 0.25f
#endif
__global__ void dbg_time_out(float* out, const unsigned long long* st) {
    if (threadIdx.x == 0 && blockIdx.x == 0) { out[0] = (float)(st[TA1] - st[TA0]) * 0.01f * TSC; out[1] = (float)(st[TB1] - st[TB0]) * 0.01f * TSC; }
}
static void dbg_run(void* d_out, void* d_ws, hipStream_t stream) {
    dbg_time_out<<<1, 64, 0, stream>>>((float*)d_out, (const unsigned long long*)((unsigned*)((unsigned char*)d_ws + WS_CTL) + 5200));
}
#endif
#endif
#ifndef MK_SINGLE
#define MK_SINGLE 0
#endif
template <int PLO, int PHI> static bool prep_kernel() {
    int per_cu = 0;
    if (hipFuncSetAttribute((const void*)fwd_kernel<PLO, PHI>, hipFuncAttributeMaxDynamicSharedMemorySize, LDS_BYTES) != hipSuccess) { fprintf(stderr, "kernel_launch: hipFuncSetAttribute failed\n"); return false; }
    if (hipOccupancyMaxActiveBlocksPerMultiprocessor(&per_cu, (const void*)fwd_kernel<PLO, PHI>, NTHREADS, LDS_BYTES) != hipSuccess || per_cu < 1) { fprintf(stderr, "kernel_launch: occupancy query says %d\n", per_cu); (void)hipGetLastError(); return false; }
    return true;
}
template <int P> struct PhaseLaunch {
    static bool prep() { return prep_kernel<P, P + 1>() && PhaseLaunch<P + 1>::prep(); }
    static void go(int grid, hipStream_t stream, const KArgs& a) { hipLaunchKernelGGL((fwd_kernel<P, P + 1>), dim3(grid), dim3(NTHREADS), LDS_BYTES, stream, a); PhaseLaunch<P + 1>::go(grid, stream, a); }
};
#ifndef DBG_LAST
#define DBG_LAST NPHASE
#endif
template <> struct PhaseLaunch<DBG_LAST> { static bool prep() { return true; } static void go(int, hipStream_t, const KArgs&) {} };
extern "C" void kernel_launch(void* const* d_in, const int* in_sizes, int n_in, void* d_out, int out_size, void* d_ws, size_t ws_size, hipStream_t stream) {
    static int grid = 0;
    if (grid == 0) {
        if (n_in != 34 || out_size != T * D || ws_size < WS_END) { fprintf(stderr, "kernel_launch: unexpected problem shape (n_in %d, out %d, ws %zu < %zu)\n", n_in, out_size, ws_size, (size_t)WS_END); grid = -1; return; }
        int dev = 0, cus = 0;
        if (hipGetDevice(&dev) != hipSuccess || hipDeviceGetAttribute(&cus, hipDeviceAttributeMultiprocessorCount, dev) != hipSuccess) { grid = -1; return; }
#if MK_SINGLE
        if (!prep_kernel<0, NPHASE>()) { grid = -1; return; }
#else
        if (!PhaseLaunch<0>::prep()) { grid = -1; return; }
#endif
        grid = cus;
    }
    if (grid < 0) return;
    (void)hipMemsetAsync((char*)d_ws + WS_CTL, 0, CTL_ZERO_BYTES, stream);
    KArgs a{};
    for (int i = 0; i < 34; ++i) a.in[i] = (const float*)d_in[i];
    a.out = (float*)d_out; a.ws = (unsigned char*)d_ws; a.ph_lo = 0; a.ph_hi = NPHASE;
#if MK_SINGLE
    hipLaunchKernelGGL((fwd_kernel<0, NPHASE>), dim3(grid), dim3(NTHREADS), LDS_BYTES, stream, a);
#else
    PhaseLaunch<0>::go(grid, stream, a);
#endif
#if defined(DBG_CHECK) || defined(DBG_TIME)
    dbg_run(d_out, d_ws, stream);
#endif
}
```

```cpp
#define MK_SINGLE 1
#include <hip/hip_runtime.h>
#include <cstdio>
#include <cstdint>

#define LAS __attribute__((address_space(3)))
#define GAS __attribute__((address_space(1)))
typedef unsigned short bf16_t;
typedef short bf16x8 __attribute__((ext_vector_type(8)));
typedef float f32x4 __attribute__((ext_vector_type(4)));
typedef float f32x2 __attribute__((ext_vector_type(2)));
typedef unsigned u32x4 __attribute__((ext_vector_type(4)));
typedef unsigned u32x2 __attribute__((ext_vector_type(2)));

constexpr int D = 1024, NB = 8, SEQ = 8192, T = NB * SEQ;
constexpr int RW = 512, HD = 64, NH = 8;
constexpr int RWKV_COLS = 1792, IN_COLS = 4864;
constexpr int NE = 256, TOPK = 8, EFF = 256;
constexpr int NWAVES = 8, NTHREADS = 512;
constexpr int MAXROWS = T * TOPK + 256 * 256;

constexpr size_t MiB = 1u << 20;
constexpr size_t WS_CTL = 0;
constexpr int CW_BAR = 0, CW_SEGCNT = 4096, CW_NT = 4608;
constexpr size_t CTL_ZERO_BYTES = 20480;
constexpr size_t WS_MOD = 65536;
constexpr size_t WS_SW = 1 * MiB;
constexpr size_t SW_WIN = WS_SW;
constexpr size_t SW_WOA = SW_WIN + (size_t)IN_COLS * D * 2;
constexpr size_t SW_WOB = SW_WOA + (size_t)D * RW * 2;
constexpr size_t SW_WO = SW_WOB + (size_t)D * RW * 2;
constexpr size_t SW_WR = SW_WO + (size_t)D * D * 2;
constexpr size_t SW_WS13 = SW_WR + (size_t)NE * D * 2;
constexpr size_t SW_WS2 = SW_WS13 + (size_t)512 * D * 2;
constexpr size_t SW_WUP = SW_WS2 + (size_t)D * EFF * 2;
constexpr size_t SW_AUP = SW_WUP + (size_t)RW * 64 * 2;
constexpr size_t SW_GUP = SW_AUP + (size_t)RW * 64 * 2;
constexpr size_t SW_WSM = SW_GUP + (size_t)RW * 128 * 2;
constexpr size_t SW_END = SW_WSM + (size_t)8 * 128 * 128 * 2;
static_assert(SW_END <= 20 * MiB, "small weights");
constexpr size_t WS_RT = 20 * MiB;
constexpr size_t RT_EIDX = WS_RT;
constexpr size_t RT_EWT = RT_EIDX + (size_t)T * 8 * 4;
constexpr size_t RT_LRANK = RT_EWT + (size_t)T * 8 * 4;
constexpr size_t RT_TBASE = RT_LRANK + (size_t)T * 8 * 4;
constexpr size_t RT_ROWTOK = RT_TBASE + (size_t)256 * 256 * 4;
constexpr size_t RT_ROWDST = RT_ROWTOK + (size_t)MAXROWS * 4;
constexpr size_t RT_ROWW = RT_ROWDST + (size_t)MAXROWS * 4;
constexpr size_t RT_TAB = RT_ROWW + (size_t)MAXROWS * 4;
constexpr size_t RT_SBON = RT_TAB + (size_t)3 * 4096 * 8;
constexpr size_t RT_END = RT_SBON + (size_t)T * 8 * 4;
static_assert(RT_END <= 40 * MiB, "routing arrays");
constexpr size_t WS_BIG = 40 * MiB;
constexpr size_t B_H1 = WS_BIG + 0 * MiB;
constexpr size_t B_YB = WS_BIG + 0 * MiB;
constexpr size_t B_YA = WS_BIG + 64 * MiB;
constexpr size_t B_XS = WS_BIG + 64 * MiB;
constexpr size_t B_PRW = WS_BIG + 128 * MiB;
constexpr size_t B_M8 = WS_BIG + 128 * MiB;
constexpr size_t B_S = WS_BIG + 128 * MiB;
constexpr size_t B_PUV = WS_BIG + 352 * MiB;
constexpr size_t B_QY = WS_BIG + 352 * MiB;
constexpr size_t B_M1 = WS_BIG + 352 * MiB;
constexpr size_t B_PG = WS_BIG + 480 * MiB;
constexpr size_t B_MN = WS_BIG + 736 * MiB;
constexpr size_t B_G = WS_BIG + 864 * MiB;
constexpr size_t B_BV = WS_BIG + 928 * MiB;
constexpr size_t B_H2 = WS_BIG + 0 * MiB;
constexpr size_t B_W13 = WS_BIG + 128 * MiB;
constexpr size_t B_H2F8 = WS_BIG + 256 * MiB;
constexpr size_t B_SH = WS_BIG + 384 * MiB;
constexpr size_t B_SC = WS_BIG + 416 * MiB;
constexpr size_t B_SLOT = WS_BIG + 0 * MiB;
constexpr size_t B_SHO = WS_BIG + 928 * MiB;
constexpr size_t B_W2 = WS_BIG + 512 * MiB;
constexpr size_t B_HID = WS_BIG + 640 * MiB;
constexpr size_t WS_END = WS_BIG + 992 * MiB;
static_assert((size_t)MAXROWS * EFF * 2 <= 320 * MiB, "hid");

constexpr int LDS_STAGE = 0;
constexpr int LDS_MISC = 147456;
constexpr int LDS_BARW = 155648;
constexpr int LDS_BYTES = 163840;

typedef __bf16 bf16x2_t __attribute__((ext_vector_type(2)));
__device__ __forceinline__ unsigned pk2(float lo, float hi) { f32x2 f = {lo, hi}; return __builtin_bit_cast(unsigned, __builtin_convertvector(f, bf16x2_t)); }
__device__ __forceinline__ u32x2 pk8(const f32x4& a, const f32x4& b) { u32x2 w; int t = __builtin_amdgcn_cvt_pk_fp8_f32(a[0], a[1], 0, false); t = __builtin_amdgcn_cvt_pk_fp8_f32(a[2], a[3], t, true); w.x = (unsigned)t;
    t = __builtin_amdgcn_cvt_pk_fp8_f32(b[0], b[1], 0, false); t = __builtin_amdgcn_cvt_pk_fp8_f32(b[2], b[3], t, true); w.y = (unsigned)t; return w; }
__device__ __forceinline__ f32x4 up8(unsigned w) { const f32x2 lo = __builtin_amdgcn_cvt_pk_f32_fp8((int)w, false), hi = __builtin_amdgcn_cvt_pk_f32_fp8((int)w, true); return (f32x4){lo.x, lo.y, hi.x, hi.y}; }
__device__ __forceinline__ float bflo(unsigned w) { return __uint_as_float(w << 16); }
__device__ __forceinline__ float bfhi(unsigned w) { return __uint_as_float(w & 0xffff0000u); }
__device__ __forceinline__ float bf2f(bf16_t h) { return __uint_as_float(((unsigned)h) << 16); }
__device__ __forceinline__ bf16_t f2bf(float f) { return (bf16_t)(pk2(f, 0.f) & 0xffffu); }
__device__ __forceinline__ float fexp(float x) { return __builtin_amdgcn_exp2f(x * 1.44269504089f); }
__device__ __forceinline__ float flog(float x) { return __builtin_amdgcn_logf(x) * 0.69314718056f; }
__device__ __forceinline__ float frcp(float x) { return __builtin_amdgcn_rcpf(x); }
__device__ __forceinline__ float sigmoidf_(float x) { return frcp(1.0f + fexp(-x)); }
__device__ __forceinline__ float siluf_(float x) { return x * sigmoidf_(x); }
__device__ __forceinline__ float tanhf_(float x) { return 1.0f - 2.0f * frcp(1.0f + fexp(2.0f * x)); }
__device__ __forceinline__ float gelu_tanh(float x) { const float u = 0.7978845608f * (x + 0.044715f * x * x * x); return x * frcp(1.0f + fexp(-2.0f * u)); }
__device__ __forceinline__ float wave_sum(float v) {
#pragma unroll
    for (int o = 1; o < 64; o <<= 1) v += __shfl_xor(v, o);
    return v;
}
#define LDS_WAIT() asm volatile("s_waitcnt lgkmcnt(0)" ::: "memory")
#define VM_WAIT() asm volatile("s_waitcnt vmcnt(0)" ::: "memory")

#define XB_TMO      128
#define XB_XCNT(j)  (256  + 64 * (j))
#define XB_XSUB(j)  (1280 + 64 * (j))
#define XB_XGEN(j)  (2304 + 64 * (j))
#define XB_TOP      3328
#define XB_TOPGEN   3392
#define XCD_BAR_WORDS 3456
#define XB_SPIN_CAP (1u << 18)
__device__ __forceinline__ unsigned xb_ld(unsigned* p)              { return __hip_atomic_load(p, __ATOMIC_RELAXED, __HIP_MEMORY_SCOPE_AGENT); }
__device__ __forceinline__ unsigned xb_add(unsigned* p, unsigned v) { return __hip_atomic_fetch_add(p, v, __ATOMIC_RELAXED, __HIP_MEMORY_SCOPE_AGENT); }
__device__ __forceinline__ unsigned xb_xcc_id() { return (unsigned)__builtin_amdgcn_s_getreg((3 << 11) | 20) & 0xFu; }
#define XB_SPIN(cond, bar) do { unsigned _sp = 0; while (cond) { __builtin_amdgcn_s_sleep(1); \
    if ((++_sp & 255u) == 0u) { if (xb_ld(&(bar)[XB_TMO])) break; if (_sp > XB_SPIN_CAP) { atomicAdd(&(bar)[XB_TMO], 1u); break; } } } } while (0)
struct XcdBarrier { unsigned* bar; unsigned x; volatile LAS unsigned* st; };
__device__ __forceinline__ XcdBarrier xcd_barrier_post(unsigned* bar, volatile LAS unsigned* st) {
    XcdBarrier b; b.bar = bar; b.x = xb_xcc_id(); b.st = st;
    if (threadIdx.x == 0) (void)xb_add(&bar[XB_XCNT(b.x)], 1u);
    return b;
}
__device__ __forceinline__ void xcd_barrier_complete(unsigned* bar, unsigned x, unsigned& nloc, unsigned& nx) {
    const unsigned G = gridDim.x * gridDim.y * gridDim.z;
    unsigned sum, cnt, mine, sp = 0u;
    for (;;) {
        sum = 0u; cnt = 0u; mine = 0u;
#pragma unroll
        for (unsigned j = 0; j < 16; ++j) { const unsigned c = xb_ld(&bar[XB_XCNT(j)]); sum += c; cnt += (c > 0u) ? 1u : 0u; mine = (j == x) ? c : mine; }
        if (sum == G) break;
        __builtin_amdgcn_s_sleep(1);
        if ((++sp & 255u) == 0u) { if (xb_ld(&bar[XB_TMO])) break; if (sp > XB_SPIN_CAP) { atomicAdd(&bar[XB_TMO], 1u); break; } }
    }
    nloc = mine > 0u ? mine : 1u; nx = cnt > 0u ? cnt : 1u;
}
__device__ __forceinline__ void xcd_barrier(const XcdBarrier& b) {
    asm volatile("s_waitcnt vmcnt(0)" ::: "memory");
    __syncthreads();
    if (threadIdx.x == 0) {
        unsigned* bar = b.bar;
        __builtin_amdgcn_s_waitcnt(0);
        unsigned nloc = b.st[0], nx = b.st[1];
        if (nloc == 0u) { xcd_barrier_complete(bar, b.x, nloc, nx); b.st[0] = nloc; b.st[1] = nx; }
        const unsigned old = xb_add(&bar[XB_XSUB(b.x)], 1u);
        const unsigned gen = old / nloc;
        if (old + 1u == (gen + 1u) * nloc) {
            __builtin_amdgcn_fence(__ATOMIC_RELEASE, "agent");
            asm volatile("s_waitcnt vmcnt(0)" ::: "memory");
            const unsigned og = xb_add(&bar[XB_TOP], 1u);
            const unsigned tg = og / nx;
            if (og + 1u == (tg + 1u) * nx) xb_add(&bar[XB_TOPGEN], 1u);
            else XB_SPIN(xb_ld(&bar[XB_TOPGEN]) == tg, bar);
            __builtin_amdgcn_fence(__ATOMIC_ACQUIRE, "agent");
            xb_add(&bar[XB_XGEN(b.x)], 1u);
            asm volatile("s_waitcnt vmcnt(0)" ::: "memory");
        } else {
            XB_SPIN(xb_ld(&bar[XB_XGEN(b.x)]) == gen, bar);
            __builtin_amdgcn_fence(__ATOMIC_ACQUIRE, "agent");
            asm volatile("s_waitcnt vmcnt(0)" ::: "memory");
        }
    }
    __syncthreads();
}
namespace gm {
typedef int i32x4 __attribute__((ext_vector_type(4)));
typedef int i32x8 __attribute__((ext_vector_type(8)));
constexpr int BM = 256, BK = 64, HALF = 128, HTB = HALF * BK * 2, STAGE_BYTES = 8 * HTB, NXCD = 8, WGM = 8;
__host__ __device__ __forceinline__ int lds_byte(int r, int c) { const int st = (r >> 4) * 2 + (c >> 5), rr = r & 15, cc = c & 31, ob = rr * 64 + cc * 2; return st * 1024 + (ob ^ (((ob >> 9) & 1) << 5)); }
__host__ __device__ __forceinline__ void stage_rc(int b, int& R, int& C) { const int st = b / 1024, sb = b % 1024, swz = sb ^ (((sb >> 9) & 1) << 5); R = (st >> 1) * 16 + swz / 64; C = (st & 1) * 32 + (swz % 64) / 2; }
__host__ __device__ __forceinline__ int perm32(int rho) { const int n = rho >> 4, i = rho & 15; return 8 * (i >> 2) + 4 * n + (i & 3); }

struct Unit { int pm, pn, e, row0, par; };

struct DenseSched {
    static constexpr bool GATHER = false;
    const char* A; const char* B; int nM, nN, nwg, G, c; size_t tstep;
    __device__ __forceinline__ void init(const void* A_, const void* B_, int M, int N, int K, int G_, int c_, int es = 2) { A = (const char*)A_; B = (const char*)B_; nM = M / BM; nN = N / BM; nwg = nM * nN; G = G_; c = c_; tstep = (size_t)BM * K * es; }
    __device__ __forceinline__ bool next(int i, Unit& u) const {
        const long L = (long)i * G + c; if (L >= nwg) return false;
        int wgid = (int)L; { const int q = nwg / NXCD, r = nwg % NXCD, xcd = wgid % NXCD, off = wgid / NXCD; wgid = (xcd < r ? xcd * (q + 1) : r * (q + 1) + (xcd - r) * q) + off; }
        const int nig = WGM * nN, gid = wgid / nig, fm = gid * WGM, gsz = (nM - fm) < WGM ? (nM - fm) : WGM;
        u.pm = fm + ((wgid % nig) % gsz); u.pn = (wgid % nig) / gsz; u.e = 0; u.row0 = u.pm * BM; return true;
    }
    __device__ __forceinline__ const char* a_ptr(const Unit& u) const { return A + (size_t)u.pm * tstep; }
    __device__ __forceinline__ const char* b_ptr(const Unit& u) const { return B + (size_t)u.pn * tstep; }
    __device__ __forceinline__ unsigned row_off(const Unit&, int) const { return 0u; }
};
template <bool GATHER_>
struct GroupSched {
    static constexpr bool GATHER = GATHER_;
    const char* A; const char* B; const int* tab; const int* rowtok; int ntiles, npn, G, c, K; size_t ebytes, tstep;
    __device__ __forceinline__ bool next(int i, Unit& u) const {
        int tile;
        if (G == 256) {
            const int xcd = c & 7, slot = c >> 3, tpx = 32 / npn; tile = i * 8 * tpx + xcd * tpx + slot / npn; u.pn = slot % npn; if (tile >= ntiles) return false;
        } else { const long L = (long)i * G + c; if (L >= (long)ntiles * npn) return false; tile = (int)(L / npn); u.pn = (int)(L % npn); }
        u.pm = tile;
        u.row0 = __builtin_amdgcn_readfirstlane(tab[2 * tile]); u.e = __builtin_amdgcn_readfirstlane(tab[2 * tile + 1]); return true;
    }
    __device__ __forceinline__ const char* a_ptr(const Unit& u) const { return GATHER ? A : A + (size_t)u.row0 * K; }
    __device__ __forceinline__ const char* b_ptr(const Unit& u) const { return B + (size_t)u.e * ebytes + (size_t)u.pn * tstep; }
    __device__ __forceinline__ unsigned row_off(const Unit& u, int r) const { return (unsigned)rowtok[u.row0 + r] * (unsigned)K; }
};

template <class Epi, class Sched, bool ALIGN_EPI, bool F8 = false, int SCALE_W = 127>
__device__ __forceinline__ void gemm_phase(LAS unsigned char* lds, const int Kel, const Sched& S, const Epi& E) {
    const int K = F8 ? Kel / 2 : Kel;
    int tid_ = threadIdx.x; asm volatile("" : "+v"(tid_));
    const int tid = tid_, wid = __builtin_amdgcn_readfirstlane(tid >> 6), lane = tid & 63, wr = wid >> 2, wc = wid & 3, fr = lane & 15, fq = lane >> 4;
    const int nt = K / BK;
    int sR[2], sC[2]; unsigned voffB[2];
#pragma unroll
    for (int i = 0; i < 2; ++i) { int R, C; stage_rc(tid * 16 + i * 8192, R, C); sR[i] = R; sC[i] = C; const int Rb = Epi::PERM ? ((R & ~31) + perm32(R & 31)) : R; voffB[i] = (unsigned)(Rb * K + C) * 2u; }
    const size_t kstep = (size_t)(BK * 2);
    const size_t hstep = (size_t)HALF * K * 2;
    const unsigned ldsw = (unsigned)wid * 1024u;
    const int aoff = lds_byte(wr * 64 + fr, fq * 8), boff = lds_byte(wc * 32 + fr, fq * 8);
#define PG8_SA(b, h) (((b) * 2 + (h)) * HTB)
#define PG8_SB(b, h) ((4 + (b) * 2 + (h)) * HTB)
#define PG8_STGB(bufoff, gbase) do { _Pragma("unroll") for (int _i = 0; _i < 2; ++_i) \
        __builtin_amdgcn_global_load_lds((const unsigned*)((const char*)(gbase) + voffB[_i]), (LAS unsigned*)(lds + (bufoff) + ldsw + _i * 8192), 16, 0, 0); } while (0)
#define PG8_STGA(bufoff, gbase, VO, h) do { _Pragma("unroll") for (int _i = 0; _i < 2; ++_i) \
        __builtin_amdgcn_global_load_lds((const unsigned*)((const char*)(gbase) + VO[h][_i]), (LAS unsigned*)(lds + (bufoff) + ldsw + _i * 8192), 16, 0, 0); } while (0)
#define PG8_VOA(u, VO) do { _Pragma("unroll") for (int _h = 0; _h < 2; ++_h) _Pragma("unroll") for (int _i = 0; _i < 2; ++_i) \
        VO[_h][_i] = Sched::GATHER ? (S.row_off(u, _h * HALF + sR[_i]) + (unsigned)sC[_i] * 2u) : ((unsigned)((_h * HALF + sR[_i]) * K + sC[_i]) * 2u); } while (0)
#define PG8_LDA(dst, b, h) do { _Pragma("unroll") for (int m = 0; m < 4; ++m) { if constexpr (F8) { dst##8[m].lo = *(const LAS i32x4*)(lds + PG8_SA(b, h) + aoff + m * 2048); dst##8[m].hi = *(const LAS i32x4*)(lds + PG8_SA(b, h) + aoff + m * 2048 + 1024); } else { _Pragma("unroll") for (int k = 0; k < 2; ++k) dst[m][k] = *(const LAS bf16x8*)(lds + PG8_SA(b, h) + aoff + m * 2048 + k * 1024); } } } while (0)
#define PG8_LDB(dst, b, h) do { _Pragma("unroll") for (int n = 0; n < 2; ++n) { if constexpr (F8) { dst##8[n].lo = *(const LAS i32x4*)(lds + PG8_SB(b, h) + boff + n * 2048); dst##8[n].hi = *(const LAS i32x4*)(lds + PG8_SB(b, h) + boff + n * 2048 + 1024); } else { _Pragma("unroll") for (int k = 0; k < 2; ++k) dst[n][k] = *(const LAS bf16x8*)(lds + PG8_SB(b, h) + boff + n * 2048 + k * 1024); } } } while (0)
#define PG8_MMA(ai, bj, At, Bt) do { __builtin_amdgcn_s_setprio(1); _Pragma("unroll") for (int m = 0; m < 4; ++m) _Pragma("unroll") for (int n = 0; n < 2; ++n) { \
        if constexpr (F8) { asm volatile("v_mfma_scale_f32_16x16x128_f8f6f4 %0, %1, %2, %0, %3, %4 op_sel_hi:[0,0,0]" : "+v"(acc[ai][bj][m][n]) : "v"(Bt##8[n]), "v"(At##8[m]), "v"(scw_), "v"(sca_)); } \
        else { _Pragma("unroll") for (int k = 0; k < 2; ++k) acc[ai][bj][m][n] = __builtin_amdgcn_mfma_f32_16x16x32_bf16(Bt[n][k], At[m][k], acc[ai][bj][m][n], 0, 0, 0); } } \
        __builtin_amdgcn_s_setprio(0); } while (0)
#define PG8_WAIT_V(n) asm volatile("s_waitcnt vmcnt(" #n ")" ::: "memory")
#define PG8_WAIT_L(n) asm volatile("s_waitcnt lgkmcnt(" #n ")" ::: "memory")
#define PG8_BAR __builtin_amdgcn_s_barrier()
#define PG8_SCHED __builtin_amdgcn_sched_barrier(0)
    Unit cur, nxt; int ui = 0;
    if (!S.next(0, cur)) return;
    f32x4 acc[2][2][4][2];
#pragma unroll
    for (int a = 0; a < 2; ++a)
#pragma unroll
        for (int b = 0; b < 2; ++b)
#pragma unroll
            for (int m = 0; m < 4; ++m)
#pragma unroll
                for (int n = 0; n < 2; ++n) acc[a][b][m][n] = (f32x4){0.f, 0.f, 0.f, 0.f};
    const int scw_ = SCALE_W, sca_ = 127;
    bf16x8 At[4][2], B0[2][2], B1[2][2]; i32x8 At8[4], B08[2], B18[2];
    unsigned voA[2][2], nvoA[2][2];
    PG8_VOA(cur, voA);
    if (Sched::GATHER) { asm volatile("s_waitcnt vmcnt(0)" ::: "memory"); }
    const char* cA = S.a_ptr(cur); const char* cB = S.b_ptr(cur);
    cur.par = 0; E.stage_rows(cur, lds, wid);
    PG8_STGB(PG8_SB(0, 0), cB); PG8_STGB(PG8_SB(0, 1), cB + hstep); PG8_STGA(PG8_SA(0, 0), cA, voA, 0); PG8_STGA(PG8_SA(0, 1), cA, voA, 1);
    if (wr == 1) PG8_BAR;
    PG8_WAIT_V(2); PG8_BAR;
    PG8_STGB(PG8_SB(1, 0), cB + kstep); PG8_STGA(PG8_SA(1, 0), cA + kstep, voA, 0); PG8_STGB(PG8_SB(1, 1), cB + hstep + kstep);
    PG8_WAIT_V(6); PG8_BAR;
    for (;;) {
        const bool has_next = S.next(ui + 1, nxt); nxt.par = (ui + 1) & 3;
        const char* nA = has_next ? S.a_ptr(nxt) : cA; const char* nB = has_next ? S.b_ptr(nxt) : cB;
        if (Sched::GATHER) { if (has_next) { PG8_VOA(nxt, nvoA); } else {
#pragma unroll
            for (int h = 0; h < 2; ++h)
#pragma unroll
                for (int i = 0; i < 2; ++i) nvoA[h][i] = voA[h][i]; } }
#pragma unroll 1
        for (int t = 0; t < nt; t += 2) {
            const bool last = (t == nt - 2);
            const char* a1 = cA + (size_t)(t + 1) * kstep;
            const char* a2 = last ? nA : cA + (size_t)(t + 2) * kstep; const char* b2 = last ? nB : cB + (size_t)(t + 2) * kstep;
            const char* a3 = a2 + kstep; const char* b3 = b2 + kstep;
            unsigned vo2[2][2];
#pragma unroll
            for (int h = 0; h < 2; ++h)
#pragma unroll
                for (int i = 0; i < 2; ++i) vo2[h][i] = (Sched::GATHER && last) ? nvoA[h][i] : voA[h][i];
            if (last && has_next) E.stage_rows(nxt, lds, wid);
            PG8_LDB(B0, 0, 0); PG8_LDB(B1, 0, 1); PG8_SCHED; PG8_LDA(At, 0, 0); PG8_STGA(PG8_SA(1, 1), a1, voA, 1);
            PG8_WAIT_V(8); PG8_WAIT_L(0); PG8_BAR; PG8_MMA(0, 0, At, B0); PG8_MMA(0, 1, At, B1); PG8_BAR; PG8_SCHED;
            PG8_LDA(At, 0, 1); PG8_STGB(PG8_SB(0, 0), b2); PG8_STGB(PG8_SB(0, 1), b2 + hstep); PG8_STGA(PG8_SA(0, 0), a2, vo2, 0);
            PG8_WAIT_V(8); PG8_WAIT_L(0); PG8_BAR; PG8_MMA(1, 0, At, B0); PG8_MMA(1, 1, At, B1); PG8_BAR; PG8_SCHED;
            PG8_LDB(B0, 1, 0); PG8_LDB(B1, 1, 1); PG8_SCHED; PG8_LDA(At, 1, 0); PG8_STGA(PG8_SA(0, 1), a2, vo2, 1);
            PG8_WAIT_V(8); PG8_WAIT_L(0); PG8_BAR; PG8_MMA(0, 0, At, B0); PG8_MMA(0, 1, At, B1); PG8_BAR; PG8_SCHED;
            PG8_LDA(At, 1, 1); PG8_STGB(PG8_SB(1, 0), b3); PG8_STGB(PG8_SB(1, 1), b3 + hstep); PG8_STGA(PG8_SA(1, 0), a3, vo2, 0);
            PG8_WAIT_V(8); PG8_WAIT_L(0); PG8_BAR; PG8_MMA(1, 0, At, B0); PG8_MMA(1, 1, At, B1); PG8_BAR; PG8_SCHED;
        }
        if constexpr (F8) asm volatile("s_nop 15\n\ts_nop 15\n\ts_nop 15" ::: "memory");
        if constexpr (ALIGN_EPI) { if (wr == 0) PG8_BAR; }
        E(acc, cur, wr, wc, fr, fq);
        if (!has_next) break;
#pragma unroll
        for (int a = 0; a < 2; ++a)
#pragma unroll
            for (int b = 0; b < 2; ++b)
#pragma unroll
                for (int m = 0; m < 4; ++m)
#pragma unroll
                    for (int n = 0; n < 2; ++n) acc[a][b][m][n] = (f32x4){0.f, 0.f, 0.f, 0.f};
        cur = nxt; cA = nA; cB = nB; ++ui;
        if (Sched::GATHER) {
#pragma unroll
            for (int h = 0; h < 2; ++h)
#pragma unroll
                for (int i = 0; i < 2; ++i) voA[h][i] = nvoA[h][i]; }
        if constexpr (ALIGN_EPI) { if (wr == 1) PG8_BAR; }
    }
    PG8_WAIT_V(0);
    if constexpr (!ALIGN_EPI) { if (wr == 0) PG8_BAR; }
    PG8_BAR;
#undef PG8_SA
#undef PG8_SB
#undef PG8_STGA
#undef PG8_STGB
#undef PG8_VOA
#undef PG8_LDA
#undef PG8_LDB
#undef PG8_MMA
#undef PG8_WAIT_V
#undef PG8_WAIT_L
#undef PG8_BAR
#undef PG8_SCHED
}

typedef f32x4 Acc[2][2][4][2];
struct EpiInProj {
    static constexpr bool PERM = true;
    __device__ __forceinline__ void stage_rows(const Unit&, LAS unsigned char*, int) const {}
    bf16_t *prw, *puv, *pg;
    template <int ACT> __device__ __forceinline__ void tile(const Acc& acc, bf16_t* base, int ld, int row0, int col0) const {
#pragma unroll
        for (int ai = 0; ai < 2; ++ai)
#pragma unroll
            for (int m = 0; m < 4; ++m) { bf16_t* rowp = base + (size_t)(row0 + ai * HALF + m * 16) * ld + col0;
#pragma unroll
                for (int bj = 0; bj < 2; ++bj) { f32x4 v0 = acc[ai][bj][m][0], v1 = acc[ai][bj][m][1];
                    if (ACT == 1) {
#pragma unroll
                        for (int j = 0; j < 4; ++j) { v0[j] = gelu_tanh(v0[j]); v1[j] = gelu_tanh(v1[j]); } }
                    if (ACT == 2) {
#pragma unroll
                        for (int j = 0; j < 4; ++j) { v0[j] = sigmoidf_(v0[j]); v1[j] = sigmoidf_(v1[j]); } }
                    u32x4 w; w.x = pk2(v0[0], v0[1]); w.y = pk2(v0[2], v0[3]); w.z = pk2(v1[0], v1[1]); w.w = pk2(v1[2], v1[3]);
                    *(u32x4*)(rowp + bj * HALF) = w; }
                __builtin_amdgcn_sched_barrier(0); }
    }
    __device__ __forceinline__ void operator()(const Acc& acc, const Unit& u, int wr, int wc, int fr, int fq) const {
        const int row0 = u.row0 + wr * 64 + fr, cw = wc * 32 + 8 * fq;
        if (u.pn < 7) tile<0>(acc, prw, RWKV_COLS, row0, u.pn * 256 + cw);
        else if (u.pn < 11) tile<1>(acc, puv, 1024, row0, (u.pn - 7) * 256 + cw);
        else tile<2>(acc, pg, 2048, row0, (u.pn - 11) * 256 + cw);
    }
};
template <bool SECOND> struct EpiMerge {
    static constexpr bool PERM = true;
    __device__ __forceinline__ void stage_rows(const Unit&, LAS unsigned char*, int) const {}
    bf16_t* m1; const bf16_t* pg; unsigned char* m8;
    __device__ __forceinline__ void operator()(const Acc& acc, const Unit& u, int wr, int wc, int fr, int fq) const {
        const int row0 = u.row0 + wr * 64 + fr, col0 = u.pn * 256 + wc * 32 + 8 * fq;
#pragma unroll
        for (int ai = 0; ai < 2; ++ai)
#pragma unroll
            for (int m = 0; m < 4; ++m) { const size_t r = (size_t)(row0 + ai * HALF + m * 16);
#pragma unroll
                for (int bj = 0; bj < 2; ++bj) { const int c = col0 + bj * HALF;
                    const u32x4 g = *(const u32x4*)(pg + r * 2048 + (SECOND ? 1024 : 0) + c);
                    f32x4 v0 = acc[ai][bj][m][0], v1 = acc[ai][bj][m][1];
                    v0[0] *= bflo(g.x); v0[1] *= bfhi(g.x); v0[2] *= bflo(g.y); v0[3] *= bfhi(g.y); v1[0] *= bflo(g.z); v1[1] *= bfhi(g.z); v1[2] *= bflo(g.w); v1[3] *= bfhi(g.w);
                    if (SECOND) { const u32x4 p = *(const u32x4*)(m1 + r * 1024 + c);
                        v0[0] += bflo(p.x); v0[1] += bfhi(p.x); v0[2] += bflo(p.y); v0[3] += bfhi(p.y); v1[0] += bflo(p.z); v1[1] += bfhi(p.z); v1[2] += bflo(p.w); v1[3] += bfhi(p.w); }
                    if (SECOND) *(u32x2*)(m8 + r * 1024 + c) = pk8(v0, v1);
                    else { u32x4 w; w.x = pk2(v0[0], v0[1]); w.y = pk2(v0[2], v0[3]); w.z = pk2(v1[0], v1[1]); w.w = pk2(v1[2], v1[3]); *(u32x4*)(m1 + r * 1024 + c) = w; } }
                __builtin_amdgcn_sched_barrier(0); }
    }
};
struct EpiResid {
    static constexpr bool PERM = false;
    __device__ __forceinline__ void stage_rows(const Unit&, LAS unsigned char*, int) const {}
    float* out; const float* base; const float* gate;
    __device__ __forceinline__ void operator()(const Acc& acc, const Unit& u, int wr, int wc, int fr, int fq) const {
        const int row0 = u.row0 + wr * 64 + fr, col0 = u.pn * 256 + wc * 32 + 4 * fq;
        const float* gp = gate + (size_t)(u.row0 >> 13) * 6144 + col0;
        f32x4 gv[2][2];
#pragma unroll
        for (int bj = 0; bj < 2; ++bj)
#pragma unroll
            for (int n = 0; n < 2; ++n) gv[bj][n] = *(const f32x4*)(gp + bj * HALF + n * 16);
#pragma unroll
        for (int ai = 0; ai < 2; ++ai)
#pragma unroll
            for (int m = 0; m < 4; ++m) { const size_t ro = (size_t)(row0 + ai * HALF + m * 16) * 1024 + col0;
#pragma unroll
                for (int bj = 0; bj < 2; ++bj)
#pragma unroll
                    for (int n = 0; n < 2; ++n) { const f32x4 b = *(const f32x4*)(base + ro + bj * HALF + n * 16);
                        *(f32x4*)(out + ro + bj * HALF + n * 16) = b + gv[bj][n] * acc[ai][bj][m][n]; } }
    }
};
struct EpiRouter {
    static constexpr bool PERM = false;
    __device__ __forceinline__ void stage_rows(const Unit&, LAS unsigned char*, int) const {}
    float* sc;
    __device__ __forceinline__ void operator()(const Acc& acc, const Unit& u, int wr, int wc, int fr, int fq) const {
        const int row0 = u.row0 + wr * 64 + fr, col0 = wc * 32 + 4 * fq;
#pragma unroll
        for (int ai = 0; ai < 2; ++ai)
#pragma unroll
            for (int m = 0; m < 4; ++m) { float* rowp = sc + (size_t)(row0 + ai * HALF + m * 16) * 256 + col0;
#pragma unroll
                for (int bj = 0; bj < 2; ++bj)
#pragma unroll
                    for (int n = 0; n < 2; ++n) { f32x4 v = acc[ai][bj][m][n];
#pragma unroll
                        for (int j = 0; j < 4; ++j) v[j] = sigmoidf_(v[j]);
                        *(f32x4*)(rowp + bj * HALF + n * 16) = v; }
                __builtin_amdgcn_sched_barrier(0); }
    }
};
template <bool F8OUT> struct EpiGateUp {
    static constexpr bool PERM = true;
    __device__ __forceinline__ void stage_rows(const Unit&, LAS unsigned char*, int) const {}
    void* hid;
    __device__ __forceinline__ void operator()(const Acc& acc, const Unit& u, int wr, int wc, int fr, int fq) const {
        const int row0 = u.row0 + wr * 64 + fr, col0 = u.pn * HALF + wc * 32 + 8 * fq;
#pragma unroll
        for (int ai = 0; ai < 2; ++ai)
#pragma unroll
            for (int m = 0; m < 4; ++m) { const size_t off = (size_t)(row0 + ai * HALF + m * 16) * EFF + col0;
                f32x4 v0, v1;
#pragma unroll
                for (int j = 0; j < 4; ++j) { v0[j] = siluf_(acc[ai][0][m][0][j]) * acc[ai][1][m][0][j]; v1[j] = siluf_(acc[ai][0][m][1][j]) * acc[ai][1][m][1][j]; }
                if constexpr (F8OUT) *(u32x2*)((unsigned char*)hid + off) = pk8(v0, v1);
                else { u32x4 w; w.x = pk2(v0[0], v0[1]); w.y = pk2(v0[2], v0[3]); w.z = pk2(v1[0], v1[1]); w.w = pk2(v1[2], v1[3]); *(u32x4*)((bf16_t*)hid + off) = w; }
                __builtin_amdgcn_sched_barrier(0); }
    }
};
struct EpiExpertDown {
    static constexpr bool PERM = true;
    unsigned char* slot; const int* rowdst; const float* roww;
    __device__ __forceinline__ void stage_rows(const Unit& u, LAS unsigned char* lds, int wid) const {
        if (wid < 4) { const int lane = threadIdx.x & 63; LAS unsigned char* base = lds + LDS_MISC + u.par * 2048 + wid * 256;
            __builtin_amdgcn_global_load_lds((const unsigned*)(rowdst + u.row0 + wid * 64 + lane), (LAS unsigned*)base, 4, 0, 0);
            __builtin_amdgcn_global_load_lds((const unsigned*)(roww + u.row0 + wid * 64 + lane), (LAS unsigned*)(base + 1024), 4, 0, 0); }
    }
    __device__ __forceinline__ void operator()(const Acc& acc, const Unit& u, int wr, int wc, int fr, int fq) const {
        const unsigned cb = (unsigned)(u.pn * 256 + wc * 32 + 8 * fq);
        const LAS int* td = (const LAS int*)((LAS unsigned char*)nullptr + LDS_MISC + u.par * 2048) + wr * 64 + fr; const LAS float* tw = (const LAS float*)(td + 256);
#pragma unroll
        for (int ai = 0; ai < 2; ++ai)
#pragma unroll
            for (int m = 0; m < 4; ++m) {
                const int dst = td[ai * HALF + m * 16]; const float ws_ = tw[ai * HALF + m * 16];
                if (dst >= 0) { unsigned char* rowp = slot + (size_t)((unsigned)dst * 1024u + cb);
#pragma unroll
                    for (int bj = 0; bj < 2; ++bj) { const f32x4 v0 = acc[ai][bj][m][0] * ws_, v1 = acc[ai][bj][m][1] * ws_;
                        *(u32x2*)(rowp + bj * HALF) = pk8(v0, v1); } }
                __builtin_amdgcn_sched_barrier(0);
            }
    }
};
struct EpiSharedDown {
    static constexpr bool PERM = true;
    unsigned char* sho;
    __device__ __forceinline__ void stage_rows(const Unit&, LAS unsigned char*, int) const {}
    __device__ __forceinline__ void operator()(const Acc& acc, const Unit& u, int wr, int wc, int fr, int fq) const {
        const int row0 = u.row0 + wr * 64 + fr, col0 = u.pn * 256 + wc * 32 + 8 * fq;
#pragma unroll
        for (int ai = 0; ai < 2; ++ai)
#pragma unroll
            for (int m = 0; m < 4; ++m) { unsigned char* rowp = sho + (size_t)(row0 + ai * HALF + m * 16) * 1024 + col0;
#pragma unroll
                for (int bj = 0; bj < 2; ++bj) *(u32x2*)(rowp + bj * HALF) = pk8(acc[ai][bj][m][0], acc[ai][bj][m][1]);
                __builtin_amdgcn_sched_barrier(0); }
    }
};
}
__device__ __forceinline__ void phase_mod(const float* c, const float* ada_w, const float* ada_b, float* mod, LAS unsigned char* lds, int tid, int G) {
    LAS float* sl = (LAS float*)lds; LAS float* red = (LAS float*)(lds + 32768);
    for (int i = tid; i < NB * D; i += NTHREADS) { const float v = c[i]; sl[i] = siluf_(v); }
    __syncthreads();
    const int cl = tid % 24, kg = tid / 24;
    for (int cb = blockIdx.x; cb < 256; cb += G) {
        const int col0 = cb * 24;
        if (tid < 384) {
            float a[NB];
#pragma unroll
            for (int b = 0; b < NB; ++b) a[b] = 0.f;
            for (int k = kg; k < D; k += 16) { const float w = ada_w[(size_t)k * 6144 + col0 + cl];
#pragma unroll
                for (int b = 0; b < NB; ++b) a[b] += sl[b * D + k] * w; }
#pragma unroll
            for (int b = 0; b < NB; ++b) red[(kg * 24 + cl) * NB + b] = a[b];
        }
        __syncthreads();
        if (tid < 192) { const int c2 = tid >> 3, b = tid & 7; float s = 0.f;
#pragma unroll
            for (int g = 0; g < 16; ++g) s += red[(g * 24 + c2) * NB + b];
            mod[(size_t)b * 6144 + col0 + c2] = s + ada_b[col0 + c2]; }
        __syncthreads();
    }
}
__device__ __forceinline__ void transpose_item(const float* W, int ldw, int k0, int n0, bf16_t* WT, int ldt, int drow0, LAS float* scr, int lane) {
#pragma unroll 8
    for (int i = 0; i < 32; ++i) { const int kk = 2 * i + (lane >> 5); scr[kk * 33 + (lane & 31)] = W[(size_t)(k0 + kk) * ldw + n0 + (lane & 31)]; }
    LDS_WAIT(); asm volatile("" ::: "memory");
    const int c = lane & 7;
#pragma unroll
    for (int j = 0; j < 4; ++j) { const int n = (lane >> 3) + 8 * j; const LAS float* s = scr + (8 * c) * 33 + n;
        u32x4 o; o.x = pk2(s[0 * 33], s[1 * 33]); o.y = pk2(s[2 * 33], s[3 * 33]); o.z = pk2(s[4 * 33], s[5 * 33]); o.w = pk2(s[6 * 33], s[7 * 33]);
        *(u32x4*)(WT + (size_t)(drow0 + n) * ldt + k0 + 8 * c) = o; }
    LDS_WAIT(); asm volatile("" ::: "memory");
}
__device__ __forceinline__ void transpose_job(const float* W, int K, int N, bf16_t* WT, int gated, int goff, int item, LAS float* scr, int lane) {
    const int nblk = N / 32, kb = item / nblk, nb = item % nblk, n0 = 32 * nb;
    const int drow0 = gated ? (256 * (n0 >> 7) + goff + (n0 & 127)) : n0;
    transpose_item(W, N, 64 * kb, n0, WT, K, drow0, scr, lane);
}
__device__ __forceinline__ void transpose_item64(const float* W, int ldw, int k0, int n0, bf16_t* WT, int ldt, int drow0, LAS float* scr, int lane) {
    f32x4 v[16];
    const int c4 = lane & 15, r4 = lane >> 4;
#pragma unroll
    for (int i = 0; i < 16; ++i) v[i] = *(const f32x4*)(W + (size_t)(k0 + 4 * i + r4) * ldw + n0 + 4 * c4);
#pragma unroll
    for (int i = 0; i < 16; ++i) { LAS float* d = scr + (4 * i + r4) * 65 + 4 * c4; d[0] = v[i].x; d[1] = v[i].y; d[2] = v[i].z; d[3] = v[i].w; }
    LDS_WAIT(); asm volatile("" ::: "memory");
    const int c = lane & 7;
#pragma unroll
    for (int j = 0; j < 8; ++j) { const int n = (lane >> 3) + 8 * j; const LAS float* s = scr + (8 * c) * 65 + n;
        u32x4 o; o.x = pk2(s[0 * 65], s[1 * 65]); o.y = pk2(s[2 * 65], s[3 * 65]); o.z = pk2(s[4 * 65], s[5 * 65]); o.w = pk2(s[6 * 65], s[7 * 65]);
        *(u32x4*)(WT + (size_t)(drow0 + n) * ldt + k0 + 8 * c) = o; }
    LDS_WAIT(); asm volatile("" ::: "memory");
}
constexpr float WSCALE = 32.0f;
__device__ __forceinline__ void transpose_item64_f8(const float* W, int ldw, int k0, int n0, unsigned char* WT8, int ldt, int drow0, LAS float* scr, int lane) {
    f32x4 v[16];
    const int c4 = lane & 15, r4 = lane >> 4;
#pragma unroll
    for (int i = 0; i < 16; ++i) v[i] = *(const f32x4*)(W + (size_t)(k0 + 4 * i + r4) * ldw + n0 + 4 * c4);
#pragma unroll
    for (int i = 0; i < 16; ++i) { LAS float* d = scr + (4 * i + r4) * 65 + 4 * c4; d[0] = v[i].x; d[1] = v[i].y; d[2] = v[i].z; d[3] = v[i].w; }
    LDS_WAIT(); asm volatile("" ::: "memory");
    const int c = lane & 7;
#pragma unroll
    for (int j = 0; j < 8; ++j) { const int n = (lane >> 3) + 8 * j; const LAS float* s = scr + (8 * c) * 65 + n;
        const f32x4 lo = (f32x4){s[0 * 65], s[1 * 65], s[2 * 65], s[3 * 65]} * WSCALE, hi = (f32x4){s[4 * 65], s[5 * 65], s[6 * 65], s[7 * 65]} * WSCALE;
        *(u32x2*)(WT8 + (size_t)(drow0 + n) * ldt + k0 + 8 * c) = pk8(lo, hi); }
    LDS_WAIT(); asm volatile("" ::: "memory");
}
struct SmallW { const float *w_in, *w_out_a, *w_out_b, *w_out, *router_w, *sw1, *sw3, *sw2, *w_up, *a_up, *g_up, *gws; };
__device__ __forceinline__ void phase_small_weights(const SmallW& P, unsigned char* ws, LAS unsigned char* lds, int gw, int NGW, int wave, int lane) {
    LAS float* scr = (LAS float*)(lds + wave * 16640);
    constexpr int I0 = 16 * 76, I1 = 8 * 16, I2 = 8 * 16, I3 = 16 * 16, I4 = 16 * 8, I5 = 16 * 8, I6 = 16 * 8, I7 = 4 * 32, I8 = 16, I9 = 16, I10 = 2 * 16;
    constexpr int NIT = I0 + I1 + I2 + I3 + I4 + I5 + I6 + I7 + I8 + I9 + I10;
    for (int it = gw; it < NIT; it += NGW) {
        int r = it;
        if (r < I0) { const int kb = r / 76, nb = r % 76; transpose_item64_f8(P.w_in, IN_COLS, 64 * kb, 64 * nb, ws + SW_WIN, D, 64 * nb, scr, lane); continue; } r -= I0;
        if (r < I1) { transpose_item64_f8(P.w_out_a, D, 64 * (r >> 4), 64 * (r & 15), ws + SW_WOA, RW, 64 * (r & 15), scr, lane); continue; } r -= I1;
        if (r < I2) { transpose_item64_f8(P.w_out_b, D, 64 * (r >> 4), 64 * (r & 15), ws + SW_WOB, RW, 64 * (r & 15), scr, lane); continue; } r -= I2;
        if (r < I3) { transpose_item64_f8(P.w_out, D, 64 * (r >> 4), 64 * (r & 15), ws + SW_WO, D, 64 * (r & 15), scr, lane); continue; } r -= I3;
        if (r < I4) { transpose_job(P.router_w, D, NE, (bf16_t*)(ws + SW_WR), 0, 0, r, scr, lane); continue; } r -= I4;
        if (r < I5) { transpose_job(P.sw1, D, EFF, (bf16_t*)(ws + SW_WS13), 1, 0, r, scr, lane); continue; } r -= I5;
        if (r < I6) { transpose_job(P.sw3, D, EFF, (bf16_t*)(ws + SW_WS13), 1, 128, r, scr, lane); continue; } r -= I6;
        if (r < I7) { transpose_job(P.sw2, EFF, D, (bf16_t*)(ws + SW_WS2), 0, 0, r, scr, lane); continue; } r -= I7;
        if (r < I8) { transpose_job(P.w_up, 64, RW, (bf16_t*)(ws + SW_WUP), 0, 0, r, scr, lane); continue; } r -= I8;
        if (r < I9) { transpose_job(P.a_up, 64, RW, (bf16_t*)(ws + SW_AUP), 0, 0, r, scr, lane); continue; } r -= I9;
        transpose_job(P.g_up, 128, RW, (bf16_t*)(ws + SW_GUP), 0, 0, r, scr, lane);
    }
    bf16_t* wsm = (bf16_t*)(ws + SW_WSM);
    for (int i = gw * 64 + lane; i < 8 * 128 * 128; i += NGW * 64) { const int col = i & 127, row = (i >> 7) & 127; wsm[i] = (col <= row) ? f2bf(P.gws[i]) : (bf16_t)0; }
}
__device__ __forceinline__ void phase_expert_weights(const float* w1, const float* w3, const float* w2, unsigned char* ws, LAS unsigned char* lds, int gw, int NGW, int wave, int lane) {
    LAS float* scr = (LAS float*)(lds + wave * 16640);
    constexpr int PER = 64;
    for (int it = gw; it < NE * 3 * PER; it += NGW) {
        const int e = it / (3 * PER), r = it % (3 * PER), which = r / PER, item = r % PER;
        if (which < 2) { const int kb = item >> 2, nb = item & 3, n0 = 64 * nb;
            transpose_item64_f8((which ? w3 : w1) + (size_t)e * D * EFF, EFF, 64 * kb, n0, ws + B_W13 + (size_t)e * 512 * D, D, 256 * (n0 >> 7) + which * 128 + (n0 & 127), scr, lane); }
        else { const int kb = item >> 4, nb = item & 15;
            transpose_item64_f8(w2 + (size_t)e * EFF * D, D, 64 * kb, 64 * nb, ws + B_W2 + (size_t)e * D * EFF, EFF, 64 * nb, scr, lane); }
    }
}
__device__ __forceinline__ void phase_norm_mod(const float* X, const float* gain, const float* mod, int sh_off, int sc_off, bf16_t* out, unsigned char* out8, int gw, int NGW, int lane) {
    constexpr int R = 4;
    for (int m0 = gw; m0 < T; m0 += R * NGW) {
        f32x4 v[R][4];
#pragma unroll
        for (int rr = 0; rr < R; ++rr) { const int m = m0 + rr * NGW; const f32x4* xr = (const f32x4*)(X + (size_t)(m < T ? m : m0) * D) + lane;
#pragma unroll
            for (int j = 0; j < 4; ++j) v[rr][j] = xr[64 * j]; }
#pragma unroll
        for (int rr = 0; rr < R; ++rr) { const int m = m0 + rr * NGW; if (m >= T) break;
            float ss = 0.f;
#pragma unroll
            for (int j = 0; j < 4; ++j) ss += (v[rr][j].x * v[rr][j].x + v[rr][j].y * v[rr][j].y) + (v[rr][j].z * v[rr][j].z + v[rr][j].w * v[rr][j].w);
            const float rstd = __builtin_amdgcn_rsqf(wave_sum(ss) * (1.f / D) + 1e-6f);
            const float* mb = mod + (size_t)(m >> 13) * 6144;
            u32x2* o8 = (u32x2*)(out + (size_t)m * D) + lane;
#pragma unroll
            for (int j = 0; j < 4; ++j) { const int col = 4 * lane + 256 * j;
                const f32x4 g = *(const f32x4*)(gain + col), sc = *(const f32x4*)(mb + sc_off + col), sh = *(const f32x4*)(mb + sh_off + col);
                const f32x4 y = v[rr][j] * rstd * g * (sc + 1.0f) + sh;
                if (out) { u32x2 w; w.x = pk2(y.x, y.y); w.y = pk2(y.z, y.w); o8[64 * j] = w; }
                if (out8) { int t8 = __builtin_amdgcn_cvt_pk_fp8_f32(y.x, y.y, 0, false); t8 = __builtin_amdgcn_cvt_pk_fp8_f32(y.z, y.w, t8, true); *(unsigned*)(out8 + (size_t)m * D + col) = (unsigned)t8; } } }
    }
}
struct YaArgs { bf16_t* ya; const bf16_t* g; const bf16_t* prw; const float* sbon; const float* mu; const float* ln_g; const float* ln_b; };
__device__ __forceinline__ void phase_ya_final(const YaArgs& P, int gw, int NGW, int lane) {
    const int ch0 = lane * 8, head = lane >> 3;
    float muv[8], lg[8], lb[8];
#pragma unroll
    for (int j = 0; j < 8; ++j) { muv[j] = P.mu[1024 + ch0 + j]; lg[j] = P.ln_g[ch0 + j]; lb[j] = P.ln_b[ch0 + j]; }
    for (int m = gw; m < T; m += NGW) {
        const u32x4 yw = *(const u32x4*)(P.ya + (size_t)m * RW + ch0);
        const u32x4 gw4 = *(const u32x4*)(P.g + (size_t)m * RW + ch0);
        const u32x4 vc = *(const u32x4*)(P.prw + (size_t)m * RWKV_COLS + 1024 + ch0);
        u32x4 vp = (u32x4){0u, 0u, 0u, 0u};
        if ((m & (SEQ - 1)) != 0) vp = *(const u32x4*)(P.prw + (size_t)(m - 1) * RWKV_COLS + 1024 + ch0);
        const float sb = P.sbon[(size_t)m * NH + head];
        float y[8], gg[8], vv[8], pv[8];
        y[0] = bflo(yw.x); y[1] = bfhi(yw.x); y[2] = bflo(yw.y); y[3] = bfhi(yw.y); y[4] = bflo(yw.z); y[5] = bfhi(yw.z); y[6] = bflo(yw.w); y[7] = bfhi(yw.w);
        gg[0] = bflo(gw4.x); gg[1] = bfhi(gw4.x); gg[2] = bflo(gw4.y); gg[3] = bfhi(gw4.y); gg[4] = bflo(gw4.z); gg[5] = bfhi(gw4.z); gg[6] = bflo(gw4.w); gg[7] = bfhi(gw4.w);
        vv[0] = bflo(vc.x); vv[1] = bfhi(vc.x); vv[2] = bflo(vc.y); vv[3] = bfhi(vc.y); vv[4] = bflo(vc.z); vv[5] = bfhi(vc.z); vv[6] = bflo(vc.w); vv[7] = bfhi(vc.w);
        pv[0] = bflo(vp.x); pv[1] = bfhi(vp.x); pv[2] = bflo(vp.y); pv[3] = bfhi(vp.y); pv[4] = bflo(vp.z); pv[5] = bfhi(vp.z); pv[6] = bflo(vp.w); pv[7] = bfhi(vp.w);
        float s = 0.f;
#pragma unroll
        for (int j = 0; j < 8; ++j) s += y[j];
        s += __shfl_xor(s, 1); s += __shfl_xor(s, 2); s += __shfl_xor(s, 4);
        const float mean = s * (1.f / 64.f); float q = 0.f;
#pragma unroll
        for (int j = 0; j < 8; ++j) { y[j] -= mean; q += y[j] * y[j]; }
        q += __shfl_xor(q, 1); q += __shfl_xor(q, 2); q += __shfl_xor(q, 4);
        const float rstd = __builtin_amdgcn_rsqf(q * (1.f / 64.f) + 64e-5f);
        float o[8];
#pragma unroll
        for (int j = 0; j < 8; ++j) { const float vs = vv[j] + (pv[j] - vv[j]) * muv[j]; o[j] = (y[j] * rstd * lg[j] + lb[j] + sb * vs) * gg[j]; }
        u32x4 w; w.x = pk2(o[0], o[1]); w.y = pk2(o[2], o[3]); w.z = pk2(o[4], o[5]); w.w = pk2(o[6], o[7]);
        *(u32x4*)(P.ya + (size_t)m * RW + ch0) = w;
    }
}
__device__ __forceinline__ void phase_xs(const bf16_t* prw, const float* mu, bf16_t* xs, int gw, int NGW, int lane) {
    const f32x4 m4 = *(const f32x4*)(mu + 1536 + 4 * lane);
    for (int t = gw; t < T; t += NGW) {
        const bf16_t* src = prw + (size_t)t * RWKV_COLS + 1536 + 4 * lane;
        const u32x2 cw = *(const u32x2*)src; u32x2 pw = (u32x2){0u, 0u};
        if ((t & (SEQ - 1)) != 0) pw = *(const u32x2*)(src - RWKV_COLS);
        f32x4 v = (f32x4){bflo(cw.x), bfhi(cw.x), bflo(cw.y), bfhi(cw.y)}; const f32x4 p = (f32x4){bflo(pw.x), bfhi(pw.x), bflo(pw.y), bfhi(pw.y)};
        v = v + (p - v) * m4;
        if (lane < 16) {
#pragma unroll
            for (int j = 0; j < 4; ++j) v[j] = tanhf_(v[j]); }
        else if (lane >= 32) {
#pragma unroll
            for (int j = 0; j < 4; ++j) v[j] = sigmoidf_(v[j]); }
        u32x2 w; w.x = pk2(v[0], v[1]); w.y = pk2(v[2], v[3]);
        *(u32x2*)(xs + (size_t)t * 256 + 4 * lane) = w;
    }
}
__device__ __forceinline__ void phase_combine(float* out, const unsigned char* slot, const unsigned char* sho, const float* mod, const float* normf, int gw, int NGW, int lane) {
    for (int m = gw; m < T; m += NGW) {
        const int b = m >> 13;
        f32x4* xr = (f32x4*)(out + (size_t)m * D + 16 * lane);
        const float* g2 = mod + (size_t)b * 6144 + 5120 + 16 * lane;
        u32x4 sw[TOPK + 1];
#pragma unroll
        for (int k = 0; k < TOPK; ++k) sw[k] = *(const u32x4*)(slot + ((size_t)m * TOPK + k) * D + 16 * lane);
        sw[TOPK] = *(const u32x4*)(sho + (size_t)m * D + 16 * lane);
        f32x4 x[4];
#pragma unroll
        for (int j = 0; j < 4; ++j) x[j] = xr[j];
        f32x4 a[4];
#pragma unroll
        for (int j = 0; j < 4; ++j) a[j] = (f32x4){0.f, 0.f, 0.f, 0.f};
#pragma unroll
        for (int k = 0; k <= TOPK; ++k) { a[0] += up8(sw[k].x); a[1] += up8(sw[k].y); a[2] += up8(sw[k].z); a[3] += up8(sw[k].w); }
        float ss = 0.f;
#pragma unroll
        for (int j = 0; j < 4; ++j) { x[j] = x[j] + *(const f32x4*)(g2 + 4 * j) * a[j]; ss += (x[j].x * x[j].x + x[j].y * x[j].y) + (x[j].z * x[j].z + x[j].w * x[j].w); }
        const float rstd = __builtin_amdgcn_rsqf(wave_sum(ss) * (1.f / D) + 1e-6f);
#pragma unroll
        for (int j = 0; j < 4; ++j) xr[j] = x[j] * rstd * *(const f32x4*)(normf + 16 * lane + 4 * j);
    }
}
namespace rk {
constexpr int LD = 72;
constexpr int SLOTB = 64 * LD * 2;
constexpr int LDG = 136;
typedef LAS bf16_t* lp;
__device__ __forceinline__ lp slot(LAS unsigned char* lds, int i) { return (lp)(lds + i * SLOTB); }
template <int KS>
__device__ __forceinline__ void mm_nt(const LAS bf16_t* X, int ldx, const LAS bf16_t* Y, int ldy, int m, int nt0, int r, int q, f32x4 (&acc)[2]) {
#pragma unroll
    for (int s = 0; s < KS; ++s) {
        const bf16x8 a = *(const LAS bf16x8*)(X + (16 * m + r) * ldx + 32 * s + 8 * q);
#pragma unroll
        for (int n = 0; n < 2; ++n) { const bf16x8 b = *(const LAS bf16x8*)(Y + (16 * (nt0 + n) + r) * ldy + 32 * s + 8 * q); acc[n] = __builtin_amdgcn_mfma_f32_16x16x32_bf16(a, b, acc[n], 0, 0, 0); }
    }
}
__device__ __forceinline__ void st_rm(lp dst, int m, int nt, int r, int q, const f32x4& a) {
#pragma unroll
    for (int ii = 0; ii < 4; ++ii) dst[(16 * m + 4 * q + ii) * LD + 16 * nt + r] = f2bf(a[ii]);
}
__device__ __forceinline__ void st_tr(lp dst, int m, int nt, int r, int q, const f32x4& a) {
    u32x2 w; w.x = pk2(a[0], a[1]); w.y = pk2(a[2], a[3]); *(LAS u32x2*)(dst + (16 * nt + r) * LD + 16 * m + 4 * q) = w;
}
__device__ __forceinline__ void ld_rm(const LAS bf16_t* src, int m, int nt, int r, int q, f32x4& a) {
#pragma unroll
    for (int ii = 0; ii < 4; ++ii) a[ii] = bf2f(src[(16 * m + 4 * q + ii) * LD + 16 * nt + r]);
}
struct Args {
    const bf16_t* prw; const float* mu; const float *w0, *a0, *k_k, *k_a, *r_k;
    const bf16_t *wup, *aup, *gup;
    const bf16_t* xs;
    bf16_t* g; bf16_t* bv; unsigned char* mn; unsigned char* qy;
};
constexpr int LDS_MU = 155904;
struct Pre { u32x4 cw[3], pw[3]; bf16x8 xs[8]; };
__device__ __forceinline__ void task_map(int task, int h, int& i, int& ch, int& col) {
    i = task / 24; ch = task % 24;
    col = (ch >> 3) * 512 + h * 64 + 8 * (ch & 7);
}
__device__ __forceinline__ void load_mu(const Args& P, LAS unsigned char* lds, int tid) {
    LAS float* MU = (LAS float*)(lds + LDS_MU);
    for (int i = tid; i < RWKV_COLS; i += NTHREADS) MU[i] = P.mu[i];
    __syncthreads();
}
__device__ __forceinline__ void prefetch(const Args& P, int b, int h, int c, int tid, Pre& pre) {
    const int t0 = b * SEQ + c * 64;
#pragma unroll
    for (int it = 0; it < 3; ++it) {
        int i, ch, col; task_map(tid + it * NTHREADS, h, i, ch, col);
        const bf16_t* src = P.prw + (size_t)(t0 + i) * RWKV_COLS + col;
        pre.cw[it] = *(const u32x4*)src;
        pre.pw[it] = (u32x4){0u, 0u, 0u, 0u};
        if (i != 0 || c != 0) pre.pw[it] = *(const u32x4*)(src - RWKV_COLS);
    }
    const int lane = tid & 63, r = lane & 15, q = lane >> 4, m = (tid >> 6) & 3;
    const bf16_t* xr = P.xs + (size_t)(t0 + 16 * m + r) * 256 + 8 * q;
#pragma unroll
    for (int f = 0; f < 8; ++f) pre.xs[f] = *(const bf16x8*)(xr + 32 * f);
}
__device__ __forceinline__ void unit(const Args& P, LAS unsigned char* lds, int b, int h, int c, int uidx, int tid, Pre& pf, bool has_next, int nb, int nh_, int nc) {
    const int wave = __builtin_amdgcn_readfirstlane(tid >> 6), lane = tid & 63, r = lane & 15, q = lane >> 4, m = wave & 3, nh = wave >> 2;
    const int t0 = b * SEQ + c * 64;
    lp S0 = slot(lds, 0), S1 = slot(lds, 1), S2 = slot(lds, 2), S3 = slot(lds, 3), S4 = slot(lds, 4), S5 = slot(lds, 5), S6 = slot(lds, 6), S7 = slot(lds, 7);
    lp S8 = slot(lds, 8), S9 = slot(lds, 9), S10 = slot(lds, 10), S11 = slot(lds, 11), S12 = slot(lds, 12), S13 = slot(lds, 13), S14 = slot(lds, 14), S15 = slot(lds, 15);
    LAS float* PART = (LAS float*)(lds + LDS_MISC);
    LAS float* CT = PART + 256;
    LAS float* DEND = CT + 256;
    const LAS float* MU = (const LAS float*)(lds + LDS_MU);
#define RK_BAR() do { asm volatile("s_waitcnt lgkmcnt(0)" ::: "memory"); __builtin_amdgcn_s_barrier(); asm volatile("" ::: "memory"); } while (0)
#define RK_DBG(bit, sp) do {} while (0)
#pragma unroll
    for (int it = 0; it < 3; ++it) {
        int i, ch, col; task_map(tid + it * NTHREADS, h, i, ch, col);
        LAS bf16_t* dst = slot(lds, 8 + (ch >> 3)) + i * LD + 8 * (ch & 7);
        const u32x4 cw = pf.cw[it], pw = pf.pw[it];
        const f32x4 m0 = *(const LAS f32x4*)(MU + col), m1 = *(const LAS f32x4*)(MU + col + 4);
        float v[8], p[8];
        v[0] = bflo(cw.x); v[1] = bfhi(cw.x); v[2] = bflo(cw.y); v[3] = bfhi(cw.y); v[4] = bflo(cw.z); v[5] = bfhi(cw.z); v[6] = bflo(cw.w); v[7] = bfhi(cw.w);
        p[0] = bflo(pw.x); p[1] = bfhi(pw.x); p[2] = bflo(pw.y); p[3] = bfhi(pw.y); p[4] = bflo(pw.z); p[5] = bfhi(pw.z); p[6] = bflo(pw.w); p[7] = bfhi(pw.w);
#pragma unroll
        for (int j = 0; j < 4; ++j) { v[j] += (p[j] - v[j]) * m0[j]; v[4 + j] += (p[4 + j] - v[4 + j]) * m1[j]; }
        u32x4 w; w.x = pk2(v[0], v[1]); w.y = pk2(v[2], v[3]); w.z = pk2(v[4], v[5]); w.w = pk2(v[6], v[7]);
        *(LAS u32x4*)dst = w;
    }
    RK_BAR();
    f32x4 aw[2], aa[2], ag[2];
#pragma unroll
    for (int n = 0; n < 2; ++n) { aw[n] = (f32x4){0.f, 0.f, 0.f, 0.f}; aa[n] = aw[n]; ag[n] = aw[n]; }
#pragma unroll
    for (int s = 0; s < 2; ++s) {
#pragma unroll
        for (int n = 0; n < 2; ++n) { const int row = h * 64 + 16 * (2 * nh + n) + r;
            const bf16x8 bw = *(const bf16x8*)(P.wup + (size_t)row * 64 + 32 * s + 8 * q), ba = *(const bf16x8*)(P.aup + (size_t)row * 64 + 32 * s + 8 * q);
            aw[n] = __builtin_amdgcn_mfma_f32_16x16x32_bf16(pf.xs[s], bw, aw[n], 0, 0, 0); aa[n] = __builtin_amdgcn_mfma_f32_16x16x32_bf16(pf.xs[2 + s], ba, aa[n], 0, 0, 0); }
    }
#pragma unroll
    for (int s = 0; s < 4; ++s) {
#pragma unroll
        for (int n = 0; n < 2; ++n) { const int row = h * 64 + 16 * (2 * nh + n) + r;
            const bf16x8 bg = *(const bf16x8*)(P.gup + (size_t)row * 128 + 32 * s + 8 * q);
            ag[n] = __builtin_amdgcn_mfma_f32_16x16x32_bf16(pf.xs[4 + s], bg, ag[n], 0, 0, 0); }
    }
    if (has_next) prefetch(P, nb, nh_, nc, tid, pf);
    float rr[2][4], kq[2][4], vv[2][4], av[2][4], lw[2][4], kp[2][4], pre[2][4], preq[2];
    float ss[4] = {0.f, 0.f, 0.f, 0.f}, bs[4] = {0.f, 0.f, 0.f, 0.f};
#pragma unroll
    for (int n = 0; n < 2; ++n) {
        const int ch = 32 * nh + 16 * n + r, chg = h * 64 + ch;
        const float w0v = P.w0[chg], a0v = P.a0[chg], kkc = P.k_k[chg], kac = P.k_a[chg], rkc = P.r_k[chg];
#pragma unroll
        for (int ii = 0; ii < 4; ++ii) {
            const int pos = 16 * m + 4 * q + ii;
            const float rv = bf2f(S8[pos * LD + ch]), kraw = bf2f(S9[pos * LD + ch]); vv[n][ii] = bf2f(S10[pos * LD + ch]); rr[n][ii] = rv;
            const float z = -(w0v + aw[n][ii]);
            const float sp = fmaxf(z, 0.f) + flog(1.0f + fexp(-fabsf(z)));
            lw[n][ii] = -fexp(-sp - 0.5f);
            const float a_ = sigmoidf_(a0v + aa[n][ii]); av[n][ii] = a_;
            P.g[(size_t)(t0 + pos) * RW + chg] = f2bf(ag[n][ii]);
            const float kk = kraw * kkc; kq[n][ii] = kk;
            const float kpv = kraw * (1.0f + (a_ - 1.0f) * kac); kp[n][ii] = kpv;
            ss[ii] += kk * kk; bs[ii] += rv * kpv * rkc;
        }
        pre[n][0] = lw[n][0]; pre[n][1] = pre[n][0] + lw[n][1]; pre[n][2] = pre[n][1] + lw[n][2]; pre[n][3] = pre[n][2] + lw[n][3];
        const float tot = pre[n][3];
        const float t0_ = __shfl(tot, r), t1_ = __shfl(tot, r + 16), t2_ = __shfl(tot, r + 32), t3_ = __shfl(tot, r + 48);
        preq[n] = (q > 0 ? t0_ : 0.f) + (q > 1 ? t1_ : 0.f) + (q > 2 ? t2_ : 0.f);
        if (q == 0) CT[m * 64 + ch] = (t0_ + t1_) + (t2_ + t3_);
    }
#pragma unroll
    for (int ii = 0; ii < 4; ++ii) {
#pragma unroll
        for (int o = 1; o < 16; o <<= 1) { ss[ii] += __shfl_xor(ss[ii], o); bs[ii] += __shfl_xor(bs[ii], o); }
        if (r == 0) { const int pos = 16 * m + 4 * q + ii; PART[(nh * 64 + pos) * 2] = ss[ii]; PART[(nh * 64 + pos) * 2 + 1] = bs[ii]; }
    }
    RK_BAR();
#pragma unroll
    for (int n = 0; n < 2; ++n) {
        const int ch = 32 * nh + 16 * n + r;
        float carry = 0.f, lend = 0.f;
#pragma unroll
        for (int mm = 0; mm < 4; ++mm) { const float cv = CT[mm * 64 + ch]; lend += cv; carry += (mm < m) ? cv : 0.f; }
        f32x4 tA, tBh, tKh, tV;
#pragma unroll
        for (int ii = 0; ii < 4; ++ii) {
            const int pos = 16 * m + 4 * q + ii;
            const float L = carry + preq[n] + pre[n][ii], Lm1 = L - lw[n][ii];
            const float ssum = PART[pos * 2] + PART[(64 + pos) * 2];
            const float inv = frcp(fmaxf(__builtin_sqrtf(ssum), 1e-12f));
            const float kkn = kq[n][ii] * inv, kb = kkn * av[n][ii];
            const float eN = fexp(-L), eE = fexp(lend - L);
            const float At = -kkn * fexp(Lm1), Rt = rr[n][ii] * fexp(L), Bt = kb * eN, Kt = kp[n][ii] * eN;
            S0[pos * LD + ch] = f2bf(At); S1[pos * LD + ch] = f2bf(Bt); S2[pos * LD + ch] = f2bf(Kt); S3[pos * LD + ch] = f2bf(Rt);
            tA[ii] = At; tBh[ii] = kb * eE; tKh[ii] = kp[n][ii] * eE; tV[ii] = vv[n][ii];
            P.bv[(size_t)(t0 + pos) * RW + h * 64 + ch] = f2bf((PART[pos * 2 + 1] + PART[(64 + pos) * 2 + 1]) * vv[n][ii]);
        }
        { u32x2 w; const int off = ch * LD + 16 * m + 4 * q;
          w.x = pk2(tA[0], tA[1]); w.y = pk2(tA[2], tA[3]); *(LAS u32x2*)(S4 + off) = w;
          w.x = pk2(tBh[0], tBh[1]); w.y = pk2(tBh[2], tBh[3]); *(LAS u32x2*)(S5 + off) = w;
          w.x = pk2(tKh[0], tKh[1]); w.y = pk2(tKh[2], tKh[3]); *(LAS u32x2*)(S6 + off) = w;
          w.x = pk2(tV[0], tV[1]); w.y = pk2(tV[2], tV[3]); *(LAS u32x2*)(S7 + off) = w; }
        if (m == 0 && q == 0) DEND[ch] = fexp(lend);
    }
    RK_BAR();
    RK_DBG(0, S0); RK_DBG(1, S1); RK_DBG(2, S2); RK_DBG(3, S3); RK_DBG(4, S4); RK_DBG(5, S5); RK_DBG(6, S6); RK_DBG(7, S7);
    const int nt0 = 2 * nh;
    f32x4 acc[2], acc2[2];
#define RK_ZERO(a) do { a[0] = (f32x4){0.f, 0.f, 0.f, 0.f}; a[1] = a[0]; } while (0)
#define RK_LDT(src, mt, ntt, a) do { const u32x2 w_ = *(const LAS u32x2*)((src) + (16 * (ntt) + r) * LD + 16 * (mt) + 4 * q); a = (f32x4){bflo(w_.x), bfhi(w_.x), bflo(w_.y), bfhi(w_.y)}; } while (0)
#define RK_MASK(a, ntt, COND) do { _Pragma("unroll") for (int ii = 0; ii < 4; ++ii) { const int row = 16 * m + 4 * q + ii, col = 16 * (ntt) + r; a[ii] = (COND) ? a[ii] : 0.f; } } while (0)
    RK_ZERO(acc); mm_nt<2>(S0, LD, S1, LD, m, nt0, r, q, acc);
#pragma unroll
    for (int n = 0; n < 2; ++n) { RK_MASK(acc[n], nt0 + n, col < row); st_tr(S9, m, nt0 + n, r, q, acc[n]); }
    RK_ZERO(acc); mm_nt<2>(S1, LD, S0, LD, m, nt0, r, q, acc);
#pragma unroll
    for (int n = 0; n < 2; ++n) { RK_MASK(acc[n], nt0 + n, row < col); st_tr(S8, m, nt0 + n, r, q, acc[n]);
#pragma unroll
        for (int ii = 0; ii < 4; ++ii) acc[n][ii] += ((16 * m + 4 * q + ii) == (16 * (nt0 + n) + r)) ? 1.f : 0.f;
        st_tr(S10, m, nt0 + n, r, q, acc[n]); }
    RK_ZERO(acc); mm_nt<2>(S2, LD, S0, LD, m, nt0, r, q, acc);
#pragma unroll
    for (int n = 0; n < 2; ++n) { RK_MASK(acc[n], nt0 + n, row < col); st_tr(S11, m, nt0 + n, r, q, acc[n]); }
    RK_ZERO(acc); mm_nt<2>(S1, LD, S3, LD, m, nt0, r, q, acc);
#pragma unroll
    for (int n = 0; n < 2; ++n) { RK_MASK(acc[n], nt0 + n, row <= col); st_tr(S12, m, nt0 + n, r, q, acc[n]); }
    RK_ZERO(acc); mm_nt<2>(S2, LD, S3, LD, m, nt0, r, q, acc);
#pragma unroll
    for (int n = 0; n < 2; ++n) { RK_MASK(acc[n], nt0 + n, row <= col); st_tr(S13, m, nt0 + n, r, q, acc[n]); }
    RK_BAR();
    RK_ZERO(acc); mm_nt<2>(S8, LD, S9, LD, m, nt0, r, q, acc);
    RK_ZERO(acc2); mm_nt<2>(S9, LD, S8, LD, m, nt0, r, q, acc2);
#pragma unroll
    for (int n = 0; n < 2; ++n) { st_tr(S1, m, nt0 + n, r, q, acc[n]); st_tr(S0, m, nt0 + n, r, q, acc2[n]); }
    RK_ZERO(acc); mm_nt<2>(S11, LD, S7, LD, m, nt0, r, q, acc);
#pragma unroll
    for (int n = 0; n < 2; ++n) st_tr(S14, m, nt0 + n, r, q, acc[n]);
    RK_BAR();
#define RK_ROUND(Tsrc, Tdst, Psrc, PTsrc, Pdst, PTdst) do { \
        RK_LDT(Tsrc, m, nt0, acc[0]); RK_LDT(Tsrc, m, nt0 + 1, acc[1]); mm_nt<2>(PTsrc, LD, Tsrc, LD, m, nt0, r, q, acc); \
        _Pragma("unroll") for (int n = 0; n < 2; ++n) st_tr(Tdst, m, nt0 + n, r, q, acc[n]); \
        RK_ZERO(acc); mm_nt<2>(Psrc, LD, PTsrc, LD, m, nt0, r, q, acc); RK_ZERO(acc2); mm_nt<2>(PTsrc, LD, Psrc, LD, m, nt0, r, q, acc2); \
        _Pragma("unroll") for (int n = 0; n < 2; ++n) { st_tr(PTdst, m, nt0 + n, r, q, acc[n]); st_tr(Pdst, m, nt0 + n, r, q, acc2[n]); } \
        RK_BAR(); } while (0)
#ifndef EXP_SKIP_ROUNDS
    RK_ROUND(S10, S2, S0, S1, S8, S9);
    RK_ROUND(S2, S10, S8, S9, S0, S1);
    RK_ROUND(S10, S2, S0, S1, S8, S9);
    RK_ROUND(S2, S10, S8, S9, S0, S1);
#endif
    RK_LDT(S10, m, nt0, acc[0]); RK_LDT(S10, m, nt0 + 1, acc[1]); mm_nt<2>(S1, LD, S10, LD, m, nt0, r, q, acc);
#pragma unroll
    for (int n = 0; n < 2; ++n) st_tr(S2, m, nt0 + n, r, q, acc[n]);
    RK_BAR();
    RK_ZERO(acc); mm_nt<2>(S2, LD, S4, LD, m, nt0, r, q, acc);
    RK_ZERO(acc2); mm_nt<2>(S2, LD, S14, LD, m, nt0, r, q, acc2);
#pragma unroll
    for (int n = 0; n < 2; ++n) { st_tr(S11, m, nt0 + n, r, q, acc[n]); st_tr(S15, m, nt0 + n, r, q, acc2[n]); }
    RK_BAR();
    {
        const int sw = wave & 1, ntw = wave >> 1;
        unsigned char* mn_ = P.mn + (size_t)uidx * 16384; unsigned char* qy_ = P.qy + (size_t)uidx * 16384;
        f32x4 c2[2];
#define RK_MM2(X, Y) do { _Pragma("unroll") for (int s_ = 0; s_ < 2; ++s_) { const bf16x8 b_ = *(const LAS bf16x8*)((Y) + (16 * ntw + r) * LD + 32 * s_ + 8 * q); \
            _Pragma("unroll") for (int mi = 0; mi < 2; ++mi) { const bf16x8 a_ = *(const LAS bf16x8*)((X) + (16 * (2 * sw + mi) + r) * LD + 32 * s_ + 8 * q); c2[mi] = __builtin_amdgcn_mfma_f32_16x16x32_bf16(a_, b_, c2[mi], 0, 0, 0); } } } while (0)
        RK_ZERO(c2); RK_MM2(S11, S5);
#pragma unroll
        for (int mi = 0; mi < 2; ++mi)
#pragma unroll
            for (int ii = 0; ii < 4; ++ii) { const int row = 16 * (2 * sw + mi) + 4 * q + ii, col = 16 * ntw + r; c2[mi][ii] += (row == col) ? DEND[row] : 0.f; }
        { u32x4 w; w.x = pk2(c2[0][0], c2[0][1]); w.y = pk2(c2[0][2], c2[0][3]); w.z = pk2(c2[1][0], c2[1][1]); w.w = pk2(c2[1][2], c2[1][3]); *(u32x4*)(mn_ + ((ntw * 2 + sw) * 64 + lane) * 16) = w; }
#pragma unroll
        for (int mi = 0; mi < 2; ++mi) { const u32x2 rw_ = *(const LAS u32x2*)(S3 + (16 * ntw + r) * LD + 16 * (2 * sw + mi) + 4 * q); c2[mi] = (f32x4){bflo(rw_.x), bfhi(rw_.x), bflo(rw_.y), bfhi(rw_.y)}; }
        RK_MM2(S11, S12);
        { u32x4 w; w.x = pk2(c2[0][0], c2[0][1]); w.y = pk2(c2[0][2], c2[0][3]); w.z = pk2(c2[1][0], c2[1][1]); w.w = pk2(c2[1][2], c2[1][3]); *(u32x4*)(qy_ + ((ntw * 2 + sw) * 64 + lane) * 16) = w; }
        RK_ZERO(c2); RK_MM2(S5, S15); RK_MM2(S6, S7);
#pragma unroll
        for (int mi = 0; mi < 2; ++mi) { u32x2 w; w.x = pk2(c2[mi][0], c2[mi][1]); w.y = pk2(c2[mi][2], c2[mi][3]); *(u32x2*)(mn_ + 8192 + ((ntw * 4 + 2 * sw + mi) * 64 + lane) * 8) = w; }
        RK_ZERO(c2); RK_MM2(S15, S12); RK_MM2(S7, S13);
#pragma unroll
        for (int mi = 0; mi < 2; ++mi) { u32x2 w; w.x = pk2(c2[mi][0], c2[mi][1]); w.y = pk2(c2[mi][2], c2[mi][3]); *(u32x2*)(qy_ + 8192 + (((2 * sw + mi) * 4 + ntw) * 64 + lane) * 8) = w; }
#undef RK_MM2
    }
    RK_BAR();
#undef RK_ZERO
#undef RK_ROUND
#undef RK_LDT
#undef RK_MASK
#undef RK_BAR
}
__device__ __forceinline__ void scan_wg(const unsigned char* mn, unsigned char* sbuf, int ubase, int vq, LAS unsigned char* lds, int tid) {
    const int wave = __builtin_amdgcn_readfirstlane(tid >> 6), lane = tid & 63;
    constexpr int NC = SEQ / 64, NS = 8, SLOT = 10240, AHEAD = 6;
    const unsigned char* src = mn + (size_t)ubase * 16384 + lane * 16;
    const bool loader = (wave >= 1 && wave <= 5);
    const size_t poff = (wave == 5) ? (size_t)(8192 + vq * 2048) : (size_t)(2048 * (wave - 1));
#define SC_ISSUE(c) do { const unsigned char* s_ = src + (size_t)(c) * 16384 + poff; LAS unsigned char* d_ = lds + ((c) % NS) * SLOT + 2048 * (wave - 1); \
        _Pragma("unroll") for (int i_ = 0; i_ < 2; ++i_) __builtin_amdgcn_global_load_lds((const unsigned*)(s_ + i_ * 1024), (LAS unsigned*)(d_ + i_ * 1024), 16, 0, 0); } while (0)
#define SC_BAR() do { asm volatile("s_waitcnt lgkmcnt(0)" ::: "memory"); __builtin_amdgcn_s_barrier(); asm volatile("" ::: "memory"); } while (0)
    bf16x8 sB[2];
#pragma unroll
    for (int s = 0; s < 2; ++s) sB[s] = (bf16x8){0, 0, 0, 0, 0, 0, 0, 0};
    if (loader) {
#pragma unroll
        for (int c = 0; c < AHEAD; ++c) SC_ISSUE(c);
        asm volatile("s_waitcnt vmcnt(10)" ::: "memory"); }
    SC_BAR();
    for (int c = 0; c < NC; ++c) {
        if (loader) {
            if (c + AHEAD < NC) { SC_ISSUE(c + AHEAD); asm volatile("s_waitcnt vmcnt(10)" ::: "memory"); }
            else { asm volatile("s_waitcnt vmcnt(0)" ::: "memory"); }
        } else if (wave == 0) {
            const LAS unsigned char* sl = lds + (c % NS) * SLOT;
            unsigned char* so = sbuf + (size_t)(ubase + c) * 8192 + (vq * 2) * 1024 + lane * 16;
            *(bf16x8*)so = sB[0]; *(bf16x8*)(so + 1024) = sB[1];
            f32x4 aS[4];
#pragma unroll
            for (int mm = 0; mm < 4; ++mm) {
                const u32x2 nI = *(const LAS u32x2*)(sl + 8192 + (mm * 64 + lane) * 8);
                aS[mm] = (f32x4){bflo(nI.x), bfhi(nI.x), bflo(nI.y), bfhi(nI.y)};
#pragma unroll
                for (int s = 0; s < 2; ++s) { const bf16x8 aM = *(const LAS bf16x8*)(sl + ((mm * 2 + s) * 64 + lane) * 16); aS[mm] = __builtin_amdgcn_mfma_f32_16x16x32_bf16(aM, sB[s], aS[mm], 0, 0, 0); }
            }
#pragma unroll
            for (int s = 0; s < 2; ++s) { u32x4 w; w.x = pk2(aS[2 * s][0], aS[2 * s][1]); w.y = pk2(aS[2 * s][2], aS[2 * s][3]); w.z = pk2(aS[2 * s + 1][0], aS[2 * s + 1][1]); w.w = pk2(aS[2 * s + 1][2], aS[2 * s + 1][3]);
                sB[s] = __builtin_bit_cast(bf16x8, w); }
        }
        SC_BAR();
    }
#undef SC_ISSUE
#undef SC_BAR
}
struct YArgs { const unsigned char* qy; const unsigned char* sbuf; const bf16_t* g; const bf16_t* bv; const float* ln_g; const float* ln_b; unsigned char* ya; };
__device__ __forceinline__ void ypass_unit(const YArgs& P, int u, int lane) {
    const int r = lane & 15, q = lane >> 4, b = u >> 10, h = (u >> 7) & 7, c = u & 127, t0 = b * SEQ + c * 64;
    const unsigned char* qy_ = P.qy + (size_t)u * 16384; const unsigned char* s_ = P.sbuf + (size_t)u * 8192;
    bf16x8 Qf[4][2], Sf[4][2]; u32x2 y0[4][4];
#pragma unroll
    for (int i = 0; i < 4; ++i)
#pragma unroll
        for (int s = 0; s < 2; ++s) { Qf[i][s] = *(const bf16x8*)(qy_ + ((i * 2 + s) * 64 + lane) * 16); Sf[i][s] = *(const bf16x8*)(s_ + ((i * 2 + s) * 64 + lane) * 16); }
#pragma unroll
    for (int vq = 0; vq < 4; ++vq)
#pragma unroll
        for (int mm = 0; mm < 4; ++mm) y0[vq][mm] = *(const u32x2*)(qy_ + 8192 + ((vq * 4 + mm) * 64 + lane) * 8);
    f32x4 lg[4], lb[4];
#pragma unroll
    for (int vq = 0; vq < 4; ++vq) { lg[vq] = *(const f32x4*)(P.ln_g + h * 64 + 16 * vq + 4 * q); lb[vq] = *(const f32x4*)(P.ln_b + h * 64 + 16 * vq + 4 * q); }
#pragma unroll
    for (int mm = 0; mm < 4; ++mm) {
        const size_t ro = (size_t)(t0 + 16 * mm + r) * RW + h * 64 + 4 * q;
        u32x2 gw_[4], bw_[4];
#pragma unroll
        for (int vq = 0; vq < 4; ++vq) { gw_[vq] = *(const u32x2*)(P.g + ro + 16 * vq); bw_[vq] = *(const u32x2*)(P.bv + ro + 16 * vq); }
        f32x4 acc[4]; float sum = 0.f;
#pragma unroll
        for (int vq = 0; vq < 4; ++vq) {
            acc[vq] = (f32x4){bflo(y0[vq][mm].x), bfhi(y0[vq][mm].x), bflo(y0[vq][mm].y), bfhi(y0[vq][mm].y)};
#pragma unroll
            for (int s = 0; s < 2; ++s) acc[vq] = __builtin_amdgcn_mfma_f32_16x16x32_bf16(Sf[vq][s], Qf[mm][s], acc[vq], 0, 0, 0);
            sum += (acc[vq][0] + acc[vq][1]) + (acc[vq][2] + acc[vq][3]);
        }
        sum += __shfl_xor(sum, 16); sum += __shfl_xor(sum, 32);
        const float mean = sum * (1.f / 64.f); float var = 0.f;
#pragma unroll
        for (int vq = 0; vq < 4; ++vq) { acc[vq] = acc[vq] - mean; var += (acc[vq][0] * acc[vq][0] + acc[vq][1] * acc[vq][1]) + (acc[vq][2] * acc[vq][2] + acc[vq][3] * acc[vq][3]); }
        var += __shfl_xor(var, 16); var += __shfl_xor(var, 32);
        const float rstd = __builtin_amdgcn_rsqf(var * (1.f / 64.f) + 64e-5f);
#pragma unroll
        for (int vq = 0; vq < 4; ++vq) {
            const f32x4 gg = (f32x4){bflo(gw_[vq].x), bfhi(gw_[vq].x), bflo(gw_[vq].y), bfhi(gw_[vq].y)}, bb = (f32x4){bflo(bw_[vq].x), bfhi(bw_[vq].x), bflo(bw_[vq].y), bfhi(bw_[vq].y)};
            const f32x4 o = (acc[vq] * rstd * lg[vq] + lb[vq] + bb) * gg;
            int t8 = __builtin_amdgcn_cvt_pk_fp8_f32(o[0], o[1], 0, false); t8 = __builtin_amdgcn_cvt_pk_fp8_f32(o[2], o[3], t8, true); *(unsigned*)(P.ya + ro + 16 * vq) = (unsigned)t8; }
    }
}
}
namespace gl {
constexpr int LDV = 136;
struct Args { const bf16_t* puv; const bf16_t* wsm; const float* bs; const float* ln_g; const float* ln_b; unsigned char* yb; };
__device__ __forceinline__ void unit(const Args& P, LAS unsigned char* lds, int b, int blk, int tid) {
    const int wave = __builtin_amdgcn_readfirstlane(tid >> 6), lane = tid & 63, r = lane & 15, q = lane >> 4;
    const int t0 = b * SEQ + blk * 128;
    LAS float* STAT = (LAS float*)(lds + LDS_MISC);
    for (int j = 0; j < 16; ++j) {
        const int tk = 16 * wave + j;
        const u32x4 w = *(const u32x4*)(P.puv + (size_t)(t0 + tk) * 1024 + 512 + 8 * lane);
        float v[8]; v[0] = bflo(w.x); v[1] = bfhi(w.x); v[2] = bflo(w.y); v[3] = bfhi(w.y); v[4] = bflo(w.z); v[5] = bfhi(w.z); v[6] = bflo(w.w); v[7] = bfhi(w.w);
        float s = 0.f, s2 = 0.f;
#pragma unroll
        for (int e = 0; e < 8; ++e) { s += v[e]; s2 += v[e] * v[e]; }
        s = wave_sum(s); s2 = wave_sum(s2);
        const float mean = s * (1.f / 512.f), var = fmaxf(s2 * (1.f / 512.f) - mean * mean, 0.f);
        if (lane == 0) { STAT[tk * 2] = mean; STAT[tk * 2 + 1] = __builtin_amdgcn_rsqf(var + 1e-5f); }
    }
    __syncthreads();
    for (int g = 0; g < 8; ++g) {
        LAS bf16_t* VT = (LAS bf16_t*)(lds + (g & 1) * 20480);
#pragma unroll
        for (int it = 0; it < 2; ++it) {
            const int task = tid + it * NTHREADS, j = task >> 3, cc = task & 7, ch = g * 64 + 8 * cc;
            const u32x4 w = *(const u32x4*)(P.puv + (size_t)(t0 + j) * 1024 + 512 + ch);
            const float mean = STAT[j * 2], rstd = STAT[j * 2 + 1];
            const f32x4 g0 = *(const f32x4*)(P.ln_g + ch), g1 = *(const f32x4*)(P.ln_g + ch + 4), b0 = *(const f32x4*)(P.ln_b + ch), b1 = *(const f32x4*)(P.ln_b + ch + 4);
            float v[8]; v[0] = bflo(w.x); v[1] = bfhi(w.x); v[2] = bflo(w.y); v[3] = bfhi(w.y); v[4] = bflo(w.z); v[5] = bfhi(w.z); v[6] = bflo(w.w); v[7] = bfhi(w.w);
#pragma unroll
            for (int e = 0; e < 4; ++e) { v[e] = (v[e] - mean) * rstd * g0[e] + b0[e]; v[4 + e] = (v[4 + e] - mean) * rstd * g1[e] + b1[e]; }
#pragma unroll
            for (int e = 0; e < 8; ++e) VT[(8 * cc + e) * LDV + j] = f2bf(v[e]);
        }
        __syncthreads();
        f32x4 acc[4];
#pragma unroll
        for (int n = 0; n < 4; ++n) acc[n] = (f32x4){0.f, 0.f, 0.f, 0.f};
        const bf16_t* wrow = P.wsm + ((size_t)g * 128 + 16 * wave + r) * 128 + 8 * q;
        const int ks = (wave >> 1) + 1;
        for (int s = 0; s < ks; ++s) {
            const bf16x8 a = *(const bf16x8*)(wrow + 32 * s);
#pragma unroll
            for (int n = 0; n < 4; ++n) { const bf16x8 bb = *(const LAS bf16x8*)(VT + (16 * n + r) * LDV + 32 * s + 8 * q); acc[n] = __builtin_amdgcn_mfma_f32_16x16x32_bf16(a, bb, acc[n], 0, 0, 0); }
        }
#pragma unroll
        for (int ii = 0; ii < 4; ++ii) { const int i = 16 * wave + 4 * q + ii; const float bias = P.bs[g * 128 + i];
#pragma unroll
            for (int n = 0; n < 4; ++n) { const int c = g * 64 + 16 * n + r; const float u = bf2f(P.puv[(size_t)(t0 + i) * 1024 + c]);
                P.yb[(size_t)(t0 + i) * RW + c] = (unsigned char)(__builtin_amdgcn_cvt_pk_fp8_f32(u * (acc[n][ii] + bias), 0.f, 0, false) & 0xff); } }
    }
    __syncthreads();
}
}

struct RouteArgs { const float* sc; const float* bias; int* eidx; float* ewt; int* lrank; int* tbase; unsigned* segcnt; };
__device__ __forceinline__ void phase_topk(const RouteArgs& P, LAS unsigned char* lds, int tid, int G) {
    const int wave = __builtin_amdgcn_readfirstlane(tid >> 6), lane = tid & 63, grp = lane >> 3;
    LAS int* hist = (LAS int*)(lds + LDS_MISC);
    const f32x4 bias4 = *(const f32x4*)(P.bias + 4 * lane);
    const float NEG = -__builtin_inff();
    for (int tile = blockIdx.x; tile < T / 256; tile += G) {
        if (tid < NE) hist[tid] = 0;
        __syncthreads();
        for (int j = 0; j < 32; j += 2) {
            const int t0 = tile * 256 + wave * 32 + j;
            float s[2][4], v[2][4], gs[2];
#pragma unroll
            for (int u = 0; u < 2; ++u) { const f32x4 s4 = *(const f32x4*)(P.sc + (size_t)(t0 + u) * NE + 4 * lane); s[u][0] = s4.x; s[u][1] = s4.y; s[u][2] = s4.z; s[u][3] = s4.w;
#pragma unroll
                for (int e = 0; e < 4; ++e) v[u][e] = s[u][e] + bias4[e]; }
            float m1[2], m2[2];
#pragma unroll
            for (int u = 0; u < 2; ++u) { const float a = fmaxf(v[u][0], v[u][1]), b = fminf(v[u][0], v[u][1]), c = fmaxf(v[u][2], v[u][3]), d = fminf(v[u][2], v[u][3]); m1[u] = fmaxf(a, c); m2[u] = fmaxf(fminf(a, c), fmaxf(b, d)); }
#pragma unroll
            for (int o = 1; o < 8; o <<= 1) {
#pragma unroll
                for (int u = 0; u < 2; ++u) { const float o1 = __shfl_xor(m1[u], o), o2 = __shfl_xor(m2[u], o); const float n1 = fmaxf(m1[u], o1), n2 = fmaxf(fminf(m1[u], o1), fmaxf(m2[u], o2)); m1[u] = n1; m2[u] = n2; } }
#pragma unroll
            for (int u = 0; u < 2; ++u) gs[u] = m1[u] + m2[u];
            int cnt[2] = {0, 0};
#pragma unroll
            for (int g = 0; g < 8; ++g) {
#pragma unroll
                for (int u = 0; u < 2; ++u) { const float og = __shfl(gs[u], 8 * g); cnt[u] += (og > gs[u] || (og == gs[u] && g < grp)) ? 1 : 0; } }
#pragma unroll
            for (int u = 0; u < 2; ++u) {
#pragma unroll
                for (int e = 0; e < 4; ++e) v[u][e] = (cnt[u] < 4) ? v[u][e] : NEG; }
            int myidx[2] = {0, 0}; float mysc[2] = {0.f, 0.f}, ssum[2] = {0.f, 0.f};
#pragma unroll
            for (int k = 0; k < TOPK; ++k) {
                float bv[2]; int idx[2];
#pragma unroll
                for (int u = 0; u < 2; ++u) { bv[u] = v[u][0]; int bi = 0;
#pragma unroll
                    for (int e = 1; e < 4; ++e) { const bool gt = v[u][e] > bv[u]; bv[u] = gt ? v[u][e] : bv[u]; bi = gt ? e : bi; }
                    idx[u] = 4 * lane + bi; }
#pragma unroll
                for (int o = 1; o < 64; o <<= 1) {
#pragma unroll
                    for (int u = 0; u < 2; ++u) { const float ov = __shfl_xor(bv[u], o); const int oi = __shfl_xor(idx[u], o); const bool tk = (ov > bv[u]) || (ov == bv[u] && oi < idx[u]); bv[u] = tk ? ov : bv[u]; idx[u] = tk ? oi : idx[u]; } }
#pragma unroll
                for (int u = 0; u < 2; ++u) { const int own = idx[u] >> 2, ee = idx[u] & 3;
                    const float mine = (ee == 0) ? s[u][0] : (ee == 1) ? s[u][1] : (ee == 2) ? s[u][2] : s[u][3];
                    const float scv = __shfl(mine, own);
#pragma unroll
                    for (int e = 0; e < 4; ++e) v[u][e] = (lane == own && e == ee) ? NEG : v[u][e];
                    ssum[u] += scv; myidx[u] = (lane == k) ? idx[u] : myidx[u]; mysc[u] = (lane == k) ? scv : mysc[u]; }
            }
            if (lane < TOPK) {
#pragma unroll
                for (int u = 0; u < 2; ++u) { const int t = t0 + u;
                    const int lr = __hip_atomic_fetch_add(hist + myidx[u], 1, __ATOMIC_RELAXED, __HIP_MEMORY_SCOPE_WORKGROUP);
                    P.eidx[(size_t)t * TOPK + lane] = myidx[u]; P.ewt[(size_t)t * TOPK + lane] = mysc[u] / ssum[u] * 2.5f; P.lrank[(size_t)t * TOPK + lane] = lr; }
            }
        }
        __syncthreads();
        if (tid < NE) { const int cnt = hist[tid]; unsigned base = 0u;
            if (cnt) base = __hip_atomic_fetch_add(P.segcnt + tid, (unsigned)cnt, __ATOMIC_RELAXED, __HIP_MEMORY_SCOPE_AGENT);
            P.tbase[tile * NE + tid] = (int)base; }
        __syncthreads();
    }
}
struct ScatArgs { const int* eidx; const float* ewt; const int* lrank; const int* tbase; const unsigned* segcnt; int* rowtok; int* rowdst; float* roww; int* tab; unsigned* ntile; };
__device__ __forceinline__ void phase_scatter(const ScatArgs& P, LAS unsigned char* lds, int tid, int G) {
    LAS int* cntL = (LAS int*)(lds + LDS_MISC); LAS int* segst = cntL + 256; LAS int* tsa = segst + 256;
    if (tid < NE) cntL[tid] = (int)__hip_atomic_load(P.segcnt + tid, __ATOMIC_RELAXED, __HIP_MEMORY_SCOPE_AGENT);
    __syncthreads();
    if (tid == 0) {
        int run = 0, ta = 0;
        for (int s = 0; s < NE; ++s) { const int nts = (cntL[s] + 255) >> 8; segst[s] = run; tsa[s] = ta; run += nts * 256; ta += nts; }
        if (blockIdx.x == 0) P.ntile[0] = (unsigned)ta;
    }
    __syncthreads();
    for (int tile = blockIdx.x; tile < T / 256; tile += G) {
        for (int a = tid; a < 256 * TOPK; a += NTHREADS) {
            const int tok = tile * 256 + (a >> 3), k = a & 7; const size_t ai = (size_t)tok * TOPK + k;
            const int e = P.eidx[ai];
            const int pos = segst[e] + P.tbase[tile * NE + e] + P.lrank[ai];
            P.rowtok[pos] = tok; P.rowdst[pos] = tok * TOPK + k; P.roww[pos] = P.ewt[ai];
        }
    }
    for (int s = blockIdx.x; s < NE; s += G) {
        const int st = segst[s], cnt = cntL[s], nts = (cnt + 255) >> 8;
        for (int p = st + cnt + tid; p < st + nts * 256; p += NTHREADS) { P.rowtok[p] = 0; P.rowdst[p] = -1; P.roww[p] = 0.f; }
        if (tid < nts) { int* ta_ = P.tab + 2 * (tsa[s] + tid); ta_[0] = st + 256 * tid; ta_[1] = s; }
    }
}
constexpr int NPHASE = 20;
struct KArgs { const float* in[34]; float* out; unsigned char* ws; int ph_lo, ph_hi; };
template <int PLO, int PHI>
__global__ void __launch_bounds__(NTHREADS, 2) fwd_kernel(KArgs a) {
    extern __shared__ __attribute__((aligned(16))) unsigned char lds_raw[];
    LAS unsigned char* lds = (LAS unsigned char*)lds_raw;
    const int G = gridDim.x, bid = blockIdx.x, NGW = G * NWAVES;
#define PH_IDS() int tid = threadIdx.x; asm volatile("" : "+v"(tid)); const int lane = tid & 63, wave = __builtin_amdgcn_readfirstlane(tid >> 6), gw = bid * NWAVES + wave; (void)lane; (void)wave; (void)gw
    unsigned char* ws = a.ws;
    unsigned* ctl = (unsigned*)(ws + WS_CTL);
    float* mod = (float*)(ws + WS_MOD);
    constexpr int lo = PLO, hi = PHI;
    if (threadIdx.x == 0) *(LAS u32x4*)(lds + LDS_BARW) = (u32x4){0u, 0u, 0u, 0u};
    __syncthreads();
    XcdBarrier bar; bar.bar = ctl + CW_BAR; bar.x = 0; bar.st = nullptr;
    if (hi - lo > 1) bar = xcd_barrier_post(ctl + CW_BAR, (volatile LAS unsigned*)(lds + LDS_BARW));
#define IN(k) (lo <= (k) && (k) < hi)
#ifdef DBG_TIME
#define STAMP(k) do { if (blockIdx.x == 0 && threadIdx.x == 0) ((unsigned long long*)(ctl + 5200))[k] = __builtin_amdgcn_s_memrealtime(); } while (0)
#else
#define STAMP(k) do {} while (0)
#endif
#define SEAM(k) do { if (IN(k) && IN((k) + 1)) xcd_barrier(bar); } while (0)
#ifndef DBG_REPEAT
#define DBG_REPEAT (-1)
#define DBG_NREP 0
#endif
#define REP(k) for (int rep_ = 0; rep_ < (((k) == DBG_REPEAT) ? 1 + DBG_NREP : 1); ++rep_, (((k) == DBG_REPEAT && rep_ <= DBG_NREP) ? xcd_barrier(bar) : (void)0))

    STAMP(0);
    if (IN(0)) REP(0) { PH_IDS();
        phase_mod(a.in[1], a.in[2], a.in[3], mod, lds, tid, G);
        SmallW sw{a.in[6], a.in[22], a.in[23], a.in[24], a.in[25], a.in[30], a.in[31], a.in[32], a.in[9], a.in[11], a.in[12], a.in[20]};
        phase_small_weights(sw, ws, lds, gw, NGW, wave, lane);
    }
    SEAM(0); STAMP(1);
    if (IN(1)) REP(1) { PH_IDS(); phase_norm_mod(a.in[0], a.in[4], mod, 0, 1024, nullptr, ws + B_H1, gw, NGW, lane); }
    SEAM(1); STAMP(2);
    if (IN(2)) REP(2) {
        gm::DenseSched S; S.init(ws + B_H1, ws + SW_WIN, T, IN_COLS, D, G, bid, 1);
        gm::EpiInProj E{(bf16_t*)(ws + B_PRW), (bf16_t*)(ws + B_PUV), (bf16_t*)(ws + B_PG)};
        gm::gemm_phase<gm::EpiInProj, gm::DenseSched, true, true, 122>(lds, D, S, E);
    }
    SEAM(2); STAMP(3);
    if (IN(3)) REP(3) { PH_IDS();
        gl::Args Q{(const bf16_t*)(ws + B_PUV), (const bf16_t*)(ws + SW_WSM), a.in[21], a.in[18], a.in[19], ws + B_YB};
        for (int u = bid; u < 512; u += G) gl::unit(Q, lds, u >> 6, u & 63, tid);
        phase_xs((const bf16_t*)(ws + B_PRW), a.in[7], (bf16_t*)(ws + B_XS), gw, NGW, lane);
    }
    SEAM(3); STAMP(4);
    if (IN(4)) REP(4) { PH_IDS();
        rk::Args P{(const bf16_t*)(ws + B_PRW), a.in[7], a.in[8], a.in[10], a.in[13], a.in[14], a.in[15], (const bf16_t*)(ws + SW_WUP), (const bf16_t*)(ws + SW_AUP), (const bf16_t*)(ws + SW_GUP), (const bf16_t*)(ws + B_XS),
                   (bf16_t*)(ws + B_G), (bf16_t*)(ws + B_BV), ws + B_MN, ws + B_QY};
        rk::Pre pre; rk::load_mu(P, lds, tid);
        if (bid < 8192) rk::prefetch(P, bid >> 10, (bid >> 7) & 7, bid & 127, tid, pre);
        for (int u = bid; u < 8192; u += G) { const int un = u + G; rk::unit(P, lds, u >> 10, (u >> 7) & 7, u & 127, u, tid, pre, un < 8192, un >> 10, (un >> 7) & 7, un & 127); }
    }
    SEAM(4); STAMP(5);
    if (IN(5)) REP(5) { PH_IDS();
        for (int w = bid; w < 256; w += G) rk::scan_wg(ws + B_MN, ws + B_S, ((w & 7) + 8 * (w >> 5)) * 128, (w >> 3) & 3, lds, tid);
    }
    SEAM(5); STAMP(6);
    if (IN(6)) REP(6) { PH_IDS();
        rk::YArgs Y{ws + B_QY, ws + B_S, (const bf16_t*)(ws + B_G), (const bf16_t*)(ws + B_BV), a.in[16], a.in[17], ws + B_YA};
        for (int u = gw; u < 8192; u += NGW) rk::ypass_unit(Y, u, lane);
    }
    SEAM(6); STAMP(7);
    STAMP(8);
    if (IN(8)) REP(8) {
        gm::DenseSched S; S.init(ws + B_YA, ws + SW_WOA, T, D, RW, G, bid, 1);
        gm::EpiMerge<false> E{(bf16_t*)(ws + B_M1), (const bf16_t*)(ws + B_PG), nullptr};
        gm::gemm_phase<gm::EpiMerge<false>, gm::DenseSched, true, true, 122>(lds, RW, S, E);
    }
    SEAM(8); STAMP(9);
    if (IN(9)) {
        gm::DenseSched S; S.init(ws + B_YB, ws + SW_WOB, T, D, RW, G, bid, 1);
        gm::EpiMerge<true> E{(bf16_t*)(ws + B_M1), (const bf16_t*)(ws + B_PG), ws + B_M8};
        gm::gemm_phase<gm::EpiMerge<true>, gm::DenseSched, true, true, 122>(lds, RW, S, E);
    }
    SEAM(9); STAMP(10);
    if (IN(10)) REP(10) {
        gm::DenseSched S; S.init(ws + B_M8, ws + SW_WO, T, D, D, G, bid, 1);
        gm::EpiResid E{a.out, a.in[0], mod + 2048};
        gm::gemm_phase<gm::EpiResid, gm::DenseSched, true, true, 122>(lds, D, S, E);
    }
    SEAM(10); STAMP(11);
    if (IN(11)) REP(11) { PH_IDS();
        phase_norm_mod(a.out, a.in[5], mod, 3072, 4096, (bf16_t*)(ws + B_H2), ws + B_H2F8, gw, NGW, lane);
        phase_expert_weights(a.in[27], a.in[28], a.in[29], ws, lds, gw, NGW, wave, lane);
    }
    SEAM(11); STAMP(12);
    if (IN(12)) REP(12) {
        { gm::DenseSched S; S.init(ws + B_H2, ws + SW_WR, T, NE, D, G, bid); gm::EpiRouter E{(float*)(ws + B_SC)}; gm::gemm_phase<gm::EpiRouter, gm::DenseSched, true>(lds, D, S, E); }
        { gm::DenseSched S; S.init(ws + B_H2, ws + SW_WS13, T, 512, D, G, bid); gm::EpiGateUp<false> E{ws + B_SH}; gm::gemm_phase<gm::EpiGateUp<false>, gm::DenseSched, true>(lds, D, S, E); }
    }
    SEAM(12); STAMP(13);
    if (IN(13)) { PH_IDS();
        RouteArgs R{(const float*)(ws + B_SC), a.in[26], (int*)(ws + RT_EIDX), (float*)(ws + RT_EWT), (int*)(ws + RT_LRANK), (int*)(ws + RT_TBASE), ctl + CW_SEGCNT};
        phase_topk(R, lds, tid, G);
        gm::DenseSched S; S.init(ws + B_SH, ws + SW_WS2, T, D, EFF, G, bid);
        gm::EpiSharedDown E{ws + B_SHO};
        gm::gemm_phase<gm::EpiSharedDown, gm::DenseSched, true>(lds, EFF, S, E);
    }
    SEAM(13); STAMP(14);
    if (IN(14)) REP(14) { PH_IDS();
        ScatArgs P{(const int*)(ws + RT_EIDX), (const float*)(ws + RT_EWT), (const int*)(ws + RT_LRANK), (const int*)(ws + RT_TBASE), ctl + CW_SEGCNT,
                   (int*)(ws + RT_ROWTOK), (int*)(ws + RT_ROWDST), (float*)(ws + RT_ROWW), (int*)(ws + RT_TAB), ctl + CW_NT};
        phase_scatter(P, lds, tid, G);
    }
    SEAM(14); STAMP(15);
    if (IN(15)) REP(15) {
        gm::GroupSched<true> S; S.A = (const char*)(ws + B_H2F8); S.B = (const char*)(ws + B_W13); S.tab = (const int*)(ws + RT_TAB); S.rowtok = (const int*)(ws + RT_ROWTOK);
        S.ntiles = (int)__hip_atomic_load(ctl + CW_NT, __ATOMIC_RELAXED, __HIP_MEMORY_SCOPE_AGENT); S.npn = 2; S.G = G; S.c = bid; S.K = D; S.ebytes = (size_t)512 * D; S.tstep = (size_t)256 * D;
        gm::EpiGateUp<true> E{ws + B_HID};
        gm::gemm_phase<gm::EpiGateUp<true>, gm::GroupSched<true>, true, true, 122>(lds, D, S, E);
    }
    SEAM(15); STAMP(16);
    if (IN(16)) REP(16) {
        gm::GroupSched<false> S; S.A = (const char*)(ws + B_HID); S.B = (const char*)(ws + B_W2); S.tab = (const int*)(ws + RT_TAB); S.rowtok = nullptr;
        S.ntiles = (int)__hip_atomic_load(ctl + CW_NT, __ATOMIC_RELAXED, __HIP_MEMORY_SCOPE_AGENT); S.npn = 4; S.G = G; S.c = bid; S.K = EFF; S.ebytes = (size_t)D * EFF; S.tstep = (size_t)256 * EFF;
        gm::EpiExpertDown E{ws + B_SLOT, (const int*)(ws + RT_ROWDST), (const float*)(ws + RT_ROWW)};
        gm::gemm_phase<gm::EpiExpertDown, gm::GroupSched<false>, true, true, 122>(lds, EFF, S, E);
    }
    SEAM(16); STAMP(17);
    if (IN(17)) { PH_IDS(); phase_combine(a.out, ws + B_SLOT, ws + B_SHO, mod, a.in[33], gw, NGW, lane); }
    STAMP(18); STAMP(19);
    __syncthreads(); STAMP(20);
#undef IN
#undef SEAM
}

#if defined(DBG_CHECK) || defined(DBG_TIME)
#ifdef DBG_TIME
#ifndef TSC
#define TSC 0.25f
#endif
__global__ void dbg_time_out(float* out, const unsigned long long* st) {
    if (threadIdx.x == 0 && blockIdx.x == 0) { out[0] = (float)(st[TA1] - st[TA0]) * 0.01f * TSC; out[1] = (float)(st[TB1] - st[TB0]) * 0.01f * TSC; }
}
static void dbg_run(void* d_out, void* d_ws, hipStream_t stream) {
    dbg_time_out<<<1, 64, 0, stream>>>((float*)d_out, (const unsigned long long*)((unsigned*)((unsigned char*)d_ws + WS_CTL) + 5200));
}
#endif
#endif
#ifndef MK_SINGLE
#define MK_SINGLE 0
#endif
template <int PLO, int PHI> static bool prep_kernel() {
    int per_cu = 0;
    if (hipFuncSetAttribute((const void*)fwd_kernel<PLO, PHI>, hipFuncAttributeMaxDynamicSharedMemorySize, LDS_BYTES) != hipSuccess) { fprintf(stderr, "kernel_launch: hipFuncSetAttribute failed\n"); return false; }
    if (hipOccupancyMaxActiveBlocksPerMultiprocessor(&per_cu, (const void*)fwd_kernel<PLO, PHI>, NTHREADS, LDS_BYTES) != hipSuccess || per_cu < 1) { fprintf(stderr, "kernel_launch: occupancy query says %d\n", per_cu); (void)hipGetLastError(); return false; }
    return true;
}
template <int P> struct PhaseLaunch {
    static bool prep() { return prep_kernel<P, P + 1>() && PhaseLaunch<P + 1>::prep(); }
    static void go(int grid, hipStream_t stream, const KArgs& a) { hipLaunchKernelGGL((fwd_kernel<P, P + 1>), dim3(grid), dim3(NTHREADS), LDS_BYTES, stream, a); PhaseLaunch<P + 1>::go(grid, stream, a); }
};
#ifndef DBG_LAST
#define DBG_LAST NPHASE
#endif
template <> struct PhaseLaunch<DBG_LAST> { static bool prep() { return true; } static void go(int, hipStream_t, const KArgs&) {} };
extern "C" void kernel_launch(void* const* d_in, const int* in_sizes, int n_in, void* d_out, int out_size, void* d_ws, size_t ws_size, hipStream_t stream) {
    static int grid = 0;
    if (grid == 0) {
        if (n_in != 34 || out_size != T * D || ws_size < WS_END) { fprintf(stderr, "kernel_launch: unexpected problem shape (n_in %d, out %d, ws %zu < %zu)\n", n_in, out_size, ws_size, (size_t)WS_END); grid = -1; return; }
        int dev = 0, cus = 0;
        if (hipGetDevice(&dev) != hipSuccess || hipDeviceGetAttribute(&cus, hipDeviceAttributeMultiprocessorCount, dev) != hipSuccess) { grid = -1; return; }
#if MK_SINGLE
        if (!prep_kernel<0, NPHASE>()) { grid = -1; return; }
#else
        if (!PhaseLaunch<0>::prep()) { grid = -1; return; }
#endif
        grid = cus;
    }
    if (grid < 0) return;
    (void)hipMemsetAsync((char*)d_ws + WS_CTL, 0, CTL_ZERO_BYTES, stream);
    KArgs a{};
    for (int i = 0; i < 34; ++i) a.in[i] = (const float*)d_in[i];
    a.out = (float*)d_out; a.ws = (unsigned char*)d_ws; a.ph_lo = 0; a.ph_hi = NPHASE;
#if MK_SINGLE
    hipLaunchKernelGGL((fwd_kernel<0, NPHASE>), dim3(grid), dim3(NTHREADS), LDS_BYTES, stream, a);
#else
    PhaseLaunch<0>::go(grid, stream, a);
#endif
#if defined(DBG_CHECK) || defined(DBG_TIME)
    dbg_run(d_out, d_ws, stream);
#endif
}
```

```cpp
#define MK_SINGLE 1
#include <hip/hip_runtime.h>
#include <cstdio>
#include <cstdint>

#define LAS __attribute__((address_space(3)))
#define GAS __attribute__((address_space(1)))
typedef unsigned short bf16_t;
typedef short bf16x8 __attribute__((ext_vector_type(8)));
typedef float f32x4 __attribute__((ext_vector_type(4)));
typedef float f32x2 __attribute__((ext_vector_type(2)));
typedef unsigned u32x4 __attribute__((ext_vector_type(4)));
typedef unsigned u32x2 __attribute__((ext_vector_type(2)));

constexpr int D = 1024, NB = 8, SEQ = 8192, T = NB * SEQ;
constexpr int RW = 512, HD = 64, NH = 8;
constexpr int RWKV_COLS = 1792, IN_COLS = 4864;
constexpr int NE = 256, TOPK = 8, EFF = 256;
constexpr int NWAVES = 8, NTHREADS = 512;
constexpr int MAXROWS = T * TOPK + 256 * 256;

constexpr size_t MiB = 1u << 20;
constexpr size_t WS_CTL = 0;
constexpr int CW_BAR = 0, CW_SEGCNT = 4096, CW_NT = 4608;
constexpr size_t CTL_ZERO_BYTES = 20480;
constexpr size_t WS_MOD = 65536;
constexpr size_t WS_SW = 1 * MiB;
constexpr size_t SW_WIN = WS_SW;
constexpr size_t SW_WOA = SW_WIN + (size_t)IN_COLS * D * 2;
constexpr size_t SW_WOB = SW_WOA + (size_t)D * RW * 2;
constexpr size_t SW_WO = SW_WOB + (size_t)D * RW * 2;
constexpr size_t SW_WR = SW_WO + (size_t)D * D * 2;
constexpr size_t SW_WS13 = SW_WR + (size_t)NE * D * 2;
constexpr size_t SW_WS2 = SW_WS13 + (size_t)512 * D * 2;
constexpr size_t SW_WUP = SW_WS2 + (size_t)D * EFF * 2;
constexpr size_t SW_AUP = SW_WUP + (size_t)RW * 64 * 2;
constexpr size_t SW_GUP = SW_AUP + (size_t)RW * 64 * 2;
constexpr size_t SW_WSM = SW_GUP + (size_t)RW * 128 * 2;
constexpr size_t SW_END = SW_WSM + (size_t)8 * 128 * 128 * 2;
static_assert(SW_END <= 20 * MiB, "small weights");
constexpr size_t WS_RT = 20 * MiB;
constexpr size_t RT_EIDX = WS_RT;
constexpr size_t RT_EWT = RT_EIDX + (size_t)T * 8 * 4;
constexpr size_t RT_LRANK = RT_EWT + (size_t)T * 8 * 4;
constexpr size_t RT_TBASE = RT_LRANK + (size_t)T * 8 * 4;
constexpr size_t RT_ROWTOK = RT_TBASE + (size_t)256 * 256 * 4;
constexpr size_t RT_ROWDST = RT_ROWTOK + (size_t)MAXROWS * 4;
constexpr size_t RT_ROWW = RT_ROWDST + (size_t)MAXROWS * 4;
constexpr size_t RT_TAB = RT_ROWW + (size_t)MAXROWS * 4;
constexpr size_t RT_SBON = RT_TAB + (size_t)3 * 4096 * 8;
constexpr size_t RT_END = RT_SBON + (size_t)T * 8 * 4;
static_assert(RT_END <= 40 * MiB, "routing arrays");
constexpr size_t WS_BIG = 40 * MiB;
constexpr size_t B_H1 = WS_BIG + 0 * MiB;
constexpr size_t B_YB = WS_BIG + 0 * MiB;
constexpr size_t B_YA = WS_BIG + 64 * MiB;
constexpr size_t B_XS = WS_BIG + 64 * MiB;
constexpr size_t B_PRW = WS_BIG + 128 * MiB;
constexpr size_t B_M8 = WS_BIG + 128 * MiB;
constexpr size_t B_S = WS_BIG + 128 * MiB;
constexpr size_t B_PUV = WS_BIG + 352 * MiB;
constexpr size_t B_QY = WS_BIG + 352 * MiB;
constexpr size_t B_M1 = WS_BIG + 352 * MiB;
constexpr size_t B_PG = WS_BIG + 480 * MiB;
constexpr size_t B_MN = WS_BIG + 736 * MiB;
constexpr size_t B_G = WS_BIG + 864 * MiB;
constexpr size_t B_BV = WS_BIG + 928 * MiB;
constexpr size_t B_H2 = WS_BIG + 0 * MiB;
constexpr size_t B_W13 = WS_BIG + 128 * MiB;
constexpr size_t B_H2F8 = WS_BIG + 256 * MiB;
constexpr size_t B_SH = WS_BIG + 384 * MiB;
constexpr size_t B_SC = WS_BIG + 416 * MiB;
constexpr size_t B_SLOT = WS_BIG + 0 * MiB;
constexpr size_t B_SHO = WS_BIG + 928 * MiB;
constexpr size_t B_W2 = WS_BIG + 512 * MiB;
constexpr size_t B_X1 = WS_BIG + 576 * MiB;
constexpr size_t B_HID = WS_BIG + 704 * MiB;
constexpr size_t WS_END = WS_BIG + 992 * MiB;
static_assert((size_t)MAXROWS * EFF * 2 <= 320 * MiB, "hid");

constexpr int LDS_STAGE = 0;
constexpr int LDS_MISC = 147456;
constexpr int LDS_BARW = 155648;
constexpr int LDS_BYTES = 163840;

typedef __bf16 bf16x2_t __attribute__((ext_vector_type(2)));
__device__ __forceinline__ unsigned pk2(float lo, float hi) { f32x2 f = {lo, hi}; return __builtin_bit_cast(unsigned, __builtin_convertvector(f, bf16x2_t)); }
__device__ __forceinline__ u32x2 pk8(const f32x4& a, const f32x4& b) { u32x2 w; int t = __builtin_amdgcn_cvt_pk_fp8_f32(a[0], a[1], 0, false); t = __builtin_amdgcn_cvt_pk_fp8_f32(a[2], a[3], t, true); w.x = (unsigned)t;
    t = __builtin_amdgcn_cvt_pk_fp8_f32(b[0], b[1], 0, false); t = __builtin_amdgcn_cvt_pk_fp8_f32(b[2], b[3], t, true); w.y = (unsigned)t; return w; }
__device__ __forceinline__ f32x4 up8(unsigned w) { const f32x2 lo = __builtin_amdgcn_cvt_pk_f32_fp8((int)w, false), hi = __builtin_amdgcn_cvt_pk_f32_fp8((int)w, true); return (f32x4){lo.x, lo.y, hi.x, hi.y}; }
__device__ __forceinline__ float bflo(unsigned w) { return __uint_as_float(w << 16); }
__device__ __forceinline__ float bfhi(unsigned w) { return __uint_as_float(w & 0xffff0000u); }
__device__ __forceinline__ float bf2f(bf16_t h) { return __uint_as_float(((unsigned)h) << 16); }
__device__ __forceinline__ bf16_t f2bf(float f) { return (bf16_t)(pk2(f, 0.f) & 0xffffu); }
__device__ __forceinline__ float fexp(float x) { return __builtin_amdgcn_exp2f(x * 1.44269504089f); }
__device__ __forceinline__ float flog(float x) { return __builtin_amdgcn_logf(x) * 0.69314718056f; }
__device__ __forceinline__ float frcp(float x) { return __builtin_amdgcn_rcpf(x); }
__device__ __forceinline__ float sigmoidf_(float x) { return frcp(1.0f + fexp(-x)); }
__device__ __forceinline__ float siluf_(float x) { return x * sigmoidf_(x); }
__device__ __forceinline__ float tanhf_(float x) { return 1.0f - 2.0f * frcp(1.0f + fexp(2.0f * x)); }
__device__ __forceinline__ float gelu_tanh(float x) { const float u = 0.7978845608f * (x + 0.044715f * x * x * x); return x * frcp(1.0f + fexp(-2.0f * u)); }
__device__ __forceinline__ float wave_sum(float v) {
#pragma unroll
    for (int o = 1; o < 64; o <<= 1) v += __shfl_xor(v, o);
    return v;
}
#define LDS_WAIT() asm volatile("s_waitcnt lgkmcnt(0)" ::: "memory")
#define VM_WAIT() asm volatile("s_waitcnt vmcnt(0)" ::: "memory")

#define XB_TMO      128
#define XB_XCNT(j)  (256  + 64 * (j))
#define XB_XSUB(j)  (1280 + 64 * (j))
#define XB_XGEN(j)  (2304 + 64 * (j))
#define XB_TOP      3328
#define XB_TOPGEN   3392
#define XCD_BAR_WORDS 3456
#define XB_SPIN_CAP (1u << 18)
__device__ __forceinline__ unsigned xb_ld(unsigned* p)              { return __hip_atomic_load(p, __ATOMIC_RELAXED, __HIP_MEMORY_SCOPE_AGENT); }
__device__ __forceinline__ unsigned xb_add(unsigned* p, unsigned v) { return __hip_atomic_fetch_add(p, v, __ATOMIC_RELAXED, __HIP_MEMORY_SCOPE_AGENT); }
__device__ __forceinline__ unsigned xb_xcc_id() { return (unsigned)__builtin_amdgcn_s_getreg((3 << 11) | 20) & 0xFu; }
#define XB_SPIN(cond, bar) do { unsigned _sp = 0; while (cond) { __builtin_amdgcn_s_sleep(1); \
    if ((++_sp & 255u) == 0u) { if (xb_ld(&(bar)[XB_TMO])) break; if (_sp > XB_SPIN_CAP) { atomicAdd(&(bar)[XB_TMO], 1u); break; } } } } while (0)
struct XcdBarrier { unsigned* bar; unsigned x; volatile LAS unsigned* st; };
__device__ __forceinline__ XcdBarrier xcd_barrier_post(unsigned* bar, volatile LAS unsigned* st) {
    XcdBarrier b; b.bar = bar; b.x = xb_xcc_id(); b.st = st;
    if (threadIdx.x == 0) (void)xb_add(&bar[XB_XCNT(b.x)], 1u);
    return b;
}
__device__ __forceinline__ void xcd_barrier_complete(unsigned* bar, unsigned x, unsigned& nloc, unsigned& nx) {
    const unsigned G = gridDim.x * gridDim.y * gridDim.z;
    unsigned sum, cnt, mine, sp = 0u;
    for (;;) {
        sum = 0u; cnt = 0u; mine = 0u;
#pragma unroll
        for (unsigned j = 0; j < 16; ++j) { const unsigned c = xb_ld(&bar[XB_XCNT(j)]); sum += c; cnt += (c > 0u) ? 1u : 0u; mine = (j == x) ? c : mine; }
        if (sum == G) break;
        __builtin_amdgcn_s_sleep(1);
        if ((++sp & 255u) == 0u) { if (xb_ld(&bar[XB_TMO])) break; if (sp > XB_SPIN_CAP) { atomicAdd(&bar[XB_TMO], 1u); break; } }
    }
    nloc = mine > 0u ? mine : 1u; nx = cnt > 0u ? cnt : 1u;
}
__device__ __forceinline__ void xcd_barrier(const XcdBarrier& b) {
    asm volatile("s_waitcnt vmcnt(0)" ::: "memory");
    __syncthreads();
    if (threadIdx.x == 0) {
        unsigned* bar = b.bar;
        __builtin_amdgcn_s_waitcnt(0);
        unsigned nloc = b.st[0], nx = b.st[1];
        if (nloc == 0u) { xcd_barrier_complete(bar, b.x, nloc, nx); b.st[0] = nloc; b.st[1] = nx; }
        const unsigned old = xb_add(&bar[XB_XSUB(b.x)], 1u);
        const unsigned gen = old / nloc;
        if (old + 1u == (gen + 1u) * nloc) {
            __builtin_amdgcn_fence(__ATOMIC_RELEASE, "agent");
            asm volatile("s_waitcnt vmcnt(0)" ::: "memory");
            const unsigned og = xb_add(&bar[XB_TOP], 1u);
            const unsigned tg = og / nx;
            if (og + 1u == (tg + 1u) * nx) xb_add(&bar[XB_TOPGEN], 1u);
            else XB_SPIN(xb_ld(&bar[XB_TOPGEN]) == tg, bar);
            __builtin_amdgcn_fence(__ATOMIC_ACQUIRE, "agent");
            xb_add(&bar[XB_XGEN(b.x)], 1u);
            asm volatile("s_waitcnt vmcnt(0)" ::: "memory");
        } else {
            XB_SPIN(xb_ld(&bar[XB_XGEN(b.x)]) == gen, bar);
            __builtin_amdgcn_fence(__ATOMIC_ACQUIRE, "agent");
            asm volatile("s_waitcnt vmcnt(0)" ::: "memory");
        }
    }
    __syncthreads();
}
namespace gm {
typedef int i32x4 __attribute__((ext_vector_type(4)));
typedef int i32x8 __attribute__((ext_vector_type(8)));
constexpr int BM = 256, BK = 64, HALF = 128, HTB = HALF * BK * 2, STAGE_BYTES = 8 * HTB, NXCD = 8, WGM = 8;
__host__ __device__ __forceinline__ int lds_byte(int r, int c) { const int st = (r >> 4) * 2 + (c >> 5), rr = r & 15, cc = c & 31, ob = rr * 64 + cc * 2; return st * 1024 + (ob ^ (((ob >> 9) & 1) << 5)); }
__host__ __device__ __forceinline__ void stage_rc(int b, int& R, int& C) { const int st = b / 1024, sb = b % 1024, swz = sb ^ (((sb >> 9) & 1) << 5); R = (st >> 1) * 16 + swz / 64; C = (st & 1) * 32 + (swz % 64) / 2; }
__host__ __device__ __forceinline__ int perm32(int rho) { const int n = rho >> 4, i = rho & 15; return 8 * (i >> 2) + 4 * n + (i & 3); }

struct Unit { int pm, pn, e, row0, par; };

struct DenseSched {
    static constexpr bool GATHER = false;
    const char* A; const char* B; int nM, nN, nwg, G, c; size_t tstep;
    __device__ __forceinline__ void init(const void* A_, const void* B_, int M, int N, int K, int G_, int c_, int es = 2) { A = (const char*)A_; B = (const char*)B_; nM = M / BM; nN = N / BM; nwg = nM * nN; G = G_; c = c_; tstep = (size_t)BM * K * es; }
    __device__ __forceinline__ bool next(int i, Unit& u) const {
        const long L = (long)i * G + c; if (L >= nwg) return false;
        int wgid = (int)L; { const int q = nwg / NXCD, r = nwg % NXCD, xcd = wgid % NXCD, off = wgid / NXCD; wgid = (xcd < r ? xcd * (q + 1) : r * (q + 1) + (xcd - r) * q) + off; }
        const int nig = WGM * nN, gid = wgid / nig, fm = gid * WGM, gsz = (nM - fm) < WGM ? (nM - fm) : WGM;
        u.pm = fm + ((wgid % nig) % gsz); u.pn = (wgid % nig) / gsz; u.e = 0; u.row0 = u.pm * BM; return true;
    }
    __device__ __forceinline__ const char* a_ptr(const Unit& u) const { return A + (size_t)u.pm * tstep; }
    __device__ __forceinline__ const char* b_ptr(const Unit& u) const { return B + (size_t)u.pn * tstep; }
    __device__ __forceinline__ unsigned row_off(const Unit&, int) const { return 0u; }
};
template <bool GATHER_>
struct GroupSched {
    static constexpr bool GATHER = GATHER_;
    const char* A; const char* B; const int* tab; const int* rowtok; int ntiles, npn, G, c, K; size_t ebytes, tstep;
    __device__ __forceinline__ bool next(int i, Unit& u) const {
        int tile;
        if (G == 256) {
            const int xcd = c & 7, slot = c >> 3, tpx = 32 / npn; tile = i * 8 * tpx + xcd * tpx + slot / npn; u.pn = slot % npn; if (tile >= ntiles) return false;
        } else { const long L = (long)i * G + c; if (L >= (long)ntiles * npn) return false; tile = (int)(L / npn); u.pn = (int)(L % npn); }
        u.pm = tile;
        u.row0 = __builtin_amdgcn_readfirstlane(tab[2 * tile]); u.e = __builtin_amdgcn_readfirstlane(tab[2 * tile + 1]); return true;
    }
    __device__ __forceinline__ const char* a_ptr(const Unit& u) const { return GATHER ? A : A + (size_t)u.row0 * K; }
    __device__ __forceinline__ const char* b_ptr(const Unit& u) const { return B + (size_t)u.e * ebytes + (size_t)u.pn * tstep; }
    __device__ __forceinline__ unsigned row_off(const Unit& u, int r) const { return (unsigned)rowtok[u.row0 + r] * (unsigned)K; }
};

template <class Epi, class Sched, bool ALIGN_EPI, bool F8 = false, int SCALE_W = 127>
__device__ __forceinline__ void gemm_phase(LAS unsigned char* lds, const int Kel, const Sched& S, const Epi& E) {
    const int K = F8 ? Kel / 2 : Kel;
    int tid_ = threadIdx.x; asm volatile("" : "+v"(tid_));
    const int tid = tid_, wid = __builtin_amdgcn_readfirstlane(tid >> 6), lane = tid & 63, wr = wid >> 2, wc = wid & 3, fr = lane & 15, fq = lane >> 4;
    const int nt = K / BK;
    int sR[2], sC[2]; unsigned voffB[2];
#pragma unroll
    for (int i = 0; i < 2; ++i) { int R, C; stage_rc(tid * 16 + i * 8192, R, C); sR[i] = R; sC[i] = C; const int Rb = Epi::PERM ? ((R & ~31) + perm32(R & 31)) : R; voffB[i] = (unsigned)(Rb * K + C) * 2u; }
    const size_t kstep = (size_t)(BK * 2);
    const size_t hstep = (size_t)HALF * K * 2;
    const unsigned ldsw = (unsigned)wid * 1024u;
    const int aoff = lds_byte(wr * 64 + fr, fq * 8), boff = lds_byte(wc * 32 + fr, fq * 8);
#define PG8_SA(b, h) (((b) * 2 + (h)) * HTB)
#define PG8_SB(b, h) ((4 + (b) * 2 + (h)) * HTB)
#define PG8_STGB(bufoff, gbase) do { _Pragma("unroll") for (int _i = 0; _i < 2; ++_i) \
        __builtin_amdgcn_global_load_lds((const unsigned*)((const char*)(gbase) + voffB[_i]), (LAS unsigned*)(lds + (bufoff) + ldsw + _i * 8192), 16, 0, 0); } while (0)
#define PG8_STGA(bufoff, gbase, VO, h) do { _Pragma("unroll") for (int _i = 0; _i < 2; ++_i) \
        __builtin_amdgcn_global_load_lds((const unsigned*)((const char*)(gbase) + VO[h][_i]), (LAS unsigned*)(lds + (bufoff) + ldsw + _i * 8192), 16, 0, 0); } while (0)
#define PG8_VOA(u, VO) do { _Pragma("unroll") for (int _h = 0; _h < 2; ++_h) _Pragma("unroll") for (int _i = 0; _i < 2; ++_i) \
        VO[_h][_i] = Sched::GATHER ? (S.row_off(u, _h * HALF + sR[_i]) + (unsigned)sC[_i] * 2u) : ((unsigned)((_h * HALF + sR[_i]) * K + sC[_i]) * 2u); } while (0)
#define PG8_LDA(dst, b, h) do { _Pragma("unroll") for (int m = 0; m < 4; ++m) { if constexpr (F8) { dst##8[m].lo = *(const LAS i32x4*)(lds + PG8_SA(b, h) + aoff + m * 2048); dst##8[m].hi = *(const LAS i32x4*)(lds + PG8_SA(b, h) + aoff + m * 2048 + 1024); } else { _Pragma("unroll") for (int k = 0; k < 2; ++k) dst[m][k] = *(const LAS bf16x8*)(lds + PG8_SA(b, h) + aoff + m * 2048 + k * 1024); } } } while (0)
#define PG8_LDB(dst, b, h) do { _Pragma("unroll") for (int n = 0; n < 2; ++n) { if constexpr (F8) { dst##8[n].lo = *(const LAS i32x4*)(lds + PG8_SB(b, h) + boff + n * 2048); dst##8[n].hi = *(const LAS i32x4*)(lds + PG8_SB(b, h) + boff + n * 2048 + 1024); } else { _Pragma("unroll") for (int k = 0; k < 2; ++k) dst[n][k] = *(const LAS bf16x8*)(lds + PG8_SB(b, h) + boff + n * 2048 + k * 1024); } } } while (0)
#define PG8_MMA(ai, bj, At, Bt) do { __builtin_amdgcn_s_setprio(1); _Pragma("unroll") for (int m = 0; m < 4; ++m) _Pragma("unroll") for (int n = 0; n < 2; ++n) { \
        if constexpr (F8) { asm volatile("v_mfma_scale_f32_16x16x128_f8f6f4 %0, %1, %2, %0, %3, %4 op_sel_hi:[0,0,0]" : "+v"(acc[ai][bj][m][n]) : "v"(Bt##8[n]), "v"(At##8[m]), "v"(scw_), "v"(sca_)); } \
        else { _Pragma("unroll") for (int k = 0; k < 2; ++k) acc[ai][bj][m][n] = __builtin_amdgcn_mfma_f32_16x16x32_bf16(Bt[n][k], At[m][k], acc[ai][bj][m][n], 0, 0, 0); } } \
        __builtin_amdgcn_s_setprio(0); } while (0)
#define PG8_WAIT_V(n) asm volatile("s_waitcnt vmcnt(" #n ")" ::: "memory")
#define PG8_WAIT_L(n) asm volatile("s_waitcnt lgkmcnt(" #n ")" ::: "memory")
#define PG8_BAR __builtin_amdgcn_s_barrier()
#define PG8_SCHED __builtin_amdgcn_sched_barrier(0)
    Unit cur, nxt; int ui = 0;
    if (!S.next(0, cur)) return;
    f32x4 acc[2][2][4][2];
#pragma unroll
    for (int a = 0; a < 2; ++a)
#pragma unroll
        for (int b = 0; b < 2; ++b)
#pragma unroll
            for (int m = 0; m < 4; ++m)
#pragma unroll
                for (int n = 0; n < 2; ++n) acc[a][b][m][n] = (f32x4){0.f, 0.f, 0.f, 0.f};
    const int scw_ = SCALE_W, sca_ = 127;
    bf16x8 At[4][2], B0[2][2], B1[2][2]; i32x8 At8[4], B08[2], B18[2];
    unsigned voA[2][2], nvoA[2][2];
    PG8_VOA(cur, voA);
    if (Sched::GATHER) { asm volatile("s_waitcnt vmcnt(0)" ::: "memory"); }
    const char* cA = S.a_ptr(cur); const char* cB = S.b_ptr(cur);
    cur.par = 0; E.stage_rows(cur, lds, wid);
    PG8_STGB(PG8_SB(0, 0), cB); PG8_STGB(PG8_SB(0, 1), cB + hstep); PG8_STGA(PG8_SA(0, 0), cA, voA, 0); PG8_STGA(PG8_SA(0, 1), cA, voA, 1);
    if (wr == 1) PG8_BAR;
    PG8_WAIT_V(2); PG8_BAR;
    PG8_STGB(PG8_SB(1, 0), cB + kstep); PG8_STGA(PG8_SA(1, 0), cA + kstep, voA, 0); PG8_STGB(PG8_SB(1, 1), cB + hstep + kstep);
    PG8_WAIT_V(6); PG8_BAR;
    for (;;) {
        const bool has_next = S.next(ui + 1, nxt); nxt.par = (ui + 1) & 3;
        const char* nA = has_next ? S.a_ptr(nxt) : cA; const char* nB = has_next ? S.b_ptr(nxt) : cB;
        if (Sched::GATHER) { if (has_next) { PG8_VOA(nxt, nvoA); } else {
#pragma unroll
            for (int h = 0; h < 2; ++h)
#pragma unroll
                for (int i = 0; i < 2; ++i) nvoA[h][i] = voA[h][i]; } }
#pragma unroll 1
        for (int t = 0; t < nt; t += 2) {
            const bool last = (t == nt - 2);
            const char* a1 = cA + (size_t)(t + 1) * kstep;
            const char* a2 = last ? nA : cA + (size_t)(t + 2) * kstep; const char* b2 = last ? nB : cB + (size_t)(t + 2) * kstep;
            const char* a3 = a2 + kstep; const char* b3 = b2 + kstep;
            unsigned vo2[2][2];
#pragma unroll
            for (int h = 0; h < 2; ++h)
#pragma unroll
                for (int i = 0; i < 2; ++i) vo2[h][i] = (Sched::GATHER && last) ? nvoA[h][i] : voA[h][i];
            if (last && has_next) E.stage_rows(nxt, lds, wid);
            PG8_LDB(B0, 0, 0); PG8_LDB(B1, 0, 1); PG8_SCHED; PG8_LDA(At, 0, 0); PG8_STGA(PG8_SA(1, 1), a1, voA, 1);
            PG8_WAIT_V(8); PG8_WAIT_L(0); PG8_BAR; PG8_MMA(0, 0, At, B0); PG8_MMA(0, 1, At, B1); PG8_BAR; PG8_SCHED;
            PG8_LDA(At, 0, 1); PG8_STGB(PG8_SB(0, 0), b2); PG8_STGB(PG8_SB(0, 1), b2 + hstep); PG8_STGA(PG8_SA(0, 0), a2, vo2, 0);
            PG8_WAIT_V(8); PG8_WAIT_L(0); PG8_BAR; PG8_MMA(1, 0, At, B0); PG8_MMA(1, 1, At, B1); PG8_BAR; PG8_SCHED;
            PG8_LDB(B0, 1, 0); PG8_LDB(B1, 1, 1); PG8_SCHED; PG8_LDA(At, 1, 0); PG8_STGA(PG8_SA(0, 1), a2, vo2, 1);
            PG8_WAIT_V(8); PG8_WAIT_L(0); PG8_BAR; PG8_MMA(0, 0, At, B0); PG8_MMA(0, 1, At, B1); PG8_BAR; PG8_SCHED;
            PG8_LDA(At, 1, 1); PG8_STGB(PG8_SB(1, 0), b3); PG8_STGB(PG8_SB(1, 1), b3 + hstep); PG8_STGA(PG8_SA(1, 0), a3, vo2, 0);
            PG8_WAIT_V(8); PG8_WAIT_L(0); PG8_BAR; PG8_MMA(1, 0, At, B0); PG8_MMA(1, 1, At, B1); PG8_BAR; PG8_SCHED;
        }
        if constexpr (F8) asm volatile("s_nop 15\n\ts_nop 15\n\ts_nop 15" ::: "memory");
        if constexpr (ALIGN_EPI) { if (wr == 0) PG8_BAR; }
        E(acc, cur, wr, wc, fr, fq);
        if (!has_next) break;
#pragma unroll
        for (int a = 0; a < 2; ++a)
#pragma unroll
            for (int b = 0; b < 2; ++b)
#pragma unroll
                for (int m = 0; m < 4; ++m)
#pragma unroll
                    for (int n = 0; n < 2; ++n) acc[a][b][m][n] = (f32x4){0.f, 0.f, 0.f, 0.f};
        cur = nxt; cA = nA; cB = nB; ++ui;
        if (Sched::GATHER) {
#pragma unroll
            for (int h = 0; h < 2; ++h)
#pragma unroll
                for (int i = 0; i < 2; ++i) voA[h][i] = nvoA[h][i]; }
        if constexpr (ALIGN_EPI) { if (wr == 1) PG8_BAR; }
    }
    PG8_WAIT_V(0);
    if constexpr (!ALIGN_EPI) { if (wr == 0) PG8_BAR; }
    PG8_BAR;
#undef PG8_SA
#undef PG8_SB
#undef PG8_STGA
#undef PG8_STGB
#undef PG8_VOA
#undef PG8_LDA
#undef PG8_LDB
#undef PG8_MMA
#undef PG8_WAIT_V
#undef PG8_WAIT_L
#undef PG8_BAR
#undef PG8_SCHED
}

typedef f32x4 Acc[2][2][4][2];
struct EpiInProj {
    static constexpr bool PERM = true;
    __device__ __forceinline__ void stage_rows(const Unit&, LAS unsigned char*, int) const {}
    bf16_t *prw, *puv, *pg;
    template <int ACT> __device__ __forceinline__ void tile(const Acc& acc, bf16_t* base, int ld, int row0, int col0) const {
#pragma unroll
        for (int ai = 0; ai < 2; ++ai)
#pragma unroll
            for (int m = 0; m < 4; ++m) { bf16_t* rowp = base + (size_t)(row0 + ai * HALF + m * 16) * ld + col0;
#pragma unroll
                for (int bj = 0; bj < 2; ++bj) { f32x4 v0 = acc[ai][bj][m][0], v1 = acc[ai][bj][m][1];
                    if (ACT == 1) {
#pragma unroll
                        for (int j = 0; j < 4; ++j) { v0[j] = gelu_tanh(v0[j]); v1[j] = gelu_tanh(v1[j]); } }
                    if (ACT == 2) {
#pragma unroll
                        for (int j = 0; j < 4; ++j) { v0[j] = sigmoidf_(v0[j]); v1[j] = sigmoidf_(v1[j]); } }
                    u32x4 w; w.x = pk2(v0[0], v0[1]); w.y = pk2(v0[2], v0[3]); w.z = pk2(v1[0], v1[1]); w.w = pk2(v1[2], v1[3]);
                    *(u32x4*)(rowp + bj * HALF) = w; }
                __builtin_amdgcn_sched_barrier(0); }
    }
    __device__ __forceinline__ void operator()(const Acc& acc, const Unit& u, int wr, int wc, int fr, int fq) const {
        const int row0 = u.row0 + wr * 64 + fr, cw = wc * 32 + 8 * fq;
        if (u.pn < 7) tile<0>(acc, prw, RWKV_COLS, row0, u.pn * 256 + cw);
        else if (u.pn < 11) tile<1>(acc, puv, 1024, row0, (u.pn - 7) * 256 + cw);
        else tile<2>(acc, pg, 2048, row0, (u.pn - 11) * 256 + cw);
    }
};
template <bool SECOND> struct EpiMerge {
    static constexpr bool PERM = true;
    __device__ __forceinline__ void stage_rows(const Unit&, LAS unsigned char*, int) const {}
    bf16_t* m1; const bf16_t* pg; unsigned char* m8;
    __device__ __forceinline__ void operator()(const Acc& acc, const Unit& u, int wr, int wc, int fr, int fq) const {
        const int row0 = u.row0 + wr * 64 + fr, col0 = u.pn * 256 + wc * 32 + 8 * fq;
#pragma unroll
        for (int ai = 0; ai < 2; ++ai)
#pragma unroll
            for (int m = 0; m < 4; ++m) { const size_t r = (size_t)(row0 + ai * HALF + m * 16);
#pragma unroll
                for (int bj = 0; bj < 2; ++bj) { const int c = col0 + bj * HALF;
                    const u32x4 g = *(const u32x4*)(pg + r * 2048 + (SECOND ? 1024 : 0) + c);
                    f32x4 v0 = acc[ai][bj][m][0], v1 = acc[ai][bj][m][1];
                    v0[0] *= bflo(g.x); v0[1] *= bfhi(g.x); v0[2] *= bflo(g.y); v0[3] *= bfhi(g.y); v1[0] *= bflo(g.z); v1[1] *= bfhi(g.z); v1[2] *= bflo(g.w); v1[3] *= bfhi(g.w);
                    if (SECOND) { const u32x4 p = *(const u32x4*)(m1 + r * 1024 + c);
                        v0[0] += bflo(p.x); v0[1] += bfhi(p.x); v0[2] += bflo(p.y); v0[3] += bfhi(p.y); v1[0] += bflo(p.z); v1[1] += bfhi(p.z); v1[2] += bflo(p.w); v1[3] += bfhi(p.w); }
                    if (SECOND) *(u32x2*)(m8 + r * 1024 + c) = pk8(v0, v1);
                    else { u32x4 w; w.x = pk2(v0[0], v0[1]); w.y = pk2(v0[2], v0[3]); w.z = pk2(v1[0], v1[1]); w.w = pk2(v1[2], v1[3]); *(u32x4*)(m1 + r * 1024 + c) = w; } }
                __builtin_amdgcn_sched_barrier(0); }
    }
};
struct EpiResid {
    static constexpr bool PERM = true;
    __device__ __forceinline__ void stage_rows(const Unit&, LAS unsigned char*, int) const {}
    bf16_t* out; const float* base; const float* gate;
    __device__ __forceinline__ void operator()(const Acc& acc, const Unit& u, int wr, int wc, int fr, int fq) const {
        const int row0 = u.row0 + wr * 64 + fr, col0 = u.pn * 256 + wc * 32 + 8 * fq;
        const float* gp = gate + (size_t)(u.row0 >> 13) * 6144 + col0;
        f32x4 gv[2][2];
#pragma unroll
        for (int bj = 0; bj < 2; ++bj)
#pragma unroll
            for (int n = 0; n < 2; ++n) gv[bj][n] = *(const f32x4*)(gp + bj * HALF + n * 4);
#pragma unroll
        for (int ai = 0; ai < 2; ++ai)
#pragma unroll
            for (int m = 0; m < 4; ++m) { const size_t ro = (size_t)(row0 + ai * HALF + m * 16) * 1024 + col0;
#pragma unroll
                for (int bj = 0; bj < 2; ++bj) { const f32x4 b0 = *(const f32x4*)(base + ro + bj * HALF), b1 = *(const f32x4*)(base + ro + bj * HALF + 4);
                    const f32x4 v0 = b0 + gv[bj][0] * acc[ai][bj][m][0], v1 = b1 + gv[bj][1] * acc[ai][bj][m][1];
                    u32x4 w; w.x = pk2(v0[0], v0[1]); w.y = pk2(v0[2], v0[3]); w.z = pk2(v1[0], v1[1]); w.w = pk2(v1[2], v1[3]);
                    *(u32x4*)(out + ro + bj * HALF) = w; }
                __builtin_amdgcn_sched_barrier(0); }
    }
};
struct EpiRouter {
    static constexpr bool PERM = false;
    __device__ __forceinline__ void stage_rows(const Unit&, LAS unsigned char*, int) const {}
    float* sc;
    __device__ __forceinline__ void operator()(const Acc& acc, const Unit& u, int wr, int wc, int fr, int fq) const {
        const int row0 = u.row0 + wr * 64 + fr, col0 = wc * 32 + 4 * fq;
#pragma unroll
        for (int ai = 0; ai < 2; ++ai)
#pragma unroll
            for (int m = 0; m < 4; ++m) { float* rowp = sc + (size_t)(row0 + ai * HALF + m * 16) * 256 + col0;
#pragma unroll
                for (int bj = 0; bj < 2; ++bj)
#pragma unroll
                    for (int n = 0; n < 2; ++n) { f32x4 v = acc[ai][bj][m][n];
#pragma unroll
                        for (int j = 0; j < 4; ++j) v[j] = sigmoidf_(v[j]);
                        *(f32x4*)(rowp + bj * HALF + n * 16) = v; }
                __builtin_amdgcn_sched_barrier(0); }
    }
};
template <bool F8OUT> struct EpiGateUp {
    static constexpr bool PERM = true;
    __device__ __forceinline__ void stage_rows(const Unit&, LAS unsigned char*, int) const {}
    void* hid;
    __device__ __forceinline__ void operator()(const Acc& acc, const Unit& u, int wr, int wc, int fr, int fq) const {
        const int row0 = u.row0 + wr * 64 + fr, col0 = u.pn * HALF + wc * 32 + 8 * fq;
#pragma unroll
        for (int ai = 0; ai < 2; ++ai)
#pragma unroll
            for (int m = 0; m < 4; ++m) { const size_t off = (size_t)(row0 + ai * HALF + m * 16) * EFF + col0;
                f32x4 v0, v1;
#pragma unroll
                for (int j = 0; j < 4; ++j) { v0[j] = siluf_(acc[ai][0][m][0][j]) * acc[ai][1][m][0][j]; v1[j] = siluf_(acc[ai][0][m][1][j]) * acc[ai][1][m][1][j]; }
                if constexpr (F8OUT) *(u32x2*)((unsigned char*)hid + off) = pk8(v0, v1);
                else { u32x4 w; w.x = pk2(v0[0], v0[1]); w.y = pk2(v0[2], v0[3]); w.z = pk2(v1[0], v1[1]); w.w = pk2(v1[2], v1[3]); *(u32x4*)((bf16_t*)hid + off) = w; }
                __builtin_amdgcn_sched_barrier(0); }
    }
};
struct EpiExpertDown {
    static constexpr bool PERM = true;
    unsigned char* slot; const int* rowdst; const float* roww;
    __device__ __forceinline__ void stage_rows(const Unit& u, LAS unsigned char* lds, int wid) const {
        if (wid < 4) { const int lane = threadIdx.x & 63; LAS unsigned char* base = lds + LDS_MISC + u.par * 2048 + wid * 256;
            __builtin_amdgcn_global_load_lds((const unsigned*)(rowdst + u.row0 + wid * 64 + lane), (LAS unsigned*)base, 4, 0, 0);
            __builtin_amdgcn_global_load_lds((const unsigned*)(roww + u.row0 + wid * 64 + lane), (LAS unsigned*)(base + 1024), 4, 0, 0); }
    }
    __device__ __forceinline__ void operator()(const Acc& acc, const Unit& u, int wr, int wc, int fr, int fq) const {
        const unsigned cb = (unsigned)(u.pn * 256 + wc * 32 + 8 * fq);
        const LAS int* td = (const LAS int*)((LAS unsigned char*)nullptr + LDS_MISC + u.par * 2048) + wr * 64 + fr; const LAS float* tw = (const LAS float*)(td + 256);
#pragma unroll
        for (int ai = 0; ai < 2; ++ai)
#pragma unroll
            for (int m = 0; m < 4; ++m) {
                const int dst = td[ai * HALF + m * 16]; const float ws_ = tw[ai * HALF + m * 16];
                if (dst >= 0) { unsigned char* rowp = slot + (size_t)((unsigned)dst * 1024u + cb);
#pragma unroll
                    for (int bj = 0; bj < 2; ++bj) { const f32x4 v0 = acc[ai][bj][m][0] * ws_, v1 = acc[ai][bj][m][1] * ws_;
                        *(u32x2*)(rowp + bj * HALF) = pk8(v0, v1); } }
                __builtin_amdgcn_sched_barrier(0);
            }
    }
};
struct EpiSharedDown {
    static constexpr bool PERM = true;
    unsigned char* sho;
    __device__ __forceinline__ void stage_rows(const Unit&, LAS unsigned char*, int) const {}
    __device__ __forceinline__ void operator()(const Acc& acc, const Unit& u, int wr, int wc, int fr, int fq) const {
        const int row0 = u.row0 + wr * 64 + fr, col0 = u.pn * 256 + wc * 32 + 8 * fq;
#pragma unroll
        for (int ai = 0; ai < 2; ++ai)
#pragma unroll
            for (int m = 0; m < 4; ++m) { unsigned char* rowp = sho + (size_t)(row0 + ai * HALF + m * 16) * 1024 + col0;
#pragma unroll
                for (int bj = 0; bj < 2; ++bj) *(u32x2*)(rowp + bj * HALF) = pk8(acc[ai][bj][m][0], acc[ai][bj][m][1]);
                __builtin_amdgcn_sched_barrier(0); }
    }
};
}
__device__ __forceinline__ void phase_mod(const float* c, const float* ada_w, const float* ada_b, float* mod, LAS unsigned char* lds, int tid, int G) {
    LAS float* sl = (LAS float*)lds; LAS float* red = (LAS float*)(lds + 32768);
    for (int i = tid; i < NB * D; i += NTHREADS) { const float v = c[i]; sl[i] = siluf_(v); }
    __syncthreads();
    const int cl = tid % 24, kg = tid / 24;
    for (int cb = blockIdx.x; cb < 256; cb += G) {
        const int col0 = cb * 24;
        if (tid < 384) {
            float a[NB];
#pragma unroll
            for (int b = 0; b < NB; ++b) a[b] = 0.f;
            for (int k = kg; k < D; k += 16) { const float w = ada_w[(size_t)k * 6144 + col0 + cl];
#pragma unroll
                for (int b = 0; b < NB; ++b) a[b] += sl[b * D + k] * w; }
#pragma unroll
            for (int b = 0; b < NB; ++b) red[(kg * 24 + cl) * NB + b] = a[b];
        }
        __syncthreads();
        if (tid < 192) { const int c2 = tid >> 3, b = tid & 7; float s = 0.f;
#pragma unroll
            for (int g = 0; g < 16; ++g) s += red[(g * 24 + c2) * NB + b];
            mod[(size_t)b * 6144 + col0 + c2] = s + ada_b[col0 + c2]; }
        __syncthreads();
    }
}
__device__ __forceinline__ void transpose_item(const float* W, int ldw, int k0, int n0, bf16_t* WT, int ldt, int drow0, LAS float* scr, int lane) {
#pragma unroll 8
    for (int i = 0; i < 32; ++i) { const int kk = 2 * i + (lane >> 5); scr[kk * 33 + (lane & 31)] = W[(size_t)(k0 + kk) * ldw + n0 + (lane & 31)]; }
    LDS_WAIT(); asm volatile("" ::: "memory");
    const int c = lane & 7;
#pragma unroll
    for (int j = 0; j < 4; ++j) { const int n = (lane >> 3) + 8 * j; const LAS float* s = scr + (8 * c) * 33 + n;
        u32x4 o; o.x = pk2(s[0 * 33], s[1 * 33]); o.y = pk2(s[2 * 33], s[3 * 33]); o.z = pk2(s[4 * 33], s[5 * 33]); o.w = pk2(s[6 * 33], s[7 * 33]);
        *(u32x4*)(WT + (size_t)(drow0 + n) * ldt + k0 + 8 * c) = o; }
    LDS_WAIT(); asm volatile("" ::: "memory");
}
__device__ __forceinline__ void transpose_job(const float* W, int K, int N, bf16_t* WT, int gated, int goff, int item, LAS float* scr, int lane) {
    const int nblk = N / 32, kb = item / nblk, nb = item % nblk, n0 = 32 * nb;
    const int drow0 = gated ? (256 * (n0 >> 7) + goff + (n0 & 127)) : n0;
    transpose_item(W, N, 64 * kb, n0, WT, K, drow0, scr, lane);
}
__device__ __forceinline__ void transpose_item64(const float* W, int ldw, int k0, int n0, bf16_t* WT, int ldt, int drow0, LAS float* scr, int lane) {
    f32x4 v[16];
    const int c4 = lane & 15, r4 = lane >> 4;
#pragma unroll
    for (int i = 0; i < 16; ++i) v[i] = *(const f32x4*)(W + (size_t)(k0 + 4 * i + r4) * ldw + n0 + 4 * c4);
#pragma unroll
    for (int i = 0; i < 16; ++i) { LAS float* d = scr + (4 * i + r4) * 65 + 4 * c4; d[0] = v[i].x; d[1] = v[i].y; d[2] = v[i].z; d[3] = v[i].w; }
    LDS_WAIT(); asm volatile("" ::: "memory");
    const int c = lane & 7;
#pragma unroll
    for (int j = 0; j < 8; ++j) { const int n = (lane >> 3) + 8 * j; const LAS float* s = scr + (8 * c) * 65 + n;
        u32x4 o; o.x = pk2(s[0 * 65], s[1 * 65]); o.y = pk2(s[2 * 65], s[3 * 65]); o.z = pk2(s[4 * 65], s[5 * 65]); o.w = pk2(s[6 * 65], s[7 * 65]);
        *(u32x4*)(WT + (size_t)(drow0 + n) * ldt + k0 + 8 * c) = o; }
    LDS_WAIT(); asm volatile("" ::: "memory");
}
constexpr float WSCALE = 32.0f;
__device__ __forceinline__ void transpose_item64_f8(const float* W, int ldw, int k0, int n0, unsigned char* WT8, int ldt, int drow0, LAS float* scr, int lane) {
    f32x4 v[16];
    const int c4 = lane & 15, r4 = lane >> 4;
#pragma unroll
    for (int i = 0; i < 16; ++i) v[i] = *(const f32x4*)(W + (size_t)(k0 + 4 * i + r4) * ldw + n0 + 4 * c4);
#pragma unroll
    for (int i = 0; i < 16; ++i) { LAS float* d = scr + (4 * i + r4) * 65 + 4 * c4; d[0] = v[i].x; d[1] = v[i].y; d[2] = v[i].z; d[3] = v[i].w; }
    LDS_WAIT(); asm volatile("" ::: "memory");
    const int c = lane & 7;
#pragma unroll
    for (int j = 0; j < 8; ++j) { const int n = (lane >> 3) + 8 * j; const LAS float* s = scr + (8 * c) * 65 + n;
        const f32x4 lo = (f32x4){s[0 * 65], s[1 * 65], s[2 * 65], s[3 * 65]} * WSCALE, hi = (f32x4){s[4 * 65], s[5 * 65], s[6 * 65], s[7 * 65]} * WSCALE;
        *(u32x2*)(WT8 + (size_t)(drow0 + n) * ldt + k0 + 8 * c) = pk8(lo, hi); }
    LDS_WAIT(); asm volatile("" ::: "memory");
}
struct SmallW { const float *w_in, *w_out_a, *w_out_b, *w_out, *router_w, *sw1, *sw3, *sw2, *w_up, *a_up, *g_up, *gws; };
__device__ __forceinline__ void phase_small_weights(const SmallW& P, unsigned char* ws, LAS unsigned char* lds, int gw, int NGW, int wave, int lane) {
    LAS float* scr = (LAS float*)(lds + wave * 16640);
    constexpr int I0 = 16 * 76, I1 = 8 * 16, I2 = 8 * 16, I3 = 16 * 16, I4 = 16 * 8, I5 = 16 * 4, I6 = 16 * 4, I7 = 4 * 16, I8 = 16, I9 = 16, I10 = 2 * 16;
    constexpr int NIT = I0 + I1 + I2 + I3 + I4 + I5 + I6 + I7 + I8 + I9 + I10;
    for (int it = gw; it < NIT; it += NGW) {
        int r = it;
        if (r < I0) { const int kb = r / 76, nb = r % 76; transpose_item64_f8(P.w_in, IN_COLS, 64 * kb, 64 * nb, ws + SW_WIN, D, 64 * nb, scr, lane); continue; } r -= I0;
        if (r < I1) { transpose_item64_f8(P.w_out_a, D, 64 * (r >> 4), 64 * (r & 15), ws + SW_WOA, RW, 64 * (r & 15), scr, lane); continue; } r -= I1;
        if (r < I2) { transpose_item64_f8(P.w_out_b, D, 64 * (r >> 4), 64 * (r & 15), ws + SW_WOB, RW, 64 * (r & 15), scr, lane); continue; } r -= I2;
        if (r < I3) { transpose_item64_f8(P.w_out, D, 64 * (r >> 4), 64 * (r & 15), ws + SW_WO, D, 64 * (r & 15), scr, lane); continue; } r -= I3;
        if (r < I4) { transpose_job(P.router_w, D, NE, (bf16_t*)(ws + SW_WR), 0, 0, r, scr, lane); continue; } r -= I4;
        if (r < I5) { const int n0 = 64 * (r & 3); transpose_item64_f8(P.sw1, EFF, 64 * (r >> 2), n0, ws + SW_WS13, D, 256 * (n0 >> 7) + (n0 & 127), scr, lane); continue; } r -= I5;
        if (r < I6) { const int n0 = 64 * (r & 3); transpose_item64_f8(P.sw3, EFF, 64 * (r >> 2), n0, ws + SW_WS13, D, 256 * (n0 >> 7) + 128 + (n0 & 127), scr, lane); continue; } r -= I6;
        if (r < I7) { transpose_item64_f8(P.sw2, D, 64 * (r >> 4), 64 * (r & 15), ws + SW_WS2, EFF, 64 * (r & 15), scr, lane); continue; } r -= I7;
        if (r < I8) { transpose_job(P.w_up, 64, RW, (bf16_t*)(ws + SW_WUP), 0, 0, r, scr, lane); continue; } r -= I8;
        if (r < I9) { transpose_job(P.a_up, 64, RW, (bf16_t*)(ws + SW_AUP), 0, 0, r, scr, lane); continue; } r -= I9;
        transpose_job(P.g_up, 128, RW, (bf16_t*)(ws + SW_GUP), 0, 0, r, scr, lane);
    }
    bf16_t* wsm = (bf16_t*)(ws + SW_WSM);
    for (int i = gw * 64 + lane; i < 8 * 128 * 128; i += NGW * 64) { const int col = i & 127, row = (i >> 7) & 127; wsm[i] = (col <= row) ? f2bf(P.gws[i]) : (bf16_t)0; }
}
__device__ __forceinline__ void phase_expert_weights(const float* w1, const float* w3, const float* w2, unsigned char* ws, LAS unsigned char* lds, int gw, int NGW, int wave, int lane) {
    LAS float* scr = (LAS float*)(lds + wave * 16640);
    constexpr int PER = 64;
    for (int it = gw; it < NE * 3 * PER; it += NGW) {
        const int e = it / (3 * PER), r = it % (3 * PER), which = r / PER, item = r % PER;
        if (which < 2) { const int kb = item >> 2, nb = item & 3, n0 = 64 * nb;
            transpose_item64_f8((which ? w3 : w1) + (size_t)e * D * EFF, EFF, 64 * kb, n0, ws + B_W13 + (size_t)e * 512 * D, D, 256 * (n0 >> 7) + which * 128 + (n0 & 127), scr, lane); }
        else { const int kb = item >> 4, nb = item & 15;
            transpose_item64_f8(w2 + (size_t)e * EFF * D, D, 64 * kb, 64 * nb, ws + B_W2 + (size_t)e * D * EFF, EFF, 64 * nb, scr, lane); }
    }
}
template <bool XBF>
__device__ __forceinline__ void phase_norm_mod(const void* X, const float* gain, const float* mod, int sh_off, int sc_off, bf16_t* out, unsigned char* out8, int gw, int NGW, int lane) {
    constexpr int R = 4;
    for (int m0 = gw; m0 < T; m0 += R * NGW) {
        f32x4 v[R][4];
#pragma unroll
        for (int rr = 0; rr < R; ++rr) { const int m = m0 + rr * NGW; const size_t mr = (size_t)(m < T ? m : m0);
            if constexpr (XBF) { const u32x2* xr = (const u32x2*)((const bf16_t*)X + mr * D) + lane;
#pragma unroll
                for (int j = 0; j < 4; ++j) { const u32x2 w = xr[64 * j]; v[rr][j] = (f32x4){bflo(w.x), bfhi(w.x), bflo(w.y), bfhi(w.y)}; } }
            else { const f32x4* xr = (const f32x4*)((const float*)X + mr * D) + lane;
#pragma unroll
                for (int j = 0; j < 4; ++j) v[rr][j] = xr[64 * j]; } }
#pragma unroll
        for (int rr = 0; rr < R; ++rr) { const int m = m0 + rr * NGW; if (m >= T) break;
            float ss = 0.f;
#pragma unroll
            for (int j = 0; j < 4; ++j) ss += (v[rr][j].x * v[rr][j].x + v[rr][j].y * v[rr][j].y) + (v[rr][j].z * v[rr][j].z + v[rr][j].w * v[rr][j].w);
            const float rstd = __builtin_amdgcn_rsqf(wave_sum(ss) * (1.f / D) + 1e-6f);
            const float* mb = mod + (size_t)(m >> 13) * 6144;
            u32x2* o8 = (u32x2*)(out + (size_t)m * D) + lane;
#pragma unroll
            for (int j = 0; j < 4; ++j) { const int col = 4 * lane + 256 * j;
                const f32x4 g = *(const f32x4*)(gain + col), sc = *(const f32x4*)(mb + sc_off + col), sh = *(const f32x4*)(mb + sh_off + col);
                const f32x4 y = v[rr][j] * rstd * g * (sc + 1.0f) + sh;
                if (out) { u32x2 w; w.x = pk2(y.x, y.y); w.y = pk2(y.z, y.w); o8[64 * j] = w; }
                if (out8) { int t8 = __builtin_amdgcn_cvt_pk_fp8_f32(y.x, y.y, 0, false); t8 = __builtin_amdgcn_cvt_pk_fp8_f32(y.z, y.w, t8, true); *(unsigned*)(out8 + (size_t)m * D + col) = (unsigned)t8; } } }
    }
}
struct YaArgs { bf16_t* ya; const bf16_t* g; const bf16_t* prw; const float* sbon; const float* mu; const float* ln_g; const float* ln_b; };
__device__ __forceinline__ void phase_ya_final(const YaArgs& P, int gw, int NGW, int lane) {
    const int ch0 = lane * 8, head = lane >> 3;
    float muv[8], lg[8], lb[8];
#pragma unroll
    for (int j = 0; j < 8; ++j) { muv[j] = P.mu[1024 + ch0 + j]; lg[j] = P.ln_g[ch0 + j]; lb[j] = P.ln_b[ch0 + j]; }
    for (int m = gw; m < T; m += NGW) {
        const u32x4 yw = *(const u32x4*)(P.ya + (size_t)m * RW + ch0);
        const u32x4 gw4 = *(const u32x4*)(P.g + (size_t)m * RW + ch0);
        const u32x4 vc = *(const u32x4*)(P.prw + (size_t)m * RWKV_COLS + 1024 + ch0);
        u32x4 vp = (u32x4){0u, 0u, 0u, 0u};
        if ((m & (SEQ - 1)) != 0) vp = *(const u32x4*)(P.prw + (size_t)(m - 1) * RWKV_COLS + 1024 + ch0);
        const float sb = P.sbon[(size_t)m * NH + head];
        float y[8], gg[8], vv[8], pv[8];
        y[0] = bflo(yw.x); y[1] = bfhi(yw.x); y[2] = bflo(yw.y); y[3] = bfhi(yw.y); y[4] = bflo(yw.z); y[5] = bfhi(yw.z); y[6] = bflo(yw.w); y[7] = bfhi(yw.w);
        gg[0] = bflo(gw4.x); gg[1] = bfhi(gw4.x); gg[2] = bflo(gw4.y); gg[3] = bfhi(gw4.y); gg[4] = bflo(gw4.z); gg[5] = bfhi(gw4.z); gg[6] = bflo(gw4.w); gg[7] = bfhi(gw4.w);
        vv[0] = bflo(vc.x); vv[1] = bfhi(vc.x); vv[2] = bflo(vc.y); vv[3] = bfhi(vc.y); vv[4] = bflo(vc.z); vv[5] = bfhi(vc.z); vv[6] = bflo(vc.w); vv[7] = bfhi(vc.w);
        pv[0] = bflo(vp.x); pv[1] = bfhi(vp.x); pv[2] = bflo(vp.y); pv[3] = bfhi(vp.y); pv[4] = bflo(vp.z); pv[5] = bfhi(vp.z); pv[6] = bflo(vp.w); pv[7] = bfhi(vp.w);
        float s = 0.f;
#pragma unroll
        for (int j = 0; j < 8; ++j) s += y[j];
        s += __shfl_xor(s, 1); s += __shfl_xor(s, 2); s += __shfl_xor(s, 4);
        const float mean = s * (1.f / 64.f); float q = 0.f;
#pragma unroll
        for (int j = 0; j < 8; ++j) { y[j] -= mean; q += y[j] * y[j]; }
        q += __shfl_xor(q, 1); q += __shfl_xor(q, 2); q += __shfl_xor(q, 4);
        const float rstd = __builtin_amdgcn_rsqf(q * (1.f / 64.f) + 64e-5f);
        float o[8];
#pragma unroll
        for (int j = 0; j < 8; ++j) { const float vs = vv[j] + (pv[j] - vv[j]) * muv[j]; o[j] = (y[j] * rstd * lg[j] + lb[j] + sb * vs) * gg[j]; }
        u32x4 w; w.x = pk2(o[0], o[1]); w.y = pk2(o[2], o[3]); w.z = pk2(o[4], o[5]); w.w = pk2(o[6], o[7]);
        *(u32x4*)(P.ya + (size_t)m * RW + ch0) = w;
    }
}
__device__ __forceinline__ void phase_xs(const bf16_t* prw, const float* mu, bf16_t* xs, int gw, int NGW, int lane) {
    const f32x4 m4 = *(const f32x4*)(mu + 1536 + 4 * lane);
    for (int t = gw; t < T; t += NGW) {
        const bf16_t* src = prw + (size_t)t * RWKV_COLS + 1536 + 4 * lane;
        const u32x2 cw = *(const u32x2*)src; u32x2 pw = (u32x2){0u, 0u};
        if ((t & (SEQ - 1)) != 0) pw = *(const u32x2*)(src - RWKV_COLS);
        f32x4 v = (f32x4){bflo(cw.x), bfhi(cw.x), bflo(cw.y), bfhi(cw.y)}; const f32x4 p = (f32x4){bflo(pw.x), bfhi(pw.x), bflo(pw.y), bfhi(pw.y)};
        v = v + (p - v) * m4;
        if (lane < 16) {
#pragma unroll
            for (int j = 0; j < 4; ++j) v[j] = tanhf_(v[j]); }
        else if (lane >= 32) {
#pragma unroll
            for (int j = 0; j < 4; ++j) v[j] = sigmoidf_(v[j]); }
        u32x2 w; w.x = pk2(v[0], v[1]); w.y = pk2(v[2], v[3]);
        *(u32x2*)(xs + (size_t)t * 256 + 4 * lane) = w;
    }
}
__device__ __forceinline__ void phase_combine(float* out, const bf16_t* x1, const unsigned char* slot, const unsigned char* sho, const float* mod, const float* normf, int gw, int NGW, int lane) {
    for (int m = gw; m < T; m += NGW) {
        const int b = m >> 13;
        f32x4* xr = (f32x4*)(out + (size_t)m * D + 16 * lane);
        const float* g2 = mod + (size_t)b * 6144 + 5120 + 16 * lane;
        u32x4 sw[TOPK + 1];
#pragma unroll
        for (int k = 0; k < TOPK; ++k) sw[k] = *(const u32x4*)(slot + ((size_t)m * TOPK + k) * D + 16 * lane);
        sw[TOPK] = *(const u32x4*)(sho + (size_t)m * D + 16 * lane);
        f32x4 x[4];
        { const u32x4 w0 = *(const u32x4*)(x1 + (size_t)m * D + 16 * lane), w1 = *(const u32x4*)(x1 + (size_t)m * D + 16 * lane + 8);
          x[0] = (f32x4){bflo(w0.x), bfhi(w0.x), bflo(w0.y), bfhi(w0.y)}; x[1] = (f32x4){bflo(w0.z), bfhi(w0.z), bflo(w0.w), bfhi(w0.w)};
          x[2] = (f32x4){bflo(w1.x), bfhi(w1.x), bflo(w1.y), bfhi(w1.y)}; x[3] = (f32x4){bflo(w1.z), bfhi(w1.z), bflo(w1.w), bfhi(w1.w)}; }
        f32x4 a[4];
#pragma unroll
        for (int j = 0; j < 4; ++j) a[j] = (f32x4){0.f, 0.f, 0.f, 0.f};
#pragma unroll
        for (int k = 0; k <= TOPK; ++k) { a[0] += up8(sw[k].x); a[1] += up8(sw[k].y); a[2] += up8(sw[k].z); a[3] += up8(sw[k].w); }
        float ss = 0.f;
#pragma unroll
        for (int j = 0; j < 4; ++j) { x[j] = x[j] + *(const f32x4*)(g2 + 4 * j) * a[j]; ss += (x[j].x * x[j].x + x[j].y * x[j].y) + (x[j].z * x[j].z + x[j].w * x[j].w); }
        const float rstd = __builtin_amdgcn_rsqf(wave_sum(ss) * (1.f / D) + 1e-6f);
#pragma unroll
        for (int j = 0; j < 4; ++j) xr[j] = x[j] * rstd * *(const f32x4*)(normf + 16 * lane + 4 * j);
    }
}
namespace rk {
constexpr int LD = 72;
constexpr int SLOTB = 64 * LD * 2;
constexpr int LDG = 136;
typedef LAS bf16_t* lp;
__device__ __forceinline__ lp slot(LAS unsigned char* lds, int i) { return (lp)(lds + i * SLOTB); }
template <int KS>
__device__ __forceinline__ void mm_nt(const LAS bf16_t* X, int ldx, const LAS bf16_t* Y, int ldy, int m, int nt0, int r, int q, f32x4 (&acc)[2]) {
#pragma unroll
    for (int s = 0; s < KS; ++s) {
        const bf16x8 a = *(const LAS bf16x8*)(X + (16 * m + r) * ldx + 32 * s + 8 * q);
#pragma unroll
        for (int n = 0; n < 2; ++n) { const bf16x8 b = *(const LAS bf16x8*)(Y + (16 * (nt0 + n) + r) * ldy + 32 * s + 8 * q); acc[n] = __builtin_amdgcn_mfma_f32_16x16x32_bf16(a, b, acc[n], 0, 0, 0); }
    }
}
__device__ __forceinline__ void st_rm(lp dst, int m, int nt, int r, int q, const f32x4& a) {
#pragma unroll
    for (int ii = 0; ii < 4; ++ii) dst[(16 * m + 4 * q + ii) * LD + 16 * nt + r] = f2bf(a[ii]);
}
__device__ __forceinline__ void st_tr(lp dst, int m, int nt, int r, int q, const f32x4& a) {
    u32x2 w; w.x = pk2(a[0], a[1]); w.y = pk2(a[2], a[3]); *(LAS u32x2*)(dst + (16 * nt + r) * LD + 16 * m + 4 * q) = w;
}
__device__ __forceinline__ void ld_rm(const LAS bf16_t* src, int m, int nt, int r, int q, f32x4& a) {
#pragma unroll
    for (int ii = 0; ii < 4; ++ii) a[ii] = bf2f(src[(16 * m + 4 * q + ii) * LD + 16 * nt + r]);
}
struct Args {
    const bf16_t* prw; const float* mu; const float *w0, *a0, *k_k, *k_a, *r_k;
    const bf16_t *wup, *aup, *gup;
    const bf16_t* xs;
    bf16_t* g; bf16_t* bv; unsigned char* mn; unsigned char* qy;
};
constexpr int LDS_MU = 155904;
struct Pre { u32x4 cw[3], pw[3]; bf16x8 xs[8]; };
__device__ __forceinline__ void task_map(int task, int h, int& i, int& ch, int& col) {
    i = task / 24; ch = task % 24;
    col = (ch >> 3) * 512 + h * 64 + 8 * (ch & 7);
}
__device__ __forceinline__ void load_mu(const Args& P, LAS unsigned char* lds, int tid) {
    LAS float* MU = (LAS float*)(lds + LDS_MU);
    for (int i = tid; i < RWKV_COLS; i += NTHREADS) MU[i] = P.mu[i];
    __syncthreads();
}
__device__ __forceinline__ void prefetch(const Args& P, int b, int h, int c, int tid, Pre& pre) {
    const int t0 = b * SEQ + c * 64;
#pragma unroll
    for (int it = 0; it < 3; ++it) {
        int i, ch, col; task_map(tid + it * NTHREADS, h, i, ch, col);
        const bf16_t* src = P.prw + (size_t)(t0 + i) * RWKV_COLS + col;
        pre.cw[it] = *(const u32x4*)src;
        pre.pw[it] = (u32x4){0u, 0u, 0u, 0u};
        if (i != 0 || c != 0) pre.pw[it] = *(const u32x4*)(src - RWKV_COLS);
    }
    const int lane = tid & 63, r = lane & 15, q = lane >> 4, m = (tid >> 6) & 3;
    const bf16_t* xr = P.xs + (size_t)(t0 + 16 * m + r) * 256 + 8 * q;
#pragma unroll
    for (int f = 0; f < 8; ++f) pre.xs[f] = *(const bf16x8*)(xr + 32 * f);
}
__device__ __forceinline__ void unit(const Args& P, LAS unsigned char* lds, int b, int h, int c, int uidx, int tid, Pre& pf, bool has_next, int nb, int nh_, int nc) {
    const int wave = __builtin_amdgcn_readfirstlane(tid >> 6), lane = tid & 63, r = lane & 15, q = lane >> 4, m = wave & 3, nh = wave >> 2;
    const int t0 = b * SEQ + c * 64;
    lp S0 = slot(lds, 0), S1 = slot(lds, 1), S2 = slot(lds, 2), S3 = slot(lds, 3), S4 = slot(lds, 4), S5 = slot(lds, 5), S6 = slot(lds, 6), S7 = slot(lds, 7);
    lp S8 = slot(lds, 8), S9 = slot(lds, 9), S10 = slot(lds, 10), S11 = slot(lds, 11), S12 = slot(lds, 12), S13 = slot(lds, 13), S14 = slot(lds, 14), S15 = slot(lds, 15);
    LAS float* PART = (LAS float*)(lds + LDS_MISC);
    LAS float* CT = PART + 256;
    LAS float* DEND = CT + 256;
    const LAS float* MU = (const LAS float*)(lds + LDS_MU);
#define RK_BAR() do { asm volatile("s_waitcnt lgkmcnt(0)" ::: "memory"); __builtin_amdgcn_s_barrier(); asm volatile("" ::: "memory"); } while (0)
#define RK_DBG(bit, sp) do {} while (0)
#pragma unroll
    for (int it = 0; it < 3; ++it) {
        int i, ch, col; task_map(tid + it * NTHREADS, h, i, ch, col);
        LAS bf16_t* dst = slot(lds, 8 + (ch >> 3)) + i * LD + 8 * (ch & 7);
        const u32x4 cw = pf.cw[it], pw = pf.pw[it];
        const f32x4 m0 = *(const LAS f32x4*)(MU + col), m1 = *(const LAS f32x4*)(MU + col + 4);
        float v[8], p[8];
        v[0] = bflo(cw.x); v[1] = bfhi(cw.x); v[2] = bflo(cw.y); v[3] = bfhi(cw.y); v[4] = bflo(cw.z); v[5] = bfhi(cw.z); v[6] = bflo(cw.w); v[7] = bfhi(cw.w);
        p[0] = bflo(pw.x); p[1] = bfhi(pw.x); p[2] = bflo(pw.y); p[3] = bfhi(pw.y); p[4] = bflo(pw.z); p[5] = bfhi(pw.z); p[6] = bflo(pw.w); p[7] = bfhi(pw.w);
#pragma unroll
        for (int j = 0; j < 4; ++j) { v[j] += (p[j] - v[j]) * m0[j]; v[4 + j] += (p[4 + j] - v[4 + j]) * m1[j]; }
        u32x4 w; w.x = pk2(v[0], v[1]); w.y = pk2(v[2], v[3]); w.z = pk2(v[4], v[5]); w.w = pk2(v[6], v[7]);
        *(LAS u32x4*)dst = w;
    }
    RK_BAR();
    f32x4 aw[2], aa[2], ag[2];
#pragma unroll
    for (int n = 0; n < 2; ++n) { aw[n] = (f32x4){0.f, 0.f, 0.f, 0.f}; aa[n] = aw[n]; ag[n] = aw[n]; }
#pragma unroll
    for (int s = 0; s < 2; ++s) {
#pragma unroll
        for (int n = 0; n < 2; ++n) { const int row = h * 64 + 16 * (2 * nh + n) + r;
            const bf16x8 bw = *(const bf16x8*)(P.wup + (size_t)row * 64 + 32 * s + 8 * q), ba = *(const bf16x8*)(P.aup + (size_t)row * 64 + 32 * s + 8 * q);
            aw[n] = __builtin_amdgcn_mfma_f32_16x16x32_bf16(pf.xs[s], bw, aw[n], 0, 0, 0); aa[n] = __builtin_amdgcn_mfma_f32_16x16x32_bf16(pf.xs[2 + s], ba, aa[n], 0, 0, 0); }
    }
#pragma unroll
    for (int s = 0; s < 4; ++s) {
#pragma unroll
        for (int n = 0; n < 2; ++n) { const int row = h * 64 + 16 * (2 * nh + n) + r;
            const bf16x8 bg = *(const bf16x8*)(P.gup + (size_t)row * 128 + 32 * s + 8 * q);
            ag[n] = __builtin_amdgcn_mfma_f32_16x16x32_bf16(pf.xs[4 + s], bg, ag[n], 0, 0, 0); }
    }
    if (has_next) prefetch(P, nb, nh_, nc, tid, pf);
    float rr[2][4], kq[2][4], vv[2][4], av[2][4], lw[2][4], kp[2][4], pre[2][4], preq[2];
    float ss[4] = {0.f, 0.f, 0.f, 0.f}, bs[4] = {0.f, 0.f, 0.f, 0.f};
#pragma unroll
    for (int n = 0; n < 2; ++n) {
        const int ch = 32 * nh + 16 * n + r, chg = h * 64 + ch;
        const float w0v = P.w0[chg], a0v = P.a0[chg], kkc = P.k_k[chg], kac = P.k_a[chg], rkc = P.r_k[chg];
#pragma unroll
        for (int ii = 0; ii < 4; ++ii) {
            const int pos = 16 * m + 4 * q + ii;
            const float rv = bf2f(S8[pos * LD + ch]), kraw = bf2f(S9[pos * LD + ch]); vv[n][ii] = bf2f(S10[pos * LD + ch]); rr[n][ii] = rv;
            const float z = -(w0v + aw[n][ii]);
            const float sp = fmaxf(z, 0.f) + flog(1.0f + fexp(-fabsf(z)));
            lw[n][ii] = -fexp(-sp - 0.5f);
            const float a_ = sigmoidf_(a0v + aa[n][ii]); av[n][ii] = a_;
            P.g[(size_t)(t0 + pos) * RW + chg] = f2bf(ag[n][ii]);
            const float kk = kraw * kkc; kq[n][ii] = kk;
            const float kpv = kraw * (1.0f + (a_ - 1.0f) * kac); kp[n][ii] = kpv;
            ss[ii] += kk * kk; bs[ii] += rv * kpv * rkc;
        }
        pre[n][0] = lw[n][0]; pre[n][1] = pre[n][0] + lw[n][1]; pre[n][2] = pre[n][1] + lw[n][2]; pre[n][3] = pre[n][2] + lw[n][3];
        const float tot = pre[n][3];
        const float t0_ = __shfl(tot, r), t1_ = __shfl(tot, r + 16), t2_ = __shfl(tot, r + 32), t3_ = __shfl(tot, r + 48);
        preq[n] = (q > 0 ? t0_ : 0.f) + (q > 1 ? t1_ : 0.f) + (q > 2 ? t2_ : 0.f);
        if (q == 0) CT[m * 64 + ch] = (t0_ + t1_) + (t2_ + t3_);
    }
#pragma unroll
    for (int ii = 0; ii < 4; ++ii) {
#pragma unroll
        for (int o = 1; o < 16; o <<= 1) { ss[ii] += __shfl_xor(ss[ii], o); bs[ii] += __shfl_xor(bs[ii], o); }
        if (r == 0) { const int pos = 16 * m + 4 * q + ii; PART[(nh * 64 + pos) * 2] = ss[ii]; PART[(nh * 64 + pos) * 2 + 1] = bs[ii]; }
    }
    RK_BAR();
#pragma unroll
    for (int n = 0; n < 2; ++n) {
        const int ch = 32 * nh + 16 * n + r;
        float carry = 0.f, lend = 0.f;
#pragma unroll
        for (int mm = 0; mm < 4; ++mm) { const float cv = CT[mm * 64 + ch]; lend += cv; carry += (mm < m) ? cv : 0.f; }
        f32x4 tA, tBh, tKh, tV;
#pragma unroll
        for (int ii = 0; ii < 4; ++ii) {
            const int pos = 16 * m + 4 * q + ii;
            const float L = carry + preq[n] + pre[n][ii], Lm1 = L - lw[n][ii];
            const float ssum = PART[pos * 2] + PART[(64 + pos) * 2];
            const float inv = frcp(fmaxf(__builtin_sqrtf(ssum), 1e-12f));
            const float kkn = kq[n][ii] * inv, kb = kkn * av[n][ii];
            const float eN = fexp(-L), eE = fexp(lend - L);
            const float At = -kkn * fexp(Lm1), Rt = rr[n][ii] * fexp(L), Bt = kb * eN, Kt = kp[n][ii] * eN;
            S0[pos * LD + ch] = f2bf(At); S1[pos * LD + ch] = f2bf(Bt); S2[pos * LD + ch] = f2bf(Kt); S3[pos * LD + ch] = f2bf(Rt);
            tA[ii] = At; tBh[ii] = kb * eE; tKh[ii] = kp[n][ii] * eE; tV[ii] = vv[n][ii];
            P.bv[(size_t)(t0 + pos) * RW + h * 64 + ch] = f2bf((PART[pos * 2 + 1] + PART[(64 + pos) * 2 + 1]) * vv[n][ii]);
        }
        { u32x2 w; const int off = ch * LD + 16 * m + 4 * q;
          w.x = pk2(tA[0], tA[1]); w.y = pk2(tA[2], tA[3]); *(LAS u32x2*)(S4 + off) = w;
          w.x = pk2(tBh[0], tBh[1]); w.y = pk2(tBh[2], tBh[3]); *(LAS u32x2*)(S5 + off) = w;
          w.x = pk2(tKh[0], tKh[1]); w.y = pk2(tKh[2], tKh[3]); *(LAS u32x2*)(S6 + off) = w;
          w.x = pk2(tV[0], tV[1]); w.y = pk2(tV[2], tV[3]); *(LAS u32x2*)(S7 + off) = w; }
        if (m == 0 && q == 0) DEND[ch] = fexp(lend);
    }
    RK_BAR();
    RK_DBG(0, S0); RK_DBG(1, S1); RK_DBG(2, S2); RK_DBG(3, S3); RK_DBG(4, S4); RK_DBG(5, S5); RK_DBG(6, S6); RK_DBG(7, S7);
    const int nt0 = 2 * nh;
    f32x4 acc[2], acc2[2];
#define RK_ZERO(a) do { a[0] = (f32x4){0.f, 0.f, 0.f, 0.f}; a[1] = a[0]; } while (0)
#define RK_LDT(src, mt, ntt, a) do { const u32x2 w_ = *(const LAS u32x2*)((src) + (16 * (ntt) + r) * LD + 16 * (mt) + 4 * q); a = (f32x4){bflo(w_.x), bfhi(w_.x), bflo(w_.y), bfhi(w_.y)}; } while (0)
#define RK_MASK(a, ntt, COND) do { _Pragma("unroll") for (int ii = 0; ii < 4; ++ii) { const int row = 16 * m + 4 * q + ii, col = 16 * (ntt) + r; a[ii] = (COND) ? a[ii] : 0.f; } } while (0)
    RK_ZERO(acc); mm_nt<2>(S0, LD, S1, LD, m, nt0, r, q, acc);
#pragma unroll
    for (int n = 0; n < 2; ++n) { RK_MASK(acc[n], nt0 + n, col < row); st_tr(S9, m, nt0 + n, r, q, acc[n]); }
    RK_ZERO(acc); mm_nt<2>(S1, LD, S0, LD, m, nt0, r, q, acc);
#pragma unroll
    for (int n = 0; n < 2; ++n) { RK_MASK(acc[n], nt0 + n, row < col); st_tr(S8, m, nt0 + n, r, q, acc[n]);
#pragma unroll
        for (int ii = 0; ii < 4; ++ii) acc[n][ii] += ((16 * m + 4 * q + ii) == (16 * (nt0 + n) + r)) ? 1.f : 0.f;
        st_tr(S10, m, nt0 + n, r, q, acc[n]); }
    RK_ZERO(acc); mm_nt<2>(S2, LD, S0, LD, m, nt0, r, q, acc);
#pragma unroll
    for (int n = 0; n < 2; ++n) { RK_MASK(acc[n], nt0 + n, row < col); st_tr(S11, m, nt0 + n, r, q, acc[n]); }
    RK_ZERO(acc); mm_nt<2>(S1, LD, S3, LD, m, nt0, r, q, acc);
#pragma unroll
    for (int n = 0; n < 2; ++n) { RK_MASK(acc[n], nt0 + n, row <= col); st_tr(S12, m, nt0 + n, r, q, acc[n]); }
    RK_ZERO(acc); mm_nt<2>(S2, LD, S3, LD, m, nt0, r, q, acc);
#pragma unroll
    for (int n = 0; n < 2; ++n) { RK_MASK(acc[n], nt0 + n, row <= col); st_tr(S13, m, nt0 + n, r, q, acc[n]); }
    RK_BAR();
    RK_ZERO(acc); mm_nt<2>(S8, LD, S9, LD, m, nt0, r, q, acc);
    RK_ZERO(acc2); mm_nt<2>(S9, LD, S8, LD, m, nt0, r, q, acc2);
#pragma unroll
    for (int n = 0; n < 2; ++n) { st_tr(S1, m, nt0 + n, r, q, acc[n]); st_tr(S0, m, nt0 + n, r, q, acc2[n]); }
    RK_ZERO(acc); mm_nt<2>(S11, LD, S7, LD, m, nt0, r, q, acc);
#pragma unroll
    for (int n = 0; n < 2; ++n) st_tr(S14, m, nt0 + n, r, q, acc[n]);
    RK_BAR();
#define RK_ROUND(Tsrc, Tdst, Psrc, PTsrc, Pdst, PTdst) do { \
        RK_LDT(Tsrc, m, nt0, acc[0]); RK_LDT(Tsrc, m, nt0 + 1, acc[1]); mm_nt<2>(PTsrc, LD, Tsrc, LD, m, nt0, r, q, acc); \
        _Pragma("unroll") for (int n = 0; n < 2; ++n) st_tr(Tdst, m, nt0 + n, r, q, acc[n]); \
        RK_ZERO(acc); mm_nt<2>(Psrc, LD, PTsrc, LD, m, nt0, r, q, acc); RK_ZERO(acc2); mm_nt<2>(PTsrc, LD, Psrc, LD, m, nt0, r, q, acc2); \
        _Pragma("unroll") for (int n = 0; n < 2; ++n) { st_tr(PTdst, m, nt0 + n, r, q, acc[n]); st_tr(Pdst, m, nt0 + n, r, q, acc2[n]); } \
        RK_BAR(); } while (0)
#ifndef EXP_SKIP_ROUNDS
    RK_ROUND(S10, S2, S0, S1, S8, S9);
    RK_ROUND(S2, S10, S8, S9, S0, S1);
    RK_ROUND(S10, S2, S0, S1, S8, S9);
    RK_ROUND(S2, S10, S8, S9, S0, S1);
#endif
    RK_LDT(S10, m, nt0, acc[0]); RK_LDT(S10, m, nt0 + 1, acc[1]); mm_nt<2>(S1, LD, S10, LD, m, nt0, r, q, acc);
#pragma unroll
    for (int n = 0; n < 2; ++n) st_tr(S2, m, nt0 + n, r, q, acc[n]);
    RK_BAR();
    RK_ZERO(acc); mm_nt<2>(S2, LD, S4, LD, m, nt0, r, q, acc);
    RK_ZERO(acc2); mm_nt<2>(S2, LD, S14, LD, m, nt0, r, q, acc2);
#pragma unroll
    for (int n = 0; n < 2; ++n) { st_tr(S11, m, nt0 + n, r, q, acc[n]); st_tr(S15, m, nt0 + n, r, q, acc2[n]); }
    RK_BAR();
    {
        const int sw = wave & 1, ntw = wave >> 1;
        unsigned char* mn_ = P.mn + (size_t)uidx * 16384; unsigned char* qy_ = P.qy + (size_t)uidx * 16384;
        f32x4 c2[2];
#define RK_MM2(X, Y) do { _Pragma("unroll") for (int s_ = 0; s_ < 2; ++s_) { const bf16x8 b_ = *(const LAS bf16x8*)((Y) + (16 * ntw + r) * LD + 32 * s_ + 8 * q); \
            _Pragma("unroll") for (int mi = 0; mi < 2; ++mi) { const bf16x8 a_ = *(const LAS bf16x8*)((X) + (16 * (2 * sw + mi) + r) * LD + 32 * s_ + 8 * q); c2[mi] = __builtin_amdgcn_mfma_f32_16x16x32_bf16(a_, b_, c2[mi], 0, 0, 0); } } } while (0)
        RK_ZERO(c2); RK_MM2(S11, S5);
#pragma unroll
        for (int mi = 0; mi < 2; ++mi)
#pragma unroll
            for (int ii = 0; ii < 4; ++ii) { const int row = 16 * (2 * sw + mi) + 4 * q + ii, col = 16 * ntw + r; c2[mi][ii] += (row == col) ? DEND[row] : 0.f; }
        { u32x4 w; w.x = pk2(c2[0][0], c2[0][1]); w.y = pk2(c2[0][2], c2[0][3]); w.z = pk2(c2[1][0], c2[1][1]); w.w = pk2(c2[1][2], c2[1][3]); *(u32x4*)(mn_ + ((ntw * 2 + sw) * 64 + lane) * 16) = w; }
#pragma unroll
        for (int mi = 0; mi < 2; ++mi) { const u32x2 rw_ = *(const LAS u32x2*)(S3 + (16 * ntw + r) * LD + 16 * (2 * sw + mi) + 4 * q); c2[mi] = (f32x4){bflo(rw_.x), bfhi(rw_.x), bflo(rw_.y), bfhi(rw_.y)}; }
        RK_MM2(S11, S12);
        { u32x4 w; w.x = pk2(c2[0][0], c2[0][1]); w.y = pk2(c2[0][2], c2[0][3]); w.z = pk2(c2[1][0], c2[1][1]); w.w = pk2(c2[1][2], c2[1][3]); *(u32x4*)(qy_ + ((ntw * 2 + sw) * 64 + lane) * 16) = w; }
        RK_ZERO(c2); RK_MM2(S5, S15); RK_MM2(S6, S7);
#pragma unroll
        for (int mi = 0; mi < 2; ++mi) { u32x2 w; w.x = pk2(c2[mi][0], c2[mi][1]); w.y = pk2(c2[mi][2], c2[mi][3]); *(u32x2*)(mn_ + 8192 + ((ntw * 4 + 2 * sw + mi) * 64 + lane) * 8) = w; }
        RK_ZERO(c2); RK_MM2(S15, S12); RK_MM2(S7, S13);
#pragma unroll
        for (int mi = 0; mi < 2; ++mi) { u32x2 w; w.x = pk2(c2[mi][0], c2[mi][1]); w.y = pk2(c2[mi][2], c2[mi][3]); *(u32x2*)(qy_ + 8192 + (((2 * sw + mi) * 4 + ntw) * 64 + lane) * 8) = w; }
#undef RK_MM2
    }
    RK_BAR();
#undef RK_ZERO
#undef RK_ROUND
#undef RK_LDT
#undef RK_MASK
#undef RK_BAR
}
__device__ __forceinline__ void scan_wg(const unsigned char* mn, unsigned char* sbuf, int ubase, int vq, LAS unsigned char* lds, int tid) {
    const int wave = __builtin_amdgcn_readfirstlane(tid >> 6), lane = tid & 63;
    constexpr int NC = SEQ / 64, NS = 8, SLOT = 10240, AHEAD = 6;
    const unsigned char* src = mn + (size_t)ubase * 16384 + lane * 16;
    const bool loader = (wave >= 1 && wave <= 5);
    const size_t poff = (wave == 5) ? (size_t)(8192 + vq * 2048) : (size_t)(2048 * (wave - 1));
#define SC_ISSUE(c) do { const unsigned char* s_ = src + (size_t)(c) * 16384 + poff; LAS unsigned char* d_ = lds + ((c) % NS) * SLOT + 2048 * (wave - 1); \
        _Pragma("unroll") for (int i_ = 0; i_ < 2; ++i_) __builtin_amdgcn_global_load_lds((const unsigned*)(s_ + i_ * 1024), (LAS unsigned*)(d_ + i_ * 1024), 16, 0, 0); } while (0)
#define SC_BAR() do { asm volatile("s_waitcnt lgkmcnt(0)" ::: "memory"); __builtin_amdgcn_s_barrier(); asm volatile("" ::: "memory"); } while (0)
    bf16x8 sB[2];
#pragma unroll
    for (int s = 0; s < 2; ++s) sB[s] = (bf16x8){0, 0, 0, 0, 0, 0, 0, 0};
    if (loader) {
#pragma unroll
        for (int c = 0; c < AHEAD; ++c) SC_ISSUE(c);
        asm volatile("s_waitcnt vmcnt(10)" ::: "memory"); }
    SC_BAR();
    for (int c = 0; c < NC; ++c) {
        if (loader) {
            if (c + AHEAD < NC) { SC_ISSUE(c + AHEAD); asm volatile("s_waitcnt vmcnt(10)" ::: "memory"); }
            else { asm volatile("s_waitcnt vmcnt(0)" ::: "memory"); }
        } else if (wave == 0) {
            const LAS unsigned char* sl = lds + (c % NS) * SLOT;
            unsigned char* so = sbuf + (size_t)(ubase + c) * 8192 + (vq * 2) * 1024 + lane * 16;
            *(bf16x8*)so = sB[0]; *(bf16x8*)(so + 1024) = sB[1];
            f32x4 aS[4];
#pragma unroll
            for (int mm = 0; mm < 4; ++mm) {
                const u32x2 nI = *(const LAS u32x2*)(sl + 8192 + (mm * 64 + lane) * 8);
                aS[mm] = (f32x4){bflo(nI.x), bfhi(nI.x), bflo(nI.y), bfhi(nI.y)};
#pragma unroll
                for (int s = 0; s < 2; ++s) { const bf16x8 aM = *(const LAS bf16x8*)(sl + ((mm * 2 + s) * 64 + lane) * 16); aS[mm] = __builtin_amdgcn_mfma_f32_16x16x32_bf16(aM, sB[s], aS[mm], 0, 0, 0); }
            }
#pragma unroll
            for (int s = 0; s < 2; ++s) { u32x4 w; w.x = pk2(aS[2 * s][0], aS[2 * s][1]); w.y = pk2(aS[2 * s][2], aS[2 * s][3]); w.z = pk2(aS[2 * s + 1][0], aS[2 * s + 1][1]); w.w = pk2(aS[2 * s + 1][2], aS[2 * s + 1][3]);
                sB[s] = __builtin_bit_cast(bf16x8, w); }
        }
        SC_BAR();
    }
#undef SC_ISSUE
#undef SC_BAR
}
struct YArgs { const unsigned char* qy; const unsigned char* sbuf; const bf16_t* g; const bf16_t* bv; const float* ln_g; const float* ln_b; unsigned char* ya; };
__device__ __forceinline__ void ypass_unit(const YArgs& P, int u, int lane) {
    const int r = lane & 15, q = lane >> 4, b = u >> 10, h = (u >> 7) & 7, c = u & 127, t0 = b * SEQ + c * 64;
    const unsigned char* qy_ = P.qy + (size_t)u * 16384; const unsigned char* s_ = P.sbuf + (size_t)u * 8192;
    bf16x8 Qf[4][2], Sf[4][2]; u32x2 y0[4][4];
#pragma unroll
    for (int i = 0; i < 4; ++i)
#pragma unroll
        for (int s = 0; s < 2; ++s) { Qf[i][s] = *(const bf16x8*)(qy_ + ((i * 2 + s) * 64 + lane) * 16); Sf[i][s] = *(const bf16x8*)(s_ + ((i * 2 + s) * 64 + lane) * 16); }
#pragma unroll
    for (int vq = 0; vq < 4; ++vq)
#pragma unroll
        for (int mm = 0; mm < 4; ++mm) y0[vq][mm] = *(const u32x2*)(qy_ + 8192 + ((vq * 4 + mm) * 64 + lane) * 8);
    f32x4 lg[4], lb[4];
#pragma unroll
    for (int vq = 0; vq < 4; ++vq) { lg[vq] = *(const f32x4*)(P.ln_g + h * 64 + 16 * vq + 4 * q); lb[vq] = *(const f32x4*)(P.ln_b + h * 64 + 16 * vq + 4 * q); }
#pragma unroll
    for (int mm = 0; mm < 4; ++mm) {
        const size_t ro = (size_t)(t0 + 16 * mm + r) * RW + h * 64 + 4 * q;
        u32x2 gw_[4], bw_[4];
#pragma unroll
        for (int vq = 0; vq < 4; ++vq) { gw_[vq] = *(const u32x2*)(P.g + ro + 16 * vq); bw_[vq] = *(const u32x2*)(P.bv + ro + 16 * vq); }
        f32x4 acc[4]; float sum = 0.f;
#pragma unroll
        for (int vq = 0; vq < 4; ++vq) {
            acc[vq] = (f32x4){bflo(y0[vq][mm].x), bfhi(y0[vq][mm].x), bflo(y0[vq][mm].y), bfhi(y0[vq][mm].y)};
#pragma unroll
            for (int s = 0; s < 2; ++s) acc[vq] = __builtin_amdgcn_mfma_f32_16x16x32_bf16(Sf[vq][s], Qf[mm][s], acc[vq], 0, 0, 0);
            sum += (acc[vq][0] + acc[vq][1]) + (acc[vq][2] + acc[vq][3]);
        }
        sum += __shfl_xor(sum, 16); sum += __shfl_xor(sum, 32);
        const float mean = sum * (1.f / 64.f); float var = 0.f;
#pragma unroll
        for (int vq = 0; vq < 4; ++vq) { acc[vq] = acc[vq] - mean; var += (acc[vq][0] * acc[vq][0] + acc[vq][1] * acc[vq][1]) + (acc[vq][2] * acc[vq][2] + acc[vq][3] * acc[vq][3]); }
        var += __shfl_xor(var, 16); var += __shfl_xor(var, 32);
        const float rstd = __builtin_amdgcn_rsqf(var * (1.f / 64.f) + 64e-5f);
#pragma unroll
        for (int vq = 0; vq < 4; ++vq) {
            const f32x4 gg = (f32x4){bflo(gw_[vq].x), bfhi(gw_[vq].x), bflo(gw_[vq].y), bfhi(gw_[vq].y)}, bb = (f32x4){bflo(bw_[vq].x), bfhi(bw_[vq].x), bflo(bw_[vq].y), bfhi(bw_[vq].y)};
            const f32x4 o = (acc[vq] * rstd * lg[vq] + lb[vq] + bb) * gg;
            int t8 = __builtin_amdgcn_cvt_pk_fp8_f32(o[0], o[1], 0, false); t8 = __builtin_amdgcn_cvt_pk_fp8_f32(o[2], o[3], t8, true); *(unsigned*)(P.ya + ro + 16 * vq) = (unsigned)t8; }
    }
}
}
namespace gl {
constexpr int LDV = 136;
struct Args { const bf16_t* puv; const bf16_t* wsm; const float* bs; const float* ln_g; const float* ln_b; unsigned char* yb; };
__device__ __forceinline__ void unit(const Args& P, LAS unsigned char* lds, int b, int blk, int tid) {
    const int wave = __builtin_amdgcn_readfirstlane(tid >> 6), lane = tid & 63, r = lane & 15, q = lane >> 4;
    const int t0 = b * SEQ + blk * 128;
    LAS float* STAT = (LAS float*)(lds + LDS_MISC);
    for (int j = 0; j < 16; ++j) {
        const int tk = 16 * wave + j;
        const u32x4 w = *(const u32x4*)(P.puv + (size_t)(t0 + tk) * 1024 + 512 + 8 * lane);
        float v[8]; v[0] = bflo(w.x); v[1] = bfhi(w.x); v[2] = bflo(w.y); v[3] = bfhi(w.y); v[4] = bflo(w.z); v[5] = bfhi(w.z); v[6] = bflo(w.w); v[7] = bfhi(w.w);
        float s = 0.f, s2 = 0.f;
#pragma unroll
        for (int e = 0; e < 8; ++e) { s += v[e]; s2 += v[e] * v[e]; }
        s = wave_sum(s); s2 = wave_sum(s2);
        const float mean = s * (1.f / 512.f), var = fmaxf(s2 * (1.f / 512.f) - mean * mean, 0.f);
        if (lane == 0) { STAT[tk * 2] = mean; STAT[tk * 2 + 1] = __builtin_amdgcn_rsqf(var + 1e-5f); }
    }
    __syncthreads();
    for (int g = 0; g < 8; ++g) {
        LAS bf16_t* VT = (LAS bf16_t*)(lds + (g & 1) * 20480);
#pragma unroll
        for (int it = 0; it < 2; ++it) {
            const int task = tid + it * NTHREADS, j = task >> 3, cc = task & 7, ch = g * 64 + 8 * cc;
            const u32x4 w = *(const u32x4*)(P.puv + (size_t)(t0 + j) * 1024 + 512 + ch);
            const float mean = STAT[j * 2], rstd = STAT[j * 2 + 1];
            const f32x4 g0 = *(const f32x4*)(P.ln_g + ch), g1 = *(const f32x4*)(P.ln_g + ch + 4), b0 = *(const f32x4*)(P.ln_b + ch), b1 = *(const f32x4*)(P.ln_b + ch + 4);
            float v[8]; v[0] = bflo(w.x); v[1] = bfhi(w.x); v[2] = bflo(w.y); v[3] = bfhi(w.y); v[4] = bflo(w.z); v[5] = bfhi(w.z); v[6] = bflo(w.w); v[7] = bfhi(w.w);
#pragma unroll
            for (int e = 0; e < 4; ++e) { v[e] = (v[e] - mean) * rstd * g0[e] + b0[e]; v[4 + e] = (v[4 + e] - mean) * rstd * g1[e] + b1[e]; }
#pragma unroll
            for (int e = 0; e < 8; ++e) VT[(8 * cc + e) * LDV + j] = f2bf(v[e]);
        }
        __syncthreads();
        f32x4 acc[4];
#pragma unroll
        for (int n = 0; n < 4; ++n) acc[n] = (f32x4){0.f, 0.f, 0.f, 0.f};
        const bf16_t* wrow = P.wsm + ((size_t)g * 128 + 16 * wave + r) * 128 + 8 * q;
        const int ks = (wave >> 1) + 1;
        for (int s = 0; s < ks; ++s) {
            const bf16x8 a = *(const bf16x8*)(wrow + 32 * s);
#pragma unroll
            for (int n = 0; n < 4; ++n) { const bf16x8 bb = *(const LAS bf16x8*)(VT + (16 * n + r) * LDV + 32 * s + 8 * q); acc[n] = __builtin_amdgcn_mfma_f32_16x16x32_bf16(a, bb, acc[n], 0, 0, 0); }
        }
#pragma unroll
        for (int ii = 0; ii < 4; ++ii) { const int i = 16 * wave + 4 * q + ii; const float bias = P.bs[g * 128 + i];
#pragma unroll
            for (int n = 0; n < 4; ++n) { const int c = g * 64 + 16 * n + r; const float u = bf2f(P.puv[(size_t)(t0 + i) * 1024 + c]);
                P.yb[(size_t)(t0 + i) * RW + c] = (unsigned char)(__builtin_amdgcn_cvt_pk_fp8_f32(u * (acc[n][ii] + bias), 0.f, 0, false) & 0xff); } }
    }
    __syncthreads();
}
}

struct RouteArgs { const float* sc; const float* bias; int* eidx; float* ewt; int* lrank; int* tbase; unsigned* segcnt; };
__device__ __forceinline__ void phase_topk(const RouteArgs& P, LAS unsigned char* lds, int tid, int G) {
    const int wave = __builtin_amdgcn_readfirstlane(tid >> 6), lane = tid & 63, grp = lane >> 3;
    LAS int* hist = (LAS int*)(lds + LDS_MISC);
    const f32x4 bias4 = *(const f32x4*)(P.bias + 4 * lane);
    const float NEG = -__builtin_inff();
    for (int tile = blockIdx.x; tile < T / 256; tile += G) {
        if (tid < NE) hist[tid] = 0;
        __syncthreads();
        f32x4 nx[2];
#pragma unroll
        for (int u = 0; u < 2; ++u) nx[u] = *(const f32x4*)(P.sc + (size_t)(tile * 256 + wave * 32 + u) * NE + 4 * lane);
        for (int j = 0; j < 32; j += 2) {
            const int t0 = tile * 256 + wave * 32 + j;
            float s[2][4], v[2][4], gs[2];
            const f32x4 cur4[2] = {nx[0], nx[1]};
            if (j + 2 < 32) {
#pragma unroll
                for (int u = 0; u < 2; ++u) nx[u] = *(const f32x4*)(P.sc + (size_t)(t0 + 2 + u) * NE + 4 * lane); }
#pragma unroll
            for (int u = 0; u < 2; ++u) { const f32x4 s4 = cur4[u]; s[u][0] = s4.x; s[u][1] = s4.y; s[u][2] = s4.z; s[u][3] = s4.w;
#pragma unroll
                for (int e = 0; e < 4; ++e) v[u][e] = s[u][e] + bias4[e]; }
            float m1[2], m2[2];
#pragma unroll
            for (int u = 0; u < 2; ++u) { const float a = fmaxf(v[u][0], v[u][1]), b = fminf(v[u][0], v[u][1]), c = fmaxf(v[u][2], v[u][3]), d = fminf(v[u][2], v[u][3]); m1[u] = fmaxf(a, c); m2[u] = fmaxf(fminf(a, c), fmaxf(b, d)); }
#pragma unroll
            for (int o = 1; o < 8; o <<= 1) {
#pragma unroll
                for (int u = 0; u < 2; ++u) { const float o1 = __shfl_xor(m1[u], o), o2 = __shfl_xor(m2[u], o); const float n1 = fmaxf(m1[u], o1), n2 = fmaxf(fminf(m1[u], o1), fmaxf(m2[u], o2)); m1[u] = n1; m2[u] = n2; } }
#pragma unroll
            for (int u = 0; u < 2; ++u) gs[u] = m1[u] + m2[u];
            int cnt[2] = {0, 0};
#pragma unroll
            for (int g = 0; g < 8; ++g) {
#pragma unroll
                for (int u = 0; u < 2; ++u) { const float og = __shfl(gs[u], 8 * g); cnt[u] += (og > gs[u] || (og == gs[u] && g < grp)) ? 1 : 0; } }
#pragma unroll
            for (int u = 0; u < 2; ++u) {
#pragma unroll
                for (int e = 0; e < 4; ++e) v[u][e] = (cnt[u] < 4) ? v[u][e] : NEG; }
            int myidx[2] = {0, 0}; float mysc[2] = {0.f, 0.f}, ssum[2] = {0.f, 0.f};
#pragma unroll
            for (int k = 0; k < TOPK; ++k) {
                float bv[2]; int idx[2];
#pragma unroll
                for (int u = 0; u < 2; ++u) { bv[u] = v[u][0]; int bi = 0;
#pragma unroll
                    for (int e = 1; e < 4; ++e) { const bool gt = v[u][e] > bv[u]; bv[u] = gt ? v[u][e] : bv[u]; bi = gt ? e : bi; }
                    idx[u] = 4 * lane + bi; }
#pragma unroll
                for (int o = 1; o < 64; o <<= 1) {
#pragma unroll
                    for (int u = 0; u < 2; ++u) { const float ov = __shfl_xor(bv[u], o); const int oi = __shfl_xor(idx[u], o); const bool tk = (ov > bv[u]) || (ov == bv[u] && oi < idx[u]); bv[u] = tk ? ov : bv[u]; idx[u] = tk ? oi : idx[u]; } }
#pragma unroll
                for (int u = 0; u < 2; ++u) { const int own = idx[u] >> 2, ee = idx[u] & 3;
                    const float mine = (ee == 0) ? s[u][0] : (ee == 1) ? s[u][1] : (ee == 2) ? s[u][2] : s[u][3];
                    const float scv = __shfl(mine, own);
#pragma unroll
                    for (int e = 0; e < 4; ++e) v[u][e] = (lane == own && e == ee) ? NEG : v[u][e];
                    ssum[u] += scv; myidx[u] = (lane == k) ? idx[u] : myidx[u]; mysc[u] = (lane == k) ? scv : mysc[u]; }
            }
            if (lane < TOPK) {
#pragma unroll
                for (int u = 0; u < 2; ++u) { const int t = t0 + u;
                    const int lr = __hip_atomic_fetch_add(hist + myidx[u], 1, __ATOMIC_RELAXED, __HIP_MEMORY_SCOPE_WORKGROUP);
                    P.eidx[(size_t)t * TOPK + lane] = myidx[u]; P.ewt[(size_t)t * TOPK + lane] = mysc[u] / ssum[u] * 2.5f; P.lrank[(size_t)t * TOPK + lane] = lr; }
            }
        }
        __syncthreads();
        if (tid < NE) { const int cnt = hist[tid]; unsigned base = 0u;
            if (cnt) base = __hip_atomic_fetch_add(P.segcnt + tid, (unsigned)cnt, __ATOMIC_RELAXED, __HIP_MEMORY_SCOPE_AGENT);
            P.tbase[tile * NE + tid] = (int)base; }
        __syncthreads();
    }
}
struct ScatArgs { const int* eidx; const float* ewt; const int* lrank; const int* tbase; const unsigned* segcnt; int* rowtok; int* rowdst; float* roww; int* tab; unsigned* ntile; };
__device__ __forceinline__ void phase_scatter(const ScatArgs& P, LAS unsigned char* lds, int tid, int G) {
    LAS int* cntL = (LAS int*)(lds + LDS_MISC); LAS int* segst = cntL + 256; LAS int* tsa = segst + 256;
    if (tid < NE) cntL[tid] = (int)__hip_atomic_load(P.segcnt + tid, __ATOMIC_RELAXED, __HIP_MEMORY_SCOPE_AGENT);
    __syncthreads();
    if (tid == 0) {
        int run = 0, ta = 0;
        for (int s = 0; s < NE; ++s) { const int nts = (cntL[s] + 255) >> 8; segst[s] = run; tsa[s] = ta; run += nts * 256; ta += nts; }
        if (blockIdx.x == 0) P.ntile[0] = (unsigned)ta;
    }
    __syncthreads();
    for (int tile = blockIdx.x; tile < T / 256; tile += G) {
        for (int a = tid; a < 256 * TOPK; a += NTHREADS) {
            const int tok = tile * 256 + (a >> 3), k = a & 7; const size_t ai = (size_t)tok * TOPK + k;
            const int e = P.eidx[ai];
            const int pos = segst[e] + P.tbase[tile * NE + e] + P.lrank[ai];
            P.rowtok[pos] = tok; P.rowdst[pos] = tok * TOPK + k; P.roww[pos] = P.ewt[ai];
        }
    }
    for (int s = blockIdx.x; s < NE; s += G) {
        const int st = segst[s], cnt = cntL[s], nts = (cnt + 255) >> 8;
        for (int p = st + cnt + tid; p < st + nts * 256; p += NTHREADS) { P.rowtok[p] = 0; P.rowdst[p] = -1; P.roww[p] = 0.f; }
        if (tid < nts) { int* ta_ = P.tab + 2 * (tsa[s] + tid); ta_[0] = st + 256 * tid; ta_[1] = s; }
    }
}
constexpr int NPHASE = 20;
struct KArgs { const float* in[34]; float* out; unsigned char* ws; int ph_lo, ph_hi; };
template <int PLO, int PHI>
__global__ void __launch_bounds__(NTHREADS, 2) fwd_kernel(KArgs a) {
    extern __shared__ __attribute__((aligned(16))) unsigned char lds_raw[];
    LAS unsigned char* lds = (LAS unsigned char*)lds_raw;
    const int G = gridDim.x, bid = blockIdx.x, NGW = G * NWAVES;
#define PH_IDS() int tid = threadIdx.x; asm volatile("" : "+v"(tid)); const int lane = tid & 63, wave = __builtin_amdgcn_readfirstlane(tid >> 6), gw = bid * NWAVES + wave; (void)lane; (void)wave; (void)gw
    unsigned char* ws = a.ws;
    unsigned* ctl = (unsigned*)(ws + WS_CTL);
    float* mod = (float*)(ws + WS_MOD);
    constexpr int lo = PLO, hi = PHI;
    if (threadIdx.x == 0) *(LAS u32x4*)(lds + LDS_BARW) = (u32x4){0u, 0u, 0u, 0u};
    __syncthreads();
    XcdBarrier bar; bar.bar = ctl + CW_BAR; bar.x = 0; bar.st = nullptr;
    if (hi - lo > 1) bar = xcd_barrier_post(ctl + CW_BAR, (volatile LAS unsigned*)(lds + LDS_BARW));
#define IN(k) (lo <= (k) && (k) < hi)
#ifdef DBG_TIME
#define STAMP(k) do { if (blockIdx.x == 0 && threadIdx.x == 0) ((unsigned long long*)(ctl + 5200))[k] = __builtin_amdgcn_s_memrealtime(); } while (0)
#else
#define STAMP(k) do {} while (0)
#endif
#define SEAM(k) do { if (IN(k) && IN((k) + 1)) xcd_barrier(bar); } while (0)
#ifndef DBG_REPEAT
#define DBG_REPEAT (-1)
#define DBG_NREP 0
#endif
#define REP(k) for (int rep_ = 0; rep_ < (((k) == DBG_REPEAT) ? 1 + DBG_NREP : 1); ++rep_, (((k) == DBG_REPEAT && rep_ <= DBG_NREP) ? xcd_barrier(bar) : (void)0))

    STAMP(0);
    if (IN(0)) REP(0) { PH_IDS();
        phase_mod(a.in[1], a.in[2], a.in[3], mod, lds, tid, G);
        SmallW sw{a.in[6], a.in[22], a.in[23], a.in[24], a.in[25], a.in[30], a.in[31], a.in[32], a.in[9], a.in[11], a.in[12], a.in[20]};
        phase_small_weights(sw, ws, lds, gw, NGW, wave, lane);
    }
    SEAM(0); STAMP(1);
    if (IN(1)) REP(1) { PH_IDS(); phase_norm_mod<false>(a.in[0], a.in[4], mod, 0, 1024, nullptr, ws + B_H1, gw, NGW, lane); }
    SEAM(1); STAMP(2);
    if (IN(2)) REP(2) {
        gm::DenseSched S; S.init(ws + B_H1, ws + SW_WIN, T, IN_COLS, D, G, bid, 1);
        gm::EpiInProj E{(bf16_t*)(ws + B_PRW), (bf16_t*)(ws + B_PUV), (bf16_t*)(ws + B_PG)};
        gm::gemm_phase<gm::EpiInProj, gm::DenseSched, true, true, 122>(lds, D, S, E);
    }
    SEAM(2); STAMP(3);
    if (IN(3)) REP(3) { PH_IDS();
        gl::Args Q{(const bf16_t*)(ws + B_PUV), (const bf16_t*)(ws + SW_WSM), a.in[21], a.in[18], a.in[19], ws + B_YB};
        for (int u = bid; u < 512; u += G) gl::unit(Q, lds, u >> 6, u & 63, tid);
        phase_xs((const bf16_t*)(ws + B_PRW), a.in[7], (bf16_t*)(ws + B_XS), gw, NGW, lane);
    }
    SEAM(3); STAMP(4);
    if (IN(4)) REP(4) { PH_IDS();
        rk::Args P{(const bf16_t*)(ws + B_PRW), a.in[7], a.in[8], a.in[10], a.in[13], a.in[14], a.in[15], (const bf16_t*)(ws + SW_WUP), (const bf16_t*)(ws + SW_AUP), (const bf16_t*)(ws + SW_GUP), (const bf16_t*)(ws + B_XS),
                   (bf16_t*)(ws + B_G), (bf16_t*)(ws + B_BV), ws + B_MN, ws + B_QY};
        rk::Pre pre; rk::load_mu(P, lds, tid);
        if (bid < 8192) rk::prefetch(P, bid >> 10, (bid >> 7) & 7, bid & 127, tid, pre);
        for (int u = bid; u < 8192; u += G) { const int un = u + G; rk::unit(P, lds, u >> 10, (u >> 7) & 7, u & 127, u, tid, pre, un < 8192, un >> 10, (un >> 7) & 7, un & 127); }
    }
    SEAM(4); STAMP(5);
    if (IN(5)) REP(5) { PH_IDS();
        for (int w = bid; w < 256; w += G) rk::scan_wg(ws + B_MN, ws + B_S, ((w & 7) + 8 * (w >> 5)) * 128, (w >> 3) & 3, lds, tid);
    }
    SEAM(5); STAMP(6);
    if (IN(6)) REP(6) { PH_IDS();
        rk::YArgs Y{ws + B_QY, ws + B_S, (const bf16_t*)(ws + B_G), (const bf16_t*)(ws + B_BV), a.in[16], a.in[17], ws + B_YA};
        for (int u = gw; u < 8192; u += NGW) rk::ypass_unit(Y, u, lane);
    }
    SEAM(6); STAMP(7);
    STAMP(8);
    if (IN(8)) REP(8) {
        gm::DenseSched S; S.init(ws + B_YA, ws + SW_WOA, T, D, RW, G, bid, 1);
        gm::EpiMerge<false> E{(bf16_t*)(ws + B_M1), (const bf16_t*)(ws + B_PG), nullptr};
        gm::gemm_phase<gm::EpiMerge<false>, gm::DenseSched, true, true, 122>(lds, RW, S, E);
    }
    SEAM(8); STAMP(9);
    if (IN(9)) {
        gm::DenseSched S; S.init(ws + B_YB, ws + SW_WOB, T, D, RW, G, bid, 1);
        gm::EpiMerge<true> E{(bf16_t*)(ws + B_M1), (const bf16_t*)(ws + B_PG), ws + B_M8};
        gm::gemm_phase<gm::EpiMerge<true>, gm::DenseSched, true, true, 122>(lds, RW, S, E);
    }
    SEAM(9); STAMP(10);
    if (IN(10)) REP(10) {
        gm::DenseSched S; S.init(ws + B_M8, ws + SW_WO, T, D, D, G, bid, 1);
        gm::EpiResid E{(bf16_t*)(ws + B_X1), a.in[0], mod + 2048};
        gm::gemm_phase<gm::EpiResid, gm::DenseSched, true, true, 122>(lds, D, S, E);
    }
    SEAM(10); STAMP(11);
    if (IN(11)) REP(11) { PH_IDS();
        phase_norm_mod<true>(ws + B_X1, a.in[5], mod, 3072, 4096, (bf16_t*)(ws + B_H2), ws + B_H2F8, gw, NGW, lane);
        phase_expert_weights(a.in[27], a.in[28], a.in[29], ws, lds, gw, NGW, wave, lane);
    }
    SEAM(11); STAMP(12);
    if (IN(12)) REP(12) {
        { gm::DenseSched S; S.init(ws + B_H2, ws + SW_WR, T, NE, D, G, bid); gm::EpiRouter E{(float*)(ws + B_SC)}; gm::gemm_phase<gm::EpiRouter, gm::DenseSched, true>(lds, D, S, E); }
        { gm::DenseSched S; S.init(ws + B_H2F8, ws + SW_WS13, T, 512, D, G, bid, 1); gm::EpiGateUp<true> E{ws + B_SH}; gm::gemm_phase<gm::EpiGateUp<true>, gm::DenseSched, true, true, 122>(lds, D, S, E); }
    }
    SEAM(12); STAMP(13);
    if (IN(13)) { PH_IDS();
        RouteArgs R{(const float*)(ws + B_SC), a.in[26], (int*)(ws + RT_EIDX), (float*)(ws + RT_EWT), (int*)(ws + RT_LRANK), (int*)(ws + RT_TBASE), ctl + CW_SEGCNT};
        phase_topk(R, lds, tid, G);
        gm::DenseSched S; S.init(ws + B_SH, ws + SW_WS2, T, D, EFF, G, bid, 1);
        gm::EpiSharedDown E{ws + B_SHO};
        gm::gemm_phase<gm::EpiSharedDown, gm::DenseSched, true, true, 122>(lds, EFF, S, E);
    }
    SEAM(13); STAMP(14);
    if (IN(14)) REP(14) { PH_IDS();
        ScatArgs P{(const int*)(ws + RT_EIDX), (const float*)(ws + RT_EWT), (const int*)(ws + RT_LRANK), (const int*)(ws + RT_TBASE), ctl + CW_SEGCNT,
                   (int*)(ws + RT_ROWTOK), (int*)(ws + RT_ROWDST), (float*)(ws + RT_ROWW), (int*)(ws + RT_TAB), ctl + CW_NT};
        phase_scatter(P, lds, tid, G);
    }
    SEAM(14); STAMP(15);
    if (IN(15)) REP(15) {
        gm::GroupSched<true> S; S.A = (const char*)(ws + B_H2F8); S.B = (const char*)(ws + B_W13); S.tab = (const int*)(ws + RT_TAB); S.rowtok = (const int*)(ws + RT_ROWTOK);
        S.ntiles = (int)__hip_atomic_load(ctl + CW_NT, __ATOMIC_RELAXED, __HIP_MEMORY_SCOPE_AGENT); S.npn = 2; S.G = G; S.c = bid; S.K = D; S.ebytes = (size_t)512 * D; S.tstep = (size_t)256 * D;
        gm::EpiGateUp<true> E{ws + B_HID};
        gm::gemm_phase<gm::EpiGateUp<true>, gm::GroupSched<true>, true, true, 122>(lds, D, S, E);
    }
    SEAM(15); STAMP(16);
    if (IN(16)) REP(16) {
        gm::GroupSched<false> S; S.A = (const char*)(ws + B_HID); S.B = (const char*)(ws + B_W2); S.tab = (const int*)(ws + RT_TAB); S.rowtok = nullptr;
        S.ntiles = (int)__hip_atomic_load(ctl + CW_NT, __ATOMIC_RELAXED, __HIP_MEMORY_SCOPE_AGENT); S.npn = 4; S.G = G; S.c = bid; S.K = EFF; S.ebytes = (size_t)D * EFF; S.tstep = (size_t)256 * EFF;
        gm::EpiExpertDown E{ws + B_SLOT, (const int*)(ws + RT_ROWDST), (const float*)(ws + RT_ROWW)};
        gm::gemm_phase<gm::EpiExpertDown, gm::GroupSched<false>, true, true, 122>(lds, EFF, S, E);
    }
    SEAM(16); STAMP(17);
    if (IN(17)) { PH_IDS(); phase_combine(a.out, (const bf16_t*)(ws + B_X1), ws + B_SLOT, ws + B_SHO, mod, a.in[33], gw, NGW, lane); }
    STAMP(18); STAMP(19);
    __syncthreads(); STAMP(20);
#undef IN
#undef SEAM
}

#if defined(DBG_CHECK) || defined(DBG_TIME)
#ifdef DBG_TIME
#ifndef TSC
#define TSC 0.25f
#endif
__global__ void dbg_time_out(float* out, const unsigned long long* st) {
    if (threadIdx.x == 0 && blockIdx.x == 0) { out[0] = (float)(st[TA1] - st[TA0]) * 0.01f * TSC; out[1] = (float)(st[TB1] - st[TB0]) * 0.01f * TSC; }
}
static void dbg_run(void* d_out, void* d_ws, hipStream_t stream) {
    dbg_time_out<<<1, 64, 0, stream>>>((float*)d_out, (const unsigned long long*)((unsigned*)((unsigned char*)d_ws + WS_CTL) + 5200));
}
#endif
#endif
#ifndef MK_SINGLE
#define MK_SINGLE 0
#endif
template <int PLO, int PHI> static bool prep_kernel() {
    int per_cu = 0;
    if (hipFuncSetAttribute((const void*)fwd_kernel<PLO, PHI>, hipFuncAttributeMaxDynamicSharedMemorySize, LDS_BYTES) != hipSuccess) { fprintf(stderr, "kernel_launch: hipFuncSetAttribute failed\n"); return false; }
    if (hipOccupancyMaxActiveBlocksPerMultiprocessor(&per_cu, (const void*)fwd_kernel<PLO, PHI>, NTHREADS, LDS_BYTES) != hipSuccess || per_cu < 1) { fprintf(stderr, "kernel_launch: occupancy query says %d\n", per_cu); (void)hipGetLastError(); return false; }
    return true;
}
template <int P> struct PhaseLaunch {
    static bool prep() { return prep_kernel<P, P + 1>() && PhaseLaunch<P + 1>::prep(); }
    static void go(int grid, hipStream_t stream, const KArgs& a) { hipLaunchKernelGGL((fwd_kernel<P, P + 1>), dim3(grid), dim3(NTHREADS), LDS_BYTES, stream, a); PhaseLaunch<P + 1>::go(grid, stream, a); }
};
#ifndef DBG_LAST
#define DBG_LAST NPHASE
#endif
template <> struct PhaseLaunch<DBG_LAST> { static bool prep() { return true; } static void go(int, hipStream_t, const KArgs&) {} };
extern "C" void kernel_launch(void* const* d_in, const int* in_sizes, int n_in, void* d_out, int out_size, void* d_ws, size_t ws_size, hipStream_t stream) {
    static int grid = 0;
    if (grid == 0) {
        if (n_in != 34 || out_size != T * D || ws_size < WS_END) { fprintf(stderr, "kernel_launch: unexpected problem shape (n_in %d, out %d, ws %zu < %zu)\n", n_in, out_size, ws_size, (size_t)WS_END); grid = -1; return; }
        int dev = 0, cus = 0;
        if (hipGetDevice(&dev) != hipSuccess || hipDeviceGetAttribute(&cus, hipDeviceAttributeMultiprocessorCount, dev) != hipSuccess) { grid = -1; return; }
#if MK_SINGLE
        if (!prep_kernel<0, NPHASE>()) { grid = -1; return; }
#else
        if (!PhaseLaunch<0>::prep()) { grid = -1; return; }
#endif
        grid = cus;
    }
    if (grid < 0) return;
    (void)hipMemsetAsync((char*)d_ws + WS_CTL, 0, CTL_ZERO_BYTES, stream);
    KArgs a{};
    for (int i = 0; i < 34; ++i) a.in[i] = (const float*)d_in[i];
    a.out = (float*)d_out; a.ws = (unsigned char*)d_ws; a.ph_lo = 0; a.ph_hi = NPHASE;
#if MK_SINGLE
    hipLaunchKernelGGL((fwd_kernel<0, NPHASE>), dim3(grid), dim3(NTHREADS), LDS_BYTES, stream, a);
#else
    PhaseLaunch<0>::go(grid, stream, a);
#endif
#if defined(DBG_CHECK) || defined(DBG_TIME)
    dbg_run(d_out, d_ws, stream);
#endif
}
```

```cpp
#define MK_SINGLE 1
#include <hip/hip_runtime.h>
#include <cstdio>
#include <cstdint>

#define LAS __attribute__((address_space(3)))
#define GAS __attribute__((address_space(1)))
typedef unsigned short bf16_t;
typedef short bf16x8 __attribute__((ext_vector_type(8)));
typedef float f32x4 __attribute__((ext_vector_type(4)));
typedef float f32x2 __attribute__((ext_vector_type(2)));
typedef unsigned u32x4 __attribute__((ext_vector_type(4)));
typedef unsigned u32x2 __attribute__((ext_vector_type(2)));

constexpr int D = 1024, NB = 8, SEQ = 8192, T = NB * SEQ;
constexpr int RW = 512, HD = 64, NH = 8;
constexpr int RWKV_COLS = 1792, IN_COLS = 4864;
constexpr int NE = 256, TOPK = 8, EFF = 256;
constexpr int NWAVES = 8, NTHREADS = 512;
constexpr int MAXROWS = T * TOPK + 256 * 256;

constexpr size_t MiB = 1u << 20;
constexpr size_t WS_CTL = 0;
constexpr int CW_BAR = 0, CW_SEGCNT = 4096, CW_NT = 4608;
constexpr size_t CTL_ZERO_BYTES = 20480;
constexpr size_t WS_MOD = 65536;
constexpr size_t WS_SW = 1 * MiB;
constexpr size_t SW_WIN = WS_SW;
constexpr size_t SW_WOA = SW_WIN + (size_t)IN_COLS * D * 2;
constexpr size_t SW_WOB = SW_WOA + (size_t)D * RW * 2;
constexpr size_t SW_WO = SW_WOB + (size_t)D * RW * 2;
constexpr size_t SW_WR = SW_WO + (size_t)D * D * 2;
constexpr size_t SW_WS13 = SW_WR + (size_t)NE * D * 2;
constexpr size_t SW_WS2 = SW_WS13 + (size_t)512 * D * 2;
constexpr size_t SW_WUP = SW_WS2 + (size_t)D * EFF * 2;
constexpr size_t SW_AUP = SW_WUP + (size_t)RW * 64 * 2;
constexpr size_t SW_GUP = SW_AUP + (size_t)RW * 64 * 2;
constexpr size_t SW_WSM = SW_GUP + (size_t)RW * 128 * 2;
constexpr size_t SW_END = SW_WSM + (size_t)8 * 128 * 128 * 2;
static_assert(SW_END <= 20 * MiB, "small weights");
constexpr size_t WS_RT = 20 * MiB;
constexpr size_t RT_EIDX = WS_RT;
constexpr size_t RT_EWT = RT_EIDX + (size_t)T * 8 * 4;
constexpr size_t RT_LRANK = RT_EWT + (size_t)T * 8 * 4;
constexpr size_t RT_TBASE = RT_LRANK + (size_t)T * 8 * 4;
constexpr size_t RT_ROWTOK = RT_TBASE + (size_t)256 * 256 * 4;
constexpr size_t RT_ROWDST = RT_ROWTOK + (size_t)MAXROWS * 4;
constexpr size_t RT_ROWW = RT_ROWDST + (size_t)MAXROWS * 4;
constexpr size_t RT_TAB = RT_ROWW + (size_t)MAXROWS * 4;
constexpr size_t RT_SBON = RT_TAB + (size_t)3 * 4096 * 8;
constexpr size_t RT_END = RT_SBON + (size_t)T * 8 * 4;
static_assert(RT_END <= 40 * MiB, "routing arrays");
constexpr size_t WS_BIG = 40 * MiB;
constexpr size_t B_H1 = WS_BIG + 0 * MiB;
constexpr size_t B_YB = WS_BIG + 0 * MiB;
constexpr size_t B_YA = WS_BIG + 64 * MiB;
constexpr size_t B_XS = WS_BIG + 64 * MiB;
constexpr size_t B_PRW = WS_BIG + 128 * MiB;
constexpr size_t B_M8 = WS_BIG + 128 * MiB;
constexpr size_t B_S = WS_BIG + 128 * MiB;
constexpr size_t B_PUV = WS_BIG + 352 * MiB;
constexpr size_t B_QY = WS_BIG + 352 * MiB;
constexpr size_t B_M1 = WS_BIG + 352 * MiB;
constexpr size_t B_PG = WS_BIG + 480 * MiB;
constexpr size_t B_MN = WS_BIG + 736 * MiB;
constexpr size_t B_G = WS_BIG + 864 * MiB;
constexpr size_t B_BV = WS_BIG + 928 * MiB;
constexpr size_t B_H2 = WS_BIG + 0 * MiB;
constexpr size_t B_W13 = WS_BIG + 128 * MiB;
constexpr size_t B_H2F8 = WS_BIG + 256 * MiB;
constexpr size_t B_SH = WS_BIG + 384 * MiB;
constexpr size_t B_SC = WS_BIG + 416 * MiB;
constexpr size_t B_SLOT = WS_BIG + 0 * MiB;
constexpr size_t B_SHO = WS_BIG + 928 * MiB;
constexpr size_t B_W2 = WS_BIG + 512 * MiB;
constexpr size_t B_X1 = WS_BIG + 576 * MiB;
constexpr size_t B_HID = WS_BIG + 704 * MiB;
constexpr size_t WS_END = WS_BIG + 992 * MiB;
static_assert((size_t)MAXROWS * EFF * 2 <= 320 * MiB, "hid");

constexpr int LDS_STAGE = 0;
constexpr int LDS_MISC = 153600;
constexpr int LDS_BARW = 161792;
constexpr int LDS_BYTES = 163840;

typedef __bf16 bf16x2_t __attribute__((ext_vector_type(2)));
__device__ __forceinline__ unsigned pk2(float lo, float hi) { f32x2 f = {lo, hi}; return __builtin_bit_cast(unsigned, __builtin_convertvector(f, bf16x2_t)); }
__device__ __forceinline__ u32x2 pk8(const f32x4& a, const f32x4& b) { u32x2 w; int t = __builtin_amdgcn_cvt_pk_fp8_f32(a[0], a[1], 0, false); t = __builtin_amdgcn_cvt_pk_fp8_f32(a[2], a[3], t, true); w.x = (unsigned)t;
    t = __builtin_amdgcn_cvt_pk_fp8_f32(b[0], b[1], 0, false); t = __builtin_amdgcn_cvt_pk_fp8_f32(b[2], b[3], t, true); w.y = (unsigned)t; return w; }
__device__ __forceinline__ f32x4 up8(unsigned w) { const f32x2 lo = __builtin_amdgcn_cvt_pk_f32_fp8((int)w, false), hi = __builtin_amdgcn_cvt_pk_f32_fp8((int)w, true); return (f32x4){lo.x, lo.y, hi.x, hi.y}; }
__device__ __forceinline__ float bflo(unsigned w) { return __uint_as_float(w << 16); }
__device__ __forceinline__ float bfhi(unsigned w) { return __uint_as_float(w & 0xffff0000u); }
__device__ __forceinline__ float bf2f(bf16_t h) { return __uint_as_float(((unsigned)h) << 16); }
__device__ __forceinline__ bf16_t f2bf(float f) { return (bf16_t)(pk2(f, 0.f) & 0xffffu); }
__device__ __forceinline__ float fexp(float x) { return __builtin_amdgcn_exp2f(x * 1.44269504089f); }
__device__ __forceinline__ float flog(float x) { return __builtin_amdgcn_logf(x) * 0.69314718056f; }
__device__ __forceinline__ float frcp(float x) { return __builtin_amdgcn_rcpf(x); }
__device__ __forceinline__ float sigmoidf_(float x) { return frcp(1.0f + fexp(-x)); }
__device__ __forceinline__ float siluf_(float x) { return x * sigmoidf_(x); }
__device__ __forceinline__ float tanhf_(float x) { return 1.0f - 2.0f * frcp(1.0f + fexp(2.0f * x)); }
__device__ __forceinline__ float gelu_tanh(float x) { const float u = 0.7978845608f * (x + 0.044715f * x * x * x); return x * frcp(1.0f + fexp(-2.0f * u)); }
__device__ __forceinline__ float wave_sum(float v) {
#pragma unroll
    for (int o = 1; o < 64; o <<= 1) v += __shfl_xor(v, o);
    return v;
}
#define LDS_WAIT() asm volatile("s_waitcnt lgkmcnt(0)" ::: "memory")
#define VM_WAIT() asm volatile("s_waitcnt vmcnt(0)" ::: "memory")

#define XB_TMO      128
#define XB_XCNT(j)  (256  + 64 * (j))
#define XB_XSUB(j)  (1280 + 64 * (j))
#define XB_XGEN(j)  (2304 + 64 * (j))
#define XB_TOP      3328
#define XB_TOPGEN   3392
#define XCD_BAR_WORDS 3456
#define XB_SPIN_CAP (1u << 18)
__device__ __forceinline__ unsigned xb_ld(unsigned* p)              { return __hip_atomic_load(p, __ATOMIC_RELAXED, __HIP_MEMORY_SCOPE_AGENT); }
__device__ __forceinline__ unsigned xb_add(unsigned* p, unsigned v) { return __hip_atomic_fetch_add(p, v, __ATOMIC_RELAXED, __HIP_MEMORY_SCOPE_AGENT); }
__device__ __forceinline__ unsigned xb_xcc_id() { return (unsigned)__builtin_amdgcn_s_getreg((3 << 11) | 20) & 0xFu; }
#define XB_SPIN(cond, bar) do { unsigned _sp = 0; while (cond) { __builtin_amdgcn_s_sleep(1); \
    if ((++_sp & 255u) == 0u) { if (xb_ld(&(bar)[XB_TMO])) break; if (_sp > XB_SPIN_CAP) { atomicAdd(&(bar)[XB_TMO], 1u); break; } } } } while (0)
struct XcdBarrier { unsigned* bar; unsigned x; volatile LAS unsigned* st; };
__device__ __forceinline__ XcdBarrier xcd_barrier_post(unsigned* bar, volatile LAS unsigned* st) {
    XcdBarrier b; b.bar = bar; b.x = xb_xcc_id(); b.st = st;
    if (threadIdx.x == 0) (void)xb_add(&bar[XB_XCNT(b.x)], 1u);
    return b;
}
__device__ __forceinline__ void xcd_barrier_complete(unsigned* bar, unsigned x, unsigned& nloc, unsigned& nx) {
    const unsigned G = gridDim.x * gridDim.y * gridDim.z;
    unsigned sum, cnt, mine, sp = 0u;
    for (;;) {
        sum = 0u; cnt = 0u; mine = 0u;
#pragma unroll
        for (unsigned j = 0; j < 16; ++j) { const unsigned c = xb_ld(&bar[XB_XCNT(j)]); sum += c; cnt += (c > 0u) ? 1u : 0u; mine = (j == x) ? c : mine; }
        if (sum == G) break;
        __builtin_amdgcn_s_sleep(1);
        if ((++sp & 255u) == 0u) { if (xb_ld(&bar[XB_TMO])) break; if (sp > XB_SPIN_CAP) { atomicAdd(&bar[XB_TMO], 1u); break; } }
    }
    nloc = mine > 0u ? mine : 1u; nx = cnt > 0u ? cnt : 1u;
}
__device__ __forceinline__ void xcd_barrier(const XcdBarrier& b) {
    asm volatile("s_waitcnt vmcnt(0)" ::: "memory");
    __syncthreads();
    if (threadIdx.x == 0) {
        unsigned* bar = b.bar;
        __builtin_amdgcn_s_waitcnt(0);
        unsigned nloc = b.st[0], nx = b.st[1];
        if (nloc == 0u) { xcd_barrier_complete(bar, b.x, nloc, nx); b.st[0] = nloc; b.st[1] = nx; }
        const unsigned old = xb_add(&bar[XB_XSUB(b.x)], 1u);
        const unsigned gen = old / nloc;
        if (old + 1u == (gen + 1u) * nloc) {
            __builtin_amdgcn_fence(__ATOMIC_RELEASE, "agent");
            asm volatile("s_waitcnt vmcnt(0)" ::: "memory");
            const unsigned og = xb_add(&bar[XB_TOP], 1u);
            const unsigned tg = og / nx;
            if (og + 1u == (tg + 1u) * nx) xb_add(&bar[XB_TOPGEN], 1u);
            else XB_SPIN(xb_ld(&bar[XB_TOPGEN]) == tg, bar);
            __builtin_amdgcn_fence(__ATOMIC_ACQUIRE, "agent");
            xb_add(&bar[XB_XGEN(b.x)], 1u);
            asm volatile("s_waitcnt vmcnt(0)" ::: "memory");
        } else {
            XB_SPIN(xb_ld(&bar[XB_XGEN(b.x)]) == gen, bar);
            __builtin_amdgcn_fence(__ATOMIC_ACQUIRE, "agent");
            asm volatile("s_waitcnt vmcnt(0)" ::: "memory");
        }
    }
    __syncthreads();
}
namespace gm {
typedef int i32x4 __attribute__((ext_vector_type(4)));
typedef int i32x8 __attribute__((ext_vector_type(8)));
constexpr int BM = 256, BK = 64, HALF = 128, HTB = HALF * BK * 2, STAGE_BYTES = 8 * HTB, NXCD = 8, WGM = 8;
__host__ __device__ __forceinline__ int lds_byte(int r, int c) { const int st = (r >> 4) * 2 + (c >> 5), rr = r & 15, cc = c & 31, ob = rr * 64 + cc * 2; return st * 1024 + (ob ^ (((ob >> 9) & 1) << 5)); }
__host__ __device__ __forceinline__ void stage_rc(int b, int& R, int& C) { const int st = b / 1024, sb = b % 1024, swz = sb ^ (((sb >> 9) & 1) << 5); R = (st >> 1) * 16 + swz / 64; C = (st & 1) * 32 + (swz % 64) / 2; }
__host__ __device__ __forceinline__ int perm32(int rho) { const int n = rho >> 4, i = rho & 15; return 8 * (i >> 2) + 4 * n + (i & 3); }

struct Unit { int pm, pn, e, row0, par; };

struct DenseSched {
    static constexpr bool GATHER = false;
    const char* A; const char* B; int nM, nN, nwg, G, c; size_t tstep; const int* rowtok; int K;
    __device__ __forceinline__ void init(const void* A_, const void* B_, int M, int N, int K, int G_, int c_, int es = 2) { A = (const char*)A_; B = (const char*)B_; nM = M / BM; nN = N / BM; nwg = nM * nN; G = G_; c = c_; tstep = (size_t)BM * K * es; rowtok = nullptr; this->K = 0; }
    __device__ __forceinline__ bool next(int i, Unit& u) const {
        const long L = (long)i * G + c; if (L >= nwg) return false;
        int wgid = (int)L; { const int q = nwg / NXCD, r = nwg % NXCD, xcd = wgid % NXCD, off = wgid / NXCD; wgid = (xcd < r ? xcd * (q + 1) : r * (q + 1) + (xcd - r) * q) + off; }
        const int nig = WGM * nN, gid = wgid / nig, fm = gid * WGM, gsz = (nM - fm) < WGM ? (nM - fm) : WGM;
        u.pm = fm + ((wgid % nig) % gsz); u.pn = (wgid % nig) / gsz; u.e = 0; u.row0 = u.pm * BM; return true;
    }
    __device__ __forceinline__ const char* a_ptr(const Unit& u) const { return A + (size_t)u.pm * tstep; }
    __device__ __forceinline__ const char* b_ptr(const Unit& u) const { return B + (size_t)u.pn * tstep; }
    __device__ __forceinline__ unsigned row_off(const Unit&, int) const { return 0u; }
};
template <bool GATHER_>
struct GroupSched {
    static constexpr bool GATHER = GATHER_;
    const char* A; const char* B; const int* tab; const int* rowtok; int ntiles, npn, G, c, K; size_t ebytes, tstep;
    __device__ __forceinline__ bool next(int i, Unit& u) const {
        int tile;
        if (G == 256) {
            const int xcd = c & 7, slot = c >> 3, tpx = 32 / npn; tile = i * 8 * tpx + xcd * tpx + slot / npn; u.pn = slot % npn; if (tile >= ntiles) return false;
        } else { const long L = (long)i * G + c; if (L >= (long)ntiles * npn) return false; tile = (int)(L / npn); u.pn = (int)(L % npn); }
        u.pm = tile;
        u.row0 = __builtin_amdgcn_readfirstlane(tab[2 * tile]); u.e = __builtin_amdgcn_readfirstlane(tab[2 * tile + 1]); return true;
    }
    __device__ __forceinline__ const char* a_ptr(const Unit& u) const { return GATHER ? A : A + (size_t)u.row0 * K; }
    __device__ __forceinline__ const char* b_ptr(const Unit& u) const { return B + (size_t)u.e * ebytes + (size_t)u.pn * tstep; }
    __device__ __forceinline__ unsigned row_off(const Unit& u, int r) const { return (unsigned)rowtok[u.row0 + r] * (unsigned)K; }
};

template <class Epi, class Sched, bool ALIGN_EPI, bool F8 = false, int SCALE_W = 127>
__device__ __forceinline__ void gemm_phase(LAS unsigned char* lds, const int Kel, const Sched& S, const Epi& E) {
    const int K = F8 ? Kel / 2 : Kel;
    int tid_ = threadIdx.x; asm volatile("" : "+v"(tid_));
    const int tid = tid_, wid = __builtin_amdgcn_readfirstlane(tid >> 6), lane = tid & 63, wr = wid >> 2, wc = wid & 3, fr = lane & 15, fq = lane >> 4;
    const int nt = K / BK;
    int sR[2], sC[2]; unsigned voffB[2];
#pragma unroll
    for (int i = 0; i < 2; ++i) { int R, C; stage_rc(tid * 16 + i * 8192, R, C); sR[i] = R; sC[i] = C; const int Rb = Epi::PERM ? ((R & ~31) + perm32(R & 31)) : R; voffB[i] = (unsigned)(Rb * K + C) * 2u; }
    const size_t kstep = (size_t)(BK * 2);
    const size_t hstep = (size_t)HALF * K * 2;
    const unsigned ldsw = (unsigned)wid * 1024u;
    const int aoff = lds_byte(wr * 64 + fr, fq * 8), boff = lds_byte(wc * 32 + fr, fq * 8);
#define PG8_SA(b, h) (((b) * 2 + (h)) * HTB)
#define PG8_SB(b, h) ((4 + (b) * 2 + (h)) * HTB)
#define PG8_STGB(bufoff, gbase) do { _Pragma("unroll") for (int _i = 0; _i < 2; ++_i) \
        __builtin_amdgcn_global_load_lds((const unsigned*)((const char*)(gbase) + voffB[_i]), (LAS unsigned*)(lds + (bufoff) + ldsw + _i * 8192), 16, 0, 0); } while (0)
#define PG8_STGA(bufoff, gbase, VO, h) do { _Pragma("unroll") for (int _i = 0; _i < 2; ++_i) \
        __builtin_amdgcn_global_load_lds((const unsigned*)((const char*)(gbase) + VO[h][_i]), (LAS unsigned*)(lds + (bufoff) + ldsw + _i * 8192), 16, 0, 0); } while (0)
#define PG8_VOA(u, VO) do { _Pragma("unroll") for (int _h = 0; _h < 2; ++_h) _Pragma("unroll") for (int _i = 0; _i < 2; ++_i) \
        VO[_h][_i] = Sched::GATHER ? (S.row_off(u, _h * HALF + sR[_i]) + (unsigned)sC[_i] * 2u) : ((unsigned)((_h * HALF + sR[_i]) * K + sC[_i]) * 2u); } while (0)
#define PG8_LDA(dst, b, h) do { _Pragma("unroll") for (int m = 0; m < 4; ++m) { if constexpr (F8) { dst##8[m].lo = *(const LAS i32x4*)(lds + PG8_SA(b, h) + aoff + m * 2048); dst##8[m].hi = *(const LAS i32x4*)(lds + PG8_SA(b, h) + aoff + m * 2048 + 1024); } else { _Pragma("unroll") for (int k = 0; k < 2; ++k) dst[m][k] = *(const LAS bf16x8*)(lds + PG8_SA(b, h) + aoff + m * 2048 + k * 1024); } } } while (0)
#define PG8_LDB(dst, b, h) do { _Pragma("unroll") for (int n = 0; n < 2; ++n) { if constexpr (F8) { dst##8[n].lo = *(const LAS i32x4*)(lds + PG8_SB(b, h) + boff + n * 2048); dst##8[n].hi = *(const LAS i32x4*)(lds + PG8_SB(b, h) + boff + n * 2048 + 1024); } else { _Pragma("unroll") for (int k = 0; k < 2; ++k) dst[n][k] = *(const LAS bf16x8*)(lds + PG8_SB(b, h) + boff + n * 2048 + k * 1024); } } } while (0)
#define PG8_MMA(ai, bj, At, Bt) do { __builtin_amdgcn_s_setprio(1); _Pragma("unroll") for (int m = 0; m < 4; ++m) _Pragma("unroll") for (int n = 0; n < 2; ++n) { \
        if constexpr (F8) { asm volatile("v_mfma_scale_f32_16x16x128_f8f6f4 %0, %1, %2, %0, %3, %4 op_sel_hi:[0,0,0]" : "+v"(acc[ai][bj][m][n]) : "v"(Bt##8[n]), "v"(At##8[m]), "v"(scw_), "v"(sca_)); } \
        else { _Pragma("unroll") for (int k = 0; k < 2; ++k) acc[ai][bj][m][n] = __builtin_amdgcn_mfma_f32_16x16x32_bf16(Bt[n][k], At[m][k], acc[ai][bj][m][n], 0, 0, 0); } } \
        __builtin_amdgcn_s_setprio(0); } while (0)
#define PG8_WAIT_V(n) asm volatile("s_waitcnt vmcnt(" #n ")" ::: "memory")
#define PG8_WAIT_L(n) asm volatile("s_waitcnt lgkmcnt(" #n ")" ::: "memory")
#define PG8_BAR __builtin_amdgcn_s_barrier()
#define PG8_SCHED __builtin_amdgcn_sched_barrier(0)
    Unit cur, nxt; int ui = 0;
    if (!S.next(0, cur)) return;
    f32x4 acc[2][2][4][2];
#pragma unroll
    for (int a = 0; a < 2; ++a)
#pragma unroll
        for (int b = 0; b < 2; ++b)
#pragma unroll
            for (int m = 0; m < 4; ++m)
#pragma unroll
                for (int n = 0; n < 2; ++n) acc[a][b][m][n] = (f32x4){0.f, 0.f, 0.f, 0.f};
    const int scw_ = SCALE_W, sca_ = 127;
    bf16x8 At[4][2], B0[2][2], B1[2][2]; i32x8 At8[4], B08[2], B18[2];
    unsigned voA[2][2], nvoA[2][2];
    PG8_VOA(cur, voA);
    if (Sched::GATHER) { asm volatile("s_waitcnt vmcnt(0)" ::: "memory"); }
    const char* cA = S.a_ptr(cur); const char* cB = S.b_ptr(cur);
    cur.par = 0; E.stage_rows(cur, lds, wid);
    PG8_STGB(PG8_SB(0, 0), cB); PG8_STGB(PG8_SB(0, 1), cB + hstep); PG8_STGA(PG8_SA(0, 0), cA, voA, 0); PG8_STGA(PG8_SA(0, 1), cA, voA, 1);
    if (wr == 1) PG8_BAR;
    PG8_WAIT_V(2); PG8_BAR;
    PG8_STGB(PG8_SB(1, 0), cB + kstep); PG8_STGA(PG8_SA(1, 0), cA + kstep, voA, 0); PG8_STGB(PG8_SB(1, 1), cB + hstep + kstep);
    PG8_WAIT_V(6); PG8_BAR;
    for (;;) {
        const bool has_next = S.next(ui + 1, nxt); nxt.par = (ui + 1) & 3;
        const char* nA = has_next ? S.a_ptr(nxt) : cA; const char* nB = has_next ? S.b_ptr(nxt) : cB;
        if (Sched::GATHER) {
            if (has_next) { if (wid < 4) __builtin_amdgcn_global_load_lds((const unsigned*)(S.rowtok + nxt.row0 + wid * 64 + lane), (LAS unsigned*)(lds + LDS_MISC + nxt.par * 1024 + wid * 256), 4, 0, 0); }
#pragma unroll
            for (int h = 0; h < 2; ++h)
#pragma unroll
                for (int i = 0; i < 2; ++i) nvoA[h][i] = voA[h][i]; }
#pragma unroll 1
        for (int t = 0; t < nt; t += 2) {
            const bool last = (t == nt - 2);
            const char* a1 = cA + (size_t)(t + 1) * kstep;
            const char* a2 = last ? nA : cA + (size_t)(t + 2) * kstep; const char* b2 = last ? nB : cB + (size_t)(t + 2) * kstep;
            const char* a3 = a2 + kstep; const char* b3 = b2 + kstep;
            unsigned vo2[2][2];
#pragma unroll
            for (int h = 0; h < 2; ++h)
#pragma unroll
                for (int i = 0; i < 2; ++i) vo2[h][i] = (Sched::GATHER && last) ? nvoA[h][i] : voA[h][i];
            if (last && has_next) E.stage_rows(nxt, lds, wid);
            if (Sched::GATHER && last && has_next) { const LAS int* rt_ = (const LAS int*)(lds + LDS_MISC + nxt.par * 1024);
#pragma unroll
                for (int h = 0; h < 2; ++h)
#pragma unroll
                    for (int i = 0; i < 2; ++i) { vo2[h][i] = (unsigned)rt_[h * HALF + sR[i]] * (unsigned)S.K + (unsigned)sC[i] * 2u; nvoA[h][i] = vo2[h][i]; } }
            PG8_LDB(B0, 0, 0); PG8_LDB(B1, 0, 1); PG8_SCHED; PG8_LDA(At, 0, 0); PG8_STGA(PG8_SA(1, 1), a1, voA, 1);
            PG8_WAIT_V(8); PG8_WAIT_L(0); PG8_BAR; PG8_MMA(0, 0, At, B0); PG8_MMA(0, 1, At, B1); PG8_BAR; PG8_SCHED;
            PG8_LDA(At, 0, 1); PG8_STGB(PG8_SB(0, 0), b2); PG8_STGB(PG8_SB(0, 1), b2 + hstep); PG8_STGA(PG8_SA(0, 0), a2, vo2, 0);
            PG8_WAIT_V(8); PG8_WAIT_L(0); PG8_BAR; PG8_MMA(1, 0, At, B0); PG8_MMA(1, 1, At, B1); PG8_BAR; PG8_SCHED;
            PG8_LDB(B0, 1, 0); PG8_LDB(B1, 1, 1); PG8_SCHED; PG8_LDA(At, 1, 0); PG8_STGA(PG8_SA(0, 1), a2, vo2, 1);
            PG8_WAIT_V(8); PG8_WAIT_L(0); PG8_BAR; PG8_MMA(0, 0, At, B0); PG8_MMA(0, 1, At, B1); PG8_BAR; PG8_SCHED;
            PG8_LDA(At, 1, 1); PG8_STGB(PG8_SB(1, 0), b3); PG8_STGB(PG8_SB(1, 1), b3 + hstep); PG8_STGA(PG8_SA(1, 0), a3, vo2, 0);
            PG8_WAIT_V(8); PG8_WAIT_L(0); PG8_BAR; PG8_MMA(1, 0, At, B0); PG8_MMA(1, 1, At, B1); PG8_BAR; PG8_SCHED;
        }
        if constexpr (F8) asm volatile("s_nop 15\n\ts_nop 15\n\ts_nop 15" ::: "memory");
        if constexpr (ALIGN_EPI) { if (wr == 0) PG8_BAR; }
        E(acc, cur, wr, wc, fr, fq);
        if (!has_next) break;
#pragma unroll
        for (int a = 0; a < 2; ++a)
#pragma unroll
            for (int b = 0; b < 2; ++b)
#pragma unroll
                for (int m = 0; m < 4; ++m)
#pragma unroll
                    for (int n = 0; n < 2; ++n) acc[a][b][m][n] = (f32x4){0.f, 0.f, 0.f, 0.f};
        cur = nxt; cA = nA; cB = nB; ++ui;
        if (Sched::GATHER) {
#pragma unroll
            for (int h = 0; h < 2; ++h)
#pragma unroll
                for (int i = 0; i < 2; ++i) voA[h][i] = nvoA[h][i]; }
        if constexpr (ALIGN_EPI) { if (wr == 1) PG8_BAR; }
    }
    PG8_WAIT_V(0);
    if constexpr (!ALIGN_EPI) { if (wr == 0) PG8_BAR; }
    PG8_BAR;
#undef PG8_SA
#undef PG8_SB
#undef PG8_STGA
#undef PG8_STGB
#undef PG8_VOA
#undef PG8_LDA
#undef PG8_LDB
#undef PG8_MMA
#undef PG8_WAIT_V
#undef PG8_WAIT_L
#undef PG8_BAR
#undef PG8_SCHED
}

typedef f32x4 Acc[2][2][4][2];
struct EpiInProj {
    static constexpr bool PERM = true;
    __device__ __forceinline__ void stage_rows(const Unit&, LAS unsigned char*, int) const {}
    bf16_t *prw, *puv, *pg;
    template <int ACT> __device__ __forceinline__ void tile(const Acc& acc, bf16_t* base, int ld, int row0, int col0) const {
#pragma unroll
        for (int ai = 0; ai < 2; ++ai)
#pragma unroll
            for (int m = 0; m < 4; ++m) { bf16_t* rowp = base + (size_t)(row0 + ai * HALF + m * 16) * ld + col0;
#pragma unroll
                for (int bj = 0; bj < 2; ++bj) { f32x4 v0 = acc[ai][bj][m][0], v1 = acc[ai][bj][m][1];
                    if (ACT == 1) {
#pragma unroll
                        for (int j = 0; j < 4; ++j) { v0[j] = gelu_tanh(v0[j]); v1[j] = gelu_tanh(v1[j]); } }
                    if (ACT == 2) {
#pragma unroll
                        for (int j = 0; j < 4; ++j) { v0[j] = sigmoidf_(v0[j]); v1[j] = sigmoidf_(v1[j]); } }
                    u32x4 w; w.x = pk2(v0[0], v0[1]); w.y = pk2(v0[2], v0[3]); w.z = pk2(v1[0], v1[1]); w.w = pk2(v1[2], v1[3]);
                    *(u32x4*)(rowp + bj * HALF) = w; }
                __builtin_amdgcn_sched_barrier(0); }
    }
    __device__ __forceinline__ void operator()(const Acc& acc, const Unit& u, int wr, int wc, int fr, int fq) const {
        const int row0 = u.row0 + wr * 64 + fr, cw = wc * 32 + 8 * fq;
        if (u.pn < 7) tile<0>(acc, prw, RWKV_COLS, row0, u.pn * 256 + cw);
        else if (u.pn < 11) tile<1>(acc, puv, 1024, row0, (u.pn - 7) * 256 + cw);
        else tile<2>(acc, pg, 2048, row0, (u.pn - 11) * 256 + cw);
    }
};
template <bool SECOND> struct EpiMerge {
    static constexpr bool PERM = true;
    __device__ __forceinline__ void stage_rows(const Unit&, LAS unsigned char*, int) const {}
    bf16_t* m1; const bf16_t* pg; unsigned char* m8;
    __device__ __forceinline__ void operator()(const Acc& acc, const Unit& u, int wr, int wc, int fr, int fq) const {
        const int row0 = u.row0 + wr * 64 + fr, col0 = u.pn * 256 + wc * 32 + 8 * fq;
#pragma unroll
        for (int ai = 0; ai < 2; ++ai)
#pragma unroll
            for (int m = 0; m < 4; ++m) { const size_t r = (size_t)(row0 + ai * HALF + m * 16);
#pragma unroll
                for (int bj = 0; bj < 2; ++bj) { const int c = col0 + bj * HALF;
                    const u32x4 g = *(const u32x4*)(pg + r * 2048 + (SECOND ? 1024 : 0) + c);
                    f32x4 v0 = acc[ai][bj][m][0], v1 = acc[ai][bj][m][1];
                    v0[0] *= bflo(g.x); v0[1] *= bfhi(g.x); v0[2] *= bflo(g.y); v0[3] *= bfhi(g.y); v1[0] *= bflo(g.z); v1[1] *= bfhi(g.z); v1[2] *= bflo(g.w); v1[3] *= bfhi(g.w);
                    if (SECOND) { const u32x4 p = *(const u32x4*)(m1 + r * 1024 + c);
                        v0[0] += bflo(p.x); v0[1] += bfhi(p.x); v0[2] += bflo(p.y); v0[3] += bfhi(p.y); v1[0] += bflo(p.z); v1[1] += bfhi(p.z); v1[2] += bflo(p.w); v1[3] += bfhi(p.w); }
                    if (SECOND) *(u32x2*)(m8 + r * 1024 + c) = pk8(v0, v1);
                    else { u32x4 w; w.x = pk2(v0[0], v0[1]); w.y = pk2(v0[2], v0[3]); w.z = pk2(v1[0], v1[1]); w.w = pk2(v1[2], v1[3]); *(u32x4*)(m1 + r * 1024 + c) = w; } }
                __builtin_amdgcn_sched_barrier(0); }
    }
};
struct EpiResid {
    static constexpr bool PERM = true;
    __device__ __forceinline__ void stage_rows(const Unit&, LAS unsigned char*, int) const {}
    bf16_t* out; const float* base; const float* gate;
    __device__ __forceinline__ void operator()(const Acc& acc, const Unit& u, int wr, int wc, int fr, int fq) const {
        const int row0 = u.row0 + wr * 64 + fr, col0 = u.pn * 256 + wc * 32 + 8 * fq;
        const float* gp = gate + (size_t)(u.row0 >> 13) * 6144 + col0;
        f32x4 gv[2][2];
#pragma unroll
        for (int bj = 0; bj < 2; ++bj)
#pragma unroll
            for (int n = 0; n < 2; ++n) gv[bj][n] = *(const f32x4*)(gp + bj * HALF + n * 4);
#pragma unroll
        for (int ai = 0; ai < 2; ++ai)
#pragma unroll
            for (int m = 0; m < 4; ++m) { const size_t ro = (size_t)(row0 + ai * HALF + m * 16) * 1024 + col0;
#pragma unroll
                for (int bj = 0; bj < 2; ++bj) { const f32x4 b0 = *(const f32x4*)(base + ro + bj * HALF), b1 = *(const f32x4*)(base + ro + bj * HALF + 4);
                    const f32x4 v0 = b0 + gv[bj][0] * acc[ai][bj][m][0], v1 = b1 + gv[bj][1] * acc[ai][bj][m][1];
                    u32x4 w; w.x = pk2(v0[0], v0[1]); w.y = pk2(v0[2], v0[3]); w.z = pk2(v1[0], v1[1]); w.w = pk2(v1[2], v1[3]);
                    *(u32x4*)(out + ro + bj * HALF) = w; }
                __builtin_amdgcn_sched_barrier(0); }
    }
};
struct EpiRouter {
    static constexpr bool PERM = false;
    __device__ __forceinline__ void stage_rows(const Unit&, LAS unsigned char*, int) const {}
    float* sc;
    __device__ __forceinline__ void operator()(const Acc& acc, const Unit& u, int wr, int wc, int fr, int fq) const {
        const int row0 = u.row0 + wr * 64 + fr, col0 = wc * 32 + 4 * fq;
#pragma unroll
        for (int ai = 0; ai < 2; ++ai)
#pragma unroll
            for (int m = 0; m < 4; ++m) { float* rowp = sc + (size_t)(row0 + ai * HALF + m * 16) * 256 + col0;
#pragma unroll
                for (int bj = 0; bj < 2; ++bj)
#pragma unroll
                    for (int n = 0; n < 2; ++n) { f32x4 v = acc[ai][bj][m][n];
#pragma unroll
                        for (int j = 0; j < 4; ++j) v[j] = sigmoidf_(v[j]);
                        *(f32x4*)(rowp + bj * HALF + n * 16) = v; }
                __builtin_amdgcn_sched_barrier(0); }
    }
};
template <bool F8OUT> struct EpiGateUp {
    static constexpr bool PERM = true;
    __device__ __forceinline__ void stage_rows(const Unit&, LAS unsigned char*, int) const {}
    void* hid;
    __device__ __forceinline__ void operator()(const Acc& acc, const Unit& u, int wr, int wc, int fr, int fq) const {
        const int row0 = u.row0 + wr * 64 + fr, col0 = u.pn * HALF + wc * 32 + 8 * fq;
#pragma unroll
        for (int ai = 0; ai < 2; ++ai)
#pragma unroll
            for (int m = 0; m < 4; ++m) { const size_t off = (size_t)(row0 + ai * HALF + m * 16) * EFF + col0;
                f32x4 v0, v1;
#pragma unroll
                for (int j = 0; j < 4; ++j) { v0[j] = siluf_(acc[ai][0][m][0][j]) * acc[ai][1][m][0][j]; v1[j] = siluf_(acc[ai][0][m][1][j]) * acc[ai][1][m][1][j]; }
                if constexpr (F8OUT) *(u32x2*)((unsigned char*)hid + off) = pk8(v0, v1);
                else { u32x4 w; w.x = pk2(v0[0], v0[1]); w.y = pk2(v0[2], v0[3]); w.z = pk2(v1[0], v1[1]); w.w = pk2(v1[2], v1[3]); *(u32x4*)((bf16_t*)hid + off) = w; }
                __builtin_amdgcn_sched_barrier(0); }
    }
};
struct EpiExpertDown {
    static constexpr bool PERM = true;
    unsigned char* slot; const int* rowdst; const float* roww;
    __device__ __forceinline__ void stage_rows(const Unit& u, LAS unsigned char* lds, int wid) const {
        if (wid < 4) { const int lane = threadIdx.x & 63; LAS unsigned char* base = lds + LDS_MISC + u.par * 2048 + wid * 256;
            __builtin_amdgcn_global_load_lds((const unsigned*)(rowdst + u.row0 + wid * 64 + lane), (LAS unsigned*)base, 4, 0, 0);
            __builtin_amdgcn_global_load_lds((const unsigned*)(roww + u.row0 + wid * 64 + lane), (LAS unsigned*)(base + 1024), 4, 0, 0); }
    }
    __device__ __forceinline__ void operator()(const Acc& acc, const Unit& u, int wr, int wc, int fr, int fq) const {
        const unsigned cb = (unsigned)(u.pn * 256 + wc * 32 + 8 * fq);
        const LAS int* td = (const LAS int*)((LAS unsigned char*)nullptr + LDS_MISC + u.par * 2048) + wr * 64 + fr; const LAS float* tw = (const LAS float*)(td + 256);
#pragma unroll
        for (int ai = 0; ai < 2; ++ai)
#pragma unroll
            for (int m = 0; m < 4; ++m) {
                const int dst = td[ai * HALF + m * 16]; const float ws_ = tw[ai * HALF + m * 16];
#ifdef DBG_NOSTORE
                if (dst >= 0 && ws_ == 123456.f) {
#else
                if (dst >= 0) {
#endif
                    unsigned char* rowp = slot + (size_t)((unsigned)dst * 1024u + cb);
#pragma unroll
                    for (int bj = 0; bj < 2; ++bj) { const f32x4 v0 = acc[ai][bj][m][0] * ws_, v1 = acc[ai][bj][m][1] * ws_;
                        *(u32x2*)(rowp + bj * HALF) = pk8(v0, v1); } }
                __builtin_amdgcn_sched_barrier(0);
            }
    }
};
struct EpiSharedDown {
    static constexpr bool PERM = true;
    unsigned char* sho;
    __device__ __forceinline__ void stage_rows(const Unit&, LAS unsigned char*, int) const {}
    __device__ __forceinline__ void operator()(const Acc& acc, const Unit& u, int wr, int wc, int fr, int fq) const {
        const int row0 = u.row0 + wr * 64 + fr, col0 = u.pn * 256 + wc * 32 + 8 * fq;
#pragma unroll
        for (int ai = 0; ai < 2; ++ai)
#pragma unroll
            for (int m = 0; m < 4; ++m) { unsigned char* rowp = sho + (size_t)(row0 + ai * HALF + m * 16) * 1024 + col0;
#pragma unroll
                for (int bj = 0; bj < 2; ++bj) *(u32x2*)(rowp + bj * HALF) = pk8(acc[ai][bj][m][0], acc[ai][bj][m][1]);
                __builtin_amdgcn_sched_barrier(0); }
    }
};
}
__device__ __forceinline__ void phase_mod(const float* c, const float* ada_w, const float* ada_b, float* mod, LAS unsigned char* lds, int tid, int G) {
    LAS float* sl = (LAS float*)lds; LAS float* red = (LAS float*)(lds + 32768);
    for (int i = tid; i < NB * D; i += NTHREADS) { const float v = c[i]; sl[i] = siluf_(v); }
    __syncthreads();
    const int cl = tid % 24, kg = tid / 24;
    for (int cb = blockIdx.x; cb < 256; cb += G) {
        const int col0 = cb * 24;
        if (tid < 384) {
            float a[NB];
#pragma unroll
            for (int b = 0; b < NB; ++b) a[b] = 0.f;
#pragma unroll 1
            for (int k0 = kg; k0 < D; k0 += 16 * 16) { float w[16];
#pragma unroll
                for (int i = 0; i < 16; ++i) w[i] = ada_w[(size_t)(k0 + 16 * i) * 6144 + col0 + cl];
#pragma unroll
                for (int i = 0; i < 16; ++i) {
#pragma unroll
                    for (int b = 0; b < NB; ++b) a[b] += sl[b * D + k0 + 16 * i] * w[i]; } }
#pragma unroll
            for (int b = 0; b < NB; ++b) red[(kg * 24 + cl) * NB + b] = a[b];
        }
        __syncthreads();
        if (tid < 192) { const int c2 = tid >> 3, b = tid & 7; float s = 0.f;
#pragma unroll
            for (int g = 0; g < 16; ++g) s += red[(g * 24 + c2) * NB + b];
            mod[(size_t)b * 6144 + col0 + c2] = s + ada_b[col0 + c2]; }
        __syncthreads();
    }
}
__device__ __forceinline__ void transpose_item(const float* W, int ldw, int k0, int n0, bf16_t* WT, int ldt, int drow0, LAS float* scr, int lane) {
#pragma unroll 8
    for (int i = 0; i < 32; ++i) { const int kk = 2 * i + (lane >> 5); scr[kk * 33 + (lane & 31)] = W[(size_t)(k0 + kk) * ldw + n0 + (lane & 31)]; }
    LDS_WAIT(); asm volatile("" ::: "memory");
    const int c = lane & 7;
#pragma unroll
    for (int j = 0; j < 4; ++j) { const int n = (lane >> 3) + 8 * j; const LAS float* s = scr + (8 * c) * 33 + n;
        u32x4 o; o.x = pk2(s[0 * 33], s[1 * 33]); o.y = pk2(s[2 * 33], s[3 * 33]); o.z = pk2(s[4 * 33], s[5 * 33]); o.w = pk2(s[6 * 33], s[7 * 33]);
        *(u32x4*)(WT + (size_t)(drow0 + n) * ldt + k0 + 8 * c) = o; }
    LDS_WAIT(); asm volatile("" ::: "memory");
}
__device__ __forceinline__ void transpose_job(const float* W, int K, int N, bf16_t* WT, int gated, int goff, int item, LAS float* scr, int lane) {
    const int nblk = N / 32, kb = item / nblk, nb = item % nblk, n0 = 32 * nb;
    const int drow0 = gated ? (256 * (n0 >> 7) + goff + (n0 & 127)) : n0;
    transpose_item(W, N, 64 * kb, n0, WT, K, drow0, scr, lane);
}
__device__ __forceinline__ void transpose_item64(const float* W, int ldw, int k0, int n0, bf16_t* WT, int ldt, int drow0, LAS float* scr, int lane) {
    f32x4 v[16];
    const int c4 = lane & 15, r4 = lane >> 4;
#pragma unroll
    for (int i = 0; i < 16; ++i) v[i] = *(const f32x4*)(W + (size_t)(k0 + 4 * i + r4) * ldw + n0 + 4 * c4);
#pragma unroll
    for (int i = 0; i < 16; ++i) { LAS float* d = scr + (4 * i + r4) * 65 + 4 * c4; d[0] = v[i].x; d[1] = v[i].y; d[2] = v[i].z; d[3] = v[i].w; }
    LDS_WAIT(); asm volatile("" ::: "memory");
    const int c = lane & 7;
#pragma unroll
    for (int j = 0; j < 8; ++j) { const int n = (lane >> 3) + 8 * j; const LAS float* s = scr + (8 * c) * 65 + n;
        u32x4 o; o.x = pk2(s[0 * 65], s[1 * 65]); o.y = pk2(s[2 * 65], s[3 * 65]); o.z = pk2(s[4 * 65], s[5 * 65]); o.w = pk2(s[6 * 65], s[7 * 65]);
        *(u32x4*)(WT + (size_t)(drow0 + n) * ldt + k0 + 8 * c) = o; }
    LDS_WAIT(); asm volatile("" ::: "memory");
}
constexpr float WSCALE = 32.0f;
__device__ __forceinline__ void transpose_item64_f8(const float* W, int ldw, int k0, int n0, unsigned char* WT8, int ldt, int drow0, LAS float* scr, int lane) {
    f32x4 v[16];
    const int c4 = lane & 15, r4 = lane >> 4;
#pragma unroll
    for (int i = 0; i < 16; ++i) v[i] = *(const f32x4*)(W + (size_t)(k0 + 4 * i + r4) * ldw + n0 + 4 * c4);
#pragma unroll
    for (int i = 0; i < 16; ++i) { LAS float* d = scr + (4 * i + r4) * 65 + 4 * c4; d[0] = v[i].x; d[1] = v[i].y; d[2] = v[i].z; d[3] = v[i].w; }
    LDS_WAIT(); asm volatile("" ::: "memory");
    const int c = lane & 7;
#pragma unroll
    for (int j = 0; j < 8; ++j) { const int n = (lane >> 3) + 8 * j; const LAS float* s = scr + (8 * c) * 65 + n;
        const f32x4 lo = (f32x4){s[0 * 65], s[1 * 65], s[2 * 65], s[3 * 65]} * WSCALE, hi = (f32x4){s[4 * 65], s[5 * 65], s[6 * 65], s[7 * 65]} * WSCALE;
        *(u32x2*)(WT8 + (size_t)(drow0 + n) * ldt + k0 + 8 * c) = pk8(lo, hi); }
    LDS_WAIT(); asm volatile("" ::: "memory");
}
struct SmallW { const float *w_in, *w_out_a, *w_out_b, *w_out, *router_w, *sw1, *sw3, *sw2, *w_up, *a_up, *g_up, *gws; };
__device__ __forceinline__ void phase_small_weights(const SmallW& P, unsigned char* ws, LAS unsigned char* lds, int gw, int NGW, int wave, int lane) {
    LAS float* scr = (LAS float*)(lds + wave * 16640);
    constexpr int I0 = 16 * 76, I1 = 8 * 16, I2 = 8 * 16, I3 = 16 * 16, I4 = 16 * 8, I5 = 16 * 4, I6 = 16 * 4, I7 = 4 * 16, I8 = 16, I9 = 16, I10 = 2 * 16;
    constexpr int NIT = I0 + I1 + I2 + I3 + I4 + I5 + I6 + I7 + I8 + I9 + I10;
    for (int it = gw; it < NIT; it += NGW) {
        int r = it;
        if (r < I0) { const int kb = r / 76, nb = r % 76; transpose_item64_f8(P.w_in, IN_COLS, 64 * kb, 64 * nb, ws + SW_WIN, D, 64 * nb, scr, lane); continue; } r -= I0;
        if (r < I1) { transpose_item64_f8(P.w_out_a, D, 64 * (r >> 4), 64 * (r & 15), ws + SW_WOA, RW, 64 * (r & 15), scr, lane); continue; } r -= I1;
        if (r < I2) { transpose_item64_f8(P.w_out_b, D, 64 * (r >> 4), 64 * (r & 15), ws + SW_WOB, RW, 64 * (r & 15), scr, lane); continue; } r -= I2;
        if (r < I3) { transpose_item64_f8(P.w_out, D, 64 * (r >> 4), 64 * (r & 15), ws + SW_WO, D, 64 * (r & 15), scr, lane); continue; } r -= I3;
        if (r < I4) { transpose_job(P.router_w, D, NE, (bf16_t*)(ws + SW_WR), 0, 0, r, scr, lane); continue; } r -= I4;
        if (r < I5) { const int n0 = 64 * (r & 3); transpose_item64_f8(P.sw1, EFF, 64 * (r >> 2), n0, ws + SW_WS13, D, 256 * (n0 >> 7) + (n0 & 127), scr, lane); continue; } r -= I5;
        if (r < I6) { const int n0 = 64 * (r & 3); transpose_item64_f8(P.sw3, EFF, 64 * (r >> 2), n0, ws + SW_WS13, D, 256 * (n0 >> 7) + 128 + (n0 & 127), scr, lane); continue; } r -= I6;
        if (r < I7) { transpose_item64_f8(P.sw2, D, 64 * (r >> 4), 64 * (r & 15), ws + SW_WS2, EFF, 64 * (r & 15), scr, lane); continue; } r -= I7;
        if (r < I8) { transpose_job(P.w_up, 64, RW, (bf16_t*)(ws + SW_WUP), 0, 0, r, scr, lane); continue; } r -= I8;
        if (r < I9) { transpose_job(P.a_up, 64, RW, (bf16_t*)(ws + SW_AUP), 0, 0, r, scr, lane); continue; } r -= I9;
        transpose_job(P.g_up, 128, RW, (bf16_t*)(ws + SW_GUP), 0, 0, r, scr, lane);
    }
    bf16_t* wsm = (bf16_t*)(ws + SW_WSM);
    for (int i = gw * 64 + lane; i < 8 * 128 * 128; i += NGW * 64) { const int col = i & 127, row = (i >> 7) & 127; wsm[i] = (col <= row) ? f2bf(P.gws[i]) : (bf16_t)0; }
}
__device__ __forceinline__ void phase_expert_weights(const float* w1, const float* w3, const float* w2, unsigned char* ws, LAS unsigned char* lds, int gw, int NGW, int wave, int lane) {
    LAS float* scr = (LAS float*)(lds + wave * 16640);
    constexpr int PER = 64;
    for (int it = gw; it < NE * 3 * PER; it += NGW) {
        const int e = it / (3 * PER), r = it % (3 * PER), which = r / PER, item = r % PER;
        if (which < 2) { const int kb = item >> 2, nb = item & 3, n0 = 64 * nb;
            transpose_item64_f8((which ? w3 : w1) + (size_t)e * D * EFF, EFF, 64 * kb, n0, ws + B_W13 + (size_t)e * 512 * D, D, 256 * (n0 >> 7) + which * 128 + (n0 & 127), scr, lane); }
        else { const int kb = item >> 4, nb = item & 15;
            transpose_item64_f8(w2 + (size_t)e * EFF * D, D, 64 * kb, 64 * nb, ws + B_W2 + (size_t)e * D * EFF, EFF, 64 * nb, scr, lane); }
    }
}
template <bool XBF>
__device__ __forceinline__ void phase_norm_mod(const void* X, const float* gain, const float* mod, int sh_off, int sc_off, bf16_t* out, unsigned char* out8, int gw, int NGW, int lane) {
    constexpr int R = XBF ? 4 : 8;
    for (int m0 = gw; m0 < T; m0 += R * NGW) {
        f32x4 v[R][4];
#pragma unroll
        for (int rr = 0; rr < R; ++rr) { const int m = m0 + rr * NGW; const size_t mr = (size_t)(m < T ? m : m0);
            if constexpr (XBF) { const u32x2* xr = (const u32x2*)((const bf16_t*)X + mr * D) + lane;
#pragma unroll
                for (int j = 0; j < 4; ++j) { const u32x2 w = xr[64 * j]; v[rr][j] = (f32x4){bflo(w.x), bfhi(w.x), bflo(w.y), bfhi(w.y)}; } }
            else { const f32x4* xr = (const f32x4*)((const float*)X + mr * D) + lane;
#pragma unroll
                for (int j = 0; j < 4; ++j) v[rr][j] = xr[64 * j]; } }
#pragma unroll
        for (int rr = 0; rr < R; ++rr) { const int m = m0 + rr * NGW; if (m >= T) break;
            float ss = 0.f;
#pragma unroll
            for (int j = 0; j < 4; ++j) ss += (v[rr][j].x * v[rr][j].x + v[rr][j].y * v[rr][j].y) + (v[rr][j].z * v[rr][j].z + v[rr][j].w * v[rr][j].w);
            const float rstd = __builtin_amdgcn_rsqf(wave_sum(ss) * (1.f / D) + 1e-6f);
            const float* mb = mod + (size_t)(m >> 13) * 6144;
            u32x2* o8 = (u32x2*)(out + (size_t)m * D) + lane;
#pragma unroll
            for (int j = 0; j < 4; ++j) { const int col = 4 * lane + 256 * j;
                const f32x4 g = *(const f32x4*)(gain + col), sc = *(const f32x4*)(mb + sc_off + col), sh = *(const f32x4*)(mb + sh_off + col);
                const f32x4 y = v[rr][j] * rstd * g * (sc + 1.0f) + sh;
                if (out) { u32x2 w; w.x = pk2(y.x, y.y); w.y = pk2(y.z, y.w); o8[64 * j] = w; }
                if (out8) { int t8 = __builtin_amdgcn_cvt_pk_fp8_f32(y.x, y.y, 0, false); t8 = __builtin_amdgcn_cvt_pk_fp8_f32(y.z, y.w, t8, true); *(unsigned*)(out8 + (size_t)m * D + col) = (unsigned)t8; } } }
    }
}
struct YaArgs { bf16_t* ya; const bf16_t* g; const bf16_t* prw; const float* sbon; const float* mu; const float* ln_g; const float* ln_b; };
__device__ __forceinline__ void phase_ya_final(const YaArgs& P, int gw, int NGW, int lane) {
    const int ch0 = lane * 8, head = lane >> 3;
    float muv[8], lg[8], lb[8];
#pragma unroll
    for (int j = 0; j < 8; ++j) { muv[j] = P.mu[1024 + ch0 + j]; lg[j] = P.ln_g[ch0 + j]; lb[j] = P.ln_b[ch0 + j]; }
    for (int m = gw; m < T; m += NGW) {
        const u32x4 yw = *(const u32x4*)(P.ya + (size_t)m * RW + ch0);
        const u32x4 gw4 = *(const u32x4*)(P.g + (size_t)m * RW + ch0);
        const u32x4 vc = *(const u32x4*)(P.prw + (size_t)m * RWKV_COLS + 1024 + ch0);
        u32x4 vp = (u32x4){0u, 0u, 0u, 0u};
        if ((m & (SEQ - 1)) != 0) vp = *(const u32x4*)(P.prw + (size_t)(m - 1) * RWKV_COLS + 1024 + ch0);
        const float sb = P.sbon[(size_t)m * NH + head];
        float y[8], gg[8], vv[8], pv[8];
        y[0] = bflo(yw.x); y[1] = bfhi(yw.x); y[2] = bflo(yw.y); y[3] = bfhi(yw.y); y[4] = bflo(yw.z); y[5] = bfhi(yw.z); y[6] = bflo(yw.w); y[7] = bfhi(yw.w);
        gg[0] = bflo(gw4.x); gg[1] = bfhi(gw4.x); gg[2] = bflo(gw4.y); gg[3] = bfhi(gw4.y); gg[4] = bflo(gw4.z); gg[5] = bfhi(gw4.z); gg[6] = bflo(gw4.w); gg[7] = bfhi(gw4.w);
        vv[0] = bflo(vc.x); vv[1] = bfhi(vc.x); vv[2] = bflo(vc.y); vv[3] = bfhi(vc.y); vv[4] = bflo(vc.z); vv[5] = bfhi(vc.z); vv[6] = bflo(vc.w); vv[7] = bfhi(vc.w);
        pv[0] = bflo(vp.x); pv[1] = bfhi(vp.x); pv[2] = bflo(vp.y); pv[3] = bfhi(vp.y); pv[4] = bflo(vp.z); pv[5] = bfhi(vp.z); pv[6] = bflo(vp.w); pv[7] = bfhi(vp.w);
        float s = 0.f;
#pragma unroll
        for (int j = 0; j < 8; ++j) s += y[j];
        s += __shfl_xor(s, 1); s += __shfl_xor(s, 2); s += __shfl_xor(s, 4);
        const float mean = s * (1.f / 64.f); float q = 0.f;
#pragma unroll
        for (int j = 0; j < 8; ++j) { y[j] -= mean; q += y[j] * y[j]; }
        q += __shfl_xor(q, 1); q += __shfl_xor(q, 2); q += __shfl_xor(q, 4);
        const float rstd = __builtin_amdgcn_rsqf(q * (1.f / 64.f) + 64e-5f);
        float o[8];
#pragma unroll
        for (int j = 0; j < 8; ++j) { const float vs = vv[j] + (pv[j] - vv[j]) * muv[j]; o[j] = (y[j] * rstd * lg[j] + lb[j] + sb * vs) * gg[j]; }
        u32x4 w; w.x = pk2(o[0], o[1]); w.y = pk2(o[2], o[3]); w.z = pk2(o[4], o[5]); w.w = pk2(o[6], o[7]);
        *(u32x4*)(P.ya + (size_t)m * RW + ch0) = w;
    }
}
__device__ __forceinline__ void phase_xs(const bf16_t* prw, const float* mu, bf16_t* xs, int gw, int NGW, int lane) {
    const f32x4 m4 = *(const f32x4*)(mu + 1536 + 4 * lane);
    for (int t = gw; t < T; t += NGW) {
        const bf16_t* src = prw + (size_t)t * RWKV_COLS + 1536 + 4 * lane;
        const u32x2 cw = *(const u32x2*)src; u32x2 pw = (u32x2){0u, 0u};
        if ((t & (SEQ - 1)) != 0) pw = *(const u32x2*)(src - RWKV_COLS);
        f32x4 v = (f32x4){bflo(cw.x), bfhi(cw.x), bflo(cw.y), bfhi(cw.y)}; const f32x4 p = (f32x4){bflo(pw.x), bfhi(pw.x), bflo(pw.y), bfhi(pw.y)};
        v = v + (p - v) * m4;
        if (lane < 16) {
#pragma unroll
            for (int j = 0; j < 4; ++j) v[j] = tanhf_(v[j]); }
        else if (lane >= 32) {
#pragma unroll
            for (int j = 0; j < 4; ++j) v[j] = sigmoidf_(v[j]); }
        u32x2 w; w.x = pk2(v[0], v[1]); w.y = pk2(v[2], v[3]);
        *(u32x2*)(xs + (size_t)t * 256 + 4 * lane) = w;
    }
}
__device__ __forceinline__ void phase_combine(float* out, const bf16_t* x1, const unsigned char* slot, const unsigned char* sho, const float* mod, const float* normf, int gw, int NGW, int lane) {
    for (int m = gw; m < T; m += NGW) {
        const int b = m >> 13;
        f32x4* xr = (f32x4*)(out + (size_t)m * D + 16 * lane);
        const float* g2 = mod + (size_t)b * 6144 + 5120 + 16 * lane;
        u32x4 sw[TOPK + 1];
#pragma unroll
        for (int k = 0; k < TOPK; ++k) sw[k] = *(const u32x4*)(slot + ((size_t)m * TOPK + k) * D + 16 * lane);
        sw[TOPK] = *(const u32x4*)(sho + (size_t)m * D + 16 * lane);
        f32x4 x[4];
        { const u32x4 w0 = *(const u32x4*)(x1 + (size_t)m * D + 16 * lane), w1 = *(const u32x4*)(x1 + (size_t)m * D + 16 * lane + 8);
          x[0] = (f32x4){bflo(w0.x), bfhi(w0.x), bflo(w0.y), bfhi(w0.y)}; x[1] = (f32x4){bflo(w0.z), bfhi(w0.z), bflo(w0.w), bfhi(w0.w)};
          x[2] = (f32x4){bflo(w1.x), bfhi(w1.x), bflo(w1.y), bfhi(w1.y)}; x[3] = (f32x4){bflo(w1.z), bfhi(w1.z), bflo(w1.w), bfhi(w1.w)}; }
        f32x4 a[4];
#pragma unroll
        for (int j = 0; j < 4; ++j) a[j] = (f32x4){0.f, 0.f, 0.f, 0.f};
#pragma unroll
        for (int k = 0; k <= TOPK; ++k) { a[0] += up8(sw[k].x); a[1] += up8(sw[k].y); a[2] += up8(sw[k].z); a[3] += up8(sw[k].w); }
        float ss = 0.f;
#pragma unroll
        for (int j = 0; j < 4; ++j) { x[j] = x[j] + *(const f32x4*)(g2 + 4 * j) * a[j]; ss += (x[j].x * x[j].x + x[j].y * x[j].y) + (x[j].z * x[j].z + x[j].w * x[j].w); }
        const float rstd = __builtin_amdgcn_rsqf(wave_sum(ss) * (1.f / D) + 1e-6f);
#pragma unroll
        for (int j = 0; j < 4; ++j) xr[j] = x[j] * rstd * *(const f32x4*)(normf + 16 * lane + 4 * j);
    }
}
namespace rk {
constexpr int LD = 80;
constexpr int SLOTB = 64 * LD * 2;
constexpr int LDG = 136;
typedef LAS bf16_t* lp;
__device__ __forceinline__ lp slot(LAS unsigned char* lds, int i) { return (lp)(lds + i * SLOTB); }
template <int KS>
__device__ __forceinline__ void mm_nt(const LAS bf16_t* X, int ldx, const LAS bf16_t* Y, int ldy, int m, int nt0, int r, int q, f32x4 (&acc)[2]) {
#pragma unroll
    for (int s = 0; s < KS; ++s) {
        const bf16x8 a = *(const LAS bf16x8*)(X + (16 * m + r) * ldx + 32 * s + 8 * q);
#pragma unroll
        for (int n = 0; n < 2; ++n) { const bf16x8 b = *(const LAS bf16x8*)(Y + (16 * (nt0 + n) + r) * ldy + 32 * s + 8 * q); acc[n] = __builtin_amdgcn_mfma_f32_16x16x32_bf16(a, b, acc[n], 0, 0, 0); }
    }
}
__device__ __forceinline__ void st_rm(lp dst, int m, int nt, int r, int q, const f32x4& a) {
#pragma unroll
    for (int ii = 0; ii < 4; ++ii) dst[(16 * m + 4 * q + ii) * LD + 16 * nt + r] = f2bf(a[ii]);
}
__device__ __forceinline__ void st_tr(lp dst, int m, int nt, int r, int q, const f32x4& a) {
    u32x2 w; w.x = pk2(a[0], a[1]); w.y = pk2(a[2], a[3]); *(LAS u32x2*)(dst + (16 * nt + r) * LD + 16 * m + 4 * q) = w;
}
__device__ __forceinline__ void ld_rm(const LAS bf16_t* src, int m, int nt, int r, int q, f32x4& a) {
#pragma unroll
    for (int ii = 0; ii < 4; ++ii) a[ii] = bf2f(src[(16 * m + 4 * q + ii) * LD + 16 * nt + r]);
}
struct Args {
    const bf16_t* prw; const float* mu; const float *w0, *a0, *k_k, *k_a, *r_k;
    const bf16_t *wup, *aup, *gup;
    const bf16_t* xs;
    bf16_t* g; bf16_t* bv; unsigned char* mn; unsigned char* qy;
};
constexpr int LDS_MU = LDS_MISC + 2304;
struct Pre { u32x4 cw[3], pw[3]; bf16x8 xs[8]; };
__device__ __forceinline__ void task_map(int task, int h, int& i, int& ch, int& col) {
    i = task / 24; ch = task % 24;
    col = (ch >> 3) * 512 + h * 64 + 8 * (ch & 7);
}
__device__ __forceinline__ void load_mu(const Args& P, LAS unsigned char* lds, int tid) {
    LAS bf16_t* MU = (LAS bf16_t*)(lds + LDS_MU);
    for (int i = tid; i < 1536; i += NTHREADS) MU[i] = f2bf(P.mu[i]);
    __syncthreads();
}
__device__ __forceinline__ void prefetch(const Args& P, int b, int h, int c, int tid, Pre& pre) {
    const int t0 = b * SEQ + c * 64;
#pragma unroll
    for (int it = 0; it < 3; ++it) {
        int i, ch, col; task_map(tid + it * NTHREADS, h, i, ch, col);
        const bf16_t* src = P.prw + (size_t)(t0 + i) * RWKV_COLS + col;
        pre.cw[it] = *(const u32x4*)src;
        pre.pw[it] = (u32x4){0u, 0u, 0u, 0u};
        if (i != 0 || c != 0) pre.pw[it] = *(const u32x4*)(src - RWKV_COLS);
    }
    const int lane = tid & 63, r = lane & 15, q = lane >> 4, m = (tid >> 6) & 3;
    const bf16_t* xr = P.xs + (size_t)(t0 + 16 * m + r) * 256 + 8 * q;
#pragma unroll
    for (int f = 0; f < 8; ++f) pre.xs[f] = *(const bf16x8*)(xr + 32 * f);
}
__device__ __forceinline__ void unit(const Args& P, LAS unsigned char* lds, int b, int h, int c, int uidx, int tid, Pre& pf, bool has_next, int nb, int nh_, int nc) {
    const int wave = __builtin_amdgcn_readfirstlane(tid >> 6), lane = tid & 63, r = lane & 15, q = lane >> 4, m = wave & 3, nh = wave >> 2;
    const int t0 = b * SEQ + c * 64;
    lp S0 = slot(lds, 0), S1 = slot(lds, 1), S2 = slot(lds, 2), S3 = slot(lds, 3), S4 = slot(lds, 4), S5 = slot(lds, 5), S6 = slot(lds, 6), S7 = slot(lds, 7);
    lp S8 = slot(lds, 8), S9 = slot(lds, 9), S10 = slot(lds, 10), S11 = slot(lds, 11), S12 = slot(lds, 12), S13 = slot(lds, 13), S14 = slot(lds, 14);
    LAS float* PART = (LAS float*)(lds + LDS_MISC);
    LAS float* CT = PART + 256;
    LAS float* DEND = CT + 256;
    const LAS bf16_t* MU = (const LAS bf16_t*)(lds + LDS_MU);
#define RK_BAR() do { asm volatile("s_waitcnt lgkmcnt(0)" ::: "memory"); __builtin_amdgcn_s_barrier(); asm volatile("" ::: "memory"); } while (0)
#define RK_DBG(bit, sp) do {} while (0)
#pragma unroll
    for (int it = 0; it < 3; ++it) {
        int i, ch, col; task_map(tid + it * NTHREADS, h, i, ch, col);
        LAS bf16_t* dst = slot(lds, 8 + (ch >> 3)) + i * LD + 8 * (ch & 7);
        const u32x4 cw = pf.cw[it], pw = pf.pw[it];
        const u32x4 mw = *(const LAS u32x4*)(MU + col);
        const f32x4 m0 = (f32x4){bflo(mw.x), bfhi(mw.x), bflo(mw.y), bfhi(mw.y)}, m1 = (f32x4){bflo(mw.z), bfhi(mw.z), bflo(mw.w), bfhi(mw.w)};
        float v[8], p[8];
        v[0] = bflo(cw.x); v[1] = bfhi(cw.x); v[2] = bflo(cw.y); v[3] = bfhi(cw.y); v[4] = bflo(cw.z); v[5] = bfhi(cw.z); v[6] = bflo(cw.w); v[7] = bfhi(cw.w);
        p[0] = bflo(pw.x); p[1] = bfhi(pw.x); p[2] = bflo(pw.y); p[3] = bfhi(pw.y); p[4] = bflo(pw.z); p[5] = bfhi(pw.z); p[6] = bflo(pw.w); p[7] = bfhi(pw.w);
#pragma unroll
        for (int j = 0; j < 4; ++j) { v[j] += (p[j] - v[j]) * m0[j]; v[4 + j] += (p[4 + j] - v[4 + j]) * m1[j]; }
        u32x4 w; w.x = pk2(v[0], v[1]); w.y = pk2(v[2], v[3]); w.z = pk2(v[4], v[5]); w.w = pk2(v[6], v[7]);
        *(LAS u32x4*)dst = w;
    }
    RK_BAR();
    f32x4 aw[2], aa[2], ag[2];
#pragma unroll
    for (int n = 0; n < 2; ++n) { aw[n] = (f32x4){0.f, 0.f, 0.f, 0.f}; aa[n] = aw[n]; ag[n] = aw[n]; }
#pragma unroll
    for (int s = 0; s < 2; ++s) {
#pragma unroll
        for (int n = 0; n < 2; ++n) { const int row = h * 64 + 16 * (2 * nh + n) + r;
            const bf16x8 bw = *(const bf16x8*)(P.wup + (size_t)row * 64 + 32 * s + 8 * q), ba = *(const bf16x8*)(P.aup + (size_t)row * 64 + 32 * s + 8 * q);
            aw[n] = __builtin_amdgcn_mfma_f32_16x16x32_bf16(pf.xs[s], bw, aw[n], 0, 0, 0); aa[n] = __builtin_amdgcn_mfma_f32_16x16x32_bf16(pf.xs[2 + s], ba, aa[n], 0, 0, 0); }
    }
#pragma unroll
    for (int s = 0; s < 4; ++s) {
#pragma unroll
        for (int n = 0; n < 2; ++n) { const int row = h * 64 + 16 * (2 * nh + n) + r;
            const bf16x8 bg = *(const bf16x8*)(P.gup + (size_t)row * 128 + 32 * s + 8 * q);
            ag[n] = __builtin_amdgcn_mfma_f32_16x16x32_bf16(pf.xs[4 + s], bg, ag[n], 0, 0, 0); }
    }
    if (has_next) prefetch(P, nb, nh_, nc, tid, pf);
    float rr[2][4], kq[2][4], vv[2][4], av[2][4], lw[2][4], kp[2][4], pre[2][4], preq[2];
    float ss[4] = {0.f, 0.f, 0.f, 0.f}, bs[4] = {0.f, 0.f, 0.f, 0.f};
#pragma unroll
    for (int n = 0; n < 2; ++n) {
        const int ch = 32 * nh + 16 * n + r, chg = h * 64 + ch;
        const float w0v = P.w0[chg], a0v = P.a0[chg], kkc = P.k_k[chg], kac = P.k_a[chg], rkc = P.r_k[chg];
#pragma unroll
        for (int ii = 0; ii < 4; ++ii) {
            const int pos = 16 * m + 4 * q + ii;
            const float rv = bf2f(S8[pos * LD + ch]), kraw = bf2f(S9[pos * LD + ch]); vv[n][ii] = bf2f(S10[pos * LD + ch]); rr[n][ii] = rv;
            const float z = -(w0v + aw[n][ii]);
            const float sp = fmaxf(z, 0.f) + flog(1.0f + fexp(-fabsf(z)));
            lw[n][ii] = -fexp(-sp - 0.5f);
            const float a_ = sigmoidf_(a0v + aa[n][ii]); av[n][ii] = a_;
            P.g[(size_t)(t0 + pos) * RW + chg] = f2bf(ag[n][ii]);
            const float kk = kraw * kkc; kq[n][ii] = kk;
            const float kpv = kraw * (1.0f + (a_ - 1.0f) * kac); kp[n][ii] = kpv;
            ss[ii] += kk * kk; bs[ii] += rv * kpv * rkc;
        }
        pre[n][0] = lw[n][0]; pre[n][1] = pre[n][0] + lw[n][1]; pre[n][2] = pre[n][1] + lw[n][2]; pre[n][3] = pre[n][2] + lw[n][3];
        const float tot = pre[n][3];
        const float t0_ = __shfl(tot, r), t1_ = __shfl(tot, r + 16), t2_ = __shfl(tot, r + 32), t3_ = __shfl(tot, r + 48);
        preq[n] = (q > 0 ? t0_ : 0.f) + (q > 1 ? t1_ : 0.f) + (q > 2 ? t2_ : 0.f);
        if (q == 0) CT[m * 64 + ch] = (t0_ + t1_) + (t2_ + t3_);
    }
#pragma unroll
    for (int ii = 0; ii < 4; ++ii) {
#pragma unroll
        for (int o = 1; o < 16; o <<= 1) { ss[ii] += __shfl_xor(ss[ii], o); bs[ii] += __shfl_xor(bs[ii], o); }
        if (r == 0) { const int pos = 16 * m + 4 * q + ii; PART[(nh * 64 + pos) * 2] = ss[ii]; PART[(nh * 64 + pos) * 2 + 1] = bs[ii]; }
    }
    RK_BAR();
#pragma unroll
    for (int n = 0; n < 2; ++n) {
        const int ch = 32 * nh + 16 * n + r;
        float carry = 0.f, lend = 0.f;
#pragma unroll
        for (int mm = 0; mm < 4; ++mm) { const float cv = CT[mm * 64 + ch]; lend += cv; carry += (mm < m) ? cv : 0.f; }
        f32x4 tA, tBh, tKh, tV;
#pragma unroll
        for (int ii = 0; ii < 4; ++ii) {
            const int pos = 16 * m + 4 * q + ii;
            const float L = carry + preq[n] + pre[n][ii], Lm1 = L - lw[n][ii];
            const float ssum = PART[pos * 2] + PART[(64 + pos) * 2];
            const float inv = frcp(fmaxf(__builtin_sqrtf(ssum), 1e-12f));
            const float kkn = kq[n][ii] * inv, kb = kkn * av[n][ii];
            const float eN = fexp(-L), eE = fexp(lend - L);
            const float At = -kkn * fexp(Lm1), Rt = rr[n][ii] * fexp(L), Bt = kb * eN, Kt = kp[n][ii] * eN;
            S0[pos * LD + ch] = f2bf(At); S1[pos * LD + ch] = f2bf(Bt); S2[pos * LD + ch] = f2bf(Kt); S3[pos * LD + ch] = f2bf(Rt);
            tA[ii] = At; tBh[ii] = kb * eE; tKh[ii] = kp[n][ii] * eE; tV[ii] = vv[n][ii];
            P.bv[(size_t)(t0 + pos) * RW + h * 64 + ch] = f2bf((PART[pos * 2 + 1] + PART[(64 + pos) * 2 + 1]) * vv[n][ii]);
        }
        { u32x2 w; const int off = ch * LD + 16 * m + 4 * q;
          w.x = pk2(tA[0], tA[1]); w.y = pk2(tA[2], tA[3]); *(LAS u32x2*)(S4 + off) = w;
          w.x = pk2(tBh[0], tBh[1]); w.y = pk2(tBh[2], tBh[3]); *(LAS u32x2*)(S5 + off) = w;
          w.x = pk2(tKh[0], tKh[1]); w.y = pk2(tKh[2], tKh[3]); *(LAS u32x2*)(S6 + off) = w;
          w.x = pk2(tV[0], tV[1]); w.y = pk2(tV[2], tV[3]); *(LAS u32x2*)(S7 + off) = w; }
        if (m == 0 && q == 0) DEND[ch] = fexp(lend);
    }
    RK_BAR();
    RK_DBG(0, S0); RK_DBG(1, S1); RK_DBG(2, S2); RK_DBG(3, S3); RK_DBG(4, S4); RK_DBG(5, S5); RK_DBG(6, S6); RK_DBG(7, S7);
    const int nt0 = 2 * nh;
    f32x4 acc[2], acc2[2];
#define RK_ZERO(a) do { a[0] = (f32x4){0.f, 0.f, 0.f, 0.f}; a[1] = a[0]; } while (0)
#define RK_LDT(src, mt, ntt, a) do { const u32x2 w_ = *(const LAS u32x2*)((src) + (16 * (ntt) + r) * LD + 16 * (mt) + 4 * q); a = (f32x4){bflo(w_.x), bfhi(w_.x), bflo(w_.y), bfhi(w_.y)}; } while (0)
#define RK_MASK(a, ntt, COND) do { _Pragma("unroll") for (int ii = 0; ii < 4; ++ii) { const int row = 16 * m + 4 * q + ii, col = 16 * (ntt) + r; a[ii] = (COND) ? a[ii] : 0.f; } } while (0)
    RK_ZERO(acc); mm_nt<2>(S0, LD, S1, LD, m, nt0, r, q, acc);
#pragma unroll
    for (int n = 0; n < 2; ++n) { RK_MASK(acc[n], nt0 + n, col < row); st_tr(S9, m, nt0 + n, r, q, acc[n]); }
    RK_ZERO(acc); mm_nt<2>(S1, LD, S0, LD, m, nt0, r, q, acc);
#pragma unroll
    for (int n = 0; n < 2; ++n) { RK_MASK(acc[n], nt0 + n, row < col); st_tr(S8, m, nt0 + n, r, q, acc[n]);
#pragma unroll
        for (int ii = 0; ii < 4; ++ii) acc[n][ii] += ((16 * m + 4 * q + ii) == (16 * (nt0 + n) + r)) ? 1.f : 0.f;
        st_tr(S10, m, nt0 + n, r, q, acc[n]); }
    RK_ZERO(acc); mm_nt<2>(S2, LD, S0, LD, m, nt0, r, q, acc);
#pragma unroll
    for (int n = 0; n < 2; ++n) { RK_MASK(acc[n], nt0 + n, row < col); st_tr(S11, m, nt0 + n, r, q, acc[n]); }
    RK_ZERO(acc); mm_nt<2>(S1, LD, S3, LD, m, nt0, r, q, acc);
#pragma unroll
    for (int n = 0; n < 2; ++n) { RK_MASK(acc[n], nt0 + n, row <= col); st_tr(S12, m, nt0 + n, r, q, acc[n]); }
    RK_ZERO(acc); mm_nt<2>(S2, LD, S3, LD, m, nt0, r, q, acc);
#pragma unroll
    for (int n = 0; n < 2; ++n) { RK_MASK(acc[n], nt0 + n, row <= col); st_tr(S13, m, nt0 + n, r, q, acc[n]); }
    RK_BAR();
    RK_ZERO(acc); mm_nt<2>(S8, LD, S9, LD, m, nt0, r, q, acc);
    RK_ZERO(acc2); mm_nt<2>(S9, LD, S8, LD, m, nt0, r, q, acc2);
#pragma unroll
    for (int n = 0; n < 2; ++n) { st_tr(S1, m, nt0 + n, r, q, acc[n]); st_tr(S0, m, nt0 + n, r, q, acc2[n]); }
    RK_ZERO(acc); mm_nt<2>(S11, LD, S7, LD, m, nt0, r, q, acc);
#pragma unroll
    for (int n = 0; n < 2; ++n) st_tr(S14, m, nt0 + n, r, q, acc[n]);
    RK_BAR();
#define RK_ROUND(Tsrc, Tdst, Psrc, PTsrc, Pdst, PTdst) do { \
        RK_LDT(Tsrc, m, nt0, acc[0]); RK_LDT(Tsrc, m, nt0 + 1, acc[1]); mm_nt<2>(PTsrc, LD, Tsrc, LD, m, nt0, r, q, acc); \
        _Pragma("unroll") for (int n = 0; n < 2; ++n) st_tr(Tdst, m, nt0 + n, r, q, acc[n]); \
        RK_ZERO(acc); mm_nt<2>(Psrc, LD, PTsrc, LD, m, nt0, r, q, acc); RK_ZERO(acc2); mm_nt<2>(PTsrc, LD, Psrc, LD, m, nt0, r, q, acc2); \
        _Pragma("unroll") for (int n = 0; n < 2; ++n) { st_tr(PTdst, m, nt0 + n, r, q, acc[n]); st_tr(Pdst, m, nt0 + n, r, q, acc2[n]); } \
        RK_BAR(); } while (0)
#ifndef EXP_SKIP_ROUNDS
    RK_ROUND(S10, S2, S0, S1, S8, S9);
    RK_ROUND(S2, S10, S8, S9, S0, S1);
    RK_ROUND(S10, S2, S0, S1, S8, S9);
    RK_ROUND(S2, S10, S8, S9, S0, S1);
#endif
    RK_LDT(S10, m, nt0, acc[0]); RK_LDT(S10, m, nt0 + 1, acc[1]); mm_nt<2>(S1, LD, S10, LD, m, nt0, r, q, acc);
#pragma unroll
    for (int n = 0; n < 2; ++n) st_tr(S2, m, nt0 + n, r, q, acc[n]);
    RK_BAR();
    RK_ZERO(acc); mm_nt<2>(S2, LD, S4, LD, m, nt0, r, q, acc);
    RK_ZERO(acc2); mm_nt<2>(S2, LD, S14, LD, m, nt0, r, q, acc2);
#pragma unroll
    for (int n = 0; n < 2; ++n) { st_tr(S11, m, nt0 + n, r, q, acc[n]); st_tr(S0, m, nt0 + n, r, q, acc2[n]); }
    RK_BAR();
    {
        const int sw = wave & 1, ntw = wave >> 1;
        unsigned char* mn_ = P.mn + (size_t)uidx * 16384; unsigned char* qy_ = P.qy + (size_t)uidx * 16384;
        f32x4 c2[2];
#define RK_MM2(X, Y) do { _Pragma("unroll") for (int s_ = 0; s_ < 2; ++s_) { const bf16x8 b_ = *(const LAS bf16x8*)((Y) + (16 * ntw + r) * LD + 32 * s_ + 8 * q); \
            _Pragma("unroll") for (int mi = 0; mi < 2; ++mi) { const bf16x8 a_ = *(const LAS bf16x8*)((X) + (16 * (2 * sw + mi) + r) * LD + 32 * s_ + 8 * q); c2[mi] = __builtin_amdgcn_mfma_f32_16x16x32_bf16(a_, b_, c2[mi], 0, 0, 0); } } } while (0)
        RK_ZERO(c2); RK_MM2(S11, S5);
#pragma unroll
        for (int mi = 0; mi < 2; ++mi)
#pragma unroll
            for (int ii = 0; ii < 4; ++ii) { const int row = 16 * (2 * sw + mi) + 4 * q + ii, col = 16 * ntw + r; c2[mi][ii] += (row == col) ? DEND[row] : 0.f; }
        { u32x4 w; w.x = pk2(c2[0][0], c2[0][1]); w.y = pk2(c2[0][2], c2[0][3]); w.z = pk2(c2[1][0], c2[1][1]); w.w = pk2(c2[1][2], c2[1][3]); *(u32x4*)(mn_ + ((ntw * 2 + sw) * 64 + lane) * 16) = w; }
#pragma unroll
        for (int mi = 0; mi < 2; ++mi) { const u32x2 rw_ = *(const LAS u32x2*)(S3 + (16 * ntw + r) * LD + 16 * (2 * sw + mi) + 4 * q); c2[mi] = (f32x4){bflo(rw_.x), bfhi(rw_.x), bflo(rw_.y), bfhi(rw_.y)}; }
        RK_MM2(S11, S12);
        { u32x4 w; w.x = pk2(c2[0][0], c2[0][1]); w.y = pk2(c2[0][2], c2[0][3]); w.z = pk2(c2[1][0], c2[1][1]); w.w = pk2(c2[1][2], c2[1][3]); *(u32x4*)(qy_ + ((ntw * 2 + sw) * 64 + lane) * 16) = w; }
        RK_ZERO(c2); RK_MM2(S5, S0); RK_MM2(S6, S7);
#pragma unroll
        for (int mi = 0; mi < 2; ++mi) { u32x2 w; w.x = pk2(c2[mi][0], c2[mi][1]); w.y = pk2(c2[mi][2], c2[mi][3]); *(u32x2*)(mn_ + 8192 + ((ntw * 4 + 2 * sw + mi) * 64 + lane) * 8) = w; }
        RK_ZERO(c2); RK_MM2(S0, S12); RK_MM2(S7, S13);
#pragma unroll
        for (int mi = 0; mi < 2; ++mi) { u32x2 w; w.x = pk2(c2[mi][0], c2[mi][1]); w.y = pk2(c2[mi][2], c2[mi][3]); *(u32x2*)(qy_ + 8192 + (((2 * sw + mi) * 4 + ntw) * 64 + lane) * 8) = w; }
#undef RK_MM2
    }
    RK_BAR();
#undef RK_ZERO
#undef RK_ROUND
#undef RK_LDT
#undef RK_MASK
#undef RK_BAR
}
__device__ __forceinline__ void scan_wg(const unsigned char* mn, unsigned char* sbuf, int ubase, int vq, LAS unsigned char* lds, int tid) {
    const int wave = __builtin_amdgcn_readfirstlane(tid >> 6), lane = tid & 63;
    constexpr int NC = SEQ / 64, NS = 8, SLOT = 10240, AHEAD = 6;
    const unsigned char* src = mn + (size_t)ubase * 16384 + lane * 16;
    const bool loader = (wave >= 1 && wave <= 5);
    const size_t poff = (wave == 5) ? (size_t)(8192 + vq * 2048) : (size_t)(2048 * (wave - 1));
#define SC_ISSUE(c) do { const unsigned char* s_ = src + (size_t)(c) * 16384 + poff; LAS unsigned char* d_ = lds + ((c) % NS) * SLOT + 2048 * (wave - 1); \
        _Pragma("unroll") for (int i_ = 0; i_ < 2; ++i_) __builtin_amdgcn_global_load_lds((const unsigned*)(s_ + i_ * 1024), (LAS unsigned*)(d_ + i_ * 1024), 16, 0, 0); } while (0)
#define SC_BAR() do { asm volatile("s_waitcnt lgkmcnt(0)" ::: "memory"); __builtin_amdgcn_s_barrier(); asm volatile("" ::: "memory"); } while (0)
    bf16x8 sB[2];
#pragma unroll
    for (int s = 0; s < 2; ++s) sB[s] = (bf16x8){0, 0, 0, 0, 0, 0, 0, 0};
    if (loader) {
#pragma unroll
        for (int c = 0; c < AHEAD; ++c) SC_ISSUE(c);
        asm volatile("s_waitcnt vmcnt(10)" ::: "memory"); }
    SC_BAR();
    for (int c = 0; c < NC; ++c) {
        if (loader) {
            if (c + AHEAD < NC) { SC_ISSUE(c + AHEAD); asm volatile("s_waitcnt vmcnt(10)" ::: "memory"); }
            else { asm volatile("s_waitcnt vmcnt(0)" ::: "memory"); }
        } else if (wave == 0) {
            const LAS unsigned char* sl = lds + (c % NS) * SLOT;
            unsigned char* so = sbuf + (size_t)(ubase + c) * 8192 + (vq * 2) * 1024 + lane * 16;
            *(bf16x8*)so = sB[0]; *(bf16x8*)(so + 1024) = sB[1];
            f32x4 aS[4];
#pragma unroll
            for (int mm = 0; mm < 4; ++mm) {
                const u32x2 nI = *(const LAS u32x2*)(sl + 8192 + (mm * 64 + lane) * 8);
                aS[mm] = (f32x4){bflo(nI.x), bfhi(nI.x), bflo(nI.y), bfhi(nI.y)};
#pragma unroll
                for (int s = 0; s < 2; ++s) { const bf16x8 aM = *(const LAS bf16x8*)(sl + ((mm * 2 + s) * 64 + lane) * 16); aS[mm] = __builtin_amdgcn_mfma_f32_16x16x32_bf16(aM, sB[s], aS[mm], 0, 0, 0); }
            }
#pragma unroll
            for (int s = 0; s < 2; ++s) { u32x4 w; w.x = pk2(aS[2 * s][0], aS[2 * s][1]); w.y = pk2(aS[2 * s][2], aS[2 * s][3]); w.z = pk2(aS[2 * s + 1][0], aS[2 * s + 1][1]); w.w = pk2(aS[2 * s + 1][2], aS[2 * s + 1][3]);
                sB[s] = __builtin_bit_cast(bf16x8, w); }
        }
        SC_BAR();
    }
#undef SC_ISSUE
#undef SC_BAR
}
struct YArgs { const unsigned char* qy; const unsigned char* sbuf; const bf16_t* g; const bf16_t* bv; const float* ln_g; const float* ln_b; unsigned char* ya; };
__device__ __forceinline__ void ypass_unit(const YArgs& P, int u, int lane) {
    const int r = lane & 15, q = lane >> 4, b = u >> 10, h = (u >> 7) & 7, c = u & 127, t0 = b * SEQ + c * 64;
    const unsigned char* qy_ = P.qy + (size_t)u * 16384; const unsigned char* s_ = P.sbuf + (size_t)u * 8192;
    bf16x8 Qf[4][2], Sf[4][2]; u32x2 y0[4][4];
#pragma unroll
    for (int i = 0; i < 4; ++i)
#pragma unroll
        for (int s = 0; s < 2; ++s) { Qf[i][s] = *(const bf16x8*)(qy_ + ((i * 2 + s) * 64 + lane) * 16); Sf[i][s] = *(const bf16x8*)(s_ + ((i * 2 + s) * 64 + lane) * 16); }
#pragma unroll
    for (int vq = 0; vq < 4; ++vq)
#pragma unroll
        for (int mm = 0; mm < 4; ++mm) y0[vq][mm] = *(const u32x2*)(qy_ + 8192 + ((vq * 4 + mm) * 64 + lane) * 8);
    f32x4 lg[4], lb[4];
#pragma unroll
    for (int vq = 0; vq < 4; ++vq) { lg[vq] = *(const f32x4*)(P.ln_g + h * 64 + 16 * vq + 4 * q); lb[vq] = *(const f32x4*)(P.ln_b + h * 64 + 16 * vq + 4 * q); }
#pragma unroll
    for (int mm = 0; mm < 4; ++mm) {
        const size_t ro = (size_t)(t0 + 16 * mm + r) * RW + h * 64 + 4 * q;
        u32x2 gw_[4], bw_[4];
#pragma unroll
        for (int vq = 0; vq < 4; ++vq) { gw_[vq] = *(const u32x2*)(P.g + ro + 16 * vq); bw_[vq] = *(const u32x2*)(P.bv + ro + 16 * vq); }
        f32x4 acc[4]; float sum = 0.f;
#pragma unroll
        for (int vq = 0; vq < 4; ++vq) {
            acc[vq] = (f32x4){bflo(y0[vq][mm].x), bfhi(y0[vq][mm].x), bflo(y0[vq][mm].y), bfhi(y0[vq][mm].y)};
#pragma unroll
            for (int s = 0; s < 2; ++s) acc[vq] = __builtin_amdgcn_mfma_f32_16x16x32_bf16(Sf[vq][s], Qf[mm][s], acc[vq], 0, 0, 0);
            sum += (acc[vq][0] + acc[vq][1]) + (acc[vq][2] + acc[vq][3]);
        }
        sum += __shfl_xor(sum, 16); sum += __shfl_xor(sum, 32);
        const float mean = sum * (1.f / 64.f); float var = 0.f;
#pragma unroll
        for (int vq = 0; vq < 4; ++vq) { acc[vq] = acc[vq] - mean; var += (acc[vq][0] * acc[vq][0] + acc[vq][1] * acc[vq][1]) + (acc[vq][2] * acc[vq][2] + acc[vq][3] * acc[vq][3]); }
        var += __shfl_xor(var, 16); var += __shfl_xor(var, 32);
        const float rstd = __builtin_amdgcn_rsqf(var * (1.f / 64.f) + 64e-5f);
#pragma unroll
        for (int vq = 0; vq < 4; ++vq) {
            const f32x4 gg = (f32x4){bflo(gw_[vq].x), bfhi(gw_[vq].x), bflo(gw_[vq].y), bfhi(gw_[vq].y)}, bb = (f32x4){bflo(bw_[vq].x), bfhi(bw_[vq].x), bflo(bw_[vq].y), bfhi(bw_[vq].y)};
            const f32x4 o = (acc[vq] * rstd * lg[vq] + lb[vq] + bb) * gg;
            int t8 = __builtin_amdgcn_cvt_pk_fp8_f32(o[0], o[1], 0, false); t8 = __builtin_amdgcn_cvt_pk_fp8_f32(o[2], o[3], t8, true); *(unsigned*)(P.ya + ro + 16 * vq) = (unsigned)t8; }
    }
}
}
namespace gl {
constexpr int LDV = 136;
struct Args { const bf16_t* puv; const bf16_t* wsm; const float* bs; const float* ln_g; const float* ln_b; unsigned char* yb; };
__device__ __forceinline__ void unit(const Args& P, LAS unsigned char* lds, int b, int blk, int tid) {
    const int wave = __builtin_amdgcn_readfirstlane(tid >> 6), lane = tid & 63, r = lane & 15, q = lane >> 4;
    const int t0 = b * SEQ + blk * 128;
    LAS float* STAT = (LAS float*)(lds + LDS_MISC);
#pragma unroll
    for (int hb = 0; hb < 2; ++hb) {
        u32x4 w[8];
#pragma unroll
        for (int j = 0; j < 8; ++j) w[j] = *(const u32x4*)(P.puv + (size_t)(t0 + 16 * wave + 8 * hb + j) * 1024 + 512 + 8 * lane);
#pragma unroll
        for (int j = 0; j < 8; ++j) {
            float v[8]; v[0] = bflo(w[j].x); v[1] = bfhi(w[j].x); v[2] = bflo(w[j].y); v[3] = bfhi(w[j].y); v[4] = bflo(w[j].z); v[5] = bfhi(w[j].z); v[6] = bflo(w[j].w); v[7] = bfhi(w[j].w);
            float s = 0.f, s2 = 0.f;
#pragma unroll
            for (int e = 0; e < 8; ++e) { s += v[e]; s2 += v[e] * v[e]; }
            s = wave_sum(s); s2 = wave_sum(s2);
            const float mean = s * (1.f / 512.f), var = fmaxf(s2 * (1.f / 512.f) - mean * mean, 0.f);
            if (lane == 0) { const int tk = 16 * wave + 8 * hb + j; STAT[tk * 2] = mean; STAT[tk * 2 + 1] = __builtin_amdgcn_rsqf(var + 1e-5f); }
        }
    }
    u32x4 pv[2], pu[2];
#define GL_LOAD(g) do { _Pragma("unroll") for (int it = 0; it < 2; ++it) { const int task = tid + it * NTHREADS, j = task >> 3, cc = task & 7; \
        const bf16_t* row = P.puv + (size_t)(t0 + j) * 1024 + (g) * 64 + 8 * cc; pu[it] = *(const u32x4*)row; pv[it] = *(const u32x4*)(row + 512); } } while (0)
    GL_LOAD(0);
    __syncthreads();
    for (int g = 0; g < 8; ++g) {
        LAS bf16_t* VT = (LAS bf16_t*)(lds + (g & 1) * 20480);
        LAS bf16_t* US = (LAS bf16_t*)(lds + 40960 + (g & 1) * 18432);
#pragma unroll
        for (int it = 0; it < 2; ++it) {
            const int task = tid + it * NTHREADS, j = task >> 3, cc = task & 7, ch = g * 64 + 8 * cc;
            const u32x4 w = pv[it];
            const float mean = STAT[j * 2], rstd = STAT[j * 2 + 1];
            const f32x4 g0 = *(const f32x4*)(P.ln_g + ch), g1 = *(const f32x4*)(P.ln_g + ch + 4), b0 = *(const f32x4*)(P.ln_b + ch), b1 = *(const f32x4*)(P.ln_b + ch + 4);
            float v[8]; v[0] = bflo(w.x); v[1] = bfhi(w.x); v[2] = bflo(w.y); v[3] = bfhi(w.y); v[4] = bflo(w.z); v[5] = bfhi(w.z); v[6] = bflo(w.w); v[7] = bfhi(w.w);
#pragma unroll
            for (int e = 0; e < 4; ++e) { v[e] = (v[e] - mean) * rstd * g0[e] + b0[e]; v[4 + e] = (v[4 + e] - mean) * rstd * g1[e] + b1[e]; }
#pragma unroll
            for (int e = 0; e < 8; ++e) VT[(8 * cc + e) * LDV + j] = f2bf(v[e]);
            *(LAS u32x4*)(US + j * 72 + 8 * cc) = pu[it];
        }
        if (g + 1 < 8) GL_LOAD(g + 1);
        __syncthreads();
        f32x4 acc[4];
#pragma unroll
        for (int n = 0; n < 4; ++n) acc[n] = (f32x4){0.f, 0.f, 0.f, 0.f};
        const bf16_t* wrow = P.wsm + ((size_t)g * 128 + 16 * wave + r) * 128 + 8 * q;
        const int ks = (wave >> 1) + 1;
        for (int s = 0; s < ks; ++s) {
            const bf16x8 a = *(const bf16x8*)(wrow + 32 * s);
#pragma unroll
            for (int n = 0; n < 4; ++n) { const bf16x8 bb = *(const LAS bf16x8*)(VT + (16 * n + r) * LDV + 32 * s + 8 * q); acc[n] = __builtin_amdgcn_mfma_f32_16x16x32_bf16(a, bb, acc[n], 0, 0, 0); }
        }
#pragma unroll
        for (int ii = 0; ii < 4; ++ii) { const int i = 16 * wave + 4 * q + ii; const float bias = P.bs[g * 128 + i];
#pragma unroll
            for (int n = 0; n < 4; ++n) { const int c = 16 * n + r; const float u = bf2f(US[i * 72 + c]);
                P.yb[(size_t)(t0 + i) * RW + g * 64 + c] = (unsigned char)(__builtin_amdgcn_cvt_pk_fp8_f32(u * (acc[n][ii] + bias), 0.f, 0, false) & 0xff); } }
    }
    __syncthreads();
#undef GL_LOAD
}
}

struct RouteArgs { const float* sc; const float* bias; int* eidx; float* ewt; int* lrank; int* tbase; unsigned* segcnt; };
__device__ __forceinline__ void phase_topk(const RouteArgs& P, LAS unsigned char* lds, int tid, int G) {
    const int wave = __builtin_amdgcn_readfirstlane(tid >> 6), lane = tid & 63, grp = lane >> 3;
    LAS int* hist = (LAS int*)(lds + LDS_MISC);
    const f32x4 bias4 = *(const f32x4*)(P.bias + 4 * lane);
    const float NEG = -__builtin_inff();
    for (int tile = blockIdx.x; tile < T / 256; tile += G) {
        if (tid < NE) hist[tid] = 0;
        __syncthreads();
        f32x4 nx[2];
#pragma unroll
        for (int u = 0; u < 2; ++u) nx[u] = *(const f32x4*)(P.sc + (size_t)(tile * 256 + wave * 32 + u) * NE + 4 * lane);
        for (int j = 0; j < 32; j += 2) {
            const int t0 = tile * 256 + wave * 32 + j;
            float s[2][4], v[2][4], gs[2];
            const f32x4 cur4[2] = {nx[0], nx[1]};
            if (j + 2 < 32) {
#pragma unroll
                for (int u = 0; u < 2; ++u) nx[u] = *(const f32x4*)(P.sc + (size_t)(t0 + 2 + u) * NE + 4 * lane); }
#pragma unroll
            for (int u = 0; u < 2; ++u) { const f32x4 s4 = cur4[u]; s[u][0] = s4.x; s[u][1] = s4.y; s[u][2] = s4.z; s[u][3] = s4.w;
#pragma unroll
                for (int e = 0; e < 4; ++e) v[u][e] = s[u][e] + bias4[e]; }
            float m1[2], m2[2];
#pragma unroll
            for (int u = 0; u < 2; ++u) { const float a = fmaxf(v[u][0], v[u][1]), b = fminf(v[u][0], v[u][1]), c = fmaxf(v[u][2], v[u][3]), d = fminf(v[u][2], v[u][3]); m1[u] = fmaxf(a, c); m2[u] = fmaxf(fminf(a, c), fmaxf(b, d)); }
#pragma unroll
            for (int o = 1; o < 8; o <<= 1) {
#pragma unroll
                for (int u = 0; u < 2; ++u) { const float o1 = __shfl_xor(m1[u], o), o2 = __shfl_xor(m2[u], o); const float n1 = fmaxf(m1[u], o1), n2 = fmaxf(fminf(m1[u], o1), fmaxf(m2[u], o2)); m1[u] = n1; m2[u] = n2; } }
#pragma unroll
            for (int u = 0; u < 2; ++u) gs[u] = m1[u] + m2[u];
            int cnt[2] = {0, 0};
#pragma unroll
            for (int g = 0; g < 8; ++g) {
#pragma unroll
                for (int u = 0; u < 2; ++u) { const float og = __shfl(gs[u], 8 * g); cnt[u] += (og > gs[u] || (og == gs[u] && g < grp)) ? 1 : 0; } }
#pragma unroll
            for (int u = 0; u < 2; ++u) {
#pragma unroll
                for (int e = 0; e < 4; ++e) v[u][e] = (cnt[u] < 4) ? v[u][e] : NEG; }
            int myidx[2] = {0, 0}; float mysc[2] = {0.f, 0.f}, ssum[2] = {0.f, 0.f};
#pragma unroll
            for (int k = 0; k < TOPK; ++k) {
                float bv[2]; int idx[2];
#pragma unroll
                for (int u = 0; u < 2; ++u) { bv[u] = v[u][0]; int bi = 0;
#pragma unroll
                    for (int e = 1; e < 4; ++e) { const bool gt = v[u][e] > bv[u]; bv[u] = gt ? v[u][e] : bv[u]; bi = gt ? e : bi; }
                    idx[u] = 4 * lane + bi; }
#pragma unroll
                for (int o = 1; o < 64; o <<= 1) {
#pragma unroll
                    for (int u = 0; u < 2; ++u) { const float ov = __shfl_xor(bv[u], o); const int oi = __shfl_xor(idx[u], o); const bool tk = (ov > bv[u]) || (ov == bv[u] && oi < idx[u]); bv[u] = tk ? ov : bv[u]; idx[u] = tk ? oi : idx[u]; } }
#pragma unroll
                for (int u = 0; u < 2; ++u) { const int own = idx[u] >> 2, ee = idx[u] & 3;
                    const float mine = (ee == 0) ? s[u][0] : (ee == 1) ? s[u][1] : (ee == 2) ? s[u][2] : s[u][3];
                    const float scv = __shfl(mine, own);
#pragma unroll
                    for (int e = 0; e < 4; ++e) v[u][e] = (lane == own && e == ee) ? NEG : v[u][e];
                    ssum[u] += scv; myidx[u] = (lane == k) ? idx[u] : myidx[u]; mysc[u] = (lane == k) ? scv : mysc[u]; }
            }
            if (lane < TOPK) {
#pragma unroll
                for (int u = 0; u < 2; ++u) { const int t = t0 + u;
                    const int lr = __hip_atomic_fetch_add(hist + myidx[u], 1, __ATOMIC_RELAXED, __HIP_MEMORY_SCOPE_WORKGROUP);
                    P.eidx[(size_t)t * TOPK + lane] = myidx[u]; P.ewt[(size_t)t * TOPK + lane] = mysc[u] / ssum[u] * 2.5f; P.lrank[(size_t)t * TOPK + lane] = lr; }
            }
        }
        __syncthreads();
        if (tid < NE) { const int cnt = hist[tid]; unsigned base = 0u;
            if (cnt) base = __hip_atomic_fetch_add(P.segcnt + tid, (unsigned)cnt, __ATOMIC_RELAXED, __HIP_MEMORY_SCOPE_AGENT);
            P.tbase[tile * NE + tid] = (int)base; }
        __syncthreads();
    }
}
struct ScatArgs { const int* eidx; const float* ewt; const int* lrank; const int* tbase; const unsigned* segcnt; int* rowtok; int* rowdst; float* roww; int* tab; unsigned* ntile; };
__device__ __forceinline__ void phase_scatter(const ScatArgs& P, LAS unsigned char* lds, int tid, int G) {
    LAS int* cntL = (LAS int*)(lds + LDS_MISC); LAS int* segst = cntL + 256; LAS int* tsa = segst + 256;
    if (tid < NE) cntL[tid] = (int)__hip_atomic_load(P.segcnt + tid, __ATOMIC_RELAXED, __HIP_MEMORY_SCOPE_AGENT);
    __syncthreads();
    if (tid == 0) {
        int run = 0, ta = 0;
        for (int s = 0; s < NE; ++s) { const int nts = (cntL[s] + 255) >> 8; segst[s] = run; tsa[s] = ta; run += nts * 256; ta += nts; }
        if (blockIdx.x == 0) P.ntile[0] = (unsigned)ta;
    }
    __syncthreads();
    for (int tile = blockIdx.x; tile < T / 256; tile += G) {
        for (int a = tid; a < 256 * TOPK; a += NTHREADS) {
            const int tok = tile * 256 + (a >> 3), k = a & 7; const size_t ai = (size_t)tok * TOPK + k;
            const int e = P.eidx[ai];
            const int pos = segst[e] + P.tbase[tile * NE + e] + P.lrank[ai];
            P.rowtok[pos] = tok; P.rowdst[pos] = tok * TOPK + k; P.roww[pos] = P.ewt[ai];
        }
    }
    for (int s = blockIdx.x; s < NE; s += G) {
        const int st = segst[s], cnt = cntL[s], nts = (cnt + 255) >> 8;
        for (int p = st + cnt + tid; p < st + nts * 256; p += NTHREADS) { P.rowtok[p] = 0; P.rowdst[p] = -1; P.roww[p] = 0.f; }
        if (tid < nts) { int* ta_ = P.tab + 2 * (tsa[s] + tid); ta_[0] = st + 256 * tid; ta_[1] = s; }
    }
}
constexpr int NPHASE = 20;
struct KArgs { const float* in[34]; float* out; unsigned char* ws; int ph_lo, ph_hi; };
template <int PLO, int PHI>
__global__ void __launch_bounds__(NTHREADS, 2) fwd_kernel(KArgs a) {
    extern __shared__ __attribute__((aligned(16))) unsigned char lds_raw[];
    LAS unsigned char* lds = (LAS unsigned char*)lds_raw;
    const int G = gridDim.x, bid = blockIdx.x, NGW = G * NWAVES;
#define PH_IDS() int tid = threadIdx.x; asm volatile("" : "+v"(tid)); const int lane = tid & 63, wave = __builtin_amdgcn_readfirstlane(tid >> 6), gw = bid * NWAVES + wave; (void)lane; (void)wave; (void)gw
    unsigned char* ws = a.ws;
    unsigned* ctl = (unsigned*)(ws + WS_CTL);
    float* mod = (float*)(ws + WS_MOD);
    constexpr int lo = PLO, hi = PHI;
    if (threadIdx.x == 0) *(LAS u32x4*)(lds + LDS_BARW) = (u32x4){0u, 0u, 0u, 0u};
    __syncthreads();
    XcdBarrier bar; bar.bar = ctl + CW_BAR; bar.x = 0; bar.st = nullptr;
    if (hi - lo > 1) bar = xcd_barrier_post(ctl + CW_BAR, (volatile LAS unsigned*)(lds + LDS_BARW));
#define IN(k) (lo <= (k) && (k) < hi)
#ifdef DBG_TIME
#define STAMP(k) do { if (blockIdx.x == 0 && threadIdx.x == 0) ((unsigned long long*)(ctl + 5200))[k] = __builtin_amdgcn_s_memrealtime(); } while (0)
#else
#define STAMP(k) do {} while (0)
#endif
#define SEAM(k) do { if (IN(k) && IN((k) + 1)) xcd_barrier(bar); } while (0)
#ifndef DBG_REPEAT
#define DBG_REPEAT (-1)
#define DBG_NREP 0
#endif
#define REP(k) for (int rep_ = 0; rep_ < (((k) == DBG_REPEAT) ? 1 + DBG_NREP : 1); ++rep_, (((k) == DBG_REPEAT && rep_ <= DBG_NREP) ? xcd_barrier(bar) : (void)0))

    STAMP(0);
    if (IN(0)) REP(0) { PH_IDS();
        phase_mod(a.in[1], a.in[2], a.in[3], mod, lds, tid, G);
        SmallW sw{a.in[6], a.in[22], a.in[23], a.in[24], a.in[25], a.in[30], a.in[31], a.in[32], a.in[9], a.in[11], a.in[12], a.in[20]};
        phase_small_weights(sw, ws, lds, gw, NGW, wave, lane);
    }
    SEAM(0); STAMP(1);
    if (IN(1)) REP(1) { PH_IDS(); phase_norm_mod<false>(a.in[0], a.in[4], mod, 0, 1024, nullptr, ws + B_H1, gw, NGW, lane); }
    SEAM(1); STAMP(2);
    if (IN(2)) REP(2) {
        gm::DenseSched S; S.init(ws + B_H1, ws + SW_WIN, T, IN_COLS, D, G, bid, 1);
        gm::EpiInProj E{(bf16_t*)(ws + B_PRW), (bf16_t*)(ws + B_PUV), (bf16_t*)(ws + B_PG)};
        gm::gemm_phase<gm::EpiInProj, gm::DenseSched, true, true, 122>(lds, D, S, E);
    }
    SEAM(2); STAMP(3);
    if (IN(3)) REP(3) { PH_IDS();
        gl::Args Q{(const bf16_t*)(ws + B_PUV), (const bf16_t*)(ws + SW_WSM), a.in[21], a.in[18], a.in[19], ws + B_YB};
        for (int u = bid; u < 512; u += G) gl::unit(Q, lds, u >> 6, u & 63, tid);
        phase_xs((const bf16_t*)(ws + B_PRW), a.in[7], (bf16_t*)(ws + B_XS), gw, NGW, lane);
    }
    SEAM(3); STAMP(4);
    if (IN(4)) REP(4) { PH_IDS();
        rk::Args P{(const bf16_t*)(ws + B_PRW), a.in[7], a.in[8], a.in[10], a.in[13], a.in[14], a.in[15], (const bf16_t*)(ws + SW_WUP), (const bf16_t*)(ws + SW_AUP), (const bf16_t*)(ws + SW_GUP), (const bf16_t*)(ws + B_XS),
                   (bf16_t*)(ws + B_G), (bf16_t*)(ws + B_BV), ws + B_MN, ws + B_QY};
        rk::Pre pre; rk::load_mu(P, lds, tid);
        if (bid < 8192) rk::prefetch(P, bid >> 10, (bid >> 7) & 7, bid & 127, tid, pre);
        for (int u = bid; u < 8192; u += G) { const int un = u + G; rk::unit(P, lds, u >> 10, (u >> 7) & 7, u & 127, u, tid, pre, un < 8192, un >> 10, (un >> 7) & 7, un & 127); }
    }
    SEAM(4); STAMP(5);
    if (IN(5)) REP(5) { PH_IDS();
        for (int w = bid; w < 256; w += G) rk::scan_wg(ws + B_MN, ws + B_S, ((w & 7) + 8 * (w >> 5)) * 128, (w >> 3) & 3, lds, tid);
    }
    SEAM(5); STAMP(6);
    if (IN(6)) REP(6) { PH_IDS();
        rk::YArgs Y{ws + B_QY, ws + B_S, (const bf16_t*)(ws + B_G), (const bf16_t*)(ws + B_BV), a.in[16], a.in[17], ws + B_YA};
        for (int u = gw; u < 8192; u += NGW) rk::ypass_unit(Y, u, lane);
    }
    SEAM(6); STAMP(7);
    STAMP(8);
    if (IN(8)) REP(8) {
        gm::DenseSched S; S.init(ws + B_YA, ws + SW_WOA, T, D, RW, G, bid, 1);
        gm::EpiMerge<false> E{(bf16_t*)(ws + B_M1), (const bf16_t*)(ws + B_PG), nullptr};
        gm::gemm_phase<gm::EpiMerge<false>, gm::DenseSched, true, true, 122>(lds, RW, S, E);
    }
    STAMP(9);
    if (IN(9)) {
        gm::DenseSched S; S.init(ws + B_YB, ws + SW_WOB, T, D, RW, G, bid, 1);
        gm::EpiMerge<true> E{(bf16_t*)(ws + B_M1), (const bf16_t*)(ws + B_PG), ws + B_M8};
        gm::gemm_phase<gm::EpiMerge<true>, gm::DenseSched, true, true, 122>(lds, RW, S, E);
    }
    SEAM(9); STAMP(10);
    if (IN(10)) REP(10) {
        gm::DenseSched S; S.init(ws + B_M8, ws + SW_WO, T, D, D, G, bid, 1);
        gm::EpiResid E{(bf16_t*)(ws + B_X1), a.in[0], mod + 2048};
        gm::gemm_phase<gm::EpiResid, gm::DenseSched, true, true, 122>(lds, D, S, E);
    }
    SEAM(10); STAMP(11);
    if (IN(11)) REP(11) { PH_IDS();
        phase_norm_mod<true>(ws + B_X1, a.in[5], mod, 3072, 4096, (bf16_t*)(ws + B_H2), ws + B_H2F8, gw, NGW, lane);
        phase_expert_weights(a.in[27], a.in[28], a.in[29], ws, lds, gw, NGW, wave, lane);
    }
    SEAM(11); STAMP(12);
    if (IN(12)) REP(12) {
        { gm::DenseSched S; S.init(ws + B_H2, ws + SW_WR, T, NE, D, G, bid); gm::EpiRouter E{(float*)(ws + B_SC)}; gm::gemm_phase<gm::EpiRouter, gm::DenseSched, true>(lds, D, S, E); }
        { gm::DenseSched S; S.init(ws + B_H2F8, ws + SW_WS13, T, 512, D, G, bid, 1); gm::EpiGateUp<true> E{ws + B_SH}; gm::gemm_phase<gm::EpiGateUp<true>, gm::DenseSched, true, true, 122>(lds, D, S, E); }
    }
    SEAM(12); STAMP(13);
    if (IN(13)) { PH_IDS();
        RouteArgs R{(const float*)(ws + B_SC), a.in[26], (int*)(ws + RT_EIDX), (float*)(ws + RT_EWT), (int*)(ws + RT_LRANK), (int*)(ws + RT_TBASE), ctl + CW_SEGCNT};
        phase_topk(R, lds, tid, G);
        gm::DenseSched S; S.init(ws + B_SH, ws + SW_WS2, T, D, EFF, G, bid, 1);
        gm::EpiSharedDown E{ws + B_SHO};
        gm::gemm_phase<gm::EpiSharedDown, gm::DenseSched, true, true, 122>(lds, EFF, S, E);
    }
    SEAM(13); STAMP(14);
    if (IN(14)) REP(14) { PH_IDS();
        ScatArgs P{(const int*)(ws + RT_EIDX), (const float*)(ws + RT_EWT), (const int*)(ws + RT_LRANK), (const int*)(ws + RT_TBASE), ctl + CW_SEGCNT,
                   (int*)(ws + RT_ROWTOK), (int*)(ws + RT_ROWDST), (float*)(ws + RT_ROWW), (int*)(ws + RT_TAB), ctl + CW_NT};
        phase_scatter(P, lds, tid, G);
    }
    SEAM(14); STAMP(15);
    if (IN(15)) REP(15) {
        gm::GroupSched<true> S; S.A = (const char*)(ws + B_H2F8); S.B = (const char*)(ws + B_W13); S.tab = (const int*)(ws + RT_TAB); S.rowtok = (const int*)(ws + RT_ROWTOK);
        S.ntiles = (int)__hip_atomic_load(ctl + CW_NT, __ATOMIC_RELAXED, __HIP_MEMORY_SCOPE_AGENT); S.npn = 2; S.G = G; S.c = bid; S.K = D; S.ebytes = (size_t)512 * D; S.tstep = (size_t)256 * D;
        gm::EpiGateUp<true> E{ws + B_HID};
        gm::gemm_phase<gm::EpiGateUp<true>, gm::GroupSched<true>, true, true, 122>(lds, D, S, E);
    }
    SEAM(15); STAMP(16);
    if (IN(16)) REP(16) {
        gm::GroupSched<false> S; S.A = (const char*)(ws + B_HID); S.B = (const char*)(ws + B_W2); S.tab = (const int*)(ws + RT_TAB); S.rowtok = nullptr;
        S.ntiles = (int)__hip_atomic_load(ctl + CW_NT, __ATOMIC_RELAXED, __HIP_MEMORY_SCOPE_AGENT); S.npn = 4; S.G = G; S.c = bid; S.K = EFF; S.ebytes = (size_t)D * EFF; S.tstep = (size_t)256 * EFF;
        gm::EpiExpertDown E{ws + B_SLOT, (const int*)(ws + RT_ROWDST), (const float*)(ws + RT_ROWW)};
        gm::gemm_phase<gm::EpiExpertDown, gm::GroupSched<false>, true, true, 122>(lds, EFF, S, E);
    }
    SEAM(16); STAMP(17);
    if (IN(17)) { PH_IDS(); phase_combine(a.out, (const bf16_t*)(ws + B_X1), ws + B_SLOT, ws + B_SHO, mod, a.in[33], gw, NGW, lane); }
    STAMP(18); STAMP(19);
    __syncthreads(); STAMP(20);
#undef IN
#undef SEAM
}

#if defined(DBG_CHECK) || defined(DBG_TIME)
#ifdef DBG_TIME
#ifndef TSC
#define TSC 0.25f
#endif
__global__ void dbg_time_out(float* out, const unsigned long long* st) {
    if (threadIdx.x == 0 && blockIdx.x == 0) { out[0] = (float)(st[TA1] - st[TA0]) * 0.01f * TSC; out[1] = (float)(st[TB1] - st[TB0]) * 0.01f * TSC; }
}
static void dbg_run(void* d_out, void* d_ws, hipStream_t stream) {
    dbg_time_out<<<1, 64, 0, stream>>>((float*)d_out, (const unsigned long long*)((unsigned*)((unsigned char*)d_ws + WS_CTL) + 5200));
}
#endif
#endif
#ifndef MK_SINGLE
#define MK_SINGLE 0
#endif
template <int PLO, int PHI> static bool prep_kernel() {
    int per_cu = 0;
    if (hipFuncSetAttribute((const void*)fwd_kernel<PLO, PHI>, hipFuncAttributeMaxDynamicSharedMemorySize, LDS_BYTES) != hipSuccess) { fprintf(stderr, "kernel_launch: hipFuncSetAttribute failed\n"); return false; }
    if (hipOccupancyMaxActiveBlocksPerMultiprocessor(&per_cu, (const void*)fwd_kernel<PLO, PHI>, NTHREADS, LDS_BYTES) != hipSuccess || per_cu < 1) { fprintf(stderr, "kernel_launch: occupancy query says %d\n", per_cu); (void)hipGetLastError(); return false; }
    return true;
}
template <int P> struct PhaseLaunch {
    static bool prep() { return prep_kernel<P, P + 1>() && PhaseLaunch<P + 1>::prep(); }
    static void go(int grid, hipStream_t stream, const KArgs& a) { hipLaunchKernelGGL((fwd_kernel<P, P + 1>), dim3(grid), dim3(NTHREADS), LDS_BYTES, stream, a); PhaseLaunch<P + 1>::go(grid, stream, a); }
};
#ifndef DBG_LAST
#define DBG_LAST NPHASE
#endif
template <> struct PhaseLaunch<DBG_LAST> { static bool prep() { return true; } static void go(int, hipStream_t, const KArgs&) {} };
extern "C" void kernel_launch(void* const* d_in, const int* in_sizes, int n_in, void* d_out, int out_size, void* d_ws, size_t ws_size, hipStream_t stream) {
    static int grid = 0;
    if (grid == 0) {
        if (n_in != 34 || out_size != T * D || ws_size < WS_END) { fprintf(stderr, "kernel_launch: unexpected problem shape (n_in %d, out %d, ws %zu < %zu)\n", n_in, out_size, ws_size, (size_t)WS_END); grid = -1; return; }
        int dev = 0, cus = 0;
        if (hipGetDevice(&dev) != hipSuccess || hipDeviceGetAttribute(&cus, hipDeviceAttributeMultiprocessorCount, dev) != hipSuccess) { grid = -1; return; }
#if MK_SINGLE
        if (!prep_kernel<0, NPHASE>()) { grid = -1; return; }
#else
        if (!PhaseLaunch<0>::prep()) { grid = -1; return; }
#endif
        grid = cus;
    }
    if (grid < 0) return;
    (void)hipMemsetAsync((char*)d_ws + WS_CTL, 0, CTL_ZERO_BYTES, stream);
    KArgs a{};
    for (int i = 0; i < 34; ++i) a.in[i] = (const float*)d_in[i];
    a.out = (float*)d_out; a.ws = (unsigned char*)d_ws; a.ph_lo = 0; a.ph_hi = NPHASE;
#if MK_SINGLE
    hipLaunchKernelGGL((fwd_kernel<0, NPHASE>), dim3(grid), dim3(NTHREADS), LDS_BYTES, stream, a);
#else
    PhaseLaunch<0>::go(grid, stream, a);
#endif
#if defined(DBG_CHECK) || defined(DBG_TIME)
    dbg_run(d_out, d_ws, stream);
#endif
}
```

```cpp
#define MK_SINGLE 1
#include <hip/hip_runtime.h>
#include <cstdio>
#include <cstdint>

#define LAS __attribute__((address_space(3)))
#define GAS __attribute__((address_space(1)))
typedef unsigned short bf16_t;
typedef short bf16x8 __attribute__((ext_vector_type(8)));
typedef float f32x4 __attribute__((ext_vector_type(4)));
typedef float f32x2 __attribute__((ext_vector_type(2)));
typedef unsigned u32x4 __attribute__((ext_vector_type(4)));
typedef unsigned u32x2 __attribute__((ext_vector_type(2)));

constexpr int D = 1024, NB = 8, SEQ = 8192, T = NB * SEQ;
constexpr int RW = 512, HD = 64, NH = 8;
constexpr int RWKV_COLS = 1792, IN_COLS = 4864;
constexpr int NE = 256, TOPK = 8, EFF = 256;
constexpr int NWAVES = 8, NTHREADS = 512;
constexpr int MAXROWS = T * TOPK + 256 * 256;

constexpr size_t MiB = 1u << 20;
constexpr size_t WS_CTL = 0;
constexpr int CW_BAR = 0, CW_SEGCNT = 4096, CW_NT = 4608;
constexpr size_t CTL_ZERO_BYTES = 20480;
constexpr size_t WS_MOD = 65536;
constexpr size_t WS_SW = 1 * MiB;
constexpr size_t SW_WIN = WS_SW;
constexpr size_t SW_WOA = SW_WIN + (size_t)IN_COLS * D * 2;
constexpr size_t SW_WOB = SW_WOA + (size_t)D * RW * 2;
constexpr size_t SW_WO = SW_WOB + (size_t)D * RW * 2;
constexpr size_t SW_WR = SW_WO + (size_t)D * D * 2;
constexpr size_t SW_WS13 = SW_WR + (size_t)NE * D * 2;
constexpr size_t SW_WS2 = SW_WS13 + (size_t)512 * D * 2;
constexpr size_t SW_WUP = SW_WS2 + (size_t)D * EFF * 2;
constexpr size_t SW_AUP = SW_WUP + (size_t)RW * 64 * 2;
constexpr size_t SW_GUP = SW_AUP + (size_t)RW * 64 * 2;
constexpr size_t SW_WSM = SW_GUP + (size_t)RW * 128 * 2;
constexpr size_t SW_END = SW_WSM + (size_t)8 * 128 * 128 * 2;
static_assert(SW_END <= 20 * MiB, "small weights");
constexpr size_t WS_RT = 20 * MiB;
constexpr size_t RT_EIDX = WS_RT;
constexpr size_t RT_EWT = RT_EIDX + (size_t)T * 8 * 4;
constexpr size_t RT_LRANK = RT_EWT + (size_t)T * 8 * 4;
constexpr size_t RT_TBASE = RT_LRANK + (size_t)T * 8 * 4;
constexpr size_t RT_ROWTOK = RT_TBASE + (size_t)256 * 256 * 4;
constexpr size_t RT_ROWDST = RT_ROWTOK + (size_t)MAXROWS * 4;
constexpr size_t RT_ROWW = RT_ROWDST + (size_t)MAXROWS * 4;
constexpr size_t RT_TAB = RT_ROWW + (size_t)MAXROWS * 4;
constexpr size_t RT_SBON = RT_TAB + (size_t)3 * 4096 * 8;
constexpr size_t RT_END = RT_SBON + (size_t)T * 8 * 4;
static_assert(RT_END <= 40 * MiB, "routing arrays");
constexpr size_t WS_BIG = 40 * MiB;
constexpr size_t B_H1 = WS_BIG + 0 * MiB;
constexpr size_t B_YB = WS_BIG + 0 * MiB;
constexpr size_t B_YA = WS_BIG + 64 * MiB;
constexpr size_t B_XS = WS_BIG + 64 * MiB;
constexpr size_t B_PRW = WS_BIG + 128 * MiB;
constexpr size_t B_M8 = WS_BIG + 128 * MiB;
constexpr size_t B_S = WS_BIG + 128 * MiB;
constexpr size_t B_PUV = WS_BIG + 352 * MiB;
constexpr size_t B_QY = WS_BIG + 352 * MiB;
constexpr size_t B_M1 = WS_BIG + 352 * MiB;
constexpr size_t B_PG = WS_BIG + 480 * MiB;
constexpr size_t B_MN = WS_BIG + 736 * MiB;
constexpr size_t B_G = WS_BIG + 864 * MiB;
constexpr size_t B_BV = WS_BIG + 928 * MiB;
constexpr size_t B_H2 = WS_BIG + 0 * MiB;
constexpr size_t B_W13 = WS_BIG + 128 * MiB;
constexpr size_t B_H2F8 = WS_BIG + 256 * MiB;
constexpr size_t B_SH = WS_BIG + 384 * MiB;
constexpr size_t B_SC = WS_BIG + 416 * MiB;
constexpr size_t B_SLOT = WS_BIG + 0 * MiB;
constexpr size_t B_SHO = WS_BIG + 928 * MiB;
constexpr size_t B_W2 = WS_BIG + 512 * MiB;
constexpr size_t B_X1 = WS_BIG + 576 * MiB;
constexpr size_t B_HID = WS_BIG + 704 * MiB;
constexpr size_t WS_END = WS_BIG + 992 * MiB;
static_assert((size_t)MAXROWS * EFF * 2 <= 320 * MiB, "hid");

constexpr int LDS_STAGE = 0;
constexpr int LDS_MISC = 153600;
constexpr int LDS_BARW = 161792;
constexpr int LDS_BYTES = 163840;

typedef __bf16 bf16x2_t __attribute__((ext_vector_type(2)));
__device__ __forceinline__ unsigned pk2(float lo, float hi) { f32x2 f = {lo, hi}; return __builtin_bit_cast(unsigned, __builtin_convertvector(f, bf16x2_t)); }
__device__ __forceinline__ u32x2 pk8(const f32x4& a, const f32x4& b) { u32x2 w; int t = __builtin_amdgcn_cvt_pk_fp8_f32(a[0], a[1], 0, false); t = __builtin_amdgcn_cvt_pk_fp8_f32(a[2], a[3], t, true); w.x = (unsigned)t;
    t = __builtin_amdgcn_cvt_pk_fp8_f32(b[0], b[1], 0, false); t = __builtin_amdgcn_cvt_pk_fp8_f32(b[2], b[3], t, true); w.y = (unsigned)t; return w; }
__device__ __forceinline__ f32x4 up8(unsigned w) { const f32x2 lo = __builtin_amdgcn_cvt_pk_f32_fp8((int)w, false), hi = __builtin_amdgcn_cvt_pk_f32_fp8((int)w, true); return (f32x4){lo.x, lo.y, hi.x, hi.y}; }
__device__ __forceinline__ float bflo(unsigned w) { return __uint_as_float(w << 16); }
__device__ __forceinline__ float bfhi(unsigned w) { return __uint_as_float(w & 0xffff0000u); }
__device__ __forceinline__ float bf2f(bf16_t h) { return __uint_as_float(((unsigned)h) << 16); }
__device__ __forceinline__ bf16_t f2bf(float f) { return (bf16_t)(pk2(f, 0.f) & 0xffffu); }
__device__ __forceinline__ float fexp(float x) { return __builtin_amdgcn_exp2f(x * 1.44269504089f); }
__device__ __forceinline__ float flog(float x) { return __builtin_amdgcn_logf(x) * 0.69314718056f; }
__device__ __forceinline__ float frcp(float x) { return __builtin_amdgcn_rcpf(x); }
__device__ __forceinline__ float sigmoidf_(float x) { return frcp(1.0f + fexp(-x)); }
__device__ __forceinline__ float siluf_(float x) { return x * sigmoidf_(x); }
__device__ __forceinline__ float tanhf_(float x) { return 1.0f - 2.0f * frcp(1.0f + fexp(2.0f * x)); }
__device__ __forceinline__ float gelu_tanh(float x) { const float u = 0.7978845608f * (x + 0.044715f * x * x * x); return x * frcp(1.0f + fexp(-2.0f * u)); }
__device__ __forceinline__ float wave_sum(float v) {
#pragma unroll
    for (int o = 1; o < 64; o <<= 1) v += __shfl_xor(v, o);
    return v;
}
#define LDS_WAIT() asm volatile("s_waitcnt lgkmcnt(0)" ::: "memory")
#define VM_WAIT() asm volatile("s_waitcnt vmcnt(0)" ::: "memory")

#define XB_TMO      128
#define XB_XCNT(j)  (256  + 64 * (j))
#define XB_XSUB(j)  (1280 + 64 * (j))
#define XB_XGEN(j)  (2304 + 64 * (j))
#define XB_TOP      3328
#define XB_TOPGEN   3392
#define XCD_BAR_WORDS 3456
#define XB_SPIN_CAP (1u << 18)
__device__ __forceinline__ unsigned xb_ld(unsigned* p)              { return __hip_atomic_load(p, __ATOMIC_RELAXED, __HIP_MEMORY_SCOPE_AGENT); }
__device__ __forceinline__ unsigned xb_add(unsigned* p, unsigned v) { return __hip_atomic_fetch_add(p, v, __ATOMIC_RELAXED, __HIP_MEMORY_SCOPE_AGENT); }
__device__ __forceinline__ unsigned xb_xcc_id() { return (unsigned)__builtin_amdgcn_s_getreg((3 << 11) | 20) & 0xFu; }
#define XB_SPIN(cond, bar) do { unsigned _sp = 0; while (cond) { __builtin_amdgcn_s_sleep(1); \
    if ((++_sp & 255u) == 0u) { if (xb_ld(&(bar)[XB_TMO])) break; if (_sp > XB_SPIN_CAP) { atomicAdd(&(bar)[XB_TMO], 1u); break; } } } } while (0)
struct XcdBarrier { unsigned* bar; unsigned x; volatile LAS unsigned* st; };
__device__ __forceinline__ XcdBarrier xcd_barrier_post(unsigned* bar, volatile LAS unsigned* st) {
    XcdBarrier b; b.bar = bar; b.x = xb_xcc_id(); b.st = st;
    if (threadIdx.x == 0) (void)xb_add(&bar[XB_XCNT(b.x)], 1u);
    return b;
}
__device__ __forceinline__ void xcd_barrier_complete(unsigned* bar, unsigned x, unsigned& nloc, unsigned& nx) {
    const unsigned G = gridDim.x * gridDim.y * gridDim.z;
    unsigned sum, cnt, mine, sp = 0u;
    for (;;) {
        sum = 0u; cnt = 0u; mine = 0u;
#pragma unroll
        for (unsigned j = 0; j < 16; ++j) { const unsigned c = xb_ld(&bar[XB_XCNT(j)]); sum += c; cnt += (c > 0u) ? 1u : 0u; mine = (j == x) ? c : mine; }
        if (sum == G) break;
        __builtin_amdgcn_s_sleep(1);
        if ((++sp & 255u) == 0u) { if (xb_ld(&bar[XB_TMO])) break; if (sp > XB_SPIN_CAP) { atomicAdd(&bar[XB_TMO], 1u); break; } }
    }
    nloc = mine > 0u ? mine : 1u; nx = cnt > 0u ? cnt : 1u;
}
__device__ __forceinline__ void xcd_barrier(const XcdBarrier& b) {
    asm volatile("s_waitcnt vmcnt(0)" ::: "memory");
    __syncthreads();
    if (threadIdx.x == 0) {
        unsigned* bar = b.bar;
        __builtin_amdgcn_s_waitcnt(0);
        unsigned nloc = b.st[0], nx = b.st[1];
        if (nloc == 0u) { xcd_barrier_complete(bar, b.x, nloc, nx); b.st[0] = nloc; b.st[1] = nx; }
        const unsigned old = xb_add(&bar[XB_XSUB(b.x)], 1u);
        const unsigned gen = old / nloc;
        if (old + 1u == (gen + 1u) * nloc) {
            __builtin_amdgcn_fence(__ATOMIC_RELEASE, "agent");
            asm volatile("s_waitcnt vmcnt(0)" ::: "memory");
            const unsigned og = xb_add(&bar[XB_TOP], 1u);
            const unsigned tg = og / nx;
            if (og + 1u == (tg + 1u) * nx) xb_add(&bar[XB_TOPGEN], 1u);
            else XB_SPIN(xb_ld(&bar[XB_TOPGEN]) == tg, bar);
            __builtin_amdgcn_fence(__ATOMIC_ACQUIRE, "agent");
            xb_add(&bar[XB_XGEN(b.x)], 1u);
            asm volatile("s_waitcnt vmcnt(0)" ::: "memory");
        } else {
            XB_SPIN(xb_ld(&bar[XB_XGEN(b.x)]) == gen, bar);
            __builtin_amdgcn_fence(__ATOMIC_ACQUIRE, "agent");
            asm volatile("s_waitcnt vmcnt(0)" ::: "memory");
        }
    }
    __syncthreads();
}
namespace gm {
typedef int i32x4 __attribute__((ext_vector_type(4)));
typedef int i32x8 __attribute__((ext_vector_type(8)));
constexpr int BM = 256, BK = 64, HALF = 128, HTB = HALF * BK * 2, STAGE_BYTES = 8 * HTB, NXCD = 8, WGM = 8;
__host__ __device__ __forceinline__ int lds_byte(int r, int c) { const int st = (r >> 4) * 2 + (c >> 5), rr = r & 15, cc = c & 31, ob = rr * 64 + cc * 2; return st * 1024 + (ob ^ (((ob >> 9) & 1) << 5)); }
__host__ __device__ __forceinline__ void stage_rc(int b, int& R, int& C) { const int st = b / 1024, sb = b % 1024, swz = sb ^ (((sb >> 9) & 1) << 5); R = (st >> 1) * 16 + swz / 64; C = (st & 1) * 32 + (swz % 64) / 2; }
__host__ __device__ __forceinline__ int perm32(int rho) { const int n = rho >> 4, i = rho & 15; return 8 * (i >> 2) + 4 * n + (i & 3); }

struct Unit { int pm, pn, e, row0, par; };

struct DenseSched {
    static constexpr bool GATHER = false;
    const char* A; const char* B; int nM, nN, nwg, G, c; size_t tstep; const int* rowtok; int K;
    __device__ __forceinline__ void init(const void* A_, const void* B_, int M, int N, int K, int G_, int c_, int es = 2) { A = (const char*)A_; B = (const char*)B_; nM = M / BM; nN = N / BM; nwg = nM * nN; G = G_; c = c_; tstep = (size_t)BM * K * es; rowtok = nullptr; this->K = 0; }
    __device__ __forceinline__ bool next(int i, Unit& u) const {
        const long L = (long)i * G + c; if (L >= nwg) return false;
        int wgid = (int)L; { const int q = nwg / NXCD, r = nwg % NXCD, xcd = wgid % NXCD, off = wgid / NXCD; wgid = (xcd < r ? xcd * (q + 1) : r * (q + 1) + (xcd - r) * q) + off; }
        const int nig = WGM * nN, gid = wgid / nig, fm = gid * WGM, gsz = (nM - fm) < WGM ? (nM - fm) : WGM;
        u.pm = fm + ((wgid % nig) % gsz); u.pn = (wgid % nig) / gsz; u.e = 0; u.row0 = u.pm * BM; return true;
    }
    __device__ __forceinline__ const char* a_ptr(const Unit& u) const { return A + (size_t)u.pm * tstep; }
    __device__ __forceinline__ const char* b_ptr(const Unit& u) const { return B + (size_t)u.pn * tstep; }
    __device__ __forceinline__ unsigned row_off(const Unit&, int) const { return 0u; }
};
template <bool GATHER_>
struct GroupSched {
    static constexpr bool GATHER = GATHER_;
    const char* A; const char* B; const int* tab; const int* rowtok; int ntiles, npn, G, c, K; size_t ebytes, tstep;
    __device__ __forceinline__ bool next(int i, Unit& u) const {
        int tile;
        if (G == 256) {
            const int xcd = c & 7, slot = c >> 3, tpx = 32 / npn; tile = i * 8 * tpx + xcd * tpx + slot / npn; u.pn = slot % npn; if (tile >= ntiles) return false;
        } else { const long L = (long)i * G + c; if (L >= (long)ntiles * npn) return false; tile = (int)(L / npn); u.pn = (int)(L % npn); }
        u.pm = tile;
        u.row0 = __builtin_amdgcn_readfirstlane(tab[2 * tile]); u.e = __builtin_amdgcn_readfirstlane(tab[2 * tile + 1]); return true;
    }
    __device__ __forceinline__ const char* a_ptr(const Unit& u) const { return GATHER ? A : A + (size_t)u.row0 * K; }
    __device__ __forceinline__ const char* b_ptr(const Unit& u) const { return B + (size_t)u.e * ebytes + (size_t)u.pn * tstep; }
    __device__ __forceinline__ unsigned row_off(const Unit& u, int r) const { return (unsigned)rowtok[u.row0 + r] * (unsigned)K; }
};

template <class Epi, class Sched, bool ALIGN_EPI, bool F8 = false, int SCALE_W = 127>
__device__ __forceinline__ void gemm_phase(LAS unsigned char* lds, const int Kel, const Sched& S, const Epi& E) {
    const int K = F8 ? Kel / 2 : Kel;
    int tid_ = threadIdx.x; asm volatile("" : "+v"(tid_));
    const int tid = tid_, wid = __builtin_amdgcn_readfirstlane(tid >> 6), lane = tid & 63, wr = wid >> 2, wc = wid & 3, fr = lane & 15, fq = lane >> 4;
    const int nt = K / BK;
    int sR[2], sC[2]; unsigned voffB[2];
#pragma unroll
    for (int i = 0; i < 2; ++i) { int R, C; stage_rc(tid * 16 + i * 8192, R, C); sR[i] = R; sC[i] = C; const int Rb = Epi::PERM ? ((R & ~31) + perm32(R & 31)) : R; voffB[i] = (unsigned)(Rb * K + C) * 2u; }
    const size_t kstep = (size_t)(BK * 2);
    const size_t hstep = (size_t)HALF * K * 2;
    const unsigned ldsw = (unsigned)wid * 1024u;
    const int aoff = lds_byte(wr * 64 + fr, fq * 8), boff = lds_byte(wc * 32 + fr, fq * 8);
#define PG8_SA(b, h) (((b) * 2 + (h)) * HTB)
#define PG8_SB(b, h) ((4 + (b) * 2 + (h)) * HTB)
#define PG8_STGB(bufoff, gbase) do { _Pragma("unroll") for (int _i = 0; _i < 2; ++_i) \
        __builtin_amdgcn_global_load_lds((const unsigned*)((const char*)(gbase) + voffB[_i]), (LAS unsigned*)(lds + (bufoff) + ldsw + _i * 8192), 16, 0, 0); } while (0)
#define PG8_STGA(bufoff, gbase, VO, h) do { _Pragma("unroll") for (int _i = 0; _i < 2; ++_i) \
        __builtin_amdgcn_global_load_lds((const unsigned*)((const char*)(gbase) + VO[h][_i]), (LAS unsigned*)(lds + (bufoff) + ldsw + _i * 8192), 16, 0, 0); } while (0)
#define PG8_VOA(u, VO) do { _Pragma("unroll") for (int _h = 0; _h < 2; ++_h) _Pragma("unroll") for (int _i = 0; _i < 2; ++_i) \
        VO[_h][_i] = Sched::GATHER ? (S.row_off(u, _h * HALF + sR[_i]) + (unsigned)sC[_i] * 2u) : ((unsigned)((_h * HALF + sR[_i]) * K + sC[_i]) * 2u); } while (0)
#define PG8_LDA(dst, b, h) do { _Pragma("unroll") for (int m = 0; m < 4; ++m) { if constexpr (F8) { dst##8[m].lo = *(const LAS i32x4*)(lds + PG8_SA(b, h) + aoff + m * 2048); dst##8[m].hi = *(const LAS i32x4*)(lds + PG8_SA(b, h) + aoff + m * 2048 + 1024); } else { _Pragma("unroll") for (int k = 0; k < 2; ++k) dst[m][k] = *(const LAS bf16x8*)(lds + PG8_SA(b, h) + aoff + m * 2048 + k * 1024); } } } while (0)
#define PG8_LDB(dst, b, h) do { _Pragma("unroll") for (int n = 0; n < 2; ++n) { if constexpr (F8) { dst##8[n].lo = *(const LAS i32x4*)(lds + PG8_SB(b, h) + boff + n * 2048); dst##8[n].hi = *(const LAS i32x4*)(lds + PG8_SB(b, h) + boff + n * 2048 + 1024); } else { _Pragma("unroll") for (int k = 0; k < 2; ++k) dst[n][k] = *(const LAS bf16x8*)(lds + PG8_SB(b, h) + boff + n * 2048 + k * 1024); } } } while (0)
#define PG8_MMA(ai, bj, At, Bt) do { __builtin_amdgcn_s_setprio(1); _Pragma("unroll") for (int m = 0; m < 4; ++m) _Pragma("unroll") for (int n = 0; n < 2; ++n) { \
        if constexpr (F8) { asm volatile("v_mfma_scale_f32_16x16x128_f8f6f4 %0, %1, %2, %0, %3, %4 op_sel_hi:[0,0,0]" : "+v"(acc[ai][bj][m][n]) : "v"(Bt##8[n]), "v"(At##8[m]), "v"(scw_), "v"(sca_)); } \
        else { _Pragma("unroll") for (int k = 0; k < 2; ++k) acc[ai][bj][m][n] = __builtin_amdgcn_mfma_f32_16x16x32_bf16(Bt[n][k], At[m][k], acc[ai][bj][m][n], 0, 0, 0); } } \
        __builtin_amdgcn_s_setprio(0); } while (0)
#define PG8_WAIT_V(n) asm volatile("s_waitcnt vmcnt(" #n ")" ::: "memory")
#define PG8_WAIT_L(n) asm volatile("s_waitcnt lgkmcnt(" #n ")" ::: "memory")
#define PG8_BAR __builtin_amdgcn_s_barrier()
#define PG8_SCHED __builtin_amdgcn_sched_barrier(0)
    Unit cur, nxt; int ui = 0;
    if (!S.next(0, cur)) return;
    f32x4 acc[2][2][4][2];
#pragma unroll
    for (int a = 0; a < 2; ++a)
#pragma unroll
        for (int b = 0; b < 2; ++b)
#pragma unroll
            for (int m = 0; m < 4; ++m)
#pragma unroll
                for (int n = 0; n < 2; ++n) acc[a][b][m][n] = (f32x4){0.f, 0.f, 0.f, 0.f};
    const int scw_ = SCALE_W, sca_ = 127;
    bf16x8 At[4][2], B0[2][2], B1[2][2]; i32x8 At8[4], B08[2], B18[2];
    unsigned voA[2][2], nvoA[2][2];
    PG8_VOA(cur, voA);
    if (Sched::GATHER) { asm volatile("s_waitcnt vmcnt(0)" ::: "memory"); }
    const char* cA = S.a_ptr(cur); const char* cB = S.b_ptr(cur);
    cur.par = 0; E.stage_rows(cur, lds, wid);
    PG8_STGB(PG8_SB(0, 0), cB); PG8_STGB(PG8_SB(0, 1), cB + hstep); PG8_STGA(PG8_SA(0, 0), cA, voA, 0); PG8_STGA(PG8_SA(0, 1), cA, voA, 1);
    if (wr == 1) PG8_BAR;
    PG8_WAIT_V(2); PG8_BAR;
    PG8_STGB(PG8_SB(1, 0), cB + kstep); PG8_STGA(PG8_SA(1, 0), cA + kstep, voA, 0); PG8_STGB(PG8_SB(1, 1), cB + hstep + kstep);
    PG8_WAIT_V(6); PG8_BAR;
    for (;;) {
        const bool has_next = S.next(ui + 1, nxt); nxt.par = (ui + 1) & 3;
        const char* nA = has_next ? S.a_ptr(nxt) : cA; const char* nB = has_next ? S.b_ptr(nxt) : cB;
        if (Sched::GATHER) {
            if (has_next) { if (wid < 4) __builtin_amdgcn_global_load_lds((const unsigned*)(S.rowtok + nxt.row0 + wid * 64 + lane), (LAS unsigned*)(lds + LDS_MISC + nxt.par * 1024 + wid * 256), 4, 0, 0); }
#pragma unroll
            for (int h = 0; h < 2; ++h)
#pragma unroll
                for (int i = 0; i < 2; ++i) nvoA[h][i] = voA[h][i]; }
#pragma unroll 1
        for (int t = 0; t < nt; t += 2) {
            const bool last = (t == nt - 2);
            const char* a1 = cA + (size_t)(t + 1) * kstep;
            const char* a2 = last ? nA : cA + (size_t)(t + 2) * kstep; const char* b2 = last ? nB : cB + (size_t)(t + 2) * kstep;
            const char* a3 = a2 + kstep; const char* b3 = b2 + kstep;
            unsigned vo2[2][2];
#pragma unroll
            for (int h = 0; h < 2; ++h)
#pragma unroll
                for (int i = 0; i < 2; ++i) vo2[h][i] = (Sched::GATHER && last) ? nvoA[h][i] : voA[h][i];
            if (last && has_next) E.stage_rows(nxt, lds, wid);
            if (Sched::GATHER && last && has_next) { const LAS int* rt_ = (const LAS int*)(lds + LDS_MISC + nxt.par * 1024);
#pragma unroll
                for (int h = 0; h < 2; ++h)
#pragma unroll
                    for (int i = 0; i < 2; ++i) { vo2[h][i] = (unsigned)rt_[h * HALF + sR[i]] * (unsigned)S.K + (unsigned)sC[i] * 2u; nvoA[h][i] = vo2[h][i]; } }
            PG8_LDB(B0, 0, 0); PG8_LDB(B1, 0, 1); PG8_SCHED; PG8_LDA(At, 0, 0); PG8_STGA(PG8_SA(1, 1), a1, voA, 1);
            PG8_WAIT_V(8); PG8_WAIT_L(0); PG8_BAR; PG8_MMA(0, 0, At, B0); PG8_MMA(0, 1, At, B1); PG8_BAR; PG8_SCHED;
            PG8_LDA(At, 0, 1); PG8_STGB(PG8_SB(0, 0), b2); PG8_STGB(PG8_SB(0, 1), b2 + hstep); PG8_STGA(PG8_SA(0, 0), a2, vo2, 0);
            PG8_WAIT_V(8); PG8_WAIT_L(0); PG8_BAR; PG8_MMA(1, 0, At, B0); PG8_MMA(1, 1, At, B1); PG8_BAR; PG8_SCHED;
            PG8_LDB(B0, 1, 0); PG8_LDB(B1, 1, 1); PG8_SCHED; PG8_LDA(At, 1, 0); PG8_STGA(PG8_SA(0, 1), a2, vo2, 1);
            PG8_WAIT_V(8); PG8_WAIT_L(0); PG8_BAR; PG8_MMA(0, 0, At, B0); PG8_MMA(0, 1, At, B1); PG8_BAR; PG8_SCHED;
            PG8_LDA(At, 1, 1); PG8_STGB(PG8_SB(1, 0), b3); PG8_STGB(PG8_SB(1, 1), b3 + hstep); PG8_STGA(PG8_SA(1, 0), a3, vo2, 0);
            PG8_WAIT_V(8); PG8_WAIT_L(0); PG8_BAR; PG8_MMA(1, 0, At, B0); PG8_MMA(1, 1, At, B1); PG8_BAR; PG8_SCHED;
        }
        if constexpr (F8) asm volatile("s_nop 15\n\ts_nop 15\n\ts_nop 15" ::: "memory");
        if constexpr (ALIGN_EPI) { if (wr == 0) PG8_BAR; }
        E(acc, cur, wr, wc, fr, fq);
        if (!has_next) break;
#pragma unroll
        for (int a = 0; a < 2; ++a)
#pragma unroll
            for (int b = 0; b < 2; ++b)
#pragma unroll
                for (int m = 0; m < 4; ++m)
#pragma unroll
                    for (int n = 0; n < 2; ++n) acc[a][b][m][n] = (f32x4){0.f, 0.f, 0.f, 0.f};
        cur = nxt; cA = nA; cB = nB; ++ui;
        if (Sched::GATHER) {
#pragma unroll
            for (int h = 0; h < 2; ++h)
#pragma unroll
                for (int i = 0; i < 2; ++i) voA[h][i] = nvoA[h][i]; }
        if constexpr (ALIGN_EPI) { if (wr == 1) PG8_BAR; }
    }
    PG8_WAIT_V(0);
    if constexpr (!ALIGN_EPI) { if (wr == 0) PG8_BAR; }
    PG8_BAR;
#undef PG8_SA
#undef PG8_SB
#undef PG8_STGA
#undef PG8_STGB
#undef PG8_VOA
#undef PG8_LDA
#undef PG8_LDB
#undef PG8_MMA
#undef PG8_WAIT_V
#undef PG8_WAIT_L
#undef PG8_BAR
#undef PG8_SCHED
}

typedef f32x4 Acc[2][2][4][2];
struct EpiInProj {
    static constexpr bool PERM = true;
    __device__ __forceinline__ void stage_rows(const Unit&, LAS unsigned char*, int) const {}
    bf16_t *prw, *puv, *pg;
    template <int ACT> __device__ __forceinline__ void tile(const Acc& acc, bf16_t* base, int ld, int row0, int col0) const {
#pragma unroll
        for (int ai = 0; ai < 2; ++ai)
#pragma unroll
            for (int m = 0; m < 4; ++m) { bf16_t* rowp = base + (size_t)(row0 + ai * HALF + m * 16) * ld + col0;
#pragma unroll
                for (int bj = 0; bj < 2; ++bj) { f32x4 v0 = acc[ai][bj][m][0], v1 = acc[ai][bj][m][1];
                    if (ACT == 1) {
#pragma unroll
                        for (int j = 0; j < 4; ++j) { v0[j] = gelu_tanh(v0[j]); v1[j] = gelu_tanh(v1[j]); } }
                    if (ACT == 2) {
#pragma unroll
                        for (int j = 0; j < 4; ++j) { v0[j] = sigmoidf_(v0[j]); v1[j] = sigmoidf_(v1[j]); } }
                    u32x4 w; w.x = pk2(v0[0], v0[1]); w.y = pk2(v0[2], v0[3]); w.z = pk2(v1[0], v1[1]); w.w = pk2(v1[2], v1[3]);
                    *(u32x4*)(rowp + bj * HALF) = w; }
                __builtin_amdgcn_sched_barrier(0); }
    }
    __device__ __forceinline__ void operator()(const Acc& acc, const Unit& u, int wr, int wc, int fr, int fq) const {
        const int row0 = u.row0 + wr * 64 + fr, cw = wc * 32 + 8 * fq;
        if (u.pn < 7) tile<0>(acc, prw, RWKV_COLS, row0, u.pn * 256 + cw);
        else if (u.pn < 11) tile<1>(acc, puv, 1024, row0, (u.pn - 7) * 256 + cw);
        else tile<2>(acc, pg, 2048, row0, (u.pn - 11) * 256 + cw);
    }
};
template <bool SECOND> struct EpiMerge {
    static constexpr bool PERM = true;
    __device__ __forceinline__ void stage_rows(const Unit&, LAS unsigned char*, int) const {}
    bf16_t* m1; const bf16_t* pg; unsigned char* m8;
    __device__ __forceinline__ void operator()(const Acc& acc, const Unit& u, int wr, int wc, int fr, int fq) const {
        const int row0 = u.row0 + wr * 64 + fr, col0 = u.pn * 256 + wc * 32 + 8 * fq;
#pragma unroll
        for (int ai = 0; ai < 2; ++ai)
#pragma unroll
            for (int m = 0; m < 4; ++m) { const size_t r = (size_t)(row0 + ai * HALF + m * 16);
#pragma unroll
                for (int bj = 0; bj < 2; ++bj) { const int c = col0 + bj * HALF;
                    const u32x4 g = *(const u32x4*)(pg + r * 2048 + (SECOND ? 1024 : 0) + c);
                    f32x4 v0 = acc[ai][bj][m][0], v1 = acc[ai][bj][m][1];
                    v0[0] *= bflo(g.x); v0[1] *= bfhi(g.x); v0[2] *= bflo(g.y); v0[3] *= bfhi(g.y); v1[0] *= bflo(g.z); v1[1] *= bfhi(g.z); v1[2] *= bflo(g.w); v1[3] *= bfhi(g.w);
                    if (SECOND) { const u32x4 p = *(const u32x4*)(m1 + r * 1024 + c);
                        v0[0] += bflo(p.x); v0[1] += bfhi(p.x); v0[2] += bflo(p.y); v0[3] += bfhi(p.y); v1[0] += bflo(p.z); v1[1] += bfhi(p.z); v1[2] += bflo(p.w); v1[3] += bfhi(p.w); }
                    if (SECOND) *(u32x2*)(m8 + r * 1024 + c) = pk8(v0, v1);
                    else { u32x4 w; w.x = pk2(v0[0], v0[1]); w.y = pk2(v0[2], v0[3]); w.z = pk2(v1[0], v1[1]); w.w = pk2(v1[2], v1[3]); *(u32x4*)(m1 + r * 1024 + c) = w; } }
                __builtin_amdgcn_sched_barrier(0); }
    }
};
struct EpiResid {
    static constexpr bool PERM = true;
    __device__ __forceinline__ void stage_rows(const Unit&, LAS unsigned char*, int) const {}
    bf16_t* out; const float* base; const float* gate;
    __device__ __forceinline__ void operator()(const Acc& acc, const Unit& u, int wr, int wc, int fr, int fq) const {
        const int row0 = u.row0 + wr * 64 + fr, col0 = u.pn * 256 + wc * 32 + 8 * fq;
        const float* gp = gate + (size_t)(u.row0 >> 13) * 6144 + col0;
        f32x4 gv[2][2];
#pragma unroll
        for (int bj = 0; bj < 2; ++bj)
#pragma unroll
            for (int n = 0; n < 2; ++n) gv[bj][n] = *(const f32x4*)(gp + bj * HALF + n * 4);
#pragma unroll
        for (int ai = 0; ai < 2; ++ai)
#pragma unroll
            for (int m = 0; m < 4; ++m) { const size_t ro = (size_t)(row0 + ai * HALF + m * 16) * 1024 + col0;
#pragma unroll
                for (int bj = 0; bj < 2; ++bj) { const f32x4 b0 = *(const f32x4*)(base + ro + bj * HALF), b1 = *(const f32x4*)(base + ro + bj * HALF + 4);
                    const f32x4 v0 = b0 + gv[bj][0] * acc[ai][bj][m][0], v1 = b1 + gv[bj][1] * acc[ai][bj][m][1];
                    u32x4 w; w.x = pk2(v0[0], v0[1]); w.y = pk2(v0[2], v0[3]); w.z = pk2(v1[0], v1[1]); w.w = pk2(v1[2], v1[3]);
                    *(u32x4*)(out + ro + bj * HALF) = w; }
                __builtin_amdgcn_sched_barrier(0); }
    }
};
struct EpiRouter {
    static constexpr bool PERM = false;
    __device__ __forceinline__ void stage_rows(const Unit&, LAS unsigned char*, int) const {}
    float* sc;
    __device__ __forceinline__ void operator()(const Acc& acc, const Unit& u, int wr, int wc, int fr, int fq) const {
        const int row0 = u.row0 + wr * 64 + fr, col0 = wc * 32 + 4 * fq;
#pragma unroll
        for (int ai = 0; ai < 2; ++ai)
#pragma unroll
            for (int m = 0; m < 4; ++m) { float* rowp = sc + (size_t)(row0 + ai * HALF + m * 16) * 256 + col0;
#pragma unroll
                for (int bj = 0; bj < 2; ++bj)
#pragma unroll
                    for (int n = 0; n < 2; ++n) { f32x4 v = acc[ai][bj][m][n];
#pragma unroll
                        for (int j = 0; j < 4; ++j) v[j] = sigmoidf_(v[j]);
                        *(f32x4*)(rowp + bj * HALF + n * 16) = v; }
                __builtin_amdgcn_sched_barrier(0); }
    }
};
template <bool F8OUT> struct EpiGateUp {
    static constexpr bool PERM = true;
    __device__ __forceinline__ void stage_rows(const Unit&, LAS unsigned char*, int) const {}
    void* hid;
    __device__ __forceinline__ void operator()(const Acc& acc, const Unit& u, int wr, int wc, int fr, int fq) const {
        const int row0 = u.row0 + wr * 64 + fr, col0 = u.pn * HALF + wc * 32 + 8 * fq;
#pragma unroll
        for (int ai = 0; ai < 2; ++ai)
#pragma unroll
            for (int m = 0; m < 4; ++m) { const size_t off = (size_t)(row0 + ai * HALF + m * 16) * EFF + col0;
                f32x4 v0, v1;
#pragma unroll
                for (int j = 0; j < 4; ++j) { v0[j] = siluf_(acc[ai][0][m][0][j]) * acc[ai][1][m][0][j]; v1[j] = siluf_(acc[ai][0][m][1][j]) * acc[ai][1][m][1][j]; }
                if constexpr (F8OUT) *(u32x2*)((unsigned char*)hid + off) = pk8(v0, v1);
                else { u32x4 w; w.x = pk2(v0[0], v0[1]); w.y = pk2(v0[2], v0[3]); w.z = pk2(v1[0], v1[1]); w.w = pk2(v1[2], v1[3]); *(u32x4*)((bf16_t*)hid + off) = w; }
                __builtin_amdgcn_sched_barrier(0); }
    }
};
struct EpiExpertDown {
    static constexpr bool PERM = true;
    unsigned char* slot; const int* rowdst; const float* roww;
    __device__ __forceinline__ void stage_rows(const Unit& u, LAS unsigned char* lds, int wid) const {
        if (wid < 4) { const int lane = threadIdx.x & 63; LAS unsigned char* base = lds + LDS_MISC + u.par * 2048 + wid * 256;
            __builtin_amdgcn_global_load_lds((const unsigned*)(rowdst + u.row0 + wid * 64 + lane), (LAS unsigned*)base, 4, 0, 0);
            __builtin_amdgcn_global_load_lds((const unsigned*)(roww + u.row0 + wid * 64 + lane), (LAS unsigned*)(base + 1024), 4, 0, 0); }
    }
    __device__ __forceinline__ void operator()(const Acc& acc, const Unit& u, int wr, int wc, int fr, int fq) const {
        const unsigned cb = (unsigned)(u.pn * 256 + wc * 64 + 16 * fq);
        const LAS int* td = (const LAS int*)((LAS unsigned char*)nullptr + LDS_MISC + u.par * 2048) + wr * 64 + fr; const LAS float* tw = (const LAS float*)(td + 256);
#pragma unroll
        for (int ai = 0; ai < 2; ++ai)
#pragma unroll
            for (int m = 0; m < 4; ++m) {
                const int dst = td[ai * HALF + m * 16]; const float ws_ = tw[ai * HALF + m * 16];
                if (dst >= 0) { const u32x2 lo = pk8(acc[ai][0][m][0] * ws_, acc[ai][0][m][1] * ws_), hi = pk8(acc[ai][1][m][0] * ws_, acc[ai][1][m][1] * ws_);
                    *(u32x4*)(slot + (size_t)((unsigned)dst * 1024u + cb)) = (u32x4){lo.x, lo.y, hi.x, hi.y}; }
                __builtin_amdgcn_sched_barrier(0);
            }
    }
};
struct EpiSharedDown {
    static constexpr bool PERM = true;
    unsigned char* sho;
    __device__ __forceinline__ void stage_rows(const Unit&, LAS unsigned char*, int) const {}
    __device__ __forceinline__ void operator()(const Acc& acc, const Unit& u, int wr, int wc, int fr, int fq) const {
        const int row0 = u.row0 + wr * 64 + fr, col0 = u.pn * 256 + wc * 32 + 8 * fq;
#pragma unroll
        for (int ai = 0; ai < 2; ++ai)
#pragma unroll
            for (int m = 0; m < 4; ++m) { unsigned char* rowp = sho + (size_t)(row0 + ai * HALF + m * 16) * 1024 + col0;
#pragma unroll
                for (int bj = 0; bj < 2; ++bj) *(u32x2*)(rowp + bj * HALF) = pk8(acc[ai][bj][m][0], acc[ai][bj][m][1]);
                __builtin_amdgcn_sched_barrier(0); }
    }
};
}
__device__ __forceinline__ void phase_mod(const float* c, const float* ada_w, const float* ada_b, float* mod, LAS unsigned char* lds, int tid, int G) {
    LAS float* sl = (LAS float*)lds; LAS float* red = (LAS float*)(lds + 32768);
    for (int i = tid; i < NB * D; i += NTHREADS) { const float v = c[i]; sl[i] = siluf_(v); }
    __syncthreads();
    const int cl = tid % 24, kg = tid / 24;
    for (int cb = blockIdx.x; cb < 256; cb += G) {
        const int col0 = cb * 24;
        if (tid < 384) {
            float a[NB];
#pragma unroll
            for (int b = 0; b < NB; ++b) a[b] = 0.f;
#pragma unroll 1
            for (int k0 = kg; k0 < D; k0 += 16 * 16) { float w[16];
#pragma unroll
                for (int i = 0; i < 16; ++i) w[i] = ada_w[(size_t)(k0 + 16 * i) * 6144 + col0 + cl];
#pragma unroll
                for (int i = 0; i < 16; ++i) {
#pragma unroll
                    for (int b = 0; b < NB; ++b) a[b] += sl[b * D + k0 + 16 * i] * w[i]; } }
#pragma unroll
            for (int b = 0; b < NB; ++b) red[(kg * 24 + cl) * NB + b] = a[b];
        }
        __syncthreads();
        if (tid < 192) { const int c2 = tid >> 3, b = tid & 7; float s = 0.f;
#pragma unroll
            for (int g = 0; g < 16; ++g) s += red[(g * 24 + c2) * NB + b];
            mod[(size_t)b * 6144 + col0 + c2] = s + ada_b[col0 + c2]; }
        __syncthreads();
    }
}
__device__ __forceinline__ void transpose_item(const float* W, int ldw, int k0, int n0, bf16_t* WT, int ldt, int drow0, LAS float* scr, int lane) {
#pragma unroll 8
    for (int i = 0; i < 32; ++i) { const int kk = 2 * i + (lane >> 5); scr[kk * 33 + (lane & 31)] = W[(size_t)(k0 + kk) * ldw + n0 + (lane & 31)]; }
    LDS_WAIT(); asm volatile("" ::: "memory");
    const int c = lane & 7;
#pragma unroll
    for (int j = 0; j < 4; ++j) { const int n = (lane >> 3) + 8 * j; const LAS float* s = scr + (8 * c) * 33 + n;
        u32x4 o; o.x = pk2(s[0 * 33], s[1 * 33]); o.y = pk2(s[2 * 33], s[3 * 33]); o.z = pk2(s[4 * 33], s[5 * 33]); o.w = pk2(s[6 * 33], s[7 * 33]);
        *(u32x4*)(WT + (size_t)(drow0 + n) * ldt + k0 + 8 * c) = o; }
    LDS_WAIT(); asm volatile("" ::: "memory");
}
__device__ __forceinline__ void transpose_job(const float* W, int K, int N, bf16_t* WT, int gated, int goff, int item, LAS float* scr, int lane) {
    const int nblk = N / 32, kb = item / nblk, nb = item % nblk, n0 = 32 * nb;
    const int drow0 = gated ? (256 * (n0 >> 7) + goff + (n0 & 127)) : n0;
    transpose_item(W, N, 64 * kb, n0, WT, K, drow0, scr, lane);
}
__device__ __forceinline__ void transpose_item64(const float* W, int ldw, int k0, int n0, bf16_t* WT, int ldt, int drow0, LAS float* scr, int lane) {
    f32x4 v[16];
    const int c4 = lane & 15, r4 = lane >> 4;
#pragma unroll
    for (int i = 0; i < 16; ++i) v[i] = *(const f32x4*)(W + (size_t)(k0 + 4 * i + r4) * ldw + n0 + 4 * c4);
#pragma unroll
    for (int i = 0; i < 16; ++i) { LAS float* d = scr + (4 * i + r4) * 65 + 4 * c4; d[0] = v[i].x; d[1] = v[i].y; d[2] = v[i].z; d[3] = v[i].w; }
    LDS_WAIT(); asm volatile("" ::: "memory");
    const int c = lane & 7;
#pragma unroll
    for (int j = 0; j < 8; ++j) { const int n = (lane >> 3) + 8 * j; const LAS float* s = scr + (8 * c) * 65 + n;
        u32x4 o; o.x = pk2(s[0 * 65], s[1 * 65]); o.y = pk2(s[2 * 65], s[3 * 65]); o.z = pk2(s[4 * 65], s[5 * 65]); o.w = pk2(s[6 * 65], s[7 * 65]);
        *(u32x4*)(WT + (size_t)(drow0 + n) * ldt + k0 + 8 * c) = o; }
    LDS_WAIT(); asm volatile("" ::: "memory");
}
constexpr float WSCALE = 32.0f;
__device__ __forceinline__ void transpose_item64_f8(const float* W, int ldw, int k0, int n0, unsigned char* WT8, int ldt, int drow0, LAS float* scr, int lane) {
    f32x4 v[16];
    const int c4 = lane & 15, r4 = lane >> 4;
#pragma unroll
    for (int i = 0; i < 16; ++i) v[i] = *(const f32x4*)(W + (size_t)(k0 + 4 * i + r4) * ldw + n0 + 4 * c4);
#pragma unroll
    for (int i = 0; i < 16; ++i) { LAS float* d = scr + (4 * i + r4) * 65 + 4 * c4; d[0] = v[i].x; d[1] = v[i].y; d[2] = v[i].z; d[3] = v[i].w; }
    LDS_WAIT(); asm volatile("" ::: "memory");
    const int c = lane & 7;
#pragma unroll
    for (int j = 0; j < 8; ++j) { const int n = (lane >> 3) + 8 * j; const LAS float* s = scr + (8 * c) * 65 + n;
        const f32x4 lo = (f32x4){s[0 * 65], s[1 * 65], s[2 * 65], s[3 * 65]} * WSCALE, hi = (f32x4){s[4 * 65], s[5 * 65], s[6 * 65], s[7 * 65]} * WSCALE;
        *(u32x2*)(WT8 + (size_t)(drow0 + n) * ldt + k0 + 8 * c) = pk8(lo, hi); }
    LDS_WAIT(); asm volatile("" ::: "memory");
}
struct SmallW { const float *w_in, *w_out_a, *w_out_b, *w_out, *router_w, *sw1, *sw3, *sw2, *w_up, *a_up, *g_up, *gws; };
__device__ __forceinline__ void phase_small_weights(const SmallW& P, unsigned char* ws, LAS unsigned char* lds, int gw, int NGW, int wave, int lane) {
    LAS float* scr = (LAS float*)(lds + wave * 16640);
    constexpr int I0 = 16 * 76, I1 = 8 * 16, I2 = 8 * 16, I3 = 16 * 16, I4 = 16 * 8, I5 = 16 * 4, I6 = 16 * 4, I7 = 4 * 16, I8 = 16, I9 = 16, I10 = 2 * 16;
    constexpr int NIT = I0 + I1 + I2 + I3 + I4 + I5 + I6 + I7 + I8 + I9 + I10;
    for (int it = gw; it < NIT; it += NGW) {
        int r = it;
        if (r < I0) { const int kb = r / 76, nb = r % 76; transpose_item64_f8(P.w_in, IN_COLS, 64 * kb, 64 * nb, ws + SW_WIN, D, 64 * nb, scr, lane); continue; } r -= I0;
        if (r < I1) { transpose_item64_f8(P.w_out_a, D, 64 * (r >> 4), 64 * (r & 15), ws + SW_WOA, RW, 64 * (r & 15), scr, lane); continue; } r -= I1;
        if (r < I2) { transpose_item64_f8(P.w_out_b, D, 64 * (r >> 4), 64 * (r & 15), ws + SW_WOB, RW, 64 * (r & 15), scr, lane); continue; } r -= I2;
        if (r < I3) { transpose_item64_f8(P.w_out, D, 64 * (r >> 4), 64 * (r & 15), ws + SW_WO, D, 64 * (r & 15), scr, lane); continue; } r -= I3;
        if (r < I4) { transpose_job(P.router_w, D, NE, (bf16_t*)(ws + SW_WR), 0, 0, r, scr, lane); continue; } r -= I4;
        if (r < I5) { const int n0 = 64 * (r & 3); transpose_item64_f8(P.sw1, EFF, 64 * (r >> 2), n0, ws + SW_WS13, D, 256 * (n0 >> 7) + (n0 & 127), scr, lane); continue; } r -= I5;
        if (r < I6) { const int n0 = 64 * (r & 3); transpose_item64_f8(P.sw3, EFF, 64 * (r >> 2), n0, ws + SW_WS13, D, 256 * (n0 >> 7) + 128 + (n0 & 127), scr, lane); continue; } r -= I6;
        if (r < I7) { transpose_item64_f8(P.sw2, D, 64 * (r >> 4), 64 * (r & 15), ws + SW_WS2, EFF, 64 * (r & 15), scr, lane); continue; } r -= I7;
        if (r < I8) { transpose_job(P.w_up, 64, RW, (bf16_t*)(ws + SW_WUP), 0, 0, r, scr, lane); continue; } r -= I8;
        if (r < I9) { transpose_job(P.a_up, 64, RW, (bf16_t*)(ws + SW_AUP), 0, 0, r, scr, lane); continue; } r -= I9;
        transpose_job(P.g_up, 128, RW, (bf16_t*)(ws + SW_GUP), 0, 0, r, scr, lane);
    }
    bf16_t* wsm = (bf16_t*)(ws + SW_WSM);
    for (int i = gw * 64 + lane; i < 8 * 128 * 128; i += NGW * 64) { const int col = i & 127, row = (i >> 7) & 127; wsm[i] = (col <= row) ? f2bf(P.gws[i]) : (bf16_t)0; }
}
template <bool PERM16>
__device__ __forceinline__ void transpose_item128_f8(const float* W, int ldw, int k0, int n0, unsigned char* WT8, int ldt, int drow0, LAS float* scr, int lane) {
    f32x4 v[16];
    const int c4 = lane & 7, r8 = lane >> 3;
#pragma unroll
    for (int i = 0; i < 16; ++i) v[i] = *(const f32x4*)(W + (size_t)(k0 + 8 * i + r8) * ldw + n0 + 4 * c4);
#pragma unroll
    for (int i = 0; i < 16; ++i) { LAS float* d = scr + (8 * i + r8) * 33 + 4 * c4; d[0] = v[i].x; d[1] = v[i].y; d[2] = v[i].z; d[3] = v[i].w; }
    LDS_WAIT(); asm volatile("" ::: "memory");
    const int c = lane & 7;
#pragma unroll
    for (int j = 0; j < 4; ++j) { const int n = (lane >> 3) + 8 * j; const LAS float* s = scr + (16 * c) * 33 + n;
        f32x4 a0 = (f32x4){s[0 * 33], s[1 * 33], s[2 * 33], s[3 * 33]} * WSCALE, a1 = (f32x4){s[4 * 33], s[5 * 33], s[6 * 33], s[7 * 33]} * WSCALE;
        f32x4 a2 = (f32x4){s[8 * 33], s[9 * 33], s[10 * 33], s[11 * 33]} * WSCALE, a3 = (f32x4){s[12 * 33], s[13 * 33], s[14 * 33], s[15 * 33]} * WSCALE;
        const u32x2 lo = pk8(a0, a1), hi = pk8(a2, a3);
        int dr = drow0 + n; if (PERM16) { const int r = dr & 255; dr = (dr & ~255) + 128 * ((r >> 3) & 1) + 8 * (r >> 4) + (r & 7); }
        *(u32x4*)(WT8 + (size_t)dr * ldt + k0 + 16 * c) = (u32x4){lo.x, lo.y, hi.x, hi.y}; }
    LDS_WAIT(); asm volatile("" ::: "memory");
}
__device__ __forceinline__ void phase_expert_weights(const float* w1, const float* w3, const float* w2, unsigned char* ws, LAS unsigned char* lds, int gw, int NGW, int wave, int lane) {
    LAS float* scr = (LAS float*)(lds + wave * 16896);
    constexpr int PER = 64;
    for (int it = gw; it < NE * 3 * PER; it += NGW) {
        const int e = it / (3 * PER), r = it % (3 * PER), which = r / PER, item = r % PER;
        if (which < 2) { const int kb = item >> 3, nb = item & 7, n0 = 32 * nb;
            transpose_item128_f8<false>((which ? w3 : w1) + (size_t)e * D * EFF, EFF, 128 * kb, n0, ws + B_W13 + (size_t)e * 512 * D, D, 256 * (n0 >> 7) + which * 128 + (n0 & 127), scr, lane); }
        else { const int kb = item >> 5, nb = item & 31;
            transpose_item128_f8<true>(w2 + (size_t)e * EFF * D, D, 128 * kb, 32 * nb, ws + B_W2 + (size_t)e * D * EFF, EFF, 32 * nb, scr, lane); }
    }
}
template <bool XBF>
__device__ __forceinline__ void phase_norm_mod(const void* X, const float* gain, const float* mod, int sh_off, int sc_off, bf16_t* out, unsigned char* out8, int gw, int NGW, int lane) {
    constexpr int R = XBF ? 4 : 8;
    for (int m0 = gw; m0 < T; m0 += R * NGW) {
        f32x4 v[R][4];
#pragma unroll
        for (int rr = 0; rr < R; ++rr) { const int m = m0 + rr * NGW; const size_t mr = (size_t)(m < T ? m : m0);
            if constexpr (XBF) { const u32x2* xr = (const u32x2*)((const bf16_t*)X + mr * D) + lane;
#pragma unroll
                for (int j = 0; j < 4; ++j) { const u32x2 w = xr[64 * j]; v[rr][j] = (f32x4){bflo(w.x), bfhi(w.x), bflo(w.y), bfhi(w.y)}; } }
            else { const f32x4* xr = (const f32x4*)((const float*)X + mr * D) + lane;
#pragma unroll
                for (int j = 0; j < 4; ++j) v[rr][j] = xr[64 * j]; } }
#pragma unroll
        for (int rr = 0; rr < R; ++rr) { const int m = m0 + rr * NGW; if (m >= T) break;
            float ss = 0.f;
#pragma unroll
            for (int j = 0; j < 4; ++j) ss += (v[rr][j].x * v[rr][j].x + v[rr][j].y * v[rr][j].y) + (v[rr][j].z * v[rr][j].z + v[rr][j].w * v[rr][j].w);
            const float rstd = __builtin_amdgcn_rsqf(wave_sum(ss) * (1.f / D) + 1e-6f);
            const float* mb = mod + (size_t)(m >> 13) * 6144;
            u32x2* o8 = (u32x2*)(out + (size_t)m * D) + lane;
#pragma unroll
            for (int j = 0; j < 4; ++j) { const int col = 4 * lane + 256 * j;
                const f32x4 g = *(const f32x4*)(gain + col), sc = *(const f32x4*)(mb + sc_off + col), sh = *(const f32x4*)(mb + sh_off + col);
                const f32x4 y = v[rr][j] * rstd * g * (sc + 1.0f) + sh;
                if (out) { u32x2 w; w.x = pk2(y.x, y.y); w.y = pk2(y.z, y.w); o8[64 * j] = w; }
                if (out8) { int t8 = __builtin_amdgcn_cvt_pk_fp8_f32(y.x, y.y, 0, false); t8 = __builtin_amdgcn_cvt_pk_fp8_f32(y.z, y.w, t8, true); *(unsigned*)(out8 + (size_t)m * D + col) = (unsigned)t8; } } }
    }
}
struct YaArgs { bf16_t* ya; const bf16_t* g; const bf16_t* prw; const float* sbon; const float* mu; const float* ln_g; const float* ln_b; };
__device__ __forceinline__ void phase_ya_final(const YaArgs& P, int gw, int NGW, int lane) {
    const int ch0 = lane * 8, head = lane >> 3;
    float muv[8], lg[8], lb[8];
#pragma unroll
    for (int j = 0; j < 8; ++j) { muv[j] = P.mu[1024 + ch0 + j]; lg[j] = P.ln_g[ch0 + j]; lb[j] = P.ln_b[ch0 + j]; }
    for (int m = gw; m < T; m += NGW) {
        const u32x4 yw = *(const u32x4*)(P.ya + (size_t)m * RW + ch0);
        const u32x4 gw4 = *(const u32x4*)(P.g + (size_t)m * RW + ch0);
        const u32x4 vc = *(const u32x4*)(P.prw + (size_t)m * RWKV_COLS + 1024 + ch0);
        u32x4 vp = (u32x4){0u, 0u, 0u, 0u};
        if ((m & (SEQ - 1)) != 0) vp = *(const u32x4*)(P.prw + (size_t)(m - 1) * RWKV_COLS + 1024 + ch0);
        const float sb = P.sbon[(size_t)m * NH + head];
        float y[8], gg[8], vv[8], pv[8];
        y[0] = bflo(yw.x); y[1] = bfhi(yw.x); y[2] = bflo(yw.y); y[3] = bfhi(yw.y); y[4] = bflo(yw.z); y[5] = bfhi(yw.z); y[6] = bflo(yw.w); y[7] = bfhi(yw.w);
        gg[0] = bflo(gw4.x); gg[1] = bfhi(gw4.x); gg[2] = bflo(gw4.y); gg[3] = bfhi(gw4.y); gg[4] = bflo(gw4.z); gg[5] = bfhi(gw4.z); gg[6] = bflo(gw4.w); gg[7] = bfhi(gw4.w);
        vv[0] = bflo(vc.x); vv[1] = bfhi(vc.x); vv[2] = bflo(vc.y); vv[3] = bfhi(vc.y); vv[4] = bflo(vc.z); vv[5] = bfhi(vc.z); vv[6] = bflo(vc.w); vv[7] = bfhi(vc.w);
        pv[0] = bflo(vp.x); pv[1] = bfhi(vp.x); pv[2] = bflo(vp.y); pv[3] = bfhi(vp.y); pv[4] = bflo(vp.z); pv[5] = bfhi(vp.z); pv[6] = bflo(vp.w); pv[7] = bfhi(vp.w);
        float s = 0.f;
#pragma unroll
        for (int j = 0; j < 8; ++j) s += y[j];
        s += __shfl_xor(s, 1); s += __shfl_xor(s, 2); s += __shfl_xor(s, 4);
        const float mean = s * (1.f / 64.f); float q = 0.f;
#pragma unroll
        for (int j = 0; j < 8; ++j) { y[j] -= mean; q += y[j] * y[j]; }
        q += __shfl_xor(q, 1); q += __shfl_xor(q, 2); q += __shfl_xor(q, 4);
        const float rstd = __builtin_amdgcn_rsqf(q * (1.f / 64.f) + 64e-5f);
        float o[8];
#pragma unroll
        for (int j = 0; j < 8; ++j) { const float vs = vv[j] + (pv[j] - vv[j]) * muv[j]; o[j] = (y[j] * rstd * lg[j] + lb[j] + sb * vs) * gg[j]; }
        u32x4 w; w.x = pk2(o[0], o[1]); w.y = pk2(o[2], o[3]); w.z = pk2(o[4], o[5]); w.w = pk2(o[6], o[7]);
        *(u32x4*)(P.ya + (size_t)m * RW + ch0) = w;
    }
}
__device__ __forceinline__ void phase_xs(const bf16_t* prw, const float* mu, bf16_t* xs, int gw, int NGW, int lane) {
    const f32x4 m4 = *(const f32x4*)(mu + 1536 + 4 * lane);
    for (int t = gw; t < T; t += NGW) {
        const bf16_t* src = prw + (size_t)t * RWKV_COLS + 1536 + 4 * lane;
        const u32x2 cw = *(const u32x2*)src; u32x2 pw = (u32x2){0u, 0u};
        if ((t & (SEQ - 1)) != 0) pw = *(const u32x2*)(src - RWKV_COLS);
        f32x4 v = (f32x4){bflo(cw.x), bfhi(cw.x), bflo(cw.y), bfhi(cw.y)}; const f32x4 p = (f32x4){bflo(pw.x), bfhi(pw.x), bflo(pw.y), bfhi(pw.y)};
        v = v + (p - v) * m4;
        if (lane < 16) {
#pragma unroll
            for (int j = 0; j < 4; ++j) v[j] = tanhf_(v[j]); }
        else if (lane >= 32) {
#pragma unroll
            for (int j = 0; j < 4; ++j) v[j] = sigmoidf_(v[j]); }
        u32x2 w; w.x = pk2(v[0], v[1]); w.y = pk2(v[2], v[3]);
        *(u32x2*)(xs + (size_t)t * 256 + 4 * lane) = w;
    }
}
__device__ __forceinline__ void phase_combine(float* out, const bf16_t* x1, const unsigned char* slot, const unsigned char* sho, const float* mod, const float* normf, int gw, int NGW, int lane) {
    for (int m = gw; m < T; m += NGW) {
        const int b = m >> 13;
        f32x4* xr = (f32x4*)(out + (size_t)m * D + 16 * lane);
        const float* g2 = mod + (size_t)b * 6144 + 5120 + 16 * lane;
        u32x4 sw[TOPK + 1];
#pragma unroll
        for (int k = 0; k < TOPK; ++k) sw[k] = *(const u32x4*)(slot + ((size_t)m * TOPK + k) * D + 16 * lane);
        sw[TOPK] = *(const u32x4*)(sho + (size_t)m * D + 16 * lane);
        f32x4 x[4];
        { const u32x4 w0 = *(const u32x4*)(x1 + (size_t)m * D + 16 * lane), w1 = *(const u32x4*)(x1 + (size_t)m * D + 16 * lane + 8);
          x[0] = (f32x4){bflo(w0.x), bfhi(w0.x), bflo(w0.y), bfhi(w0.y)}; x[1] = (f32x4){bflo(w0.z), bfhi(w0.z), bflo(w0.w), bfhi(w0.w)};
          x[2] = (f32x4){bflo(w1.x), bfhi(w1.x), bflo(w1.y), bfhi(w1.y)}; x[3] = (f32x4){bflo(w1.z), bfhi(w1.z), bflo(w1.w), bfhi(w1.w)}; }
        f32x4 a[4];
#pragma unroll
        for (int j = 0; j < 4; ++j) a[j] = (f32x4){0.f, 0.f, 0.f, 0.f};
#pragma unroll
        for (int k = 0; k <= TOPK; ++k) { a[0] += up8(sw[k].x); a[1] += up8(sw[k].y); a[2] += up8(sw[k].z); a[3] += up8(sw[k].w); }
        float ss = 0.f;
#pragma unroll
        for (int j = 0; j < 4; ++j) { x[j] = x[j] + *(const f32x4*)(g2 + 4 * j) * a[j]; ss += (x[j].x * x[j].x + x[j].y * x[j].y) + (x[j].z * x[j].z + x[j].w * x[j].w); }
        const float rstd = __builtin_amdgcn_rsqf(wave_sum(ss) * (1.f / D) + 1e-6f);
#pragma unroll
        for (int j = 0; j < 4; ++j) xr[j] = x[j] * rstd * *(const f32x4*)(normf + 16 * lane + 4 * j);
    }
}
namespace rk {
constexpr int LD = 80;
constexpr int SLOTB = 64 * LD * 2;
constexpr int LDG = 136;
typedef LAS bf16_t* lp;
__device__ __forceinline__ lp slot(LAS unsigned char* lds, int i) { return (lp)(lds + i * SLOTB); }
template <int KS>
__device__ __forceinline__ void mm_nt(const LAS bf16_t* X, int ldx, const LAS bf16_t* Y, int ldy, int m, int nt0, int r, int q, f32x4 (&acc)[2]) {
#pragma unroll
    for (int s = 0; s < KS; ++s) {
        const bf16x8 a = *(const LAS bf16x8*)(X + (16 * m + r) * ldx + 32 * s + 8 * q);
#pragma unroll
        for (int n = 0; n < 2; ++n) { const bf16x8 b = *(const LAS bf16x8*)(Y + (16 * (nt0 + n) + r) * ldy + 32 * s + 8 * q); acc[n] = __builtin_amdgcn_mfma_f32_16x16x32_bf16(a, b, acc[n], 0, 0, 0); }
    }
}
__device__ __forceinline__ void st_rm(lp dst, int m, int nt, int r, int q, const f32x4& a) {
#pragma unroll
    for (int ii = 0; ii < 4; ++ii) dst[(16 * m + 4 * q + ii) * LD + 16 * nt + r] = f2bf(a[ii]);
}
__device__ __forceinline__ void st_tr(lp dst, int m, int nt, int r, int q, const f32x4& a) {
    u32x2 w; w.x = pk2(a[0], a[1]); w.y = pk2(a[2], a[3]); *(LAS u32x2*)(dst + (16 * nt + r) * LD + 16 * m + 4 * q) = w;
}
__device__ __forceinline__ void ld_rm(const LAS bf16_t* src, int m, int nt, int r, int q, f32x4& a) {
#pragma unroll
    for (int ii = 0; ii < 4; ++ii) a[ii] = bf2f(src[(16 * m + 4 * q + ii) * LD + 16 * nt + r]);
}
struct Args {
    const bf16_t* prw; const float* mu; const float *w0, *a0, *k_k, *k_a, *r_k;
    const bf16_t *wup, *aup, *gup;
    const bf16_t* xs;
    bf16_t* g; bf16_t* bv; unsigned char* mn; unsigned char* qy;
};
constexpr int LDS_MU = LDS_MISC + 2304;
struct Pre { u32x4 cw[3], pw[3]; bf16x8 xs[8]; };
__device__ __forceinline__ void task_map(int task, int h, int& i, int& ch, int& col) {
    i = task / 24; ch = task % 24;
    col = (ch >> 3) * 512 + h * 64 + 8 * (ch & 7);
}
__device__ __forceinline__ void load_mu(const Args& P, LAS unsigned char* lds, int tid) {
    LAS bf16_t* MU = (LAS bf16_t*)(lds + LDS_MU);
    for (int i = tid; i < 1536; i += NTHREADS) MU[i] = f2bf(P.mu[i]);
    __syncthreads();
}
__device__ __forceinline__ void prefetch(const Args& P, int b, int h, int c, int tid, Pre& pre) {
    const int t0 = b * SEQ + c * 64;
#pragma unroll
    for (int it = 0; it < 3; ++it) {
        int i, ch, col; task_map(tid + it * NTHREADS, h, i, ch, col);
        const bf16_t* src = P.prw + (size_t)(t0 + i) * RWKV_COLS + col;
        pre.cw[it] = *(const u32x4*)src;
        pre.pw[it] = (u32x4){0u, 0u, 0u, 0u};
        if (i != 0 || c != 0) pre.pw[it] = *(const u32x4*)(src - RWKV_COLS);
    }
    const int lane = tid & 63, r = lane & 15, q = lane >> 4, m = (tid >> 6) & 3;
    const bf16_t* xr = P.xs + (size_t)(t0 + 16 * m + r) * 256 + 8 * q;
#pragma unroll
    for (int f = 0; f < 8; ++f) pre.xs[f] = *(const bf16x8*)(xr + 32 * f);
}
__device__ __forceinline__ void unit(const Args& P, LAS unsigned char* lds, int b, int h, int c, int uidx, int tid, Pre& pf, bool has_next, int nb, int nh_, int nc) {
    const int wave = __builtin_amdgcn_readfirstlane(tid >> 6), lane = tid & 63, r = lane & 15, q = lane >> 4, m = wave & 3, nh = wave >> 2;
    const int t0 = b * SEQ + c * 64;
    lp S0 = slot(lds, 0), S1 = slot(lds, 1), S2 = slot(lds, 2), S3 = slot(lds, 3), S4 = slot(lds, 4), S5 = slot(lds, 5), S6 = slot(lds, 6), S7 = slot(lds, 7);
    lp S8 = slot(lds, 8), S9 = slot(lds, 9), S10 = slot(lds, 10), S11 = slot(lds, 11), S12 = slot(lds, 12), S13 = slot(lds, 13), S14 = slot(lds, 14);
    LAS float* PART = (LAS float*)(lds + LDS_MISC);
    LAS float* CT = PART + 256;
    LAS float* DEND = CT + 256;
    const LAS bf16_t* MU = (const LAS bf16_t*)(lds + LDS_MU);
#define RK_BAR() do { asm volatile("s_waitcnt lgkmcnt(0)" ::: "memory"); __builtin_amdgcn_s_barrier(); asm volatile("" ::: "memory"); } while (0)
#define RK_DBG(bit, sp) do {} while (0)
#pragma unroll
    for (int it = 0; it < 3; ++it) {
        int i, ch, col; task_map(tid + it * NTHREADS, h, i, ch, col);
        LAS bf16_t* dst = slot(lds, 8 + (ch >> 3)) + i * LD + 8 * (ch & 7);
        const u32x4 cw = pf.cw[it], pw = pf.pw[it];
        const u32x4 mw = *(const LAS u32x4*)(MU + col);
        const f32x4 m0 = (f32x4){bflo(mw.x), bfhi(mw.x), bflo(mw.y), bfhi(mw.y)}, m1 = (f32x4){bflo(mw.z), bfhi(mw.z), bflo(mw.w), bfhi(mw.w)};
        float v[8], p[8];
        v[0] = bflo(cw.x); v[1] = bfhi(cw.x); v[2] = bflo(cw.y); v[3] = bfhi(cw.y); v[4] = bflo(cw.z); v[5] = bfhi(cw.z); v[6] = bflo(cw.w); v[7] = bfhi(cw.w);
        p[0] = bflo(pw.x); p[1] = bfhi(pw.x); p[2] = bflo(pw.y); p[3] = bfhi(pw.y); p[4] = bflo(pw.z); p[5] = bfhi(pw.z); p[6] = bflo(pw.w); p[7] = bfhi(pw.w);
#pragma unroll
        for (int j = 0; j < 4; ++j) { v[j] += (p[j] - v[j]) * m0[j]; v[4 + j] += (p[4 + j] - v[4 + j]) * m1[j]; }
        u32x4 w; w.x = pk2(v[0], v[1]); w.y = pk2(v[2], v[3]); w.z = pk2(v[4], v[5]); w.w = pk2(v[6], v[7]);
        *(LAS u32x4*)dst = w;
    }
    RK_BAR();
    f32x4 aw[2], aa[2], ag[2];
#pragma unroll
    for (int n = 0; n < 2; ++n) { aw[n] = (f32x4){0.f, 0.f, 0.f, 0.f}; aa[n] = aw[n]; ag[n] = aw[n]; }
#pragma unroll
    for (int s = 0; s < 2; ++s) {
#pragma unroll
        for (int n = 0; n < 2; ++n) { const int row = h * 64 + 16 * (2 * nh + n) + r;
            const bf16x8 bw = *(const bf16x8*)(P.wup + (size_t)row * 64 + 32 * s + 8 * q), ba = *(const bf16x8*)(P.aup + (size_t)row * 64 + 32 * s + 8 * q);
            aw[n] = __builtin_amdgcn_mfma_f32_16x16x32_bf16(pf.xs[s], bw, aw[n], 0, 0, 0); aa[n] = __builtin_amdgcn_mfma_f32_16x16x32_bf16(pf.xs[2 + s], ba, aa[n], 0, 0, 0); }
    }
#pragma unroll
    for (int s = 0; s < 4; ++s) {
#pragma unroll
        for (int n = 0; n < 2; ++n) { const int row = h * 64 + 16 * (2 * nh + n) + r;
            const bf16x8 bg = *(const bf16x8*)(P.gup + (size_t)row * 128 + 32 * s + 8 * q);
            ag[n] = __builtin_amdgcn_mfma_f32_16x16x32_bf16(pf.xs[4 + s], bg, ag[n], 0, 0, 0); }
    }
    if (has_next) prefetch(P, nb, nh_, nc, tid, pf);
    float rr[2][4], kq[2][4], vv[2][4], av[2][4], lw[2][4], kp[2][4], pre[2][4], preq[2];
    float ss[4] = {0.f, 0.f, 0.f, 0.f}, bs[4] = {0.f, 0.f, 0.f, 0.f};
#pragma unroll
    for (int n = 0; n < 2; ++n) {
        const int ch = 32 * nh + 16 * n + r, chg = h * 64 + ch;
        const float w0v = P.w0[chg], a0v = P.a0[chg], kkc = P.k_k[chg], kac = P.k_a[chg], rkc = P.r_k[chg];
#pragma unroll
        for (int ii = 0; ii < 4; ++ii) {
            const int pos = 16 * m + 4 * q + ii;
            const float rv = bf2f(S8[pos * LD + ch]), kraw = bf2f(S9[pos * LD + ch]); vv[n][ii] = bf2f(S10[pos * LD + ch]); rr[n][ii] = rv;
            const float z = -(w0v + aw[n][ii]);
            const float sp = fmaxf(z, 0.f) + flog(1.0f + fexp(-fabsf(z)));
            lw[n][ii] = -fexp(-sp - 0.5f);
            const float a_ = sigmoidf_(a0v + aa[n][ii]); av[n][ii] = a_;
            P.g[(size_t)(t0 + pos) * RW + chg] = f2bf(ag[n][ii]);
            const float kk = kraw * kkc; kq[n][ii] = kk;
            const float kpv = kraw * (1.0f + (a_ - 1.0f) * kac); kp[n][ii] = kpv;
            ss[ii] += kk * kk; bs[ii] += rv * kpv * rkc;
        }
        pre[n][0] = lw[n][0]; pre[n][1] = pre[n][0] + lw[n][1]; pre[n][2] = pre[n][1] + lw[n][2]; pre[n][3] = pre[n][2] + lw[n][3];
        const float tot = pre[n][3];
        const float t0_ = __shfl(tot, r), t1_ = __shfl(tot, r + 16), t2_ = __shfl(tot, r + 32), t3_ = __shfl(tot, r + 48);
        preq[n] = (q > 0 ? t0_ : 0.f) + (q > 1 ? t1_ : 0.f) + (q > 2 ? t2_ : 0.f);
        if (q == 0) CT[m * 64 + ch] = (t0_ + t1_) + (t2_ + t3_);
    }
#pragma unroll
    for (int ii = 0; ii < 4; ++ii) {
#pragma unroll
        for (int o = 1; o < 16; o <<= 1) { ss[ii] += __shfl_xor(ss[ii], o); bs[ii] += __shfl_xor(bs[ii], o); }
        if (r == 0) { const int pos = 16 * m + 4 * q + ii; PART[(nh * 64 + pos) * 2] = ss[ii]; PART[(nh * 64 + pos) * 2 + 1] = bs[ii]; }
    }
    RK_BAR();
#pragma unroll
    for (int n = 0; n < 2; ++n) {
        const int ch = 32 * nh + 16 * n + r;
        float carry = 0.f, lend = 0.f;
#pragma unroll
        for (int mm = 0; mm < 4; ++mm) { const float cv = CT[mm * 64 + ch]; lend += cv; carry += (mm < m) ? cv : 0.f; }
        f32x4 tA, tBh, tKh, tV;
#pragma unroll
        for (int ii = 0; ii < 4; ++ii) {
            const int pos = 16 * m + 4 * q + ii;
            const float L = carry + preq[n] + pre[n][ii], Lm1 = L - lw[n][ii];
            const float ssum = PART[pos * 2] + PART[(64 + pos) * 2];
            const float inv = frcp(fmaxf(__builtin_sqrtf(ssum), 1e-12f));
            const float kkn = kq[n][ii] * inv, kb = kkn * av[n][ii];
            const float eN = fexp(-L), eE = fexp(lend - L);
            const float At = -kkn * fexp(Lm1), Rt = rr[n][ii] * fexp(L), Bt = kb * eN, Kt = kp[n][ii] * eN;
            S0[pos * LD + ch] = f2bf(At); S1[pos * LD + ch] = f2bf(Bt); S2[pos * LD + ch] = f2bf(Kt); S3[pos * LD + ch] = f2bf(Rt);
            tA[ii] = At; tBh[ii] = kb * eE; tKh[ii] = kp[n][ii] * eE; tV[ii] = vv[n][ii];
            P.bv[(size_t)(t0 + pos) * RW + h * 64 + ch] = f2bf((PART[pos * 2 + 1] + PART[(64 + pos) * 2 + 1]) * vv[n][ii]);
        }
        { u32x2 w; const int off = ch * LD + 16 * m + 4 * q;
          w.x = pk2(tA[0], tA[1]); w.y = pk2(tA[2], tA[3]); *(LAS u32x2*)(S4 + off) = w;
          w.x = pk2(tBh[0], tBh[1]); w.y = pk2(tBh[2], tBh[3]); *(LAS u32x2*)(S5 + off) = w;
          w.x = pk2(tKh[0], tKh[1]); w.y = pk2(tKh[2], tKh[3]); *(LAS u32x2*)(S6 + off) = w;
          w.x = pk2(tV[0], tV[1]); w.y = pk2(tV[2], tV[3]); *(LAS u32x2*)(S7 + off) = w; }
        if (m == 0 && q == 0) DEND[ch] = fexp(lend);
    }
    RK_BAR();
    RK_DBG(0, S0); RK_DBG(1, S1); RK_DBG(2, S2); RK_DBG(3, S3); RK_DBG(4, S4); RK_DBG(5, S5); RK_DBG(6, S6); RK_DBG(7, S7);
    const int nt0 = 2 * nh;
    f32x4 acc[2], acc2[2];
#define RK_ZERO(a) do { a[0] = (f32x4){0.f, 0.f, 0.f, 0.f}; a[1] = a[0]; } while (0)
#define RK_LDT(src, mt, ntt, a) do { const u32x2 w_ = *(const LAS u32x2*)((src) + (16 * (ntt) + r) * LD + 16 * (mt) + 4 * q); a = (f32x4){bflo(w_.x), bfhi(w_.x), bflo(w_.y), bfhi(w_.y)}; } while (0)
#define RK_MASK(a, ntt, COND) do { _Pragma("unroll") for (int ii = 0; ii < 4; ++ii) { const int row = 16 * m + 4 * q + ii, col = 16 * (ntt) + r; a[ii] = (COND) ? a[ii] : 0.f; } } while (0)
    RK_ZERO(acc); mm_nt<2>(S0, LD, S1, LD, m, nt0, r, q, acc);
#pragma unroll
    for (int n = 0; n < 2; ++n) { RK_MASK(acc[n], nt0 + n, col < row); st_tr(S9, m, nt0 + n, r, q, acc[n]); }
    RK_ZERO(acc); mm_nt<2>(S1, LD, S0, LD, m, nt0, r, q, acc);
#pragma unroll
    for (int n = 0; n < 2; ++n) { RK_MASK(acc[n], nt0 + n, row < col); st_tr(S8, m, nt0 + n, r, q, acc[n]);
#pragma unroll
        for (int ii = 0; ii < 4; ++ii) acc[n][ii] += ((16 * m + 4 * q + ii) == (16 * (nt0 + n) + r)) ? 1.f : 0.f;
        st_tr(S10, m, nt0 + n, r, q, acc[n]); }
    RK_ZERO(acc); mm_nt<2>(S2, LD, S0, LD, m, nt0, r, q, acc);
#pragma unroll
    for (int n = 0; n < 2; ++n) { RK_MASK(acc[n], nt0 + n, row < col); st_tr(S11, m, nt0 + n, r, q, acc[n]); }
    RK_ZERO(acc); mm_nt<2>(S1, LD, S3, LD, m, nt0, r, q, acc);
#pragma unroll
    for (int n = 0; n < 2; ++n) { RK_MASK(acc[n], nt0 + n, row <= col); st_tr(S12, m, nt0 + n, r, q, acc[n]); }
    RK_ZERO(acc); mm_nt<2>(S2, LD, S3, LD, m, nt0, r, q, acc);
#pragma unroll
    for (int n = 0; n < 2; ++n) { RK_MASK(acc[n], nt0 + n, row <= col); st_tr(S13, m, nt0 + n, r, q, acc[n]); }
    RK_BAR();
    RK_ZERO(acc); mm_nt<2>(S8, LD, S9, LD, m, nt0, r, q, acc);
    RK_ZERO(acc2); mm_nt<2>(S9, LD, S8, LD, m, nt0, r, q, acc2);
#pragma unroll
    for (int n = 0; n < 2; ++n) { st_tr(S1, m, nt0 + n, r, q, acc[n]); st_tr(S0, m, nt0 + n, r, q, acc2[n]); }
    RK_ZERO(acc); mm_nt<2>(S11, LD, S7, LD, m, nt0, r, q, acc);
#pragma unroll
    for (int n = 0; n < 2; ++n) st_tr(S14, m, nt0 + n, r, q, acc[n]);
    RK_BAR();
#define RK_ROUND(Tsrc, Tdst, Psrc, PTsrc, Pdst, PTdst) do { \
        RK_LDT(Tsrc, m, nt0, acc[0]); RK_LDT(Tsrc, m, nt0 + 1, acc[1]); mm_nt<2>(PTsrc, LD, Tsrc, LD, m, nt0, r, q, acc); \
        _Pragma("unroll") for (int n = 0; n < 2; ++n) st_tr(Tdst, m, nt0 + n, r, q, acc[n]); \
        RK_ZERO(acc); mm_nt<2>(Psrc, LD, PTsrc, LD, m, nt0, r, q, acc); RK_ZERO(acc2); mm_nt<2>(PTsrc, LD, Psrc, LD, m, nt0, r, q, acc2); \
        _Pragma("unroll") for (int n = 0; n < 2; ++n) { st_tr(PTdst, m, nt0 + n, r, q, acc[n]); st_tr(Pdst, m, nt0 + n, r, q, acc2[n]); } \
        RK_BAR(); } while (0)
#ifndef EXP_SKIP_ROUNDS
    RK_ROUND(S10, S2, S0, S1, S8, S9);
    RK_ROUND(S2, S10, S8, S9, S0, S1);
    RK_ROUND(S10, S2, S0, S1, S8, S9);
    RK_ROUND(S2, S10, S8, S9, S0, S1);
#endif
    RK_LDT(S10, m, nt0, acc[0]); RK_LDT(S10, m, nt0 + 1, acc[1]); mm_nt<2>(S1, LD, S10, LD, m, nt0, r, q, acc);
#pragma unroll
    for (int n = 0; n < 2; ++n) st_tr(S2, m, nt0 + n, r, q, acc[n]);
    RK_BAR();
    RK_ZERO(acc); mm_nt<2>(S2, LD, S4, LD, m, nt0, r, q, acc);
    RK_ZERO(acc2); mm_nt<2>(S2, LD, S14, LD, m, nt0, r, q, acc2);
#pragma unroll
    for (int n = 0; n < 2; ++n) { st_tr(S11, m, nt0 + n, r, q, acc[n]); st_tr(S0, m, nt0 + n, r, q, acc2[n]); }
    RK_BAR();
    {
        const int sw = wave & 1, ntw = wave >> 1;
        unsigned char* mn_ = P.mn + (size_t)uidx * 16384; unsigned char* qy_ = P.qy + (size_t)uidx * 16384;
        f32x4 c2[2];
#define RK_MM2(X, Y) do { _Pragma("unroll") for (int s_ = 0; s_ < 2; ++s_) { const bf16x8 b_ = *(const LAS bf16x8*)((Y) + (16 * ntw + r) * LD + 32 * s_ + 8 * q); \
            _Pragma("unroll") for (int mi = 0; mi < 2; ++mi) { const bf16x8 a_ = *(const LAS bf16x8*)((X) + (16 * (2 * sw + mi) + r) * LD + 32 * s_ + 8 * q); c2[mi] = __builtin_amdgcn_mfma_f32_16x16x32_bf16(a_, b_, c2[mi], 0, 0, 0); } } } while (0)
        RK_ZERO(c2); RK_MM2(S11, S5);
#pragma unroll
        for (int mi = 0; mi < 2; ++mi)
#pragma unroll
            for (int ii = 0; ii < 4; ++ii) { const int row = 16 * (2 * sw + mi) + 4 * q + ii, col = 16 * ntw + r; c2[mi][ii] += (row == col) ? DEND[row] : 0.f; }
        { u32x4 w; w.x = pk2(c2[0][0], c2[0][1]); w.y = pk2(c2[0][2], c2[0][3]); w.z = pk2(c2[1][0], c2[1][1]); w.w = pk2(c2[1][2], c2[1][3]); *(u32x4*)(mn_ + ((ntw * 2 + sw) * 64 + lane) * 16) = w; }
#pragma unroll
        for (int mi = 0; mi < 2; ++mi) { const u32x2 rw_ = *(const LAS u32x2*)(S3 + (16 * ntw + r) * LD + 16 * (2 * sw + mi) + 4 * q); c2[mi] = (f32x4){bflo(rw_.x), bfhi(rw_.x), bflo(rw_.y), bfhi(rw_.y)}; }
        RK_MM2(S11, S12);
        { u32x4 w; w.x = pk2(c2[0][0], c2[0][1]); w.y = pk2(c2[0][2], c2[0][3]); w.z = pk2(c2[1][0], c2[1][1]); w.w = pk2(c2[1][2], c2[1][3]); *(u32x4*)(qy_ + ((ntw * 2 + sw) * 64 + lane) * 16) = w; }
        RK_ZERO(c2); RK_MM2(S5, S0); RK_MM2(S6, S7);
#pragma unroll
        for (int mi = 0; mi < 2; ++mi) { u32x2 w; w.x = pk2(c2[mi][0], c2[mi][1]); w.y = pk2(c2[mi][2], c2[mi][3]); *(u32x2*)(mn_ + 8192 + ((ntw * 4 + 2 * sw + mi) * 64 + lane) * 8) = w; }
        RK_ZERO(c2); RK_MM2(S0, S12); RK_MM2(S7, S13);
#pragma unroll
        for (int mi = 0; mi < 2; ++mi) { u32x2 w; w.x = pk2(c2[mi][0], c2[mi][1]); w.y = pk2(c2[mi][2], c2[mi][3]); *(u32x2*)(qy_ + 8192 + (((2 * sw + mi) * 4 + ntw) * 64 + lane) * 8) = w; }
#undef RK_MM2
    }
    RK_BAR();
#undef RK_ZERO
#undef RK_ROUND
#undef RK_LDT
#undef RK_MASK
#undef RK_BAR
}
__device__ __forceinline__ void scan_wg(const unsigned char* mn, unsigned char* sbuf, int ubase, int vq, LAS unsigned char* lds, int tid) {
    const int wave = __builtin_amdgcn_readfirstlane(tid >> 6), lane = tid & 63;
    constexpr int NC = SEQ / 64, NS = 8, SLOT = 10240, AHEAD = 6;
    const unsigned char* src = mn + (size_t)ubase * 16384 + lane * 16;
    const bool loader = (wave >= 1 && wave <= 5);
    const size_t poff = (wave == 5) ? (size_t)(8192 + vq * 2048) : (size_t)(2048 * (wave - 1));
#define SC_ISSUE(c) do { const unsigned char* s_ = src + (size_t)(c) * 16384 + poff; LAS unsigned char* d_ = lds + ((c) % NS) * SLOT + 2048 * (wave - 1); \
        _Pragma("unroll") for (int i_ = 0; i_ < 2; ++i_) __builtin_amdgcn_global_load_lds((const unsigned*)(s_ + i_ * 1024), (LAS unsigned*)(d_ + i_ * 1024), 16, 0, 0); } while (0)
#define SC_BAR() do { asm volatile("s_waitcnt lgkmcnt(0)" ::: "memory"); __builtin_amdgcn_s_barrier(); asm volatile("" ::: "memory"); } while (0)
    bf16x8 sB[2];
#pragma unroll
    for (int s = 0; s < 2; ++s) sB[s] = (bf16x8){0, 0, 0, 0, 0, 0, 0, 0};
    if (loader) {
#pragma unroll
        for (int c = 0; c < AHEAD; ++c) SC_ISSUE(c);
        asm volatile("s_waitcnt vmcnt(10)" ::: "memory"); }
    SC_BAR();
    for (int c = 0; c < NC; ++c) {
        if (loader) {
            if (c + AHEAD < NC) { SC_ISSUE(c + AHEAD); asm volatile("s_waitcnt vmcnt(10)" ::: "memory"); }
            else { asm volatile("s_waitcnt vmcnt(0)" ::: "memory"); }
        } else if (wave == 0) {
            const LAS unsigned char* sl = lds + (c % NS) * SLOT;
            unsigned char* so = sbuf + (size_t)(ubase + c) * 8192 + (vq * 2) * 1024 + lane * 16;
            *(bf16x8*)so = sB[0]; *(bf16x8*)(so + 1024) = sB[1];
            f32x4 aS[4];
#pragma unroll
            for (int mm = 0; mm < 4; ++mm) {
                const u32x2 nI = *(const LAS u32x2*)(sl + 8192 + (mm * 64 + lane) * 8);
                aS[mm] = (f32x4){bflo(nI.x), bfhi(nI.x), bflo(nI.y), bfhi(nI.y)};
#pragma unroll
                for (int s = 0; s < 2; ++s) { const bf16x8 aM = *(const LAS bf16x8*)(sl + ((mm * 2 + s) * 64 + lane) * 16); aS[mm] = __builtin_amdgcn_mfma_f32_16x16x32_bf16(aM, sB[s], aS[mm], 0, 0, 0); }
            }
#pragma unroll
            for (int s = 0; s < 2; ++s) { u32x4 w; w.x = pk2(aS[2 * s][0], aS[2 * s][1]); w.y = pk2(aS[2 * s][2], aS[2 * s][3]); w.z = pk2(aS[2 * s + 1][0], aS[2 * s + 1][1]); w.w = pk2(aS[2 * s + 1][2], aS[2 * s + 1][3]);
                sB[s] = __builtin_bit_cast(bf16x8, w); }
        }
        SC_BAR();
    }
#undef SC_ISSUE
#undef SC_BAR
}
struct YArgs { const unsigned char* qy; const unsigned char* sbuf; const bf16_t* g; const bf16_t* bv; const float* ln_g; const float* ln_b; unsigned char* ya; };
__device__ __forceinline__ void ypass_unit(const YArgs& P, int u, int lane) {
    const int r = lane & 15, q = lane >> 4, b = u >> 10, h = (u >> 7) & 7, c = u & 127, t0 = b * SEQ + c * 64;
    const unsigned char* qy_ = P.qy + (size_t)u * 16384; const unsigned char* s_ = P.sbuf + (size_t)u * 8192;
    bf16x8 Qf[4][2], Sf[4][2]; u32x2 y0[4][4];
#pragma unroll
    for (int i = 0; i < 4; ++i)
#pragma unroll
        for (int s = 0; s < 2; ++s) { Qf[i][s] = *(const bf16x8*)(qy_ + ((i * 2 + s) * 64 + lane) * 16); Sf[i][s] = *(const bf16x8*)(s_ + ((i * 2 + s) * 64 + lane) * 16); }
#pragma unroll
    for (int vq = 0; vq < 4; ++vq)
#pragma unroll
        for (int mm = 0; mm < 4; ++mm) y0[vq][mm] = *(const u32x2*)(qy_ + 8192 + ((vq * 4 + mm) * 64 + lane) * 8);
    f32x4 lg[4], lb[4];
#pragma unroll
    for (int vq = 0; vq < 4; ++vq) { lg[vq] = *(const f32x4*)(P.ln_g + h * 64 + 16 * vq + 4 * q); lb[vq] = *(const f32x4*)(P.ln_b + h * 64 + 16 * vq + 4 * q); }
#pragma unroll
    for (int mm = 0; mm < 4; ++mm) {
        const size_t ro = (size_t)(t0 + 16 * mm + r) * RW + h * 64 + 4 * q;
        u32x2 gw_[4], bw_[4];
#pragma unroll
        for (int vq = 0; vq < 4; ++vq) { gw_[vq] = *(const u32x2*)(P.g + ro + 16 * vq); bw_[vq] = *(const u32x2*)(P.bv + ro + 16 * vq); }
        f32x4 acc[4]; float sum = 0.f;
#pragma unroll
        for (int vq = 0; vq < 4; ++vq) {
            acc[vq] = (f32x4){bflo(y0[vq][mm].x), bfhi(y0[vq][mm].x), bflo(y0[vq][mm].y), bfhi(y0[vq][mm].y)};
#pragma unroll
            for (int s = 0; s < 2; ++s) acc[vq] = __builtin_amdgcn_mfma_f32_16x16x32_bf16(Sf[vq][s], Qf[mm][s], acc[vq], 0, 0, 0);
            sum += (acc[vq][0] + acc[vq][1]) + (acc[vq][2] + acc[vq][3]);
        }
        sum += __shfl_xor(sum, 16); sum += __shfl_xor(sum, 32);
        const float mean = sum * (1.f / 64.f); float var = 0.f;
#pragma unroll
        for (int vq = 0; vq < 4; ++vq) { acc[vq] = acc[vq] - mean; var += (acc[vq][0] * acc[vq][0] + acc[vq][1] * acc[vq][1]) + (acc[vq][2] * acc[vq][2] + acc[vq][3] * acc[vq][3]); }
        var += __shfl_xor(var, 16); var += __shfl_xor(var, 32);
        const float rstd = __builtin_amdgcn_rsqf(var * (1.f / 64.f) + 64e-5f);
#pragma unroll
        for (int vq = 0; vq < 4; ++vq) {
            const f32x4 gg = (f32x4){bflo(gw_[vq].x), bfhi(gw_[vq].x), bflo(gw_[vq].y), bfhi(gw_[vq].y)}, bb = (f32x4){bflo(bw_[vq].x), bfhi(bw_[vq].x), bflo(bw_[vq].y), bfhi(bw_[vq].y)};
            const f32x4 o = (acc[vq] * rstd * lg[vq] + lb[vq] + bb) * gg;
            int t8 = __builtin_amdgcn_cvt_pk_fp8_f32(o[0], o[1], 0, false); t8 = __builtin_amdgcn_cvt_pk_fp8_f32(o[2], o[3], t8, true); *(unsigned*)(P.ya + ro + 16 * vq) = (unsigned)t8; }
    }
}
}
namespace gl {
constexpr int LDV = 136;
struct Args { const bf16_t* puv; const bf16_t* wsm; const float* bs; const float* ln_g; const float* ln_b; unsigned char* yb; };
__device__ __forceinline__ void unit(const Args& P, LAS unsigned char* lds, int b, int blk, int tid) {
    const int wave = __builtin_amdgcn_readfirstlane(tid >> 6), lane = tid & 63, r = lane & 15, q = lane >> 4;
    const int t0 = b * SEQ + blk * 128;
    LAS float* STAT = (LAS float*)(lds + LDS_MISC);
#pragma unroll
    for (int hb = 0; hb < 2; ++hb) {
        u32x4 w[8];
#pragma unroll
        for (int j = 0; j < 8; ++j) w[j] = *(const u32x4*)(P.puv + (size_t)(t0 + 16 * wave + 8 * hb + j) * 1024 + 512 + 8 * lane);
#pragma unroll
        for (int j = 0; j < 8; ++j) {
            float v[8]; v[0] = bflo(w[j].x); v[1] = bfhi(w[j].x); v[2] = bflo(w[j].y); v[3] = bfhi(w[j].y); v[4] = bflo(w[j].z); v[5] = bfhi(w[j].z); v[6] = bflo(w[j].w); v[7] = bfhi(w[j].w);
            float s = 0.f, s2 = 0.f;
#pragma unroll
            for (int e = 0; e < 8; ++e) { s += v[e]; s2 += v[e] * v[e]; }
            s = wave_sum(s); s2 = wave_sum(s2);
            const float mean = s * (1.f / 512.f), var = fmaxf(s2 * (1.f / 512.f) - mean * mean, 0.f);
            if (lane == 0) { const int tk = 16 * wave + 8 * hb + j; STAT[tk * 2] = mean; STAT[tk * 2 + 1] = __builtin_amdgcn_rsqf(var + 1e-5f); }
        }
    }
    u32x4 pv[2], pu[2];
#define GL_LOAD(g) do { _Pragma("unroll") for (int it = 0; it < 2; ++it) { const int task = tid + it * NTHREADS, j = task >> 3, cc = task & 7; \
        const bf16_t* row = P.puv + (size_t)(t0 + j) * 1024 + (g) * 64 + 8 * cc; pu[it] = *(const u32x4*)row; pv[it] = *(const u32x4*)(row + 512); } } while (0)
    GL_LOAD(0);
    __syncthreads();
    for (int g = 0; g < 8; ++g) {
        LAS bf16_t* VT = (LAS bf16_t*)(lds + (g & 1) * 20480);
        LAS bf16_t* US = (LAS bf16_t*)(lds + 40960 + (g & 1) * 18432);
#pragma unroll
        for (int it = 0; it < 2; ++it) {
            const int task = tid + it * NTHREADS, j = task >> 3, cc = task & 7, ch = g * 64 + 8 * cc;
            const u32x4 w = pv[it];
            const float mean = STAT[j * 2], rstd = STAT[j * 2 + 1];
            const f32x4 g0 = *(const f32x4*)(P.ln_g + ch), g1 = *(const f32x4*)(P.ln_g + ch + 4), b0 = *(const f32x4*)(P.ln_b + ch), b1 = *(const f32x4*)(P.ln_b + ch + 4);
            float v[8]; v[0] = bflo(w.x); v[1] = bfhi(w.x); v[2] = bflo(w.y); v[3] = bfhi(w.y); v[4] = bflo(w.z); v[5] = bfhi(w.z); v[6] = bflo(w.w); v[7] = bfhi(w.w);
#pragma unroll
            for (int e = 0; e < 4; ++e) { v[e] = (v[e] - mean) * rstd * g0[e] + b0[e]; v[4 + e] = (v[4 + e] - mean) * rstd * g1[e] + b1[e]; }
#pragma unroll
            for (int e = 0; e < 8; ++e) VT[(8 * cc + e) * LDV + j] = f2bf(v[e]);
            *(LAS u32x4*)(US + j * 72 + 8 * cc) = pu[it];
        }
        if (g + 1 < 8) GL_LOAD(g + 1);
        __syncthreads();
        f32x4 acc[4];
#pragma unroll
        for (int n = 0; n < 4; ++n) acc[n] = (f32x4){0.f, 0.f, 0.f, 0.f};
        const bf16_t* wrow = P.wsm + ((size_t)g * 128 + 16 * wave + r) * 128 + 8 * q;
        const int ks = (wave >> 1) + 1;
        for (int s = 0; s < ks; ++s) {
            const bf16x8 a = *(const bf16x8*)(wrow + 32 * s);
#pragma unroll
            for (int n = 0; n < 4; ++n) { const bf16x8 bb = *(const LAS bf16x8*)(VT + (16 * n + r) * LDV + 32 * s + 8 * q); acc[n] = __builtin_amdgcn_mfma_f32_16x16x32_bf16(a, bb, acc[n], 0, 0, 0); }
        }
#pragma unroll
        for (int ii = 0; ii < 4; ++ii) { const int i = 16 * wave + 4 * q + ii; const float bias = P.bs[g * 128 + i];
#pragma unroll
            for (int n = 0; n < 4; ++n) { const int c = 16 * n + r; const float u = bf2f(US[i * 72 + c]);
                P.yb[(size_t)(t0 + i) * RW + g * 64 + c] = (unsigned char)(__builtin_amdgcn_cvt_pk_fp8_f32(u * (acc[n][ii] + bias), 0.f, 0, false) & 0xff); } }
    }
    __syncthreads();
#undef GL_LOAD
}
}

struct RouteArgs { const float* sc; const float* bias; int* eidx; float* ewt; int* lrank; int* tbase; unsigned* segcnt; };
__device__ __forceinline__ void topk_tile(const RouteArgs& P, LAS unsigned char* lds, int tid, int tile) {
    const int wave = __builtin_amdgcn_readfirstlane(tid >> 6), lane = tid & 63, grp = lane >> 3;
    LAS int* hist = (LAS int*)(lds + LDS_MISC);
    const f32x4 bias4 = *(const f32x4*)(P.bias + 4 * lane);
    const float NEG = -__builtin_inff();
    {
        if (tid < NE) hist[tid] = 0;
        __syncthreads();
        f32x4 nx[2];
#pragma unroll
        for (int u = 0; u < 2; ++u) nx[u] = *(const f32x4*)(P.sc + (size_t)(tile * 256 + wave * 32 + u) * NE + 4 * lane);
        for (int j = 0; j < 32; j += 2) {
            const int t0 = tile * 256 + wave * 32 + j;
            float s[2][4], v[2][4], gs[2];
            const f32x4 cur4[2] = {nx[0], nx[1]};
            if (j + 2 < 32) {
#pragma unroll
                for (int u = 0; u < 2; ++u) nx[u] = *(const f32x4*)(P.sc + (size_t)(t0 + 2 + u) * NE + 4 * lane); }
#pragma unroll
            for (int u = 0; u < 2; ++u) { const f32x4 s4 = cur4[u]; s[u][0] = s4.x; s[u][1] = s4.y; s[u][2] = s4.z; s[u][3] = s4.w;
#pragma unroll
                for (int e = 0; e < 4; ++e) v[u][e] = s[u][e] + bias4[e]; }
            float m1[2], m2[2];
#pragma unroll
            for (int u = 0; u < 2; ++u) { const float a = fmaxf(v[u][0], v[u][1]), b = fminf(v[u][0], v[u][1]), c = fmaxf(v[u][2], v[u][3]), d = fminf(v[u][2], v[u][3]); m1[u] = fmaxf(a, c); m2[u] = fmaxf(fminf(a, c), fmaxf(b, d)); }
#pragma unroll
            for (int o = 1; o < 8; o <<= 1) {
#pragma unroll
                for (int u = 0; u < 2; ++u) { const float o1 = __shfl_xor(m1[u], o), o2 = __shfl_xor(m2[u], o); const float n1 = fmaxf(m1[u], o1), n2 = fmaxf(fminf(m1[u], o1), fmaxf(m2[u], o2)); m1[u] = n1; m2[u] = n2; } }
#pragma unroll
            for (int u = 0; u < 2; ++u) gs[u] = m1[u] + m2[u];
            int cnt[2] = {0, 0};
#pragma unroll
            for (int g = 0; g < 8; ++g) {
#pragma unroll
                for (int u = 0; u < 2; ++u) { const float og = __shfl(gs[u], 8 * g); cnt[u] += (og > gs[u] || (og == gs[u] && g < grp)) ? 1 : 0; } }
#pragma unroll
            for (int u = 0; u < 2; ++u) {
#pragma unroll
                for (int e = 0; e < 4; ++e) v[u][e] = (cnt[u] < 4) ? v[u][e] : NEG; }
            int myidx[2] = {0, 0}; float mysc[2] = {0.f, 0.f}, ssum[2] = {0.f, 0.f};
#pragma unroll
            for (int k = 0; k < TOPK; ++k) {
                float bv[2]; int idx[2];
#pragma unroll
                for (int u = 0; u < 2; ++u) { bv[u] = v[u][0]; int bi = 0;
#pragma unroll
                    for (int e = 1; e < 4; ++e) { const bool gt = v[u][e] > bv[u]; bv[u] = gt ? v[u][e] : bv[u]; bi = gt ? e : bi; }
                    idx[u] = 4 * lane + bi; }
#pragma unroll
                for (int o = 1; o < 64; o <<= 1) {
#pragma unroll
                    for (int u = 0; u < 2; ++u) { const float ov = __shfl_xor(bv[u], o); const int oi = __shfl_xor(idx[u], o); const bool tk = (ov > bv[u]) || (ov == bv[u] && oi < idx[u]); bv[u] = tk ? ov : bv[u]; idx[u] = tk ? oi : idx[u]; } }
#pragma unroll
                for (int u = 0; u < 2; ++u) { const int own = idx[u] >> 2, ee = idx[u] & 3;
                    const float mine = (ee == 0) ? s[u][0] : (ee == 1) ? s[u][1] : (ee == 2) ? s[u][2] : s[u][3];
                    const float scv = __shfl(mine, own);
#pragma unroll
                    for (int e = 0; e < 4; ++e) v[u][e] = (lane == own && e == ee) ? NEG : v[u][e];
                    ssum[u] += scv; myidx[u] = (lane == k) ? idx[u] : myidx[u]; mysc[u] = (lane == k) ? scv : mysc[u]; }
            }
            if (lane < TOPK) {
#pragma unroll
                for (int u = 0; u < 2; ++u) { const int t = t0 + u;
                    const int lr = __hip_atomic_fetch_add(hist + myidx[u], 1, __ATOMIC_RELAXED, __HIP_MEMORY_SCOPE_WORKGROUP);
                    P.eidx[(size_t)t * TOPK + lane] = myidx[u]; P.ewt[(size_t)t * TOPK + lane] = mysc[u] / ssum[u] * 2.5f; P.lrank[(size_t)t * TOPK + lane] = lr; }
            }
        }
        __syncthreads();
        if (tid < NE) { const int cnt = hist[tid]; unsigned base = 0u;
            if (cnt) base = __hip_atomic_fetch_add(P.segcnt + tid, (unsigned)cnt, __ATOMIC_RELAXED, __HIP_MEMORY_SCOPE_AGENT);
            P.tbase[tile * NE + tid] = (int)base; }
        __syncthreads();
    }
}
struct ScatArgs { const int* eidx; const float* ewt; const int* lrank; const int* tbase; const unsigned* segcnt; int* rowtok; int* rowdst; float* roww; int* tab; unsigned* ntile; };
__device__ __forceinline__ void phase_scatter(const ScatArgs& P, LAS unsigned char* lds, int tid, int G) {
    LAS int* cntL = (LAS int*)(lds + LDS_MISC); LAS int* segst = cntL + 256; LAS int* tsa = segst + 256;
    if (tid < NE) cntL[tid] = (int)__hip_atomic_load(P.segcnt + tid, __ATOMIC_RELAXED, __HIP_MEMORY_SCOPE_AGENT);
    __syncthreads();
    if (tid == 0) {
        int run = 0, ta = 0;
        for (int s = 0; s < NE; ++s) { const int nts = (cntL[s] + 255) >> 8; segst[s] = run; tsa[s] = ta; run += nts * 256; ta += nts; }
        if (blockIdx.x == 0) P.ntile[0] = (unsigned)ta;
    }
    __syncthreads();
    for (int tile = blockIdx.x; tile < T / 256; tile += G) {
        for (int a = tid; a < 256 * TOPK; a += NTHREADS) {
            const int tok = tile * 256 + (a >> 3), k = a & 7; const size_t ai = (size_t)tok * TOPK + k;
            const int e = P.eidx[ai];
            const int pos = segst[e] + P.tbase[tile * NE + e] + P.lrank[ai];
            P.rowtok[pos] = tok; P.rowdst[pos] = tok * TOPK + k; P.roww[pos] = P.ewt[ai];
        }
    }
    for (int s = blockIdx.x; s < NE; s += G) {
        const int st = segst[s], cnt = cntL[s], nts = (cnt + 255) >> 8;
        for (int p = st + cnt + tid; p < st + nts * 256; p += NTHREADS) { P.rowtok[p] = 0; P.rowdst[p] = -1; P.roww[p] = 0.f; }
        if (tid < nts) { int* ta_ = P.tab + 2 * (tsa[s] + tid); ta_[0] = st + 256 * tid; ta_[1] = s; }
    }
}
constexpr int NPHASE = 20;
struct KArgs { const float* in[34]; float* out; unsigned char* ws; int ph_lo, ph_hi; };
template <int PLO, int PHI>
__global__ void __launch_bounds__(NTHREADS, 2) fwd_kernel(KArgs a) {
    extern __shared__ __attribute__((aligned(16))) unsigned char lds_raw[];
    LAS unsigned char* lds = (LAS unsigned char*)lds_raw;
    const int G = gridDim.x, bid = blockIdx.x, NGW = G * NWAVES;
#define PH_IDS() int tid = threadIdx.x; asm volatile("" : "+v"(tid)); const int lane = tid & 63, wave = __builtin_amdgcn_readfirstlane(tid >> 6), gw = bid * NWAVES + wave; (void)lane; (void)wave; (void)gw
    unsigned char* ws = a.ws;
    unsigned* ctl = (unsigned*)(ws + WS_CTL);
    float* mod = (float*)(ws + WS_MOD);
    constexpr int lo = PLO, hi = PHI;
    if (threadIdx.x == 0) *(LAS u32x4*)(lds + LDS_BARW) = (u32x4){0u, 0u, 0u, 0u};
    __syncthreads();
    XcdBarrier bar; bar.bar = ctl + CW_BAR; bar.x = 0; bar.st = nullptr;
    if (hi - lo > 1) bar = xcd_barrier_post(ctl + CW_BAR, (volatile LAS unsigned*)(lds + LDS_BARW));
#define IN(k) (lo <= (k) && (k) < hi)
#ifdef DBG_TIME
#define STAMP(k) do { if (blockIdx.x == 0 && threadIdx.x == 0) ((unsigned long long*)(ctl + 5200))[k] = __builtin_amdgcn_s_memrealtime(); } while (0)
#else
#define STAMP(k) do {} while (0)
#endif
#define SEAM(k) do { if (IN(k) && IN((k) + 1)) xcd_barrier(bar); } while (0)
#ifndef DBG_REPEAT
#define DBG_REPEAT (-1)
#define DBG_NREP 0
#endif
#define REP(k) for (int rep_ = 0; rep_ < (((k) == DBG_REPEAT) ? 1 + DBG_NREP : 1); ++rep_, (((k) == DBG_REPEAT && rep_ <= DBG_NREP) ? xcd_barrier(bar) : (void)0))

    STAMP(0);
    if (IN(0)) REP(0) { PH_IDS();
        phase_mod(a.in[1], a.in[2], a.in[3], mod, lds, tid, G);
        SmallW sw{a.in[6], a.in[22], a.in[23], a.in[24], a.in[25], a.in[30], a.in[31], a.in[32], a.in[9], a.in[11], a.in[12], a.in[20]};
        phase_small_weights(sw, ws, lds, gw, NGW, wave, lane);
    }
    SEAM(0); STAMP(1);
    if (IN(1)) REP(1) { PH_IDS(); phase_norm_mod<false>(a.in[0], a.in[4], mod, 0, 1024, nullptr, ws + B_H1, gw, NGW, lane); }
    SEAM(1); STAMP(2);
    if (IN(2)) REP(2) {
        gm::DenseSched S; S.init(ws + B_H1, ws + SW_WIN, T, IN_COLS, D, G, bid, 1);
        gm::EpiInProj E{(bf16_t*)(ws + B_PRW), (bf16_t*)(ws + B_PUV), (bf16_t*)(ws + B_PG)};
        gm::gemm_phase<gm::EpiInProj, gm::DenseSched, true, true, 122>(lds, D, S, E);
    }
    SEAM(2); STAMP(3);
    if (IN(3)) REP(3) { PH_IDS();
        gl::Args Q{(const bf16_t*)(ws + B_PUV), (const bf16_t*)(ws + SW_WSM), a.in[21], a.in[18], a.in[19], ws + B_YB};
        for (int u = bid; u < 512; u += G) gl::unit(Q, lds, u >> 6, u & 63, tid);
        phase_xs((const bf16_t*)(ws + B_PRW), a.in[7], (bf16_t*)(ws + B_XS), gw, NGW, lane);
    }
    SEAM(3); STAMP(4);
    if (IN(4)) REP(4) { PH_IDS();
        rk::Args P{(const bf16_t*)(ws + B_PRW), a.in[7], a.in[8], a.in[10], a.in[13], a.in[14], a.in[15], (const bf16_t*)(ws + SW_WUP), (const bf16_t*)(ws + SW_AUP), (const bf16_t*)(ws + SW_GUP), (const bf16_t*)(ws + B_XS),
                   (bf16_t*)(ws + B_G), (bf16_t*)(ws + B_BV), ws + B_MN, ws + B_QY};
        rk::Pre pre; rk::load_mu(P, lds, tid);
        if (bid < 8192) rk::prefetch(P, bid >> 10, (bid >> 7) & 7, bid & 127, tid, pre);
        for (int u = bid; u < 8192; u += G) { const int un = u + G; rk::unit(P, lds, u >> 10, (u >> 7) & 7, u & 127, u, tid, pre, un < 8192, un >> 10, (un >> 7) & 7, un & 127); }
    }
    SEAM(4); STAMP(5);
    if (IN(5)) REP(5) { PH_IDS();
        for (int w = bid; w < 256; w += G) rk::scan_wg(ws + B_MN, ws + B_S, ((w & 7) + 8 * (w >> 5)) * 128, (w >> 3) & 3, lds, tid);
    }
    SEAM(5); STAMP(6);
    if (IN(6)) REP(6) { PH_IDS();
        rk::YArgs Y{ws + B_QY, ws + B_S, (const bf16_t*)(ws + B_G), (const bf16_t*)(ws + B_BV), a.in[16], a.in[17], ws + B_YA};
        for (int u = gw; u < 8192; u += NGW) rk::ypass_unit(Y, u, lane);
    }
    SEAM(6); STAMP(7);
    STAMP(8);
    if (IN(8)) REP(8) {
        gm::DenseSched S; S.init(ws + B_YA, ws + SW_WOA, T, D, RW, G, bid, 1);
        gm::EpiMerge<false> E{(bf16_t*)(ws + B_M1), (const bf16_t*)(ws + B_PG), nullptr};
        gm::gemm_phase<gm::EpiMerge<false>, gm::DenseSched, true, true, 122>(lds, RW, S, E);
    }
    STAMP(9);
    if (IN(9)) {
        gm::DenseSched S; S.init(ws + B_YB, ws + SW_WOB, T, D, RW, G, bid, 1);
        gm::EpiMerge<true> E{(bf16_t*)(ws + B_M1), (const bf16_t*)(ws + B_PG), ws + B_M8};
        gm::gemm_phase<gm::EpiMerge<true>, gm::DenseSched, true, true, 122>(lds, RW, S, E);
    }
    SEAM(9); STAMP(10);
    if (IN(10)) REP(10) {
        gm::DenseSched S; S.init(ws + B_M8, ws + SW_WO, T, D, D, G, bid, 1);
        gm::EpiResid E{(bf16_t*)(ws + B_X1), a.in[0], mod + 2048};
        gm::gemm_phase<gm::EpiResid, gm::DenseSched, true, true, 122>(lds, D, S, E);
    }
    SEAM(10); STAMP(11);
    if (IN(11)) REP(11) { PH_IDS();
        phase_norm_mod<true>(ws + B_X1, a.in[5], mod, 3072, 4096, (bf16_t*)(ws + B_H2), ws + B_H2F8, gw, NGW, lane);
        phase_expert_weights(a.in[27], a.in[28], a.in[29], ws, lds, gw, NGW, wave, lane);
    }
    SEAM(11); STAMP(12);
    if (IN(12)) { PH_IDS();
        RouteArgs R{(const float*)(ws + B_SC), a.in[26], (int*)(ws + RT_EIDX), (float*)(ws + RT_EWT), (int*)(ws + RT_LRANK), (int*)(ws + RT_TBASE), ctl + CW_SEGCNT};
        { gm::DenseSched S; S.init(ws + B_H2, ws + SW_WR, T, NE, D, G, bid); gm::EpiRouter E{(float*)(ws + B_SC)}; gm::gemm_phase<gm::EpiRouter, gm::DenseSched, true>(lds, D, S, E);
          gm::Unit u; for (int i = 0; S.next(i, u); ++i) topk_tile(R, lds, tid, u.pm); }
        { gm::DenseSched S; S.init(ws + B_H2F8, ws + SW_WS13, T, 512, D, G, bid, 1); gm::EpiGateUp<true> E{ws + B_SH}; gm::gemm_phase<gm::EpiGateUp<true>, gm::DenseSched, true, true, 122>(lds, D, S, E); }
    }
    SEAM(12); STAMP(13);
    if (IN(13)) { PH_IDS();
        ScatArgs P{(const int*)(ws + RT_EIDX), (const float*)(ws + RT_EWT), (const int*)(ws + RT_LRANK), (const int*)(ws + RT_TBASE), ctl + CW_SEGCNT,
                   (int*)(ws + RT_ROWTOK), (int*)(ws + RT_ROWDST), (float*)(ws + RT_ROWW), (int*)(ws + RT_TAB), ctl + CW_NT};
        phase_scatter(P, lds, tid, G);
        __syncthreads();
        gm::DenseSched S; S.init(ws + B_SH, ws + SW_WS2, T, D, EFF, G, bid, 1);
        gm::EpiSharedDown E{ws + B_SHO};
        gm::gemm_phase<gm::EpiSharedDown, gm::DenseSched, true, true, 122>(lds, EFF, S, E);
    }
    SEAM(13); STAMP(14); STAMP(15);
    if (IN(15)) REP(15) {
        gm::GroupSched<true> S; S.A = (const char*)(ws + B_H2F8); S.B = (const char*)(ws + B_W13); S.tab = (const int*)(ws + RT_TAB); S.rowtok = (const int*)(ws + RT_ROWTOK);
        S.ntiles = (int)__hip_atomic_load(ctl + CW_NT, __ATOMIC_RELAXED, __HIP_MEMORY_SCOPE_AGENT); S.npn = 2; S.G = G; S.c = bid; S.K = D; S.ebytes = (size_t)512 * D; S.tstep = (size_t)256 * D;
        gm::EpiGateUp<true> E{ws + B_HID};
        gm::gemm_phase<gm::EpiGateUp<true>, gm::GroupSched<true>, true, true, 122>(lds, D, S, E);
    }
    SEAM(15); STAMP(16);
    if (IN(16)) REP(16) {
        gm::GroupSched<false> S; S.A = (const char*)(ws + B_HID); S.B = (const char*)(ws + B_W2); S.tab = (const int*)(ws + RT_TAB); S.rowtok = nullptr;
        S.ntiles = (int)__hip_atomic_load(ctl + CW_NT, __ATOMIC_RELAXED, __HIP_MEMORY_SCOPE_AGENT); S.npn = 4; S.G = G; S.c = bid; S.K = EFF; S.ebytes = (size_t)D * EFF; S.tstep = (size_t)256 * EFF;
        gm::EpiExpertDown E{ws + B_SLOT, (const int*)(ws + RT_ROWDST), (const float*)(ws + RT_ROWW)};
        gm::gemm_phase<gm::EpiExpertDown, gm::GroupSched<false>, true, true, 122>(lds, EFF, S, E);
    }
    SEAM(16); STAMP(17);
    if (IN(17)) { PH_IDS(); phase_combine(a.out, (const bf16_t*)(ws + B_X1), ws + B_SLOT, ws + B_SHO, mod, a.in[33], gw, NGW, lane); }
    STAMP(18); STAMP(19);
    __syncthreads(); STAMP(20);
#undef IN
#undef SEAM
}

#if defined(DBG_CHECK) || defined(DBG_TIME)
#ifdef DBG_TIME
#ifndef TSC
#define TSC 0.25f
#endif
__global__ void dbg_time_out(float* out, const unsigned long long* st) {
    if (threadIdx.x == 0 && blockIdx.x == 0) { out[0] = (float)(st[TA1] - st[TA0]) * 0.01f * TSC; out[1] = (float)(st[TB1] - st[TB0]) * 0.01f * TSC; }
}
static void dbg_run(void* d_out, void* d_ws, hipStream_t stream) {
    dbg_time_out<<<1, 64, 0, stream>>>((float*)d_out, (const unsigned long long*)((unsigned*)((unsigned char*)d_ws + WS_CTL) + 5200));
}
#endif
#endif
#ifndef MK_SINGLE
#define MK_SINGLE 0
#endif
template <int PLO, int PHI> static bool prep_kernel() {
    int per_cu = 0;
    if (hipFuncSetAttribute((const void*)fwd_kernel<PLO, PHI>, hipFuncAttributeMaxDynamicSharedMemorySize, LDS_BYTES) != hipSuccess) { fprintf(stderr, "kernel_launch: hipFuncSetAttribute failed\n"); return false; }
    if (hipOccupancyMaxActiveBlocksPerMultiprocessor(&per_cu, (const void*)fwd_kernel<PLO, PHI>, NTHREADS, LDS_BYTES) != hipSuccess || per_cu < 1) { fprintf(stderr, "kernel_launch: occupancy query says %d\n", per_cu); (void)hipGetLastError(); return false; }
    return true;
}
template <int P> struct PhaseLaunch {
    static bool prep() { return prep_kernel<P, P + 1>() && PhaseLaunch<P + 1>::prep(); }
    static void go(int grid, hipStream_t stream, const KArgs& a) { hipLaunchKernelGGL((fwd_kernel<P, P + 1>), dim3(grid), dim3(NTHREADS), LDS_BYTES, stream, a); PhaseLaunch<P + 1>::go(grid, stream, a); }
};
#ifndef DBG_LAST
#define DBG_LAST NPHASE
#endif
template <> struct PhaseLaunch<DBG_LAST> { static bool prep() { return true; } static void go(int, hipStream_t, const KArgs&) {} };
extern "C" void kernel_launch(void* const* d_in, const int* in_sizes, int n_in, void* d_out, int out_size, void* d_ws, size_t ws_size, hipStream_t stream) {
    static int grid = 0;
    if (grid == 0) {
        if (n_in != 34 || out_size != T * D || ws_size < WS_END) { fprintf(stderr, "kernel_launch: unexpected problem shape (n_in %d, out %d, ws %zu < %zu)\n", n_in, out_size, ws_size, (size_t)WS_END); grid = -1; return; }
        int dev = 0, cus = 0;
        if (hipGetDevice(&dev) != hipSuccess || hipDeviceGetAttribute(&cus, hipDeviceAttributeMultiprocessorCount, dev) != hipSuccess) { grid = -1; return; }
#if MK_SINGLE
        if (!prep_kernel<0, NPHASE>()) { grid = -1; return; }
#else
        if (!PhaseLaunch<0>::prep()) { grid = -1; return; }
#endif
        grid = cus;
    }
    if (grid < 0) return;
    (void)hipMemsetAsync((char*)d_ws + WS_CTL, 0, CTL_ZERO_BYTES, stream);
    KArgs a{};
    for (int i = 0; i < 34; ++i) a.in[i] = (const float*)d_in[i];
    a.out = (float*)d_out; a.ws = (unsigned char*)d_ws; a.ph_lo = 0; a.ph_hi = NPHASE;
#if MK_SINGLE
    hipLaunchKernelGGL((fwd_kernel<0, NPHASE>), dim3(grid), dim3(NTHREADS), LDS_BYTES, stream, a);
#else
    PhaseLaunch<0>::go(grid, stream, a);
#endif
#if defined(DBG_CHECK) || defined(DBG_TIME)
    dbg_run(d_out, d_ws, stream);
#endif
}
```

```cpp
#define MK_SINGLE 1
#include <hip/hip_runtime.h>
#include <cstdio>
#include <cstdint>

#define LAS __attribute__((address_space(3)))
#define GAS __attribute__((address_space(1)))
typedef unsigned short bf16_t;
typedef short bf16x8 __attribute__((ext_vector_type(8)));
typedef float f32x4 __attribute__((ext_vector_type(4)));
typedef float f32x2 __attribute__((ext_vector_type(2)));
typedef unsigned u32x4 __attribute__((ext_vector_type(4)));
typedef unsigned u32x2 __attribute__((ext_vector_type(2)));

constexpr int D = 1024, NB = 8, SEQ = 8192, T = NB * SEQ;
constexpr int RW = 512, HD = 64, NH = 8;
constexpr int RWKV_COLS = 1792, IN_COLS = 4864;
constexpr int NE = 256, TOPK = 8, EFF = 256;
constexpr int NWAVES = 8, NTHREADS = 512;
constexpr int MAXROWS = T * TOPK + 256 * 256;

constexpr size_t MiB = 1u << 20;
constexpr size_t WS_CTL = 0;
constexpr int CW_BAR = 0, CW_SEGCNT = 4096, CW_NT = 4608;
constexpr size_t CTL_ZERO_BYTES = 20480;
constexpr size_t WS_MOD = 65536;
constexpr size_t WS_SW = 1 * MiB;
constexpr size_t SW_WIN = WS_SW;
constexpr size_t SW_WOA = SW_WIN + (size_t)IN_COLS * D * 2;
constexpr size_t SW_WOB = SW_WOA + (size_t)D * RW * 2;
constexpr size_t SW_WO = SW_WOB + (size_t)D * RW * 2;
constexpr size_t SW_WR = SW_WO + (size_t)D * D * 2;
constexpr size_t SW_WS13 = SW_WR + (size_t)NE * D * 2;
constexpr size_t SW_WS2 = SW_WS13 + (size_t)512 * D * 2;
constexpr size_t SW_WUP = SW_WS2 + (size_t)D * EFF * 2;
constexpr size_t SW_AUP = SW_WUP + (size_t)RW * 64 * 2;
constexpr size_t SW_GUP = SW_AUP + (size_t)RW * 64 * 2;
constexpr size_t SW_WSM = SW_GUP + (size_t)RW * 128 * 2;
constexpr size_t SW_END = SW_WSM + (size_t)8 * 128 * 128 * 2;
static_assert(SW_END <= 20 * MiB, "small weights");
constexpr size_t WS_RT = 20 * MiB;
constexpr size_t RT_EIDX = WS_RT;
constexpr size_t RT_EWT = RT_EIDX + (size_t)T * 8 * 4;
constexpr size_t RT_LRANK = RT_EWT + (size_t)T * 8 * 4;
constexpr size_t RT_TBASE = RT_LRANK + (size_t)T * 8 * 4;
constexpr size_t RT_ROWTOK = RT_TBASE + (size_t)256 * 256 * 4;
constexpr size_t RT_ROWDST = RT_ROWTOK + (size_t)MAXROWS * 4;
constexpr size_t RT_ROWW = RT_ROWDST + (size_t)MAXROWS * 4;
constexpr size_t RT_TAB = RT_ROWW + (size_t)MAXROWS * 4;
constexpr size_t RT_SBON = RT_TAB + (size_t)3 * 4096 * 8;
constexpr size_t RT_END = RT_SBON + (size_t)T * 8 * 4;
static_assert(RT_END <= 40 * MiB, "routing arrays");
constexpr size_t WS_BIG = 40 * MiB;
constexpr size_t B_H1 = WS_BIG + 0 * MiB;
constexpr size_t B_YB = WS_BIG + 0 * MiB;
constexpr size_t B_YA = WS_BIG + 64 * MiB;
constexpr size_t B_XS = WS_BIG + 64 * MiB;
constexpr size_t B_PRW = WS_BIG + 128 * MiB;
constexpr size_t B_M8 = WS_BIG + 128 * MiB;
constexpr size_t B_S = WS_BIG + 128 * MiB;
constexpr size_t B_PUV = WS_BIG + 352 * MiB;
constexpr size_t B_QY = WS_BIG + 352 * MiB;
constexpr size_t B_M1 = WS_BIG + 352 * MiB;
constexpr size_t B_PG = WS_BIG + 480 * MiB;
constexpr size_t B_MN = WS_BIG + 736 * MiB;
constexpr size_t B_G = WS_BIG + 864 * MiB;
constexpr size_t B_BV = WS_BIG + 928 * MiB;
constexpr size_t B_H2 = WS_BIG + 0 * MiB;
constexpr size_t B_W13 = WS_BIG + 128 * MiB;
constexpr size_t B_H2F8 = WS_BIG + 256 * MiB;
constexpr size_t B_SH = WS_BIG + 384 * MiB;
constexpr size_t B_SC = WS_BIG + 416 * MiB;
constexpr size_t B_SLOT = WS_BIG + 0 * MiB;
constexpr size_t B_SHO = WS_BIG + 928 * MiB;
constexpr size_t B_W2 = WS_BIG + 512 * MiB;
constexpr size_t B_X1 = WS_BIG + 576 * MiB;
constexpr size_t B_HID = WS_BIG + 704 * MiB;
constexpr size_t WS_END = WS_BIG + 992 * MiB;
static_assert((size_t)MAXROWS * EFF * 2 <= 320 * MiB, "hid");

constexpr int LDS_STAGE = 0;
constexpr int LDS_MISC = 153600;
constexpr int LDS_BARW = 161792;
constexpr int LDS_BYTES = 163840;

typedef __bf16 bf16x2_t __attribute__((ext_vector_type(2)));
__device__ __forceinline__ unsigned pk2(float lo, float hi) { f32x2 f = {lo, hi}; return __builtin_bit_cast(unsigned, __builtin_convertvector(f, bf16x2_t)); }
__device__ __forceinline__ u32x2 pk8(const f32x4& a, const f32x4& b) { u32x2 w; int t = __builtin_amdgcn_cvt_pk_fp8_f32(a[0], a[1], 0, false); t = __builtin_amdgcn_cvt_pk_fp8_f32(a[2], a[3], t, true); w.x = (unsigned)t;
    t = __builtin_amdgcn_cvt_pk_fp8_f32(b[0], b[1], 0, false); t = __builtin_amdgcn_cvt_pk_fp8_f32(b[2], b[3], t, true); w.y = (unsigned)t; return w; }
__device__ __forceinline__ f32x4 up8(unsigned w) { const f32x2 lo = __builtin_amdgcn_cvt_pk_f32_fp8((int)w, false), hi = __builtin_amdgcn_cvt_pk_f32_fp8((int)w, true); return (f32x4){lo.x, lo.y, hi.x, hi.y}; }
__device__ __forceinline__ float bflo(unsigned w) { return __uint_as_float(w << 16); }
__device__ __forceinline__ float bfhi(unsigned w) { return __uint_as_float(w & 0xffff0000u); }
__device__ __forceinline__ float bf2f(bf16_t h) { return __uint_as_float(((unsigned)h) << 16); }
__device__ __forceinline__ bf16_t f2bf(float f) { return (bf16_t)(pk2(f, 0.f) & 0xffffu); }
__device__ __forceinline__ float fexp(float x) { return __builtin_amdgcn_exp2f(x * 1.44269504089f); }
__device__ __forceinline__ float flog(float x) { return __builtin_amdgcn_logf(x) * 0.69314718056f; }
__device__ __forceinline__ float frcp(float x) { return __builtin_amdgcn_rcpf(x); }
__device__ __forceinline__ float sigmoidf_(float x) { return frcp(1.0f + fexp(-x)); }
__device__ __forceinline__ float siluf_(float x) { return x * sigmoidf_(x); }
__device__ __forceinline__ float tanhf_(float x) { return 1.0f - 2.0f * frcp(1.0f + fexp(2.0f * x)); }
__device__ __forceinline__ float gelu_tanh(float x) { const float u = 0.7978845608f * (x + 0.044715f * x * x * x); return x * frcp(1.0f + fexp(-2.0f * u)); }
__device__ __forceinline__ float wave_sum(float v) {
#pragma unroll
    for (int o = 1; o < 64; o <<= 1) v += __shfl_xor(v, o);
    return v;
}
#define LDS_WAIT() asm volatile("s_waitcnt lgkmcnt(0)" ::: "memory")
#define VM_WAIT() asm volatile("s_waitcnt vmcnt(0)" ::: "memory")

#define XB_TMO      128
#define XB_XCNT(j)  (256  + 64 * (j))
#define XB_XSUB(j)  (1280 + 64 * (j))
#define XB_XGEN(j)  (2304 + 64 * (j))
#define XB_TOP      3328
#define XB_TOPGEN   3392
#define XCD_BAR_WORDS 3456
#define XB_SPIN_CAP (1u << 18)
__device__ __forceinline__ unsigned xb_ld(unsigned* p)              { return __hip_atomic_load(p, __ATOMIC_RELAXED, __HIP_MEMORY_SCOPE_AGENT); }
__device__ __forceinline__ unsigned xb_add(unsigned* p, unsigned v) { return __hip_atomic_fetch_add(p, v, __ATOMIC_RELAXED, __HIP_MEMORY_SCOPE_AGENT); }
__device__ __forceinline__ unsigned xb_xcc_id() { return (unsigned)__builtin_amdgcn_s_getreg((3 << 11) | 20) & 0xFu; }
#define XB_SPIN(cond, bar) do { unsigned _sp = 0; while (cond) { __builtin_amdgcn_s_sleep(1); \
    if ((++_sp & 255u) == 0u) { if (xb_ld(&(bar)[XB_TMO])) break; if (_sp > XB_SPIN_CAP) { atomicAdd(&(bar)[XB_TMO], 1u); break; } } } } while (0)
struct XcdBarrier { unsigned* bar; unsigned x; volatile LAS unsigned* st; };
__device__ __forceinline__ XcdBarrier xcd_barrier_post(unsigned* bar, volatile LAS unsigned* st) {
    XcdBarrier b; b.bar = bar; b.x = xb_xcc_id(); b.st = st;
    if (threadIdx.x == 0) (void)xb_add(&bar[XB_XCNT(b.x)], 1u);
    return b;
}
__device__ __forceinline__ void xcd_barrier_complete(unsigned* bar, unsigned x, unsigned& nloc, unsigned& nx) {
    const unsigned G = gridDim.x * gridDim.y * gridDim.z;
    unsigned sum, cnt, mine, sp = 0u;
    for (;;) {
        sum = 0u; cnt = 0u; mine = 0u;
#pragma unroll
        for (unsigned j = 0; j < 16; ++j) { const unsigned c = xb_ld(&bar[XB_XCNT(j)]); sum += c; cnt += (c > 0u) ? 1u : 0u; mine = (j == x) ? c : mine; }
        if (sum == G) break;
        __builtin_amdgcn_s_sleep(1);
        if ((++sp & 255u) == 0u) { if (xb_ld(&bar[XB_TMO])) break; if (sp > XB_SPIN_CAP) { atomicAdd(&bar[XB_TMO], 1u); break; } }
    }
    nloc = mine > 0u ? mine : 1u; nx = cnt > 0u ? cnt : 1u;
}
__device__ __forceinline__ void xcd_barrier(const XcdBarrier& b) {
    asm volatile("s_waitcnt vmcnt(0)" ::: "memory");
    __syncthreads();
    if (threadIdx.x == 0) {
        unsigned* bar = b.bar;
        __builtin_amdgcn_s_waitcnt(0);
        unsigned nloc = b.st[0], nx = b.st[1];
        if (nloc == 0u) { xcd_barrier_complete(bar, b.x, nloc, nx); b.st[0] = nloc; b.st[1] = nx; }
        const unsigned old = xb_add(&bar[XB_XSUB(b.x)], 1u);
        const unsigned gen = old / nloc;
        if (old + 1u == (gen + 1u) * nloc) {
            __builtin_amdgcn_fence(__ATOMIC_RELEASE, "agent");
            asm volatile("s_waitcnt vmcnt(0)" ::: "memory");
            const unsigned og = xb_add(&bar[XB_TOP], 1u);
            const unsigned tg = og / nx;
            if (og + 1u == (tg + 1u) * nx) xb_add(&bar[XB_TOPGEN], 1u);
            else XB_SPIN(xb_ld(&bar[XB_TOPGEN]) == tg, bar);
            __builtin_amdgcn_fence(__ATOMIC_ACQUIRE, "agent");
            xb_add(&bar[XB_XGEN(b.x)], 1u);
            asm volatile("s_waitcnt vmcnt(0)" ::: "memory");
        } else {
            XB_SPIN(xb_ld(&bar[XB_XGEN(b.x)]) == gen, bar);
            __builtin_amdgcn_fence(__ATOMIC_ACQUIRE, "agent");
            asm volatile("s_waitcnt vmcnt(0)" ::: "memory");
        }
    }
    __syncthreads();
}
namespace gm {
typedef int i32x4 __attribute__((ext_vector_type(4)));
typedef int i32x8 __attribute__((ext_vector_type(8)));
constexpr int BM = 256, BK = 64, HALF = 128, HTB = HALF * BK * 2, STAGE_BYTES = 8 * HTB, NXCD = 8, WGM = 8;
__host__ __device__ __forceinline__ int lds_byte(int r, int c) { const int st = (r >> 4) * 2 + (c >> 5), rr = r & 15, cc = c & 31, ob = rr * 64 + cc * 2; return st * 1024 + (ob ^ (((ob >> 9) & 1) << 5)); }
__host__ __device__ __forceinline__ void stage_rc(int b, int& R, int& C) { const int st = b / 1024, sb = b % 1024, swz = sb ^ (((sb >> 9) & 1) << 5); R = (st >> 1) * 16 + swz / 64; C = (st & 1) * 32 + (swz % 64) / 2; }
__host__ __device__ __forceinline__ int perm32(int rho) { const int n = rho >> 4, i = rho & 15; return 8 * (i >> 2) + 4 * n + (i & 3); }

struct Unit { int pm, pn, e, row0, par; };

struct DenseSched {
    static constexpr bool GATHER = false;
    const char* A; const char* B; int nM, nN, nwg, G, c; size_t tstep; const int* rowtok; int K;
    __device__ __forceinline__ void init(const void* A_, const void* B_, int M, int N, int K, int G_, int c_, int es = 2) { A = (const char*)A_; B = (const char*)B_; nM = M / BM; nN = N / BM; nwg = nM * nN; G = G_; c = c_; tstep = (size_t)BM * K * es; rowtok = nullptr; this->K = 0; }
    __device__ __forceinline__ bool next(int i, Unit& u) const {
        const long L = (long)i * G + c; if (L >= nwg) return false;
        int wgid = (int)L; { const int q = nwg / NXCD, r = nwg % NXCD, xcd = wgid % NXCD, off = wgid / NXCD; wgid = (xcd < r ? xcd * (q + 1) : r * (q + 1) + (xcd - r) * q) + off; }
        const int nig = WGM * nN, gid = wgid / nig, fm = gid * WGM, gsz = (nM - fm) < WGM ? (nM - fm) : WGM;
        u.pm = fm + ((wgid % nig) % gsz); u.pn = (wgid % nig) / gsz; u.e = 0; u.row0 = u.pm * BM; return true;
    }
    __device__ __forceinline__ const char* a_ptr(const Unit& u) const { return A + (size_t)u.pm * tstep; }
    __device__ __forceinline__ const char* b_ptr(const Unit& u) const { return B + (size_t)u.pn * tstep; }
    __device__ __forceinline__ unsigned row_off(const Unit&, int) const { return 0u; }
};
template <bool GATHER_>
struct GroupSched {
    static constexpr bool GATHER = GATHER_;
    const char* A; const char* B; const int* tab; const int* rowtok; int ntiles, npn, G, c, K; size_t ebytes, tstep;
    __device__ __forceinline__ bool next(int i, Unit& u) const {
        int tile;
        if (G == 256) {
            const int xcd = c & 7, slot = c >> 3, tpx = 32 / npn; tile = i * 8 * tpx + xcd * tpx + slot / npn; u.pn = slot % npn; if (tile >= ntiles) return false;
        } else { const long L = (long)i * G + c; if (L >= (long)ntiles * npn) return false; tile = (int)(L / npn); u.pn = (int)(L % npn); }
        u.pm = tile;
        u.row0 = __builtin_amdgcn_readfirstlane(tab[2 * tile]); u.e = __builtin_amdgcn_readfirstlane(tab[2 * tile + 1]); return true;
    }
    __device__ __forceinline__ const char* a_ptr(const Unit& u) const { return GATHER ? A : A + (size_t)u.row0 * K; }
    __device__ __forceinline__ const char* b_ptr(const Unit& u) const { return B + (size_t)u.e * ebytes + (size_t)u.pn * tstep; }
    __device__ __forceinline__ unsigned row_off(const Unit& u, int r) const { return (unsigned)rowtok[u.row0 + r] * (unsigned)K; }
};

template <class Epi, class Sched, bool ALIGN_EPI, bool F8 = false, int SCALE_W = 127>
__device__ __forceinline__ void gemm_phase(LAS unsigned char* lds, const int Kel, const Sched& S, const Epi& E) {
    const int K = F8 ? Kel / 2 : Kel;
    int tid_ = threadIdx.x; asm volatile("" : "+v"(tid_));
    const int tid = tid_, wid = __builtin_amdgcn_readfirstlane(tid >> 6), lane = tid & 63, wr = wid >> 2, wc = wid & 3, fr = lane & 15, fq = lane >> 4;
    const int nt = K / BK;
    int sR[2], sC[2]; unsigned voffB[2];
#pragma unroll
    for (int i = 0; i < 2; ++i) { int R, C; stage_rc(tid * 16 + i * 8192, R, C); sR[i] = R; sC[i] = C; const int Rb = Epi::PERM ? ((R & ~31) + perm32(R & 31)) : R; voffB[i] = (unsigned)(Rb * K + C) * 2u; }
    const size_t kstep = (size_t)(BK * 2);
    const size_t hstep = (size_t)HALF * K * 2;
    const unsigned ldsw = (unsigned)wid * 1024u;
    const int aoff = lds_byte(wr * 64 + fr, fq * 8), boff = lds_byte(wc * 32 + fr, fq * 8);
#define PG8_SA(b, h) (((b) * 2 + (h)) * HTB)
#define PG8_SB(b, h) ((4 + (b) * 2 + (h)) * HTB)
#define PG8_STGB(bufoff, gbase) do { _Pragma("unroll") for (int _i = 0; _i < 2; ++_i) \
        __builtin_amdgcn_global_load_lds((const unsigned*)((const char*)(gbase) + voffB[_i]), (LAS unsigned*)(lds + (bufoff) + ldsw + _i * 8192), 16, 0, 0); } while (0)
#define PG8_STGA(bufoff, gbase, VO, h) do { _Pragma("unroll") for (int _i = 0; _i < 2; ++_i) \
        __builtin_amdgcn_global_load_lds((const unsigned*)((const char*)(gbase) + VO[h][_i]), (LAS unsigned*)(lds + (bufoff) + ldsw + _i * 8192), 16, 0, 0); } while (0)
#define PG8_VOA(u, VO) do { _Pragma("unroll") for (int _h = 0; _h < 2; ++_h) _Pragma("unroll") for (int _i = 0; _i < 2; ++_i) \
        VO[_h][_i] = Sched::GATHER ? (S.row_off(u, _h * HALF + sR[_i]) + (unsigned)sC[_i] * 2u) : ((unsigned)((_h * HALF + sR[_i]) * K + sC[_i]) * 2u); } while (0)
#define PG8_LDA(dst, b, h) do { _Pragma("unroll") for (int m = 0; m < 4; ++m) { if constexpr (F8) { dst##8[m].lo = *(const LAS i32x4*)(lds + PG8_SA(b, h) + aoff + m * 2048); dst##8[m].hi = *(const LAS i32x4*)(lds + PG8_SA(b, h) + aoff + m * 2048 + 1024); } else { _Pragma("unroll") for (int k = 0; k < 2; ++k) dst[m][k] = *(const LAS bf16x8*)(lds + PG8_SA(b, h) + aoff + m * 2048 + k * 1024); } } } while (0)
#define PG8_LDB(dst, b, h) do { _Pragma("unroll") for (int n = 0; n < 2; ++n) { if constexpr (F8) { dst##8[n].lo = *(const LAS i32x4*)(lds + PG8_SB(b, h) + boff + n * 2048); dst##8[n].hi = *(const LAS i32x4*)(lds + PG8_SB(b, h) + boff + n * 2048 + 1024); } else { _Pragma("unroll") for (int k = 0; k < 2; ++k) dst[n][k] = *(const LAS bf16x8*)(lds + PG8_SB(b, h) + boff + n * 2048 + k * 1024); } } } while (0)
#define PG8_MMA(ai, bj, At, Bt) do { __builtin_amdgcn_s_setprio(1); _Pragma("unroll") for (int m = 0; m < 4; ++m) _Pragma("unroll") for (int n = 0; n < 2; ++n) { \
        if constexpr (F8) { asm volatile("v_mfma_scale_f32_16x16x128_f8f6f4 %0, %1, %2, %0, %3, %4 op_sel_hi:[0,0,0]" : "+v"(acc[ai][bj][m][n]) : "v"(Bt##8[n]), "v"(At##8[m]), "v"(scw_), "v"(sca_)); } \
        else { _Pragma("unroll") for (int k = 0; k < 2; ++k) acc[ai][bj][m][n] = __builtin_amdgcn_mfma_f32_16x16x32_bf16(Bt[n][k], At[m][k], acc[ai][bj][m][n], 0, 0, 0); } } \
        __builtin_amdgcn_s_setprio(0); } while (0)
#define PG8_WAIT_V(n) asm volatile("s_waitcnt vmcnt(" #n ")" ::: "memory")
#define PG8_WAIT_L(n) asm volatile("s_waitcnt lgkmcnt(" #n ")" ::: "memory")
#define PG8_BAR __builtin_amdgcn_s_barrier()
#define PG8_SCHED __builtin_amdgcn_sched_barrier(0)
    Unit cur, nxt; int ui = 0;
    if (!S.next(0, cur)) return;
    f32x4 acc[2][2][4][2];
#pragma unroll
    for (int a = 0; a < 2; ++a)
#pragma unroll
        for (int b = 0; b < 2; ++b)
#pragma unroll
            for (int m = 0; m < 4; ++m)
#pragma unroll
                for (int n = 0; n < 2; ++n) acc[a][b][m][n] = (f32x4){0.f, 0.f, 0.f, 0.f};
    const int scw_ = SCALE_W, sca_ = 127;
    bf16x8 At[4][2], B0[2][2], B1[2][2]; i32x8 At8[4], B08[2], B18[2];
    unsigned voA[2][2], nvoA[2][2];
    PG8_VOA(cur, voA);
    if (Sched::GATHER) { asm volatile("s_waitcnt vmcnt(0)" ::: "memory"); }
    const char* cA = S.a_ptr(cur); const char* cB = S.b_ptr(cur);
    cur.par = 0; E.stage_rows(cur, lds, wid);
    PG8_STGB(PG8_SB(0, 0), cB); PG8_STGB(PG8_SB(0, 1), cB + hstep); PG8_STGA(PG8_SA(0, 0), cA, voA, 0); PG8_STGA(PG8_SA(0, 1), cA, voA, 1);
    if (wr == 1) PG8_BAR;
    PG8_WAIT_V(2); PG8_BAR;
    PG8_STGB(PG8_SB(1, 0), cB + kstep); PG8_STGA(PG8_SA(1, 0), cA + kstep, voA, 0); PG8_STGB(PG8_SB(1, 1), cB + hstep + kstep);
    PG8_WAIT_V(6); PG8_BAR;
    for (;;) {
        const bool has_next = S.next(ui + 1, nxt); nxt.par = (ui + 1) & 3;
        const char* nA = has_next ? S.a_ptr(nxt) : cA; const char* nB = has_next ? S.b_ptr(nxt) : cB;
        if (Sched::GATHER) {
            if (has_next) { if (wid < 4) __builtin_amdgcn_global_load_lds((const unsigned*)(S.rowtok + nxt.row0 + wid * 64 + lane), (LAS unsigned*)(lds + LDS_MISC + nxt.par * 1024 + wid * 256), 4, 0, 0); }
#pragma unroll
            for (int h = 0; h < 2; ++h)
#pragma unroll
                for (int i = 0; i < 2; ++i) nvoA[h][i] = voA[h][i]; }
#pragma unroll 1
        for (int t = 0; t < nt; t += 2) {
            const bool last = (t == nt - 2);
            const char* a1 = cA + (size_t)(t + 1) * kstep;
            const char* a2 = last ? nA : cA + (size_t)(t + 2) * kstep; const char* b2 = last ? nB : cB + (size_t)(t + 2) * kstep;
            const char* a3 = a2 + kstep; const char* b3 = b2 + kstep;
            unsigned vo2[2][2];
#pragma unroll
            for (int h = 0; h < 2; ++h)
#pragma unroll
                for (int i = 0; i < 2; ++i) vo2[h][i] = (Sched::GATHER && last) ? nvoA[h][i] : voA[h][i];
            if (last && has_next) E.stage_rows(nxt, lds, wid);
            if (Sched::GATHER && last && has_next) { const LAS int* rt_ = (const LAS int*)(lds + LDS_MISC + nxt.par * 1024);
#pragma unroll
                for (int h = 0; h < 2; ++h)
#pragma unroll
                    for (int i = 0; i < 2; ++i) { vo2[h][i] = (unsigned)rt_[h * HALF + sR[i]] * (unsigned)S.K + (unsigned)sC[i] * 2u; nvoA[h][i] = vo2[h][i]; } }
            PG8_LDB(B0, 0, 0); PG8_LDB(B1, 0, 1); PG8_SCHED; PG8_LDA(At, 0, 0); PG8_STGA(PG8_SA(1, 1), a1, voA, 1);
            PG8_WAIT_V(8); PG8_WAIT_L(0); PG8_BAR; PG8_MMA(0, 0, At, B0); PG8_MMA(0, 1, At, B1); PG8_BAR; PG8_SCHED;
            PG8_LDA(At, 0, 1); PG8_STGB(PG8_SB(0, 0), b2); PG8_STGB(PG8_SB(0, 1), b2 + hstep); PG8_STGA(PG8_SA(0, 0), a2, vo2, 0);
            PG8_WAIT_V(8); PG8_WAIT_L(0); PG8_BAR; PG8_MMA(1, 0, At, B0); PG8_MMA(1, 1, At, B1); PG8_BAR; PG8_SCHED;
            PG8_LDB(B0, 1, 0); PG8_LDB(B1, 1, 1); PG8_SCHED; PG8_LDA(At, 1, 0); PG8_STGA(PG8_SA(0, 1), a2, vo2, 1);
            PG8_WAIT_V(8); PG8_WAIT_L(0); PG8_BAR; PG8_MMA(0, 0, At, B0); PG8_MMA(0, 1, At, B1); PG8_BAR; PG8_SCHED;
            PG8_LDA(At, 1, 1); PG8_STGB(PG8_SB(1, 0), b3); PG8_STGB(PG8_SB(1, 1), b3 + hstep); PG8_STGA(PG8_SA(1, 0), a3, vo2, 0);
            PG8_WAIT_V(8); PG8_WAIT_L(0); PG8_BAR; PG8_MMA(1, 0, At, B0); PG8_MMA(1, 1, At, B1); PG8_BAR; PG8_SCHED;
        }
        if constexpr (F8) asm volatile("s_nop 15\n\ts_nop 15\n\ts_nop 15" ::: "memory");
        if constexpr (ALIGN_EPI) { if (wr == 0) PG8_BAR; }
        E(acc, cur, wr, wc, fr, fq);
        if (!has_next) break;
#pragma unroll
        for (int a = 0; a < 2; ++a)
#pragma unroll
            for (int b = 0; b < 2; ++b)
#pragma unroll
                for (int m = 0; m < 4; ++m)
#pragma unroll
                    for (int n = 0; n < 2; ++n) acc[a][b][m][n] = (f32x4){0.f, 0.f, 0.f, 0.f};
        cur = nxt; cA = nA; cB = nB; ++ui;
        if (Sched::GATHER) {
#pragma unroll
            for (int h = 0; h < 2; ++h)
#pragma unroll
                for (int i = 0; i < 2; ++i) voA[h][i] = nvoA[h][i]; }
        if constexpr (ALIGN_EPI) { if (wr == 1) PG8_BAR; }
    }
    PG8_WAIT_V(0);
    if constexpr (!ALIGN_EPI) { if (wr == 0) PG8_BAR; }
    PG8_BAR;
#undef PG8_SA
#undef PG8_SB
#undef PG8_STGA
#undef PG8_STGB
#undef PG8_VOA
#undef PG8_LDA
#undef PG8_LDB
#undef PG8_MMA
#undef PG8_WAIT_V
#undef PG8_WAIT_L
#undef PG8_BAR
#undef PG8_SCHED
}

typedef f32x4 Acc[2][2][4][2];
struct EpiInProj {
    static constexpr bool PERM = true;
    __device__ __forceinline__ void stage_rows(const Unit&, LAS unsigned char*, int) const {}
    bf16_t *prw, *puv, *pg;
    template <int ACT> __device__ __forceinline__ void tile(const Acc& acc, bf16_t* base, int ld, int row0, int col0) const {
#pragma unroll
        for (int ai = 0; ai < 2; ++ai)
#pragma unroll
            for (int m = 0; m < 4; ++m) { bf16_t* rowp = base + (size_t)(row0 + ai * HALF + m * 16) * ld + col0;
#pragma unroll
                for (int bj = 0; bj < 2; ++bj) { f32x4 v0 = acc[ai][bj][m][0], v1 = acc[ai][bj][m][1];
                    if (ACT == 1) {
#pragma unroll
                        for (int j = 0; j < 4; ++j) { v0[j] = gelu_tanh(v0[j]); v1[j] = gelu_tanh(v1[j]); } }
                    if (ACT == 2) {
#pragma unroll
                        for (int j = 0; j < 4; ++j) { v0[j] = sigmoidf_(v0[j]); v1[j] = sigmoidf_(v1[j]); } }
                    u32x4 w; w.x = pk2(v0[0], v0[1]); w.y = pk2(v0[2], v0[3]); w.z = pk2(v1[0], v1[1]); w.w = pk2(v1[2], v1[3]);
                    *(u32x4*)(rowp + bj * HALF) = w; }
                __builtin_amdgcn_sched_barrier(0); }
    }
    __device__ __forceinline__ void operator()(const Acc& acc, const Unit& u, int wr, int wc, int fr, int fq) const {
        const int row0 = u.row0 + wr * 64 + fr, cw = wc * 32 + 8 * fq;
        if (u.pn < 7) tile<0>(acc, prw, RWKV_COLS, row0, u.pn * 256 + cw);
        else if (u.pn < 11) tile<1>(acc, puv, 1024, row0, (u.pn - 7) * 256 + cw);
        else tile<2>(acc, pg, 2048, row0, (u.pn - 11) * 256 + cw);
    }
};
template <bool SECOND> struct EpiMerge {
    static constexpr bool PERM = true;
    __device__ __forceinline__ void stage_rows(const Unit&, LAS unsigned char*, int) const {}
    bf16_t* m1; const bf16_t* pg; unsigned char* m8;
    __device__ __forceinline__ void operator()(const Acc& acc, const Unit& u, int wr, int wc, int fr, int fq) const {
        const int row0 = u.row0 + wr * 64 + fr, col0 = u.pn * 256 + wc * 32 + 8 * fq;
#pragma unroll
        for (int ai = 0; ai < 2; ++ai)
#pragma unroll
            for (int m = 0; m < 4; ++m) { const size_t r = (size_t)(row0 + ai * HALF + m * 16);
#pragma unroll
                for (int bj = 0; bj < 2; ++bj) { const int c = col0 + bj * HALF;
                    const u32x4 g = *(const u32x4*)(pg + r * 2048 + (SECOND ? 1024 : 0) + c);
                    f32x4 v0 = acc[ai][bj][m][0], v1 = acc[ai][bj][m][1];
                    v0[0] *= bflo(g.x); v0[1] *= bfhi(g.x); v0[2] *= bflo(g.y); v0[3] *= bfhi(g.y); v1[0] *= bflo(g.z); v1[1] *= bfhi(g.z); v1[2] *= bflo(g.w); v1[3] *= bfhi(g.w);
                    if (SECOND) { const u32x4 p = *(const u32x4*)(m1 + r * 1024 + c);
                        v0[0] += bflo(p.x); v0[1] += bfhi(p.x); v0[2] += bflo(p.y); v0[3] += bfhi(p.y); v1[0] += bflo(p.z); v1[1] += bfhi(p.z); v1[2] += bflo(p.w); v1[3] += bfhi(p.w); }
                    if (SECOND) *(u32x2*)(m8 + r * 1024 + c) = pk8(v0, v1);
                    else { u32x4 w; w.x = pk2(v0[0], v0[1]); w.y = pk2(v0[2], v0[3]); w.z = pk2(v1[0], v1[1]); w.w = pk2(v1[2], v1[3]); *(u32x4*)(m1 + r * 1024 + c) = w; } }
                __builtin_amdgcn_sched_barrier(0); }
    }
};
struct EpiResid {
    static constexpr bool PERM = true;
    __device__ __forceinline__ void stage_rows(const Unit&, LAS unsigned char*, int) const {}
    bf16_t* out; const float* base; const float* gate;
    __device__ __forceinline__ void operator()(const Acc& acc, const Unit& u, int wr, int wc, int fr, int fq) const {
        const int row0 = u.row0 + wr * 64 + fr, col0 = u.pn * 256 + wc * 32 + 8 * fq;
        const float* gp = gate + (size_t)(u.row0 >> 13) * 6144 + col0;
        f32x4 gv[2][2];
#pragma unroll
        for (int bj = 0; bj < 2; ++bj)
#pragma unroll
            for (int n = 0; n < 2; ++n) gv[bj][n] = *(const f32x4*)(gp + bj * HALF + n * 4);
#pragma unroll
        for (int ai = 0; ai < 2; ++ai)
#pragma unroll
            for (int m = 0; m < 4; ++m) { const size_t ro = (size_t)(row0 + ai * HALF + m * 16) * 1024 + col0;
#pragma unroll
                for (int bj = 0; bj < 2; ++bj) { const f32x4 b0 = *(const f32x4*)(base + ro + bj * HALF), b1 = *(const f32x4*)(base + ro + bj * HALF + 4);
                    const f32x4 v0 = b0 + gv[bj][0] * acc[ai][bj][m][0], v1 = b1 + gv[bj][1] * acc[ai][bj][m][1];
                    u32x4 w; w.x = pk2(v0[0], v0[1]); w.y = pk2(v0[2], v0[3]); w.z = pk2(v1[0], v1[1]); w.w = pk2(v1[2], v1[3]);
                    *(u32x4*)(out + ro + bj * HALF) = w; }
                __builtin_amdgcn_sched_barrier(0); }
    }
};
struct EpiRouter {
    static constexpr bool PERM = false;
    __device__ __forceinline__ void stage_rows(const Unit&, LAS unsigned char*, int) const {}
    float* sc;
    __device__ __forceinline__ void operator()(const Acc& acc, const Unit& u, int wr, int wc, int fr, int fq) const {
        const int row0 = u.row0 + wr * 64 + fr, col0 = wc * 32 + 4 * fq;
#pragma unroll
        for (int ai = 0; ai < 2; ++ai)
#pragma unroll
            for (int m = 0; m < 4; ++m) { float* rowp = sc + (size_t)(row0 + ai * HALF + m * 16) * 256 + col0;
#pragma unroll
                for (int bj = 0; bj < 2; ++bj)
#pragma unroll
                    for (int n = 0; n < 2; ++n) { f32x4 v = acc[ai][bj][m][n];
#pragma unroll
                        for (int j = 0; j < 4; ++j) v[j] = sigmoidf_(v[j]);
                        *(f32x4*)(rowp + bj * HALF + n * 16) = v; }
                __builtin_amdgcn_sched_barrier(0); }
    }
};
template <bool F8OUT> struct EpiGateUp {
    static constexpr bool PERM = true;
    __device__ __forceinline__ void stage_rows(const Unit&, LAS unsigned char*, int) const {}
    void* hid;
    __device__ __forceinline__ void operator()(const Acc& acc, const Unit& u, int wr, int wc, int fr, int fq) const {
        const int row0 = u.row0 + wr * 64 + fr, col0 = u.pn * HALF + wc * 32 + 8 * fq;
#pragma unroll
        for (int ai = 0; ai < 2; ++ai)
#pragma unroll
            for (int m = 0; m < 4; ++m) { const size_t off = (size_t)(row0 + ai * HALF + m * 16) * EFF + col0;
                f32x4 v0, v1;
#pragma unroll
                for (int j = 0; j < 4; ++j) { v0[j] = siluf_(acc[ai][0][m][0][j]) * acc[ai][1][m][0][j]; v1[j] = siluf_(acc[ai][0][m][1][j]) * acc[ai][1][m][1][j]; }
                if constexpr (F8OUT) *(u32x2*)((unsigned char*)hid + off) = pk8(v0, v1);
                else { u32x4 w; w.x = pk2(v0[0], v0[1]); w.y = pk2(v0[2], v0[3]); w.z = pk2(v1[0], v1[1]); w.w = pk2(v1[2], v1[3]); *(u32x4*)((bf16_t*)hid + off) = w; }
                __builtin_amdgcn_sched_barrier(0); }
    }
};
struct EpiExpertDown {
    static constexpr bool PERM = true;
    unsigned char* slot; const int* rowdst; const float* roww;
    __device__ __forceinline__ void stage_rows(const Unit& u, LAS unsigned char* lds, int wid) const {
        if (wid < 4) { const int lane = threadIdx.x & 63; LAS unsigned char* base = lds + LDS_MISC + u.par * 2048 + wid * 256;
            __builtin_amdgcn_global_load_lds((const unsigned*)(rowdst + u.row0 + wid * 64 + lane), (LAS unsigned*)base, 4, 0, 0);
            __builtin_amdgcn_global_load_lds((const unsigned*)(roww + u.row0 + wid * 64 + lane), (LAS unsigned*)(base + 1024), 4, 0, 0); }
    }
    __device__ __forceinline__ void operator()(const Acc& acc, const Unit& u, int wr, int wc, int fr, int fq) const {
        const unsigned cb = (unsigned)(u.pn * 256 + wc * 64 + 16 * fq);
        const LAS int* td = (const LAS int*)((LAS unsigned char*)nullptr + LDS_MISC + u.par * 2048) + wr * 64 + fr; const LAS float* tw = (const LAS float*)(td + 256);
#pragma unroll
        for (int ai = 0; ai < 2; ++ai)
#pragma unroll
            for (int m = 0; m < 4; ++m) {
                const int dst = td[ai * HALF + m * 16]; const float ws_ = tw[ai * HALF + m * 16];
                if (dst >= 0) { const u32x2 lo = pk8(acc[ai][0][m][0] * ws_, acc[ai][0][m][1] * ws_), hi = pk8(acc[ai][1][m][0] * ws_, acc[ai][1][m][1] * ws_);
                    *(u32x4*)(slot + (size_t)((unsigned)dst * 1024u + cb)) = (u32x4){lo.x, lo.y, hi.x, hi.y}; }
                __builtin_amdgcn_sched_barrier(0);
            }
    }
};
struct EpiSharedDown {
    static constexpr bool PERM = true;
    unsigned char* sho;
    __device__ __forceinline__ void stage_rows(const Unit&, LAS unsigned char*, int) const {}
    __device__ __forceinline__ void operator()(const Acc& acc, const Unit& u, int wr, int wc, int fr, int fq) const {
        const int row0 = u.row0 + wr * 64 + fr, col0 = u.pn * 256 + wc * 32 + 8 * fq;
#pragma unroll
        for (int ai = 0; ai < 2; ++ai)
#pragma unroll
            for (int m = 0; m < 4; ++m) { unsigned char* rowp = sho + (size_t)(row0 + ai * HALF + m * 16) * 1024 + col0;
#pragma unroll
                for (int bj = 0; bj < 2; ++bj) *(u32x2*)(rowp + bj * HALF) = pk8(acc[ai][bj][m][0], acc[ai][bj][m][1]);
                __builtin_amdgcn_sched_barrier(0); }
    }
};
}
__device__ __forceinline__ void phase_mod(const float* c, const float* ada_w, const float* ada_b, float* mod, LAS unsigned char* lds, int tid, int G) {
    LAS float* sl = (LAS float*)lds; LAS float* red = (LAS float*)(lds + 32768);
    for (int i = tid; i < NB * D; i += NTHREADS) { const float v = c[i]; sl[i] = siluf_(v); }
    __syncthreads();
    const int cl = tid % 24, kg = tid / 24;
    for (int cb = blockIdx.x; cb < 256; cb += G) {
        const int col0 = cb * 24;
        if (tid < 384) {
            float a[NB];
#pragma unroll
            for (int b = 0; b < NB; ++b) a[b] = 0.f;
#pragma unroll 1
            for (int k0 = kg; k0 < D; k0 += 16 * 16) { float w[16];
#pragma unroll
                for (int i = 0; i < 16; ++i) w[i] = ada_w[(size_t)(k0 + 16 * i) * 6144 + col0 + cl];
#pragma unroll
                for (int i = 0; i < 16; ++i) {
#pragma unroll
                    for (int b = 0; b < NB; ++b) a[b] += sl[b * D + k0 + 16 * i] * w[i]; } }
#pragma unroll
            for (int b = 0; b < NB; ++b) red[(kg * 24 + cl) * NB + b] = a[b];
        }
        __syncthreads();
        if (tid < 192) { const int c2 = tid >> 3, b = tid & 7; float s = 0.f;
#pragma unroll
            for (int g = 0; g < 16; ++g) s += red[(g * 24 + c2) * NB + b];
            mod[(size_t)b * 6144 + col0 + c2] = s + ada_b[col0 + c2]; }
        __syncthreads();
    }
}
__device__ __forceinline__ void transpose_item(const float* W, int ldw, int k0, int n0, bf16_t* WT, int ldt, int drow0, LAS float* scr, int lane) {
#pragma unroll 8
    for (int i = 0; i < 32; ++i) { const int kk = 2 * i + (lane >> 5); scr[kk * 33 + (lane & 31)] = W[(size_t)(k0 + kk) * ldw + n0 + (lane & 31)]; }
    LDS_WAIT(); asm volatile("" ::: "memory");
    const int c = lane & 7;
#pragma unroll
    for (int j = 0; j < 4; ++j) { const int n = (lane >> 3) + 8 * j; const LAS float* s = scr + (8 * c) * 33 + n;
        u32x4 o; o.x = pk2(s[0 * 33], s[1 * 33]); o.y = pk2(s[2 * 33], s[3 * 33]); o.z = pk2(s[4 * 33], s[5 * 33]); o.w = pk2(s[6 * 33], s[7 * 33]);
        *(u32x4*)(WT + (size_t)(drow0 + n) * ldt + k0 + 8 * c) = o; }
    LDS_WAIT(); asm volatile("" ::: "memory");
}
__device__ __forceinline__ void transpose_job(const float* W, int K, int N, bf16_t* WT, int gated, int goff, int item, LAS float* scr, int lane) {
    const int nblk = N / 32, kb = item / nblk, nb = item % nblk, n0 = 32 * nb;
    const int drow0 = gated ? (256 * (n0 >> 7) + goff + (n0 & 127)) : n0;
    transpose_item(W, N, 64 * kb, n0, WT, K, drow0, scr, lane);
}
__device__ __forceinline__ void transpose_item64(const float* W, int ldw, int k0, int n0, bf16_t* WT, int ldt, int drow0, LAS float* scr, int lane) {
    f32x4 v[16];
    const int c4 = lane & 15, r4 = lane >> 4;
#pragma unroll
    for (int i = 0; i < 16; ++i) v[i] = *(const f32x4*)(W + (size_t)(k0 + 4 * i + r4) * ldw + n0 + 4 * c4);
#pragma unroll
    for (int i = 0; i < 16; ++i) { LAS float* d = scr + (4 * i + r4) * 65 + 4 * c4; d[0] = v[i].x; d[1] = v[i].y; d[2] = v[i].z; d[3] = v[i].w; }
    LDS_WAIT(); asm volatile("" ::: "memory");
    const int c = lane & 7;
#pragma unroll
    for (int j = 0; j < 8; ++j) { const int n = (lane >> 3) + 8 * j; const LAS float* s = scr + (8 * c) * 65 + n;
        u32x4 o; o.x = pk2(s[0 * 65], s[1 * 65]); o.y = pk2(s[2 * 65], s[3 * 65]); o.z = pk2(s[4 * 65], s[5 * 65]); o.w = pk2(s[6 * 65], s[7 * 65]);
        *(u32x4*)(WT + (size_t)(drow0 + n) * ldt + k0 + 8 * c) = o; }
    LDS_WAIT(); asm volatile("" ::: "memory");
}
constexpr float WSCALE = 32.0f;
__device__ __forceinline__ void transpose_item64_f8(const float* W, int ldw, int k0, int n0, unsigned char* WT8, int ldt, int drow0, LAS float* scr, int lane) {
    f32x4 v[16];
    const int c4 = lane & 15, r4 = lane >> 4;
#pragma unroll
    for (int i = 0; i < 16; ++i) v[i] = *(const f32x4*)(W + (size_t)(k0 + 4 * i + r4) * ldw + n0 + 4 * c4);
#pragma unroll
    for (int i = 0; i < 16; ++i) { LAS float* d = scr + (4 * i + r4) * 65 + 4 * c4; d[0] = v[i].x; d[1] = v[i].y; d[2] = v[i].z; d[3] = v[i].w; }
    LDS_WAIT(); asm volatile("" ::: "memory");
    const int c = lane & 7;
#pragma unroll
    for (int j = 0; j < 8; ++j) { const int n = (lane >> 3) + 8 * j; const LAS float* s = scr + (8 * c) * 65 + n;
        const f32x4 lo = (f32x4){s[0 * 65], s[1 * 65], s[2 * 65], s[3 * 65]} * WSCALE, hi = (f32x4){s[4 * 65], s[5 * 65], s[6 * 65], s[7 * 65]} * WSCALE;
        *(u32x2*)(WT8 + (size_t)(drow0 + n) * ldt + k0 + 8 * c) = pk8(lo, hi); }
    LDS_WAIT(); asm volatile("" ::: "memory");
}
struct SmallW { const float *w_in, *w_out_a, *w_out_b, *w_out, *router_w, *sw1, *sw3, *sw2, *w_up, *a_up, *g_up, *gws; };
__device__ __forceinline__ void phase_small_weights(const SmallW& P, unsigned char* ws, LAS unsigned char* lds, int gw, int NGW, int wave, int lane) {
    LAS float* scr = (LAS float*)(lds + wave * 16640);
    constexpr int I0 = 16 * 76, I1 = 8 * 16, I2 = 8 * 16, I3 = 16 * 16, I4 = 16 * 8, I5 = 16 * 4, I6 = 16 * 4, I7 = 4 * 16, I8 = 16, I9 = 16, I10 = 2 * 16;
    constexpr int NIT = I0 + I1 + I2 + I3 + I4 + I5 + I6 + I7 + I8 + I9 + I10;
    for (int it = gw; it < NIT; it += NGW) {
        int r = it;
        if (r < I0) { const int kb = r / 76, nb = r % 76; transpose_item64_f8(P.w_in, IN_COLS, 64 * kb, 64 * nb, ws + SW_WIN, D, 64 * nb, scr, lane); continue; } r -= I0;
        if (r < I1) { transpose_item64_f8(P.w_out_a, D, 64 * (r >> 4), 64 * (r & 15), ws + SW_WOA, RW, 64 * (r & 15), scr, lane); continue; } r -= I1;
        if (r < I2) { transpose_item64_f8(P.w_out_b, D, 64 * (r >> 4), 64 * (r & 15), ws + SW_WOB, RW, 64 * (r & 15), scr, lane); continue; } r -= I2;
        if (r < I3) { transpose_item64_f8(P.w_out, D, 64 * (r >> 4), 64 * (r & 15), ws + SW_WO, D, 64 * (r & 15), scr, lane); continue; } r -= I3;
        if (r < I4) { transpose_job(P.router_w, D, NE, (bf16_t*)(ws + SW_WR), 0, 0, r, scr, lane); continue; } r -= I4;
        if (r < I5) { const int n0 = 64 * (r & 3); transpose_item64_f8(P.sw1, EFF, 64 * (r >> 2), n0, ws + SW_WS13, D, 256 * (n0 >> 7) + (n0 & 127), scr, lane); continue; } r -= I5;
        if (r < I6) { const int n0 = 64 * (r & 3); transpose_item64_f8(P.sw3, EFF, 64 * (r >> 2), n0, ws + SW_WS13, D, 256 * (n0 >> 7) + 128 + (n0 & 127), scr, lane); continue; } r -= I6;
        if (r < I7) { transpose_item64_f8(P.sw2, D, 64 * (r >> 4), 64 * (r & 15), ws + SW_WS2, EFF, 64 * (r & 15), scr, lane); continue; } r -= I7;
        if (r < I8) { transpose_job(P.w_up, 64, RW, (bf16_t*)(ws + SW_WUP), 0, 0, r, scr, lane); continue; } r -= I8;
        if (r < I9) { transpose_job(P.a_up, 64, RW, (bf16_t*)(ws + SW_AUP), 0, 0, r, scr, lane); continue; } r -= I9;
        transpose_job(P.g_up, 128, RW, (bf16_t*)(ws + SW_GUP), 0, 0, r, scr, lane);
    }
    bf16_t* wsm = (bf16_t*)(ws + SW_WSM);
    for (int i = gw * 64 + lane; i < 8 * 128 * 128; i += NGW * 64) { const int col = i & 127, row = (i >> 7) & 127; wsm[i] = (col <= row) ? f2bf(P.gws[i]) : (bf16_t)0; }
}
template <bool PERM16>
__device__ __forceinline__ void transpose_item128_f8(const float* W, int ldw, int k0, int n0, unsigned char* WT8, int ldt, int drow0, LAS float* scr, int lane) {
    f32x4 v[16];
    const int c4 = lane & 7, r8 = lane >> 3;
#pragma unroll
    for (int i = 0; i < 16; ++i) v[i] = *(const f32x4*)(W + (size_t)(k0 + 8 * i + r8) * ldw + n0 + 4 * c4);
#pragma unroll
    for (int i = 0; i < 16; ++i) { LAS float* d = scr + (8 * i + r8) * 33 + 4 * c4; d[0] = v[i].x; d[1] = v[i].y; d[2] = v[i].z; d[3] = v[i].w; }
    LDS_WAIT(); asm volatile("" ::: "memory");
    const int c = lane & 7;
#pragma unroll
    for (int j = 0; j < 4; ++j) { const int n = (lane >> 3) + 8 * j; const LAS float* s = scr + (16 * c) * 33 + n;
        f32x4 a0 = (f32x4){s[0 * 33], s[1 * 33], s[2 * 33], s[3 * 33]} * WSCALE, a1 = (f32x4){s[4 * 33], s[5 * 33], s[6 * 33], s[7 * 33]} * WSCALE;
        f32x4 a2 = (f32x4){s[8 * 33], s[9 * 33], s[10 * 33], s[11 * 33]} * WSCALE, a3 = (f32x4){s[12 * 33], s[13 * 33], s[14 * 33], s[15 * 33]} * WSCALE;
        const u32x2 lo = pk8(a0, a1), hi = pk8(a2, a3);
        int dr = drow0 + n; if (PERM16) { const int r = dr & 255; dr = (dr & ~255) + 128 * ((r >> 3) & 1) + 8 * (r >> 4) + (r & 7); }
        *(u32x4*)(WT8 + (size_t)dr * ldt + k0 + 16 * c) = (u32x4){lo.x, lo.y, hi.x, hi.y}; }
    LDS_WAIT(); asm volatile("" ::: "memory");
}
__device__ __forceinline__ void phase_expert_weights(const float* w1, const float* w3, const float* w2, unsigned char* ws, LAS unsigned char* lds, int gw, int NGW, int wave, int lane) {
    LAS float* scr = (LAS float*)(lds + wave * 16896);
    constexpr int PER = 64;
    for (int it = gw; it < NE * 3 * PER; it += NGW) {
        const int e = it / (3 * PER), r = it % (3 * PER), which = r / PER, item = r % PER;
        if (which < 2) { const int kb = item >> 3, nb = item & 7, n0 = 32 * nb;
            transpose_item128_f8<false>((which ? w3 : w1) + (size_t)e * D * EFF, EFF, 128 * kb, n0, ws + B_W13 + (size_t)e * 512 * D, D, 256 * (n0 >> 7) + which * 128 + (n0 & 127), scr, lane); }
        else { const int kb = item >> 5, nb = item & 31;
            transpose_item128_f8<true>(w2 + (size_t)e * EFF * D, D, 128 * kb, 32 * nb, ws + B_W2 + (size_t)e * D * EFF, EFF, 32 * nb, scr, lane); }
    }
}
template <bool XBF>
__device__ __forceinline__ void phase_norm_mod(const void* X, const float* gain, const float* mod, int sh_off, int sc_off, bf16_t* out, unsigned char* out8, int gw, int NGW, int lane) {
    constexpr int R = XBF ? 4 : 8;
    for (int m0 = gw; m0 < T; m0 += R * NGW) {
        f32x4 v[R][4];
#pragma unroll
        for (int rr = 0; rr < R; ++rr) { const int m = m0 + rr * NGW; const size_t mr = (size_t)(m < T ? m : m0);
            if constexpr (XBF) { const u32x2* xr = (const u32x2*)((const bf16_t*)X + mr * D) + lane;
#pragma unroll
                for (int j = 0; j < 4; ++j) { const u32x2 w = xr[64 * j]; v[rr][j] = (f32x4){bflo(w.x), bfhi(w.x), bflo(w.y), bfhi(w.y)}; } }
            else { const f32x4* xr = (const f32x4*)((const float*)X + mr * D) + lane;
#pragma unroll
                for (int j = 0; j < 4; ++j) v[rr][j] = xr[64 * j]; } }
#pragma unroll
        for (int rr = 0; rr < R; ++rr) { const int m = m0 + rr * NGW; if (m >= T) break;
            float ss = 0.f;
#pragma unroll
            for (int j = 0; j < 4; ++j) ss += (v[rr][j].x * v[rr][j].x + v[rr][j].y * v[rr][j].y) + (v[rr][j].z * v[rr][j].z + v[rr][j].w * v[rr][j].w);
            const float rstd = __builtin_amdgcn_rsqf(wave_sum(ss) * (1.f / D) + 1e-6f);
            const float* mb = mod + (size_t)(m >> 13) * 6144;
            u32x2* o8 = (u32x2*)(out + (size_t)m * D) + lane;
#pragma unroll
            for (int j = 0; j < 4; ++j) { const int col = 4 * lane + 256 * j;
                const f32x4 g = *(const f32x4*)(gain + col), sc = *(const f32x4*)(mb + sc_off + col), sh = *(const f32x4*)(mb + sh_off + col);
                const f32x4 y = v[rr][j] * rstd * g * (sc + 1.0f) + sh;
                if (out) { u32x2 w; w.x = pk2(y.x, y.y); w.y = pk2(y.z, y.w); o8[64 * j] = w; }
                if (out8) { int t8 = __builtin_amdgcn_cvt_pk_fp8_f32(y.x, y.y, 0, false); t8 = __builtin_amdgcn_cvt_pk_fp8_f32(y.z, y.w, t8, true); *(unsigned*)(out8 + (size_t)m * D + col) = (unsigned)t8; } } }
    }
}
struct YaArgs { bf16_t* ya; const bf16_t* g; const bf16_t* prw; const float* sbon; const float* mu; const float* ln_g; const float* ln_b; };
__device__ __forceinline__ void phase_ya_final(const YaArgs& P, int gw, int NGW, int lane) {
    const int ch0 = lane * 8, head = lane >> 3;
    float muv[8], lg[8], lb[8];
#pragma unroll
    for (int j = 0; j < 8; ++j) { muv[j] = P.mu[1024 + ch0 + j]; lg[j] = P.ln_g[ch0 + j]; lb[j] = P.ln_b[ch0 + j]; }
    for (int m = gw; m < T; m += NGW) {
        const u32x4 yw = *(const u32x4*)(P.ya + (size_t)m * RW + ch0);
        const u32x4 gw4 = *(const u32x4*)(P.g + (size_t)m * RW + ch0);
        const u32x4 vc = *(const u32x4*)(P.prw + (size_t)m * RWKV_COLS + 1024 + ch0);
        u32x4 vp = (u32x4){0u, 0u, 0u, 0u};
        if ((m & (SEQ - 1)) != 0) vp = *(const u32x4*)(P.prw + (size_t)(m - 1) * RWKV_COLS + 1024 + ch0);
        const float sb = P.sbon[(size_t)m * NH + head];
        float y[8], gg[8], vv[8], pv[8];
        y[0] = bflo(yw.x); y[1] = bfhi(yw.x); y[2] = bflo(yw.y); y[3] = bfhi(yw.y); y[4] = bflo(yw.z); y[5] = bfhi(yw.z); y[6] = bflo(yw.w); y[7] = bfhi(yw.w);
        gg[0] = bflo(gw4.x); gg[1] = bfhi(gw4.x); gg[2] = bflo(gw4.y); gg[3] = bfhi(gw4.y); gg[4] = bflo(gw4.z); gg[5] = bfhi(gw4.z); gg[6] = bflo(gw4.w); gg[7] = bfhi(gw4.w);
        vv[0] = bflo(vc.x); vv[1] = bfhi(vc.x); vv[2] = bflo(vc.y); vv[3] = bfhi(vc.y); vv[4] = bflo(vc.z); vv[5] = bfhi(vc.z); vv[6] = bflo(vc.w); vv[7] = bfhi(vc.w);
        pv[0] = bflo(vp.x); pv[1] = bfhi(vp.x); pv[2] = bflo(vp.y); pv[3] = bfhi(vp.y); pv[4] = bflo(vp.z); pv[5] = bfhi(vp.z); pv[6] = bflo(vp.w); pv[7] = bfhi(vp.w);
        float s = 0.f;
#pragma unroll
        for (int j = 0; j < 8; ++j) s += y[j];
        s += __shfl_xor(s, 1); s += __shfl_xor(s, 2); s += __shfl_xor(s, 4);
        const float mean = s * (1.f / 64.f); float q = 0.f;
#pragma unroll
        for (int j = 0; j < 8; ++j) { y[j] -= mean; q += y[j] * y[j]; }
        q += __shfl_xor(q, 1); q += __shfl_xor(q, 2); q += __shfl_xor(q, 4);
        const float rstd = __builtin_amdgcn_rsqf(q * (1.f / 64.f) + 64e-5f);
        float o[8];
#pragma unroll
        for (int j = 0; j < 8; ++j) { const float vs = vv[j] + (pv[j] - vv[j]) * muv[j]; o[j] = (y[j] * rstd * lg[j] + lb[j] + sb * vs) * gg[j]; }
        u32x4 w; w.x = pk2(o[0], o[1]); w.y = pk2(o[2], o[3]); w.z = pk2(o[4], o[5]); w.w = pk2(o[6], o[7]);
        *(u32x4*)(P.ya + (size_t)m * RW + ch0) = w;
    }
}
__device__ __forceinline__ void phase_xs(const bf16_t* prw, const float* mu, bf16_t* xs, int gw, int NGW, int lane) {
    const f32x4 m4 = *(const f32x4*)(mu + 1536 + 4 * lane);
    for (int t = gw; t < T; t += NGW) {
        const bf16_t* src = prw + (size_t)t * RWKV_COLS + 1536 + 4 * lane;
        const u32x2 cw = *(const u32x2*)src; u32x2 pw = (u32x2){0u, 0u};
        if ((t & (SEQ - 1)) != 0) pw = *(const u32x2*)(src - RWKV_COLS);
        f32x4 v = (f32x4){bflo(cw.x), bfhi(cw.x), bflo(cw.y), bfhi(cw.y)}; const f32x4 p = (f32x4){bflo(pw.x), bfhi(pw.x), bflo(pw.y), bfhi(pw.y)};
        v = v + (p - v) * m4;
        if (lane < 16) {
#pragma unroll
            for (int j = 0; j < 4; ++j) v[j] = tanhf_(v[j]); }
        else if (lane >= 32) {
#pragma unroll
            for (int j = 0; j < 4; ++j) v[j] = sigmoidf_(v[j]); }
        u32x2 w; w.x = pk2(v[0], v[1]); w.y = pk2(v[2], v[3]);
        *(u32x2*)(xs + (size_t)t * 256 + 4 * lane) = w;
    }
}
__device__ __forceinline__ void phase_combine(float* out, const bf16_t* x1, const unsigned char* slot, const unsigned char* sho, const float* mod, const float* normf, int gw, int NGW, int lane) {
    for (int m = gw; m < T; m += NGW) {
        const int b = m >> 13;
        f32x4* xr = (f32x4*)(out + (size_t)m * D + 16 * lane);
        const float* g2 = mod + (size_t)b * 6144 + 5120 + 16 * lane;
        u32x4 sw[TOPK + 1];
#pragma unroll
        for (int k = 0; k < TOPK; ++k) sw[k] = *(const u32x4*)(slot + ((size_t)m * TOPK + k) * D + 16 * lane);
        sw[TOPK] = *(const u32x4*)(sho + (size_t)m * D + 16 * lane);
        f32x4 x[4];
        { const u32x4 w0 = *(const u32x4*)(x1 + (size_t)m * D + 16 * lane), w1 = *(const u32x4*)(x1 + (size_t)m * D + 16 * lane + 8);
          x[0] = (f32x4){bflo(w0.x), bfhi(w0.x), bflo(w0.y), bfhi(w0.y)}; x[1] = (f32x4){bflo(w0.z), bfhi(w0.z), bflo(w0.w), bfhi(w0.w)};
          x[2] = (f32x4){bflo(w1.x), bfhi(w1.x), bflo(w1.y), bfhi(w1.y)}; x[3] = (f32x4){bflo(w1.z), bfhi(w1.z), bflo(w1.w), bfhi(w1.w)}; }
        f32x4 a[4];
#pragma unroll
        for (int j = 0; j < 4; ++j) a[j] = (f32x4){0.f, 0.f, 0.f, 0.f};
#pragma unroll
        for (int k = 0; k <= TOPK; ++k) { a[0] += up8(sw[k].x); a[1] += up8(sw[k].y); a[2] += up8(sw[k].z); a[3] += up8(sw[k].w); }
        float ss = 0.f;
#pragma unroll
        for (int j = 0; j < 4; ++j) { x[j] = x[j] + *(const f32x4*)(g2 + 4 * j) * a[j]; ss += (x[j].x * x[j].x + x[j].y * x[j].y) + (x[j].z * x[j].z + x[j].w * x[j].w); }
        const float rstd = __builtin_amdgcn_rsqf(wave_sum(ss) * (1.f / D) + 1e-6f);
#pragma unroll
        for (int j = 0; j < 4; ++j) xr[j] = x[j] * rstd * *(const f32x4*)(normf + 16 * lane + 4 * j);
    }
}
namespace rk {
constexpr int LD = 80;
constexpr int SLOTB = 64 * LD * 2;
constexpr int LDG = 136;
typedef LAS bf16_t* lp;
__device__ __forceinline__ lp slot(LAS unsigned char* lds, int i) { return (lp)(lds + i * SLOTB); }
template <int KS>
__device__ __forceinline__ void mm_nt(const LAS bf16_t* X, int ldx, const LAS bf16_t* Y, int ldy, int m, int nt0, int r, int q, f32x4 (&acc)[2]) {
#pragma unroll
    for (int s = 0; s < KS; ++s) {
        const bf16x8 a = *(const LAS bf16x8*)(X + (16 * m + r) * ldx + 32 * s + 8 * q);
#pragma unroll
        for (int n = 0; n < 2; ++n) { const bf16x8 b = *(const LAS bf16x8*)(Y + (16 * (nt0 + n) + r) * ldy + 32 * s + 8 * q); acc[n] = __builtin_amdgcn_mfma_f32_16x16x32_bf16(a, b, acc[n], 0, 0, 0); }
    }
}
__device__ __forceinline__ void st_rm(lp dst, int m, int nt, int r, int q, const f32x4& a) {
#pragma unroll
    for (int ii = 0; ii < 4; ++ii) dst[(16 * m + 4 * q + ii) * LD + 16 * nt + r] = f2bf(a[ii]);
}
__device__ __forceinline__ void st_tr(lp dst, int m, int nt, int r, int q, const f32x4& a) {
    u32x2 w; w.x = pk2(a[0], a[1]); w.y = pk2(a[2], a[3]); *(LAS u32x2*)(dst + (16 * nt + r) * LD + 16 * m + 4 * q) = w;
}
__device__ __forceinline__ void ld_rm(const LAS bf16_t* src, int m, int nt, int r, int q, f32x4& a) {
#pragma unroll
    for (int ii = 0; ii < 4; ++ii) a[ii] = bf2f(src[(16 * m + 4 * q + ii) * LD + 16 * nt + r]);
}
struct Args {
    const bf16_t* prw; const float* mu; const float *w0, *a0, *k_k, *k_a, *r_k;
    const bf16_t *wup, *aup, *gup;
    const bf16_t* xs;
    bf16_t* g; bf16_t* bv; unsigned char* mn; unsigned char* qy;
};
constexpr int LDS_MU = LDS_MISC + 2304;
struct Pre { u32x4 cw[3], pw[3]; bf16x8 xs[8]; };
__device__ __forceinline__ void task_map(int task, int h, int& i, int& ch, int& col) {
    i = task / 24; ch = task % 24;
    col = (ch >> 3) * 512 + h * 64 + 8 * (ch & 7);
}
__device__ __forceinline__ void load_mu(const Args& P, LAS unsigned char* lds, int tid) {
    LAS bf16_t* MU = (LAS bf16_t*)(lds + LDS_MU);
    for (int i = tid; i < 1536; i += NTHREADS) MU[i] = f2bf(P.mu[i]);
    __syncthreads();
}
__device__ __forceinline__ void prefetch(const Args& P, int b, int h, int c, int tid, Pre& pre) {
    const int t0 = b * SEQ + c * 64;
#pragma unroll
    for (int it = 0; it < 3; ++it) {
        int i, ch, col; task_map(tid + it * NTHREADS, h, i, ch, col);
        const bf16_t* src = P.prw + (size_t)(t0 + i) * RWKV_COLS + col;
        pre.cw[it] = *(const u32x4*)src;
        pre.pw[it] = (u32x4){0u, 0u, 0u, 0u};
        if (i != 0 || c != 0) pre.pw[it] = *(const u32x4*)(src - RWKV_COLS);
    }
    const int lane = tid & 63, r = lane & 15, q = lane >> 4, m = (tid >> 6) & 3;
    const bf16_t* xr = P.xs + (size_t)(t0 + 16 * m + r) * 256 + 8 * q;
#pragma unroll
    for (int f = 0; f < 8; ++f) pre.xs[f] = *(const bf16x8*)(xr + 32 * f);
}
__device__ __forceinline__ void unit(const Args& P, LAS unsigned char* lds, int b, int h, int c, int uidx, int tid, Pre& pf, bool has_next, int nb, int nh_, int nc) {
    const int wave = __builtin_amdgcn_readfirstlane(tid >> 6), lane = tid & 63, r = lane & 15, q = lane >> 4, m = wave & 3, nh = wave >> 2;
    const int t0 = b * SEQ + c * 64;
    lp S0 = slot(lds, 0), S1 = slot(lds, 1), S2 = slot(lds, 2), S3 = slot(lds, 3), S4 = slot(lds, 4), S5 = slot(lds, 5), S6 = slot(lds, 6), S7 = slot(lds, 7);
    lp S8 = slot(lds, 8), S9 = slot(lds, 9), S10 = slot(lds, 10), S11 = slot(lds, 11), S12 = slot(lds, 12), S13 = slot(lds, 13), S14 = slot(lds, 14);
    LAS float* PART = (LAS float*)(lds + LDS_MISC);
    LAS float* CT = PART + 256;
    LAS float* DEND = CT + 256;
    const LAS bf16_t* MU = (const LAS bf16_t*)(lds + LDS_MU);
#define RK_BAR() do { asm volatile("s_waitcnt lgkmcnt(0)" ::: "memory"); __builtin_amdgcn_s_barrier(); asm volatile("" ::: "memory"); } while (0)
#define RK_DBG(bit, sp) do {} while (0)
#pragma unroll
    for (int it = 0; it < 3; ++it) {
        int i, ch, col; task_map(tid + it * NTHREADS, h, i, ch, col);
        LAS bf16_t* dst = slot(lds, 8 + (ch >> 3)) + i * LD + 8 * (ch & 7);
        const u32x4 cw = pf.cw[it], pw = pf.pw[it];
        const u32x4 mw = *(const LAS u32x4*)(MU + col);
        const f32x4 m0 = (f32x4){bflo(mw.x), bfhi(mw.x), bflo(mw.y), bfhi(mw.y)}, m1 = (f32x4){bflo(mw.z), bfhi(mw.z), bflo(mw.w), bfhi(mw.w)};
        float v[8], p[8];
        v[0] = bflo(cw.x); v[1] = bfhi(cw.x); v[2] = bflo(cw.y); v[3] = bfhi(cw.y); v[4] = bflo(cw.z); v[5] = bfhi(cw.z); v[6] = bflo(cw.w); v[7] = bfhi(cw.w);
        p[0] = bflo(pw.x); p[1] = bfhi(pw.x); p[2] = bflo(pw.y); p[3] = bfhi(pw.y); p[4] = bflo(pw.z); p[5] = bfhi(pw.z); p[6] = bflo(pw.w); p[7] = bfhi(pw.w);
#pragma unroll
        for (int j = 0; j < 4; ++j) { v[j] += (p[j] - v[j]) * m0[j]; v[4 + j] += (p[4 + j] - v[4 + j]) * m1[j]; }
        u32x4 w; w.x = pk2(v[0], v[1]); w.y = pk2(v[2], v[3]); w.z = pk2(v[4], v[5]); w.w = pk2(v[6], v[7]);
        *(LAS u32x4*)dst = w;
    }
    RK_BAR();
    f32x4 aw[2], aa[2], ag[2];
#pragma unroll
    for (int n = 0; n < 2; ++n) { aw[n] = (f32x4){0.f, 0.f, 0.f, 0.f}; aa[n] = aw[n]; ag[n] = aw[n]; }
#pragma unroll
    for (int s = 0; s < 2; ++s) {
#pragma unroll
        for (int n = 0; n < 2; ++n) { const int row = h * 64 + 16 * (2 * nh + n) + r;
            const bf16x8 bw = *(const bf16x8*)(P.wup + (size_t)row * 64 + 32 * s + 8 * q), ba = *(const bf16x8*)(P.aup + (size_t)row * 64 + 32 * s + 8 * q);
            aw[n] = __builtin_amdgcn_mfma_f32_16x16x32_bf16(pf.xs[s], bw, aw[n], 0, 0, 0); aa[n] = __builtin_amdgcn_mfma_f32_16x16x32_bf16(pf.xs[2 + s], ba, aa[n], 0, 0, 0); }
    }
#pragma unroll
    for (int s = 0; s < 4; ++s) {
#pragma unroll
        for (int n = 0; n < 2; ++n) { const int row = h * 64 + 16 * (2 * nh + n) + r;
            const bf16x8 bg = *(const bf16x8*)(P.gup + (size_t)row * 128 + 32 * s + 8 * q);
            ag[n] = __builtin_amdgcn_mfma_f32_16x16x32_bf16(pf.xs[4 + s], bg, ag[n], 0, 0, 0); }
    }
    if (has_next) prefetch(P, nb, nh_, nc, tid, pf);
    float rr[2][4], kq[2][4], vv[2][4], av[2][4], lw[2][4], kp[2][4], pre[2][4], preq[2];
    float ss[4] = {0.f, 0.f, 0.f, 0.f}, bs[4] = {0.f, 0.f, 0.f, 0.f};
#pragma unroll
    for (int n = 0; n < 2; ++n) {
        const int ch = 32 * nh + 16 * n + r, chg = h * 64 + ch;
        const float w0v = P.w0[chg], a0v = P.a0[chg], kkc = P.k_k[chg], kac = P.k_a[chg], rkc = P.r_k[chg];
#pragma unroll
        for (int ii = 0; ii < 4; ++ii) {
            const int pos = 16 * m + 4 * q + ii;
            const float rv = bf2f(S8[pos * LD + ch]), kraw = bf2f(S9[pos * LD + ch]); vv[n][ii] = bf2f(S10[pos * LD + ch]); rr[n][ii] = rv;
            const float z = -(w0v + aw[n][ii]);
            const float sp = fmaxf(z, 0.f) + flog(1.0f + fexp(-fabsf(z)));
            lw[n][ii] = -fexp(-sp - 0.5f);
            const float a_ = sigmoidf_(a0v + aa[n][ii]); av[n][ii] = a_;
            P.g[(size_t)(t0 + pos) * RW + chg] = f2bf(ag[n][ii]);
            const float kk = kraw * kkc; kq[n][ii] = kk;
            const float kpv = kraw * (1.0f + (a_ - 1.0f) * kac); kp[n][ii] = kpv;
            ss[ii] += kk * kk; bs[ii] += rv * kpv * rkc;
        }
        pre[n][0] = lw[n][0]; pre[n][1] = pre[n][0] + lw[n][1]; pre[n][2] = pre[n][1] + lw[n][2]; pre[n][3] = pre[n][2] + lw[n][3];
        const float tot = pre[n][3];
        const float t0_ = __shfl(tot, r), t1_ = __shfl(tot, r + 16), t2_ = __shfl(tot, r + 32), t3_ = __shfl(tot, r + 48);
        preq[n] = (q > 0 ? t0_ : 0.f) + (q > 1 ? t1_ : 0.f) + (q > 2 ? t2_ : 0.f);
        if (q == 0) CT[m * 64 + ch] = (t0_ + t1_) + (t2_ + t3_);
    }
#pragma unroll
    for (int ii = 0; ii < 4; ++ii) {
#pragma unroll
        for (int o = 1; o < 16; o <<= 1) { ss[ii] += __shfl_xor(ss[ii], o); bs[ii] += __shfl_xor(bs[ii], o); }
        if (r == 0) { const int pos = 16 * m + 4 * q + ii; PART[(nh * 64 + pos) * 2] = ss[ii]; PART[(nh * 64 + pos) * 2 + 1] = bs[ii]; }
    }
    RK_BAR();
#pragma unroll
    for (int n = 0; n < 2; ++n) {
        const int ch = 32 * nh + 16 * n + r;
        float carry = 0.f, lend = 0.f;
#pragma unroll
        for (int mm = 0; mm < 4; ++mm) { const float cv = CT[mm * 64 + ch]; lend += cv; carry += (mm < m) ? cv : 0.f; }
        f32x4 tA, tBh, tKh, tV;
#pragma unroll
        for (int ii = 0; ii < 4; ++ii) {
            const int pos = 16 * m + 4 * q + ii;
            const float L = carry + preq[n] + pre[n][ii], Lm1 = L - lw[n][ii];
            const float ssum = PART[pos * 2] + PART[(64 + pos) * 2];
            const float inv = frcp(fmaxf(__builtin_sqrtf(ssum), 1e-12f));
            const float kkn = kq[n][ii] * inv, kb = kkn * av[n][ii];
            const float eN = fexp(-L), eE = fexp(lend - L);
            const float At = -kkn * fexp(Lm1), Rt = rr[n][ii] * fexp(L), Bt = kb * eN, Kt = kp[n][ii] * eN;
            S0[pos * LD + ch] = f2bf(At); S1[pos * LD + ch] = f2bf(Bt); S2[pos * LD + ch] = f2bf(Kt); S3[pos * LD + ch] = f2bf(Rt);
            tA[ii] = At; tBh[ii] = kb * eE; tKh[ii] = kp[n][ii] * eE; tV[ii] = vv[n][ii];
            P.bv[(size_t)(t0 + pos) * RW + h * 64 + ch] = f2bf((PART[pos * 2 + 1] + PART[(64 + pos) * 2 + 1]) * vv[n][ii]);
        }
        { u32x2 w; const int off = ch * LD + 16 * m + 4 * q;
          w.x = pk2(tA[0], tA[1]); w.y = pk2(tA[2], tA[3]); *(LAS u32x2*)(S4 + off) = w;
          w.x = pk2(tBh[0], tBh[1]); w.y = pk2(tBh[2], tBh[3]); *(LAS u32x2*)(S5 + off) = w;
          w.x = pk2(tKh[0], tKh[1]); w.y = pk2(tKh[2], tKh[3]); *(LAS u32x2*)(S6 + off) = w;
          w.x = pk2(tV[0], tV[1]); w.y = pk2(tV[2], tV[3]); *(LAS u32x2*)(S7 + off) = w; }
        if (m == 0 && q == 0) DEND[ch] = fexp(lend);
    }
    RK_BAR();
    RK_DBG(0, S0); RK_DBG(1, S1); RK_DBG(2, S2); RK_DBG(3, S3); RK_DBG(4, S4); RK_DBG(5, S5); RK_DBG(6, S6); RK_DBG(7, S7);
    const int nt0 = 2 * nh;
    f32x4 acc[2], acc2[2];
#define RK_ZERO(a) do { a[0] = (f32x4){0.f, 0.f, 0.f, 0.f}; a[1] = a[0]; } while (0)
#define RK_LDT(src, mt, ntt, a) do { const u32x2 w_ = *(const LAS u32x2*)((src) + (16 * (ntt) + r) * LD + 16 * (mt) + 4 * q); a = (f32x4){bflo(w_.x), bfhi(w_.x), bflo(w_.y), bfhi(w_.y)}; } while (0)
#define RK_MASK(a, ntt, COND) do { _Pragma("unroll") for (int ii = 0; ii < 4; ++ii) { const int row = 16 * m + 4 * q + ii, col = 16 * (ntt) + r; a[ii] = (COND) ? a[ii] : 0.f; } } while (0)
    RK_ZERO(acc); mm_nt<2>(S0, LD, S1, LD, m, nt0, r, q, acc);
#pragma unroll
    for (int n = 0; n < 2; ++n) { RK_MASK(acc[n], nt0 + n, col < row); st_tr(S9, m, nt0 + n, r, q, acc[n]); }
    RK_ZERO(acc); mm_nt<2>(S1, LD, S0, LD, m, nt0, r, q, acc);
#pragma unroll
    for (int n = 0; n < 2; ++n) { RK_MASK(acc[n], nt0 + n, row < col); st_tr(S8, m, nt0 + n, r, q, acc[n]);
#pragma unroll
        for (int ii = 0; ii < 4; ++ii) acc[n][ii] += ((16 * m + 4 * q + ii) == (16 * (nt0 + n) + r)) ? 1.f : 0.f;
        st_tr(S10, m, nt0 + n, r, q, acc[n]); }
    RK_ZERO(acc); mm_nt<2>(S2, LD, S0, LD, m, nt0, r, q, acc);
#pragma unroll
    for (int n = 0; n < 2; ++n) { RK_MASK(acc[n], nt0 + n, row < col); st_tr(S11, m, nt0 + n, r, q, acc[n]); }
    RK_ZERO(acc); mm_nt<2>(S1, LD, S3, LD, m, nt0, r, q, acc);
#pragma unroll
    for (int n = 0; n < 2; ++n) { RK_MASK(acc[n], nt0 + n, row <= col); st_tr(S12, m, nt0 + n, r, q, acc[n]); }
    RK_ZERO(acc); mm_nt<2>(S2, LD, S3, LD, m, nt0, r, q, acc);
#pragma unroll
    for (int n = 0; n < 2; ++n) { RK_MASK(acc[n], nt0 + n, row <= col); st_tr(S13, m, nt0 + n, r, q, acc[n]); }
    RK_BAR();
    RK_ZERO(acc); mm_nt<2>(S8, LD, S9, LD, m, nt0, r, q, acc);
    RK_ZERO(acc2); mm_nt<2>(S9, LD, S8, LD, m, nt0, r, q, acc2);
#pragma unroll
    for (int n = 0; n < 2; ++n) { st_tr(S1, m, nt0 + n, r, q, acc[n]); st_tr(S0, m, nt0 + n, r, q, acc2[n]); }
    RK_ZERO(acc); mm_nt<2>(S11, LD, S7, LD, m, nt0, r, q, acc);
#pragma unroll
    for (int n = 0; n < 2; ++n) st_tr(S14, m, nt0 + n, r, q, acc[n]);
    RK_BAR();
#define RK_ROUND(Tsrc, Tdst, Psrc, PTsrc, Pdst, PTdst) do { \
        RK_LDT(Tsrc, m, nt0, acc[0]); RK_LDT(Tsrc, m, nt0 + 1, acc[1]); mm_nt<2>(PTsrc, LD, Tsrc, LD, m, nt0, r, q, acc); \
        _Pragma("unroll") for (int n = 0; n < 2; ++n) st_tr(Tdst, m, nt0 + n, r, q, acc[n]); \
        RK_ZERO(acc); mm_nt<2>(Psrc, LD, PTsrc, LD, m, nt0, r, q, acc); RK_ZERO(acc2); mm_nt<2>(PTsrc, LD, Psrc, LD, m, nt0, r, q, acc2); \
        _Pragma("unroll") for (int n = 0; n < 2; ++n) { st_tr(PTdst, m, nt0 + n, r, q, acc[n]); st_tr(Pdst, m, nt0 + n, r, q, acc2[n]); } \
        RK_BAR(); } while (0)
#ifndef EXP_SKIP_ROUNDS
    RK_ROUND(S10, S2, S0, S1, S8, S9);
    RK_ROUND(S2, S10, S8, S9, S0, S1);
    RK_ROUND(S10, S2, S0, S1, S8, S9);
    RK_ROUND(S2, S10, S8, S9, S0, S1);
#endif
    RK_LDT(S10, m, nt0, acc[0]); RK_LDT(S10, m, nt0 + 1, acc[1]); mm_nt<2>(S1, LD, S10, LD, m, nt0, r, q, acc);
#pragma unroll
    for (int n = 0; n < 2; ++n) st_tr(S2, m, nt0 + n, r, q, acc[n]);
    RK_BAR();
    RK_ZERO(acc); mm_nt<2>(S2, LD, S4, LD, m, nt0, r, q, acc);
    RK_ZERO(acc2); mm_nt<2>(S2, LD, S14, LD, m, nt0, r, q, acc2);
#pragma unroll
    for (int n = 0; n < 2; ++n) { st_tr(S11, m, nt0 + n, r, q, acc[n]); st_tr(S0, m, nt0 + n, r, q, acc2[n]); }
    RK_BAR();
    {
        const int sw = wave & 1, ntw = wave >> 1;
        unsigned char* mn_ = P.mn + (size_t)uidx * 16384; unsigned char* qy_ = P.qy + (size_t)uidx * 16384;
        f32x4 c2[2];
#define RK_MM2(X, Y) do { _Pragma("unroll") for (int s_ = 0; s_ < 2; ++s_) { const bf16x8 b_ = *(const LAS bf16x8*)((Y) + (16 * ntw + r) * LD + 32 * s_ + 8 * q); \
            _Pragma("unroll") for (int mi = 0; mi < 2; ++mi) { const bf16x8 a_ = *(const LAS bf16x8*)((X) + (16 * (2 * sw + mi) + r) * LD + 32 * s_ + 8 * q); c2[mi] = __builtin_amdgcn_mfma_f32_16x16x32_bf16(a_, b_, c2[mi], 0, 0, 0); } } } while (0)
        RK_ZERO(c2); RK_MM2(S11, S5);
#pragma unroll
        for (int mi = 0; mi < 2; ++mi)
#pragma unroll
            for (int ii = 0; ii < 4; ++ii) { const int row = 16 * (2 * sw + mi) + 4 * q + ii, col = 16 * ntw + r; c2[mi][ii] += (row == col) ? DEND[row] : 0.f; }
        { u32x4 w; w.x = pk2(c2[0][0], c2[0][1]); w.y = pk2(c2[0][2], c2[0][3]); w.z = pk2(c2[1][0], c2[1][1]); w.w = pk2(c2[1][2], c2[1][3]); *(u32x4*)(mn_ + ((ntw * 2 + sw) * 64 + lane) * 16) = w; }
#pragma unroll
        for (int mi = 0; mi < 2; ++mi) { const u32x2 rw_ = *(const LAS u32x2*)(S3 + (16 * ntw + r) * LD + 16 * (2 * sw + mi) + 4 * q); c2[mi] = (f32x4){bflo(rw_.x), bfhi(rw_.x), bflo(rw_.y), bfhi(rw_.y)}; }
        RK_MM2(S11, S12);
        { u32x4 w; w.x = pk2(c2[0][0], c2[0][1]); w.y = pk2(c2[0][2], c2[0][3]); w.z = pk2(c2[1][0], c2[1][1]); w.w = pk2(c2[1][2], c2[1][3]); *(u32x4*)(qy_ + ((ntw * 2 + sw) * 64 + lane) * 16) = w; }
        RK_ZERO(c2); RK_MM2(S5, S0); RK_MM2(S6, S7);
#pragma unroll
        for (int mi = 0; mi < 2; ++mi) { u32x2 w; w.x = pk2(c2[mi][0], c2[mi][1]); w.y = pk2(c2[mi][2], c2[mi][3]); *(u32x2*)(mn_ + 8192 + ((ntw * 4 + 2 * sw + mi) * 64 + lane) * 8) = w; }
        RK_ZERO(c2); RK_MM2(S0, S12); RK_MM2(S7, S13);
#pragma unroll
        for (int mi = 0; mi < 2; ++mi) { u32x2 w; w.x = pk2(c2[mi][0], c2[mi][1]); w.y = pk2(c2[mi][2], c2[mi][3]); *(u32x2*)(qy_ + 8192 + (((2 * sw + mi) * 4 + ntw) * 64 + lane) * 8) = w; }
#undef RK_MM2
    }
    RK_BAR();
#undef RK_ZERO
#undef RK_ROUND
#undef RK_LDT
#undef RK_MASK
#undef RK_BAR
}
__device__ __forceinline__ void scan_wg(const unsigned char* mn, unsigned char* sbuf, int ubase, int vq, LAS unsigned char* lds, int tid) {
    const int wave = __builtin_amdgcn_readfirstlane(tid >> 6), lane = tid & 63;
    constexpr int NC = SEQ / 64, NS = 8, SLOT = 10240, AHEAD = 6;
    const unsigned char* src = mn + (size_t)ubase * 16384 + lane * 16;
    const bool loader = (wave >= 1 && wave <= 5);
    const size_t poff = (wave == 5) ? (size_t)(8192 + vq * 2048) : (size_t)(2048 * (wave - 1));
#define SC_ISSUE(c) do { const unsigned char* s_ = src + (size_t)(c) * 16384 + poff; LAS unsigned char* d_ = lds + ((c) % NS) * SLOT + 2048 * (wave - 1); \
        _Pragma("unroll") for (int i_ = 0; i_ < 2; ++i_) __builtin_amdgcn_global_load_lds((const unsigned*)(s_ + i_ * 1024), (LAS unsigned*)(d_ + i_ * 1024), 16, 0, 0); } while (0)
#define SC_BAR() do { asm volatile("s_waitcnt lgkmcnt(0)" ::: "memory"); __builtin_amdgcn_s_barrier(); asm volatile("" ::: "memory"); } while (0)
    bf16x8 sB[2];
#pragma unroll
    for (int s = 0; s < 2; ++s) sB[s] = (bf16x8){0, 0, 0, 0, 0, 0, 0, 0};
    if (loader) {
#pragma unroll
        for (int c = 0; c < AHEAD; ++c) SC_ISSUE(c);
        asm volatile("s_waitcnt vmcnt(10)" ::: "memory"); }
    SC_BAR();
    for (int c = 0; c < NC; ++c) {
        if (loader) {
            if (c + AHEAD < NC) { SC_ISSUE(c + AHEAD); asm volatile("s_waitcnt vmcnt(10)" ::: "memory"); }
            else { asm volatile("s_waitcnt vmcnt(0)" ::: "memory"); }
        } else if (wave == 0) {
            const LAS unsigned char* sl = lds + (c % NS) * SLOT;
            unsigned char* so = sbuf + (size_t)(ubase + c) * 8192 + (vq * 2) * 1024 + lane * 16;
            *(bf16x8*)so = sB[0]; *(bf16x8*)(so + 1024) = sB[1];
            f32x4 aS[4];
#pragma unroll
            for (int mm = 0; mm < 4; ++mm) {
                const u32x2 nI = *(const LAS u32x2*)(sl + 8192 + (mm * 64 + lane) * 8);
                aS[mm] = (f32x4){bflo(nI.x), bfhi(nI.x), bflo(nI.y), bfhi(nI.y)};
#pragma unroll
                for (int s = 0; s < 2; ++s) { const bf16x8 aM = *(const LAS bf16x8*)(sl + ((mm * 2 + s) * 64 + lane) * 16); aS[mm] = __builtin_amdgcn_mfma_f32_16x16x32_bf16(aM, sB[s], aS[mm], 0, 0, 0); }
            }
#pragma unroll
            for (int s = 0; s < 2; ++s) { u32x4 w; w.x = pk2(aS[2 * s][0], aS[2 * s][1]); w.y = pk2(aS[2 * s][2], aS[2 * s][3]); w.z = pk2(aS[2 * s + 1][0], aS[2 * s + 1][1]); w.w = pk2(aS[2 * s + 1][2], aS[2 * s + 1][3]);
                sB[s] = __builtin_bit_cast(bf16x8, w); }
        }
        SC_BAR();
    }
#undef SC_ISSUE
#undef SC_BAR
}
struct YArgs { const unsigned char* qy; const unsigned char* sbuf; const bf16_t* g; const bf16_t* bv; const float* ln_g; const float* ln_b; unsigned char* ya; };
__device__ __forceinline__ void ypass_unit(const YArgs& P, int u, int lane) {
    const int r = lane & 15, q = lane >> 4, b = u >> 10, h = (u >> 7) & 7, c = u & 127, t0 = b * SEQ + c * 64;
    const unsigned char* qy_ = P.qy + (size_t)u * 16384; const unsigned char* s_ = P.sbuf + (size_t)u * 8192;
    bf16x8 Qf[4][2], Sf[4][2]; u32x2 y0[4][4];
#pragma unroll
    for (int i = 0; i < 4; ++i)
#pragma unroll
        for (int s = 0; s < 2; ++s) { Qf[i][s] = *(const bf16x8*)(qy_ + ((i * 2 + s) * 64 + lane) * 16); Sf[i][s] = *(const bf16x8*)(s_ + ((i * 2 + s) * 64 + lane) * 16); }
#pragma unroll
    for (int vq = 0; vq < 4; ++vq)
#pragma unroll
        for (int mm = 0; mm < 4; ++mm) y0[vq][mm] = *(const u32x2*)(qy_ + 8192 + ((vq * 4 + mm) * 64 + lane) * 8);
    f32x4 lg[4], lb[4];
#pragma unroll
    for (int vq = 0; vq < 4; ++vq) { lg[vq] = *(const f32x4*)(P.ln_g + h * 64 + 16 * vq + 4 * q); lb[vq] = *(const f32x4*)(P.ln_b + h * 64 + 16 * vq + 4 * q); }
#pragma unroll
    for (int mm = 0; mm < 4; ++mm) {
        const size_t ro = (size_t)(t0 + 16 * mm + r) * RW + h * 64 + 4 * q;
        u32x2 gw_[4], bw_[4];
#pragma unroll
        for (int vq = 0; vq < 4; ++vq) { gw_[vq] = *(const u32x2*)(P.g + ro + 16 * vq); bw_[vq] = *(const u32x2*)(P.bv + ro + 16 * vq); }
        f32x4 acc[4]; float sum = 0.f;
#pragma unroll
        for (int vq = 0; vq < 4; ++vq) {
            acc[vq] = (f32x4){bflo(y0[vq][mm].x), bfhi(y0[vq][mm].x), bflo(y0[vq][mm].y), bfhi(y0[vq][mm].y)};
#pragma unroll
            for (int s = 0; s < 2; ++s) acc[vq] = __builtin_amdgcn_mfma_f32_16x16x32_bf16(Sf[vq][s], Qf[mm][s], acc[vq], 0, 0, 0);
            sum += (acc[vq][0] + acc[vq][1]) + (acc[vq][2] + acc[vq][3]);
        }
        sum += __shfl_xor(sum, 16); sum += __shfl_xor(sum, 32);
        const float mean = sum * (1.f / 64.f); float var = 0.f;
#pragma unroll
        for (int vq = 0; vq < 4; ++vq) { acc[vq] = acc[vq] - mean; var += (acc[vq][0] * acc[vq][0] + acc[vq][1] * acc[vq][1]) + (acc[vq][2] * acc[vq][2] + acc[vq][3] * acc[vq][3]); }
        var += __shfl_xor(var, 16); var += __shfl_xor(var, 32);
        const float rstd = __builtin_amdgcn_rsqf(var * (1.f / 64.f) + 64e-5f);
#pragma unroll
        for (int vq = 0; vq < 4; ++vq) {
            const f32x4 gg = (f32x4){bflo(gw_[vq].x), bfhi(gw_[vq].x), bflo(gw_[vq].y), bfhi(gw_[vq].y)}, bb = (f32x4){bflo(bw_[vq].x), bfhi(bw_[vq].x), bflo(bw_[vq].y), bfhi(bw_[vq].y)};
            const f32x4 o = (acc[vq] * rstd * lg[vq] + lb[vq] + bb) * gg;
            int t8 = __builtin_amdgcn_cvt_pk_fp8_f32(o[0], o[1], 0, false); t8 = __builtin_amdgcn_cvt_pk_fp8_f32(o[2], o[3], t8, true); *(unsigned*)(P.ya + ro + 16 * vq) = (unsigned)t8; }
    }
}
}
namespace gl {
constexpr int LDV = 136;
struct Args { const bf16_t* puv; const bf16_t* wsm; const float* bs; const float* ln_g; const float* ln_b; unsigned char* yb; };
__device__ __forceinline__ void unit(const Args& P, LAS unsigned char* lds, int b, int blk, int tid) {
    const int wave = __builtin_amdgcn_readfirstlane(tid >> 6), lane = tid & 63, r = lane & 15, q = lane >> 4;
    const int t0 = b * SEQ + blk * 128;
    LAS float* STAT = (LAS float*)(lds + LDS_MISC);
#pragma unroll
    for (int hb = 0; hb < 2; ++hb) {
        u32x4 w[8];
#pragma unroll
        for (int j = 0; j < 8; ++j) w[j] = *(const u32x4*)(P.puv + (size_t)(t0 + 16 * wave + 8 * hb + j) * 1024 + 512 + 8 * lane);
#pragma unroll
        for (int j = 0; j < 8; ++j) {
            float v[8]; v[0] = bflo(w[j].x); v[1] = bfhi(w[j].x); v[2] = bflo(w[j].y); v[3] = bfhi(w[j].y); v[4] = bflo(w[j].z); v[5] = bfhi(w[j].z); v[6] = bflo(w[j].w); v[7] = bfhi(w[j].w);
            float s = 0.f, s2 = 0.f;
#pragma unroll
            for (int e = 0; e < 8; ++e) { s += v[e]; s2 += v[e] * v[e]; }
            s = wave_sum(s); s2 = wave_sum(s2);
            const float mean = s * (1.f / 512.f), var = fmaxf(s2 * (1.f / 512.f) - mean * mean, 0.f);
            if (lane == 0) { const int tk = 16 * wave + 8 * hb + j; STAT[tk * 2] = mean; STAT[tk * 2 + 1] = __builtin_amdgcn_rsqf(var + 1e-5f); }
        }
    }
    u32x4 pv[2], pu[2];
#define GL_LOAD(g) do { _Pragma("unroll") for (int it = 0; it < 2; ++it) { const int task = tid + it * NTHREADS, j = task >> 3, cc = task & 7; \
        const bf16_t* row = P.puv + (size_t)(t0 + j) * 1024 + (g) * 64 + 8 * cc; pu[it] = *(const u32x4*)row; pv[it] = *(const u32x4*)(row + 512); } } while (0)
    GL_LOAD(0);
    __syncthreads();
    for (int g = 0; g < 8; ++g) {
        LAS bf16_t* VT = (LAS bf16_t*)(lds + (g & 1) * 20480);
        LAS bf16_t* US = (LAS bf16_t*)(lds + 40960 + (g & 1) * 18432);
#pragma unroll
        for (int it = 0; it < 2; ++it) {
            const int task = tid + it * NTHREADS, j = task >> 3, cc = task & 7, ch = g * 64 + 8 * cc;
            const u32x4 w = pv[it];
            const float mean = STAT[j * 2], rstd = STAT[j * 2 + 1];
            const f32x4 g0 = *(const f32x4*)(P.ln_g + ch), g1 = *(const f32x4*)(P.ln_g + ch + 4), b0 = *(const f32x4*)(P.ln_b + ch), b1 = *(const f32x4*)(P.ln_b + ch + 4);
            float v[8]; v[0] = bflo(w.x); v[1] = bfhi(w.x); v[2] = bflo(w.y); v[3] = bfhi(w.y); v[4] = bflo(w.z); v[5] = bfhi(w.z); v[6] = bflo(w.w); v[7] = bfhi(w.w);
#pragma unroll
            for (int e = 0; e < 4; ++e) { v[e] = (v[e] - mean) * rstd * g0[e] + b0[e]; v[4 + e] = (v[4 + e] - mean) * rstd * g1[e] + b1[e]; }
#pragma unroll
            for (int e = 0; e < 8; ++e) VT[(8 * cc + e) * LDV + j] = f2bf(v[e]);
            *(LAS u32x4*)(US + j * 72 + 8 * cc) = pu[it];
        }
        if (g + 1 < 8) GL_LOAD(g + 1);
        __syncthreads();
        f32x4 acc[4];
#pragma unroll
        for (int n = 0; n < 4; ++n) acc[n] = (f32x4){0.f, 0.f, 0.f, 0.f};
        const bf16_t* wrow = P.wsm + ((size_t)g * 128 + 16 * wave + r) * 128 + 8 * q;
        const int ks = (wave >> 1) + 1;
        for (int s = 0; s < ks; ++s) {
            const bf16x8 a = *(const bf16x8*)(wrow + 32 * s);
#pragma unroll
            for (int n = 0; n < 4; ++n) { const bf16x8 bb = *(const LAS bf16x8*)(VT + (16 * n + r) * LDV + 32 * s + 8 * q); acc[n] = __builtin_amdgcn_mfma_f32_16x16x32_bf16(a, bb, acc[n], 0, 0, 0); }
        }
#pragma unroll
        for (int ii = 0; ii < 4; ++ii) { const int i = 16 * wave + 4 * q + ii; const float bias = P.bs[g * 128 + i];
#pragma unroll
            for (int n = 0; n < 4; ++n) { const int c = 16 * n + r; const float u = bf2f(US[i * 72 + c]);
                P.yb[(size_t)(t0 + i) * RW + g * 64 + c] = (unsigned char)(__builtin_amdgcn_cvt_pk_fp8_f32(u * (acc[n][ii] + bias), 0.f, 0, false) & 0xff); } }
    }
    __syncthreads();
#undef GL_LOAD
}
}

struct RouteArgs { const float* sc; const float* bias; int* eidx; float* ewt; int* lrank; int* tbase; unsigned* segcnt; };
__device__ __forceinline__ void topk_tile(const RouteArgs& P, LAS unsigned char* lds, int tid, int tile) {
    const int wave = __builtin_amdgcn_readfirstlane(tid >> 6), lane = tid & 63, grp = lane >> 3;
    LAS int* hist = (LAS int*)(lds + LDS_MISC);
    const f32x4 bias4 = *(const f32x4*)(P.bias + 4 * lane);
    const float NEG = -__builtin_inff();
    {
        if (tid < NE) hist[tid] = 0;
        __syncthreads();
        f32x4 nx[2];
#pragma unroll
        for (int u = 0; u < 2; ++u) nx[u] = *(const f32x4*)(P.sc + (size_t)(tile * 256 + wave * 32 + u) * NE + 4 * lane);
        for (int j = 0; j < 32; j += 2) {
            const int t0 = tile * 256 + wave * 32 + j;
            float s[2][4], v[2][4], gs[2];
            const f32x4 cur4[2] = {nx[0], nx[1]};
            if (j + 2 < 32) {
#pragma unroll
                for (int u = 0; u < 2; ++u) nx[u] = *(const f32x4*)(P.sc + (size_t)(t0 + 2 + u) * NE + 4 * lane); }
#pragma unroll
            for (int u = 0; u < 2; ++u) { const f32x4 s4 = cur4[u]; s[u][0] = s4.x; s[u][1] = s4.y; s[u][2] = s4.z; s[u][3] = s4.w;
#pragma unroll
                for (int e = 0; e < 4; ++e) v[u][e] = s[u][e] + bias4[e]; }
            float m1[2], m2[2];
#pragma unroll
            for (int u = 0; u < 2; ++u) { const float a = fmaxf(v[u][0], v[u][1]), b = fminf(v[u][0], v[u][1]), c = fmaxf(v[u][2], v[u][3]), d = fminf(v[u][2], v[u][3]); m1[u] = fmaxf(a, c); m2[u] = fmaxf(fminf(a, c), fmaxf(b, d)); }
#pragma unroll
            for (int o = 1; o < 8; o <<= 1) {
#pragma unroll
                for (int u = 0; u < 2; ++u) { const float o1 = __shfl_xor(m1[u], o), o2 = __shfl_xor(m2[u], o); const float n1 = fmaxf(m1[u], o1), n2 = fmaxf(fminf(m1[u], o1), fmaxf(m2[u], o2)); m1[u] = n1; m2[u] = n2; } }
#pragma unroll
            for (int u = 0; u < 2; ++u) gs[u] = m1[u] + m2[u];
            int cnt[2] = {0, 0};
#pragma unroll
            for (int g = 0; g < 8; ++g) {
#pragma unroll
                for (int u = 0; u < 2; ++u) { const float og = __shfl(gs[u], 8 * g); cnt[u] += (og > gs[u] || (og == gs[u] && g < grp)) ? 1 : 0; } }
#pragma unroll
            for (int u = 0; u < 2; ++u) {
#pragma unroll
                for (int e = 0; e < 4; ++e) v[u][e] = (cnt[u] < 4) ? v[u][e] : NEG; }
            int myidx[2] = {0, 0}; float mysc[2] = {0.f, 0.f}, ssum[2] = {0.f, 0.f};
#pragma unroll
            for (int k = 0; k < TOPK; ++k) {
                float bv[2]; int idx[2];
#pragma unroll
                for (int u = 0; u < 2; ++u) { bv[u] = v[u][0]; int bi = 0;
#pragma unroll
                    for (int e = 1; e < 4; ++e) { const bool gt = v[u][e] > bv[u]; bv[u] = gt ? v[u][e] : bv[u]; bi = gt ? e : bi; }
                    idx[u] = 4 * lane + bi; }
#pragma unroll
                for (int o = 1; o < 64; o <<= 1) {
#pragma unroll
                    for (int u = 0; u < 2; ++u) { const float ov = __shfl_xor(bv[u], o); const int oi = __shfl_xor(idx[u], o); const bool tk = (ov > bv[u]) || (ov == bv[u] && oi < idx[u]); bv[u] = tk ? ov : bv[u]; idx[u] = tk ? oi : idx[u]; } }
#pragma unroll
                for (int u = 0; u < 2; ++u) { const int own = idx[u] >> 2, ee = idx[u] & 3;
                    const float mine = (ee == 0) ? s[u][0] : (ee == 1) ? s[u][1] : (ee == 2) ? s[u][2] : s[u][3];
                    const float scv = __shfl(mine, own);
#pragma unroll
                    for (int e = 0; e < 4; ++e) v[u][e] = (lane == own && e == ee) ? NEG : v[u][e];
                    ssum[u] += scv; myidx[u] = (lane == k) ? idx[u] : myidx[u]; mysc[u] = (lane == k) ? scv : mysc[u]; }
            }
            if (lane < TOPK) {
#pragma unroll
                for (int u = 0; u < 2; ++u) { const int t = t0 + u;
                    const int lr = __hip_atomic_fetch_add(hist + myidx[u], 1, __ATOMIC_RELAXED, __HIP_MEMORY_SCOPE_WORKGROUP);
                    P.eidx[(size_t)t * TOPK + lane] = myidx[u]; P.ewt[(size_t)t * TOPK + lane] = mysc[u] / ssum[u] * 2.5f; P.lrank[(size_t)t * TOPK + lane] = lr; }
            }
        }
        __syncthreads();
        if (tid < NE) { const int cnt = hist[tid]; unsigned base = 0u;
            if (cnt) base = __hip_atomic_fetch_add(P.segcnt + tid, (unsigned)cnt, __ATOMIC_RELAXED, __HIP_MEMORY_SCOPE_AGENT);
            P.tbase[tile * NE + tid] = (int)base; }
        __syncthreads();
    }
}
struct ScatArgs { const int* eidx; const float* ewt; const int* lrank; const int* tbase; const unsigned* segcnt; int* rowtok; int* rowdst; float* roww; int* tab; unsigned* ntile; };
__device__ __forceinline__ void phase_scatter(const ScatArgs& P, LAS unsigned char* lds, int tid, int G) {
    LAS int* cntL = (LAS int*)(lds + LDS_MISC); LAS int* segst = cntL + 256; LAS int* tsa = segst + 256;
    if (tid < NE) cntL[tid] = (int)__hip_atomic_load(P.segcnt + tid, __ATOMIC_RELAXED, __HIP_MEMORY_SCOPE_AGENT);
    __syncthreads();
    if (tid == 0) {
        int run = 0, ta = 0;
        for (int s = 0; s < NE; ++s) { const int nts = (cntL[s] + 255) >> 8; segst[s] = run; tsa[s] = ta; run += nts * 256; ta += nts; }
        if (blockIdx.x == 0) P.ntile[0] = (unsigned)ta;
    }
    __syncthreads();
    for (int tile = blockIdx.x; tile < T / 256; tile += G) {
        for (int a = tid; a < 256 * TOPK; a += NTHREADS) {
            const int tok = tile * 256 + (a >> 3), k = a & 7; const size_t ai = (size_t)tok * TOPK + k;
            const int e = P.eidx[ai];
            const int pos = segst[e] + P.tbase[tile * NE + e] + P.lrank[ai];
            P.rowtok[pos] = tok; P.rowdst[pos] = tok * TOPK + k; P.roww[pos] = P.ewt[ai];
        }
    }
    for (int s = blockIdx.x; s < NE; s += G) {
        const int st = segst[s], cnt = cntL[s], nts = (cnt + 255) >> 8;
        for (int p = st + cnt + tid; p < st + nts * 256; p += NTHREADS) { P.rowtok[p] = 0; P.rowdst[p] = -1; P.roww[p] = 0.f; }
        if (tid < nts) { int* ta_ = P.tab + 2 * (tsa[s] + tid); ta_[0] = st + 256 * tid; ta_[1] = s; }
    }
}
constexpr int NPHASE = 20;
struct KArgs { const float* in[34]; float* out; unsigned char* ws; int ph_lo, ph_hi; };
template <int PLO, int PHI>
__global__ void __launch_bounds__(NTHREADS, 2) fwd_kernel(KArgs a) {
    extern __shared__ __attribute__((aligned(16))) unsigned char lds_raw[];
    LAS unsigned char* lds = (LAS unsigned char*)lds_raw;
    const int G = gridDim.x, bid = blockIdx.x, NGW = G * NWAVES;
#define PH_IDS() int tid = threadIdx.x; asm volatile("" : "+v"(tid)); const int lane = tid & 63, wave = __builtin_amdgcn_readfirstlane(tid >> 6), gw = bid * NWAVES + wave; (void)lane; (void)wave; (void)gw
    unsigned char* ws = a.ws;
    unsigned* ctl = (unsigned*)(ws + WS_CTL);
    float* mod = (float*)(ws + WS_MOD);
    constexpr int lo = PLO, hi = PHI;
    if (threadIdx.x == 0) *(LAS u32x4*)(lds + LDS_BARW) = (u32x4){0u, 0u, 0u, 0u};
    __syncthreads();
    XcdBarrier bar; bar.bar = ctl + CW_BAR; bar.x = 0; bar.st = nullptr;
    if (hi - lo > 1) bar = xcd_barrier_post(ctl + CW_BAR, (volatile LAS unsigned*)(lds + LDS_BARW));
#define IN(k) (lo <= (k) && (k) < hi)
#ifdef DBG_TIME
#define STAMP(k) do { if (blockIdx.x == 0 && threadIdx.x == 0) ((unsigned long long*)(ctl + 5200))[k] = __builtin_amdgcn_s_memrealtime(); } while (0)
#else
#define STAMP(k) do {} while (0)
#endif
#define SEAM(k) do { if (IN(k) && IN((k) + 1)) xcd_barrier(bar); } while (0)
#ifndef DBG_REPEAT
#define DBG_REPEAT (-1)
#define DBG_NREP 0
#endif
#define REP(k) for (int rep_ = 0; rep_ < (((k) == DBG_REPEAT) ? 1 + DBG_NREP : 1); ++rep_, (((k) == DBG_REPEAT && rep_ <= DBG_NREP) ? xcd_barrier(bar) : (void)0))

    STAMP(0);
    if (IN(0)) REP(0) { PH_IDS();
        phase_mod(a.in[1], a.in[2], a.in[3], mod, lds, tid, G);
    }
    SEAM(0); STAMP(1);
    if (IN(1)) REP(1) { PH_IDS();
        SmallW sw{a.in[6], a.in[22], a.in[23], a.in[24], a.in[25], a.in[30], a.in[31], a.in[32], a.in[9], a.in[11], a.in[12], a.in[20]};
        phase_small_weights(sw, ws, lds, gw, NGW, wave, lane);
        phase_norm_mod<false>(a.in[0], a.in[4], mod, 0, 1024, nullptr, ws + B_H1, gw, NGW, lane);
    }
    SEAM(1); STAMP(2);
    if (IN(2)) REP(2) {
        gm::DenseSched S; S.init(ws + B_H1, ws + SW_WIN, T, IN_COLS, D, G, bid, 1);
        gm::EpiInProj E{(bf16_t*)(ws + B_PRW), (bf16_t*)(ws + B_PUV), (bf16_t*)(ws + B_PG)};
        gm::gemm_phase<gm::EpiInProj, gm::DenseSched, true, true, 122>(lds, D, S, E);
    }
    SEAM(2); STAMP(3);
    if (IN(3)) REP(3) { PH_IDS();
        gl::Args Q{(const bf16_t*)(ws + B_PUV), (const bf16_t*)(ws + SW_WSM), a.in[21], a.in[18], a.in[19], ws + B_YB};
        for (int u = bid; u < 512; u += G) gl::unit(Q, lds, u >> 6, u & 63, tid);
        phase_xs((const bf16_t*)(ws + B_PRW), a.in[7], (bf16_t*)(ws + B_XS), gw, NGW, lane);
    }
    SEAM(3); STAMP(4);
    if (IN(4)) REP(4) { PH_IDS();
        rk::Args P{(const bf16_t*)(ws + B_PRW), a.in[7], a.in[8], a.in[10], a.in[13], a.in[14], a.in[15], (const bf16_t*)(ws + SW_WUP), (const bf16_t*)(ws + SW_AUP), (const bf16_t*)(ws + SW_GUP), (const bf16_t*)(ws + B_XS),
                   (bf16_t*)(ws + B_G), (bf16_t*)(ws + B_BV), ws + B_MN, ws + B_QY};
        rk::Pre pre; rk::load_mu(P, lds, tid);
        if (bid < 8192) rk::prefetch(P, bid >> 10, (bid >> 7) & 7, bid & 127, tid, pre);
        for (int u = bid; u < 8192; u += G) { const int un = u + G; rk::unit(P, lds, u >> 10, (u >> 7) & 7, u & 127, u, tid, pre, un < 8192, un >> 10, (un >> 7) & 7, un & 127); }
    }
    SEAM(4); STAMP(5);
    if (IN(5)) REP(5) { PH_IDS();
        for (int w = bid; w < 256; w += G) rk::scan_wg(ws + B_MN, ws + B_S, ((w & 7) + 8 * (w >> 5)) * 128, (w >> 3) & 3, lds, tid);
    }
    SEAM(5); STAMP(6);
    if (IN(6)) REP(6) { PH_IDS();
        rk::YArgs Y{ws + B_QY, ws + B_S, (const bf16_t*)(ws + B_G), (const bf16_t*)(ws + B_BV), a.in[16], a.in[17], ws + B_YA};
        for (int u = gw; u < 8192; u += NGW) rk::ypass_unit(Y, u, lane);
    }
    SEAM(6); STAMP(7);
    STAMP(8);
    if (IN(8)) REP(8) {
        gm::DenseSched S; S.init(ws + B_YA, ws + SW_WOA, T, D, RW, G, bid, 1);
        gm::EpiMerge<false> E{(bf16_t*)(ws + B_M1), (const bf16_t*)(ws + B_PG), nullptr};
        gm::gemm_phase<gm::EpiMerge<false>, gm::DenseSched, true, true, 122>(lds, RW, S, E);
    }
    STAMP(9);
    if (IN(9)) {
        gm::DenseSched S; S.init(ws + B_YB, ws + SW_WOB, T, D, RW, G, bid, 1);
        gm::EpiMerge<true> E{(bf16_t*)(ws + B_M1), (const bf16_t*)(ws + B_PG), ws + B_M8};
        gm::gemm_phase<gm::EpiMerge<true>, gm::DenseSched, true, true, 122>(lds, RW, S, E);
    }
    SEAM(9); STAMP(10);
    if (IN(10)) REP(10) {
        gm::DenseSched S; S.init(ws + B_M8, ws + SW_WO, T, D, D, G, bid, 1);
        gm::EpiResid E{(bf16_t*)(ws + B_X1), a.in[0], mod + 2048};
        gm::gemm_phase<gm::EpiResid, gm::DenseSched, true, true, 122>(lds, D, S, E);
    }
    SEAM(10); STAMP(11);
    if (IN(11)) REP(11) { PH_IDS();
        phase_norm_mod<true>(ws + B_X1, a.in[5], mod, 3072, 4096, (bf16_t*)(ws + B_H2), ws + B_H2F8, gw, NGW, lane);
        phase_expert_weights(a.in[27], a.in[28], a.in[29], ws, lds, gw, NGW, wave, lane);
    }
    SEAM(11); STAMP(12);
    if (IN(12)) { PH_IDS();
        RouteArgs R{(const float*)(ws + B_SC), a.in[26], (int*)(ws + RT_EIDX), (float*)(ws + RT_EWT), (int*)(ws + RT_LRANK), (int*)(ws + RT_TBASE), ctl + CW_SEGCNT};
        { gm::DenseSched S; S.init(ws + B_H2, ws + SW_WR, T, NE, D, G, bid); gm::EpiRouter E{(float*)(ws + B_SC)}; gm::gemm_phase<gm::EpiRouter, gm::DenseSched, true>(lds, D, S, E);
          gm::Unit u; for (int i = 0; S.next(i, u); ++i) topk_tile(R, lds, tid, u.pm); }
        { gm::DenseSched S; S.init(ws + B_H2F8, ws + SW_WS13, T, 512, D, G, bid, 1); gm::EpiGateUp<true> E{ws + B_SH}; gm::gemm_phase<gm::EpiGateUp<true>, gm::DenseSched, true, true, 122>(lds, D, S, E); }
    }
    SEAM(12); STAMP(13);
    if (IN(13)) { PH_IDS();
        ScatArgs P{(const int*)(ws + RT_EIDX), (const float*)(ws + RT_EWT), (const int*)(ws + RT_LRANK), (const int*)(ws + RT_TBASE), ctl + CW_SEGCNT,
                   (int*)(ws + RT_ROWTOK), (int*)(ws + RT_ROWDST), (float*)(ws + RT_ROWW), (int*)(ws + RT_TAB), ctl + CW_NT};
        phase_scatter(P, lds, tid, G);
        __syncthreads();
        gm::DenseSched S; S.init(ws + B_SH, ws + SW_WS2, T, D, EFF, G, bid, 1);
        gm::EpiSharedDown E{ws + B_SHO};
        gm::gemm_phase<gm::EpiSharedDown, gm::DenseSched, true, true, 122>(lds, EFF, S, E);
    }
    SEAM(13); STAMP(14); STAMP(15);
    if (IN(15)) REP(15) {
        gm::GroupSched<true> S; S.A = (const char*)(ws + B_H2F8); S.B = (const char*)(ws + B_W13); S.tab = (const int*)(ws + RT_TAB); S.rowtok = (const int*)(ws + RT_ROWTOK);
        S.ntiles = (int)__hip_atomic_load(ctl + CW_NT, __ATOMIC_RELAXED, __HIP_MEMORY_SCOPE_AGENT); S.npn = 2; S.G = G; S.c = bid; S.K = D; S.ebytes = (size_t)512 * D; S.tstep = (size_t)256 * D;
        gm::EpiGateUp<true> E{ws + B_HID};
        gm::gemm_phase<gm::EpiGateUp<true>, gm::GroupSched<true>, true, true, 122>(lds, D, S, E);
    }
    SEAM(15); STAMP(16);
    if (IN(16)) REP(16) {
        gm::GroupSched<false> S; S.A = (const char*)(ws + B_HID); S.B = (const char*)(ws + B_W2); S.tab = (const int*)(ws + RT_TAB); S.rowtok = nullptr;
        S.ntiles = (int)__hip_atomic_load(ctl + CW_NT, __ATOMIC_RELAXED, __HIP_MEMORY_SCOPE_AGENT); S.npn = 4; S.G = G; S.c = bid; S.K = EFF; S.ebytes = (size_t)D * EFF; S.tstep = (size_t)256 * EFF;
        gm::EpiExpertDown E{ws + B_SLOT, (const int*)(ws + RT_ROWDST), (const float*)(ws + RT_ROWW)};
        gm::gemm_phase<gm::EpiExpertDown, gm::GroupSched<false>, true, true, 122>(lds, EFF, S, E);
    }
    SEAM(16); STAMP(17);
    if (IN(17)) { PH_IDS(); phase_combine(a.out, (const bf16_t*)(ws + B_X1), ws + B_SLOT, ws + B_SHO, mod, a.in[33], gw, NGW, lane); }
    STAMP(18); STAMP(19);
    __syncthreads(); STAMP(20);
#undef IN
#undef SEAM
}

#if defined(DBG_CHECK) || defined(DBG_TIME)
#ifdef DBG_TIME
#ifndef TSC
#define TSC 0.25f
#endif
__global__ void dbg_time_out(float* out, const unsigned long long* st) {
    if (threadIdx.x == 0 && blockIdx.x == 0) { out[0] = (float)(st[TA1] - st[TA0]) * 0.01f * TSC; out[1] = (float)(st[TB1] - st[TB0]) * 0.01f * TSC; }
}
static void dbg_run(void* d_out, void* d_ws, hipStream_t stream) {
    dbg_time_out<<<1, 64, 0, stream>>>((float*)d_out, (const unsigned long long*)((unsigned*)((unsigned char*)d_ws + WS_CTL) + 5200));
}
#endif
#endif
#ifndef MK_SINGLE
#define MK_SINGLE 0
#endif
template <int PLO, int PHI> static bool prep_kernel() {
    int per_cu = 0;
    if (hipFuncSetAttribute((const void*)fwd_kernel<PLO, PHI>, hipFuncAttributeMaxDynamicSharedMemorySize, LDS_BYTES) != hipSuccess) { fprintf(stderr, "kernel_launch: hipFuncSetAttribute failed\n"); return false; }
    if (hipOccupancyMaxActiveBlocksPerMultiprocessor(&per_cu, (const void*)fwd_kernel<PLO, PHI>, NTHREADS, LDS_BYTES) != hipSuccess || per_cu < 1) { fprintf(stderr, "kernel_launch: occupancy query says %d\n", per_cu); (void)hipGetLastError(); return false; }
    return true;
}
template <int P> struct PhaseLaunch {
    static bool prep() { return prep_kernel<P, P + 1>() && PhaseLaunch<P + 1>::prep(); }
    static void go(int grid, hipStream_t stream, const KArgs& a) { hipLaunchKernelGGL((fwd_kernel<P, P + 1>), dim3(grid), dim3(NTHREADS), LDS_BYTES, stream, a); PhaseLaunch<P + 1>::go(grid, stream, a); }
};
#ifndef DBG_LAST
#define DBG_LAST NPHASE
#endif
template <> struct PhaseLaunch<DBG_LAST> { static bool prep() { return true; } static void go(int, hipStream_t, const KArgs&) {} };
extern "C" void kernel_launch(void* const* d_in, const int* in_sizes, int n_in, void* d_out, int out_size, void* d_ws, size_t ws_size, hipStream_t stream) {
    static int grid = 0;
    if (grid == 0) {
        if (n_in != 34 || out_size != T * D || ws_size < WS_END) { fprintf(stderr, "kernel_launch: unexpected problem shape (n_in %d, out %d, ws %zu < %zu)\n", n_in, out_size, ws_size, (size_t)WS_END); grid = -1; return; }
        int dev = 0, cus = 0;
        if (hipGetDevice(&dev) != hipSuccess || hipDeviceGetAttribute(&cus, hipDeviceAttributeMultiprocessorCount, dev) != hipSuccess) { grid = -1; return; }
#if MK_SINGLE
        if (!prep_kernel<0, NPHASE>()) { grid = -1; return; }
#else
        if (!PhaseLaunch<0>::prep()) { grid = -1; return; }
#endif
        grid = cus;
    }
    if (grid < 0) return;
    (void)hipMemsetAsync((char*)d_ws + WS_CTL, 0, CTL_ZERO_BYTES, stream);
    KArgs a{};
    for (int i = 0; i < 34; ++i) a.in[i] = (const float*)d_in[i];
    a.out = (float*)d_out; a.ws = (unsigned char*)d_ws; a.ph_lo = 0; a.ph_hi = NPHASE;
#if MK_SINGLE
    hipLaunchKernelGGL((fwd_kernel<0, NPHASE>), dim3(grid), dim3(NTHREADS), LDS_BYTES, stream, a);
#else
    PhaseLaunch<0>::go(grid, stream, a);
#endif
#if defined(DBG_CHECK) || defined(DBG_TIME)
    dbg_run(d_out, d_ws, stream);
#endif
}
```

```cpp
#define MK_SINGLE 1
#include <hip/hip_runtime.h>
#include <cstdio>
#include <cstdint>

#define LAS __attribute__((address_space(3)))
#define GAS __attribute__((address_space(1)))
typedef unsigned short bf16_t;
typedef short bf16x8 __attribute__((ext_vector_type(8)));
typedef float f32x4 __attribute__((ext_vector_type(4)));
typedef float f32x2 __attribute__((ext_vector_type(2)));
typedef unsigned u32x4 __attribute__((ext_vector_type(4)));
typedef unsigned u32x2 __attribute__((ext_vector_type(2)));

constexpr int D = 1024, NB = 8, SEQ = 8192, T = NB * SEQ;
constexpr int RW = 512, HD = 64, NH = 8;
constexpr int RWKV_COLS = 1792, IN_COLS = 4864;
constexpr int NE = 256, TOPK = 8, EFF = 256;
constexpr int NWAVES = 8, NTHREADS = 512;
constexpr int MAXROWS = T * TOPK + 256 * 256;

constexpr size_t MiB = 1u << 20;
constexpr size_t WS_CTL = 0;
constexpr int CW_BAR = 0, CW_SEGCNT = 4096, CW_NT = 4608;
constexpr size_t CTL_ZERO_BYTES = 32768;
constexpr size_t WS_MOD = 65536;
constexpr size_t WS_SW = 1 * MiB;
constexpr size_t SW_WIN = WS_SW;
constexpr size_t SW_WOA = SW_WIN + (size_t)IN_COLS * D * 2;
constexpr size_t SW_WOB = SW_WOA + (size_t)D * RW * 2;
constexpr size_t SW_WO = SW_WOB + (size_t)D * RW * 2;
constexpr size_t SW_WR = SW_WO + (size_t)D * D * 2;
constexpr size_t SW_WS13 = SW_WR + (size_t)NE * D * 2;
constexpr size_t SW_WS2 = SW_WS13 + (size_t)512 * D * 2;
constexpr size_t SW_WUP = SW_WS2 + (size_t)D * EFF * 2;
constexpr size_t SW_AUP = SW_WUP + (size_t)RW * 64 * 2;
constexpr size_t SW_GUP = SW_AUP + (size_t)RW * 64 * 2;
constexpr size_t SW_WSM = SW_GUP + (size_t)RW * 128 * 2;
constexpr size_t SW_END = SW_WSM + (size_t)8 * 128 * 128 * 2;
static_assert(SW_END <= 20 * MiB, "small weights");
constexpr size_t WS_RT = 20 * MiB;
constexpr size_t RT_EIDX = WS_RT;
constexpr size_t RT_EWT = RT_EIDX + (size_t)T * 8 * 4;
constexpr size_t RT_LRANK = RT_EWT + (size_t)T * 8 * 4;
constexpr size_t RT_TBASE = RT_LRANK + (size_t)T * 8 * 4;
constexpr size_t RT_ROWTOK = RT_TBASE + (size_t)256 * 256 * 4;
constexpr size_t RT_ROWDST = RT_ROWTOK + (size_t)MAXROWS * 4;
constexpr size_t RT_ROWW = RT_ROWDST + (size_t)MAXROWS * 4;
constexpr size_t RT_TAB = RT_ROWW + (size_t)MAXROWS * 4;
constexpr size_t RT_SBON = RT_TAB + (size_t)3 * 4096 * 8;
constexpr size_t RT_END = RT_SBON + (size_t)T * 8 * 4;
static_assert(RT_END <= 40 * MiB, "routing arrays");
constexpr size_t WS_BIG = 40 * MiB;
constexpr size_t B_H1 = WS_BIG + 0 * MiB;
constexpr size_t B_YB = WS_BIG + 0 * MiB;
constexpr size_t B_YA = WS_BIG + 64 * MiB;
constexpr size_t B_XS = WS_BIG + 64 * MiB;
constexpr size_t B_PRW = WS_BIG + 128 * MiB;
constexpr size_t B_M8 = WS_BIG + 128 * MiB;
constexpr size_t B_S = WS_BIG + 128 * MiB;
constexpr size_t B_PUV = WS_BIG + 352 * MiB;
constexpr size_t B_QY = WS_BIG + 352 * MiB;
constexpr size_t B_M1 = WS_BIG + 352 * MiB;
constexpr size_t B_PG = WS_BIG + 480 * MiB;
constexpr size_t B_MN = WS_BIG + 736 * MiB;
constexpr size_t B_G = WS_BIG + 864 * MiB;
constexpr size_t B_BV = WS_BIG + 928 * MiB;
constexpr size_t B_H2 = WS_BIG + 0 * MiB;
constexpr size_t B_W13 = WS_BIG + 128 * MiB;
constexpr size_t B_H2F8 = WS_BIG + 256 * MiB;
constexpr size_t B_SH = WS_BIG + 384 * MiB;
constexpr size_t B_SC = WS_BIG + 416 * MiB;
constexpr size_t B_SLOT = WS_BIG + 0 * MiB;
constexpr size_t B_SHO = WS_BIG + 928 * MiB;
constexpr size_t B_W2 = WS_BIG + 512 * MiB;
constexpr size_t B_X1 = WS_BIG + 576 * MiB;
constexpr size_t B_HID = WS_BIG + 704 * MiB;
constexpr size_t WS_END = WS_BIG + 992 * MiB;
static_assert((size_t)MAXROWS * EFF * 2 <= 320 * MiB, "hid");

constexpr int LDS_STAGE = 0;
constexpr int LDS_MISC = 153600;
constexpr int LDS_BARW = 161792;
constexpr int LDS_BYTES = 163840;

typedef __bf16 bf16x2_t __attribute__((ext_vector_type(2)));
__device__ __forceinline__ unsigned pk2(float lo, float hi) { f32x2 f = {lo, hi}; return __builtin_bit_cast(unsigned, __builtin_convertvector(f, bf16x2_t)); }
__device__ __forceinline__ u32x2 pk8(const f32x4& a, const f32x4& b) { u32x2 w; int t = __builtin_amdgcn_cvt_pk_fp8_f32(a[0], a[1], 0, false); t = __builtin_amdgcn_cvt_pk_fp8_f32(a[2], a[3], t, true); w.x = (unsigned)t;
    t = __builtin_amdgcn_cvt_pk_fp8_f32(b[0], b[1], 0, false); t = __builtin_amdgcn_cvt_pk_fp8_f32(b[2], b[3], t, true); w.y = (unsigned)t; return w; }
__device__ __forceinline__ f32x4 up8(unsigned w) { const f32x2 lo = __builtin_amdgcn_cvt_pk_f32_fp8((int)w, false), hi = __builtin_amdgcn_cvt_pk_f32_fp8((int)w, true); return (f32x4){lo.x, lo.y, hi.x, hi.y}; }
__device__ __forceinline__ float bflo(unsigned w) { return __uint_as_float(w << 16); }
__device__ __forceinline__ float bfhi(unsigned w) { return __uint_as_float(w & 0xffff0000u); }
__device__ __forceinline__ float bf2f(bf16_t h) { return __uint_as_float(((unsigned)h) << 16); }
__device__ __forceinline__ bf16_t f2bf(float f) { return (bf16_t)(pk2(f, 0.f) & 0xffffu); }
__device__ __forceinline__ float fexp(float x) { return __builtin_amdgcn_exp2f(x * 1.44269504089f); }
__device__ __forceinline__ float flog(float x) { return __builtin_amdgcn_logf(x) * 0.69314718056f; }
__device__ __forceinline__ float frcp(float x) { return __builtin_amdgcn_rcpf(x); }
__device__ __forceinline__ float sigmoidf_(float x) { return frcp(1.0f + fexp(-x)); }
__device__ __forceinline__ float siluf_(float x) { return x * sigmoidf_(x); }
__device__ __forceinline__ float tanhf_(float x) { return 1.0f - 2.0f * frcp(1.0f + fexp(2.0f * x)); }
__device__ __forceinline__ float gelu_tanh(float x) { const float u = 0.7978845608f * (x + 0.044715f * x * x * x); return x * frcp(1.0f + fexp(-2.0f * u)); }
__device__ __forceinline__ float wave_sum(float v) {
#pragma unroll
    for (int o = 1; o < 64; o <<= 1) v += __shfl_xor(v, o);
    return v;
}
#define LDS_WAIT() asm volatile("s_waitcnt lgkmcnt(0)" ::: "memory")
#define VM_WAIT() asm volatile("s_waitcnt vmcnt(0)" ::: "memory")

#define XB_TMO      128
#define XB_XCNT(j)  (256  + 64 * (j))
#define XB_XSUB(j)  (1280 + 64 * (j))
#define XB_XGEN(j)  (2304 + 64 * (j))
#define XB_TOP      3328
#define XB_TOPGEN   3392
#define XCD_BAR_WORDS 3456
#define XB_SPIN_CAP (1u << 18)
__device__ __forceinline__ unsigned xb_ld(unsigned* p)              { return __hip_atomic_load(p, __ATOMIC_RELAXED, __HIP_MEMORY_SCOPE_AGENT); }
__device__ __forceinline__ unsigned xb_add(unsigned* p, unsigned v) { return __hip_atomic_fetch_add(p, v, __ATOMIC_RELAXED, __HIP_MEMORY_SCOPE_AGENT); }
__device__ __forceinline__ unsigned xb_xcc_id() { return (unsigned)__builtin_amdgcn_s_getreg((3 << 11) | 20) & 0xFu; }
#define XB_SPIN(cond, bar) do { unsigned _sp = 0; while (cond) { __builtin_amdgcn_s_sleep(1); \
    if ((++_sp & 255u) == 0u) { if (xb_ld(&(bar)[XB_TMO])) break; if (_sp > XB_SPIN_CAP) { atomicAdd(&(bar)[XB_TMO], 1u); break; } } } } while (0)
struct XcdBarrier { unsigned* bar; unsigned x; volatile LAS unsigned* st; };
__device__ __forceinline__ XcdBarrier xcd_barrier_post(unsigned* bar, volatile LAS unsigned* st) {
    XcdBarrier b; b.bar = bar; b.x = xb_xcc_id(); b.st = st;
    if (threadIdx.x == 0) (void)xb_add(&bar[XB_XCNT(b.x)], 1u);
    return b;
}
__device__ __forceinline__ void xcd_barrier_complete(unsigned* bar, unsigned x, unsigned& nloc, unsigned& nx) {
    const unsigned G = gridDim.x * gridDim.y * gridDim.z;
    unsigned sum, cnt, mine, sp = 0u;
    for (;;) {
        sum = 0u; cnt = 0u; mine = 0u;
#pragma unroll
        for (unsigned j = 0; j < 16; ++j) { const unsigned c = xb_ld(&bar[XB_XCNT(j)]); sum += c; cnt += (c > 0u) ? 1u : 0u; mine = (j == x) ? c : mine; }
        if (sum == G) break;
        __builtin_amdgcn_s_sleep(1);
        if ((++sp & 255u) == 0u) { if (xb_ld(&bar[XB_TMO])) break; if (sp > XB_SPIN_CAP) { atomicAdd(&bar[XB_TMO], 1u); break; } }
    }
    nloc = mine > 0u ? mine : 1u; nx = cnt > 0u ? cnt : 1u;
}
__device__ __forceinline__ void xcd_barrier(const XcdBarrier& b) {
    asm volatile("s_waitcnt vmcnt(0)" ::: "memory");
    __syncthreads();
    if (threadIdx.x == 0) {
        unsigned* bar = b.bar;
        __builtin_amdgcn_s_waitcnt(0);
        unsigned nloc = b.st[0], nx = b.st[1];
        if (nloc == 0u) { xcd_barrier_complete(bar, b.x, nloc, nx); b.st[0] = nloc; b.st[1] = nx; }
        const unsigned old = xb_add(&bar[XB_XSUB(b.x)], 1u);
        const unsigned gen = old / nloc;
        if (old + 1u == (gen + 1u) * nloc) {
            __builtin_amdgcn_fence(__ATOMIC_RELEASE, "agent");
            asm volatile("s_waitcnt vmcnt(0)" ::: "memory");
            const unsigned og = xb_add(&bar[XB_TOP], 1u);
            const unsigned tg = og / nx;
            if (og + 1u == (tg + 1u) * nx) xb_add(&bar[XB_TOPGEN], 1u);
            else XB_SPIN(xb_ld(&bar[XB_TOPGEN]) == tg, bar);
            __builtin_amdgcn_fence(__ATOMIC_ACQUIRE, "agent");
            xb_add(&bar[XB_XGEN(b.x)], 1u);
            asm volatile("s_waitcnt vmcnt(0)" ::: "memory");
        } else {
            XB_SPIN(xb_ld(&bar[XB_XGEN(b.x)]) == gen, bar);
            __builtin_amdgcn_fence(__ATOMIC_ACQUIRE, "agent");
            asm volatile("s_waitcnt vmcnt(0)" ::: "memory");
        }
    }
    __syncthreads();
}
namespace gm {
typedef int i32x4 __attribute__((ext_vector_type(4)));
typedef int i32x8 __attribute__((ext_vector_type(8)));
constexpr int BM = 256, BK = 64, HALF = 128, HTB = HALF * BK * 2, STAGE_BYTES = 8 * HTB, NXCD = 8, WGM = 8;
__host__ __device__ __forceinline__ int lds_byte(int r, int c) { const int st = (r >> 4) * 2 + (c >> 5), rr = r & 15, cc = c & 31, ob = rr * 64 + cc * 2; return st * 1024 + (ob ^ (((ob >> 9) & 1) << 5)); }
__host__ __device__ __forceinline__ void stage_rc(int b, int& R, int& C) { const int st = b / 1024, sb = b % 1024, swz = sb ^ (((sb >> 9) & 1) << 5); R = (st >> 1) * 16 + swz / 64; C = (st & 1) * 32 + (swz % 64) / 2; }
__host__ __device__ __forceinline__ int perm32(int rho) { const int n = rho >> 4, i = rho & 15; return 8 * (i >> 2) + 4 * n + (i & 3); }

struct Unit { int pm, pn, e, row0, par; };

struct DenseSched {
    static constexpr bool GATHER = false;
    const char* A; const char* B; int nM, nN, nwg, G, c; size_t tstep; const int* rowtok; int K;
    __device__ __forceinline__ void init(const void* A_, const void* B_, int M, int N, int K, int G_, int c_, int es = 2) { A = (const char*)A_; B = (const char*)B_; nM = M / BM; nN = N / BM; nwg = nM * nN; G = G_; c = c_; tstep = (size_t)BM * K * es; rowtok = nullptr; this->K = 0; }
    __device__ __forceinline__ bool next(int i, Unit& u) const {
        const long L = (long)i * G + c; if (L >= nwg) return false;
        int wgid = (int)L; { const int q = nwg / NXCD, r = nwg % NXCD, xcd = wgid % NXCD, off = wgid / NXCD; wgid = (xcd < r ? xcd * (q + 1) : r * (q + 1) + (xcd - r) * q) + off; }
        const int nig = WGM * nN, gid = wgid / nig, fm = gid * WGM, gsz = (nM - fm) < WGM ? (nM - fm) : WGM;
        u.pm = fm + ((wgid % nig) % gsz); u.pn = (wgid % nig) / gsz; u.e = 0; u.row0 = u.pm * BM; return true;
    }
    __device__ __forceinline__ const char* a_ptr(const Unit& u) const { return A + (size_t)u.pm * tstep; }
    __device__ __forceinline__ const char* b_ptr(const Unit& u) const { return B + (size_t)u.pn * tstep; }
    __device__ __forceinline__ unsigned row_off(const Unit&, int) const { return 0u; }
};
template <bool GATHER_>
struct GroupSched {
    static constexpr bool GATHER = GATHER_;
    const char* A; const char* B; const int* tab; const int* rowtok; int ntiles, npn, G, c, K; size_t ebytes, tstep;
    __device__ __forceinline__ bool next(int i, Unit& u) const {
        int tile;
        if (G == 256) {
            const int xcd = c & 7, slot = c >> 3, tpx = 32 / npn; tile = i * 8 * tpx + xcd * tpx + slot / npn; u.pn = slot % npn; if (tile >= ntiles) return false;
        } else { const long L = (long)i * G + c; if (L >= (long)ntiles * npn) return false; tile = (int)(L / npn); u.pn = (int)(L % npn); }
        u.pm = tile;
        u.row0 = __builtin_amdgcn_readfirstlane(tab[2 * tile]); u.e = __builtin_amdgcn_readfirstlane(tab[2 * tile + 1]); return true;
    }
    __device__ __forceinline__ const char* a_ptr(const Unit& u) const { return GATHER ? A : A + (size_t)u.row0 * K; }
    __device__ __forceinline__ const char* b_ptr(const Unit& u) const { return B + (size_t)u.e * ebytes + (size_t)u.pn * tstep; }
    __device__ __forceinline__ unsigned row_off(const Unit& u, int r) const { return (unsigned)rowtok[u.row0 + r] * (unsigned)K; }
};

template <class Epi, class Sched, bool ALIGN_EPI, bool F8 = false, int SCALE_W = 127>
__device__ __forceinline__ void gemm_phase(LAS unsigned char* lds, const int Kel, const Sched& S, const Epi& E) {
    const int K = F8 ? Kel / 2 : Kel;
    int tid_ = threadIdx.x; asm volatile("" : "+v"(tid_));
    const int tid = tid_, wid = __builtin_amdgcn_readfirstlane(tid >> 6), lane = tid & 63, wr = wid >> 2, wc = wid & 3, fr = lane & 15, fq = lane >> 4;
    const int nt = K / BK;
    int sR[2], sC[2]; unsigned voffB[2];
#pragma unroll
    for (int i = 0; i < 2; ++i) { int R, C; stage_rc(tid * 16 + i * 8192, R, C); sR[i] = R; sC[i] = C; const int Rb = Epi::PERM ? ((R & ~31) + perm32(R & 31)) : R; voffB[i] = (unsigned)(Rb * K + C) * 2u; }
    const size_t kstep = (size_t)(BK * 2);
    const size_t hstep = (size_t)HALF * K * 2;
    const unsigned ldsw = (unsigned)wid * 1024u;
    const int aoff = lds_byte(wr * 64 + fr, fq * 8), boff = lds_byte(wc * 32 + fr, fq * 8);
#define PG8_SA(b, h) (((b) * 2 + (h)) * HTB)
#define PG8_SB(b, h) ((4 + (b) * 2 + (h)) * HTB)
#define PG8_STGB(bufoff, gbase) do { _Pragma("unroll") for (int _i = 0; _i < 2; ++_i) \
        __builtin_amdgcn_global_load_lds((const unsigned*)((const char*)(gbase) + voffB[_i]), (LAS unsigned*)(lds + (bufoff) + ldsw + _i * 8192), 16, 0, 0); } while (0)
#define PG8_STGA(bufoff, gbase, VO, h) do { _Pragma("unroll") for (int _i = 0; _i < 2; ++_i) \
        __builtin_amdgcn_global_load_lds((const unsigned*)((const char*)(gbase) + VO[h][_i]), (LAS unsigned*)(lds + (bufoff) + ldsw + _i * 8192), 16, 0, 0); } while (0)
#define PG8_VOA(u, VO) do { _Pragma("unroll") for (int _h = 0; _h < 2; ++_h) _Pragma("unroll") for (int _i = 0; _i < 2; ++_i) \
        VO[_h][_i] = Sched::GATHER ? (S.row_off(u, _h * HALF + sR[_i]) + (unsigned)sC[_i] * 2u) : ((unsigned)((_h * HALF + sR[_i]) * K + sC[_i]) * 2u); } while (0)
#define PG8_LDA(dst, b, h) do { _Pragma("unroll") for (int m = 0; m < 4; ++m) { if constexpr (F8) { dst##8[m].lo = *(const LAS i32x4*)(lds + PG8_SA(b, h) + aoff + m * 2048); dst##8[m].hi = *(const LAS i32x4*)(lds + PG8_SA(b, h) + aoff + m * 2048 + 1024); } else { _Pragma("unroll") for (int k = 0; k < 2; ++k) dst[m][k] = *(const LAS bf16x8*)(lds + PG8_SA(b, h) + aoff + m * 2048 + k * 1024); } } } while (0)
#define PG8_LDB(dst, b, h) do { _Pragma("unroll") for (int n = 0; n < 2; ++n) { if constexpr (F8) { dst##8[n].lo = *(const LAS i32x4*)(lds + PG8_SB(b, h) + boff + n * 2048); dst##8[n].hi = *(const LAS i32x4*)(lds + PG8_SB(b, h) + boff + n * 2048 + 1024); } else { _Pragma("unroll") for (int k = 0; k < 2; ++k) dst[n][k] = *(const LAS bf16x8*)(lds + PG8_SB(b, h) + boff + n * 2048 + k * 1024); } } } while (0)
#define PG8_MMA(ai, bj, At, Bt) do { __builtin_amdgcn_s_setprio(1); _Pragma("unroll") for (int m = 0; m < 4; ++m) _Pragma("unroll") for (int n = 0; n < 2; ++n) { \
        if constexpr (F8) { asm volatile("v_mfma_scale_f32_16x16x128_f8f6f4 %0, %1, %2, %0, %3, %4 op_sel_hi:[0,0,0]" : "+v"(acc[ai][bj][m][n]) : "v"(Bt##8[n]), "v"(At##8[m]), "v"(scw_), "v"(sca_)); } \
        else { _Pragma("unroll") for (int k = 0; k < 2; ++k) acc[ai][bj][m][n] = __builtin_amdgcn_mfma_f32_16x16x32_bf16(Bt[n][k], At[m][k], acc[ai][bj][m][n], 0, 0, 0); } } \
        __builtin_amdgcn_s_setprio(0); } while (0)
#define PG8_WAIT_V(n) asm volatile("s_waitcnt vmcnt(" #n ")" ::: "memory")
#define PG8_WAIT_L(n) asm volatile("s_waitcnt lgkmcnt(" #n ")" ::: "memory")
#define PG8_BAR __builtin_amdgcn_s_barrier()
#define PG8_SCHED __builtin_amdgcn_sched_barrier(0)
    Unit cur, nxt; int ui = 0;
    if (!S.next(0, cur)) return;
    f32x4 acc[2][2][4][2];
#pragma unroll
    for (int a = 0; a < 2; ++a)
#pragma unroll
        for (int b = 0; b < 2; ++b)
#pragma unroll
            for (int m = 0; m < 4; ++m)
#pragma unroll
                for (int n = 0; n < 2; ++n) acc[a][b][m][n] = (f32x4){0.f, 0.f, 0.f, 0.f};
    const int scw_ = SCALE_W, sca_ = 127;
    bf16x8 At[4][2], B0[2][2], B1[2][2]; i32x8 At8[4], B08[2], B18[2];
    unsigned voA[2][2], nvoA[2][2];
    PG8_VOA(cur, voA);
    if (Sched::GATHER) { asm volatile("s_waitcnt vmcnt(0)" ::: "memory"); }
    const char* cA = S.a_ptr(cur); const char* cB = S.b_ptr(cur);
    cur.par = 0; E.stage_rows(cur, lds, wid);
    PG8_STGB(PG8_SB(0, 0), cB); PG8_STGB(PG8_SB(0, 1), cB + hstep); PG8_STGA(PG8_SA(0, 0), cA, voA, 0); PG8_STGA(PG8_SA(0, 1), cA, voA, 1);
    if (wr == 1) PG8_BAR;
    PG8_WAIT_V(2); PG8_BAR;
    PG8_STGB(PG8_SB(1, 0), cB + kstep); PG8_STGA(PG8_SA(1, 0), cA + kstep, voA, 0); PG8_STGB(PG8_SB(1, 1), cB + hstep + kstep);
    PG8_WAIT_V(6); PG8_BAR;
    for (;;) {
        const bool has_next = S.next(ui + 1, nxt); nxt.par = (ui + 1) & 3;
        const char* nA = has_next ? S.a_ptr(nxt) : cA; const char* nB = has_next ? S.b_ptr(nxt) : cB;
        if (Sched::GATHER) {
            if (has_next) { if (wid < 4) __builtin_amdgcn_global_load_lds((const unsigned*)(S.rowtok + nxt.row0 + wid * 64 + lane), (LAS unsigned*)(lds + LDS_MISC + nxt.par * 1024 + wid * 256), 4, 0, 0); }
#pragma unroll
            for (int h = 0; h < 2; ++h)
#pragma unroll
                for (int i = 0; i < 2; ++i) nvoA[h][i] = voA[h][i]; }
#pragma unroll 1
        for (int t = 0; t < nt; t += 2) {
            const bool last = (t == nt - 2);
            const char* a1 = cA + (size_t)(t + 1) * kstep;
            const char* a2 = last ? nA : cA + (size_t)(t + 2) * kstep; const char* b2 = last ? nB : cB + (size_t)(t + 2) * kstep;
            const char* a3 = a2 + kstep; const char* b3 = b2 + kstep;
            unsigned vo2[2][2];
#pragma unroll
            for (int h = 0; h < 2; ++h)
#pragma unroll
                for (int i = 0; i < 2; ++i) vo2[h][i] = (Sched::GATHER && last) ? nvoA[h][i] : voA[h][i];
            if (last && has_next) E.stage_rows(nxt, lds, wid);
            if (Sched::GATHER && last && has_next) { const LAS int* rt_ = (const LAS int*)(lds + LDS_MISC + nxt.par * 1024);
#pragma unroll
                for (int h = 0; h < 2; ++h)
#pragma unroll
                    for (int i = 0; i < 2; ++i) { vo2[h][i] = (unsigned)rt_[h * HALF + sR[i]] * (unsigned)S.K + (unsigned)sC[i] * 2u; nvoA[h][i] = vo2[h][i]; } }
            PG8_LDB(B0, 0, 0); PG8_LDB(B1, 0, 1); PG8_SCHED; PG8_LDA(At, 0, 0); PG8_STGA(PG8_SA(1, 1), a1, voA, 1);
            PG8_WAIT_V(8); PG8_WAIT_L(0); PG8_BAR; PG8_MMA(0, 0, At, B0); PG8_MMA(0, 1, At, B1); PG8_BAR; PG8_SCHED;
            PG8_LDA(At, 0, 1); PG8_STGB(PG8_SB(0, 0), b2); PG8_STGB(PG8_SB(0, 1), b2 + hstep); PG8_STGA(PG8_SA(0, 0), a2, vo2, 0);
            PG8_WAIT_V(8); PG8_WAIT_L(0); PG8_BAR; PG8_MMA(1, 0, At, B0); PG8_MMA(1, 1, At, B1); PG8_BAR; PG8_SCHED;
            PG8_LDB(B0, 1, 0); PG8_LDB(B1, 1, 1); PG8_SCHED; PG8_LDA(At, 1, 0); PG8_STGA(PG8_SA(0, 1), a2, vo2, 1);
            PG8_WAIT_V(8); PG8_WAIT_L(0); PG8_BAR; PG8_MMA(0, 0, At, B0); PG8_MMA(0, 1, At, B1); PG8_BAR; PG8_SCHED;
            PG8_LDA(At, 1, 1); PG8_STGB(PG8_SB(1, 0), b3); PG8_STGB(PG8_SB(1, 1), b3 + hstep); PG8_STGA(PG8_SA(1, 0), a3, vo2, 0);
            PG8_WAIT_V(8); PG8_WAIT_L(0); PG8_BAR; PG8_MMA(1, 0, At, B0); PG8_MMA(1, 1, At, B1); PG8_BAR; PG8_SCHED;
        }
        if constexpr (F8) asm volatile("s_nop 15\n\ts_nop 15\n\ts_nop 15" ::: "memory");
        if constexpr (ALIGN_EPI) { if (wr == 0) PG8_BAR; }
        E(acc, cur, wr, wc, fr, fq);
        if (!has_next) break;
#pragma unroll
        for (int a = 0; a < 2; ++a)
#pragma unroll
            for (int b = 0; b < 2; ++b)
#pragma unroll
                for (int m = 0; m < 4; ++m)
#pragma unroll
                    for (int n = 0; n < 2; ++n) acc[a][b][m][n] = (f32x4){0.f, 0.f, 0.f, 0.f};
        cur = nxt; cA = nA; cB = nB; ++ui;
        if (Sched::GATHER) {
#pragma unroll
            for (int h = 0; h < 2; ++h)
#pragma unroll
                for (int i = 0; i < 2; ++i) voA[h][i] = nvoA[h][i]; }
        if constexpr (ALIGN_EPI) { if (wr == 1) PG8_BAR; }
    }
    PG8_WAIT_V(0);
    if constexpr (!ALIGN_EPI) { if (wr == 0) PG8_BAR; }
    PG8_BAR;
#undef PG8_SA
#undef PG8_SB
#undef PG8_STGA
#undef PG8_STGB
#undef PG8_VOA
#undef PG8_LDA
#undef PG8_LDB
#undef PG8_MMA
#undef PG8_WAIT_V
#undef PG8_WAIT_L
#undef PG8_BAR
#undef PG8_SCHED
}

typedef f32x4 Acc[2][2][4][2];
struct EpiInProj {
    static constexpr bool PERM = true;
    __device__ __forceinline__ void stage_rows(const Unit&, LAS unsigned char*, int) const {}
    bf16_t *prw, *puv, *pg;
    template <int ACT> __device__ __forceinline__ void tile(const Acc& acc, bf16_t* base, int ld, int row0, int col0) const {
#pragma unroll
        for (int ai = 0; ai < 2; ++ai)
#pragma unroll
            for (int m = 0; m < 4; ++m) { bf16_t* rowp = base + (size_t)(row0 + ai * HALF + m * 16) * ld + col0;
#pragma unroll
                for (int bj = 0; bj < 2; ++bj) { f32x4 v0 = acc[ai][bj][m][0], v1 = acc[ai][bj][m][1];
                    if (ACT == 1) {
#pragma unroll
                        for (int j = 0; j < 4; ++j) { v0[j] = gelu_tanh(v0[j]); v1[j] = gelu_tanh(v1[j]); } }
                    if (ACT == 2) {
#pragma unroll
                        for (int j = 0; j < 4; ++j) { v0[j] = sigmoidf_(v0[j]); v1[j] = sigmoidf_(v1[j]); } }
                    u32x4 w; w.x = pk2(v0[0], v0[1]); w.y = pk2(v0[2], v0[3]); w.z = pk2(v1[0], v1[1]); w.w = pk2(v1[2], v1[3]);
                    *(u32x4*)(rowp + bj * HALF) = w; }
                __builtin_amdgcn_sched_barrier(0); }
    }
    __device__ __forceinline__ void operator()(const Acc& acc, const Unit& u, int wr, int wc, int fr, int fq) const {
        const int row0 = u.row0 + wr * 64 + fr, cw = wc * 32 + 8 * fq;
        if (u.pn < 7) tile<0>(acc, prw, RWKV_COLS, row0, u.pn * 256 + cw);
        else if (u.pn < 11) tile<1>(acc, puv, 1024, row0, (u.pn - 7) * 256 + cw);
        else tile<2>(acc, pg, 2048, row0, (u.pn - 11) * 256 + cw);
    }
};
template <bool SECOND> struct EpiMerge {
    static constexpr bool PERM = true;
    __device__ __forceinline__ void stage_rows(const Unit&, LAS unsigned char*, int) const {}
    bf16_t* m1; const bf16_t* pg; unsigned char* m8;
    __device__ __forceinline__ void operator()(const Acc& acc, const Unit& u, int wr, int wc, int fr, int fq) const {
        const int row0 = u.row0 + wr * 64 + fr, col0 = u.pn * 256 + wc * 32 + 8 * fq;
#pragma unroll
        for (int ai = 0; ai < 2; ++ai)
#pragma unroll
            for (int m = 0; m < 4; ++m) { const size_t r = (size_t)(row0 + ai * HALF + m * 16);
#pragma unroll
                for (int bj = 0; bj < 2; ++bj) { const int c = col0 + bj * HALF;
                    const u32x4 g = *(const u32x4*)(pg + r * 2048 + (SECOND ? 1024 : 0) + c);
                    f32x4 v0 = acc[ai][bj][m][0], v1 = acc[ai][bj][m][1];
                    v0[0] *= bflo(g.x); v0[1] *= bfhi(g.x); v0[2] *= bflo(g.y); v0[3] *= bfhi(g.y); v1[0] *= bflo(g.z); v1[1] *= bfhi(g.z); v1[2] *= bflo(g.w); v1[3] *= bfhi(g.w);
                    if (SECOND) { const u32x4 p = *(const u32x4*)(m1 + r * 1024 + c);
                        v0[0] += bflo(p.x); v0[1] += bfhi(p.x); v0[2] += bflo(p.y); v0[3] += bfhi(p.y); v1[0] += bflo(p.z); v1[1] += bfhi(p.z); v1[2] += bflo(p.w); v1[3] += bfhi(p.w); }
                    if (SECOND) *(u32x2*)(m8 + r * 1024 + c) = pk8(v0, v1);
                    else { u32x4 w; w.x = pk2(v0[0], v0[1]); w.y = pk2(v0[2], v0[3]); w.z = pk2(v1[0], v1[1]); w.w = pk2(v1[2], v1[3]); *(u32x4*)(m1 + r * 1024 + c) = w; } }
                __builtin_amdgcn_sched_barrier(0); }
    }
};
struct EpiResid {
    static constexpr bool PERM = true;
    __device__ __forceinline__ void stage_rows(const Unit&, LAS unsigned char*, int) const {}
    bf16_t* out; const float* base; const float* gate;
    __device__ __forceinline__ void operator()(const Acc& acc, const Unit& u, int wr, int wc, int fr, int fq) const {
        const int row0 = u.row0 + wr * 64 + fr, col0 = u.pn * 256 + wc * 32 + 8 * fq;
        const float* gp = gate + (size_t)(u.row0 >> 13) * 6144 + col0;
        f32x4 gv[2][2];
#pragma unroll
        for (int bj = 0; bj < 2; ++bj)
#pragma unroll
            for (int n = 0; n < 2; ++n) gv[bj][n] = *(const f32x4*)(gp + bj * HALF + n * 4);
#pragma unroll
        for (int ai = 0; ai < 2; ++ai)
#pragma unroll
            for (int m = 0; m < 4; ++m) { const size_t ro = (size_t)(row0 + ai * HALF + m * 16) * 1024 + col0;
#pragma unroll
                for (int bj = 0; bj < 2; ++bj) { const f32x4 b0 = *(const f32x4*)(base + ro + bj * HALF), b1 = *(const f32x4*)(base + ro + bj * HALF + 4);
                    const f32x4 v0 = b0 + gv[bj][0] * acc[ai][bj][m][0], v1 = b1 + gv[bj][1] * acc[ai][bj][m][1];
                    u32x4 w; w.x = pk2(v0[0], v0[1]); w.y = pk2(v0[2], v0[3]); w.z = pk2(v1[0], v1[1]); w.w = pk2(v1[2], v1[3]);
                    *(u32x4*)(out + ro + bj * HALF) = w; }
                __builtin_amdgcn_sched_barrier(0); }
    }
};
struct EpiRouter {
    static constexpr bool PERM = false;
    __device__ __forceinline__ void stage_rows(const Unit&, LAS unsigned char*, int) const {}
    float* sc;
    __device__ __forceinline__ void operator()(const Acc& acc, const Unit& u, int wr, int wc, int fr, int fq) const {
        const int row0 = u.row0 + wr * 64 + fr, col0 = wc * 32 + 4 * fq;
#pragma unroll
        for (int ai = 0; ai < 2; ++ai)
#pragma unroll
            for (int m = 0; m < 4; ++m) { float* rowp = sc + (size_t)(row0 + ai * HALF + m * 16) * 256 + col0;
#pragma unroll
                for (int bj = 0; bj < 2; ++bj)
#pragma unroll
                    for (int n = 0; n < 2; ++n) { f32x4 v = acc[ai][bj][m][n];
#pragma unroll
                        for (int j = 0; j < 4; ++j) v[j] = sigmoidf_(v[j]);
                        *(f32x4*)(rowp + bj * HALF + n * 16) = v; }
                __builtin_amdgcn_sched_barrier(0); }
    }
};
template <bool F8OUT> struct EpiGateUp {
    static constexpr bool PERM = true;
    __device__ __forceinline__ void stage_rows(const Unit&, LAS unsigned char*, int) const {}
    void* hid;
    __device__ __forceinline__ void operator()(const Acc& acc, const Unit& u, int wr, int wc, int fr, int fq) const {
        const int row0 = u.row0 + wr * 64 + fr, col0 = u.pn * HALF + wc * 32 + 8 * fq;
#pragma unroll
        for (int ai = 0; ai < 2; ++ai)
#pragma unroll
            for (int m = 0; m < 4; ++m) { const size_t off = (size_t)(row0 + ai * HALF + m * 16) * EFF + col0;
                f32x4 v0, v1;
#pragma unroll
                for (int j = 0; j < 4; ++j) { v0[j] = siluf_(acc[ai][0][m][0][j]) * acc[ai][1][m][0][j]; v1[j] = siluf_(acc[ai][0][m][1][j]) * acc[ai][1][m][1][j]; }
                if constexpr (F8OUT) *(u32x2*)((unsigned char*)hid + off) = pk8(v0, v1);
                else { u32x4 w; w.x = pk2(v0[0], v0[1]); w.y = pk2(v0[2], v0[3]); w.z = pk2(v1[0], v1[1]); w.w = pk2(v1[2], v1[3]); *(u32x4*)((bf16_t*)hid + off) = w; }
                __builtin_amdgcn_sched_barrier(0); }
    }
};
struct EpiExpertDown {
    static constexpr bool PERM = true;
    unsigned char* slot; const int* rowdst; const float* roww;
    __device__ __forceinline__ void stage_rows(const Unit& u, LAS unsigned char* lds, int wid) const {
        if (wid < 4) { const int lane = threadIdx.x & 63; LAS unsigned char* base = lds + LDS_MISC + u.par * 2048 + wid * 256;
            __builtin_amdgcn_global_load_lds((const unsigned*)(rowdst + u.row0 + wid * 64 + lane), (LAS unsigned*)base, 4, 0, 0);
            __builtin_amdgcn_global_load_lds((const unsigned*)(roww + u.row0 + wid * 64 + lane), (LAS unsigned*)(base + 1024), 4, 0, 0); }
    }
    __device__ __forceinline__ void operator()(const Acc& acc, const Unit& u, int wr, int wc, int fr, int fq) const {
        const unsigned cb = (unsigned)(u.pn * 256 + wc * 64 + 16 * fq);
        const LAS int* td = (const LAS int*)((LAS unsigned char*)nullptr + LDS_MISC + u.par * 2048) + wr * 64 + fr; const LAS float* tw = (const LAS float*)(td + 256);
#pragma unroll
        for (int ai = 0; ai < 2; ++ai)
#pragma unroll
            for (int m = 0; m < 4; ++m) {
                const int dst = td[ai * HALF + m * 16]; const float ws_ = tw[ai * HALF + m * 16];
                if (dst >= 0) { const u32x2 lo = pk8(acc[ai][0][m][0] * ws_, acc[ai][0][m][1] * ws_), hi = pk8(acc[ai][1][m][0] * ws_, acc[ai][1][m][1] * ws_);
                    *(u32x4*)(slot + (size_t)((unsigned)dst * 1024u + cb)) = (u32x4){lo.x, lo.y, hi.x, hi.y}; }
                __builtin_amdgcn_sched_barrier(0);
            }
    }
};
struct EpiSharedDown {
    static constexpr bool PERM = true;
    unsigned char* sho;
    __device__ __forceinline__ void stage_rows(const Unit&, LAS unsigned char*, int) const {}
    __device__ __forceinline__ void operator()(const Acc& acc, const Unit& u, int wr, int wc, int fr, int fq) const {
        const int row0 = u.row0 + wr * 64 + fr, col0 = u.pn * 256 + wc * 32 + 8 * fq;
#pragma unroll
        for (int ai = 0; ai < 2; ++ai)
#pragma unroll
            for (int m = 0; m < 4; ++m) { unsigned char* rowp = sho + (size_t)(row0 + ai * HALF + m * 16) * 1024 + col0;
#pragma unroll
                for (int bj = 0; bj < 2; ++bj) *(u32x2*)(rowp + bj * HALF) = pk8(acc[ai][bj][m][0], acc[ai][bj][m][1]);
                __builtin_amdgcn_sched_barrier(0); }
    }
};
}
__device__ __forceinline__ void phase_mod(const float* c, const float* ada_w, const float* ada_b, float* mod, LAS unsigned char* lds, int tid, int G) {
    LAS float* sl = (LAS float*)lds; LAS float* red = (LAS float*)(lds + 32768);
    for (int i = tid; i < NB * D; i += NTHREADS) { const float v = c[i]; sl[i] = siluf_(v); }
    __syncthreads();
    const int cl = tid % 24, kg = tid / 24;
    for (int cb = blockIdx.x; cb < 256; cb += G) {
        const int col0 = cb * 24;
        if (tid < 384) {
            float a[NB];
#pragma unroll
            for (int b = 0; b < NB; ++b) a[b] = 0.f;
#pragma unroll 1
            for (int k0 = kg; k0 < D; k0 += 16 * 16) { float w[16];
#pragma unroll
                for (int i = 0; i < 16; ++i) w[i] = ada_w[(size_t)(k0 + 16 * i) * 6144 + col0 + cl];
#pragma unroll
                for (int i = 0; i < 16; ++i) {
#pragma unroll
                    for (int b = 0; b < NB; ++b) a[b] += sl[b * D + k0 + 16 * i] * w[i]; } }
#pragma unroll
            for (int b = 0; b < NB; ++b) red[(kg * 24 + cl) * NB + b] = a[b];
        }
        __syncthreads();
        if (tid < 192) { const int c2 = tid >> 3, b = tid & 7; float s = 0.f;
#pragma unroll
            for (int g = 0; g < 16; ++g) s += red[(g * 24 + c2) * NB + b];
            mod[(size_t)b * 6144 + col0 + c2] = s + ada_b[col0 + c2]; }
        __syncthreads();
    }
}
__device__ __forceinline__ void transpose_item(const float* W, int ldw, int k0, int n0, bf16_t* WT, int ldt, int drow0, LAS float* scr, int lane) {
#pragma unroll 8
    for (int i = 0; i < 32; ++i) { const int kk = 2 * i + (lane >> 5); scr[kk * 33 + (lane & 31)] = W[(size_t)(k0 + kk) * ldw + n0 + (lane & 31)]; }
    LDS_WAIT(); asm volatile("" ::: "memory");
    const int c = lane & 7;
#pragma unroll
    for (int j = 0; j < 4; ++j) { const int n = (lane >> 3) + 8 * j; const LAS float* s = scr + (8 * c) * 33 + n;
        u32x4 o; o.x = pk2(s[0 * 33], s[1 * 33]); o.y = pk2(s[2 * 33], s[3 * 33]); o.z = pk2(s[4 * 33], s[5 * 33]); o.w = pk2(s[6 * 33], s[7 * 33]);
        *(u32x4*)(WT + (size_t)(drow0 + n) * ldt + k0 + 8 * c) = o; }
    LDS_WAIT(); asm volatile("" ::: "memory");
}
__device__ __forceinline__ void transpose_job(const float* W, int K, int N, bf16_t* WT, int gated, int goff, int item, LAS float* scr, int lane) {
    const int nblk = N / 32, kb = item / nblk, nb = item % nblk, n0 = 32 * nb;
    const int drow0 = gated ? (256 * (n0 >> 7) + goff + (n0 & 127)) : n0;
    transpose_item(W, N, 64 * kb, n0, WT, K, drow0, scr, lane);
}
__device__ __forceinline__ void transpose_item64(const float* W, int ldw, int k0, int n0, bf16_t* WT, int ldt, int drow0, LAS float* scr, int lane) {
    f32x4 v[16];
    const int c4 = lane & 15, r4 = lane >> 4;
#pragma unroll
    for (int i = 0; i < 16; ++i) v[i] = *(const f32x4*)(W + (size_t)(k0 + 4 * i + r4) * ldw + n0 + 4 * c4);
#pragma unroll
    for (int i = 0; i < 16; ++i) { LAS float* d = scr + (4 * i + r4) * 65 + 4 * c4; d[0] = v[i].x; d[1] = v[i].y; d[2] = v[i].z; d[3] = v[i].w; }
    LDS_WAIT(); asm volatile("" ::: "memory");
    const int c = lane & 7;
#pragma unroll
    for (int j = 0; j < 8; ++j) { const int n = (lane >> 3) + 8 * j; const LAS float* s = scr + (8 * c) * 65 + n;
        u32x4 o; o.x = pk2(s[0 * 65], s[1 * 65]); o.y = pk2(s[2 * 65], s[3 * 65]); o.z = pk2(s[4 * 65], s[5 * 65]); o.w = pk2(s[6 * 65], s[7 * 65]);
        *(u32x4*)(WT + (size_t)(drow0 + n) * ldt + k0 + 8 * c) = o; }
    LDS_WAIT(); asm volatile("" ::: "memory");
}
constexpr float WSCALE = 32.0f;
__device__ __forceinline__ void transpose_item64_f8(const float* W, int ldw, int k0, int n0, unsigned char* WT8, int ldt, int drow0, LAS float* scr, int lane) {
    f32x4 v[16];
    const int c4 = lane & 15, r4 = lane >> 4;
#pragma unroll
    for (int i = 0; i < 16; ++i) v[i] = *(const f32x4*)(W + (size_t)(k0 + 4 * i + r4) * ldw + n0 + 4 * c4);
#pragma unroll
    for (int i = 0; i < 16; ++i) { LAS float* d = scr + (4 * i + r4) * 65 + 4 * c4; d[0] = v[i].x; d[1] = v[i].y; d[2] = v[i].z; d[3] = v[i].w; }
    LDS_WAIT(); asm volatile("" ::: "memory");
    const int c = lane & 7;
#pragma unroll
    for (int j = 0; j < 8; ++j) { const int n = (lane >> 3) + 8 * j; const LAS float* s = scr + (8 * c) * 65 + n;
        const f32x4 lo = (f32x4){s[0 * 65], s[1 * 65], s[2 * 65], s[3 * 65]} * WSCALE, hi = (f32x4){s[4 * 65], s[5 * 65], s[6 * 65], s[7 * 65]} * WSCALE;
        *(u32x2*)(WT8 + (size_t)(drow0 + n) * ldt + k0 + 8 * c) = pk8(lo, hi); }
    LDS_WAIT(); asm volatile("" ::: "memory");
}
struct SmallW { const float *w_in, *w_out_a, *w_out_b, *w_out, *router_w, *sw1, *sw3, *sw2, *w_up, *a_up, *g_up, *gws; };
__device__ __forceinline__ void phase_small_weights(const SmallW& P, unsigned char* ws, LAS unsigned char* lds, int gw, int NGW, int wave, int lane) {
    LAS float* scr = (LAS float*)(lds + wave * 16640);
    constexpr int I0 = 16 * 76, I1 = 8 * 16, I2 = 8 * 16, I3 = 16 * 16, I4 = 16 * 8, I5 = 16 * 4, I6 = 16 * 4, I7 = 4 * 16, I8 = 16, I9 = 16, I10 = 2 * 16;
    constexpr int NIT = I0 + I1 + I2 + I3 + I4 + I5 + I6 + I7 + I8 + I9 + I10;
    for (int it = gw; it < NIT; it += NGW) {
        int r = it;
        if (r < I0) { const int kb = r / 76, nb = r % 76; transpose_item64_f8(P.w_in, IN_COLS, 64 * kb, 64 * nb, ws + SW_WIN, D, 64 * nb, scr, lane); continue; } r -= I0;
        if (r < I1) { transpose_item64_f8(P.w_out_a, D, 64 * (r >> 4), 64 * (r & 15), ws + SW_WOA, RW, 64 * (r & 15), scr, lane); continue; } r -= I1;
        if (r < I2) { transpose_item64_f8(P.w_out_b, D, 64 * (r >> 4), 64 * (r & 15), ws + SW_WOB, RW, 64 * (r & 15), scr, lane); continue; } r -= I2;
        if (r < I3) { transpose_item64_f8(P.w_out, D, 64 * (r >> 4), 64 * (r & 15), ws + SW_WO, D, 64 * (r & 15), scr, lane); continue; } r -= I3;
        if (r < I4) { transpose_job(P.router_w, D, NE, (bf16_t*)(ws + SW_WR), 0, 0, r, scr, lane); continue; } r -= I4;
        if (r < I5) { const int n0 = 64 * (r & 3); transpose_item64_f8(P.sw1, EFF, 64 * (r >> 2), n0, ws + SW_WS13, D, 256 * (n0 >> 7) + (n0 & 127), scr, lane); continue; } r -= I5;
        if (r < I6) { const int n0 = 64 * (r & 3); transpose_item64_f8(P.sw3, EFF, 64 * (r >> 2), n0, ws + SW_WS13, D, 256 * (n0 >> 7) + 128 + (n0 & 127), scr, lane); continue; } r -= I6;
        if (r < I7) { transpose_item64_f8(P.sw2, D, 64 * (r >> 4), 64 * (r & 15), ws + SW_WS2, EFF, 64 * (r & 15), scr, lane); continue; } r -= I7;
        if (r < I8) { transpose_job(P.w_up, 64, RW, (bf16_t*)(ws + SW_WUP), 0, 0, r, scr, lane); continue; } r -= I8;
        if (r < I9) { transpose_job(P.a_up, 64, RW, (bf16_t*)(ws + SW_AUP), 0, 0, r, scr, lane); continue; } r -= I9;
        transpose_job(P.g_up, 128, RW, (bf16_t*)(ws + SW_GUP), 0, 0, r, scr, lane);
    }
    bf16_t* wsm = (bf16_t*)(ws + SW_WSM);
    for (int i = gw * 64 + lane; i < 8 * 128 * 128; i += NGW * 64) { const int col = i & 127, row = (i >> 7) & 127; wsm[i] = (col <= row) ? f2bf(P.gws[i]) : (bf16_t)0; }
}
template <bool PERM16>
__device__ __forceinline__ void transpose_item128_f8(const float* W, int ldw, int k0, int n0, unsigned char* WT8, int ldt, int drow0, LAS float* scr, int lane) {
    f32x4 v[16];
    const int c4 = lane & 7, r8 = lane >> 3;
#pragma unroll
    for (int i = 0; i < 16; ++i) v[i] = *(const f32x4*)(W + (size_t)(k0 + 8 * i + r8) * ldw + n0 + 4 * c4);
#pragma unroll
    for (int i = 0; i < 16; ++i) { LAS float* d = scr + (8 * i + r8) * 33 + 4 * c4; d[0] = v[i].x; d[1] = v[i].y; d[2] = v[i].z; d[3] = v[i].w; }
    LDS_WAIT(); asm volatile("" ::: "memory");
    const int c = lane & 7;
#pragma unroll
    for (int j = 0; j < 4; ++j) { const int n = (lane >> 3) + 8 * j; const LAS float* s = scr + (16 * c) * 33 + n;
        f32x4 a0 = (f32x4){s[0 * 33], s[1 * 33], s[2 * 33], s[3 * 33]} * WSCALE, a1 = (f32x4){s[4 * 33], s[5 * 33], s[6 * 33], s[7 * 33]} * WSCALE;
        f32x4 a2 = (f32x4){s[8 * 33], s[9 * 33], s[10 * 33], s[11 * 33]} * WSCALE, a3 = (f32x4){s[12 * 33], s[13 * 33], s[14 * 33], s[15 * 33]} * WSCALE;
        const u32x2 lo = pk8(a0, a1), hi = pk8(a2, a3);
        int dr = drow0 + n; if (PERM16) { const int r = dr & 255; dr = (dr & ~255) + 128 * ((r >> 3) & 1) + 8 * (r >> 4) + (r & 7); }
        *(u32x4*)(WT8 + (size_t)dr * ldt + k0 + 16 * c) = (u32x4){lo.x, lo.y, hi.x, hi.y}; }
    LDS_WAIT(); asm volatile("" ::: "memory");
}
__device__ __forceinline__ void phase_expert_weights(const float* w1, const float* w3, const float* w2, unsigned char* ws, LAS unsigned char* lds, int gw, int NGW, int wave, int lane) {
    LAS float* scr = (LAS float*)(lds + wave * 16896);
    constexpr int PER = 64;
    for (int it = gw; it < NE * 3 * PER; it += NGW) {
        const int e = it / (3 * PER), r = it % (3 * PER), which = r / PER, item = r % PER;
        if (which < 2) { const int kb = item >> 3, nb = item & 7, n0 = 32 * nb;
            transpose_item128_f8<false>((which ? w3 : w1) + (size_t)e * D * EFF, EFF, 128 * kb, n0, ws + B_W13 + (size_t)e * 512 * D, D, 256 * (n0 >> 7) + which * 128 + (n0 & 127), scr, lane); }
        else { const int kb = item >> 5, nb = item & 31;
            transpose_item128_f8<true>(w2 + (size_t)e * EFF * D, D, 128 * kb, 32 * nb, ws + B_W2 + (size_t)e * D * EFF, EFF, 32 * nb, scr, lane); }
    }
}
template <bool XBF>
__device__ __forceinline__ void phase_norm_mod(const void* X, const float* gain, const float* mod, int sh_off, int sc_off, bf16_t* out, unsigned char* out8, int gw, int NGW, int lane) {
    constexpr int R = XBF ? 4 : 8;
    for (int m0 = gw; m0 < T; m0 += R * NGW) {
        f32x4 v[R][4];
#pragma unroll
        for (int rr = 0; rr < R; ++rr) { const int m = m0 + rr * NGW; const size_t mr = (size_t)(m < T ? m : m0);
            if constexpr (XBF) { const u32x2* xr = (const u32x2*)((const bf16_t*)X + mr * D) + lane;
#pragma unroll
                for (int j = 0; j < 4; ++j) { const u32x2 w = xr[64 * j]; v[rr][j] = (f32x4){bflo(w.x), bfhi(w.x), bflo(w.y), bfhi(w.y)}; } }
            else { const f32x4* xr = (const f32x4*)((const float*)X + mr * D) + lane;
#pragma unroll
                for (int j = 0; j < 4; ++j) v[rr][j] = xr[64 * j]; } }
#pragma unroll
        for (int rr = 0; rr < R; ++rr) { const int m = m0 + rr * NGW; if (m >= T) break;
            float ss = 0.f;
#pragma unroll
            for (int j = 0; j < 4; ++j) ss += (v[rr][j].x * v[rr][j].x + v[rr][j].y * v[rr][j].y) + (v[rr][j].z * v[rr][j].z + v[rr][j].w * v[rr][j].w);
            const float rstd = __builtin_amdgcn_rsqf(wave_sum(ss) * (1.f / D) + 1e-6f);
            const float* mb = mod + (size_t)(m >> 13) * 6144;
            u32x2* o8 = (u32x2*)(out + (size_t)m * D) + lane;
#pragma unroll
            for (int j = 0; j < 4; ++j) { const int col = 4 * lane + 256 * j;
                const f32x4 g = *(const f32x4*)(gain + col), sc = *(const f32x4*)(mb + sc_off + col), sh = *(const f32x4*)(mb + sh_off + col);
                const f32x4 y = v[rr][j] * rstd * g * (sc + 1.0f) + sh;
                if (out) { u32x2 w; w.x = pk2(y.x, y.y); w.y = pk2(y.z, y.w); o8[64 * j] = w; }
                if (out8) { int t8 = __builtin_amdgcn_cvt_pk_fp8_f32(y.x, y.y, 0, false); t8 = __builtin_amdgcn_cvt_pk_fp8_f32(y.z, y.w, t8, true); *(unsigned*)(out8 + (size_t)m * D + col) = (unsigned)t8; } } }
    }
}
struct YaArgs { bf16_t* ya; const bf16_t* g; const bf16_t* prw; const float* sbon; const float* mu; const float* ln_g; const float* ln_b; };
__device__ __forceinline__ void phase_ya_final(const YaArgs& P, int gw, int NGW, int lane) {
    const int ch0 = lane * 8, head = lane >> 3;
    float muv[8], lg[8], lb[8];
#pragma unroll
    for (int j = 0; j < 8; ++j) { muv[j] = P.mu[1024 + ch0 + j]; lg[j] = P.ln_g[ch0 + j]; lb[j] = P.ln_b[ch0 + j]; }
    for (int m = gw; m < T; m += NGW) {
        const u32x4 yw = *(const u32x4*)(P.ya + (size_t)m * RW + ch0);
        const u32x4 gw4 = *(const u32x4*)(P.g + (size_t)m * RW + ch0);
        const u32x4 vc = *(const u32x4*)(P.prw + (size_t)m * RWKV_COLS + 1024 + ch0);
        u32x4 vp = (u32x4){0u, 0u, 0u, 0u};
        if ((m & (SEQ - 1)) != 0) vp = *(const u32x4*)(P.prw + (size_t)(m - 1) * RWKV_COLS + 1024 + ch0);
        const float sb = P.sbon[(size_t)m * NH + head];
        float y[8], gg[8], vv[8], pv[8];
        y[0] = bflo(yw.x); y[1] = bfhi(yw.x); y[2] = bflo(yw.y); y[3] = bfhi(yw.y); y[4] = bflo(yw.z); y[5] = bfhi(yw.z); y[6] = bflo(yw.w); y[7] = bfhi(yw.w);
        gg[0] = bflo(gw4.x); gg[1] = bfhi(gw4.x); gg[2] = bflo(gw4.y); gg[3] = bfhi(gw4.y); gg[4] = bflo(gw4.z); gg[5] = bfhi(gw4.z); gg[6] = bflo(gw4.w); gg[7] = bfhi(gw4.w);
        vv[0] = bflo(vc.x); vv[1] = bfhi(vc.x); vv[2] = bflo(vc.y); vv[3] = bfhi(vc.y); vv[4] = bflo(vc.z); vv[5] = bfhi(vc.z); vv[6] = bflo(vc.w); vv[7] = bfhi(vc.w);
        pv[0] = bflo(vp.x); pv[1] = bfhi(vp.x); pv[2] = bflo(vp.y); pv[3] = bfhi(vp.y); pv[4] = bflo(vp.z); pv[5] = bfhi(vp.z); pv[6] = bflo(vp.w); pv[7] = bfhi(vp.w);
        float s = 0.f;
#pragma unroll
        for (int j = 0; j < 8; ++j) s += y[j];
        s += __shfl_xor(s, 1); s += __shfl_xor(s, 2); s += __shfl_xor(s, 4);
        const float mean = s * (1.f / 64.f); float q = 0.f;
#pragma unroll
        for (int j = 0; j < 8; ++j) { y[j] -= mean; q += y[j] * y[j]; }
        q += __shfl_xor(q, 1); q += __shfl_xor(q, 2); q += __shfl_xor(q, 4);
        const float rstd = __builtin_amdgcn_rsqf(q * (1.f / 64.f) + 64e-5f);
        float o[8];
#pragma unroll
        for (int j = 0; j < 8; ++j) { const float vs = vv[j] + (pv[j] - vv[j]) * muv[j]; o[j] = (y[j] * rstd * lg[j] + lb[j] + sb * vs) * gg[j]; }
        u32x4 w; w.x = pk2(o[0], o[1]); w.y = pk2(o[2], o[3]); w.z = pk2(o[4], o[5]); w.w = pk2(o[6], o[7]);
        *(u32x4*)(P.ya + (size_t)m * RW + ch0) = w;
    }
}
__device__ __forceinline__ void phase_xs(const bf16_t* prw, const float* mu, bf16_t* xs, int gw, int NGW, int lane) {
    const f32x4 m4 = *(const f32x4*)(mu + 1536 + 4 * lane);
    for (int t = gw; t < T; t += NGW) {
        const bf16_t* src = prw + (size_t)t * RWKV_COLS + 1536 + 4 * lane;
        const u32x2 cw = *(const u32x2*)src; u32x2 pw = (u32x2){0u, 0u};
        if ((t & (SEQ - 1)) != 0) pw = *(const u32x2*)(src - RWKV_COLS);
        f32x4 v = (f32x4){bflo(cw.x), bfhi(cw.x), bflo(cw.y), bfhi(cw.y)}; const f32x4 p = (f32x4){bflo(pw.x), bfhi(pw.x), bflo(pw.y), bfhi(pw.y)};
        v = v + (p - v) * m4;
        if (lane < 16) {
#pragma unroll
            for (int j = 0; j < 4; ++j) v[j] = tanhf_(v[j]); }
        else if (lane >= 32) {
#pragma unroll
            for (int j = 0; j < 4; ++j) v[j] = sigmoidf_(v[j]); }
        u32x2 w; w.x = pk2(v[0], v[1]); w.y = pk2(v[2], v[3]);
        *(u32x2*)(xs + (size_t)t * 256 + 4 * lane) = w;
    }
}
__device__ __forceinline__ void phase_gate(const bf16_t* xs, const bf16_t* gup, bf16_t* g, int gw, int NGW, int lane) {
    const int r = lane & 15, q = lane >> 4;
    for (int item = gw; item < 8 * 256; item += NGW) {
        const int cb = item & 7, tg = item >> 3;
        bf16x8 af[4][4];
#pragma unroll
        for (int mt = 0; mt < 4; ++mt)
#pragma unroll
            for (int s = 0; s < 4; ++s) af[mt][s] = *(const bf16x8*)(gup + (size_t)(cb * 64 + 16 * mt + r) * 128 + 32 * s + 8 * q);
        bf16x8 nb[4];
#pragma unroll
        for (int s = 0; s < 4; ++s) nb[s] = *(const bf16x8*)(xs + (size_t)(tg * 256 + r) * 256 + 128 + 32 * s + 8 * q);
        for (int tt = 0; tt < 16; ++tt) {
            const int t0 = tg * 256 + tt * 16;
            bf16x8 bfr[4];
#pragma unroll
            for (int s = 0; s < 4; ++s) bfr[s] = nb[s];
            if (tt + 1 < 16) {
#pragma unroll
                for (int s = 0; s < 4; ++s) nb[s] = *(const bf16x8*)(xs + (size_t)(t0 + 16 + r) * 256 + 128 + 32 * s + 8 * q); }
#pragma unroll
            for (int mt = 0; mt < 4; ++mt) { f32x4 acc = (f32x4){0.f, 0.f, 0.f, 0.f};
#pragma unroll
                for (int s = 0; s < 4; ++s) acc = __builtin_amdgcn_mfma_f32_16x16x32_bf16(af[mt][s], bfr[s], acc, 0, 0, 0);
                u32x2 w; w.x = pk2(acc[0], acc[1]); w.y = pk2(acc[2], acc[3]);
                *(u32x2*)(g + (size_t)(t0 + r) * RW + cb * 64 + 16 * mt + 4 * q) = w; }
        }
    }
}
__device__ __forceinline__ void phase_combine(float* out, const bf16_t* x1, const unsigned char* slot, const unsigned char* sho, const float* mod, const float* normf, int gw, int NGW, int lane) {
    for (int m = gw; m < T; m += NGW) {
        const int b = m >> 13;
        f32x4* xr = (f32x4*)(out + (size_t)m * D + 16 * lane);
        const float* g2 = mod + (size_t)b * 6144 + 5120 + 16 * lane;
        u32x4 sw[TOPK + 1];
#pragma unroll
        for (int k = 0; k < TOPK; ++k) sw[k] = *(const u32x4*)(slot + ((size_t)m * TOPK + k) * D + 16 * lane);
        sw[TOPK] = *(const u32x4*)(sho + (size_t)m * D + 16 * lane);
        f32x4 x[4];
        { const u32x4 w0 = *(const u32x4*)(x1 + (size_t)m * D + 16 * lane), w1 = *(const u32x4*)(x1 + (size_t)m * D + 16 * lane + 8);
          x[0] = (f32x4){bflo(w0.x), bfhi(w0.x), bflo(w0.y), bfhi(w0.y)}; x[1] = (f32x4){bflo(w0.z), bfhi(w0.z), bflo(w0.w), bfhi(w0.w)};
          x[2] = (f32x4){bflo(w1.x), bfhi(w1.x), bflo(w1.y), bfhi(w1.y)}; x[3] = (f32x4){bflo(w1.z), bfhi(w1.z), bflo(w1.w), bfhi(w1.w)}; }
        f32x4 a[4];
#pragma unroll
        for (int j = 0; j < 4; ++j) a[j] = (f32x4){0.f, 0.f, 0.f, 0.f};
#pragma unroll
        for (int k = 0; k <= TOPK; ++k) { a[0] += up8(sw[k].x); a[1] += up8(sw[k].y); a[2] += up8(sw[k].z); a[3] += up8(sw[k].w); }
        float ss = 0.f;
#pragma unroll
        for (int j = 0; j < 4; ++j) { x[j] = x[j] + *(const f32x4*)(g2 + 4 * j) * a[j]; ss += (x[j].x * x[j].x + x[j].y * x[j].y) + (x[j].z * x[j].z + x[j].w * x[j].w); }
        const float rstd = __builtin_amdgcn_rsqf(wave_sum(ss) * (1.f / D) + 1e-6f);
#pragma unroll
        for (int j = 0; j < 4; ++j) xr[j] = x[j] * rstd * *(const f32x4*)(normf + 16 * lane + 4 * j);
    }
}
namespace rk {
constexpr int LD = 80;
constexpr int SLOTB = 64 * LD * 2;
constexpr int LDG = 136;
typedef LAS bf16_t* lp;
__device__ __forceinline__ lp slot(LAS unsigned char* lds, int i) { return (lp)(lds + i * SLOTB); }
template <int KS>
__device__ __forceinline__ void mm_nt(const LAS bf16_t* X, int ldx, const LAS bf16_t* Y, int ldy, int m, int nt0, int r, int q, f32x4 (&acc)[2]) {
#pragma unroll
    for (int s = 0; s < KS; ++s) {
        const bf16x8 a = *(const LAS bf16x8*)(X + (16 * m + r) * ldx + 32 * s + 8 * q);
#pragma unroll
        for (int n = 0; n < 2; ++n) { const bf16x8 b = *(const LAS bf16x8*)(Y + (16 * (nt0 + n) + r) * ldy + 32 * s + 8 * q); acc[n] = __builtin_amdgcn_mfma_f32_16x16x32_bf16(a, b, acc[n], 0, 0, 0); }
    }
}
__device__ __forceinline__ void st_rm(lp dst, int m, int nt, int r, int q, const f32x4& a) {
#pragma unroll
    for (int ii = 0; ii < 4; ++ii) dst[(16 * m + 4 * q + ii) * LD + 16 * nt + r] = f2bf(a[ii]);
}
__device__ __forceinline__ void st_tr(lp dst, int m, int nt, int r, int q, const f32x4& a) {
    u32x2 w; w.x = pk2(a[0], a[1]); w.y = pk2(a[2], a[3]); *(LAS u32x2*)(dst + (16 * nt + r) * LD + 16 * m + 4 * q) = w;
}
__device__ __forceinline__ void ld_rm(const LAS bf16_t* src, int m, int nt, int r, int q, f32x4& a) {
#pragma unroll
    for (int ii = 0; ii < 4; ++ii) a[ii] = bf2f(src[(16 * m + 4 * q + ii) * LD + 16 * nt + r]);
}
struct Args {
    const bf16_t* prw; const float* mu; const float *w0, *a0, *k_k, *k_a, *r_k;
    const bf16_t *wup, *aup, *gup;
    const bf16_t* xs;
    bf16_t* g; bf16_t* bv; unsigned char* mn; unsigned char* qy;
};
constexpr int LDS_MU = LDS_MISC + 2304;
struct Pre { u32x4 cw[3], pw[3]; bf16x8 xs[4]; };
__device__ __forceinline__ void task_map(int task, int h, int& i, int& ch, int& col) {
    i = task / 24; ch = task % 24;
    col = (ch >> 3) * 512 + h * 64 + 8 * (ch & 7);
}
__device__ __forceinline__ void load_mu(const Args& P, LAS unsigned char* lds, int tid) {
    LAS bf16_t* MU = (LAS bf16_t*)(lds + LDS_MU);
    for (int i = tid; i < 1536; i += NTHREADS) MU[i] = f2bf(P.mu[i]);
    __syncthreads();
}
struct Hd { bf16x8 w[4], a[4]; float w0[2], a0[2], kk[2], ka[2], rk[2]; };
__device__ __forceinline__ void load_head(const Args& P, int h, int tid, Hd& hd) {
    const int lane = tid & 63, r = lane & 15, q = lane >> 4, nh = tid >> 8;
#pragma unroll
    for (int n = 0; n < 2; ++n) { const int row = h * 64 + 16 * (2 * nh + n) + r;
#pragma unroll
        for (int s = 0; s < 2; ++s) { hd.w[s * 2 + n] = *(const bf16x8*)(P.wup + (size_t)row * 64 + 32 * s + 8 * q); hd.a[s * 2 + n] = *(const bf16x8*)(P.aup + (size_t)row * 64 + 32 * s + 8 * q); }
        hd.w0[n] = P.w0[row]; hd.a0[n] = P.a0[row]; hd.kk[n] = P.k_k[row]; hd.ka[n] = P.k_a[row]; hd.rk[n] = P.r_k[row]; }
}
__device__ __forceinline__ void prefetch(const Args& P, int b, int h, int c, int tid, Pre& pre) {
    const int t0 = b * SEQ + c * 64;
#pragma unroll
    for (int it = 0; it < 3; ++it) {
        int i, ch, col; task_map(tid + it * NTHREADS, h, i, ch, col);
        const bf16_t* src = P.prw + (size_t)(t0 + i) * RWKV_COLS + col;
        pre.cw[it] = *(const u32x4*)src;
        pre.pw[it] = (u32x4){0u, 0u, 0u, 0u};
        if (i != 0 || c != 0) pre.pw[it] = *(const u32x4*)(src - RWKV_COLS);
    }
    const int lane = tid & 63, r = lane & 15, q = lane >> 4, m = (tid >> 6) & 3;
    const bf16_t* xr = P.xs + (size_t)(t0 + 16 * m + r) * 256 + 8 * q;
#pragma unroll
    for (int f = 0; f < 4; ++f) pre.xs[f] = *(const bf16x8*)(xr + 32 * f);
}
__device__ __forceinline__ void unit(const Args& P, LAS unsigned char* lds, int b, int h, int c, int uidx, int tid, Pre& pf, Hd& hd, bool has_next, int nb, int nh_, int nc) {
    const int wave = __builtin_amdgcn_readfirstlane(tid >> 6), lane = tid & 63, r = lane & 15, q = lane >> 4, m = wave & 3, nh = wave >> 2;
    const int t0 = b * SEQ + c * 64;
    lp S0 = slot(lds, 0), S1 = slot(lds, 1), S2 = slot(lds, 2), S3 = slot(lds, 3), S4 = slot(lds, 4), S5 = slot(lds, 5), S6 = slot(lds, 6), S7 = slot(lds, 7);
    lp S8 = slot(lds, 8), S9 = slot(lds, 9), S10 = slot(lds, 10), S11 = slot(lds, 11), S12 = slot(lds, 12), S13 = slot(lds, 13), S14 = slot(lds, 14);
    LAS float* PART = (LAS float*)(lds + LDS_MISC);
    LAS float* CT = PART + 256;
    LAS float* DEND = CT + 256;
    const LAS bf16_t* MU = (const LAS bf16_t*)(lds + LDS_MU);
#define RK_BAR() do { asm volatile("s_waitcnt lgkmcnt(0)" ::: "memory"); __builtin_amdgcn_s_barrier(); asm volatile("" ::: "memory"); } while (0)
#define RK_DBG(bit, sp) do {} while (0)
#pragma unroll
    for (int it = 0; it < 3; ++it) {
        int i, ch, col; task_map(tid + it * NTHREADS, h, i, ch, col);
        LAS bf16_t* dst = slot(lds, 8 + (ch >> 3)) + i * LD + 8 * (ch & 7);
        const u32x4 cw = pf.cw[it], pw = pf.pw[it];
        const u32x4 mw = *(const LAS u32x4*)(MU + col);
        const f32x4 m0 = (f32x4){bflo(mw.x), bfhi(mw.x), bflo(mw.y), bfhi(mw.y)}, m1 = (f32x4){bflo(mw.z), bfhi(mw.z), bflo(mw.w), bfhi(mw.w)};
        float v[8], p[8];
        v[0] = bflo(cw.x); v[1] = bfhi(cw.x); v[2] = bflo(cw.y); v[3] = bfhi(cw.y); v[4] = bflo(cw.z); v[5] = bfhi(cw.z); v[6] = bflo(cw.w); v[7] = bfhi(cw.w);
        p[0] = bflo(pw.x); p[1] = bfhi(pw.x); p[2] = bflo(pw.y); p[3] = bfhi(pw.y); p[4] = bflo(pw.z); p[5] = bfhi(pw.z); p[6] = bflo(pw.w); p[7] = bfhi(pw.w);
#pragma unroll
        for (int j = 0; j < 4; ++j) { v[j] += (p[j] - v[j]) * m0[j]; v[4 + j] += (p[4 + j] - v[4 + j]) * m1[j]; }
        u32x4 w; w.x = pk2(v[0], v[1]); w.y = pk2(v[2], v[3]); w.z = pk2(v[4], v[5]); w.w = pk2(v[6], v[7]);
        *(LAS u32x4*)dst = w;
    }
    RK_BAR();
    f32x4 aw[2], aa[2];
#pragma unroll
    for (int n = 0; n < 2; ++n) { aw[n] = (f32x4){0.f, 0.f, 0.f, 0.f}; aa[n] = aw[n]; }
#pragma unroll
    for (int s = 0; s < 2; ++s)
#pragma unroll
        for (int n = 0; n < 2; ++n) { aw[n] = __builtin_amdgcn_mfma_f32_16x16x32_bf16(pf.xs[s], hd.w[s * 2 + n], aw[n], 0, 0, 0); aa[n] = __builtin_amdgcn_mfma_f32_16x16x32_bf16(pf.xs[2 + s], hd.a[s * 2 + n], aa[n], 0, 0, 0); }
    if (has_next) prefetch(P, nb, nh_, nc, tid, pf);
    float rr[2][4], kq[2][4], vv[2][4], av[2][4], lw[2][4], kp[2][4], pre[2][4], preq[2];
    float ss[4] = {0.f, 0.f, 0.f, 0.f}, bs[4] = {0.f, 0.f, 0.f, 0.f};
#pragma unroll
    for (int n = 0; n < 2; ++n) {
        const int ch = 32 * nh + 16 * n + r, chg = h * 64 + ch;
        const float w0v = hd.w0[n], a0v = hd.a0[n], kkc = hd.kk[n], kac = hd.ka[n], rkc = hd.rk[n];
#pragma unroll
        for (int ii = 0; ii < 4; ++ii) {
            const int pos = 16 * m + 4 * q + ii;
            const float rv = bf2f(S8[pos * LD + ch]), kraw = bf2f(S9[pos * LD + ch]); vv[n][ii] = bf2f(S10[pos * LD + ch]); rr[n][ii] = rv;
            const float z = -(w0v + aw[n][ii]);
            const float sp = fmaxf(z, 0.f) + flog(1.0f + fexp(-fabsf(z)));
            lw[n][ii] = -fexp(-sp - 0.5f);
            const float a_ = sigmoidf_(a0v + aa[n][ii]); av[n][ii] = a_;
            const float kk = kraw * kkc; kq[n][ii] = kk;
            const float kpv = kraw * (1.0f + (a_ - 1.0f) * kac); kp[n][ii] = kpv;
            ss[ii] += kk * kk; bs[ii] += rv * kpv * rkc;
        }
        pre[n][0] = lw[n][0]; pre[n][1] = pre[n][0] + lw[n][1]; pre[n][2] = pre[n][1] + lw[n][2]; pre[n][3] = pre[n][2] + lw[n][3];
        const float tot = pre[n][3];
        const float t0_ = __shfl(tot, r), t1_ = __shfl(tot, r + 16), t2_ = __shfl(tot, r + 32), t3_ = __shfl(tot, r + 48);
        preq[n] = (q > 0 ? t0_ : 0.f) + (q > 1 ? t1_ : 0.f) + (q > 2 ? t2_ : 0.f);
        if (q == 0) CT[m * 64 + ch] = (t0_ + t1_) + (t2_ + t3_);
    }
#pragma unroll
    for (int ii = 0; ii < 4; ++ii) {
#pragma unroll
        for (int o = 1; o < 16; o <<= 1) { ss[ii] += __shfl_xor(ss[ii], o); bs[ii] += __shfl_xor(bs[ii], o); }
        if (r == 0) { const int pos = 16 * m + 4 * q + ii; PART[(nh * 64 + pos) * 2] = ss[ii]; PART[(nh * 64 + pos) * 2 + 1] = bs[ii]; }
    }
    RK_BAR();
#pragma unroll
    for (int n = 0; n < 2; ++n) {
        const int ch = 32 * nh + 16 * n + r;
        float carry = 0.f, lend = 0.f;
#pragma unroll
        for (int mm = 0; mm < 4; ++mm) { const float cv = CT[mm * 64 + ch]; lend += cv; carry += (mm < m) ? cv : 0.f; }
        f32x4 tA, tBh, tKh, tV;
#pragma unroll
        for (int ii = 0; ii < 4; ++ii) {
            const int pos = 16 * m + 4 * q + ii;
            const float L = carry + preq[n] + pre[n][ii], Lm1 = L - lw[n][ii];
            const float ssum = PART[pos * 2] + PART[(64 + pos) * 2];
            const float inv = frcp(fmaxf(__builtin_sqrtf(ssum), 1e-12f));
            const float kkn = kq[n][ii] * inv, kb = kkn * av[n][ii];
            const float eN = fexp(-L), eE = fexp(lend - L);
            const float At = -kkn * fexp(Lm1), Rt = rr[n][ii] * fexp(L), Bt = kb * eN, Kt = kp[n][ii] * eN;
            S0[pos * LD + ch] = f2bf(At); S1[pos * LD + ch] = f2bf(Bt); S2[pos * LD + ch] = f2bf(Kt); S3[pos * LD + ch] = f2bf(Rt);
            tA[ii] = At; tBh[ii] = kb * eE; tKh[ii] = kp[n][ii] * eE; tV[ii] = vv[n][ii];
            P.bv[(size_t)(t0 + pos) * RW + h * 64 + ch] = f2bf((PART[pos * 2 + 1] + PART[(64 + pos) * 2 + 1]) * vv[n][ii]);
        }
        { u32x2 w; const int off = ch * LD + 16 * m + 4 * q;
          w.x = pk2(tA[0], tA[1]); w.y = pk2(tA[2], tA[3]); *(LAS u32x2*)(S4 + off) = w;
          w.x = pk2(tBh[0], tBh[1]); w.y = pk2(tBh[2], tBh[3]); *(LAS u32x2*)(S5 + off) = w;
          w.x = pk2(tKh[0], tKh[1]); w.y = pk2(tKh[2], tKh[3]); *(LAS u32x2*)(S6 + off) = w;
          w.x = pk2(tV[0], tV[1]); w.y = pk2(tV[2], tV[3]); *(LAS u32x2*)(S7 + off) = w; }
        if (m == 0 && q == 0) DEND[ch] = fexp(lend);
    }
    RK_BAR();
    if (has_next) load_head(P, nh_, tid, hd);
    RK_DBG(0, S0); RK_DBG(1, S1); RK_DBG(2, S2); RK_DBG(3, S3); RK_DBG(4, S4); RK_DBG(5, S5); RK_DBG(6, S6); RK_DBG(7, S7);
    const int nt0 = 2 * nh;
    f32x4 acc[2], acc2[2];
#define RK_ZERO(a) do { a[0] = (f32x4){0.f, 0.f, 0.f, 0.f}; a[1] = a[0]; } while (0)
#define RK_LDT(src, mt, ntt, a) do { const u32x2 w_ = *(const LAS u32x2*)((src) + (16 * (ntt) + r) * LD + 16 * (mt) + 4 * q); a = (f32x4){bflo(w_.x), bfhi(w_.x), bflo(w_.y), bfhi(w_.y)}; } while (0)
#define RK_MASK(a, ntt, COND) do { _Pragma("unroll") for (int ii = 0; ii < 4; ++ii) { const int row = 16 * m + 4 * q + ii, col = 16 * (ntt) + r; a[ii] = (COND) ? a[ii] : 0.f; } } while (0)
    RK_ZERO(acc); mm_nt<2>(S0, LD, S1, LD, m, nt0, r, q, acc);
#pragma unroll
    for (int n = 0; n < 2; ++n) { RK_MASK(acc[n], nt0 + n, col < row); st_tr(S9, m, nt0 + n, r, q, acc[n]); }
    RK_ZERO(acc); mm_nt<2>(S1, LD, S0, LD, m, nt0, r, q, acc);
#pragma unroll
    for (int n = 0; n < 2; ++n) { RK_MASK(acc[n], nt0 + n, row < col); st_tr(S8, m, nt0 + n, r, q, acc[n]);
#pragma unroll
        for (int ii = 0; ii < 4; ++ii) acc[n][ii] += ((16 * m + 4 * q + ii) == (16 * (nt0 + n) + r)) ? 1.f : 0.f;
        st_tr(S10, m, nt0 + n, r, q, acc[n]); }
    RK_ZERO(acc); mm_nt<2>(S2, LD, S0, LD, m, nt0, r, q, acc);
#pragma unroll
    for (int n = 0; n < 2; ++n) { RK_MASK(acc[n], nt0 + n, row < col); st_tr(S11, m, nt0 + n, r, q, acc[n]); }
    RK_ZERO(acc); mm_nt<2>(S1, LD, S3, LD, m, nt0, r, q, acc);
#pragma unroll
    for (int n = 0; n < 2; ++n) { RK_MASK(acc[n], nt0 + n, row <= col); st_tr(S12, m, nt0 + n, r, q, acc[n]); }
    RK_ZERO(acc); mm_nt<2>(S2, LD, S3, LD, m, nt0, r, q, acc);
#pragma unroll
    for (int n = 0; n < 2; ++n) { RK_MASK(acc[n], nt0 + n, row <= col); st_tr(S13, m, nt0 + n, r, q, acc[n]); }
    RK_BAR();
    RK_ZERO(acc); mm_nt<2>(S8, LD, S9, LD, m, nt0, r, q, acc);
    RK_ZERO(acc2); mm_nt<2>(S9, LD, S8, LD, m, nt0, r, q, acc2);
#pragma unroll
    for (int n = 0; n < 2; ++n) { st_tr(S1, m, nt0 + n, r, q, acc[n]); st_tr(S0, m, nt0 + n, r, q, acc2[n]); }
    RK_ZERO(acc); mm_nt<2>(S11, LD, S7, LD, m, nt0, r, q, acc);
#pragma unroll
    for (int n = 0; n < 2; ++n) st_tr(S14, m, nt0 + n, r, q, acc[n]);
    RK_BAR();
#define RK_ROUND(Tsrc, Tdst, Psrc, PTsrc, Pdst, PTdst) do { \
        RK_LDT(Tsrc, m, nt0, acc[0]); RK_LDT(Tsrc, m, nt0 + 1, acc[1]); mm_nt<2>(PTsrc, LD, Tsrc, LD, m, nt0, r, q, acc); \
        _Pragma("unroll") for (int n = 0; n < 2; ++n) st_tr(Tdst, m, nt0 + n, r, q, acc[n]); \
        RK_ZERO(acc); mm_nt<2>(Psrc, LD, PTsrc, LD, m, nt0, r, q, acc); RK_ZERO(acc2); mm_nt<2>(PTsrc, LD, Psrc, LD, m, nt0, r, q, acc2); \
        _Pragma("unroll") for (int n = 0; n < 2; ++n) { st_tr(PTdst, m, nt0 + n, r, q, acc[n]); st_tr(Pdst, m, nt0 + n, r, q, acc2[n]); } \
        RK_BAR(); } while (0)
#ifndef EXP_SKIP_ROUNDS
    RK_ROUND(S10, S2, S0, S1, S8, S9);
    RK_ROUND(S2, S10, S8, S9, S0, S1);
    RK_ROUND(S10, S2, S0, S1, S8, S9);
    RK_ROUND(S2, S10, S8, S9, S0, S1);
#endif
    RK_LDT(S10, m, nt0, acc[0]); RK_LDT(S10, m, nt0 + 1, acc[1]); mm_nt<2>(S1, LD, S10, LD, m, nt0, r, q, acc);
#pragma unroll
    for (int n = 0; n < 2; ++n) st_tr(S2, m, nt0 + n, r, q, acc[n]);
    RK_BAR();
    RK_ZERO(acc); mm_nt<2>(S2, LD, S4, LD, m, nt0, r, q, acc);
    RK_ZERO(acc2); mm_nt<2>(S2, LD, S14, LD, m, nt0, r, q, acc2);
#pragma unroll
    for (int n = 0; n < 2; ++n) { st_tr(S11, m, nt0 + n, r, q, acc[n]); st_tr(S0, m, nt0 + n, r, q, acc2[n]); }
    RK_BAR();
    {
        const int sw = wave & 1, ntw = wave >> 1;
        unsigned char* mn_ = P.mn + (size_t)uidx * 16384; unsigned char* qy_ = P.qy + (size_t)uidx * 16384;
        f32x4 c2[2];
#define RK_MM2(X, Y) do { _Pragma("unroll") for (int s_ = 0; s_ < 2; ++s_) { const bf16x8 b_ = *(const LAS bf16x8*)((Y) + (16 * ntw + r) * LD + 32 * s_ + 8 * q); \
            _Pragma("unroll") for (int mi = 0; mi < 2; ++mi) { const bf16x8 a_ = *(const LAS bf16x8*)((X) + (16 * (2 * sw + mi) + r) * LD + 32 * s_ + 8 * q); c2[mi] = __builtin_amdgcn_mfma_f32_16x16x32_bf16(a_, b_, c2[mi], 0, 0, 0); } } } while (0)
        RK_ZERO(c2); RK_MM2(S11, S5);
#pragma unroll
        for (int mi = 0; mi < 2; ++mi)
#pragma unroll
            for (int ii = 0; ii < 4; ++ii) { const int row = 16 * (2 * sw + mi) + 4 * q + ii, col = 16 * ntw + r; c2[mi][ii] += (row == col) ? DEND[row] : 0.f; }
        { u32x4 w; w.x = pk2(c2[0][0], c2[0][1]); w.y = pk2(c2[0][2], c2[0][3]); w.z = pk2(c2[1][0], c2[1][1]); w.w = pk2(c2[1][2], c2[1][3]); *(u32x4*)(mn_ + ((ntw * 2 + sw) * 64 + lane) * 16) = w; }
#pragma unroll
        for (int mi = 0; mi < 2; ++mi) { const u32x2 rw_ = *(const LAS u32x2*)(S3 + (16 * ntw + r) * LD + 16 * (2 * sw + mi) + 4 * q); c2[mi] = (f32x4){bflo(rw_.x), bfhi(rw_.x), bflo(rw_.y), bfhi(rw_.y)}; }
        RK_MM2(S11, S12);
        { u32x4 w; w.x = pk2(c2[0][0], c2[0][1]); w.y = pk2(c2[0][2], c2[0][3]); w.z = pk2(c2[1][0], c2[1][1]); w.w = pk2(c2[1][2], c2[1][3]); *(u32x4*)(qy_ + ((ntw * 2 + sw) * 64 + lane) * 16) = w; }
        RK_ZERO(c2); RK_MM2(S5, S0); RK_MM2(S6, S7);
#pragma unroll
        for (int mi = 0; mi < 2; ++mi) { u32x2 w; w.x = pk2(c2[mi][0], c2[mi][1]); w.y = pk2(c2[mi][2], c2[mi][3]); *(u32x2*)(mn_ + 8192 + ((ntw * 4 + 2 * sw + mi) * 64 + lane) * 8) = w; }
        RK_ZERO(c2); RK_MM2(S0, S12); RK_MM2(S7, S13);
#pragma unroll
        for (int mi = 0; mi < 2; ++mi) { u32x2 w; w.x = pk2(c2[mi][0], c2[mi][1]); w.y = pk2(c2[mi][2], c2[mi][3]); *(u32x2*)(qy_ + 8192 + (((2 * sw + mi) * 4 + ntw) * 64 + lane) * 8) = w; }
#undef RK_MM2
    }
    RK_BAR();
#undef RK_ZERO
#undef RK_ROUND
#undef RK_LDT
#undef RK_MASK
#undef RK_BAR
}
__device__ __forceinline__ void scan_wg(const unsigned char* mn, unsigned char* sbuf, int ubase, int vq, LAS unsigned char* lds, int tid) {
    const int wave = __builtin_amdgcn_readfirstlane(tid >> 6), lane = tid & 63;
    constexpr int NC = SEQ / 64, NS = 8, SLOT = 10240, AHEAD = 6;
    const unsigned char* src = mn + (size_t)ubase * 16384 + lane * 16;
    const bool loader = (wave >= 1 && wave <= 5);
    const size_t poff = (wave == 5) ? (size_t)(8192 + vq * 2048) : (size_t)(2048 * (wave - 1));
#define SC_ISSUE(c) do { const unsigned char* s_ = src + (size_t)(c) * 16384 + poff; LAS unsigned char* d_ = lds + ((c) % NS) * SLOT + 2048 * (wave - 1); \
        _Pragma("unroll") for (int i_ = 0; i_ < 2; ++i_) __builtin_amdgcn_global_load_lds((const unsigned*)(s_ + i_ * 1024), (LAS unsigned*)(d_ + i_ * 1024), 16, 0, 0); } while (0)
#define SC_BAR() do { asm volatile("s_waitcnt lgkmcnt(0)" ::: "memory"); __builtin_amdgcn_s_barrier(); asm volatile("" ::: "memory"); } while (0)
    bf16x8 sB[2];
#pragma unroll
    for (int s = 0; s < 2; ++s) sB[s] = (bf16x8){0, 0, 0, 0, 0, 0, 0, 0};
    if (loader) {
#pragma unroll
        for (int c = 0; c < AHEAD; ++c) SC_ISSUE(c);
        asm volatile("s_waitcnt vmcnt(10)" ::: "memory"); }
    SC_BAR();
    for (int c = 0; c < NC; ++c) {
        if (loader) {
            if (c + AHEAD < NC) { SC_ISSUE(c + AHEAD); asm volatile("s_waitcnt vmcnt(10)" ::: "memory"); }
            else { asm volatile("s_waitcnt vmcnt(0)" ::: "memory"); }
        } else if (wave == 0) {
            const LAS unsigned char* sl = lds + (c % NS) * SLOT;
            unsigned char* so = sbuf + (size_t)(ubase + c) * 8192 + (vq * 2) * 1024 + lane * 16;
            *(bf16x8*)so = sB[0]; *(bf16x8*)(so + 1024) = sB[1];
            f32x4 aS[4];
#pragma unroll
            for (int mm = 0; mm < 4; ++mm) {
                const u32x2 nI = *(const LAS u32x2*)(sl + 8192 + (mm * 64 + lane) * 8);
                aS[mm] = (f32x4){bflo(nI.x), bfhi(nI.x), bflo(nI.y), bfhi(nI.y)};
#pragma unroll
                for (int s = 0; s < 2; ++s) { const bf16x8 aM = *(const LAS bf16x8*)(sl + ((mm * 2 + s) * 64 + lane) * 16); aS[mm] = __builtin_amdgcn_mfma_f32_16x16x32_bf16(aM, sB[s], aS[mm], 0, 0, 0); }
            }
#pragma unroll
            for (int s = 0; s < 2; ++s) { u32x4 w; w.x = pk2(aS[2 * s][0], aS[2 * s][1]); w.y = pk2(aS[2 * s][2], aS[2 * s][3]); w.z = pk2(aS[2 * s + 1][0], aS[2 * s + 1][1]); w.w = pk2(aS[2 * s + 1][2], aS[2 * s + 1][3]);
                sB[s] = __builtin_bit_cast(bf16x8, w); }
        }
        SC_BAR();
    }
#undef SC_ISSUE
#undef SC_BAR
}
struct YArgs { const unsigned char* qy; const unsigned char* sbuf; const bf16_t* g; const bf16_t* bv; const float* ln_g; const float* ln_b; unsigned char* ya; };
__device__ __forceinline__ void ypass_unit(const YArgs& P, int u, int lane) {
    const int r = lane & 15, q = lane >> 4, b = u >> 10, h = (u >> 7) & 7, c = u & 127, t0 = b * SEQ + c * 64;
    const unsigned char* qy_ = P.qy + (size_t)u * 16384; const unsigned char* s_ = P.sbuf + (size_t)u * 8192;
    bf16x8 Qf[4][2], Sf[4][2]; u32x2 y0[4][4];
#pragma unroll
    for (int i = 0; i < 4; ++i)
#pragma unroll
        for (int s = 0; s < 2; ++s) { Qf[i][s] = *(const bf16x8*)(qy_ + ((i * 2 + s) * 64 + lane) * 16); Sf[i][s] = *(const bf16x8*)(s_ + ((i * 2 + s) * 64 + lane) * 16); }
#pragma unroll
    for (int vq = 0; vq < 4; ++vq)
#pragma unroll
        for (int mm = 0; mm < 4; ++mm) y0[vq][mm] = *(const u32x2*)(qy_ + 8192 + ((vq * 4 + mm) * 64 + lane) * 8);
    f32x4 lg[4], lb[4];
#pragma unroll
    for (int vq = 0; vq < 4; ++vq) { lg[vq] = *(const f32x4*)(P.ln_g + h * 64 + 16 * vq + 4 * q); lb[vq] = *(const f32x4*)(P.ln_b + h * 64 + 16 * vq + 4 * q); }
#pragma unroll
    for (int mm = 0; mm < 4; ++mm) {
        const size_t ro = (size_t)(t0 + 16 * mm + r) * RW + h * 64 + 4 * q;
        u32x2 gw_[4], bw_[4];
#pragma unroll
        for (int vq = 0; vq < 4; ++vq) { gw_[vq] = *(const u32x2*)(P.g + ro + 16 * vq); bw_[vq] = *(const u32x2*)(P.bv + ro + 16 * vq); }
        f32x4 acc[4]; float sum = 0.f;
#pragma unroll
        for (int vq = 0; vq < 4; ++vq) {
            acc[vq] = (f32x4){bflo(y0[vq][mm].x), bfhi(y0[vq][mm].x), bflo(y0[vq][mm].y), bfhi(y0[vq][mm].y)};
#pragma unroll
            for (int s = 0; s < 2; ++s) acc[vq] = __builtin_amdgcn_mfma_f32_16x16x32_bf16(Sf[vq][s], Qf[mm][s], acc[vq], 0, 0, 0);
            sum += (acc[vq][0] + acc[vq][1]) + (acc[vq][2] + acc[vq][3]);
        }
        sum += __shfl_xor(sum, 16); sum += __shfl_xor(sum, 32);
        const float mean = sum * (1.f / 64.f); float var = 0.f;
#pragma unroll
        for (int vq = 0; vq < 4; ++vq) { acc[vq] = acc[vq] - mean; var += (acc[vq][0] * acc[vq][0] + acc[vq][1] * acc[vq][1]) + (acc[vq][2] * acc[vq][2] + acc[vq][3] * acc[vq][3]); }
        var += __shfl_xor(var, 16); var += __shfl_xor(var, 32);
        const float rstd = __builtin_amdgcn_rsqf(var * (1.f / 64.f) + 64e-5f);
#pragma unroll
        for (int vq = 0; vq < 4; ++vq) {
            const f32x4 gg = (f32x4){bflo(gw_[vq].x), bfhi(gw_[vq].x), bflo(gw_[vq].y), bfhi(gw_[vq].y)}, bb = (f32x4){bflo(bw_[vq].x), bfhi(bw_[vq].x), bflo(bw_[vq].y), bfhi(bw_[vq].y)};
            const f32x4 o = (acc[vq] * rstd * lg[vq] + lb[vq] + bb) * gg;
            int t8 = __builtin_amdgcn_cvt_pk_fp8_f32(o[0], o[1], 0, false); t8 = __builtin_amdgcn_cvt_pk_fp8_f32(o[2], o[3], t8, true); *(unsigned*)(P.ya + ro + 16 * vq) = (unsigned)t8; }
    }
}
}
namespace gl {
constexpr int LDV = 136;
struct Args { const bf16_t* puv; const bf16_t* wsm; const float* bs; const float* ln_g; const float* ln_b; unsigned char* yb; };
__device__ __forceinline__ void unit(const Args& P, LAS unsigned char* lds, int b, int blk, int tid) {
    const int wave = __builtin_amdgcn_readfirstlane(tid >> 6), lane = tid & 63, r = lane & 15, q = lane >> 4;
    const int t0 = b * SEQ + blk * 128;
    LAS float* STAT = (LAS float*)(lds + LDS_MISC);
#pragma unroll
    for (int hb = 0; hb < 2; ++hb) {
        u32x4 w[8];
#pragma unroll
        for (int j = 0; j < 8; ++j) w[j] = *(const u32x4*)(P.puv + (size_t)(t0 + 16 * wave + 8 * hb + j) * 1024 + 512 + 8 * lane);
#pragma unroll
        for (int j = 0; j < 8; ++j) {
            float v[8]; v[0] = bflo(w[j].x); v[1] = bfhi(w[j].x); v[2] = bflo(w[j].y); v[3] = bfhi(w[j].y); v[4] = bflo(w[j].z); v[5] = bfhi(w[j].z); v[6] = bflo(w[j].w); v[7] = bfhi(w[j].w);
            float s = 0.f, s2 = 0.f;
#pragma unroll
            for (int e = 0; e < 8; ++e) { s += v[e]; s2 += v[e] * v[e]; }
            s = wave_sum(s); s2 = wave_sum(s2);
            const float mean = s * (1.f / 512.f), var = fmaxf(s2 * (1.f / 512.f) - mean * mean, 0.f);
            if (lane == 0) { const int tk = 16 * wave + 8 * hb + j; STAT[tk * 2] = mean; STAT[tk * 2 + 1] = __builtin_amdgcn_rsqf(var + 1e-5f); }
        }
    }
    u32x4 pv[2], pu[2];
#define GL_LOAD(g) do { _Pragma("unroll") for (int it = 0; it < 2; ++it) { const int task = tid + it * NTHREADS, j = task >> 3, cc = task & 7; \
        const bf16_t* row = P.puv + (size_t)(t0 + j) * 1024 + (g) * 64 + 8 * cc; pu[it] = *(const u32x4*)row; pv[it] = *(const u32x4*)(row + 512); } } while (0)
    GL_LOAD(0);
    __syncthreads();
    for (int g = 0; g < 8; ++g) {
        LAS bf16_t* VT = (LAS bf16_t*)(lds + (g & 1) * 20480);
        LAS bf16_t* US = (LAS bf16_t*)(lds + 40960 + (g & 1) * 18432);
#pragma unroll
        for (int it = 0; it < 2; ++it) {
            const int task = tid + it * NTHREADS, j = task >> 3, cc = task & 7, ch = g * 64 + 8 * cc;
            const u32x4 w = pv[it];
            const float mean = STAT[j * 2], rstd = STAT[j * 2 + 1];
            const f32x4 g0 = *(const f32x4*)(P.ln_g + ch), g1 = *(const f32x4*)(P.ln_g + ch + 4), b0 = *(const f32x4*)(P.ln_b + ch), b1 = *(const f32x4*)(P.ln_b + ch + 4);
            float v[8]; v[0] = bflo(w.x); v[1] = bfhi(w.x); v[2] = bflo(w.y); v[3] = bfhi(w.y); v[4] = bflo(w.z); v[5] = bfhi(w.z); v[6] = bflo(w.w); v[7] = bfhi(w.w);
#pragma unroll
            for (int e = 0; e < 4; ++e) { v[e] = (v[e] - mean) * rstd * g0[e] + b0[e]; v[4 + e] = (v[4 + e] - mean) * rstd * g1[e] + b1[e]; }
#pragma unroll
            for (int e = 0; e < 8; ++e) VT[(8 * cc + e) * LDV + j] = f2bf(v[e]);
            *(LAS u32x4*)(US + j * 72 + 8 * cc) = pu[it];
        }
        if (g + 1 < 8) GL_LOAD(g + 1);
        __syncthreads();
        f32x4 acc[4];
#pragma unroll
        for (int n = 0; n < 4; ++n) acc[n] = (f32x4){0.f, 0.f, 0.f, 0.f};
        const bf16_t* wrow = P.wsm + ((size_t)g * 128 + 16 * wave + r) * 128 + 8 * q;
        const int ks = (wave >> 1) + 1;
        for (int s = 0; s < ks; ++s) {
            const bf16x8 a = *(const bf16x8*)(wrow + 32 * s);
#pragma unroll
            for (int n = 0; n < 4; ++n) { const bf16x8 bb = *(const LAS bf16x8*)(VT + (16 * n + r) * LDV + 32 * s + 8 * q); acc[n] = __builtin_amdgcn_mfma_f32_16x16x32_bf16(a, bb, acc[n], 0, 0, 0); }
        }
#pragma unroll
        for (int ii = 0; ii < 4; ++ii) { const int i = 16 * wave + 4 * q + ii; const float bias = P.bs[g * 128 + i];
#pragma unroll
            for (int n = 0; n < 4; ++n) { const int c = 16 * n + r; const float u = bf2f(US[i * 72 + c]);
                P.yb[(size_t)(t0 + i) * RW + g * 64 + c] = (unsigned char)(__builtin_amdgcn_cvt_pk_fp8_f32(u * (acc[n][ii] + bias), 0.f, 0, false) & 0xff); } }
    }
    __syncthreads();
#undef GL_LOAD
}
}

struct RouteArgs { const float* sc; const float* bias; int* eidx; float* ewt; int* lrank; int* tbase; unsigned* segcnt; };
__device__ __forceinline__ void topk_tile(const RouteArgs& P, LAS unsigned char* lds, int tid, int tile) {
    const int wave = __builtin_amdgcn_readfirstlane(tid >> 6), lane = tid & 63, grp = lane >> 3;
    LAS int* hist = (LAS int*)(lds + LDS_MISC);
    const f32x4 bias4 = *(const f32x4*)(P.bias + 4 * lane);
    const float NEG = -__builtin_inff();
    {
        if (tid < NE) hist[tid] = 0;
        __syncthreads();
        f32x4 nx[2];
#pragma unroll
        for (int u = 0; u < 2; ++u) nx[u] = *(const f32x4*)(P.sc + (size_t)(tile * 256 + wave * 32 + u) * NE + 4 * lane);
        for (int j = 0; j < 32; j += 2) {
            const int t0 = tile * 256 + wave * 32 + j;
            float s[2][4], v[2][4], gs[2];
            const f32x4 cur4[2] = {nx[0], nx[1]};
            if (j + 2 < 32) {
#pragma unroll
                for (int u = 0; u < 2; ++u) nx[u] = *(const f32x4*)(P.sc + (size_t)(t0 + 2 + u) * NE + 4 * lane); }
#pragma unroll
            for (int u = 0; u < 2; ++u) { const f32x4 s4 = cur4[u]; s[u][0] = s4.x; s[u][1] = s4.y; s[u][2] = s4.z; s[u][3] = s4.w;
#pragma unroll
                for (int e = 0; e < 4; ++e) v[u][e] = s[u][e] + bias4[e]; }
            float m1[2], m2[2];
#pragma unroll
            for (int u = 0; u < 2; ++u) { const float a = fmaxf(v[u][0], v[u][1]), b = fminf(v[u][0], v[u][1]), c = fmaxf(v[u][2], v[u][3]), d = fminf(v[u][2], v[u][3]); m1[u] = fmaxf(a, c); m2[u] = fmaxf(fminf(a, c), fmaxf(b, d)); }
#pragma unroll
            for (int o = 1; o < 8; o <<= 1) {
#pragma unroll
                for (int u = 0; u < 2; ++u) { const float o1 = __shfl_xor(m1[u], o), o2 = __shfl_xor(m2[u], o); const float n1 = fmaxf(m1[u], o1), n2 = fmaxf(fminf(m1[u], o1), fmaxf(m2[u], o2)); m1[u] = n1; m2[u] = n2; } }
#pragma unroll
            for (int u = 0; u < 2; ++u) gs[u] = m1[u] + m2[u];
            int cnt[2] = {0, 0};
#pragma unroll
            for (int g = 0; g < 8; ++g) {
#pragma unroll
                for (int u = 0; u < 2; ++u) { const float og = __shfl(gs[u], 8 * g); cnt[u] += (og > gs[u] || (og == gs[u] && g < grp)) ? 1 : 0; } }
#pragma unroll
            for (int u = 0; u < 2; ++u) {
#pragma unroll
                for (int e = 0; e < 4; ++e) v[u][e] = (cnt[u] < 4) ? v[u][e] : NEG; }
            int myidx[2] = {0, 0}; float mysc[2] = {0.f, 0.f}, ssum[2] = {0.f, 0.f};
#pragma unroll
            for (int k = 0; k < TOPK; ++k) {
                float bv[2]; int idx[2];
#pragma unroll
                for (int u = 0; u < 2; ++u) { bv[u] = v[u][0]; int bi = 0;
#pragma unroll
                    for (int e = 1; e < 4; ++e) { const bool gt = v[u][e] > bv[u]; bv[u] = gt ? v[u][e] : bv[u]; bi = gt ? e : bi; }
                    idx[u] = 4 * lane + bi; }
#pragma unroll
                for (int o = 1; o < 64; o <<= 1) {
#pragma unroll
                    for (int u = 0; u < 2; ++u) { const float ov = __shfl_xor(bv[u], o); const int oi = __shfl_xor(idx[u], o); const bool tk = (ov > bv[u]) || (ov == bv[u] && oi < idx[u]); bv[u] = tk ? ov : bv[u]; idx[u] = tk ? oi : idx[u]; } }
#pragma unroll
                for (int u = 0; u < 2; ++u) { const int own = idx[u] >> 2, ee = idx[u] & 3;
                    const float mine = (ee == 0) ? s[u][0] : (ee == 1) ? s[u][1] : (ee == 2) ? s[u][2] : s[u][3];
                    const float scv = __shfl(mine, own);
#pragma unroll
                    for (int e = 0; e < 4; ++e) v[u][e] = (lane == own && e == ee) ? NEG : v[u][e];
                    ssum[u] += scv; myidx[u] = (lane == k) ? idx[u] : myidx[u]; mysc[u] = (lane == k) ? scv : mysc[u]; }
            }
            if (lane < TOPK) {
#pragma unroll
                for (int u = 0; u < 2; ++u) { const int t = t0 + u;
                    const int lr = __hip_atomic_fetch_add(hist + myidx[u], 1, __ATOMIC_RELAXED, __HIP_MEMORY_SCOPE_WORKGROUP);
                    P.eidx[(size_t)t * TOPK + lane] = myidx[u]; P.ewt[(size_t)t * TOPK + lane] = mysc[u] / ssum[u] * 2.5f; P.lrank[(size_t)t * TOPK + lane] = lr; }
            }
        }
        __syncthreads();
        if (tid < NE) { const int cnt = hist[tid]; unsigned base = 0u;
            if (cnt) base = __hip_atomic_fetch_add(P.segcnt + tid, (unsigned)cnt, __ATOMIC_RELAXED, __HIP_MEMORY_SCOPE_AGENT);
            P.tbase[tile * NE + tid] = (int)base; }
        __syncthreads();
    }
}
struct ScatArgs { const int* eidx; const float* ewt; const int* lrank; const int* tbase; const unsigned* segcnt; int* rowtok; int* rowdst; float* roww; int* tab; unsigned* ntile; };
__device__ __forceinline__ void phase_scatter(const ScatArgs& P, LAS unsigned char* lds, int tid, int G) {
    LAS int* cntL = (LAS int*)(lds + LDS_MISC); LAS int* segst = cntL + 256; LAS int* tsa = segst + 256;
    if (tid < NE) cntL[tid] = (int)__hip_atomic_load(P.segcnt + tid, __ATOMIC_RELAXED, __HIP_MEMORY_SCOPE_AGENT);
    __syncthreads();
    if (tid == 0) {
        int run = 0, ta = 0;
        for (int s = 0; s < NE; ++s) { const int nts = (cntL[s] + 255) >> 8; segst[s] = run; tsa[s] = ta; run += nts * 256; ta += nts; }
        if (blockIdx.x == 0) P.ntile[0] = (unsigned)ta;
    }
    __syncthreads();
    for (int tile = blockIdx.x; tile < T / 256; tile += G) {
        for (int a = tid; a < 256 * TOPK; a += NTHREADS) {
            const int tok = tile * 256 + (a >> 3), k = a & 7; const size_t ai = (size_t)tok * TOPK + k;
            const int e = P.eidx[ai];
            const int pos = segst[e] + P.tbase[tile * NE + e] + P.lrank[ai];
            P.rowtok[pos] = tok; P.rowdst[pos] = tok * TOPK + k; P.roww[pos] = P.ewt[ai];
        }
    }
    for (int s = blockIdx.x; s < NE; s += G) {
        const int st = segst[s], cnt = cntL[s], nts = (cnt + 255) >> 8;
        for (int p = st + cnt + tid; p < st + nts * 256; p += NTHREADS) { P.rowtok[p] = 0; P.rowdst[p] = -1; P.roww[p] = 0.f; }
        if (tid < nts) { int* ta_ = P.tab + 2 * (tsa[s] + tid); ta_[0] = st + 256 * tid; ta_[1] = s; }
    }
}
constexpr int NPHASE = 20;
struct KArgs { const float* in[34]; float* out; unsigned char* ws; int ph_lo, ph_hi; };
template <int PLO, int PHI>
__global__ void __launch_bounds__(NTHREADS, 2) fwd_kernel(KArgs a) {
    extern __shared__ __attribute__((aligned(16))) unsigned char lds_raw[];
    LAS unsigned char* lds = (LAS unsigned char*)lds_raw;
    const int G = gridDim.x, bid = blockIdx.x, NGW = G * NWAVES;
#define PH_IDS() int tid = threadIdx.x; asm volatile("" : "+v"(tid)); const int lane = tid & 63, wave = __builtin_amdgcn_readfirstlane(tid >> 6), gw = bid * NWAVES + wave; (void)lane; (void)wave; (void)gw
    unsigned char* ws = a.ws;
    unsigned* ctl = (unsigned*)(ws + WS_CTL);
    float* mod = (float*)(ws + WS_MOD);
    constexpr int lo = PLO, hi = PHI;
    if (threadIdx.x == 0) *(LAS u32x4*)(lds + LDS_BARW) = (u32x4){0u, 0u, 0u, 0u};
    __syncthreads();
    XcdBarrier bar; bar.bar = ctl + CW_BAR; bar.x = 0; bar.st = nullptr;
    if (hi - lo > 1) bar = xcd_barrier_post(ctl + CW_BAR, (volatile LAS unsigned*)(lds + LDS_BARW));
#define IN(k) (lo <= (k) && (k) < hi)
#ifdef DBG_TIME
#define STAMP(k) do { if (blockIdx.x == 0 && threadIdx.x == 0) ((unsigned long long*)(ctl + 5200))[k] = __builtin_amdgcn_s_memrealtime(); } while (0)
#else
#define STAMP(k) do {} while (0)
#endif
#define SEAM(k) do { if (IN(k) && IN((k) + 1)) xcd_barrier(bar); } while (0)
#ifndef DBG_REPEAT
#define DBG_REPEAT (-1)
#define DBG_NREP 0
#endif
#define REP(k) for (int rep_ = 0; rep_ < (((k) == DBG_REPEAT) ? 1 + DBG_NREP : 1); ++rep_, (((k) == DBG_REPEAT && rep_ <= DBG_NREP) ? xcd_barrier(bar) : (void)0))

    STAMP(0);
    if (IN(0)) REP(0) { PH_IDS();
        phase_mod(a.in[1], a.in[2], a.in[3], mod, lds, tid, G);
    }
    SEAM(0); STAMP(1);
    if (IN(1)) REP(1) { PH_IDS();
        SmallW sw{a.in[6], a.in[22], a.in[23], a.in[24], a.in[25], a.in[30], a.in[31], a.in[32], a.in[9], a.in[11], a.in[12], a.in[20]};
        phase_small_weights(sw, ws, lds, gw, NGW, wave, lane);
        phase_norm_mod<false>(a.in[0], a.in[4], mod, 0, 1024, nullptr, ws + B_H1, gw, NGW, lane);
    }
    SEAM(1); STAMP(2);
    if (IN(2)) REP(2) {
        gm::DenseSched S; S.init(ws + B_H1, ws + SW_WIN, T, IN_COLS, D, G, bid, 1);
        gm::EpiInProj E{(bf16_t*)(ws + B_PRW), (bf16_t*)(ws + B_PUV), (bf16_t*)(ws + B_PG)};
        gm::gemm_phase<gm::EpiInProj, gm::DenseSched, true, true, 122>(lds, D, S, E);
    }
    SEAM(2); STAMP(3);
    if (IN(3)) REP(3) { PH_IDS();
        gl::Args Q{(const bf16_t*)(ws + B_PUV), (const bf16_t*)(ws + SW_WSM), a.in[21], a.in[18], a.in[19], ws + B_YB};
        for (int u = bid; u < 512; u += G) gl::unit(Q, lds, u >> 6, u & 63, tid);
        phase_xs((const bf16_t*)(ws + B_PRW), a.in[7], (bf16_t*)(ws + B_XS), gw, NGW, lane);
    }
    SEAM(3); STAMP(4);
    if (IN(4)) REP(4) { PH_IDS();
        rk::Args P{(const bf16_t*)(ws + B_PRW), a.in[7], a.in[8], a.in[10], a.in[13], a.in[14], a.in[15], (const bf16_t*)(ws + SW_WUP), (const bf16_t*)(ws + SW_AUP), (const bf16_t*)(ws + SW_GUP), (const bf16_t*)(ws + B_XS),
                   (bf16_t*)(ws + B_G), (bf16_t*)(ws + B_BV), ws + B_MN, ws + B_QY};
        phase_gate((const bf16_t*)(ws + B_XS), (const bf16_t*)(ws + SW_GUP), (bf16_t*)(ws + B_G), gw, NGW, lane);
        rk::Pre pre; rk::Hd hd; rk::load_mu(P, lds, tid);
        const bool fixh = (G % 8) == 0; const int nper = fixh ? (G >> 3) : G, first = fixh ? (bid >> 3) : bid, lim = fixh ? 1024 : 8192;
#define RK_UNIT_OF(idx, B_, H_, C_) const int B_ = fixh ? ((idx) >> 7) : ((idx) >> 10), H_ = fixh ? (bid & 7) : (((idx) >> 7) & 7), C_ = (idx) & 127
        if (first < lim) { RK_UNIT_OF(first, b0_, h0_, c0_); rk::prefetch(P, b0_, h0_, c0_, tid, pre); rk::load_head(P, h0_, tid, hd); }
        for (int idx = first; idx < lim; idx += nper) { const int nx = idx + nper; RK_UNIT_OF(idx, b_, h_, c_); RK_UNIT_OF(nx < lim ? nx : idx, nb_, nh__, nc_);
            rk::unit(P, lds, b_, h_, c_, (b_ * 8 + h_) * 128 + c_, tid, pre, hd, nx < lim, nb_, nh__, nc_); }
#undef RK_UNIT_OF
    }
    SEAM(4); STAMP(5);
    if (IN(5)) REP(5) { PH_IDS();
        for (int w = bid; w < 256; w += G) rk::scan_wg(ws + B_MN, ws + B_S, ((w & 7) + 8 * (w >> 5)) * 128, (w >> 3) & 3, lds, tid);
    }
    SEAM(5); STAMP(6);
    if (IN(6)) REP(6) { PH_IDS();
        rk::YArgs Y{ws + B_QY, ws + B_S, (const bf16_t*)(ws + B_G), (const bf16_t*)(ws + B_BV), a.in[16], a.in[17], ws + B_YA};
        for (int u = gw; u < 8192; u += NGW) rk::ypass_unit(Y, u, lane);
    }
    SEAM(6); STAMP(7);
    STAMP(8);
    if (IN(8)) REP(8) {
        gm::DenseSched S; S.init(ws + B_YA, ws + SW_WOA, T, D, RW, G, bid, 1);
        gm::EpiMerge<false> E{(bf16_t*)(ws + B_M1), (const bf16_t*)(ws + B_PG), nullptr};
        gm::gemm_phase<gm::EpiMerge<false>, gm::DenseSched, true, true, 122>(lds, RW, S, E);
    }
    STAMP(9);
    if (IN(9)) {
        gm::DenseSched S; S.init(ws + B_YB, ws + SW_WOB, T, D, RW, G, bid, 1);
        gm::EpiMerge<true> E{(bf16_t*)(ws + B_M1), (const bf16_t*)(ws + B_PG), ws + B_M8};
        gm::gemm_phase<gm::EpiMerge<true>, gm::DenseSched, true, true, 122>(lds, RW, S, E);
    }
    SEAM(9); STAMP(10);
    if (IN(10)) REP(10) {
        gm::DenseSched S; S.init(ws + B_M8, ws + SW_WO, T, D, D, G, bid, 1);
        gm::EpiResid E{(bf16_t*)(ws + B_X1), a.in[0], mod + 2048};
        gm::gemm_phase<gm::EpiResid, gm::DenseSched, true, true, 122>(lds, D, S, E);
    }
    SEAM(10); STAMP(11);
    if (IN(11)) REP(11) { PH_IDS();
        phase_norm_mod<true>(ws + B_X1, a.in[5], mod, 3072, 4096, (bf16_t*)(ws + B_H2), ws + B_H2F8, gw, NGW, lane);
        phase_expert_weights(a.in[27], a.in[28], a.in[29], ws, lds, gw, NGW, wave, lane);
    }
    SEAM(11); STAMP(12);
    if (IN(12)) { PH_IDS();
        RouteArgs R{(const float*)(ws + B_SC), a.in[26], (int*)(ws + RT_EIDX), (float*)(ws + RT_EWT), (int*)(ws + RT_LRANK), (int*)(ws + RT_TBASE), ctl + CW_SEGCNT};
        { gm::DenseSched S; S.init(ws + B_H2, ws + SW_WR, T, NE, D, G, bid); gm::EpiRouter E{(float*)(ws + B_SC)}; gm::gemm_phase<gm::EpiRouter, gm::DenseSched, true>(lds, D, S, E);
          gm::Unit u; for (int i = 0; S.next(i, u); ++i) topk_tile(R, lds, tid, u.pm); }
        { gm::DenseSched S; S.init(ws + B_H2F8, ws + SW_WS13, T, 512, D, G, bid, 1); gm::EpiGateUp<true> E{ws + B_SH}; gm::gemm_phase<gm::EpiGateUp<true>, gm::DenseSched, true, true, 122>(lds, D, S, E); }
    }
    SEAM(12); STAMP(13);
    if (IN(13)) { PH_IDS();
        ScatArgs P{(const int*)(ws + RT_EIDX), (const float*)(ws + RT_EWT), (const int*)(ws + RT_LRANK), (const int*)(ws + RT_TBASE), ctl + CW_SEGCNT,
                   (int*)(ws + RT_ROWTOK), (int*)(ws + RT_ROWDST), (float*)(ws + RT_ROWW), (int*)(ws + RT_TAB), ctl + CW_NT};
        phase_scatter(P, lds, tid, G);
        __syncthreads();
        gm::DenseSched S; S.init(ws + B_SH, ws + SW_WS2, T, D, EFF, G, bid, 1);
        gm::EpiSharedDown E{ws + B_SHO};
        gm::gemm_phase<gm::EpiSharedDown, gm::DenseSched, true, true, 122>(lds, EFF, S, E);
    }
    SEAM(13); STAMP(14); STAMP(15);
    if (IN(15)) REP(15) {
        gm::GroupSched<true> S; S.A = (const char*)(ws + B_H2F8); S.B = (const char*)(ws + B_W13); S.tab = (const int*)(ws + RT_TAB); S.rowtok = (const int*)(ws + RT_ROWTOK);
        S.ntiles = (int)__hip_atomic_load(ctl + CW_NT, __ATOMIC_RELAXED, __HIP_MEMORY_SCOPE_AGENT); S.npn = 2; S.G = G; S.c = bid; S.K = D; S.ebytes = (size_t)512 * D; S.tstep = (size_t)256 * D;
        gm::EpiGateUp<true> E{ws + B_HID};
        gm::gemm_phase<gm::EpiGateUp<true>, gm::GroupSched<true>, true, true, 122>(lds, D, S, E);
    }
    SEAM(15); STAMP(16);
    if (IN(16)) REP(16) {
        gm::GroupSched<false> S; S.A = (const char*)(ws + B_HID); S.B = (const char*)(ws + B_W2); S.tab = (const int*)(ws + RT_TAB); S.rowtok = nullptr;
        S.ntiles = (int)__hip_atomic_load(ctl + CW_NT, __ATOMIC_RELAXED, __HIP_MEMORY_SCOPE_AGENT); S.npn = 4; S.G = G; S.c = bid; S.K = EFF; S.ebytes = (size_t)D * EFF; S.tstep = (size_t)256 * EFF;
        gm::EpiExpertDown E{ws + B_SLOT, (const int*)(ws + RT_ROWDST), (const float*)(ws + RT_ROWW)};
        gm::gemm_phase<gm::EpiExpertDown, gm::GroupSched<false>, true, true, 122>(lds, EFF, S, E);
    }
    SEAM(16); STAMP(17);
    if (IN(17)) { PH_IDS(); phase_combine(a.out, (const bf16_t*)(ws + B_X1), ws + B_SLOT, ws + B_SHO, mod, a.in[33], gw, NGW, lane); }
    STAMP(18); STAMP(19);
    __syncthreads(); STAMP(20);
#undef IN
#undef SEAM
}

#if defined(DBG_CHECK) || defined(DBG_TIME)
#ifdef DBG_TIME
#ifndef TSC
#define TSC 0.25f
#endif
__global__ void dbg_time_out(float* out, const unsigned long long* st) {
    if (threadIdx.x == 0 && blockIdx.x == 0) { out[0] = (float)(st[TA1] - st[TA0]) * 0.01f * TSC; out[1] = (float)(st[TB1] - st[TB0]) * 0.01f * TSC; }
}
static void dbg_run(void* d_out, void* d_ws, hipStream_t stream) {
    dbg_time_out<<<1, 64, 0, stream>>>((float*)d_out, (const unsigned long long*)((unsigned*)((unsigned char*)d_ws + WS_CTL) + 5200));
}
#endif
#endif
#ifndef MK_SINGLE
#define MK_SINGLE 0
#endif
template <int PLO, int PHI> static bool prep_kernel() {
    int per_cu = 0;
    if (hipFuncSetAttribute((const void*)fwd_kernel<PLO, PHI>, hipFuncAttributeMaxDynamicSharedMemorySize, LDS_BYTES) != hipSuccess) { fprintf(stderr, "kernel_launch: hipFuncSetAttribute failed\n"); return false; }
    if (hipOccupancyMaxActiveBlocksPerMultiprocessor(&per_cu, (const void*)fwd_kernel<PLO, PHI>, NTHREADS, LDS_BYTES) != hipSuccess || per_cu < 1) { fprintf(stderr, "kernel_launch: occupancy query says %d\n", per_cu); (void)hipGetLastError(); return false; }
    return true;
}
template <int P> struct PhaseLaunch {
    static bool prep() { return prep_kernel<P, P + 1>() && PhaseLaunch<P + 1>::prep(); }
    static void go(int grid, hipStream_t stream, const KArgs& a) { hipLaunchKernelGGL((fwd_kernel<P, P + 1>), dim3(grid), dim3(NTHREADS), LDS_BYTES, stream, a); PhaseLaunch<P + 1>::go(grid, stream, a); }
};
#ifndef DBG_LAST
#define DBG_LAST NPHASE
#endif
template <> struct PhaseLaunch<DBG_LAST> { static bool prep() { return true; } static void go(int, hipStream_t, const KArgs&) {} };
extern "C" void kernel_launch(void* const* d_in, const int* in_sizes, int n_in, void* d_out, int out_size, void* d_ws, size_t ws_size, hipStream_t stream) {
    static int grid = 0;
    if (grid == 0) {
        if (n_in != 34 || out_size != T * D || ws_size < WS_END) { fprintf(stderr, "kernel_launch: unexpected problem shape (n_in %d, out %d, ws %zu < %zu)\n", n_in, out_size, ws_size, (size_t)WS_END); grid = -1; return; }
        int dev = 0, cus = 0;
        if (hipGetDevice(&dev) != hipSuccess || hipDeviceGetAttribute(&cus, hipDeviceAttributeMultiprocessorCount, dev) != hipSuccess) { grid = -1; return; }
#if MK_SINGLE
        if (!prep_kernel<0, NPHASE>()) { grid = -1; return; }
#else
        if (!PhaseLaunch<0>::prep()) { grid = -1; return; }
#endif
        grid = cus;
    }
    if (grid < 0) return;
    (void)hipMemsetAsync((char*)d_ws + WS_CTL, 0, CTL_ZERO_BYTES, stream);
    KArgs a{};
    for (int i = 0; i < 34; ++i) a.in[i] = (const float*)d_in[i];
    a.out = (float*)d_out; a.ws = (unsigned char*)d_ws; a.ph_lo = 0; a.ph_hi = NPHASE;
#if MK_SINGLE
    hipLaunchKernelGGL((fwd_kernel<0, NPHASE>), dim3(grid), dim3(NTHREADS), LDS_BYTES, stream, a);
#else
    PhaseLaunch<0>::go(grid, stream, a);
#endif
#if defined(DBG_CHECK) || defined(DBG_TIME)
    dbg_run(d_out, d_ws, stream);
#endif
}
```

```cpp
#define MK_SINGLE 1
#include <hip/hip_runtime.h>
#include <cstdio>
#include <cstdint>

#define LAS __attribute__((address_space(3)))
#define GAS __attribute__((address_space(1)))
typedef unsigned short bf16_t;
typedef short bf16x8 __attribute__((ext_vector_type(8)));
typedef float f32x4 __attribute__((ext_vector_type(4)));
typedef float f32x2 __attribute__((ext_vector_type(2)));
typedef unsigned u32x4 __attribute__((ext_vector_type(4)));
typedef unsigned u32x2 __attribute__((ext_vector_type(2)));

constexpr int D = 1024, NB = 8, SEQ = 8192, T = NB * SEQ;
constexpr int RW = 512, HD = 64, NH = 8;
constexpr int RWKV_COLS = 1792, IN_COLS = 4864;
constexpr int NE = 256, TOPK = 8, EFF = 256;
constexpr int NWAVES = 8, NTHREADS = 512;
constexpr int MAXROWS = T * TOPK + 256 * 256;

constexpr size_t MiB = 1u << 20;
constexpr size_t WS_CTL = 0;
constexpr int CW_BAR = 0, CW_SEGCNT = 4096, CW_NT = 4608;
constexpr size_t CTL_ZERO_BYTES = 32768;
constexpr size_t WS_MOD = 65536;
constexpr size_t WS_SW = 1 * MiB;
constexpr size_t SW_WIN = WS_SW;
constexpr size_t SW_WOA = SW_WIN + (size_t)IN_COLS * D * 2;
constexpr size_t SW_WOB = SW_WOA + (size_t)D * RW * 2;
constexpr size_t SW_WO = SW_WOB + (size_t)D * RW * 2;
constexpr size_t SW_WR = SW_WO + (size_t)D * D * 2;
constexpr size_t SW_WS13 = SW_WR + (size_t)NE * D * 2;
constexpr size_t SW_WS2 = SW_WS13 + (size_t)512 * D * 2;
constexpr size_t SW_WUP = SW_WS2 + (size_t)D * EFF * 2;
constexpr size_t SW_AUP = SW_WUP + (size_t)RW * 64 * 2;
constexpr size_t SW_GUP = SW_AUP + (size_t)RW * 64 * 2;
constexpr size_t SW_WSM = SW_GUP + (size_t)RW * 128 * 2;
constexpr size_t SW_END = SW_WSM + (size_t)8 * 128 * 128 * 2;
static_assert(SW_END <= 20 * MiB, "small weights");
constexpr size_t WS_RT = 20 * MiB;
constexpr size_t RT_EIDX = WS_RT;
constexpr size_t RT_EWT = RT_EIDX + (size_t)T * 8 * 4;
constexpr size_t RT_LRANK = RT_EWT + (size_t)T * 8 * 4;
constexpr size_t RT_TBASE = RT_LRANK + (size_t)T * 8 * 4;
constexpr size_t RT_ROWTOK = RT_TBASE + (size_t)256 * 256 * 4;
constexpr size_t RT_ROWDST = RT_ROWTOK + (size_t)MAXROWS * 4;
constexpr size_t RT_ROWW = RT_ROWDST + (size_t)MAXROWS * 4;
constexpr size_t RT_TAB = RT_ROWW + (size_t)MAXROWS * 4;
constexpr size_t RT_SBON = RT_TAB + (size_t)3 * 4096 * 8;
constexpr size_t RT_END = RT_SBON + (size_t)T * 8 * 4;
static_assert(RT_END <= 40 * MiB, "routing arrays");
constexpr size_t WS_BIG = 40 * MiB;
constexpr size_t B_H1 = WS_BIG + 0 * MiB;
constexpr size_t B_YB = WS_BIG + 0 * MiB;
constexpr size_t B_YA = WS_BIG + 64 * MiB;
constexpr size_t B_XS = WS_BIG + 64 * MiB;
constexpr size_t B_PRW = WS_BIG + 128 * MiB;
constexpr size_t B_M8 = WS_BIG + 128 * MiB;
constexpr size_t B_S = WS_BIG + 128 * MiB;
constexpr size_t B_PUV = WS_BIG + 352 * MiB;
constexpr size_t B_QY = WS_BIG + 352 * MiB;
constexpr size_t B_M1 = WS_BIG + 352 * MiB;
constexpr size_t B_PG = WS_BIG + 480 * MiB;
constexpr size_t B_MN = WS_BIG + 736 * MiB;
constexpr size_t B_G = WS_BIG + 864 * MiB;
constexpr size_t B_BV = WS_BIG + 928 * MiB;
constexpr size_t B_H2 = WS_BIG + 0 * MiB;
constexpr size_t B_W13 = WS_BIG + 128 * MiB;
constexpr size_t B_H2F8 = WS_BIG + 256 * MiB;
constexpr size_t B_SH = WS_BIG + 384 * MiB;
constexpr size_t B_SC = WS_BIG + 416 * MiB;
constexpr size_t B_SLOT = WS_BIG + 0 * MiB;
constexpr size_t B_SHO = WS_BIG + 928 * MiB;
constexpr size_t B_W2 = WS_BIG + 512 * MiB;
constexpr size_t B_X1 = WS_BIG + 576 * MiB;
constexpr size_t B_HID = WS_BIG + 704 * MiB;
constexpr size_t WS_END = WS_BIG + 992 * MiB;
static_assert((size_t)MAXROWS * EFF * 2 <= 320 * MiB, "hid");

constexpr int LDS_STAGE = 0;
constexpr int LDS_MISC = 153600;
constexpr int LDS_BARW = 161792;
constexpr int LDS_BYTES = 163840;

typedef __bf16 bf16x2_t __attribute__((ext_vector_type(2)));
__device__ __forceinline__ unsigned pk2(float lo, float hi) { f32x2 f = {lo, hi}; return __builtin_bit_cast(unsigned, __builtin_convertvector(f, bf16x2_t)); }
__device__ __forceinline__ u32x2 pk8(const f32x4& a, const f32x4& b) { u32x2 w; int t = __builtin_amdgcn_cvt_pk_fp8_f32(a[0], a[1], 0, false); t = __builtin_amdgcn_cvt_pk_fp8_f32(a[2], a[3], t, true); w.x = (unsigned)t;
    t = __builtin_amdgcn_cvt_pk_fp8_f32(b[0], b[1], 0, false); t = __builtin_amdgcn_cvt_pk_fp8_f32(b[2], b[3], t, true); w.y = (unsigned)t; return w; }
__device__ __forceinline__ f32x4 up8(unsigned w) { const f32x2 lo = __builtin_amdgcn_cvt_pk_f32_fp8((int)w, false), hi = __builtin_amdgcn_cvt_pk_f32_fp8((int)w, true); return (f32x4){lo.x, lo.y, hi.x, hi.y}; }
__device__ __forceinline__ float bflo(unsigned w) { return __uint_as_float(w << 16); }
__device__ __forceinline__ float bfhi(unsigned w) { return __uint_as_float(w & 0xffff0000u); }
__device__ __forceinline__ float bf2f(bf16_t h) { return __uint_as_float(((unsigned)h) << 16); }
__device__ __forceinline__ bf16_t f2bf(float f) { return (bf16_t)(pk2(f, 0.f) & 0xffffu); }
__device__ __forceinline__ float fexp(float x) { return __builtin_amdgcn_exp2f(x * 1.44269504089f); }
__device__ __forceinline__ float flog(float x) { return __builtin_amdgcn_logf(x) * 0.69314718056f; }
__device__ __forceinline__ float frcp(float x) { return __builtin_amdgcn_rcpf(x); }
__device__ __forceinline__ float sigmoidf_(float x) { return frcp(1.0f + fexp(-x)); }
__device__ __forceinline__ float siluf_(float x) { return x * sigmoidf_(x); }
__device__ __forceinline__ float tanhf_(float x) { return 1.0f - 2.0f * frcp(1.0f + fexp(2.0f * x)); }
__device__ __forceinline__ float gelu_tanh(float x) { const float u = 0.7978845608f * (x + 0.044715f * x * x * x); return x * frcp(1.0f + fexp(-2.0f * u)); }
__device__ __forceinline__ float wave_sum(float v) {
#pragma unroll
    for (int o = 1; o < 64; o <<= 1) v += __shfl_xor(v, o);
    return v;
}
#define LDS_WAIT() asm volatile("s_waitcnt lgkmcnt(0)" ::: "memory")
#define VM_WAIT() asm volatile("s_waitcnt vmcnt(0)" ::: "memory")

#define XB_TMO      128
#define XB_XCNT(j)  (256  + 64 * (j))
#define XB_XSUB(j)  (1280 + 64 * (j))
#define XB_XGEN(j)  (2304 + 64 * (j))
#define XB_TOP      3328
#define XB_TOPGEN   3392
#define XCD_BAR_WORDS 3456
#define XB_SPIN_CAP (1u << 18)
__device__ __forceinline__ unsigned xb_ld(unsigned* p)              { return __hip_atomic_load(p, __ATOMIC_RELAXED, __HIP_MEMORY_SCOPE_AGENT); }
__device__ __forceinline__ unsigned xb_add(unsigned* p, unsigned v) { return __hip_atomic_fetch_add(p, v, __ATOMIC_RELAXED, __HIP_MEMORY_SCOPE_AGENT); }
__device__ __forceinline__ unsigned xb_xcc_id() { return (unsigned)__builtin_amdgcn_s_getreg((3 << 11) | 20) & 0xFu; }
#define XB_SPIN(cond, bar) do { unsigned _sp = 0; while (cond) { __builtin_amdgcn_s_sleep(1); \
    if ((++_sp & 255u) == 0u) { if (xb_ld(&(bar)[XB_TMO])) break; if (_sp > XB_SPIN_CAP) { atomicAdd(&(bar)[XB_TMO], 1u); break; } } } } while (0)
struct XcdBarrier { unsigned* bar; unsigned x; volatile LAS unsigned* st; };
__device__ __forceinline__ XcdBarrier xcd_barrier_post(unsigned* bar, volatile LAS unsigned* st) {
    XcdBarrier b; b.bar = bar; b.x = xb_xcc_id(); b.st = st;
    if (threadIdx.x == 0) (void)xb_add(&bar[XB_XCNT(b.x)], 1u);
    return b;
}
__device__ __forceinline__ void xcd_barrier_complete(unsigned* bar, unsigned x, unsigned& nloc, unsigned& nx) {
    const unsigned G = gridDim.x * gridDim.y * gridDim.z;
    unsigned sum, cnt, mine, sp = 0u;
    for (;;) {
        sum = 0u; cnt = 0u; mine = 0u;
#pragma unroll
        for (unsigned j = 0; j < 16; ++j) { const unsigned c = xb_ld(&bar[XB_XCNT(j)]); sum += c; cnt += (c > 0u) ? 1u : 0u; mine = (j == x) ? c : mine; }
        if (sum == G) break;
        __builtin_amdgcn_s_sleep(1);
        if ((++sp & 255u) == 0u) { if (xb_ld(&bar[XB_TMO])) break; if (sp > XB_SPIN_CAP) { atomicAdd(&bar[XB_TMO], 1u); break; } }
    }
    nloc = mine > 0u ? mine : 1u; nx = cnt > 0u ? cnt : 1u;
}
__device__ __forceinline__ void xcd_barrier(const XcdBarrier& b) {
    asm volatile("s_waitcnt vmcnt(0)" ::: "memory");
    __syncthreads();
    if (threadIdx.x == 0) {
        unsigned* bar = b.bar;
        __builtin_amdgcn_s_waitcnt(0);
        unsigned nloc = b.st[0], nx = b.st[1];
        if (nloc == 0u) { xcd_barrier_complete(bar, b.x, nloc, nx); b.st[0] = nloc; b.st[1] = nx; }
        const unsigned old = xb_add(&bar[XB_XSUB(b.x)], 1u);
        const unsigned gen = old / nloc;
        if (old + 1u == (gen + 1u) * nloc) {
            __builtin_amdgcn_fence(__ATOMIC_RELEASE, "agent");
            asm volatile("s_waitcnt vmcnt(0)" ::: "memory");
            const unsigned og = xb_add(&bar[XB_TOP], 1u);
            const unsigned tg = og / nx;
            if (og + 1u == (tg + 1u) * nx) xb_add(&bar[XB_TOPGEN], 1u);
            else XB_SPIN(xb_ld(&bar[XB_TOPGEN]) == tg, bar);
            __builtin_amdgcn_fence(__ATOMIC_ACQUIRE, "agent");
            xb_add(&bar[XB_XGEN(b.x)], 1u);
            asm volatile("s_waitcnt vmcnt(0)" ::: "memory");
        } else {
            XB_SPIN(xb_ld(&bar[XB_XGEN(b.x)]) == gen, bar);
            __builtin_amdgcn_fence(__ATOMIC_ACQUIRE, "agent");
            asm volatile("s_waitcnt vmcnt(0)" ::: "memory");
        }
    }
    __syncthreads();
}
namespace gm {
typedef int i32x4 __attribute__((ext_vector_type(4)));
typedef int i32x8 __attribute__((ext_vector_type(8)));
constexpr int BM = 256, BK = 64, HALF = 128, HTB = HALF * BK * 2, STAGE_BYTES = 8 * HTB, NXCD = 8, WGM = 8;
__host__ __device__ __forceinline__ int lds_byte(int r, int c) { const int st = (r >> 4) * 2 + (c >> 5), rr = r & 15, cc = c & 31, ob = rr * 64 + cc * 2; return st * 1024 + (ob ^ (((ob >> 9) & 1) << 5)); }
__host__ __device__ __forceinline__ void stage_rc(int b, int& R, int& C) { const int st = b / 1024, sb = b % 1024, swz = sb ^ (((sb >> 9) & 1) << 5); R = (st >> 1) * 16 + swz / 64; C = (st & 1) * 32 + (swz % 64) / 2; }
__host__ __device__ __forceinline__ int perm32(int rho) { const int n = rho >> 4, i = rho & 15; return 8 * (i >> 2) + 4 * n + (i & 3); }

struct Unit { int pm, pn, e, row0, par; };

struct DenseSched {
    static constexpr bool GATHER = false;
    const char* A; const char* B; int nM, nN, nwg, G, c; size_t tstep; const int* rowtok; int K;
    __device__ __forceinline__ void init(const void* A_, const void* B_, int M, int N, int K, int G_, int c_, int es = 2) { A = (const char*)A_; B = (const char*)B_; nM = M / BM; nN = N / BM; nwg = nM * nN; G = G_; c = c_; tstep = (size_t)BM * K * es; rowtok = nullptr; this->K = 0; }
    __device__ __forceinline__ bool next(int i, Unit& u) const {
        const long L = (long)i * G + c; if (L >= nwg) return false;
        int wgid = (int)L; { const int q = nwg / NXCD, r = nwg % NXCD, xcd = wgid % NXCD, off = wgid / NXCD; wgid = (xcd < r ? xcd * (q + 1) : r * (q + 1) + (xcd - r) * q) + off; }
        const int nig = WGM * nN, gid = wgid / nig, fm = gid * WGM, gsz = (nM - fm) < WGM ? (nM - fm) : WGM;
        u.pm = fm + ((wgid % nig) % gsz); u.pn = (wgid % nig) / gsz; u.e = 0; u.row0 = u.pm * BM; return true;
    }
    __device__ __forceinline__ const char* a_ptr(const Unit& u) const { return A + (size_t)u.pm * tstep; }
    __device__ __forceinline__ const char* b_ptr(const Unit& u) const { return B + (size_t)u.pn * tstep; }
    __device__ __forceinline__ unsigned row_off(const Unit&, int) const { return 0u; }
};
template <bool GATHER_>
struct GroupSched {
    static constexpr bool GATHER = GATHER_;
    const char* A; const char* B; const int* tab; const int* rowtok; int ntiles, npn, G, c, K; size_t ebytes, tstep;
    __device__ __forceinline__ bool next(int i, Unit& u) const {
        int tile;
        if (G == 256) {
            const int xcd = c & 7, slot = c >> 3, tpx = 32 / npn; tile = i * 8 * tpx + xcd * tpx + slot / npn; u.pn = slot % npn; if (tile >= ntiles) return false;
        } else { const long L = (long)i * G + c; if (L >= (long)ntiles * npn) return false; tile = (int)(L / npn); u.pn = (int)(L % npn); }
        u.pm = tile;
        u.row0 = __builtin_amdgcn_readfirstlane(tab[2 * tile]); u.e = __builtin_amdgcn_readfirstlane(tab[2 * tile + 1]); return true;
    }
    __device__ __forceinline__ const char* a_ptr(const Unit& u) const { return GATHER ? A : A + (size_t)u.row0 * K; }
    __device__ __forceinline__ const char* b_ptr(const Unit& u) const { return B + (size_t)u.e * ebytes + (size_t)u.pn * tstep; }
    __device__ __forceinline__ unsigned row_off(const Unit& u, int r) const { return (unsigned)rowtok[u.row0 + r] * (unsigned)K; }
};

template <class Epi, class Sched, bool ALIGN_EPI, bool F8 = false, int SCALE_W = 127>
__device__ __forceinline__ void gemm_phase(LAS unsigned char* lds, const int Kel, const Sched& S, const Epi& E) {
    const int K = F8 ? Kel / 2 : Kel;
    int tid_ = threadIdx.x; asm volatile("" : "+v"(tid_));
    const int tid = tid_, wid = __builtin_amdgcn_readfirstlane(tid >> 6), lane = tid & 63, wr = wid >> 2, wc = wid & 3, fr = lane & 15, fq = lane >> 4;
    const int nt = K / BK;
    int sR[2], sC[2]; unsigned voffB[2];
#pragma unroll
    for (int i = 0; i < 2; ++i) { int R, C; stage_rc(tid * 16 + i * 8192, R, C); sR[i] = R; sC[i] = C; const int Rb = Epi::PERM ? ((R & ~31) + perm32(R & 31)) : R; voffB[i] = (unsigned)(Rb * K + C) * 2u; }
    const size_t kstep = (size_t)(BK * 2);
    const size_t hstep = (size_t)HALF * K * 2;
    const unsigned ldsw = (unsigned)wid * 1024u;
    const int aoff = lds_byte(wr * 64 + fr, fq * 8), boff = lds_byte(wc * 32 + fr, fq * 8);
#define PG8_SA(b, h) (((b) * 2 + (h)) * HTB)
#define PG8_SB(b, h) ((4 + (b) * 2 + (h)) * HTB)
#define PG8_STGB(bufoff, gbase) do { _Pragma("unroll") for (int _i = 0; _i < 2; ++_i) \
        __builtin_amdgcn_global_load_lds((const unsigned*)((const char*)(gbase) + voffB[_i]), (LAS unsigned*)(lds + (bufoff) + ldsw + _i * 8192), 16, 0, 0); } while (0)
#define PG8_STGA(bufoff, gbase, VO, h) do { _Pragma("unroll") for (int _i = 0; _i < 2; ++_i) \
        __builtin_amdgcn_global_load_lds((const unsigned*)((const char*)(gbase) + VO[h][_i]), (LAS unsigned*)(lds + (bufoff) + ldsw + _i * 8192), 16, 0, 0); } while (0)
#define PG8_VOA(u, VO) do { _Pragma("unroll") for (int _h = 0; _h < 2; ++_h) _Pragma("unroll") for (int _i = 0; _i < 2; ++_i) \
        VO[_h][_i] = Sched::GATHER ? (S.row_off(u, _h * HALF + sR[_i]) + (unsigned)sC[_i] * 2u) : ((unsigned)((_h * HALF + sR[_i]) * K + sC[_i]) * 2u); } while (0)
#define PG8_LDA(dst, b, h) do { _Pragma("unroll") for (int m = 0; m < 4; ++m) { if constexpr (F8) { dst##8[m].lo = *(const LAS i32x4*)(lds + PG8_SA(b, h) + aoff + m * 2048); dst##8[m].hi = *(const LAS i32x4*)(lds + PG8_SA(b, h) + aoff + m * 2048 + 1024); } else { _Pragma("unroll") for (int k = 0; k < 2; ++k) dst[m][k] = *(const LAS bf16x8*)(lds + PG8_SA(b, h) + aoff + m * 2048 + k * 1024); } } } while (0)
#define PG8_LDB(dst, b, h) do { _Pragma("unroll") for (int n = 0; n < 2; ++n) { if constexpr (F8) { dst##8[n].lo = *(const LAS i32x4*)(lds + PG8_SB(b, h) + boff + n * 2048); dst##8[n].hi = *(const LAS i32x4*)(lds + PG8_SB(b, h) + boff + n * 2048 + 1024); } else { _Pragma("unroll") for (int k = 0; k < 2; ++k) dst[n][k] = *(const LAS bf16x8*)(lds + PG8_SB(b, h) + boff + n * 2048 + k * 1024); } } } while (0)
#define PG8_MMA(ai, bj, At, Bt) do { __builtin_amdgcn_s_setprio(1); _Pragma("unroll") for (int m = 0; m < 4; ++m) _Pragma("unroll") for (int n = 0; n < 2; ++n) { \
        if constexpr (F8) { asm volatile("v_mfma_scale_f32_16x16x128_f8f6f4 %0, %1, %2, %0, %3, %4 op_sel_hi:[0,0,0]" : "+v"(acc[ai][bj][m][n]) : "v"(Bt##8[n]), "v"(At##8[m]), "v"(scw_), "v"(sca_)); } \
        else { _Pragma("unroll") for (int k = 0; k < 2; ++k) acc[ai][bj][m][n] = __builtin_amdgcn_mfma_f32_16x16x32_bf16(Bt[n][k], At[m][k], acc[ai][bj][m][n], 0, 0, 0); } } \
        __builtin_amdgcn_s_setprio(0); } while (0)
#define PG8_WAIT_V(n) asm volatile("s_waitcnt vmcnt(" #n ")" ::: "memory")
#define PG8_WAIT_L(n) asm volatile("s_waitcnt lgkmcnt(" #n ")" ::: "memory")
#define PG8_BAR __builtin_amdgcn_s_barrier()
#define PG8_SCHED __builtin_amdgcn_sched_barrier(0)
    Unit cur, nxt; int ui = 0;
    if (!S.next(0, cur)) return;
    f32x4 acc[2][2][4][2];
#pragma unroll
    for (int a = 0; a < 2; ++a)
#pragma unroll
        for (int b = 0; b < 2; ++b)
#pragma unroll
            for (int m = 0; m < 4; ++m)
#pragma unroll
                for (int n = 0; n < 2; ++n) acc[a][b][m][n] = (f32x4){0.f, 0.f, 0.f, 0.f};
    const int scw_ = SCALE_W, sca_ = 127;
    bf16x8 At[4][2], B0[2][2], B1[2][2]; i32x8 At8[4], B08[2], B18[2];
    unsigned voA[2][2], nvoA[2][2];
    PG8_VOA(cur, voA);
    if (Sched::GATHER) { asm volatile("s_waitcnt vmcnt(0)" ::: "memory"); }
    const char* cA = S.a_ptr(cur); const char* cB = S.b_ptr(cur);
    cur.par = 0; E.stage_rows(cur, lds, wid);
    PG8_STGB(PG8_SB(0, 0), cB); PG8_STGB(PG8_SB(0, 1), cB + hstep); PG8_STGA(PG8_SA(0, 0), cA, voA, 0); PG8_STGA(PG8_SA(0, 1), cA, voA, 1);
    if (wr == 1) PG8_BAR;
    PG8_WAIT_V(2); PG8_BAR;
    PG8_STGB(PG8_SB(1, 0), cB + kstep); PG8_STGA(PG8_SA(1, 0), cA + kstep, voA, 0); PG8_STGB(PG8_SB(1, 1), cB + hstep + kstep);
    PG8_WAIT_V(6); PG8_BAR;
    Unit nn; bool has_next = S.next(1, nxt);
    for (;;) {
        nxt.par = (ui + 1) & 3;
        const bool has_nn = has_next && S.next(ui + 2, nn);
        const char* nA = has_next ? S.a_ptr(nxt) : cA; const char* nB = has_next ? S.b_ptr(nxt) : cB;
        if (Sched::GATHER) {
            if (has_next) { if (wid < 4) __builtin_amdgcn_global_load_lds((const unsigned*)(S.rowtok + nxt.row0 + wid * 64 + lane), (LAS unsigned*)(lds + LDS_MISC + nxt.par * 1024 + wid * 256), 4, 0, 0); }
#pragma unroll
            for (int h = 0; h < 2; ++h)
#pragma unroll
                for (int i = 0; i < 2; ++i) nvoA[h][i] = voA[h][i]; }
#pragma unroll 1
        for (int t = 0; t < nt; t += 2) {
            const bool last = (t == nt - 2);
            const char* a1 = cA + (size_t)(t + 1) * kstep;
            const char* a2 = last ? nA : cA + (size_t)(t + 2) * kstep; const char* b2 = last ? nB : cB + (size_t)(t + 2) * kstep;
            const char* a3 = a2 + kstep; const char* b3 = b2 + kstep;
            unsigned vo2[2][2];
#pragma unroll
            for (int h = 0; h < 2; ++h)
#pragma unroll
                for (int i = 0; i < 2; ++i) vo2[h][i] = (Sched::GATHER && last) ? nvoA[h][i] : voA[h][i];
            if (last && has_next) E.stage_rows(nxt, lds, wid);
            if (Sched::GATHER && last && has_next) { const LAS int* rt_ = (const LAS int*)(lds + LDS_MISC + nxt.par * 1024);
#pragma unroll
                for (int h = 0; h < 2; ++h)
#pragma unroll
                    for (int i = 0; i < 2; ++i) { vo2[h][i] = (unsigned)rt_[h * HALF + sR[i]] * (unsigned)S.K + (unsigned)sC[i] * 2u; nvoA[h][i] = vo2[h][i]; } }
            PG8_LDB(B0, 0, 0); PG8_LDB(B1, 0, 1); PG8_SCHED; PG8_LDA(At, 0, 0); PG8_STGA(PG8_SA(1, 1), a1, voA, 1);
            PG8_WAIT_V(8); PG8_WAIT_L(0); PG8_BAR; PG8_MMA(0, 0, At, B0); PG8_MMA(0, 1, At, B1); PG8_BAR; PG8_SCHED;
            PG8_LDA(At, 0, 1); PG8_STGB(PG8_SB(0, 0), b2); PG8_STGB(PG8_SB(0, 1), b2 + hstep); PG8_STGA(PG8_SA(0, 0), a2, vo2, 0);
            PG8_WAIT_V(8); PG8_WAIT_L(0); PG8_BAR; PG8_MMA(1, 0, At, B0); PG8_MMA(1, 1, At, B1); PG8_BAR; PG8_SCHED;
            PG8_LDB(B0, 1, 0); PG8_LDB(B1, 1, 1); PG8_SCHED; PG8_LDA(At, 1, 0); PG8_STGA(PG8_SA(0, 1), a2, vo2, 1);
            PG8_WAIT_V(8); PG8_WAIT_L(0); PG8_BAR; PG8_MMA(0, 0, At, B0); PG8_MMA(0, 1, At, B1); PG8_BAR; PG8_SCHED;
            PG8_LDA(At, 1, 1); PG8_STGB(PG8_SB(1, 0), b3); PG8_STGB(PG8_SB(1, 1), b3 + hstep); PG8_STGA(PG8_SA(1, 0), a3, vo2, 0);
            PG8_WAIT_V(8); PG8_WAIT_L(0); PG8_BAR; PG8_MMA(1, 0, At, B0); PG8_MMA(1, 1, At, B1); PG8_BAR; PG8_SCHED;
        }
        if constexpr (F8) asm volatile("s_nop 15\n\ts_nop 15\n\ts_nop 15" ::: "memory");
        if constexpr (ALIGN_EPI) { if (wr == 0) PG8_BAR; }
        E(acc, cur, wr, wc, fr, fq);
        if (!has_next) break;
#pragma unroll
        for (int a = 0; a < 2; ++a)
#pragma unroll
            for (int b = 0; b < 2; ++b)
#pragma unroll
                for (int m = 0; m < 4; ++m)
#pragma unroll
                    for (int n = 0; n < 2; ++n) acc[a][b][m][n] = (f32x4){0.f, 0.f, 0.f, 0.f};
        cur = nxt; cA = nA; cB = nB; ++ui; nxt = nn; has_next = has_nn;
        if (Sched::GATHER) {
#pragma unroll
            for (int h = 0; h < 2; ++h)
#pragma unroll
                for (int i = 0; i < 2; ++i) voA[h][i] = nvoA[h][i]; }
        if constexpr (ALIGN_EPI) { if (wr == 1) PG8_BAR; }
    }
    PG8_WAIT_V(0);
    if constexpr (!ALIGN_EPI) { if (wr == 0) PG8_BAR; }
    PG8_BAR;
#undef PG8_SA
#undef PG8_SB
#undef PG8_STGA
#undef PG8_STGB
#undef PG8_VOA
#undef PG8_LDA
#undef PG8_LDB
#undef PG8_MMA
#undef PG8_WAIT_V
#undef PG8_WAIT_L
#undef PG8_BAR
#undef PG8_SCHED
}

typedef f32x4 Acc[2][2][4][2];
struct EpiInProj {
    static constexpr bool PERM = true;
    __device__ __forceinline__ void stage_rows(const Unit&, LAS unsigned char*, int) const {}
    bf16_t *prw, *puv, *pg;
    template <int ACT> __device__ __forceinline__ void tile(const Acc& acc, bf16_t* base, int ld, int row0, int col0) const {
#pragma unroll
        for (int ai = 0; ai < 2; ++ai)
#pragma unroll
            for (int m = 0; m < 4; ++m) { bf16_t* rowp = base + (size_t)(row0 + ai * HALF + m * 16) * ld + col0;
#pragma unroll
                for (int bj = 0; bj < 2; ++bj) { f32x4 v0 = acc[ai][bj][m][0], v1 = acc[ai][bj][m][1];
                    if (ACT == 1) {
#pragma unroll
                        for (int j = 0; j < 4; ++j) { v0[j] = gelu_tanh(v0[j]); v1[j] = gelu_tanh(v1[j]); } }
                    if (ACT == 2) {
#pragma unroll
                        for (int j = 0; j < 4; ++j) { v0[j] = sigmoidf_(v0[j]); v1[j] = sigmoidf_(v1[j]); } }
                    u32x4 w; w.x = pk2(v0[0], v0[1]); w.y = pk2(v0[2], v0[3]); w.z = pk2(v1[0], v1[1]); w.w = pk2(v1[2], v1[3]);
                    *(u32x4*)(rowp + bj * HALF) = w; }
                __builtin_amdgcn_sched_barrier(0); }
    }
    __device__ __forceinline__ void operator()(const Acc& acc, const Unit& u, int wr, int wc, int fr, int fq) const {
        const int row0 = u.row0 + wr * 64 + fr, cw = wc * 32 + 8 * fq;
        if (u.pn < 7) tile<0>(acc, prw, RWKV_COLS, row0, u.pn * 256 + cw);
        else if (u.pn < 11) tile<1>(acc, puv, 1024, row0, (u.pn - 7) * 256 + cw);
        else tile<2>(acc, pg, 2048, row0, (u.pn - 11) * 256 + cw);
    }
};
template <bool SECOND> struct EpiMerge {
    static constexpr bool PERM = true;
    __device__ __forceinline__ void stage_rows(const Unit&, LAS unsigned char*, int) const {}
    bf16_t* m1; const bf16_t* pg; unsigned char* m8;
    __device__ __forceinline__ void operator()(const Acc& acc, const Unit& u, int wr, int wc, int fr, int fq) const {
        const int row0 = u.row0 + wr * 64 + fr, col0 = u.pn * 256 + wc * 32 + 8 * fq;
#pragma unroll
        for (int ai = 0; ai < 2; ++ai)
#pragma unroll
            for (int m = 0; m < 4; ++m) { const size_t r = (size_t)(row0 + ai * HALF + m * 16);
#pragma unroll
                for (int bj = 0; bj < 2; ++bj) { const int c = col0 + bj * HALF;
                    const u32x4 g = *(const u32x4*)(pg + r * 2048 + (SECOND ? 1024 : 0) + c);
                    f32x4 v0 = acc[ai][bj][m][0], v1 = acc[ai][bj][m][1];
                    v0[0] *= bflo(g.x); v0[1] *= bfhi(g.x); v0[2] *= bflo(g.y); v0[3] *= bfhi(g.y); v1[0] *= bflo(g.z); v1[1] *= bfhi(g.z); v1[2] *= bflo(g.w); v1[3] *= bfhi(g.w);
                    if (SECOND) { const u32x4 p = *(const u32x4*)(m1 + r * 1024 + c);
                        v0[0] += bflo(p.x); v0[1] += bfhi(p.x); v0[2] += bflo(p.y); v0[3] += bfhi(p.y); v1[0] += bflo(p.z); v1[1] += bfhi(p.z); v1[2] += bflo(p.w); v1[3] += bfhi(p.w); }
                    if (SECOND) *(u32x2*)(m8 + r * 1024 + c) = pk8(v0, v1);
                    else { u32x4 w; w.x = pk2(v0[0], v0[1]); w.y = pk2(v0[2], v0[3]); w.z = pk2(v1[0], v1[1]); w.w = pk2(v1[2], v1[3]); *(u32x4*)(m1 + r * 1024 + c) = w; } }
                __builtin_amdgcn_sched_barrier(0); }
    }
};
struct EpiResid {
    static constexpr bool PERM = true;
    __device__ __forceinline__ void stage_rows(const Unit&, LAS unsigned char*, int) const {}
    bf16_t* out; const float* base; const float* gate;
    __device__ __forceinline__ void operator()(const Acc& acc, const Unit& u, int wr, int wc, int fr, int fq) const {
        const int row0 = u.row0 + wr * 64 + fr, col0 = u.pn * 256 + wc * 32 + 8 * fq;
        const float* gp = gate + (size_t)(u.row0 >> 13) * 6144 + col0;
        f32x4 gv[2][2];
#pragma unroll
        for (int bj = 0; bj < 2; ++bj)
#pragma unroll
            for (int n = 0; n < 2; ++n) gv[bj][n] = *(const f32x4*)(gp + bj * HALF + n * 4);
#pragma unroll
        for (int ai = 0; ai < 2; ++ai)
#pragma unroll
            for (int m = 0; m < 4; ++m) { const size_t ro = (size_t)(row0 + ai * HALF + m * 16) * 1024 + col0;
#pragma unroll
                for (int bj = 0; bj < 2; ++bj) { const f32x4 b0 = *(const f32x4*)(base + ro + bj * HALF), b1 = *(const f32x4*)(base + ro + bj * HALF + 4);
                    const f32x4 v0 = b0 + gv[bj][0] * acc[ai][bj][m][0], v1 = b1 + gv[bj][1] * acc[ai][bj][m][1];
                    u32x4 w; w.x = pk2(v0[0], v0[1]); w.y = pk2(v0[2], v0[3]); w.z = pk2(v1[0], v1[1]); w.w = pk2(v1[2], v1[3]);
                    *(u32x4*)(out + ro + bj * HALF) = w; }
                __builtin_amdgcn_sched_barrier(0); }
    }
};
struct EpiRouter {
    static constexpr bool PERM = false;
    __device__ __forceinline__ void stage_rows(const Unit&, LAS unsigned char*, int) const {}
    float* sc;
    __device__ __forceinline__ void operator()(const Acc& acc, const Unit& u, int wr, int wc, int fr, int fq) const {
        const int row0 = u.row0 + wr * 64 + fr, col0 = wc * 32 + 4 * fq;
#pragma unroll
        for (int ai = 0; ai < 2; ++ai)
#pragma unroll
            for (int m = 0; m < 4; ++m) { float* rowp = sc + (size_t)(row0 + ai * HALF + m * 16) * 256 + col0;
#pragma unroll
                for (int bj = 0; bj < 2; ++bj)
#pragma unroll
                    for (int n = 0; n < 2; ++n) { f32x4 v = acc[ai][bj][m][n];
#pragma unroll
                        for (int j = 0; j < 4; ++j) v[j] = sigmoidf_(v[j]);
                        *(f32x4*)(rowp + bj * HALF + n * 16) = v; }
                __builtin_amdgcn_sched_barrier(0); }
    }
};
template <bool F8OUT> struct EpiGateUp {
    static constexpr bool PERM = true;
    __device__ __forceinline__ void stage_rows(const Unit&, LAS unsigned char*, int) const {}
    void* hid;
    __device__ __forceinline__ void operator()(const Acc& acc, const Unit& u, int wr, int wc, int fr, int fq) const {
        const int row0 = u.row0 + wr * 64 + fr, col0 = u.pn * HALF + wc * 32 + 8 * fq;
#pragma unroll
        for (int ai = 0; ai < 2; ++ai)
#pragma unroll
            for (int m = 0; m < 4; ++m) { const size_t off = (size_t)(row0 + ai * HALF + m * 16) * EFF + col0;
                f32x4 v0, v1;
#pragma unroll
                for (int j = 0; j < 4; ++j) { v0[j] = siluf_(acc[ai][0][m][0][j]) * acc[ai][1][m][0][j]; v1[j] = siluf_(acc[ai][0][m][1][j]) * acc[ai][1][m][1][j]; }
                if constexpr (F8OUT) *(u32x2*)((unsigned char*)hid + off) = pk8(v0, v1);
                else { u32x4 w; w.x = pk2(v0[0], v0[1]); w.y = pk2(v0[2], v0[3]); w.z = pk2(v1[0], v1[1]); w.w = pk2(v1[2], v1[3]); *(u32x4*)((bf16_t*)hid + off) = w; }
                __builtin_amdgcn_sched_barrier(0); }
    }
};
struct EpiExpertDown {
    static constexpr bool PERM = true;
    unsigned char* slot; const int* rowdst; const float* roww;
    __device__ __forceinline__ void stage_rows(const Unit& u, LAS unsigned char* lds, int wid) const {
        if (wid < 4) { const int lane = threadIdx.x & 63; LAS unsigned char* base = lds + LDS_MISC + u.par * 2048 + wid * 256;
            __builtin_amdgcn_global_load_lds((const unsigned*)(rowdst + u.row0 + wid * 64 + lane), (LAS unsigned*)base, 4, 0, 0);
            __builtin_amdgcn_global_load_lds((const unsigned*)(roww + u.row0 + wid * 64 + lane), (LAS unsigned*)(base + 1024), 4, 0, 0); }
    }
    __device__ __forceinline__ void operator()(const Acc& acc, const Unit& u, int wr, int wc, int fr, int fq) const {
        const unsigned cb = (unsigned)(u.pn * 256 + wc * 64 + 16 * fq);
        const LAS int* td = (const LAS int*)((LAS unsigned char*)nullptr + LDS_MISC + u.par * 2048) + wr * 64 + fr; const LAS float* tw = (const LAS float*)(td + 256);
        int dst[2][4]; float ws_[2][4];
#pragma unroll
        for (int ai = 0; ai < 2; ++ai)
#pragma unroll
            for (int m = 0; m < 4; ++m) { dst[ai][m] = td[ai * HALF + m * 16]; ws_[ai][m] = tw[ai * HALF + m * 16]; }
#pragma unroll
        for (int ai = 0; ai < 2; ++ai)
#pragma unroll
            for (int m = 0; m < 4; ++m) {
                if (dst[ai][m] >= 0) { const float s_ = ws_[ai][m]; const u32x2 lo = pk8(acc[ai][0][m][0] * s_, acc[ai][0][m][1] * s_), hi = pk8(acc[ai][1][m][0] * s_, acc[ai][1][m][1] * s_);
                    *(u32x4*)(slot + (size_t)((unsigned)dst[ai][m] * 1024u + cb)) = (u32x4){lo.x, lo.y, hi.x, hi.y}; }
            }
    }
};
struct EpiSharedDown {
    static constexpr bool PERM = true;
    unsigned char* sho;
    __device__ __forceinline__ void stage_rows(const Unit&, LAS unsigned char*, int) const {}
    __device__ __forceinline__ void operator()(const Acc& acc, const Unit& u, int wr, int wc, int fr, int fq) const {
        const int row0 = u.row0 + wr * 64 + fr, col0 = u.pn * 256 + wc * 32 + 8 * fq;
#pragma unroll
        for (int ai = 0; ai < 2; ++ai)
#pragma unroll
            for (int m = 0; m < 4; ++m) { unsigned char* rowp = sho + (size_t)(row0 + ai * HALF + m * 16) * 1024 + col0;
#pragma unroll
                for (int bj = 0; bj < 2; ++bj) *(u32x2*)(rowp + bj * HALF) = pk8(acc[ai][bj][m][0], acc[ai][bj][m][1]);
                __builtin_amdgcn_sched_barrier(0); }
    }
};
}
__device__ __forceinline__ void phase_mod(const float* c, const float* ada_w, const float* ada_b, float* mod, LAS unsigned char* lds, int tid, int G) {
    LAS float* sl = (LAS float*)lds; LAS float* red = (LAS float*)(lds + 32768);
    for (int i = tid; i < NB * D; i += NTHREADS) { const float v = c[i]; sl[i] = siluf_(v); }
    __syncthreads();
    const int cl = tid % 24, kg = tid / 24;
    for (int cb = blockIdx.x; cb < 256; cb += G) {
        const int col0 = cb * 24;
        if (tid < 384) {
            float a[NB];
#pragma unroll
            for (int b = 0; b < NB; ++b) a[b] = 0.f;
#pragma unroll 1
            for (int k0 = kg; k0 < D; k0 += 16 * 16) { float w[16];
#pragma unroll
                for (int i = 0; i < 16; ++i) w[i] = ada_w[(size_t)(k0 + 16 * i) * 6144 + col0 + cl];
#pragma unroll
                for (int i = 0; i < 16; ++i) {
#pragma unroll
                    for (int b = 0; b < NB; ++b) a[b] += sl[b * D + k0 + 16 * i] * w[i]; } }
#pragma unroll
            for (int b = 0; b < NB; ++b) red[(kg * 24 + cl) * NB + b] = a[b];
        }
        __syncthreads();
        if (tid < 192) { const int c2 = tid >> 3, b = tid & 7; float s = 0.f;
#pragma unroll
            for (int g = 0; g < 16; ++g) s += red[(g * 24 + c2) * NB + b];
            mod[(size_t)b * 6144 + col0 + c2] = s + ada_b[col0 + c2]; }
        __syncthreads();
    }
}
__device__ __forceinline__ void transpose_item(const float* W, int ldw, int k0, int n0, bf16_t* WT, int ldt, int drow0, LAS float* scr, int lane) {
#pragma unroll 8
    for (int i = 0; i < 32; ++i) { const int kk = 2 * i + (lane >> 5); scr[kk * 33 + (lane & 31)] = W[(size_t)(k0 + kk) * ldw + n0 + (lane & 31)]; }
    LDS_WAIT(); asm volatile("" ::: "memory");
    const int c = lane & 7;
#pragma unroll
    for (int j = 0; j < 4; ++j) { const int n = (lane >> 3) + 8 * j; const LAS float* s = scr + (8 * c) * 33 + n;
        u32x4 o; o.x = pk2(s[0 * 33], s[1 * 33]); o.y = pk2(s[2 * 33], s[3 * 33]); o.z = pk2(s[4 * 33], s[5 * 33]); o.w = pk2(s[6 * 33], s[7 * 33]);
        *(u32x4*)(WT + (size_t)(drow0 + n) * ldt + k0 + 8 * c) = o; }
    LDS_WAIT(); asm volatile("" ::: "memory");
}
__device__ __forceinline__ void transpose_job(const float* W, int K, int N, bf16_t* WT, int gated, int goff, int item, LAS float* scr, int lane) {
    const int nblk = N / 32, kb = item / nblk, nb = item % nblk, n0 = 32 * nb;
    const int drow0 = gated ? (256 * (n0 >> 7) + goff + (n0 & 127)) : n0;
    transpose_item(W, N, 64 * kb, n0, WT, K, drow0, scr, lane);
}
__device__ __forceinline__ void transpose_item64(const float* W, int ldw, int k0, int n0, bf16_t* WT, int ldt, int drow0, LAS float* scr, int lane) {
    f32x4 v[16];
    const int c4 = lane & 15, r4 = lane >> 4;
#pragma unroll
    for (int i = 0; i < 16; ++i) v[i] = *(const f32x4*)(W + (size_t)(k0 + 4 * i + r4) * ldw + n0 + 4 * c4);
#pragma unroll
    for (int i = 0; i < 16; ++i) { LAS float* d = scr + (4 * i + r4) * 65 + 4 * c4; d[0] = v[i].x; d[1] = v[i].y; d[2] = v[i].z; d[3] = v[i].w; }
    LDS_WAIT(); asm volatile("" ::: "memory");
    const int c = lane & 7;
#pragma unroll
    for (int j = 0; j < 8; ++j) { const int n = (lane >> 3) + 8 * j; const LAS float* s = scr + (8 * c) * 65 + n;
        u32x4 o; o.x = pk2(s[0 * 65], s[1 * 65]); o.y = pk2(s[2 * 65], s[3 * 65]); o.z = pk2(s[4 * 65], s[5 * 65]); o.w = pk2(s[6 * 65], s[7 * 65]);
        *(u32x4*)(WT + (size_t)(drow0 + n) * ldt + k0 + 8 * c) = o; }
    LDS_WAIT(); asm volatile("" ::: "memory");
}
constexpr float WSCALE = 32.0f;
__device__ __forceinline__ void transpose_item64_f8(const float* W, int ldw, int k0, int n0, unsigned char* WT8, int ldt, int drow0, LAS float* scr, int lane) {
    f32x4 v[16];
    const int c4 = lane & 15, r4 = lane >> 4;
#pragma unroll
    for (int i = 0; i < 16; ++i) v[i] = *(const f32x4*)(W + (size_t)(k0 + 4 * i + r4) * ldw + n0 + 4 * c4);
#pragma unroll
    for (int i = 0; i < 16; ++i) { LAS float* d = scr + (4 * i + r4) * 65 + 4 * c4; d[0] = v[i].x; d[1] = v[i].y; d[2] = v[i].z; d[3] = v[i].w; }
    LDS_WAIT(); asm volatile("" ::: "memory");
    const int c = lane & 7;
#pragma unroll
    for (int j = 0; j < 8; ++j) { const int n = (lane >> 3) + 8 * j; const LAS float* s = scr + (8 * c) * 65 + n;
        const f32x4 lo = (f32x4){s[0 * 65], s[1 * 65], s[2 * 65], s[3 * 65]} * WSCALE, hi = (f32x4){s[4 * 65], s[5 * 65], s[6 * 65], s[7 * 65]} * WSCALE;
        *(u32x2*)(WT8 + (size_t)(drow0 + n) * ldt + k0 + 8 * c) = pk8(lo, hi); }
    LDS_WAIT(); asm volatile("" ::: "memory");
}
struct SmallW { const float *w_in, *w_out_a, *w_out_b, *w_out, *router_w, *sw1, *sw3, *sw2, *w_up, *a_up, *g_up, *gws; };
__device__ __forceinline__ void phase_small_weights(const SmallW& P, unsigned char* ws, LAS unsigned char* lds, int gw, int NGW, int wave, int lane) {
    LAS float* scr = (LAS float*)(lds + wave * 16640);
    constexpr int I0 = 16 * 76, I1 = 8 * 16, I2 = 8 * 16, I3 = 16 * 16, I4 = 16 * 8, I5 = 16 * 4, I6 = 16 * 4, I7 = 4 * 16, I8 = 16, I9 = 16, I10 = 2 * 16;
    constexpr int NIT = I0 + I1 + I2 + I3 + I4 + I5 + I6 + I7 + I8 + I9 + I10;
    for (int it = gw; it < NIT; it += NGW) {
        int r = it;
        if (r < I0) { const int kb = r / 76, nb = r % 76; transpose_item64_f8(P.w_in, IN_COLS, 64 * kb, 64 * nb, ws + SW_WIN, D, 64 * nb, scr, lane); continue; } r -= I0;
        if (r < I1) { transpose_item64_f8(P.w_out_a, D, 64 * (r >> 4), 64 * (r & 15), ws + SW_WOA, RW, 64 * (r & 15), scr, lane); continue; } r -= I1;
        if (r < I2) { transpose_item64_f8(P.w_out_b, D, 64 * (r >> 4), 64 * (r & 15), ws + SW_WOB, RW, 64 * (r & 15), scr, lane); continue; } r -= I2;
        if (r < I3) { transpose_item64_f8(P.w_out, D, 64 * (r >> 4), 64 * (r & 15), ws + SW_WO, D, 64 * (r & 15), scr, lane); continue; } r -= I3;
        if (r < I4) { transpose_job(P.router_w, D, NE, (bf16_t*)(ws + SW_WR), 0, 0, r, scr, lane); continue; } r -= I4;
        if (r < I5) { const int n0 = 64 * (r & 3); transpose_item64_f8(P.sw1, EFF, 64 * (r >> 2), n0, ws + SW_WS13, D, 256 * (n0 >> 7) + (n0 & 127), scr, lane); continue; } r -= I5;
        if (r < I6) { const int n0 = 64 * (r & 3); transpose_item64_f8(P.sw3, EFF, 64 * (r >> 2), n0, ws + SW_WS13, D, 256 * (n0 >> 7) + 128 + (n0 & 127), scr, lane); continue; } r -= I6;
        if (r < I7) { transpose_item64_f8(P.sw2, D, 64 * (r >> 4), 64 * (r & 15), ws + SW_WS2, EFF, 64 * (r & 15), scr, lane); continue; } r -= I7;
        if (r < I8) { transpose_job(P.w_up, 64, RW, (bf16_t*)(ws + SW_WUP), 0, 0, r, scr, lane); continue; } r -= I8;
        if (r < I9) { transpose_job(P.a_up, 64, RW, (bf16_t*)(ws + SW_AUP), 0, 0, r, scr, lane); continue; } r -= I9;
        transpose_job(P.g_up, 128, RW, (bf16_t*)(ws + SW_GUP), 0, 0, r, scr, lane);
    }
    bf16_t* wsm = (bf16_t*)(ws + SW_WSM);
    for (int i = gw * 64 + lane; i < 8 * 128 * 128; i += NGW * 64) { const int col = i & 127, row = (i >> 7) & 127; wsm[i] = (col <= row) ? f2bf(P.gws[i]) : (bf16_t)0; }
}
template <bool PERM16>
__device__ __forceinline__ void transpose_item128_f8(const float* W, int ldw, int k0, int n0, unsigned char* WT8, int ldt, int drow0, LAS float* scr, int lane) {
    f32x4 v[16];
    const int c4 = lane & 7, r8 = lane >> 3;
#pragma unroll
    for (int i = 0; i < 16; ++i) v[i] = *(const f32x4*)(W + (size_t)(k0 + 8 * i + r8) * ldw + n0 + 4 * c4);
#pragma unroll
    for (int i = 0; i < 16; ++i) { LAS float* d = scr + (8 * i + r8) * 33 + 4 * c4; d[0] = v[i].x; d[1] = v[i].y; d[2] = v[i].z; d[3] = v[i].w; }
    LDS_WAIT(); asm volatile("" ::: "memory");
    const int c = lane & 7;
#pragma unroll
    for (int j = 0; j < 4; ++j) { const int n = (lane >> 3) + 8 * j; const LAS float* s = scr + (16 * c) * 33 + n;
        f32x4 a0 = (f32x4){s[0 * 33], s[1 * 33], s[2 * 33], s[3 * 33]} * WSCALE, a1 = (f32x4){s[4 * 33], s[5 * 33], s[6 * 33], s[7 * 33]} * WSCALE;
        f32x4 a2 = (f32x4){s[8 * 33], s[9 * 33], s[10 * 33], s[11 * 33]} * WSCALE, a3 = (f32x4){s[12 * 33], s[13 * 33], s[14 * 33], s[15 * 33]} * WSCALE;
        const u32x2 lo = pk8(a0, a1), hi = pk8(a2, a3);
        int dr = drow0 + n; if (PERM16) { const int r = dr & 255; dr = (dr & ~255) + 128 * ((r >> 3) & 1) + 8 * (r >> 4) + (r & 7); }
        *(u32x4*)(WT8 + (size_t)dr * ldt + k0 + 16 * c) = (u32x4){lo.x, lo.y, hi.x, hi.y}; }
    LDS_WAIT(); asm volatile("" ::: "memory");
}
__device__ __forceinline__ void phase_expert_weights(const float* w1, const float* w3, const float* w2, unsigned char* ws, LAS unsigned char* lds, int gw, int NGW, int wave, int lane) {
    LAS float* scr = (LAS float*)(lds + wave * 16896);
    constexpr int PER = 64;
    for (int it = gw; it < NE * 3 * PER; it += NGW) {
        const int e = it / (3 * PER), r = it % (3 * PER), which = r / PER, item = r % PER;
        if (which < 2) { const int kb = item >> 3, nb = item & 7, n0 = 32 * nb;
            transpose_item128_f8<false>((which ? w3 : w1) + (size_t)e * D * EFF, EFF, 128 * kb, n0, ws + B_W13 + (size_t)e * 512 * D, D, 256 * (n0 >> 7) + which * 128 + (n0 & 127), scr, lane); }
        else { const int kb = item >> 5, nb = item & 31;
            transpose_item128_f8<true>(w2 + (size_t)e * EFF * D, D, 128 * kb, 32 * nb, ws + B_W2 + (size_t)e * D * EFF, EFF, 32 * nb, scr, lane); }
    }
}
template <bool XBF>
__device__ __forceinline__ void phase_norm_mod(const void* X, const float* gain, const float* mod, int sh_off, int sc_off, bf16_t* out, unsigned char* out8, int gw, int NGW, int lane) {
    constexpr int R = XBF ? 4 : 8;
    for (int m0 = gw; m0 < T; m0 += R * NGW) {
        f32x4 v[R][4];
#pragma unroll
        for (int rr = 0; rr < R; ++rr) { const int m = m0 + rr * NGW; const size_t mr = (size_t)(m < T ? m : m0);
            if constexpr (XBF) { const u32x2* xr = (const u32x2*)((const bf16_t*)X + mr * D) + lane;
#pragma unroll
                for (int j = 0; j < 4; ++j) { const u32x2 w = xr[64 * j]; v[rr][j] = (f32x4){bflo(w.x), bfhi(w.x), bflo(w.y), bfhi(w.y)}; } }
            else { const f32x4* xr = (const f32x4*)((const float*)X + mr * D) + lane;
#pragma unroll
                for (int j = 0; j < 4; ++j) v[rr][j] = xr[64 * j]; } }
#pragma unroll
        for (int rr = 0; rr < R; ++rr) { const int m = m0 + rr * NGW; if (m >= T) break;
            float ss = 0.f;
#pragma unroll
            for (int j = 0; j < 4; ++j) ss += (v[rr][j].x * v[rr][j].x + v[rr][j].y * v[rr][j].y) + (v[rr][j].z * v[rr][j].z + v[rr][j].w * v[rr][j].w);
            const float rstd = __builtin_amdgcn_rsqf(wave_sum(ss) * (1.f / D) + 1e-6f);
            const float* mb = mod + (size_t)(m >> 13) * 6144;
            u32x2* o8 = (u32x2*)(out + (size_t)m * D) + lane;
#pragma unroll
            for (int j = 0; j < 4; ++j) { const int col = 4 * lane + 256 * j;
                const f32x4 g = *(const f32x4*)(gain + col), sc = *(const f32x4*)(mb + sc_off + col), sh = *(const f32x4*)(mb + sh_off + col);
                const f32x4 y = v[rr][j] * rstd * g * (sc + 1.0f) + sh;
                if (out) { u32x2 w; w.x = pk2(y.x, y.y); w.y = pk2(y.z, y.w); o8[64 * j] = w; }
                if (out8) { int t8 = __builtin_amdgcn_cvt_pk_fp8_f32(y.x, y.y, 0, false); t8 = __builtin_amdgcn_cvt_pk_fp8_f32(y.z, y.w, t8, true); *(unsigned*)(out8 + (size_t)m * D + col) = (unsigned)t8; } } }
    }
}
struct YaArgs { bf16_t* ya; const bf16_t* g; const bf16_t* prw; const float* sbon; const float* mu; const float* ln_g; const float* ln_b; };
__device__ __forceinline__ void phase_ya_final(const YaArgs& P, int gw, int NGW, int lane) {
    const int ch0 = lane * 8, head = lane >> 3;
    float muv[8], lg[8], lb[8];
#pragma unroll
    for (int j = 0; j < 8; ++j) { muv[j] = P.mu[1024 + ch0 + j]; lg[j] = P.ln_g[ch0 + j]; lb[j] = P.ln_b[ch0 + j]; }
    for (int m = gw; m < T; m += NGW) {
        const u32x4 yw = *(const u32x4*)(P.ya + (size_t)m * RW + ch0);
        const u32x4 gw4 = *(const u32x4*)(P.g + (size_t)m * RW + ch0);
        const u32x4 vc = *(const u32x4*)(P.prw + (size_t)m * RWKV_COLS + 1024 + ch0);
        u32x4 vp = (u32x4){0u, 0u, 0u, 0u};
        if ((m & (SEQ - 1)) != 0) vp = *(const u32x4*)(P.prw + (size_t)(m - 1) * RWKV_COLS + 1024 + ch0);
        const float sb = P.sbon[(size_t)m * NH + head];
        float y[8], gg[8], vv[8], pv[8];
        y[0] = bflo(yw.x); y[1] = bfhi(yw.x); y[2] = bflo(yw.y); y[3] = bfhi(yw.y); y[4] = bflo(yw.z); y[5] = bfhi(yw.z); y[6] = bflo(yw.w); y[7] = bfhi(yw.w);
        gg[0] = bflo(gw4.x); gg[1] = bfhi(gw4.x); gg[2] = bflo(gw4.y); gg[3] = bfhi(gw4.y); gg[4] = bflo(gw4.z); gg[5] = bfhi(gw4.z); gg[6] = bflo(gw4.w); gg[7] = bfhi(gw4.w);
        vv[0] = bflo(vc.x); vv[1] = bfhi(vc.x); vv[2] = bflo(vc.y); vv[3] = bfhi(vc.y); vv[4] = bflo(vc.z); vv[5] = bfhi(vc.z); vv[6] = bflo(vc.w); vv[7] = bfhi(vc.w);
        pv[0] = bflo(vp.x); pv[1] = bfhi(vp.x); pv[2] = bflo(vp.y); pv[3] = bfhi(vp.y); pv[4] = bflo(vp.z); pv[5] = bfhi(vp.z); pv[6] = bflo(vp.w); pv[7] = bfhi(vp.w);
        float s = 0.f;
#pragma unroll
        for (int j = 0; j < 8; ++j) s += y[j];
        s += __shfl_xor(s, 1); s += __shfl_xor(s, 2); s += __shfl_xor(s, 4);
        const float mean = s * (1.f / 64.f); float q = 0.f;
#pragma unroll
        for (int j = 0; j < 8; ++j) { y[j] -= mean; q += y[j] * y[j]; }
        q += __shfl_xor(q, 1); q += __shfl_xor(q, 2); q += __shfl_xor(q, 4);
        const float rstd = __builtin_amdgcn_rsqf(q * (1.f / 64.f) + 64e-5f);
        float o[8];
#pragma unroll
        for (int j = 0; j < 8; ++j) { const float vs = vv[j] + (pv[j] - vv[j]) * muv[j]; o[j] = (y[j] * rstd * lg[j] + lb[j] + sb * vs) * gg[j]; }
        u32x4 w; w.x = pk2(o[0], o[1]); w.y = pk2(o[2], o[3]); w.z = pk2(o[4], o[5]); w.w = pk2(o[6], o[7]);
        *(u32x4*)(P.ya + (size_t)m * RW + ch0) = w;
    }
}
__device__ __forceinline__ void phase_xs(const bf16_t* prw, const float* mu, bf16_t* xs, int gw, int NGW, int lane) {
    const f32x4 m4 = *(const f32x4*)(mu + 1536 + 4 * lane);
    for (int t = gw; t < T; t += NGW) {
        const bf16_t* src = prw + (size_t)t * RWKV_COLS + 1536 + 4 * lane;
        const u32x2 cw = *(const u32x2*)src; u32x2 pw = (u32x2){0u, 0u};
        if ((t & (SEQ - 1)) != 0) pw = *(const u32x2*)(src - RWKV_COLS);
        f32x4 v = (f32x4){bflo(cw.x), bfhi(cw.x), bflo(cw.y), bfhi(cw.y)}; const f32x4 p = (f32x4){bflo(pw.x), bfhi(pw.x), bflo(pw.y), bfhi(pw.y)};
        v = v + (p - v) * m4;
        if (lane < 16) {
#pragma unroll
            for (int j = 0; j < 4; ++j) v[j] = tanhf_(v[j]); }
        else if (lane >= 32) {
#pragma unroll
            for (int j = 0; j < 4; ++j) v[j] = sigmoidf_(v[j]); }
        u32x2 w; w.x = pk2(v[0], v[1]); w.y = pk2(v[2], v[3]);
        *(u32x2*)(xs + (size_t)t * 256 + 4 * lane) = w;
    }
}
__device__ __forceinline__ void phase_gate(const bf16_t* xs, const bf16_t* gup, bf16_t* g, int gw, int NGW, int lane) {
    const int r = lane & 15, q = lane >> 4;
    for (int item = gw; item < 8 * 256; item += NGW) {
        const int cb = item & 7, tg = item >> 3;
        bf16x8 af[4][4];
#pragma unroll
        for (int mt = 0; mt < 4; ++mt)
#pragma unroll
            for (int s = 0; s < 4; ++s) af[mt][s] = *(const bf16x8*)(gup + (size_t)(cb * 64 + 16 * mt + r) * 128 + 32 * s + 8 * q);
        bf16x8 nb[4];
#pragma unroll
        for (int s = 0; s < 4; ++s) nb[s] = *(const bf16x8*)(xs + (size_t)(tg * 256 + r) * 256 + 128 + 32 * s + 8 * q);
        for (int tt = 0; tt < 16; ++tt) {
            const int t0 = tg * 256 + tt * 16;
            bf16x8 bfr[4];
#pragma unroll
            for (int s = 0; s < 4; ++s) bfr[s] = nb[s];
            if (tt + 1 < 16) {
#pragma unroll
                for (int s = 0; s < 4; ++s) nb[s] = *(const bf16x8*)(xs + (size_t)(t0 + 16 + r) * 256 + 128 + 32 * s + 8 * q); }
#pragma unroll
            for (int mt = 0; mt < 4; ++mt) { f32x4 acc = (f32x4){0.f, 0.f, 0.f, 0.f};
#pragma unroll
                for (int s = 0; s < 4; ++s) acc = __builtin_amdgcn_mfma_f32_16x16x32_bf16(af[mt][s], bfr[s], acc, 0, 0, 0);
                u32x2 w; w.x = pk2(acc[0], acc[1]); w.y = pk2(acc[2], acc[3]);
                *(u32x2*)(g + (size_t)(t0 + r) * RW + cb * 64 + 16 * mt + 4 * q) = w; }
        }
    }
}
__device__ __forceinline__ void phase_combine(float* out, const bf16_t* x1, const unsigned char* slot, const unsigned char* sho, const float* mod, const float* normf, int gw, int NGW, int lane) {
    for (int m = gw; m < T; m += NGW) {
        const int b = m >> 13;
        f32x4* xr = (f32x4*)(out + (size_t)m * D + 16 * lane);
        const float* g2 = mod + (size_t)b * 6144 + 5120 + 16 * lane;
        u32x4 sw[TOPK + 1];
#pragma unroll
        for (int k = 0; k < TOPK; ++k) sw[k] = *(const u32x4*)(slot + ((size_t)m * TOPK + k) * D + 16 * lane);
        sw[TOPK] = *(const u32x4*)(sho + (size_t)m * D + 16 * lane);
        f32x4 x[4];
        { const u32x4 w0 = *(const u32x4*)(x1 + (size_t)m * D + 16 * lane), w1 = *(const u32x4*)(x1 + (size_t)m * D + 16 * lane + 8);
          x[0] = (f32x4){bflo(w0.x), bfhi(w0.x), bflo(w0.y), bfhi(w0.y)}; x[1] = (f32x4){bflo(w0.z), bfhi(w0.z), bflo(w0.w), bfhi(w0.w)};
          x[2] = (f32x4){bflo(w1.x), bfhi(w1.x), bflo(w1.y), bfhi(w1.y)}; x[3] = (f32x4){bflo(w1.z), bfhi(w1.z), bflo(w1.w), bfhi(w1.w)}; }
        f32x4 a[4];
#pragma unroll
        for (int j = 0; j < 4; ++j) a[j] = (f32x4){0.f, 0.f, 0.f, 0.f};
#pragma unroll
        for (int k = 0; k <= TOPK; ++k) { a[0] += up8(sw[k].x); a[1] += up8(sw[k].y); a[2] += up8(sw[k].z); a[3] += up8(sw[k].w); }
        float ss = 0.f;
#pragma unroll
        for (int j = 0; j < 4; ++j) { x[j] = x[j] + *(const f32x4*)(g2 + 4 * j) * a[j]; ss += (x[j].x * x[j].x + x[j].y * x[j].y) + (x[j].z * x[j].z + x[j].w * x[j].w); }
        const float rstd = __builtin_amdgcn_rsqf(wave_sum(ss) * (1.f / D) + 1e-6f);
#pragma unroll
        for (int j = 0; j < 4; ++j) xr[j] = x[j] * rstd * *(const f32x4*)(normf + 16 * lane + 4 * j);
    }
}
namespace rk {
constexpr int LD = 80;
constexpr int SLOTB = 64 * LD * 2;
constexpr int LDG = 136;
typedef LAS bf16_t* lp;
__device__ __forceinline__ lp slot(LAS unsigned char* lds, int i) { return (lp)(lds + i * SLOTB); }
template <int KS>
__device__ __forceinline__ void mm_nt(const LAS bf16_t* X, int ldx, const LAS bf16_t* Y, int ldy, int m, int nt0, int r, int q, f32x4 (&acc)[2]) {
#pragma unroll
    for (int s = 0; s < KS; ++s) {
        const bf16x8 a = *(const LAS bf16x8*)(X + (16 * m + r) * ldx + 32 * s + 8 * q);
#pragma unroll
        for (int n = 0; n < 2; ++n) { const bf16x8 b = *(const LAS bf16x8*)(Y + (16 * (nt0 + n) + r) * ldy + 32 * s + 8 * q); acc[n] = __builtin_amdgcn_mfma_f32_16x16x32_bf16(a, b, acc[n], 0, 0, 0); }
    }
}
__device__ __forceinline__ void st_rm(lp dst, int m, int nt, int r, int q, const f32x4& a) {
#pragma unroll
    for (int ii = 0; ii < 4; ++ii) dst[(16 * m + 4 * q + ii) * LD + 16 * nt + r] = f2bf(a[ii]);
}
__device__ __forceinline__ void st_tr(lp dst, int m, int nt, int r, int q, const f32x4& a) {
    u32x2 w; w.x = pk2(a[0], a[1]); w.y = pk2(a[2], a[3]); *(LAS u32x2*)(dst + (16 * nt + r) * LD + 16 * m + 4 * q) = w;
}
__device__ __forceinline__ void ld_rm(const LAS bf16_t* src, int m, int nt, int r, int q, f32x4& a) {
#pragma unroll
    for (int ii = 0; ii < 4; ++ii) a[ii] = bf2f(src[(16 * m + 4 * q + ii) * LD + 16 * nt + r]);
}
struct Args {
    const bf16_t* prw; const float* mu; const float *w0, *a0, *k_k, *k_a, *r_k;
    const bf16_t *wup, *aup, *gup;
    const bf16_t* xs;
    bf16_t* g; bf16_t* bv; unsigned char* mn; unsigned char* qy;
};
constexpr int LDS_MU = LDS_MISC + 2304;
struct Pre { u32x4 cw[3], pw[3]; bf16x8 xs[4]; };
__device__ __forceinline__ void task_map(int task, int h, int& i, int& ch, int& col) {
    i = task / 24; ch = task % 24;
    col = (ch >> 3) * 512 + h * 64 + 8 * (ch & 7);
}
__device__ __forceinline__ void load_mu(const Args& P, LAS unsigned char* lds, int tid) {
    LAS bf16_t* MU = (LAS bf16_t*)(lds + LDS_MU);
    for (int i = tid; i < 1536; i += NTHREADS) MU[i] = f2bf(P.mu[i]);
    __syncthreads();
}
struct Hd { bf16x8 w[4], a[4]; float w0[2], a0[2], kk[2], ka[2], rk[2]; };
__device__ __forceinline__ void load_head(const Args& P, int h, int tid, Hd& hd) {
    const int lane = tid & 63, r = lane & 15, q = lane >> 4, nh = tid >> 8;
#pragma unroll
    for (int n = 0; n < 2; ++n) { const int row = h * 64 + 16 * (2 * nh + n) + r;
#pragma unroll
        for (int s = 0; s < 2; ++s) { hd.w[s * 2 + n] = *(const bf16x8*)(P.wup + (size_t)row * 64 + 32 * s + 8 * q); hd.a[s * 2 + n] = *(const bf16x8*)(P.aup + (size_t)row * 64 + 32 * s + 8 * q); }
        hd.w0[n] = P.w0[row]; hd.a0[n] = P.a0[row]; hd.kk[n] = P.k_k[row]; hd.ka[n] = P.k_a[row]; hd.rk[n] = P.r_k[row]; }
}
__device__ __forceinline__ void prefetch(const Args& P, int b, int h, int c, int tid, Pre& pre) {
    const int t0 = b * SEQ + c * 64;
#pragma unroll
    for (int it = 0; it < 3; ++it) {
        int i, ch, col; task_map(tid + it * NTHREADS, h, i, ch, col);
        const bf16_t* src = P.prw + (size_t)(t0 + i) * RWKV_COLS + col;
        pre.cw[it] = *(const u32x4*)src;
        pre.pw[it] = (u32x4){0u, 0u, 0u, 0u};
        if (i != 0 || c != 0) pre.pw[it] = *(const u32x4*)(src - RWKV_COLS);
    }
    const int lane = tid & 63, r = lane & 15, q = lane >> 4, m = (tid >> 6) & 3;
    const bf16_t* xr = P.xs + (size_t)(t0 + 16 * m + r) * 256 + 8 * q;
#pragma unroll
    for (int f = 0; f < 4; ++f) pre.xs[f] = *(const bf16x8*)(xr + 32 * f);
}
__device__ __forceinline__ void unit(const Args& P, LAS unsigned char* lds, int b, int h, int c, int uidx, int tid, Pre& pf, Hd& hd, bool has_next, int nb, int nh_, int nc) {
    const int wave = __builtin_amdgcn_readfirstlane(tid >> 6), lane = tid & 63, r = lane & 15, q = lane >> 4, m = wave & 3, nh = wave >> 2;
    const int t0 = b * SEQ + c * 64;
    lp S0 = slot(lds, 0), S1 = slot(lds, 1), S2 = slot(lds, 2), S3 = slot(lds, 3), S4 = slot(lds, 4), S5 = slot(lds, 5), S6 = slot(lds, 6), S7 = slot(lds, 7);
    lp S8 = slot(lds, 8), S9 = slot(lds, 9), S10 = slot(lds, 10), S11 = slot(lds, 11), S12 = slot(lds, 12), S13 = slot(lds, 13), S14 = slot(lds, 14);
    LAS float* PART = (LAS float*)(lds + LDS_MISC);
    LAS float* CT = PART + 256;
    LAS float* DEND = CT + 256;
    const LAS bf16_t* MU = (const LAS bf16_t*)(lds + LDS_MU);
#define RK_BAR() do { asm volatile("s_waitcnt lgkmcnt(0)" ::: "memory"); __builtin_amdgcn_s_barrier(); asm volatile("" ::: "memory"); } while (0)
#define RK_DBG(bit, sp) do {} while (0)
#pragma unroll
    for (int it = 0; it < 3; ++it) {
        int i, ch, col; task_map(tid + it * NTHREADS, h, i, ch, col);
        LAS bf16_t* dst = slot(lds, 8 + (ch >> 3)) + i * LD + 8 * (ch & 7);
        const u32x4 cw = pf.cw[it], pw = pf.pw[it];
        const u32x4 mw = *(const LAS u32x4*)(MU + col);
        const f32x4 m0 = (f32x4){bflo(mw.x), bfhi(mw.x), bflo(mw.y), bfhi(mw.y)}, m1 = (f32x4){bflo(mw.z), bfhi(mw.z), bflo(mw.w), bfhi(mw.w)};
        float v[8], p[8];
        v[0] = bflo(cw.x); v[1] = bfhi(cw.x); v[2] = bflo(cw.y); v[3] = bfhi(cw.y); v[4] = bflo(cw.z); v[5] = bfhi(cw.z); v[6] = bflo(cw.w); v[7] = bfhi(cw.w);
        p[0] = bflo(pw.x); p[1] = bfhi(pw.x); p[2] = bflo(pw.y); p[3] = bfhi(pw.y); p[4] = bflo(pw.z); p[5] = bfhi(pw.z); p[6] = bflo(pw.w); p[7] = bfhi(pw.w);
#pragma unroll
        for (int j = 0; j < 4; ++j) { v[j] += (p[j] - v[j]) * m0[j]; v[4 + j] += (p[4 + j] - v[4 + j]) * m1[j]; }
        u32x4 w; w.x = pk2(v[0], v[1]); w.y = pk2(v[2], v[3]); w.z = pk2(v[4], v[5]); w.w = pk2(v[6], v[7]);
        *(LAS u32x4*)dst = w;
    }
    RK_BAR();
    f32x4 aw[2], aa[2];
#pragma unroll
    for (int n = 0; n < 2; ++n) { aw[n] = (f32x4){0.f, 0.f, 0.f, 0.f}; aa[n] = aw[n]; }
#pragma unroll
    for (int s = 0; s < 2; ++s)
#pragma unroll
        for (int n = 0; n < 2; ++n) { aw[n] = __builtin_amdgcn_mfma_f32_16x16x32_bf16(pf.xs[s], hd.w[s * 2 + n], aw[n], 0, 0, 0); aa[n] = __builtin_amdgcn_mfma_f32_16x16x32_bf16(pf.xs[2 + s], hd.a[s * 2 + n], aa[n], 0, 0, 0); }
    if (has_next) prefetch(P, nb, nh_, nc, tid, pf);
    float rr[2][4], kq[2][4], vv[2][4], av[2][4], lw[2][4], kp[2][4], pre[2][4], preq[2];
    float ss[4] = {0.f, 0.f, 0.f, 0.f}, bs[4] = {0.f, 0.f, 0.f, 0.f};
#pragma unroll
    for (int n = 0; n < 2; ++n) {
        const int ch = 32 * nh + 16 * n + r, chg = h * 64 + ch;
        const float w0v = hd.w0[n], a0v = hd.a0[n], kkc = hd.kk[n], kac = hd.ka[n], rkc = hd.rk[n];
#pragma unroll
        for (int ii = 0; ii < 4; ++ii) {
            const int pos = 16 * m + 4 * q + ii;
            const float rv = bf2f(S8[pos * LD + ch]), kraw = bf2f(S9[pos * LD + ch]); vv[n][ii] = bf2f(S10[pos * LD + ch]); rr[n][ii] = rv;
            const float z = -(w0v + aw[n][ii]);
            const float sp = fmaxf(z, 0.f) + flog(1.0f + fexp(-fabsf(z)));
            lw[n][ii] = -fexp(-sp - 0.5f);
            const float a_ = sigmoidf_(a0v + aa[n][ii]); av[n][ii] = a_;
            const float kk = kraw * kkc; kq[n][ii] = kk;
            const float kpv = kraw * (1.0f + (a_ - 1.0f) * kac); kp[n][ii] = kpv;
            ss[ii] += kk * kk; bs[ii] += rv * kpv * rkc;
        }
        pre[n][0] = lw[n][0]; pre[n][1] = pre[n][0] + lw[n][1]; pre[n][2] = pre[n][1] + lw[n][2]; pre[n][3] = pre[n][2] + lw[n][3];
        const float tot = pre[n][3];
        const float t0_ = __shfl(tot, r), t1_ = __shfl(tot, r + 16), t2_ = __shfl(tot, r + 32), t3_ = __shfl(tot, r + 48);
        preq[n] = (q > 0 ? t0_ : 0.f) + (q > 1 ? t1_ : 0.f) + (q > 2 ? t2_ : 0.f);
        if (q == 0) CT[m * 64 + ch] = (t0_ + t1_) + (t2_ + t3_);
    }
#pragma unroll
    for (int ii = 0; ii < 4; ++ii) {
#pragma unroll
        for (int o = 1; o < 16; o <<= 1) { ss[ii] += __shfl_xor(ss[ii], o); bs[ii] += __shfl_xor(bs[ii], o); }
        if (r == 0) { const int pos = 16 * m + 4 * q + ii; PART[(nh * 64 + pos) * 2] = ss[ii]; PART[(nh * 64 + pos) * 2 + 1] = bs[ii]; }
    }
    RK_BAR();
#pragma unroll
    for (int n = 0; n < 2; ++n) {
        const int ch = 32 * nh + 16 * n + r;
        float carry = 0.f, lend = 0.f;
#pragma unroll
        for (int mm = 0; mm < 4; ++mm) { const float cv = CT[mm * 64 + ch]; lend += cv; carry += (mm < m) ? cv : 0.f; }
        f32x4 tA, tBh, tKh, tV;
#pragma unroll
        for (int ii = 0; ii < 4; ++ii) {
            const int pos = 16 * m + 4 * q + ii;
            const float L = carry + preq[n] + pre[n][ii], Lm1 = L - lw[n][ii];
            const float ssum = PART[pos * 2] + PART[(64 + pos) * 2];
            const float inv = frcp(fmaxf(__builtin_sqrtf(ssum), 1e-12f));
            const float kkn = kq[n][ii] * inv, kb = kkn * av[n][ii];
            const float eN = fexp(-L), eE = fexp(lend - L);
            const float At = -kkn * fexp(Lm1), Rt = rr[n][ii] * fexp(L), Bt = kb * eN, Kt = kp[n][ii] * eN;
            S0[pos * LD + ch] = f2bf(At); S1[pos * LD + ch] = f2bf(Bt); S2[pos * LD + ch] = f2bf(Kt); S3[pos * LD + ch] = f2bf(Rt);
            tA[ii] = At; tBh[ii] = kb * eE; tKh[ii] = kp[n][ii] * eE; tV[ii] = vv[n][ii];
            P.bv[(size_t)(t0 + pos) * RW + h * 64 + ch] = f2bf((PART[pos * 2 + 1] + PART[(64 + pos) * 2 + 1]) * vv[n][ii]);
        }
        { u32x2 w; const int off = ch * LD + 16 * m + 4 * q;
          w.x = pk2(tA[0], tA[1]); w.y = pk2(tA[2], tA[3]); *(LAS u32x2*)(S4 + off) = w;
          w.x = pk2(tBh[0], tBh[1]); w.y = pk2(tBh[2], tBh[3]); *(LAS u32x2*)(S5 + off) = w;
          w.x = pk2(tKh[0], tKh[1]); w.y = pk2(tKh[2], tKh[3]); *(LAS u32x2*)(S6 + off) = w;
          w.x = pk2(tV[0], tV[1]); w.y = pk2(tV[2], tV[3]); *(LAS u32x2*)(S7 + off) = w; }
        if (m == 0 && q == 0) DEND[ch] = fexp(lend);
    }
    RK_BAR();
    if (has_next) load_head(P, nh_, tid, hd);
    RK_DBG(0, S0); RK_DBG(1, S1); RK_DBG(2, S2); RK_DBG(3, S3); RK_DBG(4, S4); RK_DBG(5, S5); RK_DBG(6, S6); RK_DBG(7, S7);
    const int nt0 = 2 * nh;
    f32x4 acc[2], acc2[2];
#define RK_ZERO(a) do { a[0] = (f32x4){0.f, 0.f, 0.f, 0.f}; a[1] = a[0]; } while (0)
#define RK_LDT(src, mt, ntt, a) do { const u32x2 w_ = *(const LAS u32x2*)((src) + (16 * (ntt) + r) * LD + 16 * (mt) + 4 * q); a = (f32x4){bflo(w_.x), bfhi(w_.x), bflo(w_.y), bfhi(w_.y)}; } while (0)
#define RK_MASK(a, ntt, COND) do { _Pragma("unroll") for (int ii = 0; ii < 4; ++ii) { const int row = 16 * m + 4 * q + ii, col = 16 * (ntt) + r; a[ii] = (COND) ? a[ii] : 0.f; } } while (0)
    RK_ZERO(acc); mm_nt<2>(S0, LD, S1, LD, m, nt0, r, q, acc);
#pragma unroll
    for (int n = 0; n < 2; ++n) { RK_MASK(acc[n], nt0 + n, col < row); st_tr(S9, m, nt0 + n, r, q, acc[n]); }
    RK_ZERO(acc); mm_nt<2>(S1, LD, S0, LD, m, nt0, r, q, acc);
#pragma unroll
    for (int n = 0; n < 2; ++n) { RK_MASK(acc[n], nt0 + n, row < col); st_tr(S8, m, nt0 + n, r, q, acc[n]);
#pragma unroll
        for (int ii = 0; ii < 4; ++ii) acc[n][ii] += ((16 * m + 4 * q + ii) == (16 * (nt0 + n) + r)) ? 1.f : 0.f;
        st_tr(S10, m, nt0 + n, r, q, acc[n]); }
    RK_ZERO(acc); mm_nt<2>(S2, LD, S0, LD, m, nt0, r, q, acc);
#pragma unroll
    for (int n = 0; n < 2; ++n) { RK_MASK(acc[n], nt0 + n, row < col); st_tr(S11, m, nt0 + n, r, q, acc[n]); }
    RK_ZERO(acc); mm_nt<2>(S1, LD, S3, LD, m, nt0, r, q, acc);
#pragma unroll
    for (int n = 0; n < 2; ++n) { RK_MASK(acc[n], nt0 + n, row <= col); st_tr(S12, m, nt0 + n, r, q, acc[n]); }
    RK_ZERO(acc); mm_nt<2>(S2, LD, S3, LD, m, nt0, r, q, acc);
#pragma unroll
    for (int n = 0; n < 2; ++n) { RK_MASK(acc[n], nt0 + n, row <= col); st_tr(S13, m, nt0 + n, r, q, acc[n]); }
    RK_BAR();
    RK_ZERO(acc); mm_nt<2>(S8, LD, S9, LD, m, nt0, r, q, acc);
    RK_ZERO(acc2); mm_nt<2>(S9, LD, S8, LD, m, nt0, r, q, acc2);
#pragma unroll
    for (int n = 0; n < 2; ++n) { st_tr(S1, m, nt0 + n, r, q, acc[n]); st_tr(S0, m, nt0 + n, r, q, acc2[n]); }
    RK_ZERO(acc); mm_nt<2>(S11, LD, S7, LD, m, nt0, r, q, acc);
#pragma unroll
    for (int n = 0; n < 2; ++n) st_tr(S14, m, nt0 + n, r, q, acc[n]);
    RK_BAR();
#define RK_ROUND(Tsrc, Tdst, Psrc, PTsrc, Pdst, PTdst) do { \
        RK_LDT(Tsrc, m, nt0, acc[0]); RK_LDT(Tsrc, m, nt0 + 1, acc[1]); mm_nt<2>(PTsrc, LD, Tsrc, LD, m, nt0, r, q, acc); \
        _Pragma("unroll") for (int n = 0; n < 2; ++n) st_tr(Tdst, m, nt0 + n, r, q, acc[n]); \
        RK_ZERO(acc); mm_nt<2>(Psrc, LD, PTsrc, LD, m, nt0, r, q, acc); RK_ZERO(acc2); mm_nt<2>(PTsrc, LD, Psrc, LD, m, nt0, r, q, acc2); \
        _Pragma("unroll") for (int n = 0; n < 2; ++n) { st_tr(PTdst, m, nt0 + n, r, q, acc[n]); st_tr(Pdst, m, nt0 + n, r, q, acc2[n]); } \
        RK_BAR(); } while (0)
#ifndef EXP_SKIP_ROUNDS
    RK_ROUND(S10, S2, S0, S1, S8, S9);
    RK_ROUND(S2, S10, S8, S9, S0, S1);
    RK_ROUND(S10, S2, S0, S1, S8, S9);
    RK_ROUND(S2, S10, S8, S9, S0, S1);
#endif
    RK_LDT(S10, m, nt0, acc[0]); RK_LDT(S10, m, nt0 + 1, acc[1]); mm_nt<2>(S1, LD, S10, LD, m, nt0, r, q, acc);
#pragma unroll
    for (int n = 0; n < 2; ++n) st_tr(S2, m, nt0 + n, r, q, acc[n]);
    RK_BAR();
    RK_ZERO(acc); mm_nt<2>(S2, LD, S4, LD, m, nt0, r, q, acc);
    RK_ZERO(acc2); mm_nt<2>(S2, LD, S14, LD, m, nt0, r, q, acc2);
#pragma unroll
    for (int n = 0; n < 2; ++n) { st_tr(S11, m, nt0 + n, r, q, acc[n]); st_tr(S0, m, nt0 + n, r, q, acc2[n]); }
    RK_BAR();
    {
        const int sw = wave & 1, ntw = wave >> 1;
        unsigned char* mn_ = P.mn + (size_t)uidx * 16384; unsigned char* qy_ = P.qy + (size_t)uidx * 16384;
        f32x4 c2[2];
#define RK_MM2(X, Y) do { _Pragma("unroll") for (int s_ = 0; s_ < 2; ++s_) { const bf16x8 b_ = *(const LAS bf16x8*)((Y) + (16 * ntw + r) * LD + 32 * s_ + 8 * q); \
            _Pragma("unroll") for (int mi = 0; mi < 2; ++mi) { const bf16x8 a_ = *(const LAS bf16x8*)((X) + (16 * (2 * sw + mi) + r) * LD + 32 * s_ + 8 * q); c2[mi] = __builtin_amdgcn_mfma_f32_16x16x32_bf16(a_, b_, c2[mi], 0, 0, 0); } } } while (0)
        RK_ZERO(c2); RK_MM2(S11, S5);
#pragma unroll
        for (int mi = 0; mi < 2; ++mi)
#pragma unroll
            for (int ii = 0; ii < 4; ++ii) { const int row = 16 * (2 * sw + mi) + 4 * q + ii, col = 16 * ntw + r; c2[mi][ii] += (row == col) ? DEND[row] : 0.f; }
        { u32x4 w; w.x = pk2(c2[0][0], c2[0][1]); w.y = pk2(c2[0][2], c2[0][3]); w.z = pk2(c2[1][0], c2[1][1]); w.w = pk2(c2[1][2], c2[1][3]); *(u32x4*)(mn_ + ((ntw * 2 + sw) * 64 + lane) * 16) = w; }
#pragma unroll
        for (int mi = 0; mi < 2; ++mi) { const u32x2 rw_ = *(const LAS u32x2*)(S3 + (16 * ntw + r) * LD + 16 * (2 * sw + mi) + 4 * q); c2[mi] = (f32x4){bflo(rw_.x), bfhi(rw_.x), bflo(rw_.y), bfhi(rw_.y)}; }
        RK_MM2(S11, S12);
        { u32x4 w; w.x = pk2(c2[0][0], c2[0][1]); w.y = pk2(c2[0][2], c2[0][3]); w.z = pk2(c2[1][0], c2[1][1]); w.w = pk2(c2[1][2], c2[1][3]); *(u32x4*)(qy_ + ((ntw * 2 + sw) * 64 + lane) * 16) = w; }
        RK_ZERO(c2); RK_MM2(S5, S0); RK_MM2(S6, S7);
#pragma unroll
        for (int mi = 0; mi < 2; ++mi) { u32x2 w; w.x = pk2(c2[mi][0], c2[mi][1]); w.y = pk2(c2[mi][2], c2[mi][3]); *(u32x2*)(mn_ + 8192 + ((ntw * 4 + 2 * sw + mi) * 64 + lane) * 8) = w; }
        RK_ZERO(c2); RK_MM2(S0, S12); RK_MM2(S7, S13);
#pragma unroll
        for (int mi = 0; mi < 2; ++mi) { u32x2 w; w.x = pk2(c2[mi][0], c2[mi][1]); w.y = pk2(c2[mi][2], c2[mi][3]); *(u32x2*)(qy_ + 8192 + (((2 * sw + mi) * 4 + ntw) * 64 + lane) * 8) = w; }
#undef RK_MM2
    }
    RK_BAR();
#undef RK_ZERO
#undef RK_ROUND
#undef RK_LDT
#undef RK_MASK
#undef RK_BAR
}
__device__ __forceinline__ void scan_wg(const unsigned char* mn, unsigned char* sbuf, int ubase, int vq, LAS unsigned char* lds, int tid) {
    const int wave = __builtin_amdgcn_readfirstlane(tid >> 6), lane = tid & 63;
    constexpr int NC = SEQ / 64, NS = 8, SLOT = 10240, AHEAD = 6;
    const unsigned char* src = mn + (size_t)ubase * 16384 + lane * 16;
    const bool loader = (wave >= 1 && wave <= 5);
    const size_t poff = (wave == 5) ? (size_t)(8192 + vq * 2048) : (size_t)(2048 * (wave - 1));
#define SC_ISSUE(c) do { const unsigned char* s_ = src + (size_t)(c) * 16384 + poff; LAS unsigned char* d_ = lds + ((c) % NS) * SLOT + 2048 * (wave - 1); \
        _Pragma("unroll") for (int i_ = 0; i_ < 2; ++i_) __builtin_amdgcn_global_load_lds((const unsigned*)(s_ + i_ * 1024), (LAS unsigned*)(d_ + i_ * 1024), 16, 0, 0); } while (0)
#define SC_BAR() do { asm volatile("s_waitcnt lgkmcnt(0)" ::: "memory"); __builtin_amdgcn_s_barrier(); asm volatile("" ::: "memory"); } while (0)
    bf16x8 sB[2];
#pragma unroll
    for (int s = 0; s < 2; ++s) sB[s] = (bf16x8){0, 0, 0, 0, 0, 0, 0, 0};
    if (loader) {
#pragma unroll
        for (int c = 0; c < AHEAD; ++c) SC_ISSUE(c);
        asm volatile("s_waitcnt vmcnt(10)" ::: "memory"); }
    SC_BAR();
    for (int c = 0; c < NC; ++c) {
        if (loader) {
            if (c + AHEAD < NC) { SC_ISSUE(c + AHEAD); asm volatile("s_waitcnt vmcnt(10)" ::: "memory"); }
            else { asm volatile("s_waitcnt vmcnt(0)" ::: "memory"); }
        } else if (wave == 0) {
            const LAS unsigned char* sl = lds + (c % NS) * SLOT;
            unsigned char* so = sbuf + (size_t)(ubase + c) * 8192 + (vq * 2) * 1024 + lane * 16;
            *(bf16x8*)so = sB[0]; *(bf16x8*)(so + 1024) = sB[1];
            f32x4 aS[4];
#pragma unroll
            for (int mm = 0; mm < 4; ++mm) {
                const u32x2 nI = *(const LAS u32x2*)(sl + 8192 + (mm * 64 + lane) * 8);
                aS[mm] = (f32x4){bflo(nI.x), bfhi(nI.x), bflo(nI.y), bfhi(nI.y)};
#pragma unroll
                for (int s = 0; s < 2; ++s) { const bf16x8 aM = *(const LAS bf16x8*)(sl + ((mm * 2 + s) * 64 + lane) * 16); aS[mm] = __builtin_amdgcn_mfma_f32_16x16x32_bf16(aM, sB[s], aS[mm], 0, 0, 0); }
            }
#pragma unroll
            for (int s = 0; s < 2; ++s) { u32x4 w; w.x = pk2(aS[2 * s][0], aS[2 * s][1]); w.y = pk2(aS[2 * s][2], aS[2 * s][3]); w.z = pk2(aS[2 * s + 1][0], aS[2 * s + 1][1]); w.w = pk2(aS[2 * s + 1][2], aS[2 * s + 1][3]);
                sB[s] = __builtin_bit_cast(bf16x8, w); }
        }
        SC_BAR();
    }
#undef SC_ISSUE
#undef SC_BAR
}
struct YArgs { const unsigned char* qy; const unsigned char* sbuf; const bf16_t* g; const bf16_t* bv; const float* ln_g; const float* ln_b; unsigned char* ya; };
__device__ __forceinline__ void ypass_unit(const YArgs& P, int u, int lane) {
    const int r = lane & 15, q = lane >> 4, b = u >> 10, h = (u >> 7) & 7, c = u & 127, t0 = b * SEQ + c * 64;
    const unsigned char* qy_ = P.qy + (size_t)u * 16384; const unsigned char* s_ = P.sbuf + (size_t)u * 8192;
    bf16x8 Qf[4][2], Sf[4][2]; u32x2 y0[4][4];
#pragma unroll
    for (int i = 0; i < 4; ++i)
#pragma unroll
        for (int s = 0; s < 2; ++s) { Qf[i][s] = *(const bf16x8*)(qy_ + ((i * 2 + s) * 64 + lane) * 16); Sf[i][s] = *(const bf16x8*)(s_ + ((i * 2 + s) * 64 + lane) * 16); }
#pragma unroll
    for (int vq = 0; vq < 4; ++vq)
#pragma unroll
        for (int mm = 0; mm < 4; ++mm) y0[vq][mm] = *(const u32x2*)(qy_ + 8192 + ((vq * 4 + mm) * 64 + lane) * 8);
    f32x4 lg[4], lb[4];
#pragma unroll
    for (int vq = 0; vq < 4; ++vq) { lg[vq] = *(const f32x4*)(P.ln_g + h * 64 + 16 * vq + 4 * q); lb[vq] = *(const f32x4*)(P.ln_b + h * 64 + 16 * vq + 4 * q); }
#pragma unroll
    for (int mm = 0; mm < 4; ++mm) {
        const size_t ro = (size_t)(t0 + 16 * mm + r) * RW + h * 64 + 4 * q;
        u32x2 gw_[4], bw_[4];
#pragma unroll
        for (int vq = 0; vq < 4; ++vq) { gw_[vq] = *(const u32x2*)(P.g + ro + 16 * vq); bw_[vq] = *(const u32x2*)(P.bv + ro + 16 * vq); }
        f32x4 acc[4]; float sum = 0.f;
#pragma unroll
        for (int vq = 0; vq < 4; ++vq) {
            acc[vq] = (f32x4){bflo(y0[vq][mm].x), bfhi(y0[vq][mm].x), bflo(y0[vq][mm].y), bfhi(y0[vq][mm].y)};
#pragma unroll
            for (int s = 0; s < 2; ++s) acc[vq] = __builtin_amdgcn_mfma_f32_16x16x32_bf16(Sf[vq][s], Qf[mm][s], acc[vq], 0, 0, 0);
            sum += (acc[vq][0] + acc[vq][1]) + (acc[vq][2] + acc[vq][3]);
        }
        sum += __shfl_xor(sum, 16); sum += __shfl_xor(sum, 32);
        const float mean = sum * (1.f / 64.f); float var = 0.f;
#pragma unroll
        for (int vq = 0; vq < 4; ++vq) { acc[vq] = acc[vq] - mean; var += (acc[vq][0] * acc[vq][0] + acc[vq][1] * acc[vq][1]) + (acc[vq][2] * acc[vq][2] + acc[vq][3] * acc[vq][3]); }
        var += __shfl_xor(var, 16); var += __shfl_xor(var, 32);
        const float rstd = __builtin_amdgcn_rsqf(var * (1.f / 64.f) + 64e-5f);
#pragma unroll
        for (int vq = 0; vq < 4; ++vq) {
            const f32x4 gg = (f32x4){bflo(gw_[vq].x), bfhi(gw_[vq].x), bflo(gw_[vq].y), bfhi(gw_[vq].y)}, bb = (f32x4){bflo(bw_[vq].x), bfhi(bw_[vq].x), bflo(bw_[vq].y), bfhi(bw_[vq].y)};
            const f32x4 o = (acc[vq] * rstd * lg[vq] + lb[vq] + bb) * gg;
            int t8 = __builtin_amdgcn_cvt_pk_fp8_f32(o[0], o[1], 0, false); t8 = __builtin_amdgcn_cvt_pk_fp8_f32(o[2], o[3], t8, true); *(unsigned*)(P.ya + ro + 16 * vq) = (unsigned)t8; }
    }
}
}
namespace gl {
constexpr int LDV = 136;
struct Args { const bf16_t* puv; const bf16_t* wsm; const float* bs; const float* ln_g; const float* ln_b; unsigned char* yb; };
__device__ __forceinline__ void unit(const Args& P, LAS unsigned char* lds, int b, int blk, int tid) {
    const int wave = __builtin_amdgcn_readfirstlane(tid >> 6), lane = tid & 63, r = lane & 15, q = lane >> 4;
    const int t0 = b * SEQ + blk * 128;
    LAS float* STAT = (LAS float*)(lds + LDS_MISC);
#pragma unroll
    for (int hb = 0; hb < 2; ++hb) {
        u32x4 w[8];
#pragma unroll
        for (int j = 0; j < 8; ++j) w[j] = *(const u32x4*)(P.puv + (size_t)(t0 + 16 * wave + 8 * hb + j) * 1024 + 512 + 8 * lane);
#pragma unroll
        for (int j = 0; j < 8; ++j) {
            float v[8]; v[0] = bflo(w[j].x); v[1] = bfhi(w[j].x); v[2] = bflo(w[j].y); v[3] = bfhi(w[j].y); v[4] = bflo(w[j].z); v[5] = bfhi(w[j].z); v[6] = bflo(w[j].w); v[7] = bfhi(w[j].w);
            float s = 0.f, s2 = 0.f;
#pragma unroll
            for (int e = 0; e < 8; ++e) { s += v[e]; s2 += v[e] * v[e]; }
            s = wave_sum(s); s2 = wave_sum(s2);
            const float mean = s * (1.f / 512.f), var = fmaxf(s2 * (1.f / 512.f) - mean * mean, 0.f);
            if (lane == 0) { const int tk = 16 * wave + 8 * hb + j; STAT[tk * 2] = mean; STAT[tk * 2 + 1] = __builtin_amdgcn_rsqf(var + 1e-5f); }
        }
    }
    u32x4 pv[2], pu[2];
#define GL_LOAD(g) do { _Pragma("unroll") for (int it = 0; it < 2; ++it) { const int task = tid + it * NTHREADS, j = task >> 3, cc = task & 7; \
        const bf16_t* row = P.puv + (size_t)(t0 + j) * 1024 + (g) * 64 + 8 * cc; pu[it] = *(const u32x4*)row; pv[it] = *(const u32x4*)(row + 512); } } while (0)
    GL_LOAD(0);
    __syncthreads();
    for (int g = 0; g < 8; ++g) {
        LAS bf16_t* VT = (LAS bf16_t*)(lds + (g & 1) * 20480);
        LAS bf16_t* US = (LAS bf16_t*)(lds + 40960 + (g & 1) * 18432);
#pragma unroll
        for (int it = 0; it < 2; ++it) {
            const int task = tid + it * NTHREADS, j = task >> 3, cc = task & 7, ch = g * 64 + 8 * cc;
            const u32x4 w = pv[it];
            const float mean = STAT[j * 2], rstd = STAT[j * 2 + 1];
            const f32x4 g0 = *(const f32x4*)(P.ln_g + ch), g1 = *(const f32x4*)(P.ln_g + ch + 4), b0 = *(const f32x4*)(P.ln_b + ch), b1 = *(const f32x4*)(P.ln_b + ch + 4);
            float v[8]; v[0] = bflo(w.x); v[1] = bfhi(w.x); v[2] = bflo(w.y); v[3] = bfhi(w.y); v[4] = bflo(w.z); v[5] = bfhi(w.z); v[6] = bflo(w.w); v[7] = bfhi(w.w);
#pragma unroll
            for (int e = 0; e < 4; ++e) { v[e] = (v[e] - mean) * rstd * g0[e] + b0[e]; v[4 + e] = (v[4 + e] - mean) * rstd * g1[e] + b1[e]; }
#pragma unroll
            for (int e = 0; e < 8; ++e) VT[(8 * cc + e) * LDV + j] = f2bf(v[e]);
            *(LAS u32x4*)(US + j * 72 + 8 * cc) = pu[it];
        }
        if (g + 1 < 8) GL_LOAD(g + 1);
        __syncthreads();
        f32x4 acc[4];
#pragma unroll
        for (int n = 0; n < 4; ++n) acc[n] = (f32x4){0.f, 0.f, 0.f, 0.f};
        const bf16_t* wrow = P.wsm + ((size_t)g * 128 + 16 * wave + r) * 128 + 8 * q;
        const int ks = (wave >> 1) + 1;
        for (int s = 0; s < ks; ++s) {
            const bf16x8 a = *(const bf16x8*)(wrow + 32 * s);
#pragma unroll
            for (int n = 0; n < 4; ++n) { const bf16x8 bb = *(const LAS bf16x8*)(VT + (16 * n + r) * LDV + 32 * s + 8 * q); acc[n] = __builtin_amdgcn_mfma_f32_16x16x32_bf16(a, bb, acc[n], 0, 0, 0); }
        }
#pragma unroll
        for (int ii = 0; ii < 4; ++ii) { const int i = 16 * wave + 4 * q + ii; const float bias = P.bs[g * 128 + i];
#pragma unroll
            for (int n = 0; n < 4; ++n) { const int c = 16 * n + r; const float u = bf2f(US[i * 72 + c]);
                P.yb[(size_t)(t0 + i) * RW + g * 64 + c] = (unsigned char)(__builtin_amdgcn_cvt_pk_fp8_f32(u * (acc[n][ii] + bias), 0.f, 0, false) & 0xff); } }
    }
    __syncthreads();
#undef GL_LOAD
}
}

struct RouteArgs { const float* sc; const float* bias; int* eidx; float* ewt; int* lrank; int* tbase; unsigned* segcnt; };
__device__ __forceinline__ void topk_tile(const RouteArgs& P, LAS unsigned char* lds, int tid, int tile) {
    const int wave = __builtin_amdgcn_readfirstlane(tid >> 6), lane = tid & 63, grp = lane >> 3;
    LAS int* hist = (LAS int*)(lds + LDS_MISC);
    const f32x4 bias4 = *(const f32x4*)(P.bias + 4 * lane);
    const float NEG = -__builtin_inff();
    {
        if (tid < NE) hist[tid] = 0;
        __syncthreads();
        f32x4 nx[2];
#pragma unroll
        for (int u = 0; u < 2; ++u) nx[u] = *(const f32x4*)(P.sc + (size_t)(tile * 256 + wave * 32 + u) * NE + 4 * lane);
        for (int j = 0; j < 32; j += 2) {
            const int t0 = tile * 256 + wave * 32 + j;
            float s[2][4], v[2][4], gs[2];
            const f32x4 cur4[2] = {nx[0], nx[1]};
            if (j + 2 < 32) {
#pragma unroll
                for (int u = 0; u < 2; ++u) nx[u] = *(const f32x4*)(P.sc + (size_t)(t0 + 2 + u) * NE + 4 * lane); }
#pragma unroll
            for (int u = 0; u < 2; ++u) { const f32x4 s4 = cur4[u]; s[u][0] = s4.x; s[u][1] = s4.y; s[u][2] = s4.z; s[u][3] = s4.w;
#pragma unroll
                for (int e = 0; e < 4; ++e) v[u][e] = s[u][e] + bias4[e]; }
            float m1[2], m2[2];
#pragma unroll
            for (int u = 0; u < 2; ++u) { const float a = fmaxf(v[u][0], v[u][1]), b = fminf(v[u][0], v[u][1]), c = fmaxf(v[u][2], v[u][3]), d = fminf(v[u][2], v[u][3]); m1[u] = fmaxf(a, c); m2[u] = fmaxf(fminf(a, c), fmaxf(b, d)); }
#pragma unroll
            for (int o = 1; o < 8; o <<= 1) {
#pragma unroll
                for (int u = 0; u < 2; ++u) { const float o1 = __shfl_xor(m1[u], o), o2 = __shfl_xor(m2[u], o); const float n1 = fmaxf(m1[u], o1), n2 = fmaxf(fminf(m1[u], o1), fmaxf(m2[u], o2)); m1[u] = n1; m2[u] = n2; } }
#pragma unroll
            for (int u = 0; u < 2; ++u) gs[u] = m1[u] + m2[u];
            int cnt[2] = {0, 0};
#pragma unroll
            for (int g = 0; g < 8; ++g) {
#pragma unroll
                for (int u = 0; u < 2; ++u) { const float og = __shfl(gs[u], 8 * g); cnt[u] += (og > gs[u] || (og == gs[u] && g < grp)) ? 1 : 0; } }
#pragma unroll
            for (int u = 0; u < 2; ++u) {
#pragma unroll
                for (int e = 0; e < 4; ++e) v[u][e] = (cnt[u] < 4) ? v[u][e] : NEG; }
            int myidx[2] = {0, 0}; float mysc[2] = {0.f, 0.f}, ssum[2] = {0.f, 0.f};
#pragma unroll
            for (int k = 0; k < TOPK; ++k) {
                float bv[2]; int idx[2];
#pragma unroll
                for (int u = 0; u < 2; ++u) { bv[u] = v[u][0]; int bi = 0;
#pragma unroll
                    for (int e = 1; e < 4; ++e) { const bool gt = v[u][e] > bv[u]; bv[u] = gt ? v[u][e] : bv[u]; bi = gt ? e : bi; }
                    idx[u] = 4 * lane + bi; }
#pragma unroll
                for (int o = 1; o < 64; o <<= 1) {
#pragma unroll
                    for (int u = 0; u < 2; ++u) { const float ov = __shfl_xor(bv[u], o); const int oi = __shfl_xor(idx[u], o); const bool tk = (ov > bv[u]) || (ov == bv[u] && oi < idx[u]); bv[u] = tk ? ov : bv[u]; idx[u] = tk ? oi : idx[u]; } }
#pragma unroll
                for (int u = 0; u < 2; ++u) { const int own = idx[u] >> 2, ee = idx[u] & 3;
                    const float mine = (ee == 0) ? s[u][0] : (ee == 1) ? s[u][1] : (ee == 2) ? s[u][2] : s[u][3];
                    const float scv = __shfl(mine, own);
#pragma unroll
                    for (int e = 0; e < 4; ++e) v[u][e] = (lane == own && e == ee) ? NEG : v[u][e];
                    ssum[u] += scv; myidx[u] = (lane == k) ? idx[u] : myidx[u]; mysc[u] = (lane == k) ? scv : mysc[u]; }
            }
            if (lane < TOPK) {
#pragma unroll
                for (int u = 0; u < 2; ++u) { const int t = t0 + u;
                    const int lr = __hip_atomic_fetch_add(hist + myidx[u], 1, __ATOMIC_RELAXED, __HIP_MEMORY_SCOPE_WORKGROUP);
                    P.eidx[(size_t)t * TOPK + lane] = myidx[u]; P.ewt[(size_t)t * TOPK + lane] = mysc[u] / ssum[u] * 2.5f; P.lrank[(size_t)t * TOPK + lane] = lr; }
            }
        }
        __syncthreads();
        if (tid < NE) { const int cnt = hist[tid]; unsigned base = 0u;
            if (cnt) base = __hip_atomic_fetch_add(P.segcnt + tid, (unsigned)cnt, __ATOMIC_RELAXED, __HIP_MEMORY_SCOPE_AGENT);
            P.tbase[tile * NE + tid] = (int)base; }
        __syncthreads();
    }
}
struct ScatArgs { const int* eidx; const float* ewt; const int* lrank; const int* tbase; const unsigned* segcnt; int* rowtok; int* rowdst; float* roww; int* tab; unsigned* ntile; };
__device__ __forceinline__ void phase_scatter(const ScatArgs& P, LAS unsigned char* lds, int tid, int G) {
    LAS int* cntL = (LAS int*)(lds + LDS_MISC); LAS int* segst = cntL + 256; LAS int* tsa = segst + 256;
    if (tid < NE) cntL[tid] = (int)__hip_atomic_load(P.segcnt + tid, __ATOMIC_RELAXED, __HIP_MEMORY_SCOPE_AGENT);
    __syncthreads();
    if (tid == 0) {
        int run = 0, ta = 0;
        for (int s = 0; s < NE; ++s) { const int nts = (cntL[s] + 255) >> 8; segst[s] = run; tsa[s] = ta; run += nts * 256; ta += nts; }
        if (blockIdx.x == 0) P.ntile[0] = (unsigned)ta;
    }
    __syncthreads();
    for (int tile = blockIdx.x; tile < T / 256; tile += G) {
        for (int a = tid; a < 256 * TOPK; a += NTHREADS) {
            const int tok = tile * 256 + (a >> 3), k = a & 7; const size_t ai = (size_t)tok * TOPK + k;
            const int e = P.eidx[ai];
            const int pos = segst[e] + P.tbase[tile * NE + e] + P.lrank[ai];
            P.rowtok[pos] = tok; P.rowdst[pos] = tok * TOPK + k; P.roww[pos] = P.ewt[ai];
        }
    }
    for (int s = blockIdx.x; s < NE; s += G) {
        const int st = segst[s], cnt = cntL[s], nts = (cnt + 255) >> 8;
        for (int p = st + cnt + tid; p < st + nts * 256; p += NTHREADS) { P.rowtok[p] = 0; P.rowdst[p] = -1; P.roww[p] = 0.f; }
        if (tid < nts) { int* ta_ = P.tab + 2 * (tsa[s] + tid); ta_[0] = st + 256 * tid; ta_[1] = s; }
    }
}
constexpr int NPHASE = 20;
struct KArgs { const float* in[34]; float* out; unsigned char* ws; int ph_lo, ph_hi; };
template <int PLO, int PHI>
__global__ void __launch_bounds__(NTHREADS, 2) fwd_kernel(KArgs a) {
    extern __shared__ __attribute__((aligned(16))) unsigned char lds_raw[];
    LAS unsigned char* lds = (LAS unsigned char*)lds_raw;
    const int G = gridDim.x, bid = blockIdx.x, NGW = G * NWAVES;
#define PH_IDS() int tid = threadIdx.x; asm volatile("" : "+v"(tid)); const int lane = tid & 63, wave = __builtin_amdgcn_readfirstlane(tid >> 6), gw = bid * NWAVES + wave; (void)lane; (void)wave; (void)gw
    unsigned char* ws = a.ws;
    unsigned* ctl = (unsigned*)(ws + WS_CTL);
    float* mod = (float*)(ws + WS_MOD);
    constexpr int lo = PLO, hi = PHI;
    if (threadIdx.x == 0) *(LAS u32x4*)(lds + LDS_BARW) = (u32x4){0u, 0u, 0u, 0u};
    __syncthreads();
    XcdBarrier bar; bar.bar = ctl + CW_BAR; bar.x = 0; bar.st = nullptr;
    if (hi - lo > 1) bar = xcd_barrier_post(ctl + CW_BAR, (volatile LAS unsigned*)(lds + LDS_BARW));
#define IN(k) (lo <= (k) && (k) < hi)
#ifdef DBG_TIME
#define STAMP(k) do { if (blockIdx.x == 0 && threadIdx.x == 0) ((unsigned long long*)(ctl + 5200))[k] = __builtin_amdgcn_s_memrealtime(); } while (0)
#else
#define STAMP(k) do {} while (0)
#endif
#define SEAM(k) do { if (IN(k) && IN((k) + 1)) xcd_barrier(bar); } while (0)
#ifndef DBG_REPEAT
#define DBG_REPEAT (-1)
#define DBG_NREP 0
#endif
#define REP(k) for (int rep_ = 0; rep_ < (((k) == DBG_REPEAT) ? 1 + DBG_NREP : 1); ++rep_, (((k) == DBG_REPEAT && rep_ <= DBG_NREP) ? xcd_barrier(bar) : (void)0))

    STAMP(0);
    if (IN(0)) REP(0) { PH_IDS();
        phase_mod(a.in[1], a.in[2], a.in[3], mod, lds, tid, G);
    }
    SEAM(0); STAMP(1);
    if (IN(1)) REP(1) { PH_IDS();
        SmallW sw{a.in[6], a.in[22], a.in[23], a.in[24], a.in[25], a.in[30], a.in[31], a.in[32], a.in[9], a.in[11], a.in[12], a.in[20]};
        phase_small_weights(sw, ws, lds, gw, NGW, wave, lane);
        phase_norm_mod<false>(a.in[0], a.in[4], mod, 0, 1024, nullptr, ws + B_H1, gw, NGW, lane);
    }
    SEAM(1); STAMP(2);
    if (IN(2)) REP(2) {
        gm::DenseSched S; S.init(ws + B_H1, ws + SW_WIN, T, IN_COLS, D, G, bid, 1);
        gm::EpiInProj E{(bf16_t*)(ws + B_PRW), (bf16_t*)(ws + B_PUV), (bf16_t*)(ws + B_PG)};
        gm::gemm_phase<gm::EpiInProj, gm::DenseSched, true, true, 122>(lds, D, S, E);
    }
    SEAM(2); STAMP(3);
    if (IN(3)) REP(3) { PH_IDS();
        gl::Args Q{(const bf16_t*)(ws + B_PUV), (const bf16_t*)(ws + SW_WSM), a.in[21], a.in[18], a.in[19], ws + B_YB};
        for (int u = bid; u < 512; u += G) gl::unit(Q, lds, u >> 6, u & 63, tid);
        phase_xs((const bf16_t*)(ws + B_PRW), a.in[7], (bf16_t*)(ws + B_XS), gw, NGW, lane);
    }
    SEAM(3); STAMP(4);
    if (IN(4)) REP(4) { PH_IDS();
        rk::Args P{(const bf16_t*)(ws + B_PRW), a.in[7], a.in[8], a.in[10], a.in[13], a.in[14], a.in[15], (const bf16_t*)(ws + SW_WUP), (const bf16_t*)(ws + SW_AUP), (const bf16_t*)(ws + SW_GUP), (const bf16_t*)(ws + B_XS),
                   (bf16_t*)(ws + B_G), (bf16_t*)(ws + B_BV), ws + B_MN, ws + B_QY};
        phase_gate((const bf16_t*)(ws + B_XS), (const bf16_t*)(ws + SW_GUP), (bf16_t*)(ws + B_G), gw, NGW, lane);
        rk::Pre pre; rk::Hd hd; rk::load_mu(P, lds, tid);
        const bool fixh = (G % 8) == 0; const int nper = fixh ? (G >> 3) : G, first = fixh ? (bid >> 3) : bid, lim = fixh ? 1024 : 8192;
#define RK_UNIT_OF(idx, B_, H_, C_) const int B_ = fixh ? ((idx) >> 7) : ((idx) >> 10), H_ = fixh ? (bid & 7) : (((idx) >> 7) & 7), C_ = (idx) & 127
        if (first < lim) { RK_UNIT_OF(first, b0_, h0_, c0_); rk::prefetch(P, b0_, h0_, c0_, tid, pre); rk::load_head(P, h0_, tid, hd); }
        for (int idx = first; idx < lim; idx += nper) { const int nx = idx + nper; RK_UNIT_OF(idx, b_, h_, c_); RK_UNIT_OF(nx < lim ? nx : idx, nb_, nh__, nc_);
            rk::unit(P, lds, b_, h_, c_, (b_ * 8 + h_) * 128 + c_, tid, pre, hd, nx < lim, nb_, nh__, nc_); }
#undef RK_UNIT_OF
    }
    SEAM(4); STAMP(5);
    if (IN(5)) REP(5) { PH_IDS();
        for (int w = bid; w < 256; w += G) rk::scan_wg(ws + B_MN, ws + B_S, ((w & 7) + 8 * (w >> 5)) * 128, (w >> 3) & 3, lds, tid);
    }
    SEAM(5); STAMP(6);
    if (IN(6)) REP(6) { PH_IDS();
        rk::YArgs Y{ws + B_QY, ws + B_S, (const bf16_t*)(ws + B_G), (const bf16_t*)(ws + B_BV), a.in[16], a.in[17], ws + B_YA};
        for (int u = gw; u < 8192; u += NGW) rk::ypass_unit(Y, u, lane);
    }
    SEAM(6); STAMP(7);
    STAMP(8);
    if (IN(8)) REP(8) {
        gm::DenseSched S; S.init(ws + B_YA, ws + SW_WOA, T, D, RW, G, bid, 1);
        gm::EpiMerge<false> E{(bf16_t*)(ws + B_M1), (const bf16_t*)(ws + B_PG), nullptr};
        gm::gemm_phase<gm::EpiMerge<false>, gm::DenseSched, true, true, 122>(lds, RW, S, E);
    }
    STAMP(9);
    if (IN(9)) {
        gm::DenseSched S; S.init(ws + B_YB, ws + SW_WOB, T, D, RW, G, bid, 1);
        gm::EpiMerge<true> E{(bf16_t*)(ws + B_M1), (const bf16_t*)(ws + B_PG), ws + B_M8};
        gm::gemm_phase<gm::EpiMerge<true>, gm::DenseSched, true, true, 122>(lds, RW, S, E);
    }
    SEAM(9); STAMP(10);
    if (IN(10)) REP(10) {
        gm::DenseSched S; S.init(ws + B_M8, ws + SW_WO, T, D, D, G, bid, 1);
        gm::EpiResid E{(bf16_t*)(ws + B_X1), a.in[0], mod + 2048};
        gm::gemm_phase<gm::EpiResid, gm::DenseSched, true, true, 122>(lds, D, S, E);
    }
    SEAM(10); STAMP(11);
    if (IN(11)) REP(11) { PH_IDS();
        phase_norm_mod<true>(ws + B_X1, a.in[5], mod, 3072, 4096, (bf16_t*)(ws + B_H2), ws + B_H2F8, gw, NGW, lane);
        phase_expert_weights(a.in[27], a.in[28], a.in[29], ws, lds, gw, NGW, wave, lane);
    }
    SEAM(11); STAMP(12);
    if (IN(12)) { PH_IDS();
        RouteArgs R{(const float*)(ws + B_SC), a.in[26], (int*)(ws + RT_EIDX), (float*)(ws + RT_EWT), (int*)(ws + RT_LRANK), (int*)(ws + RT_TBASE), ctl + CW_SEGCNT};
        { gm::DenseSched S; S.init(ws + B_H2, ws + SW_WR, T, NE, D, G, bid); gm::EpiRouter E{(float*)(ws + B_SC)}; gm::gemm_phase<gm::EpiRouter, gm::DenseSched, true>(lds, D, S, E);
          gm::Unit u; for (int i = 0; S.next(i, u); ++i) topk_tile(R, lds, tid, u.pm); }
        { gm::DenseSched S; S.init(ws + B_H2F8, ws + SW_WS13, T, 512, D, G, bid, 1); gm::EpiGateUp<true> E{ws + B_SH}; gm::gemm_phase<gm::EpiGateUp<true>, gm::DenseSched, true, true, 122>(lds, D, S, E); }
    }
    SEAM(12); STAMP(13);
    if (IN(13)) { PH_IDS();
        ScatArgs P{(const int*)(ws + RT_EIDX), (const float*)(ws + RT_EWT), (const int*)(ws + RT_LRANK), (const int*)(ws + RT_TBASE), ctl + CW_SEGCNT,
                   (int*)(ws + RT_ROWTOK), (int*)(ws + RT_ROWDST), (float*)(ws + RT_ROWW), (int*)(ws + RT_TAB), ctl + CW_NT};
        phase_scatter(P, lds, tid, G);
        __syncthreads();
        gm::DenseSched S; S.init(ws + B_SH, ws + SW_WS2, T, D, EFF, G, bid, 1);
        gm::EpiSharedDown E{ws + B_SHO};
        gm::gemm_phase<gm::EpiSharedDown, gm::DenseSched, true, true, 122>(lds, EFF, S, E);
    }
    SEAM(13); STAMP(14); STAMP(15);
    if (IN(15)) REP(15) {
        gm::GroupSched<true> S; S.A = (const char*)(ws + B_H2F8); S.B = (const char*)(ws + B_W13); S.tab = (const int*)(ws + RT_TAB); S.rowtok = (const int*)(ws + RT_ROWTOK);
        S.ntiles = (int)__hip_atomic_load(ctl + CW_NT, __ATOMIC_RELAXED, __HIP_MEMORY_SCOPE_AGENT); S.npn = 2; S.G = G; S.c = bid; S.K = D; S.ebytes = (size_t)512 * D; S.tstep = (size_t)256 * D;
        gm::EpiGateUp<true> E{ws + B_HID};
        gm::gemm_phase<gm::EpiGateUp<true>, gm::GroupSched<true>, true, true, 122>(lds, D, S, E);
    }
    SEAM(15); STAMP(16);
    if (IN(16)) REP(16) {
        gm::GroupSched<false> S; S.A = (const char*)(ws + B_HID); S.B = (const char*)(ws + B_W2); S.tab = (const int*)(ws + RT_TAB); S.rowtok = nullptr;
        S.ntiles = (int)__hip_atomic_load(ctl + CW_NT, __ATOMIC_RELAXED, __HIP_MEMORY_SCOPE_AGENT); S.npn = 4; S.G = G; S.c = bid; S.K = EFF; S.ebytes = (size_t)D * EFF; S.tstep = (size_t)256 * EFF;
        gm::EpiExpertDown E{ws + B_SLOT, (const int*)(ws + RT_ROWDST), (const float*)(ws + RT_ROWW)};
        gm::gemm_phase<gm::EpiExpertDown, gm::GroupSched<false>, true, true, 122>(lds, EFF, S, E);
    }
    SEAM(16); STAMP(17);
    if (IN(17)) { PH_IDS(); phase_combine(a.out, (const bf16_t*)(ws + B_X1), ws + B_SLOT, ws + B_SHO, mod, a.in[33], gw, NGW, lane); }
    STAMP(18); STAMP(19);
    __syncthreads(); STAMP(20);
#undef IN
#undef SEAM
}

#if defined(DBG_CHECK) || defined(DBG_TIME)
#ifdef DBG_TIME
#ifndef TSC
#define TSC 0.25f
#endif
__global__ void dbg_time_out(float* out, const unsigned long long* st) {
    if (threadIdx.x == 0 && blockIdx.x == 0) { out[0] = (float)(st[TA1] - st[TA0]) * 0.01f * TSC; out[1] = (float)(st[TB1] - st[TB0]) * 0.01f * TSC; }
}
static void dbg_run(void* d_out, void* d_ws, hipStream_t stream) {
    dbg_time_out<<<1, 64, 0, stream>>>((float*)d_out, (const unsigned long long*)((unsigned*)((unsigned char*)d_ws + WS_CTL) + 5200));
}
#endif
#endif
#ifndef MK_SINGLE
#define MK_SINGLE 0
#endif
template <int PLO, int PHI> static bool prep_kernel() {
    int per_cu = 0;
    if (hipFuncSetAttribute((const void*)fwd_kernel<PLO, PHI>, hipFuncAttributeMaxDynamicSharedMemorySize, LDS_BYTES) != hipSuccess) { fprintf(stderr, "kernel_launch: hipFuncSetAttribute failed\n"); return false; }
    if (hipOccupancyMaxActiveBlocksPerMultiprocessor(&per_cu, (const void*)fwd_kernel<PLO, PHI>, NTHREADS, LDS_BYTES) != hipSuccess || per_cu < 1) { fprintf(stderr, "kernel_launch: occupancy query says %d\n", per_cu); (void)hipGetLastError(); return false; }
    return true;
}
template <int P> struct PhaseLaunch {
    static bool prep() { return prep_kernel<P, P + 1>() && PhaseLaunch<P + 1>::prep(); }
    static void go(int grid, hipStream_t stream, const KArgs& a) { hipLaunchKernelGGL((fwd_kernel<P, P + 1>), dim3(grid), dim3(NTHREADS), LDS_BYTES, stream, a); PhaseLaunch<P + 1>::go(grid, stream, a); }
};
#ifndef DBG_LAST
#define DBG_LAST NPHASE
#endif
template <> struct PhaseLaunch<DBG_LAST> { static bool prep() { return true; } static void go(int, hipStream_t, const KArgs&) {} };
extern "C" void kernel_launch(void* const* d_in, const int* in_sizes, int n_in, void* d_out, int out_size, void* d_ws, size_t ws_size, hipStream_t stream) {
    static int grid = 0;
    if (grid == 0) {
        if (n_in != 34 || out_size != T * D || ws_size < WS_END) { fprintf(stderr, "kernel_launch: unexpected problem shape (n_in %d, out %d, ws %zu < %zu)\n", n_in, out_size, ws_size, (size_t)WS_END); grid = -1; return; }
        int dev = 0, cus = 0;
        if (hipGetDevice(&dev) != hipSuccess || hipDeviceGetAttribute(&cus, hipDeviceAttributeMultiprocessorCount, dev) != hipSuccess) { grid = -1; return; }
#if MK_SINGLE
        if (!prep_kernel<0, NPHASE>()) { grid = -1; return; }
#else
        if (!PhaseLaunch<0>::prep()) { grid = -1; return; }
#endif
        grid = cus;
    }
    if (grid < 0) return;
    (void)hipMemsetAsync((char*)d_ws + WS_CTL, 0, CTL_ZERO_BYTES, stream);
    KArgs a{};
    for (int i = 0; i < 34; ++i) a.in[i] = (const float*)d_in[i];
    a.out = (float*)d_out; a.ws = (unsigned char*)d_ws; a.ph_lo = 0; a.ph_hi = NPHASE;
#if MK_SINGLE
    hipLaunchKernelGGL((fwd_kernel<0, NPHASE>), dim3(grid), dim3(NTHREADS), LDS_BYTES, stream, a);
#else
    PhaseLaunch<0>::go(grid, stream, a);
#endif
#if defined(DBG_CHECK) || defined(DBG_TIME)
    dbg_run(d_out, d_ws, stream);
#endif
}
```

```cpp
#define MK_SINGLE 1
#include <hip/hip_runtime.h>
#include <cstdio>
#include <cstdint>

#define LAS __attribute__((address_space(3)))
#define GAS __attribute__((address_space(1)))
typedef unsigned short bf16_t;
typedef short bf16x8 __attribute__((ext_vector_type(8)));
typedef float f32x4 __attribute__((ext_vector_type(4)));
typedef float f32x2 __attribute__((ext_vector_type(2)));
typedef unsigned u32x4 __attribute__((ext_vector_type(4)));
typedef unsigned u32x2 __attribute__((ext_vector_type(2)));

constexpr int D = 1024, NB = 8, SEQ = 8192, T = NB * SEQ;
constexpr int RW = 512, HD = 64, NH = 8;
constexpr int RWKV_COLS = 1792, IN_COLS = 4864;
constexpr int NE = 256, TOPK = 8, EFF = 256;
constexpr int NWAVES = 8, NTHREADS = 512;
constexpr int MAXROWS = T * TOPK + 256 * 256;

constexpr size_t MiB = 1u << 20;
constexpr size_t WS_CTL = 0;
constexpr int CW_BAR = 0, CW_SEGCNT = 4096, CW_NT = 4608;
constexpr size_t CTL_ZERO_BYTES = 32768;
constexpr size_t WS_MOD = 65536;
constexpr size_t WS_SW = 1 * MiB;
constexpr size_t SW_WIN = WS_SW;
constexpr size_t SW_WOA = SW_WIN + (size_t)IN_COLS * D * 2;
constexpr size_t SW_WOB = SW_WOA + (size_t)D * RW * 2;
constexpr size_t SW_WO = SW_WOB + (size_t)D * RW * 2;
constexpr size_t SW_WR = SW_WO + (size_t)D * D * 2;
constexpr size_t SW_WS13 = SW_WR + (size_t)NE * D * 2;
constexpr size_t SW_WS2 = SW_WS13 + (size_t)512 * D * 2;
constexpr size_t SW_WUP = SW_WS2 + (size_t)D * EFF * 2;
constexpr size_t SW_AUP = SW_WUP + (size_t)RW * 64 * 2;
constexpr size_t SW_GUP = SW_AUP + (size_t)RW * 64 * 2;
constexpr size_t SW_WSM = SW_GUP + (size_t)RW * 128 * 2;
constexpr size_t SW_END = SW_WSM + (size_t)8 * 128 * 128 * 2;
static_assert(SW_END <= 20 * MiB, "small weights");
constexpr size_t WS_RT = 20 * MiB;
constexpr size_t RT_EIDX = WS_RT;
constexpr size_t RT_EWT = RT_EIDX + (size_t)T * 8 * 4;
constexpr size_t RT_LRANK = RT_EWT + (size_t)T * 8 * 4;
constexpr size_t RT_TBASE = RT_LRANK + (size_t)T * 8 * 4;
constexpr size_t RT_ROWTOK = RT_TBASE + (size_t)256 * 256 * 4;
constexpr size_t RT_ROWDST = RT_ROWTOK + (size_t)MAXROWS * 4;
constexpr size_t RT_ROWW = RT_ROWDST + (size_t)MAXROWS * 4;
constexpr size_t RT_TAB = RT_ROWW + (size_t)MAXROWS * 4;
constexpr size_t RT_SBON = RT_TAB + (size_t)3 * 4096 * 8;
constexpr size_t RT_END = RT_SBON + (size_t)T * 8 * 4;
static_assert(RT_END <= 40 * MiB, "routing arrays");
constexpr size_t WS_BIG = 40 * MiB;
constexpr size_t B_H1 = WS_BIG + 0 * MiB;
constexpr size_t B_YB = WS_BIG + 0 * MiB;
constexpr size_t B_YA = WS_BIG + 64 * MiB;
constexpr size_t B_XS = WS_BIG + 64 * MiB;
constexpr size_t B_PRW = WS_BIG + 128 * MiB;
constexpr size_t B_M8 = WS_BIG + 128 * MiB;
constexpr size_t B_S = WS_BIG + 128 * MiB;
constexpr size_t B_PUV = WS_BIG + 352 * MiB;
constexpr size_t B_QY = WS_BIG + 352 * MiB;
constexpr size_t B_M1 = WS_BIG + 352 * MiB;
constexpr size_t B_PG = WS_BIG + 480 * MiB;
constexpr size_t B_MN = WS_BIG + 736 * MiB;
constexpr size_t B_G = WS_BIG + 864 * MiB;
constexpr size_t B_BV = WS_BIG + 928 * MiB;
constexpr size_t B_H2 = WS_BIG + 0 * MiB;
constexpr size_t B_W13 = WS_BIG + 128 * MiB;
constexpr size_t B_H2F8 = WS_BIG + 256 * MiB;
constexpr size_t B_SH = WS_BIG + 384 * MiB;
constexpr size_t B_SC = WS_BIG + 416 * MiB;
constexpr size_t B_SLOT = WS_BIG + 0 * MiB;
constexpr size_t B_SHO = WS_BIG + 928 * MiB;
constexpr size_t B_W2 = WS_BIG + 512 * MiB;
constexpr size_t B_X1 = WS_BIG + 576 * MiB;
constexpr size_t B_HID = WS_BIG + 704 * MiB;
constexpr size_t WS_END = WS_BIG + 992 * MiB;
static_assert((size_t)MAXROWS * EFF * 2 <= 320 * MiB, "hid");

constexpr int LDS_STAGE = 0;
constexpr int LDS_MISC = 153600;
constexpr int LDS_BARW = 161792;
constexpr int LDS_BYTES = 163840;

typedef __bf16 bf16x2_t __attribute__((ext_vector_type(2)));
__device__ __forceinline__ unsigned pk2(float lo, float hi) { f32x2 f = {lo, hi}; return __builtin_bit_cast(unsigned, __builtin_convertvector(f, bf16x2_t)); }
__device__ __forceinline__ u32x2 pk8(const f32x4& a, const f32x4& b) { u32x2 w; int t = __builtin_amdgcn_cvt_pk_fp8_f32(a[0], a[1], 0, false); t = __builtin_amdgcn_cvt_pk_fp8_f32(a[2], a[3], t, true); w.x = (unsigned)t;
    t = __builtin_amdgcn_cvt_pk_fp8_f32(b[0], b[1], 0, false); t = __builtin_amdgcn_cvt_pk_fp8_f32(b[2], b[3], t, true); w.y = (unsigned)t; return w; }
__device__ __forceinline__ f32x4 up8(unsigned w) { const f32x2 lo = __builtin_amdgcn_cvt_pk_f32_fp8((int)w, false), hi = __builtin_amdgcn_cvt_pk_f32_fp8((int)w, true); return (f32x4){lo.x, lo.y, hi.x, hi.y}; }
__device__ __forceinline__ float bflo(unsigned w) { return __uint_as_float(w << 16); }
__device__ __forceinline__ float bfhi(unsigned w) { return __uint_as_float(w & 0xffff0000u); }
__device__ __forceinline__ float bf2f(bf16_t h) { return __uint_as_float(((unsigned)h) << 16); }
__device__ __forceinline__ bf16_t f2bf(float f) { return (bf16_t)(pk2(f, 0.f) & 0xffffu); }
__device__ __forceinline__ float fexp(float x) { return __builtin_amdgcn_exp2f(x * 1.44269504089f); }
__device__ __forceinline__ float flog(float x) { return __builtin_amdgcn_logf(x) * 0.69314718056f; }
__device__ __forceinline__ float frcp(float x) { return __builtin_amdgcn_rcpf(x); }
__device__ __forceinline__ float sigmoidf_(float x) { return frcp(1.0f + fexp(-x)); }
__device__ __forceinline__ float siluf_(float x) { return x * sigmoidf_(x); }
__device__ __forceinline__ float tanhf_(float x) { return 1.0f - 2.0f * frcp(1.0f + fexp(2.0f * x)); }
__device__ __forceinline__ float gelu_tanh(float x) { const float u = 0.7978845608f * (x + 0.044715f * x * x * x); return x * frcp(1.0f + fexp(-2.0f * u)); }
__device__ __forceinline__ float wave_sum(float v) {
#pragma unroll
    for (int o = 1; o < 64; o <<= 1) v += __shfl_xor(v, o);
    return v;
}
#define LDS_WAIT() asm volatile("s_waitcnt lgkmcnt(0)" ::: "memory")
#define VM_WAIT() asm volatile("s_waitcnt vmcnt(0)" ::: "memory")

#define XB_TMO      128
#define XB_XCNT(j)  (256  + 64 * (j))
#define XB_XSUB(j)  (1280 + 64 * (j))
#define XB_XGEN(j)  (2304 + 64 * (j))
#define XB_TOP      3328
#define XB_TOPGEN   3392
#define XCD_BAR_WORDS 3456
#define XB_SPIN_CAP (1u << 18)
__device__ __forceinline__ unsigned xb_ld(unsigned* p)              { return __hip_atomic_load(p, __ATOMIC_RELAXED, __HIP_MEMORY_SCOPE_AGENT); }
__device__ __forceinline__ unsigned xb_add(unsigned* p, unsigned v) { return __hip_atomic_fetch_add(p, v, __ATOMIC_RELAXED, __HIP_MEMORY_SCOPE_AGENT); }
__device__ __forceinline__ unsigned xb_xcc_id() { return (unsigned)__builtin_amdgcn_s_getreg((3 << 11) | 20) & 0xFu; }
#define XB_SPIN(cond, bar) do { unsigned _sp = 0; while (cond) { __builtin_amdgcn_s_sleep(1); \
    if ((++_sp & 255u) == 0u) { if (xb_ld(&(bar)[XB_TMO])) break; if (_sp > XB_SPIN_CAP) { atomicAdd(&(bar)[XB_TMO], 1u); break; } } } } while (0)
struct XcdBarrier { unsigned* bar; unsigned x; volatile LAS unsigned* st; };
__device__ __forceinline__ XcdBarrier xcd_barrier_post(unsigned* bar, volatile LAS unsigned* st) {
    XcdBarrier b; b.bar = bar; b.x = xb_xcc_id(); b.st = st;
    if (threadIdx.x == 0) (void)xb_add(&bar[XB_XCNT(b.x)], 1u);
    return b;
}
__device__ __forceinline__ void xcd_barrier_complete(unsigned* bar, unsigned x, unsigned& nloc, unsigned& nx) {
    const unsigned G = gridDim.x * gridDim.y * gridDim.z;
    unsigned sum, cnt, mine, sp = 0u;
    for (;;) {
        sum = 0u; cnt = 0u; mine = 0u;
#pragma unroll
        for (unsigned j = 0; j < 16; ++j) { const unsigned c = xb_ld(&bar[XB_XCNT(j)]); sum += c; cnt += (c > 0u) ? 1u : 0u; mine = (j == x) ? c : mine; }
        if (sum == G) break;
        __builtin_amdgcn_s_sleep(1);
        if ((++sp & 255u) == 0u) { if (xb_ld(&bar[XB_TMO])) break; if (sp > XB_SPIN_CAP) { atomicAdd(&bar[XB_TMO], 1u); break; } }
    }
    nloc = mine > 0u ? mine : 1u; nx = cnt > 0u ? cnt : 1u;
}
__device__ __forceinline__ void xcd_barrier(const XcdBarrier& b) {
    asm volatile("s_waitcnt vmcnt(0)" ::: "memory");
    __syncthreads();
    if (threadIdx.x == 0) {
        unsigned* bar = b.bar;
        __builtin_amdgcn_s_waitcnt(0);
        unsigned nloc = b.st[0], nx = b.st[1];
        if (nloc == 0u) { xcd_barrier_complete(bar, b.x, nloc, nx); b.st[0] = nloc; b.st[1] = nx; }
        const unsigned old = xb_add(&bar[XB_XSUB(b.x)], 1u);
        const unsigned gen = old / nloc;
        if (old + 1u == (gen + 1u) * nloc) {
            __builtin_amdgcn_fence(__ATOMIC_RELEASE, "agent");
            asm volatile("s_waitcnt vmcnt(0)" ::: "memory");
            const unsigned og = xb_add(&bar[XB_TOP], 1u);
            const unsigned tg = og / nx;
            if (og + 1u == (tg + 1u) * nx) xb_add(&bar[XB_TOPGEN], 1u);
            else XB_SPIN(xb_ld(&bar[XB_TOPGEN]) == tg, bar);
            __builtin_amdgcn_fence(__ATOMIC_ACQUIRE, "agent");
            xb_add(&bar[XB_XGEN(b.x)], 1u);
            asm volatile("s_waitcnt vmcnt(0)" ::: "memory");
        } else {
            XB_SPIN(xb_ld(&bar[XB_XGEN(b.x)]) == gen, bar);
            __builtin_amdgcn_fence(__ATOMIC_ACQUIRE, "agent");
            asm volatile("s_waitcnt vmcnt(0)" ::: "memory");
        }
    }
    __syncthreads();
}
namespace gm {
typedef int i32x4 __attribute__((ext_vector_type(4)));
typedef int i32x8 __attribute__((ext_vector_type(8)));
constexpr int BM = 256, BK = 64, HALF = 128, HTB = HALF * BK * 2, STAGE_BYTES = 8 * HTB, NXCD = 8, WGM = 8;
__host__ __device__ __forceinline__ int lds_byte(int r, int c) { const int st = (r >> 4) * 2 + (c >> 5), rr = r & 15, cc = c & 31, ob = rr * 64 + cc * 2; return st * 1024 + (ob ^ (((ob >> 9) & 1) << 5)); }
__host__ __device__ __forceinline__ void stage_rc(int b, int& R, int& C) { const int st = b / 1024, sb = b % 1024, swz = sb ^ (((sb >> 9) & 1) << 5); R = (st >> 1) * 16 + swz / 64; C = (st & 1) * 32 + (swz % 64) / 2; }
__host__ __device__ __forceinline__ int perm32(int rho) { const int n = rho >> 4, i = rho & 15; return 8 * (i >> 2) + 4 * n + (i & 3); }

struct Unit { int pm, pn, e, row0, par; };

struct DenseSched {
    static constexpr bool GATHER = false;
    const char* A; const char* B; int nM, nN, nwg, G, c; size_t tstep; const int* rowtok; int K;
    __device__ __forceinline__ void init(const void* A_, const void* B_, int M, int N, int K, int G_, int c_, int es = 2) { A = (const char*)A_; B = (const char*)B_; nM = M / BM; nN = N / BM; nwg = nM * nN; G = G_; c = c_; tstep = (size_t)BM * K * es; rowtok = nullptr; this->K = 0; }
    __device__ __forceinline__ bool next(int i, Unit& u) const {
        const long L = (long)i * G + c; if (L >= nwg) return false;
        int wgid = (int)L; { const int q = nwg / NXCD, r = nwg % NXCD, xcd = wgid % NXCD, off = wgid / NXCD; wgid = (xcd < r ? xcd * (q + 1) : r * (q + 1) + (xcd - r) * q) + off; }
        const int nig = WGM * nN, gid = wgid / nig, fm = gid * WGM, gsz = (nM - fm) < WGM ? (nM - fm) : WGM;
        u.pm = fm + ((wgid % nig) % gsz); u.pn = (wgid % nig) / gsz; u.e = 0; u.row0 = u.pm * BM; return true;
    }
    __device__ __forceinline__ const char* a_ptr(const Unit& u) const { return A + (size_t)u.pm * tstep; }
    __device__ __forceinline__ const char* b_ptr(const Unit& u) const { return B + (size_t)u.pn * tstep; }
    __device__ __forceinline__ unsigned row_off(const Unit&, int) const { return 0u; }
};
template <bool GATHER_>
struct GroupSched {
    static constexpr bool GATHER = GATHER_;
    const char* A; const char* B; const int* tab; const int* rowtok; int ntiles, npn, G, c, K; size_t ebytes, tstep;
    __device__ __forceinline__ bool next(int i, Unit& u) const {
        int tile;
        if (G == 256) {
            const int xcd = c & 7, slot = c >> 3, tpx = 32 / npn; tile = i * 8 * tpx + xcd * tpx + slot / npn; u.pn = slot % npn; if (tile >= ntiles) return false;
        } else { const long L = (long)i * G + c; if (L >= (long)ntiles * npn) return false; tile = (int)(L / npn); u.pn = (int)(L % npn); }
        u.pm = tile;
        u.row0 = __builtin_amdgcn_readfirstlane(tab[2 * tile]); u.e = __builtin_amdgcn_readfirstlane(tab[2 * tile + 1]); return true;
    }
    __device__ __forceinline__ const char* a_ptr(const Unit& u) const { return GATHER ? A : A + (size_t)u.row0 * K; }
    __device__ __forceinline__ const char* b_ptr(const Unit& u) const { return B + (size_t)u.e * ebytes + (size_t)u.pn * tstep; }
    __device__ __forceinline__ unsigned row_off(const Unit& u, int r) const { return (unsigned)rowtok[u.row0 + r] * (unsigned)K; }
};

template <class Epi, class Sched, bool ALIGN_EPI, bool F8 = false, int SCALE_W = 127>
__device__ __forceinline__ void gemm_phase(LAS unsigned char* lds, const int Kel, const Sched& S, const Epi& E) {
    const int K = F8 ? Kel / 2 : Kel;
    int tid_ = threadIdx.x; asm volatile("" : "+v"(tid_));
    const int tid = tid_, wid = __builtin_amdgcn_readfirstlane(tid >> 6), lane = tid & 63, wr = wid >> 2, wc = wid & 3, fr = lane & 15, fq = lane >> 4;
    const int nt = K / BK;
    int sR[2], sC[2]; unsigned voffB[2];
#pragma unroll
    for (int i = 0; i < 2; ++i) { int R, C; stage_rc(tid * 16 + i * 8192, R, C); sR[i] = R; sC[i] = C; const int Rb = Epi::PERM ? ((R & ~31) + perm32(R & 31)) : R; voffB[i] = (unsigned)(Rb * K + C) * 2u; }
    const size_t kstep = (size_t)(BK * 2);
    const size_t hstep = (size_t)HALF * K * 2;
    const unsigned ldsw = (unsigned)wid * 1024u;
    const int aoff = lds_byte(wr * 64 + fr, fq * 8), boff = lds_byte(wc * 32 + fr, fq * 8);
#define PG8_SA(b, h) (((b) * 2 + (h)) * HTB)
#define PG8_SB(b, h) ((4 + (b) * 2 + (h)) * HTB)
#define PG8_STGB(bufoff, gbase) do { _Pragma("unroll") for (int _i = 0; _i < 2; ++_i) \
        __builtin_amdgcn_global_load_lds((const unsigned*)((const char*)(gbase) + voffB[_i]), (LAS unsigned*)(lds + (bufoff) + ldsw + _i * 8192), 16, 0, 0); } while (0)
#define PG8_STGA(bufoff, gbase, VO, h) do { _Pragma("unroll") for (int _i = 0; _i < 2; ++_i) \
        __builtin_amdgcn_global_load_lds((const unsigned*)((const char*)(gbase) + VO[h][_i]), (LAS unsigned*)(lds + (bufoff) + ldsw + _i * 8192), 16, 0, 0); } while (0)
#define PG8_VOA(u, VO) do { _Pragma("unroll") for (int _h = 0; _h < 2; ++_h) _Pragma("unroll") for (int _i = 0; _i < 2; ++_i) \
        VO[_h][_i] = Sched::GATHER ? (S.row_off(u, _h * HALF + sR[_i]) + (unsigned)sC[_i] * 2u) : ((unsigned)((_h * HALF + sR[_i]) * K + sC[_i]) * 2u); } while (0)
#define PG8_LDA(dst, b, h) do { _Pragma("unroll") for (int m = 0; m < 4; ++m) { if constexpr (F8) { dst##8[m].lo = *(const LAS i32x4*)(lds + PG8_SA(b, h) + aoff + m * 2048); dst##8[m].hi = *(const LAS i32x4*)(lds + PG8_SA(b, h) + aoff + m * 2048 + 1024); } else { _Pragma("unroll") for (int k = 0; k < 2; ++k) dst[m][k] = *(const LAS bf16x8*)(lds + PG8_SA(b, h) + aoff + m * 2048 + k * 1024); } } } while (0)
#define PG8_LDB(dst, b, h) do { _Pragma("unroll") for (int n = 0; n < 2; ++n) { if constexpr (F8) { dst##8[n].lo = *(const LAS i32x4*)(lds + PG8_SB(b, h) + boff + n * 2048); dst##8[n].hi = *(const LAS i32x4*)(lds + PG8_SB(b, h) + boff + n * 2048 + 1024); } else { _Pragma("unroll") for (int k = 0; k < 2; ++k) dst[n][k] = *(const LAS bf16x8*)(lds + PG8_SB(b, h) + boff + n * 2048 + k * 1024); } } } while (0)
#define PG8_MMA(ai, bj, At, Bt) do { __builtin_amdgcn_s_setprio(1); _Pragma("unroll") for (int m = 0; m < 4; ++m) _Pragma("unroll") for (int n = 0; n < 2; ++n) { \
        if constexpr (F8) { asm volatile("v_mfma_scale_f32_16x16x128_f8f6f4 %0, %1, %2, %0, %3, %4 op_sel_hi:[0,0,0]" : "+v"(acc[ai][bj][m][n]) : "v"(Bt##8[n]), "v"(At##8[m]), "v"(scw_), "v"(sca_)); } \
        else { _Pragma("unroll") for (int k = 0; k < 2; ++k) acc[ai][bj][m][n] = __builtin_amdgcn_mfma_f32_16x16x32_bf16(Bt[n][k], At[m][k], acc[ai][bj][m][n], 0, 0, 0); } } \
        __builtin_amdgcn_s_setprio(0); } while (0)
#define PG8_WAIT_V(n) asm volatile("s_waitcnt vmcnt(" #n ")" ::: "memory")
#define PG8_WAIT_L(n) asm volatile("s_waitcnt lgkmcnt(" #n ")" ::: "memory")
#define PG8_BAR __builtin_amdgcn_s_barrier()
#define PG8_SCHED __builtin_amdgcn_sched_barrier(0)
    Unit cur, nxt; int ui = 0;
    if (!S.next(0, cur)) return;
    f32x4 acc[2][2][4][2];
#pragma unroll
    for (int a = 0; a < 2; ++a)
#pragma unroll
        for (int b = 0; b < 2; ++b)
#pragma unroll
            for (int m = 0; m < 4; ++m)
#pragma unroll
                for (int n = 0; n < 2; ++n) acc[a][b][m][n] = (f32x4){0.f, 0.f, 0.f, 0.f};
    const int scw_ = SCALE_W, sca_ = 127;
    bf16x8 At[4][2], B0[2][2], B1[2][2]; i32x8 At8[4], B08[2], B18[2];
    unsigned voA[2][2], nvoA[2][2];
    PG8_VOA(cur, voA);
    if (Sched::GATHER) { asm volatile("s_waitcnt vmcnt(0)" ::: "memory"); }
    const char* cA = S.a_ptr(cur); const char* cB = S.b_ptr(cur);
    cur.par = 0; E.stage_rows(cur, lds, wid);
    PG8_STGB(PG8_SB(0, 0), cB); PG8_STGB(PG8_SB(0, 1), cB + hstep); PG8_STGA(PG8_SA(0, 0), cA, voA, 0); PG8_STGA(PG8_SA(0, 1), cA, voA, 1);
    if (wr == 1) PG8_BAR;
    PG8_WAIT_V(2); PG8_BAR;
    PG8_STGB(PG8_SB(1, 0), cB + kstep); PG8_STGA(PG8_SA(1, 0), cA + kstep, voA, 0); PG8_STGB(PG8_SB(1, 1), cB + hstep + kstep);
    PG8_WAIT_V(6); PG8_BAR;
    Unit nn; bool has_next = S.next(1, nxt);
    for (;;) {
        nxt.par = (ui + 1) & 3;
        const bool has_nn = has_next && S.next(ui + 2, nn);
        const char* nA = has_next ? S.a_ptr(nxt) : cA; const char* nB = has_next ? S.b_ptr(nxt) : cB;
        if (Sched::GATHER) {
            if (has_next) { if (wid < 4) __builtin_amdgcn_global_load_lds((const unsigned*)(S.rowtok + nxt.row0 + wid * 64 + lane), (LAS unsigned*)(lds + LDS_MISC + nxt.par * 1024 + wid * 256), 4, 0, 0); }
#pragma unroll
            for (int h = 0; h < 2; ++h)
#pragma unroll
                for (int i = 0; i < 2; ++i) nvoA[h][i] = voA[h][i]; }
#pragma unroll 1
        for (int t = 0; t < nt; t += 2) {
            const bool last = (t == nt - 2);
            const char* a1 = cA + (size_t)(t + 1) * kstep;
            const char* a2 = last ? nA : cA + (size_t)(t + 2) * kstep; const char* b2 = last ? nB : cB + (size_t)(t + 2) * kstep;
            const char* a3 = a2 + kstep; const char* b3 = b2 + kstep;
            unsigned vo2[2][2];
#pragma unroll
            for (int h = 0; h < 2; ++h)
#pragma unroll
                for (int i = 0; i < 2; ++i) vo2[h][i] = (Sched::GATHER && last) ? nvoA[h][i] : voA[h][i];
            if (last && has_next) E.stage_rows(nxt, lds, wid);
            if (Sched::GATHER && last && has_next) { const LAS int* rt_ = (const LAS int*)(lds + LDS_MISC + nxt.par * 1024);
#pragma unroll
                for (int h = 0; h < 2; ++h)
#pragma unroll
                    for (int i = 0; i < 2; ++i) { vo2[h][i] = (unsigned)rt_[h * HALF + sR[i]] * (unsigned)S.K + (unsigned)sC[i] * 2u; nvoA[h][i] = vo2[h][i]; } }
            PG8_LDB(B0, 0, 0); PG8_LDB(B1, 0, 1); PG8_SCHED; PG8_LDA(At, 0, 0); PG8_STGA(PG8_SA(1, 1), a1, voA, 1);
            PG8_WAIT_V(8); PG8_WAIT_L(0); PG8_BAR; PG8_MMA(0, 0, At, B0); PG8_MMA(0, 1, At, B1); PG8_BAR; PG8_SCHED;
            PG8_LDA(At, 0, 1); PG8_STGB(PG8_SB(0, 0), b2); PG8_STGB(PG8_SB(0, 1), b2 + hstep); PG8_STGA(PG8_SA(0, 0), a2, vo2, 0);
            PG8_WAIT_V(8); PG8_WAIT_L(0); PG8_BAR; PG8_MMA(1, 0, At, B0); PG8_MMA(1, 1, At, B1); PG8_BAR; PG8_SCHED;
            PG8_LDB(B0, 1, 0); PG8_LDB(B1, 1, 1); PG8_SCHED; PG8_LDA(At, 1, 0); PG8_STGA(PG8_SA(0, 1), a2, vo2, 1);
            PG8_WAIT_V(8); PG8_WAIT_L(0); PG8_BAR; PG8_MMA(0, 0, At, B0); PG8_MMA(0, 1, At, B1); PG8_BAR; PG8_SCHED;
            PG8_LDA(At, 1, 1); PG8_STGB(PG8_SB(1, 0), b3); PG8_STGB(PG8_SB(1, 1), b3 + hstep); PG8_STGA(PG8_SA(1, 0), a3, vo2, 0);
            PG8_WAIT_V(8); PG8_WAIT_L(0); PG8_BAR; PG8_MMA(1, 0, At, B0); PG8_MMA(1, 1, At, B1); PG8_BAR; PG8_SCHED;
        }
        if constexpr (F8) asm volatile("s_nop 15\n\ts_nop 15\n\ts_nop 15" ::: "memory");
        if constexpr (ALIGN_EPI) { if (wr == 0) PG8_BAR; }
        E(acc, cur, wr, wc, fr, fq);
        if (!has_next) break;
#pragma unroll
        for (int a = 0; a < 2; ++a)
#pragma unroll
            for (int b = 0; b < 2; ++b)
#pragma unroll
                for (int m = 0; m < 4; ++m)
#pragma unroll
                    for (int n = 0; n < 2; ++n) acc[a][b][m][n] = (f32x4){0.f, 0.f, 0.f, 0.f};
        cur = nxt; cA = nA; cB = nB; ++ui; nxt = nn; has_next = has_nn;
        if (Sched::GATHER) {
#pragma unroll
            for (int h = 0; h < 2; ++h)
#pragma unroll
                for (int i = 0; i < 2; ++i) voA[h][i] = nvoA[h][i]; }
        if constexpr (ALIGN_EPI) { if (wr == 1) PG8_BAR; }
    }
    PG8_WAIT_V(0);
    if constexpr (!ALIGN_EPI) { if (wr == 0) PG8_BAR; }
    PG8_BAR;
#undef PG8_SA
#undef PG8_SB
#undef PG8_STGA
#undef PG8_STGB
#undef PG8_VOA
#undef PG8_LDA
#undef PG8_LDB
#undef PG8_MMA
#undef PG8_WAIT_V
#undef PG8_WAIT_L
#undef PG8_BAR
#undef PG8_SCHED
}

typedef f32x4 Acc[2][2][4][2];
struct EpiInProj {
    static constexpr bool PERM = true;
    __device__ __forceinline__ void stage_rows(const Unit&, LAS unsigned char*, int) const {}
    bf16_t *prw, *puv, *pg;
    template <int ACT> __device__ __forceinline__ void tile(const Acc& acc, bf16_t* base, int ld, int row0, int col0) const {
#pragma unroll
        for (int ai = 0; ai < 2; ++ai)
#pragma unroll
            for (int m = 0; m < 4; ++m) { bf16_t* rowp = base + (size_t)(row0 + ai * HALF + m * 16) * ld + col0;
#pragma unroll
                for (int bj = 0; bj < 2; ++bj) { f32x4 v0 = acc[ai][bj][m][0], v1 = acc[ai][bj][m][1];
                    if (ACT == 1) {
#pragma unroll
                        for (int j = 0; j < 4; ++j) { v0[j] = gelu_tanh(v0[j]); v1[j] = gelu_tanh(v1[j]); } }
                    if (ACT == 2) {
#pragma unroll
                        for (int j = 0; j < 4; ++j) { v0[j] = sigmoidf_(v0[j]); v1[j] = sigmoidf_(v1[j]); } }
                    u32x4 w; w.x = pk2(v0[0], v0[1]); w.y = pk2(v0[2], v0[3]); w.z = pk2(v1[0], v1[1]); w.w = pk2(v1[2], v1[3]);
                    *(u32x4*)(rowp + bj * HALF) = w; }
                __builtin_amdgcn_sched_barrier(0); }
    }
    __device__ __forceinline__ void operator()(const Acc& acc, const Unit& u, int wr, int wc, int fr, int fq) const {
        const int row0 = u.row0 + wr * 64 + fr, cw = wc * 32 + 8 * fq;
        if (u.pn < 7) tile<0>(acc, prw, RWKV_COLS, row0, u.pn * 256 + cw);
        else if (u.pn < 11) tile<1>(acc, puv, 1024, row0, (u.pn - 7) * 256 + cw);
        else tile<2>(acc, pg, 2048, row0, (u.pn - 11) * 256 + cw);
    }
};
template <bool SECOND> struct EpiMerge {
    static constexpr bool PERM = true;
    __device__ __forceinline__ void stage_rows(const Unit&, LAS unsigned char*, int) const {}
    bf16_t* m1; const bf16_t* pg; unsigned char* m8;
    __device__ __forceinline__ void operator()(const Acc& acc, const Unit& u, int wr, int wc, int fr, int fq) const {
        const int row0 = u.row0 + wr * 64 + fr, col0 = u.pn * 256 + wc * 32 + 8 * fq;
#pragma unroll
        for (int ai = 0; ai < 2; ++ai)
#pragma unroll
            for (int m = 0; m < 4; ++m) { const size_t r = (size_t)(row0 + ai * HALF + m * 16);
#pragma unroll
                for (int bj = 0; bj < 2; ++bj) { const int c = col0 + bj * HALF;
                    const u32x4 g = *(const u32x4*)(pg + r * 2048 + (SECOND ? 1024 : 0) + c);
                    f32x4 v0 = acc[ai][bj][m][0], v1 = acc[ai][bj][m][1];
                    v0[0] *= bflo(g.x); v0[1] *= bfhi(g.x); v0[2] *= bflo(g.y); v0[3] *= bfhi(g.y); v1[0] *= bflo(g.z); v1[1] *= bfhi(g.z); v1[2] *= bflo(g.w); v1[3] *= bfhi(g.w);
                    if (SECOND) { const u32x4 p = *(const u32x4*)(m1 + r * 1024 + c);
                        v0[0] += bflo(p.x); v0[1] += bfhi(p.x); v0[2] += bflo(p.y); v0[3] += bfhi(p.y); v1[0] += bflo(p.z); v1[1] += bfhi(p.z); v1[2] += bflo(p.w); v1[3] += bfhi(p.w); }
                    if (SECOND) *(u32x2*)(m8 + r * 1024 + c) = pk8(v0, v1);
                    else { u32x4 w; w.x = pk2(v0[0], v0[1]); w.y = pk2(v0[2], v0[3]); w.z = pk2(v1[0], v1[1]); w.w = pk2(v1[2], v1[3]); *(u32x4*)(m1 + r * 1024 + c) = w; } }
                __builtin_amdgcn_sched_barrier(0); }
    }
};
struct EpiResid {
    static constexpr bool PERM = true;
    __device__ __forceinline__ void stage_rows(const Unit&, LAS unsigned char*, int) const {}
    bf16_t* out; const float* base; const float* gate;
    __device__ __forceinline__ void operator()(const Acc& acc, const Unit& u, int wr, int wc, int fr, int fq) const {
        const int row0 = u.row0 + wr * 64 + fr, col0 = u.pn * 256 + wc * 32 + 8 * fq;
        const float* gp = gate + (size_t)(u.row0 >> 13) * 6144 + col0;
        f32x4 gv[2][2];
#pragma unroll
        for (int bj = 0; bj < 2; ++bj)
#pragma unroll
            for (int n = 0; n < 2; ++n) gv[bj][n] = *(const f32x4*)(gp + bj * HALF + n * 4);
#pragma unroll
        for (int ai = 0; ai < 2; ++ai)
#pragma unroll
            for (int m = 0; m < 4; ++m) { const size_t ro = (size_t)(row0 + ai * HALF + m * 16) * 1024 + col0;
#pragma unroll
                for (int bj = 0; bj < 2; ++bj) { const f32x4 b0 = *(const f32x4*)(base + ro + bj * HALF), b1 = *(const f32x4*)(base + ro + bj * HALF + 4);
                    const f32x4 v0 = b0 + gv[bj][0] * acc[ai][bj][m][0], v1 = b1 + gv[bj][1] * acc[ai][bj][m][1];
                    u32x4 w; w.x = pk2(v0[0], v0[1]); w.y = pk2(v0[2], v0[3]); w.z = pk2(v1[0], v1[1]); w.w = pk2(v1[2], v1[3]);
                    *(u32x4*)(out + ro + bj * HALF) = w; }
                __builtin_amdgcn_sched_barrier(0); }
    }
};
struct EpiRouter {
    static constexpr bool PERM = false;
    __device__ __forceinline__ void stage_rows(const Unit&, LAS unsigned char*, int) const {}
    float* sc;
    __device__ __forceinline__ void operator()(const Acc& acc, const Unit& u, int wr, int wc, int fr, int fq) const {
        const int row0 = u.row0 + wr * 64 + fr, col0 = wc * 32 + 4 * fq;
#pragma unroll
        for (int ai = 0; ai < 2; ++ai)
#pragma unroll
            for (int m = 0; m < 4; ++m) { float* rowp = sc + (size_t)(row0 + ai * HALF + m * 16) * 256 + col0;
#pragma unroll
                for (int bj = 0; bj < 2; ++bj)
#pragma unroll
                    for (int n = 0; n < 2; ++n) { f32x4 v = acc[ai][bj][m][n];
#pragma unroll
                        for (int j = 0; j < 4; ++j) v[j] = sigmoidf_(v[j]);
                        *(f32x4*)(rowp + bj * HALF + n * 16) = v; }
                __builtin_amdgcn_sched_barrier(0); }
    }
};
template <bool F8OUT> struct EpiGateUp {
    static constexpr bool PERM = true;
    __device__ __forceinline__ void stage_rows(const Unit&, LAS unsigned char*, int) const {}
    void* hid;
    __device__ __forceinline__ void operator()(const Acc& acc, const Unit& u, int wr, int wc, int fr, int fq) const {
        const int row0 = u.row0 + wr * 64 + fr, col0 = u.pn * HALF + wc * 32 + 8 * fq;
#pragma unroll
        for (int ai = 0; ai < 2; ++ai)
#pragma unroll
            for (int m = 0; m < 4; ++m) { const size_t off = (size_t)(row0 + ai * HALF + m * 16) * EFF + col0;
                f32x4 v0, v1;
#pragma unroll
                for (int j = 0; j < 4; ++j) { v0[j] = siluf_(acc[ai][0][m][0][j]) * acc[ai][1][m][0][j]; v1[j] = siluf_(acc[ai][0][m][1][j]) * acc[ai][1][m][1][j]; }
                if constexpr (F8OUT) *(u32x2*)((unsigned char*)hid + off) = pk8(v0, v1);
                else { u32x4 w; w.x = pk2(v0[0], v0[1]); w.y = pk2(v0[2], v0[3]); w.z = pk2(v1[0], v1[1]); w.w = pk2(v1[2], v1[3]); *(u32x4*)((bf16_t*)hid + off) = w; }
                __builtin_amdgcn_sched_barrier(0); }
    }
};
struct EpiExpertDown {
    static constexpr bool PERM = true;
    unsigned char* slot; const int* rowdst; const float* roww;
    __device__ __forceinline__ void stage_rows(const Unit& u, LAS unsigned char* lds, int wid) const {
        if (wid < 4) { const int lane = threadIdx.x & 63; LAS unsigned char* base = lds + LDS_MISC + u.par * 2048 + wid * 256;
            __builtin_amdgcn_global_load_lds((const unsigned*)(rowdst + u.row0 + wid * 64 + lane), (LAS unsigned*)base, 4, 0, 0);
            __builtin_amdgcn_global_load_lds((const unsigned*)(roww + u.row0 + wid * 64 + lane), (LAS unsigned*)(base + 1024), 4, 0, 0); }
    }
    __device__ __forceinline__ void operator()(const Acc& acc, const Unit& u, int wr, int wc, int fr, int fq) const {
        const unsigned cb = (unsigned)(u.pn * 256 + wc * 64 + 16 * fq);
        const LAS int* td = (const LAS int*)((LAS unsigned char*)nullptr + LDS_MISC + u.par * 2048) + wr * 64 + fr; const LAS float* tw = (const LAS float*)(td + 256);
        int dst[2][4]; float ws_[2][4];
#pragma unroll
        for (int ai = 0; ai < 2; ++ai)
#pragma unroll
            for (int m = 0; m < 4; ++m) { dst[ai][m] = td[ai * HALF + m * 16]; ws_[ai][m] = tw[ai * HALF + m * 16]; }
#pragma unroll
        for (int ai = 0; ai < 2; ++ai)
#pragma unroll
            for (int m = 0; m < 4; ++m) {
                if (dst[ai][m] >= 0) { const float s_ = ws_[ai][m]; const u32x2 lo = pk8(acc[ai][0][m][0] * s_, acc[ai][0][m][1] * s_), hi = pk8(acc[ai][1][m][0] * s_, acc[ai][1][m][1] * s_);
                    *(u32x4*)(slot + (size_t)((unsigned)dst[ai][m] * 1024u + cb)) = (u32x4){lo.x, lo.y, hi.x, hi.y}; }
            }
    }
};
struct EpiSharedDown {
    static constexpr bool PERM = true;
    unsigned char* sho;
    __device__ __forceinline__ void stage_rows(const Unit&, LAS unsigned char*, int) const {}
    __device__ __forceinline__ void operator()(const Acc& acc, const Unit& u, int wr, int wc, int fr, int fq) const {
        const int row0 = u.row0 + wr * 64 + fr, col0 = u.pn * 256 + wc * 32 + 8 * fq;
#pragma unroll
        for (int ai = 0; ai < 2; ++ai)
#pragma unroll
            for (int m = 0; m < 4; ++m) { unsigned char* rowp = sho + (size_t)(row0 + ai * HALF + m * 16) * 1024 + col0;
#pragma unroll
                for (int bj = 0; bj < 2; ++bj) *(u32x2*)(rowp + bj * HALF) = pk8(acc[ai][bj][m][0], acc[ai][bj][m][1]);
                __builtin_amdgcn_sched_barrier(0); }
    }
};
}
__device__ __forceinline__ void phase_mod(const float* c, const float* ada_w, const float* ada_b, float* mod, LAS unsigned char* lds, int tid, int G) {
    LAS float* sl = (LAS float*)lds; LAS float* red = (LAS float*)(lds + 32768);
    for (int i = tid; i < NB * D; i += NTHREADS) { const float v = c[i]; sl[i] = siluf_(v); }
    __syncthreads();
    const int cl = tid % 24, kg = tid / 24;
    for (int cb = blockIdx.x; cb < 256; cb += G) {
        const int col0 = cb * 24;
        if (tid < 384) {
            float a[NB];
#pragma unroll
            for (int b = 0; b < NB; ++b) a[b] = 0.f;
#pragma unroll 1
            for (int k0 = kg; k0 < D; k0 += 16 * 16) { float w[16];
#pragma unroll
                for (int i = 0; i < 16; ++i) w[i] = ada_w[(size_t)(k0 + 16 * i) * 6144 + col0 + cl];
#pragma unroll
                for (int i = 0; i < 16; ++i) {
#pragma unroll
                    for (int b = 0; b < NB; ++b) a[b] += sl[b * D + k0 + 16 * i] * w[i]; } }
#pragma unroll
            for (int b = 0; b < NB; ++b) red[(kg * 24 + cl) * NB + b] = a[b];
        }
        __syncthreads();
        if (tid < 192) { const int c2 = tid >> 3, b = tid & 7; float s = 0.f;
#pragma unroll
            for (int g = 0; g < 16; ++g) s += red[(g * 24 + c2) * NB + b];
            mod[(size_t)b * 6144 + col0 + c2] = s + ada_b[col0 + c2]; }
        __syncthreads();
    }
}
__device__ __forceinline__ void transpose_item(const float* W, int ldw, int k0, int n0, bf16_t* WT, int ldt, int drow0, LAS float* scr, int lane) {
#pragma unroll 8
    for (int i = 0; i < 32; ++i) { const int kk = 2 * i + (lane >> 5); scr[kk * 33 + (lane & 31)] = W[(size_t)(k0 + kk) * ldw + n0 + (lane & 31)]; }
    LDS_WAIT(); asm volatile("" ::: "memory");
    const int c = lane & 7;
#pragma unroll
    for (int j = 0; j < 4; ++j) { const int n = (lane >> 3) + 8 * j; const LAS float* s = scr + (8 * c) * 33 + n;
        u32x4 o; o.x = pk2(s[0 * 33], s[1 * 33]); o.y = pk2(s[2 * 33], s[3 * 33]); o.z = pk2(s[4 * 33], s[5 * 33]); o.w = pk2(s[6 * 33], s[7 * 33]);
        *(u32x4*)(WT + (size_t)(drow0 + n) * ldt + k0 + 8 * c) = o; }
    LDS_WAIT(); asm volatile("" ::: "memory");
}
__device__ __forceinline__ void transpose_job(const float* W, int K, int N, bf16_t* WT, int gated, int goff, int item, LAS float* scr, int lane) {
    const int nblk = N / 32, kb = item / nblk, nb = item % nblk, n0 = 32 * nb;
    const int drow0 = gated ? (256 * (n0 >> 7) + goff + (n0 & 127)) : n0;
    transpose_item(W, N, 64 * kb, n0, WT, K, drow0, scr, lane);
}
__device__ __forceinline__ void transpose_item64(const float* W, int ldw, int k0, int n0, bf16_t* WT, int ldt, int drow0, LAS float* scr, int lane) {
    f32x4 v[16];
    const int c4 = lane & 15, r4 = lane >> 4;
#pragma unroll
    for (int i = 0; i < 16; ++i) v[i] = *(const f32x4*)(W + (size_t)(k0 + 4 * i + r4) * ldw + n0 + 4 * c4);
#pragma unroll
    for (int i = 0; i < 16; ++i) { LAS float* d = scr + (4 * i + r4) * 65 + 4 * c4; d[0] = v[i].x; d[1] = v[i].y; d[2] = v[i].z; d[3] = v[i].w; }
    LDS_WAIT(); asm volatile("" ::: "memory");
    const int c = lane & 7;
#pragma unroll
    for (int j = 0; j < 8; ++j) { const int n = (lane >> 3) + 8 * j; const LAS float* s = scr + (8 * c) * 65 + n;
        u32x4 o; o.x = pk2(s[0 * 65], s[1 * 65]); o.y = pk2(s[2 * 65], s[3 * 65]); o.z = pk2(s[4 * 65], s[5 * 65]); o.w = pk2(s[6 * 65], s[7 * 65]);
        *(u32x4*)(WT + (size_t)(drow0 + n) * ldt + k0 + 8 * c) = o; }
    LDS_WAIT(); asm volatile("" ::: "memory");
}
constexpr float WSCALE = 32.0f;
__device__ __forceinline__ void transpose_item64_f8(const float* W, int ldw, int k0, int n0, unsigned char* WT8, int ldt, int drow0, LAS float* scr, int lane) {
    f32x4 v[16];
    const int c4 = lane & 15, r4 = lane >> 4;
#pragma unroll
    for (int i = 0; i < 16; ++i) v[i] = *(const f32x4*)(W + (size_t)(k0 + 4 * i + r4) * ldw + n0 + 4 * c4);
#pragma unroll
    for (int i = 0; i < 16; ++i) { LAS float* d = scr + (4 * i + r4) * 65 + 4 * c4; d[0] = v[i].x; d[1] = v[i].y; d[2] = v[i].z; d[3] = v[i].w; }
    LDS_WAIT(); asm volatile("" ::: "memory");
    const int c = lane & 7;
#pragma unroll
    for (int j = 0; j < 8; ++j) { const int n = (lane >> 3) + 8 * j; const LAS float* s = scr + (8 * c) * 65 + n;
        const f32x4 lo = (f32x4){s[0 * 65], s[1 * 65], s[2 * 65], s[3 * 65]} * WSCALE, hi = (f32x4){s[4 * 65], s[5 * 65], s[6 * 65], s[7 * 65]} * WSCALE;
        *(u32x2*)(WT8 + (size_t)(drow0 + n) * ldt + k0 + 8 * c) = pk8(lo, hi); }
    LDS_WAIT(); asm volatile("" ::: "memory");
}
struct SmallW { const float *w_in, *w_out_a, *w_out_b, *w_out, *router_w, *sw1, *sw3, *sw2, *w_up, *a_up, *g_up, *gws; };
__device__ __forceinline__ void phase_small_weights(const SmallW& P, unsigned char* ws, LAS unsigned char* lds, int gw, int NGW, int wave, int lane) {
    LAS float* scr = (LAS float*)(lds + wave * 16640);
    constexpr int I0 = 16 * 76, I1 = 8 * 16, I2 = 8 * 16, I3 = 16 * 16, I4 = 16 * 8, I5 = 16 * 4, I6 = 16 * 4, I7 = 4 * 16, I8 = 16, I9 = 16, I10 = 2 * 16;
    constexpr int NIT = I0 + I1 + I2 + I3 + I4 + I5 + I6 + I7 + I8 + I9 + I10;
    for (int it = gw; it < NIT; it += NGW) {
        int r = it;
        if (r < I0) { const int kb = r / 76, nb = r % 76; transpose_item64_f8(P.w_in, IN_COLS, 64 * kb, 64 * nb, ws + SW_WIN, D, 64 * nb, scr, lane); continue; } r -= I0;
        if (r < I1) { transpose_item64_f8(P.w_out_a, D, 64 * (r >> 4), 64 * (r & 15), ws + SW_WOA, RW, 64 * (r & 15), scr, lane); continue; } r -= I1;
        if (r < I2) { transpose_item64_f8(P.w_out_b, D, 64 * (r >> 4), 64 * (r & 15), ws + SW_WOB, RW, 64 * (r & 15), scr, lane); continue; } r -= I2;
        if (r < I3) { transpose_item64_f8(P.w_out, D, 64 * (r >> 4), 64 * (r & 15), ws + SW_WO, D, 64 * (r & 15), scr, lane); continue; } r -= I3;
        if (r < I4) { transpose_job(P.router_w, D, NE, (bf16_t*)(ws + SW_WR), 0, 0, r, scr, lane); continue; } r -= I4;
        if (r < I5) { const int n0 = 64 * (r & 3); transpose_item64_f8(P.sw1, EFF, 64 * (r >> 2), n0, ws + SW_WS13, D, 256 * (n0 >> 7) + (n0 & 127), scr, lane); continue; } r -= I5;
        if (r < I6) { const int n0 = 64 * (r & 3); transpose_item64_f8(P.sw3, EFF, 64 * (r >> 2), n0, ws + SW_WS13, D, 256 * (n0 >> 7) + 128 + (n0 & 127), scr, lane); continue; } r -= I6;
        if (r < I7) { transpose_item64_f8(P.sw2, D, 64 * (r >> 4), 64 * (r & 15), ws + SW_WS2, EFF, 64 * (r & 15), scr, lane); continue; } r -= I7;
        if (r < I8) { transpose_job(P.w_up, 64, RW, (bf16_t*)(ws + SW_WUP), 0, 0, r, scr, lane); continue; } r -= I8;
        if (r < I9) { transpose_job(P.a_up, 64, RW, (bf16_t*)(ws + SW_AUP), 0, 0, r, scr, lane); continue; } r -= I9;
        transpose_job(P.g_up, 128, RW, (bf16_t*)(ws + SW_GUP), 0, 0, r, scr, lane);
    }
    bf16_t* wsm = (bf16_t*)(ws + SW_WSM);
    for (int i = gw * 64 + lane; i < 8 * 128 * 128; i += NGW * 64) { const int col = i & 127, row = (i >> 7) & 127; wsm[i] = (col <= row) ? f2bf(P.gws[i]) : (bf16_t)0; }
}
template <bool PERM16>
__device__ __forceinline__ void transpose_item128_f8(const float* W, int ldw, int k0, int n0, unsigned char* WT8, int ldt, int drow0, LAS float* scr, int lane) {
    f32x4 v[16];
    const int c4 = lane & 7, r8 = lane >> 3;
#pragma unroll
    for (int i = 0; i < 16; ++i) v[i] = *(const f32x4*)(W + (size_t)(k0 + 8 * i + r8) * ldw + n0 + 4 * c4);
#pragma unroll
    for (int i = 0; i < 16; ++i) { LAS float* d = scr + (8 * i + r8) * 33 + 4 * c4; d[0] = v[i].x; d[1] = v[i].y; d[2] = v[i].z; d[3] = v[i].w; }
    LDS_WAIT(); asm volatile("" ::: "memory");
    const int c = lane & 7;
#pragma unroll
    for (int j = 0; j < 4; ++j) { const int n = (lane >> 3) + 8 * j; const LAS float* s = scr + (16 * c) * 33 + n;
        f32x4 a0 = (f32x4){s[0 * 33], s[1 * 33], s[2 * 33], s[3 * 33]} * WSCALE, a1 = (f32x4){s[4 * 33], s[5 * 33], s[6 * 33], s[7 * 33]} * WSCALE;
        f32x4 a2 = (f32x4){s[8 * 33], s[9 * 33], s[10 * 33], s[11 * 33]} * WSCALE, a3 = (f32x4){s[12 * 33], s[13 * 33], s[14 * 33], s[15 * 33]} * WSCALE;
        const u32x2 lo = pk8(a0, a1), hi = pk8(a2, a3);
        int dr = drow0 + n; if (PERM16) { const int r = dr & 255; dr = (dr & ~255) + 128 * ((r >> 3) & 1) + 8 * (r >> 4) + (r & 7); }
        *(u32x4*)(WT8 + (size_t)dr * ldt + k0 + 16 * c) = (u32x4){lo.x, lo.y, hi.x, hi.y}; }
    LDS_WAIT(); asm volatile("" ::: "memory");
}
__device__ __forceinline__ void phase_expert_weights(const float* w1, const float* w3, const float* w2, unsigned char* ws, LAS unsigned char* lds, int gw, int NGW, int wave, int lane) {
    LAS float* scr = (LAS float*)(lds + wave * 16896);
    constexpr int PER = 64;
    for (int it = gw; it < NE * 3 * PER; it += NGW) {
        const int e = it / (3 * PER), r = it % (3 * PER), which = r / PER, item = r % PER;
        if (which < 2) { const int kb = item >> 3, nb = item & 7, n0 = 32 * nb;
            transpose_item128_f8<false>((which ? w3 : w1) + (size_t)e * D * EFF, EFF, 128 * kb, n0, ws + B_W13 + (size_t)e * 512 * D, D, 256 * (n0 >> 7) + which * 128 + (n0 & 127), scr, lane); }
        else { const int kb = item >> 5, nb = item & 31;
            transpose_item128_f8<true>(w2 + (size_t)e * EFF * D, D, 128 * kb, 32 * nb, ws + B_W2 + (size_t)e * D * EFF, EFF, 32 * nb, scr, lane); }
    }
}
template <bool XBF>
__device__ __forceinline__ void phase_norm_mod(const void* X, const float* gain, const float* mod, int sh_off, int sc_off, bf16_t* out, unsigned char* out8, int gw, int NGW, int lane) {
    constexpr int R = XBF ? 4 : 8;
    for (int m0 = gw; m0 < T; m0 += R * NGW) {
        f32x4 v[R][4];
#pragma unroll
        for (int rr = 0; rr < R; ++rr) { const int m = m0 + rr * NGW; const size_t mr = (size_t)(m < T ? m : m0);
            if constexpr (XBF) { const u32x2* xr = (const u32x2*)((const bf16_t*)X + mr * D) + lane;
#pragma unroll
                for (int j = 0; j < 4; ++j) { const u32x2 w = xr[64 * j]; v[rr][j] = (f32x4){bflo(w.x), bfhi(w.x), bflo(w.y), bfhi(w.y)}; } }
            else { const f32x4* xr = (const f32x4*)((const float*)X + mr * D) + lane;
#pragma unroll
                for (int j = 0; j < 4; ++j) v[rr][j] = xr[64 * j]; } }
#pragma unroll
        for (int rr = 0; rr < R; ++rr) { const int m = m0 + rr * NGW; if (m >= T) break;
            float ss = 0.f;
#pragma unroll
            for (int j = 0; j < 4; ++j) ss += (v[rr][j].x * v[rr][j].x + v[rr][j].y * v[rr][j].y) + (v[rr][j].z * v[rr][j].z + v[rr][j].w * v[rr][j].w);
            const float rstd = __builtin_amdgcn_rsqf(wave_sum(ss) * (1.f / D) + 1e-6f);
            const float* mb = mod + (size_t)(m >> 13) * 6144;
            u32x2* o8 = (u32x2*)(out + (size_t)m * D) + lane;
#pragma unroll
            for (int j = 0; j < 4; ++j) { const int col = 4 * lane + 256 * j;
                const f32x4 g = *(const f32x4*)(gain + col), sc = *(const f32x4*)(mb + sc_off + col), sh = *(const f32x4*)(mb + sh_off + col);
                const f32x4 y = v[rr][j] * rstd * g * (sc + 1.0f) + sh;
                if (out) { u32x2 w; w.x = pk2(y.x, y.y); w.y = pk2(y.z, y.w); o8[64 * j] = w; }
                if (out8) { int t8 = __builtin_amdgcn_cvt_pk_fp8_f32(y.x, y.y, 0, false); t8 = __builtin_amdgcn_cvt_pk_fp8_f32(y.z, y.w, t8, true); *(unsigned*)(out8 + (size_t)m * D + col) = (unsigned)t8; } } }
    }
}
struct YaArgs { bf16_t* ya; const bf16_t* g; const bf16_t* prw; const float* sbon; const float* mu; const float* ln_g; const float* ln_b; };
__device__ __forceinline__ void phase_ya_final(const YaArgs& P, int gw, int NGW, int lane) {
    const int ch0 = lane * 8, head = lane >> 3;
    float muv[8], lg[8], lb[8];
#pragma unroll
    for (int j = 0; j < 8; ++j) { muv[j] = P.mu[1024 + ch0 + j]; lg[j] = P.ln_g[ch0 + j]; lb[j] = P.ln_b[ch0 + j]; }
    for (int m = gw; m < T; m += NGW) {
        const u32x4 yw = *(const u32x4*)(P.ya + (size_t)m * RW + ch0);
        const u32x4 gw4 = *(const u32x4*)(P.g + (size_t)m * RW + ch0);
        const u32x4 vc = *(const u32x4*)(P.prw + (size_t)m * RWKV_COLS + 1024 + ch0);
        u32x4 vp = (u32x4){0u, 0u, 0u, 0u};
        if ((m & (SEQ - 1)) != 0) vp = *(const u32x4*)(P.prw + (size_t)(m - 1) * RWKV_COLS + 1024 + ch0);
        const float sb = P.sbon[(size_t)m * NH + head];
        float y[8], gg[8], vv[8], pv[8];
        y[0] = bflo(yw.x); y[1] = bfhi(yw.x); y[2] = bflo(yw.y); y[3] = bfhi(yw.y); y[4] = bflo(yw.z); y[5] = bfhi(yw.z); y[6] = bflo(yw.w); y[7] = bfhi(yw.w);
        gg[0] = bflo(gw4.x); gg[1] = bfhi(gw4.x); gg[2] = bflo(gw4.y); gg[3] = bfhi(gw4.y); gg[4] = bflo(gw4.z); gg[5] = bfhi(gw4.z); gg[6] = bflo(gw4.w); gg[7] = bfhi(gw4.w);
        vv[0] = bflo(vc.x); vv[1] = bfhi(vc.x); vv[2] = bflo(vc.y); vv[3] = bfhi(vc.y); vv[4] = bflo(vc.z); vv[5] = bfhi(vc.z); vv[6] = bflo(vc.w); vv[7] = bfhi(vc.w);
        pv[0] = bflo(vp.x); pv[1] = bfhi(vp.x); pv[2] = bflo(vp.y); pv[3] = bfhi(vp.y); pv[4] = bflo(vp.z); pv[5] = bfhi(vp.z); pv[6] = bflo(vp.w); pv[7] = bfhi(vp.w);
        float s = 0.f;
#pragma unroll
        for (int j = 0; j < 8; ++j) s += y[j];
        s += __shfl_xor(s, 1); s += __shfl_xor(s, 2); s += __shfl_xor(s, 4);
        const float mean = s * (1.f / 64.f); float q = 0.f;
#pragma unroll
        for (int j = 0; j < 8; ++j) { y[j] -= mean; q += y[j] * y[j]; }
        q += __shfl_xor(q, 1); q += __shfl_xor(q, 2); q += __shfl_xor(q, 4);
        const float rstd = __builtin_amdgcn_rsqf(q * (1.f / 64.f) + 64e-5f);
        float o[8];
#pragma unroll
        for (int j = 0; j < 8; ++j) { const float vs = vv[j] + (pv[j] - vv[j]) * muv[j]; o[j] = (y[j] * rstd * lg[j] + lb[j] + sb * vs) * gg[j]; }
        u32x4 w; w.x = pk2(o[0], o[1]); w.y = pk2(o[2], o[3]); w.z = pk2(o[4], o[5]); w.w = pk2(o[6], o[7]);
        *(u32x4*)(P.ya + (size_t)m * RW + ch0) = w;
    }
}
__device__ __forceinline__ void phase_xs(const bf16_t* prw, const float* mu, bf16_t* xs, int gw, int NGW, int lane) {
    const f32x4 m4 = *(const f32x4*)(mu + 1536 + 4 * lane);
    for (int t = gw; t < T; t += NGW) {
        const bf16_t* src = prw + (size_t)t * RWKV_COLS + 1536 + 4 * lane;
        const u32x2 cw = *(const u32x2*)src; u32x2 pw = (u32x2){0u, 0u};
        if ((t & (SEQ - 1)) != 0) pw = *(const u32x2*)(src - RWKV_COLS);
        f32x4 v = (f32x4){bflo(cw.x), bfhi(cw.x), bflo(cw.y), bfhi(cw.y)}; const f32x4 p = (f32x4){bflo(pw.x), bfhi(pw.x), bflo(pw.y), bfhi(pw.y)};
        v = v + (p - v) * m4;
        if (lane < 16) {
#pragma unroll
            for (int j = 0; j < 4; ++j) v[j] = tanhf_(v[j]); }
        else if (lane >= 32) {
#pragma unroll
            for (int j = 0; j < 4; ++j) v[j] = sigmoidf_(v[j]); }
        u32x2 w; w.x = pk2(v[0], v[1]); w.y = pk2(v[2], v[3]);
        *(u32x2*)(xs + (size_t)t * 256 + 4 * lane) = w;
    }
}
__device__ __forceinline__ void phase_gate(const bf16_t* xs, const bf16_t* gup, bf16_t* g, int gw, int NGW, int lane) {
    const int r = lane & 15, q = lane >> 4;
    for (int item = gw; item < 8 * 256; item += NGW) {
        const int cb = item & 7, tg = item >> 3;
        bf16x8 af[4][4];
#pragma unroll
        for (int mt = 0; mt < 4; ++mt)
#pragma unroll
            for (int s = 0; s < 4; ++s) af[mt][s] = *(const bf16x8*)(gup + (size_t)(cb * 64 + 16 * mt + r) * 128 + 32 * s + 8 * q);
        bf16x8 nb[4];
#pragma unroll
        for (int s = 0; s < 4; ++s) nb[s] = *(const bf16x8*)(xs + (size_t)(tg * 256 + r) * 256 + 128 + 32 * s + 8 * q);
        for (int tt = 0; tt < 16; ++tt) {
            const int t0 = tg * 256 + tt * 16;
            bf16x8 bfr[4];
#pragma unroll
            for (int s = 0; s < 4; ++s) bfr[s] = nb[s];
            if (tt + 1 < 16) {
#pragma unroll
                for (int s = 0; s < 4; ++s) nb[s] = *(const bf16x8*)(xs + (size_t)(t0 + 16 + r) * 256 + 128 + 32 * s + 8 * q); }
#pragma unroll
            for (int mt = 0; mt < 4; ++mt) { f32x4 acc = (f32x4){0.f, 0.f, 0.f, 0.f};
#pragma unroll
                for (int s = 0; s < 4; ++s) acc = __builtin_amdgcn_mfma_f32_16x16x32_bf16(af[mt][s], bfr[s], acc, 0, 0, 0);
                u32x2 w; w.x = pk2(acc[0], acc[1]); w.y = pk2(acc[2], acc[3]);
                *(u32x2*)(g + (size_t)(t0 + r) * RW + cb * 64 + 16 * mt + 4 * q) = w; }
        }
    }
}
__device__ __forceinline__ void phase_combine(float* out, const bf16_t* x1, const unsigned char* slot, const unsigned char* sho, const float* mod, const float* normf, int gw, int NGW, int lane) {
    for (int m = gw; m < T; m += NGW) {
        const int b = m >> 13;
        f32x4* xr = (f32x4*)(out + (size_t)m * D + 16 * lane);
        const float* g2 = mod + (size_t)b * 6144 + 5120 + 16 * lane;
        u32x4 sw[TOPK + 1];
#pragma unroll
        for (int k = 0; k < TOPK; ++k) sw[k] = *(const u32x4*)(slot + ((size_t)m * TOPK + k) * D + 16 * lane);
        sw[TOPK] = *(const u32x4*)(sho + (size_t)m * D + 16 * lane);
        f32x4 x[4];
        { const u32x4 w0 = *(const u32x4*)(x1 + (size_t)m * D + 16 * lane), w1 = *(const u32x4*)(x1 + (size_t)m * D + 16 * lane + 8);
          x[0] = (f32x4){bflo(w0.x), bfhi(w0.x), bflo(w0.y), bfhi(w0.y)}; x[1] = (f32x4){bflo(w0.z), bfhi(w0.z), bflo(w0.w), bfhi(w0.w)};
          x[2] = (f32x4){bflo(w1.x), bfhi(w1.x), bflo(w1.y), bfhi(w1.y)}; x[3] = (f32x4){bflo(w1.z), bfhi(w1.z), bflo(w1.w), bfhi(w1.w)}; }
        f32x4 a[4];
#pragma unroll
        for (int j = 0; j < 4; ++j) a[j] = (f32x4){0.f, 0.f, 0.f, 0.f};
#pragma unroll
        for (int k = 0; k <= TOPK; ++k) { a[0] += up8(sw[k].x); a[1] += up8(sw[k].y); a[2] += up8(sw[k].z); a[3] += up8(sw[k].w); }
        float ss = 0.f;
#pragma unroll
        for (int j = 0; j < 4; ++j) { x[j] = x[j] + *(const f32x4*)(g2 + 4 * j) * a[j]; ss += (x[j].x * x[j].x + x[j].y * x[j].y) + (x[j].z * x[j].z + x[j].w * x[j].w); }
        const float rstd = __builtin_amdgcn_rsqf(wave_sum(ss) * (1.f / D) + 1e-6f);
#pragma unroll
        for (int j = 0; j < 4; ++j) xr[j] = x[j] * rstd * *(const f32x4*)(normf + 16 * lane + 4 * j);
    }
}
namespace rk {
constexpr int LD = 80;
constexpr int SLOTB = 64 * LD * 2;
constexpr int LDG = 136;
typedef LAS bf16_t* lp;
__device__ __forceinline__ lp slot(LAS unsigned char* lds, int i) { return (lp)(lds + i * SLOTB); }
template <int KS>
__device__ __forceinline__ void mm_nt(const LAS bf16_t* X, int ldx, const LAS bf16_t* Y, int ldy, int m, int nt0, int r, int q, f32x4 (&acc)[2]) {
#pragma unroll
    for (int s = 0; s < KS; ++s) {
        const bf16x8 a = *(const LAS bf16x8*)(X + (16 * m + r) * ldx + 32 * s + 8 * q);
#pragma unroll
        for (int n = 0; n < 2; ++n) { const bf16x8 b = *(const LAS bf16x8*)(Y + (16 * (nt0 + n) + r) * ldy + 32 * s + 8 * q); acc[n] = __builtin_amdgcn_mfma_f32_16x16x32_bf16(a, b, acc[n], 0, 0, 0); }
    }
}
__device__ __forceinline__ void st_rm(lp dst, int m, int nt, int r, int q, const f32x4& a) {
#pragma unroll
    for (int ii = 0; ii < 4; ++ii) dst[(16 * m + 4 * q + ii) * LD + 16 * nt + r] = f2bf(a[ii]);
}
__device__ __forceinline__ void st_tr(lp dst, int m, int nt, int r, int q, const f32x4& a) {
    u32x2 w; w.x = pk2(a[0], a[1]); w.y = pk2(a[2], a[3]); *(LAS u32x2*)(dst + (16 * nt + r) * LD + 16 * m + 4 * q) = w;
}
__device__ __forceinline__ void ld_rm(const LAS bf16_t* src, int m, int nt, int r, int q, f32x4& a) {
#pragma unroll
    for (int ii = 0; ii < 4; ++ii) a[ii] = bf2f(src[(16 * m + 4 * q + ii) * LD + 16 * nt + r]);
}
struct Args {
    const bf16_t* prw; const float* mu; const float *w0, *a0, *k_k, *k_a, *r_k;
    const bf16_t *wup, *aup, *gup;
    const bf16_t* xs;
    bf16_t* g; bf16_t* bv; unsigned char* mn; unsigned char* qy;
};
constexpr int LDS_MU = LDS_MISC + 2304;
struct Pre { u32x4 cw[3], pw[3]; bf16x8 xs[4]; };
__device__ __forceinline__ void task_map(int task, int h, int& i, int& ch, int& col) {
    i = task / 24; ch = task % 24;
    col = (ch >> 3) * 512 + h * 64 + 8 * (ch & 7);
}
__device__ __forceinline__ void load_mu(const Args& P, LAS unsigned char* lds, int tid) {
    LAS bf16_t* MU = (LAS bf16_t*)(lds + LDS_MU);
    for (int i = tid; i < 1536; i += NTHREADS) MU[i] = f2bf(P.mu[i]);
    __syncthreads();
}
struct Hd { bf16x8 w[4], a[4]; float w0[2], a0[2], kk[2], ka[2], rk[2]; };
__device__ __forceinline__ void load_head(const Args& P, int h, int tid, Hd& hd) {
    const int lane = tid & 63, r = lane & 15, q = lane >> 4, nh = tid >> 8;
#pragma unroll
    for (int n = 0; n < 2; ++n) { const int row = h * 64 + 16 * (2 * nh + n) + r;
#pragma unroll
        for (int s = 0; s < 2; ++s) { hd.w[s * 2 + n] = *(const bf16x8*)(P.wup + (size_t)row * 64 + 32 * s + 8 * q); hd.a[s * 2 + n] = *(const bf16x8*)(P.aup + (size_t)row * 64 + 32 * s + 8 * q); }
        hd.w0[n] = P.w0[row]; hd.a0[n] = P.a0[row]; hd.kk[n] = P.k_k[row]; hd.ka[n] = P.k_a[row]; hd.rk[n] = P.r_k[row]; }
}
__device__ __forceinline__ void prefetch(const Args& P, int b, int h, int c, int tid, Pre& pre) {
    const int t0 = b * SEQ + c * 64;
#pragma unroll
    for (int it = 0; it < 3; ++it) {
        int i, ch, col; task_map(tid + it * NTHREADS, h, i, ch, col);
        const bf16_t* src = P.prw + (size_t)(t0 + i) * RWKV_COLS + col;
        pre.cw[it] = *(const u32x4*)src;
        pre.pw[it] = (u32x4){0u, 0u, 0u, 0u};
        if (i != 0 || c != 0) pre.pw[it] = *(const u32x4*)(src - RWKV_COLS);
    }
    const int lane = tid & 63, r = lane & 15, q = lane >> 4, m = (tid >> 6) & 3;
    const bf16_t* xr = P.xs + (size_t)(t0 + 16 * m + r) * 256 + 8 * q;
#pragma unroll
    for (int f = 0; f < 4; ++f) pre.xs[f] = *(const bf16x8*)(xr + 32 * f);
}
__device__ __forceinline__ void unit(const Args& P, LAS unsigned char* lds, int b, int h, int c, int uidx, int tid, Pre& pf, Hd& hd, bool has_next, int nb, int nh_, int nc) {
    const int wave = __builtin_amdgcn_readfirstlane(tid >> 6), lane = tid & 63, r = lane & 15, q = lane >> 4, m = wave & 3, nh = wave >> 2;
    const int t0 = b * SEQ + c * 64;
    lp S0 = slot(lds, 0), S1 = slot(lds, 1), S2 = slot(lds, 2), S3 = slot(lds, 3), S4 = slot(lds, 4), S5 = slot(lds, 5), S6 = slot(lds, 6), S7 = slot(lds, 7);
    lp S8 = slot(lds, 8), S9 = slot(lds, 9), S10 = slot(lds, 10), S11 = slot(lds, 11), S12 = slot(lds, 12), S13 = slot(lds, 13), S14 = slot(lds, 14);
    LAS float* PART = (LAS float*)(lds + LDS_MISC);
    LAS float* CT = PART + 256;
    LAS float* DEND = CT + 256;
    const LAS bf16_t* MU = (const LAS bf16_t*)(lds + LDS_MU);
#define RK_BAR() do { asm volatile("s_waitcnt lgkmcnt(0)" ::: "memory"); __builtin_amdgcn_s_barrier(); asm volatile("" ::: "memory"); } while (0)
#define RK_DBG(bit, sp) do {} while (0)
#pragma unroll
    for (int it = 0; it < 3; ++it) {
        int i, ch, col; task_map(tid + it * NTHREADS, h, i, ch, col);
        LAS bf16_t* dst = slot(lds, 8 + (ch >> 3)) + i * LD + 8 * (ch & 7);
        const u32x4 cw = pf.cw[it], pw = pf.pw[it];
        const u32x4 mw = *(const LAS u32x4*)(MU + col);
        const f32x4 m0 = (f32x4){bflo(mw.x), bfhi(mw.x), bflo(mw.y), bfhi(mw.y)}, m1 = (f32x4){bflo(mw.z), bfhi(mw.z), bflo(mw.w), bfhi(mw.w)};
        float v[8], p[8];
        v[0] = bflo(cw.x); v[1] = bfhi(cw.x); v[2] = bflo(cw.y); v[3] = bfhi(cw.y); v[4] = bflo(cw.z); v[5] = bfhi(cw.z); v[6] = bflo(cw.w); v[7] = bfhi(cw.w);
        p[0] = bflo(pw.x); p[1] = bfhi(pw.x); p[2] = bflo(pw.y); p[3] = bfhi(pw.y); p[4] = bflo(pw.z); p[5] = bfhi(pw.z); p[6] = bflo(pw.w); p[7] = bfhi(pw.w);
#pragma unroll
        for (int j = 0; j < 4; ++j) { v[j] += (p[j] - v[j]) * m0[j]; v[4 + j] += (p[4 + j] - v[4 + j]) * m1[j]; }
        u32x4 w; w.x = pk2(v[0], v[1]); w.y = pk2(v[2], v[3]); w.z = pk2(v[4], v[5]); w.w = pk2(v[6], v[7]);
        *(LAS u32x4*)dst = w;
    }
    RK_BAR();
    f32x4 aw[2], aa[2];
#pragma unroll
    for (int n = 0; n < 2; ++n) { aw[n] = (f32x4){0.f, 0.f, 0.f, 0.f}; aa[n] = aw[n]; }
#pragma unroll
    for (int s = 0; s < 2; ++s)
#pragma unroll
        for (int n = 0; n < 2; ++n) { aw[n] = __builtin_amdgcn_mfma_f32_16x16x32_bf16(pf.xs[s], hd.w[s * 2 + n], aw[n], 0, 0, 0); aa[n] = __builtin_amdgcn_mfma_f32_16x16x32_bf16(pf.xs[2 + s], hd.a[s * 2 + n], aa[n], 0, 0, 0); }
    if (has_next) prefetch(P, nb, nh_, nc, tid, pf);
    float rr[2][4], kq[2][4], vv[2][4], av[2][4], lw[2][4], kp[2][4], pre[2][4], preq[2];
    float ss[4] = {0.f, 0.f, 0.f, 0.f}, bs[4] = {0.f, 0.f, 0.f, 0.f};
#pragma unroll
    for (int n = 0; n < 2; ++n) {
        const int ch = 32 * nh + 16 * n + r, chg = h * 64 + ch;
        const float w0v = hd.w0[n], a0v = hd.a0[n], kkc = hd.kk[n], kac = hd.ka[n], rkc = hd.rk[n];
#pragma unroll
        for (int ii = 0; ii < 4; ++ii) {
            const int pos = 16 * m + 4 * q + ii;
            const float rv = bf2f(S8[pos * LD + ch]), kraw = bf2f(S9[pos * LD + ch]); vv[n][ii] = bf2f(S10[pos * LD + ch]); rr[n][ii] = rv;
            const float z = -(w0v + aw[n][ii]);
            const float sp = fmaxf(z, 0.f) + flog(1.0f + fexp(-fabsf(z)));
            lw[n][ii] = -fexp(-sp - 0.5f);
            const float a_ = sigmoidf_(a0v + aa[n][ii]); av[n][ii] = a_;
            const float kk = kraw * kkc; kq[n][ii] = kk;
            const float kpv = kraw * (1.0f + (a_ - 1.0f) * kac); kp[n][ii] = kpv;
            ss[ii] += kk * kk; bs[ii] += rv * kpv * rkc;
        }
        pre[n][0] = lw[n][0]; pre[n][1] = pre[n][0] + lw[n][1]; pre[n][2] = pre[n][1] + lw[n][2]; pre[n][3] = pre[n][2] + lw[n][3];
        const float tot = pre[n][3];
        const float t0_ = __shfl(tot, r), t1_ = __shfl(tot, r + 16), t2_ = __shfl(tot, r + 32), t3_ = __shfl(tot, r + 48);
        preq[n] = (q > 0 ? t0_ : 0.f) + (q > 1 ? t1_ : 0.f) + (q > 2 ? t2_ : 0.f);
        if (q == 0) CT[m * 64 + ch] = (t0_ + t1_) + (t2_ + t3_);
    }
#pragma unroll
    for (int ii = 0; ii < 4; ++ii) {
#pragma unroll
        for (int o = 1; o < 16; o <<= 1) { ss[ii] += __shfl_xor(ss[ii], o); bs[ii] += __shfl_xor(bs[ii], o); }
        if (r == 0) { const int pos = 16 * m + 4 * q + ii; PART[(nh * 64 + pos) * 2] = ss[ii]; PART[(nh * 64 + pos) * 2 + 1] = bs[ii]; }
    }
    RK_BAR();
#pragma unroll
    for (int n = 0; n < 2; ++n) {
        const int ch = 32 * nh + 16 * n + r;
        float carry = 0.f, lend = 0.f;
#pragma unroll
        for (int mm = 0; mm < 4; ++mm) { const float cv = CT[mm * 64 + ch]; lend += cv; carry += (mm < m) ? cv : 0.f; }
        f32x4 tA, tBh, tKh, tV;
#pragma unroll
        for (int ii = 0; ii < 4; ++ii) {
            const int pos = 16 * m + 4 * q + ii;
            const float L = carry + preq[n] + pre[n][ii], Lm1 = L - lw[n][ii];
            const float ssum = PART[pos * 2] + PART[(64 + pos) * 2];
            const float inv = frcp(fmaxf(__builtin_sqrtf(ssum), 1e-12f));
            const float kkn = kq[n][ii] * inv, kb = kkn * av[n][ii];
            const float eN = fexp(-L), eE = fexp(lend - L);
            const float At = -kkn * fexp(Lm1), Rt = rr[n][ii] * fexp(L), Bt = kb * eN, Kt = kp[n][ii] * eN;
            S0[pos * LD + ch] = f2bf(At); S1[pos * LD + ch] = f2bf(Bt); S2[pos * LD + ch] = f2bf(Kt); S3[pos * LD + ch] = f2bf(Rt);
            tA[ii] = At; tBh[ii] = kb * eE; tKh[ii] = kp[n][ii] * eE; tV[ii] = vv[n][ii];
            P.bv[(size_t)(t0 + pos) * RW + h * 64 + ch] = f2bf((PART[pos * 2 + 1] + PART[(64 + pos) * 2 + 1]) * vv[n][ii]);
        }
        { u32x2 w; const int off = ch * LD + 16 * m + 4 * q;
          w.x = pk2(tA[0], tA[1]); w.y = pk2(tA[2], tA[3]); *(LAS u32x2*)(S4 + off) = w;
          w.x = pk2(tBh[0], tBh[1]); w.y = pk2(tBh[2], tBh[3]); *(LAS u32x2*)(S5 + off) = w;
          w.x = pk2(tKh[0], tKh[1]); w.y = pk2(tKh[2], tKh[3]); *(LAS u32x2*)(S6 + off) = w;
          w.x = pk2(tV[0], tV[1]); w.y = pk2(tV[2], tV[3]); *(LAS u32x2*)(S7 + off) = w; }
        if (m == 0 && q == 0) DEND[ch] = fexp(lend);
    }
    RK_BAR();
    if (has_next) load_head(P, nh_, tid, hd);
    RK_DBG(0, S0); RK_DBG(1, S1); RK_DBG(2, S2); RK_DBG(3, S3); RK_DBG(4, S4); RK_DBG(5, S5); RK_DBG(6, S6); RK_DBG(7, S7);
    const int nt0 = 2 * nh;
    f32x4 acc[2], acc2[2];
#define RK_ZERO(a) do { a[0] = (f32x4){0.f, 0.f, 0.f, 0.f}; a[1] = a[0]; } while (0)
#define RK_LDT(src, mt, ntt, a) do { const u32x2 w_ = *(const LAS u32x2*)((src) + (16 * (ntt) + r) * LD + 16 * (mt) + 4 * q); a = (f32x4){bflo(w_.x), bfhi(w_.x), bflo(w_.y), bfhi(w_.y)}; } while (0)
#define RK_MASK(a, ntt, COND) do { _Pragma("unroll") for (int ii = 0; ii < 4; ++ii) { const int row = 16 * m + 4 * q + ii, col = 16 * (ntt) + r; a[ii] = (COND) ? a[ii] : 0.f; } } while (0)
    RK_ZERO(acc); mm_nt<2>(S0, LD, S1, LD, m, nt0, r, q, acc);
#pragma unroll
    for (int n = 0; n < 2; ++n) { RK_MASK(acc[n], nt0 + n, col < row); st_tr(S9, m, nt0 + n, r, q, acc[n]); }
    RK_ZERO(acc); mm_nt<2>(S1, LD, S0, LD, m, nt0, r, q, acc);
#pragma unroll
    for (int n = 0; n < 2; ++n) { RK_MASK(acc[n], nt0 + n, row < col); st_tr(S8, m, nt0 + n, r, q, acc[n]);
#pragma unroll
        for (int ii = 0; ii < 4; ++ii) acc[n][ii] += ((16 * m + 4 * q + ii) == (16 * (nt0 + n) + r)) ? 1.f : 0.f;
        st_tr(S10, m, nt0 + n, r, q, acc[n]); }
    RK_ZERO(acc); mm_nt<2>(S2, LD, S0, LD, m, nt0, r, q, acc);
#pragma unroll
    for (int n = 0; n < 2; ++n) { RK_MASK(acc[n], nt0 + n, row < col); st_tr(S11, m, nt0 + n, r, q, acc[n]); }
    RK_ZERO(acc); mm_nt<2>(S1, LD, S3, LD, m, nt0, r, q, acc);
#pragma unroll
    for (int n = 0; n < 2; ++n) { RK_MASK(acc[n], nt0 + n, row <= col); st_tr(S12, m, nt0 + n, r, q, acc[n]); }
    RK_ZERO(acc); mm_nt<2>(S2, LD, S3, LD, m, nt0, r, q, acc);
#pragma unroll
    for (int n = 0; n < 2; ++n) { RK_MASK(acc[n], nt0 + n, row <= col); st_tr(S13, m, nt0 + n, r, q, acc[n]); }
    RK_BAR();
    RK_ZERO(acc); mm_nt<2>(S8, LD, S9, LD, m, nt0, r, q, acc);
    RK_ZERO(acc2); mm_nt<2>(S9, LD, S8, LD, m, nt0, r, q, acc2);
#pragma unroll
    for (int n = 0; n < 2; ++n) { st_tr(S1, m, nt0 + n, r, q, acc[n]); st_tr(S0, m, nt0 + n, r, q, acc2[n]); }
    RK_ZERO(acc); mm_nt<2>(S11, LD, S7, LD, m, nt0, r, q, acc);
#pragma unroll
    for (int n = 0; n < 2; ++n) st_tr(S14, m, nt0 + n, r, q, acc[n]);
    RK_BAR();
#define RK_ROUND(Tsrc, Tdst, Psrc, PTsrc, Pdst, PTdst) do { \
        RK_LDT(Tsrc, m, nt0, acc[0]); RK_LDT(Tsrc, m, nt0 + 1, acc[1]); mm_nt<2>(PTsrc, LD, Tsrc, LD, m, nt0, r, q, acc); \
        _Pragma("unroll") for (int n = 0; n < 2; ++n) st_tr(Tdst, m, nt0 + n, r, q, acc[n]); \
        RK_ZERO(acc); mm_nt<2>(Psrc, LD, PTsrc, LD, m, nt0, r, q, acc); RK_ZERO(acc2); mm_nt<2>(PTsrc, LD, Psrc, LD, m, nt0, r, q, acc2); \
        _Pragma("unroll") for (int n = 0; n < 2; ++n) { st_tr(PTdst, m, nt0 + n, r, q, acc[n]); st_tr(Pdst, m, nt0 + n, r, q, acc2[n]); } \
        RK_BAR(); } while (0)
#ifndef EXP_SKIP_ROUNDS
    RK_ROUND(S10, S2, S0, S1, S8, S9);
    RK_ROUND(S2, S10, S8, S9, S0, S1);
    RK_ROUND(S10, S2, S0, S1, S8, S9);
    RK_ROUND(S2, S10, S8, S9, S0, S1);
#endif
    RK_LDT(S10, m, nt0, acc[0]); RK_LDT(S10, m, nt0 + 1, acc[1]); mm_nt<2>(S1, LD, S10, LD, m, nt0, r, q, acc);
#pragma unroll
    for (int n = 0; n < 2; ++n) st_tr(S2, m, nt0 + n, r, q, acc[n]);
    RK_BAR();
    RK_ZERO(acc); mm_nt<2>(S2, LD, S4, LD, m, nt0, r, q, acc);
    RK_ZERO(acc2); mm_nt<2>(S2, LD, S14, LD, m, nt0, r, q, acc2);
#pragma unroll
    for (int n = 0; n < 2; ++n) { st_tr(S11, m, nt0 + n, r, q, acc[n]); st_tr(S0, m, nt0 + n, r, q, acc2[n]); }
    RK_BAR();
    {
        const int sw = wave & 1, ntw = wave >> 1;
        unsigned char* mn_ = P.mn + (size_t)uidx * 16384; unsigned char* qy_ = P.qy + (size_t)uidx * 16384;
        f32x4 c2[2];
#define RK_MM2(X, Y) do { _Pragma("unroll") for (int s_ = 0; s_ < 2; ++s_) { const bf16x8 b_ = *(const LAS bf16x8*)((Y) + (16 * ntw + r) * LD + 32 * s_ + 8 * q); \
            _Pragma("unroll") for (int mi = 0; mi < 2; ++mi) { const bf16x8 a_ = *(const LAS bf16x8*)((X) + (16 * (2 * sw + mi) + r) * LD + 32 * s_ + 8 * q); c2[mi] = __builtin_amdgcn_mfma_f32_16x16x32_bf16(a_, b_, c2[mi], 0, 0, 0); } } } while (0)
        RK_ZERO(c2); RK_MM2(S11, S5);
#pragma unroll
        for (int mi = 0; mi < 2; ++mi)
#pragma unroll
            for (int ii = 0; ii < 4; ++ii) { const int row = 16 * (2 * sw + mi) + 4 * q + ii, col = 16 * ntw + r; c2[mi][ii] += (row == col) ? DEND[row] : 0.f; }
        { u32x4 w; w.x = pk2(c2[0][0], c2[0][1]); w.y = pk2(c2[0][2], c2[0][3]); w.z = pk2(c2[1][0], c2[1][1]); w.w = pk2(c2[1][2], c2[1][3]); *(u32x4*)(mn_ + ((ntw * 2 + sw) * 64 + lane) * 16) = w; }
#pragma unroll
        for (int mi = 0; mi < 2; ++mi) { const u32x2 rw_ = *(const LAS u32x2*)(S3 + (16 * ntw + r) * LD + 16 * (2 * sw + mi) + 4 * q); c2[mi] = (f32x4){bflo(rw_.x), bfhi(rw_.x), bflo(rw_.y), bfhi(rw_.y)}; }
        RK_MM2(S11, S12);
        { u32x4 w; w.x = pk2(c2[0][0], c2[0][1]); w.y = pk2(c2[0][2], c2[0][3]); w.z = pk2(c2[1][0], c2[1][1]); w.w = pk2(c2[1][2], c2[1][3]); *(u32x4*)(qy_ + ((ntw * 2 + sw) * 64 + lane) * 16) = w; }
        RK_ZERO(c2); RK_MM2(S5, S0); RK_MM2(S6, S7);
#pragma unroll
        for (int mi = 0; mi < 2; ++mi) { u32x2 w; w.x = pk2(c2[mi][0], c2[mi][1]); w.y = pk2(c2[mi][2], c2[mi][3]); *(u32x2*)(mn_ + 8192 + ((ntw * 4 + 2 * sw + mi) * 64 + lane) * 8) = w; }
        RK_ZERO(c2); RK_MM2(S0, S12); RK_MM2(S7, S13);
#pragma unroll
        for (int mi = 0; mi < 2; ++mi) { u32x2 w; w.x = pk2(c2[mi][0], c2[mi][1]); w.y = pk2(c2[mi][2], c2[mi][3]); *(u32x2*)(qy_ + 8192 + (((2 * sw + mi) * 4 + ntw) * 64 + lane) * 8) = w; }
#undef RK_MM2
    }
    RK_BAR();
#undef RK_ZERO
#undef RK_ROUND
#undef RK_LDT
#undef RK_MASK
#undef RK_BAR
}
__device__ __forceinline__ void scan_wg(const unsigned char* mn, unsigned char* sbuf, int ubase, int vq, LAS unsigned char* lds, int tid) {
    const int wave = __builtin_amdgcn_readfirstlane(tid >> 6), lane = tid & 63;
    constexpr int NC = SEQ / 64, NS = 8, SLOT = 10240, AHEAD = 6;
    const unsigned char* src = mn + (size_t)ubase * 16384 + lane * 16;
    const bool loader = (wave >= 1 && wave <= 5);
    const size_t poff = (wave == 5) ? (size_t)(8192 + vq * 2048) : (size_t)(2048 * (wave - 1));
#define SC_ISSUE(c) do { const unsigned char* s_ = src + (size_t)(c) * 16384 + poff; LAS unsigned char* d_ = lds + ((c) % NS) * SLOT + 2048 * (wave - 1); \
        _Pragma("unroll") for (int i_ = 0; i_ < 2; ++i_) __builtin_amdgcn_global_load_lds((const unsigned*)(s_ + i_ * 1024), (LAS unsigned*)(d_ + i_ * 1024), 16, 0, 0); } while (0)
#define SC_BAR() do { asm volatile("s_waitcnt lgkmcnt(0)" ::: "memory"); __builtin_amdgcn_s_barrier(); asm volatile("" ::: "memory"); } while (0)
    bf16x8 sB[2];
#pragma unroll
    for (int s = 0; s < 2; ++s) sB[s] = (bf16x8){0, 0, 0, 0, 0, 0, 0, 0};
    if (loader) {
#pragma unroll
        for (int c = 0; c < AHEAD; ++c) SC_ISSUE(c);
        asm volatile("s_waitcnt vmcnt(10)" ::: "memory"); }
    SC_BAR();
    for (int c = 0; c < NC; ++c) {
        if (loader) {
            if (c + AHEAD < NC) { SC_ISSUE(c + AHEAD); asm volatile("s_waitcnt vmcnt(10)" ::: "memory"); }
            else { asm volatile("s_waitcnt vmcnt(0)" ::: "memory"); }
        } else if (wave == 0) {
            const LAS unsigned char* sl = lds + (c % NS) * SLOT;
            unsigned char* so = sbuf + (size_t)(ubase + c) * 8192 + (vq * 2) * 1024 + lane * 16;
            *(bf16x8*)so = sB[0]; *(bf16x8*)(so + 1024) = sB[1];
            f32x4 aS[4];
#pragma unroll
            for (int mm = 0; mm < 4; ++mm) {
                const u32x2 nI = *(const LAS u32x2*)(sl + 8192 + (mm * 64 + lane) * 8);
                aS[mm] = (f32x4){bflo(nI.x), bfhi(nI.x), bflo(nI.y), bfhi(nI.y)};
#pragma unroll
                for (int s = 0; s < 2; ++s) { const bf16x8 aM = *(const LAS bf16x8*)(sl + ((mm * 2 + s) * 64 + lane) * 16); aS[mm] = __builtin_amdgcn_mfma_f32_16x16x32_bf16(aM, sB[s], aS[mm], 0, 0, 0); }
            }
#pragma unroll
            for (int s = 0; s < 2; ++s) { u32x4 w; w.x = pk2(aS[2 * s][0], aS[2 * s][1]); w.y = pk2(aS[2 * s][2], aS[2 * s][3]); w.z = pk2(aS[2 * s + 1][0], aS[2 * s + 1][1]); w.w = pk2(aS[2 * s + 1][2], aS[2 * s + 1][3]);
                sB[s] = __builtin_bit_cast(bf16x8, w); }
        }
        SC_BAR();
    }
#undef SC_ISSUE
#undef SC_BAR
}
struct YArgs { const unsigned char* qy; const unsigned char* sbuf; const bf16_t* g; const bf16_t* bv; const float* ln_g; const float* ln_b; unsigned char* ya; };
__device__ __forceinline__ void ypass_unit(const YArgs& P, int u, int lane) {
    const int r = lane & 15, q = lane >> 4, b = u >> 10, h = (u >> 7) & 7, c = u & 127, t0 = b * SEQ + c * 64;
    const unsigned char* qy_ = P.qy + (size_t)u * 16384; const unsigned char* s_ = P.sbuf + (size_t)u * 8192;
    bf16x8 Qf[4][2], Sf[4][2]; u32x2 y0[4][4];
#pragma unroll
    for (int i = 0; i < 4; ++i)
#pragma unroll
        for (int s = 0; s < 2; ++s) { Qf[i][s] = *(const bf16x8*)(qy_ + ((i * 2 + s) * 64 + lane) * 16); Sf[i][s] = *(const bf16x8*)(s_ + ((i * 2 + s) * 64 + lane) * 16); }
#pragma unroll
    for (int vq = 0; vq < 4; ++vq)
#pragma unroll
        for (int mm = 0; mm < 4; ++mm) y0[vq][mm] = *(const u32x2*)(qy_ + 8192 + ((vq * 4 + mm) * 64 + lane) * 8);
    f32x4 lg[4], lb[4];
#pragma unroll
    for (int vq = 0; vq < 4; ++vq) { lg[vq] = *(const f32x4*)(P.ln_g + h * 64 + 16 * vq + 4 * q); lb[vq] = *(const f32x4*)(P.ln_b + h * 64 + 16 * vq + 4 * q); }
#pragma unroll
    for (int mm = 0; mm < 4; ++mm) {
        const size_t ro = (size_t)(t0 + 16 * mm + r) * RW + h * 64 + 4 * q;
        u32x2 gw_[4], bw_[4];
#pragma unroll
        for (int vq = 0; vq < 4; ++vq) { gw_[vq] = *(const u32x2*)(P.g + ro + 16 * vq); bw_[vq] = *(const u32x2*)(P.bv + ro + 16 * vq); }
        f32x4 acc[4]; float sum = 0.f;
#pragma unroll
        for (int vq = 0; vq < 4; ++vq) {
            acc[vq] = (f32x4){bflo(y0[vq][mm].x), bfhi(y0[vq][mm].x), bflo(y0[vq][mm].y), bfhi(y0[vq][mm].y)};
#pragma unroll
            for (int s = 0; s < 2; ++s) acc[vq] = __builtin_amdgcn_mfma_f32_16x16x32_bf16(Sf[vq][s], Qf[mm][s], acc[vq], 0, 0, 0);
            sum += (acc[vq][0] + acc[vq][1]) + (acc[vq][2] + acc[vq][3]);
        }
        sum += __shfl_xor(sum, 16); sum += __shfl_xor(sum, 32);
        const float mean = sum * (1.f / 64.f); float var = 0.f;
#pragma unroll
        for (int vq = 0; vq < 4; ++vq) { acc[vq] = acc[vq] - mean; var += (acc[vq][0] * acc[vq][0] + acc[vq][1] * acc[vq][1]) + (acc[vq][2] * acc[vq][2] + acc[vq][3] * acc[vq][3]); }
        var += __shfl_xor(var, 16); var += __shfl_xor(var, 32);
        const float rstd = __builtin_amdgcn_rsqf(var * (1.f / 64.f) + 64e-5f);
#pragma unroll
        for (int vq = 0; vq < 4; ++vq) {
            const f32x4 gg = (f32x4){bflo(gw_[vq].x), bfhi(gw_[vq].x), bflo(gw_[vq].y), bfhi(gw_[vq].y)}, bb = (f32x4){bflo(bw_[vq].x), bfhi(bw_[vq].x), bflo(bw_[vq].y), bfhi(bw_[vq].y)};
            const f32x4 o = (acc[vq] * rstd * lg[vq] + lb[vq] + bb) * gg;
            int t8 = __builtin_amdgcn_cvt_pk_fp8_f32(o[0], o[1], 0, false); t8 = __builtin_amdgcn_cvt_pk_fp8_f32(o[2], o[3], t8, true); *(unsigned*)(P.ya + ro + 16 * vq) = (unsigned)t8; }
    }
}
}
namespace gl {
constexpr int LDV = 136;
struct Args { const bf16_t* puv; const bf16_t* wsm; const float* bs; const float* ln_g; const float* ln_b; unsigned char* yb; };
__device__ __forceinline__ void unit(const Args& P, LAS unsigned char* lds, int b, int blk, int tid) {
    const int wave = __builtin_amdgcn_readfirstlane(tid >> 6), lane = tid & 63, r = lane & 15, q = lane >> 4;
    const int t0 = b * SEQ + blk * 128;
    LAS float* STAT = (LAS float*)(lds + LDS_MISC);
#pragma unroll
    for (int hb = 0; hb < 2; ++hb) {
        u32x4 w[8];
#pragma unroll
        for (int j = 0; j < 8; ++j) w[j] = *(const u32x4*)(P.puv + (size_t)(t0 + 16 * wave + 8 * hb + j) * 1024 + 512 + 8 * lane);
#pragma unroll
        for (int j = 0; j < 8; ++j) {
            float v[8]; v[0] = bflo(w[j].x); v[1] = bfhi(w[j].x); v[2] = bflo(w[j].y); v[3] = bfhi(w[j].y); v[4] = bflo(w[j].z); v[5] = bfhi(w[j].z); v[6] = bflo(w[j].w); v[7] = bfhi(w[j].w);
            float s = 0.f, s2 = 0.f;
#pragma unroll
            for (int e = 0; e < 8; ++e) { s += v[e]; s2 += v[e] * v[e]; }
            s = wave_sum(s); s2 = wave_sum(s2);
            const float mean = s * (1.f / 512.f), var = fmaxf(s2 * (1.f / 512.f) - mean * mean, 0.f);
            if (lane == 0) { const int tk = 16 * wave + 8 * hb + j; STAT[tk * 2] = mean; STAT[tk * 2 + 1] = __builtin_amdgcn_rsqf(var + 1e-5f); }
        }
    }
    u32x4 pv[2], pu[2];
#define GL_LOAD(g) do { _Pragma("unroll") for (int it = 0; it < 2; ++it) { const int task = tid + it * NTHREADS, j = task >> 3, cc = task & 7; \
        const bf16_t* row = P.puv + (size_t)(t0 + j) * 1024 + (g) * 64 + 8 * cc; pu[it] = *(const u32x4*)row; pv[it] = *(const u32x4*)(row + 512); } } while (0)
    GL_LOAD(0);
    __syncthreads();
    for (int g = 0; g < 8; ++g) {
        LAS bf16_t* VT = (LAS bf16_t*)(lds + (g & 1) * 20480);
        LAS bf16_t* US = (LAS bf16_t*)(lds + 40960 + (g & 1) * 18432);
#pragma unroll
        for (int it = 0; it < 2; ++it) {
            const int task = tid + it * NTHREADS, j = task >> 3, cc = task & 7, ch = g * 64 + 8 * cc;
            const u32x4 w = pv[it];
            const float mean = STAT[j * 2], rstd = STAT[j * 2 + 1];
            const f32x4 g0 = *(const f32x4*)(P.ln_g + ch), g1 = *(const f32x4*)(P.ln_g + ch + 4), b0 = *(const f32x4*)(P.ln_b + ch), b1 = *(const f32x4*)(P.ln_b + ch + 4);
            float v[8]; v[0] = bflo(w.x); v[1] = bfhi(w.x); v[2] = bflo(w.y); v[3] = bfhi(w.y); v[4] = bflo(w.z); v[5] = bfhi(w.z); v[6] = bflo(w.w); v[7] = bfhi(w.w);
#pragma unroll
            for (int e = 0; e < 4; ++e) { v[e] = (v[e] - mean) * rstd * g0[e] + b0[e]; v[4 + e] = (v[4 + e] - mean) * rstd * g1[e] + b1[e]; }
#pragma unroll
            for (int e = 0; e < 8; ++e) VT[(8 * cc + e) * LDV + j] = f2bf(v[e]);
            *(LAS u32x4*)(US + j * 72 + 8 * cc) = pu[it];
        }
        if (g + 1 < 8) GL_LOAD(g + 1);
        __syncthreads();
        f32x4 acc[4];
#pragma unroll
        for (int n = 0; n < 4; ++n) acc[n] = (f32x4){0.f, 0.f, 0.f, 0.f};
        const bf16_t* wrow = P.wsm + ((size_t)g * 128 + 16 * wave + r) * 128 + 8 * q;
        const int ks = (wave >> 1) + 1;
        for (int s = 0; s < ks; ++s) {
            const bf16x8 a = *(const bf16x8*)(wrow + 32 * s);
#pragma unroll
            for (int n = 0; n < 4; ++n) { const bf16x8 bb = *(const LAS bf16x8*)(VT + (16 * n + r) * LDV + 32 * s + 8 * q); acc[n] = __builtin_amdgcn_mfma_f32_16x16x32_bf16(a, bb, acc[n], 0, 0, 0); }
        }
#pragma unroll
        for (int ii = 0; ii < 4; ++ii) { const int i = 16 * wave + 4 * q + ii; const float bias = P.bs[g * 128 + i];
#pragma unroll
            for (int n = 0; n < 4; ++n) { const int c = 16 * n + r; const float u = bf2f(US[i * 72 + c]);
                P.yb[(size_t)(t0 + i) * RW + g * 64 + c] = (unsigned char)(__builtin_amdgcn_cvt_pk_fp8_f32(u * (acc[n][ii] + bias), 0.f, 0, false) & 0xff); } }
    }
    __syncthreads();
#undef GL_LOAD
}
}

struct RouteArgs { const float* sc; const float* bias; int* eidx; float* ewt; int* lrank; int* tbase; unsigned* segcnt; };
template <int CTRL> __device__ __forceinline__ float dppf(float v) { return __builtin_bit_cast(float, __builtin_amdgcn_update_dpp(0, __builtin_bit_cast(int, v), CTRL, 0xf, 0xf, true)); }
constexpr int DPP_X1 = 0xB1, DPP_X2 = 0x4E, DPP_HM = 0x141, DPP_RM = 0x140;
__device__ __forceinline__ unsigned fkey(float v) { const unsigned b = __float_as_uint(v); return b ^ ((b >> 31) ? 0xFFFFFFFFu : 0x80000000u); }
__device__ __forceinline__ void topk_tile(const RouteArgs& P, LAS unsigned char* lds, int tid, int tile) {
    const int wave = __builtin_amdgcn_readfirstlane(tid >> 6), lane = tid & 63, grp = lane >> 3;
    LAS int* hist = (LAS int*)(lds + LDS_MISC);
    const f32x4 bias4 = *(const f32x4*)(P.bias + 4 * lane);
    if (tid < NE) hist[tid] = 0;
    __syncthreads();
    f32x4 nx[2];
#pragma unroll
    for (int u = 0; u < 2; ++u) nx[u] = *(const f32x4*)(P.sc + (size_t)(tile * 256 + wave * 32 + u) * NE + 4 * lane);
    for (int j = 0; j < 32; j += 2) {
        const int t0 = tile * 256 + wave * 32 + j;
        const f32x4 cur4[2] = {nx[0], nx[1]};
        if (j + 2 < 32) {
#pragma unroll
            for (int u = 0; u < 2; ++u) nx[u] = *(const f32x4*)(P.sc + (size_t)(t0 + 2 + u) * NE + 4 * lane); }
        float s[2][4]; unsigned key[2][4];
#pragma unroll
        for (int u = 0; u < 2; ++u) {
            float v[4];
#pragma unroll
            for (int e = 0; e < 4; ++e) { s[u][e] = cur4[u][e]; v[e] = s[u][e] + bias4[e]; }
            float m1, m2;
            { const float a = fmaxf(v[0], v[1]), b = fminf(v[0], v[1]), c = fmaxf(v[2], v[3]), d = fminf(v[2], v[3]); m1 = fmaxf(a, c); m2 = fmaxf(fminf(a, c), fmaxf(b, d)); }
            { float o1 = dppf<DPP_X1>(m1), o2 = dppf<DPP_X1>(m2); float n1 = fmaxf(m1, o1), n2 = fmaxf(fminf(m1, o1), fmaxf(m2, o2)); m1 = n1; m2 = n2;
              o1 = dppf<DPP_X2>(m1); o2 = dppf<DPP_X2>(m2); n1 = fmaxf(m1, o1); n2 = fmaxf(fminf(m1, o1), fmaxf(m2, o2)); m1 = n1; m2 = n2;
              o1 = dppf<DPP_HM>(m1); o2 = dppf<DPP_HM>(m2); n1 = fmaxf(m1, o1); n2 = fmaxf(fminf(m1, o1), fmaxf(m2, o2)); m1 = n1; m2 = n2; }
            const float gs = m1 + m2;
            int cnt = 0;
#pragma unroll
            for (int g = 0; g < 8; ++g) { const float og = __builtin_bit_cast(float, __builtin_amdgcn_readlane(__builtin_bit_cast(int, gs), 8 * g)); cnt += (og > gs || (og == gs && g < grp)) ? 1 : 0; }
#pragma unroll
            for (int e = 0; e < 4; ++e) key[u][e] = (cnt < 4) ? fkey(v[e]) : 0u;
        }
        unsigned thr[2] = {0u, 0u};
#pragma unroll 1
        for (int bit = 31; bit >= 0; --bit) {
#pragma unroll
            for (int u = 0; u < 2; ++u) { const unsigned cand = thr[u] | (1u << bit); int c = 0;
#pragma unroll
                for (int e = 0; e < 4; ++e) c += __builtin_popcountll(__ballot(key[u][e] >= cand));
                thr[u] = (c >= TOPK) ? cand : thr[u]; }
        }
#pragma unroll
        for (int u = 0; u < 2; ++u) {
            const int t = t0 + u;
            bool sel[4]; unsigned long long meq[4]; int cgt = 0;
#pragma unroll
            for (int e = 0; e < 4; ++e) { sel[e] = key[u][e] > thr[u]; cgt += __builtin_popcountll(__ballot(sel[e])); meq[e] = __ballot(key[u][e] == thr[u]); }
            for (int need = TOPK - cgt; need > 0; --need) {
                const unsigned long long many = meq[0] | meq[1] | meq[2] | meq[3];
                const int L = __builtin_ctzll(many);
                const int e_ = ((meq[0] >> L) & 1ull) ? 0 : ((meq[1] >> L) & 1ull) ? 1 : ((meq[2] >> L) & 1ull) ? 2 : 3;
#pragma unroll
                for (int e = 0; e < 4; ++e) { if (e == e_) { meq[e] &= ~(1ull << L); sel[e] = sel[e] || (lane == L); } }
            }
            float part = 0.f;
#pragma unroll
            for (int e = 0; e < 4; ++e) part += sel[e] ? s[u][e] : 0.f;
            part += dppf<DPP_X1>(part); part += dppf<DPP_X2>(part); part += dppf<DPP_HM>(part); part += dppf<DPP_RM>(part);
            const float ssum = (__builtin_bit_cast(float, __builtin_amdgcn_readlane(__builtin_bit_cast(int, part), 0)) + __builtin_bit_cast(float, __builtin_amdgcn_readlane(__builtin_bit_cast(int, part), 16)))
                             + (__builtin_bit_cast(float, __builtin_amdgcn_readlane(__builtin_bit_cast(int, part), 32)) + __builtin_bit_cast(float, __builtin_amdgcn_readlane(__builtin_bit_cast(int, part), 48)));
            const float scale = 2.5f / ssum;
            int base = 0;
#pragma unroll
            for (int e = 0; e < 4; ++e) { const unsigned long long ms = __ballot(sel[e]);
                if (sel[e]) { const int k = base + __builtin_amdgcn_mbcnt_hi((unsigned)(ms >> 32), __builtin_amdgcn_mbcnt_lo((unsigned)ms, 0)); const int idx = 4 * lane + e;
                    const int lr = __hip_atomic_fetch_add(hist + idx, 1, __ATOMIC_RELAXED, __HIP_MEMORY_SCOPE_WORKGROUP);
                    P.eidx[(size_t)t * TOPK + k] = idx; P.ewt[(size_t)t * TOPK + k] = s[u][e] * scale; P.lrank[(size_t)t * TOPK + k] = lr; }
                base += __builtin_popcountll(ms); }
        }
    }
    __syncthreads();
    if (tid < NE) { const int cnt = hist[tid]; unsigned base = 0u;
        if (cnt) base = __hip_atomic_fetch_add(P.segcnt + tid, (unsigned)cnt, __ATOMIC_RELAXED, __HIP_MEMORY_SCOPE_AGENT);
        P.tbase[tile * NE + tid] = (int)base; }
    __syncthreads();
}
struct ScatArgs { const int* eidx; const float* ewt; const int* lrank; const int* tbase; const unsigned* segcnt; int* rowtok; int* rowdst; float* roww; int* tab; unsigned* ntile; };
__device__ __forceinline__ void phase_scatter(const ScatArgs& P, LAS unsigned char* lds, int tid, int G) {
    LAS int* cntL = (LAS int*)(lds + LDS_MISC); LAS int* segst = cntL + 256; LAS int* tsa = segst + 256;
    if (tid < NE) cntL[tid] = (int)__hip_atomic_load(P.segcnt + tid, __ATOMIC_RELAXED, __HIP_MEMORY_SCOPE_AGENT);
    __syncthreads();
    if (tid == 0) {
        int run = 0, ta = 0;
        for (int s = 0; s < NE; ++s) { const int nts = (cntL[s] + 255) >> 8; segst[s] = run; tsa[s] = ta; run += nts * 256; ta += nts; }
        if (blockIdx.x == 0) P.ntile[0] = (unsigned)ta;
    }
    __syncthreads();
    for (int tile = blockIdx.x; tile < T / 256; tile += G) {
        for (int a = tid; a < 256 * TOPK; a += NTHREADS) {
            const int tok = tile * 256 + (a >> 3), k = a & 7; const size_t ai = (size_t)tok * TOPK + k;
            const int e = P.eidx[ai];
            const int pos = segst[e] + P.tbase[tile * NE + e] + P.lrank[ai];
            P.rowtok[pos] = tok; P.rowdst[pos] = tok * TOPK + k; P.roww[pos] = P.ewt[ai];
        }
    }
    for (int s = blockIdx.x; s < NE; s += G) {
        const int st = segst[s], cnt = cntL[s], nts = (cnt + 255) >> 8;
        for (int p = st + cnt + tid; p < st + nts * 256; p += NTHREADS) { P.rowtok[p] = 0; P.rowdst[p] = -1; P.roww[p] = 0.f; }
        if (tid < nts) { int* ta_ = P.tab + 2 * (tsa[s] + tid); ta_[0] = st + 256 * tid; ta_[1] = s; }
    }
}
constexpr int NPHASE = 20;
struct KArgs { const float* in[34]; float* out; unsigned char* ws; int ph_lo, ph_hi; };
template <int PLO, int PHI>
__global__ void __launch_bounds__(NTHREADS, 2) fwd_kernel(KArgs a) {
    extern __shared__ __attribute__((aligned(16))) unsigned char lds_raw[];
    LAS unsigned char* lds = (LAS unsigned char*)lds_raw;
    const int G = gridDim.x, bid = blockIdx.x, NGW = G * NWAVES;
#define PH_IDS() int tid = threadIdx.x; asm volatile("" : "+v"(tid)); const int lane = tid & 63, wave = __builtin_amdgcn_readfirstlane(tid >> 6), gw = bid * NWAVES + wave; (void)lane; (void)wave; (void)gw
    unsigned char* ws = a.ws;
    unsigned* ctl = (unsigned*)(ws + WS_CTL);
    float* mod = (float*)(ws + WS_MOD);
    constexpr int lo = PLO, hi = PHI;
    if (threadIdx.x == 0) *(LAS u32x4*)(lds + LDS_BARW) = (u32x4){0u, 0u, 0u, 0u};
    __syncthreads();
    XcdBarrier bar; bar.bar = ctl + CW_BAR; bar.x = 0; bar.st = nullptr;
    if (hi - lo > 1) bar = xcd_barrier_post(ctl + CW_BAR, (volatile LAS unsigned*)(lds + LDS_BARW));
#define IN(k) (lo <= (k) && (k) < hi)
#ifdef DBG_TIME
#define STAMP(k) do { if (blockIdx.x == 0 && threadIdx.x == 0) ((unsigned long long*)(ctl + 5200))[k] = __builtin_amdgcn_s_memrealtime(); } while (0)
#else
#define STAMP(k) do {} while (0)
#endif
#define SEAM(k) do { if (IN(k) && IN((k) + 1)) xcd_barrier(bar); } while (0)
#ifndef DBG_REPEAT
#define DBG_REPEAT (-1)
#define DBG_NREP 0
#endif
#define REP(k) for (int rep_ = 0; rep_ < (((k) == DBG_REPEAT) ? 1 + DBG_NREP : 1); ++rep_, (((k) == DBG_REPEAT && rep_ <= DBG_NREP) ? xcd_barrier(bar) : (void)0))

    STAMP(0);
    if (IN(0)) REP(0) { PH_IDS();
        phase_mod(a.in[1], a.in[2], a.in[3], mod, lds, tid, G);
    }
    SEAM(0); STAMP(1);
    if (IN(1)) REP(1) { PH_IDS();
        SmallW sw{a.in[6], a.in[22], a.in[23], a.in[24], a.in[25], a.in[30], a.in[31], a.in[32], a.in[9], a.in[11], a.in[12], a.in[20]};
        phase_small_weights(sw, ws, lds, gw, NGW, wave, lane);
        phase_norm_mod<false>(a.in[0], a.in[4], mod, 0, 1024, nullptr, ws + B_H1, gw, NGW, lane);
    }
    SEAM(1); STAMP(2);
    if (IN(2)) REP(2) {
        gm::DenseSched S; S.init(ws + B_H1, ws + SW_WIN, T, IN_COLS, D, G, bid, 1);
        gm::EpiInProj E{(bf16_t*)(ws + B_PRW), (bf16_t*)(ws + B_PUV), (bf16_t*)(ws + B_PG)};
        gm::gemm_phase<gm::EpiInProj, gm::DenseSched, true, true, 122>(lds, D, S, E);
    }
    SEAM(2); STAMP(3);
    if (IN(3)) REP(3) { PH_IDS();
        gl::Args Q{(const bf16_t*)(ws + B_PUV), (const bf16_t*)(ws + SW_WSM), a.in[21], a.in[18], a.in[19], ws + B_YB};
        for (int u = bid; u < 512; u += G) gl::unit(Q, lds, u >> 6, u & 63, tid);
        phase_xs((const bf16_t*)(ws + B_PRW), a.in[7], (bf16_t*)(ws + B_XS), gw, NGW, lane);
    }
    SEAM(3); STAMP(4);
    if (IN(4)) REP(4) { PH_IDS();
        rk::Args P{(const bf16_t*)(ws + B_PRW), a.in[7], a.in[8], a.in[10], a.in[13], a.in[14], a.in[15], (const bf16_t*)(ws + SW_WUP), (const bf16_t*)(ws + SW_AUP), (const bf16_t*)(ws + SW_GUP), (const bf16_t*)(ws + B_XS),
                   (bf16_t*)(ws + B_G), (bf16_t*)(ws + B_BV), ws + B_MN, ws + B_QY};
        phase_gate((const bf16_t*)(ws + B_XS), (const bf16_t*)(ws + SW_GUP), (bf16_t*)(ws + B_G), gw, NGW, lane);
        rk::Pre pre; rk::Hd hd; rk::load_mu(P, lds, tid);
        const bool fixh = (G % 8) == 0; const int nper = fixh ? (G >> 3) : G, first = fixh ? (bid >> 3) : bid, lim = fixh ? 1024 : 8192;
#define RK_UNIT_OF(idx, B_, H_, C_) const int B_ = fixh ? ((idx) >> 7) : ((idx) >> 10), H_ = fixh ? (bid & 7) : (((idx) >> 7) & 7), C_ = (idx) & 127
        if (first < lim) { RK_UNIT_OF(first, b0_, h0_, c0_); rk::prefetch(P, b0_, h0_, c0_, tid, pre); rk::load_head(P, h0_, tid, hd); }
        for (int idx = first; idx < lim; idx += nper) { const int nx = idx + nper; RK_UNIT_OF(idx, b_, h_, c_); RK_UNIT_OF(nx < lim ? nx : idx, nb_, nh__, nc_);
            rk::unit(P, lds, b_, h_, c_, (b_ * 8 + h_) * 128 + c_, tid, pre, hd, nx < lim, nb_, nh__, nc_); }
#undef RK_UNIT_OF
    }
    SEAM(4); STAMP(5);
    if (IN(5)) REP(5) { PH_IDS();
        for (int w = bid; w < 256; w += G) rk::scan_wg(ws + B_MN, ws + B_S, ((w & 7) + 8 * (w >> 5)) * 128, (w >> 3) & 3, lds, tid);
    }
    SEAM(5); STAMP(6);
    if (IN(6)) REP(6) { PH_IDS();
        rk::YArgs Y{ws + B_QY, ws + B_S, (const bf16_t*)(ws + B_G), (const bf16_t*)(ws + B_BV), a.in[16], a.in[17], ws + B_YA};
        for (int u = gw; u < 8192; u += NGW) rk::ypass_unit(Y, u, lane);
    }
    SEAM(6); STAMP(7);
    STAMP(8);
    if (IN(8)) REP(8) {
        gm::DenseSched S; S.init(ws + B_YA, ws + SW_WOA, T, D, RW, G, bid, 1);
        gm::EpiMerge<false> E{(bf16_t*)(ws + B_M1), (const bf16_t*)(ws + B_PG), nullptr};
        gm::gemm_phase<gm::EpiMerge<false>, gm::DenseSched, true, true, 122>(lds, RW, S, E);
    }
    STAMP(9);
    if (IN(9)) {
        gm::DenseSched S; S.init(ws + B_YB, ws + SW_WOB, T, D, RW, G, bid, 1);
        gm::EpiMerge<true> E{(bf16_t*)(ws + B_M1), (const bf16_t*)(ws + B_PG), ws + B_M8};
        gm::gemm_phase<gm::EpiMerge<true>, gm::DenseSched, true, true, 122>(lds, RW, S, E);
    }
    SEAM(9); STAMP(10);
    if (IN(10)) REP(10) {
        gm::DenseSched S; S.init(ws + B_M8, ws + SW_WO, T, D, D, G, bid, 1);
        gm::EpiResid E{(bf16_t*)(ws + B_X1), a.in[0], mod + 2048};
        gm::gemm_phase<gm::EpiResid, gm::DenseSched, true, true, 122>(lds, D, S, E);
    }
    SEAM(10); STAMP(11);
    if (IN(11)) REP(11) { PH_IDS();
        phase_norm_mod<true>(ws + B_X1, a.in[5], mod, 3072, 4096, (bf16_t*)(ws + B_H2), ws + B_H2F8, gw, NGW, lane);
        phase_expert_weights(a.in[27], a.in[28], a.in[29], ws, lds, gw, NGW, wave, lane);
    }
    SEAM(11); STAMP(12);
    if (IN(12)) { PH_IDS();
        RouteArgs R{(const float*)(ws + B_SC), a.in[26], (int*)(ws + RT_EIDX), (float*)(ws + RT_EWT), (int*)(ws + RT_LRANK), (int*)(ws + RT_TBASE), ctl + CW_SEGCNT};
        { gm::DenseSched S; S.init(ws + B_H2, ws + SW_WR, T, NE, D, G, bid); gm::EpiRouter E{(float*)(ws + B_SC)}; gm::gemm_phase<gm::EpiRouter, gm::DenseSched, true>(lds, D, S, E);
          gm::Unit u; for (int i = 0; S.next(i, u); ++i) topk_tile(R, lds, tid, u.pm); }
        { gm::DenseSched S; S.init(ws + B_H2F8, ws + SW_WS13, T, 512, D, G, bid, 1); gm::EpiGateUp<true> E{ws + B_SH}; gm::gemm_phase<gm::EpiGateUp<true>, gm::DenseSched, true, true, 122>(lds, D, S, E); }
    }
    SEAM(12); STAMP(13);
    if (IN(13)) { PH_IDS();
        ScatArgs P{(const int*)(ws + RT_EIDX), (const float*)(ws + RT_EWT), (const int*)(ws + RT_LRANK), (const int*)(ws + RT_TBASE), ctl + CW_SEGCNT,
                   (int*)(ws + RT_ROWTOK), (int*)(ws + RT_ROWDST), (float*)(ws + RT_ROWW), (int*)(ws + RT_TAB), ctl + CW_NT};
        phase_scatter(P, lds, tid, G);
        __syncthreads();
        gm::DenseSched S; S.init(ws + B_SH, ws + SW_WS2, T, D, EFF, G, bid, 1);
        gm::EpiSharedDown E{ws + B_SHO};
        gm::gemm_phase<gm::EpiSharedDown, gm::DenseSched, true, true, 122>(lds, EFF, S, E);
    }
    SEAM(13); STAMP(14); STAMP(15);
    if (IN(15)) REP(15) {
        gm::GroupSched<true> S; S.A = (const char*)(ws + B_H2F8); S.B = (const char*)(ws + B_W13); S.tab = (const int*)(ws + RT_TAB); S.rowtok = (const int*)(ws + RT_ROWTOK);
        S.ntiles = (int)__hip_atomic_load(ctl + CW_NT, __ATOMIC_RELAXED, __HIP_MEMORY_SCOPE_AGENT); S.npn = 2; S.G = G; S.c = bid; S.K = D; S.ebytes = (size_t)512 * D; S.tstep = (size_t)256 * D;
        gm::EpiGateUp<true> E{ws + B_HID};
        gm::gemm_phase<gm::EpiGateUp<true>, gm::GroupSched<true>, true, true, 122>(lds, D, S, E);
    }
    SEAM(15); STAMP(16);
    if (IN(16)) REP(16) {
        gm::GroupSched<false> S; S.A = (const char*)(ws + B_HID); S.B = (const char*)(ws + B_W2); S.tab = (const int*)(ws + RT_TAB); S.rowtok = nullptr;
        S.ntiles = (int)__hip_atomic_load(ctl + CW_NT, __ATOMIC_RELAXED, __HIP_MEMORY_SCOPE_AGENT); S.npn = 4; S.G = G; S.c = bid; S.K = EFF; S.ebytes = (size_t)D * EFF; S.tstep = (size_t)256 * EFF;
        gm::EpiExpertDown E{ws + B_SLOT, (const int*)(ws + RT_ROWDST), (const float*)(ws + RT_ROWW)};
        gm::gemm_phase<gm::EpiExpertDown, gm::GroupSched<false>, true, true, 122>(lds, EFF, S, E);
    }
    SEAM(16); STAMP(17);
    if (IN(17)) { PH_IDS(); phase_combine(a.out, (const bf16_t*)(ws + B_X1), ws + B_SLOT, ws + B_SHO, mod, a.in[33], gw, NGW, lane); }
    STAMP(18); STAMP(19);
    __syncthreads(); STAMP(20);
#undef IN
#undef SEAM
}

#if defined(DBG_CHECK) || defined(DBG_TIME)
#ifdef DBG_TIME
#ifndef TSC
#define TSC 0.25f
#endif
__global__ void dbg_time_out(float* out, const unsigned long long* st) {
    if (threadIdx.x == 0 && blockIdx.x == 0) { out[0] = (float)(st[TA1] - st[TA0]) * 0.01f * TSC; out[1] = (float)(st[TB1] - st[TB0]) * 0.01f * TSC; }
}
static void dbg_run(void* d_out, void* d_ws, hipStream_t stream) {
    dbg_time_out<<<1, 64, 0, stream>>>((float*)d_out, (const unsigned long long*)((unsigned*)((unsigned char*)d_ws + WS_CTL) + 5200));
}
#endif
#endif
#ifndef MK_SINGLE
#define MK_SINGLE 0
#endif
template <int PLO, int PHI> static bool prep_kernel() {
    int per_cu = 0;
    if (hipFuncSetAttribute((const void*)fwd_kernel<PLO, PHI>, hipFuncAttributeMaxDynamicSharedMemorySize, LDS_BYTES) != hipSuccess) { fprintf(stderr, "kernel_launch: hipFuncSetAttribute failed\n"); return false; }
    if (hipOccupancyMaxActiveBlocksPerMultiprocessor(&per_cu, (const void*)fwd_kernel<PLO, PHI>, NTHREADS, LDS_BYTES) != hipSuccess || per_cu < 1) { fprintf(stderr, "kernel_launch: occupancy query says %d\n", per_cu); (void)hipGetLastError(); return false; }
    return true;
}
template <int P> struct PhaseLaunch {
    static bool prep() { return prep_kernel<P, P + 1>() && PhaseLaunch<P + 1>::prep(); }
    static void go(int grid, hipStream_t stream, const KArgs& a) { hipLaunchKernelGGL((fwd_kernel<P, P + 1>), dim3(grid), dim3(NTHREADS), LDS_BYTES, stream, a); PhaseLaunch<P + 1>::go(grid, stream, a); }
};
#ifndef DBG_LAST
#define DBG_LAST NPHASE
#endif
template <> struct PhaseLaunch<DBG_LAST> { static bool prep() { return true; } static void go(int, hipStream_t, const KArgs&) {} };
extern "C" void kernel_launch(void* const* d_in, const int* in_sizes, int n_in, void* d_out, int out_size, void* d_ws, size_t ws_size, hipStream_t stream) {
    static int grid = 0;
    if (grid == 0) {
        if (n_in != 34 || out_size != T * D || ws_size < WS_END) { fprintf(stderr, "kernel_launch: unexpected problem shape (n_in %d, out %d, ws %zu < %zu)\n", n_in, out_size, ws_size, (size_t)WS_END); grid = -1; return; }
        int dev = 0, cus = 0;
        if (hipGetDevice(&dev) != hipSuccess || hipDeviceGetAttribute(&cus, hipDeviceAttributeMultiprocessorCount, dev) != hipSuccess) { grid = -1; return; }
#if MK_SINGLE
        if (!prep_kernel<0, NPHASE>()) { grid = -1; return; }
#else
        if (!PhaseLaunch<0>::prep()) { grid = -1; return; }
#endif
        grid = cus;
    }
    if (grid < 0) return;
    (void)hipMemsetAsync((char*)d_ws + WS_CTL, 0, CTL_ZERO_BYTES, stream);
    KArgs a{};
    for (int i = 0; i < 34; ++i) a.in[i] = (const float*)d_in[i];
    a.out = (float*)d_out; a.ws = (unsigned char*)d_ws; a.ph_lo = 0; a.ph_hi = NPHASE;
#if MK_SINGLE
    hipLaunchKernelGGL((fwd_kernel<0, NPHASE>), dim3(grid), dim3(NTHREADS), LDS_BYTES, stream, a);
#else
    PhaseLaunch<0>::go(grid, stream, a);
#endif
#if defined(DBG_CHECK) || defined(DBG_TIME)
    dbg_run(d_out, d_ws, stream);
#endif
}
```

```cpp
#define MK_SINGLE 1
#include <hip/hip_runtime.h>
#include <cstdio>
#include <cstdint>

#define LAS __attribute__((address_space(3)))
#define GAS __attribute__((address_space(1)))
typedef unsigned short bf16_t;
typedef short bf16x8 __attribute__((ext_vector_type(8)));
typedef float f32x4 __attribute__((ext_vector_type(4)));
typedef float f32x2 __attribute__((ext_vector_type(2)));
typedef unsigned u32x4 __attribute__((ext_vector_type(4)));
typedef unsigned u32x2 __attribute__((ext_vector_type(2)));

constexpr int D = 1024, NB = 8, SEQ = 8192, T = NB * SEQ;
constexpr int RW = 512, HD = 64, NH = 8;
constexpr int RWKV_COLS = 1792, IN_COLS = 4864;
constexpr int NE = 256, TOPK = 8, EFF = 256;
constexpr int NWAVES = 8, NTHREADS = 512;
constexpr int MAXROWS = T * TOPK + 256 * 256;

constexpr size_t MiB = 1u << 20;
constexpr size_t WS_CTL = 0;
constexpr int CW_BAR = 0, CW_SEGCNT = 4096, CW_NT = 4608;
constexpr size_t CTL_ZERO_BYTES = 32768;
constexpr size_t WS_MOD = 65536;
constexpr size_t WS_SW = 1 * MiB;
constexpr size_t SW_WIN = WS_SW;
constexpr size_t SW_WOA = SW_WIN + (size_t)IN_COLS * D * 2;
constexpr size_t SW_WOB = SW_WOA + (size_t)D * RW * 2;
constexpr size_t SW_WO = SW_WOB + (size_t)D * RW * 2;
constexpr size_t SW_WR = SW_WO + (size_t)D * D * 2;
constexpr size_t SW_WS13 = SW_WR + (size_t)NE * D * 2;
constexpr size_t SW_WS2 = SW_WS13 + (size_t)512 * D * 2;
constexpr size_t SW_WUP = SW_WS2 + (size_t)D * EFF * 2;
constexpr size_t SW_AUP = SW_WUP + (size_t)RW * 64 * 2;
constexpr size_t SW_GUP = SW_AUP + (size_t)RW * 64 * 2;
constexpr size_t SW_WSM = SW_GUP + (size_t)RW * 128 * 2;
constexpr size_t SW_END = SW_WSM + (size_t)8 * 128 * 128 * 2;
static_assert(SW_END <= 20 * MiB, "small weights");
constexpr size_t WS_RT = 20 * MiB;
constexpr size_t RT_EIDX = WS_RT;
constexpr size_t RT_EWT = RT_EIDX + (size_t)T * 8 * 4;
constexpr size_t RT_LRANK = RT_EWT + (size_t)T * 8 * 4;
constexpr size_t RT_TBASE = RT_LRANK + (size_t)T * 8 * 4;
constexpr size_t RT_ROWTOK = RT_TBASE + (size_t)256 * 256 * 4;
constexpr size_t RT_ROWDST = RT_ROWTOK + (size_t)MAXROWS * 4;
constexpr size_t RT_ROWW = RT_ROWDST + (size_t)MAXROWS * 4;
constexpr size_t RT_TAB = RT_ROWW + (size_t)MAXROWS * 4;
constexpr size_t RT_SBON = RT_TAB + (size_t)3 * 4096 * 8;
constexpr size_t RT_END = RT_SBON + (size_t)T * 8 * 4;
static_assert(RT_END <= 40 * MiB, "routing arrays");
constexpr size_t WS_BIG = 40 * MiB;
constexpr size_t B_H1 = WS_BIG + 0 * MiB;
constexpr size_t B_YB = WS_BIG + 0 * MiB;
constexpr size_t B_YA = WS_BIG + 64 * MiB;
constexpr size_t B_XS = WS_BIG + 64 * MiB;
constexpr size_t B_PRW = WS_BIG + 128 * MiB;
constexpr size_t B_M8 = WS_BIG + 128 * MiB;
constexpr size_t B_S = WS_BIG + 128 * MiB;
constexpr size_t B_PUV = WS_BIG + 352 * MiB;
constexpr size_t B_QY = WS_BIG + 352 * MiB;
constexpr size_t B_M1 = WS_BIG + 352 * MiB;
constexpr size_t B_PG = WS_BIG + 480 * MiB;
constexpr size_t B_MN = WS_BIG + 736 * MiB;
constexpr size_t B_G = WS_BIG + 864 * MiB;
constexpr size_t B_BV = WS_BIG + 928 * MiB;
constexpr size_t B_H2 = WS_BIG + 0 * MiB;
constexpr size_t B_W13 = WS_BIG + 128 * MiB;
constexpr size_t B_H2F8 = WS_BIG + 256 * MiB;
constexpr size_t B_SH = WS_BIG + 384 * MiB;
constexpr size_t B_SC = WS_BIG + 416 * MiB;
constexpr size_t B_SLOT = WS_BIG + 0 * MiB;
constexpr size_t B_SHO = WS_BIG + 928 * MiB;
constexpr size_t B_W2 = WS_BIG + 512 * MiB;
constexpr size_t B_X1 = WS_BIG + 576 * MiB;
constexpr size_t B_HID = WS_BIG + 704 * MiB;
constexpr size_t WS_END = WS_BIG + 992 * MiB;
static_assert((size_t)MAXROWS * EFF * 2 <= 320 * MiB, "hid");

constexpr int LDS_STAGE = 0;
constexpr int LDS_MISC = 153600;
constexpr int LDS_BARW = 161792;
constexpr int LDS_BYTES = 163840;

typedef __bf16 bf16x2_t __attribute__((ext_vector_type(2)));
__device__ __forceinline__ unsigned pk2(float lo, float hi) { f32x2 f = {lo, hi}; return __builtin_bit_cast(unsigned, __builtin_convertvector(f, bf16x2_t)); }
__device__ __forceinline__ u32x2 pk8(const f32x4& a, const f32x4& b) { u32x2 w; int t = __builtin_amdgcn_cvt_pk_fp8_f32(a[0], a[1], 0, false); t = __builtin_amdgcn_cvt_pk_fp8_f32(a[2], a[3], t, true); w.x = (unsigned)t;
    t = __builtin_amdgcn_cvt_pk_fp8_f32(b[0], b[1], 0, false); t = __builtin_amdgcn_cvt_pk_fp8_f32(b[2], b[3], t, true); w.y = (unsigned)t; return w; }
__device__ __forceinline__ f32x4 up8(unsigned w) { const f32x2 lo = __builtin_amdgcn_cvt_pk_f32_fp8((int)w, false), hi = __builtin_amdgcn_cvt_pk_f32_fp8((int)w, true); return (f32x4){lo.x, lo.y, hi.x, hi.y}; }
__device__ __forceinline__ float bflo(unsigned w) { return __uint_as_float(w << 16); }
__device__ __forceinline__ float bfhi(unsigned w) { return __uint_as_float(w & 0xffff0000u); }
__device__ __forceinline__ float bf2f(bf16_t h) { return __uint_as_float(((unsigned)h) << 16); }
__device__ __forceinline__ bf16_t f2bf(float f) { return (bf16_t)(pk2(f, 0.f) & 0xffffu); }
__device__ __forceinline__ float fexp(float x) { return __builtin_amdgcn_exp2f(x * 1.44269504089f); }
__device__ __forceinline__ float flog(float x) { return __builtin_amdgcn_logf(x) * 0.69314718056f; }
__device__ __forceinline__ float frcp(float x) { return __builtin_amdgcn_rcpf(x); }
__device__ __forceinline__ float sigmoidf_(float x) { return frcp(1.0f + fexp(-x)); }
__device__ __forceinline__ float siluf_(float x) { return x * sigmoidf_(x); }
__device__ __forceinline__ float tanhf_(float x) { return 1.0f - 2.0f * frcp(1.0f + fexp(2.0f * x)); }
__device__ __forceinline__ float gelu_tanh(float x) { const float u = 0.7978845608f * (x + 0.044715f * x * x * x); return x * frcp(1.0f + fexp(-2.0f * u)); }
template <int CTRL> __device__ __forceinline__ float dppf(float v) { return __builtin_bit_cast(float, __builtin_amdgcn_update_dpp(0, __builtin_bit_cast(int, v), CTRL, 0xf, 0xf, true)); }
constexpr int DPP_X1 = 0xB1, DPP_X2 = 0x4E, DPP_HM = 0x141, DPP_RM = 0x140;
__device__ __forceinline__ float row_sum16(float v) { v += dppf<DPP_X1>(v); v += dppf<DPP_X2>(v); v += dppf<DPP_HM>(v); v += dppf<DPP_RM>(v); return v; }
__device__ __forceinline__ float rdl(float v, int l) { return __builtin_bit_cast(float, __builtin_amdgcn_readlane(__builtin_bit_cast(int, v), l)); }
__device__ __forceinline__ float wave_sum(float v) { v = row_sum16(v); return (rdl(v, 0) + rdl(v, 16)) + (rdl(v, 32) + rdl(v, 48)); }
#define LDS_WAIT() asm volatile("s_waitcnt lgkmcnt(0)" ::: "memory")
#define VM_WAIT() asm volatile("s_waitcnt vmcnt(0)" ::: "memory")

#define XB_TMO      128
#define XB_XCNT(j)  (256  + 64 * (j))
#define XB_XSUB(j)  (1280 + 64 * (j))
#define XB_XGEN(j)  (2304 + 64 * (j))
#define XB_TOP      3328
#define XB_TOPGEN   3392
#define XCD_BAR_WORDS 3456
#define XB_SPIN_CAP (1u << 18)
__device__ __forceinline__ unsigned xb_ld(unsigned* p)              { return __hip_atomic_load(p, __ATOMIC_RELAXED, __HIP_MEMORY_SCOPE_AGENT); }
__device__ __forceinline__ unsigned xb_add(unsigned* p, unsigned v) { return __hip_atomic_fetch_add(p, v, __ATOMIC_RELAXED, __HIP_MEMORY_SCOPE_AGENT); }
__device__ __forceinline__ unsigned xb_xcc_id() { return (unsigned)__builtin_amdgcn_s_getreg((3 << 11) | 20) & 0xFu; }
#define XB_SPIN(cond, bar) do { unsigned _sp = 0; while (cond) { __builtin_amdgcn_s_sleep(1); \
    if ((++_sp & 255u) == 0u) { if (xb_ld(&(bar)[XB_TMO])) break; if (_sp > XB_SPIN_CAP) { atomicAdd(&(bar)[XB_TMO], 1u); break; } } } } while (0)
struct XcdBarrier { unsigned* bar; unsigned x; volatile LAS unsigned* st; };
__device__ __forceinline__ XcdBarrier xcd_barrier_post(unsigned* bar, volatile LAS unsigned* st) {
    XcdBarrier b; b.bar = bar; b.x = xb_xcc_id(); b.st = st;
    if (threadIdx.x == 0) (void)xb_add(&bar[XB_XCNT(b.x)], 1u);
    return b;
}
__device__ __forceinline__ void xcd_barrier_complete(unsigned* bar, unsigned x, unsigned& nloc, unsigned& nx) {
    const unsigned G = gridDim.x * gridDim.y * gridDim.z;
    unsigned sum, cnt, mine, sp = 0u;
    for (;;) {
        sum = 0u; cnt = 0u; mine = 0u;
#pragma unroll
        for (unsigned j = 0; j < 16; ++j) { const unsigned c = xb_ld(&bar[XB_XCNT(j)]); sum += c; cnt += (c > 0u) ? 1u : 0u; mine = (j == x) ? c : mine; }
        if (sum == G) break;
        __builtin_amdgcn_s_sleep(1);
        if ((++sp & 255u) == 0u) { if (xb_ld(&bar[XB_TMO])) break; if (sp > XB_SPIN_CAP) { atomicAdd(&bar[XB_TMO], 1u); break; } }
    }
    nloc = mine > 0u ? mine : 1u; nx = cnt > 0u ? cnt : 1u;
}
__device__ __forceinline__ void xcd_barrier(const XcdBarrier& b) {
    asm volatile("s_waitcnt vmcnt(0)" ::: "memory");
    __syncthreads();
    if (threadIdx.x == 0) {
        unsigned* bar = b.bar;
        __builtin_amdgcn_s_waitcnt(0);
        unsigned nloc = b.st[0], nx = b.st[1];
        if (nloc == 0u) { xcd_barrier_complete(bar, b.x, nloc, nx); b.st[0] = nloc; b.st[1] = nx; }
        const unsigned old = xb_add(&bar[XB_XSUB(b.x)], 1u);
        const unsigned gen = old / nloc;
        if (old + 1u == (gen + 1u) * nloc) {
            __builtin_amdgcn_fence(__ATOMIC_RELEASE, "agent");
            asm volatile("s_waitcnt vmcnt(0)" ::: "memory");
            const unsigned og = xb_add(&bar[XB_TOP], 1u);
            const unsigned tg = og / nx;
            if (og + 1u == (tg + 1u) * nx) xb_add(&bar[XB_TOPGEN], 1u);
            else XB_SPIN(xb_ld(&bar[XB_TOPGEN]) == tg, bar);
            __builtin_amdgcn_fence(__ATOMIC_ACQUIRE, "agent");
            xb_add(&bar[XB_XGEN(b.x)], 1u);
            asm volatile("s_waitcnt vmcnt(0)" ::: "memory");
        } else {
            XB_SPIN(xb_ld(&bar[XB_XGEN(b.x)]) == gen, bar);
            __builtin_amdgcn_fence(__ATOMIC_ACQUIRE, "agent");
            asm volatile("s_waitcnt vmcnt(0)" ::: "memory");
        }
    }
    __syncthreads();
}
namespace gm {
typedef int i32x4 __attribute__((ext_vector_type(4)));
typedef int i32x8 __attribute__((ext_vector_type(8)));
constexpr int BM = 256, BK = 64, HALF = 128, HTB = HALF * BK * 2, STAGE_BYTES = 8 * HTB, NXCD = 8, WGM = 8;
__host__ __device__ __forceinline__ int lds_byte(int r, int c) { const int st = (r >> 4) * 2 + (c >> 5), rr = r & 15, cc = c & 31, ob = rr * 64 + cc * 2; return st * 1024 + (ob ^ (((ob >> 9) & 1) << 5)); }
__host__ __device__ __forceinline__ void stage_rc(int b, int& R, int& C) { const int st = b / 1024, sb = b % 1024, swz = sb ^ (((sb >> 9) & 1) << 5); R = (st >> 1) * 16 + swz / 64; C = (st & 1) * 32 + (swz % 64) / 2; }
__host__ __device__ __forceinline__ int perm32(int rho) { const int n = rho >> 4, i = rho & 15; return 8 * (i >> 2) + 4 * n + (i & 3); }

struct Unit { int pm, pn, e, row0, par; };

struct DenseSched {
    static constexpr bool GATHER = false;
    const char* A; const char* B; int nM, nN, nwg, G, c; size_t tstep; const int* rowtok; int K;
    __device__ __forceinline__ void init(const void* A_, const void* B_, int M, int N, int K, int G_, int c_, int es = 2) { A = (const char*)A_; B = (const char*)B_; nM = M / BM; nN = N / BM; nwg = nM * nN; G = G_; c = c_; tstep = (size_t)BM * K * es; rowtok = nullptr; this->K = 0; }
    __device__ __forceinline__ bool next(int i, Unit& u) const {
        const long L = (long)i * G + c; if (L >= nwg) return false;
        int wgid = (int)L; { const int q = nwg / NXCD, r = nwg % NXCD, xcd = wgid % NXCD, off = wgid / NXCD; wgid = (xcd < r ? xcd * (q + 1) : r * (q + 1) + (xcd - r) * q) + off; }
        const int nig = WGM * nN, gid = wgid / nig, fm = gid * WGM, gsz = (nM - fm) < WGM ? (nM - fm) : WGM;
        u.pm = fm + ((wgid % nig) % gsz); u.pn = (wgid % nig) / gsz; u.e = 0; u.row0 = u.pm * BM; return true;
    }
    __device__ __forceinline__ const char* a_ptr(const Unit& u) const { return A + (size_t)u.pm * tstep; }
    __device__ __forceinline__ const char* b_ptr(const Unit& u) const { return B + (size_t)u.pn * tstep; }
    __device__ __forceinline__ unsigned row_off(const Unit&, int) const { return 0u; }
};
template <bool GATHER_>
struct GroupSched {
    static constexpr bool GATHER = GATHER_;
    const char* A; const char* B; const int* tab; const int* rowtok; int ntiles, npn, G, c, K; size_t ebytes, tstep;
    __device__ __forceinline__ bool next(int i, Unit& u) const {
        int tile;
        if (G == 256) {
            const int xcd = c & 7, slot = c >> 3, tpx = 32 / npn; tile = i * 8 * tpx + xcd * tpx + slot / npn; u.pn = slot % npn; if (tile >= ntiles) return false;
        } else { const long L = (long)i * G + c; if (L >= (long)ntiles * npn) return false; tile = (int)(L / npn); u.pn = (int)(L % npn); }
        u.pm = tile;
        u.row0 = __builtin_amdgcn_readfirstlane(tab[2 * tile]); u.e = __builtin_amdgcn_readfirstlane(tab[2 * tile + 1]); return true;
    }
    __device__ __forceinline__ const char* a_ptr(const Unit& u) const { return GATHER ? A : A + (size_t)u.row0 * K; }
    __device__ __forceinline__ const char* b_ptr(const Unit& u) const { return B + (size_t)u.e * ebytes + (size_t)u.pn * tstep; }
    __device__ __forceinline__ unsigned row_off(const Unit& u, int r) const { return (unsigned)rowtok[u.row0 + r] * (unsigned)K; }
};

template <class Epi, class Sched, bool ALIGN_EPI, bool F8 = false, int SCALE_W = 127>
__device__ __forceinline__ void gemm_phase(LAS unsigned char* lds, const int Kel, const Sched& S, const Epi& E) {
    const int K = F8 ? Kel / 2 : Kel;
    int tid_ = threadIdx.x; asm volatile("" : "+v"(tid_));
    const int tid = tid_, wid = __builtin_amdgcn_readfirstlane(tid >> 6), lane = tid & 63, wr = wid >> 2, wc = wid & 3, fr = lane & 15, fq = lane >> 4;
    const int nt = K / BK;
    int sR[2], sC[2]; unsigned voffB[2];
#pragma unroll
    for (int i = 0; i < 2; ++i) { int R, C; stage_rc(tid * 16 + i * 8192, R, C); sR[i] = R; sC[i] = C; const int Rb = Epi::PERM ? ((R & ~31) + perm32(R & 31)) : R; voffB[i] = (unsigned)(Rb * K + C) * 2u; }
    const size_t kstep = (size_t)(BK * 2);
    const size_t hstep = (size_t)HALF * K * 2;
    const unsigned ldsw = (unsigned)wid * 1024u;
    const int aoff = lds_byte(wr * 64 + fr, fq * 8), boff = lds_byte(wc * 32 + fr, fq * 8);
#define PG8_SA(b, h) (((b) * 2 + (h)) * HTB)
#define PG8_SB(b, h) ((4 + (b) * 2 + (h)) * HTB)
#define PG8_STGB(bufoff, gbase) do { _Pragma("unroll") for (int _i = 0; _i < 2; ++_i) \
        __builtin_amdgcn_global_load_lds((const unsigned*)((const char*)(gbase) + voffB[_i]), (LAS unsigned*)(lds + (bufoff) + ldsw + _i * 8192), 16, 0, 0); } while (0)
#define PG8_STGA(bufoff, gbase, VO, h) do { _Pragma("unroll") for (int _i = 0; _i < 2; ++_i) \
        __builtin_amdgcn_global_load_lds((const unsigned*)((const char*)(gbase) + VO[h][_i]), (LAS unsigned*)(lds + (bufoff) + ldsw + _i * 8192), 16, 0, 0); } while (0)
#define PG8_VOA(u, VO) do { _Pragma("unroll") for (int _h = 0; _h < 2; ++_h) _Pragma("unroll") for (int _i = 0; _i < 2; ++_i) \
        VO[_h][_i] = Sched::GATHER ? (S.row_off(u, _h * HALF + sR[_i]) + (unsigned)sC[_i] * 2u) : ((unsigned)((_h * HALF + sR[_i]) * K + sC[_i]) * 2u); } while (0)
#define PG8_LDA(dst, b, h) do { _Pragma("unroll") for (int m = 0; m < 4; ++m) { if constexpr (F8) { dst##8[m].lo = *(const LAS i32x4*)(lds + PG8_SA(b, h) + aoff + m * 2048); dst##8[m].hi = *(const LAS i32x4*)(lds + PG8_SA(b, h) + aoff + m * 2048 + 1024); } else { _Pragma("unroll") for (int k = 0; k < 2; ++k) dst[m][k] = *(const LAS bf16x8*)(lds + PG8_SA(b, h) + aoff + m * 2048 + k * 1024); } } } while (0)
#define PG8_LDB(dst, b, h) do { _Pragma("unroll") for (int n = 0; n < 2; ++n) { if constexpr (F8) { dst##8[n].lo = *(const LAS i32x4*)(lds + PG8_SB(b, h) + boff + n * 2048); dst##8[n].hi = *(const LAS i32x4*)(lds + PG8_SB(b, h) + boff + n * 2048 + 1024); } else { _Pragma("unroll") for (int k = 0; k < 2; ++k) dst[n][k] = *(const LAS bf16x8*)(lds + PG8_SB(b, h) + boff + n * 2048 + k * 1024); } } } while (0)
#define PG8_MMA(ai, bj, At, Bt) do { __builtin_amdgcn_s_setprio(1); _Pragma("unroll") for (int m = 0; m < 4; ++m) _Pragma("unroll") for (int n = 0; n < 2; ++n) { \
        if constexpr (F8) { asm volatile("v_mfma_scale_f32_16x16x128_f8f6f4 %0, %1, %2, %0, %3, %4 op_sel_hi:[0,0,0]" : "+v"(acc[ai][bj][m][n]) : "v"(Bt##8[n]), "v"(At##8[m]), "v"(scw_), "v"(sca_)); } \
        else { _Pragma("unroll") for (int k = 0; k < 2; ++k) acc[ai][bj][m][n] = __builtin_amdgcn_mfma_f32_16x16x32_bf16(Bt[n][k], At[m][k], acc[ai][bj][m][n], 0, 0, 0); } } \
        __builtin_amdgcn_s_setprio(0); } while (0)
#define PG8_WAIT_V(n) asm volatile("s_waitcnt vmcnt(" #n ")" ::: "memory")
#define PG8_WAIT_L(n) asm volatile("s_waitcnt lgkmcnt(" #n ")" ::: "memory")
#define PG8_BAR __builtin_amdgcn_s_barrier()
#define PG8_SCHED __builtin_amdgcn_sched_barrier(0)
    Unit cur, nxt; int ui = 0;
    if (!S.next(0, cur)) return;
    f32x4 acc[2][2][4][2];
#pragma unroll
    for (int a = 0; a < 2; ++a)
#pragma unroll
        for (int b = 0; b < 2; ++b)
#pragma unroll
            for (int m = 0; m < 4; ++m)
#pragma unroll
                for (int n = 0; n < 2; ++n) acc[a][b][m][n] = (f32x4){0.f, 0.f, 0.f, 0.f};
    const int scw_ = SCALE_W, sca_ = 127;
    bf16x8 At[4][2], B0[2][2], B1[2][2]; i32x8 At8[4], B08[2], B18[2];
    unsigned voA[2][2], nvoA[2][2];
    PG8_VOA(cur, voA);
    if (Sched::GATHER) { asm volatile("s_waitcnt vmcnt(0)" ::: "memory"); }
    const char* cA = S.a_ptr(cur); const char* cB = S.b_ptr(cur);
    cur.par = 0; E.stage_rows(cur, lds, wid);
    PG8_STGB(PG8_SB(0, 0), cB); PG8_STGB(PG8_SB(0, 1), cB + hstep); PG8_STGA(PG8_SA(0, 0), cA, voA, 0); PG8_STGA(PG8_SA(0, 1), cA, voA, 1);
    if (wr == 1) PG8_BAR;
    PG8_WAIT_V(2); PG8_BAR;
    PG8_STGB(PG8_SB(1, 0), cB + kstep); PG8_STGA(PG8_SA(1, 0), cA + kstep, voA, 0); PG8_STGB(PG8_SB(1, 1), cB + hstep + kstep);
    PG8_WAIT_V(6); PG8_BAR;
    Unit nn; bool has_next = S.next(1, nxt);
    for (;;) {
        nxt.par = (ui + 1) & 3;
        const bool has_nn = has_next && S.next(ui + 2, nn);
        const char* nA = has_next ? S.a_ptr(nxt) : cA; const char* nB = has_next ? S.b_ptr(nxt) : cB;
        if (Sched::GATHER) {
            if (has_next) { if (wid < 4) __builtin_amdgcn_global_load_lds((const unsigned*)(S.rowtok + nxt.row0 + wid * 64 + lane), (LAS unsigned*)(lds + LDS_MISC + nxt.par * 1024 + wid * 256), 4, 0, 0); }
#pragma unroll
            for (int h = 0; h < 2; ++h)
#pragma unroll
                for (int i = 0; i < 2; ++i) nvoA[h][i] = voA[h][i]; }
#pragma unroll 1
        for (int t = 0; t < nt; t += 2) {
            const bool last = (t == nt - 2);
            const char* a1 = cA + (size_t)(t + 1) * kstep;
            const char* a2 = last ? nA : cA + (size_t)(t + 2) * kstep; const char* b2 = last ? nB : cB + (size_t)(t + 2) * kstep;
            const char* a3 = a2 + kstep; const char* b3 = b2 + kstep;
            unsigned vo2[2][2];
#pragma unroll
            for (int h = 0; h < 2; ++h)
#pragma unroll
                for (int i = 0; i < 2; ++i) vo2[h][i] = (Sched::GATHER && last) ? nvoA[h][i] : voA[h][i];
            if (last && has_next) E.stage_rows(nxt, lds, wid);
            if (Sched::GATHER && last && has_next) { const LAS int* rt_ = (const LAS int*)(lds + LDS_MISC + nxt.par * 1024);
#pragma unroll
                for (int h = 0; h < 2; ++h)
#pragma unroll
                    for (int i = 0; i < 2; ++i) { vo2[h][i] = (unsigned)rt_[h * HALF + sR[i]] * (unsigned)S.K + (unsigned)sC[i] * 2u; nvoA[h][i] = vo2[h][i]; } }
            PG8_LDB(B0, 0, 0); PG8_LDB(B1, 0, 1); PG8_SCHED; PG8_LDA(At, 0, 0); PG8_STGA(PG8_SA(1, 1), a1, voA, 1);
            PG8_WAIT_V(8); PG8_WAIT_L(0); PG8_BAR; PG8_MMA(0, 0, At, B0); PG8_MMA(0, 1, At, B1); PG8_BAR; PG8_SCHED;
            PG8_LDA(At, 0, 1); PG8_STGB(PG8_SB(0, 0), b2); PG8_STGB(PG8_SB(0, 1), b2 + hstep); PG8_STGA(PG8_SA(0, 0), a2, vo2, 0);
            PG8_WAIT_V(8); PG8_WAIT_L(0); PG8_BAR; PG8_MMA(1, 0, At, B0); PG8_MMA(1, 1, At, B1); PG8_BAR; PG8_SCHED;
            PG8_LDB(B0, 1, 0); PG8_LDB(B1, 1, 1); PG8_SCHED; PG8_LDA(At, 1, 0); PG8_STGA(PG8_SA(0, 1), a2, vo2, 1);
            PG8_WAIT_V(8); PG8_WAIT_L(0); PG8_BAR; PG8_MMA(0, 0, At, B0); PG8_MMA(0, 1, At, B1); PG8_BAR; PG8_SCHED;
            PG8_LDA(At, 1, 1); PG8_STGB(PG8_SB(1, 0), b3); PG8_STGB(PG8_SB(1, 1), b3 + hstep); PG8_STGA(PG8_SA(1, 0), a3, vo2, 0);
            PG8_WAIT_V(8); PG8_WAIT_L(0); PG8_BAR; PG8_MMA(1, 0, At, B0); PG8_MMA(1, 1, At, B1); PG8_BAR; PG8_SCHED;
        }
        if constexpr (F8) asm volatile("s_nop 15\n\ts_nop 15\n\ts_nop 15" ::: "memory");
        if constexpr (ALIGN_EPI) { if (wr == 0) PG8_BAR; }
        E(acc, cur, wr, wc, fr, fq);
        if (!has_next) break;
#pragma unroll
        for (int a = 0; a < 2; ++a)
#pragma unroll
            for (int b = 0; b < 2; ++b)
#pragma unroll
                for (int m = 0; m < 4; ++m)
#pragma unroll
                    for (int n = 0; n < 2; ++n) acc[a][b][m][n] = (f32x4){0.f, 0.f, 0.f, 0.f};
        cur = nxt; cA = nA; cB = nB; ++ui; nxt = nn; has_next = has_nn;
        if (Sched::GATHER) {
#pragma unroll
            for (int h = 0; h < 2; ++h)
#pragma unroll
                for (int i = 0; i < 2; ++i) voA[h][i] = nvoA[h][i]; }
        if constexpr (ALIGN_EPI) { if (wr == 1) PG8_BAR; }
    }
    PG8_WAIT_V(0);
    if constexpr (!ALIGN_EPI) { if (wr == 0) PG8_BAR; }
    PG8_BAR;
#undef PG8_SA
#undef PG8_SB
#undef PG8_STGA
#undef PG8_STGB
#undef PG8_VOA
#undef PG8_LDA
#undef PG8_LDB
#undef PG8_MMA
#undef PG8_WAIT_V
#undef PG8_WAIT_L
#undef PG8_BAR
#undef PG8_SCHED
}

typedef f32x4 Acc[2][2][4][2];
struct EpiInProj {
    static constexpr bool PERM = true;
    __device__ __forceinline__ void stage_rows(const Unit&, LAS unsigned char*, int) const {}
    bf16_t *prw, *puv, *pg;
    template <int ACT> __device__ __forceinline__ void tile(const Acc& acc, bf16_t* base, int ld, int row0, int col0) const {
#pragma unroll
        for (int ai = 0; ai < 2; ++ai)
#pragma unroll
            for (int m = 0; m < 4; ++m) { bf16_t* rowp = base + (size_t)(row0 + ai * HALF + m * 16) * ld + col0;
#pragma unroll
                for (int bj = 0; bj < 2; ++bj) { f32x4 v0 = acc[ai][bj][m][0], v1 = acc[ai][bj][m][1];
                    if (ACT == 1) {
#pragma unroll
                        for (int j = 0; j < 4; ++j) { v0[j] = gelu_tanh(v0[j]); v1[j] = gelu_tanh(v1[j]); } }
                    if (ACT == 2) {
#pragma unroll
                        for (int j = 0; j < 4; ++j) { v0[j] = sigmoidf_(v0[j]); v1[j] = sigmoidf_(v1[j]); } }
                    u32x4 w; w.x = pk2(v0[0], v0[1]); w.y = pk2(v0[2], v0[3]); w.z = pk2(v1[0], v1[1]); w.w = pk2(v1[2], v1[3]);
                    *(u32x4*)(rowp + bj * HALF) = w; }
                __builtin_amdgcn_sched_barrier(0); }
    }
    __device__ __forceinline__ void operator()(const Acc& acc, const Unit& u, int wr, int wc, int fr, int fq) const {
        const int row0 = u.row0 + wr * 64 + fr, cw = wc * 32 + 8 * fq;
        if (u.pn < 7) tile<0>(acc, prw, RWKV_COLS, row0, u.pn * 256 + cw);
        else if (u.pn < 11) tile<1>(acc, puv, 1024, row0, (u.pn - 7) * 256 + cw);
        else tile<2>(acc, pg, 2048, row0, (u.pn - 11) * 256 + cw);
    }
};
template <bool SECOND> struct EpiMerge {
    static constexpr bool PERM = true;
    __device__ __forceinline__ void stage_rows(const Unit&, LAS unsigned char*, int) const {}
    bf16_t* m1; const bf16_t* pg; unsigned char* m8;
    __device__ __forceinline__ void operator()(const Acc& acc, const Unit& u, int wr, int wc, int fr, int fq) const {
        const int row0 = u.row0 + wr * 64 + fr, col0 = u.pn * 256 + wc * 32 + 8 * fq;
#pragma unroll
        for (int ai = 0; ai < 2; ++ai)
#pragma unroll
            for (int m = 0; m < 4; ++m) { const size_t r = (size_t)(row0 + ai * HALF + m * 16);
#pragma unroll
                for (int bj = 0; bj < 2; ++bj) { const int c = col0 + bj * HALF;
                    const u32x4 g = *(const u32x4*)(pg + r * 2048 + (SECOND ? 1024 : 0) + c);
                    f32x4 v0 = acc[ai][bj][m][0], v1 = acc[ai][bj][m][1];
                    v0[0] *= bflo(g.x); v0[1] *= bfhi(g.x); v0[2] *= bflo(g.y); v0[3] *= bfhi(g.y); v1[0] *= bflo(g.z); v1[1] *= bfhi(g.z); v1[2] *= bflo(g.w); v1[3] *= bfhi(g.w);
                    if (SECOND) { const u32x4 p = *(const u32x4*)(m1 + r * 1024 + c);
                        v0[0] += bflo(p.x); v0[1] += bfhi(p.x); v0[2] += bflo(p.y); v0[3] += bfhi(p.y); v1[0] += bflo(p.z); v1[1] += bfhi(p.z); v1[2] += bflo(p.w); v1[3] += bfhi(p.w); }
                    if (SECOND) *(u32x2*)(m8 + r * 1024 + c) = pk8(v0, v1);
                    else { u32x4 w; w.x = pk2(v0[0], v0[1]); w.y = pk2(v0[2], v0[3]); w.z = pk2(v1[0], v1[1]); w.w = pk2(v1[2], v1[3]); *(u32x4*)(m1 + r * 1024 + c) = w; } }
                __builtin_amdgcn_sched_barrier(0); }
    }
};
struct EpiResid {
    static constexpr bool PERM = true;
    __device__ __forceinline__ void stage_rows(const Unit&, LAS unsigned char*, int) const {}
    bf16_t* out; const float* base; const float* gate;
    __device__ __forceinline__ void operator()(const Acc& acc, const Unit& u, int wr, int wc, int fr, int fq) const {
        const int row0 = u.row0 + wr * 64 + fr, col0 = u.pn * 256 + wc * 32 + 8 * fq;
        const float* gp = gate + (size_t)(u.row0 >> 13) * 6144 + col0;
        f32x4 gv[2][2];
#pragma unroll
        for (int bj = 0; bj < 2; ++bj)
#pragma unroll
            for (int n = 0; n < 2; ++n) gv[bj][n] = *(const f32x4*)(gp + bj * HALF + n * 4);
#pragma unroll
        for (int ai = 0; ai < 2; ++ai)
#pragma unroll
            for (int m = 0; m < 4; ++m) { const size_t ro = (size_t)(row0 + ai * HALF + m * 16) * 1024 + col0;
#pragma unroll
                for (int bj = 0; bj < 2; ++bj) { const f32x4 b0 = *(const f32x4*)(base + ro + bj * HALF), b1 = *(const f32x4*)(base + ro + bj * HALF + 4);
                    const f32x4 v0 = b0 + gv[bj][0] * acc[ai][bj][m][0], v1 = b1 + gv[bj][1] * acc[ai][bj][m][1];
                    u32x4 w; w.x = pk2(v0[0], v0[1]); w.y = pk2(v0[2], v0[3]); w.z = pk2(v1[0], v1[1]); w.w = pk2(v1[2], v1[3]);
                    *(u32x4*)(out + ro + bj * HALF) = w; }
                __builtin_amdgcn_sched_barrier(0); }
    }
};
struct EpiRouter {
    static constexpr bool PERM = false;
    __device__ __forceinline__ void stage_rows(const Unit&, LAS unsigned char*, int) const {}
    float* sc;
    __device__ __forceinline__ void operator()(const Acc& acc, const Unit& u, int wr, int wc, int fr, int fq) const {
        const int row0 = u.row0 + wr * 64 + fr, col0 = wc * 32 + 4 * fq;
#pragma unroll
        for (int ai = 0; ai < 2; ++ai)
#pragma unroll
            for (int m = 0; m < 4; ++m) { float* rowp = sc + (size_t)(row0 + ai * HALF + m * 16) * 256 + col0;
#pragma unroll
                for (int bj = 0; bj < 2; ++bj)
#pragma unroll
                    for (int n = 0; n < 2; ++n) { f32x4 v = acc[ai][bj][m][n];
#pragma unroll
                        for (int j = 0; j < 4; ++j) v[j] = sigmoidf_(v[j]);
                        *(f32x4*)(rowp + bj * HALF + n * 16) = v; }
                __builtin_amdgcn_sched_barrier(0); }
    }
};
template <bool F8OUT> struct EpiGateUp {
    static constexpr bool PERM = true;
    __device__ __forceinline__ void stage_rows(const Unit&, LAS unsigned char*, int) const {}
    void* hid;
    __device__ __forceinline__ void operator()(const Acc& acc, const Unit& u, int wr, int wc, int fr, int fq) const {
        const int row0 = u.row0 + wr * 64 + fr, col0 = u.pn * HALF + wc * 32 + 8 * fq;
#pragma unroll
        for (int ai = 0; ai < 2; ++ai)
#pragma unroll
            for (int m = 0; m < 4; ++m) { const size_t off = (size_t)(row0 + ai * HALF + m * 16) * EFF + col0;
                f32x4 v0, v1;
#pragma unroll
                for (int j = 0; j < 4; ++j) { v0[j] = siluf_(acc[ai][0][m][0][j]) * acc[ai][1][m][0][j]; v1[j] = siluf_(acc[ai][0][m][1][j]) * acc[ai][1][m][1][j]; }
                if constexpr (F8OUT) *(u32x2*)((unsigned char*)hid + off) = pk8(v0, v1);
                else { u32x4 w; w.x = pk2(v0[0], v0[1]); w.y = pk2(v0[2], v0[3]); w.z = pk2(v1[0], v1[1]); w.w = pk2(v1[2], v1[3]); *(u32x4*)((bf16_t*)hid + off) = w; }
                __builtin_amdgcn_sched_barrier(0); }
    }
};
struct EpiExpertDown {
    static constexpr bool PERM = true;
    unsigned char* slot; const int* rowdst; const float* roww;
    __device__ __forceinline__ void stage_rows(const Unit& u, LAS unsigned char* lds, int wid) const {
        if (wid < 4) { const int lane = threadIdx.x & 63; LAS unsigned char* base = lds + LDS_MISC + u.par * 2048 + wid * 256;
            __builtin_amdgcn_global_load_lds((const unsigned*)(rowdst + u.row0 + wid * 64 + lane), (LAS unsigned*)base, 4, 0, 0);
            __builtin_amdgcn_global_load_lds((const unsigned*)(roww + u.row0 + wid * 64 + lane), (LAS unsigned*)(base + 1024), 4, 0, 0); }
    }
    __device__ __forceinline__ void operator()(const Acc& acc, const Unit& u, int wr, int wc, int fr, int fq) const {
        const unsigned cb = (unsigned)(u.pn * 256 + wc * 64 + 16 * fq);
        const LAS int* td = (const LAS int*)((LAS unsigned char*)nullptr + LDS_MISC + u.par * 2048) + wr * 64 + fr; const LAS float* tw = (const LAS float*)(td + 256);
        int dst[2][4]; float ws_[2][4];
#pragma unroll
        for (int ai = 0; ai < 2; ++ai)
#pragma unroll
            for (int m = 0; m < 4; ++m) { dst[ai][m] = td[ai * HALF + m * 16]; ws_[ai][m] = tw[ai * HALF + m * 16]; }
#pragma unroll
        for (int ai = 0; ai < 2; ++ai)
#pragma unroll
            for (int m = 0; m < 4; ++m) {
                if (dst[ai][m] >= 0) { const float s_ = ws_[ai][m]; const u32x2 lo = pk8(acc[ai][0][m][0] * s_, acc[ai][0][m][1] * s_), hi = pk8(acc[ai][1][m][0] * s_, acc[ai][1][m][1] * s_);
                    *(u32x4*)(slot + (size_t)((unsigned)dst[ai][m] * 1024u + cb)) = (u32x4){lo.x, lo.y, hi.x, hi.y}; }
            }
    }
};
struct EpiSharedDown {
    static constexpr bool PERM = true;
    unsigned char* sho;
    __device__ __forceinline__ void stage_rows(const Unit&, LAS unsigned char*, int) const {}
    __device__ __forceinline__ void operator()(const Acc& acc, const Unit& u, int wr, int wc, int fr, int fq) const {
        const int row0 = u.row0 + wr * 64 + fr, col0 = u.pn * 256 + wc * 32 + 8 * fq;
#pragma unroll
        for (int ai = 0; ai < 2; ++ai)
#pragma unroll
            for (int m = 0; m < 4; ++m) { unsigned char* rowp = sho + (size_t)(row0 + ai * HALF + m * 16) * 1024 + col0;
#pragma unroll
                for (int bj = 0; bj < 2; ++bj) *(u32x2*)(rowp + bj * HALF) = pk8(acc[ai][bj][m][0], acc[ai][bj][m][1]);
                __builtin_amdgcn_sched_barrier(0); }
    }
};
}
__device__ __forceinline__ void phase_mod(const float* c, const float* ada_w, const float* ada_b, float* mod, LAS unsigned char* lds, int tid, int G) {
    LAS float* sl = (LAS float*)lds; LAS float* red = (LAS float*)(lds + 32768);
    for (int i = tid; i < NB * D; i += NTHREADS) { const float v = c[i]; sl[i] = siluf_(v); }
    __syncthreads();
    const int cl = tid % 24, kg = tid / 24;
    for (int cb = blockIdx.x; cb < 256; cb += G) {
        const int col0 = cb * 24;
        if (tid < 384) {
            float a[NB];
#pragma unroll
            for (int b = 0; b < NB; ++b) a[b] = 0.f;
#pragma unroll 1
            for (int k0 = kg; k0 < D; k0 += 16 * 16) { float w[16];
#pragma unroll
                for (int i = 0; i < 16; ++i) w[i] = ada_w[(size_t)(k0 + 16 * i) * 6144 + col0 + cl];
#pragma unroll
                for (int i = 0; i < 16; ++i) {
#pragma unroll
                    for (int b = 0; b < NB; ++b) a[b] += sl[b * D + k0 + 16 * i] * w[i]; } }
#pragma unroll
            for (int b = 0; b < NB; ++b) red[(kg * 24 + cl) * NB + b] = a[b];
        }
        __syncthreads();
        if (tid < 192) { const int c2 = tid >> 3, b = tid & 7; float s = 0.f;
#pragma unroll
            for (int g = 0; g < 16; ++g) s += red[(g * 24 + c2) * NB + b];
            mod[(size_t)b * 6144 + col0 + c2] = s + ada_b[col0 + c2]; }
        __syncthreads();
    }
}
__device__ __forceinline__ void transpose_item(const float* W, int ldw, int k0, int n0, bf16_t* WT, int ldt, int drow0, LAS float* scr, int lane) {
#pragma unroll 8
    for (int i = 0; i < 32; ++i) { const int kk = 2 * i + (lane >> 5); scr[kk * 33 + (lane & 31)] = W[(size_t)(k0 + kk) * ldw + n0 + (lane & 31)]; }
    LDS_WAIT(); asm volatile("" ::: "memory");
    const int c = lane & 7;
#pragma unroll
    for (int j = 0; j < 4; ++j) { const int n = (lane >> 3) + 8 * j; const LAS float* s = scr + (8 * c) * 33 + n;
        u32x4 o; o.x = pk2(s[0 * 33], s[1 * 33]); o.y = pk2(s[2 * 33], s[3 * 33]); o.z = pk2(s[4 * 33], s[5 * 33]); o.w = pk2(s[6 * 33], s[7 * 33]);
        *(u32x4*)(WT + (size_t)(drow0 + n) * ldt + k0 + 8 * c) = o; }
    LDS_WAIT(); asm volatile("" ::: "memory");
}
__device__ __forceinline__ void transpose_job(const float* W, int K, int N, bf16_t* WT, int gated, int goff, int item, LAS float* scr, int lane) {
    const int nblk = N / 32, kb = item / nblk, nb = item % nblk, n0 = 32 * nb;
    const int drow0 = gated ? (256 * (n0 >> 7) + goff + (n0 & 127)) : n0;
    transpose_item(W, N, 64 * kb, n0, WT, K, drow0, scr, lane);
}
__device__ __forceinline__ void transpose_item64(const float* W, int ldw, int k0, int n0, bf16_t* WT, int ldt, int drow0, LAS float* scr, int lane) {
    f32x4 v[16];
    const int c4 = lane & 15, r4 = lane >> 4;
#pragma unroll
    for (int i = 0; i < 16; ++i) v[i] = *(const f32x4*)(W + (size_t)(k0 + 4 * i + r4) * ldw + n0 + 4 * c4);
#pragma unroll
    for (int i = 0; i < 16; ++i) { LAS float* d = scr + (4 * i + r4) * 65 + 4 * c4; d[0] = v[i].x; d[1] = v[i].y; d[2] = v[i].z; d[3] = v[i].w; }
    LDS_WAIT(); asm volatile("" ::: "memory");
    const int c = lane & 7;
#pragma unroll
    for (int j = 0; j < 8; ++j) { const int n = (lane >> 3) + 8 * j; const LAS float* s = scr + (8 * c) * 65 + n;
        u32x4 o; o.x = pk2(s[0 * 65], s[1 * 65]); o.y = pk2(s[2 * 65], s[3 * 65]); o.z = pk2(s[4 * 65], s[5 * 65]); o.w = pk2(s[6 * 65], s[7 * 65]);
        *(u32x4*)(WT + (size_t)(drow0 + n) * ldt + k0 + 8 * c) = o; }
    LDS_WAIT(); asm volatile("" ::: "memory");
}
constexpr float WSCALE = 32.0f;
__device__ __forceinline__ void transpose_item64_f8(const float* W, int ldw, int k0, int n0, unsigned char* WT8, int ldt, int drow0, LAS float* scr, int lane) {
    f32x4 v[16];
    const int c4 = lane & 15, r4 = lane >> 4;
#pragma unroll
    for (int i = 0; i < 16; ++i) v[i] = *(const f32x4*)(W + (size_t)(k0 + 4 * i + r4) * ldw + n0 + 4 * c4);
#pragma unroll
    for (int i = 0; i < 16; ++i) { LAS float* d = scr + (4 * i + r4) * 65 + 4 * c4; d[0] = v[i].x; d[1] = v[i].y; d[2] = v[i].z; d[3] = v[i].w; }
    LDS_WAIT(); asm volatile("" ::: "memory");
    const int c = lane & 7;
#pragma unroll
    for (int j = 0; j < 8; ++j) { const int n = (lane >> 3) + 8 * j; const LAS float* s = scr + (8 * c) * 65 + n;
        const f32x4 lo = (f32x4){s[0 * 65], s[1 * 65], s[2 * 65], s[3 * 65]} * WSCALE, hi = (f32x4){s[4 * 65], s[5 * 65], s[6 * 65], s[7 * 65]} * WSCALE;
        *(u32x2*)(WT8 + (size_t)(drow0 + n) * ldt + k0 + 8 * c) = pk8(lo, hi); }
    LDS_WAIT(); asm volatile("" ::: "memory");
}
struct SmallW { const float *w_in, *w_out_a, *w_out_b, *w_out, *router_w, *sw1, *sw3, *sw2, *w_up, *a_up, *g_up, *gws; };
__device__ __forceinline__ void phase_small_weights(const SmallW& P, unsigned char* ws, LAS unsigned char* lds, int gw, int NGW, int wave, int lane) {
    LAS float* scr = (LAS float*)(lds + wave * 16640);
    constexpr int I0 = 16 * 76, I1 = 8 * 16, I2 = 8 * 16, I3 = 16 * 16, I4 = 16 * 8, I5 = 16 * 4, I6 = 16 * 4, I7 = 4 * 16, I8 = 16, I9 = 16, I10 = 2 * 16;
    constexpr int NIT = I0 + I1 + I2 + I3 + I4 + I5 + I6 + I7 + I8 + I9 + I10;
    for (int it = gw; it < NIT; it += NGW) {
        int r = it;
        if (r < I0) { const int kb = r / 76, nb = r % 76; transpose_item64_f8(P.w_in, IN_COLS, 64 * kb, 64 * nb, ws + SW_WIN, D, 64 * nb, scr, lane); continue; } r -= I0;
        if (r < I1) { transpose_item64_f8(P.w_out_a, D, 64 * (r >> 4), 64 * (r & 15), ws + SW_WOA, RW, 64 * (r & 15), scr, lane); continue; } r -= I1;
        if (r < I2) { transpose_item64_f8(P.w_out_b, D, 64 * (r >> 4), 64 * (r & 15), ws + SW_WOB, RW, 64 * (r & 15), scr, lane); continue; } r -= I2;
        if (r < I3) { transpose_item64_f8(P.w_out, D, 64 * (r >> 4), 64 * (r & 15), ws + SW_WO, D, 64 * (r & 15), scr, lane); continue; } r -= I3;
        if (r < I4) { transpose_job(P.router_w, D, NE, (bf16_t*)(ws + SW_WR), 0, 0, r, scr, lane); continue; } r -= I4;
        if (r < I5) { const int n0 = 64 * (r & 3); transpose_item64_f8(P.sw1, EFF, 64 * (r >> 2), n0, ws + SW_WS13, D, 256 * (n0 >> 7) + (n0 & 127), scr, lane); continue; } r -= I5;
        if (r < I6) { const int n0 = 64 * (r & 3); transpose_item64_f8(P.sw3, EFF, 64 * (r >> 2), n0, ws + SW_WS13, D, 256 * (n0 >> 7) + 128 + (n0 & 127), scr, lane); continue; } r -= I6;
        if (r < I7) { transpose_item64_f8(P.sw2, D, 64 * (r >> 4), 64 * (r & 15), ws + SW_WS2, EFF, 64 * (r & 15), scr, lane); continue; } r -= I7;
        if (r < I8) { transpose_job(P.w_up, 64, RW, (bf16_t*)(ws + SW_WUP), 0, 0, r, scr, lane); continue; } r -= I8;
        if (r < I9) { transpose_job(P.a_up, 64, RW, (bf16_t*)(ws + SW_AUP), 0, 0, r, scr, lane); continue; } r -= I9;
        transpose_job(P.g_up, 128, RW, (bf16_t*)(ws + SW_GUP), 0, 0, r, scr, lane);
    }
    bf16_t* wsm = (bf16_t*)(ws + SW_WSM);
    for (int i = gw * 64 + lane; i < 8 * 128 * 128; i += NGW * 64) { const int col = i & 127, row = (i >> 7) & 127; wsm[i] = (col <= row) ? f2bf(P.gws[i]) : (bf16_t)0; }
}
template <bool PERM16>
__device__ __forceinline__ void transpose_item128_f8(const float* W, int ldw, int k0, int n0, unsigned char* WT8, int ldt, int drow0, LAS float* scr, int lane) {
    f32x4 v[16];
    const int c4 = lane & 7, r8 = lane >> 3;
#pragma unroll
    for (int i = 0; i < 16; ++i) v[i] = *(const f32x4*)(W + (size_t)(k0 + 8 * i + r8) * ldw + n0 + 4 * c4);
#pragma unroll
    for (int i = 0; i < 16; ++i) { LAS float* d = scr + (8 * i + r8) * 33 + 4 * c4; d[0] = v[i].x; d[1] = v[i].y; d[2] = v[i].z; d[3] = v[i].w; }
    LDS_WAIT(); asm volatile("" ::: "memory");
    const int c = lane & 7;
#pragma unroll
    for (int j = 0; j < 4; ++j) { const int n = (lane >> 3) + 8 * j; const LAS float* s = scr + (16 * c) * 33 + n;
        f32x4 a0 = (f32x4){s[0 * 33], s[1 * 33], s[2 * 33], s[3 * 33]} * WSCALE, a1 = (f32x4){s[4 * 33], s[5 * 33], s[6 * 33], s[7 * 33]} * WSCALE;
        f32x4 a2 = (f32x4){s[8 * 33], s[9 * 33], s[10 * 33], s[11 * 33]} * WSCALE, a3 = (f32x4){s[12 * 33], s[13 * 33], s[14 * 33], s[15 * 33]} * WSCALE;
        const u32x2 lo = pk8(a0, a1), hi = pk8(a2, a3);
        int dr = drow0 + n; if (PERM16) { const int r = dr & 255; dr = (dr & ~255) + 128 * ((r >> 3) & 1) + 8 * (r >> 4) + (r & 7); }
        *(u32x4*)(WT8 + (size_t)dr * ldt + k0 + 16 * c) = (u32x4){lo.x, lo.y, hi.x, hi.y}; }
    LDS_WAIT(); asm volatile("" ::: "memory");
}
__device__ __forceinline__ void phase_expert_weights(const float* w1, const float* w3, const float* w2, unsigned char* ws, LAS unsigned char* lds, int gw, int NGW, int wave, int lane) {
    LAS float* scr = (LAS float*)(lds + wave * 16896);
    constexpr int PER = 64;
    for (int it = gw; it < NE * 3 * PER; it += NGW) {
        const int e = it / (3 * PER), r = it % (3 * PER), which = r / PER, item = r % PER;
        if (which < 2) { const int kb = item >> 3, nb = item & 7, n0 = 32 * nb;
            transpose_item128_f8<false>((which ? w3 : w1) + (size_t)e * D * EFF, EFF, 128 * kb, n0, ws + B_W13 + (size_t)e * 512 * D, D, 256 * (n0 >> 7) + which * 128 + (n0 & 127), scr, lane); }
        else { const int kb = item >> 5, nb = item & 31;
            transpose_item128_f8<true>(w2 + (size_t)e * EFF * D, D, 128 * kb, 32 * nb, ws + B_W2 + (size_t)e * D * EFF, EFF, 32 * nb, scr, lane); }
    }
}
template <bool XBF>
__device__ __forceinline__ void phase_norm_mod(const void* X, const float* gain, const float* mod, int sh_off, int sc_off, bf16_t* out, unsigned char* out8, int gw, int NGW, int lane) {
    constexpr int R = XBF ? 4 : 8;
    for (int m0 = gw; m0 < T; m0 += R * NGW) {
        f32x4 v[R][4];
#pragma unroll
        for (int rr = 0; rr < R; ++rr) { const int m = m0 + rr * NGW; const size_t mr = (size_t)(m < T ? m : m0);
            if constexpr (XBF) { const u32x2* xr = (const u32x2*)((const bf16_t*)X + mr * D) + lane;
#pragma unroll
                for (int j = 0; j < 4; ++j) { const u32x2 w = xr[64 * j]; v[rr][j] = (f32x4){bflo(w.x), bfhi(w.x), bflo(w.y), bfhi(w.y)}; } }
            else { const f32x4* xr = (const f32x4*)((const float*)X + mr * D) + lane;
#pragma unroll
                for (int j = 0; j < 4; ++j) v[rr][j] = xr[64 * j]; } }
#pragma unroll
        for (int rr = 0; rr < R; ++rr) { const int m = m0 + rr * NGW; if (m >= T) break;
            float ss = 0.f;
#pragma unroll
            for (int j = 0; j < 4; ++j) ss += (v[rr][j].x * v[rr][j].x + v[rr][j].y * v[rr][j].y) + (v[rr][j].z * v[rr][j].z + v[rr][j].w * v[rr][j].w);
            const float rstd = __builtin_amdgcn_rsqf(wave_sum(ss) * (1.f / D) + 1e-6f);
            const float* mb = mod + (size_t)(m >> 13) * 6144;
            u32x2* o8 = (u32x2*)(out + (size_t)m * D) + lane;
#pragma unroll
            for (int j = 0; j < 4; ++j) { const int col = 4 * lane + 256 * j;
                const f32x4 g = *(const f32x4*)(gain + col), sc = *(const f32x4*)(mb + sc_off + col), sh = *(const f32x4*)(mb + sh_off + col);
                const f32x4 y = v[rr][j] * rstd * g * (sc + 1.0f) + sh;
                if (out) { u32x2 w; w.x = pk2(y.x, y.y); w.y = pk2(y.z, y.w); o8[64 * j] = w; }
                if (out8) { int t8 = __builtin_amdgcn_cvt_pk_fp8_f32(y.x, y.y, 0, false); t8 = __builtin_amdgcn_cvt_pk_fp8_f32(y.z, y.w, t8, true); *(unsigned*)(out8 + (size_t)m * D + col) = (unsigned)t8; } } }
    }
}
struct YaArgs { bf16_t* ya; const bf16_t* g; const bf16_t* prw; const float* sbon; const float* mu; const float* ln_g; const float* ln_b; };
__device__ __forceinline__ void phase_ya_final(const YaArgs& P, int gw, int NGW, int lane) {
    const int ch0 = lane * 8, head = lane >> 3;
    float muv[8], lg[8], lb[8];
#pragma unroll
    for (int j = 0; j < 8; ++j) { muv[j] = P.mu[1024 + ch0 + j]; lg[j] = P.ln_g[ch0 + j]; lb[j] = P.ln_b[ch0 + j]; }
    for (int m = gw; m < T; m += NGW) {
        const u32x4 yw = *(const u32x4*)(P.ya + (size_t)m * RW + ch0);
        const u32x4 gw4 = *(const u32x4*)(P.g + (size_t)m * RW + ch0);
        const u32x4 vc = *(const u32x4*)(P.prw + (size_t)m * RWKV_COLS + 1024 + ch0);
        u32x4 vp = (u32x4){0u, 0u, 0u, 0u};
        if ((m & (SEQ - 1)) != 0) vp = *(const u32x4*)(P.prw + (size_t)(m - 1) * RWKV_COLS + 1024 + ch0);
        const float sb = P.sbon[(size_t)m * NH + head];
        float y[8], gg[8], vv[8], pv[8];
        y[0] = bflo(yw.x); y[1] = bfhi(yw.x); y[2] = bflo(yw.y); y[3] = bfhi(yw.y); y[4] = bflo(yw.z); y[5] = bfhi(yw.z); y[6] = bflo(yw.w); y[7] = bfhi(yw.w);
        gg[0] = bflo(gw4.x); gg[1] = bfhi(gw4.x); gg[2] = bflo(gw4.y); gg[3] = bfhi(gw4.y); gg[4] = bflo(gw4.z); gg[5] = bfhi(gw4.z); gg[6] = bflo(gw4.w); gg[7] = bfhi(gw4.w);
        vv[0] = bflo(vc.x); vv[1] = bfhi(vc.x); vv[2] = bflo(vc.y); vv[3] = bfhi(vc.y); vv[4] = bflo(vc.z); vv[5] = bfhi(vc.z); vv[6] = bflo(vc.w); vv[7] = bfhi(vc.w);
        pv[0] = bflo(vp.x); pv[1] = bfhi(vp.x); pv[2] = bflo(vp.y); pv[3] = bfhi(vp.y); pv[4] = bflo(vp.z); pv[5] = bfhi(vp.z); pv[6] = bflo(vp.w); pv[7] = bfhi(vp.w);
        float s = 0.f;
#pragma unroll
        for (int j = 0; j < 8; ++j) s += y[j];
        s += __shfl_xor(s, 1); s += __shfl_xor(s, 2); s += __shfl_xor(s, 4);
        const float mean = s * (1.f / 64.f); float q = 0.f;
#pragma unroll
        for (int j = 0; j < 8; ++j) { y[j] -= mean; q += y[j] * y[j]; }
        q += __shfl_xor(q, 1); q += __shfl_xor(q, 2); q += __shfl_xor(q, 4);
        const float rstd = __builtin_amdgcn_rsqf(q * (1.f / 64.f) + 64e-5f);
        float o[8];
#pragma unroll
        for (int j = 0; j < 8; ++j) { const float vs = vv[j] + (pv[j] - vv[j]) * muv[j]; o[j] = (y[j] * rstd * lg[j] + lb[j] + sb * vs) * gg[j]; }
        u32x4 w; w.x = pk2(o[0], o[1]); w.y = pk2(o[2], o[3]); w.z = pk2(o[4], o[5]); w.w = pk2(o[6], o[7]);
        *(u32x4*)(P.ya + (size_t)m * RW + ch0) = w;
    }
}
__device__ __forceinline__ void phase_xs(const bf16_t* prw, const float* mu, bf16_t* xs, int gw, int NGW, int lane) {
    const f32x4 m4 = *(const f32x4*)(mu + 1536 + 4 * lane);
    constexpr int R = 8;
    for (int t0 = gw * R; t0 < T; t0 += NGW * R) {
        u32x2 cw[R], pw[R];
#pragma unroll
        for (int i = 0; i < R; ++i) { const int t = t0 + i; const bf16_t* src = prw + (size_t)t * RWKV_COLS + 1536 + 4 * lane;
            cw[i] = *(const u32x2*)src; pw[i] = (u32x2){0u, 0u};
            if ((t & (SEQ - 1)) != 0) pw[i] = *(const u32x2*)(src - RWKV_COLS); }
#pragma unroll
        for (int i = 0; i < R; ++i) {
            f32x4 v = (f32x4){bflo(cw[i].x), bfhi(cw[i].x), bflo(cw[i].y), bfhi(cw[i].y)}; const f32x4 p = (f32x4){bflo(pw[i].x), bfhi(pw[i].x), bflo(pw[i].y), bfhi(pw[i].y)};
            v = v + (p - v) * m4;
            if (lane < 16) {
#pragma unroll
                for (int j = 0; j < 4; ++j) v[j] = tanhf_(v[j]); }
            else if (lane >= 32) {
#pragma unroll
                for (int j = 0; j < 4; ++j) v[j] = sigmoidf_(v[j]); }
            u32x2 w; w.x = pk2(v[0], v[1]); w.y = pk2(v[2], v[3]);
            *(u32x2*)(xs + (size_t)(t0 + i) * 256 + 4 * lane) = w; }
    }
}
__device__ __forceinline__ void phase_gate(const bf16_t* xs, const bf16_t* gup, bf16_t* g, int gw, int NGW, int lane) {
    const int r = lane & 15, q = lane >> 4;
    for (int item = gw; item < 8 * 256; item += NGW) {
        const int cb = item & 7, tg = item >> 3;
        bf16x8 af[4][4];
#pragma unroll
        for (int mt = 0; mt < 4; ++mt)
#pragma unroll
            for (int s = 0; s < 4; ++s) af[mt][s] = *(const bf16x8*)(gup + (size_t)(cb * 64 + 16 * mt + r) * 128 + 32 * s + 8 * q);
        bf16x8 nb[4];
#pragma unroll
        for (int s = 0; s < 4; ++s) nb[s] = *(const bf16x8*)(xs + (size_t)(tg * 256 + r) * 256 + 128 + 32 * s + 8 * q);
        for (int tt = 0; tt < 16; ++tt) {
            const int t0 = tg * 256 + tt * 16;
            bf16x8 bfr[4];
#pragma unroll
            for (int s = 0; s < 4; ++s) bfr[s] = nb[s];
            if (tt + 1 < 16) {
#pragma unroll
                for (int s = 0; s < 4; ++s) nb[s] = *(const bf16x8*)(xs + (size_t)(t0 + 16 + r) * 256 + 128 + 32 * s + 8 * q); }
#pragma unroll
            for (int mt = 0; mt < 4; ++mt) { f32x4 acc = (f32x4){0.f, 0.f, 0.f, 0.f};
#pragma unroll
                for (int s = 0; s < 4; ++s) acc = __builtin_amdgcn_mfma_f32_16x16x32_bf16(af[mt][s], bfr[s], acc, 0, 0, 0);
                u32x2 w; w.x = pk2(acc[0], acc[1]); w.y = pk2(acc[2], acc[3]);
                *(u32x2*)(g + (size_t)(t0 + r) * RW + cb * 64 + 16 * mt + 4 * q) = w; }
        }
    }
}
__device__ __forceinline__ void phase_combine(float* out, const bf16_t* x1, const unsigned char* slot, const unsigned char* sho, const float* mod, const float* normf, int gw, int NGW, int lane) {
    for (int m = gw; m < T; m += NGW) {
        const int b = m >> 13;
        f32x4* xr = (f32x4*)(out + (size_t)m * D + 16 * lane);
        const float* g2 = mod + (size_t)b * 6144 + 5120 + 16 * lane;
        u32x4 sw[TOPK + 1];
#pragma unroll
        for (int k = 0; k < TOPK; ++k) sw[k] = *(const u32x4*)(slot + ((size_t)m * TOPK + k) * D + 16 * lane);
        sw[TOPK] = *(const u32x4*)(sho + (size_t)m * D + 16 * lane);
        f32x4 x[4];
        { const u32x4 w0 = *(const u32x4*)(x1 + (size_t)m * D + 16 * lane), w1 = *(const u32x4*)(x1 + (size_t)m * D + 16 * lane + 8);
          x[0] = (f32x4){bflo(w0.x), bfhi(w0.x), bflo(w0.y), bfhi(w0.y)}; x[1] = (f32x4){bflo(w0.z), bfhi(w0.z), bflo(w0.w), bfhi(w0.w)};
          x[2] = (f32x4){bflo(w1.x), bfhi(w1.x), bflo(w1.y), bfhi(w1.y)}; x[3] = (f32x4){bflo(w1.z), bfhi(w1.z), bflo(w1.w), bfhi(w1.w)}; }
        f32x4 a[4];
#pragma unroll
        for (int j = 0; j < 4; ++j) a[j] = (f32x4){0.f, 0.f, 0.f, 0.f};
#pragma unroll
        for (int k = 0; k <= TOPK; ++k) { a[0] += up8(sw[k].x); a[1] += up8(sw[k].y); a[2] += up8(sw[k].z); a[3] += up8(sw[k].w); }
        float ss = 0.f;
#pragma unroll
        for (int j = 0; j < 4; ++j) { x[j] = x[j] + *(const f32x4*)(g2 + 4 * j) * a[j]; ss += (x[j].x * x[j].x + x[j].y * x[j].y) + (x[j].z * x[j].z + x[j].w * x[j].w); }
        const float rstd = __builtin_amdgcn_rsqf(wave_sum(ss) * (1.f / D) + 1e-6f);
#pragma unroll
        for (int j = 0; j < 4; ++j) xr[j] = x[j] * rstd * *(const f32x4*)(normf + 16 * lane + 4 * j);
    }
}
namespace rk {
constexpr int LD = 80;
constexpr int SLOTB = 64 * LD * 2;
constexpr int LDG = 136;
typedef LAS bf16_t* lp;
__device__ __forceinline__ lp slot(LAS unsigned char* lds, int i) { return (lp)(lds + i * SLOTB); }
template <int KS>
__device__ __forceinline__ void mm_nt(const LAS bf16_t* X, int ldx, const LAS bf16_t* Y, int ldy, int m, int nt0, int r, int q, f32x4 (&acc)[2]) {
#pragma unroll
    for (int s = 0; s < KS; ++s) {
        const bf16x8 a = *(const LAS bf16x8*)(X + (16 * m + r) * ldx + 32 * s + 8 * q);
#pragma unroll
        for (int n = 0; n < 2; ++n) { const bf16x8 b = *(const LAS bf16x8*)(Y + (16 * (nt0 + n) + r) * ldy + 32 * s + 8 * q); acc[n] = __builtin_amdgcn_mfma_f32_16x16x32_bf16(a, b, acc[n], 0, 0, 0); }
    }
}
__device__ __forceinline__ void st_rm(lp dst, int m, int nt, int r, int q, const f32x4& a) {
#pragma unroll
    for (int ii = 0; ii < 4; ++ii) dst[(16 * m + 4 * q + ii) * LD + 16 * nt + r] = f2bf(a[ii]);
}
__device__ __forceinline__ void st_tr(lp dst, int m, int nt, int r, int q, const f32x4& a) {
    u32x2 w; w.x = pk2(a[0], a[1]); w.y = pk2(a[2], a[3]); *(LAS u32x2*)(dst + (16 * nt + r) * LD + 16 * m + 4 * q) = w;
}
__device__ __forceinline__ void ld_rm(const LAS bf16_t* src, int m, int nt, int r, int q, f32x4& a) {
#pragma unroll
    for (int ii = 0; ii < 4; ++ii) a[ii] = bf2f(src[(16 * m + 4 * q + ii) * LD + 16 * nt + r]);
}
struct Args {
    const bf16_t* prw; const float* mu; const float *w0, *a0, *k_k, *k_a, *r_k;
    const bf16_t *wup, *aup, *gup;
    const bf16_t* xs;
    bf16_t* g; bf16_t* bv; unsigned char* mn; unsigned char* qy;
};
constexpr int LDS_MU = LDS_MISC + 2304;
struct Pre { u32x4 cw[3], pw[3]; bf16x8 xs[4]; };
__device__ __forceinline__ void task_map(int task, int h, int& i, int& ch, int& col) {
    i = task / 24; ch = task % 24;
    col = (ch >> 3) * 512 + h * 64 + 8 * (ch & 7);
}
__device__ __forceinline__ void load_mu(const Args& P, LAS unsigned char* lds, int tid) {
    LAS bf16_t* MU = (LAS bf16_t*)(lds + LDS_MU);
    for (int i = tid; i < 1536; i += NTHREADS) MU[i] = f2bf(P.mu[i]);
    __syncthreads();
}
struct Hd { bf16x8 w[4], a[4]; float w0[2], a0[2], kk[2], ka[2], rk[2]; };
__device__ __forceinline__ void load_head(const Args& P, int h, int tid, Hd& hd) {
    const int lane = tid & 63, r = lane & 15, q = lane >> 4, nh = tid >> 8;
#pragma unroll
    for (int n = 0; n < 2; ++n) { const int row = h * 64 + 16 * (2 * nh + n) + r;
#pragma unroll
        for (int s = 0; s < 2; ++s) { hd.w[s * 2 + n] = *(const bf16x8*)(P.wup + (size_t)row * 64 + 32 * s + 8 * q); hd.a[s * 2 + n] = *(const bf16x8*)(P.aup + (size_t)row * 64 + 32 * s + 8 * q); }
        hd.w0[n] = P.w0[row]; hd.a0[n] = P.a0[row]; hd.kk[n] = P.k_k[row]; hd.ka[n] = P.k_a[row]; hd.rk[n] = P.r_k[row]; }
}
__device__ __forceinline__ void prefetch(const Args& P, int b, int h, int c, int tid, Pre& pre) {
    const int t0 = b * SEQ + c * 64;
#pragma unroll
    for (int it = 0; it < 3; ++it) {
        int i, ch, col; task_map(tid + it * NTHREADS, h, i, ch, col);
        const bf16_t* src = P.prw + (size_t)(t0 + i) * RWKV_COLS + col;
        pre.cw[it] = *(const u32x4*)src;
        pre.pw[it] = (u32x4){0u, 0u, 0u, 0u};
        if (i != 0 || c != 0) pre.pw[it] = *(const u32x4*)(src - RWKV_COLS);
    }
    const int lane = tid & 63, r = lane & 15, q = lane >> 4, m = (tid >> 6) & 3;
    const bf16_t* xr = P.xs + (size_t)(t0 + 16 * m + r) * 256 + 8 * q;
#pragma unroll
    for (int f = 0; f < 4; ++f) pre.xs[f] = *(const bf16x8*)(xr + 32 * f);
}
__device__ __forceinline__ void unit(const Args& P, LAS unsigned char* lds, int b, int h, int c, int uidx, int tid, Pre& pf, Hd& hd, bool has_next, int nb, int nh_, int nc) {
    const int wave = __builtin_amdgcn_readfirstlane(tid >> 6), lane = tid & 63, r = lane & 15, q = lane >> 4, m = wave & 3, nh = wave >> 2;
    const int t0 = b * SEQ + c * 64;
    lp S0 = slot(lds, 0), S1 = slot(lds, 1), S2 = slot(lds, 2), S3 = slot(lds, 3), S4 = slot(lds, 4), S5 = slot(lds, 5), S6 = slot(lds, 6), S7 = slot(lds, 7);
    lp S8 = slot(lds, 8), S9 = slot(lds, 9), S10 = slot(lds, 10), S11 = slot(lds, 11), S12 = slot(lds, 12), S13 = slot(lds, 13), S14 = slot(lds, 14);
    LAS float* PART = (LAS float*)(lds + LDS_MISC);
    LAS float* CT = PART + 256;
    LAS float* DEND = CT + 256;
    const LAS bf16_t* MU = (const LAS bf16_t*)(lds + LDS_MU);
#define RK_BAR() do { asm volatile("s_waitcnt lgkmcnt(0)" ::: "memory"); __builtin_amdgcn_s_barrier(); asm volatile("" ::: "memory"); } while (0)
#define RK_DBG(bit, sp) do {} while (0)
#pragma unroll
    for (int it = 0; it < 3; ++it) {
        int i, ch, col; task_map(tid + it * NTHREADS, h, i, ch, col);
        LAS bf16_t* dst = slot(lds, 8 + (ch >> 3)) + i * LD + 8 * (ch & 7);
        const u32x4 cw = pf.cw[it], pw = pf.pw[it];
        const u32x4 mw = *(const LAS u32x4*)(MU + col);
        const f32x4 m0 = (f32x4){bflo(mw.x), bfhi(mw.x), bflo(mw.y), bfhi(mw.y)}, m1 = (f32x4){bflo(mw.z), bfhi(mw.z), bflo(mw.w), bfhi(mw.w)};
        float v[8], p[8];
        v[0] = bflo(cw.x); v[1] = bfhi(cw.x); v[2] = bflo(cw.y); v[3] = bfhi(cw.y); v[4] = bflo(cw.z); v[5] = bfhi(cw.z); v[6] = bflo(cw.w); v[7] = bfhi(cw.w);
        p[0] = bflo(pw.x); p[1] = bfhi(pw.x); p[2] = bflo(pw.y); p[3] = bfhi(pw.y); p[4] = bflo(pw.z); p[5] = bfhi(pw.z); p[6] = bflo(pw.w); p[7] = bfhi(pw.w);
#pragma unroll
        for (int j = 0; j < 4; ++j) { v[j] += (p[j] - v[j]) * m0[j]; v[4 + j] += (p[4 + j] - v[4 + j]) * m1[j]; }
        u32x4 w; w.x = pk2(v[0], v[1]); w.y = pk2(v[2], v[3]); w.z = pk2(v[4], v[5]); w.w = pk2(v[6], v[7]);
        *(LAS u32x4*)dst = w;
    }
    RK_BAR();
    f32x4 aw[2], aa[2];
#pragma unroll
    for (int n = 0; n < 2; ++n) { aw[n] = (f32x4){0.f, 0.f, 0.f, 0.f}; aa[n] = aw[n]; }
#pragma unroll
    for (int s = 0; s < 2; ++s)
#pragma unroll
        for (int n = 0; n < 2; ++n) { aw[n] = __builtin_amdgcn_mfma_f32_16x16x32_bf16(pf.xs[s], hd.w[s * 2 + n], aw[n], 0, 0, 0); aa[n] = __builtin_amdgcn_mfma_f32_16x16x32_bf16(pf.xs[2 + s], hd.a[s * 2 + n], aa[n], 0, 0, 0); }
    if (has_next) prefetch(P, nb, nh_, nc, tid, pf);
    float rr[2][4], kq[2][4], vv[2][4], av[2][4], lw[2][4], kp[2][4], pre[2][4], preq[2];
    float ss[4] = {0.f, 0.f, 0.f, 0.f}, bs[4] = {0.f, 0.f, 0.f, 0.f};
#pragma unroll
    for (int n = 0; n < 2; ++n) {
        const int ch = 32 * nh + 16 * n + r, chg = h * 64 + ch;
        const float w0v = hd.w0[n], a0v = hd.a0[n], kkc = hd.kk[n], kac = hd.ka[n], rkc = hd.rk[n];
#pragma unroll
        for (int ii = 0; ii < 4; ++ii) {
            const int pos = 16 * m + 4 * q + ii;
            const float rv = bf2f(S8[pos * LD + ch]), kraw = bf2f(S9[pos * LD + ch]); vv[n][ii] = bf2f(S10[pos * LD + ch]); rr[n][ii] = rv;
            const float z = -(w0v + aw[n][ii]);
            const float sp = fmaxf(z, 0.f) + flog(1.0f + fexp(-fabsf(z)));
            lw[n][ii] = -fexp(-sp - 0.5f);
            const float a_ = sigmoidf_(a0v + aa[n][ii]); av[n][ii] = a_;
            const float kk = kraw * kkc; kq[n][ii] = kk;
            const float kpv = kraw * (1.0f + (a_ - 1.0f) * kac); kp[n][ii] = kpv;
            ss[ii] += kk * kk; bs[ii] += rv * kpv * rkc;
        }
        pre[n][0] = lw[n][0]; pre[n][1] = pre[n][0] + lw[n][1]; pre[n][2] = pre[n][1] + lw[n][2]; pre[n][3] = pre[n][2] + lw[n][3];
        const float tot = pre[n][3];
        const float t0_ = __shfl(tot, r), t1_ = __shfl(tot, r + 16), t2_ = __shfl(tot, r + 32), t3_ = __shfl(tot, r + 48);
        preq[n] = (q > 0 ? t0_ : 0.f) + (q > 1 ? t1_ : 0.f) + (q > 2 ? t2_ : 0.f);
        if (q == 0) CT[m * 64 + ch] = (t0_ + t1_) + (t2_ + t3_);
    }
#pragma unroll
    for (int ii = 0; ii < 4; ++ii) {
        ss[ii] = row_sum16(ss[ii]); bs[ii] = row_sum16(bs[ii]);
        if (r == 0) { const int pos = 16 * m + 4 * q + ii; PART[(nh * 64 + pos) * 2] = ss[ii]; PART[(nh * 64 + pos) * 2 + 1] = bs[ii]; }
    }
    RK_BAR();
#pragma unroll
    for (int n = 0; n < 2; ++n) {
        const int ch = 32 * nh + 16 * n + r;
        float carry = 0.f, lend = 0.f;
#pragma unroll
        for (int mm = 0; mm < 4; ++mm) { const float cv = CT[mm * 64 + ch]; lend += cv; carry += (mm < m) ? cv : 0.f; }
        f32x4 tA, tBh, tKh, tV;
#pragma unroll
        for (int ii = 0; ii < 4; ++ii) {
            const int pos = 16 * m + 4 * q + ii;
            const float L = carry + preq[n] + pre[n][ii], Lm1 = L - lw[n][ii];
            const float ssum = PART[pos * 2] + PART[(64 + pos) * 2];
            const float inv = frcp(fmaxf(__builtin_sqrtf(ssum), 1e-12f));
            const float kkn = kq[n][ii] * inv, kb = kkn * av[n][ii];
            const float eN = fexp(-L), eE = fexp(lend - L);
            const float At = -kkn * fexp(Lm1), Rt = rr[n][ii] * fexp(L), Bt = kb * eN, Kt = kp[n][ii] * eN;
            S0[pos * LD + ch] = f2bf(At); S1[pos * LD + ch] = f2bf(Bt); S2[pos * LD + ch] = f2bf(Kt); S3[pos * LD + ch] = f2bf(Rt);
            tA[ii] = At; tBh[ii] = kb * eE; tKh[ii] = kp[n][ii] * eE; tV[ii] = vv[n][ii];
            P.bv[(size_t)(t0 + pos) * RW + h * 64 + ch] = f2bf((PART[pos * 2 + 1] + PART[(64 + pos) * 2 + 1]) * vv[n][ii]);
        }
        { u32x2 w; const int off = ch * LD + 16 * m + 4 * q;
          w.x = pk2(tA[0], tA[1]); w.y = pk2(tA[2], tA[3]); *(LAS u32x2*)(S4 + off) = w;
          w.x = pk2(tBh[0], tBh[1]); w.y = pk2(tBh[2], tBh[3]); *(LAS u32x2*)(S5 + off) = w;
          w.x = pk2(tKh[0], tKh[1]); w.y = pk2(tKh[2], tKh[3]); *(LAS u32x2*)(S6 + off) = w;
          w.x = pk2(tV[0], tV[1]); w.y = pk2(tV[2], tV[3]); *(LAS u32x2*)(S7 + off) = w; }
        if (m == 0 && q == 0) DEND[ch] = fexp(lend);
    }
    RK_BAR();
    if (has_next) load_head(P, nh_, tid, hd);
    RK_DBG(0, S0); RK_DBG(1, S1); RK_DBG(2, S2); RK_DBG(3, S3); RK_DBG(4, S4); RK_DBG(5, S5); RK_DBG(6, S6); RK_DBG(7, S7);
    const int nt0 = 2 * nh;
    f32x4 acc[2], acc2[2];
#define RK_ZERO(a) do { a[0] = (f32x4){0.f, 0.f, 0.f, 0.f}; a[1] = a[0]; } while (0)
#define RK_LDT(src, mt, ntt, a) do { const u32x2 w_ = *(const LAS u32x2*)((src) + (16 * (ntt) + r) * LD + 16 * (mt) + 4 * q); a = (f32x4){bflo(w_.x), bfhi(w_.x), bflo(w_.y), bfhi(w_.y)}; } while (0)
#define RK_MASK(a, ntt, COND) do { _Pragma("unroll") for (int ii = 0; ii < 4; ++ii) { const int row = 16 * m + 4 * q + ii, col = 16 * (ntt) + r; a[ii] = (COND) ? a[ii] : 0.f; } } while (0)
    RK_ZERO(acc); mm_nt<2>(S0, LD, S1, LD, m, nt0, r, q, acc);
#pragma unroll
    for (int n = 0; n < 2; ++n) { RK_MASK(acc[n], nt0 + n, col < row); st_tr(S9, m, nt0 + n, r, q, acc[n]); }
    RK_ZERO(acc); mm_nt<2>(S1, LD, S0, LD, m, nt0, r, q, acc);
#pragma unroll
    for (int n = 0; n < 2; ++n) { RK_MASK(acc[n], nt0 + n, row < col); st_tr(S8, m, nt0 + n, r, q, acc[n]);
#pragma unroll
        for (int ii = 0; ii < 4; ++ii) acc[n][ii] += ((16 * m + 4 * q + ii) == (16 * (nt0 + n) + r)) ? 1.f : 0.f;
        st_tr(S10, m, nt0 + n, r, q, acc[n]); }
    RK_ZERO(acc); mm_nt<2>(S2, LD, S0, LD, m, nt0, r, q, acc);
#pragma unroll
    for (int n = 0; n < 2; ++n) { RK_MASK(acc[n], nt0 + n, row < col); st_tr(S11, m, nt0 + n, r, q, acc[n]); }
    RK_ZERO(acc); mm_nt<2>(S1, LD, S3, LD, m, nt0, r, q, acc);
#pragma unroll
    for (int n = 0; n < 2; ++n) { RK_MASK(acc[n], nt0 + n, row <= col); st_tr(S12, m, nt0 + n, r, q, acc[n]); }
    RK_ZERO(acc); mm_nt<2>(S2, LD, S3, LD, m, nt0, r, q, acc);
#pragma unroll
    for (int n = 0; n < 2; ++n) { RK_MASK(acc[n], nt0 + n, row <= col); st_tr(S13, m, nt0 + n, r, q, acc[n]); }
    RK_BAR();
    RK_ZERO(acc); mm_nt<2>(S8, LD, S9, LD, m, nt0, r, q, acc);
    RK_ZERO(acc2); mm_nt<2>(S9, LD, S8, LD, m, nt0, r, q, acc2);
#pragma unroll
    for (int n = 0; n < 2; ++n) { st_tr(S1, m, nt0 + n, r, q, acc[n]); st_tr(S0, m, nt0 + n, r, q, acc2[n]); }
    RK_ZERO(acc); mm_nt<2>(S11, LD, S7, LD, m, nt0, r, q, acc);
#pragma unroll
    for (int n = 0; n < 2; ++n) st_tr(S14, m, nt0 + n, r, q, acc[n]);
    RK_BAR();
#define RK_ROUND(Tsrc, Tdst, Psrc, PTsrc, Pdst, PTdst) do { \
        RK_LDT(Tsrc, m, nt0, acc[0]); RK_LDT(Tsrc, m, nt0 + 1, acc[1]); mm_nt<2>(PTsrc, LD, Tsrc, LD, m, nt0, r, q, acc); \
        _Pragma("unroll") for (int n = 0; n < 2; ++n) st_tr(Tdst, m, nt0 + n, r, q, acc[n]); \
        RK_ZERO(acc); mm_nt<2>(Psrc, LD, PTsrc, LD, m, nt0, r, q, acc); RK_ZERO(acc2); mm_nt<2>(PTsrc, LD, Psrc, LD, m, nt0, r, q, acc2); \
        _Pragma("unroll") for (int n = 0; n < 2; ++n) { st_tr(PTdst, m, nt0 + n, r, q, acc[n]); st_tr(Pdst, m, nt0 + n, r, q, acc2[n]); } \
        RK_BAR(); } while (0)
#ifndef EXP_SKIP_ROUNDS
    RK_ROUND(S10, S2, S0, S1, S8, S9);
    RK_ROUND(S2, S10, S8, S9, S0, S1);
    RK_ROUND(S10, S2, S0, S1, S8, S9);
    RK_ROUND(S2, S10, S8, S9, S0, S1);
#endif
    RK_LDT(S10, m, nt0, acc[0]); RK_LDT(S10, m, nt0 + 1, acc[1]); mm_nt<2>(S1, LD, S10, LD, m, nt0, r, q, acc);
#pragma unroll
    for (int n = 0; n < 2; ++n) st_tr(S2, m, nt0 + n, r, q, acc[n]);
    RK_BAR();
    RK_ZERO(acc); mm_nt<2>(S2, LD, S4, LD, m, nt0, r, q, acc);
    RK_ZERO(acc2); mm_nt<2>(S2, LD, S14, LD, m, nt0, r, q, acc2);
#pragma unroll
    for (int n = 0; n < 2; ++n) { st_tr(S11, m, nt0 + n, r, q, acc[n]); st_tr(S0, m, nt0 + n, r, q, acc2[n]); }
    RK_BAR();
    {
        const int sw = wave & 1, ntw = wave >> 1;
        unsigned char* mn_ = P.mn + (size_t)uidx * 16384; unsigned char* qy_ = P.qy + (size_t)uidx * 16384;
        f32x4 c2[2];
#define RK_MM2(X, Y) do { _Pragma("unroll") for (int s_ = 0; s_ < 2; ++s_) { const bf16x8 b_ = *(const LAS bf16x8*)((Y) + (16 * ntw + r) * LD + 32 * s_ + 8 * q); \
            _Pragma("unroll") for (int mi = 0; mi < 2; ++mi) { const bf16x8 a_ = *(const LAS bf16x8*)((X) + (16 * (2 * sw + mi) + r) * LD + 32 * s_ + 8 * q); c2[mi] = __builtin_amdgcn_mfma_f32_16x16x32_bf16(a_, b_, c2[mi], 0, 0, 0); } } } while (0)
        RK_ZERO(c2); RK_MM2(S11, S5);
#pragma unroll
        for (int mi = 0; mi < 2; ++mi)
#pragma unroll
            for (int ii = 0; ii < 4; ++ii) { const int row = 16 * (2 * sw + mi) + 4 * q + ii, col = 16 * ntw + r; c2[mi][ii] += (row == col) ? DEND[row] : 0.f; }
        { u32x4 w; w.x = pk2(c2[0][0], c2[0][1]); w.y = pk2(c2[0][2], c2[0][3]); w.z = pk2(c2[1][0], c2[1][1]); w.w = pk2(c2[1][2], c2[1][3]); *(u32x4*)(mn_ + ((ntw * 2 + sw) * 64 + lane) * 16) = w; }
#pragma unroll
        for (int mi = 0; mi < 2; ++mi) { const u32x2 rw_ = *(const LAS u32x2*)(S3 + (16 * ntw + r) * LD + 16 * (2 * sw + mi) + 4 * q); c2[mi] = (f32x4){bflo(rw_.x), bfhi(rw_.x), bflo(rw_.y), bfhi(rw_.y)}; }
        RK_MM2(S11, S12);
        { u32x4 w; w.x = pk2(c2[0][0], c2[0][1]); w.y = pk2(c2[0][2], c2[0][3]); w.z = pk2(c2[1][0], c2[1][1]); w.w = pk2(c2[1][2], c2[1][3]); *(u32x4*)(qy_ + ((ntw * 2 + sw) * 64 + lane) * 16) = w; }
        RK_ZERO(c2); RK_MM2(S5, S0); RK_MM2(S6, S7);
#pragma unroll
        for (int mi = 0; mi < 2; ++mi) { u32x2 w; w.x = pk2(c2[mi][0], c2[mi][1]); w.y = pk2(c2[mi][2], c2[mi][3]); *(u32x2*)(mn_ + 8192 + ((ntw * 4 + 2 * sw + mi) * 64 + lane) * 8) = w; }
        RK_ZERO(c2); RK_MM2(S0, S12); RK_MM2(S7, S13);
#pragma unroll
        for (int mi = 0; mi < 2; ++mi) { u32x2 w; w.x = pk2(c2[mi][0], c2[mi][1]); w.y = pk2(c2[mi][2], c2[mi][3]); *(u32x2*)(qy_ + 8192 + (((2 * sw + mi) * 4 + ntw) * 64 + lane) * 8) = w; }
#undef RK_MM2
    }
    RK_BAR();
#undef RK_ZERO
#undef RK_ROUND
#undef RK_LDT
#undef RK_MASK
#undef RK_BAR
}
__device__ __forceinline__ void scan_wg(const unsigned char* mn, unsigned char* sbuf, int ubase, int vq, LAS unsigned char* lds, int tid) {
    const int wave = __builtin_amdgcn_readfirstlane(tid >> 6), lane = tid & 63;
    constexpr int NC = SEQ / 64, NS = 8, SLOT = 10240, AHEAD = 6;
    const unsigned char* src = mn + (size_t)ubase * 16384 + lane * 16;
    const bool loader = (wave >= 1 && wave <= 5);
    const size_t poff = (wave == 5) ? (size_t)(8192 + vq * 2048) : (size_t)(2048 * (wave - 1));
#define SC_ISSUE(c) do { const unsigned char* s_ = src + (size_t)(c) * 16384 + poff; LAS unsigned char* d_ = lds + ((c) % NS) * SLOT + 2048 * (wave - 1); \
        _Pragma("unroll") for (int i_ = 0; i_ < 2; ++i_) __builtin_amdgcn_global_load_lds((const unsigned*)(s_ + i_ * 1024), (LAS unsigned*)(d_ + i_ * 1024), 16, 0, 0); } while (0)
#define SC_BAR() do { asm volatile("s_waitcnt lgkmcnt(0)" ::: "memory"); __builtin_amdgcn_s_barrier(); asm volatile("" ::: "memory"); } while (0)
    bf16x8 sB[2];
#pragma unroll
    for (int s = 0; s < 2; ++s) sB[s] = (bf16x8){0, 0, 0, 0, 0, 0, 0, 0};
    if (loader) {
#pragma unroll
        for (int c = 0; c < AHEAD; ++c) SC_ISSUE(c);
        asm volatile("s_waitcnt vmcnt(10)" ::: "memory"); }
    SC_BAR();
    for (int c = 0; c < NC; ++c) {
        if (loader) {
            if (c + AHEAD < NC) { SC_ISSUE(c + AHEAD); asm volatile("s_waitcnt vmcnt(10)" ::: "memory"); }
            else { asm volatile("s_waitcnt vmcnt(0)" ::: "memory"); }
        } else if (wave == 0) {
            const LAS unsigned char* sl = lds + (c % NS) * SLOT;
            unsigned char* so = sbuf + (size_t)(ubase + c) * 8192 + (vq * 2) * 1024 + lane * 16;
            *(bf16x8*)so = sB[0]; *(bf16x8*)(so + 1024) = sB[1];
            f32x4 aS[4];
#pragma unroll
            for (int mm = 0; mm < 4; ++mm) {
                const u32x2 nI = *(const LAS u32x2*)(sl + 8192 + (mm * 64 + lane) * 8);
                aS[mm] = (f32x4){bflo(nI.x), bfhi(nI.x), bflo(nI.y), bfhi(nI.y)};
#pragma unroll
                for (int s = 0; s < 2; ++s) { const bf16x8 aM = *(const LAS bf16x8*)(sl + ((mm * 2 + s) * 64 + lane) * 16); aS[mm] = __builtin_amdgcn_mfma_f32_16x16x32_bf16(aM, sB[s], aS[mm], 0, 0, 0); }
            }
#pragma unroll
            for (int s = 0; s < 2; ++s) { u32x4 w; w.x = pk2(aS[2 * s][0], aS[2 * s][1]); w.y = pk2(aS[2 * s][2], aS[2 * s][3]); w.z = pk2(aS[2 * s + 1][0], aS[2 * s + 1][1]); w.w = pk2(aS[2 * s + 1][2], aS[2 * s + 1][3]);
                sB[s] = __builtin_bit_cast(bf16x8, w); }
        }
        SC_BAR();
    }
#undef SC_ISSUE
#undef SC_BAR
}
struct YArgs { const unsigned char* qy; const unsigned char* sbuf; const bf16_t* g; const bf16_t* bv; const float* ln_g; const float* ln_b; unsigned char* ya; };
__device__ __forceinline__ void ypass_unit(const YArgs& P, int u, int lane) {
    const int r = lane & 15, q = lane >> 4, b = u >> 10, h = (u >> 7) & 7, c = u & 127, t0 = b * SEQ + c * 64;
    const unsigned char* qy_ = P.qy + (size_t)u * 16384; const unsigned char* s_ = P.sbuf + (size_t)u * 8192;
    bf16x8 Qf[4][2], Sf[4][2]; u32x2 y0[4][4];
#pragma unroll
    for (int i = 0; i < 4; ++i)
#pragma unroll
        for (int s = 0; s < 2; ++s) { Qf[i][s] = *(const bf16x8*)(qy_ + ((i * 2 + s) * 64 + lane) * 16); Sf[i][s] = *(const bf16x8*)(s_ + ((i * 2 + s) * 64 + lane) * 16); }
#pragma unroll
    for (int vq = 0; vq < 4; ++vq)
#pragma unroll
        for (int mm = 0; mm < 4; ++mm) y0[vq][mm] = *(const u32x2*)(qy_ + 8192 + ((vq * 4 + mm) * 64 + lane) * 8);
    f32x4 lg[4], lb[4];
#pragma unroll
    for (int vq = 0; vq < 4; ++vq) { lg[vq] = *(const f32x4*)(P.ln_g + h * 64 + 16 * vq + 4 * q); lb[vq] = *(const f32x4*)(P.ln_b + h * 64 + 16 * vq + 4 * q); }
#pragma unroll
    for (int mm = 0; mm < 4; ++mm) {
        const size_t ro = (size_t)(t0 + 16 * mm + r) * RW + h * 64 + 4 * q;
        u32x2 gw_[4], bw_[4];
#pragma unroll
        for (int vq = 0; vq < 4; ++vq) { gw_[vq] = *(const u32x2*)(P.g + ro + 16 * vq); bw_[vq] = *(const u32x2*)(P.bv + ro + 16 * vq); }
        f32x4 acc[4]; float sum = 0.f;
#pragma unroll
        for (int vq = 0; vq < 4; ++vq) {
            acc[vq] = (f32x4){bflo(y0[vq][mm].x), bfhi(y0[vq][mm].x), bflo(y0[vq][mm].y), bfhi(y0[vq][mm].y)};
#pragma unroll
            for (int s = 0; s < 2; ++s) acc[vq] = __builtin_amdgcn_mfma_f32_16x16x32_bf16(Sf[vq][s], Qf[mm][s], acc[vq], 0, 0, 0);
            sum += (acc[vq][0] + acc[vq][1]) + (acc[vq][2] + acc[vq][3]);
        }
        sum += __shfl_xor(sum, 16); sum += __shfl_xor(sum, 32);
        const float mean = sum * (1.f / 64.f); float var = 0.f;
#pragma unroll
        for (int vq = 0; vq < 4; ++vq) { acc[vq] = acc[vq] - mean; var += (acc[vq][0] * acc[vq][0] + acc[vq][1] * acc[vq][1]) + (acc[vq][2] * acc[vq][2] + acc[vq][3] * acc[vq][3]); }
        var += __shfl_xor(var, 16); var += __shfl_xor(var, 32);
        const float rstd = __builtin_amdgcn_rsqf(var * (1.f / 64.f) + 64e-5f);
#pragma unroll
        for (int vq = 0; vq < 4; ++vq) {
            const f32x4 gg = (f32x4){bflo(gw_[vq].x), bfhi(gw_[vq].x), bflo(gw_[vq].y), bfhi(gw_[vq].y)}, bb = (f32x4){bflo(bw_[vq].x), bfhi(bw_[vq].x), bflo(bw_[vq].y), bfhi(bw_[vq].y)};
            const f32x4 o = (acc[vq] * rstd * lg[vq] + lb[vq] + bb) * gg;
            int t8 = __builtin_amdgcn_cvt_pk_fp8_f32(o[0], o[1], 0, false); t8 = __builtin_amdgcn_cvt_pk_fp8_f32(o[2], o[3], t8, true); *(unsigned*)(P.ya + ro + 16 * vq) = (unsigned)t8; }
    }
}
}
namespace gl {
constexpr int LDV = 136;
struct Args { const bf16_t* puv; const bf16_t* wsm; const float* bs; const float* ln_g; const float* ln_b; unsigned char* yb; };
__device__ __forceinline__ void unit(const Args& P, LAS unsigned char* lds, int b, int blk, int tid) {
    const int wave = __builtin_amdgcn_readfirstlane(tid >> 6), lane = tid & 63, r = lane & 15, q = lane >> 4;
    const int t0 = b * SEQ + blk * 128;
    LAS float* STAT = (LAS float*)(lds + LDS_MISC);
#pragma unroll
    for (int hb = 0; hb < 2; ++hb) {
        u32x4 w[8];
#pragma unroll
        for (int j = 0; j < 8; ++j) w[j] = *(const u32x4*)(P.puv + (size_t)(t0 + 16 * wave + 8 * hb + j) * 1024 + 512 + 8 * lane);
#pragma unroll
        for (int j = 0; j < 8; ++j) {
            float v[8]; v[0] = bflo(w[j].x); v[1] = bfhi(w[j].x); v[2] = bflo(w[j].y); v[3] = bfhi(w[j].y); v[4] = bflo(w[j].z); v[5] = bfhi(w[j].z); v[6] = bflo(w[j].w); v[7] = bfhi(w[j].w);
            float s = 0.f, s2 = 0.f;
#pragma unroll
            for (int e = 0; e < 8; ++e) { s += v[e]; s2 += v[e] * v[e]; }
            s = wave_sum(s); s2 = wave_sum(s2);
            const float mean = s * (1.f / 512.f), var = fmaxf(s2 * (1.f / 512.f) - mean * mean, 0.f);
            if (lane == 0) { const int tk = 16 * wave + 8 * hb + j; STAT[tk * 2] = mean; STAT[tk * 2 + 1] = __builtin_amdgcn_rsqf(var + 1e-5f); }
        }
    }
    u32x4 pv[2], pu[2];
#define GL_LOAD(g) do { _Pragma("unroll") for (int it = 0; it < 2; ++it) { const int task = tid + it * NTHREADS, j = task >> 3, cc = task & 7; \
        const bf16_t* row = P.puv + (size_t)(t0 + j) * 1024 + (g) * 64 + 8 * cc; pu[it] = *(const u32x4*)row; pv[it] = *(const u32x4*)(row + 512); } } while (0)
    GL_LOAD(0);
    __syncthreads();
    for (int g = 0; g < 8; ++g) {
        LAS bf16_t* VT = (LAS bf16_t*)(lds + (g & 1) * 20480);
        LAS bf16_t* US = (LAS bf16_t*)(lds + 40960 + (g & 1) * 18432);
#pragma unroll
        for (int it = 0; it < 2; ++it) {
            const int task = tid + it * NTHREADS, j = task >> 3, cc = task & 7, ch = g * 64 + 8 * cc;
            const u32x4 w = pv[it];
            const float mean = STAT[j * 2], rstd = STAT[j * 2 + 1];
            const f32x4 g0 = *(const f32x4*)(P.ln_g + ch), g1 = *(const f32x4*)(P.ln_g + ch + 4), b0 = *(const f32x4*)(P.ln_b + ch), b1 = *(const f32x4*)(P.ln_b + ch + 4);
            float v[8]; v[0] = bflo(w.x); v[1] = bfhi(w.x); v[2] = bflo(w.y); v[3] = bfhi(w.y); v[4] = bflo(w.z); v[5] = bfhi(w.z); v[6] = bflo(w.w); v[7] = bfhi(w.w);
#pragma unroll
            for (int e = 0; e < 4; ++e) { v[e] = (v[e] - mean) * rstd * g0[e] + b0[e]; v[4 + e] = (v[4 + e] - mean) * rstd * g1[e] + b1[e]; }
#pragma unroll
            for (int e = 0; e < 8; ++e) VT[(8 * cc + e) * LDV + j] = f2bf(v[e]);
            *(LAS u32x4*)(US + j * 72 + 8 * cc) = pu[it];
        }
        if (g + 1 < 8) GL_LOAD(g + 1);
        __syncthreads();
        f32x4 acc[4];
#pragma unroll
        for (int n = 0; n < 4; ++n) acc[n] = (f32x4){0.f, 0.f, 0.f, 0.f};
        const bf16_t* wrow = P.wsm + ((size_t)g * 128 + 16 * wave + r) * 128 + 8 * q;
        const int ks = (wave >> 1) + 1;
        for (int s = 0; s < ks; ++s) {
            const bf16x8 a = *(const bf16x8*)(wrow + 32 * s);
#pragma unroll
            for (int n = 0; n < 4; ++n) { const bf16x8 bb = *(const LAS bf16x8*)(VT + (16 * n + r) * LDV + 32 * s + 8 * q); acc[n] = __builtin_amdgcn_mfma_f32_16x16x32_bf16(a, bb, acc[n], 0, 0, 0); }
        }
#pragma unroll
        for (int ii = 0; ii < 4; ++ii) { const int i = 16 * wave + 4 * q + ii; const float bias = P.bs[g * 128 + i];
#pragma unroll
            for (int n = 0; n < 4; ++n) { const int c = 16 * n + r; const float u = bf2f(US[i * 72 + c]);
                P.yb[(size_t)(t0 + i) * RW + g * 64 + c] = (unsigned char)(__builtin_amdgcn_cvt_pk_fp8_f32(u * (acc[n][ii] + bias), 0.f, 0, false) & 0xff); } }
    }
    __syncthreads();
#undef GL_LOAD
}
}

struct RouteArgs { const float* sc; const float* bias; int* eidx; float* ewt; int* lrank; int* tbase; unsigned* segcnt; };
__device__ __forceinline__ unsigned fkey(float v) { const unsigned b = __float_as_uint(v); return b ^ ((b >> 31) ? 0xFFFFFFFFu : 0x80000000u); }
__device__ __forceinline__ void topk_tile(const RouteArgs& P, LAS unsigned char* lds, int tid, int tile) {
    const int wave = __builtin_amdgcn_readfirstlane(tid >> 6), lane = tid & 63, grp = lane >> 3;
    LAS int* hist = (LAS int*)(lds + LDS_MISC);
    const f32x4 bias4 = *(const f32x4*)(P.bias + 4 * lane);
    if (tid < NE) hist[tid] = 0;
    __syncthreads();
    f32x4 nx[2];
#pragma unroll
    for (int u = 0; u < 2; ++u) nx[u] = *(const f32x4*)(P.sc + (size_t)(tile * 256 + wave * 32 + u) * NE + 4 * lane);
    for (int j = 0; j < 32; j += 2) {
        const int t0 = tile * 256 + wave * 32 + j;
        const f32x4 cur4[2] = {nx[0], nx[1]};
        if (j + 2 < 32) {
#pragma unroll
            for (int u = 0; u < 2; ++u) nx[u] = *(const f32x4*)(P.sc + (size_t)(t0 + 2 + u) * NE + 4 * lane); }
        float s[2][4]; unsigned key[2][4];
#pragma unroll
        for (int u = 0; u < 2; ++u) {
            float v[4];
#pragma unroll
            for (int e = 0; e < 4; ++e) { s[u][e] = cur4[u][e]; v[e] = s[u][e] + bias4[e]; }
            float m1, m2;
            { const float a = fmaxf(v[0], v[1]), b = fminf(v[0], v[1]), c = fmaxf(v[2], v[3]), d = fminf(v[2], v[3]); m1 = fmaxf(a, c); m2 = fmaxf(fminf(a, c), fmaxf(b, d)); }
            { float o1 = dppf<DPP_X1>(m1), o2 = dppf<DPP_X1>(m2); float n1 = fmaxf(m1, o1), n2 = fmaxf(fminf(m1, o1), fmaxf(m2, o2)); m1 = n1; m2 = n2;
              o1 = dppf<DPP_X2>(m1); o2 = dppf<DPP_X2>(m2); n1 = fmaxf(m1, o1); n2 = fmaxf(fminf(m1, o1), fmaxf(m2, o2)); m1 = n1; m2 = n2;
              o1 = dppf<DPP_HM>(m1); o2 = dppf<DPP_HM>(m2); n1 = fmaxf(m1, o1); n2 = fmaxf(fminf(m1, o1), fmaxf(m2, o2)); m1 = n1; m2 = n2; }
            const float gs = m1 + m2;
            int cnt = 0;
#pragma unroll
            for (int g = 0; g < 8; ++g) { const float og = __builtin_bit_cast(float, __builtin_amdgcn_readlane(__builtin_bit_cast(int, gs), 8 * g)); cnt += (og > gs || (og == gs && g < grp)) ? 1 : 0; }
#pragma unroll
            for (int e = 0; e < 4; ++e) key[u][e] = (cnt < 4) ? fkey(v[e]) : 0u;
        }
        unsigned thr[2] = {0u, 0u};
#pragma unroll 1
        for (int bit = 31; bit >= 0; --bit) {
#pragma unroll
            for (int u = 0; u < 2; ++u) { const unsigned cand = thr[u] | (1u << bit); int c = 0;
#pragma unroll
                for (int e = 0; e < 4; ++e) c += __builtin_popcountll(__ballot(key[u][e] >= cand));
                thr[u] = (c >= TOPK) ? cand : thr[u]; }
        }
#pragma unroll
        for (int u = 0; u < 2; ++u) {
            const int t = t0 + u;
            bool sel[4]; unsigned long long meq[4]; int cgt = 0;
#pragma unroll
            for (int e = 0; e < 4; ++e) { sel[e] = key[u][e] > thr[u]; cgt += __builtin_popcountll(__ballot(sel[e])); meq[e] = __ballot(key[u][e] == thr[u]); }
            for (int need = TOPK - cgt; need > 0; --need) {
                const unsigned long long many = meq[0] | meq[1] | meq[2] | meq[3];
                const int L = __builtin_ctzll(many);
                const int e_ = ((meq[0] >> L) & 1ull) ? 0 : ((meq[1] >> L) & 1ull) ? 1 : ((meq[2] >> L) & 1ull) ? 2 : 3;
#pragma unroll
                for (int e = 0; e < 4; ++e) { if (e == e_) { meq[e] &= ~(1ull << L); sel[e] = sel[e] || (lane == L); } }
            }
            float part = 0.f;
#pragma unroll
            for (int e = 0; e < 4; ++e) part += sel[e] ? s[u][e] : 0.f;
            part += dppf<DPP_X1>(part); part += dppf<DPP_X2>(part); part += dppf<DPP_HM>(part); part += dppf<DPP_RM>(part);
            const float ssum = (__builtin_bit_cast(float, __builtin_amdgcn_readlane(__builtin_bit_cast(int, part), 0)) + __builtin_bit_cast(float, __builtin_amdgcn_readlane(__builtin_bit_cast(int, part), 16)))
                             + (__builtin_bit_cast(float, __builtin_amdgcn_readlane(__builtin_bit_cast(int, part), 32)) + __builtin_bit_cast(float, __builtin_amdgcn_readlane(__builtin_bit_cast(int, part), 48)));
            const float scale = 2.5f / ssum;
            int base = 0;
#pragma unroll
            for (int e = 0; e < 4; ++e) { const unsigned long long ms = __ballot(sel[e]);
                if (sel[e]) { const int k = base + __builtin_amdgcn_mbcnt_hi((unsigned)(ms >> 32), __builtin_amdgcn_mbcnt_lo((unsigned)ms, 0)); const int idx = 4 * lane + e;
                    const int lr = __hip_atomic_fetch_add(hist + idx, 1, __ATOMIC_RELAXED, __HIP_MEMORY_SCOPE_WORKGROUP);
                    P.eidx[(size_t)t * TOPK + k] = idx; P.ewt[(size_t)t * TOPK + k] = s[u][e] * scale; P.lrank[(size_t)t * TOPK + k] = lr; }
                base += __builtin_popcountll(ms); }
        }
    }
    __syncthreads();
    if (tid < NE) { const int cnt = hist[tid]; unsigned base = 0u;
        if (cnt) base = __hip_atomic_fetch_add(P.segcnt + tid, (unsigned)cnt, __ATOMIC_RELAXED, __HIP_MEMORY_SCOPE_AGENT);
        P.tbase[tile * NE + tid] = (int)base; }
    __syncthreads();
}
struct ScatArgs { const int* eidx; const float* ewt; const int* lrank; const int* tbase; const unsigned* segcnt; int* rowtok; int* rowdst; float* roww; int* tab; unsigned* ntile; };
__device__ __forceinline__ void phase_scatter(const ScatArgs& P, LAS unsigned char* lds, int tid, int G) {
    LAS int* cntL = (LAS int*)(lds + LDS_MISC); LAS int* segst = cntL + 256; LAS int* tsa = segst + 256;
    if (tid < NE) cntL[tid] = (int)__hip_atomic_load(P.segcnt + tid, __ATOMIC_RELAXED, __HIP_MEMORY_SCOPE_AGENT);
    __syncthreads();
    if (tid == 0) {
        int run = 0, ta = 0;
        for (int s = 0; s < NE; ++s) { const int nts = (cntL[s] + 255) >> 8; segst[s] = run; tsa[s] = ta; run += nts * 256; ta += nts; }
        if (blockIdx.x == 0) P.ntile[0] = (unsigned)ta;
    }
    __syncthreads();
    for (int tile = blockIdx.x; tile < T / 256; tile += G) {
        for (int a = tid; a < 256 * TOPK; a += NTHREADS) {
            const int tok = tile * 256 + (a >> 3), k = a & 7; const size_t ai = (size_t)tok * TOPK + k;
            const int e = P.eidx[ai];
            const int pos = segst[e] + P.tbase[tile * NE + e] + P.lrank[ai];
            P.rowtok[pos] = tok; P.rowdst[pos] = tok * TOPK + k; P.roww[pos] = P.ewt[ai];
        }
    }
    for (int s = blockIdx.x; s < NE; s += G) {
        const int st = segst[s], cnt = cntL[s], nts = (cnt + 255) >> 8;
        for (int p = st + cnt + tid; p < st + nts * 256; p += NTHREADS) { P.rowtok[p] = 0; P.rowdst[p] = -1; P.roww[p] = 0.f; }
        if (tid < nts) { int* ta_ = P.tab + 2 * (tsa[s] + tid); ta_[0] = st + 256 * tid; ta_[1] = s; }
    }
}
constexpr int NPHASE = 20;
struct KArgs { const float* in[34]; float* out; unsigned char* ws; int ph_lo, ph_hi; };
template <int PLO, int PHI>
__global__ void __launch_bounds__(NTHREADS, 2) fwd_kernel(KArgs a) {
    extern __shared__ __attribute__((aligned(16))) unsigned char lds_raw[];
    LAS unsigned char* lds = (LAS unsigned char*)lds_raw;
    const int G = gridDim.x, bid = blockIdx.x, NGW = G * NWAVES;
#define PH_IDS() int tid = threadIdx.x; asm volatile("" : "+v"(tid)); const int lane = tid & 63, wave = __builtin_amdgcn_readfirstlane(tid >> 6), gw = bid * NWAVES + wave; (void)lane; (void)wave; (void)gw
    unsigned char* ws = a.ws;
    unsigned* ctl = (unsigned*)(ws + WS_CTL);
    float* mod = (float*)(ws + WS_MOD);
    constexpr int lo = PLO, hi = PHI;
    if (threadIdx.x == 0) *(LAS u32x4*)(lds + LDS_BARW) = (u32x4){0u, 0u, 0u, 0u};
    __syncthreads();
    XcdBarrier bar; bar.bar = ctl + CW_BAR; bar.x = 0; bar.st = nullptr;
    if (hi - lo > 1) bar = xcd_barrier_post(ctl + CW_BAR, (volatile LAS unsigned*)(lds + LDS_BARW));
#define IN(k) (lo <= (k) && (k) < hi)
#ifdef DBG_TIME
#define STAMP(k) do { if (blockIdx.x == 0 && threadIdx.x == 0) ((unsigned long long*)(ctl + 5200))[k] = __builtin_amdgcn_s_memrealtime(); } while (0)
#else
#define STAMP(k) do {} while (0)
#endif
#define SEAM(k) do { if (IN(k) && IN((k) + 1)) xcd_barrier(bar); } while (0)
#ifndef DBG_REPEAT
#define DBG_REPEAT (-1)
#define DBG_NREP 0
#endif
#define REP(k) for (int rep_ = 0; rep_ < (((k) == DBG_REPEAT) ? 1 + DBG_NREP : 1); ++rep_, (((k) == DBG_REPEAT && rep_ <= DBG_NREP) ? xcd_barrier(bar) : (void)0))

    STAMP(0);
    if (IN(0)) REP(0) { PH_IDS();
        phase_mod(a.in[1], a.in[2], a.in[3], mod, lds, tid, G);
    }
    SEAM(0); STAMP(1);
    if (IN(1)) REP(1) { PH_IDS();
        SmallW sw{a.in[6], a.in[22], a.in[23], a.in[24], a.in[25], a.in[30], a.in[31], a.in[32], a.in[9], a.in[11], a.in[12], a.in[20]};
        phase_small_weights(sw, ws, lds, gw, NGW, wave, lane);
        phase_norm_mod<false>(a.in[0], a.in[4], mod, 0, 1024, nullptr, ws + B_H1, gw, NGW, lane);
    }
    SEAM(1); STAMP(2);
    if (IN(2)) REP(2) {
        gm::DenseSched S; S.init(ws + B_H1, ws + SW_WIN, T, IN_COLS, D, G, bid, 1);
        gm::EpiInProj E{(bf16_t*)(ws + B_PRW), (bf16_t*)(ws + B_PUV), (bf16_t*)(ws + B_PG)};
        gm::gemm_phase<gm::EpiInProj, gm::DenseSched, true, true, 122>(lds, D, S, E);
    }
    SEAM(2); STAMP(3);
    if (IN(3)) REP(3) { PH_IDS();
        gl::Args Q{(const bf16_t*)(ws + B_PUV), (const bf16_t*)(ws + SW_WSM), a.in[21], a.in[18], a.in[19], ws + B_YB};
        for (int u = bid; u < 512; u += G) gl::unit(Q, lds, u >> 6, u & 63, tid);
        phase_xs((const bf16_t*)(ws + B_PRW), a.in[7], (bf16_t*)(ws + B_XS), gw, NGW, lane);
    }
    SEAM(3); STAMP(4);
    if (IN(4)) REP(4) { PH_IDS();
        rk::Args P{(const bf16_t*)(ws + B_PRW), a.in[7], a.in[8], a.in[10], a.in[13], a.in[14], a.in[15], (const bf16_t*)(ws + SW_WUP), (const bf16_t*)(ws + SW_AUP), (const bf16_t*)(ws + SW_GUP), (const bf16_t*)(ws + B_XS),
                   (bf16_t*)(ws + B_G), (bf16_t*)(ws + B_BV), ws + B_MN, ws + B_QY};
        phase_gate((const bf16_t*)(ws + B_XS), (const bf16_t*)(ws + SW_GUP), (bf16_t*)(ws + B_G), gw, NGW, lane);
        rk::Pre pre; rk::Hd hd; rk::load_mu(P, lds, tid);
        const bool fixh = (G % 8) == 0; const int nper = fixh ? (G >> 3) : G, first = fixh ? (bid >> 3) : bid, lim = fixh ? 1024 : 8192;
#define RK_UNIT_OF(idx, B_, H_, C_) const int B_ = fixh ? ((idx) >> 7) : ((idx) >> 10), H_ = fixh ? (bid & 7) : (((idx) >> 7) & 7), C_ = (idx) & 127
        if (first < lim) { RK_UNIT_OF(first, b0_, h0_, c0_); rk::prefetch(P, b0_, h0_, c0_, tid, pre); rk::load_head(P, h0_, tid, hd); }
        for (int idx = first; idx < lim; idx += nper) { const int nx = idx + nper; RK_UNIT_OF(idx, b_, h_, c_); RK_UNIT_OF(nx < lim ? nx : idx, nb_, nh__, nc_);
            rk::unit(P, lds, b_, h_, c_, (b_ * 8 + h_) * 128 + c_, tid, pre, hd, nx < lim, nb_, nh__, nc_); }
#undef RK_UNIT_OF
    }
    SEAM(4); STAMP(5);
    if (IN(5)) REP(5) { PH_IDS();
        for (int w = bid; w < 256; w += G) rk::scan_wg(ws + B_MN, ws + B_S, ((w & 7) + 8 * (w >> 5)) * 128, (w >> 3) & 3, lds, tid);
    }
    SEAM(5); STAMP(6);
    if (IN(6)) REP(6) { PH_IDS();
        rk::YArgs Y{ws + B_QY, ws + B_S, (const bf16_t*)(ws + B_G), (const bf16_t*)(ws + B_BV), a.in[16], a.in[17], ws + B_YA};
        for (int u = gw; u < 8192; u += NGW) rk::ypass_unit(Y, u, lane);
    }
    SEAM(6); STAMP(7);
    STAMP(8);
    if (IN(8)) REP(8) {
        gm::DenseSched S; S.init(ws + B_YA, ws + SW_WOA, T, D, RW, G, bid, 1);
        gm::EpiMerge<false> E{(bf16_t*)(ws + B_M1), (const bf16_t*)(ws + B_PG), nullptr};
        gm::gemm_phase<gm::EpiMerge<false>, gm::DenseSched, true, true, 122>(lds, RW, S, E);
    }
    STAMP(9);
    if (IN(9)) {
        gm::DenseSched S; S.init(ws + B_YB, ws + SW_WOB, T, D, RW, G, bid, 1);
        gm::EpiMerge<true> E{(bf16_t*)(ws + B_M1), (const bf16_t*)(ws + B_PG), ws + B_M8};
        gm::gemm_phase<gm::EpiMerge<true>, gm::DenseSched, true, true, 122>(lds, RW, S, E);
    }
    SEAM(9); STAMP(10);
    if (IN(10)) REP(10) {
        gm::DenseSched S; S.init(ws + B_M8, ws + SW_WO, T, D, D, G, bid, 1);
        gm::EpiResid E{(bf16_t*)(ws + B_X1), a.in[0], mod + 2048};
        gm::gemm_phase<gm::EpiResid, gm::DenseSched, true, true, 122>(lds, D, S, E);
    }
    SEAM(10); STAMP(11);
    if (IN(11)) REP(11) { PH_IDS();
        phase_norm_mod<true>(ws + B_X1, a.in[5], mod, 3072, 4096, (bf16_t*)(ws + B_H2), ws + B_H2F8, gw, NGW, lane);
        phase_expert_weights(a.in[27], a.in[28], a.in[29], ws, lds, gw, NGW, wave, lane);
    }
    SEAM(11); STAMP(12);
    if (IN(12)) { PH_IDS();
        RouteArgs R{(const float*)(ws + B_SC), a.in[26], (int*)(ws + RT_EIDX), (float*)(ws + RT_EWT), (int*)(ws + RT_LRANK), (int*)(ws + RT_TBASE), ctl + CW_SEGCNT};
        { gm::DenseSched S; S.init(ws + B_H2, ws + SW_WR, T, NE, D, G, bid); gm::EpiRouter E{(float*)(ws + B_SC)}; gm::gemm_phase<gm::EpiRouter, gm::DenseSched, true>(lds, D, S, E);
          gm::Unit u; for (int i = 0; S.next(i, u); ++i) topk_tile(R, lds, tid, u.pm); }
        { gm::DenseSched S; S.init(ws + B_H2F8, ws + SW_WS13, T, 512, D, G, bid, 1); gm::EpiGateUp<true> E{ws + B_SH}; gm::gemm_phase<gm::EpiGateUp<true>, gm::DenseSched, true, true, 122>(lds, D, S, E); }
    }
    SEAM(12); STAMP(13);
    if (IN(13)) { PH_IDS();
        ScatArgs P{(const int*)(ws + RT_EIDX), (const float*)(ws + RT_EWT), (const int*)(ws + RT_LRANK), (const int*)(ws + RT_TBASE), ctl + CW_SEGCNT,
                   (int*)(ws + RT_ROWTOK), (int*)(ws + RT_ROWDST), (float*)(ws + RT_ROWW), (int*)(ws + RT_TAB), ctl + CW_NT};
        phase_scatter(P, lds, tid, G);
        __syncthreads();
        gm::DenseSched S; S.init(ws + B_SH, ws + SW_WS2, T, D, EFF, G, bid, 1);
        gm::EpiSharedDown E{ws + B_SHO};
        gm::gemm_phase<gm::EpiSharedDown, gm::DenseSched, true, true, 122>(lds, EFF, S, E);
    }
    SEAM(13); STAMP(14); STAMP(15);
    if (IN(15)) REP(15) {
        gm::GroupSched<true> S; S.A = (const char*)(ws + B_H2F8); S.B = (const char*)(ws + B_W13); S.tab = (const int*)(ws + RT_TAB); S.rowtok = (const int*)(ws + RT_ROWTOK);
        S.ntiles = (int)__hip_atomic_load(ctl + CW_NT, __ATOMIC_RELAXED, __HIP_MEMORY_SCOPE_AGENT); S.npn = 2; S.G = G; S.c = bid; S.K = D; S.ebytes = (size_t)512 * D; S.tstep = (size_t)256 * D;
        gm::EpiGateUp<true> E{ws + B_HID};
        gm::gemm_phase<gm::EpiGateUp<true>, gm::GroupSched<true>, true, true, 122>(lds, D, S, E);
    }
    SEAM(15); STAMP(16);
    if (IN(16)) REP(16) {
        gm::GroupSched<false> S; S.A = (const char*)(ws + B_HID); S.B = (const char*)(ws + B_W2); S.tab = (const int*)(ws + RT_TAB); S.rowtok = nullptr;
        S.ntiles = (int)__hip_atomic_load(ctl + CW_NT, __ATOMIC_RELAXED, __HIP_MEMORY_SCOPE_AGENT); S.npn = 4; S.G = G; S.c = bid; S.K = EFF; S.ebytes = (size_t)D * EFF; S.tstep = (size_t)256 * EFF;
        gm::EpiExpertDown E{ws + B_SLOT, (const int*)(ws + RT_ROWDST), (const float*)(ws + RT_ROWW)};
        gm::gemm_phase<gm::EpiExpertDown, gm::GroupSched<false>, true, true, 122>(lds, EFF, S, E);
    }
    SEAM(16); STAMP(17);
    if (IN(17)) { PH_IDS(); phase_combine(a.out, (const bf16_t*)(ws + B_X1), ws + B_SLOT, ws + B_SHO, mod, a.in[33], gw, NGW, lane); }
    STAMP(18); STAMP(19);
    __syncthreads(); STAMP(20);
#undef IN
#undef SEAM
}

#if defined(DBG_CHECK) || defined(DBG_TIME)
#ifdef DBG_TIME
#ifndef TSC
#define TSC 0.25f
#endif
__global__ void dbg_time_out(float* out, const unsigned long long* st) {
    if (threadIdx.x == 0 && blockIdx.x == 0) { out[0] = (float)(st[TA1] - st[TA0]) * 0.01f * TSC; out[1] = (float)(st[TB1] - st[TB0]) * 0.01f * TSC; }
}
static void dbg_run(void* d_out, void* d_ws, hipStream_t stream) {
    dbg_time_out<<<1, 64, 0, stream>>>((float*)d_out, (const unsigned long long*)((unsigned*)((unsigned char*)d_ws + WS_CTL) + 5200));
}
#endif
#endif
#ifndef MK_SINGLE
#define MK_SINGLE 0
#endif
template <int PLO, int PHI> static bool prep_kernel() {
    int per_cu = 0;
    if (hipFuncSetAttribute((const void*)fwd_kernel<PLO, PHI>, hipFuncAttributeMaxDynamicSharedMemorySize, LDS_BYTES) != hipSuccess) { fprintf(stderr, "kernel_launch: hipFuncSetAttribute failed\n"); return false; }
    if (hipOccupancyMaxActiveBlocksPerMultiprocessor(&per_cu, (const void*)fwd_kernel<PLO, PHI>, NTHREADS, LDS_BYTES) != hipSuccess || per_cu < 1) { fprintf(stderr, "kernel_launch: occupancy query says %d\n", per_cu); (void)hipGetLastError(); return false; }
    return true;
}
template <int P> struct PhaseLaunch {
    static bool prep() { return prep_kernel<P, P + 1>() && PhaseLaunch<P + 1>::prep(); }
    static void go(int grid, hipStream_t stream, const KArgs& a) { hipLaunchKernelGGL((fwd_kernel<P, P + 1>), dim3(grid), dim3(NTHREADS), LDS_BYTES, stream, a); PhaseLaunch<P + 1>::go(grid, stream, a); }
};
#ifndef DBG_LAST
#define DBG_LAST NPHASE
#endif
template <> struct PhaseLaunch<DBG_LAST> { static bool prep() { return true; } static void go(int, hipStream_t, const KArgs&) {} };
extern "C" void kernel_launch(void* const* d_in, const int* in_sizes, int n_in, void* d_out, int out_size, void* d_ws, size_t ws_size, hipStream_t stream) {
    static int grid = 0;
    if (grid == 0) {
        if (n_in != 34 || out_size != T * D || ws_size < WS_END) { fprintf(stderr, "kernel_launch: unexpected problem shape (n_in %d, out %d, ws %zu < %zu)\n", n_in, out_size, ws_size, (size_t)WS_END); grid = -1; return; }
        int dev = 0, cus = 0;
        if (hipGetDevice(&dev) != hipSuccess || hipDeviceGetAttribute(&cus, hipDeviceAttributeMultiprocessorCount, dev) != hipSuccess) { grid = -1; return; }
#if MK_SINGLE
        if (!prep_kernel<0, NPHASE>()) { grid = -1; return; }
#else
        if (!PhaseLaunch<0>::prep()) { grid = -1; return; }
#endif
        grid = cus;
    }
    if (grid < 0) return;
    (void)hipMemsetAsync((char*)d_ws + WS_CTL, 0, CTL_ZERO_BYTES, stream);
    KArgs a{};
    for (int i = 0; i < 34; ++i) a.in[i] = (const float*)d_in[i];
    a.out = (float*)d_out; a.ws = (unsigned char*)d_ws; a.ph_lo = 0; a.ph_hi = NPHASE;
#if MK_SINGLE
    hipLaunchKernelGGL((fwd_kernel<0, NPHASE>), dim3(grid), dim3(NTHREADS), LDS_BYTES, stream, a);
#else
    PhaseLaunch<0>::go(grid, stream, a);
#endif
#if defined(DBG_CHECK) || defined(DBG_TIME)
    dbg_run(d_out, d_ws, stream);
#endif
}
```

```cpp
#define MK_SINGLE 1
#include <hip/hip_runtime.h>
#include <cstdio>
#include <cstdint>

#define LAS __attribute__((address_space(3)))
#define GAS __attribute__((address_space(1)))
typedef unsigned short bf16_t;
typedef short bf16x8 __attribute__((ext_vector_type(8)));
typedef float f32x4 __attribute__((ext_vector_type(4)));
typedef float f32x2 __attribute__((ext_vector_type(2)));
typedef unsigned u32x4 __attribute__((ext_vector_type(4)));
typedef unsigned u32x2 __attribute__((ext_vector_type(2)));

constexpr int D = 1024, NB = 8, SEQ = 8192, T = NB * SEQ;
constexpr int RW = 512, HD = 64, NH = 8;
constexpr int RWKV_COLS = 1792, IN_COLS = 4864;
constexpr int NE = 256, TOPK = 8, EFF = 256;
constexpr int NWAVES = 8, NTHREADS = 512;
constexpr int MAXROWS = T * TOPK + 256 * 256;

constexpr size_t MiB = 1u << 20;
constexpr size_t WS_CTL = 0;
constexpr int CW_BAR = 0, CW_SEGCNT = 4096, CW_NT = 4608;
constexpr size_t CTL_ZERO_BYTES = 32768;
constexpr size_t WS_MOD = 65536;
constexpr size_t WS_SW = 1 * MiB;
constexpr size_t SW_WIN = WS_SW;
constexpr size_t SW_WOA = SW_WIN + (size_t)IN_COLS * D * 2;
constexpr size_t SW_WOB = SW_WOA + (size_t)D * RW * 2;
constexpr size_t SW_WO = SW_WOB + (size_t)D * RW * 2;
constexpr size_t SW_WR = SW_WO + (size_t)D * D * 2;
constexpr size_t SW_WS13 = SW_WR + (size_t)NE * D * 2;
constexpr size_t SW_WS2 = SW_WS13 + (size_t)512 * D * 2;
constexpr size_t SW_WUP = SW_WS2 + (size_t)D * EFF * 2;
constexpr size_t SW_AUP = SW_WUP + (size_t)RW * 64 * 2;
constexpr size_t SW_GUP = SW_AUP + (size_t)RW * 64 * 2;
constexpr size_t SW_WSM = SW_GUP + (size_t)RW * 128 * 2;
constexpr size_t SW_END = SW_WSM + (size_t)8 * 128 * 128 * 2;
static_assert(SW_END <= 20 * MiB, "small weights");
constexpr size_t WS_RT = 20 * MiB;
constexpr size_t RT_EIDX = WS_RT;
constexpr size_t RT_EWT = RT_EIDX + (size_t)T * 8 * 4;
constexpr size_t RT_LRANK = RT_EWT + (size_t)T * 8 * 4;
constexpr size_t RT_TBASE = RT_LRANK + (size_t)T * 8 * 4;
constexpr size_t RT_ROWTOK = RT_TBASE + (size_t)256 * 256 * 4;
constexpr size_t RT_ROWDST = RT_ROWTOK + (size_t)MAXROWS * 4;
constexpr size_t RT_ROWW = RT_ROWDST + (size_t)MAXROWS * 4;
constexpr size_t RT_TAB = RT_ROWW + (size_t)MAXROWS * 4;
constexpr size_t RT_SBON = RT_TAB + (size_t)3 * 4096 * 8;
constexpr size_t RT_END = RT_SBON + (size_t)T * 8 * 4;
static_assert(RT_END <= 40 * MiB, "routing arrays");
constexpr size_t WS_BIG = 40 * MiB;
constexpr size_t B_H1 = WS_BIG + 0 * MiB;
constexpr size_t B_YB = WS_BIG + 0 * MiB;
constexpr size_t B_YA = WS_BIG + 64 * MiB;
constexpr size_t B_XS = WS_BIG + 64 * MiB;
constexpr size_t B_PRW = WS_BIG + 128 * MiB;
constexpr size_t B_M8 = WS_BIG + 128 * MiB;
constexpr size_t B_S = WS_BIG + 128 * MiB;
constexpr size_t B_PUV = WS_BIG + 352 * MiB;
constexpr size_t B_QY = WS_BIG + 352 * MiB;
constexpr size_t B_M1 = WS_BIG + 352 * MiB;
constexpr size_t B_PG = WS_BIG + 480 * MiB;
constexpr size_t B_MN = WS_BIG + 736 * MiB;
constexpr size_t B_G = WS_BIG + 864 * MiB;
constexpr size_t B_BV = WS_BIG + 928 * MiB;
constexpr size_t B_H2 = WS_BIG + 0 * MiB;
constexpr size_t B_W13 = WS_BIG + 128 * MiB;
constexpr size_t B_H2F8 = WS_BIG + 256 * MiB;
constexpr size_t B_SH = WS_BIG + 384 * MiB;
constexpr size_t B_SC = WS_BIG + 416 * MiB;
constexpr size_t B_SLOT = WS_BIG + 0 * MiB;
constexpr size_t B_SHO = WS_BIG + 928 * MiB;
constexpr size_t B_W2 = WS_BIG + 512 * MiB;
constexpr size_t B_X1 = WS_BIG + 576 * MiB;
constexpr size_t B_HID = WS_BIG + 704 * MiB;
constexpr size_t WS_END = WS_BIG + 992 * MiB;
static_assert((size_t)MAXROWS * EFF * 2 <= 320 * MiB, "hid");

constexpr int LDS_STAGE = 0;
constexpr int LDS_MISC = 153600;
constexpr int LDS_BARW = 161792;
constexpr int LDS_BYTES = 163840;

typedef __bf16 bf16x2_t __attribute__((ext_vector_type(2)));
__device__ __forceinline__ unsigned pk2(float lo, float hi) { f32x2 f = {lo, hi}; return __builtin_bit_cast(unsigned, __builtin_convertvector(f, bf16x2_t)); }
__device__ __forceinline__ u32x2 pk8(const f32x4& a, const f32x4& b) { u32x2 w; int t = __builtin_amdgcn_cvt_pk_fp8_f32(a[0], a[1], 0, false); t = __builtin_amdgcn_cvt_pk_fp8_f32(a[2], a[3], t, true); w.x = (unsigned)t;
    t = __builtin_amdgcn_cvt_pk_fp8_f32(b[0], b[1], 0, false); t = __builtin_amdgcn_cvt_pk_fp8_f32(b[2], b[3], t, true); w.y = (unsigned)t; return w; }
__device__ __forceinline__ f32x4 up8(unsigned w) { const f32x2 lo = __builtin_amdgcn_cvt_pk_f32_fp8((int)w, false), hi = __builtin_amdgcn_cvt_pk_f32_fp8((int)w, true); return (f32x4){lo.x, lo.y, hi.x, hi.y}; }
__device__ __forceinline__ float bflo(unsigned w) { return __uint_as_float(w << 16); }
__device__ __forceinline__ float bfhi(unsigned w) { return __uint_as_float(w & 0xffff0000u); }
__device__ __forceinline__ float bf2f(bf16_t h) { return __uint_as_float(((unsigned)h) << 16); }
__device__ __forceinline__ bf16_t f2bf(float f) { return (bf16_t)(pk2(f, 0.f) & 0xffffu); }
__device__ __forceinline__ float fexp(float x) { return __builtin_amdgcn_exp2f(x * 1.44269504089f); }
__device__ __forceinline__ float flog(float x) { return __builtin_amdgcn_logf(x) * 0.69314718056f; }
__device__ __forceinline__ float frcp(float x) { return __builtin_amdgcn_rcpf(x); }
__device__ __forceinline__ float sigmoidf_(float x) { return frcp(1.0f + fexp(-x)); }
__device__ __forceinline__ float siluf_(float x) { return x * sigmoidf_(x); }
__device__ __forceinline__ float tanhf_(float x) { return 1.0f - 2.0f * frcp(1.0f + fexp(2.0f * x)); }
__device__ __forceinline__ float gelu_tanh(float x) { const float u = 0.7978845608f * (x + 0.044715f * x * x * x); return x * frcp(1.0f + fexp(-2.0f * u)); }
template <int CTRL> __device__ __forceinline__ float dppf(float v) { return __builtin_bit_cast(float, __builtin_amdgcn_update_dpp(0, __builtin_bit_cast(int, v), CTRL, 0xf, 0xf, true)); }
constexpr int DPP_X1 = 0xB1, DPP_X2 = 0x4E, DPP_HM = 0x141, DPP_RM = 0x140;
__device__ __forceinline__ float row_sum16(float v) { v += dppf<DPP_X1>(v); v += dppf<DPP_X2>(v); v += dppf<DPP_HM>(v); v += dppf<DPP_RM>(v); return v; }
__device__ __forceinline__ float rdl(float v, int l) { return __builtin_bit_cast(float, __builtin_amdgcn_readlane(__builtin_bit_cast(int, v), l)); }
__device__ __forceinline__ float wave_sum(float v) { v = row_sum16(v); return (rdl(v, 0) + rdl(v, 16)) + (rdl(v, 32) + rdl(v, 48)); }
#define LDS_WAIT() asm volatile("s_waitcnt lgkmcnt(0)" ::: "memory")
#define VM_WAIT() asm volatile("s_waitcnt vmcnt(0)" ::: "memory")

#define XB_TMO      128
#define XB_XCNT(j)  (256  + 64 * (j))
#define XB_XSUB(j)  (1280 + 64 * (j))
#define XB_XGEN(j)  (2304 + 64 * (j))
#define XB_TOP      3328
#define XB_TOPGEN   3392
#define XCD_BAR_WORDS 3456
#define XB_SPIN_CAP (1u << 18)
__device__ __forceinline__ unsigned xb_ld(unsigned* p)              { return __hip_atomic_load(p, __ATOMIC_RELAXED, __HIP_MEMORY_SCOPE_AGENT); }
__device__ __forceinline__ unsigned xb_add(unsigned* p, unsigned v) { return __hip_atomic_fetch_add(p, v, __ATOMIC_RELAXED, __HIP_MEMORY_SCOPE_AGENT); }
__device__ __forceinline__ unsigned xb_xcc_id() { return (unsigned)__builtin_amdgcn_s_getreg((3 << 11) | 20) & 0xFu; }
#define XB_SPIN(cond, bar) do { unsigned _sp = 0; while (cond) { __builtin_amdgcn_s_sleep(1); \
    if ((++_sp & 255u) == 0u) { if (xb_ld(&(bar)[XB_TMO])) break; if (_sp > XB_SPIN_CAP) { atomicAdd(&(bar)[XB_TMO], 1u); break; } } } } while (0)
struct XcdBarrier { unsigned* bar; unsigned x; volatile LAS unsigned* st; };
__device__ __forceinline__ XcdBarrier xcd_barrier_post(unsigned* bar, volatile LAS unsigned* st) {
    XcdBarrier b; b.bar = bar; b.x = xb_xcc_id(); b.st = st;
    if (threadIdx.x == 0) (void)xb_add(&bar[XB_XCNT(b.x)], 1u);
    return b;
}
__device__ __forceinline__ void xcd_barrier_complete(unsigned* bar, unsigned x, unsigned& nloc, unsigned& nx) {
    const unsigned G = gridDim.x * gridDim.y * gridDim.z;
    unsigned sum, cnt, mine, sp = 0u;
    for (;;) {
        sum = 0u; cnt = 0u; mine = 0u;
#pragma unroll
        for (unsigned j = 0; j < 16; ++j) { const unsigned c = xb_ld(&bar[XB_XCNT(j)]); sum += c; cnt += (c > 0u) ? 1u : 0u; mine = (j == x) ? c : mine; }
        if (sum == G) break;
        __builtin_amdgcn_s_sleep(1);
        if ((++sp & 255u) == 0u) { if (xb_ld(&bar[XB_TMO])) break; if (sp > XB_SPIN_CAP) { atomicAdd(&bar[XB_TMO], 1u); break; } }
    }
    nloc = mine > 0u ? mine : 1u; nx = cnt > 0u ? cnt : 1u;
}
__device__ __forceinline__ void xcd_barrier(const XcdBarrier& b) {
    asm volatile("s_waitcnt vmcnt(0)" ::: "memory");
    __syncthreads();
    if (threadIdx.x == 0) {
        unsigned* bar = b.bar;
        __builtin_amdgcn_s_waitcnt(0);
        unsigned nloc = b.st[0], nx = b.st[1];
        if (nloc == 0u) { xcd_barrier_complete(bar, b.x, nloc, nx); b.st[0] = nloc; b.st[1] = nx; }
        const unsigned old = xb_add(&bar[XB_XSUB(b.x)], 1u);
        const unsigned gen = old / nloc;
        if (old + 1u == (gen + 1u) * nloc) {
            __builtin_amdgcn_fence(__ATOMIC_RELEASE, "agent");
            asm volatile("s_waitcnt vmcnt(0)" ::: "memory");
            const unsigned og = xb_add(&bar[XB_TOP], 1u);
            const unsigned tg = og / nx;
            if (og + 1u == (tg + 1u) * nx) xb_add(&bar[XB_TOPGEN], 1u);
            else XB_SPIN(xb_ld(&bar[XB_TOPGEN]) == tg, bar);
            __builtin_amdgcn_fence(__ATOMIC_ACQUIRE, "agent");
            xb_add(&bar[XB_XGEN(b.x)], 1u);
            asm volatile("s_waitcnt vmcnt(0)" ::: "memory");
        } else {
            XB_SPIN(xb_ld(&bar[XB_XGEN(b.x)]) == gen, bar);
            __builtin_amdgcn_fence(__ATOMIC_ACQUIRE, "agent");
            asm volatile("s_waitcnt vmcnt(0)" ::: "memory");
        }
    }
    __syncthreads();
}
namespace gm {
typedef int i32x4 __attribute__((ext_vector_type(4)));
typedef int i32x8 __attribute__((ext_vector_type(8)));
constexpr int BM = 256, BK = 64, HALF = 128, HTB = HALF * BK * 2, STAGE_BYTES = 8 * HTB, NXCD = 8, WGM = 8;
__host__ __device__ __forceinline__ int lds_byte(int r, int c) { const int st = (r >> 4) * 2 + (c >> 5), rr = r & 15, cc = c & 31, ob = rr * 64 + cc * 2; return st * 1024 + (ob ^ (((ob >> 9) & 1) << 5)); }
__host__ __device__ __forceinline__ void stage_rc(int b, int& R, int& C) { const int st = b / 1024, sb = b % 1024, swz = sb ^ (((sb >> 9) & 1) << 5); R = (st >> 1) * 16 + swz / 64; C = (st & 1) * 32 + (swz % 64) / 2; }
__host__ __device__ __forceinline__ int perm32(int rho) { const int n = rho >> 4, i = rho & 15; return 8 * (i >> 2) + 4 * n + (i & 3); }

struct Unit { int pm, pn, e, row0, par; };

struct DenseSched {
    static constexpr bool GATHER = false;
    const char* A; const char* B; int nM, nN, nwg, G, c; size_t tstep; const int* rowtok; int K;
    __device__ __forceinline__ void init(const void* A_, const void* B_, int M, int N, int K, int G_, int c_, int es = 2) { A = (const char*)A_; B = (const char*)B_; nM = M / BM; nN = N / BM; nwg = nM * nN; G = G_; c = c_; tstep = (size_t)BM * K * es; rowtok = nullptr; this->K = 0; }
    __device__ __forceinline__ bool next(int i, Unit& u) const {
        const long L = (long)i * G + c; if (L >= nwg) return false;
        int wgid = (int)L; { const int q = nwg / NXCD, r = nwg % NXCD, xcd = wgid % NXCD, off = wgid / NXCD; wgid = (xcd < r ? xcd * (q + 1) : r * (q + 1) + (xcd - r) * q) + off; }
        const int nig = WGM * nN, gid = wgid / nig, fm = gid * WGM, gsz = (nM - fm) < WGM ? (nM - fm) : WGM;
        u.pm = fm + ((wgid % nig) % gsz); u.pn = (wgid % nig) / gsz; u.e = 0; u.row0 = u.pm * BM; return true;
    }
    __device__ __forceinline__ const char* a_ptr(const Unit& u) const { return A + (size_t)u.pm * tstep; }
    __device__ __forceinline__ const char* b_ptr(const Unit& u) const { return B + (size_t)u.pn * tstep; }
    __device__ __forceinline__ unsigned row_off(const Unit&, int) const { return 0u; }
};
template <bool GATHER_>
struct GroupSched {
    static constexpr bool GATHER = GATHER_;
    const char* A; const char* B; const int* tab; const int* rowtok; int ntiles, npn, G, c, K; size_t ebytes, tstep;
    __device__ __forceinline__ bool next(int i, Unit& u) const {
        int tile;
        if (G == 256) {
            const int xcd = c & 7, slot = c >> 3, tpx = 32 / npn; tile = i * 8 * tpx + xcd * tpx + slot / npn; u.pn = slot % npn; if (tile >= ntiles) return false;
        } else { const long L = (long)i * G + c; if (L >= (long)ntiles * npn) return false; tile = (int)(L / npn); u.pn = (int)(L % npn); }
        u.pm = tile;
        u.row0 = __builtin_amdgcn_readfirstlane(tab[2 * tile]); u.e = __builtin_amdgcn_readfirstlane(tab[2 * tile + 1]); return true;
    }
    __device__ __forceinline__ const char* a_ptr(const Unit& u) const { return GATHER ? A : A + (size_t)u.row0 * K; }
    __device__ __forceinline__ const char* b_ptr(const Unit& u) const { return B + (size_t)u.e * ebytes + (size_t)u.pn * tstep; }
    __device__ __forceinline__ unsigned row_off(const Unit& u, int r) const { return (unsigned)rowtok[u.row0 + r] * (unsigned)K; }
};

template <class Epi, class Sched, bool ALIGN_EPI, bool F8 = false, int SCALE_W = 127>
__device__ __forceinline__ void gemm_phase(LAS unsigned char* lds, const int Kel, const Sched& S, const Epi& E) {
    const int K = F8 ? Kel / 2 : Kel;
    int tid_ = threadIdx.x; asm volatile("" : "+v"(tid_));
    const int tid = tid_, wid = __builtin_amdgcn_readfirstlane(tid >> 6), lane = tid & 63, wr = wid >> 2, wc = wid & 3, fr = lane & 15, fq = lane >> 4;
    const int nt = K / BK;
    int sR[2], sC[2]; unsigned voffB[2];
#pragma unroll
    for (int i = 0; i < 2; ++i) { int R, C; stage_rc(tid * 16 + i * 8192, R, C); sR[i] = R; sC[i] = C; const int Rb = Epi::PERM ? ((R & ~31) + perm32(R & 31)) : R; voffB[i] = (unsigned)(Rb * K + C) * 2u; }
    const size_t kstep = (size_t)(BK * 2);
    const size_t hstep = (size_t)HALF * K * 2;
    const unsigned ldsw = (unsigned)wid * 1024u;
    const int aoff = lds_byte(wr * 64 + fr, fq * 8), boff = lds_byte(wc * 32 + fr, fq * 8);
#define PG8_SA(b, h) (((b) * 2 + (h)) * HTB)
#define PG8_SB(b, h) ((4 + (b) * 2 + (h)) * HTB)
#define PG8_STGB(bufoff, gbase) do { _Pragma("unroll") for (int _i = 0; _i < 2; ++_i) \
        __builtin_amdgcn_global_load_lds((const unsigned*)((const char*)(gbase) + voffB[_i]), (LAS unsigned*)(lds + (bufoff) + ldsw + _i * 8192), 16, 0, 0); } while (0)
#define PG8_STGA(bufoff, gbase, VO, h) do { _Pragma("unroll") for (int _i = 0; _i < 2; ++_i) \
        __builtin_amdgcn_global_load_lds((const unsigned*)((const char*)(gbase) + VO[h][_i]), (LAS unsigned*)(lds + (bufoff) + ldsw + _i * 8192), 16, 0, 0); } while (0)
#define PG8_VOA(u, VO) do { _Pragma("unroll") for (int _h = 0; _h < 2; ++_h) _Pragma("unroll") for (int _i = 0; _i < 2; ++_i) \
        VO[_h][_i] = Sched::GATHER ? (S.row_off(u, _h * HALF + sR[_i]) + (unsigned)sC[_i] * 2u) : ((unsigned)((_h * HALF + sR[_i]) * K + sC[_i]) * 2u); } while (0)
#define PG8_LDA(dst, b, h) do { _Pragma("unroll") for (int m = 0; m < 4; ++m) { if constexpr (F8) { dst##8[m].lo = *(const LAS i32x4*)(lds + PG8_SA(b, h) + aoff + m * 2048); dst##8[m].hi = *(const LAS i32x4*)(lds + PG8_SA(b, h) + aoff + m * 2048 + 1024); } else { _Pragma("unroll") for (int k = 0; k < 2; ++k) dst[m][k] = *(const LAS bf16x8*)(lds + PG8_SA(b, h) + aoff + m * 2048 + k * 1024); } } } while (0)
#define PG8_LDB(dst, b, h) do { _Pragma("unroll") for (int n = 0; n < 2; ++n) { if constexpr (F8) { dst##8[n].lo = *(const LAS i32x4*)(lds + PG8_SB(b, h) + boff + n * 2048); dst##8[n].hi = *(const LAS i32x4*)(lds + PG8_SB(b, h) + boff + n * 2048 + 1024); } else { _Pragma("unroll") for (int k = 0; k < 2; ++k) dst[n][k] = *(const LAS bf16x8*)(lds + PG8_SB(b, h) + boff + n * 2048 + k * 1024); } } } while (0)
#define PG8_MMA(ai, bj, At, Bt) do { __builtin_amdgcn_s_setprio(1); _Pragma("unroll") for (int m = 0; m < 4; ++m) _Pragma("unroll") for (int n = 0; n < 2; ++n) { \
        if constexpr (F8) { asm volatile("v_mfma_scale_f32_16x16x128_f8f6f4 %0, %1, %2, %0, %3, %4 op_sel_hi:[0,0,0]" : "+v"(acc[ai][bj][m][n]) : "v"(Bt##8[n]), "v"(At##8[m]), "v"(scw_), "v"(sca_)); } \
        else { _Pragma("unroll") for (int k = 0; k < 2; ++k) acc[ai][bj][m][n] = __builtin_amdgcn_mfma_f32_16x16x32_bf16(Bt[n][k], At[m][k], acc[ai][bj][m][n], 0, 0, 0); } } \
        __builtin_amdgcn_s_setprio(0); } while (0)
#define PG8_WAIT_V(n) asm volatile("s_waitcnt vmcnt(" #n ")" ::: "memory")
#define PG8_WAIT_L(n) asm volatile("s_waitcnt lgkmcnt(" #n ")" ::: "memory")
#define PG8_BAR __builtin_amdgcn_s_barrier()
#define PG8_SCHED __builtin_amdgcn_sched_barrier(0)
    Unit cur, nxt; int ui = 0;
    if (!S.next(0, cur)) return;
    f32x4 acc[2][2][4][2];
#pragma unroll
    for (int a = 0; a < 2; ++a)
#pragma unroll
        for (int b = 0; b < 2; ++b)
#pragma unroll
            for (int m = 0; m < 4; ++m)
#pragma unroll
                for (int n = 0; n < 2; ++n) acc[a][b][m][n] = (f32x4){0.f, 0.f, 0.f, 0.f};
    const int scw_ = SCALE_W, sca_ = 127;
    bf16x8 At[4][2], B0[2][2], B1[2][2]; i32x8 At8[4], B08[2], B18[2];
    unsigned voA[2][2], nvoA[2][2];
    PG8_VOA(cur, voA);
    if (Sched::GATHER) { asm volatile("s_waitcnt vmcnt(0)" ::: "memory"); }
    const char* cA = S.a_ptr(cur); const char* cB = S.b_ptr(cur);
    cur.par = 0; E.stage_rows(cur, lds, wid);
    PG8_STGB(PG8_SB(0, 0), cB); PG8_STGB(PG8_SB(0, 1), cB + hstep); PG8_STGA(PG8_SA(0, 0), cA, voA, 0); PG8_STGA(PG8_SA(0, 1), cA, voA, 1);
    if (wr == 1) PG8_BAR;
    PG8_WAIT_V(2); PG8_BAR;
    PG8_STGB(PG8_SB(1, 0), cB + kstep); PG8_STGA(PG8_SA(1, 0), cA + kstep, voA, 0); PG8_STGB(PG8_SB(1, 1), cB + hstep + kstep);
    PG8_WAIT_V(6); PG8_BAR;
    Unit nn; bool has_next = S.next(1, nxt);
    for (;;) {
        nxt.par = (ui + 1) & 3;
        const bool has_nn = has_next && S.next(ui + 2, nn);
        const char* nA = has_next ? S.a_ptr(nxt) : cA; const char* nB = has_next ? S.b_ptr(nxt) : cB;
        if (Sched::GATHER) {
            if (has_next) { if (wid < 4) __builtin_amdgcn_global_load_lds((const unsigned*)(S.rowtok + nxt.row0 + wid * 64 + lane), (LAS unsigned*)(lds + LDS_MISC + nxt.par * 1024 + wid * 256), 4, 0, 0); }
#pragma unroll
            for (int h = 0; h < 2; ++h)
#pragma unroll
                for (int i = 0; i < 2; ++i) nvoA[h][i] = voA[h][i]; }
#pragma unroll 1
        for (int t = 0; t < nt; t += 2) {
            if constexpr (Epi::MIDK) { if (t == (nt >> 1)) {
                if constexpr (F8) asm volatile("s_nop 15\n\ts_nop 15\n\ts_nop 15" ::: "memory");
                int fr_ = fr, fq_ = fq; asm volatile("" : "+v"(fr_), "+v"(fq_));
                E.mid(acc, cur, wr, wc, fr_, fq_); } }
            const bool last = (t == nt - 2);
            const char* a1 = cA + (size_t)(t + 1) * kstep;
            const char* a2 = last ? nA : cA + (size_t)(t + 2) * kstep; const char* b2 = last ? nB : cB + (size_t)(t + 2) * kstep;
            const char* a3 = a2 + kstep; const char* b3 = b2 + kstep;
            unsigned vo2[2][2];
#pragma unroll
            for (int h = 0; h < 2; ++h)
#pragma unroll
                for (int i = 0; i < 2; ++i) vo2[h][i] = (Sched::GATHER && last) ? nvoA[h][i] : voA[h][i];
            if (last && has_next) E.stage_rows(nxt, lds, wid);
            if (Sched::GATHER && last && has_next) { const LAS int* rt_ = (const LAS int*)(lds + LDS_MISC + nxt.par * 1024);
#pragma unroll
                for (int h = 0; h < 2; ++h)
#pragma unroll
                    for (int i = 0; i < 2; ++i) { vo2[h][i] = (unsigned)rt_[h * HALF + sR[i]] * (unsigned)S.K + (unsigned)sC[i] * 2u; nvoA[h][i] = vo2[h][i]; } }
            PG8_LDB(B0, 0, 0); PG8_LDB(B1, 0, 1); PG8_SCHED; PG8_LDA(At, 0, 0); PG8_STGA(PG8_SA(1, 1), a1, voA, 1);
            PG8_WAIT_V(8); PG8_WAIT_L(0); PG8_BAR; PG8_MMA(0, 0, At, B0); PG8_MMA(0, 1, At, B1); PG8_BAR; PG8_SCHED;
            PG8_LDA(At, 0, 1); PG8_STGB(PG8_SB(0, 0), b2); PG8_STGB(PG8_SB(0, 1), b2 + hstep); PG8_STGA(PG8_SA(0, 0), a2, vo2, 0);
            PG8_WAIT_V(8); PG8_WAIT_L(0); PG8_BAR; PG8_MMA(1, 0, At, B0); PG8_MMA(1, 1, At, B1); PG8_BAR; PG8_SCHED;
            PG8_LDB(B0, 1, 0); PG8_LDB(B1, 1, 1); PG8_SCHED; PG8_LDA(At, 1, 0); PG8_STGA(PG8_SA(0, 1), a2, vo2, 1);
            PG8_WAIT_V(8); PG8_WAIT_L(0); PG8_BAR; PG8_MMA(0, 0, At, B0); PG8_MMA(0, 1, At, B1); PG8_BAR; PG8_SCHED;
            PG8_LDA(At, 1, 1); PG8_STGB(PG8_SB(1, 0), b3); PG8_STGB(PG8_SB(1, 1), b3 + hstep); PG8_STGA(PG8_SA(1, 0), a3, vo2, 0);
            PG8_WAIT_V(8); PG8_WAIT_L(0); PG8_BAR; PG8_MMA(1, 0, At, B0); PG8_MMA(1, 1, At, B1); PG8_BAR; PG8_SCHED;
        }
        if constexpr (F8) asm volatile("s_nop 15\n\ts_nop 15\n\ts_nop 15" ::: "memory");
        if constexpr (ALIGN_EPI) { if (wr == 0) PG8_BAR; }
        E(acc, cur, wr, wc, fr, fq);
        if (!has_next) break;
#pragma unroll
        for (int a = 0; a < 2; ++a)
#pragma unroll
            for (int b = 0; b < 2; ++b)
#pragma unroll
                for (int m = 0; m < 4; ++m)
#pragma unroll
                    for (int n = 0; n < 2; ++n) acc[a][b][m][n] = (f32x4){0.f, 0.f, 0.f, 0.f};
        cur = nxt; cA = nA; cB = nB; ++ui; nxt = nn; has_next = has_nn;
        if (Sched::GATHER) {
#pragma unroll
            for (int h = 0; h < 2; ++h)
#pragma unroll
                for (int i = 0; i < 2; ++i) voA[h][i] = nvoA[h][i]; }
        if constexpr (ALIGN_EPI) { if (wr == 1) PG8_BAR; }
    }
    PG8_WAIT_V(0);
    if constexpr (!ALIGN_EPI) { if (wr == 0) PG8_BAR; }
    PG8_BAR;
#undef PG8_SA
#undef PG8_SB
#undef PG8_STGA
#undef PG8_STGB
#undef PG8_VOA
#undef PG8_LDA
#undef PG8_LDB
#undef PG8_MMA
#undef PG8_WAIT_V
#undef PG8_WAIT_L
#undef PG8_BAR
#undef PG8_SCHED
}

typedef f32x4 Acc[2][2][4][2];
struct EpiInProj {
    static constexpr bool PERM = true; static constexpr bool MIDK = false;
    __device__ __forceinline__ void stage_rows(const Unit&, LAS unsigned char*, int) const {}
    bf16_t *prw, *puv, *pg;
    template <int ACT> __device__ __forceinline__ void tile(const Acc& acc, bf16_t* base, int ld, int row0, int col0) const {
#pragma unroll
        for (int ai = 0; ai < 2; ++ai)
#pragma unroll
            for (int m = 0; m < 4; ++m) { bf16_t* rowp = base + (size_t)(row0 + ai * HALF + m * 16) * ld + col0;
#pragma unroll
                for (int bj = 0; bj < 2; ++bj) { f32x4 v0 = acc[ai][bj][m][0], v1 = acc[ai][bj][m][1];
                    if (ACT == 1) {
#pragma unroll
                        for (int j = 0; j < 4; ++j) { v0[j] = gelu_tanh(v0[j]); v1[j] = gelu_tanh(v1[j]); } }
                    if (ACT == 2) {
#pragma unroll
                        for (int j = 0; j < 4; ++j) { v0[j] = sigmoidf_(v0[j]); v1[j] = sigmoidf_(v1[j]); } }
                    u32x4 w; w.x = pk2(v0[0], v0[1]); w.y = pk2(v0[2], v0[3]); w.z = pk2(v1[0], v1[1]); w.w = pk2(v1[2], v1[3]);
                    *(u32x4*)(rowp + bj * HALF) = w; }
                __builtin_amdgcn_sched_barrier(0); }
    }
    __device__ __forceinline__ void operator()(const Acc& acc, const Unit& u, int wr, int wc, int fr, int fq) const {
        const int row0 = u.row0 + wr * 64 + fr, cw = wc * 32 + 8 * fq;
        if (u.pn < 7) tile<0>(acc, prw, RWKV_COLS, row0, u.pn * 256 + cw);
        else if (u.pn < 11) tile<1>(acc, puv, 1024, row0, (u.pn - 7) * 256 + cw);
        else tile<2>(acc, pg, 2048, row0, (u.pn - 11) * 256 + cw);
    }
};
template <bool SECOND> struct EpiMerge {
    static constexpr bool PERM = true; static constexpr bool MIDK = false;
    __device__ __forceinline__ void stage_rows(const Unit&, LAS unsigned char*, int) const {}
    bf16_t* m1; const bf16_t* pg; unsigned char* m8;
    __device__ __forceinline__ void operator()(const Acc& acc, const Unit& u, int wr, int wc, int fr, int fq) const {
        const int row0 = u.row0 + wr * 64 + fr, col0 = u.pn * 256 + wc * 32 + 8 * fq;
#pragma unroll
        for (int ai = 0; ai < 2; ++ai)
#pragma unroll
            for (int m = 0; m < 4; ++m) { const size_t r = (size_t)(row0 + ai * HALF + m * 16);
#pragma unroll
                for (int bj = 0; bj < 2; ++bj) { const int c = col0 + bj * HALF;
                    const u32x4 g = *(const u32x4*)(pg + r * 2048 + (SECOND ? 1024 : 0) + c);
                    f32x4 v0 = acc[ai][bj][m][0], v1 = acc[ai][bj][m][1];
                    v0[0] *= bflo(g.x); v0[1] *= bfhi(g.x); v0[2] *= bflo(g.y); v0[3] *= bfhi(g.y); v1[0] *= bflo(g.z); v1[1] *= bfhi(g.z); v1[2] *= bflo(g.w); v1[3] *= bfhi(g.w);
                    if (SECOND) { const u32x4 p = *(const u32x4*)(m1 + r * 1024 + c);
                        v0[0] += bflo(p.x); v0[1] += bfhi(p.x); v0[2] += bflo(p.y); v0[3] += bfhi(p.y); v1[0] += bflo(p.z); v1[1] += bfhi(p.z); v1[2] += bflo(p.w); v1[3] += bfhi(p.w); }
                    if (SECOND) *(u32x2*)(m8 + r * 1024 + c) = pk8(v0, v1);
                    else { u32x4 w; w.x = pk2(v0[0], v0[1]); w.y = pk2(v0[2], v0[3]); w.z = pk2(v1[0], v1[1]); w.w = pk2(v1[2], v1[3]); *(u32x4*)(m1 + r * 1024 + c) = w; } }
                __builtin_amdgcn_sched_barrier(0); }
    }
};
struct EpiMergeF {
    static constexpr bool PERM = true; static constexpr bool MIDK = true;
    __device__ __forceinline__ void stage_rows(const Unit&, LAS unsigned char*, int) const {}
    const bf16_t* pg; unsigned char* m8;
    __device__ __forceinline__ void mid(Acc& acc, const Unit& u, int wr, int wc, int fr, int fq) const {
        const int row0 = u.row0 + wr * 64 + fr, col0 = u.pn * 256 + wc * 32 + 8 * fq;
#pragma unroll
        for (int ai = 0; ai < 2; ++ai) {
            u32x4 ga[4][2], gb[4][2];
#pragma unroll
            for (int m = 0; m < 4; ++m)
#pragma unroll
                for (int bj = 0; bj < 2; ++bj) { const bf16_t* p = pg + (size_t)(row0 + ai * HALF + m * 16) * 2048 + col0 + bj * HALF; ga[m][bj] = *(const u32x4*)p; gb[m][bj] = *(const u32x4*)(p + 1024); }
#pragma unroll
            for (int m = 0; m < 4; ++m)
#pragma unroll
                for (int bj = 0; bj < 2; ++bj) {
                    const u32x4 x = ga[m][bj], y = gb[m][bj];
                    const float a_[8] = {bflo(x.x), bfhi(x.x), bflo(x.y), bfhi(x.y), bflo(x.z), bfhi(x.z), bflo(x.w), bfhi(x.w)};
                    const float b_[8] = {bflo(y.x), bfhi(y.x), bflo(y.y), bfhi(y.y), bflo(y.z), bfhi(y.z), bflo(y.w), bfhi(y.w)};
#pragma unroll
                    for (int e = 0; e < 4; ++e) { acc[ai][bj][m][0][e] *= a_[e] * __builtin_amdgcn_rcpf(fmaxf(b_[e], 1e-30f)); acc[ai][bj][m][1][e] *= a_[4 + e] * __builtin_amdgcn_rcpf(fmaxf(b_[4 + e], 1e-30f)); } }
            __builtin_amdgcn_sched_barrier(0); }
    }
    __device__ __forceinline__ void operator()(const Acc& acc, const Unit& u, int wr, int wc, int fr, int fq) const {
        const int row0 = u.row0 + wr * 64 + fr, col0 = u.pn * 256 + wc * 32 + 8 * fq;
#pragma unroll
        for (int ai = 0; ai < 2; ++ai) {
            u32x4 gb[4][2];
#pragma unroll
            for (int m = 0; m < 4; ++m)
#pragma unroll
                for (int bj = 0; bj < 2; ++bj) gb[m][bj] = *(const u32x4*)(pg + (size_t)(row0 + ai * HALF + m * 16) * 2048 + 1024 + col0 + bj * HALF);
#pragma unroll
            for (int m = 0; m < 4; ++m)
#pragma unroll
                for (int bj = 0; bj < 2; ++bj) { const u32x4 g = gb[m][bj];
                    f32x4 v0 = acc[ai][bj][m][0], v1 = acc[ai][bj][m][1];
                    v0[0] *= fmaxf(bflo(g.x), 1e-30f); v0[1] *= fmaxf(bfhi(g.x), 1e-30f); v0[2] *= fmaxf(bflo(g.y), 1e-30f); v0[3] *= fmaxf(bfhi(g.y), 1e-30f);
                    v1[0] *= fmaxf(bflo(g.z), 1e-30f); v1[1] *= fmaxf(bfhi(g.z), 1e-30f); v1[2] *= fmaxf(bflo(g.w), 1e-30f); v1[3] *= fmaxf(bfhi(g.w), 1e-30f);
                    *(u32x2*)(m8 + (size_t)(row0 + ai * HALF + m * 16) * 1024 + col0 + bj * HALF) = pk8(v0, v1); }
            __builtin_amdgcn_sched_barrier(0); }
    }
};
struct EpiResid {
    static constexpr bool PERM = true; static constexpr bool MIDK = false;
    __device__ __forceinline__ void stage_rows(const Unit&, LAS unsigned char*, int) const {}
    bf16_t* out; const float* base; const float* gate;
    __device__ __forceinline__ void operator()(const Acc& acc, const Unit& u, int wr, int wc, int fr, int fq) const {
        const int row0 = u.row0 + wr * 64 + fr, col0 = u.pn * 256 + wc * 32 + 8 * fq;
        const float* gp = gate + (size_t)(u.row0 >> 13) * 6144 + col0;
        f32x4 gv[2][2];
#pragma unroll
        for (int bj = 0; bj < 2; ++bj)
#pragma unroll
            for (int n = 0; n < 2; ++n) gv[bj][n] = *(const f32x4*)(gp + bj * HALF + n * 4);
#pragma unroll
        for (int ai = 0; ai < 2; ++ai) {
            f32x4 bs[4][2][2];
#pragma unroll
            for (int m = 0; m < 4; ++m)
#pragma unroll
                for (int bj = 0; bj < 2; ++bj) { const float* p = base + (size_t)(row0 + ai * HALF + m * 16) * 1024 + col0 + bj * HALF; bs[m][bj][0] = __builtin_nontemporal_load((const f32x4*)p); bs[m][bj][1] = __builtin_nontemporal_load((const f32x4*)(p + 4)); }
#pragma unroll
            for (int m = 0; m < 4; ++m)
#pragma unroll
                for (int bj = 0; bj < 2; ++bj) {
                    const f32x4 v0 = bs[m][bj][0] + gv[bj][0] * acc[ai][bj][m][0], v1 = bs[m][bj][1] + gv[bj][1] * acc[ai][bj][m][1];
                    u32x4 w; w.x = pk2(v0[0], v0[1]); w.y = pk2(v0[2], v0[3]); w.z = pk2(v1[0], v1[1]); w.w = pk2(v1[2], v1[3]);
                    *(u32x4*)(out + (size_t)(row0 + ai * HALF + m * 16) * 1024 + col0 + bj * HALF) = w; }
            __builtin_amdgcn_sched_barrier(0); }
    }
};
struct EpiRouter {
    static constexpr bool PERM = false; static constexpr bool MIDK = false;
    __device__ __forceinline__ void stage_rows(const Unit&, LAS unsigned char*, int) const {}
    float* sc;
    __device__ __forceinline__ void operator()(const Acc& acc, const Unit& u, int wr, int wc, int fr, int fq) const {
        const int row0 = u.row0 + wr * 64 + fr, col0 = wc * 32 + 4 * fq;
#pragma unroll
        for (int ai = 0; ai < 2; ++ai)
#pragma unroll
            for (int m = 0; m < 4; ++m) { float* rowp = sc + (size_t)(row0 + ai * HALF + m * 16) * 256 + col0;
#pragma unroll
                for (int bj = 0; bj < 2; ++bj)
#pragma unroll
                    for (int n = 0; n < 2; ++n) { f32x4 v = acc[ai][bj][m][n];
#pragma unroll
                        for (int j = 0; j < 4; ++j) v[j] = sigmoidf_(v[j]);
                        *(f32x4*)(rowp + bj * HALF + n * 16) = v; }
                __builtin_amdgcn_sched_barrier(0); }
    }
};
template <bool F8OUT> struct EpiGateUp {
    static constexpr bool PERM = true; static constexpr bool MIDK = false;
    __device__ __forceinline__ void stage_rows(const Unit&, LAS unsigned char*, int) const {}
    void* hid;
    __device__ __forceinline__ void operator()(const Acc& acc, const Unit& u, int wr, int wc, int fr, int fq) const {
        const int row0 = u.row0 + wr * 64 + fr, col0 = u.pn * HALF + wc * 32 + 8 * fq;
#pragma unroll
        for (int ai = 0; ai < 2; ++ai)
#pragma unroll
            for (int m = 0; m < 4; ++m) { const size_t off = (size_t)(row0 + ai * HALF + m * 16) * EFF + col0;
                f32x4 v0, v1;
#pragma unroll
                for (int j = 0; j < 4; ++j) { v0[j] = siluf_(acc[ai][0][m][0][j]) * acc[ai][1][m][0][j]; v1[j] = siluf_(acc[ai][0][m][1][j]) * acc[ai][1][m][1][j]; }
                if constexpr (F8OUT) *(u32x2*)((unsigned char*)hid + off) = pk8(v0, v1);
                else { u32x4 w; w.x = pk2(v0[0], v0[1]); w.y = pk2(v0[2], v0[3]); w.z = pk2(v1[0], v1[1]); w.w = pk2(v1[2], v1[3]); *(u32x4*)((bf16_t*)hid + off) = w; }
                __builtin_amdgcn_sched_barrier(0); }
    }
};
struct EpiExpertDown {
    static constexpr bool PERM = true; static constexpr bool MIDK = false;
    unsigned char* slot; const int* rowdst; const float* roww;
    __device__ __forceinline__ void stage_rows(const Unit& u, LAS unsigned char* lds, int wid) const {
        if (wid < 4) { const int lane = threadIdx.x & 63; LAS unsigned char* base = lds + LDS_MISC + u.par * 2048 + wid * 256;
            __builtin_amdgcn_global_load_lds((const unsigned*)(rowdst + u.row0 + wid * 64 + lane), (LAS unsigned*)base, 4, 0, 0);
            __builtin_amdgcn_global_load_lds((const unsigned*)(roww + u.row0 + wid * 64 + lane), (LAS unsigned*)(base + 1024), 4, 0, 0); }
    }
    __device__ __forceinline__ void operator()(const Acc& acc, const Unit& u, int wr, int wc, int fr, int fq) const {
        const unsigned cb = (unsigned)(u.pn * 256 + wc * 64 + 16 * fq);
        const LAS int* td = (const LAS int*)((LAS unsigned char*)nullptr + LDS_MISC + u.par * 2048) + wr * 64 + fr; const LAS float* tw = (const LAS float*)(td + 256);
        int dst[2][4]; float ws_[2][4];
#pragma unroll
        for (int ai = 0; ai < 2; ++ai)
#pragma unroll
            for (int m = 0; m < 4; ++m) { dst[ai][m] = td[ai * HALF + m * 16]; ws_[ai][m] = tw[ai * HALF + m * 16]; }
#pragma unroll
        for (int ai = 0; ai < 2; ++ai)
#pragma unroll
            for (int m = 0; m < 4; ++m) {
                if (dst[ai][m] >= 0) { const float s_ = ws_[ai][m]; const u32x2 lo = pk8(acc[ai][0][m][0] * s_, acc[ai][0][m][1] * s_), hi = pk8(acc[ai][1][m][0] * s_, acc[ai][1][m][1] * s_);
                    *(u32x4*)(slot + (size_t)((unsigned)dst[ai][m] * 1024u + cb)) = (u32x4){lo.x, lo.y, hi.x, hi.y}; }
            }
    }
};
struct EpiSharedDown {
    static constexpr bool PERM = true; static constexpr bool MIDK = false;
    unsigned char* sho;
    __device__ __forceinline__ void stage_rows(const Unit&, LAS unsigned char*, int) const {}
    __device__ __forceinline__ void operator()(const Acc& acc, const Unit& u, int wr, int wc, int fr, int fq) const {
        const int row0 = u.row0 + wr * 64 + fr, col0 = u.pn * 256 + wc * 32 + 8 * fq;
#pragma unroll
        for (int ai = 0; ai < 2; ++ai)
#pragma unroll
            for (int m = 0; m < 4; ++m) { unsigned char* rowp = sho + (size_t)(row0 + ai * HALF + m * 16) * 1024 + col0;
#pragma unroll
                for (int bj = 0; bj < 2; ++bj) *(u32x2*)(rowp + bj * HALF) = pk8(acc[ai][bj][m][0], acc[ai][bj][m][1]);
                __builtin_amdgcn_sched_barrier(0); }
    }
};
}
__device__ __forceinline__ void phase_mod(const float* c, const float* ada_w, const float* ada_b, float* mod, LAS unsigned char* lds, int tid, int G) {
    LAS float* sl = (LAS float*)lds; LAS float* red = (LAS float*)(lds + 32768);
    for (int i = tid; i < NB * D; i += NTHREADS) { const float v = c[i]; sl[i] = siluf_(v); }
    __syncthreads();
    const int cl = tid % 24, kg = tid / 24;
    for (int cb = blockIdx.x; cb < 256; cb += G) {
        const int col0 = cb * 24;
        if (tid < 384) {
            float a[NB];
#pragma unroll
            for (int b = 0; b < NB; ++b) a[b] = 0.f;
#pragma unroll
            for (int k0 = kg; k0 < D; k0 += 16 * 16) { float w[16];
#pragma unroll
                for (int i = 0; i < 16; ++i) w[i] = __builtin_nontemporal_load(ada_w + (size_t)(k0 + 16 * i) * 6144 + col0 + cl);
#pragma unroll
                for (int i = 0; i < 16; ++i) {
#pragma unroll
                    for (int b = 0; b < NB; ++b) a[b] += sl[b * D + k0 + 16 * i] * w[i]; } }
#pragma unroll
            for (int b = 0; b < NB; ++b) red[(kg * 24 + cl) * NB + b] = a[b];
        }
        __syncthreads();
        if (tid < 192) { const int c2 = tid >> 3, b = tid & 7; float s = 0.f;
#pragma unroll
            for (int g = 0; g < 16; ++g) s += red[(g * 24 + c2) * NB + b];
            mod[(size_t)b * 6144 + col0 + c2] = s + ada_b[col0 + c2]; }
        __syncthreads();
    }
}
__device__ __forceinline__ void transpose_item(const float* W, int ldw, int k0, int n0, bf16_t* WT, int ldt, int drow0, LAS float* scr, int lane) {
#pragma unroll 8
    for (int i = 0; i < 32; ++i) { const int kk = 2 * i + (lane >> 5); scr[kk * 33 + (lane & 31)] = W[(size_t)(k0 + kk) * ldw + n0 + (lane & 31)]; }
    LDS_WAIT(); asm volatile("" ::: "memory");
    const int c = lane & 7;
#pragma unroll
    for (int j = 0; j < 4; ++j) { const int n = (lane >> 3) + 8 * j; const LAS float* s = scr + (8 * c) * 33 + n;
        u32x4 o; o.x = pk2(s[0 * 33], s[1 * 33]); o.y = pk2(s[2 * 33], s[3 * 33]); o.z = pk2(s[4 * 33], s[5 * 33]); o.w = pk2(s[6 * 33], s[7 * 33]);
        *(u32x4*)(WT + (size_t)(drow0 + n) * ldt + k0 + 8 * c) = o; }
    LDS_WAIT(); asm volatile("" ::: "memory");
}
__device__ __forceinline__ void transpose_job(const float* W, int K, int N, bf16_t* WT, int gated, int goff, int item, LAS float* scr, int lane) {
    const int nblk = N / 32, kb = item / nblk, nb = item % nblk, n0 = 32 * nb;
    const int drow0 = gated ? (256 * (n0 >> 7) + goff + (n0 & 127)) : n0;
    transpose_item(W, N, 64 * kb, n0, WT, K, drow0, scr, lane);
}
__device__ __forceinline__ void transpose_item64(const float* W, int ldw, int k0, int n0, bf16_t* WT, int ldt, int drow0, LAS float* scr, int lane) {
    f32x4 v[16];
    const int c4 = lane & 15, r4 = lane >> 4;
#pragma unroll
    for (int i = 0; i < 16; ++i) v[i] = __builtin_nontemporal_load((const f32x4*)(W + (size_t)(k0 + 4 * i + r4) * ldw + n0 + 4 * c4));
#pragma unroll
    for (int i = 0; i < 16; ++i) { LAS float* d = scr + (4 * i + r4) * 65 + 4 * c4; d[0] = v[i].x; d[1] = v[i].y; d[2] = v[i].z; d[3] = v[i].w; }
    LDS_WAIT(); asm volatile("" ::: "memory");
    const int c = lane & 7;
#pragma unroll
    for (int j = 0; j < 8; ++j) { const int n = (lane >> 3) + 8 * j; const LAS float* s = scr + (8 * c) * 65 + n;
        u32x4 o; o.x = pk2(s[0 * 65], s[1 * 65]); o.y = pk2(s[2 * 65], s[3 * 65]); o.z = pk2(s[4 * 65], s[5 * 65]); o.w = pk2(s[6 * 65], s[7 * 65]);
        *(u32x4*)(WT + (size_t)(drow0 + n) * ldt + k0 + 8 * c) = o; }
    LDS_WAIT(); asm volatile("" ::: "memory");
}
constexpr float WSCALE = 32.0f;
__device__ __forceinline__ void transpose_item64_f8(const float* W, int ldw, int k0, int n0, unsigned char* WT8, int ldt, int drow0, LAS float* scr, int lane) {
    f32x4 v[16];
    const int c4 = lane & 15, r4 = lane >> 4;
#pragma unroll
    for (int i = 0; i < 16; ++i) v[i] = __builtin_nontemporal_load((const f32x4*)(W + (size_t)(k0 + 4 * i + r4) * ldw + n0 + 4 * c4));
#pragma unroll
    for (int i = 0; i < 16; ++i) { LAS float* d = scr + (4 * i + r4) * 65 + 4 * c4; d[0] = v[i].x; d[1] = v[i].y; d[2] = v[i].z; d[3] = v[i].w; }
    LDS_WAIT(); asm volatile("" ::: "memory");
    const int c = lane & 7;
#pragma unroll
    for (int j = 0; j < 8; ++j) { const int n = (lane >> 3) + 8 * j; const LAS float* s = scr + (8 * c) * 65 + n;
        const f32x4 lo = (f32x4){s[0 * 65], s[1 * 65], s[2 * 65], s[3 * 65]} * WSCALE, hi = (f32x4){s[4 * 65], s[5 * 65], s[6 * 65], s[7 * 65]} * WSCALE;
        *(u32x2*)(WT8 + (size_t)(drow0 + n) * ldt + k0 + 8 * c) = pk8(lo, hi); }
    LDS_WAIT(); asm volatile("" ::: "memory");
}
struct SmallW { const float *w_in, *w_out_a, *w_out_b, *w_out, *router_w, *sw1, *sw3, *sw2, *w_up, *a_up, *g_up, *gws; };
__device__ __forceinline__ void phase_small_weights(const SmallW& P, unsigned char* ws, LAS unsigned char* lds, int gw, int NGW, int wave, int lane) {
    LAS float* scr = (LAS float*)(lds + wave * 16640);
    constexpr int I0 = 16 * 76, I1 = 8 * 16, I2 = 8 * 16, I3 = 16 * 16, I4 = 16 * 8, I5 = 16 * 4, I6 = 16 * 4, I7 = 4 * 16, I8 = 16, I9 = 16, I10 = 2 * 16;
    constexpr int NIT = I0 + I1 + I2 + I3 + I4 + I5 + I6 + I7 + I8 + I9 + I10;
    for (int it = gw; it < NIT; it += NGW) {
        int r = it;
        if (r < I0) { const int kb = r / 76, nb = r % 76; transpose_item64_f8(P.w_in, IN_COLS, 64 * kb, 64 * nb, ws + SW_WIN, D, 64 * nb, scr, lane); continue; } r -= I0;
        if (r < I1) { transpose_item64_f8(P.w_out_a, D, 64 * (r >> 4), 64 * (r & 15), ws + SW_WOA, 2 * RW, 64 * (r & 15), scr, lane); continue; } r -= I1;
        if (r < I2) { transpose_item64_f8(P.w_out_b, D, 64 * (r >> 4), 64 * (r & 15), ws + SW_WOA + RW, 2 * RW, 64 * (r & 15), scr, lane); continue; } r -= I2;
        if (r < I3) { transpose_item64_f8(P.w_out, D, 64 * (r >> 4), 64 * (r & 15), ws + SW_WO, D, 64 * (r & 15), scr, lane); continue; } r -= I3;
        if (r < I4) { transpose_job(P.router_w, D, NE, (bf16_t*)(ws + SW_WR), 0, 0, r, scr, lane); continue; } r -= I4;
        if (r < I5) { const int n0 = 64 * (r & 3); transpose_item64_f8(P.sw1, EFF, 64 * (r >> 2), n0, ws + SW_WS13, D, 256 * (n0 >> 7) + (n0 & 127), scr, lane); continue; } r -= I5;
        if (r < I6) { const int n0 = 64 * (r & 3); transpose_item64_f8(P.sw3, EFF, 64 * (r >> 2), n0, ws + SW_WS13, D, 256 * (n0 >> 7) + 128 + (n0 & 127), scr, lane); continue; } r -= I6;
        if (r < I7) { transpose_item64_f8(P.sw2, D, 64 * (r >> 4), 64 * (r & 15), ws + SW_WS2, EFF, 64 * (r & 15), scr, lane); continue; } r -= I7;
        if (r < I8) { transpose_job(P.w_up, 64, RW, (bf16_t*)(ws + SW_WUP), 0, 0, r, scr, lane); continue; } r -= I8;
        if (r < I9) { transpose_job(P.a_up, 64, RW, (bf16_t*)(ws + SW_AUP), 0, 0, r, scr, lane); continue; } r -= I9;
        transpose_job(P.g_up, 128, RW, (bf16_t*)(ws + SW_GUP), 0, 0, r, scr, lane);
    }
    bf16_t* wsm = (bf16_t*)(ws + SW_WSM);
    for (int i = gw * 64 + lane; i < 8 * 128 * 128; i += NGW * 64) { const int col = i & 127, row = (i >> 7) & 127; wsm[i] = (col <= row) ? f2bf(P.gws[i]) : (bf16_t)0; }
}
__device__ __forceinline__ void cv128_load(f32x4 (&v)[16], const float* W, int ldw, int k0, int n0, int lane) {
    const int c4 = lane & 7, r8 = lane >> 3;
#pragma unroll
    for (int i = 0; i < 16; ++i) v[i] = __builtin_nontemporal_load((const f32x4*)(W + (size_t)(k0 + 8 * i + r8) * ldw + n0 + 4 * c4));
}
__device__ __forceinline__ void cv128_finish(const f32x4 (&v)[16], bool perm16, int k0, unsigned char* WT8, int ldt, int drow0, LAS float* scr, int lane) {
    const int c4 = lane & 7, r8 = lane >> 3;
#pragma unroll
    for (int i = 0; i < 16; ++i) { LAS float* d = scr + (8 * i + r8) * 33 + 4 * c4; d[0] = v[i].x; d[1] = v[i].y; d[2] = v[i].z; d[3] = v[i].w; }
    LDS_WAIT(); asm volatile("" ::: "memory");
    const int c = lane & 7;
#pragma unroll
    for (int j = 0; j < 4; ++j) { const int n = (lane >> 3) + 8 * j; const LAS float* s = scr + (16 * c) * 33 + n;
        f32x4 a0 = (f32x4){s[0 * 33], s[1 * 33], s[2 * 33], s[3 * 33]} * WSCALE, a1 = (f32x4){s[4 * 33], s[5 * 33], s[6 * 33], s[7 * 33]} * WSCALE;
        f32x4 a2 = (f32x4){s[8 * 33], s[9 * 33], s[10 * 33], s[11 * 33]} * WSCALE, a3 = (f32x4){s[12 * 33], s[13 * 33], s[14 * 33], s[15 * 33]} * WSCALE;
        const u32x2 lo = pk8(a0, a1), hi = pk8(a2, a3);
        int dr = drow0 + n; if (perm16) { const int r = dr & 255; dr = (dr & ~255) + 128 * ((r >> 3) & 1) + 8 * (r >> 4) + (r & 7); }
        *(u32x4*)(WT8 + (size_t)dr * ldt + k0 + 16 * c) = (u32x4){lo.x, lo.y, hi.x, hi.y}; }
    LDS_WAIT(); asm volatile("" ::: "memory");
}
__device__ __forceinline__ void cv64_load(f32x4 (&v)[8], const float* W, int ldw, int k0, int n0, int lane) {
    const int c4 = lane & 7, r8 = lane >> 3;
#pragma unroll
    for (int i = 0; i < 8; ++i) v[i] = __builtin_nontemporal_load((const f32x4*)(W + (size_t)(k0 + 8 * i + r8) * ldw + n0 + 4 * c4));
}
__device__ __forceinline__ void cv64_finish(const f32x4 (&v)[8], bool perm16, int k0, unsigned char* WT8, int ldt, int drow0, LAS float* scr, int lane) {
    const int c4 = lane & 7, r8 = lane >> 3;
#pragma unroll
    for (int i = 0; i < 8; ++i) { LAS float* d = scr + (8 * i + r8) * 33 + 4 * c4; d[0] = v[i].x; d[1] = v[i].y; d[2] = v[i].z; d[3] = v[i].w; }
    LDS_WAIT(); asm volatile("" ::: "memory");
    const int c = lane & 3;
#pragma unroll
    for (int j = 0; j < 2; ++j) { const int n = (lane >> 2) + 16 * j; const LAS float* s = scr + (16 * c) * 33 + n;
        f32x4 a0 = (f32x4){s[0 * 33], s[1 * 33], s[2 * 33], s[3 * 33]} * WSCALE, a1 = (f32x4){s[4 * 33], s[5 * 33], s[6 * 33], s[7 * 33]} * WSCALE;
        f32x4 a2 = (f32x4){s[8 * 33], s[9 * 33], s[10 * 33], s[11 * 33]} * WSCALE, a3 = (f32x4){s[12 * 33], s[13 * 33], s[14 * 33], s[15 * 33]} * WSCALE;
        const u32x2 lo = pk8(a0, a1), hi = pk8(a2, a3);
        int dr = drow0 + n; if (perm16) { const int r = dr & 255; dr = (dr & ~255) + 128 * ((r >> 3) & 1) + 8 * (r >> 4) + (r & 7); }
        *(u32x4*)(WT8 + (size_t)dr * ldt + k0 + 16 * c) = (u32x4){lo.x, lo.y, hi.x, hi.y}; }
    LDS_WAIT(); asm volatile("" ::: "memory");
}
struct ExpW { const float* w1; const float* w3; const float* w2; unsigned char* ws; unsigned char* w2dst; };
constexpr int CV_PER = 64;
constexpr int CV_TOTAL = NE * 3 * CV_PER;
#ifndef CV_P12
#define CV_P12 16
#endif
constexpr int CV_SPLIT = CV_TOTAL - 2048 * CV_P12, CV_EVERY = 16 / CV_P12;
#ifndef CV_P3H
#define CV_P3H 16
#endif
constexpr int CV_EARLY = 1024 * CV_P3H;
static_assert(CV_EARLY <= NE * CV_PER && CV_EARLY <= CV_SPLIT, "early items are W2 items");
struct CvItem { const float* W; unsigned char* dst; int ldw, k0, n0, ldt, drow0; bool perm; };
constexpr int CV_W2 = NE * CV_PER;
__device__ __forceinline__ CvItem cv_decode(const ExpW X, int it) {
    const bool isw2 = it < CV_W2;
    const int r_ = it - CV_W2, e13 = r_ >> 7, which = (r_ >> 6) & 1, i13 = r_ & 63, n13 = 32 * (i13 & 7);
    const int e2 = it >> 6, i2 = it & 63;
    CvItem c;
    c.W = isw2 ? X.w2 + (size_t)e2 * EFF * D : (which ? X.w3 : X.w1) + (size_t)e13 * D * EFF;
    c.ldw = isw2 ? D : EFF;
    c.k0 = isw2 ? 128 * (i2 >> 5) : 128 * (i13 >> 3);
    c.n0 = isw2 ? 32 * (i2 & 31) : n13;
    c.dst = isw2 ? X.w2dst + (size_t)e2 * D * EFF : X.ws + B_W13 + (size_t)e13 * 512 * D;
    c.ldt = isw2 ? EFF : D;
    c.drow0 = isw2 ? 32 * (i2 & 31) : 256 * (n13 >> 7) + which * 128 + (n13 & 127);
    c.perm = isw2;
    return c;
}
__device__ __forceinline__ CvItem cv_decode_half(const ExpW X, int h) { CvItem c = cv_decode(X, h >> 1); c.k0 += 64 * (h & 1); return c; }
__device__ __forceinline__ void phase_expert_weights(const ExpW X, LAS unsigned char* lds, int it_lo, int it_hi, int gw, int NGW, int wave, int lane) {
    LAS float* scr = (LAS float*)(lds + wave * 16896);
    for (int it = it_lo + gw; it < it_hi; it += NGW) {
        const CvItem c = cv_decode(X, it);
        f32x4 v[16];
        cv128_load(v, c.W, c.ldw, c.k0, c.n0, lane);
        cv128_finish(v, c.perm, c.k0, c.dst, c.ldt, c.drow0, scr, lane);
    }
}
template <bool XBF>
__device__ __forceinline__ void phase_norm_mod(const void* X, const float* gain, const float* mod, int sh_off, int sc_off, bf16_t* out, unsigned char* out8, int gw, int NGW, int lane) {
    constexpr int R = XBF ? 4 : 8;
    for (int m0 = gw; m0 < T; m0 += R * NGW) {
        f32x4 v[R][4];
#pragma unroll
        for (int rr = 0; rr < R; ++rr) { const int m = m0 + rr * NGW; const size_t mr = (size_t)(m < T ? m : m0);
            if constexpr (XBF) { const u32x2* xr = (const u32x2*)((const bf16_t*)X + mr * D) + lane;
#pragma unroll
                for (int j = 0; j < 4; ++j) { const u32x2 w = __builtin_nontemporal_load(xr + 64 * j); v[rr][j] = (f32x4){bflo(w.x), bfhi(w.x), bflo(w.y), bfhi(w.y)}; } }
            else { const f32x4* xr = (const f32x4*)((const float*)X + mr * D) + lane;
#pragma unroll
                for (int j = 0; j < 4; ++j) v[rr][j] = __builtin_nontemporal_load(xr + 64 * j); } }
#pragma unroll
        for (int rr = 0; rr < R; ++rr) { const int m = m0 + rr * NGW; if (m >= T) break;
            float ss = 0.f;
#pragma unroll
            for (int j = 0; j < 4; ++j) ss += (v[rr][j].x * v[rr][j].x + v[rr][j].y * v[rr][j].y) + (v[rr][j].z * v[rr][j].z + v[rr][j].w * v[rr][j].w);
            const float rstd = __builtin_amdgcn_rsqf(wave_sum(ss) * (1.f / D) + 1e-6f);
            const float* mb = mod + (size_t)(m >> 13) * 6144;
            u32x2* o8 = (u32x2*)(out + (size_t)m * D) + lane;
#pragma unroll
            for (int j = 0; j < 4; ++j) { const int col = 4 * lane + 256 * j;
                const f32x4 g = *(const f32x4*)(gain + col), sc = *(const f32x4*)(mb + sc_off + col), sh = *(const f32x4*)(mb + sh_off + col);
                const f32x4 y = v[rr][j] * rstd * g * (sc + 1.0f) + sh;
                if (out) { u32x2 w; w.x = pk2(y.x, y.y); w.y = pk2(y.z, y.w); o8[64 * j] = w; }
                if (out8) { int t8 = __builtin_amdgcn_cvt_pk_fp8_f32(y.x, y.y, 0, false); t8 = __builtin_amdgcn_cvt_pk_fp8_f32(y.z, y.w, t8, true); *(unsigned*)(out8 + (size_t)m * D + col) = (unsigned)t8; } } }
    }
}
struct YaArgs { bf16_t* ya; const bf16_t* g; const bf16_t* prw; const float* sbon; const float* mu; const float* ln_g; const float* ln_b; };
__device__ __forceinline__ void phase_ya_final(const YaArgs& P, int gw, int NGW, int lane) {
    const int ch0 = lane * 8, head = lane >> 3;
    float muv[8], lg[8], lb[8];
#pragma unroll
    for (int j = 0; j < 8; ++j) { muv[j] = P.mu[1024 + ch0 + j]; lg[j] = P.ln_g[ch0 + j]; lb[j] = P.ln_b[ch0 + j]; }
    for (int m = gw; m < T; m += NGW) {
        const u32x4 yw = *(const u32x4*)(P.ya + (size_t)m * RW + ch0);
        const u32x4 gw4 = *(const u32x4*)(P.g + (size_t)m * RW + ch0);
        const u32x4 vc = *(const u32x4*)(P.prw + (size_t)m * RWKV_COLS + 1024 + ch0);
        u32x4 vp = (u32x4){0u, 0u, 0u, 0u};
        if ((m & (SEQ - 1)) != 0) vp = *(const u32x4*)(P.prw + (size_t)(m - 1) * RWKV_COLS + 1024 + ch0);
        const float sb = P.sbon[(size_t)m * NH + head];
        float y[8], gg[8], vv[8], pv[8];
        y[0] = bflo(yw.x); y[1] = bfhi(yw.x); y[2] = bflo(yw.y); y[3] = bfhi(yw.y); y[4] = bflo(yw.z); y[5] = bfhi(yw.z); y[6] = bflo(yw.w); y[7] = bfhi(yw.w);
        gg[0] = bflo(gw4.x); gg[1] = bfhi(gw4.x); gg[2] = bflo(gw4.y); gg[3] = bfhi(gw4.y); gg[4] = bflo(gw4.z); gg[5] = bfhi(gw4.z); gg[6] = bflo(gw4.w); gg[7] = bfhi(gw4.w);
        vv[0] = bflo(vc.x); vv[1] = bfhi(vc.x); vv[2] = bflo(vc.y); vv[3] = bfhi(vc.y); vv[4] = bflo(vc.z); vv[5] = bfhi(vc.z); vv[6] = bflo(vc.w); vv[7] = bfhi(vc.w);
        pv[0] = bflo(vp.x); pv[1] = bfhi(vp.x); pv[2] = bflo(vp.y); pv[3] = bfhi(vp.y); pv[4] = bflo(vp.z); pv[5] = bfhi(vp.z); pv[6] = bflo(vp.w); pv[7] = bfhi(vp.w);
        float s = 0.f;
#pragma unroll
        for (int j = 0; j < 8; ++j) s += y[j];
        s += __shfl_xor(s, 1); s += __shfl_xor(s, 2); s += __shfl_xor(s, 4);
        const float mean = s * (1.f / 64.f); float q = 0.f;
#pragma unroll
        for (int j = 0; j < 8; ++j) { y[j] -= mean; q += y[j] * y[j]; }
        q += __shfl_xor(q, 1); q += __shfl_xor(q, 2); q += __shfl_xor(q, 4);
        const float rstd = __builtin_amdgcn_rsqf(q * (1.f / 64.f) + 64e-5f);
        float o[8];
#pragma unroll
        for (int j = 0; j < 8; ++j) { const float vs = vv[j] + (pv[j] - vv[j]) * muv[j]; o[j] = (y[j] * rstd * lg[j] + lb[j] + sb * vs) * gg[j]; }
        u32x4 w; w.x = pk2(o[0], o[1]); w.y = pk2(o[2], o[3]); w.z = pk2(o[4], o[5]); w.w = pk2(o[6], o[7]);
        *(u32x4*)(P.ya + (size_t)m * RW + ch0) = w;
    }
}
__device__ __forceinline__ void phase_xs(const bf16_t* prw, const float* mu, bf16_t* xs, int gw, int NGW, int lane) {
    const f32x4 m4 = *(const f32x4*)(mu + 1536 + 4 * lane);
    constexpr int R = 8;
    for (int t0 = gw * R; t0 < T; t0 += NGW * R) {
        u32x2 cw[R], pw[R];
#pragma unroll
        for (int i = 0; i < R; ++i) { const int t = t0 + i; const bf16_t* src = prw + (size_t)t * RWKV_COLS + 1536 + 4 * lane;
            cw[i] = *(const u32x2*)src; pw[i] = (u32x2){0u, 0u};
            if ((t & (SEQ - 1)) != 0) pw[i] = *(const u32x2*)(src - RWKV_COLS); }
#pragma unroll
        for (int i = 0; i < R; ++i) {
            f32x4 v = (f32x4){bflo(cw[i].x), bfhi(cw[i].x), bflo(cw[i].y), bfhi(cw[i].y)}; const f32x4 p = (f32x4){bflo(pw[i].x), bfhi(pw[i].x), bflo(pw[i].y), bfhi(pw[i].y)};
            v = v + (p - v) * m4;
            if (lane < 16) {
#pragma unroll
                for (int j = 0; j < 4; ++j) v[j] = tanhf_(v[j]); }
            else if (lane >= 32) {
#pragma unroll
                for (int j = 0; j < 4; ++j) v[j] = sigmoidf_(v[j]); }
            u32x2 w; w.x = pk2(v[0], v[1]); w.y = pk2(v[2], v[3]);
            *(u32x2*)(xs + (size_t)(t0 + i) * 256 + 4 * lane) = w; }
    }
}
__device__ __forceinline__ void phase_gate(const bf16_t* xs, const bf16_t* gup, bf16_t* g, int gw, int NGW, int lane) {
    const int r = lane & 15, q = lane >> 4;
    for (int item = gw; item < 8 * 256; item += NGW) {
        const int cb = item & 7, tg = item >> 3;
        bf16x8 af[4][4];
#pragma unroll
        for (int mt = 0; mt < 4; ++mt)
#pragma unroll
            for (int s = 0; s < 4; ++s) af[mt][s] = *(const bf16x8*)(gup + (size_t)(cb * 64 + 16 * mt + r) * 128 + 32 * s + 8 * q);
        bf16x8 nb[4];
#pragma unroll
        for (int s = 0; s < 4; ++s) nb[s] = *(const bf16x8*)(xs + (size_t)(tg * 256 + r) * 256 + 128 + 32 * s + 8 * q);
        for (int tt = 0; tt < 16; ++tt) {
            const int t0 = tg * 256 + tt * 16;
            bf16x8 bfr[4];
#pragma unroll
            for (int s = 0; s < 4; ++s) bfr[s] = nb[s];
            if (tt + 1 < 16) {
#pragma unroll
                for (int s = 0; s < 4; ++s) nb[s] = *(const bf16x8*)(xs + (size_t)(t0 + 16 + r) * 256 + 128 + 32 * s + 8 * q); }
#pragma unroll
            for (int mt = 0; mt < 4; ++mt) { f32x4 acc = (f32x4){0.f, 0.f, 0.f, 0.f};
#pragma unroll
                for (int s = 0; s < 4; ++s) acc = __builtin_amdgcn_mfma_f32_16x16x32_bf16(af[mt][s], bfr[s], acc, 0, 0, 0);
                u32x2 w; w.x = pk2(acc[0], acc[1]); w.y = pk2(acc[2], acc[3]);
                *(u32x2*)(g + (size_t)(t0 + r) * RW + cb * 64 + 16 * mt + 4 * q) = w; }
        }
    }
}
__device__ __forceinline__ void phase_combine(float* out, const bf16_t* x1, const unsigned char* slot, const unsigned char* sho, const float* mod, const float* normf, int gw, int NGW, int lane) {
    for (int m = gw; m < T; m += NGW) {
        const int b = m >> 13;
        f32x4* xr = (f32x4*)(out + (size_t)m * D + 16 * lane);
        const float* g2 = mod + (size_t)b * 6144 + 5120 + 16 * lane;
        u32x4 sw[TOPK + 1];
#pragma unroll
        for (int k = 0; k < TOPK; ++k) sw[k] = __builtin_nontemporal_load((const u32x4*)(slot + ((size_t)m * TOPK + k) * D + 16 * lane));
        sw[TOPK] = __builtin_nontemporal_load((const u32x4*)(sho + (size_t)m * D + 16 * lane));
        f32x4 x[4];
        { const u32x4 w0 = *(const u32x4*)(x1 + (size_t)m * D + 16 * lane), w1 = *(const u32x4*)(x1 + (size_t)m * D + 16 * lane + 8);
          x[0] = (f32x4){bflo(w0.x), bfhi(w0.x), bflo(w0.y), bfhi(w0.y)}; x[1] = (f32x4){bflo(w0.z), bfhi(w0.z), bflo(w0.w), bfhi(w0.w)};
          x[2] = (f32x4){bflo(w1.x), bfhi(w1.x), bflo(w1.y), bfhi(w1.y)}; x[3] = (f32x4){bflo(w1.z), bfhi(w1.z), bflo(w1.w), bfhi(w1.w)}; }
        f32x4 a[4];
#pragma unroll
        for (int j = 0; j < 4; ++j) a[j] = (f32x4){0.f, 0.f, 0.f, 0.f};
#pragma unroll
        for (int k = 0; k <= TOPK; ++k) { a[0] += up8(sw[k].x); a[1] += up8(sw[k].y); a[2] += up8(sw[k].z); a[3] += up8(sw[k].w); }
        float ss = 0.f;
#pragma unroll
        for (int j = 0; j < 4; ++j) { x[j] = x[j] + *(const f32x4*)(g2 + 4 * j) * a[j]; ss += (x[j].x * x[j].x + x[j].y * x[j].y) + (x[j].z * x[j].z + x[j].w * x[j].w); }
        const float rstd = __builtin_amdgcn_rsqf(wave_sum(ss) * (1.f / D) + 1e-6f);
#pragma unroll
        for (int j = 0; j < 4; ++j) xr[j] = x[j] * rstd * *(const f32x4*)(normf + 16 * lane + 4 * j);
    }
}
namespace rk {
constexpr int LD = 80;
constexpr int SLOTB = 64 * LD * 2;
constexpr int LDG = 136;
typedef LAS bf16_t* lp;
__device__ __forceinline__ lp slot(LAS unsigned char* lds, int i) { return (lp)(lds + i * SLOTB); }
template <int KS>
__device__ __forceinline__ void mm_nt(const LAS bf16_t* X, int ldx, const LAS bf16_t* Y, int ldy, int m, int nt0, int r, int q, f32x4 (&acc)[2]) {
#pragma unroll
    for (int s = 0; s < KS; ++s) {
        const bf16x8 a = *(const LAS bf16x8*)(X + (16 * m + r) * ldx + 32 * s + 8 * q);
#pragma unroll
        for (int n = 0; n < 2; ++n) { const bf16x8 b = *(const LAS bf16x8*)(Y + (16 * (nt0 + n) + r) * ldy + 32 * s + 8 * q); acc[n] = __builtin_amdgcn_mfma_f32_16x16x32_bf16(a, b, acc[n], 0, 0, 0); }
    }
}
__device__ __forceinline__ void st_rm(lp dst, int m, int nt, int r, int q, const f32x4& a) {
#pragma unroll
    for (int ii = 0; ii < 4; ++ii) dst[(16 * m + 4 * q + ii) * LD + 16 * nt + r] = f2bf(a[ii]);
}
__device__ __forceinline__ void st_tr(lp dst, int m, int nt, int r, int q, const f32x4& a) {
    u32x2 w; w.x = pk2(a[0], a[1]); w.y = pk2(a[2], a[3]); *(LAS u32x2*)(dst + (16 * nt + r) * LD + 16 * m + 4 * q) = w;
}
__device__ __forceinline__ void ld_rm(const LAS bf16_t* src, int m, int nt, int r, int q, f32x4& a) {
#pragma unroll
    for (int ii = 0; ii < 4; ++ii) a[ii] = bf2f(src[(16 * m + 4 * q + ii) * LD + 16 * nt + r]);
}
struct Args {
    const bf16_t* prw; const float* mu; const float *w0, *a0, *k_k, *k_a, *r_k;
    const bf16_t *wup, *aup, *gup;
    const bf16_t* xs;
    bf16_t* g; bf16_t* bv; unsigned char* mn; unsigned char* qy;
};
constexpr int LDS_MU = LDS_MISC + 2304;
struct Pre { u32x4 cw[3], pw[3]; bf16x8 xs[4]; };
__device__ __forceinline__ void task_map(int task, int h, int& i, int& ch, int& col) {
    i = task / 24; ch = task % 24;
    col = (ch >> 3) * 512 + h * 64 + 8 * (ch & 7);
}
__device__ __forceinline__ void load_mu(const Args& P, LAS unsigned char* lds, int tid) {
    LAS bf16_t* MU = (LAS bf16_t*)(lds + LDS_MU);
    for (int i = tid; i < 1536; i += NTHREADS) MU[i] = f2bf(P.mu[i]);
    __syncthreads();
}
struct Hd { bf16x8 w[4], a[4]; float w0[2], a0[2], kk[2], ka[2], rk[2]; };
__device__ __forceinline__ void load_head(const Args& P, int h, int tid, Hd& hd) {
    const int lane = tid & 63, r = lane & 15, q = lane >> 4, nh = tid >> 8;
#pragma unroll
    for (int n = 0; n < 2; ++n) { const int row = h * 64 + 16 * (2 * nh + n) + r;
#pragma unroll
        for (int s = 0; s < 2; ++s) { hd.w[s * 2 + n] = *(const bf16x8*)(P.wup + (size_t)row * 64 + 32 * s + 8 * q); hd.a[s * 2 + n] = *(const bf16x8*)(P.aup + (size_t)row * 64 + 32 * s + 8 * q); }
        hd.w0[n] = P.w0[row]; hd.a0[n] = P.a0[row]; hd.kk[n] = P.k_k[row]; hd.ka[n] = P.k_a[row]; hd.rk[n] = P.r_k[row]; }
}
__device__ __forceinline__ void prefetch(const Args& P, int b, int h, int c, int tid, Pre& pre) {
    const int t0 = b * SEQ + c * 64;
#pragma unroll
    for (int it = 0; it < 3; ++it) {
        int i, ch, col; task_map(tid + it * NTHREADS, h, i, ch, col);
        const bf16_t* src = P.prw + (size_t)(t0 + i) * RWKV_COLS + col;
        pre.cw[it] = *(const u32x4*)src;
        pre.pw[it] = (u32x4){0u, 0u, 0u, 0u};
        if (i != 0 || c != 0) pre.pw[it] = *(const u32x4*)(src - RWKV_COLS);
    }
    const int lane = tid & 63, r = lane & 15, q = lane >> 4, m = (tid >> 6) & 3;
    const bf16_t* xr = P.xs + (size_t)(t0 + 16 * m + r) * 256 + 8 * q;
#pragma unroll
    for (int f = 0; f < 4; ++f) pre.xs[f] = *(const bf16x8*)(xr + 32 * f);
}
__device__ __forceinline__ void unit(const Args& P, LAS unsigned char* lds, int b, int h, int c, int uidx, int tid, Pre& pf, Hd& hd, bool has_next, int nb, int nh_, int nc) {
    const int wave = __builtin_amdgcn_readfirstlane(tid >> 6), lane = tid & 63, r = lane & 15, q = lane >> 4, m = wave & 3, nh = wave >> 2;
    const int t0 = b * SEQ + c * 64;
    lp S0 = slot(lds, 0), S1 = slot(lds, 1), S2 = slot(lds, 2), S3 = slot(lds, 3), S4 = slot(lds, 4), S5 = slot(lds, 5), S6 = slot(lds, 6), S7 = slot(lds, 7);
    lp S8 = slot(lds, 8), S9 = slot(lds, 9), S10 = slot(lds, 10), S11 = slot(lds, 11), S12 = slot(lds, 12), S13 = slot(lds, 13), S14 = slot(lds, 14);
    LAS float* PART = (LAS float*)(lds + LDS_MISC);
    LAS float* CT = PART + 256;
    LAS float* DEND = CT + 256;
    const LAS bf16_t* MU = (const LAS bf16_t*)(lds + LDS_MU);
#define RK_BAR() do { asm volatile("s_waitcnt lgkmcnt(0)" ::: "memory"); __builtin_amdgcn_s_barrier(); asm volatile("" ::: "memory"); } while (0)
#define RK_DBG(bit, sp) do {} while (0)
#pragma unroll
    for (int it = 0; it < 3; ++it) {
        int i, ch, col; task_map(tid + it * NTHREADS, h, i, ch, col);
        LAS bf16_t* dst = slot(lds, 8 + (ch >> 3)) + i * LD + 8 * (ch & 7);
        const u32x4 cw = pf.cw[it], pw = pf.pw[it];
        const u32x4 mw = *(const LAS u32x4*)(MU + col);
        const f32x4 m0 = (f32x4){bflo(mw.x), bfhi(mw.x), bflo(mw.y), bfhi(mw.y)}, m1 = (f32x4){bflo(mw.z), bfhi(mw.z), bflo(mw.w), bfhi(mw.w)};
        float v[8], p[8];
        v[0] = bflo(cw.x); v[1] = bfhi(cw.x); v[2] = bflo(cw.y); v[3] = bfhi(cw.y); v[4] = bflo(cw.z); v[5] = bfhi(cw.z); v[6] = bflo(cw.w); v[7] = bfhi(cw.w);
        p[0] = bflo(pw.x); p[1] = bfhi(pw.x); p[2] = bflo(pw.y); p[3] = bfhi(pw.y); p[4] = bflo(pw.z); p[5] = bfhi(pw.z); p[6] = bflo(pw.w); p[7] = bfhi(pw.w);
#pragma unroll
        for (int j = 0; j < 4; ++j) { v[j] += (p[j] - v[j]) * m0[j]; v[4 + j] += (p[4 + j] - v[4 + j]) * m1[j]; }
        u32x4 w; w.x = pk2(v[0], v[1]); w.y = pk2(v[2], v[3]); w.z = pk2(v[4], v[5]); w.w = pk2(v[6], v[7]);
        *(LAS u32x4*)dst = w;
    }
    RK_BAR();
    f32x4 aw[2], aa[2];
#pragma unroll
    for (int n = 0; n < 2; ++n) { aw[n] = (f32x4){0.f, 0.f, 0.f, 0.f}; aa[n] = aw[n]; }
#pragma unroll
    for (int s = 0; s < 2; ++s)
#pragma unroll
        for (int n = 0; n < 2; ++n) { aw[n] = __builtin_amdgcn_mfma_f32_16x16x32_bf16(pf.xs[s], hd.w[s * 2 + n], aw[n], 0, 0, 0); aa[n] = __builtin_amdgcn_mfma_f32_16x16x32_bf16(pf.xs[2 + s], hd.a[s * 2 + n], aa[n], 0, 0, 0); }
    if (has_next) prefetch(P, nb, nh_, nc, tid, pf);
    float rr[2][4], kq[2][4], vv[2][4], av[2][4], lw[2][4], kp[2][4], pre[2][4], preq[2];
    float ss[4] = {0.f, 0.f, 0.f, 0.f}, bs[4] = {0.f, 0.f, 0.f, 0.f};
#pragma unroll
    for (int n = 0; n < 2; ++n) {
        const int ch = 32 * nh + 16 * n + r, chg = h * 64 + ch;
        const float w0v = hd.w0[n], a0v = hd.a0[n], kkc = hd.kk[n], kac = hd.ka[n], rkc = hd.rk[n];
#pragma unroll
        for (int ii = 0; ii < 4; ++ii) {
            const int pos = 16 * m + 4 * q + ii;
            const float rv = bf2f(S8[pos * LD + ch]), kraw = bf2f(S9[pos * LD + ch]); vv[n][ii] = bf2f(S10[pos * LD + ch]); rr[n][ii] = rv;
            lw[n][ii] = -0.60653066f * sigmoidf_(w0v + aw[n][ii]);
            const float a_ = sigmoidf_(a0v + aa[n][ii]); av[n][ii] = a_;
            const float kk = kraw * kkc; kq[n][ii] = kk;
            const float kpv = kraw * (1.0f + (a_ - 1.0f) * kac); kp[n][ii] = kpv;
            ss[ii] += kk * kk; bs[ii] += rv * kpv * rkc;
        }
        pre[n][0] = lw[n][0]; pre[n][1] = pre[n][0] + lw[n][1]; pre[n][2] = pre[n][1] + lw[n][2]; pre[n][3] = pre[n][2] + lw[n][3];
        const float tot = pre[n][3];
        const float t0_ = __shfl(tot, r), t1_ = __shfl(tot, r + 16), t2_ = __shfl(tot, r + 32), t3_ = __shfl(tot, r + 48);
        preq[n] = (q > 0 ? t0_ : 0.f) + (q > 1 ? t1_ : 0.f) + (q > 2 ? t2_ : 0.f);
        if (q == 0) CT[m * 64 + ch] = (t0_ + t1_) + (t2_ + t3_);
    }
#pragma unroll
    for (int ii = 0; ii < 4; ++ii) {
        ss[ii] = row_sum16(ss[ii]); bs[ii] = row_sum16(bs[ii]);
        if (r == 0) { const int pos = 16 * m + 4 * q + ii; PART[(nh * 64 + pos) * 2] = ss[ii]; PART[(nh * 64 + pos) * 2 + 1] = bs[ii]; }
    }
    RK_BAR();
#pragma unroll
    for (int n = 0; n < 2; ++n) {
        const int ch = 32 * nh + 16 * n + r;
        float carry = 0.f, lend = 0.f;
#pragma unroll
        for (int mm = 0; mm < 4; ++mm) { const float cv = CT[mm * 64 + ch]; lend += cv; carry += (mm < m) ? cv : 0.f; }
        f32x4 tA, tBh, tKh, tV;
        const float elend = fexp(lend);
        float ePrev = fexp(carry + preq[n]);
#pragma unroll
        for (int ii = 0; ii < 4; ++ii) {
            const int pos = 16 * m + 4 * q + ii;
            const float L = carry + preq[n] + pre[n][ii];
            const float ssum = PART[pos * 2] + PART[(64 + pos) * 2];
            const float inv = fminf(__builtin_amdgcn_rsqf(ssum), 1e12f);
            const float kkn = kq[n][ii] * inv, kb = kkn * av[n][ii];
            const float eN = fexp(-L), eL = frcp(eN), eE = elend * eN;
            const float At = -kkn * ePrev, Rt = rr[n][ii] * eL, Bt = kb * eN, Kt = kp[n][ii] * eN;
            ePrev = eL;
            S0[pos * LD + ch] = f2bf(At); S1[pos * LD + ch] = f2bf(Bt); S2[pos * LD + ch] = f2bf(Kt); S3[pos * LD + ch] = f2bf(Rt);
            tA[ii] = At; tBh[ii] = kb * eE; tKh[ii] = kp[n][ii] * eE; tV[ii] = vv[n][ii];
            P.bv[(size_t)(t0 + pos) * RW + h * 64 + ch] = f2bf((PART[pos * 2 + 1] + PART[(64 + pos) * 2 + 1]) * vv[n][ii]);
        }
        { u32x2 w; const int off = ch * LD + 16 * m + 4 * q;
          w.x = pk2(tA[0], tA[1]); w.y = pk2(tA[2], tA[3]); *(LAS u32x2*)(S4 + off) = w;
          w.x = pk2(tBh[0], tBh[1]); w.y = pk2(tBh[2], tBh[3]); *(LAS u32x2*)(S5 + off) = w;
          w.x = pk2(tKh[0], tKh[1]); w.y = pk2(tKh[2], tKh[3]); *(LAS u32x2*)(S6 + off) = w;
          w.x = pk2(tV[0], tV[1]); w.y = pk2(tV[2], tV[3]); *(LAS u32x2*)(S7 + off) = w; }
        if (m == 0 && q == 0) DEND[ch] = elend;
    }
    RK_BAR();
    if (has_next) load_head(P, nh_, tid, hd);
    RK_DBG(0, S0); RK_DBG(1, S1); RK_DBG(2, S2); RK_DBG(3, S3); RK_DBG(4, S4); RK_DBG(5, S5); RK_DBG(6, S6); RK_DBG(7, S7);
    const int nt0 = 2 * nh;
    f32x4 acc[2], acc2[2];
#define RK_ZERO(a) do { a[0] = (f32x4){0.f, 0.f, 0.f, 0.f}; a[1] = a[0]; } while (0)
#define RK_LDT(src, mt, ntt, a) do { const u32x2 w_ = *(const LAS u32x2*)((src) + (16 * (ntt) + r) * LD + 16 * (mt) + 4 * q); a = (f32x4){bflo(w_.x), bfhi(w_.x), bflo(w_.y), bfhi(w_.y)}; } while (0)
#define RK_MASK(a, ntt, COND) do { _Pragma("unroll") for (int ii = 0; ii < 4; ++ii) { const int row = 16 * m + 4 * q + ii, col = 16 * (ntt) + r; a[ii] = (COND) ? a[ii] : 0.f; } } while (0)
    RK_ZERO(acc); mm_nt<2>(S0, LD, S1, LD, m, nt0, r, q, acc);
#pragma unroll
    for (int n = 0; n < 2; ++n) { RK_MASK(acc[n], nt0 + n, col < row); st_tr(S9, m, nt0 + n, r, q, acc[n]); }
    RK_ZERO(acc); mm_nt<2>(S1, LD, S0, LD, m, nt0, r, q, acc);
#pragma unroll
    for (int n = 0; n < 2; ++n) { RK_MASK(acc[n], nt0 + n, row < col); st_tr(S8, m, nt0 + n, r, q, acc[n]);
#pragma unroll
        for (int ii = 0; ii < 4; ++ii) acc[n][ii] += ((16 * m + 4 * q + ii) == (16 * (nt0 + n) + r)) ? 1.f : 0.f;
        st_tr(S10, m, nt0 + n, r, q, acc[n]); }
    RK_ZERO(acc); mm_nt<2>(S2, LD, S0, LD, m, nt0, r, q, acc);
#pragma unroll
    for (int n = 0; n < 2; ++n) { RK_MASK(acc[n], nt0 + n, row < col); st_tr(S11, m, nt0 + n, r, q, acc[n]); }
    RK_ZERO(acc); mm_nt<2>(S1, LD, S3, LD, m, nt0, r, q, acc);
#pragma unroll
    for (int n = 0; n < 2; ++n) { RK_MASK(acc[n], nt0 + n, row <= col); st_tr(S12, m, nt0 + n, r, q, acc[n]); }
    RK_ZERO(acc); mm_nt<2>(S2, LD, S3, LD, m, nt0, r, q, acc);
#pragma unroll
    for (int n = 0; n < 2; ++n) { RK_MASK(acc[n], nt0 + n, row <= col); st_tr(S13, m, nt0 + n, r, q, acc[n]); }
    RK_BAR();
    RK_ZERO(acc); mm_nt<2>(S8, LD, S9, LD, m, nt0, r, q, acc);
    RK_ZERO(acc2); mm_nt<2>(S9, LD, S8, LD, m, nt0, r, q, acc2);
#pragma unroll
    for (int n = 0; n < 2; ++n) { st_tr(S1, m, nt0 + n, r, q, acc[n]); st_tr(S0, m, nt0 + n, r, q, acc2[n]); }
    RK_ZERO(acc); mm_nt<2>(S11, LD, S7, LD, m, nt0, r, q, acc);
#pragma unroll
    for (int n = 0; n < 2; ++n) st_tr(S14, m, nt0 + n, r, q, acc[n]);
    RK_BAR();
#define RK_ROUND(Tsrc, Tdst, Psrc, PTsrc, Pdst, PTdst) do { \
        if (wave < 6) { const int pr_ = wave >> 1, hm_ = wave & 1; \
            const LAS bf16_t* X_ = (pr_ == 1) ? (const LAS bf16_t*)(Psrc) : (const LAS bf16_t*)(PTsrc); \
            const LAS bf16_t* Y_ = (pr_ == 0) ? (const LAS bf16_t*)(Tsrc) : ((pr_ == 1) ? (const LAS bf16_t*)(PTsrc) : (const LAS bf16_t*)(Psrc)); \
            lp D_ = (pr_ == 0) ? (Tdst) : ((pr_ == 1) ? (PTdst) : (Pdst)); \
            f32x4 ac_[2][4]; \
            _Pragma("unroll") for (int i_ = 0; i_ < 2; ++i_) _Pragma("unroll") for (int n_ = 0; n_ < 4; ++n_) ac_[i_][n_] = (f32x4){0.f, 0.f, 0.f, 0.f}; \
            if (pr_ == 0) { _Pragma("unroll") for (int i_ = 0; i_ < 2; ++i_) _Pragma("unroll") for (int n_ = 0; n_ < 4; ++n_) RK_LDT(Tsrc, 2 * hm_ + i_, n_, ac_[i_][n_]); } \
            _Pragma("unroll") for (int s_ = 0; s_ < 2; ++s_) { bf16x8 a_[2], b_[4]; \
                _Pragma("unroll") for (int i_ = 0; i_ < 2; ++i_) a_[i_] = *(const LAS bf16x8*)(X_ + (16 * (2 * hm_ + i_) + r) * LD + 32 * s_ + 8 * q); \
                _Pragma("unroll") for (int n_ = 0; n_ < 4; ++n_) b_[n_] = *(const LAS bf16x8*)(Y_ + (16 * n_ + r) * LD + 32 * s_ + 8 * q); \
                _Pragma("unroll") for (int i_ = 0; i_ < 2; ++i_) _Pragma("unroll") for (int n_ = 0; n_ < 4; ++n_) ac_[i_][n_] = __builtin_amdgcn_mfma_f32_16x16x32_bf16(a_[i_], b_[n_], ac_[i_][n_], 0, 0, 0); } \
            _Pragma("unroll") for (int i_ = 0; i_ < 2; ++i_) _Pragma("unroll") for (int n_ = 0; n_ < 4; ++n_) st_tr(D_, 2 * hm_ + i_, n_, r, q, ac_[i_][n_]); } \
        RK_BAR(); } while (0)
#ifndef EXP_SKIP_ROUNDS
    RK_ROUND(S10, S2, S0, S1, S8, S9);
    RK_ROUND(S2, S10, S8, S9, S0, S1);
    RK_ROUND(S10, S2, S0, S1, S8, S9);
    RK_ROUND(S2, S10, S8, S9, S0, S1);
#endif
    RK_LDT(S10, m, nt0, acc[0]); RK_LDT(S10, m, nt0 + 1, acc[1]); mm_nt<2>(S1, LD, S10, LD, m, nt0, r, q, acc);
#pragma unroll
    for (int n = 0; n < 2; ++n) st_tr(S2, m, nt0 + n, r, q, acc[n]);
    RK_BAR();
    RK_ZERO(acc); mm_nt<2>(S2, LD, S4, LD, m, nt0, r, q, acc);
    RK_ZERO(acc2); mm_nt<2>(S2, LD, S14, LD, m, nt0, r, q, acc2);
#pragma unroll
    for (int n = 0; n < 2; ++n) { st_tr(S11, m, nt0 + n, r, q, acc[n]); st_tr(S0, m, nt0 + n, r, q, acc2[n]); }
    RK_BAR();
    {
        const int sw = wave & 1, ntw = wave >> 1;
        unsigned char* mn_ = P.mn + (size_t)uidx * 16384; unsigned char* qy_ = P.qy + (size_t)uidx * 16384;
        f32x4 c2[2];
#define RK_MM2(X, Y) do { _Pragma("unroll") for (int s_ = 0; s_ < 2; ++s_) { const bf16x8 b_ = *(const LAS bf16x8*)((Y) + (16 * ntw + r) * LD + 32 * s_ + 8 * q); \
            _Pragma("unroll") for (int mi = 0; mi < 2; ++mi) { const bf16x8 a_ = *(const LAS bf16x8*)((X) + (16 * (2 * sw + mi) + r) * LD + 32 * s_ + 8 * q); c2[mi] = __builtin_amdgcn_mfma_f32_16x16x32_bf16(a_, b_, c2[mi], 0, 0, 0); } } } while (0)
        RK_ZERO(c2); RK_MM2(S11, S5);
#pragma unroll
        for (int mi = 0; mi < 2; ++mi)
#pragma unroll
            for (int ii = 0; ii < 4; ++ii) { const int row = 16 * (2 * sw + mi) + 4 * q + ii, col = 16 * ntw + r; c2[mi][ii] += (row == col) ? DEND[row] : 0.f; }
        { u32x4 w; w.x = pk2(c2[0][0], c2[0][1]); w.y = pk2(c2[0][2], c2[0][3]); w.z = pk2(c2[1][0], c2[1][1]); w.w = pk2(c2[1][2], c2[1][3]); *(u32x4*)(mn_ + ((ntw * 2 + sw) * 64 + lane) * 16) = w; }
#pragma unroll
        for (int mi = 0; mi < 2; ++mi) { const u32x2 rw_ = *(const LAS u32x2*)(S3 + (16 * ntw + r) * LD + 16 * (2 * sw + mi) + 4 * q); c2[mi] = (f32x4){bflo(rw_.x), bfhi(rw_.x), bflo(rw_.y), bfhi(rw_.y)}; }
        RK_MM2(S11, S12);
        { u32x4 w; w.x = pk2(c2[0][0], c2[0][1]); w.y = pk2(c2[0][2], c2[0][3]); w.z = pk2(c2[1][0], c2[1][1]); w.w = pk2(c2[1][2], c2[1][3]); *(u32x4*)(qy_ + ((ntw * 2 + sw) * 64 + lane) * 16) = w; }
        RK_ZERO(c2); RK_MM2(S5, S0); RK_MM2(S6, S7);
#pragma unroll
        for (int mi = 0; mi < 2; ++mi) { u32x2 w; w.x = pk2(c2[mi][0], c2[mi][1]); w.y = pk2(c2[mi][2], c2[mi][3]); *(u32x2*)(mn_ + 8192 + ((ntw * 4 + 2 * sw + mi) * 64 + lane) * 8) = w; }
        RK_ZERO(c2); RK_MM2(S0, S12); RK_MM2(S7, S13);
#pragma unroll
        for (int mi = 0; mi < 2; ++mi) { u32x2 w; w.x = pk2(c2[mi][0], c2[mi][1]); w.y = pk2(c2[mi][2], c2[mi][3]); *(u32x2*)(qy_ + 8192 + (((2 * sw + mi) * 4 + ntw) * 64 + lane) * 8) = w; }
#undef RK_MM2
    }
    RK_BAR();
#undef RK_ZERO
#undef RK_ROUND
#undef RK_LDT
#undef RK_MASK
#undef RK_BAR
}
__device__ __forceinline__ void scan_wg(const unsigned char* mn, unsigned char* sbuf, int ubase, int vq, LAS unsigned char* lds, int tid) {
    const int wave = __builtin_amdgcn_readfirstlane(tid >> 6), lane = tid & 63;
    constexpr int NC = SEQ / 64, NS = 8, SLOT = 10240, AHEAD = 6;
    const unsigned char* src = mn + (size_t)ubase * 16384 + lane * 16;
    const bool loader = (wave >= 1 && wave <= 5);
    const size_t poff = (wave == 5) ? (size_t)(8192 + vq * 2048) : (size_t)(2048 * (wave - 1));
#define SC_ISSUE(c) do { const unsigned char* s_ = src + (size_t)(c) * 16384 + poff; LAS unsigned char* d_ = lds + ((c) % NS) * SLOT + 2048 * (wave - 1); \
        _Pragma("unroll") for (int i_ = 0; i_ < 2; ++i_) __builtin_amdgcn_global_load_lds((const unsigned*)(s_ + i_ * 1024), (LAS unsigned*)(d_ + i_ * 1024), 16, 0, 2); } while (0)
#define SC_BAR() do { asm volatile("s_waitcnt lgkmcnt(0)" ::: "memory"); __builtin_amdgcn_s_barrier(); asm volatile("" ::: "memory"); } while (0)
    bf16x8 sB[2];
#pragma unroll
    for (int s = 0; s < 2; ++s) sB[s] = (bf16x8){0, 0, 0, 0, 0, 0, 0, 0};
    if (loader) {
#pragma unroll
        for (int c = 0; c < AHEAD; ++c) SC_ISSUE(c);
        asm volatile("s_waitcnt vmcnt(10)" ::: "memory"); }
    SC_BAR();
    for (int c = 0; c < NC; ++c) {
        if (loader) {
            if (c + AHEAD < NC) { SC_ISSUE(c + AHEAD); asm volatile("s_waitcnt vmcnt(10)" ::: "memory"); }
            else { asm volatile("s_waitcnt vmcnt(0)" ::: "memory"); }
        } else if (wave == 0) {
            const LAS unsigned char* sl = lds + (c % NS) * SLOT;
            unsigned char* so = sbuf + (size_t)(ubase + c) * 8192 + (vq * 2) * 1024 + lane * 16;
            *(bf16x8*)so = sB[0]; *(bf16x8*)(so + 1024) = sB[1];
            f32x4 aS[4];
#pragma unroll
            for (int mm = 0; mm < 4; ++mm) {
                const u32x2 nI = *(const LAS u32x2*)(sl + 8192 + (mm * 64 + lane) * 8);
                aS[mm] = (f32x4){bflo(nI.x), bfhi(nI.x), bflo(nI.y), bfhi(nI.y)};
#pragma unroll
                for (int s = 0; s < 2; ++s) { const bf16x8 aM = *(const LAS bf16x8*)(sl + ((mm * 2 + s) * 64 + lane) * 16); aS[mm] = __builtin_amdgcn_mfma_f32_16x16x32_bf16(aM, sB[s], aS[mm], 0, 0, 0); }
            }
#pragma unroll
            for (int s = 0; s < 2; ++s) { u32x4 w; w.x = pk2(aS[2 * s][0], aS[2 * s][1]); w.y = pk2(aS[2 * s][2], aS[2 * s][3]); w.z = pk2(aS[2 * s + 1][0], aS[2 * s + 1][1]); w.w = pk2(aS[2 * s + 1][2], aS[2 * s + 1][3]);
                sB[s] = __builtin_bit_cast(bf16x8, w); }
        }
        SC_BAR();
    }
#undef SC_ISSUE
#undef SC_BAR
}
struct YArgs { const unsigned char* qy; const unsigned char* sbuf; const bf16_t* g; const bf16_t* bv; const float* ln_g; const float* ln_b; unsigned char* ya; };
__device__ __forceinline__ void ypass_unit(const YArgs& P, int u, int lane) {
    const int r = lane & 15, q = lane >> 4, b = u >> 10, h = (u >> 7) & 7, c = u & 127, t0 = b * SEQ + c * 64;
    const unsigned char* qy_ = P.qy + (size_t)u * 16384; const unsigned char* s_ = P.sbuf + (size_t)u * 8192;
    bf16x8 Qf[4][2], Sf[4][2]; u32x2 y0[4][4];
#pragma unroll
    for (int i = 0; i < 4; ++i)
#pragma unroll
        for (int s = 0; s < 2; ++s) { Qf[i][s] = *(const bf16x8*)(qy_ + ((i * 2 + s) * 64 + lane) * 16); Sf[i][s] = *(const bf16x8*)(s_ + ((i * 2 + s) * 64 + lane) * 16); }
#pragma unroll
    for (int vq = 0; vq < 4; ++vq)
#pragma unroll
        for (int mm = 0; mm < 4; ++mm) y0[vq][mm] = *(const u32x2*)(qy_ + 8192 + ((vq * 4 + mm) * 64 + lane) * 8);
    f32x4 lg[4], lb[4];
#pragma unroll
    for (int vq = 0; vq < 4; ++vq) { lg[vq] = *(const f32x4*)(P.ln_g + h * 64 + 16 * vq + 4 * q); lb[vq] = *(const f32x4*)(P.ln_b + h * 64 + 16 * vq + 4 * q); }
#pragma unroll
    for (int mm = 0; mm < 4; ++mm) {
        const size_t ro = (size_t)(t0 + 16 * mm + r) * RW + h * 64 + 4 * q;
        u32x2 gw_[4], bw_[4];
#pragma unroll
        for (int vq = 0; vq < 4; ++vq) { gw_[vq] = *(const u32x2*)(P.g + ro + 16 * vq); bw_[vq] = *(const u32x2*)(P.bv + ro + 16 * vq); }
        f32x4 acc[4]; float sum = 0.f;
#pragma unroll
        for (int vq = 0; vq < 4; ++vq) {
            acc[vq] = (f32x4){bflo(y0[vq][mm].x), bfhi(y0[vq][mm].x), bflo(y0[vq][mm].y), bfhi(y0[vq][mm].y)};
#pragma unroll
            for (int s = 0; s < 2; ++s) acc[vq] = __builtin_amdgcn_mfma_f32_16x16x32_bf16(Sf[vq][s], Qf[mm][s], acc[vq], 0, 0, 0);
            sum += (acc[vq][0] + acc[vq][1]) + (acc[vq][2] + acc[vq][3]);
        }
        sum += __shfl_xor(sum, 16); sum += __shfl_xor(sum, 32);
        const float mean = sum * (1.f / 64.f); float var = 0.f;
#pragma unroll
        for (int vq = 0; vq < 4; ++vq) { acc[vq] = acc[vq] - mean; var += (acc[vq][0] * acc[vq][0] + acc[vq][1] * acc[vq][1]) + (acc[vq][2] * acc[vq][2] + acc[vq][3] * acc[vq][3]); }
        var += __shfl_xor(var, 16); var += __shfl_xor(var, 32);
        const float rstd = __builtin_amdgcn_rsqf(var * (1.f / 64.f) + 64e-5f);
#pragma unroll
        for (int vq = 0; vq < 4; ++vq) {
            const f32x4 gg = (f32x4){bflo(gw_[vq].x), bfhi(gw_[vq].x), bflo(gw_[vq].y), bfhi(gw_[vq].y)}, bb = (f32x4){bflo(bw_[vq].x), bfhi(bw_[vq].x), bflo(bw_[vq].y), bfhi(bw_[vq].y)};
            const f32x4 o = (acc[vq] * rstd * lg[vq] + lb[vq] + bb) * gg;
            int t8 = __builtin_amdgcn_cvt_pk_fp8_f32(o[0], o[1], 0, false); t8 = __builtin_amdgcn_cvt_pk_fp8_f32(o[2], o[3], t8, true); *(unsigned*)(P.ya + (size_t)(t0 + 16 * mm + r) * 1024 + h * 64 + 4 * q + 16 * vq) = (unsigned)t8; }
    }
}
}
namespace gl {
constexpr int LDV = 136;
#define GL_BAR() do { asm volatile("s_waitcnt lgkmcnt(0)" ::: "memory"); __builtin_amdgcn_s_barrier(); asm volatile("" ::: "memory"); } while (0)
struct Args { const bf16_t* puv; const bf16_t* wsm; const float* bs; const float* ln_g; const float* ln_b; unsigned char* yb; };
__device__ __forceinline__ void unit(const Args& P, LAS unsigned char* lds, int b, int blk, int tid, const ExpW X, int& cvi, int cvs, int cve) {
    const int wave = __builtin_amdgcn_readfirstlane(tid >> 6), lane = tid & 63, r = lane & 15, q = lane >> 4;
    const int t0 = b * SEQ + blk * 128;
    LAS float* STAT = (LAS float*)(lds + LDS_MISC);
#pragma unroll
    for (int hb = 0; hb < 2; ++hb) {
        u32x4 w[8];
#pragma unroll
        for (int j = 0; j < 8; ++j) w[j] = *(const u32x4*)(P.puv + (size_t)(t0 + 16 * wave + 8 * hb + j) * 1024 + 512 + 8 * lane);
#pragma unroll
        for (int j = 0; j < 8; ++j) {
            float v[8]; v[0] = bflo(w[j].x); v[1] = bfhi(w[j].x); v[2] = bflo(w[j].y); v[3] = bfhi(w[j].y); v[4] = bflo(w[j].z); v[5] = bfhi(w[j].z); v[6] = bflo(w[j].w); v[7] = bfhi(w[j].w);
            float s = 0.f, s2 = 0.f;
#pragma unroll
            for (int e = 0; e < 8; ++e) { s += v[e]; s2 += v[e] * v[e]; }
            s = wave_sum(s); s2 = wave_sum(s2);
            const float mean = s * (1.f / 512.f), var = fmaxf(s2 * (1.f / 512.f) - mean * mean, 0.f);
            if (lane == 0) { const int tk = 16 * wave + 8 * hb + j; STAT[tk * 2] = mean; STAT[tk * 2 + 1] = __builtin_amdgcn_rsqf(var + 1e-5f); }
        }
    }
    u32x4 pv[2], pu[2];
#define GL_LOAD(g) do { _Pragma("unroll") for (int it = 0; it < 2; ++it) { const int task = tid + it * NTHREADS, j = task >> 3, cc = task & 7; \
        const bf16_t* row = P.puv + (size_t)(t0 + j) * 1024 + (g) * 64 + 8 * cc; pu[it] = __builtin_nontemporal_load((const u32x4*)row); pv[it] = __builtin_nontemporal_load((const u32x4*)(row + 512)); } } while (0)
    GL_LOAD(0);
    GL_BAR();
    LAS float* cscr = (LAS float*)(lds + 77824 + wave * 8448);
    for (int g = 0; g < 8; ++g) {
        const bool cvh = cvi < cve;
        const CvItem cvc = cv_decode_half(X, cvh ? cvi : 0);
        f32x4 cvv[8];
        if (cvh) cv64_load(cvv, cvc.W, cvc.ldw, cvc.k0, cvc.n0, lane);
        LAS bf16_t* VT = (LAS bf16_t*)(lds + (g & 1) * 20480);
        LAS bf16_t* US = (LAS bf16_t*)(lds + 40960 + (g & 1) * 18432);
#pragma unroll
        for (int it = 0; it < 2; ++it) {
            const int task = tid + it * NTHREADS, j = task >> 3, cc = task & 7, ch = g * 64 + 8 * cc;
            const u32x4 w = pv[it];
            const float mean = STAT[j * 2], rstd = STAT[j * 2 + 1];
            const f32x4 g0 = *(const f32x4*)(P.ln_g + ch), g1 = *(const f32x4*)(P.ln_g + ch + 4), b0 = *(const f32x4*)(P.ln_b + ch), b1 = *(const f32x4*)(P.ln_b + ch + 4);
            float v[8]; v[0] = bflo(w.x); v[1] = bfhi(w.x); v[2] = bflo(w.y); v[3] = bfhi(w.y); v[4] = bflo(w.z); v[5] = bfhi(w.z); v[6] = bflo(w.w); v[7] = bfhi(w.w);
#pragma unroll
            for (int e = 0; e < 4; ++e) { v[e] = (v[e] - mean) * rstd * g0[e] + b0[e]; v[4 + e] = (v[4 + e] - mean) * rstd * g1[e] + b1[e]; }
#pragma unroll
            for (int e = 0; e < 8; ++e) VT[(8 * cc + e) * LDV + j] = f2bf(v[e]);
            *(LAS u32x4*)(US + j * 72 + 8 * cc) = pu[it];
        }
        if (g + 1 < 8) GL_LOAD(g + 1);
        GL_BAR();
        f32x4 acc[4];
#pragma unroll
        for (int n = 0; n < 4; ++n) acc[n] = (f32x4){0.f, 0.f, 0.f, 0.f};
        const bf16_t* wrow = P.wsm + ((size_t)g * 128 + 16 * wave + r) * 128 + 8 * q;
        const int ks = (wave >> 1) + 1;
        for (int s = 0; s < ks; ++s) {
            const bf16x8 a = *(const bf16x8*)(wrow + 32 * s);
#pragma unroll
            for (int n = 0; n < 4; ++n) { const bf16x8 bb = *(const LAS bf16x8*)(VT + (16 * n + r) * LDV + 32 * s + 8 * q); acc[n] = __builtin_amdgcn_mfma_f32_16x16x32_bf16(a, bb, acc[n], 0, 0, 0); }
        }
#pragma unroll
        for (int ii = 0; ii < 4; ++ii) { const int i = 16 * wave + 4 * q + ii; const float bias = P.bs[g * 128 + i];
#pragma unroll
            for (int n = 0; n < 4; ++n) { const int c = 16 * n + r; const float u = bf2f(US[i * 72 + c]);
                P.yb[(size_t)(t0 + i) * 1024 + 512 + g * 64 + c] = (unsigned char)(__builtin_amdgcn_cvt_pk_fp8_f32(u * (acc[n][ii] + bias), 0.f, 0, false) & 0xff); } }
        if (cvh) { cv64_finish(cvv, cvc.perm, cvc.k0, cvc.dst, cvc.ldt, cvc.drow0, cscr, lane); cvi += cvs; }
    }
    GL_BAR();
#undef GL_LOAD
}
}

struct RouteArgs { const float* sc; const float* bias; int* eidx; float* ewt; int* lrank; int* tbase; unsigned* segcnt; };
__device__ __forceinline__ unsigned fkey(float v) { const unsigned b = __float_as_uint(v); return b ^ ((b >> 31) ? 0xFFFFFFFFu : 0x80000000u); }
__device__ __forceinline__ void topk_tile(const RouteArgs& P, LAS unsigned char* lds, int tid, int tile, const ExpW X, int& cvi, int cvs, int cve) {
    const int wave = __builtin_amdgcn_readfirstlane(tid >> 6), lane = tid & 63, grp = lane >> 3;
    LAS int* hist = (LAS int*)(lds + LDS_MISC);
    const f32x4 bias4 = *(const f32x4*)(P.bias + 4 * lane);
    if (tid < NE) hist[tid] = 0;
    __syncthreads();
    f32x4 nx[2];
#pragma unroll
    for (int u = 0; u < 2; ++u) nx[u] = *(const f32x4*)(P.sc + (size_t)(tile * 256 + wave * 32 + u) * NE + 4 * lane);
    LAS float* scr = (LAS float*)(lds + wave * 16896);
    for (int j = 0; j < 32; j += 2) {
        const int t0 = tile * 256 + wave * 32 + j;
        const f32x4 cur4[2] = {nx[0], nx[1]};
        const bool cvh = (cvi < cve) && ((j >> 1) % CV_EVERY == 0);
        const CvItem cvc = cv_decode(X, cvh ? cvi : 0);
        f32x4 cvv[16];
        if (cvh) cv128_load(cvv, cvc.W, cvc.ldw, cvc.k0, cvc.n0, lane);
        if (j + 2 < 32) {
#pragma unroll
            for (int u = 0; u < 2; ++u) nx[u] = *(const f32x4*)(P.sc + (size_t)(t0 + 2 + u) * NE + 4 * lane); }
        float s[2][4]; unsigned key[2][4];
#pragma unroll
        for (int u = 0; u < 2; ++u) {
            float v[4];
#pragma unroll
            for (int e = 0; e < 4; ++e) { s[u][e] = cur4[u][e]; v[e] = s[u][e] + bias4[e]; }
            float m1, m2;
            { const float a = fmaxf(v[0], v[1]), b = fminf(v[0], v[1]), c = fmaxf(v[2], v[3]), d = fminf(v[2], v[3]); m1 = fmaxf(a, c); m2 = fmaxf(fminf(a, c), fmaxf(b, d)); }
            { float o1 = dppf<DPP_X1>(m1), o2 = dppf<DPP_X1>(m2); float n1 = fmaxf(m1, o1), n2 = fmaxf(fminf(m1, o1), fmaxf(m2, o2)); m1 = n1; m2 = n2;
              o1 = dppf<DPP_X2>(m1); o2 = dppf<DPP_X2>(m2); n1 = fmaxf(m1, o1); n2 = fmaxf(fminf(m1, o1), fmaxf(m2, o2)); m1 = n1; m2 = n2;
              o1 = dppf<DPP_HM>(m1); o2 = dppf<DPP_HM>(m2); n1 = fmaxf(m1, o1); n2 = fmaxf(fminf(m1, o1), fmaxf(m2, o2)); m1 = n1; m2 = n2; }
            const float gs = m1 + m2;
            int cnt = 0;
#pragma unroll
            for (int g = 0; g < 8; ++g) { const float og = __builtin_bit_cast(float, __builtin_amdgcn_readlane(__builtin_bit_cast(int, gs), 8 * g)); cnt += (og > gs || (og == gs && g < grp)) ? 1 : 0; }
#pragma unroll
            for (int e = 0; e < 4; ++e) key[u][e] = (cnt < 4) ? fkey(v[e]) : 0u;
        }
        unsigned thr[2] = {0u, 0u};
#pragma unroll 1
        for (int bit = 31; bit >= 0; --bit) {
#pragma unroll
            for (int u = 0; u < 2; ++u) { const unsigned cand = thr[u] | (1u << bit); int c = 0;
#pragma unroll
                for (int e = 0; e < 4; ++e) c += __builtin_popcountll(__ballot(key[u][e] >= cand));
                thr[u] = (c >= TOPK) ? cand : thr[u]; }
        }
#pragma unroll
        for (int u = 0; u < 2; ++u) {
            const int t = t0 + u;
            bool sel[4]; unsigned long long meq[4]; int cgt = 0;
#pragma unroll
            for (int e = 0; e < 4; ++e) { sel[e] = key[u][e] > thr[u]; cgt += __builtin_popcountll(__ballot(sel[e])); meq[e] = __ballot(key[u][e] == thr[u]); }
            for (int need = TOPK - cgt; need > 0; --need) {
                const unsigned long long many = meq[0] | meq[1] | meq[2] | meq[3];
                const int L = __builtin_ctzll(many);
                const int e_ = ((meq[0] >> L) & 1ull) ? 0 : ((meq[1] >> L) & 1ull) ? 1 : ((meq[2] >> L) & 1ull) ? 2 : 3;
#pragma unroll
                for (int e = 0; e < 4; ++e) { if (e == e_) { meq[e] &= ~(1ull << L); sel[e] = sel[e] || (lane == L); } }
            }
            float part = 0.f;
#pragma unroll
            for (int e = 0; e < 4; ++e) part += sel[e] ? s[u][e] : 0.f;
            part += dppf<DPP_X1>(part); part += dppf<DPP_X2>(part); part += dppf<DPP_HM>(part); part += dppf<DPP_RM>(part);
            const float ssum = (__builtin_bit_cast(float, __builtin_amdgcn_readlane(__builtin_bit_cast(int, part), 0)) + __builtin_bit_cast(float, __builtin_amdgcn_readlane(__builtin_bit_cast(int, part), 16)))
                             + (__builtin_bit_cast(float, __builtin_amdgcn_readlane(__builtin_bit_cast(int, part), 32)) + __builtin_bit_cast(float, __builtin_amdgcn_readlane(__builtin_bit_cast(int, part), 48)));
            const float scale = 2.5f / ssum;
            int base = 0;
#pragma unroll
            for (int e = 0; e < 4; ++e) { const unsigned long long ms = __ballot(sel[e]);
                if (sel[e]) { const int k = base + __builtin_amdgcn_mbcnt_hi((unsigned)(ms >> 32), __builtin_amdgcn_mbcnt_lo((unsigned)ms, 0)); const int idx = 4 * lane + e;
                    const int lr = __hip_atomic_fetch_add(hist + idx, 1, __ATOMIC_RELAXED, __HIP_MEMORY_SCOPE_WORKGROUP);
                    P.eidx[(size_t)t * TOPK + k] = idx; P.ewt[(size_t)t * TOPK + k] = s[u][e] * scale; P.lrank[(size_t)t * TOPK + k] = lr; }
                base += __builtin_popcountll(ms); }
        }
        if (cvh) { cv128_finish(cvv, cvc.perm, cvc.k0, cvc.dst, cvc.ldt, cvc.drow0, scr, lane); cvi += cvs; }
    }
    __syncthreads();
    if (tid < NE) { const int cnt = hist[tid]; unsigned base = 0u;
        if (cnt) base = __hip_atomic_fetch_add(P.segcnt + tid, (unsigned)cnt, __ATOMIC_RELAXED, __HIP_MEMORY_SCOPE_AGENT);
        P.tbase[tile * NE + tid] = (int)base; }
    __syncthreads();
}
struct ScatArgs { const int* eidx; const float* ewt; const int* lrank; const int* tbase; const unsigned* segcnt; int* rowtok; int* rowdst; float* roww; int* tab; unsigned* ntile; };
__device__ __forceinline__ void phase_scatter(const ScatArgs& P, LAS unsigned char* lds, int tid, int G) {
    LAS int* cntL = (LAS int*)(lds + LDS_MISC); LAS int* segst = cntL + 256; LAS int* tsa = segst + 256;
    if (tid < NE) cntL[tid] = (int)__hip_atomic_load(P.segcnt + tid, __ATOMIC_RELAXED, __HIP_MEMORY_SCOPE_AGENT);
    __syncthreads();
    {
        LAS int* wtot = tsa + 256;
        const int lane_ = tid & 63, wv = tid >> 6;
        int nts = 0, x = 0;
        if (tid < NE) { nts = (cntL[tid] + 255) >> 8; x = nts;
#pragma unroll
            for (int d = 1; d < 64; d <<= 1) { const int y = __shfl_up(x, d); x += (lane_ >= d) ? y : 0; }
            if (lane_ == 63) wtot[wv] = x; }
        __syncthreads();
        if (tid < NE) { int pre = 0;
#pragma unroll
            for (int w = 0; w < 3; ++w) pre += (w < wv) ? wtot[w] : 0;
            const int ex = pre + x - nts; tsa[tid] = ex; segst[tid] = ex * 256;
            if (tid == NE - 1 && blockIdx.x == 0) P.ntile[0] = (unsigned)(pre + x); }
    }
    __syncthreads();
    for (int tile = blockIdx.x; tile < T / 256; tile += G) {
        for (int a = tid; a < 256 * TOPK; a += NTHREADS) {
            const int tok = tile * 256 + (a >> 3), k = a & 7; const size_t ai = (size_t)tok * TOPK + k;
            const int e = P.eidx[ai];
            const int pos = segst[e] + P.tbase[tile * NE + e] + P.lrank[ai];
            P.rowtok[pos] = tok; P.rowdst[pos] = tok * TOPK + k; P.roww[pos] = P.ewt[ai];
        }
    }
    for (int s = blockIdx.x; s < NE; s += G) {
        const int st = segst[s], cnt = cntL[s], nts = (cnt + 255) >> 8;
        for (int p = st + cnt + tid; p < st + nts * 256; p += NTHREADS) { P.rowtok[p] = 0; P.rowdst[p] = -1; P.roww[p] = 0.f; }
        if (tid < nts) { int* ta_ = P.tab + 2 * (tsa[s] + tid); ta_[0] = st + 256 * tid; ta_[1] = s; }
    }
}
constexpr int NPHASE = 20;
struct KArgs { const float* in[34]; float* out; unsigned char* ws; int ph_lo, ph_hi; };
template <int PLO, int PHI>
__global__ void __launch_bounds__(NTHREADS, 2) fwd_kernel(KArgs a) {
    extern __shared__ __attribute__((aligned(16))) unsigned char lds_raw[];
    LAS unsigned char* lds = (LAS unsigned char*)lds_raw;
    const int G = gridDim.x, bid = blockIdx.x, NGW = G * NWAVES;
#define PH_IDS() int tid = threadIdx.x; asm volatile("" : "+v"(tid)); const int lane = tid & 63, wave = __builtin_amdgcn_readfirstlane(tid >> 6), gw = bid * NWAVES + wave; (void)lane; (void)wave; (void)gw
    unsigned char* ws = a.ws;
    unsigned* ctl = (unsigned*)(ws + WS_CTL);
    float* mod = (float*)(ws + WS_MOD);
    constexpr int lo = PLO, hi = PHI;
    if (threadIdx.x == 0) *(LAS u32x4*)(lds + LDS_BARW) = (u32x4){0u, 0u, 0u, 0u};
    __syncthreads();
    XcdBarrier bar; bar.bar = ctl + CW_BAR; bar.x = 0; bar.st = nullptr;
    if (hi - lo > 1) bar = xcd_barrier_post(ctl + CW_BAR, (volatile LAS unsigned*)(lds + LDS_BARW));
#define IN(k) (lo <= (k) && (k) < hi)
#ifdef DBG_TIME
#define STAMP(k) do { if (blockIdx.x == 0 && threadIdx.x == 0) ((unsigned long long*)(ctl + 5200))[k] = __builtin_amdgcn_s_memrealtime(); } while (0)
#else
#define STAMP(k) do {} while (0)
#endif
#define SEAM(k) do { if (IN(k) && IN((k) + 1)) xcd_barrier(bar); } while (0)
#ifndef DBG_REPEAT
#define DBG_REPEAT (-1)
#define DBG_NREP 0
#endif
#define REP(k) for (int rep_ = 0; rep_ < (((k) == DBG_REPEAT) ? 1 + DBG_NREP : 1); ++rep_, (((k) == DBG_REPEAT && rep_ <= DBG_NREP) ? xcd_barrier(bar) : (void)0))

    STAMP(0);
    if (IN(0)) REP(0) { PH_IDS();
        phase_mod(a.in[1], a.in[2], a.in[3], mod, lds, tid, G);
        SmallW sw{a.in[6], a.in[22], a.in[23], a.in[24], a.in[25], a.in[30], a.in[31], a.in[32], a.in[9], a.in[11], a.in[12], a.in[20]};
        phase_small_weights(sw, ws, lds, gw, NGW, wave, lane);
    }
    SEAM(0); STAMP(1);
    if (IN(1)) REP(1) { PH_IDS();
        phase_norm_mod<false>(a.in[0], a.in[4], mod, 0, 1024, nullptr, ws + B_H1, gw, NGW, lane);
    }
    SEAM(1); STAMP(2);
    if (IN(2)) REP(2) {
        gm::DenseSched S; S.init(ws + B_H1, ws + SW_WIN, T, IN_COLS, D, G, bid, 1);
        gm::EpiInProj E{(bf16_t*)(ws + B_PRW), (bf16_t*)(ws + B_PUV), (bf16_t*)(ws + B_PG)};
        gm::gemm_phase<gm::EpiInProj, gm::DenseSched, true, true, 122>(lds, D, S, E);
    }
    SEAM(2); STAMP(3);
    if (IN(3)) REP(3) { PH_IDS();
        gl::Args Q{(const bf16_t*)(ws + B_PUV), (const bf16_t*)(ws + SW_WSM), a.in[21], a.in[18], a.in[19], ws + B_YB};
        const ExpW X{a.in[27], a.in[28], a.in[29], ws, (unsigned char*)a.out}; int cvi = gw;
        for (int u = bid; u < 512; u += G) gl::unit(Q, lds, u >> 6, u & 63, tid, X, cvi, NGW, 2 * CV_EARLY);
        for (; cvi < 2 * CV_EARLY; cvi += NGW) { const CvItem c = cv_decode_half(X, cvi); f32x4 v[8]; cv64_load(v, c.W, c.ldw, c.k0, c.n0, lane); cv64_finish(v, c.perm, c.k0, c.dst, c.ldt, c.drow0, (LAS float*)(lds + 77824 + wave * 8448), lane); }
        phase_xs((const bf16_t*)(ws + B_PRW), a.in[7], (bf16_t*)(ws + B_XS), gw, NGW, lane);
    }
    SEAM(3); STAMP(4);
    if (IN(4)) REP(4) { PH_IDS();
        rk::Args P{(const bf16_t*)(ws + B_PRW), a.in[7], a.in[8], a.in[10], a.in[13], a.in[14], a.in[15], (const bf16_t*)(ws + SW_WUP), (const bf16_t*)(ws + SW_AUP), (const bf16_t*)(ws + SW_GUP), (const bf16_t*)(ws + B_XS),
                   (bf16_t*)(ws + B_G), (bf16_t*)(ws + B_BV), ws + B_MN, ws + B_QY};
        phase_gate((const bf16_t*)(ws + B_XS), (const bf16_t*)(ws + SW_GUP), (bf16_t*)(ws + B_G), gw, NGW, lane);
        rk::Pre pre; rk::Hd hd; rk::load_mu(P, lds, tid);
        const bool fixh = (G % 8) == 0; const int nper = fixh ? (G >> 3) : G, first = fixh ? (bid >> 3) : bid, lim = fixh ? 1024 : 8192;
#define RK_UNIT_OF(idx, B_, H_, C_) const int B_ = fixh ? ((idx) >> 7) : ((idx) >> 10), H_ = fixh ? (bid & 7) : (((idx) >> 7) & 7), C_ = (idx) & 127
        if (first < lim) { RK_UNIT_OF(first, b0_, h0_, c0_); rk::prefetch(P, b0_, h0_, c0_, tid, pre); rk::load_head(P, h0_, tid, hd); }
        for (int idx = first; idx < lim; idx += nper) { const int nx = idx + nper; RK_UNIT_OF(idx, b_, h_, c_); RK_UNIT_OF(nx < lim ? nx : idx, nb_, nh__, nc_);
            rk::unit(P, lds, b_, h_, c_, (b_ * 8 + h_) * 128 + c_, tid, pre, hd, nx < lim, nb_, nh__, nc_); }
#undef RK_UNIT_OF
    }
    SEAM(4); STAMP(5);
    if (IN(5)) REP(5) { PH_IDS();
        for (int w = bid; w < 256; w += G) rk::scan_wg(ws + B_MN, ws + B_S, ((w & 7) + 8 * (w >> 5)) * 128, (w >> 3) & 3, lds, tid);
    }
    SEAM(5); STAMP(6);
    if (IN(6)) REP(6) { PH_IDS();
        rk::YArgs Y{ws + B_QY, ws + B_S, (const bf16_t*)(ws + B_G), (const bf16_t*)(ws + B_BV), a.in[16], a.in[17], ws + B_YB};
        for (int u = gw; u < 8192; u += NGW) rk::ypass_unit(Y, u, lane);
    }
    SEAM(6); STAMP(7);
    STAMP(8);
    if (IN(8)) REP(8) {
        gm::DenseSched S; S.init(ws + B_YB, ws + SW_WOA, T, D, D, G, bid, 1);
        gm::EpiMergeF E{(const bf16_t*)(ws + B_PG), ws + B_M8};
        gm::gemm_phase<gm::EpiMergeF, gm::DenseSched, true, true, 122>(lds, D, S, E);
    }
    STAMP(9);
    SEAM(9); STAMP(10);
    if (IN(10)) REP(10) {
        gm::DenseSched S; S.init(ws + B_M8, ws + SW_WO, T, D, D, G, bid, 1);
        gm::EpiResid E{(bf16_t*)(ws + B_X1), a.in[0], mod + 2048};
        gm::gemm_phase<gm::EpiResid, gm::DenseSched, true, true, 122>(lds, D, S, E);
    }
    SEAM(10); STAMP(11);
    if (IN(11)) REP(11) { PH_IDS();
        phase_norm_mod<true>(ws + B_X1, a.in[5], mod, 3072, 4096, (bf16_t*)(ws + B_H2), ws + B_H2F8, gw, NGW, lane);
        { const ExpW X{a.in[27], a.in[28], a.in[29], ws, (unsigned char*)a.out}; phase_expert_weights(X, lds, CV_EARLY, CV_SPLIT, gw, NGW, wave, lane); }
    }
    SEAM(11); STAMP(12);
    if (IN(12)) { PH_IDS();
        RouteArgs R{(const float*)(ws + B_SC), a.in[26], (int*)(ws + RT_EIDX), (float*)(ws + RT_EWT), (int*)(ws + RT_LRANK), (int*)(ws + RT_TBASE), ctl + CW_SEGCNT};
        { gm::DenseSched S; S.init(ws + B_H2, ws + SW_WR, T, NE, D, G, bid); gm::EpiRouter E{(float*)(ws + B_SC)}; gm::gemm_phase<gm::EpiRouter, gm::DenseSched, true>(lds, D, S, E);
          const ExpW X{a.in[27], a.in[28], a.in[29], ws, (unsigned char*)a.out}; int cvi = CV_SPLIT + gw;
          gm::Unit u; for (int i = 0; S.next(i, u); ++i) topk_tile(R, lds, tid, u.pm, X, cvi, NGW, CV_TOTAL);
          for (; cvi < CV_TOTAL; cvi += NGW) { const CvItem c = cv_decode(X, cvi); f32x4 v[16]; cv128_load(v, c.W, c.ldw, c.k0, c.n0, lane); cv128_finish(v, c.perm, c.k0, c.dst, c.ldt, c.drow0, (LAS float*)(lds + wave * 16896), lane); }
          __syncthreads(); }
        { gm::DenseSched S; S.init(ws + B_H2F8, ws + SW_WS13, T, 512, D, G, bid, 1); gm::EpiGateUp<true> E{ws + B_SH}; gm::gemm_phase<gm::EpiGateUp<true>, gm::DenseSched, true, true, 122>(lds, D, S, E); }
    }
    SEAM(12); STAMP(13);
    if (IN(13)) { PH_IDS();
        ScatArgs P{(const int*)(ws + RT_EIDX), (const float*)(ws + RT_EWT), (const int*)(ws + RT_LRANK), (const int*)(ws + RT_TBASE), ctl + CW_SEGCNT,
                   (int*)(ws + RT_ROWTOK), (int*)(ws + RT_ROWDST), (float*)(ws + RT_ROWW), (int*)(ws + RT_TAB), ctl + CW_NT};
        phase_scatter(P, lds, tid, G);
        __syncthreads();
        gm::DenseSched S; S.init(ws + B_SH, ws + SW_WS2, T, D, EFF, G, bid, 1);
        gm::EpiSharedDown E{ws + B_SHO};
        gm::gemm_phase<gm::EpiSharedDown, gm::DenseSched, true, true, 122>(lds, EFF, S, E);
    }
    SEAM(13); STAMP(14); STAMP(15);
    if (IN(15)) REP(15) {
        gm::GroupSched<true> S; S.A = (const char*)(ws + B_H2F8); S.B = (const char*)(ws + B_W13); S.tab = (const int*)(ws + RT_TAB); S.rowtok = (const int*)(ws + RT_ROWTOK);
        S.ntiles = (int)__hip_atomic_load(ctl + CW_NT, __ATOMIC_RELAXED, __HIP_MEMORY_SCOPE_AGENT); S.npn = 2; S.G = G; S.c = bid; S.K = D; S.ebytes = (size_t)512 * D; S.tstep = (size_t)256 * D;
        gm::EpiGateUp<true> E{ws + B_HID};
        gm::gemm_phase<gm::EpiGateUp<true>, gm::GroupSched<true>, true, true, 122>(lds, D, S, E);
    }
    SEAM(15); STAMP(16);
    if (IN(16)) REP(16) {
        gm::GroupSched<false> S; S.A = (const char*)(ws + B_HID); S.B = (const char*)a.out; S.tab = (const int*)(ws + RT_TAB); S.rowtok = nullptr;
        S.ntiles = (int)__hip_atomic_load(ctl + CW_NT, __ATOMIC_RELAXED, __HIP_MEMORY_SCOPE_AGENT); S.npn = 4; S.G = G; S.c = bid; S.K = EFF; S.ebytes = (size_t)D * EFF; S.tstep = (size_t)256 * EFF;
        gm::EpiExpertDown E{ws + B_SLOT, (const int*)(ws + RT_ROWDST), (const float*)(ws + RT_ROWW)};
        gm::gemm_phase<gm::EpiExpertDown, gm::GroupSched<false>, true, true, 122>(lds, EFF, S, E);
    }
    SEAM(16); STAMP(17);
    if (IN(17)) { PH_IDS(); phase_combine(a.out, (const bf16_t*)(ws + B_X1), ws + B_SLOT, ws + B_SHO, mod, a.in[33], gw, NGW, lane); }
    STAMP(18); STAMP(19);
    __syncthreads(); STAMP(20);
#undef IN
#undef SEAM
}

#if defined(DBG_CHECK) || defined(DBG_TIME)
#ifdef DBG_TIME
#ifndef TSC
#define TSC 0.25f
#endif
__global__ void dbg_time_out(float* out, const unsigned long long* st) {
    if (threadIdx.x == 0 && blockIdx.x == 0) { out[0] = (float)(st[TA1] - st[TA0]) * 0.01f * TSC; out[1] = (float)(st[TB1] - st[TB0]) * 0.01f * TSC; }
}
static void dbg_run(void* d_out, void* d_ws, hipStream_t stream) {
    dbg_time_out<<<1, 64, 0, stream>>>((float*)d_out, (const unsigned long long*)((unsigned*)((unsigned char*)d_ws + WS_CTL) + 5200));
}
#endif
#endif
#ifndef MK_SINGLE
#define MK_SINGLE 0
#endif
template <int PLO, int PHI> static bool prep_kernel() {
    int per_cu = 0;
    if (hipFuncSetAttribute((const void*)fwd_kernel<PLO, PHI>, hipFuncAttributeMaxDynamicSharedMemorySize, LDS_BYTES) != hipSuccess) { fprintf(stderr, "kernel_launch: hipFuncSetAttribute failed\n"); return false; }
    if (hipOccupancyMaxActiveBlocksPerMultiprocessor(&per_cu, (const void*)fwd_kernel<PLO, PHI>, NTHREADS, LDS_BYTES) != hipSuccess || per_cu < 1) { fprintf(stderr, "kernel_launch: occupancy query says %d\n", per_cu); (void)hipGetLastError(); return false; }
    return true;
}
template <int P> struct PhaseLaunch {
    static bool prep() { return prep_kernel<P, P + 1>() && PhaseLaunch<P + 1>::prep(); }
    static void go(int grid, hipStream_t stream, const KArgs& a) { hipLaunchKernelGGL((fwd_kernel<P, P + 1>), dim3(grid), dim3(NTHREADS), LDS_BYTES, stream, a); PhaseLaunch<P + 1>::go(grid, stream, a); }
};
#ifndef DBG_LAST
#define DBG_LAST NPHASE
#endif
template <> struct PhaseLaunch<DBG_LAST> { static bool prep() { return true; } static void go(int, hipStream_t, const KArgs&) {} };
extern "C" void kernel_launch(void* const* d_in, const int* in_sizes, int n_in, void* d_out, int out_size, void* d_ws, size_t ws_size, hipStream_t stream) {
    static int grid = 0;
    if (grid == 0) {
        if (n_in != 34 || out_size != T * D || ws_size < WS_END) { fprintf(stderr, "kernel_launch: unexpected problem shape (n_in %d, out %d, ws %zu < %zu)\n", n_in, out_size, ws_size, (size_t)WS_END); grid = -1; return; }
        int dev = 0, cus = 0;
        if (hipGetDevice(&dev) != hipSuccess || hipDeviceGetAttribute(&cus, hipDeviceAttributeMultiprocessorCount, dev) != hipSuccess) { grid = -1; return; }
#if MK_SINGLE
        if (!prep_kernel<0, NPHASE>()) { grid = -1; return; }
#else
        if (!PhaseLaunch<0>::prep()) { grid = -1; return; }
#endif
        grid = cus;
    }
    if (grid < 0) return;
    (void)hipMemsetAsync((char*)d_ws + WS_CTL, 0, CTL_ZERO_BYTES, stream);
    KArgs a{};
    for (int i = 0; i < 34; ++i) a.in[i] = (const float*)d_in[i];
    a.out = (float*)d_out; a.ws = (unsigned char*)d_ws; a.ph_lo = 0; a.ph_hi = NPHASE;
#if MK_SINGLE
    hipLaunchKernelGGL((fwd_kernel<0, NPHASE>), dim3(grid), dim3(NTHREADS), LDS_BYTES, stream, a);
#else
    PhaseLaunch<0>::go(grid, stream, a);
#endif
#if defined(DBG_CHECK) || defined(DBG_TIME)
    dbg_run(d_out, d_ws, stream);
#endif
}
```
